# Optimizing an MI355X kernel written in HIP

```python
import jax
import jax.numpy as jnp
from jax import lax
import numpy as np

D_MODEL = 1024
BATCH = 8
SEQ = 8192
DEPTH = 2

GRID_W = 64
CTX_LEN = 256
N_MIXERS = 2
N_RWKV = (DEPTH + 1) // 2
N_GLA = DEPTH // 2
NORM_EPS = 1e-6

RWKV_HEAD = 64
RWKV_HEADS = D_MODEL // RWKV_HEAD
DECAY_LORA = 64
ICLR_LORA = 64
GATE_LORA = 128
RWKV_GN_EPS = 64e-5

GLA_HEADS = 4
GLA_QK = D_MODEL // 2
GLA_DK = GLA_QK // GLA_HEADS
GLA_DV = D_MODEL // GLA_HEADS
GLA_GATE_RANK = 16
GLA_GATE_NORM = 16.0
GLA_CHUNK = 64
GLA_CONV_CH = 2 * GLA_QK + D_MODEL
GLA_IN = GLA_CONV_CH + D_MODEL + 2 * GLA_GATE_RANK
CONV_K = 3

PEER_HEADS = 8
N_KEYS = 128
N_EXPERTS = N_KEYS * N_KEYS
PEER_QDIM = 256
PEER_TOPK = 16
PEER_BLOCK = 128

kernel_name = "hybrid_rwkv7_gla_peer_dit"


def rms_norm(x, g, eps=NORM_EPS):
    xf = x.astype(jnp.float32)
    y = xf * lax.rsqrt(jnp.mean(jnp.square(xf), axis=-1, keepdims=True) + eps)
    return (y * g.astype(jnp.float32)).astype(x.dtype)


def ada_modulate(x, g, shift, scale):
    return rms_norm(x, g) * (1 + scale) + shift


def _flip(t):
    return jnp.flip(t, axis=1)


def _keep(t):
    return t


def centred_shift(x):
    z = jnp.zeros_like(x[:, :1])
    prev = jnp.concatenate([z, x[:, :-1]], axis=1)
    nxt = jnp.concatenate([x[:, 1:], z], axis=1)
    return 0.5 * (prev + nxt)


def rwkv7_project(h, p):
    B, T, _ = h.shape
    hd = (B, T, RWKV_HEADS, RWKV_HEAD)
    xx = centred_shift(h) - h
    xr, xw, xk, xv, xa, xg = (h + xx * p["mix"][j] for j in range(6))
    r, k, v = jnp.einsum("nbtd,nde->nbte", jnp.stack([xr, xk, xv]), p["w_rkv"])
    g = jax.nn.sigmoid(xg @ p["g1"]) @ p["g2"]
    kk = (k * p["k_k"]).reshape(hd).astype(jnp.float32)
    kk = kk / jnp.maximum(jnp.sqrt(jnp.sum(jnp.square(kk), axis=-1, keepdims=True)), 1e-12)
    decay, k_dir, b_dir = [], [], []
    for d in range(2):
        pre = (p["w0"][d] + jnp.tanh(xw @ p["w1"][d]) @ p["w2"][d]).astype(jnp.float32)
        w_log = -jax.nn.softplus(-pre) - 0.5
        decay.append(jnp.exp(-jnp.exp(w_log)).reshape(hd))
        a = jax.nn.sigmoid(p["a0"][d] + (xa @ p["a1"][d]) @ p["a2"][d])
        k_dir.append((k * (1 + (a - 1) * p["k_a"])).reshape(hd))
        b_dir.append(kk * a.reshape(hd).astype(jnp.float32))
    return dict(r=r.reshape(hd), v=v.reshape(hd), g=g, kk=kk, decay=decay, k=k_dir, b=b_dir)


def _rwkv7_step_inputs(P, d):
    return (P["r"], P["decay"][d], P["k"][d], P["v"], P["kk"], P["b"][d])


def rwkv7_scan(r, w, k, v, kk, b, s0):
    def step(s, inp):
        r_t, w_t, k_t, v_t, kk_t, b_t = inp
        sa = jnp.einsum("bhvk,bhk->bhv", s, kk_t)
        s = s * w_t[:, :, None, :] - sa[..., None] * b_t[:, :, None, :] + v_t[..., None] * k_t[:, :, None, :]
        y = jnp.einsum("bhvk,bhk->bhv", s, r_t)
        return s, y
    xs = tuple(jnp.moveaxis(t.astype(jnp.float32), 1, 0) for t in (r, w, k, v, kk, b))
    s, y = lax.scan(step, s0, xs)
    return jnp.moveaxis(y, 0, 1), s


def rwkv7_readout(y, P, p):
    B, T = y.shape[:2]
    mu = jnp.mean(y, axis=-1, keepdims=True)
    var = jnp.mean(jnp.square(y - mu), axis=-1, keepdims=True)
    yn = ((y - mu) * lax.rsqrt(var + RWKV_GN_EPS)).reshape(B, T, D_MODEL)
    yn = yn.astype(P["v"].dtype) * p["ln_w"] + p["ln_b"]
    bonus = (jnp.sum(P["r"] * P["k"][0] * p["r_k"], axis=-1, keepdims=True) * P["v"]
             + jnp.sum(P["r"] * P["k"][1] * p["r_k"], axis=-1, keepdims=True) * P["v"])
    return ((yn + bonus.reshape(B, T, D_MODEL)) * P["g"]) @ p["w_o"]


def rwkv7_mixer(h_lat, h_ctx, p, ctx_out):
    lat = rwkv7_project(h_lat, p)
    ctx = rwkv7_project(h_ctx, p)
    B = h_lat.shape[0]
    s0 = jnp.zeros((B, RWKV_HEADS, RWKV_HEAD, RWKV_HEAD), jnp.float32)
    y_lat, y_ctx = [], []
    for d in range(2):
        f = _flip if d else _keep
        yc, sc = rwkv7_scan(*[f(t) for t in _rwkv7_step_inputs(ctx, d)], s0)
        yl, _ = rwkv7_scan(*[f(t) for t in _rwkv7_step_inputs(lat, d)], sc)
        y_lat.append(f(yl))
        y_ctx.append(f(yc))
    out_lat = rwkv7_readout(y_lat[0] + y_lat[1], lat, p)
    out_ctx = rwkv7_readout(y_ctx[0] + y_ctx[1], ctx, p) if ctx_out else None
    return out_lat, out_ctx


def depthwise_conv2d(x, w):
    return lax.conv_general_dilated(x, w, (1, 1), "SAME",
                                    dimension_numbers=("NHWC", "HWIO", "NHWC"),
                                    feature_group_count=x.shape[-1])


def gla_project(h, p, rows):
    B, T, _ = h.shape
    z = h @ p["w_in"]
    qkv = z[..., :GLA_CONV_CH]
    if rows is None:
        qkv = depthwise_conv2d(qkv[:, None], p["conv"][1:2])[:, 0]
    else:
        qkv = depthwise_conv2d(qkv.reshape(B, rows, GRID_W, GLA_CONV_CH), p["conv"]).reshape(B, T, GLA_CONV_CH)
    qkv = jax.nn.silu(qkv)
    hk = (B, T, GLA_HEADS, GLA_DK)
    q = qkv[..., :GLA_QK].reshape(hk) * (GLA_DK ** -0.5)
    k = qkv[..., GLA_QK:2 * GLA_QK].reshape(hk)
    v = qkv[..., 2 * GLA_QK:].reshape(B, T, GLA_HEADS, GLA_DV)
    g = z[..., GLA_CONV_CH:GLA_CONV_CH + D_MODEL]
    lr = z[..., GLA_CONV_CH + D_MODEL:].reshape(B, T, 2, GLA_GATE_RANK)
    la = [(jax.nn.log_sigmoid((lr[:, :, d] @ p["gk_up"][d] + p["gk_b"][d]).astype(jnp.float32))
           / GLA_GATE_NORM).reshape(hk) for d in range(2)]
    return q, k, v, g, la


def gla_chunked(q, k, v, la, s0):
    B, T, H, K = q.shape
    C = GLA_CHUNK
    n = T // C

    def blk(t):
        return t.astype(jnp.float32).reshape(B, n, C, H, t.shape[-1]).transpose(1, 0, 3, 2, 4)

    q, k, v, la = blk(q), blk(k), blk(v), blk(la)
    bcum = jnp.cumsum(la, axis=3)
    ref = bcum[:, :, :, C // 2:C // 2 + 1]
    A = jnp.einsum("nbhik,nbhjk->nbhij", q * jnp.exp(bcum - ref), k * jnp.exp(ref - bcum))
    A = jnp.where(jnp.tril(jnp.ones((C, C), dtype=bool)), A, 0.0)
    o_intra = jnp.einsum("nbhij,nbhjv->nbhiv", A, v)
    b_last = bcum[:, :, :, -1:]
    q_dec = q * jnp.exp(bcum)
    k_dec = k * jnp.exp(b_last - bcum)
    d_last = jnp.exp(b_last[:, :, :, 0])

    def step(s, inp):
        qd, kd, vc, dl = inp
        o = jnp.einsum("bhck,bhkv->bhcv", qd, s)
        s = dl[..., None] * s + jnp.einsum("bhck,bhcv->bhkv", kd, vc)
        return s, o

    s, o_inter = lax.scan(step, s0, (q_dec, k_dec, v, d_last))
    o = o_intra + o_inter
    return o.transpose(1, 0, 3, 2, 4).reshape(B, T, H, v.shape[-1]), s


def gla_readout(o, g, p):
    B, T = o.shape[:2]
    on = o * lax.rsqrt(jnp.mean(jnp.square(o), axis=-1, keepdims=True) + NORM_EPS) * p["head_norm"].astype(jnp.float32)
    gate = jax.nn.silu(g).reshape(B, T, GLA_HEADS, GLA_DV)
    return (on.astype(g.dtype) * gate).reshape(B, T, D_MODEL) @ p["w_o"]


def gla_mixer(h_lat, h_ctx, p, rows, ctx_out):
    lq, lk, lv, lg, lla = gla_project(h_lat, p, rows)
    cq, ck, cv, cg, cla = gla_project(h_ctx, p, None)
    B = h_lat.shape[0]
    s0 = jnp.zeros((B, GLA_HEADS, GLA_DK, GLA_DV), jnp.float32)
    o_lat, o_ctx = [], []
    for d in range(2):
        f = _flip if d else _keep
        oc, sc = gla_chunked(f(cq), f(ck), f(cv), f(cla[d]), s0)
        ol, _ = gla_chunked(f(lq), f(lk), f(lv), f(lla[d]), sc)
        o_lat.append(f(ol))
        o_ctx.append(f(oc))
    out_lat = gla_readout(o_lat[0] + o_lat[1], lg, p)
    out_ctx = gla_readout(o_ctx[0] + o_ctx[1], cg, p) if ctx_out else None
    return out_lat, out_ctx


def peer(h, wq, sub_keys, u, v):
    B, T, D = h.shape
    xs = h.reshape(-1, PEER_BLOCK, D)

    def block(xb):
        q = (xb @ wq).reshape(PEER_BLOCK, PEER_HEADS, 2, PEER_QDIM // 2)
        s = jnp.einsum("thpc,hpnc->thpn", q, sub_keys).astype(jnp.float32)
        sv, si = lax.top_k(s, PEER_TOPK)
        cand = sv[:, :, 0, :, None] + sv[:, :, 1, None, :]
        cand_idx = si[:, :, 0, :, None] * N_KEYS + si[:, :, 1, None, :]
        top_s, top_pos = lax.top_k(cand.reshape(PEER_BLOCK, PEER_HEADS, PEER_TOPK * PEER_TOPK), PEER_TOPK)
        idx = jnp.take_along_axis(cand_idx.reshape(PEER_BLOCK, PEER_HEADS, PEER_TOPK * PEER_TOPK), top_pos, axis=-1)
        gate = jax.nn.softmax(top_s, axis=-1).astype(xb.dtype)
        ue = jnp.take(u, idx, axis=0)
        ve = jnp.take(v, idx, axis=0)
        act = jax.nn.gelu(jnp.einsum("thkd,td->thk", ue, xb), approximate=False)
        return jnp.einsum("thk,thkd->td", gate * act, ve)

    return lax.map(block, xs).reshape(B, T, D)


def setup_inputs(seed: int = 0) -> dict:
    key = jax.random.key(seed)
    ks = iter(jax.random.split(key, 48))
    f32 = jnp.float32

    def nrm(shape, scale):
        return jax.random.normal(next(ks), shape, f32) * scale

    def unif(shape, lo, hi):
        return jax.random.uniform(next(ks), shape, f32, lo, hi)

    D = D_MODEL
    NR, NG = N_RWKV, N_GLA
    inv = D ** -0.5
    return {
        "x": nrm((BATCH, SEQ, D), 1.0),
        "c": nrm((BATCH, D), 1.0),
        "ctx": nrm((BATCH, CTX_LEN, D), 1.0),
        "c_ctx": nrm((D,), 1.0),
        "ada_w": nrm((DEPTH, D, 6 * D), 0.5 * inv),
        "ada_b": nrm((DEPTH, 6 * D), 0.01),
        "norm_mix": 1.0 + nrm((DEPTH, D), 0.01),
        "norm_ffn": 1.0 + nrm((DEPTH, D), 0.01),
        "rw_mix": unif((NR, 6, D), 0.0, 1.0),
        "rw_w_rkv": nrm((NR, 3, D, D), inv),
        "rw_w0": unif((NR, 2, D), -6.0, -1.0),
        "rw_w1": nrm((NR, 2, D, DECAY_LORA), inv),
        "rw_w2": nrm((NR, 2, DECAY_LORA, D), 0.1 * DECAY_LORA ** -0.5),
        "rw_a0": nrm((NR, 2, D), 0.1),
        "rw_a1": nrm((NR, 2, D, ICLR_LORA), inv),
        "rw_a2": nrm((NR, 2, ICLR_LORA, D), 0.1 * ICLR_LORA ** -0.5),
        "rw_g1": nrm((NR, D, GATE_LORA), inv),
        "rw_g2": nrm((NR, GATE_LORA, D), GATE_LORA ** -0.5),
        "rw_k_k": 0.85 + nrm((NR, D), 0.02),
        "rw_k_a": 1.0 + nrm((NR, D), 0.02),
        "rw_r_k": nrm((NR, RWKV_HEADS, RWKV_HEAD), 0.1),
        "rw_ln_w": 1.0 + nrm((NR, D), 0.01),
        "rw_ln_b": nrm((NR, D), 0.01),
        "rw_w_o": nrm((NR, D, D), inv),
        "gla_w_in": nrm((NG, D, GLA_IN), inv),
        "gla_conv": nrm((NG, CONV_K, CONV_K, 1, GLA_CONV_CH), 1.0 / CONV_K),
        "gla_gk_up": nrm((NG, 2, GLA_GATE_RANK, GLA_QK), GLA_GATE_RANK ** -0.5),
        "gla_gk_b": nrm((NG, 2, GLA_QK), 0.1),
        "gla_head_norm": 1.0 + nrm((NG, GLA_DV), 0.01),
        "gla_w_o": nrm((NG, D, D), inv),
        "peer_wq": nrm((DEPTH, D, PEER_HEADS * PEER_QDIM), inv),
        "peer_keys": nrm((DEPTH, PEER_HEADS, 2, N_KEYS, PEER_QDIM // 2), (PEER_QDIM // 2) ** -0.5),
        "peer_u": nrm((DEPTH, N_EXPERTS, D), inv),
        "peer_v": nrm((DEPTH, N_EXPERTS, D), 1.0),
        "final_norm": 1.0 + nrm((D,), 0.01),
    }


def reference(x, c, ctx, c_ctx, ada_w, ada_b, norm_mix, norm_ffn,
              rw_mix, rw_w_rkv, rw_w0, rw_w1, rw_w2, rw_a0, rw_a1, rw_a2, rw_g1, rw_g2,
              rw_k_k, rw_k_a, rw_r_k, rw_ln_w, rw_ln_b, rw_w_o,
              gla_w_in, gla_conv, gla_gk_up, gla_gk_b, gla_head_norm, gla_w_o,
              peer_wq, peer_keys, peer_u, peer_v, final_norm):
    rows = x.shape[1] // GRID_W
    ctx_s = ctx
    silu_c = jax.nn.silu(c)
    silu_cc = jax.nn.silu(c_ctx)
    for i in range(DEPTH):
        last = i == DEPTH - 1
        mod_l = jnp.split((silu_c @ ada_w[i] + ada_b[i])[:, None, :], 6, axis=-1)
        mod_c = jnp.split(silu_cc @ ada_w[i] + ada_b[i], 6, axis=-1)
        h_l = ada_modulate(x, norm_mix[i], mod_l[0], mod_l[1])
        h_c = ada_modulate(ctx_s, norm_mix[i], mod_c[0], mod_c[1])
        j = i // N_MIXERS
        if i % N_MIXERS == 0:
            p = dict(mix=rw_mix[j], w_rkv=rw_w_rkv[j], w0=rw_w0[j], w1=rw_w1[j], w2=rw_w2[j],
                     a0=rw_a0[j], a1=rw_a1[j], a2=rw_a2[j], g1=rw_g1[j], g2=rw_g2[j],
                     k_k=rw_k_k[j], k_a=rw_k_a[j], r_k=rw_r_k[j], ln_w=rw_ln_w[j], ln_b=rw_ln_b[j],
                     w_o=rw_w_o[j])
            y_l, y_c = rwkv7_mixer(h_l, h_c, p, not last)
        else:
            p = dict(w_in=gla_w_in[j], conv=gla_conv[j], gk_up=gla_gk_up[j], gk_b=gla_gk_b[j],
                     head_norm=gla_head_norm[j], w_o=gla_w_o[j])
            y_l, y_c = gla_mixer(h_l, h_c, p, rows, not last)
        x = x + mod_l[2] * y_l
        x = x + mod_l[5] * peer(ada_modulate(x, norm_ffn[i], mod_l[3], mod_l[4]),
                                peer_wq[i], peer_keys[i], peer_u[i], peer_v[i])
        if not last:
            ctx_s = ctx_s + mod_c[2] * y_c
            ctx_s = ctx_s + mod_c[5] * peer(ada_modulate(ctx_s, norm_ffn[i], mod_c[3], mod_c[4]),
                                            peer_wq[i], peer_keys[i], peer_u[i], peer_v[i])
    return rms_norm(x, final_norm)
```

```cpp
#include <hip/hip_runtime.h>
#include <hip/hip_cooperative_groups.h>
#include <cstdio>
#include <cstdint>
namespace cg = cooperative_groups;

#define DEV __device__ __forceinline__

typedef unsigned short bf16_t;
typedef short bf16x8 __attribute__((ext_vector_type(8)));
typedef float f32x4 __attribute__((ext_vector_type(4)));
typedef __bf16 bf16x2v __attribute__((ext_vector_type(2)));

constexpr int D = 1024;
constexpr int NB = 8, SEQ = 8192, CTXL = 256;
constexpr int NL = NB * SEQ, NC = NB * CTXL, NT = NL + NC;
constexpr int NTHREADS = 512;
constexpr int LDS_BYTES = 160 * 1024;

constexpr size_t U_BYTES = (size_t)NT * 1024 * 2;
constexpr size_t WS_BAR = 0;
constexpr size_t WS_MOD = 16384;
constexpr size_t WS_CTXR = WS_MOD + (size_t)2 * 9 * 6144 * 4;
constexpr size_t WS_LR = WS_CTXR + (size_t)NC * 1024 * 4;
constexpr size_t WS_BONUS = WS_LR + (size_t)NT * 32 * 4;
constexpr size_t WS_WPROJ = WS_BONUS + (size_t)2 * NT * 16 * 4;
constexpr size_t WS_W2T = WS_WPROJ + (size_t)3456 * 1024 * 2;
constexpr size_t WS_A2T = WS_W2T + (size_t)2 * 1024 * 64 * 2;
constexpr size_t WS_G2T = WS_A2T + (size_t)2 * 1024 * 64 * 2;
constexpr size_t WS_WO0 = WS_G2T + (size_t)1024 * 128 * 2;
constexpr size_t WS_WO1 = WS_WO0 + (size_t)1024 * 1024 * 2;
constexpr size_t WS_WQ = WS_WO1 + (size_t)1024 * 1024 * 2;
constexpr size_t WS_KEYS = WS_WQ + (size_t)2 * 2048 * 1024 * 2;
constexpr size_t WS_WIN = WS_KEYS + (size_t)2 * 8 * 2 * 128 * 128 * 2;
constexpr size_t WS_PU = WS_WIN + (size_t)3200 * 1024 * 2;
constexpr size_t WS_PV = WS_PU + (size_t)2 * 16384 * 1024;
constexpr size_t WS_PSC = WS_PV + (size_t)2 * 16384 * 1024;
constexpr size_t WS_S = WS_PSC + (size_t)2 * 2 * 16384 * 4;
constexpr size_t WS_END = WS_S + 6 * U_BYTES;
static_assert(WS_END <= 1073741824ull, "workspace too large");
static_assert((WS_CTXR % 256) == 0 && (WS_WPROJ % 256) == 0 && (WS_S % 256) == 0, "alignment");

struct Params {
    const float* in[35];
    float* out;
    unsigned char* ws;
    int pad0, pad1;
};

DEV float bf_lo(unsigned u) { return __uint_as_float(u << 16); }
DEV float bf_hi(unsigned u) { return __uint_as_float(u & 0xffff0000u); }
typedef float f32x2v __attribute__((ext_vector_type(2)));
DEV unsigned pk_bf16(float lo, float hi) { const f32x2v f = {lo, hi}; union { bf16x2v v; unsigned u; } x; x.v = __builtin_convertvector(f, bf16x2v); return x.u; }
template <int N> DEV float dpp_ror(float x) { return __int_as_float(__builtin_amdgcn_update_dpp(0, __float_as_int(x), 0x120 + N, 0xF, 0xF, false)); }
DEV float row16_allreduce(float x) { x += dpp_ror<8>(x); x += dpp_ror<4>(x); x += dpp_ror<2>(x); x += dpp_ror<1>(x); return x; }
DEV float wave_allreduce(float x) { x = row16_allreduce(x); x += __shfl_xor(x, 16); x += __shfl_xor(x, 32); return x; }
DEV float sigmoidf_(float x) { return 1.0f / (1.0f + __expf(-x)); }
DEV float softplusf_(float z) { return fmaxf(z, 0.f) + __logf(1.0f + __expf(-fabsf(z))); }
DEV unsigned mono_u32(float f) { unsigned u = __float_as_uint(f); return u ^ ((u >> 31) ? 0xFFFFFFFFu : 0x80000000u); }
DEV float unmono_u32(unsigned k) { unsigned u = (k & 0x80000000u) ? (k ^ 0x80000000u) : ~k; return __uint_as_float(u); }
DEV bf16x8 as_bf16x8(uint4 v) { union { uint4 u; bf16x8 b; } x; x.u = v; return x.b; }
DEV int tid_opaque() { int t = threadIdx.x; asm volatile("" : "+v"(t)); return t; }
DEV int mod_batch(int R) { return R < NL ? (R >> 13) : 8; }

template <int BN, class AL, class EP>
DEV void gemm_unit(unsigned char* lds, const AL& al, const bf16_t* Bt, int K, int m0, const EP& ep) {
    constexpr int NI = BN / 64;
    constexpr int A_BYTES = 128 * 128;
    constexpr int B_BYTES = BN * 128;
    const int tid = tid_opaque(), lane = tid & 63, wv = tid >> 6, wm = wv >> 2, wn = wv & 3;
    const int fr = lane & 15, fq = lane >> 4;
    unsigned char* sA = lds;
    unsigned char* sB = lds + 2 * A_BYTES;
    f32x4 acc[4][NI];
#pragma unroll
    for (int mi = 0; mi < 4; ++mi)
#pragma unroll
        for (int ni = 0; ni < NI; ++ni) acc[mi][ni] = (f32x4){0.f, 0.f, 0.f, 0.f};
    const int KT = K >> 6;
    const int drow = tid >> 3, dch = (tid & 7) ^ (drow & 7);
    const bf16_t* bsrc = Bt + (size_t)drow * K + dch * 8;
    uint4 ra[2];
    auto stage = [&](int kt, int buf) {
        const int k0 = kt * 64;
#pragma unroll
        for (int i = 0; i < BN / 64; ++i)
            __builtin_amdgcn_global_load_lds((const unsigned*)(bsrc + (size_t)(64 * i) * K + k0), (unsigned*)(sB + buf * B_BYTES + i * 8192 + tid * 16), 16, 0, 0);
        if constexpr (AL::DMA) {
#pragma unroll
            for (int i = 0; i < 2; ++i)
                __builtin_amdgcn_global_load_lds((const unsigned*)(al.A + (size_t)(m0 + drow + 64 * i) * al.lda + k0 + dch * 8), (unsigned*)(sA + buf * A_BYTES + i * 8192 + tid * 16), 16, 0, 0);
        } else {
#pragma unroll
            for (int i = 0; i < 2; ++i) { const int q = tid + 512 * i; ra[i] = al.load(m0 + (q >> 3), k0 + (q & 7) * 8); }
        }
    };
    auto commit = [&](int buf) {
        if constexpr (!AL::DMA) {
#pragma unroll
            for (int i = 0; i < 2; ++i) { const int q = tid + 512 * i, row = q >> 3, ch = q & 7; *(uint4*)(sA + buf * A_BYTES + row * 128 + ((ch ^ (row & 7)) << 4)) = ra[i]; }
        }
    };
    auto compute = [&](int buf) {
        const unsigned char* a_base = sA + buf * A_BYTES;
        const unsigned char* b_base = sB + buf * B_BYTES;
#pragma unroll
        for (int ks = 0; ks < 2; ++ks) {
            bf16x8 af[4], bfr[NI];
            const int ch = ks * 4 + fq;
#pragma unroll
            for (int mi = 0; mi < 4; ++mi) { const int row = wm * 64 + mi * 16 + fr; af[mi] = *(const bf16x8*)(a_base + row * 128 + ((ch ^ (row & 7)) << 4)); }
#pragma unroll
            for (int ni = 0; ni < NI; ++ni) { const int row = wn * (BN / 4) + ni * 16 + fr; bfr[ni] = *(const bf16x8*)(b_base + row * 128 + ((ch ^ (row & 7)) << 4)); }
#pragma unroll
            for (int mi = 0; mi < 4; ++mi)
#pragma unroll
                for (int ni = 0; ni < NI; ++ni) acc[mi][ni] = __builtin_amdgcn_mfma_f32_16x16x32_bf16(bfr[ni], af[mi], acc[mi][ni], 0, 0, 0);
        }
    };
    if constexpr (AL::DMA) {
        constexpr int STG = A_BYTES + B_BYTES;
        auto stage3 = [&](int kt, int b3) {
            const int k0 = kt * 64;
            unsigned char* base = lds + b3 * STG;
#pragma unroll
            for (int i = 0; i < BN / 64; ++i)
                __builtin_amdgcn_global_load_lds((const unsigned*)(bsrc + (size_t)(64 * i) * K + k0), (unsigned*)(base + A_BYTES + i * 8192 + tid * 16), 16, 0, 0);
#pragma unroll
            for (int i = 0; i < 2; ++i)
                __builtin_amdgcn_global_load_lds((const unsigned*)(al.A + (size_t)(m0 + drow + 64 * i) * al.lda + k0 + dch * 8), (unsigned*)(base + i * 8192 + tid * 16), 16, 0, 0);
        };
        auto compute3 = [&](int b3) {
            const unsigned char* a_base = lds + b3 * STG;
            const unsigned char* b_base = a_base + A_BYTES;
#pragma unroll
            for (int ks = 0; ks < 2; ++ks) {
                bf16x8 af[4], bfr[NI];
                const int ch = ks * 4 + fq;
#pragma unroll
                for (int mi = 0; mi < 4; ++mi) { const int row = wm * 64 + mi * 16 + fr; af[mi] = *(const bf16x8*)(a_base + row * 128 + ((ch ^ (row & 7)) << 4)); }
#pragma unroll
                for (int ni = 0; ni < NI; ++ni) { const int row = wn * (BN / 4) + ni * 16 + fr; bfr[ni] = *(const bf16x8*)(b_base + row * 128 + ((ch ^ (row & 7)) << 4)); }
#pragma unroll
                for (int mi = 0; mi < 4; ++mi)
#pragma unroll
                    for (int ni = 0; ni < NI; ++ni) acc[mi][ni] = __builtin_amdgcn_mfma_f32_16x16x32_bf16(bfr[ni], af[mi], acc[mi][ni], 0, 0, 0);
            }
        };
        stage3(0, 0);
        stage3(1, 1);
        int b3 = 0;
        for (int kt = 0; kt < KT; ++kt) {
            if (kt + 1 < KT) { if constexpr (BN == 256) asm volatile("s_waitcnt vmcnt(6)" ::: "memory"); else asm volatile("s_waitcnt vmcnt(4)" ::: "memory"); }
            else asm volatile("s_waitcnt vmcnt(0)" ::: "memory");
            asm volatile("s_waitcnt lgkmcnt(0)" ::: "memory");
            __builtin_amdgcn_s_barrier();
            asm volatile("" ::: "memory");
            const int bn = (b3 == 0) ? 2 : b3 - 1;
            if (kt + 2 < KT) stage3(kt + 2, bn);
            compute3(b3);
            b3 = (b3 == 2) ? 0 : b3 + 1;
        }
        asm volatile("s_waitcnt lgkmcnt(0)" ::: "memory");
        __builtin_amdgcn_s_barrier();
        asm volatile("" ::: "memory");
    } else {
        stage(0, 0);
        commit(0);
        asm volatile("s_waitcnt vmcnt(0)" ::: "memory");
        __syncthreads();
        for (int kt = 0; kt < KT; ++kt) {
            const int cur = kt & 1;
            const bool more = (kt + 1 < KT);
            if (more) stage(kt + 1, cur ^ 1);
            compute(cur);
            if (more) commit(cur ^ 1);
            asm volatile("s_waitcnt vmcnt(0)" ::: "memory");
            __syncthreads();
        }
    }
    ep(acc, m0, wm, wn, fr, fq);
}

struct ALoadPlain {
    static constexpr bool DMA = true;
    const bf16_t* A; int lda;
    DEV uint4 load(int R, int k) const { return *(const uint4*)(A + (size_t)R * lda + k); }
};
struct ALoadMix {
    static constexpr bool DMA = false;
    const bf16_t* h; const float* mix; const bf16_t* A; int lda;
    DEV uint4 load(int R, int k) const {
        const bf16_t* pc = h + (size_t)R * 1024 + k;
        const uint4 c = *(const uint4*)pc;
        const int t = (R < NL) ? (R & 8191) : ((R - NL) & 255);
        const int last = (R < NL) ? 8191 : 255;
        uint4 pv = make_uint4(0, 0, 0, 0), nv = make_uint4(0, 0, 0, 0);
        if (t != 0) pv = *(const uint4*)(pc - 1024);
        if (t != last) nv = *(const uint4*)(pc + 1024);
        const float4 m0 = *(const float4*)(mix + k), m1 = *(const float4*)(mix + k + 4);
        const unsigned cc[4] = {c.x, c.y, c.z, c.w}, pp[4] = {pv.x, pv.y, pv.z, pv.w}, nn[4] = {nv.x, nv.y, nv.z, nv.w};
        const float mm[8] = {m0.x, m0.y, m0.z, m0.w, m1.x, m1.y, m1.z, m1.w};
        unsigned o[4];
#pragma unroll
        for (int i = 0; i < 4; ++i) {
            const float hc0 = bf_lo(cc[i]), hc1 = bf_hi(cc[i]);
            const float s0 = 0.5f * (bf_lo(pp[i]) + bf_lo(nn[i])), s1 = 0.5f * (bf_hi(pp[i]) + bf_hi(nn[i]));
            o[i] = pk_bf16(hc0 + (s0 - hc0) * mm[2 * i], hc1 + (s1 - hc1) * mm[2 * i + 1]);
        }
        return make_uint4(o[0], o[1], o[2], o[3]);
    }
};

struct TrJob { int in_idx, src_off, K, N, src_ld, dst_ld; unsigned long long dst_off; int tile0; };
constexpr int NTRJOBS = 19;
__device__ const TrJob g_trjobs[NTRJOBS] = {
    {9, 0 * 1048576, 1024, 1024, 1024, 1024, WS_WPROJ + 0ull * 1024 * 1024 * 2, 0},
    {9, 1 * 1048576, 1024, 1024, 1024, 1024, WS_WPROJ + 1ull * 1024 * 1024 * 2, 256},
    {9, 2 * 1048576, 1024, 1024, 1024, 1024, WS_WPROJ + 2ull * 1024 * 1024 * 2, 512},
    {11, 0, 1024, 64, 64, 1024, WS_WPROJ + 3072ull * 1024 * 2, 768},
    {11, 65536, 1024, 64, 64, 1024, WS_WPROJ + 3136ull * 1024 * 2, 784},
    {14, 0, 1024, 64, 64, 1024, WS_WPROJ + 3200ull * 1024 * 2, 800},
    {14, 65536, 1024, 64, 64, 1024, WS_WPROJ + 3264ull * 1024 * 2, 816},
    {16, 0, 1024, 128, 128, 1024, WS_WPROJ + 3328ull * 1024 * 2, 832},
    {12, 0, 64, 1024, 1024, 64, WS_W2T, 864},
    {12, 65536, 64, 1024, 1024, 64, WS_W2T + 1024ull * 64 * 2, 880},
    {15, 0, 64, 1024, 1024, 64, WS_A2T, 896},
    {15, 65536, 64, 1024, 1024, 64, WS_A2T + 1024ull * 64 * 2, 912},
    {17, 0, 128, 1024, 1024, 128, WS_G2T, 928},
    {23, 0, 1024, 1024, 1024, 1024, WS_WO0, 960},
    {29, 0, 1024, 1024, 1024, 1024, WS_WO1, 1216},
    {30, 0, 1024, 2048, 2048, 1024, WS_WQ, 1472},
    {30, 2097152, 1024, 2048, 2048, 1024, WS_WQ + 2048ull * 1024 * 2, 1984},
    {24, 0, 1024, 3104, 3104, 1024, WS_WIN, 2496},
    {0, 0, 0, 0, 0, 0, 0, 2496 + 16 * 49},
};
constexpr int NTRTILES = 2496 + 16 * 49;

DEV void phase0(const Params& p, unsigned char* lds) {
    const int tid = tid_opaque();
    unsigned char* ws = p.ws;
    {
        float* sc = (float*)lds;
        float* red = sc + 9 * 1024;
        float* mods = (float*)(ws + WS_MOD);
        bool have_sc = false;
        for (int task = blockIdx.x; task < 192; task += gridDim.x) {
            if (!have_sc) {
                for (int i = tid; i < 9 * 1024; i += NTHREADS) {
                    const int mb = i >> 10, k = i & 1023;
                    const float cv = mb < 8 ? p.in[1][mb * 1024 + k] : p.in[3][k];
                    sc[i] = cv / (1.0f + __expf(-cv));
                }
                have_sc = true;
            }
            __syncthreads();
            const int l = task / 96, nb = task % 96;
            const int nn = tid & 63, kg = tid >> 6;
            const float* w = p.in[4] + (size_t)l * 1024 * 6144 + nb * 64 + nn;
            float acc[9];
#pragma unroll
            for (int m = 0; m < 9; ++m) acc[m] = 0.f;
            for (int k = kg * 128; k < kg * 128 + 128; ++k) {
                const float wv = w[(size_t)k * 6144];
#pragma unroll
                for (int m = 0; m < 9; ++m) acc[m] += sc[m * 1024 + k] * wv;
            }
#pragma unroll
            for (int m = 0; m < 9; ++m) red[(kg * 9 + m) * 64 + nn] = acc[m];
            __syncthreads();
            for (int i = tid; i < 576; i += NTHREADS) {
                const int m = i >> 6, n2 = i & 63;
                float s = p.in[5][l * 6144 + nb * 64 + n2];
#pragma unroll
                for (int g = 0; g < 8; ++g) s += red[(g * 9 + m) * 64 + n2];
                mods[(size_t)(l * 9 + m) * 6144 + nb * 64 + n2] = s;
            }
            __syncthreads();
        }
        __syncthreads();
    }
    {
        float* tile = (float*)lds;
        for (int tt = blockIdx.x; tt < NTRTILES; tt += gridDim.x) {
            int j = 0;
#pragma unroll 1
            while (j + 1 < NTRJOBS && g_trjobs[j + 1].tile0 <= tt) ++j;
            const TrJob jb = g_trjobs[j];
            const int tl = tt - jb.tile0;
            const int ntn = (jb.N + 63) >> 6;
            const int k0 = (tl / ntn) * 64, n0 = (tl % ntn) * 64;
            const float* src = p.in[jb.in_idx] + jb.src_off;
            bf16_t* dst = (bf16_t*)(ws + jb.dst_off);
            {
                const int kr = tid >> 4, nc4 = (tid & 15) * 4;
#pragma unroll
                for (int i = 0; i < 2; ++i) {
                    const int kk = kr + 32 * i;
                    float4 v = make_float4(0.f, 0.f, 0.f, 0.f);
                    if (n0 + nc4 < jb.N) v = *(const float4*)(src + (size_t)(k0 + kk) * jb.src_ld + n0 + nc4);
                    tile[kk * 65 + nc4 + 0] = v.x; tile[kk * 65 + nc4 + 1] = v.y; tile[kk * 65 + nc4 + 2] = v.z; tile[kk * 65 + nc4 + 3] = v.w;
                }
            }
            __syncthreads();
            {
                const int nn = tid >> 3, kc = (tid & 7) * 8;
                if (n0 + nn < jb.N) {
                    unsigned o[4];
#pragma unroll
                    for (int i = 0; i < 4; ++i) o[i] = pk_bf16(tile[(kc + 2 * i) * 65 + nn], tile[(kc + 2 * i + 1) * 65 + nn]);
                    *(uint4*)(dst + (size_t)(n0 + nn) * jb.dst_ld + k0 + kc) = make_uint4(o[0], o[1], o[2], o[3]);
                }
            }
            __syncthreads();
        }
    }
    {
        const size_t gtid = (size_t)blockIdx.x * NTHREADS + tid, gstride = (size_t)gridDim.x * NTHREADS;
        {
            const float* src = p.in[31];
            bf16_t* dst = (bf16_t*)(ws + WS_KEYS);
            const size_t n8 = (size_t)2 * 8 * 2 * 128 * 128 / 8;
            for (size_t i = gtid; i < n8; i += gstride) {
                const float4 a = *(const float4*)(src + i * 8), b = *(const float4*)(src + i * 8 + 4);
                *(uint4*)(dst + i * 8) = make_uint4(pk_bf16(a.x, a.y), pk_bf16(a.z, a.w), pk_bf16(b.x, b.y), pk_bf16(b.z, b.w));
            }
        }
        bf16_t* wpad = (bf16_t*)(ws + WS_WIN) + (size_t)3104 * 1024;
        for (size_t i = gtid; i < (size_t)96 * 1024 / 8; i += gstride) *(uint4*)(wpad + i * 8) = make_uint4(0, 0, 0, 0);
        const int lane = tid & 63;
        const int gw = blockIdx.x * 8 + (tid >> 6), nw = gridDim.x * 8;
        float* scales = (float*)(ws + WS_PSC);
        for (int rowi = gw * 32; rowi < 2 * 32768; rowi += nw * 32)
        for (int row = rowi; row < rowi + 32; ++row) {
            const int tbl = row >> 15, r = row & 32767;
            const float* srow = p.in[32 + tbl] + (size_t)r * 1024;
            float4 v[4]; float am = 0.f;
#pragma unroll
            for (int i = 0; i < 4; ++i) { v[i] = *(const float4*)(srow + 256 * i + 4 * lane); am = fmaxf(am, fmaxf(fmaxf(fabsf(v[i].x), fabsf(v[i].y)), fmaxf(fabsf(v[i].z), fabsf(v[i].w)))); }
#pragma unroll
            for (int o = 1; o < 64; o <<= 1) am = fmaxf(am, __shfl_xor(am, o));
            const float scale = am > 0.f ? am * (1.0f / 448.0f) : 1.0f;
            const float inv = 1.0f / scale;
            unsigned w[4];
#pragma unroll
            for (int i = 0; i < 4; ++i) {
                int t = 0;
                t = __builtin_amdgcn_cvt_pk_fp8_f32(v[i].x * inv, v[i].y * inv, t, false);
                t = __builtin_amdgcn_cvt_pk_fp8_f32(v[i].z * inv, v[i].w * inv, t, true);
                w[i] = (unsigned)t;
            }
            *(uint4*)(ws + (tbl ? WS_PV : WS_PU) + (size_t)r * 1024 + 16 * lane) = make_uint4(w[0], w[1], w[2], w[3]);
            if (lane == 0) scales[tbl * 32768 + r] = scale;
        }
    }
}

DEV void normmod_store(const float4 (&v)[4], float ss, const float* g, const float* shift, const float* scale, bf16_t* dst, int lane) {
    const float rs = rsqrtf(ss * (1.0f / 1024.0f) + 1e-6f);
#pragma unroll
    for (int i = 0; i < 4; ++i) {
        const int col = i * 256 + lane * 4;
        const float4 gg = *(const float4*)(g + col), sh = *(const float4*)(shift + col), sc = *(const float4*)(scale + col);
        const float y0 = v[i].x * rs * gg.x * (1.f + sc.x) + sh.x, y1 = v[i].y * rs * gg.y * (1.f + sc.y) + sh.y;
        const float y2 = v[i].z * rs * gg.z * (1.f + sc.z) + sh.z, y3 = v[i].w * rs * gg.w * (1.f + sc.w) + sh.w;
        *(uint2*)(dst + col) = make_uint2(pk_bf16(y0, y1), pk_bf16(y2, y3));
    }
}
DEV void phase_normmod(const Params& p, int layer, int which, const float* xl, const float* xc, int nrows, bf16_t* dst) {
    const int tid = tid_opaque(), lane = tid & 63;
    const int gw = blockIdx.x * 8 + (tid >> 6), nw = gridDim.x * 8;
    const float* mods = (const float*)(p.ws + WS_MOD) + (size_t)layer * 9 * 6144;
    const float* g = p.in[which ? 7 : 6] + layer * 1024;
    for (int R = gw; R < nrows; R += nw) {
        const float* xr = R < NL ? xl + (size_t)R * 1024 : xc + (size_t)(R - NL) * 1024;
        float4 v[4]; float ss = 0.f;
#pragma unroll
        for (int i = 0; i < 4; ++i) { v[i] = *(const float4*)(xr + i * 256 + lane * 4); ss += v[i].x * v[i].x + v[i].y * v[i].y + v[i].z * v[i].z + v[i].w * v[i].w; }
        ss = wave_allreduce(ss);
        const float* mrow = mods + (size_t)mod_batch(R) * 6144 + (which ? 3 : 0) * 1024;
        normmod_store(v, ss, g, mrow, mrow + 1024, dst + (size_t)R * 1024, lane);
    }
}
template <int BN> struct EpiBf16 {
    bf16_t* dst; int ldd; int col0; int act;
    DEV void operator()(const f32x4 (&acc)[4][BN / 64], int m0, int wm, int wn, int fr, int fq) const {
#pragma unroll
        for (int mi = 0; mi < 4; ++mi) {
            const size_t R = (size_t)(m0 + wm * 64 + mi * 16 + fr);
#pragma unroll
            for (int ni = 0; ni < BN / 64; ++ni) {
                const int col = col0 + wn * (BN / 4) + ni * 16 + 4 * fq;
                float v[4] = {acc[mi][ni][0], acc[mi][ni][1], acc[mi][ni][2], acc[mi][ni][3]};
                if (act == 1) {
#pragma unroll
                    for (int j = 0; j < 4; ++j) v[j] = tanhf(v[j]);
                } else if (act == 2) {
#pragma unroll
                    for (int j = 0; j < 4; ++j) v[j] = sigmoidf_(v[j]);
                }
                *(uint2*)(dst + R * ldd + col) = make_uint2(pk_bf16(v[0], v[1]), pk_bf16(v[2], v[3]));
            }
        }
    }
};
struct EpiResid {
    const float* xold_lat; const float* xold_ctx; float* dst_lat; float* dst_ctx; const float* gate; int col0;
    DEV void operator()(const f32x4 (&acc)[4][4], int m0, int wm, int wn, int fr, int fq) const {
#pragma unroll
        for (int mi = 0; mi < 4; ++mi) {
            const int R = m0 + wm * 64 + mi * 16 + fr;
            const float* src = R < NL ? xold_lat + (size_t)R * 1024 : xold_ctx + (size_t)(R - NL) * 1024;
            float* dst = R < NL ? dst_lat + (size_t)R * 1024 : dst_ctx + (size_t)(R - NL) * 1024;
            const float* gr = gate + (size_t)mod_batch(R) * 6144;
#pragma unroll
            for (int ni = 0; ni < 4; ++ni) {
                const int col = col0 + wn * 64 + ni * 16 + 4 * fq;
                const float4 xo = *(const float4*)(src + col), g4 = *(const float4*)(gr + col);
                *(float4*)(dst + col) = make_float4(xo.x + g4.x * acc[mi][ni][0], xo.y + g4.y * acc[mi][ni][1], xo.z + g4.z * acc[mi][ni][2], xo.w + g4.w * acc[mi][ni][3]);
            }
        }
    }
};
struct EpiLr {
    float* dst;
    DEV void operator()(const f32x4 (&acc)[4][2], int m0, int wm, int wn, int fr, int fq) const {
        if (wn != 0) return;
#pragma unroll
        for (int mi = 0; mi < 4; ++mi) {
            const size_t R = (size_t)(m0 + wm * 64 + mi * 16 + fr);
#pragma unroll
            for (int ni = 0; ni < 2; ++ni) { const int col = ni * 16 + 4 * fq; *(float4*)(dst + R * 32 + col) = make_float4(acc[mi][ni][0], acc[mi][ni][1], acc[mi][ni][2], acc[mi][ni][3]); }
        }
    }
};

DEV void phase_rw_proj(const Params& p, unsigned char* lds) {
    unsigned char* ws = p.ws;
    const bf16_t* h = (const bf16_t*)(ws + WS_S + 0 * U_BYTES);
    const bf16_t* wproj = (const bf16_t*)(ws + WS_WPROJ);
    const int nunits = (NT / 128) * 15;
    for (int u = blockIdx.x; u < nunits; u += gridDim.x) {
        const int mt = u / 15, g = u % 15, m0 = mt * 128;
        if (g < 12) {
            const int grp = g >> 2, nt = g & 3;
            const int mixid = grp == 0 ? 0 : (grp == 1 ? 2 : 3);
            ALoadMix al{h, p.in[8] + mixid * 1024, h, 1024};
            EpiBf16<256> ep{(bf16_t*)(ws + WS_S + (size_t)(1 + grp) * U_BYTES), 1024, nt * 256, 0};
            gemm_unit<256>(lds, al, wproj + (size_t)(grp * 1024 + nt * 256) * 1024, 1024, m0, ep);
        } else {
            const int lg = g - 12;
            const int mixid = lg == 0 ? 1 : (lg == 1 ? 4 : 5);
            ALoadMix al{h, p.in[8] + mixid * 1024, h, 1024};
            EpiBf16<128> ep{(bf16_t*)(ws + WS_S + 4 * U_BYTES), 384, lg * 128, lg == 0 ? 1 : (lg == 1 ? 0 : 2)};
            gemm_unit<128>(lds, al, wproj + (size_t)(3072 + lg * 128) * 1024, 1024, m0, ep);
        }
    }
}

template <int N> DEV float dpp_shr0(float x) { return __int_as_float(__builtin_amdgcn_update_dpp(0, __float_as_int(x), 0x110 + N, 0xF, 0xF, true)); }
template <int CTRL> DEV float dpp_quad(float x) { return __int_as_float(__builtin_amdgcn_update_dpp(0, __float_as_int(x), CTRL, 0xF, 0xF, false)); }
DEV int tile_off(int row, int ch) { return row * 128 + ((ch ^ (row & 7)) << 4); }
DEV int tile_off2(int row, int ch) { return row * 128 + ((ch ^ ((row ^ (row >> 3)) & 7)) << 4); }
DEV void phase_rw_scan(const Params& p, unsigned char* lds) {
    const int tid = tid_opaque(), lane = tid & 63;
    const int wv = __builtin_amdgcn_readfirstlane(tid >> 6);
    const int fr = lane & 15, fq = lane >> 4;
    unsigned char* ws = p.ws;
    constexpr int SH = 0, SL = 8192, AT = 16384, RT = 18432, BT = 20480, KT = 22528, BKT = 24576  , UV = 40960  , NT = 57344;
    constexpr int MFA = 59392, MFK = 60416, X0 = 61440, VS = 65536  , PP = 73728, PM = 77824, PI = 81920, AA = 86016  ;
    constexpr int PL = 106496  , YB = 107520, LDS_END = 111616;
    const bf16_t* rbuf = (const bf16_t*)(ws + WS_S + 1 * U_BYTES);
    const bf16_t* kbuf = (const bf16_t*)(ws + WS_S + 2 * U_BYTES);
    const bf16_t* vbuf = (const bf16_t*)(ws + WS_S + 3 * U_BYTES);
    const bf16_t* lora = (const bf16_t*)(ws + WS_S + 4 * U_BYTES);
    for (int unit = blockIdx.x; unit < 256; unit += gridDim.x) {
        const int b = unit >> 5, hh = (unit >> 1) & 15, d = unit & 1;
        bf16_t* ydst = (bf16_t*)(ws + WS_S + (size_t)(d ? 5 : 0) * U_BYTES);
        float* bonus = (float*)(ws + WS_BONUS) + (size_t)((d * NB + b) * 16 + hh) * 8448;
        const int s_e = (tid >> 4) & 15, j0 = (tid & 15) * 4;
        const int ni = wv & 3;
        auto Rof = [&](int c, int s) -> int {
            if (c < 16) { const int q = c * 16 + s; return NL + b * 256 + (d ? 255 - q : q); }
            const int q = (c - 16) * 16 + s; return b * 8192 + (d ? 8191 - q : q);
        };
        constexpr int CST = LDS_END;
        uint2 pr = make_uint2(0, 0), pk = pr, pv = pr; uint4 paw[2], paa[2];
        if (wv >= 4) {
            const int ct = (tid - 256) * 16;
            *(float4*)(lds + CST + 0 * 4096 + ct) = *(const float4*)(p.in[18] + hh * 64 + j0);
            *(float4*)(lds + CST + 1 * 4096 + ct) = *(const float4*)(p.in[19] + hh * 64 + j0);
            *(float4*)(lds + CST + 2 * 4096 + ct) = *(const float4*)(p.in[20] + hh * 64 + j0);
            *(float4*)(lds + CST + 3 * 4096 + ct) = *(const float4*)(p.in[10] + d * 1024 + hh * 64 + ni * 16 + fq * 4);
            *(float4*)(lds + CST + 4 * 4096 + ct) = *(const float4*)(p.in[13] + d * 1024 + hh * 64 + ni * 16 + fq * 4);
#pragma unroll
            for (int ks = 0; ks < 2; ++ks) {
                *(uint4*)(lds + CST + (5 + ks) * 4096 + ct) = *(const uint4*)((const bf16_t*)(ws + WS_W2T) + (size_t)d * 1024 * 64 + (size_t)(hh * 64 + ni * 16 + fr) * 64 + ks * 32 + fq * 8);
                *(uint4*)(lds + CST + (7 + ks) * 4096 + ct) = *(const uint4*)((const bf16_t*)(ws + WS_A2T) + (size_t)d * 1024 * 64 + (size_t)(hh * 64 + ni * 16 + fr) * 64 + ks * 32 + fq * 8);
            }
        }
        auto load_lora = [&](int c) {
            const size_t R2 = (size_t)Rof(c, fr);
#pragma unroll
            for (int ks = 0; ks < 2; ++ks) { paw[ks] = *(const uint4*)(lora + R2 * 384 + d * 64 + ks * 32 + fq * 8); paa[ks] = *(const uint4*)(lora + R2 * 384 + 128 + d * 64 + ks * 32 + fq * 8); }
        };
        auto load_rkv = [&](int c) {
            const size_t off = (size_t)Rof(c, s_e) * 1024 + hh * 64 + j0;
            pr = *(const uint2*)(rbuf + off); pk = *(const uint2*)(kbuf + off); pv = *(const uint2*)(vbuf + off);
        };
        auto step_up = [&](int c) {
            const int ct = (tid - 256) * 16;
            const float4 bias_w = *(const float4*)(lds + CST + 3 * 4096 + ct), bias_a = *(const float4*)(lds + CST + 4 * 4096 + ct);
            bf16x8 bfw[2], bfa[2];
#pragma unroll
            for (int ks = 0; ks < 2; ++ks) { bfw[ks] = *(const bf16x8*)(lds + CST + (5 + ks) * 4096 + ct); bfa[ks] = *(const bf16x8*)(lds + CST + (7 + ks) * 4096 + ct); }
            f32x4 accw = {0.f, 0.f, 0.f, 0.f}, acca = {0.f, 0.f, 0.f, 0.f};
#pragma unroll
            for (int ks = 0; ks < 2; ++ks) { accw = __builtin_amdgcn_mfma_f32_16x16x32_bf16(bfw[ks], as_bf16x8(paw[ks]), accw, 0, 0, 0); acca = __builtin_amdgcn_mfma_f32_16x16x32_bf16(bfa[ks], as_bf16x8(paa[ks]), acca, 0, 0, 0); }
            const int n = ni * 16 + fq * 4;
            const float bw[4] = {bias_w.x, bias_w.y, bias_w.z, bias_w.w}, ba[4] = {bias_a.x, bias_a.y, bias_a.z, bias_a.w};
            float P[4], Pm[4], Pi[4], av[4];
#pragma unroll
            for (int j = 0; j < 4; ++j) {
                const float e = 0.6065306597f * __builtin_amdgcn_rcpf(1.0f + __expf(-(accw[j] + bw[j])));
                float s = e;
                s += dpp_shr0<1>(s); s += dpp_shr0<2>(s); s += dpp_shr0<4>(s); s += dpp_shr0<8>(s);
                P[j] = __expf(-s); Pi[j] = __builtin_amdgcn_rcpf(P[j]); Pm[j] = P[j] * __expf(e);
                av[j] = __builtin_amdgcn_rcpf(1.0f + __expf(-(acca[j] + ba[j])));
            }
            const int pb = (c & 1) * 16384;
            *(float4*)(lds + PP + pb + (fr * 64 + n) * 4) = make_float4(P[0], P[1], P[2], P[3]);
            *(float4*)(lds + PM + pb + (fr * 64 + n) * 4) = make_float4(Pm[0], Pm[1], Pm[2], Pm[3]);
            *(float4*)(lds + PI + pb + (fr * 64 + n) * 4) = make_float4(Pi[0], Pi[1], Pi[2], Pi[3]);
            *(float4*)(lds + AA + pb + (fr * 64 + n) * 4) = make_float4(av[0], av[1], av[2], av[3]);
            if (fr == 15) *(float4*)(lds + PL + (c & 3) * 256 + n * 4) = make_float4(P[0], P[1], P[2], P[3]);
        };
        auto step_vec = [&](int c) {
            const int eo = (s_e * 64 + j0) * 4, pb = (c & 1) * 16384, tb = (c & 1) * 8192, ct = (tid - 256) * 16;
            const float4 kk_c = *(const float4*)(lds + CST + 0 * 4096 + ct), ka_c = *(const float4*)(lds + CST + 1 * 4096 + ct), rk_c = *(const float4*)(lds + CST + 2 * 4096 + ct);
            const float4 a4 = *(const float4*)(lds + AA + pb + eo), P4 = *(const float4*)(lds + PP + pb + eo), Pm4 = *(const float4*)(lds + PM + pb + eo), Pi4 = *(const float4*)(lds + PI + pb + eo);
            const float kx[4] = {bf_lo(pk.x), bf_hi(pk.x), bf_lo(pk.y), bf_hi(pk.y)};
            const float rx[4] = {bf_lo(pr.x), bf_hi(pr.x), bf_lo(pr.y), bf_hi(pr.y)};
            const float av[4] = {a4.x, a4.y, a4.z, a4.w}, Pv[4] = {P4.x, P4.y, P4.z, P4.w}, Pmv[4] = {Pm4.x, Pm4.y, Pm4.z, Pm4.w}, Piv[4] = {Pi4.x, Pi4.y, Pi4.z, Pi4.w};
            const float kkc[4] = {kk_c.x, kk_c.y, kk_c.z, kk_c.w}, kac[4] = {ka_c.x, ka_c.y, ka_c.z, ka_c.w}, rkc[4] = {rk_c.x, rk_c.y, rk_c.z, rk_c.w};
            float t[4], n2 = 0.f;
#pragma unroll
            for (int j = 0; j < 4; ++j) { t[j] = kx[j] * kkc[j]; n2 += t[j] * t[j]; }
            n2 = row16_allreduce(n2);
            const float inv = 1.0f / fmaxf(sqrtf(n2), 1e-12f);
            float at[4], bt[4], kt[4], rt[4], bon = 0.f;
#pragma unroll
            for (int j = 0; j < 4; ++j) {
                const float kkv = t[j] * inv;
                const float kd = kx[j] * (1.0f + (av[j] - 1.0f) * kac[j]);
                const float bq = kkv * av[j];
                bon += rx[j] * kd * rkc[j];
                at[j] = -kkv * Pmv[j]; bt[j] = bq * Piv[j]; kt[j] = kd * Piv[j]; rt[j] = rx[j] * Pv[j];
            }
            bon = row16_allreduce(bon);
            if ((tid & 15) == 0) { const int Rb = Rof(c, s_e); bonus[Rb < NL ? 256 + (Rb & 8191) : ((Rb - NL) & 255)] = bon; }
            const int ro = tile_off(s_e, j0 >> 3) + (j0 & 7) * 2;
            *(uint2*)(lds + AT + ro) = make_uint2(pk_bf16(at[0], at[1]), pk_bf16(at[2], at[3]));
            *(uint2*)(lds + RT + ro) = make_uint2(pk_bf16(rt[0], rt[1]), pk_bf16(rt[2], rt[3]));
            const unsigned b01 = pk_bf16(bt[0], bt[1]), b23 = pk_bf16(bt[2], bt[3]), k01 = pk_bf16(kt[0], kt[1]), k23 = pk_bf16(kt[2], kt[3]);
            *(uint2*)(lds + BT + ro) = make_uint2(b01, b23);
            *(uint2*)(lds + KT + ro) = make_uint2(k01, k23);
            const unsigned bw2[4] = {b01 & 0xffffu, b01 >> 16, b23 & 0xffffu, b23 >> 16}, kw2[4] = {k01 & 0xffffu, k01 >> 16, k23 & 0xffffu, k23 >> 16};
            const unsigned vw[4] = {pv.x & 0xffffu, pv.x >> 16, pv.y & 0xffffu, pv.y >> 16};
            const int e0 = (s_e & 7) * 2, cq = s_e >> 3;
#pragma unroll
            for (int j = 0; j < 4; ++j) {
                const int row = j0 + j;
                *(bf16_t*)(lds + BKT + tb + tile_off2(row, 0 + cq) + e0) = (bf16_t)bw2[j];
                *(bf16_t*)(lds + BKT + tb + tile_off2(row, 2 + cq) + e0) = (bf16_t)kw2[j];
                *(bf16_t*)(lds + BKT + tb + tile_off2(row, 4 + cq) + e0) = (bf16_t)bw2[j];
                *(bf16_t*)(lds + UV + tb + tile_off2(row, 2 + cq) + e0) = (bf16_t)vw[j];
            }
            *(float4*)(lds + VS + (c & 1) * 4096 + eo) = make_float4(bf_lo(pv.x), bf_hi(pv.x), bf_lo(pv.y), bf_hi(pv.y));
        };
        f32x4 accY = {0.f, 0.f, 0.f, 0.f};
        auto step_prod = [&]() {
            const int vt = wv & 3;
            f32x4 accX = {0.f, 0.f, 0.f, 0.f};
#pragma unroll
            for (int ks = 0; ks < 2; ++ks) {
                const int ch = ks * 4 + fq;
                const bf16x8 sh = *(const bf16x8*)(lds + SH + tile_off(vt * 16 + fr, ch)), sl = *(const bf16x8*)(lds + SL + tile_off(vt * 16 + fr, ch));
                const bf16x8 bb = *(const bf16x8*)(lds + (wv < 4 ? RT : AT) + tile_off(fr, ch));
                accX = __builtin_amdgcn_mfma_f32_16x16x32_bf16(sh, bb, accX, 0, 0, 0);
                accX = __builtin_amdgcn_mfma_f32_16x16x32_bf16(sl, bb, accX, 0, 0, 0);
            }
            if (wv < 4) {
                accY = accX;
                f32x4 m = {0.f, 0.f, 0.f, 0.f};
#pragma unroll
                for (int ks = 0; ks < 2; ++ks) {
                    const int ch = ks * 4 + fq;
                    const bf16x8 fa = *(const bf16x8*)(lds + ((wv & 1) ? KT : BT) + tile_off(fr, ch));
                    const bf16x8 fb = *(const bf16x8*)(lds + ((wv & 2) ? RT : AT) + tile_off(fr, ch));
                    m = __builtin_amdgcn_mfma_f32_16x16x32_bf16(fa, fb, m, 0, 0, 0);
                }
                if (wv < 2) {
                    float* mf = (float*)(lds + (wv ? MFK : MFA));
#pragma unroll
                    for (int j = 0; j < 4; ++j) mf[(fr * 4 + j) * 4 + fq] = (4 * fq + j < fr) ? m[j] : 0.f;
                } else {
                    const float m0 = (4 * fq + 0 <= fr) ? m[0] : 0.f, m1 = (4 * fq + 1 <= fr) ? m[1] : 0.f, m2 = (4 * fq + 2 <= fr) ? m[2] : 0.f, m3 = (4 * fq + 3 <= fr) ? m[3] : 0.f;
                    const uint2 o = make_uint2(pk_bf16(m0, m1), pk_bf16(m2, m3));
                    const int colb = (wv == 2 ? 0 : 16) + 4 * fq;
                    *(uint2*)(lds + NT + tile_off(fr, colb >> 3) + (colb & 7) * 2) = o;
                    if (wv == 2) *(uint2*)(lds + NT + tile_off(fr, (32 + 4 * fq) >> 3) + ((32 + 4 * fq) & 7) * 2) = o;
                }
            } else {
#pragma unroll
                for (int j = 0; j < 4; ++j) *(float*)(lds + X0 + ((vt * 16 + 4 * fq + j) * 16 + fr) * 4) = accX[j];
            }
        };
        auto step_rec = [&](int c) {
            const int v = tid >> 2, pq = tid & 3;
            float cc[16];
#pragma unroll
            for (int i = 0; i < 4; ++i) { const float4 q = *(const float4*)(lds + X0 + (v * 16 + 4 * i) * 4); cc[4 * i] = q.x; cc[4 * i + 1] = q.y; cc[4 * i + 2] = q.z; cc[4 * i + 3] = q.w; }
            float vown[4];
#pragma unroll
            for (int i = 0; i < 4; ++i) vown[i] = *(const float*)(lds + VS + (c & 1) * 4096 + ((4 * i + pq) * 64 + v) * 4);
#pragma unroll
            for (int t = 1; t < 16; ++t) {
                const float4 mk = *(const float4*)(lds + MFK + ((t * 4 + pq) * 4) * 4);
                float s = vown[0] * mk.x; s = fmaf(vown[1], mk.y, s); s = fmaf(vown[2], mk.z, s); s = fmaf(vown[3], mk.w, s);
                s += dpp_quad<0xB1>(s); s += dpp_quad<0x4E>(s);
                cc[t] += s;
            }
            float4 ma[16];
#pragma unroll
            for (int t = 1; t < 16; ++t) ma[t] = *(const float4*)(lds + MFA + ((t * 4 + pq) * 4) * 4);
            ma[0] = make_float4(0.f, 0.f, 0.f, 0.f);
            float uown[4] = {0.f, 0.f, 0.f, 0.f}, uall[16];
#pragma unroll
            for (int t = 0; t < 16; ++t) {
                float s = uown[0] * ma[t].x; s = fmaf(uown[1], ma[t].y, s); s = fmaf(uown[2], ma[t].z, s); s = fmaf(uown[3], ma[t].w, s);
                s += dpp_quad<0xB1>(s); s += dpp_quad<0x4E>(s);
                const float u = cc[t] + s;
                uall[t] = u;
                if (pq == (t & 3)) uown[t >> 2] = u;
            }
            if (pq < 2) {
                unsigned o[8];
#pragma unroll
                for (int i = 0; i < 8; ++i) {
                    const unsigned hi = pk_bf16(uall[2 * i], uall[2 * i + 1]);
                    o[i] = pq ? pk_bf16(uall[2 * i] - bf_lo(hi), uall[2 * i + 1] - bf_hi(hi)) : hi;
                }
                const int cb = pq ? 4 : 0;
                *(uint4*)(lds + UV + (c & 1) * 8192 + tile_off2(v, cb)) = make_uint4(o[0], o[1], o[2], o[3]);
                *(uint4*)(lds + UV + (c & 1) * 8192 + tile_off2(v, cb + 1)) = make_uint4(o[4], o[5], o[6], o[7]);
            }
        };
        f32x4 accS[2];
        accS[0] = (f32x4){0.f, 0.f, 0.f, 0.f}; accS[1] = (f32x4){0.f, 0.f, 0.f, 0.f};
        auto step_upd = [&](int c) {
            const int vt = wv & 3;
            bf16x8 fuv[2];
#pragma unroll
            for (int ks = 0; ks < 2; ++ks) fuv[ks] = *(const bf16x8*)(lds + UV + (c & 1) * 8192 + tile_off2(vt * 16 + fr, ks * 4 + fq));
            if (wv < 4) {
#pragma unroll
                for (int ks = 0; ks < 2; ++ks) accY = __builtin_amdgcn_mfma_f32_16x16x32_bf16(fuv[ks], *(const bf16x8*)(lds + NT + tile_off(fr, ks * 4 + fq)), accY, 0, 0, 0);
                *(float4*)(lds + YB + (fr * 64 + vt * 16 + 4 * fq) * 4) = make_float4(accY[0], accY[1], accY[2], accY[3]);
            }
#pragma unroll
            for (int k2 = 0; k2 < 2; ++k2) {
                const int kt = 2 * (wv >> 2) + k2;
                f32x4 a = accS[k2];
#pragma unroll
                for (int ks = 0; ks < 2; ++ks) a = __builtin_amdgcn_mfma_f32_16x16x32_bf16(*(const bf16x8*)(lds + BKT + (c & 1) * 8192 + tile_off2(kt * 16 + fr, ks * 4 + fq)), fuv[ks], a, 0, 0, 0);
                const float4 pl = *(const float4*)(lds + PL + (c & 3) * 256 + (kt * 16 + 4 * fq) * 4);
                a[0] *= pl.x; a[1] *= pl.y; a[2] *= pl.z; a[3] *= pl.w;
                accS[k2] = a;
                const unsigned h01 = pk_bf16(a[0], a[1]), h23 = pk_bf16(a[2], a[3]);
                const unsigned l01 = pk_bf16(a[0] - bf_lo(h01), a[1] - bf_hi(h01)), l23 = pk_bf16(a[2] - bf_lo(h23), a[3] - bf_hi(h23));
                const int kc = kt * 16 + 4 * fq;
                const int so = tile_off(vt * 16 + fr, kc >> 3) + (kc & 7) * 2;
                *(uint2*)(lds + SH + so) = make_uint2(h01, h23);
                *(uint2*)(lds + SL + so) = make_uint2(l01, l23);
            }
        };
        for (int i = tid; i < LDS_END / 16; i += NTHREADS) *(uint4*)(lds + i * 16) = make_uint4(0, 0, 0, 0);
        if (wv >= 4) { load_lora(0); load_rkv(0); }
        __syncthreads();
        if (wv >= 4) { step_up(0); load_lora(1); }
        __syncthreads();
        if (wv >= 4) { step_vec(0); step_up(1); load_rkv(1); load_lora(2); }
        __syncthreads();
        step_prod();
        __syncthreads();
        auto ystore = [&](int c) {
            const float4 y4 = *(const float4*)(lds + YB + (s_e * 64 + j0) * 4);
            *(uint2*)(ydst + (size_t)Rof(c, s_e) * 1024 + hh * 64 + j0) = make_uint2(pk_bf16(y4.x, y4.y), pk_bf16(y4.z, y4.w));
        };
        for (int c = 0; c < 528; ++c) {
            if (wv < 4) {
                if (c > 0) ystore(c - 1);
                step_rec(c);
            } else {
                if (c + 1 < 528) step_vec(c + 1);
                if (c + 2 < 528) { step_up(c + 2); load_rkv(c + 2); }
                if (c + 3 < 528) load_lora(c + 3);
            }
            __syncthreads();
            step_upd(c);
            __syncthreads();
            if (c + 1 < 528) step_prod();
            __syncthreads();
        }
        if (wv < 4) ystore(527);
        __syncthreads();
    }
}

DEV void phase_rw_readout(const Params& p) {
    const int tid = tid_opaque(), lane = tid & 63, wv = tid >> 6, wm = wv >> 2, wn = wv & 3;
    const int fr = lane & 15, fq = lane >> 4;
    unsigned char* ws = p.ws;
    const bf16_t* y0b = (const bf16_t*)(ws + WS_S + 0 * U_BYTES);
    const bf16_t* y1b = (const bf16_t*)(ws + WS_S + 5 * U_BYTES);
    const bf16_t* vb = (const bf16_t*)(ws + WS_S + 3 * U_BYTES);
    const bf16_t* lora = (const bf16_t*)(ws + WS_S + 4 * U_BYTES);
    const bf16_t* g2t = (const bf16_t*)(ws + WS_G2T);
    bf16_t* ao = (bf16_t*)(ws + WS_S + 2 * U_BYTES);
    const float* bon0 = (const float*)(ws + WS_BONUS);
    const float* bon1 = bon0 + (size_t)NB * 16 * 8448;
    const float* lnw = p.in[21];
    const float* lnb = p.in[22];
    const int nunits = (NT / 128) * 4;
    for (int u = blockIdx.x; u < nunits; u += gridDim.x) {
        const int mt = u >> 2, nt = u & 3, m0 = mt * 128;
        const int hh = nt * 4 + wn;
        f32x4 acc[4][4];
#pragma unroll
        for (int mi = 0; mi < 4; ++mi)
#pragma unroll
            for (int ni = 0; ni < 4; ++ni) acc[mi][ni] = (f32x4){0.f, 0.f, 0.f, 0.f};
#pragma unroll 2
        for (int ks = 0; ks < 4; ++ks) {
            bf16x8 af[4], bfr[4];
#pragma unroll
            for (int mi = 0; mi < 4; ++mi) af[mi] = *(const bf16x8*)(lora + (size_t)(m0 + wm * 64 + mi * 16 + fr) * 384 + 256 + ks * 32 + fq * 8);
#pragma unroll
            for (int ni = 0; ni < 4; ++ni) bfr[ni] = *(const bf16x8*)(g2t + (size_t)(hh * 64 + ni * 16 + fr) * 128 + ks * 32 + fq * 8);
#pragma unroll
            for (int mi = 0; mi < 4; ++mi)
#pragma unroll
                for (int ni = 0; ni < 4; ++ni) acc[mi][ni] = __builtin_amdgcn_mfma_f32_16x16x32_bf16(bfr[ni], af[mi], acc[mi][ni], 0, 0, 0);
        }
#pragma unroll
        for (int mi = 0; mi < 4; ++mi) {
            const size_t R = (size_t)(m0 + wm * 64 + mi * 16 + fr);
            float yv[4][4]; float sum = 0.f;
#pragma unroll
            for (int ni = 0; ni < 4; ++ni) {
                const int col = hh * 64 + ni * 16 + 4 * fq;
                const uint2 a = *(const uint2*)(y0b + R * 1024 + col), b2 = *(const uint2*)(y1b + R * 1024 + col);
                yv[ni][0] = bf_lo(a.x) + bf_lo(b2.x); yv[ni][1] = bf_hi(a.x) + bf_hi(b2.x); yv[ni][2] = bf_lo(a.y) + bf_lo(b2.y); yv[ni][3] = bf_hi(a.y) + bf_hi(b2.y);
                sum += (yv[ni][0] + yv[ni][1]) + (yv[ni][2] + yv[ni][3]);
            }
            sum += __shfl_xor(sum, 16); sum += __shfl_xor(sum, 32);
            const float mu = sum * (1.0f / 64.0f);
            float q = 0.f;
#pragma unroll
            for (int ni = 0; ni < 4; ++ni)
#pragma unroll
                for (int j = 0; j < 4; ++j) { const float dlt = yv[ni][j] - mu; q += dlt * dlt; }
            q += __shfl_xor(q, 16); q += __shfl_xor(q, 32);
            const float rstd = rsqrtf(q * (1.0f / 64.0f) + 64e-5f);
            const size_t bidx = (size_t)(((R < NL ? (R >> 13) : ((R - NL) >> 8)) * 16 + hh)) * 8448 + (R < NL ? 256 + (R & 8191) : ((R - NL) & 255));
            const float bs = bon0[bidx] + bon1[bidx];
#pragma unroll
            for (int ni = 0; ni < 4; ++ni) {
                const int col = hh * 64 + ni * 16 + 4 * fq;
                const uint2 vv = *(const uint2*)(vb + R * 1024 + col);
                const float4 lw = *(const float4*)(lnw + col), lb = *(const float4*)(lnb + col);
                const float o0 = ((yv[ni][0] - mu) * rstd * lw.x + lb.x + bs * bf_lo(vv.x)) * acc[mi][ni][0];
                const float o1 = ((yv[ni][1] - mu) * rstd * lw.y + lb.y + bs * bf_hi(vv.x)) * acc[mi][ni][1];
                const float o2 = ((yv[ni][2] - mu) * rstd * lw.z + lb.z + bs * bf_lo(vv.y)) * acc[mi][ni][2];
                const float o3 = ((yv[ni][3] - mu) * rstd * lw.w + lb.w + bs * bf_hi(vv.y)) * acc[mi][ni][3];
                *(uint2*)(ao + R * 1024 + col) = make_uint2(pk_bf16(o0, o1), pk_bf16(o2, o3));
            }
        }
    }
}

DEV void phase_wo(const Params& p, unsigned char* lds, int layer) {
    unsigned char* ws = p.ws;
    const bf16_t* ao = (const bf16_t*)(ws + WS_S + 2 * U_BYTES);
    const bf16_t* wot = (const bf16_t*)(ws + (layer ? WS_WO1 : WS_WO0));
    float* ctxr = (float*)(ws + WS_CTXR);
    const float* gate = (const float*)(ws + WS_MOD) + (size_t)layer * 9 * 6144 + 2 * 1024;
    const int mtiles = layer ? NL / 128 : NT / 128;
    for (int u = blockIdx.x; u < mtiles * 4; u += gridDim.x) {
        const int mt = u >> 2, nt = u & 3;
        ALoadPlain al{ao, 1024};
        EpiResid ep{layer ? p.out : p.in[0], layer ? ctxr : p.in[2], p.out, ctxr, gate, nt * 256};
        gemm_unit<256>(lds, al, wot + (size_t)nt * 256 * 1024, 1024, mt * 128, ep);
    }
}

struct EpiQTile {
    unsigned char* lds;
    DEV void operator()(const f32x4 (&acc)[4][4], int m0, int wm, int wn, int fr, int fq) const {
        const int pp = wn >> 1;
#pragma unroll
        for (int mi = 0; mi < 4; ++mi) {
            const int m = wm * 64 + mi * 16 + fr;
#pragma unroll
            for (int ni = 0; ni < 4; ++ni) {
                const int c = (wn & 1) * 64 + ni * 16 + 4 * fq;
                *(uint2*)(lds + pp * 32768 + m * 256 + (((c >> 3) ^ (m & 15)) << 4) + (c & 7) * 2) = make_uint2(pk_bf16(acc[mi][ni][0], acc[mi][ni][1]), pk_bf16(acc[mi][ni][2], acc[mi][ni][3]));
            }
        }
    }
};
DEV void phase_peer_select(const Params& p, unsigned char* lds, int layer) {
    const int tid = tid_opaque(), lane = tid & 63, wv = tid >> 6, wm = wv >> 2, wn = wv & 3;
    const int fr = lane & 15, fq = lane >> 4;
    unsigned char* ws = p.ws;
    const bf16_t* hp = (const bf16_t*)(ws + WS_S + (size_t)(layer ? 0 : 1) * U_BYTES);
    const bf16_t* wqt = (const bf16_t*)(ws + WS_WQ) + (size_t)layer * 2048 * 1024;
    const bf16_t* keys = (const bf16_t*)(ws + WS_KEYS) + (size_t)layer * 8 * 2 * 128 * 128;
    int* pl_idx = (int*)(ws + WS_S + 3 * U_BYTES);
    float* pl_gate = (float*)(ws + WS_S + 3 * U_BYTES + (size_t)NT * 128 * 4);
    unsigned* slist = (unsigned*)lds;
    unsigned* tlist = (unsigned*)(lds + 256 * 132 * 4);
    const int mtiles = layer ? NL / 128 : NT / 128;
    for (int u = blockIdx.x; u < mtiles * 8; u += gridDim.x) {
        const int mt = u >> 3, head = u & 7, m0 = mt * 128;
        ALoadPlain al{hp, 1024};
        EpiQTile ep{lds};
        gemm_unit<256>(lds, al, wqt + (size_t)head * 256 * 1024, 1024, m0, ep);
        __syncthreads();
        const int pp = wn >> 1, nk0 = (wn & 1) * 64;
        f32x4 sc[4][4];
#pragma unroll
        for (int mi = 0; mi < 4; ++mi)
#pragma unroll
            for (int ni = 0; ni < 4; ++ni) sc[mi][ni] = (f32x4){0.f, 0.f, 0.f, 0.f};
        const bf16_t* kb = keys + (size_t)(head * 2 + pp) * 16384;
#pragma unroll
        for (int ks = 0; ks < 4; ++ks) {
            bf16x8 af[4], bfr[4];
            const int ch = ks * 4 + fq;
#pragma unroll
            for (int mi = 0; mi < 4; ++mi) { const int m = wm * 64 + mi * 16 + fr; af[mi] = *(const bf16x8*)(lds + pp * 32768 + m * 256 + ((ch ^ (m & 15)) << 4)); }
#pragma unroll
            for (int ni = 0; ni < 4; ++ni) bfr[ni] = *(const bf16x8*)(kb + (size_t)(nk0 + ni * 16 + fr) * 128 + ks * 32 + fq * 8);
#pragma unroll
            for (int mi = 0; mi < 4; ++mi)
#pragma unroll
                for (int ni = 0; ni < 4; ++ni) sc[mi][ni] = __builtin_amdgcn_mfma_f32_16x16x32_bf16(bfr[ni], af[mi], sc[mi][ni], 0, 0, 0);
        }
        __syncthreads();
#pragma unroll
        for (int mi = 0; mi < 4; ++mi) {
            const int m = wm * 64 + mi * 16 + fr;
#pragma unroll
            for (int ni = 0; ni < 4; ++ni) {
                const int n = nk0 + ni * 16 + 4 * fq;
                uint4 o;
                o.x = (mono_u32(sc[mi][ni][0]) & ~127u) | (unsigned)(127 - (n + 0));
                o.y = (mono_u32(sc[mi][ni][1]) & ~127u) | (unsigned)(127 - (n + 1));
                o.z = (mono_u32(sc[mi][ni][2]) & ~127u) | (unsigned)(127 - (n + 2));
                o.w = (mono_u32(sc[mi][ni][3]) & ~127u) | (unsigned)(127 - (n + 3));
                *(uint4*)(slist + (size_t)(pp * 128 + m) * 132 + n) = o;
            }
        }
        __syncthreads();
        if (tid < 256) {
            unsigned t[16];
#pragma unroll
            for (int i = 0; i < 16; ++i) t[i] = 0u;
            const unsigned* src = slist + (size_t)tid * 132;
#pragma unroll 2
            for (int j = 0; j < 32; ++j) {
                const uint4 v = *(const uint4*)(src + j * 4);
                unsigned xs[4] = {v.x, v.y, v.z, v.w};
#pragma unroll
                for (int e = 0; e < 4; ++e) {
                    unsigned x = xs[e];
#pragma unroll
                    for (int i = 0; i < 16; ++i) { const unsigned mx = max(t[i], x); x = min(t[i], x); t[i] = mx; }
                }
            }
#pragma unroll
            for (int i = 0; i < 4; ++i) *(uint4*)(tlist + tid * 16 + i * 4) = make_uint4(t[4 * i], t[4 * i + 1], t[4 * i + 2], t[4 * i + 3]);
        }
        __syncthreads();
        if (tid < 128) {
            float v0[16], v1[16];
#pragma unroll
            for (int i = 0; i < 16; ++i) { v0[i] = unmono_u32(tlist[tid * 16 + i] & ~127u); v1[i] = unmono_u32(tlist[(128 + tid) * 16 + i] & ~127u); }
            unsigned cd[16];
#pragma unroll
            for (int i = 0; i < 16; ++i) cd[i] = 0u;
#pragma unroll
            for (int i = 0; i < 16; ++i) {
#pragma unroll
                for (int j = 0; j < 16; ++j) {
                    if ((i + 1) * (j + 1) <= 16) {
                        unsigned x = (mono_u32(v0[i] + v1[j]) & ~255u) | (unsigned)(255 - (i * 16 + j));
#pragma unroll
                        for (int q = 0; q < 16; ++q) { const unsigned mx = max(cd[q], x); x = min(cd[q], x); cd[q] = mx; }
                    }
                }
            }
            float sv[16]; int ex[16];
#pragma unroll
            for (int q = 0; q < 16; ++q) {
                const int slot = 255 - (int)(cd[q] & 255u);
                const unsigned a = tlist[tid * 16 + (slot >> 4)], b2 = tlist[(128 + tid) * 16 + (slot & 15)];
                sv[q] = unmono_u32(a & ~127u) + unmono_u32(b2 & ~127u);
                ex[q] = (127 - (int)(a & 127u)) * 128 + (127 - (int)(b2 & 127u));
            }
            float mx = sv[0];
#pragma unroll
            for (int q = 1; q < 16; ++q) mx = fmaxf(mx, sv[q]);
            float den = 0.f;
#pragma unroll
            for (int q = 0; q < 16; ++q) { sv[q] = __expf(sv[q] - mx); den += sv[q]; }
            const float rden = 1.0f / den;
            const size_t base = ((size_t)head * NT + (m0 + tid)) * 16;
#pragma unroll
            for (int i = 0; i < 4; ++i) {
                *(int4*)(pl_idx + base + i * 4) = make_int4(ex[4 * i], ex[4 * i + 1], ex[4 * i + 2], ex[4 * i + 3]);
                *(float4*)(pl_gate + base + i * 4) = make_float4(sv[4 * i] * rden, sv[4 * i + 1] * rden, sv[4 * i + 2] * rden, sv[4 * i + 3] * rden);
            }
        }
        __syncthreads();
    }
}

typedef float f32x2 __attribute__((ext_vector_type(2)));
typedef unsigned int u32x4 __attribute__((ext_vector_type(4)));
DEV void phase_peer_gather(const Params& p, int layer, int fin) {
    const int tid = tid_opaque(), lane = tid & 63;
    const int gw = __builtin_amdgcn_readfirstlane(blockIdx.x * 8 + (tid >> 6)), nw = gridDim.x * 8;
    unsigned char* ws = p.ws;
    const bf16_t* hp = (const bf16_t*)(ws + WS_S + (size_t)(layer ? 0 : 1) * U_BYTES);
    const unsigned char* pu = ws + WS_PU + (size_t)layer * 16384 * 1024;
    const unsigned char* pvt = ws + WS_PV + (size_t)layer * 16384 * 1024;
    const unsigned lane16 = 16u * (unsigned)lane;
    const __amdgpu_buffer_rsrc_t rs_u = __builtin_amdgcn_make_buffer_rsrc((void*)pu, 0, 16384 * 1024, 0x00020000);
    const __amdgpu_buffer_rsrc_t rs_v = __builtin_amdgcn_make_buffer_rsrc((void*)pvt, 0, 16384 * 1024, 0x00020000);
    const float* usc = (const float*)(ws + WS_PSC) + layer * 16384;
    const float* vsc = (const float*)(ws + WS_PSC) + 32768 + layer * 16384;
    const int* pl_idx = (const int*)(ws + WS_S + 3 * U_BYTES);
    const float* pl_gate = (const float*)(ws + WS_S + 3 * U_BYTES + (size_t)NT * 128 * 4);
    float* ctxr = (float*)(ws + WS_CTXR);
    const float* mods = (const float*)(ws + WS_MOD) + (size_t)layer * 9 * 6144;
    const int nrows = layer ? NL : NT;
    uint4 bufA[16], bufB[16];
#define PG_LOAD(buf, tab, elo, ehi, g) { _Pragma("unroll") for (int e = 0; e < 16; ++e) { \
        const int ei = __builtin_amdgcn_readlane((g) < 4 ? (elo) : (ehi), ((g) * 16 + e) & 63); const u32x4 t4 = __builtin_amdgcn_raw_buffer_load_b128((tab), lane16, ei << 10, 0); buf[e] = make_uint4(t4.x, t4.y, t4.z, t4.w); } }
#define PG_DOT(buf, g) { _Pragma("unroll") for (int e = 0; e < 16; ++e) { \
        const unsigned uw[4] = {buf[e].x, buf[e].y, buf[e].z, buf[e].w}; f32x2 s2 = {0.f, 0.f}; \
        _Pragma("unroll") for (int i = 0; i < 4; ++i) { \
            const f32x2 a = __builtin_amdgcn_cvt_pk_f32_fp8((int)uw[i], false), b2 = __builtin_amdgcn_cvt_pk_f32_fp8((int)uw[i], true); \
            s2 += a * x2[2 * i] + b2 * x2[2 * i + 1]; } \
        const float s = wave_allreduce(s2.x + s2.y); \
        if (lane == (((g) * 16 + e) & 63)) { if ((g) < 4) d_lo = s; else d_hi = s; } } }
#define PG_AXPY(buf, g) { _Pragma("unroll") for (int e = 0; e < 16; ++e) { \
        const float cf = __int_as_float(__builtin_amdgcn_readlane(__float_as_int((g) < 4 ? c_lo : c_hi), ((g) * 16 + e) & 63)); \
        const f32x2 cf2 = {cf, cf}; const unsigned vw[4] = {buf[e].x, buf[e].y, buf[e].z, buf[e].w}; \
        _Pragma("unroll") for (int i = 0; i < 4; ++i) { \
            const f32x2 a = __builtin_amdgcn_cvt_pk_f32_fp8((int)vw[i], false), b2 = __builtin_amdgcn_cvt_pk_f32_fp8((int)vw[i], true); \
            acc2[2 * i] += cf2 * a; acc2[2 * i + 1] += cf2 * b2; } } }
    int R = gw;
    int e_lo = 0, e_hi = 0;
    const size_t pl_lo = (size_t)(lane >> 4) * NT * 16 + (lane & 15), pl_hi = pl_lo + (size_t)4 * NT * 16;
    if (R < nrows) { e_lo = pl_idx[pl_lo + (size_t)R * 16]; e_hi = pl_idx[pl_hi + (size_t)R * 16]; PG_LOAD(bufA, rs_u, e_lo, e_hi, 0); }
    for (; R < nrows; R += nw) {
        const bf16_t* hrow = hp + (size_t)R * 1024;
        f32x2 x2[8];
#pragma unroll
        for (int i = 0; i < 4; ++i) { const uint2 w = *(const uint2*)(hrow + 256 * i + 4 * lane); x2[2 * i] = (f32x2){bf_lo(w.x), bf_hi(w.x)}; x2[2 * i + 1] = (f32x2){bf_lo(w.y), bf_hi(w.y)}; }
        const float g_lo = pl_gate[pl_lo + (size_t)R * 16], g_hi = pl_gate[pl_hi + (size_t)R * 16];
        const float su_lo = usc[e_lo], su_hi = usc[e_hi], sv_lo = vsc[e_lo], sv_hi = vsc[e_hi];
        const int Rn = R + nw;
        int ne_lo = 0, ne_hi = 0;
        if (Rn < nrows) { ne_lo = pl_idx[pl_lo + (size_t)Rn * 16]; ne_hi = pl_idx[pl_hi + (size_t)Rn * 16]; }
        float d_lo = 0.f, d_hi = 0.f;
#pragma unroll 1
        for (int g = 0; g < 8; g += 2) {
            PG_LOAD(bufB, rs_u, e_lo, e_hi, g + 1);
            PG_DOT(bufA, g);
            if (g + 2 < 8) { PG_LOAD(bufA, rs_u, e_lo, e_hi, g + 2); } else { PG_LOAD(bufA, rs_v, e_lo, e_hi, 0); }
            PG_DOT(bufB, g + 1);
        }
        d_lo *= su_lo; d_hi *= su_hi;
        const float c_lo = g_lo * sv_lo * 0.5f * d_lo * (1.0f + erff(d_lo * 0.70710678118f));
        const float c_hi = g_hi * sv_hi * 0.5f * d_hi * (1.0f + erff(d_hi * 0.70710678118f));
        f32x2 acc2[8];
#pragma unroll
        for (int i = 0; i < 8; ++i) acc2[i] = (f32x2){0.f, 0.f};
#pragma unroll 1
        for (int g = 0; g < 8; g += 2) {
            PG_LOAD(bufB, rs_v, e_lo, e_hi, g + 1);
            PG_AXPY(bufA, g);
            if (g + 2 < 8) { PG_LOAD(bufA, rs_v, e_lo, e_hi, g + 2); } else if (Rn < nrows) { PG_LOAD(bufA, rs_u, ne_lo, ne_hi, 0); }
            PG_AXPY(bufB, g + 1);
        }
        e_lo = ne_lo; e_hi = ne_hi;
        float acc[16];
#pragma unroll
        for (int i = 0; i < 8; ++i) { acc[2 * i] = acc2[i].x; acc[2 * i + 1] = acc2[i].y; }
        float* xrow = R < NL ? p.out + (size_t)R * 1024 : ctxr + (size_t)(R - NL) * 1024;
        const float* mrow = mods + (size_t)mod_batch(R) * 6144;
        float xn[16]; float ss = 0.f;
#pragma unroll
        for (int i = 0; i < 4; ++i) {
            const int col = 256 * i + 4 * lane;
            const float4 xa = *(const float4*)(xrow + col), ga = *(const float4*)(mrow + 5 * 1024 + col);
            xn[4 * i] = xa.x + ga.x * acc[4 * i]; xn[4 * i + 1] = xa.y + ga.y * acc[4 * i + 1]; xn[4 * i + 2] = xa.z + ga.z * acc[4 * i + 2]; xn[4 * i + 3] = xa.w + ga.w * acc[4 * i + 3];
            ss += xn[4 * i] * xn[4 * i] + xn[4 * i + 1] * xn[4 * i + 1] + xn[4 * i + 2] * xn[4 * i + 2] + xn[4 * i + 3] * xn[4 * i + 3];
        }
        ss = wave_allreduce(ss);
        const float rs = rsqrtf(ss * (1.0f / 1024.0f) + 1e-6f);
        if (!fin) {
            const float* mrow1 = (const float*)(ws + WS_MOD) + (size_t)(layer + 1) * 9 * 6144 + (size_t)mod_batch(R) * 6144;
            const float* gn = p.in[6] + (layer + 1) * 1024;
            bf16_t* hdst = (bf16_t*)(ws + WS_S + 0 * U_BYTES) + (size_t)R * 1024;
#pragma unroll
            for (int i = 0; i < 4; ++i) {
                const int col = 256 * i + 4 * lane;
                *(float4*)(xrow + col) = make_float4(xn[4 * i], xn[4 * i + 1], xn[4 * i + 2], xn[4 * i + 3]);
                const float4 gg = *(const float4*)(gn + col), sh = *(const float4*)(mrow1 + col), sc = *(const float4*)(mrow1 + 1024 + col);
                const float y0 = xn[4 * i] * rs * gg.x * (1.f + sc.x) + sh.x, y1 = xn[4 * i + 1] * rs * gg.y * (1.f + sc.y) + sh.y;
                const float y2 = xn[4 * i + 2] * rs * gg.z * (1.f + sc.z) + sh.z, y3 = xn[4 * i + 3] * rs * gg.w * (1.f + sc.w) + sh.w;
                *(uint2*)(hdst + col) = make_uint2(pk_bf16(y0, y1), pk_bf16(y2, y3));
            }
        } else {
            const float* gn = p.in[34];
#pragma unroll
            for (int i = 0; i < 4; ++i) {
                const int col = 256 * i + 4 * lane;
                const float4 gg = *(const float4*)(gn + col);
                *(float4*)(xrow + col) = make_float4(xn[4 * i] * rs * gg.x, xn[4 * i + 1] * rs * gg.y, xn[4 * i + 2] * rs * gg.z, xn[4 * i + 3] * rs * gg.w);
            }
        }
    }
}

DEV void phase_gla_proj(const Params& p, unsigned char* lds) {
    unsigned char* ws = p.ws;
    const bf16_t* h = (const bf16_t*)(ws + WS_S + 0 * U_BYTES);
    const bf16_t* wint = (const bf16_t*)(ws + WS_WIN);
    const int nunits = (NT / 128) * 13;
    for (int u = blockIdx.x; u < nunits; u += gridDim.x) {
        const int mt = u / 13, g = u % 13, m0 = mt * 128;
        ALoadPlain al{h, 1024};
        if (g < 8) {
            EpiBf16<256> ep{(bf16_t*)(ws + WS_S + 1 * U_BYTES), 2048, g * 256, 0};
            gemm_unit<256>(lds, al, wint + (size_t)g * 256 * 1024, 1024, m0, ep);
        } else if (g < 12) {
            EpiBf16<256> ep{(bf16_t*)(ws + WS_S + 3 * U_BYTES), 1024, (g - 8) * 256, 0};
            gemm_unit<256>(lds, al, wint + (size_t)g * 256 * 1024, 1024, m0, ep);
        } else {
            EpiLr ep{(float*)(ws + WS_LR)};
            gemm_unit<128>(lds, al, wint + (size_t)3072 * 1024, 1024, m0, ep);
        }
    }
}

DEV void conv_emit(const float (&acc)[8], int c, bf16_t* dst) {
    const float qs = (c < 512) ? 0.08838834764831845f : 1.0f;
    unsigned ow[4];
#pragma unroll
    for (int j = 0; j < 4; ++j) { const float a0 = acc[2 * j], a1 = acc[2 * j + 1]; ow[j] = pk_bf16(a0 * sigmoidf_(a0) * qs, a1 * sigmoidf_(a1) * qs); }
    *(uint4*)dst = make_uint4(ow[0], ow[1], ow[2], ow[3]);
}
DEV void conv_tap(float (&acc)[8], const uint4& v, const float (&w)[8]) {
    acc[0] += bf_lo(v.x) * w[0]; acc[1] += bf_hi(v.x) * w[1]; acc[2] += bf_lo(v.y) * w[2]; acc[3] += bf_hi(v.y) * w[3];
    acc[4] += bf_lo(v.z) * w[4]; acc[5] += bf_hi(v.z) * w[5]; acc[6] += bf_lo(v.w) * w[6]; acc[7] += bf_hi(v.w) * w[7];
}
DEV void phase_gla_conv(const Params& p) {
    const int tid = tid_opaque();
    unsigned char* ws = p.ws;
    const bf16_t* z = (const bf16_t*)(ws + WS_S + 1 * U_BYTES);
    bf16_t* o = (bf16_t*)(ws + WS_S + 4 * U_BYTES);
    const float* cw = p.in[25];
    const int x = tid >> 3, cl = (tid & 7) * 8;
    for (int task = blockIdx.x; task < 8 * 8 * 32; task += gridDim.x) {
        const int cb = task & 31, ys = (task >> 5) & 7, b = task >> 8;
        const int c = cb * 64 + cl;
        float w[9][8];
#pragma unroll
        for (int t = 0; t < 9; ++t) { const float4 w0 = *(const float4*)(cw + t * 2048 + c), w1 = *(const float4*)(cw + t * 2048 + c + 4); w[t][0] = w0.x; w[t][1] = w0.y; w[t][2] = w0.z; w[t][3] = w0.w; w[t][4] = w1.x; w[t][5] = w1.y; w[t][6] = w1.z; w[t][7] = w1.w; }
        const uint4 zero4 = make_uint4(0, 0, 0, 0);
        auto load_row = [&](int y, uint4 (&r)[3]) {
            if (y < 0 || y >= 128) { r[0] = zero4; r[1] = zero4; r[2] = zero4; return; }
            const bf16_t* row = z + ((size_t)b * 8192 + (size_t)y * 64 + x) * 2048 + c;
            r[1] = *(const uint4*)row;
            r[0] = (x > 0) ? *(const uint4*)(row - 2048) : zero4;
            r[2] = (x < 63) ? *(const uint4*)(row + 2048) : zero4;
        };
        uint4 r0[3], r1[3], r2[3], r3[3];
        const int y0 = ys * 16;
        load_row(y0 - 1, r0); load_row(y0, r1); load_row(y0 + 1, r2);
#pragma unroll 1
        for (int yy = 0; yy < 16; ++yy) {
            load_row(yy < 15 ? y0 + yy + 2 : -1, r3);
            float acc[8];
#pragma unroll
            for (int j = 0; j < 8; ++j) acc[j] = 0.f;
#pragma unroll
            for (int dx = 0; dx < 3; ++dx) { conv_tap(acc, r0[dx], w[dx]); conv_tap(acc, r1[dx], w[3 + dx]); conv_tap(acc, r2[dx], w[6 + dx]); }
            conv_emit(acc, c, o + ((size_t)b * 8192 + (size_t)(y0 + yy) * 64 + x) * 2048 + c);
#pragma unroll
            for (int dx = 0; dx < 3; ++dx) { r0[dx] = r1[dx]; r1[dx] = r2[dx]; r2[dx] = r3[dx]; }
        }
    }
    for (int task = blockIdx.x; task < (NC / 64) * 8; task += gridDim.x) {
        const int rb = task >> 3, cbk = task & 7;
        const int R = NL + rb * 64 + (tid >> 3);
        const int t = (R - NL) & 255;
#pragma unroll 1
        for (int i = 0; i < 4; ++i) {
            const int c = cbk * 256 + (tid & 7) * 8 + i * 64;
            float acc[8];
#pragma unroll
            for (int j = 0; j < 8; ++j) acc[j] = 0.f;
#pragma unroll
            for (int dx = -1; dx <= 1; ++dx) {
                if (t + dx >= 0 && t + dx < 256) {
                    const uint4 v = *(const uint4*)(z + (size_t)(R + dx) * 2048 + c);
                    const float* wp = cw + (3 + (dx + 1)) * 2048 + c;
                    const float4 w0 = *(const float4*)wp, w1 = *(const float4*)(wp + 4);
                    const float wv[8] = {w0.x, w0.y, w0.z, w0.w, w1.x, w1.y, w1.z, w1.w};
                    conv_tap(acc, v, wv);
                }
            }
            conv_emit(acc, c, o + (size_t)R * 2048 + c);
        }
    }
}

DEV void phase_gla_scan(const Params& p, unsigned char* lds) {
    const int tid = tid_opaque(), lane = tid & 63, wv = tid >> 6;
    const int fr = lane & 15, fq = lane >> 4;
    unsigned char* ws = p.ws;
    constexpr int QE = 0, KE = 16384, QD = 32768, KDT = 49152, VT = 65536, AL = 73728, ST = 81920, BC = 98304, GS = 131072, LRL = 133632;
    const bf16_t* qkv = (const bf16_t*)(ws + WS_S + 4 * U_BYTES);
    const float* lrb = (const float*)(ws + WS_LR);
    float* bc = (float*)(lds + BC);
    float* gs = (float*)(lds + GS);
    float* lrl = (float*)(lds + LRL);
    for (int unit = blockIdx.x; unit < 256; unit += gridDim.x) {
        const int vs = unit & 3, d = (unit >> 2) & 1, hd = (unit >> 3) & 3, b = unit >> 5;
        bf16_t* odst = (bf16_t*)(ws + WS_S + (size_t)(d ? 1 : 0) * U_BYTES);
        const int lk = tid & 127, lig = tid >> 7;
        float gk[16];
#pragma unroll
        for (int q = 0; q < 16; ++q) gk[q] = p.in[26][(size_t)(d * 16 + q) * 512 + hd * 128 + lk];
        const float gbias = p.in[27][d * 512 + hd * 128 + lk];
        const int li = tid >> 3, lc = tid & 7;
        auto Rof = [&](int c, int i) -> int {
            if (c < 4) { const int q = c * 64 + i; return NL + b * 256 + (d ? 255 - q : q); }
            const int q = (c - 4) * 64 + i; return b * 8192 + (d ? 8191 - q : q);
        };
        uint4 rq[2], rk[2], rv; float2 rl;
        uint4 nq[2], nk[2], nv; float2 nl;
        auto load_chunk = [&](int c) {
            const size_t R = (size_t)Rof(c, li);
            const bf16_t* row = qkv + R * 2048;
            nq[0] = *(const uint4*)(row + hd * 128 + lc * 8); nq[1] = *(const uint4*)(row + hd * 128 + 64 + lc * 8);
            nk[0] = *(const uint4*)(row + 512 + hd * 128 + lc * 8); nk[1] = *(const uint4*)(row + 512 + hd * 128 + 64 + lc * 8);
            nv = *(const uint4*)(row + 1024 + hd * 256 + vs * 64 + lc * 8);
            nl = *(const float2*)(lrb + R * 32 + d * 16 + lc * 2);
        };
        f32x4 accS[4];
#pragma unroll
        for (int i = 0; i < 4; ++i) accS[i] = (f32x4){0.f, 0.f, 0.f, 0.f};
        for (int i = tid; i < 16384 / 16; i += NTHREADS) *(uint4*)(lds + ST + i * 16) = make_uint4(0, 0, 0, 0);
        load_chunk(0);
        for (int c = 0; c < 132; ++c) {
            rq[0] = nq[0]; rq[1] = nq[1]; rk[0] = nk[0]; rk[1] = nk[1]; rv = nv; rl = nl;
            if (c + 1 < 132) load_chunk(c + 1);
            *(float2*)(lrl + li * 16 + lc * 2) = rl;
            __syncthreads();
            {
                float run = 0.f;
#pragma unroll 4
                for (int ii = 0; ii < 16; ++ii) {
                    const int i = lig * 16 + ii;
                    float xx = gbias;
#pragma unroll
                    for (int q4 = 0; q4 < 4; ++q4) {
                        const float4 l4 = *(const float4*)(lrl + i * 16 + q4 * 4);
                        xx += l4.x * gk[q4 * 4] + l4.y * gk[q4 * 4 + 1] + l4.z * gk[q4 * 4 + 2] + l4.w * gk[q4 * 4 + 3];
                    }
                    const float la = (fminf(xx, 0.f) - __logf(1.0f + __expf(-fabsf(xx)))) * (1.0f / 16.0f);
                    run += la;
                    bc[i * 128 + lk] = run;
                }
                gs[lig * 128 + lk] = run;
            }
            __syncthreads();
            {
                if (tid < 128) gs[512 + tid] = __expf(gs[tid] + gs[128 + tid] + gs[256 + tid] + gs[384 + tid]);
                const int grp = li >> 4;
#pragma unroll
                for (int hseg = 0; hseg < 2; ++hseg) {
                    const int k0 = hseg * 64 + lc * 8;
                    float bcv[8], refv[8], lastv[8];
#pragma unroll
                    for (int j4 = 0; j4 < 2; ++j4) {
                        const float4 g0 = *(const float4*)(gs + k0 + j4 * 4), g1 = *(const float4*)(gs + 128 + k0 + j4 * 4);
                        const float4 g2 = *(const float4*)(gs + 256 + k0 + j4 * 4), g3 = *(const float4*)(gs + 384 + k0 + j4 * 4);
                        const float4 bi = *(const float4*)(bc + li * 128 + k0 + j4 * 4), b32 = *(const float4*)(bc + 32 * 128 + k0 + j4 * 4);
                        const float g0a[4] = {g0.x, g0.y, g0.z, g0.w}, g1a[4] = {g1.x, g1.y, g1.z, g1.w}, g2a[4] = {g2.x, g2.y, g2.z, g2.w}, g3a[4] = {g3.x, g3.y, g3.z, g3.w};
                        const float bia[4] = {bi.x, bi.y, bi.z, bi.w}, b32a[4] = {b32.x, b32.y, b32.z, b32.w};
#pragma unroll
                        for (int j = 0; j < 4; ++j) {
                            const float pre = (grp > 0 ? g0a[j] : 0.f) + (grp > 1 ? g1a[j] : 0.f) + (grp > 2 ? g2a[j] : 0.f);
                            bcv[j4 * 4 + j] = bia[j] + pre;
                            refv[j4 * 4 + j] = b32a[j] + g0a[j] + g1a[j];
                            lastv[j4 * 4 + j] = g0a[j] + g1a[j] + g2a[j] + g3a[j];
                        }
                    }
                    float eref[8], elast[8];
#pragma unroll
                    for (int j = 0; j < 8; ++j) { eref[j] = __expf(refv[j]); elast[j] = __expf(lastv[j] - refv[j]); }
                    const unsigned qw[4] = {rq[hseg].x, rq[hseg].y, rq[hseg].z, rq[hseg].w}, kw[4] = {rk[hseg].x, rk[hseg].y, rk[hseg].z, rk[hseg].w};
                    unsigned oqe[4], oke[4], oqd[4];
#pragma unroll
                    for (int j2 = 0; j2 < 4; ++j2) {
                        const float q0 = bf_lo(qw[j2]), q1 = bf_hi(qw[j2]), kk0 = bf_lo(kw[j2]), kk1 = bf_hi(kw[j2]);
                        const float b0 = bcv[2 * j2], b1 = bcv[2 * j2 + 1];
                        const float e0 = __expf(b0 - refv[2 * j2]), e1 = __expf(b1 - refv[2 * j2 + 1]);
                        const float r0 = __builtin_amdgcn_rcpf(e0), r1 = __builtin_amdgcn_rcpf(e1);
                        oqe[j2] = pk_bf16(q0 * e0, q1 * e1);
                        oke[j2] = pk_bf16(kk0 * r0, kk1 * r1);
                        oqd[j2] = pk_bf16(q0 * e0 * eref[2 * j2], q1 * e1 * eref[2 * j2 + 1]);
                        const unsigned kd2 = pk_bf16(kk0 * r0 * elast[2 * j2], kk1 * r1 * elast[2 * j2 + 1]);
                        const int kc0 = k0 + 2 * j2;
                        *(bf16_t*)(lds + KDT + tile_off2(kc0, li >> 3) + (li & 7) * 2) = (bf16_t)(kd2 & 0xffffu);
                        *(bf16_t*)(lds + KDT + tile_off2(kc0 + 1, li >> 3) + (li & 7) * 2) = (bf16_t)(kd2 >> 16);
                    }
                    const int chq = hseg * 8 + lc;
                    const int so = li * 256 + ((chq ^ (li & 15)) << 4);
                    *(uint4*)(lds + QE + so) = make_uint4(oqe[0], oqe[1], oqe[2], oqe[3]);
                    *(uint4*)(lds + KE + so) = make_uint4(oke[0], oke[1], oke[2], oke[3]);
                    *(uint4*)(lds + QD + so) = make_uint4(oqd[0], oqd[1], oqd[2], oqd[3]);
                }
                const unsigned vw[4] = {rv.x, rv.y, rv.z, rv.w};
#pragma unroll
                for (int j2 = 0; j2 < 4; ++j2) {
                    const int vc0 = lc * 8 + 2 * j2;
                    *(bf16_t*)(lds + VT + tile_off2(vc0, li >> 3) + (li & 7) * 2) = (bf16_t)(vw[j2] & 0xffffu);
                    *(bf16_t*)(lds + VT + tile_off2(vc0 + 1, li >> 3) + (li & 7) * 2) = (bf16_t)(vw[j2] >> 16);
                }
            }
            __syncthreads();
            const int it = wv & 3, pr2 = wv >> 2;
            f32x4 acco[2];
            {
#pragma unroll
                for (int jj = 0; jj < 2; ++jj) {
                    const int jt = pr2 * 2 + jj;
                    f32x4 a = {0.f, 0.f, 0.f, 0.f};
                    if (jt <= it) {
#pragma unroll
                        for (int ks = 0; ks < 4; ++ks) {
                            const int ch = ks * 4 + fq;
                            const int rj = jt * 16 + fr, ri = it * 16 + fr;
                            const bf16x8 fa = *(const bf16x8*)(lds + KE + rj * 256 + ((ch ^ (rj & 15)) << 4));
                            const bf16x8 fb = *(const bf16x8*)(lds + QE + ri * 256 + ((ch ^ (ri & 15)) << 4));
                            a = __builtin_amdgcn_mfma_f32_16x16x32_bf16(fa, fb, a, 0, 0, 0);
                        }
                    }
                    const int i = it * 16 + fr, j = jt * 16 + 4 * fq;
                    const float a0 = (j + 0 <= i) ? a[0] : 0.f, a1 = (j + 1 <= i) ? a[1] : 0.f, a2 = (j + 2 <= i) ? a[2] : 0.f, a3 = (j + 3 <= i) ? a[3] : 0.f;
                    *(uint2*)(lds + AL + i * 128 + (((j >> 3) ^ (i & 7)) << 4) + (j & 7) * 2) = make_uint2(pk_bf16(a0, a1), pk_bf16(a2, a3));
                }
#pragma unroll
                for (int vv = 0; vv < 2; ++vv) {
                    const int vt = pr2 * 2 + vv;
                    f32x4 a = {0.f, 0.f, 0.f, 0.f};
#pragma unroll
                    for (int ks = 0; ks < 4; ++ks) {
                        const int ch = ks * 4 + fq;
                        const int rvv = vt * 16 + fr, ri = it * 16 + fr;
                        const bf16x8 fa = *(const bf16x8*)(lds + ST + rvv * 256 + ((ch ^ (rvv & 15)) << 4));
                        const bf16x8 fb = *(const bf16x8*)(lds + QD + ri * 256 + ((ch ^ (ri & 15)) << 4));
                        a = __builtin_amdgcn_mfma_f32_16x16x32_bf16(fa, fb, a, 0, 0, 0);
                    }
                    acco[vv] = a;
                }
            }
            __syncthreads();
            {
#pragma unroll
                for (int vv = 0; vv < 2; ++vv) {
                    const int vt = pr2 * 2 + vv;
                    f32x4 a = acco[vv];
#pragma unroll
                    for (int ks = 0; ks < 2; ++ks) {
                        const int ch = ks * 4 + fq;
                        const int rvv = vt * 16 + fr, ri = it * 16 + fr;
                        const bf16x8 fa = *(const bf16x8*)(lds + VT + tile_off2(rvv, ch));
                        const bf16x8 fb = *(const bf16x8*)(lds + AL + ri * 128 + ((ch ^ (ri & 7)) << 4));
                        a = __builtin_amdgcn_mfma_f32_16x16x32_bf16(fa, fb, a, 0, 0, 0);
                    }
                    const int i = it * 16 + fr, vcol = vt * 16 + 4 * fq;
                    *(uint2*)(odst + (size_t)Rof(c, i) * 1024 + hd * 256 + vs * 64 + vcol) = make_uint2(pk_bf16(a[0], a[1]), pk_bf16(a[2], a[3]));
                }
                const int kt = wv;
                const float4 dl4 = *(const float4*)(gs + 512 + kt * 16 + 4 * fq);
                bf16x8 fa[2];
#pragma unroll
                for (int ks = 0; ks < 2; ++ks) { const int ch = ks * 4 + fq; const int rk2 = kt * 16 + fr; fa[ks] = *(const bf16x8*)(lds + KDT + tile_off2(rk2, ch)); }
#pragma unroll
                for (int vt = 0; vt < 4; ++vt) {
                    f32x4 a = accS[vt];
                    a[0] *= dl4.x; a[1] *= dl4.y; a[2] *= dl4.z; a[3] *= dl4.w;
#pragma unroll
                    for (int ks = 0; ks < 2; ++ks) {
                        const int ch = ks * 4 + fq; const int rvv = vt * 16 + fr;
                        const bf16x8 fb = *(const bf16x8*)(lds + VT + tile_off2(rvv, ch));
                        a = __builtin_amdgcn_mfma_f32_16x16x32_bf16(fa[ks], fb, a, 0, 0, 0);
                    }
                    accS[vt] = a;
                    const int vcol = vt * 16 + fr, kcol = kt * 16 + 4 * fq;
                    *(uint2*)(lds + ST + vcol * 256 + (((kcol >> 3) ^ (vcol & 15)) << 4) + (kcol & 7) * 2) = make_uint2(pk_bf16(a[0], a[1]), pk_bf16(a[2], a[3]));
                }
            }
        }
        __syncthreads();
    }
}

DEV void phase_gla_readout(const Params& p) {
    const int tid = tid_opaque(), lane = tid & 63;
    const int gw = blockIdx.x * 8 + (tid >> 6), nw = gridDim.x * 8;
    unsigned char* ws = p.ws;
    const bf16_t* o0 = (const bf16_t*)(ws + WS_S + 0 * U_BYTES);
    const bf16_t* o1 = (const bf16_t*)(ws + WS_S + 1 * U_BYTES);
    const bf16_t* gb = (const bf16_t*)(ws + WS_S + 3 * U_BYTES);
    bf16_t* ao = (bf16_t*)(ws + WS_S + 2 * U_BYTES);
    const float4 hn = *(const float4*)(p.in[28] + lane * 4);
    for (int item = gw; item < NL * 4; item += nw) {
        const size_t off = (size_t)(item >> 2) * 1024 + (item & 3) * 256 + lane * 4;
        const uint2 a = *(const uint2*)(o0 + off), b2 = *(const uint2*)(o1 + off), g2 = *(const uint2*)(gb + off);
        const float v0 = bf_lo(a.x) + bf_lo(b2.x), v1 = bf_hi(a.x) + bf_hi(b2.x), v2 = bf_lo(a.y) + bf_lo(b2.y), v3 = bf_hi(a.y) + bf_hi(b2.y);
        float ss = v0 * v0 + v1 * v1 + v2 * v2 + v3 * v3;
        ss = wave_allreduce(ss);
        const float rs = rsqrtf(ss * (1.0f / 256.0f) + 1e-6f);
        const float g0 = bf_lo(g2.x), g1 = bf_hi(g2.x), g2f = bf_lo(g2.y), g3 = bf_hi(g2.y);
        const float r0 = v0 * rs * hn.x * (g0 * sigmoidf_(g0)), r1 = v1 * rs * hn.y * (g1 * sigmoidf_(g1));
        const float r2 = v2 * rs * hn.z * (g2f * sigmoidf_(g2f)), r3 = v3 * rs * hn.w * (g3 * sigmoidf_(g3));
        *(uint2*)(ao + off) = make_uint2(pk_bf16(r0, r1), pk_bf16(r2, r3));
    }
}


#define LAS3 __attribute__((address_space(3)))
#define XB_TMO      128
#define XB_XCNT(j)  (256  + 64 * (j))
#define XB_XSUB(j)  (1280 + 64 * (j))
#define XB_XGEN(j)  (2304 + 64 * (j))
#define XB_TOP      3328
#define XB_TOPGEN   3392
#define XB_SPIN_CAP (1u << 22)
DEV unsigned xb_ld(unsigned* p) { return __hip_atomic_load(p, __ATOMIC_RELAXED, __HIP_MEMORY_SCOPE_AGENT); }
DEV unsigned xb_add(unsigned* p, unsigned v) { return __hip_atomic_fetch_add(p, v, __ATOMIC_RELAXED, __HIP_MEMORY_SCOPE_AGENT); }
DEV unsigned xb_xcc_id() { return (unsigned)__builtin_amdgcn_s_getreg((3 << 11) | 20) & 0xFu; }
#define XB_SPIN(cond, bar) do { unsigned _sp = 0; while (cond) { __builtin_amdgcn_s_sleep(1); \
    if ((++_sp & 255u) == 0u) { if (xb_ld(&(bar)[XB_TMO])) break; if (_sp > XB_SPIN_CAP) { atomicAdd(&(bar)[XB_TMO], 1u); break; } } } } while (0)
DEV void xcd_barrier_complete(unsigned* bar, unsigned x, unsigned& nloc, unsigned& nx) {
    const unsigned G = gridDim.x;
    unsigned sum, cnt, mine, sp = 0u;
    for (;;) {
        sum = 0u; cnt = 0u; mine = 0u;
#pragma unroll
        for (unsigned j = 0; j < 16; ++j) { const unsigned c = xb_ld(&bar[XB_XCNT(j)]); sum += c; cnt += (c > 0u) ? 1u : 0u; mine = (j == x) ? c : mine; }
        if (sum == G) break;
        __builtin_amdgcn_s_sleep(1);
        if ((++sp & 255u) == 0u) { if (xb_ld(&bar[XB_TMO])) break; if (sp > XB_SPIN_CAP) { atomicAdd(&bar[XB_TMO], 1u); break; } }
    }
    nloc = mine > 0u ? mine : 1u; nx = cnt > 0u ? cnt : 1u;
}
DEV void xcd_barrier(unsigned* bar, volatile LAS3 unsigned* st) {
    asm volatile("s_waitcnt vmcnt(0)" ::: "memory");
    __syncthreads();
    if (threadIdx.x == 0) {
        const unsigned x = xb_xcc_id();
        __builtin_amdgcn_s_waitcnt(0);
        unsigned nloc = st[0], nx = st[1];
        if (nloc == 0u) { xcd_barrier_complete(bar, x, nloc, nx); st[0] = nloc; st[1] = nx; }
        const unsigned old = xb_add(&bar[XB_XSUB(x)], 1u);
        const unsigned gen = old / nloc;
        if (old + 1u == (gen + 1u) * nloc) {
            __builtin_amdgcn_fence(__ATOMIC_RELEASE, "agent");
            asm volatile("s_waitcnt vmcnt(0)" ::: "memory");
            const unsigned og = xb_add(&bar[XB_TOP], 1u);
            const unsigned tg = og / nx;
            if (og + 1u == (tg + 1u) * nx) xb_add(&bar[XB_TOPGEN], 1u);
            else XB_SPIN(xb_ld(&bar[XB_TOPGEN]) == tg, bar);
            __builtin_amdgcn_fence(__ATOMIC_ACQUIRE, "agent");
            xb_add(&bar[XB_XGEN(x)], 1u);
            asm volatile("s_waitcnt vmcnt(0)" ::: "memory");
        } else {
            XB_SPIN(xb_ld(&bar[XB_XGEN(x)]) == gen, bar);
            __builtin_amdgcn_fence(__ATOMIC_ACQUIRE, "agent");
            asm volatile("s_waitcnt vmcnt(0)" ::: "memory");
        }
    }
    __syncthreads();
}
#define SYNC() do { asm volatile("s_waitcnt vmcnt(0)" ::: "memory"); grid.sync(); \
    if (threadIdx.x == 0) { __builtin_amdgcn_fence(__ATOMIC_ACQUIRE, "agent"); asm volatile("s_waitcnt vmcnt(0)" ::: "memory"); } \
    __syncthreads(); } while (0)
__global__ void __launch_bounds__(NTHREADS) mega_fwd(Params p) {
    extern __shared__ __attribute__((aligned(16))) unsigned char lds[];
    cg::grid_group grid = cg::this_grid();
    unsigned* xbar = (unsigned*)(p.ws + WS_BAR);
    volatile LAS3 unsigned* xst = (volatile LAS3 unsigned*)(lds + LDS_BYTES - 16);
    if (threadIdx.x == 0) { xst[0] = 0u; xst[1] = 0u; (void)xb_add(&xbar[XB_XCNT(xb_xcc_id())], 1u); }
    bf16_t* const S0 = (bf16_t*)(p.ws + WS_S + 0 * U_BYTES);
    bf16_t* const S1 = (bf16_t*)(p.ws + WS_S + 1 * U_BYTES);
    const float* const ctxr = (const float*)(p.ws + WS_CTXR);
    phase0(p, lds); SYNC();
#undef SYNC
#define SYNC() xcd_barrier(xbar, xst)
    phase_normmod(p, 0, 0, p.in[0], p.in[2], NT, S0); SYNC();
    phase_rw_proj(p, lds); SYNC();
    phase_rw_scan(p, lds); SYNC();
    phase_rw_readout(p); SYNC();
    phase_wo(p, lds, 0); SYNC();
    phase_normmod(p, 0, 1, p.out, ctxr, NT, S1); SYNC();
    phase_peer_select(p, lds, 0); SYNC();
    phase_peer_gather(p, 0, 0); SYNC();
    phase_gla_proj(p, lds); SYNC();
    phase_gla_conv(p); SYNC();
    phase_gla_scan(p, lds); SYNC();
    phase_gla_readout(p); SYNC();
    phase_wo(p, lds, 1); SYNC();
    phase_normmod(p, 1, 1, p.out, ctxr, NL, S0); SYNC();
    phase_peer_select(p, lds, 1); SYNC();
    phase_peer_gather(p, 1, 1);
}

extern "C" void kernel_launch(void* const* d_in, const int* in_sizes, int n_in, void* d_out, int out_size, void* d_ws, size_t ws_size, hipStream_t stream) {
    static int grid_blocks = 0;
    if (grid_blocks == 0) {
        if (n_in != 35 || ws_size < WS_END) { fprintf(stderr, "kernel_launch: unexpected n_in %d or ws_size %zu (< %zu)\n", n_in, ws_size, (size_t)WS_END); grid_blocks = -1; return; }
        int dev = 0, cus = 0, per_cu = 0;
        if (hipGetDevice(&dev) != hipSuccess || hipDeviceGetAttribute(&cus, hipDeviceAttributeMultiprocessorCount, dev) != hipSuccess) { fprintf(stderr, "kernel_launch: device query failed\n"); grid_blocks = -1; return; }
        if (hipFuncSetAttribute((const void*)mega_fwd, hipFuncAttributeMaxDynamicSharedMemorySize, LDS_BYTES) != hipSuccess) { fprintf(stderr, "kernel_launch: hipFuncSetAttribute failed\n"); grid_blocks = -1; return; }
        if (hipOccupancyMaxActiveBlocksPerMultiprocessor(&per_cu, (const void*)mega_fwd, NTHREADS, LDS_BYTES) != hipSuccess || per_cu < 1) { fprintf(stderr, "kernel_launch: occupancy query says %d blocks per CU\n", per_cu); grid_blocks = -1; return; }
        grid_blocks = cus;
    }
    if (grid_blocks < 0) return;
    Params p{};
    for (int i = 0; i < 35; ++i) p.in[i] = (const float*)d_in[i];
    p.out = (float*)d_out;
    p.ws = (unsigned char*)d_ws;
    if (hipMemsetAsync((char*)d_ws + WS_BAR, 0, 16384, stream) != hipSuccess) { fprintf(stderr, "kernel_launch: hipMemsetAsync failed\n"); return; }
    void* args[] = {&p};
    hipError_t e = hipLaunchCooperativeKernel((const void*)mega_fwd, dim3(grid_blocks), dim3(NTHREADS), args, LDS_BYTES, stream);
    if (e != hipSuccess) fprintf(stderr, "kernel_launch: cooperative launch failed: %s (grid %d)\n", hipGetErrorString(e), grid_blocks);
}
```

```cpp
#include <hip/hip_runtime.h>
#include <hip/hip_cooperative_groups.h>
#include <cstdio>
#include <cstdint>
namespace cg = cooperative_groups;

#define DEV __device__ __forceinline__
#ifndef REP
#define REP 0
#endif
#define REPEAT(n, stmt) do { if (REP == (n)) { stmt; SYNC(); } } while (0)

typedef unsigned short bf16_t;
typedef short bf16x8 __attribute__((ext_vector_type(8)));
typedef float f32x4 __attribute__((ext_vector_type(4)));
typedef __bf16 bf16x2v __attribute__((ext_vector_type(2)));

constexpr int D = 1024;
constexpr int NB = 8, SEQ = 8192, CTXL = 256;
constexpr int NL = NB * SEQ, NC = NB * CTXL, NT = NL + NC;
constexpr int NTHREADS = 512;
constexpr int LDS_BYTES = 160 * 1024;

constexpr size_t U_BYTES = (size_t)NT * 1024 * 2;
constexpr size_t WS_BAR = 0;
constexpr size_t WS_MOD = 16384;
constexpr size_t WS_CTXR = WS_MOD + (size_t)2 * 9 * 6144 * 4;
constexpr size_t WS_LR = WS_CTXR + (size_t)NC * 1024 * 4;
constexpr size_t WS_BONUS = WS_LR + (size_t)NT * 32 * 4;
constexpr size_t WS_WPROJ = WS_BONUS + (size_t)2 * NT * 16 * 4;
constexpr size_t WS_W2T = WS_WPROJ + (size_t)3456 * 1024 * 2;
constexpr size_t WS_A2T = WS_W2T + (size_t)2 * 1024 * 64 * 2;
constexpr size_t WS_G2T = WS_A2T + (size_t)2 * 1024 * 64 * 2;
constexpr size_t WS_WO0 = WS_G2T + (size_t)1024 * 128 * 2;
constexpr size_t WS_WO1 = WS_WO0 + (size_t)1024 * 1024 * 2;
constexpr size_t WS_WQ = WS_WO1 + (size_t)1024 * 1024 * 2;
constexpr size_t WS_KEYS = WS_WQ + (size_t)2 * 2048 * 1024 * 2;
constexpr size_t WS_WIN = WS_KEYS + (size_t)2 * 8 * 2 * 128 * 128 * 2;
constexpr size_t WS_PU = WS_WIN + (size_t)3200 * 1024 * 2;
constexpr size_t WS_PV = WS_PU + (size_t)2 * 16384 * 1024;
constexpr size_t WS_PSC = WS_PV + (size_t)2 * 16384 * 1024;
constexpr size_t WS_S = WS_PSC + (size_t)2 * 2 * 16384 * 4;
constexpr size_t WS_END = WS_S + 6 * U_BYTES;
static_assert(WS_END <= 1073741824ull, "workspace too large");
static_assert((WS_CTXR % 256) == 0 && (WS_WPROJ % 256) == 0 && (WS_S % 256) == 0, "alignment");

struct Params {
    const float* in[35];
    float* out;
    unsigned char* ws;
    int pad0, pad1;
};

DEV float bf_lo(unsigned u) { return __uint_as_float(u << 16); }
DEV float bf_hi(unsigned u) { return __uint_as_float(u & 0xffff0000u); }
typedef float f32x2v __attribute__((ext_vector_type(2)));
DEV unsigned pk_bf16(float lo, float hi) { const f32x2v f = {lo, hi}; union { bf16x2v v; unsigned u; } x; x.v = __builtin_convertvector(f, bf16x2v); return x.u; }
template <int N> DEV float dpp_ror(float x) { return __int_as_float(__builtin_amdgcn_update_dpp(0, __float_as_int(x), 0x120 + N, 0xF, 0xF, false)); }
DEV float row16_allreduce(float x) { x += dpp_ror<8>(x); x += dpp_ror<4>(x); x += dpp_ror<2>(x); x += dpp_ror<1>(x); return x; }
DEV float wave_allreduce(float x) { x = row16_allreduce(x); x += __shfl_xor(x, 16); x += __shfl_xor(x, 32); return x; }
DEV float sigmoidf_(float x) { return 1.0f / (1.0f + __expf(-x)); }
DEV float softplusf_(float z) { return fmaxf(z, 0.f) + __logf(1.0f + __expf(-fabsf(z))); }
DEV unsigned mono_u32(float f) { unsigned u = __float_as_uint(f); return u ^ ((u >> 31) ? 0xFFFFFFFFu : 0x80000000u); }
DEV float unmono_u32(unsigned k) { unsigned u = (k & 0x80000000u) ? (k ^ 0x80000000u) : ~k; return __uint_as_float(u); }
DEV bf16x8 as_bf16x8(uint4 v) { union { uint4 u; bf16x8 b; } x; x.u = v; return x.b; }
DEV int tid_opaque() { int t = threadIdx.x; asm volatile("" : "+v"(t)); return t; }
DEV int mod_batch(int R) { return R < NL ? (R >> 13) : 8; }

template <int BN, class AL, class EP>
DEV void gemm_unit(unsigned char* lds, const AL& al, const bf16_t* Bt, int K, int m0, const EP& ep) {
    constexpr int NI = BN / 64;
    constexpr int A_BYTES = 128 * 128;
    constexpr int B_BYTES = BN * 128;
    const int tid = tid_opaque(), lane = tid & 63, wv = tid >> 6, wm = wv >> 2, wn = wv & 3;
    const int fr = lane & 15, fq = lane >> 4;
    unsigned char* sA = lds;
    unsigned char* sB = lds + 2 * A_BYTES;
    f32x4 acc[4][NI];
#pragma unroll
    for (int mi = 0; mi < 4; ++mi)
#pragma unroll
        for (int ni = 0; ni < NI; ++ni) acc[mi][ni] = (f32x4){0.f, 0.f, 0.f, 0.f};
    const int KT = K >> 6;
    const int drow = tid >> 3, dch = (tid & 7) ^ (drow & 7);
    const bf16_t* bsrc = Bt + (size_t)drow * K + dch * 8;
    uint4 ra[2];
    auto stage = [&](int kt, int buf) {
        const int k0 = kt * 64;
#pragma unroll
        for (int i = 0; i < BN / 64; ++i)
            __builtin_amdgcn_global_load_lds((const unsigned*)(bsrc + (size_t)(64 * i) * K + k0), (unsigned*)(sB + buf * B_BYTES + i * 8192 + tid * 16), 16, 0, 0);
        if constexpr (AL::DMA) {
#pragma unroll
            for (int i = 0; i < 2; ++i)
                __builtin_amdgcn_global_load_lds((const unsigned*)(al.A + (size_t)(m0 + drow + 64 * i) * al.lda + k0 + dch * 8), (unsigned*)(sA + buf * A_BYTES + i * 8192 + tid * 16), 16, 0, 0);
        } else {
#pragma unroll
            for (int i = 0; i < 2; ++i) { const int q = tid + 512 * i; ra[i] = al.load(m0 + (q >> 3), k0 + (q & 7) * 8); }
        }
    };
    auto commit = [&](int buf) {
        if constexpr (!AL::DMA) {
#pragma unroll
            for (int i = 0; i < 2; ++i) { const int q = tid + 512 * i, row = q >> 3, ch = q & 7; *(uint4*)(sA + buf * A_BYTES + row * 128 + ((ch ^ (row & 7)) << 4)) = ra[i]; }
        }
    };
    auto compute = [&](int buf) {
        const unsigned char* a_base = sA + buf * A_BYTES;
        const unsigned char* b_base = sB + buf * B_BYTES;
#pragma unroll
        for (int ks = 0; ks < 2; ++ks) {
            bf16x8 af[4], bfr[NI];
            const int ch = ks * 4 + fq;
#pragma unroll
            for (int mi = 0; mi < 4; ++mi) { const int row = wm * 64 + mi * 16 + fr; af[mi] = *(const bf16x8*)(a_base + row * 128 + ((ch ^ (row & 7)) << 4)); }
#pragma unroll
            for (int ni = 0; ni < NI; ++ni) { const int row = wn * (BN / 4) + ni * 16 + fr; bfr[ni] = *(const bf16x8*)(b_base + row * 128 + ((ch ^ (row & 7)) << 4)); }
#pragma unroll
            for (int mi = 0; mi < 4; ++mi)
#pragma unroll
                for (int ni = 0; ni < NI; ++ni) acc[mi][ni] = __builtin_amdgcn_mfma_f32_16x16x32_bf16(bfr[ni], af[mi], acc[mi][ni], 0, 0, 0);
        }
    };
    if constexpr (AL::DMA) {
        constexpr int STG = A_BYTES + B_BYTES;
        auto stage3 = [&](int kt, int b3) {
            const int k0 = kt * 64;
            unsigned char* base = lds + b3 * STG;
#pragma unroll
            for (int i = 0; i < BN / 64; ++i)
                __builtin_amdgcn_global_load_lds((const unsigned*)(bsrc + (size_t)(64 * i) * K + k0), (unsigned*)(base + A_BYTES + i * 8192 + tid * 16), 16, 0, 0);
#pragma unroll
            for (int i = 0; i < 2; ++i)
                __builtin_amdgcn_global_load_lds((const unsigned*)(al.A + (size_t)(m0 + drow + 64 * i) * al.lda + k0 + dch * 8), (unsigned*)(base + i * 8192 + tid * 16), 16, 0, 0);
        };
        auto compute3 = [&](int b3) {
            const unsigned char* a_base = lds + b3 * STG;
            const unsigned char* b_base = a_base + A_BYTES;
#pragma unroll
            for (int ks = 0; ks < 2; ++ks) {
                bf16x8 af[4], bfr[NI];
                const int ch = ks * 4 + fq;
#pragma unroll
                for (int mi = 0; mi < 4; ++mi) { const int row = wm * 64 + mi * 16 + fr; af[mi] = *(const bf16x8*)(a_base + row * 128 + ((ch ^ (row & 7)) << 4)); }
#pragma unroll
                for (int ni = 0; ni < NI; ++ni) { const int row = wn * (BN / 4) + ni * 16 + fr; bfr[ni] = *(const bf16x8*)(b_base + row * 128 + ((ch ^ (row & 7)) << 4)); }
#pragma unroll
                for (int mi = 0; mi < 4; ++mi)
#pragma unroll
                    for (int ni = 0; ni < NI; ++ni) acc[mi][ni] = __builtin_amdgcn_mfma_f32_16x16x32_bf16(bfr[ni], af[mi], acc[mi][ni], 0, 0, 0);
            }
        };
        stage3(0, 0);
        stage3(1, 1);
        int b3 = 0;
        for (int kt = 0; kt < KT; ++kt) {
            if (kt + 1 < KT) { if constexpr (BN == 256) asm volatile("s_waitcnt vmcnt(6)" ::: "memory"); else asm volatile("s_waitcnt vmcnt(4)" ::: "memory"); }
            else asm volatile("s_waitcnt vmcnt(0)" ::: "memory");
            asm volatile("s_waitcnt lgkmcnt(0)" ::: "memory");
            __builtin_amdgcn_s_barrier();
            asm volatile("" ::: "memory");
            const int bn = (b3 == 0) ? 2 : b3 - 1;
            if (kt + 2 < KT) stage3(kt + 2, bn);
            compute3(b3);
            b3 = (b3 == 2) ? 0 : b3 + 1;
        }
        asm volatile("s_waitcnt lgkmcnt(0)" ::: "memory");
        __builtin_amdgcn_s_barrier();
        asm volatile("" ::: "memory");
    } else {
        stage(0, 0);
        commit(0);
        asm volatile("s_waitcnt vmcnt(0)" ::: "memory");
        __syncthreads();
        for (int kt = 0; kt < KT; ++kt) {
            const int cur = kt & 1;
            const bool more = (kt + 1 < KT);
            if (more) stage(kt + 1, cur ^ 1);
            compute(cur);
            if (more) commit(cur ^ 1);
            asm volatile("s_waitcnt vmcnt(0)" ::: "memory");
            __syncthreads();
        }
    }
    ep(acc, m0, wm, wn, fr, fq);
}

struct ALoadPlain {
    static constexpr bool DMA = true;
    const bf16_t* A; int lda;
    DEV uint4 load(int R, int k) const { return *(const uint4*)(A + (size_t)R * lda + k); }
};
struct ALoadMix {
    static constexpr bool DMA = false;
    const bf16_t* h; const float* mix; const bf16_t* A; int lda;
    DEV uint4 load(int R, int k) const {
        const bf16_t* pc = h + (size_t)R * 1024 + k;
        const uint4 c = *(const uint4*)pc;
        const int t = (R < NL) ? (R & 8191) : ((R - NL) & 255);
        const int last = (R < NL) ? 8191 : 255;
        uint4 pv = *(const uint4*)(pc - (t != 0 ? 1024 : 0)), nv = *(const uint4*)(pc + (t != last ? 1024 : 0));
        if (t == 0) pv = make_uint4(0, 0, 0, 0);
        if (t == last) nv = make_uint4(0, 0, 0, 0);
        const float4 m0 = *(const float4*)(mix + k), m1 = *(const float4*)(mix + k + 4);
        const unsigned cc[4] = {c.x, c.y, c.z, c.w}, pp[4] = {pv.x, pv.y, pv.z, pv.w}, nn[4] = {nv.x, nv.y, nv.z, nv.w};
        const float mm[8] = {m0.x, m0.y, m0.z, m0.w, m1.x, m1.y, m1.z, m1.w};
        unsigned o[4];
#pragma unroll
        for (int i = 0; i < 4; ++i) {
            const float hc0 = bf_lo(cc[i]), hc1 = bf_hi(cc[i]);
            const float s0 = 0.5f * (bf_lo(pp[i]) + bf_lo(nn[i])), s1 = 0.5f * (bf_hi(pp[i]) + bf_hi(nn[i]));
            o[i] = pk_bf16(hc0 + (s0 - hc0) * mm[2 * i], hc1 + (s1 - hc1) * mm[2 * i + 1]);
        }
        return make_uint4(o[0], o[1], o[2], o[3]);
    }
};

struct TrJob { int in_idx, src_off, K, N, src_ld, dst_ld; unsigned long long dst_off; int tile0; };
constexpr int NTRJOBS = 19;
__device__ const TrJob g_trjobs[NTRJOBS] = {
    {9, 0 * 1048576, 1024, 1024, 1024, 1024, WS_WPROJ + 0ull * 1024 * 1024 * 2, 0},
    {9, 1 * 1048576, 1024, 1024, 1024, 1024, WS_WPROJ + 1ull * 1024 * 1024 * 2, 256},
    {9, 2 * 1048576, 1024, 1024, 1024, 1024, WS_WPROJ + 2ull * 1024 * 1024 * 2, 512},
    {11, 0, 1024, 64, 64, 1024, WS_WPROJ + 3072ull * 1024 * 2, 768},
    {11, 65536, 1024, 64, 64, 1024, WS_WPROJ + 3136ull * 1024 * 2, 784},
    {14, 0, 1024, 64, 64, 1024, WS_WPROJ + 3200ull * 1024 * 2, 800},
    {14, 65536, 1024, 64, 64, 1024, WS_WPROJ + 3264ull * 1024 * 2, 816},
    {16, 0, 1024, 128, 128, 1024, WS_WPROJ + 3328ull * 1024 * 2, 832},
    {12, 0, 64, 1024, 1024, 64, WS_W2T, 864},
    {12, 65536, 64, 1024, 1024, 64, WS_W2T + 1024ull * 64 * 2, 880},
    {15, 0, 64, 1024, 1024, 64, WS_A2T, 896},
    {15, 65536, 64, 1024, 1024, 64, WS_A2T + 1024ull * 64 * 2, 912},
    {17, 0, 128, 1024, 1024, 128, WS_G2T, 928},
    {23, 0, 1024, 1024, 1024, 1024, WS_WO0, 960},
    {29, 0, 1024, 1024, 1024, 1024, WS_WO1, 1216},
    {30, 0, 1024, 2048, 2048, 1024, WS_WQ, 1472},
    {30, 2097152, 1024, 2048, 2048, 1024, WS_WQ + 2048ull * 1024 * 2, 1984},
    {24, 0, 1024, 3104, 3104, 1024, WS_WIN, 2496},
    {0, 0, 0, 0, 0, 0, 0, 2496 + 16 * 49},
};
constexpr int NTRTILES = 2496 + 16 * 49;

DEV void phase0(const Params& p, unsigned char* lds) {
    const int tid = tid_opaque();
    unsigned char* ws = p.ws;
    {
        float* sc = (float*)lds;
        float* red = sc + 9 * 1024;
        float* mods = (float*)(ws + WS_MOD);
        bool have_sc = false;
        for (int task = blockIdx.x; task < 192; task += gridDim.x) {
            if (!have_sc) {
                for (int i = tid; i < 9 * 1024; i += NTHREADS) {
                    const int mb = i >> 10, k = i & 1023;
                    const float cv = mb < 8 ? p.in[1][mb * 1024 + k] : p.in[3][k];
                    sc[i] = cv / (1.0f + __expf(-cv));
                }
                have_sc = true;
            }
            __syncthreads();
            const int l = task / 96, nb = task % 96;
            const int nn = tid & 63, kg = tid >> 6;
            const float* w = p.in[4] + (size_t)l * 1024 * 6144 + nb * 64 + nn;
            float acc[9];
#pragma unroll
            for (int m = 0; m < 9; ++m) acc[m] = 0.f;
            for (int k = kg * 128; k < kg * 128 + 128; ++k) {
                const float wv = w[(size_t)k * 6144];
#pragma unroll
                for (int m = 0; m < 9; ++m) acc[m] += sc[m * 1024 + k] * wv;
            }
#pragma unroll
            for (int m = 0; m < 9; ++m) red[(kg * 9 + m) * 64 + nn] = acc[m];
            __syncthreads();
            for (int i = tid; i < 576; i += NTHREADS) {
                const int m = i >> 6, n2 = i & 63;
                float s = p.in[5][l * 6144 + nb * 64 + n2];
#pragma unroll
                for (int g = 0; g < 8; ++g) s += red[(g * 9 + m) * 64 + n2];
                mods[(size_t)(l * 9 + m) * 6144 + nb * 64 + n2] = s;
            }
            __syncthreads();
        }
        __syncthreads();
    }
    {
        float* tile = (float*)lds;
        for (int tt = blockIdx.x; tt < NTRTILES; tt += gridDim.x) {
            int j = 0;
#pragma unroll 1
            while (j + 1 < NTRJOBS && g_trjobs[j + 1].tile0 <= tt) ++j;
            const TrJob jb = g_trjobs[j];
            const int tl = tt - jb.tile0;
            const int ntn = (jb.N + 63) >> 6;
            const int k0 = (tl / ntn) * 64, n0 = (tl % ntn) * 64;
            const float* src = p.in[jb.in_idx] + jb.src_off;
            bf16_t* dst = (bf16_t*)(ws + jb.dst_off);
            {
                const int kr = tid >> 4, nc4 = (tid & 15) * 4;
#pragma unroll
                for (int i = 0; i < 2; ++i) {
                    const int kk = kr + 32 * i;
                    float4 v = make_float4(0.f, 0.f, 0.f, 0.f);
                    if (n0 + nc4 < jb.N) v = *(const float4*)(src + (size_t)(k0 + kk) * jb.src_ld + n0 + nc4);
                    tile[kk * 65 + nc4 + 0] = v.x; tile[kk * 65 + nc4 + 1] = v.y; tile[kk * 65 + nc4 + 2] = v.z; tile[kk * 65 + nc4 + 3] = v.w;
                }
            }
            __syncthreads();
            {
                const int nn = tid >> 3, kc = (tid & 7) * 8;
                if (n0 + nn < jb.N) {
                    unsigned o[4];
#pragma unroll
                    for (int i = 0; i < 4; ++i) o[i] = pk_bf16(tile[(kc + 2 * i) * 65 + nn], tile[(kc + 2 * i + 1) * 65 + nn]);
                    *(uint4*)(dst + (size_t)(n0 + nn) * jb.dst_ld + k0 + kc) = make_uint4(o[0], o[1], o[2], o[3]);
                }
            }
            __syncthreads();
        }
    }
    {
        const size_t gtid = (size_t)blockIdx.x * NTHREADS + tid, gstride = (size_t)gridDim.x * NTHREADS;
        {
            const float* src = p.in[31];
            bf16_t* dst = (bf16_t*)(ws + WS_KEYS);
            const size_t n8 = (size_t)2 * 8 * 2 * 128 * 128 / 8;
            for (size_t i = gtid; i < n8; i += gstride) {
                const float4 a = *(const float4*)(src + i * 8), b = *(const float4*)(src + i * 8 + 4);
                *(uint4*)(dst + i * 8) = make_uint4(pk_bf16(a.x, a.y), pk_bf16(a.z, a.w), pk_bf16(b.x, b.y), pk_bf16(b.z, b.w));
            }
        }
        bf16_t* wpad = (bf16_t*)(ws + WS_WIN) + (size_t)3104 * 1024;
        for (size_t i = gtid; i < (size_t)96 * 1024 / 8; i += gstride) *(uint4*)(wpad + i * 8) = make_uint4(0, 0, 0, 0);
        const int lane = tid & 63;
        const int gw = blockIdx.x * 8 + (tid >> 6), nw = gridDim.x * 8;
        float* scales = (float*)(ws + WS_PSC);
        for (int rowi = gw * 32; rowi < 2 * 32768; rowi += nw * 32)
        for (int row = rowi; row < rowi + 32; ++row) {
            const int tbl = row >> 15, r = row & 32767;
            const float* srow = p.in[32 + tbl] + (size_t)r * 1024;
            float4 v[4]; float am = 0.f;
#pragma unroll
            for (int i = 0; i < 4; ++i) { v[i] = *(const float4*)(srow + 256 * i + 4 * lane); am = fmaxf(am, fmaxf(fmaxf(fabsf(v[i].x), fabsf(v[i].y)), fmaxf(fabsf(v[i].z), fabsf(v[i].w)))); }
#pragma unroll
            for (int o = 1; o < 64; o <<= 1) am = fmaxf(am, __shfl_xor(am, o));
            const float scale = am > 0.f ? am * (1.0f / 448.0f) : 1.0f;
            const float inv = 1.0f / scale;
            unsigned w[4];
#pragma unroll
            for (int i = 0; i < 4; ++i) {
                int t = 0;
                t = __builtin_amdgcn_cvt_pk_fp8_f32(v[i].x * inv, v[i].y * inv, t, false);
                t = __builtin_amdgcn_cvt_pk_fp8_f32(v[i].z * inv, v[i].w * inv, t, true);
                w[i] = (unsigned)t;
            }
            *(uint4*)(ws + (tbl ? WS_PV : WS_PU) + (size_t)r * 1024 + 16 * lane) = make_uint4(w[0], w[1], w[2], w[3]);
            if (lane == 0) scales[tbl * 32768 + r] = scale;
        }
    }
}

DEV void normmod_store(const float4 (&v)[4], float ss, const float* g, const float* shift, const float* scale, bf16_t* dst, int lane) {
    const float rs = rsqrtf(ss * (1.0f / 1024.0f) + 1e-6f);
#pragma unroll
    for (int i = 0; i < 4; ++i) {
        const int col = i * 256 + lane * 4;
        const float4 gg = *(const float4*)(g + col), sh = *(const float4*)(shift + col), sc = *(const float4*)(scale + col);
        const float y0 = v[i].x * rs * gg.x * (1.f + sc.x) + sh.x, y1 = v[i].y * rs * gg.y * (1.f + sc.y) + sh.y;
        const float y2 = v[i].z * rs * gg.z * (1.f + sc.z) + sh.z, y3 = v[i].w * rs * gg.w * (1.f + sc.w) + sh.w;
        *(uint2*)(dst + col) = make_uint2(pk_bf16(y0, y1), pk_bf16(y2, y3));
    }
}
DEV void phase_normmod(const Params& p, int layer, int which, const float* xl, const float* xc, int nrows, bf16_t* dst) {
    const int tid = tid_opaque(), lane = tid & 63;
    const int gw = blockIdx.x * 8 + (tid >> 6), nw = gridDim.x * 8;
    const float* mods = (const float*)(p.ws + WS_MOD) + (size_t)layer * 9 * 6144;
    const float* g = p.in[which ? 7 : 6] + layer * 1024;
    for (int R = gw; R < nrows; R += nw) {
        const float* xr = R < NL ? xl + (size_t)R * 1024 : xc + (size_t)(R - NL) * 1024;
        float4 v[4]; float ss = 0.f;
#pragma unroll
        for (int i = 0; i < 4; ++i) { v[i] = *(const float4*)(xr + i * 256 + lane * 4); ss += v[i].x * v[i].x + v[i].y * v[i].y + v[i].z * v[i].z + v[i].w * v[i].w; }
        ss = wave_allreduce(ss);
        const float* mrow = mods + (size_t)mod_batch(R) * 6144 + (which ? 3 : 0) * 1024;
        normmod_store(v, ss, g, mrow, mrow + 1024, dst + (size_t)R * 1024, lane);
    }
}
DEV void phase_normmix(const Params& p, bf16_t* hdst, bf16_t* xr, bf16_t* xk, bf16_t* xv) {
    const int tid = tid_opaque(), lane = tid & 63;
    const int gw = __builtin_amdgcn_readfirstlane(blockIdx.x * 8 + (tid >> 6)), nw = gridDim.x * 8;
    const float* mods = (const float*)(p.ws + WS_MOD);
    const float* g = p.in[6];
    for (int run = gw; run < NT / 8; run += nw) {
        const int R0 = run * 8;
        const int t0 = R0 < NL ? (R0 & 8191) : ((R0 - NL) & 255), slen = R0 < NL ? 8192 : 256;
        const float* mrow = mods + (size_t)mod_batch(R0) * 6144;
        float4 gg[4], sh[4], sc[4], m0[4], m2[4], m3[4];
#pragma unroll
        for (int i = 0; i < 4; ++i) {
            const int col = i * 256 + lane * 4;
            gg[i] = *(const float4*)(g + col); sh[i] = *(const float4*)(mrow + col); sc[i] = *(const float4*)(mrow + 1024 + col);
            m0[i] = *(const float4*)(p.in[8] + col); m2[i] = *(const float4*)(p.in[8] + 2 * 1024 + col); m3[i] = *(const float4*)(p.in[8] + 3 * 1024 + col);
        }
        auto hrow = [&](int R, float4 (&h)[4]) {
            const float* xrw = R < NL ? p.in[0] + (size_t)R * 1024 : p.in[2] + (size_t)(R - NL) * 1024;
            float ss = 0.f;
#pragma unroll
            for (int i = 0; i < 4; ++i) { h[i] = *(const float4*)(xrw + i * 256 + lane * 4); ss += h[i].x * h[i].x + h[i].y * h[i].y + h[i].z * h[i].z + h[i].w * h[i].w; }
            ss = wave_allreduce(ss);
            const float rs = rsqrtf(ss * (1.0f / 1024.0f) + 1e-6f);
#pragma unroll
            for (int i = 0; i < 4; ++i) {
                h[i].x = h[i].x * rs * gg[i].x * (1.f + sc[i].x) + sh[i].x; h[i].y = h[i].y * rs * gg[i].y * (1.f + sc[i].y) + sh[i].y;
                h[i].z = h[i].z * rs * gg[i].z * (1.f + sc[i].z) + sh[i].z; h[i].w = h[i].w * rs * gg[i].w * (1.f + sc[i].w) + sh[i].w;
            }
        };
        float4 hp[4], hc[4], hn[4];
        if (t0 > 0) hrow(R0 - 1, hp); else { hp[0] = hp[1] = hp[2] = hp[3] = make_float4(0.f, 0.f, 0.f, 0.f); }
        hrow(R0, hc);
#pragma unroll 1
        for (int i8 = 0; i8 < 8; ++i8) {
            const int R = R0 + i8;
            if (t0 + i8 + 1 < slen) hrow(R + 1, hn); else { hn[0] = hn[1] = hn[2] = hn[3] = make_float4(0.f, 0.f, 0.f, 0.f); }
#pragma unroll
            for (int i = 0; i < 4; ++i) {
                const size_t o = (size_t)R * 1024 + i * 256 + lane * 4;
                const float4 c = hc[i];
                const float4 xx = make_float4(0.5f * (hp[i].x + hn[i].x) - c.x, 0.5f * (hp[i].y + hn[i].y) - c.y, 0.5f * (hp[i].z + hn[i].z) - c.z, 0.5f * (hp[i].w + hn[i].w) - c.w);
                *(uint2*)(hdst + o) = make_uint2(pk_bf16(c.x, c.y), pk_bf16(c.z, c.w));
                *(uint2*)(xr + o) = make_uint2(pk_bf16(c.x + xx.x * m0[i].x, c.y + xx.y * m0[i].y), pk_bf16(c.z + xx.z * m0[i].z, c.w + xx.w * m0[i].w));
                *(uint2*)(xk + o) = make_uint2(pk_bf16(c.x + xx.x * m2[i].x, c.y + xx.y * m2[i].y), pk_bf16(c.z + xx.z * m2[i].z, c.w + xx.w * m2[i].w));
                *(uint2*)(xv + o) = make_uint2(pk_bf16(c.x + xx.x * m3[i].x, c.y + xx.y * m3[i].y), pk_bf16(c.z + xx.z * m3[i].z, c.w + xx.w * m3[i].w));
            }
#pragma unroll
            for (int i = 0; i < 4; ++i) { hp[i] = hc[i]; hc[i] = hn[i]; }
        }
    }
}

template <int BN> struct EpiBf16 {
    bf16_t* dst; int ldd; int col0; int act;
    DEV void operator()(const f32x4 (&acc)[4][BN / 64], int m0, int wm, int wn, int fr, int fq) const {
#pragma unroll
        for (int mi = 0; mi < 4; ++mi) {
            const size_t R = (size_t)(m0 + wm * 64 + mi * 16 + fr);
#pragma unroll
            for (int ni = 0; ni < BN / 64; ++ni) {
                const int col = col0 + wn * (BN / 4) + ni * 16 + 4 * fq;
                float v[4] = {acc[mi][ni][0], acc[mi][ni][1], acc[mi][ni][2], acc[mi][ni][3]};
                if (act == 1) {
#pragma unroll
                    for (int j = 0; j < 4; ++j) v[j] = tanhf(v[j]);
                } else if (act == 2) {
#pragma unroll
                    for (int j = 0; j < 4; ++j) v[j] = sigmoidf_(v[j]);
                }
                *(uint2*)(dst + R * ldd + col) = make_uint2(pk_bf16(v[0], v[1]), pk_bf16(v[2], v[3]));
            }
        }
    }
};
struct EpiResid {
    const float* xold_lat; const float* xold_ctx; float* dst_lat; float* dst_ctx; const float* gate; int col0;
    DEV void operator()(const f32x4 (&acc)[4][4], int m0, int wm, int wn, int fr, int fq) const {
#pragma unroll
        for (int mi = 0; mi < 4; ++mi) {
            const int R = m0 + wm * 64 + mi * 16 + fr;
            const float* src = R < NL ? xold_lat + (size_t)R * 1024 : xold_ctx + (size_t)(R - NL) * 1024;
            float* dst = R < NL ? dst_lat + (size_t)R * 1024 : dst_ctx + (size_t)(R - NL) * 1024;
            const float* gr = gate + (size_t)mod_batch(R) * 6144;
#pragma unroll
            for (int ni = 0; ni < 4; ++ni) {
                const int col = col0 + wn * 64 + ni * 16 + 4 * fq;
                const float4 xo = *(const float4*)(src + col), g4 = *(const float4*)(gr + col);
                *(float4*)(dst + col) = make_float4(xo.x + g4.x * acc[mi][ni][0], xo.y + g4.y * acc[mi][ni][1], xo.z + g4.z * acc[mi][ni][2], xo.w + g4.w * acc[mi][ni][3]);
            }
        }
    }
};
struct EpiLr {
    float* dst;
    DEV void operator()(const f32x4 (&acc)[4][2], int m0, int wm, int wn, int fr, int fq) const {
        if (wn != 0) return;
#pragma unroll
        for (int mi = 0; mi < 4; ++mi) {
            const size_t R = (size_t)(m0 + wm * 64 + mi * 16 + fr);
#pragma unroll
            for (int ni = 0; ni < 2; ++ni) { const int col = ni * 16 + 4 * fq; *(float4*)(dst + R * 32 + col) = make_float4(acc[mi][ni][0], acc[mi][ni][1], acc[mi][ni][2], acc[mi][ni][3]); }
        }
    }
};

namespace pg8 {
#define PG8_LAS __attribute__((address_space(3)))
constexpr int BM = 256, BK = 64, HALF = 128, HTB = HALF * BK * 2  , STAGE_BYTES = 8 * HTB, NXCD = 8, WGM = 8;

__host__ __device__ __forceinline__ int lds_byte(int r, int c) { const int st = (r >> 4) * 2 + (c >> 5), rr = r & 15, cc = c & 31, ob = rr * 64 + cc * 2; return st * 1024 + (ob ^ (((ob >> 9) & 1) << 5)); }
__host__ __device__ __forceinline__ void stage_rc(int b, int& R, int& C) { const int st = b / 1024, sb = b % 1024, swz = sb ^ (((sb >> 9) & 1) << 5); R = (st >> 1) * 16 + swz / 64; C = (st & 1) * 32 + (swz % 64) / 2; }
__host__ __device__ __forceinline__ int perm32(int rho) { const int n = rho >> 4, i = rho & 15; return 8 * (i >> 2) + 4 * n + (i & 3); }
struct Unit { int pm, pn; };
struct Gemm { const bf16_t* A; const bf16_t* Bt; int M, N, K; };
struct StaticOrder {
    int nM, nN, nwg, G, c;
    __host__ __device__ void init(int M, int N, int G_, int c_) { nM = M / BM; nN = N / BM; nwg = nM * nN; G = G_; c = c_; }
    __host__ __device__ bool next(int i, Unit& u) const {
        const long L = (long)i * G + c; if (L >= nwg) return false;
        int wgid = (int)L; { const int q = nwg / NXCD, r = nwg % NXCD, xcd = wgid % NXCD, off = wgid / NXCD; wgid = (xcd < r ? xcd * (q + 1) : r * (q + 1) + (xcd - r) * q) + off; }
        const int nig = WGM * nN, gid = wgid / nig, fm = gid * WGM, gsz = (nM - fm) < WGM ? (nM - fm) : WGM;
        u.pm = fm + ((wgid % nig) % gsz); u.pn = (wgid % nig) / gsz; return true;
    }
    __device__ __forceinline__ void a_ready(const Unit&) const {}
    __device__ __forceinline__ void done(const Unit&) const {}
};
template <class Epi, class Sched, bool STAMP = false>
__device__ __forceinline__ void gemm_phase(PG8_LAS unsigned char* lds, const Gemm g, const Sched& S, const Epi& E, unsigned long long* stamps) {
    const int tid = threadIdx.x, wid = __builtin_amdgcn_readfirstlane(tid >> 6), lane = tid & 63, wr = wid >> 2, wc = wid & 3, fr = lane & 15, fq = lane >> 4;
    const int K = g.K, nt = K / BK;
    int ts_lo = 0, ts_hi = 0, nts = 0; const unsigned long long rt_entry = STAMP ? (unsigned long long)wall_clock64() : 0ull;
#define PG8_STAMP() do { if (STAMP && wid == 0 && nts < 64) { const unsigned long long _c = (unsigned long long)clock64(); \
        ts_lo = (lane == nts) ? (int)(unsigned)_c : ts_lo; ts_hi = (lane == nts) ? (int)(unsigned)(_c >> 32) : ts_hi; ++nts; } } while (0)
    PG8_STAMP();
    unsigned voffA[2], voffB[2];
#pragma unroll
    for (int i = 0; i < 2; ++i) { int R, C; stage_rc(tid * 16 + i * 8192, R, C); const int Rb = Epi::PERM ? ((R & ~31) + perm32(R & 31)) : R;
        voffA[i] = (unsigned)(R * K + C) * 2u; voffB[i] = (unsigned)(Rb * K + C) * 2u; }
    const size_t kstep = (size_t)(BK * 2);
    const size_t hstep = (size_t)HALF * K * 2;
    const size_t tstep = 2 * hstep;
    const unsigned ldsw = (unsigned)wid * 1024u;
    const int aoff = lds_byte(wr * 64 + fr, fq * 8), boff = lds_byte(wc * 32 + fr, fq * 8);
#define PG8_SA(b, h) (((b) * 2 + (h)) * HTB)
#define PG8_SB(b, h) ((4 + (b) * 2 + (h)) * HTB)
#define PG8_STAGE(bufoff, gbase, voff) do { _Pragma("unroll") for (int _i = 0; _i < 2; ++_i) \
        __builtin_amdgcn_global_load_lds((const unsigned*)((const char*)(gbase) + (voff)[_i]), (PG8_LAS unsigned*)(lds + (bufoff) + ldsw + _i * 8192), 16, 0, 0); } while (0)
#define PG8_LDA(dst, b, h) do { _Pragma("unroll") for (int m = 0; m < 4; ++m) _Pragma("unroll") for (int k = 0; k < 2; ++k) dst[m][k] = *(const PG8_LAS bf16x8*)(lds + PG8_SA(b, h) + aoff + m * 2048 + k * 1024); } while (0)
#define PG8_LDB(dst, b, h) do { _Pragma("unroll") for (int n = 0; n < 2; ++n) _Pragma("unroll") for (int k = 0; k < 2; ++k) dst[n][k] = *(const PG8_LAS bf16x8*)(lds + PG8_SB(b, h) + boff + n * 2048 + k * 1024); } while (0)
#define PG8_MMA(ai, bj, At, Bt) do { __builtin_amdgcn_s_setprio(1); _Pragma("unroll") for (int m = 0; m < 4; ++m) _Pragma("unroll") for (int n = 0; n < 2; ++n) _Pragma("unroll") for (int k = 0; k < 2; ++k) \
        acc[ai][bj][m][n] = __builtin_amdgcn_mfma_f32_16x16x32_bf16(Bt[n][k], At[m][k], acc[ai][bj][m][n], 0, 0, 0); __builtin_amdgcn_s_setprio(0); } while (0)
#define PG8_WAIT_V(n) asm volatile("s_waitcnt vmcnt(" #n ")" ::: "memory")
#define PG8_WAIT_L(n) asm volatile("s_waitcnt lgkmcnt(" #n ")" ::: "memory")
#define PG8_BAR __builtin_amdgcn_s_barrier()
#define PG8_SCHED __builtin_amdgcn_sched_barrier(0)
    Unit cur, nxt; int ui = 0;
    if (!S.next(0, cur)) return;
    f32x4 acc[2][2][4][2];
#pragma unroll
    for (int a = 0; a < 2; ++a)
#pragma unroll
        for (int b = 0; b < 2; ++b)
#pragma unroll
            for (int m = 0; m < 4; ++m)
#pragma unroll
                for (int n = 0; n < 2; ++n) acc[a][b][m][n] = (f32x4){0.f, 0.f, 0.f, 0.f};
    bf16x8 At[4][2], B0[2][2], B1[2][2];
    const char* cA = (const char*)g.A + (size_t)cur.pm * tstep; const char* cB = (const char*)g.Bt + (size_t)cur.pn * tstep;
    S.a_ready(cur);
    PG8_STAGE(PG8_SB(0, 0), cB, voffB); PG8_STAGE(PG8_SA(0, 0), cA, voffA); PG8_STAGE(PG8_SB(0, 1), cB + hstep, voffB); PG8_STAGE(PG8_SA(0, 1), cA + hstep, voffA);
    if (wr == 1) PG8_BAR;
    PG8_WAIT_V(4); PG8_BAR;
    PG8_STAGE(PG8_SB(1, 0), cB + kstep, voffB); PG8_STAGE(PG8_SA(1, 0), cA + kstep, voffA); PG8_STAGE(PG8_SB(1, 1), cB + hstep + kstep, voffB);
    PG8_WAIT_V(6); PG8_BAR;
    PG8_STAMP();
    for (;;) {
        const bool has_next = S.next(ui + 1, nxt);
        const char* nA = has_next ? (const char*)g.A + (size_t)nxt.pm * tstep : cA; const char* nB = has_next ? (const char*)g.Bt + (size_t)nxt.pn * tstep : cB;
        for (int t = 0; t < nt; t += 2) {
            const bool last = (t == nt - 2);
            const char* a1 = cA + (size_t)(t + 1) * kstep;
            const char* a2 = last ? nA : cA + (size_t)(t + 2) * kstep; const char* b2 = last ? nB : cB + (size_t)(t + 2) * kstep;
            const char* a3 = a2 + kstep; const char* b3 = b2 + kstep;
            if (last && has_next) S.a_ready(nxt);
            PG8_LDB(B0, 0, 0); PG8_SCHED; PG8_LDA(At, 0, 0); PG8_STAGE(PG8_SA(1, 1), a1 + hstep, voffA);
            PG8_WAIT_L(8); PG8_BAR; PG8_WAIT_L(0); PG8_MMA(0, 0, At, B0); PG8_BAR; PG8_SCHED;
            PG8_LDB(B1, 0, 1); PG8_STAGE(PG8_SB(0, 0), b2, voffB);
            PG8_BAR; PG8_WAIT_L(0); PG8_MMA(0, 1, At, B1); PG8_BAR;
            PG8_LDA(At, 0, 1); PG8_STAGE(PG8_SA(0, 0), a2, voffA);
            PG8_BAR; PG8_WAIT_L(0); PG8_MMA(1, 0, At, B0); PG8_BAR; PG8_SCHED;
            PG8_STAGE(PG8_SB(0, 1), b2 + hstep, voffB);
            PG8_WAIT_V(6); PG8_BAR; PG8_MMA(1, 1, At, B1); PG8_BAR;
            PG8_LDB(B0, 1, 0); PG8_SCHED; PG8_LDA(At, 1, 0); PG8_STAGE(PG8_SA(0, 1), a2 + hstep, voffA);
            PG8_WAIT_L(8); PG8_BAR; PG8_WAIT_L(0); PG8_MMA(0, 0, At, B0); PG8_BAR; PG8_SCHED;
            PG8_LDB(B1, 1, 1); PG8_STAGE(PG8_SB(1, 0), b3, voffB);
            PG8_BAR; PG8_WAIT_L(0); PG8_MMA(0, 1, At, B1); PG8_BAR;
            PG8_LDA(At, 1, 1); PG8_STAGE(PG8_SA(1, 0), a3, voffA);
            PG8_BAR; PG8_WAIT_L(0); PG8_MMA(1, 0, At, B0); PG8_BAR; PG8_SCHED;
            PG8_STAGE(PG8_SB(1, 1), b3 + hstep, voffB);
            PG8_WAIT_V(6); PG8_BAR; PG8_MMA(1, 1, At, B1); PG8_BAR;
        }
        PG8_STAMP();
        if constexpr (!Epi::AFTER_DRAIN) { E(acc, cur, wr, wc, fr, fq); S.done(cur); }
        PG8_STAMP();
        if (!has_next) break;
#pragma unroll
        for (int a = 0; a < 2; ++a)
#pragma unroll
            for (int b = 0; b < 2; ++b)
#pragma unroll
                for (int m = 0; m < 4; ++m)
#pragma unroll
                    for (int n = 0; n < 2; ++n) acc[a][b][m][n] = (f32x4){0.f, 0.f, 0.f, 0.f};
        cur = nxt; cA = nA; cB = nB; ++ui;
    }
    PG8_WAIT_V(0);
    if (wr == 0) PG8_BAR;
    PG8_BAR;
    if constexpr (Epi::AFTER_DRAIN) { E.fused(acc, cur, wr, wc, fr, fq, lds, wid, lane); S.done(cur); }
    PG8_STAMP();
    if (STAMP && wid == 0) { stamps[lane] = lane < nts ? (((unsigned long long)(unsigned)ts_hi << 32) | (unsigned)ts_lo) : 0ull;
        if (lane == 62) stamps[62] = rt_entry; if (lane == 63) stamps[63] = (unsigned long long)wall_clock64(); }
#undef PG8_STAMP
#undef PG8_SA
#undef PG8_SB
#undef PG8_STAGE
#undef PG8_LDA
#undef PG8_LDB
#undef PG8_MMA
#undef PG8_WAIT_V
#undef PG8_WAIT_L
#undef PG8_BAR
#undef PG8_SCHED
}
struct EpiBf16Tiles {
    static constexpr bool PERM = true, AFTER_DRAIN = false;
    bf16_t* d0; int ld0; int ntile0; bf16_t* d1; int ld1;
    __device__ __forceinline__ void operator()(const f32x4 (&acc)[2][2][4][2], const Unit& u, int wr, int wc, int fr, int fq) const {
        bf16_t* base = u.pn < ntile0 ? d0 : d1; const int ld = u.pn < ntile0 ? ld0 : ld1; const int colt = (u.pn < ntile0 ? u.pn : u.pn - ntile0) * BM;
        const int row0 = u.pm * BM + wr * 64 + fr, col0 = colt + wc * 32 + 8 * fq;
#pragma unroll
        for (int ai = 0; ai < 2; ++ai)
#pragma unroll
            for (int m = 0; m < 4; ++m) { bf16_t* rowp = base + (size_t)(row0 + ai * HALF + m * 16) * ld + col0;
#pragma unroll
                for (int bj = 0; bj < 2; ++bj) { const f32x4 v0 = acc[ai][bj][m][0], v1 = acc[ai][bj][m][1];
                    *(uint4*)(rowp + bj * HALF) = make_uint4(pk_bf16(v0[0], v0[1]), pk_bf16(v0[2], v0[3]), pk_bf16(v1[0], v1[1]), pk_bf16(v1[2], v1[3])); } }
    }
};
struct EpiResid256 {
    static constexpr bool PERM = false, AFTER_DRAIN = false;
    const float* xold_lat; const float* xold_ctx; float* dst_lat; float* dst_ctx; const float* gate;
    __device__ __forceinline__ void operator()(const f32x4 (&acc)[2][2][4][2], const Unit& u, int wr, int wc, int fr, int fq) const {
        const int row0 = u.pm * BM + wr * 64 + fr, col0 = u.pn * BM + wc * 32 + 4 * fq;
#pragma unroll
        for (int ai = 0; ai < 2; ++ai)
#pragma unroll
            for (int m = 0; m < 4; ++m) {
                const int R = row0 + ai * HALF + m * 16;
                const float* src = R < NL ? xold_lat + (size_t)R * 1024 : xold_ctx + (size_t)(R - NL) * 1024;
                float* dst = R < NL ? dst_lat + (size_t)R * 1024 : dst_ctx + (size_t)(R - NL) * 1024;
                const float* gr = gate + (size_t)mod_batch(R) * 6144;
#pragma unroll
                for (int bj = 0; bj < 2; ++bj)
#pragma unroll
                    for (int n = 0; n < 2; ++n) {
                        const int col = col0 + bj * HALF + n * 16;
                        const float4 xo = *(const float4*)(src + col), g4 = *(const float4*)(gr + col);
                        const f32x4 a = acc[ai][bj][m][n];
                        *(float4*)(dst + col) = make_float4(xo.x + g4.x * a[0], xo.y + g4.y * a[1], xo.z + g4.z * a[2], xo.w + g4.w * a[3]);
                    }
            }
    }
};
}

DEV void phase_rw_proj1(const Params& p, unsigned char* lds, int which, const bf16_t* A, bf16_t* dst) {
    pg8::Gemm g{A, (const bf16_t*)(p.ws + WS_WPROJ) + (size_t)which * 1024 * 1024, NT, 1024, 1024};
    pg8::StaticOrder so; so.init(NT, 1024, gridDim.x, blockIdx.x);
    pg8::EpiBf16Tiles ep{dst, 1024, 4, dst, 1024};
    pg8::gemm_phase((PG8_LAS unsigned char*)lds, g, so, ep, nullptr);
    __syncthreads();
}
DEV void phase_rw_lora(const Params& p, unsigned char* lds) {
    unsigned char* ws = p.ws;
    const bf16_t* h = (const bf16_t*)(ws + WS_S + 0 * U_BYTES);
    const bf16_t* wproj = (const bf16_t*)(ws + WS_WPROJ);
    const int nunits = (NT / 128) * 3;
    for (int u = blockIdx.x; u < nunits; u += gridDim.x) {
        const int mt = u / 3, lg = u % 3, m0 = mt * 128;
        const int mixid = lg == 0 ? 1 : (lg == 1 ? 4 : 5);
        ALoadMix al{h, p.in[8] + mixid * 1024, h, 1024};
        EpiBf16<128> ep{(bf16_t*)(ws + WS_S + 4 * U_BYTES), 384, lg * 128, lg == 0 ? 1 : (lg == 1 ? 0 : 2)};
        gemm_unit<128>(lds, al, wproj + (size_t)(3072 + lg * 128) * 1024, 1024, m0, ep);
    }
}

template <int N> DEV float dpp_shr0(float x) { return __int_as_float(__builtin_amdgcn_update_dpp(0, __float_as_int(x), 0x110 + N, 0xF, 0xF, true)); }
template <int CTRL> DEV float dpp_quad(float x) { return __int_as_float(__builtin_amdgcn_update_dpp(0, __float_as_int(x), CTRL, 0xF, 0xF, false)); }
DEV int tile_off(int row, int ch) { return row * 128 + ((ch ^ (row & 7)) << 4); }
DEV int tile_off2(int row, int ch) { return row * 128 + ((ch ^ ((row ^ (row >> 3)) & 7)) << 4); }
DEV void phase_rw_scan(const Params& p, unsigned char* lds) {
    const int tid = tid_opaque(), lane = tid & 63;
    const int wv = __builtin_amdgcn_readfirstlane(tid >> 6);
    const int fr = lane & 15, fq = lane >> 4;
    unsigned char* ws = p.ws;
    constexpr int SH = 0, SL = 8192, AT = 16384, RT = 18432, BT = 20480, KT = 22528, BKT = 24576  , UV = 40960  , NT = 57344;
    constexpr int MFA = 59392, MFK = 60416, X0 = 61440, VS = 65536  , PP = 73728, PM = 77824, PI = 81920, AA = 86016  ;
    constexpr int PL = 106496  , YB = 107520, LDS_END = 111616;
    const bf16_t* rbuf = (const bf16_t*)(ws + WS_S + 3 * U_BYTES);
    const bf16_t* kbuf = (const bf16_t*)(ws + WS_S + 5 * U_BYTES);
    const bf16_t* vbuf = (const bf16_t*)(ws + WS_S + 1 * U_BYTES);
    const bf16_t* lora = (const bf16_t*)(ws + WS_S + 4 * U_BYTES);
    for (int unit = blockIdx.x; unit < 256; unit += gridDim.x) {
        const int b = unit >> 5, hh = (unit >> 1) & 15, d = unit & 1;
        bf16_t* ydst = (bf16_t*)(ws + WS_S + (size_t)(d ? 2 : 0) * U_BYTES);
        float* bonus = (float*)(ws + WS_BONUS) + (size_t)((d * NB + b) * 16 + hh) * 8448;
        const int s_e = (tid >> 4) & 15, j0 = (tid & 15) * 4;
        const int ni = wv & 3;
        auto Rof = [&](int c, int s) -> int {
            if (c < 16) { const int q = c * 16 + s; return NL + b * 256 + (d ? 255 - q : q); }
            const int q = (c - 16) * 16 + s; return b * 8192 + (d ? 8191 - q : q);
        };
        constexpr int CST = LDS_END;
        uint2 pr = make_uint2(0, 0), pk = pr, pv = pr; uint4 paw[2], paa[2];
        if (wv >= 4) {
            const int ct = (tid - 256) * 16;
            *(float4*)(lds + CST + 0 * 4096 + ct) = *(const float4*)(p.in[18] + hh * 64 + j0);
            *(float4*)(lds + CST + 1 * 4096 + ct) = *(const float4*)(p.in[19] + hh * 64 + j0);
            *(float4*)(lds + CST + 2 * 4096 + ct) = *(const float4*)(p.in[20] + hh * 64 + j0);
            *(float4*)(lds + CST + 3 * 4096 + ct) = *(const float4*)(p.in[10] + d * 1024 + hh * 64 + ni * 16 + fq * 4);
            *(float4*)(lds + CST + 4 * 4096 + ct) = *(const float4*)(p.in[13] + d * 1024 + hh * 64 + ni * 16 + fq * 4);
#pragma unroll
            for (int ks = 0; ks < 2; ++ks) {
                *(uint4*)(lds + CST + (5 + ks) * 4096 + ct) = *(const uint4*)((const bf16_t*)(ws + WS_W2T) + (size_t)d * 1024 * 64 + (size_t)(hh * 64 + ni * 16 + fr) * 64 + ks * 32 + fq * 8);
                *(uint4*)(lds + CST + (7 + ks) * 4096 + ct) = *(const uint4*)((const bf16_t*)(ws + WS_A2T) + (size_t)d * 1024 * 64 + (size_t)(hh * 64 + ni * 16 + fr) * 64 + ks * 32 + fq * 8);
            }
        }
        auto load_lora = [&](int c) {
            const size_t R2 = (size_t)Rof(c, fr);
#pragma unroll
            for (int ks = 0; ks < 2; ++ks) { paw[ks] = *(const uint4*)(lora + R2 * 384 + d * 64 + ks * 32 + fq * 8); paa[ks] = *(const uint4*)(lora + R2 * 384 + 128 + d * 64 + ks * 32 + fq * 8); }
        };
        auto load_rkv = [&](int c) {
            const size_t off = (size_t)Rof(c, s_e) * 1024 + hh * 64 + j0;
            pr = *(const uint2*)(rbuf + off); pk = *(const uint2*)(kbuf + off); pv = *(const uint2*)(vbuf + off);
        };
        auto step_up = [&](int c) {
            const int ct = (tid - 256) * 16;
            const float4 bias_w = *(const float4*)(lds + CST + 3 * 4096 + ct), bias_a = *(const float4*)(lds + CST + 4 * 4096 + ct);
            bf16x8 bfw[2], bfa[2];
#pragma unroll
            for (int ks = 0; ks < 2; ++ks) { bfw[ks] = *(const bf16x8*)(lds + CST + (5 + ks) * 4096 + ct); bfa[ks] = *(const bf16x8*)(lds + CST + (7 + ks) * 4096 + ct); }
            f32x4 accw = {0.f, 0.f, 0.f, 0.f}, acca = {0.f, 0.f, 0.f, 0.f};
#pragma unroll
            for (int ks = 0; ks < 2; ++ks) { accw = __builtin_amdgcn_mfma_f32_16x16x32_bf16(bfw[ks], as_bf16x8(paw[ks]), accw, 0, 0, 0); acca = __builtin_amdgcn_mfma_f32_16x16x32_bf16(bfa[ks], as_bf16x8(paa[ks]), acca, 0, 0, 0); }
            const int n = ni * 16 + fq * 4;
            const float bw[4] = {bias_w.x, bias_w.y, bias_w.z, bias_w.w}, ba[4] = {bias_a.x, bias_a.y, bias_a.z, bias_a.w};
            float P[4], Pm[4], Pi[4], av[4];
#pragma unroll
            for (int j = 0; j < 4; ++j) {
                const float e = 0.6065306597f * __builtin_amdgcn_rcpf(1.0f + __expf(-(accw[j] + bw[j])));
                float s = e;
                s += dpp_shr0<1>(s); s += dpp_shr0<2>(s); s += dpp_shr0<4>(s); s += dpp_shr0<8>(s);
                P[j] = __expf(-s); Pi[j] = __builtin_amdgcn_rcpf(P[j]); Pm[j] = P[j] * __expf(e);
                av[j] = __builtin_amdgcn_rcpf(1.0f + __expf(-(acca[j] + ba[j])));
            }
            const int pb = (c & 1) * 16384;
            *(float4*)(lds + PP + pb + (fr * 64 + n) * 4) = make_float4(P[0], P[1], P[2], P[3]);
            *(float4*)(lds + PM + pb + (fr * 64 + n) * 4) = make_float4(Pm[0], Pm[1], Pm[2], Pm[3]);
            *(float4*)(lds + PI + pb + (fr * 64 + n) * 4) = make_float4(Pi[0], Pi[1], Pi[2], Pi[3]);
            *(float4*)(lds + AA + pb + (fr * 64 + n) * 4) = make_float4(av[0], av[1], av[2], av[3]);
            if (fr == 15) *(float4*)(lds + PL + (c & 3) * 256 + n * 4) = make_float4(P[0], P[1], P[2], P[3]);
        };
        auto step_vec = [&](int c) {
            const int eo = (s_e * 64 + j0) * 4, pb = (c & 1) * 16384, tb = (c & 1) * 8192, ct = (tid - 256) * 16;
            const float4 kk_c = *(const float4*)(lds + CST + 0 * 4096 + ct), ka_c = *(const float4*)(lds + CST + 1 * 4096 + ct), rk_c = *(const float4*)(lds + CST + 2 * 4096 + ct);
            const float4 a4 = *(const float4*)(lds + AA + pb + eo), P4 = *(const float4*)(lds + PP + pb + eo), Pm4 = *(const float4*)(lds + PM + pb + eo), Pi4 = *(const float4*)(lds + PI + pb + eo);
            const float kx[4] = {bf_lo(pk.x), bf_hi(pk.x), bf_lo(pk.y), bf_hi(pk.y)};
            const float rx[4] = {bf_lo(pr.x), bf_hi(pr.x), bf_lo(pr.y), bf_hi(pr.y)};
            const float av[4] = {a4.x, a4.y, a4.z, a4.w}, Pv[4] = {P4.x, P4.y, P4.z, P4.w}, Pmv[4] = {Pm4.x, Pm4.y, Pm4.z, Pm4.w}, Piv[4] = {Pi4.x, Pi4.y, Pi4.z, Pi4.w};
            const float kkc[4] = {kk_c.x, kk_c.y, kk_c.z, kk_c.w}, kac[4] = {ka_c.x, ka_c.y, ka_c.z, ka_c.w}, rkc[4] = {rk_c.x, rk_c.y, rk_c.z, rk_c.w};
            float t[4], n2 = 0.f;
#pragma unroll
            for (int j = 0; j < 4; ++j) { t[j] = kx[j] * kkc[j]; n2 += t[j] * t[j]; }
            n2 = row16_allreduce(n2);
            const float inv = 1.0f / fmaxf(sqrtf(n2), 1e-12f);
            float at[4], bt[4], kt[4], rt[4], bon = 0.f;
#pragma unroll
            for (int j = 0; j < 4; ++j) {
                const float kkv = t[j] * inv;
                const float kd = kx[j] * (1.0f + (av[j] - 1.0f) * kac[j]);
                const float bq = kkv * av[j];
                bon += rx[j] * kd * rkc[j];
                at[j] = -kkv * Pmv[j]; bt[j] = bq * Piv[j]; kt[j] = kd * Piv[j]; rt[j] = rx[j] * Pv[j];
            }
            bon = row16_allreduce(bon);
            if ((tid & 15) == 0) { const int Rb = Rof(c, s_e); bonus[Rb < NL ? 256 + (Rb & 8191) : ((Rb - NL) & 255)] = bon; }
            const int ro = tile_off(s_e, j0 >> 3) + (j0 & 7) * 2;
            *(uint2*)(lds + AT + ro) = make_uint2(pk_bf16(at[0], at[1]), pk_bf16(at[2], at[3]));
            *(uint2*)(lds + RT + ro) = make_uint2(pk_bf16(rt[0], rt[1]), pk_bf16(rt[2], rt[3]));
            const unsigned b01 = pk_bf16(bt[0], bt[1]), b23 = pk_bf16(bt[2], bt[3]), k01 = pk_bf16(kt[0], kt[1]), k23 = pk_bf16(kt[2], kt[3]);
            *(uint2*)(lds + BT + ro) = make_uint2(b01, b23);
            *(uint2*)(lds + KT + ro) = make_uint2(k01, k23);
            const unsigned bw2[4] = {b01 & 0xffffu, b01 >> 16, b23 & 0xffffu, b23 >> 16}, kw2[4] = {k01 & 0xffffu, k01 >> 16, k23 & 0xffffu, k23 >> 16};
            const unsigned vw[4] = {pv.x & 0xffffu, pv.x >> 16, pv.y & 0xffffu, pv.y >> 16};
            const int e0 = (s_e & 7) * 2, cq = s_e >> 3;
#pragma unroll
            for (int j = 0; j < 4; ++j) {
                const int row = j0 + j;
                *(bf16_t*)(lds + BKT + tb + tile_off2(row, 0 + cq) + e0) = (bf16_t)bw2[j];
                *(bf16_t*)(lds + BKT + tb + tile_off2(row, 2 + cq) + e0) = (bf16_t)kw2[j];
                *(bf16_t*)(lds + BKT + tb + tile_off2(row, 4 + cq) + e0) = (bf16_t)bw2[j];
                *(bf16_t*)(lds + UV + tb + tile_off2(row, 2 + cq) + e0) = (bf16_t)vw[j];
            }
            *(float4*)(lds + VS + (c & 1) * 4096 + eo) = make_float4(bf_lo(pv.x), bf_hi(pv.x), bf_lo(pv.y), bf_hi(pv.y));
        };
        f32x4 accY = {0.f, 0.f, 0.f, 0.f};
        auto step_prod = [&]() {
            const int vt = wv & 3;
            f32x4 accX = {0.f, 0.f, 0.f, 0.f};
#pragma unroll
            for (int ks = 0; ks < 2; ++ks) {
                const int ch = ks * 4 + fq;
                const bf16x8 sh = *(const bf16x8*)(lds + SH + tile_off(vt * 16 + fr, ch)), sl = *(const bf16x8*)(lds + SL + tile_off(vt * 16 + fr, ch));
                const bf16x8 bb = *(const bf16x8*)(lds + (wv < 4 ? RT : AT) + tile_off(fr, ch));
                accX = __builtin_amdgcn_mfma_f32_16x16x32_bf16(sh, bb, accX, 0, 0, 0);
                accX = __builtin_amdgcn_mfma_f32_16x16x32_bf16(sl, bb, accX, 0, 0, 0);
            }
            if (wv < 4) {
                accY = accX;
                f32x4 m = {0.f, 0.f, 0.f, 0.f};
#pragma unroll
                for (int ks = 0; ks < 2; ++ks) {
                    const int ch = ks * 4 + fq;
                    const bf16x8 fa = *(const bf16x8*)(lds + ((wv & 1) ? KT : BT) + tile_off(fr, ch));
                    const bf16x8 fb = *(const bf16x8*)(lds + ((wv & 2) ? RT : AT) + tile_off(fr, ch));
                    m = __builtin_amdgcn_mfma_f32_16x16x32_bf16(fa, fb, m, 0, 0, 0);
                }
                if (wv < 2) {
                    float* mf = (float*)(lds + (wv ? MFK : MFA));
#pragma unroll
                    for (int j = 0; j < 4; ++j) mf[(fr * 4 + j) * 4 + fq] = (4 * fq + j < fr) ? m[j] : 0.f;
                } else {
                    const float m0 = (4 * fq + 0 <= fr) ? m[0] : 0.f, m1 = (4 * fq + 1 <= fr) ? m[1] : 0.f, m2 = (4 * fq + 2 <= fr) ? m[2] : 0.f, m3 = (4 * fq + 3 <= fr) ? m[3] : 0.f;
                    const uint2 o = make_uint2(pk_bf16(m0, m1), pk_bf16(m2, m3));
                    const int colb = (wv == 2 ? 0 : 16) + 4 * fq;
                    *(uint2*)(lds + NT + tile_off(fr, colb >> 3) + (colb & 7) * 2) = o;
                    if (wv == 2) *(uint2*)(lds + NT + tile_off(fr, (32 + 4 * fq) >> 3) + ((32 + 4 * fq) & 7) * 2) = o;
                }
            } else {
#pragma unroll
                for (int j = 0; j < 4; ++j) *(float*)(lds + X0 + ((vt * 16 + 4 * fq + j) * 16 + fr) * 4) = accX[j];
            }
        };
        auto step_rec = [&](int c) {
            const int v = tid >> 2, pq = tid & 3;
            float cc[16];
#pragma unroll
            for (int i = 0; i < 4; ++i) { const float4 q = *(const float4*)(lds + X0 + (v * 16 + 4 * i) * 4); cc[4 * i] = q.x; cc[4 * i + 1] = q.y; cc[4 * i + 2] = q.z; cc[4 * i + 3] = q.w; }
            float vown[4];
#pragma unroll
            for (int i = 0; i < 4; ++i) vown[i] = *(const float*)(lds + VS + (c & 1) * 4096 + ((4 * i + pq) * 64 + v) * 4);
#pragma unroll
            for (int t = 1; t < 16; ++t) {
                const float4 mk = *(const float4*)(lds + MFK + ((t * 4 + pq) * 4) * 4);
                float s = vown[0] * mk.x; s = fmaf(vown[1], mk.y, s); s = fmaf(vown[2], mk.z, s); s = fmaf(vown[3], mk.w, s);
                s += dpp_quad<0xB1>(s); s += dpp_quad<0x4E>(s);
                cc[t] += s;
            }
            float4 ma[16];
#pragma unroll
            for (int t = 1; t < 16; ++t) ma[t] = *(const float4*)(lds + MFA + ((t * 4 + pq) * 4) * 4);
            ma[0] = make_float4(0.f, 0.f, 0.f, 0.f);
            float uown[4] = {0.f, 0.f, 0.f, 0.f}, uall[16];
#pragma unroll
            for (int t = 0; t < 16; ++t) {
                float s = uown[0] * ma[t].x; s = fmaf(uown[1], ma[t].y, s); s = fmaf(uown[2], ma[t].z, s); s = fmaf(uown[3], ma[t].w, s);
                s += dpp_quad<0xB1>(s); s += dpp_quad<0x4E>(s);
                const float u = cc[t] + s;
                uall[t] = u;
                if (pq == (t & 3)) uown[t >> 2] = u;
            }
            if (pq < 2) {
                unsigned o[8];
#pragma unroll
                for (int i = 0; i < 8; ++i) {
                    const unsigned hi = pk_bf16(uall[2 * i], uall[2 * i + 1]);
                    o[i] = pq ? pk_bf16(uall[2 * i] - bf_lo(hi), uall[2 * i + 1] - bf_hi(hi)) : hi;
                }
                const int cb = pq ? 4 : 0;
                *(uint4*)(lds + UV + (c & 1) * 8192 + tile_off2(v, cb)) = make_uint4(o[0], o[1], o[2], o[3]);
                *(uint4*)(lds + UV + (c & 1) * 8192 + tile_off2(v, cb + 1)) = make_uint4(o[4], o[5], o[6], o[7]);
            }
        };
        f32x4 accS[2];
        accS[0] = (f32x4){0.f, 0.f, 0.f, 0.f}; accS[1] = (f32x4){0.f, 0.f, 0.f, 0.f};
        auto step_upd = [&](int c) {
            const int vt = wv & 3;
            bf16x8 fuv[2];
#pragma unroll
            for (int ks = 0; ks < 2; ++ks) fuv[ks] = *(const bf16x8*)(lds + UV + (c & 1) * 8192 + tile_off2(vt * 16 + fr, ks * 4 + fq));
            if (wv < 4) {
#pragma unroll
                for (int ks = 0; ks < 2; ++ks) accY = __builtin_amdgcn_mfma_f32_16x16x32_bf16(fuv[ks], *(const bf16x8*)(lds + NT + tile_off(fr, ks * 4 + fq)), accY, 0, 0, 0);
                *(float4*)(lds + YB + (fr * 64 + vt * 16 + 4 * fq) * 4) = make_float4(accY[0], accY[1], accY[2], accY[3]);
            }
#pragma unroll
            for (int k2 = 0; k2 < 2; ++k2) {
                const int kt = 2 * (wv >> 2) + k2;
                f32x4 a = accS[k2];
#pragma unroll
                for (int ks = 0; ks < 2; ++ks) a = __builtin_amdgcn_mfma_f32_16x16x32_bf16(*(const bf16x8*)(lds + BKT + (c & 1) * 8192 + tile_off2(kt * 16 + fr, ks * 4 + fq)), fuv[ks], a, 0, 0, 0);
                const float4 pl = *(const float4*)(lds + PL + (c & 3) * 256 + (kt * 16 + 4 * fq) * 4);
                a[0] *= pl.x; a[1] *= pl.y; a[2] *= pl.z; a[3] *= pl.w;
                accS[k2] = a;
                const unsigned h01 = pk_bf16(a[0], a[1]), h23 = pk_bf16(a[2], a[3]);
                const unsigned l01 = pk_bf16(a[0] - bf_lo(h01), a[1] - bf_hi(h01)), l23 = pk_bf16(a[2] - bf_lo(h23), a[3] - bf_hi(h23));
                const int kc = kt * 16 + 4 * fq;
                const int so = tile_off(vt * 16 + fr, kc >> 3) + (kc & 7) * 2;
                *(uint2*)(lds + SH + so) = make_uint2(h01, h23);
                *(uint2*)(lds + SL + so) = make_uint2(l01, l23);
            }
        };
        for (int i = tid; i < LDS_END / 16; i += NTHREADS) *(uint4*)(lds + i * 16) = make_uint4(0, 0, 0, 0);
        if (wv >= 4) { load_lora(0); load_rkv(0); }
        __syncthreads();
        if (wv >= 4) { step_up(0); load_lora(1); }
        __syncthreads();
        if (wv >= 4) { step_vec(0); step_up(1); load_rkv(1); load_lora(2); }
        __syncthreads();
        step_prod();
        __syncthreads();
        auto ystore = [&](int c) {
            const float4 y4 = *(const float4*)(lds + YB + (s_e * 64 + j0) * 4);
            *(uint2*)(ydst + (size_t)Rof(c, s_e) * 1024 + hh * 64 + j0) = make_uint2(pk_bf16(y4.x, y4.y), pk_bf16(y4.z, y4.w));
        };
        if (wv < 4) {
            for (int c = 0; c < 528; ++c) {
                if (c > 0) ystore(c - 1);
                step_rec(c);
                __syncthreads();
                step_upd(c);
                __syncthreads();
                if (c + 1 < 528) step_prod();
                __syncthreads();
            }
        } else {
            for (int c = 0; c < 528; ++c) {
                if (c + 1 < 528) step_vec(c + 1);
                if (c + 2 < 528) { step_up(c + 2); load_rkv(c + 2); }
                if (c + 3 < 528) load_lora(c + 3);
                __syncthreads();
                step_upd(c);
                __syncthreads();
                if (c + 1 < 528) step_prod();
                __syncthreads();
            }
        }
        if (wv < 4) ystore(527);
        __syncthreads();
    }
}

DEV void phase_rw_readout(const Params& p) {
    const int tid = tid_opaque(), lane = tid & 63, wv = tid >> 6, wm = wv >> 2, wn = wv & 3;
    const int fr = lane & 15, fq = lane >> 4;
    unsigned char* ws = p.ws;
    const bf16_t* y0b = (const bf16_t*)(ws + WS_S + 0 * U_BYTES);
    const bf16_t* y1b = (const bf16_t*)(ws + WS_S + 2 * U_BYTES);
    const bf16_t* vb = (const bf16_t*)(ws + WS_S + 1 * U_BYTES);
    const bf16_t* lora = (const bf16_t*)(ws + WS_S + 4 * U_BYTES);
    const bf16_t* g2t = (const bf16_t*)(ws + WS_G2T);
    bf16_t* ao = (bf16_t*)(ws + WS_S + 5 * U_BYTES);
    const float* bon0 = (const float*)(ws + WS_BONUS);
    const float* bon1 = bon0 + (size_t)NB * 16 * 8448;
    const float* lnw = p.in[21];
    const float* lnb = p.in[22];
    const int nunits = (NT / 128) * 4;
    for (int u = blockIdx.x; u < nunits; u += gridDim.x) {
        const int mt = u >> 2, nt = u & 3, m0 = mt * 128;
        const int hh = nt * 4 + wn;
        f32x4 acc[4][4];
#pragma unroll
        for (int mi = 0; mi < 4; ++mi)
#pragma unroll
            for (int ni = 0; ni < 4; ++ni) acc[mi][ni] = (f32x4){0.f, 0.f, 0.f, 0.f};
#pragma unroll 2
        for (int ks = 0; ks < 4; ++ks) {
            bf16x8 af[4], bfr[4];
#pragma unroll
            for (int mi = 0; mi < 4; ++mi) af[mi] = *(const bf16x8*)(lora + (size_t)(m0 + wm * 64 + mi * 16 + fr) * 384 + 256 + ks * 32 + fq * 8);
#pragma unroll
            for (int ni = 0; ni < 4; ++ni) bfr[ni] = *(const bf16x8*)(g2t + (size_t)(hh * 64 + ni * 16 + fr) * 128 + ks * 32 + fq * 8);
#pragma unroll
            for (int mi = 0; mi < 4; ++mi)
#pragma unroll
                for (int ni = 0; ni < 4; ++ni) acc[mi][ni] = __builtin_amdgcn_mfma_f32_16x16x32_bf16(bfr[ni], af[mi], acc[mi][ni], 0, 0, 0);
        }
#pragma unroll
        for (int mi = 0; mi < 4; ++mi) {
            const size_t R = (size_t)(m0 + wm * 64 + mi * 16 + fr);
            float yv[4][4]; float sum = 0.f;
#pragma unroll
            for (int ni = 0; ni < 4; ++ni) {
                const int col = hh * 64 + ni * 16 + 4 * fq;
                const uint2 a = *(const uint2*)(y0b + R * 1024 + col), b2 = *(const uint2*)(y1b + R * 1024 + col);
                yv[ni][0] = bf_lo(a.x) + bf_lo(b2.x); yv[ni][1] = bf_hi(a.x) + bf_hi(b2.x); yv[ni][2] = bf_lo(a.y) + bf_lo(b2.y); yv[ni][3] = bf_hi(a.y) + bf_hi(b2.y);
                sum += (yv[ni][0] + yv[ni][1]) + (yv[ni][2] + yv[ni][3]);
            }
            sum += __shfl_xor(sum, 16); sum += __shfl_xor(sum, 32);
            const float mu = sum * (1.0f / 64.0f);
            float q = 0.f;
#pragma unroll
            for (int ni = 0; ni < 4; ++ni)
#pragma unroll
                for (int j = 0; j < 4; ++j) { const float dlt = yv[ni][j] - mu; q += dlt * dlt; }
            q += __shfl_xor(q, 16); q += __shfl_xor(q, 32);
            const float rstd = rsqrtf(q * (1.0f / 64.0f) + 64e-5f);
            const size_t bidx = (size_t)(((R < NL ? (R >> 13) : ((R - NL) >> 8)) * 16 + hh)) * 8448 + (R < NL ? 256 + (R & 8191) : ((R - NL) & 255));
            const float bs = bon0[bidx] + bon1[bidx];
#pragma unroll
            for (int ni = 0; ni < 4; ++ni) {
                const int col = hh * 64 + ni * 16 + 4 * fq;
                const uint2 vv = *(const uint2*)(vb + R * 1024 + col);
                const float4 lw = *(const float4*)(lnw + col), lb = *(const float4*)(lnb + col);
                const float o0 = ((yv[ni][0] - mu) * rstd * lw.x + lb.x + bs * bf_lo(vv.x)) * acc[mi][ni][0];
                const float o1 = ((yv[ni][1] - mu) * rstd * lw.y + lb.y + bs * bf_hi(vv.x)) * acc[mi][ni][1];
                const float o2 = ((yv[ni][2] - mu) * rstd * lw.z + lb.z + bs * bf_lo(vv.y)) * acc[mi][ni][2];
                const float o3 = ((yv[ni][3] - mu) * rstd * lw.w + lb.w + bs * bf_hi(vv.y)) * acc[mi][ni][3];
                *(uint2*)(ao + R * 1024 + col) = make_uint2(pk_bf16(o0, o1), pk_bf16(o2, o3));
            }
        }
    }
}

DEV void phase_wo(const Params& p, unsigned char* lds, int layer) {
    unsigned char* ws = p.ws;
    const bf16_t* ao = (const bf16_t*)(ws + WS_S + (size_t)(layer ? 2 : 5) * U_BYTES);
    const bf16_t* wot = (const bf16_t*)(ws + (layer ? WS_WO1 : WS_WO0));
    float* ctxr = (float*)(ws + WS_CTXR);
    const float* gate = (const float*)(ws + WS_MOD) + (size_t)layer * 9 * 6144 + 2 * 1024;
    const int M = layer ? NL : NT;
    pg8::Gemm g{ao, wot, M, 1024, 1024};
    pg8::StaticOrder so; so.init(M, 1024, gridDim.x, blockIdx.x);
    pg8::EpiResid256 ep{layer ? p.out : p.in[0], layer ? ctxr : p.in[2], p.out, ctxr, gate};
    pg8::gemm_phase((PG8_LAS unsigned char*)lds, g, so, ep, nullptr);
    __syncthreads();
}

struct EpiQTile {
    unsigned char* lds;
    DEV void operator()(const f32x4 (&acc)[4][4], int m0, int wm, int wn, int fr, int fq) const {
        const int pp = wn >> 1;
#pragma unroll
        for (int mi = 0; mi < 4; ++mi) {
            const int m = wm * 64 + mi * 16 + fr;
#pragma unroll
            for (int ni = 0; ni < 4; ++ni) {
                const int c = (wn & 1) * 64 + ni * 16 + 4 * fq;
                *(uint2*)(lds + pp * 32768 + m * 256 + (((c >> 3) ^ (m & 15)) << 4) + (c & 7) * 2) = make_uint2(pk_bf16(acc[mi][ni][0], acc[mi][ni][1]), pk_bf16(acc[mi][ni][2], acc[mi][ni][3]));
            }
        }
    }
};
DEV void phase_peer_select(const Params& p, unsigned char* lds, int layer) {
    const int tid = tid_opaque(), lane = tid & 63, wv = tid >> 6, wm = wv >> 2, wn = wv & 3;
    const int fr = lane & 15, fq = lane >> 4;
    unsigned char* ws = p.ws;
    const bf16_t* hp = (const bf16_t*)(ws + WS_S + (size_t)(layer ? 0 : 1) * U_BYTES);
    const bf16_t* wqt = (const bf16_t*)(ws + WS_WQ) + (size_t)layer * 2048 * 1024;
    const bf16_t* keys = (const bf16_t*)(ws + WS_KEYS) + (size_t)layer * 8 * 2 * 128 * 128;
    int* pl_idx = (int*)(ws + WS_S + 3 * U_BYTES);
    float* pl_gate = (float*)(ws + WS_S + 3 * U_BYTES + (size_t)NT * 128 * 4);
    unsigned* slist = (unsigned*)lds;
    unsigned* tlist = (unsigned*)(lds + 256 * 132 * 4);
    const int mtiles = layer ? NL / 128 : NT / 128;
    for (int u = blockIdx.x; u < mtiles * 8; u += gridDim.x) {
        const int mt = u >> 3, head = u & 7, m0 = mt * 128;
        ALoadPlain al{hp, 1024};
        EpiQTile ep{lds};
        gemm_unit<256>(lds, al, wqt + (size_t)head * 256 * 1024, 1024, m0, ep);
        __syncthreads();
        const int pp = wn >> 1, nk0 = (wn & 1) * 64;
        f32x4 sc[4][4];
#pragma unroll
        for (int mi = 0; mi < 4; ++mi)
#pragma unroll
            for (int ni = 0; ni < 4; ++ni) sc[mi][ni] = (f32x4){0.f, 0.f, 0.f, 0.f};
        const bf16_t* kb = keys + (size_t)(head * 2 + pp) * 16384;
#pragma unroll
        for (int ks = 0; ks < 4; ++ks) {
            bf16x8 af[4], bfr[4];
            const int ch = ks * 4 + fq;
#pragma unroll
            for (int mi = 0; mi < 4; ++mi) { const int m = wm * 64 + mi * 16 + fr; af[mi] = *(const bf16x8*)(lds + pp * 32768 + m * 256 + ((ch ^ (m & 15)) << 4)); }
#pragma unroll
            for (int ni = 0; ni < 4; ++ni) bfr[ni] = *(const bf16x8*)(kb + (size_t)(nk0 + ni * 16 + fr) * 128 + ks * 32 + fq * 8);
#pragma unroll
            for (int mi = 0; mi < 4; ++mi)
#pragma unroll
                for (int ni = 0; ni < 4; ++ni) sc[mi][ni] = __builtin_amdgcn_mfma_f32_16x16x32_bf16(bfr[ni], af[mi], sc[mi][ni], 0, 0, 0);
        }
        __syncthreads();
#pragma unroll
        for (int mi = 0; mi < 4; ++mi) {
            const int m = wm * 64 + mi * 16 + fr;
#pragma unroll
            for (int ni = 0; ni < 4; ++ni) {
                const int n = nk0 + ni * 16 + 4 * fq;
                uint4 o;
                o.x = (mono_u32(sc[mi][ni][0]) & ~127u) | (unsigned)(127 - (n + 0));
                o.y = (mono_u32(sc[mi][ni][1]) & ~127u) | (unsigned)(127 - (n + 1));
                o.z = (mono_u32(sc[mi][ni][2]) & ~127u) | (unsigned)(127 - (n + 2));
                o.w = (mono_u32(sc[mi][ni][3]) & ~127u) | (unsigned)(127 - (n + 3));
                *(uint4*)(slist + (size_t)(pp * 128 + m) * 132 + n) = o;
            }
        }
        __syncthreads();
        if (tid < 256) {
            unsigned t[16];
#pragma unroll
            for (int i = 0; i < 16; ++i) t[i] = 0u;
            const unsigned* src = slist + (size_t)tid * 132;
#pragma unroll 2
            for (int j = 0; j < 32; ++j) {
                const uint4 v = *(const uint4*)(src + j * 4);
                unsigned xs[4] = {v.x, v.y, v.z, v.w};
#pragma unroll
                for (int e = 0; e < 4; ++e) {
                    unsigned x = xs[e];
#pragma unroll
                    for (int i = 0; i < 16; ++i) { const unsigned mx = max(t[i], x); x = min(t[i], x); t[i] = mx; }
                }
            }
#pragma unroll
            for (int i = 0; i < 4; ++i) *(uint4*)(tlist + tid * 16 + i * 4) = make_uint4(t[4 * i], t[4 * i + 1], t[4 * i + 2], t[4 * i + 3]);
        }
        __syncthreads();
        if (tid < 128) {
            float v0[16], v1[16];
#pragma unroll
            for (int i = 0; i < 16; ++i) { v0[i] = unmono_u32(tlist[tid * 16 + i] & ~127u); v1[i] = unmono_u32(tlist[(128 + tid) * 16 + i] & ~127u); }
            unsigned cd[16];
#pragma unroll
            for (int i = 0; i < 16; ++i) cd[i] = 0u;
#pragma unroll
            for (int i = 0; i < 16; ++i) {
#pragma unroll
                for (int j = 0; j < 16; ++j) {
                    if ((i + 1) * (j + 1) <= 16) {
                        unsigned x = (mono_u32(v0[i] + v1[j]) & ~255u) | (unsigned)(255 - (i * 16 + j));
#pragma unroll
                        for (int q = 0; q < 16; ++q) { const unsigned mx = max(cd[q], x); x = min(cd[q], x); cd[q] = mx; }
                    }
                }
            }
            float sv[16]; int ex[16];
#pragma unroll
            for (int q = 0; q < 16; ++q) {
                const int slot = 255 - (int)(cd[q] & 255u);
                const unsigned a = tlist[tid * 16 + (slot >> 4)], b2 = tlist[(128 + tid) * 16 + (slot & 15)];
                sv[q] = unmono_u32(a & ~127u) + unmono_u32(b2 & ~127u);
                ex[q] = (127 - (int)(a & 127u)) * 128 + (127 - (int)(b2 & 127u));
            }
            float mx = sv[0];
#pragma unroll
            for (int q = 1; q < 16; ++q) mx = fmaxf(mx, sv[q]);
            float den = 0.f;
#pragma unroll
            for (int q = 0; q < 16; ++q) { sv[q] = __expf(sv[q] - mx); den += sv[q]; }
            const float rden = 1.0f / den;
            const size_t base = ((size_t)head * NT + (m0 + tid)) * 16;
#pragma unroll
            for (int i = 0; i < 4; ++i) {
                *(int4*)(pl_idx + base + i * 4) = make_int4(ex[4 * i], ex[4 * i + 1], ex[4 * i + 2], ex[4 * i + 3]);
                *(float4*)(pl_gate + base + i * 4) = make_float4(sv[4 * i] * rden, sv[4 * i + 1] * rden, sv[4 * i + 2] * rden, sv[4 * i + 3] * rden);
            }
        }
        __syncthreads();
    }
}

typedef float f32x2 __attribute__((ext_vector_type(2)));
typedef unsigned int u32x4 __attribute__((ext_vector_type(4)));
DEV void phase_peer_gather(const Params& p, int layer, int fin) {
    const int tid = tid_opaque(), lane = tid & 63;
    const int gw = __builtin_amdgcn_readfirstlane(blockIdx.x * 8 + (tid >> 6)), nw = gridDim.x * 8;
    unsigned char* ws = p.ws;
    const bf16_t* hp = (const bf16_t*)(ws + WS_S + (size_t)(layer ? 0 : 1) * U_BYTES);
    const unsigned char* pu = ws + WS_PU + (size_t)layer * 16384 * 1024;
    const unsigned char* pvt = ws + WS_PV + (size_t)layer * 16384 * 1024;
    const unsigned lane16 = 16u * (unsigned)lane;
    const __amdgpu_buffer_rsrc_t rs_u = __builtin_amdgcn_make_buffer_rsrc((void*)pu, 0, 16384 * 1024, 0x00020000);
    const __amdgpu_buffer_rsrc_t rs_v = __builtin_amdgcn_make_buffer_rsrc((void*)pvt, 0, 16384 * 1024, 0x00020000);
    const float* usc = (const float*)(ws + WS_PSC) + layer * 16384;
    const float* vsc = (const float*)(ws + WS_PSC) + 32768 + layer * 16384;
    const int* pl_idx = (const int*)(ws + WS_S + 3 * U_BYTES);
    const float* pl_gate = (const float*)(ws + WS_S + 3 * U_BYTES + (size_t)NT * 128 * 4);
    float* ctxr = (float*)(ws + WS_CTXR);
    const float* mods = (const float*)(ws + WS_MOD) + (size_t)layer * 9 * 6144;
    const int nrows = layer ? NL : NT;
    uint4 bufA[16], bufB[16];
#define PG_LOAD(buf, tab, elo, ehi, g) { _Pragma("unroll") for (int e = 0; e < 16; ++e) { \
        const int ei = __builtin_amdgcn_readlane((g) < 4 ? (elo) : (ehi), ((g) * 16 + e) & 63); const u32x4 t4 = __builtin_amdgcn_raw_buffer_load_b128((tab), lane16, ei << 10, 0); buf[e] = make_uint4(t4.x, t4.y, t4.z, t4.w); } }
#define PG_DOT(buf, g) { _Pragma("unroll") for (int e = 0; e < 16; ++e) { \
        const unsigned uw[4] = {buf[e].x, buf[e].y, buf[e].z, buf[e].w}; f32x2 s2 = {0.f, 0.f}; \
        _Pragma("unroll") for (int i = 0; i < 4; ++i) { \
            const f32x2 a = __builtin_amdgcn_cvt_pk_f32_fp8((int)uw[i], false), b2 = __builtin_amdgcn_cvt_pk_f32_fp8((int)uw[i], true); \
            s2 += a * x2[2 * i] + b2 * x2[2 * i + 1]; } \
        const float s = wave_allreduce(s2.x + s2.y); \
        if (lane == (((g) * 16 + e) & 63)) { if ((g) < 4) d_lo = s; else d_hi = s; } } }
#define PG_AXPY(buf, g) { _Pragma("unroll") for (int e = 0; e < 16; ++e) { \
        const float cf = __int_as_float(__builtin_amdgcn_readlane(__float_as_int((g) < 4 ? c_lo : c_hi), ((g) * 16 + e) & 63)); \
        const f32x2 cf2 = {cf, cf}; const unsigned vw[4] = {buf[e].x, buf[e].y, buf[e].z, buf[e].w}; \
        _Pragma("unroll") for (int i = 0; i < 4; ++i) { \
            const f32x2 a = __builtin_amdgcn_cvt_pk_f32_fp8((int)vw[i], false), b2 = __builtin_amdgcn_cvt_pk_f32_fp8((int)vw[i], true); \
            acc2[2 * i] += cf2 * a; acc2[2 * i + 1] += cf2 * b2; } } }
    int R = gw;
    int e_lo = 0, e_hi = 0;
    const size_t pl_lo = (size_t)(lane >> 4) * NT * 16 + (lane & 15), pl_hi = pl_lo + (size_t)4 * NT * 16;
    if (R < nrows) { e_lo = pl_idx[pl_lo + (size_t)R * 16]; e_hi = pl_idx[pl_hi + (size_t)R * 16]; PG_LOAD(bufA, rs_u, e_lo, e_hi, 0); }
    for (; R < nrows; R += nw) {
        const bf16_t* hrow = hp + (size_t)R * 1024;
        f32x2 x2[8];
#pragma unroll
        for (int i = 0; i < 4; ++i) { const uint2 w = *(const uint2*)(hrow + 256 * i + 4 * lane); x2[2 * i] = (f32x2){bf_lo(w.x), bf_hi(w.x)}; x2[2 * i + 1] = (f32x2){bf_lo(w.y), bf_hi(w.y)}; }
        const float g_lo = pl_gate[pl_lo + (size_t)R * 16], g_hi = pl_gate[pl_hi + (size_t)R * 16];
        const float su_lo = usc[e_lo], su_hi = usc[e_hi], sv_lo = vsc[e_lo], sv_hi = vsc[e_hi];
        const int Rn = R + nw;
        int ne_lo = 0, ne_hi = 0;
        if (Rn < nrows) { ne_lo = pl_idx[pl_lo + (size_t)Rn * 16]; ne_hi = pl_idx[pl_hi + (size_t)Rn * 16]; }
        float d_lo = 0.f, d_hi = 0.f;
#pragma unroll 1
        for (int g = 0; g < 8; g += 2) {
            PG_LOAD(bufB, rs_u, e_lo, e_hi, g + 1);
            PG_DOT(bufA, g);
            if (g + 2 < 8) { PG_LOAD(bufA, rs_u, e_lo, e_hi, g + 2); } else { PG_LOAD(bufA, rs_v, e_lo, e_hi, 0); }
            PG_DOT(bufB, g + 1);
        }
        d_lo *= su_lo; d_hi *= su_hi;
        const float c_lo = g_lo * sv_lo * 0.5f * d_lo * (1.0f + erff(d_lo * 0.70710678118f));
        const float c_hi = g_hi * sv_hi * 0.5f * d_hi * (1.0f + erff(d_hi * 0.70710678118f));
        f32x2 acc2[8];
#pragma unroll
        for (int i = 0; i < 8; ++i) acc2[i] = (f32x2){0.f, 0.f};
#pragma unroll 1
        for (int g = 0; g < 8; g += 2) {
            PG_LOAD(bufB, rs_v, e_lo, e_hi, g + 1);
            PG_AXPY(bufA, g);
            if (g + 2 < 8) { PG_LOAD(bufA, rs_v, e_lo, e_hi, g + 2); } else if (Rn < nrows) { PG_LOAD(bufA, rs_u, ne_lo, ne_hi, 0); }
            PG_AXPY(bufB, g + 1);
        }
        e_lo = ne_lo; e_hi = ne_hi;
        float acc[16];
#pragma unroll
        for (int i = 0; i < 8; ++i) { acc[2 * i] = acc2[i].x; acc[2 * i + 1] = acc2[i].y; }
        float* xrow = R < NL ? p.out + (size_t)R * 1024 : ctxr + (size_t)(R - NL) * 1024;
        const float* mrow = mods + (size_t)mod_batch(R) * 6144;
        float xn[16]; float ss = 0.f;
#pragma unroll
        for (int i = 0; i < 4; ++i) {
            const int col = 256 * i + 4 * lane;
            const float4 xa = *(const float4*)(xrow + col), ga = *(const float4*)(mrow + 5 * 1024 + col);
            xn[4 * i] = xa.x + ga.x * acc[4 * i]; xn[4 * i + 1] = xa.y + ga.y * acc[4 * i + 1]; xn[4 * i + 2] = xa.z + ga.z * acc[4 * i + 2]; xn[4 * i + 3] = xa.w + ga.w * acc[4 * i + 3];
            ss += xn[4 * i] * xn[4 * i] + xn[4 * i + 1] * xn[4 * i + 1] + xn[4 * i + 2] * xn[4 * i + 2] + xn[4 * i + 3] * xn[4 * i + 3];
        }
        ss = wave_allreduce(ss);
        const float rs = rsqrtf(ss * (1.0f / 1024.0f) + 1e-6f);
        if (!fin) {
            const float* mrow1 = (const float*)(ws + WS_MOD) + (size_t)(layer + 1) * 9 * 6144 + (size_t)mod_batch(R) * 6144;
            const float* gn = p.in[6] + (layer + 1) * 1024;
            bf16_t* hdst = (bf16_t*)(ws + WS_S + 0 * U_BYTES) + (size_t)R * 1024;
#pragma unroll
            for (int i = 0; i < 4; ++i) {
                const int col = 256 * i + 4 * lane;
                *(float4*)(xrow + col) = make_float4(xn[4 * i], xn[4 * i + 1], xn[4 * i + 2], xn[4 * i + 3]);
                const float4 gg = *(const float4*)(gn + col), sh = *(const float4*)(mrow1 + col), sc = *(const float4*)(mrow1 + 1024 + col);
                const float y0 = xn[4 * i] * rs * gg.x * (1.f + sc.x) + sh.x, y1 = xn[4 * i + 1] * rs * gg.y * (1.f + sc.y) + sh.y;
                const float y2 = xn[4 * i + 2] * rs * gg.z * (1.f + sc.z) + sh.z, y3 = xn[4 * i + 3] * rs * gg.w * (1.f + sc.w) + sh.w;
                *(uint2*)(hdst + col) = make_uint2(pk_bf16(y0, y1), pk_bf16(y2, y3));
            }
        } else {
            const float* gn = p.in[34];
#pragma unroll
            for (int i = 0; i < 4; ++i) {
                const int col = 256 * i + 4 * lane;
                const float4 gg = *(const float4*)(gn + col);
                *(float4*)(xrow + col) = make_float4(xn[4 * i] * rs * gg.x, xn[4 * i + 1] * rs * gg.y, xn[4 * i + 2] * rs * gg.z, xn[4 * i + 3] * rs * gg.w);
            }
        }
    }
}

DEV void phase_gla_proj(const Params& p, unsigned char* lds) {
    unsigned char* ws = p.ws;
    const bf16_t* h = (const bf16_t*)(ws + WS_S + 0 * U_BYTES);
    const bf16_t* wint = (const bf16_t*)(ws + WS_WIN);
    {
        pg8::Gemm g{h, wint, NT, 3072, 1024};
        pg8::StaticOrder so; so.init(NT, 3072, gridDim.x, blockIdx.x);
        pg8::EpiBf16Tiles ep{(bf16_t*)(ws + WS_S + 1 * U_BYTES), 2048, 8, (bf16_t*)(ws + WS_S + 3 * U_BYTES), 1024};
        pg8::gemm_phase(( PG8_LAS unsigned char*)lds, g, so, ep, nullptr);
    }
    __syncthreads();
    for (int u = blockIdx.x; u < NT / 128; u += gridDim.x) {
        ALoadPlain al{h, 1024};
        EpiLr ep{(float*)(ws + WS_LR)};
        gemm_unit<128>(lds, al, wint + (size_t)3072 * 1024, 1024, u * 128, ep);
    }
}

DEV void conv_emit(const float (&acc)[8], int c, bf16_t* dst) {
    const float qs = (c < 512) ? 0.08838834764831845f : 1.0f;
    unsigned ow[4];
#pragma unroll
    for (int j = 0; j < 4; ++j) { const float a0 = acc[2 * j], a1 = acc[2 * j + 1]; ow[j] = pk_bf16(a0 * sigmoidf_(a0) * qs, a1 * sigmoidf_(a1) * qs); }
    *(uint4*)dst = make_uint4(ow[0], ow[1], ow[2], ow[3]);
}
DEV void conv_tap(float (&acc)[8], const uint4& v, const float (&w)[8]) {
    acc[0] += bf_lo(v.x) * w[0]; acc[1] += bf_hi(v.x) * w[1]; acc[2] += bf_lo(v.y) * w[2]; acc[3] += bf_hi(v.y) * w[3];
    acc[4] += bf_lo(v.z) * w[4]; acc[5] += bf_hi(v.z) * w[5]; acc[6] += bf_lo(v.w) * w[6]; acc[7] += bf_hi(v.w) * w[7];
}
DEV void phase_gla_conv(const Params& p) {
    const int tid = tid_opaque();
    unsigned char* ws = p.ws;
    const bf16_t* z = (const bf16_t*)(ws + WS_S + 1 * U_BYTES);
    bf16_t* o = (bf16_t*)(ws + WS_S + 4 * U_BYTES);
    const float* cw = p.in[25];
    const int x = tid >> 3, cl = (tid & 7) * 8;
    for (int task = blockIdx.x; task < 8 * 8 * 32; task += gridDim.x) {
        const int cb = task & 31, ys = (task >> 5) & 7, b = task >> 8;
        const int c = cb * 64 + cl;
        float w[9][8];
#pragma unroll
        for (int t = 0; t < 9; ++t) { const float4 w0 = *(const float4*)(cw + t * 2048 + c), w1 = *(const float4*)(cw + t * 2048 + c + 4); w[t][0] = w0.x; w[t][1] = w0.y; w[t][2] = w0.z; w[t][3] = w0.w; w[t][4] = w1.x; w[t][5] = w1.y; w[t][6] = w1.z; w[t][7] = w1.w; }
        const uint4 zero4 = make_uint4(0, 0, 0, 0);
        auto load_row = [&](int y, uint4 (&r)[3]) {
            if (y < 0 || y >= 128) { r[0] = zero4; r[1] = zero4; r[2] = zero4; return; }
            const bf16_t* row = z + ((size_t)b * 8192 + (size_t)y * 64 + x) * 2048 + c;
            r[1] = *(const uint4*)row;
            r[0] = (x > 0) ? *(const uint4*)(row - 2048) : zero4;
            r[2] = (x < 63) ? *(const uint4*)(row + 2048) : zero4;
        };
        uint4 r0[3], r1[3], r2[3], r3[3];
        const int y0 = ys * 16;
        load_row(y0 - 1, r0); load_row(y0, r1); load_row(y0 + 1, r2);
#pragma unroll 1
        for (int yy = 0; yy < 16; ++yy) {
            load_row(yy < 15 ? y0 + yy + 2 : -1, r3);
            float acc[8];
#pragma unroll
            for (int j = 0; j < 8; ++j) acc[j] = 0.f;
#pragma unroll
            for (int dx = 0; dx < 3; ++dx) { conv_tap(acc, r0[dx], w[dx]); conv_tap(acc, r1[dx], w[3 + dx]); conv_tap(acc, r2[dx], w[6 + dx]); }
            conv_emit(acc, c, o + ((size_t)b * 8192 + (size_t)(y0 + yy) * 64 + x) * 2048 + c);
#pragma unroll
            for (int dx = 0; dx < 3; ++dx) { r0[dx] = r1[dx]; r1[dx] = r2[dx]; r2[dx] = r3[dx]; }
        }
    }
    for (int task = blockIdx.x; task < (NC / 64) * 8; task += gridDim.x) {
        const int rb = task >> 3, cbk = task & 7;
        const int R = NL + rb * 64 + (tid >> 3);
        const int t = (R - NL) & 255;
#pragma unroll 1
        for (int i = 0; i < 4; ++i) {
            const int c = cbk * 256 + (tid & 7) * 8 + i * 64;
            float acc[8];
#pragma unroll
            for (int j = 0; j < 8; ++j) acc[j] = 0.f;
#pragma unroll
            for (int dx = -1; dx <= 1; ++dx) {
                if (t + dx >= 0 && t + dx < 256) {
                    const uint4 v = *(const uint4*)(z + (size_t)(R + dx) * 2048 + c);
                    const float* wp = cw + (3 + (dx + 1)) * 2048 + c;
                    const float4 w0 = *(const float4*)wp, w1 = *(const float4*)(wp + 4);
                    const float wv[8] = {w0.x, w0.y, w0.z, w0.w, w1.x, w1.y, w1.z, w1.w};
                    conv_tap(acc, v, wv);
                }
            }
            conv_emit(acc, c, o + (size_t)R * 2048 + c);
        }
    }
}

DEV void phase_gla_scan(const Params& p, unsigned char* lds) {
    const int tid = tid_opaque(), lane = tid & 63, wv = tid >> 6;
    const int fr = lane & 15, fq = lane >> 4;
    unsigned char* ws = p.ws;
    constexpr int QE = 0, KE = 16384, QD = 32768, KDT = 49152, VT = 65536, AL = 73728, ST = 81920, BC = 98304, GS = 131072, LRL = 133632;
    const bf16_t* qkv = (const bf16_t*)(ws + WS_S + 4 * U_BYTES);
    const float* lrb = (const float*)(ws + WS_LR);
    float* bc = (float*)(lds + BC);
    float* gs = (float*)(lds + GS);
    float* lrl = (float*)(lds + LRL);
    for (int unit = blockIdx.x; unit < 256; unit += gridDim.x) {
        const int vs = unit & 3, d = (unit >> 2) & 1, hd = (unit >> 3) & 3, b = unit >> 5;
        bf16_t* odst = (bf16_t*)(ws + WS_S + (size_t)(d ? 1 : 0) * U_BYTES);
        const int lk = tid & 127, lig = tid >> 7;
        float gk[16];
#pragma unroll
        for (int q = 0; q < 16; ++q) gk[q] = p.in[26][(size_t)(d * 16 + q) * 512 + hd * 128 + lk];
        const float gbias = p.in[27][d * 512 + hd * 128 + lk];
        const int li = tid >> 3, lc = tid & 7;
        auto Rof = [&](int c, int i) -> int {
            if (c < 4) { const int q = c * 64 + i; return NL + b * 256 + (d ? 255 - q : q); }
            const int q = (c - 4) * 64 + i; return b * 8192 + (d ? 8191 - q : q);
        };
        uint4 rq[2], rk[2], rv; float2 rl;
        uint4 nq[2], nk[2], nv; float2 nl;
        auto load_chunk = [&](int c) {
            const size_t R = (size_t)Rof(c, li);
            const bf16_t* row = qkv + R * 2048;
            nq[0] = *(const uint4*)(row + hd * 128 + lc * 8); nq[1] = *(const uint4*)(row + hd * 128 + 64 + lc * 8);
            nk[0] = *(const uint4*)(row + 512 + hd * 128 + lc * 8); nk[1] = *(const uint4*)(row + 512 + hd * 128 + 64 + lc * 8);
            nv = *(const uint4*)(row + 1024 + hd * 256 + vs * 64 + lc * 8);
            nl = *(const float2*)(lrb + R * 32 + d * 16 + lc * 2);
        };
        f32x4 accS[4];
#pragma unroll
        for (int i = 0; i < 4; ++i) accS[i] = (f32x4){0.f, 0.f, 0.f, 0.f};
        for (int i = tid; i < 16384 / 16; i += NTHREADS) *(uint4*)(lds + ST + i * 16) = make_uint4(0, 0, 0, 0);
        load_chunk(0);
        for (int c = 0; c < 132; ++c) {
            rq[0] = nq[0]; rq[1] = nq[1]; rk[0] = nk[0]; rk[1] = nk[1]; rv = nv; rl = nl;
            if (c + 1 < 132) load_chunk(c + 1);
            *(float2*)(lrl + li * 16 + lc * 2) = rl;
            __syncthreads();
            {
                float run = 0.f;
#pragma unroll 4
                for (int ii = 0; ii < 16; ++ii) {
                    const int i = lig * 16 + ii;
                    float xx = gbias;
#pragma unroll
                    for (int q4 = 0; q4 < 4; ++q4) {
                        const float4 l4 = *(const float4*)(lrl + i * 16 + q4 * 4);
                        xx += l4.x * gk[q4 * 4] + l4.y * gk[q4 * 4 + 1] + l4.z * gk[q4 * 4 + 2] + l4.w * gk[q4 * 4 + 3];
                    }
                    const float la = (fminf(xx, 0.f) - __logf(1.0f + __expf(-fabsf(xx)))) * (1.0f / 16.0f);
                    run += la;
                    bc[i * 128 + lk] = run;
                }
                gs[lig * 128 + lk] = run;
            }
            __syncthreads();
            {
                if (tid < 128) gs[512 + tid] = __expf(gs[tid] + gs[128 + tid] + gs[256 + tid] + gs[384 + tid]);
                const int grp = li >> 4;
#pragma unroll
                for (int hseg = 0; hseg < 2; ++hseg) {
                    const int k0 = hseg * 64 + lc * 8;
                    float bcv[8], refv[8], lastv[8];
#pragma unroll
                    for (int j4 = 0; j4 < 2; ++j4) {
                        const float4 g0 = *(const float4*)(gs + k0 + j4 * 4), g1 = *(const float4*)(gs + 128 + k0 + j4 * 4);
                        const float4 g2 = *(const float4*)(gs + 256 + k0 + j4 * 4), g3 = *(const float4*)(gs + 384 + k0 + j4 * 4);
                        const float4 bi = *(const float4*)(bc + li * 128 + k0 + j4 * 4), b32 = *(const float4*)(bc + 32 * 128 + k0 + j4 * 4);
                        const float g0a[4] = {g0.x, g0.y, g0.z, g0.w}, g1a[4] = {g1.x, g1.y, g1.z, g1.w}, g2a[4] = {g2.x, g2.y, g2.z, g2.w}, g3a[4] = {g3.x, g3.y, g3.z, g3.w};
                        const float bia[4] = {bi.x, bi.y, bi.z, bi.w}, b32a[4] = {b32.x, b32.y, b32.z, b32.w};
#pragma unroll
                        for (int j = 0; j < 4; ++j) {
                            const float pre = (grp > 0 ? g0a[j] : 0.f) + (grp > 1 ? g1a[j] : 0.f) + (grp > 2 ? g2a[j] : 0.f);
                            bcv[j4 * 4 + j] = bia[j] + pre;
                            refv[j4 * 4 + j] = b32a[j] + g0a[j] + g1a[j];
                            lastv[j4 * 4 + j] = g0a[j] + g1a[j] + g2a[j] + g3a[j];
                        }
                    }
                    float eref[8], elast[8];
#pragma unroll
                    for (int j = 0; j < 8; ++j) { eref[j] = __expf(refv[j]); elast[j] = __expf(lastv[j] - refv[j]); }
                    const unsigned qw[4] = {rq[hseg].x, rq[hseg].y, rq[hseg].z, rq[hseg].w}, kw[4] = {rk[hseg].x, rk[hseg].y, rk[hseg].z, rk[hseg].w};
                    unsigned oqe[4], oke[4], oqd[4];
#pragma unroll
                    for (int j2 = 0; j2 < 4; ++j2) {
                        const float q0 = bf_lo(qw[j2]), q1 = bf_hi(qw[j2]), kk0 = bf_lo(kw[j2]), kk1 = bf_hi(kw[j2]);
                        const float b0 = bcv[2 * j2], b1 = bcv[2 * j2 + 1];
                        const float e0 = __expf(b0 - refv[2 * j2]), e1 = __expf(b1 - refv[2 * j2 + 1]);
                        const float r0 = __builtin_amdgcn_rcpf(e0), r1 = __builtin_amdgcn_rcpf(e1);
                        oqe[j2] = pk_bf16(q0 * e0, q1 * e1);
                        oke[j2] = pk_bf16(kk0 * r0, kk1 * r1);
                        oqd[j2] = pk_bf16(q0 * e0 * eref[2 * j2], q1 * e1 * eref[2 * j2 + 1]);
                        const unsigned kd2 = pk_bf16(kk0 * r0 * elast[2 * j2], kk1 * r1 * elast[2 * j2 + 1]);
                        const int kc0 = k0 + 2 * j2;
                        *(bf16_t*)(lds + KDT + tile_off2(kc0, li >> 3) + (li & 7) * 2) = (bf16_t)(kd2 & 0xffffu);
                        *(bf16_t*)(lds + KDT + tile_off2(kc0 + 1, li >> 3) + (li & 7) * 2) = (bf16_t)(kd2 >> 16);
                    }
                    const int chq = hseg * 8 + lc;
                    const int so = li * 256 + ((chq ^ (li & 15)) << 4);
                    *(uint4*)(lds + QE + so) = make_uint4(oqe[0], oqe[1], oqe[2], oqe[3]);
                    *(uint4*)(lds + KE + so) = make_uint4(oke[0], oke[1], oke[2], oke[3]);
                    *(uint4*)(lds + QD + so) = make_uint4(oqd[0], oqd[1], oqd[2], oqd[3]);
                }
                const unsigned vw[4] = {rv.x, rv.y, rv.z, rv.w};
#pragma unroll
                for (int j2 = 0; j2 < 4; ++j2) {
                    const int vc0 = lc * 8 + 2 * j2;
                    *(bf16_t*)(lds + VT + tile_off2(vc0, li >> 3) + (li & 7) * 2) = (bf16_t)(vw[j2] & 0xffffu);
                    *(bf16_t*)(lds + VT + tile_off2(vc0 + 1, li >> 3) + (li & 7) * 2) = (bf16_t)(vw[j2] >> 16);
                }
            }
            __syncthreads();
            const int it = wv & 3, pr2 = wv >> 2;
            f32x4 acco[2];
            {
#pragma unroll
                for (int jj = 0; jj < 2; ++jj) {
                    const int jt = pr2 * 2 + jj;
                    f32x4 a = {0.f, 0.f, 0.f, 0.f};
                    if (jt <= it) {
#pragma unroll
                        for (int ks = 0; ks < 4; ++ks) {
                            const int ch = ks * 4 + fq;
                            const int rj = jt * 16 + fr, ri = it * 16 + fr;
                            const bf16x8 fa = *(const bf16x8*)(lds + KE + rj * 256 + ((ch ^ (rj & 15)) << 4));
                            const bf16x8 fb = *(const bf16x8*)(lds + QE + ri * 256 + ((ch ^ (ri & 15)) << 4));
                            a = __builtin_amdgcn_mfma_f32_16x16x32_bf16(fa, fb, a, 0, 0, 0);
                        }
                    }
                    const int i = it * 16 + fr, j = jt * 16 + 4 * fq;
                    const float a0 = (j + 0 <= i) ? a[0] : 0.f, a1 = (j + 1 <= i) ? a[1] : 0.f, a2 = (j + 2 <= i) ? a[2] : 0.f, a3 = (j + 3 <= i) ? a[3] : 0.f;
                    *(uint2*)(lds + AL + i * 128 + (((j >> 3) ^ (i & 7)) << 4) + (j & 7) * 2) = make_uint2(pk_bf16(a0, a1), pk_bf16(a2, a3));
                }
#pragma unroll
                for (int vv = 0; vv < 2; ++vv) {
                    const int vt = pr2 * 2 + vv;
                    f32x4 a = {0.f, 0.f, 0.f, 0.f};
#pragma unroll
                    for (int ks = 0; ks < 4; ++ks) {
                        const int ch = ks * 4 + fq;
                        const int rvv = vt * 16 + fr, ri = it * 16 + fr;
                        const bf16x8 fa = *(const bf16x8*)(lds + ST + rvv * 256 + ((ch ^ (rvv & 15)) << 4));
                        const bf16x8 fb = *(const bf16x8*)(lds + QD + ri * 256 + ((ch ^ (ri & 15)) << 4));
                        a = __builtin_amdgcn_mfma_f32_16x16x32_bf16(fa, fb, a, 0, 0, 0);
                    }
                    acco[vv] = a;
                }
            }
            __syncthreads();
            {
#pragma unroll
                for (int vv = 0; vv < 2; ++vv) {
                    const int vt = pr2 * 2 + vv;
                    f32x4 a = acco[vv];
#pragma unroll
                    for (int ks = 0; ks < 2; ++ks) {
                        const int ch = ks * 4 + fq;
                        const int rvv = vt * 16 + fr, ri = it * 16 + fr;
                        const bf16x8 fa = *(const bf16x8*)(lds + VT + tile_off2(rvv, ch));
                        const bf16x8 fb = *(const bf16x8*)(lds + AL + ri * 128 + ((ch ^ (ri & 7)) << 4));
                        a = __builtin_amdgcn_mfma_f32_16x16x32_bf16(fa, fb, a, 0, 0, 0);
                    }
                    const int i = it * 16 + fr, vcol = vt * 16 + 4 * fq;
                    *(uint2*)(odst + (size_t)Rof(c, i) * 1024 + hd * 256 + vs * 64 + vcol) = make_uint2(pk_bf16(a[0], a[1]), pk_bf16(a[2], a[3]));
                }
                const int kt = wv;
                const float4 dl4 = *(const float4*)(gs + 512 + kt * 16 + 4 * fq);
                bf16x8 fa[2];
#pragma unroll
                for (int ks = 0; ks < 2; ++ks) { const int ch = ks * 4 + fq; const int rk2 = kt * 16 + fr; fa[ks] = *(const bf16x8*)(lds + KDT + tile_off2(rk2, ch)); }
#pragma unroll
                for (int vt = 0; vt < 4; ++vt) {
                    f32x4 a = accS[vt];
                    a[0] *= dl4.x; a[1] *= dl4.y; a[2] *= dl4.z; a[3] *= dl4.w;
#pragma unroll
                    for (int ks = 0; ks < 2; ++ks) {
                        const int ch = ks * 4 + fq; const int rvv = vt * 16 + fr;
                        const bf16x8 fb = *(const bf16x8*)(lds + VT + tile_off2(rvv, ch));
                        a = __builtin_amdgcn_mfma_f32_16x16x32_bf16(fa[ks], fb, a, 0, 0, 0);
                    }
                    accS[vt] = a;
                    const int vcol = vt * 16 + fr, kcol = kt * 16 + 4 * fq;
                    *(uint2*)(lds + ST + vcol * 256 + (((kcol >> 3) ^ (vcol & 15)) << 4) + (kcol & 7) * 2) = make_uint2(pk_bf16(a[0], a[1]), pk_bf16(a[2], a[3]));
                }
            }
        }
        __syncthreads();
    }
}

DEV void phase_gla_readout(const Params& p) {
    const int tid = tid_opaque(), lane = tid & 63;
    const int gw = blockIdx.x * 8 + (tid >> 6), nw = gridDim.x * 8;
    unsigned char* ws = p.ws;
    const bf16_t* o0 = (const bf16_t*)(ws + WS_S + 0 * U_BYTES);
    const bf16_t* o1 = (const bf16_t*)(ws + WS_S + 1 * U_BYTES);
    const bf16_t* gb = (const bf16_t*)(ws + WS_S + 3 * U_BYTES);
    bf16_t* ao = (bf16_t*)(ws + WS_S + 2 * U_BYTES);
    const float4 hn = *(const float4*)(p.in[28] + lane * 4);
    for (int item = gw; item < NL * 4; item += nw) {
        const size_t off = (size_t)(item >> 2) * 1024 + (item & 3) * 256 + lane * 4;
        const uint2 a = *(const uint2*)(o0 + off), b2 = *(const uint2*)(o1 + off), g2 = *(const uint2*)(gb + off);
        const float v0 = bf_lo(a.x) + bf_lo(b2.x), v1 = bf_hi(a.x) + bf_hi(b2.x), v2 = bf_lo(a.y) + bf_lo(b2.y), v3 = bf_hi(a.y) + bf_hi(b2.y);
        float ss = v0 * v0 + v1 * v1 + v2 * v2 + v3 * v3;
        ss = wave_allreduce(ss);
        const float rs = rsqrtf(ss * (1.0f / 256.0f) + 1e-6f);
        const float g0 = bf_lo(g2.x), g1 = bf_hi(g2.x), g2f = bf_lo(g2.y), g3 = bf_hi(g2.y);
        const float r0 = v0 * rs * hn.x * (g0 * sigmoidf_(g0)), r1 = v1 * rs * hn.y * (g1 * sigmoidf_(g1));
        const float r2 = v2 * rs * hn.z * (g2f * sigmoidf_(g2f)), r3 = v3 * rs * hn.w * (g3 * sigmoidf_(g3));
        *(uint2*)(ao + off) = make_uint2(pk_bf16(r0, r1), pk_bf16(r2, r3));
    }
}


#define LAS3 __attribute__((address_space(3)))
#define XB_TMO      128
#define XB_XCNT(j)  (256  + 64 * (j))
#define XB_XSUB(j)  (1280 + 64 * (j))
#define XB_XGEN(j)  (2304 + 64 * (j))
#define XB_TOP      3328
#define XB_TOPGEN   3392
#define XB_SPIN_CAP (1u << 22)
DEV unsigned xb_ld(unsigned* p) { return __hip_atomic_load(p, __ATOMIC_RELAXED, __HIP_MEMORY_SCOPE_AGENT); }
DEV unsigned xb_add(unsigned* p, unsigned v) { return __hip_atomic_fetch_add(p, v, __ATOMIC_RELAXED, __HIP_MEMORY_SCOPE_AGENT); }
DEV unsigned xb_xcc_id() { return (unsigned)__builtin_amdgcn_s_getreg((3 << 11) | 20) & 0xFu; }
#define XB_SPIN(cond, bar) do { unsigned _sp = 0; while (cond) { __builtin_amdgcn_s_sleep(1); \
    if ((++_sp & 255u) == 0u) { if (xb_ld(&(bar)[XB_TMO])) break; if (_sp > XB_SPIN_CAP) { atomicAdd(&(bar)[XB_TMO], 1u); break; } } } } while (0)
DEV void xcd_barrier_complete(unsigned* bar, unsigned x, unsigned& nloc, unsigned& nx) {
    const unsigned G = gridDim.x;
    unsigned sum, cnt, mine, sp = 0u;
    for (;;) {
        sum = 0u; cnt = 0u; mine = 0u;
#pragma unroll
        for (unsigned j = 0; j < 16; ++j) { const unsigned c = xb_ld(&bar[XB_XCNT(j)]); sum += c; cnt += (c > 0u) ? 1u : 0u; mine = (j == x) ? c : mine; }
        if (sum == G) break;
        __builtin_amdgcn_s_sleep(1);
        if ((++sp & 255u) == 0u) { if (xb_ld(&bar[XB_TMO])) break; if (sp > XB_SPIN_CAP) { atomicAdd(&bar[XB_TMO], 1u); break; } }
    }
    nloc = mine > 0u ? mine : 1u; nx = cnt > 0u ? cnt : 1u;
}
DEV void xcd_barrier(unsigned* bar, volatile LAS3 unsigned* st) {
    asm volatile("s_waitcnt vmcnt(0)" ::: "memory");
    __syncthreads();
    if (threadIdx.x == 0) {
        const unsigned x = xb_xcc_id();
        __builtin_amdgcn_s_waitcnt(0);
        unsigned nloc = st[0], nx = st[1];
        if (nloc == 0u) { xcd_barrier_complete(bar, x, nloc, nx); st[0] = nloc; st[1] = nx; }
        const unsigned old = xb_add(&bar[XB_XSUB(x)], 1u);
        const unsigned gen = old / nloc;
        if (old + 1u == (gen + 1u) * nloc) {
            __builtin_amdgcn_fence(__ATOMIC_RELEASE, "agent");
            asm volatile("s_waitcnt vmcnt(0)" ::: "memory");
            const unsigned og = xb_add(&bar[XB_TOP], 1u);
            const unsigned tg = og / nx;
            if (og + 1u == (tg + 1u) * nx) xb_add(&bar[XB_TOPGEN], 1u);
            else XB_SPIN(xb_ld(&bar[XB_TOPGEN]) == tg, bar);
            __builtin_amdgcn_fence(__ATOMIC_ACQUIRE, "agent");
            xb_add(&bar[XB_XGEN(x)], 1u);
            asm volatile("s_waitcnt vmcnt(0)" ::: "memory");
        } else {
            XB_SPIN(xb_ld(&bar[XB_XGEN(x)]) == gen, bar);
            __builtin_amdgcn_fence(__ATOMIC_ACQUIRE, "agent");
            asm volatile("s_waitcnt vmcnt(0)" ::: "memory");
        }
    }
    __syncthreads();
}
#define SYNC() do { asm volatile("s_waitcnt vmcnt(0)" ::: "memory"); grid.sync(); \
    if (threadIdx.x == 0) { __builtin_amdgcn_fence(__ATOMIC_ACQUIRE, "agent"); asm volatile("s_waitcnt vmcnt(0)" ::: "memory"); } \
    __syncthreads(); } while (0)
__global__ void __launch_bounds__(NTHREADS) mega_fwd(Params p) {
    extern __shared__ __attribute__((aligned(16))) unsigned char lds[];
    cg::grid_group grid = cg::this_grid();
#define XBAR ((unsigned*)(p.ws + WS_BAR))
#define XST ((volatile LAS3 unsigned*)(lds + LDS_BYTES - 16))
    if (threadIdx.x == 0) { XST[0] = 0u; XST[1] = 0u; (void)xb_add(&XBAR[XB_XCNT(xb_xcc_id())], 1u); }
#define S0 ((bf16_t*)(p.ws + WS_S + 0 * U_BYTES))
#define SLOT(i) ((bf16_t*)(p.ws + WS_S + (size_t)(i) * U_BYTES))
#define S1 ((bf16_t*)(p.ws + WS_S + 1 * U_BYTES))
#define CTXR ((const float*)(p.ws + WS_CTXR))
    phase0(p, lds); SYNC();
#undef SYNC
#define SYNC() xcd_barrier(XBAR, XST)
    phase_normmix(p, S0, SLOT(5), SLOT(1), SLOT(2)); SYNC();
    phase_rw_proj1(p, lds, 0, SLOT(5), SLOT(3)); SYNC();
    phase_rw_proj1(p, lds, 1, SLOT(1), SLOT(5)); SYNC();
    phase_rw_proj1(p, lds, 2, SLOT(2), SLOT(1)); phase_rw_lora(p, lds); SYNC();
    REPEAT(3, phase_rw_scan(p, lds));
    phase_rw_scan(p, lds); SYNC();
    REPEAT(4, phase_rw_readout(p));
    phase_rw_readout(p); SYNC();
    REPEAT(5, phase_wo(p, lds, 0));
    phase_wo(p, lds, 0); SYNC();
    REPEAT(6, phase_normmod(p, 0, 1, p.out, CTXR, NT, S1));
    phase_normmod(p, 0, 1, p.out, CTXR, NT, S1); SYNC();
    REPEAT(7, phase_peer_select(p, lds, 0));
    phase_peer_select(p, lds, 0); SYNC();
    phase_peer_gather(p, 0, 0); SYNC();
    REPEAT(9, phase_gla_proj(p, lds));
    phase_gla_proj(p, lds); SYNC();
    REPEAT(10, phase_gla_conv(p));
    phase_gla_conv(p); SYNC();
    REPEAT(11, phase_gla_scan(p, lds));
    phase_gla_scan(p, lds); SYNC();
    REPEAT(12, phase_gla_readout(p));
    phase_gla_readout(p); SYNC();
    phase_wo(p, lds, 1); SYNC();
    REPEAT(14, phase_normmod(p, 1, 1, p.out, CTXR, NL, S0));
    phase_normmod(p, 1, 1, p.out, CTXR, NL, S0); SYNC();
    REPEAT(15, phase_peer_select(p, lds, 1));
    phase_peer_select(p, lds, 1); SYNC();
    phase_peer_gather(p, 1, 1);
}

extern "C" void kernel_launch(void* const* d_in, const int* in_sizes, int n_in, void* d_out, int out_size, void* d_ws, size_t ws_size, hipStream_t stream) {
    static int grid_blocks = 0;
    if (grid_blocks == 0) {
        if (n_in != 35 || ws_size < WS_END) { fprintf(stderr, "kernel_launch: unexpected n_in %d or ws_size %zu (< %zu)\n", n_in, ws_size, (size_t)WS_END); grid_blocks = -1; return; }
        int dev = 0, cus = 0, per_cu = 0;
        if (hipGetDevice(&dev) != hipSuccess || hipDeviceGetAttribute(&cus, hipDeviceAttributeMultiprocessorCount, dev) != hipSuccess) { fprintf(stderr, "kernel_launch: device query failed\n"); grid_blocks = -1; return; }
        if (hipFuncSetAttribute((const void*)mega_fwd, hipFuncAttributeMaxDynamicSharedMemorySize, LDS_BYTES) != hipSuccess) { fprintf(stderr, "kernel_launch: hipFuncSetAttribute failed\n"); grid_blocks = -1; return; }
        if (hipOccupancyMaxActiveBlocksPerMultiprocessor(&per_cu, (const void*)mega_fwd, NTHREADS, LDS_BYTES) != hipSuccess || per_cu < 1) { fprintf(stderr, "kernel_launch: occupancy query says %d blocks per CU\n", per_cu); grid_blocks = -1; return; }
        grid_blocks = cus;
    }
    if (grid_blocks < 0) return;
    Params p{};
    for (int i = 0; i < 35; ++i) p.in[i] = (const float*)d_in[i];
    p.out = (float*)d_out;
    p.ws = (unsigned char*)d_ws;
    if (hipMemsetAsync((char*)d_ws + WS_BAR, 0, 16384, stream) != hipSuccess) { fprintf(stderr, "kernel_launch: hipMemsetAsync failed\n"); return; }
    void* args[] = {&p};
    hipError_t e = hipLaunchCooperativeKernel((const void*)mega_fwd, dim3(grid_blocks), dim3(NTHREADS), args, LDS_BYTES, stream);
    if (e != hipSuccess) fprintf(stderr, "kernel_launch: cooperative launch failed: %s (grid %d)\n", hipGetErrorString(e), grid_blocks);
}
```

```cpp
#include <hip/hip_runtime.h>
#include <hip/hip_cooperative_groups.h>
#include <cstdio>
#include <cstdint>
namespace cg = cooperative_groups;

#define DEV __device__ __forceinline__
#ifndef REP
#define REP 0
#endif
#define GREPS(n) ((REP == (n)) ? 2 : 1)
#define REPEAT(n, stmt) do { if (REP == (n)) { stmt; SYNC(); } } while (0)

typedef unsigned short bf16_t;
typedef short bf16x8 __attribute__((ext_vector_type(8)));
typedef float f32x4 __attribute__((ext_vector_type(4)));
typedef __bf16 bf16x2v __attribute__((ext_vector_type(2)));

constexpr int D = 1024;
constexpr int NB = 8, SEQ = 8192, CTXL = 256;
constexpr int NL = NB * SEQ, NC = NB * CTXL, NT = NL + NC;
constexpr int NTHREADS = 512;
constexpr int LDS_BYTES = 160 * 1024;

constexpr size_t U_BYTES = (size_t)NT * 1024 * 2;
constexpr size_t WS_BAR = 0;
constexpr size_t WS_MOD = 16384;
constexpr size_t WS_CTXR = WS_MOD + (size_t)2 * 9 * 6144 * 4;
constexpr size_t WS_LR = WS_CTXR + (size_t)NC * 1024 * 4;
constexpr size_t WS_BONUS = WS_LR + (size_t)NT * 32 * 4;
constexpr size_t WS_WPROJ = WS_BONUS + (size_t)2 * NT * 16 * 4;
constexpr size_t WS_W2T = WS_WPROJ + (size_t)3456 * 1024 * 2;
constexpr size_t WS_A2T = WS_W2T + (size_t)2 * 1024 * 64 * 2;
constexpr size_t WS_G2T = WS_A2T + (size_t)2 * 1024 * 64 * 2;
constexpr size_t WS_WO0 = WS_G2T + (size_t)1024 * 128 * 2;
constexpr size_t WS_WO1 = WS_WO0 + (size_t)1024 * 1024 * 2;
constexpr size_t WS_WQ = WS_WO1 + (size_t)1024 * 1024 * 2;
constexpr size_t WS_KEYS = WS_WQ + (size_t)2 * 2048 * 1024 * 2;
constexpr size_t WS_WIN = WS_KEYS + (size_t)2 * 8 * 2 * 128 * 128 * 2;
constexpr size_t WS_PU = WS_WIN + (size_t)3200 * 1024 * 2;
constexpr size_t WS_PV = WS_PU + (size_t)2 * 16384 * 1024;
constexpr size_t WS_PSC = WS_PV + (size_t)2 * 16384 * 1024;
constexpr size_t WS_S = WS_PSC + (size_t)2 * 2 * 16384 * 4;
constexpr size_t WS_END = WS_S + 6 * U_BYTES;
static_assert(WS_END <= 1073741824ull, "workspace too large");
static_assert((WS_CTXR % 256) == 0 && (WS_WPROJ % 256) == 0 && (WS_S % 256) == 0, "alignment");

struct Params {
    const float* in[35];
    float* out;
    unsigned char* ws;
    int pad0, pad1;
};

DEV float bf_lo(unsigned u) { return __uint_as_float(u << 16); }
DEV float bf_hi(unsigned u) { return __uint_as_float(u & 0xffff0000u); }
typedef float f32x2v __attribute__((ext_vector_type(2)));
DEV unsigned pk_bf16(float lo, float hi) { const f32x2v f = {lo, hi}; union { bf16x2v v; unsigned u; } x; x.v = __builtin_convertvector(f, bf16x2v); return x.u; }
template <int N> DEV float dpp_ror(float x) { return __int_as_float(__builtin_amdgcn_update_dpp(0, __float_as_int(x), 0x120 + N, 0xF, 0xF, false)); }
DEV float row16_allreduce(float x) { x += dpp_ror<8>(x); x += dpp_ror<4>(x); x += dpp_ror<2>(x); x += dpp_ror<1>(x); return x; }
DEV float wave_allreduce(float x) { x = row16_allreduce(x); x += __shfl_xor(x, 16); x += __shfl_xor(x, 32); return x; }
DEV float sigmoidf_(float x) { return 1.0f / (1.0f + __expf(-x)); }
DEV float softplusf_(float z) { return fmaxf(z, 0.f) + __logf(1.0f + __expf(-fabsf(z))); }
DEV unsigned mono_u32(float f) { unsigned u = __float_as_uint(f); return u ^ ((u >> 31) ? 0xFFFFFFFFu : 0x80000000u); }
DEV float unmono_u32(unsigned k) { unsigned u = (k & 0x80000000u) ? (k ^ 0x80000000u) : ~k; return __uint_as_float(u); }
DEV bf16x8 as_bf16x8(uint4 v) { union { uint4 u; bf16x8 b; } x; x.u = v; return x.b; }
#define LAS3 __attribute__((address_space(3)))
extern __shared__ __attribute__((aligned(16))) unsigned char g_lds[];
constexpr int LDS_WTAB = LDS_BYTES - 128;
DEV unsigned hw_wave_slot() { return (unsigned)__builtin_amdgcn_s_getreg((5 << 11) | 4) & 63u; }
DEV int tid_opaque() {
    const int wv = (int)*(const volatile unsigned char*)(g_lds + LDS_WTAB + hw_wave_slot());
    int t = (wv << 6) | (int)__builtin_amdgcn_mbcnt_hi(~0u, __builtin_amdgcn_mbcnt_lo(~0u, 0u));
    asm volatile("" : "+v"(t));
    return t;
}
DEV int mod_batch(int R) { return R < NL ? (R >> 13) : 8; }

template <int BN, class AL, class EP>
DEV void gemm_unit(unsigned char* lds, const AL& al, const bf16_t* Bt, int K, int m0, const EP& ep) {
    constexpr int NI = BN / 64;
    constexpr int A_BYTES = 128 * 128;
    constexpr int B_BYTES = BN * 128;
    const int tid = tid_opaque(), lane = tid & 63, wv = tid >> 6, wm = wv >> 2, wn = wv & 3;
    const int fr = lane & 15, fq = lane >> 4;
    unsigned char* sA = lds;
    unsigned char* sB = lds + 2 * A_BYTES;
    f32x4 acc[4][NI];
#pragma unroll
    for (int mi = 0; mi < 4; ++mi)
#pragma unroll
        for (int ni = 0; ni < NI; ++ni) acc[mi][ni] = (f32x4){0.f, 0.f, 0.f, 0.f};
    const int KT = K >> 6;
    const int drow = tid >> 3, dch = (tid & 7) ^ (drow & 7);
    const bf16_t* bsrc = Bt + (size_t)drow * K + dch * 8;
    uint4 ra[2];
    auto stage = [&](int kt, int buf) {
        const int k0 = kt * 64;
#pragma unroll
        for (int i = 0; i < BN / 64; ++i)
            __builtin_amdgcn_global_load_lds((const unsigned*)(bsrc + (size_t)(64 * i) * K + k0), (unsigned*)(sB + buf * B_BYTES + i * 8192 + tid * 16), 16, 0, 0);
        if constexpr (AL::DMA) {
#pragma unroll
            for (int i = 0; i < 2; ++i)
                __builtin_amdgcn_global_load_lds((const unsigned*)(al.A + (size_t)(m0 + drow + 64 * i) * al.lda + k0 + dch * 8), (unsigned*)(sA + buf * A_BYTES + i * 8192 + tid * 16), 16, 0, 0);
        } else {
#pragma unroll
            for (int i = 0; i < 2; ++i) { const int q = tid + 512 * i; ra[i] = al.load(m0 + (q >> 3), k0 + (q & 7) * 8); }
        }
    };
    auto commit = [&](int buf) {
        if constexpr (!AL::DMA) {
#pragma unroll
            for (int i = 0; i < 2; ++i) { const int q = tid + 512 * i, row = q >> 3, ch = q & 7; *(uint4*)(sA + buf * A_BYTES + row * 128 + ((ch ^ (row & 7)) << 4)) = ra[i]; }
        }
    };
    auto compute = [&](int buf) {
        const unsigned char* a_base = sA + buf * A_BYTES;
        const unsigned char* b_base = sB + buf * B_BYTES;
#pragma unroll
        for (int ks = 0; ks < 2; ++ks) {
            bf16x8 af[4], bfr[NI];
            const int ch = ks * 4 + fq;
#pragma unroll
            for (int mi = 0; mi < 4; ++mi) { const int row = wm * 64 + mi * 16 + fr; af[mi] = *(const bf16x8*)(a_base + row * 128 + ((ch ^ (row & 7)) << 4)); }
#pragma unroll
            for (int ni = 0; ni < NI; ++ni) { const int row = wn * (BN / 4) + ni * 16 + fr; bfr[ni] = *(const bf16x8*)(b_base + row * 128 + ((ch ^ (row & 7)) << 4)); }
#pragma unroll
            for (int mi = 0; mi < 4; ++mi)
#pragma unroll
                for (int ni = 0; ni < NI; ++ni) acc[mi][ni] = __builtin_amdgcn_mfma_f32_16x16x32_bf16(bfr[ni], af[mi], acc[mi][ni], 0, 0, 0);
        }
    };
    if constexpr (AL::DMA) {
        constexpr int STG = A_BYTES + B_BYTES;
        auto stage3 = [&](int kt, int b3) {
            const int k0 = kt * 64;
            unsigned char* base = lds + b3 * STG;
#pragma unroll
            for (int i = 0; i < BN / 64; ++i)
                __builtin_amdgcn_global_load_lds((const unsigned*)(bsrc + (size_t)(64 * i) * K + k0), (unsigned*)(base + A_BYTES + i * 8192 + tid * 16), 16, 0, 0);
#pragma unroll
            for (int i = 0; i < 2; ++i)
                __builtin_amdgcn_global_load_lds((const unsigned*)(al.A + (size_t)(m0 + drow + 64 * i) * al.lda + k0 + dch * 8), (unsigned*)(base + i * 8192 + tid * 16), 16, 0, 0);
        };
        auto compute3 = [&](int b3) {
            const unsigned char* a_base = lds + b3 * STG;
            const unsigned char* b_base = a_base + A_BYTES;
#pragma unroll
            for (int ks = 0; ks < 2; ++ks) {
                bf16x8 af[4], bfr[NI];
                const int ch = ks * 4 + fq;
#pragma unroll
                for (int mi = 0; mi < 4; ++mi) { const int row = wm * 64 + mi * 16 + fr; af[mi] = *(const bf16x8*)(a_base + row * 128 + ((ch ^ (row & 7)) << 4)); }
#pragma unroll
                for (int ni = 0; ni < NI; ++ni) { const int row = wn * (BN / 4) + ni * 16 + fr; bfr[ni] = *(const bf16x8*)(b_base + row * 128 + ((ch ^ (row & 7)) << 4)); }
#pragma unroll
                for (int mi = 0; mi < 4; ++mi)
#pragma unroll
                    for (int ni = 0; ni < NI; ++ni) acc[mi][ni] = __builtin_amdgcn_mfma_f32_16x16x32_bf16(bfr[ni], af[mi], acc[mi][ni], 0, 0, 0);
            }
        };
        stage3(0, 0);
        stage3(1, 1);
        int b3 = 0;
        for (int kt = 0; kt < KT; ++kt) {
            if (kt + 1 < KT) { if constexpr (BN == 256) asm volatile("s_waitcnt vmcnt(6)" ::: "memory"); else asm volatile("s_waitcnt vmcnt(4)" ::: "memory"); }
            else asm volatile("s_waitcnt vmcnt(0)" ::: "memory");
            asm volatile("s_waitcnt lgkmcnt(0)" ::: "memory");
            __builtin_amdgcn_s_barrier();
            asm volatile("" ::: "memory");
            const int bn = (b3 == 0) ? 2 : b3 - 1;
            if (kt + 2 < KT) stage3(kt + 2, bn);
            compute3(b3);
            b3 = (b3 == 2) ? 0 : b3 + 1;
        }
        asm volatile("s_waitcnt lgkmcnt(0)" ::: "memory");
        __builtin_amdgcn_s_barrier();
        asm volatile("" ::: "memory");
    } else {
        stage(0, 0);
        commit(0);
        asm volatile("s_waitcnt vmcnt(0)" ::: "memory");
        __syncthreads();
        for (int kt = 0; kt < KT; ++kt) {
            const int cur = kt & 1;
            const bool more = (kt + 1 < KT);
            if (more) stage(kt + 1, cur ^ 1);
            compute(cur);
            if (more) commit(cur ^ 1);
            asm volatile("s_waitcnt vmcnt(0)" ::: "memory");
            __syncthreads();
        }
    }
    ep(acc, m0, wm, wn, fr, fq);
}

struct ALoadPlain {
    static constexpr bool DMA = true;
    const bf16_t* A; int lda;
    DEV uint4 load(int R, int k) const { return *(const uint4*)(A + (size_t)R * lda + k); }
};
struct ALoadMix {
    static constexpr bool DMA = false;
    const bf16_t* h; const float* mix; const bf16_t* A; int lda;
    DEV uint4 load(int R, int k) const {
        const bf16_t* pc = h + (size_t)R * 1024 + k;
        const uint4 c = *(const uint4*)pc;
        const int t = (R < NL) ? (R & 8191) : ((R - NL) & 255);
        const int last = (R < NL) ? 8191 : 255;
        uint4 pv = *(const uint4*)(pc - (t != 0 ? 1024 : 0)), nv = *(const uint4*)(pc + (t != last ? 1024 : 0));
        if (t == 0) pv = make_uint4(0, 0, 0, 0);
        if (t == last) nv = make_uint4(0, 0, 0, 0);
        const float4 m0 = *(const float4*)(mix + k), m1 = *(const float4*)(mix + k + 4);
        const unsigned cc[4] = {c.x, c.y, c.z, c.w}, pp[4] = {pv.x, pv.y, pv.z, pv.w}, nn[4] = {nv.x, nv.y, nv.z, nv.w};
        const float mm[8] = {m0.x, m0.y, m0.z, m0.w, m1.x, m1.y, m1.z, m1.w};
        unsigned o[4];
#pragma unroll
        for (int i = 0; i < 4; ++i) {
            const float hc0 = bf_lo(cc[i]), hc1 = bf_hi(cc[i]);
            const float s0 = 0.5f * (bf_lo(pp[i]) + bf_lo(nn[i])), s1 = 0.5f * (bf_hi(pp[i]) + bf_hi(nn[i]));
            o[i] = pk_bf16(hc0 + (s0 - hc0) * mm[2 * i], hc1 + (s1 - hc1) * mm[2 * i + 1]);
        }
        return make_uint4(o[0], o[1], o[2], o[3]);
    }
};

struct TrJob { int in_idx, src_off, K, N, src_ld, dst_ld; unsigned long long dst_off; int tile0; };
constexpr int NTRJOBS = 19;
__device__ const TrJob g_trjobs[NTRJOBS] = {
    {9, 0 * 1048576, 1024, 1024, 1024, 1024, WS_WPROJ + 0ull * 1024 * 1024 * 2, 0},
    {9, 1 * 1048576, 1024, 1024, 1024, 1024, WS_WPROJ + 1ull * 1024 * 1024 * 2, 256},
    {9, 2 * 1048576, 1024, 1024, 1024, 1024, WS_WPROJ + 2ull * 1024 * 1024 * 2, 512},
    {11, 0, 1024, 64, 64, 1024, WS_WPROJ + 3072ull * 1024 * 2, 768},
    {11, 65536, 1024, 64, 64, 1024, WS_WPROJ + 3136ull * 1024 * 2, 784},
    {14, 0, 1024, 64, 64, 1024, WS_WPROJ + 3200ull * 1024 * 2, 800},
    {14, 65536, 1024, 64, 64, 1024, WS_WPROJ + 3264ull * 1024 * 2, 816},
    {16, 0, 1024, 128, 128, 1024, WS_WPROJ + 3328ull * 1024 * 2, 832},
    {12, 0, 64, 1024, 1024, 64, WS_W2T, 864},
    {12, 65536, 64, 1024, 1024, 64, WS_W2T + 1024ull * 64 * 2, 880},
    {15, 0, 64, 1024, 1024, 64, WS_A2T, 896},
    {15, 65536, 64, 1024, 1024, 64, WS_A2T + 1024ull * 64 * 2, 912},
    {17, 0, 128, 1024, 1024, 128, WS_G2T, 928},
    {23, 0, 1024, 1024, 1024, 1024, WS_WO0, 960},
    {29, 0, 1024, 1024, 1024, 1024, WS_WO1, 1216},
    {30, 0, 1024, 2048, 2048, 1024, WS_WQ, 1472},
    {30, 2097152, 1024, 2048, 2048, 1024, WS_WQ + 2048ull * 1024 * 2, 1984},
    {24, 0, 1024, 3104, 3104, 1024, WS_WIN, 2496},
    {0, 0, 0, 0, 0, 0, 0, 2496 + 16 * 49},
};
constexpr int NTRTILES = 2496 + 16 * 49;

DEV void phase0(const Params& p, unsigned char* lds) {
    const int tid = tid_opaque();
    unsigned char* ws = p.ws;
    {
        float* sc = (float*)lds;
        float* red = sc + 9 * 1024;
        float* mods = (float*)(ws + WS_MOD);
        bool have_sc = false;
        for (int task = blockIdx.x; task < 192; task += gridDim.x) {
            if (!have_sc) {
                for (int i = tid; i < 9 * 1024; i += NTHREADS) {
                    const int mb = i >> 10, k = i & 1023;
                    const float cv = mb < 8 ? p.in[1][mb * 1024 + k] : p.in[3][k];
                    sc[i] = cv / (1.0f + __expf(-cv));
                }
                have_sc = true;
            }
            __syncthreads();
            const int l = task / 96, nb = task % 96;
            const int nn = tid & 63, kg = tid >> 6;
            const float* w = p.in[4] + (size_t)l * 1024 * 6144 + nb * 64 + nn;
            float acc[9];
#pragma unroll
            for (int m = 0; m < 9; ++m) acc[m] = 0.f;
            for (int k = kg * 128; k < kg * 128 + 128; ++k) {
                const float wv = w[(size_t)k * 6144];
#pragma unroll
                for (int m = 0; m < 9; ++m) acc[m] += sc[m * 1024 + k] * wv;
            }
#pragma unroll
            for (int m = 0; m < 9; ++m) red[(kg * 9 + m) * 64 + nn] = acc[m];
            __syncthreads();
            for (int i = tid; i < 576; i += NTHREADS) {
                const int m = i >> 6, n2 = i & 63;
                float s = p.in[5][l * 6144 + nb * 64 + n2];
#pragma unroll
                for (int g = 0; g < 8; ++g) s += red[(g * 9 + m) * 64 + n2];
                mods[(size_t)(l * 9 + m) * 6144 + nb * 64 + n2] = s;
            }
            __syncthreads();
        }
        __syncthreads();
    }
    {
        float* tile = (float*)lds;
        for (int tt = blockIdx.x; tt < NTRTILES; tt += gridDim.x) {
            int j = 0;
#pragma unroll 1
            while (j + 1 < NTRJOBS && g_trjobs[j + 1].tile0 <= tt) ++j;
            const TrJob jb = g_trjobs[j];
            const int tl = tt - jb.tile0;
            const int ntn = (jb.N + 63) >> 6;
            const int k0 = (tl / ntn) * 64, n0 = (tl % ntn) * 64;
            const float* src = p.in[jb.in_idx] + jb.src_off;
            bf16_t* dst = (bf16_t*)(ws + jb.dst_off);
            {
                const int kr = tid >> 4, nc4 = (tid & 15) * 4;
#pragma unroll
                for (int i = 0; i < 2; ++i) {
                    const int kk = kr + 32 * i;
                    float4 v = make_float4(0.f, 0.f, 0.f, 0.f);
                    if (n0 + nc4 < jb.N) v = *(const float4*)(src + (size_t)(k0 + kk) * jb.src_ld + n0 + nc4);
                    tile[kk * 65 + nc4 + 0] = v.x; tile[kk * 65 + nc4 + 1] = v.y; tile[kk * 65 + nc4 + 2] = v.z; tile[kk * 65 + nc4 + 3] = v.w;
                }
            }
            __syncthreads();
            {
                const int nn = tid >> 3, kc = (tid & 7) * 8;
                if (n0 + nn < jb.N) {
                    unsigned o[4];
#pragma unroll
                    for (int i = 0; i < 4; ++i) o[i] = pk_bf16(tile[(kc + 2 * i) * 65 + nn], tile[(kc + 2 * i + 1) * 65 + nn]);
                    *(uint4*)(dst + (size_t)(n0 + nn) * jb.dst_ld + k0 + kc) = make_uint4(o[0], o[1], o[2], o[3]);
                }
            }
            __syncthreads();
        }
    }
    {
        const size_t gtid = (size_t)blockIdx.x * NTHREADS + tid, gstride = (size_t)gridDim.x * NTHREADS;
        {
            const float* src = p.in[31];
            bf16_t* dst = (bf16_t*)(ws + WS_KEYS);
            const size_t n8 = (size_t)2 * 8 * 2 * 128 * 128 / 8;
            for (size_t i = gtid; i < n8; i += gstride) {
                const float4 a = *(const float4*)(src + i * 8), b = *(const float4*)(src + i * 8 + 4);
                *(uint4*)(dst + i * 8) = make_uint4(pk_bf16(a.x, a.y), pk_bf16(a.z, a.w), pk_bf16(b.x, b.y), pk_bf16(b.z, b.w));
            }
        }
        bf16_t* wpad = (bf16_t*)(ws + WS_WIN) + (size_t)3104 * 1024;
        for (size_t i = gtid; i < (size_t)96 * 1024 / 8; i += gstride) *(uint4*)(wpad + i * 8) = make_uint4(0, 0, 0, 0);
        const int lane = tid & 63;
        const int gw = blockIdx.x * 8 + (tid >> 6), nw = gridDim.x * 8;
        float* scales = (float*)(ws + WS_PSC);
        for (int rowi = gw * 32; rowi < 2 * 32768; rowi += nw * 32)
        for (int row = rowi; row < rowi + 32; ++row) {
            const int tbl = row >> 15, r = row & 32767;
            const float* srow = p.in[32 + tbl] + (size_t)r * 1024;
            float4 v[4]; float am = 0.f;
#pragma unroll
            for (int i = 0; i < 4; ++i) { v[i] = *(const float4*)(srow + 256 * i + 4 * lane); am = fmaxf(am, fmaxf(fmaxf(fabsf(v[i].x), fabsf(v[i].y)), fmaxf(fabsf(v[i].z), fabsf(v[i].w)))); }
#pragma unroll
            for (int o = 1; o < 64; o <<= 1) am = fmaxf(am, __shfl_xor(am, o));
            const float scale = am > 0.f ? am * (1.0f / 448.0f) : 1.0f;
            const float inv = 1.0f / scale;
            unsigned w[4];
#pragma unroll
            for (int i = 0; i < 4; ++i) {
                int t = 0;
                t = __builtin_amdgcn_cvt_pk_fp8_f32(v[i].x * inv, v[i].y * inv, t, false);
                t = __builtin_amdgcn_cvt_pk_fp8_f32(v[i].z * inv, v[i].w * inv, t, true);
                w[i] = (unsigned)t;
            }
            *(uint4*)(ws + (tbl ? WS_PV : WS_PU) + (size_t)r * 1024 + 16 * lane) = make_uint4(w[0], w[1], w[2], w[3]);
            if (lane == 0) scales[tbl * 32768 + r] = scale;
        }
    }
}

DEV void normmod_store(const float4 (&v)[4], float ss, const float* g, const float* shift, const float* scale, bf16_t* dst, int lane) {
    const float rs = rsqrtf(ss * (1.0f / 1024.0f) + 1e-6f);
#pragma unroll
    for (int i = 0; i < 4; ++i) {
        const int col = i * 256 + lane * 4;
        const float4 gg = *(const float4*)(g + col), sh = *(const float4*)(shift + col), sc = *(const float4*)(scale + col);
        const float y0 = v[i].x * rs * gg.x * (1.f + sc.x) + sh.x, y1 = v[i].y * rs * gg.y * (1.f + sc.y) + sh.y;
        const float y2 = v[i].z * rs * gg.z * (1.f + sc.z) + sh.z, y3 = v[i].w * rs * gg.w * (1.f + sc.w) + sh.w;
        *(uint2*)(dst + col) = make_uint2(pk_bf16(y0, y1), pk_bf16(y2, y3));
    }
}
DEV void phase_normmod(const Params& p, int layer, int which, const float* xl, const float* xc, int nrows, bf16_t* dst) {
    const int tid = tid_opaque(), lane = tid & 63;
    const int gw = blockIdx.x * 8 + (tid >> 6), nw = gridDim.x * 8;
    const float* mods = (const float*)(p.ws + WS_MOD) + (size_t)layer * 9 * 6144;
    const float* g = p.in[which ? 7 : 6] + layer * 1024;
    for (int R = gw; R < nrows; R += nw) {
        const float* xr = R < NL ? xl + (size_t)R * 1024 : xc + (size_t)(R - NL) * 1024;
        float4 v[4]; float ss = 0.f;
#pragma unroll
        for (int i = 0; i < 4; ++i) { v[i] = *(const float4*)(xr + i * 256 + lane * 4); ss += v[i].x * v[i].x + v[i].y * v[i].y + v[i].z * v[i].z + v[i].w * v[i].w; }
        ss = wave_allreduce(ss);
        const float* mrow = mods + (size_t)mod_batch(R) * 6144 + (which ? 3 : 0) * 1024;
        normmod_store(v, ss, g, mrow, mrow + 1024, dst + (size_t)R * 1024, lane);
    }
}
DEV void phase_normmix(const Params& p, bf16_t* hdst, bf16_t* xr, bf16_t* xk, bf16_t* xv) {
    const int tid = tid_opaque(), lane = tid & 63;
    const int gw = __builtin_amdgcn_readfirstlane(blockIdx.x * 8 + (tid >> 6)), nw = gridDim.x * 8;
    const float* mods = (const float*)(p.ws + WS_MOD);
    const float* g = p.in[6];
    for (int run = gw; run < NT / 8; run += nw) {
        const int R0 = run * 8;
        const int t0 = R0 < NL ? (R0 & 8191) : ((R0 - NL) & 255), slen = R0 < NL ? 8192 : 256;
        const float* mrow = mods + (size_t)mod_batch(R0) * 6144;
        float4 gg[4], sh[4], sc[4], m0[4], m2[4], m3[4];
#pragma unroll
        for (int i = 0; i < 4; ++i) {
            const int col = i * 256 + lane * 4;
            gg[i] = *(const float4*)(g + col); sh[i] = *(const float4*)(mrow + col); sc[i] = *(const float4*)(mrow + 1024 + col);
            m0[i] = *(const float4*)(p.in[8] + col); m2[i] = *(const float4*)(p.in[8] + 2 * 1024 + col); m3[i] = *(const float4*)(p.in[8] + 3 * 1024 + col);
        }
        auto hrow = [&](int R, float4 (&h)[4]) {
            const float* xrw = R < NL ? p.in[0] + (size_t)R * 1024 : p.in[2] + (size_t)(R - NL) * 1024;
            float ss = 0.f;
#pragma unroll
            for (int i = 0; i < 4; ++i) { h[i] = *(const float4*)(xrw + i * 256 + lane * 4); ss += h[i].x * h[i].x + h[i].y * h[i].y + h[i].z * h[i].z + h[i].w * h[i].w; }
            ss = wave_allreduce(ss);
            const float rs = rsqrtf(ss * (1.0f / 1024.0f) + 1e-6f);
#pragma unroll
            for (int i = 0; i < 4; ++i) {
                h[i].x = h[i].x * rs * gg[i].x * (1.f + sc[i].x) + sh[i].x; h[i].y = h[i].y * rs * gg[i].y * (1.f + sc[i].y) + sh[i].y;
                h[i].z = h[i].z * rs * gg[i].z * (1.f + sc[i].z) + sh[i].z; h[i].w = h[i].w * rs * gg[i].w * (1.f + sc[i].w) + sh[i].w;
            }
        };
        float4 hp[4], hc[4], hn[4];
        if (t0 > 0) hrow(R0 - 1, hp); else { hp[0] = hp[1] = hp[2] = hp[3] = make_float4(0.f, 0.f, 0.f, 0.f); }
        hrow(R0, hc);
#pragma unroll 1
        for (int i8 = 0; i8 < 8; ++i8) {
            const int R = R0 + i8;
            if (t0 + i8 + 1 < slen) hrow(R + 1, hn); else { hn[0] = hn[1] = hn[2] = hn[3] = make_float4(0.f, 0.f, 0.f, 0.f); }
#pragma unroll
            for (int i = 0; i < 4; ++i) {
                const size_t o = (size_t)R * 1024 + i * 256 + lane * 4;
                const float4 c = hc[i];
                const float4 xx = make_float4(0.5f * (hp[i].x + hn[i].x) - c.x, 0.5f * (hp[i].y + hn[i].y) - c.y, 0.5f * (hp[i].z + hn[i].z) - c.z, 0.5f * (hp[i].w + hn[i].w) - c.w);
                *(uint2*)(hdst + o) = make_uint2(pk_bf16(c.x, c.y), pk_bf16(c.z, c.w));
                *(uint2*)(xr + o) = make_uint2(pk_bf16(c.x + xx.x * m0[i].x, c.y + xx.y * m0[i].y), pk_bf16(c.z + xx.z * m0[i].z, c.w + xx.w * m0[i].w));
                *(uint2*)(xk + o) = make_uint2(pk_bf16(c.x + xx.x * m2[i].x, c.y + xx.y * m2[i].y), pk_bf16(c.z + xx.z * m2[i].z, c.w + xx.w * m2[i].w));
                *(uint2*)(xv + o) = make_uint2(pk_bf16(c.x + xx.x * m3[i].x, c.y + xx.y * m3[i].y), pk_bf16(c.z + xx.z * m3[i].z, c.w + xx.w * m3[i].w));
            }
#pragma unroll
            for (int i = 0; i < 4; ++i) { hp[i] = hc[i]; hc[i] = hn[i]; }
        }
    }
}

template <int BN> struct EpiBf16 {
    bf16_t* dst; int ldd; int col0; int act;
    DEV void operator()(const f32x4 (&acc)[4][BN / 64], int m0, int wm, int wn, int fr, int fq) const {
#pragma unroll
        for (int mi = 0; mi < 4; ++mi) {
            const size_t R = (size_t)(m0 + wm * 64 + mi * 16 + fr);
#pragma unroll
            for (int ni = 0; ni < BN / 64; ++ni) {
                const int col = col0 + wn * (BN / 4) + ni * 16 + 4 * fq;
                float v[4] = {acc[mi][ni][0], acc[mi][ni][1], acc[mi][ni][2], acc[mi][ni][3]};
                if (act == 1) {
#pragma unroll
                    for (int j = 0; j < 4; ++j) v[j] = tanhf(v[j]);
                } else if (act == 2) {
#pragma unroll
                    for (int j = 0; j < 4; ++j) v[j] = sigmoidf_(v[j]);
                }
                *(uint2*)(dst + R * ldd + col) = make_uint2(pk_bf16(v[0], v[1]), pk_bf16(v[2], v[3]));
            }
        }
    }
};
struct EpiResid {
    const float* xold_lat; const float* xold_ctx; float* dst_lat; float* dst_ctx; const float* gate; int col0;
    DEV void operator()(const f32x4 (&acc)[4][4], int m0, int wm, int wn, int fr, int fq) const {
#pragma unroll
        for (int mi = 0; mi < 4; ++mi) {
            const int R = m0 + wm * 64 + mi * 16 + fr;
            const float* src = R < NL ? xold_lat + (size_t)R * 1024 : xold_ctx + (size_t)(R - NL) * 1024;
            float* dst = R < NL ? dst_lat + (size_t)R * 1024 : dst_ctx + (size_t)(R - NL) * 1024;
            const float* gr = gate + (size_t)mod_batch(R) * 6144;
#pragma unroll
            for (int ni = 0; ni < 4; ++ni) {
                const int col = col0 + wn * 64 + ni * 16 + 4 * fq;
                const float4 xo = *(const float4*)(src + col), g4 = *(const float4*)(gr + col);
                *(float4*)(dst + col) = make_float4(xo.x + g4.x * acc[mi][ni][0], xo.y + g4.y * acc[mi][ni][1], xo.z + g4.z * acc[mi][ni][2], xo.w + g4.w * acc[mi][ni][3]);
            }
        }
    }
};
struct EpiLr {
    float* dst;
    DEV void operator()(const f32x4 (&acc)[4][2], int m0, int wm, int wn, int fr, int fq) const {
        if (wn != 0) return;
#pragma unroll
        for (int mi = 0; mi < 4; ++mi) {
            const size_t R = (size_t)(m0 + wm * 64 + mi * 16 + fr);
#pragma unroll
            for (int ni = 0; ni < 2; ++ni) { const int col = ni * 16 + 4 * fq; *(float4*)(dst + R * 32 + col) = make_float4(acc[mi][ni][0], acc[mi][ni][1], acc[mi][ni][2], acc[mi][ni][3]); }
        }
    }
};

namespace pg8 {
#define PG8_LAS __attribute__((address_space(3)))
constexpr int BM = 256, BK = 64, HALF = 128, HTB = HALF * BK * 2  , STAGE_BYTES = 8 * HTB, NXCD = 8, WGM = 8;

__host__ __device__ __forceinline__ int lds_byte(int r, int c) { const int st = (r >> 4) * 2 + (c >> 5), rr = r & 15, cc = c & 31, ob = rr * 64 + cc * 2; return st * 1024 + (ob ^ (((ob >> 9) & 1) << 5)); }
__host__ __device__ __forceinline__ void stage_rc(int b, int& R, int& C) { const int st = b / 1024, sb = b % 1024, swz = sb ^ (((sb >> 9) & 1) << 5); R = (st >> 1) * 16 + swz / 64; C = (st & 1) * 32 + (swz % 64) / 2; }
__host__ __device__ __forceinline__ int perm32(int rho) { const int n = rho >> 4, i = rho & 15; return 8 * (i >> 2) + 4 * n + (i & 3); }
struct Unit { int pm, pn; };
struct Gemm { const bf16_t* A; const bf16_t* Bt; int M, N, K; };
struct StaticOrder {
    int nM, nN, nwg, G, c;
    __host__ __device__ void init(int M, int N, int G_, int c_) { nM = M / BM; nN = N / BM; nwg = nM * nN; G = G_; c = c_; }
    __host__ __device__ bool next(int i, Unit& u) const {
        const long L = (long)i * G + c; if (L >= nwg) return false;
        int wgid = (int)L; { const int q = nwg / NXCD, r = nwg % NXCD, xcd = wgid % NXCD, off = wgid / NXCD; wgid = (xcd < r ? xcd * (q + 1) : r * (q + 1) + (xcd - r) * q) + off; }
        const int nig = WGM * nN, gid = wgid / nig, fm = gid * WGM, gsz = (nM - fm) < WGM ? (nM - fm) : WGM;
        u.pm = fm + ((wgid % nig) % gsz); u.pn = (wgid % nig) / gsz; return true;
    }
    __device__ __forceinline__ void a_ready(const Unit&) const {}
    __device__ __forceinline__ void done(const Unit&) const {}
};
template <class Epi, class Sched, bool STAMP = false>
__device__ __forceinline__ void gemm_phase(PG8_LAS unsigned char* lds, const Gemm g, const Sched& S, const Epi& E, unsigned long long* stamps) {
    const int tid = tid_opaque(), wid = __builtin_amdgcn_readfirstlane(tid >> 6), lane = tid & 63, wr = wid >> 2, wc = wid & 3, fr = lane & 15, fq = lane >> 4;
    const int K = g.K, nt = K / BK;
    int ts_lo = 0, ts_hi = 0, nts = 0; const unsigned long long rt_entry = STAMP ? (unsigned long long)wall_clock64() : 0ull;
#define PG8_STAMP() do { if (STAMP && wid == 0 && nts < 64) { const unsigned long long _c = (unsigned long long)clock64(); \
        ts_lo = (lane == nts) ? (int)(unsigned)_c : ts_lo; ts_hi = (lane == nts) ? (int)(unsigned)(_c >> 32) : ts_hi; ++nts; } } while (0)
    PG8_STAMP();
    unsigned voffA[2], voffB[2];
#pragma unroll
    for (int i = 0; i < 2; ++i) { int R, C; stage_rc(tid * 16 + i * 8192, R, C); const int Rb = Epi::PERM ? ((R & ~31) + perm32(R & 31)) : R;
        voffA[i] = (unsigned)(R * K + C) * 2u; voffB[i] = (unsigned)(Rb * K + C) * 2u; }
    const size_t kstep = (size_t)(BK * 2);
    const size_t hstep = (size_t)HALF * K * 2;
    const size_t tstep = 2 * hstep;
    const unsigned ldsw = (unsigned)wid * 1024u;
    const int aoff = lds_byte(wr * 64 + fr, fq * 8), boff = lds_byte(wc * 32 + fr, fq * 8);
#define PG8_SA(b, h) (((b) * 2 + (h)) * HTB)
#define PG8_SB(b, h) ((4 + (b) * 2 + (h)) * HTB)
#define PG8_STAGE(bufoff, gbase, voff) do { _Pragma("unroll") for (int _i = 0; _i < 2; ++_i) \
        __builtin_amdgcn_global_load_lds((const unsigned*)((const char*)(gbase) + (voff)[_i]), (PG8_LAS unsigned*)(lds + (bufoff) + ldsw + _i * 8192), 16, 0, 0); } while (0)
#define PG8_LDA(dst, b, h) do { _Pragma("unroll") for (int m = 0; m < 4; ++m) _Pragma("unroll") for (int k = 0; k < 2; ++k) dst[m][k] = *(const PG8_LAS bf16x8*)(lds + PG8_SA(b, h) + aoff + m * 2048 + k * 1024); } while (0)
#define PG8_LDB(dst, b, h) do { _Pragma("unroll") for (int n = 0; n < 2; ++n) _Pragma("unroll") for (int k = 0; k < 2; ++k) dst[n][k] = *(const PG8_LAS bf16x8*)(lds + PG8_SB(b, h) + boff + n * 2048 + k * 1024); } while (0)
#define PG8_MMA(ai, bj, At, Bt) do { __builtin_amdgcn_s_setprio(1); _Pragma("unroll") for (int m = 0; m < 4; ++m) _Pragma("unroll") for (int n = 0; n < 2; ++n) _Pragma("unroll") for (int k = 0; k < 2; ++k) \
        acc[ai][bj][m][n] = __builtin_amdgcn_mfma_f32_16x16x32_bf16(Bt[n][k], At[m][k], acc[ai][bj][m][n], 0, 0, 0); __builtin_amdgcn_s_setprio(0); } while (0)
#define PG8_WAIT_V(n) asm volatile("s_waitcnt vmcnt(" #n ")" ::: "memory")
#define PG8_WAIT_L(n) asm volatile("s_waitcnt lgkmcnt(" #n ")" ::: "memory")
#define PG8_BAR __builtin_amdgcn_s_barrier()
#define PG8_SCHED __builtin_amdgcn_sched_barrier(0)
    Unit cur, nxt; int ui = 0;
    if (!S.next(0, cur)) return;
    f32x4 acc[2][2][4][2];
#pragma unroll
    for (int a = 0; a < 2; ++a)
#pragma unroll
        for (int b = 0; b < 2; ++b)
#pragma unroll
            for (int m = 0; m < 4; ++m)
#pragma unroll
                for (int n = 0; n < 2; ++n) acc[a][b][m][n] = (f32x4){0.f, 0.f, 0.f, 0.f};
    bf16x8 At[4][2], B0[2][2], B1[2][2];
    const char* cA = (const char*)g.A + (size_t)cur.pm * tstep; const char* cB = (const char*)g.Bt + (size_t)cur.pn * tstep;
    S.a_ready(cur);
    PG8_STAGE(PG8_SB(0, 0), cB, voffB); PG8_STAGE(PG8_SA(0, 0), cA, voffA); PG8_STAGE(PG8_SB(0, 1), cB + hstep, voffB); PG8_STAGE(PG8_SA(0, 1), cA + hstep, voffA);
    if (wr == 1) PG8_BAR;
    PG8_WAIT_V(4); PG8_BAR;
    PG8_STAGE(PG8_SB(1, 0), cB + kstep, voffB); PG8_STAGE(PG8_SA(1, 0), cA + kstep, voffA); PG8_STAGE(PG8_SB(1, 1), cB + hstep + kstep, voffB);
    PG8_WAIT_V(6); PG8_BAR;
    PG8_STAMP();
    for (;;) {
        const bool has_next = S.next(ui + 1, nxt);
        const char* nA = has_next ? (const char*)g.A + (size_t)nxt.pm * tstep : cA; const char* nB = has_next ? (const char*)g.Bt + (size_t)nxt.pn * tstep : cB;
        for (int t = 0; t < nt; t += 2) {
            const bool last = (t == nt - 2);
            const char* a1 = cA + (size_t)(t + 1) * kstep;
            const char* a2 = last ? nA : cA + (size_t)(t + 2) * kstep; const char* b2 = last ? nB : cB + (size_t)(t + 2) * kstep;
            const char* a3 = a2 + kstep; const char* b3 = b2 + kstep;
            if (last && has_next) S.a_ready(nxt);
            PG8_LDB(B0, 0, 0); PG8_SCHED; PG8_LDA(At, 0, 0); PG8_STAGE(PG8_SA(1, 1), a1 + hstep, voffA);
            PG8_WAIT_L(8); PG8_BAR; PG8_WAIT_L(0); PG8_MMA(0, 0, At, B0); PG8_BAR; PG8_SCHED;
            PG8_LDB(B1, 0, 1); PG8_STAGE(PG8_SB(0, 0), b2, voffB);
            PG8_BAR; PG8_WAIT_L(0); PG8_MMA(0, 1, At, B1); PG8_BAR;
            PG8_LDA(At, 0, 1); PG8_STAGE(PG8_SA(0, 0), a2, voffA);
            PG8_BAR; PG8_WAIT_L(0); PG8_MMA(1, 0, At, B0); PG8_BAR; PG8_SCHED;
            PG8_STAGE(PG8_SB(0, 1), b2 + hstep, voffB);
            PG8_WAIT_V(6); PG8_BAR; PG8_MMA(1, 1, At, B1); PG8_BAR;
            PG8_LDB(B0, 1, 0); PG8_SCHED; PG8_LDA(At, 1, 0); PG8_STAGE(PG8_SA(0, 1), a2 + hstep, voffA);
            PG8_WAIT_L(8); PG8_BAR; PG8_WAIT_L(0); PG8_MMA(0, 0, At, B0); PG8_BAR; PG8_SCHED;
            PG8_LDB(B1, 1, 1); PG8_STAGE(PG8_SB(1, 0), b3, voffB);
            PG8_BAR; PG8_WAIT_L(0); PG8_MMA(0, 1, At, B1); PG8_BAR;
            PG8_LDA(At, 1, 1); PG8_STAGE(PG8_SA(1, 0), a3, voffA);
            PG8_BAR; PG8_WAIT_L(0); PG8_MMA(1, 0, At, B0); PG8_BAR; PG8_SCHED;
            PG8_STAGE(PG8_SB(1, 1), b3 + hstep, voffB);
            PG8_WAIT_V(6); PG8_BAR; PG8_MMA(1, 1, At, B1); PG8_BAR;
        }
        PG8_STAMP();
        if constexpr (!Epi::AFTER_DRAIN) { E(acc, cur, wr, wc, fr, fq); S.done(cur); }
        PG8_STAMP();
        if (!has_next) break;
#pragma unroll
        for (int a = 0; a < 2; ++a)
#pragma unroll
            for (int b = 0; b < 2; ++b)
#pragma unroll
                for (int m = 0; m < 4; ++m)
#pragma unroll
                    for (int n = 0; n < 2; ++n) acc[a][b][m][n] = (f32x4){0.f, 0.f, 0.f, 0.f};
        cur = nxt; cA = nA; cB = nB; ++ui;
    }
    PG8_WAIT_V(0);
    if (wr == 0) PG8_BAR;
    PG8_BAR;
    if constexpr (Epi::AFTER_DRAIN) { E.fused(acc, cur, wr, wc, fr, fq, lds, wid, lane); S.done(cur); }
    PG8_STAMP();
    if (STAMP && wid == 0) { stamps[lane] = lane < nts ? (((unsigned long long)(unsigned)ts_hi << 32) | (unsigned)ts_lo) : 0ull;
        if (lane == 62) stamps[62] = rt_entry; if (lane == 63) stamps[63] = (unsigned long long)wall_clock64(); }
#undef PG8_STAMP
#undef PG8_SA
#undef PG8_SB
#undef PG8_STAGE
#undef PG8_LDA
#undef PG8_LDB
#undef PG8_MMA
#undef PG8_WAIT_V
#undef PG8_WAIT_L
#undef PG8_BAR
#undef PG8_SCHED
}
struct EpiBf16Tiles {
    static constexpr bool PERM = true, AFTER_DRAIN = false;
    bf16_t* d0; int ld0; int ntile0; bf16_t* d1; int ld1;
    __device__ __forceinline__ void operator()(const f32x4 (&acc)[2][2][4][2], const Unit& u, int wr, int wc, int fr, int fq) const {
        bf16_t* base = u.pn < ntile0 ? d0 : d1; const int ld = u.pn < ntile0 ? ld0 : ld1; const int colt = (u.pn < ntile0 ? u.pn : u.pn - ntile0) * BM;
        const int row0 = u.pm * BM + wr * 64 + fr, col0 = colt + wc * 32 + 8 * fq;
#pragma unroll
        for (int ai = 0; ai < 2; ++ai)
#pragma unroll
            for (int m = 0; m < 4; ++m) { bf16_t* rowp = base + (size_t)(row0 + ai * HALF + m * 16) * ld + col0;
#pragma unroll
                for (int bj = 0; bj < 2; ++bj) { const f32x4 v0 = acc[ai][bj][m][0], v1 = acc[ai][bj][m][1];
                    *(uint4*)(rowp + bj * HALF) = make_uint4(pk_bf16(v0[0], v0[1]), pk_bf16(v0[2], v0[3]), pk_bf16(v1[0], v1[1]), pk_bf16(v1[2], v1[3])); } }
    }
};
struct EpiResid256 {
    static constexpr bool PERM = false, AFTER_DRAIN = false;
    const float* xold_lat; const float* xold_ctx; float* dst_lat; float* dst_ctx; const float* gate;
    __device__ __forceinline__ void operator()(const f32x4 (&acc)[2][2][4][2], const Unit& u, int wr, int wc, int fr, int fq) const {
        const int row0 = u.pm * BM + wr * 64 + fr, col0 = u.pn * BM + wc * 32 + 4 * fq;
#pragma unroll
        for (int ai = 0; ai < 2; ++ai)
#pragma unroll
            for (int m = 0; m < 4; ++m) {
                const int R = row0 + ai * HALF + m * 16;
                const float* src = R < NL ? xold_lat + (size_t)R * 1024 : xold_ctx + (size_t)(R - NL) * 1024;
                float* dst = R < NL ? dst_lat + (size_t)R * 1024 : dst_ctx + (size_t)(R - NL) * 1024;
                const float* gr = gate + (size_t)mod_batch(R) * 6144;
#pragma unroll
                for (int bj = 0; bj < 2; ++bj)
#pragma unroll
                    for (int n = 0; n < 2; ++n) {
                        const int col = col0 + bj * HALF + n * 16;
                        const float4 xo = *(const float4*)(src + col), g4 = *(const float4*)(gr + col);
                        const f32x4 a = acc[ai][bj][m][n];
                        *(float4*)(dst + col) = make_float4(xo.x + g4.x * a[0], xo.y + g4.y * a[1], xo.z + g4.z * a[2], xo.w + g4.w * a[3]);
                    }
            }
    }
};
}

DEV void phase_rw_proj1(const Params& p, unsigned char* lds, int which, const bf16_t* A, bf16_t* dst) {
    pg8::Gemm g{A, (const bf16_t*)(p.ws + WS_WPROJ) + (size_t)which * 1024 * 1024, NT, 1024, 1024};
    pg8::StaticOrder so; so.init(NT, 1024, gridDim.x, blockIdx.x);
    pg8::EpiBf16Tiles ep{dst, 1024, 4, dst, 1024};
    pg8::gemm_phase((PG8_LAS unsigned char*)lds, g, so, ep, nullptr);
    __syncthreads();
}
DEV void phase_rw_lora(const Params& p, unsigned char* lds) {
    unsigned char* ws = p.ws;
    const bf16_t* h = (const bf16_t*)(ws + WS_S + 0 * U_BYTES);
    const bf16_t* wproj = (const bf16_t*)(ws + WS_WPROJ);
    const int nunits = (NT / 128) * 3;
    for (int u = blockIdx.x; u < nunits; u += gridDim.x) {
        const int mt = u / 3, lg = u % 3, m0 = mt * 128;
        const int mixid = lg == 0 ? 1 : (lg == 1 ? 4 : 5);
        ALoadMix al{h, p.in[8] + mixid * 1024, h, 1024};
        EpiBf16<128> ep{(bf16_t*)(ws + WS_S + 4 * U_BYTES), 384, lg * 128, lg == 0 ? 1 : (lg == 1 ? 0 : 2)};
        gemm_unit<128>(lds, al, wproj + (size_t)(3072 + lg * 128) * 1024, 1024, m0, ep);
    }
}

template <int N> DEV float dpp_shr0(float x) { return __int_as_float(__builtin_amdgcn_update_dpp(0, __float_as_int(x), 0x110 + N, 0xF, 0xF, true)); }
template <int CTRL> DEV float dpp_quad(float x) { return __int_as_float(__builtin_amdgcn_update_dpp(0, __float_as_int(x), CTRL, 0xF, 0xF, false)); }
DEV int tile_off(int row, int ch) { return row * 128 + ((ch ^ (row & 7)) << 4); }
DEV int tile_off2(int row, int ch) { return row * 128 + ((ch ^ ((row ^ (row >> 3)) & 7)) << 4); }
DEV void phase_rw_scan(const Params& p, unsigned char* lds) {
    const int tid = tid_opaque(), lane = tid & 63;
    const int wv = __builtin_amdgcn_readfirstlane(tid >> 6);
    const int fr = lane & 15, fq = lane >> 4;
    unsigned char* ws = p.ws;
    constexpr int SH = 0, SL = 8192, AT = 16384  , RT = 20480  , BT = 24576  , KT = 28672  , BKT = 32768  , UV = 49152  , NT = 65536  ;
    constexpr int MFA = 69632, MFK = 70656, X0 = 71680, VS = 75776  , PP = 83968, PM = 88064, PI = 92160, AA = 96256  ;
    constexpr int PL = 116736  , YB = 117760, LDS_END = 121856;
    const bf16_t* rbuf = (const bf16_t*)(ws + WS_S + 3 * U_BYTES);
    const bf16_t* kbuf = (const bf16_t*)(ws + WS_S + 5 * U_BYTES);
    const bf16_t* vbuf = (const bf16_t*)(ws + WS_S + 1 * U_BYTES);
    const bf16_t* lora = (const bf16_t*)(ws + WS_S + 4 * U_BYTES);
    for (int unit = blockIdx.x; unit < 256; unit += gridDim.x) {
        const int b = unit >> 5, hh = (unit >> 1) & 15, d = unit & 1;
        bf16_t* ydst = (bf16_t*)(ws + WS_S + (size_t)(d ? 2 : 0) * U_BYTES);
        float* bonus = (float*)(ws + WS_BONUS) + (size_t)((d * NB + b) * 16 + hh) * 8448;
        const int s_e = (tid >> 4) & 15, j0 = (tid & 15) * 4;
        const int ni = wv & 3;
        auto Rof = [&](int c, int s) -> int {
            if (c < 16) { const int q = c * 16 + s; return NL + b * 256 + (d ? 255 - q : q); }
            const int q = (c - 16) * 16 + s; return b * 8192 + (d ? 8191 - q : q);
        };
        constexpr int CST = LDS_END;
        uint2 pr = make_uint2(0, 0), pk = pr, pv = pr; uint4 paw[2], paa[2];
        if (wv >= 4) {
            const int ct = (tid - 256) * 16;
            *(float4*)(lds + CST + 0 * 4096 + ct) = *(const float4*)(p.in[18] + hh * 64 + j0);
            *(float4*)(lds + CST + 1 * 4096 + ct) = *(const float4*)(p.in[19] + hh * 64 + j0);
            *(float4*)(lds + CST + 2 * 4096 + ct) = *(const float4*)(p.in[20] + hh * 64 + j0);
            *(float4*)(lds + CST + 3 * 4096 + ct) = *(const float4*)(p.in[10] + d * 1024 + hh * 64 + ni * 16 + fq * 4);
            *(float4*)(lds + CST + 4 * 4096 + ct) = *(const float4*)(p.in[13] + d * 1024 + hh * 64 + ni * 16 + fq * 4);
#pragma unroll
            for (int ks = 0; ks < 2; ++ks) {
                *(uint4*)(lds + CST + (5 + ks) * 4096 + ct) = *(const uint4*)((const bf16_t*)(ws + WS_W2T) + (size_t)d * 1024 * 64 + (size_t)(hh * 64 + ni * 16 + fr) * 64 + ks * 32 + fq * 8);
                *(uint4*)(lds + CST + (7 + ks) * 4096 + ct) = *(const uint4*)((const bf16_t*)(ws + WS_A2T) + (size_t)d * 1024 * 64 + (size_t)(hh * 64 + ni * 16 + fr) * 64 + ks * 32 + fq * 8);
            }
        }
        auto load_lora = [&](int c) {
            const size_t R2 = (size_t)Rof(c, fr);
#pragma unroll
            for (int ks = 0; ks < 2; ++ks) { paw[ks] = *(const uint4*)(lora + R2 * 384 + d * 64 + ks * 32 + fq * 8); paa[ks] = *(const uint4*)(lora + R2 * 384 + 128 + d * 64 + ks * 32 + fq * 8); }
        };
        auto load_rkv = [&](int c) {
            const size_t off = (size_t)Rof(c, s_e) * 1024 + hh * 64 + j0;
            pr = *(const uint2*)(rbuf + off); pk = *(const uint2*)(kbuf + off); pv = *(const uint2*)(vbuf + off);
        };
        auto step_up = [&](int c) {
            const int ct = (tid - 256) * 16;
            const float4 bias_w = *(const float4*)(lds + CST + 3 * 4096 + ct), bias_a = *(const float4*)(lds + CST + 4 * 4096 + ct);
            bf16x8 bfw[2], bfa[2];
#pragma unroll
            for (int ks = 0; ks < 2; ++ks) { bfw[ks] = *(const bf16x8*)(lds + CST + (5 + ks) * 4096 + ct); bfa[ks] = *(const bf16x8*)(lds + CST + (7 + ks) * 4096 + ct); }
            f32x4 accw = {0.f, 0.f, 0.f, 0.f}, acca = {0.f, 0.f, 0.f, 0.f};
#pragma unroll
            for (int ks = 0; ks < 2; ++ks) { accw = __builtin_amdgcn_mfma_f32_16x16x32_bf16(bfw[ks], as_bf16x8(paw[ks]), accw, 0, 0, 0); acca = __builtin_amdgcn_mfma_f32_16x16x32_bf16(bfa[ks], as_bf16x8(paa[ks]), acca, 0, 0, 0); }
            const int n = ni * 16 + fq * 4;
            const float bw[4] = {bias_w.x, bias_w.y, bias_w.z, bias_w.w}, ba[4] = {bias_a.x, bias_a.y, bias_a.z, bias_a.w};
            float P[4], Pm[4], Pi[4], av[4];
#pragma unroll
            for (int j = 0; j < 4; ++j) {
                const float e = 0.6065306597f * __builtin_amdgcn_rcpf(1.0f + __expf(-(accw[j] + bw[j])));
                float s = e;
                s += dpp_shr0<1>(s); s += dpp_shr0<2>(s); s += dpp_shr0<4>(s); s += dpp_shr0<8>(s);
                P[j] = __expf(-s); Pi[j] = __builtin_amdgcn_rcpf(P[j]); Pm[j] = P[j] * __expf(e);
                av[j] = __builtin_amdgcn_rcpf(1.0f + __expf(-(acca[j] + ba[j])));
            }
            const int pb = (c & 1) * 16384;
            *(float4*)(lds + PP + pb + (fr * 64 + n) * 4) = make_float4(P[0], P[1], P[2], P[3]);
            *(float4*)(lds + PM + pb + (fr * 64 + n) * 4) = make_float4(Pm[0], Pm[1], Pm[2], Pm[3]);
            *(float4*)(lds + PI + pb + (fr * 64 + n) * 4) = make_float4(Pi[0], Pi[1], Pi[2], Pi[3]);
            *(float4*)(lds + AA + pb + (fr * 64 + n) * 4) = make_float4(av[0], av[1], av[2], av[3]);
            if (fr == 15) *(float4*)(lds + PL + (c & 3) * 256 + n * 4) = make_float4(P[0], P[1], P[2], P[3]);
        };
        auto step_vec = [&](int c) {
            const int eo = (s_e * 64 + j0) * 4, pb = (c & 1) * 16384, tb = (c & 1) * 8192, ct = (tid - 256) * 16;
            const float4 kk_c = *(const float4*)(lds + CST + 0 * 4096 + ct), ka_c = *(const float4*)(lds + CST + 1 * 4096 + ct), rk_c = *(const float4*)(lds + CST + 2 * 4096 + ct);
            const float4 a4 = *(const float4*)(lds + AA + pb + eo), P4 = *(const float4*)(lds + PP + pb + eo), Pm4 = *(const float4*)(lds + PM + pb + eo), Pi4 = *(const float4*)(lds + PI + pb + eo);
            const float kx[4] = {bf_lo(pk.x), bf_hi(pk.x), bf_lo(pk.y), bf_hi(pk.y)};
            const float rx[4] = {bf_lo(pr.x), bf_hi(pr.x), bf_lo(pr.y), bf_hi(pr.y)};
            const float av[4] = {a4.x, a4.y, a4.z, a4.w}, Pv[4] = {P4.x, P4.y, P4.z, P4.w}, Pmv[4] = {Pm4.x, Pm4.y, Pm4.z, Pm4.w}, Piv[4] = {Pi4.x, Pi4.y, Pi4.z, Pi4.w};
            const float kkc[4] = {kk_c.x, kk_c.y, kk_c.z, kk_c.w}, kac[4] = {ka_c.x, ka_c.y, ka_c.z, ka_c.w}, rkc[4] = {rk_c.x, rk_c.y, rk_c.z, rk_c.w};
            float t[4], n2 = 0.f;
#pragma unroll
            for (int j = 0; j < 4; ++j) { t[j] = kx[j] * kkc[j]; n2 += t[j] * t[j]; }
            n2 = row16_allreduce(n2);
            const float inv = 1.0f / fmaxf(sqrtf(n2), 1e-12f);
            float at[4], bt[4], kt[4], rt[4], bon = 0.f;
#pragma unroll
            for (int j = 0; j < 4; ++j) {
                const float kkv = t[j] * inv;
                const float kd = kx[j] * (1.0f + (av[j] - 1.0f) * kac[j]);
                const float bq = kkv * av[j];
                bon += rx[j] * kd * rkc[j];
                at[j] = -kkv * Pmv[j]; bt[j] = bq * Piv[j]; kt[j] = kd * Piv[j]; rt[j] = rx[j] * Pv[j];
            }
            bon = row16_allreduce(bon);
            if ((tid & 15) == 0) { const int Rb = Rof(c, s_e); bonus[Rb < NL ? 256 + (Rb & 8191) : ((Rb - NL) & 255)] = bon; }
            const int ro = tile_off(s_e, j0 >> 3) + (j0 & 7) * 2;
            *(uint2*)(lds + AT + (c & 1) * 2048 + ro) = make_uint2(pk_bf16(at[0], at[1]), pk_bf16(at[2], at[3]));
            *(uint2*)(lds + RT + (c & 1) * 2048 + ro) = make_uint2(pk_bf16(rt[0], rt[1]), pk_bf16(rt[2], rt[3]));
            const unsigned b01 = pk_bf16(bt[0], bt[1]), b23 = pk_bf16(bt[2], bt[3]), k01 = pk_bf16(kt[0], kt[1]), k23 = pk_bf16(kt[2], kt[3]);
            *(uint2*)(lds + BT + (c & 1) * 2048 + ro) = make_uint2(b01, b23);
            *(uint2*)(lds + KT + (c & 1) * 2048 + ro) = make_uint2(k01, k23);
            const unsigned bw2[4] = {b01 & 0xffffu, b01 >> 16, b23 & 0xffffu, b23 >> 16}, kw2[4] = {k01 & 0xffffu, k01 >> 16, k23 & 0xffffu, k23 >> 16};
            const unsigned vw[4] = {pv.x & 0xffffu, pv.x >> 16, pv.y & 0xffffu, pv.y >> 16};
            const int e0 = (s_e & 7) * 2, cq = s_e >> 3;
#pragma unroll
            for (int j = 0; j < 4; ++j) {
                const int row = j0 + j;
                *(bf16_t*)(lds + BKT + tb + tile_off2(row, 0 + cq) + e0) = (bf16_t)bw2[j];
                *(bf16_t*)(lds + BKT + tb + tile_off2(row, 2 + cq) + e0) = (bf16_t)kw2[j];
                *(bf16_t*)(lds + BKT + tb + tile_off2(row, 4 + cq) + e0) = (bf16_t)bw2[j];
                *(bf16_t*)(lds + UV + tb + tile_off2(row, 2 + cq) + e0) = (bf16_t)vw[j];
            }
            *(float4*)(lds + VS + (c & 1) * 4096 + eo) = make_float4(bf_lo(pv.x), bf_hi(pv.x), bf_lo(pv.y), bf_hi(pv.y));
        };
        f32x4 accY = {0.f, 0.f, 0.f, 0.f};
        auto prod_S = [&](int c) {
            const int vt = wv & 3, tb = (c & 1) * 2048;
            f32x4 accX = {0.f, 0.f, 0.f, 0.f}, accR = {0.f, 0.f, 0.f, 0.f};
#pragma unroll
            for (int ks = 0; ks < 2; ++ks) {
                const int ch = ks * 4 + fq;
                const bf16x8 sh = *(const bf16x8*)(lds + SH + tile_off(vt * 16 + fr, ch)), sl = *(const bf16x8*)(lds + SL + tile_off(vt * 16 + fr, ch));
                const bf16x8 fa = *(const bf16x8*)(lds + AT + tb + tile_off(fr, ch)), frr = *(const bf16x8*)(lds + RT + tb + tile_off(fr, ch));
                accX = __builtin_amdgcn_mfma_f32_16x16x32_bf16(sh, fa, accX, 0, 0, 0);
                accR = __builtin_amdgcn_mfma_f32_16x16x32_bf16(sh, frr, accR, 0, 0, 0);
                accX = __builtin_amdgcn_mfma_f32_16x16x32_bf16(sl, fa, accX, 0, 0, 0);
                accR = __builtin_amdgcn_mfma_f32_16x16x32_bf16(sl, frr, accR, 0, 0, 0);
            }
            accY = accR;
#pragma unroll
            for (int j = 0; j < 4; ++j) *(float*)(lds + X0 + ((vt * 16 + 4 * fq + j) * 16 + fr) * 4) = accX[j];
        };
        auto prod_V = [&](int c) {
            const int tb = (c & 1) * 2048, w4 = wv & 3;
            f32x4 m = {0.f, 0.f, 0.f, 0.f};
#pragma unroll
            for (int ks = 0; ks < 2; ++ks) {
                const int ch = ks * 4 + fq;
                const bf16x8 fa = *(const bf16x8*)(lds + ((w4 & 1) ? KT : BT) + tb + tile_off(fr, ch));
                const bf16x8 fb = *(const bf16x8*)(lds + ((w4 & 2) ? RT : AT) + tb + tile_off(fr, ch));
                m = __builtin_amdgcn_mfma_f32_16x16x32_bf16(fa, fb, m, 0, 0, 0);
            }
            if (w4 < 2) {
                float* mf = (float*)(lds + (w4 ? MFK : MFA));
#pragma unroll
                for (int j = 0; j < 4; ++j) mf[(fr * 4 + j) * 4 + fq] = (4 * fq + j < fr) ? m[j] : 0.f;
            } else {
                const float m0 = (4 * fq + 0 <= fr) ? m[0] : 0.f, m1 = (4 * fq + 1 <= fr) ? m[1] : 0.f, m2 = (4 * fq + 2 <= fr) ? m[2] : 0.f, m3 = (4 * fq + 3 <= fr) ? m[3] : 0.f;
                const uint2 o = make_uint2(pk_bf16(m0, m1), pk_bf16(m2, m3));
                const int colb = (w4 == 2 ? 0 : 16) + 4 * fq;
                *(uint2*)(lds + NT + tb + tile_off(fr, colb >> 3) + (colb & 7) * 2) = o;
                if (w4 == 2) *(uint2*)(lds + NT + tb + tile_off(fr, (32 + 4 * fq) >> 3) + ((32 + 4 * fq) & 7) * 2) = o;
            }
        };
        auto step_rec = [&](int c) {
            const int v = tid >> 2, pq = tid & 3;
            float cc[16];
#pragma unroll
            for (int i = 0; i < 4; ++i) { const float4 q = *(const float4*)(lds + X0 + (v * 16 + 4 * i) * 4); cc[4 * i] = q.x; cc[4 * i + 1] = q.y; cc[4 * i + 2] = q.z; cc[4 * i + 3] = q.w; }
            float vown[4];
#pragma unroll
            for (int i = 0; i < 4; ++i) vown[i] = *(const float*)(lds + VS + (c & 1) * 4096 + ((4 * i + pq) * 64 + v) * 4);
#pragma unroll
            for (int t = 1; t < 16; ++t) {
                const float4 mk = *(const float4*)(lds + MFK + ((t * 4 + pq) * 4) * 4);
                float s = vown[0] * mk.x; s = fmaf(vown[1], mk.y, s); s = fmaf(vown[2], mk.z, s); s = fmaf(vown[3], mk.w, s);
                s += dpp_quad<0xB1>(s); s += dpp_quad<0x4E>(s);
                cc[t] += s;
            }
            float4 ma[16];
#pragma unroll
            for (int t = 1; t < 16; ++t) ma[t] = *(const float4*)(lds + MFA + ((t * 4 + pq) * 4) * 4);
            ma[0] = make_float4(0.f, 0.f, 0.f, 0.f);
            float uown[4] = {0.f, 0.f, 0.f, 0.f}, uall[16];
#pragma unroll
            for (int t = 0; t < 16; ++t) {
                float s = uown[0] * ma[t].x; s = fmaf(uown[1], ma[t].y, s); s = fmaf(uown[2], ma[t].z, s); s = fmaf(uown[3], ma[t].w, s);
                s += dpp_quad<0xB1>(s); s += dpp_quad<0x4E>(s);
                const float u = cc[t] + s;
                uall[t] = u;
                if (pq == (t & 3)) uown[t >> 2] = u;
            }
            if (pq < 2) {
                unsigned o[8];
#pragma unroll
                for (int i = 0; i < 8; ++i) {
                    const unsigned hi = pk_bf16(uall[2 * i], uall[2 * i + 1]);
                    o[i] = pq ? pk_bf16(uall[2 * i] - bf_lo(hi), uall[2 * i + 1] - bf_hi(hi)) : hi;
                }
                const int cb = pq ? 4 : 0;
                *(uint4*)(lds + UV + (c & 1) * 8192 + tile_off2(v, cb)) = make_uint4(o[0], o[1], o[2], o[3]);
                *(uint4*)(lds + UV + (c & 1) * 8192 + tile_off2(v, cb + 1)) = make_uint4(o[4], o[5], o[6], o[7]);
            }
        };
        f32x4 accS[2];
        accS[0] = (f32x4){0.f, 0.f, 0.f, 0.f}; accS[1] = (f32x4){0.f, 0.f, 0.f, 0.f};
        auto step_upd = [&](int c) {
            const int vt = wv & 3;
            bf16x8 fuv[2];
#pragma unroll
            for (int ks = 0; ks < 2; ++ks) fuv[ks] = *(const bf16x8*)(lds + UV + (c & 1) * 8192 + tile_off2(vt * 16 + fr, ks * 4 + fq));
            if (wv < 4) {
#pragma unroll
                for (int ks = 0; ks < 2; ++ks) accY = __builtin_amdgcn_mfma_f32_16x16x32_bf16(fuv[ks], *(const bf16x8*)(lds + NT + (c & 1) * 2048 + tile_off(fr, ks * 4 + fq)), accY, 0, 0, 0);
                *(float4*)(lds + YB + (fr * 64 + vt * 16 + 4 * fq) * 4) = make_float4(accY[0], accY[1], accY[2], accY[3]);
            }
#pragma unroll
            for (int k2 = 0; k2 < 2; ++k2) {
                const int kt = 2 * (wv >> 2) + k2;
                f32x4 a = accS[k2];
#pragma unroll
                for (int ks = 0; ks < 2; ++ks) a = __builtin_amdgcn_mfma_f32_16x16x32_bf16(*(const bf16x8*)(lds + BKT + (c & 1) * 8192 + tile_off2(kt * 16 + fr, ks * 4 + fq)), fuv[ks], a, 0, 0, 0);
                const float4 pl = *(const float4*)(lds + PL + (c & 3) * 256 + (kt * 16 + 4 * fq) * 4);
                a[0] *= pl.x; a[1] *= pl.y; a[2] *= pl.z; a[3] *= pl.w;
                accS[k2] = a;
                const unsigned h01 = pk_bf16(a[0], a[1]), h23 = pk_bf16(a[2], a[3]);
                const unsigned l01 = pk_bf16(a[0] - bf_lo(h01), a[1] - bf_hi(h01)), l23 = pk_bf16(a[2] - bf_lo(h23), a[3] - bf_hi(h23));
                const int kc = kt * 16 + 4 * fq;
                const int so = tile_off(vt * 16 + fr, kc >> 3) + (kc & 7) * 2;
                *(uint2*)(lds + SH + so) = make_uint2(h01, h23);
                *(uint2*)(lds + SL + so) = make_uint2(l01, l23);
            }
        };
        for (int i = tid; i < LDS_END / 16; i += NTHREADS) *(uint4*)(lds + i * 16) = make_uint4(0, 0, 0, 0);
        if (wv >= 4) { load_lora(0); load_rkv(0); }
        __syncthreads();
        if (wv >= 4) { step_up(0); load_lora(1); }
        __syncthreads();
        if (wv >= 4) { step_vec(0); step_up(1); load_rkv(1); load_lora(2); }
        __syncthreads();
        if (wv >= 4) prod_V(0);
        __syncthreads();
        auto ystore = [&](int c) {
            const float4 y4 = *(const float4*)(lds + YB + (s_e * 64 + j0) * 4);
            *(uint2*)(ydst + (size_t)Rof(c, s_e) * 1024 + hh * 64 + j0) = make_uint2(pk_bf16(y4.x, y4.y), pk_bf16(y4.z, y4.w));
        };
        if (wv < 4) {
            for (int c = 0; c < 528; ++c) {
                if (c > 0) ystore(c - 1);
                prod_S(c);
                step_rec(c);
                __syncthreads();
                step_upd(c);
                __syncthreads();
            }
        } else {
            for (int c = 0; c < 528; ++c) {
                if (c + 1 < 528) step_vec(c + 1);
                if (c + 2 < 528) { step_up(c + 2); load_rkv(c + 2); }
                if (c + 3 < 528) load_lora(c + 3);
                __syncthreads();
                step_upd(c);
                if (c + 1 < 528) prod_V(c + 1);
                __syncthreads();
            }
        }
        if (wv < 4) ystore(527);
        __syncthreads();
    }
}

DEV void phase_rw_readout(const Params& p) {
    const int tid = tid_opaque(), lane = tid & 63, wv = tid >> 6, wm = wv >> 2, wn = wv & 3;
    const int fr = lane & 15, fq = lane >> 4;
    unsigned char* ws = p.ws;
    const bf16_t* y0b = (const bf16_t*)(ws + WS_S + 0 * U_BYTES);
    const bf16_t* y1b = (const bf16_t*)(ws + WS_S + 2 * U_BYTES);
    const bf16_t* vb = (const bf16_t*)(ws + WS_S + 1 * U_BYTES);
    const bf16_t* lora = (const bf16_t*)(ws + WS_S + 4 * U_BYTES);
    const bf16_t* g2t = (const bf16_t*)(ws + WS_G2T);
    bf16_t* ao = (bf16_t*)(ws + WS_S + 5 * U_BYTES);
    const float* bon0 = (const float*)(ws + WS_BONUS);
    const float* bon1 = bon0 + (size_t)NB * 16 * 8448;
    const float* lnw = p.in[21];
    const float* lnb = p.in[22];
    const int nunits = (NT / 128) * 4;
    for (int u = blockIdx.x; u < nunits; u += gridDim.x) {
        const int mt = u >> 2, nt = u & 3, m0 = mt * 128;
        const int hh = nt * 4 + wn;
        f32x4 acc[4][4];
#pragma unroll
        for (int mi = 0; mi < 4; ++mi)
#pragma unroll
            for (int ni = 0; ni < 4; ++ni) acc[mi][ni] = (f32x4){0.f, 0.f, 0.f, 0.f};
#pragma unroll 2
        for (int ks = 0; ks < 4; ++ks) {
            bf16x8 af[4], bfr[4];
#pragma unroll
            for (int mi = 0; mi < 4; ++mi) af[mi] = *(const bf16x8*)(lora + (size_t)(m0 + wm * 64 + mi * 16 + fr) * 384 + 256 + ks * 32 + fq * 8);
#pragma unroll
            for (int ni = 0; ni < 4; ++ni) bfr[ni] = *(const bf16x8*)(g2t + (size_t)(hh * 64 + ni * 16 + fr) * 128 + ks * 32 + fq * 8);
#pragma unroll
            for (int mi = 0; mi < 4; ++mi)
#pragma unroll
                for (int ni = 0; ni < 4; ++ni) acc[mi][ni] = __builtin_amdgcn_mfma_f32_16x16x32_bf16(bfr[ni], af[mi], acc[mi][ni], 0, 0, 0);
        }
#pragma unroll
        for (int mi = 0; mi < 4; ++mi) {
            const size_t R = (size_t)(m0 + wm * 64 + mi * 16 + fr);
            float yv[4][4]; float sum = 0.f;
#pragma unroll
            for (int ni = 0; ni < 4; ++ni) {
                const int col = hh * 64 + ni * 16 + 4 * fq;
                const uint2 a = *(const uint2*)(y0b + R * 1024 + col), b2 = *(const uint2*)(y1b + R * 1024 + col);
                yv[ni][0] = bf_lo(a.x) + bf_lo(b2.x); yv[ni][1] = bf_hi(a.x) + bf_hi(b2.x); yv[ni][2] = bf_lo(a.y) + bf_lo(b2.y); yv[ni][3] = bf_hi(a.y) + bf_hi(b2.y);
                sum += (yv[ni][0] + yv[ni][1]) + (yv[ni][2] + yv[ni][3]);
            }
            sum += __shfl_xor(sum, 16); sum += __shfl_xor(sum, 32);
            const float mu = sum * (1.0f / 64.0f);
            float q = 0.f;
#pragma unroll
            for (int ni = 0; ni < 4; ++ni)
#pragma unroll
                for (int j = 0; j < 4; ++j) { const float dlt = yv[ni][j] - mu; q += dlt * dlt; }
            q += __shfl_xor(q, 16); q += __shfl_xor(q, 32);
            const float rstd = rsqrtf(q * (1.0f / 64.0f) + 64e-5f);
            const size_t bidx = (size_t)(((R < NL ? (R >> 13) : ((R - NL) >> 8)) * 16 + hh)) * 8448 + (R < NL ? 256 + (R & 8191) : ((R - NL) & 255));
            const float bs = bon0[bidx] + bon1[bidx];
#pragma unroll
            for (int ni = 0; ni < 4; ++ni) {
                const int col = hh * 64 + ni * 16 + 4 * fq;
                const uint2 vv = *(const uint2*)(vb + R * 1024 + col);
                const float4 lw = *(const float4*)(lnw + col), lb = *(const float4*)(lnb + col);
                const float o0 = ((yv[ni][0] - mu) * rstd * lw.x + lb.x + bs * bf_lo(vv.x)) * acc[mi][ni][0];
                const float o1 = ((yv[ni][1] - mu) * rstd * lw.y + lb.y + bs * bf_hi(vv.x)) * acc[mi][ni][1];
                const float o2 = ((yv[ni][2] - mu) * rstd * lw.z + lb.z + bs * bf_lo(vv.y)) * acc[mi][ni][2];
                const float o3 = ((yv[ni][3] - mu) * rstd * lw.w + lb.w + bs * bf_hi(vv.y)) * acc[mi][ni][3];
                *(uint2*)(ao + R * 1024 + col) = make_uint2(pk_bf16(o0, o1), pk_bf16(o2, o3));
            }
        }
    }
}

DEV void phase_wo(const Params& p, unsigned char* lds, int layer) {
    unsigned char* ws = p.ws;
    const bf16_t* ao = (const bf16_t*)(ws + WS_S + (size_t)(layer ? 0 : 5) * U_BYTES);
    const bf16_t* wot = (const bf16_t*)(ws + (layer ? WS_WO1 : WS_WO0));
    float* ctxr = (float*)(ws + WS_CTXR);
    const float* gate = (const float*)(ws + WS_MOD) + (size_t)layer * 9 * 6144 + 2 * 1024;
    const int M = layer ? NL : NT;
    pg8::Gemm g{ao, wot, M, 1024, 1024};
    pg8::StaticOrder so; so.init(M, 1024, gridDim.x, blockIdx.x);
    pg8::EpiResid256 ep{layer ? p.out : p.in[0], layer ? ctxr : p.in[2], p.out, ctxr, gate};
    pg8::gemm_phase((PG8_LAS unsigned char*)lds, g, so, ep, nullptr);
    __syncthreads();
}

struct EpiQTile {
    unsigned char* lds;
    DEV void operator()(const f32x4 (&acc)[4][4], int m0, int wm, int wn, int fr, int fq) const {
        const int pp = wn >> 1;
#pragma unroll
        for (int mi = 0; mi < 4; ++mi) {
            const int m = wm * 64 + mi * 16 + fr;
#pragma unroll
            for (int ni = 0; ni < 4; ++ni) {
                const int c = (wn & 1) * 64 + ni * 16 + 4 * fq;
                *(uint2*)(lds + pp * 32768 + m * 256 + (((c >> 3) ^ (m & 15)) << 4) + (c & 7) * 2) = make_uint2(pk_bf16(acc[mi][ni][0], acc[mi][ni][1]), pk_bf16(acc[mi][ni][2], acc[mi][ni][3]));
            }
        }
    }
};
DEV void phase_peer_select(const Params& p, unsigned char* lds, int layer) {
    const int tid = tid_opaque(), lane = tid & 63, wv = tid >> 6, wm = wv >> 2, wn = wv & 3;
    const int fr = lane & 15, fq = lane >> 4;
    unsigned char* ws = p.ws;
    const bf16_t* hp = (const bf16_t*)(ws + WS_S + (size_t)(layer ? 0 : 1) * U_BYTES);
    const bf16_t* wqt = (const bf16_t*)(ws + WS_WQ) + (size_t)layer * 2048 * 1024;
    const bf16_t* keys = (const bf16_t*)(ws + WS_KEYS) + (size_t)layer * 8 * 2 * 128 * 128;
    int* pl_idx = (int*)(ws + WS_S + 3 * U_BYTES);
    float* pl_gate = (float*)(ws + WS_S + 3 * U_BYTES + (size_t)NT * 128 * 4);
    unsigned* slist = (unsigned*)lds;
    unsigned* tlist = (unsigned*)(lds + 256 * 132 * 4);
    const int mtiles = layer ? NL / 128 : NT / 128;
    for (int u = blockIdx.x; u < mtiles * 8; u += gridDim.x) {
        const int mt = u >> 3, head = u & 7, m0 = mt * 128;
        ALoadPlain al{hp, 1024};
        EpiQTile ep{lds};
        gemm_unit<256>(lds, al, wqt + (size_t)head * 256 * 1024, 1024, m0, ep);
        __syncthreads();
        const int pp = wn >> 1, nk0 = (wn & 1) * 64;
        f32x4 sc[4][4];
#pragma unroll
        for (int mi = 0; mi < 4; ++mi)
#pragma unroll
            for (int ni = 0; ni < 4; ++ni) sc[mi][ni] = (f32x4){0.f, 0.f, 0.f, 0.f};
        const bf16_t* kb = keys + (size_t)(head * 2 + pp) * 16384;
#pragma unroll
        for (int ks = 0; ks < 4; ++ks) {
            bf16x8 af[4], bfr[4];
            const int ch = ks * 4 + fq;
#pragma unroll
            for (int mi = 0; mi < 4; ++mi) { const int m = wm * 64 + mi * 16 + fr; af[mi] = *(const bf16x8*)(lds + pp * 32768 + m * 256 + ((ch ^ (m & 15)) << 4)); }
#pragma unroll
            for (int ni = 0; ni < 4; ++ni) bfr[ni] = *(const bf16x8*)(kb + (size_t)(nk0 + ni * 16 + fr) * 128 + ks * 32 + fq * 8);
#pragma unroll
            for (int mi = 0; mi < 4; ++mi)
#pragma unroll
                for (int ni = 0; ni < 4; ++ni) sc[mi][ni] = __builtin_amdgcn_mfma_f32_16x16x32_bf16(bfr[ni], af[mi], sc[mi][ni], 0, 0, 0);
        }
        __syncthreads();
#pragma unroll
        for (int mi = 0; mi < 4; ++mi) {
            const int m = wm * 64 + mi * 16 + fr;
#pragma unroll
            for (int ni = 0; ni < 4; ++ni) {
                const int n = nk0 + ni * 16 + 4 * fq;
                uint4 o;
                o.x = (mono_u32(sc[mi][ni][0]) & ~127u) | (unsigned)(127 - (n + 0));
                o.y = (mono_u32(sc[mi][ni][1]) & ~127u) | (unsigned)(127 - (n + 1));
                o.z = (mono_u32(sc[mi][ni][2]) & ~127u) | (unsigned)(127 - (n + 2));
                o.w = (mono_u32(sc[mi][ni][3]) & ~127u) | (unsigned)(127 - (n + 3));
                *(uint4*)(slist + (size_t)(pp * 128 + m) * 132 + n) = o;
            }
        }
        __syncthreads();
#pragma unroll 1
        for (int ps = 0; ps < 4; ++ps) {
            const int L = ps * 64 + (tid >> 3), g8 = tid & 7;
            unsigned t[16];
            {
                const unsigned* srcp = slist + (size_t)L * 132 + g8 * 16;
#pragma unroll
                for (int i = 0; i < 4; ++i) { const uint4 v = *(const uint4*)(srcp + i * 4); t[4 * i] = v.x; t[4 * i + 1] = v.y; t[4 * i + 2] = v.z; t[4 * i + 3] = v.w; }
            }
#pragma unroll
            for (int k = 2; k <= 16; k <<= 1)
#pragma unroll
                for (int j = k >> 1; j > 0; j >>= 1)
#pragma unroll
                    for (int i = 0; i < 16; ++i) {
                        const int l = i ^ j;
                        if (l > i) {
                            const unsigned mx = max(t[i], t[l]), mn = min(t[i], t[l]);
                            if ((i & k) == 0) { t[i] = mx; t[l] = mn; } else { t[i] = mn; t[l] = mx; }
                        }
                    }
#pragma unroll
            for (int rnd = 0; rnd < 3; ++rnd) {
                unsigned c[16];
#pragma unroll
                for (int i = 0; i < 16; ++i) {
                    const int src_i = __float_as_int(__uint_as_float(t[15 - i]));
                    const int b = rnd == 0 ? __builtin_amdgcn_update_dpp(0, src_i, 0xB1, 0xF, 0xF, false)
                                : (rnd == 1 ? __builtin_amdgcn_update_dpp(0, src_i, 0x4E, 0xF, 0xF, false)
                                            : __builtin_amdgcn_update_dpp(0, src_i, 0x141, 0xF, 0xF, false));
                    c[i] = max(t[i], (unsigned)b);
                }
#pragma unroll
                for (int j = 8; j > 0; j >>= 1)
#pragma unroll
                    for (int i = 0; i < 16; ++i) {
                        const int l = i ^ j;
                        if (l > i) { const unsigned mx = max(c[i], c[l]), mn = min(c[i], c[l]); c[i] = mx; c[l] = mn; }
                    }
#pragma unroll
                for (int i = 0; i < 16; ++i) t[i] = c[i];
            }
            if (g8 == 0) {
#pragma unroll
                for (int i = 0; i < 4; ++i) *(uint4*)(tlist + L * 16 + i * 4) = make_uint4(t[4 * i], t[4 * i + 1], t[4 * i + 2], t[4 * i + 3]);
            }
        }
        __syncthreads();
        if (tid < 128) {
            float v0[16], v1[16];
#pragma unroll
            for (int i = 0; i < 16; ++i) { v0[i] = unmono_u32(tlist[tid * 16 + i] & ~127u); v1[i] = unmono_u32(tlist[(128 + tid) * 16 + i] & ~127u); }
            unsigned cd[16];
#pragma unroll
            for (int i = 0; i < 16; ++i) cd[i] = 0u;
#pragma unroll
            for (int i = 0; i < 16; ++i) {
#pragma unroll
                for (int j = 0; j < 16; ++j) {
                    if ((i + 1) * (j + 1) <= 16) {
                        unsigned x = (mono_u32(v0[i] + v1[j]) & ~255u) | (unsigned)(255 - (i * 16 + j));
#pragma unroll
                        for (int q = 0; q < 16; ++q) { const unsigned mx = max(cd[q], x); x = min(cd[q], x); cd[q] = mx; }
                    }
                }
            }
            float sv[16]; int ex[16];
#pragma unroll
            for (int q = 0; q < 16; ++q) {
                const int slot = 255 - (int)(cd[q] & 255u);
                const unsigned a = tlist[tid * 16 + (slot >> 4)], b2 = tlist[(128 + tid) * 16 + (slot & 15)];
                sv[q] = unmono_u32(a & ~127u) + unmono_u32(b2 & ~127u);
                ex[q] = (127 - (int)(a & 127u)) * 128 + (127 - (int)(b2 & 127u));
            }
            float mx = sv[0];
#pragma unroll
            for (int q = 1; q < 16; ++q) mx = fmaxf(mx, sv[q]);
            float den = 0.f;
#pragma unroll
            for (int q = 0; q < 16; ++q) { sv[q] = __expf(sv[q] - mx); den += sv[q]; }
            const float rden = 1.0f / den;
            const size_t base = ((size_t)head * NT + (m0 + tid)) * 16;
#pragma unroll
            for (int i = 0; i < 4; ++i) {
                *(int4*)(pl_idx + base + i * 4) = make_int4(ex[4 * i], ex[4 * i + 1], ex[4 * i + 2], ex[4 * i + 3]);
                *(float4*)(pl_gate + base + i * 4) = make_float4(sv[4 * i] * rden, sv[4 * i + 1] * rden, sv[4 * i + 2] * rden, sv[4 * i + 3] * rden);
            }
        }
        __syncthreads();
    }
}

typedef float f32x2 __attribute__((ext_vector_type(2)));
typedef unsigned int u32x4 __attribute__((ext_vector_type(4)));
DEV void phase_peer_gather(const Params& p, int layer, int fin) {
    const int tid = tid_opaque(), lane = tid & 63;
    const int gw = __builtin_amdgcn_readfirstlane(blockIdx.x * 8 + (tid >> 6)), nw = gridDim.x * 8;
    unsigned char* ws = p.ws;
    const bf16_t* hp = (const bf16_t*)(ws + WS_S + (size_t)(layer ? 0 : 1) * U_BYTES);
    const unsigned char* pu = ws + WS_PU + (size_t)layer * 16384 * 1024;
    const unsigned char* pvt = ws + WS_PV + (size_t)layer * 16384 * 1024;
    const unsigned lane16 = 16u * (unsigned)lane;
    const __amdgpu_buffer_rsrc_t rs_u = __builtin_amdgcn_make_buffer_rsrc((void*)pu, 0, 16384 * 1024, 0x00020000);
    const __amdgpu_buffer_rsrc_t rs_v = __builtin_amdgcn_make_buffer_rsrc((void*)pvt, 0, 16384 * 1024, 0x00020000);
    const float* usc = (const float*)(ws + WS_PSC) + layer * 16384;
    const float* vsc = (const float*)(ws + WS_PSC) + 32768 + layer * 16384;
    const int* pl_idx = (const int*)(ws + WS_S + 3 * U_BYTES);
    const float* pl_gate = (const float*)(ws + WS_S + 3 * U_BYTES + (size_t)NT * 128 * 4);
    float* ctxr = (float*)(ws + WS_CTXR);
    const float* mods = (const float*)(ws + WS_MOD) + (size_t)layer * 9 * 6144;
    const int nrows = layer ? NL : NT;
    uint4 bufA[16], bufB[16];
#define PG_LOAD(buf, tab, elo, ehi, g) { _Pragma("unroll") for (int e = 0; e < 16; ++e) { \
        const int ei = __builtin_amdgcn_readlane((g) < 4 ? (elo) : (ehi), ((g) * 16 + e) & 63); const u32x4 t4 = __builtin_amdgcn_raw_buffer_load_b128((tab), lane16, ei << 10, 0); buf[e] = make_uint4(t4.x, t4.y, t4.z, t4.w); } }
#define PG_DOT(buf, g) { _Pragma("unroll") for (int e = 0; e < 16; ++e) { \
        const unsigned uw[4] = {buf[e].x, buf[e].y, buf[e].z, buf[e].w}; f32x2 s2 = {0.f, 0.f}; \
        _Pragma("unroll") for (int i = 0; i < 4; ++i) { \
            const f32x2 a = __builtin_amdgcn_cvt_pk_f32_fp8((int)uw[i], false), b2 = __builtin_amdgcn_cvt_pk_f32_fp8((int)uw[i], true); \
            s2 += a * x2[2 * i] + b2 * x2[2 * i + 1]; } \
        const float s = wave_allreduce(s2.x + s2.y); \
        if (lane == (((g) * 16 + e) & 63)) { if ((g) < 4) d_lo = s; else d_hi = s; } } }
#define PG_AXPY(buf, g) { _Pragma("unroll") for (int e = 0; e < 16; ++e) { \
        const float cf = __int_as_float(__builtin_amdgcn_readlane(__float_as_int((g) < 4 ? c_lo : c_hi), ((g) * 16 + e) & 63)); \
        const f32x2 cf2 = {cf, cf}; const unsigned vw[4] = {buf[e].x, buf[e].y, buf[e].z, buf[e].w}; \
        _Pragma("unroll") for (int i = 0; i < 4; ++i) { \
            const f32x2 a = __builtin_amdgcn_cvt_pk_f32_fp8((int)vw[i], false), b2 = __builtin_amdgcn_cvt_pk_f32_fp8((int)vw[i], true); \
            acc2[2 * i] += cf2 * a; acc2[2 * i + 1] += cf2 * b2; } } }
    int R = gw;
    int e_lo = 0, e_hi = 0;
    const size_t pl_lo = (size_t)(lane >> 4) * NT * 16 + (lane & 15), pl_hi = pl_lo + (size_t)4 * NT * 16;
    if (R < nrows) { e_lo = pl_idx[pl_lo + (size_t)R * 16]; e_hi = pl_idx[pl_hi + (size_t)R * 16]; PG_LOAD(bufA, rs_u, e_lo, e_hi, 0); }
    for (; R < nrows; R += nw) {
        const bf16_t* hrow = hp + (size_t)R * 1024;
        f32x2 x2[8];
#pragma unroll
        for (int i = 0; i < 4; ++i) { const uint2 w = *(const uint2*)(hrow + 256 * i + 4 * lane); x2[2 * i] = (f32x2){bf_lo(w.x), bf_hi(w.x)}; x2[2 * i + 1] = (f32x2){bf_lo(w.y), bf_hi(w.y)}; }
        const float g_lo = pl_gate[pl_lo + (size_t)R * 16], g_hi = pl_gate[pl_hi + (size_t)R * 16];
        const float su_lo = usc[e_lo], su_hi = usc[e_hi], sv_lo = vsc[e_lo], sv_hi = vsc[e_hi];
        const int Rn = R + nw;
        int ne_lo = 0, ne_hi = 0;
        if (Rn < nrows) { ne_lo = pl_idx[pl_lo + (size_t)Rn * 16]; ne_hi = pl_idx[pl_hi + (size_t)Rn * 16]; }
        float d_lo = 0.f, d_hi = 0.f;
#pragma unroll 1
        for (int g = 0; g < 8; g += 2) {
            PG_LOAD(bufB, rs_u, e_lo, e_hi, g + 1);
            PG_DOT(bufA, g);
            if (g + 2 < 8) { PG_LOAD(bufA, rs_u, e_lo, e_hi, g + 2); } else { PG_LOAD(bufA, rs_v, e_lo, e_hi, 0); }
            PG_DOT(bufB, g + 1);
        }
        d_lo *= su_lo; d_hi *= su_hi;
        const float c_lo = g_lo * sv_lo * 0.5f * d_lo * (1.0f + erff(d_lo * 0.70710678118f));
        const float c_hi = g_hi * sv_hi * 0.5f * d_hi * (1.0f + erff(d_hi * 0.70710678118f));
        f32x2 acc2[8];
#pragma unroll
        for (int i = 0; i < 8; ++i) acc2[i] = (f32x2){0.f, 0.f};
#pragma unroll 1
        for (int g = 0; g < 8; g += 2) {
            PG_LOAD(bufB, rs_v, e_lo, e_hi, g + 1);
            PG_AXPY(bufA, g);
            if (g + 2 < 8) { PG_LOAD(bufA, rs_v, e_lo, e_hi, g + 2); } else if (Rn < nrows) { PG_LOAD(bufA, rs_u, ne_lo, ne_hi, 0); }
            PG_AXPY(bufB, g + 1);
        }
        e_lo = ne_lo; e_hi = ne_hi;
        float acc[16];
#pragma unroll
        for (int i = 0; i < 8; ++i) { acc[2 * i] = acc2[i].x; acc[2 * i + 1] = acc2[i].y; }
        float* xrow = R < NL ? p.out + (size_t)R * 1024 : ctxr + (size_t)(R - NL) * 1024;
        const float* mrow = mods + (size_t)mod_batch(R) * 6144;
        float xn[16]; float ss = 0.f;
#pragma unroll
        for (int i = 0; i < 4; ++i) {
            const int col = 256 * i + 4 * lane;
            const float4 xa = *(const float4*)(xrow + col), ga = *(const float4*)(mrow + 5 * 1024 + col);
            xn[4 * i] = xa.x + ga.x * acc[4 * i]; xn[4 * i + 1] = xa.y + ga.y * acc[4 * i + 1]; xn[4 * i + 2] = xa.z + ga.z * acc[4 * i + 2]; xn[4 * i + 3] = xa.w + ga.w * acc[4 * i + 3];
            ss += xn[4 * i] * xn[4 * i] + xn[4 * i + 1] * xn[4 * i + 1] + xn[4 * i + 2] * xn[4 * i + 2] + xn[4 * i + 3] * xn[4 * i + 3];
        }
        ss = wave_allreduce(ss);
        const float rs = rsqrtf(ss * (1.0f / 1024.0f) + 1e-6f);
        if (!fin) {
            const float* mrow1 = (const float*)(ws + WS_MOD) + (size_t)(layer + 1) * 9 * 6144 + (size_t)mod_batch(R) * 6144;
            const float* gn = p.in[6] + (layer + 1) * 1024;
            bf16_t* hdst = (bf16_t*)(ws + WS_S + 0 * U_BYTES) + (size_t)R * 1024;
#pragma unroll
            for (int i = 0; i < 4; ++i) {
                const int col = 256 * i + 4 * lane;
                *(float4*)(xrow + col) = make_float4(xn[4 * i], xn[4 * i + 1], xn[4 * i + 2], xn[4 * i + 3]);
                const float4 gg = *(const float4*)(gn + col), sh = *(const float4*)(mrow1 + col), sc = *(const float4*)(mrow1 + 1024 + col);
                const float y0 = xn[4 * i] * rs * gg.x * (1.f + sc.x) + sh.x, y1 = xn[4 * i + 1] * rs * gg.y * (1.f + sc.y) + sh.y;
                const float y2 = xn[4 * i + 2] * rs * gg.z * (1.f + sc.z) + sh.z, y3 = xn[4 * i + 3] * rs * gg.w * (1.f + sc.w) + sh.w;
                *(uint2*)(hdst + col) = make_uint2(pk_bf16(y0, y1), pk_bf16(y2, y3));
            }
        } else {
            const float* gn = p.in[34];
#pragma unroll
            for (int i = 0; i < 4; ++i) {
                const int col = 256 * i + 4 * lane;
                const float4 gg = *(const float4*)(gn + col);
                *(float4*)(xrow + col) = make_float4(xn[4 * i] * rs * gg.x, xn[4 * i + 1] * rs * gg.y, xn[4 * i + 2] * rs * gg.z, xn[4 * i + 3] * rs * gg.w);
            }
        }
    }
}

DEV void phase_gla_proj(const Params& p, unsigned char* lds) {
    unsigned char* ws = p.ws;
    const bf16_t* h = (const bf16_t*)(ws + WS_S + 0 * U_BYTES);
    const bf16_t* wint = (const bf16_t*)(ws + WS_WIN);
    {
        pg8::Gemm g{h, wint, NT, 3072, 1024};
        pg8::StaticOrder so; so.init(NT, 3072, gridDim.x, blockIdx.x);
        pg8::EpiBf16Tiles ep{(bf16_t*)(ws + WS_S + 1 * U_BYTES), 2048, 8, (bf16_t*)(ws + WS_S + 3 * U_BYTES), 1024};
        pg8::gemm_phase(( PG8_LAS unsigned char*)lds, g, so, ep, nullptr);
    }
    __syncthreads();
    for (int u = blockIdx.x; u < NT / 128; u += gridDim.x) {
        ALoadPlain al{h, 1024};
        EpiLr ep{(float*)(ws + WS_LR)};
        gemm_unit<128>(lds, al, wint + (size_t)3072 * 1024, 1024, u * 128, ep);
    }
}

DEV void conv_emit(const float (&acc)[8], int c, bf16_t* dst) {
    const float qs = (c < 512) ? 0.08838834764831845f : 1.0f;
    unsigned ow[4];
#pragma unroll
    for (int j = 0; j < 4; ++j) { const float a0 = acc[2 * j], a1 = acc[2 * j + 1]; ow[j] = pk_bf16(a0 * sigmoidf_(a0) * qs, a1 * sigmoidf_(a1) * qs); }
    *(uint4*)dst = make_uint4(ow[0], ow[1], ow[2], ow[3]);
}
DEV void conv_tap(float (&acc)[8], const uint4& v, const float (&w)[8]) {
    acc[0] += bf_lo(v.x) * w[0]; acc[1] += bf_hi(v.x) * w[1]; acc[2] += bf_lo(v.y) * w[2]; acc[3] += bf_hi(v.y) * w[3];
    acc[4] += bf_lo(v.z) * w[4]; acc[5] += bf_hi(v.z) * w[5]; acc[6] += bf_lo(v.w) * w[6]; acc[7] += bf_hi(v.w) * w[7];
}
DEV void phase_gla_conv(const Params& p) {
    const int tid = tid_opaque();
    unsigned char* ws = p.ws;
    const bf16_t* z = (const bf16_t*)(ws + WS_S + 1 * U_BYTES);
    bf16_t* o = (bf16_t*)(ws + WS_S + 4 * U_BYTES);
    const float* cw = p.in[25];
    const int x = tid >> 3, cl = (tid & 7) * 8;
    for (int task = blockIdx.x; task < 8 * 8 * 32; task += gridDim.x) {
        const int cb = task & 31, ys = (task >> 5) & 7, b = task >> 8;
        const int c = cb * 64 + cl;
        float w[9][8];
#pragma unroll
        for (int t = 0; t < 9; ++t) { const float4 w0 = *(const float4*)(cw + t * 2048 + c), w1 = *(const float4*)(cw + t * 2048 + c + 4); w[t][0] = w0.x; w[t][1] = w0.y; w[t][2] = w0.z; w[t][3] = w0.w; w[t][4] = w1.x; w[t][5] = w1.y; w[t][6] = w1.z; w[t][7] = w1.w; }
        const uint4 zero4 = make_uint4(0, 0, 0, 0);
        auto load_row = [&](int y, uint4 (&r)[3]) {
            if (y < 0 || y >= 128) { r[0] = zero4; r[1] = zero4; r[2] = zero4; return; }
            const bf16_t* row = z + ((size_t)b * 8192 + (size_t)y * 64 + x) * 2048 + c;
            r[1] = *(const uint4*)row;
            r[0] = (x > 0) ? *(const uint4*)(row - 2048) : zero4;
            r[2] = (x < 63) ? *(const uint4*)(row + 2048) : zero4;
        };
        uint4 r0[3], r1[3], r2[3], r3[3];
        const int y0 = ys * 16;
        load_row(y0 - 1, r0); load_row(y0, r1); load_row(y0 + 1, r2);
#pragma unroll 1
        for (int yy = 0; yy < 16; ++yy) {
            load_row(yy < 15 ? y0 + yy + 2 : -1, r3);
            float acc[8];
#pragma unroll
            for (int j = 0; j < 8; ++j) acc[j] = 0.f;
#pragma unroll
            for (int dx = 0; dx < 3; ++dx) { conv_tap(acc, r0[dx], w[dx]); conv_tap(acc, r1[dx], w[3 + dx]); conv_tap(acc, r2[dx], w[6 + dx]); }
            conv_emit(acc, c, o + ((size_t)b * 8192 + (size_t)(y0 + yy) * 64 + x) * 2048 + c);
#pragma unroll
            for (int dx = 0; dx < 3; ++dx) { r0[dx] = r1[dx]; r1[dx] = r2[dx]; r2[dx] = r3[dx]; }
        }
    }
    for (int task = blockIdx.x; task < (NC / 64) * 8; task += gridDim.x) {
        const int rb = task >> 3, cbk = task & 7;
        const int R = NL + rb * 64 + (tid >> 3);
        const int t = (R - NL) & 255;
#pragma unroll 1
        for (int i = 0; i < 4; ++i) {
            const int c = cbk * 256 + (tid & 7) * 8 + i * 64;
            float acc[8];
#pragma unroll
            for (int j = 0; j < 8; ++j) acc[j] = 0.f;
#pragma unroll
            for (int dx = -1; dx <= 1; ++dx) {
                if (t + dx >= 0 && t + dx < 256) {
                    const uint4 v = *(const uint4*)(z + (size_t)(R + dx) * 2048 + c);
                    const float* wp = cw + (3 + (dx + 1)) * 2048 + c;
                    const float4 w0 = *(const float4*)wp, w1 = *(const float4*)(wp + 4);
                    const float wv[8] = {w0.x, w0.y, w0.z, w0.w, w1.x, w1.y, w1.z, w1.w};
                    conv_tap(acc, v, wv);
                }
            }
            conv_emit(acc, c, o + (size_t)R * 2048 + c);
        }
    }
}

constexpr int GT_QE = 0, GT_KET = 16384, GT_A = 32768, GT_CONST = 40960, GT_STRIDE = 43008;
constexpr int GT_N0 = (int)((2 * U_BYTES) / GT_STRIDE);
constexpr size_t WS_TOTAL = 1073741824ull;
static_assert((size_t)(NB * 4 * 2 * 132 - GT_N0) * GT_STRIDE <= WS_TOTAL - WS_END, "tile records do not fit");
DEV size_t gla_tile_off(int b, int hd, int d, int cc) {
    const int idx = (((b * 4 + hd) * 2 + d) * 132) + cc;
    return idx < GT_N0 ? WS_S + (size_t)idx * GT_STRIDE : WS_END + (size_t)(idx - GT_N0) * GT_STRIDE;
}
DEV int gla_row0(int b, int cc) { return cc < 4 ? NL + b * 256 + cc * 64 : b * 8192 + (cc - 4) * 64; }
DEV void phase_gla_prep(const Params& p, unsigned char* lds) {
    const int tid = tid_opaque(), lane = tid & 63, wv = tid >> 6;
    const int fr = lane & 15, fq = lane >> 4;
    unsigned char* ws = p.ws;
    constexpr int QE = 0, KE = 16384, KET = 32768, BC = 49152  , GS = 82944  , LRL = 86528  , BCS = 132;
    const bf16_t* qkv = (const bf16_t*)(ws + WS_S + 4 * U_BYTES);
    const float* lrb = (const float*)(ws + WS_LR);
    unsigned char* gt = ws;
    float* bc = (float*)(lds + BC);
    float* gs = (float*)(lds + GS);
    const int li = tid >> 3, lc = tid & 7;
    const int d = blockIdx.x & 1, hd = (blockIdx.x >> 1) & 3;
    bf16x8 gkf;
    {
        unsigned w4[4] = {0u, 0u, 0u, 0u};
        if (fq < 2) {
#pragma unroll
            for (int e2 = 0; e2 < 4; ++e2) {
                const float g0 = p.in[26][(size_t)(d * 16 + 8 * fq + 2 * e2) * 512 + hd * 128 + wv * 16 + fr];
                const float g1 = p.in[26][(size_t)(d * 16 + 8 * fq + 2 * e2 + 1) * 512 + hd * 128 + wv * 16 + fr];
                w4[e2] = pk_bf16(g0, g1);
            }
        }
        gkf = as_bf16x8(make_uint4(w4[0], w4[1], w4[2], w4[3]));
    }
    const float4 gb4 = *(const float4*)(p.in[27] + d * 512 + hd * 128 + wv * 16 + 4 * fq);
    const int qstep = (int)(gridDim.x >> 3);
    uint4 nq0, nq1, nk0, nk1; float2 nl;
    auto fetch = [&](int q) {
        const size_t R = (size_t)(gla_row0(q / 132, q % 132) + li);
        const bf16_t* row = qkv + R * 2048;
        nq0 = *(const uint4*)(row + hd * 128 + lc * 8); nq1 = *(const uint4*)(row + hd * 128 + 64 + lc * 8);
        nk0 = *(const uint4*)(row + 512 + hd * 128 + lc * 8); nk1 = *(const uint4*)(row + 512 + hd * 128 + 64 + lc * 8);
        nl = *(const float2*)(lrb + R * 32 + d * 16 + lc * 2);
    };
    int q = (int)(blockIdx.x >> 3);
    if (q < NB * 132) fetch(q);
    for (; q < NB * 132; q += qstep) {
        const int cc = q % 132, b = q / 132;
        unsigned char* rec = gt + gla_tile_off(b, hd, d, cc);
        const uint4 rq0 = nq0, rq1 = nq1, rk0 = nk0, rk1 = nk1; const float2 rl = nl;
        if (q + qstep < NB * 132) fetch(q + qstep);
        *(unsigned*)(lds + LRL + li * 32 + lc * 4) = pk_bf16(rl.x, rl.y);
        __syncthreads();
        {
            const float gbv[4] = {gb4.x, gb4.y, gb4.z, gb4.w};
#pragma unroll
            for (int itl = 0; itl < 4; ++itl) {
                uint4 lr4 = *(const uint4*)(lds + LRL + (itl * 16 + fr) * 32 + (fq & 1) * 16);
                if (fq >= 2) lr4 = make_uint4(0, 0, 0, 0);
                f32x4 a = {0.f, 0.f, 0.f, 0.f};
                a = __builtin_amdgcn_mfma_f32_16x16x32_bf16(gkf, as_bf16x8(lr4), a, 0, 0, 0);
                float s[4], tot[4];
#pragma unroll
                for (int j = 0; j < 4; ++j) {
                    const float xx = a[j] + gbv[j];
                    const float la = (fminf(xx, 0.f) - __logf(1.0f + __expf(-fabsf(xx)))) * (1.0f / 16.0f);
                    float pf = la;
                    pf += dpp_shr0<1>(pf); pf += dpp_shr0<2>(pf); pf += dpp_shr0<4>(pf); pf += dpp_shr0<8>(pf);
                    tot[j] = __shfl(pf, (lane & 48) | 15);
                    s[j] = d ? (tot[j] - pf + la) : pf;
                }
                *(float4*)(bc + (itl * 16 + fr) * BCS + wv * 16 + 4 * fq) = make_float4(s[0], s[1], s[2], s[3]);
                if (fr == 15) *(float4*)(gs + itl * 128 + wv * 16 + 4 * fq) = make_float4(tot[0], tot[1], tot[2], tot[3]);
            }
        }
        __syncthreads();
        if (tid < 128) {
            const float g0 = gs[tid], g1 = gs[128 + tid], g2 = gs[256 + tid], g3 = gs[384 + tid];
            const float refc = d ? (bc[31 * BCS + tid] + g2 + g3) : (bc[32 * BCS + tid] + g0 + g1), lastc = g0 + g1 + g2 + g3;
            const float dl = __expf(lastc), er = __expf(refc), el = __expf(lastc - refc);
            gs[512 + tid] = refc;
            float* cst = (float*)(rec + GT_CONST);
            cst[tid] = er; cst[128 + tid] = el; cst[256 + tid] = dl;
        }
        __syncthreads();
        {
            const int grp = li >> 4;
            const uint4 rqs[2] = {rq0, rq1}, rks[2] = {rk0, rk1};
#pragma unroll
            for (int hseg = 0; hseg < 2; ++hseg) {
                const int k0 = hseg * 64 + lc * 8;
                float bcv[8], refv[8];
#pragma unroll
                for (int j4 = 0; j4 < 2; ++j4) {
                    const float4 g0 = *(const float4*)(gs + k0 + j4 * 4), g1 = *(const float4*)(gs + 128 + k0 + j4 * 4);
                    const float4 g2 = *(const float4*)(gs + 256 + k0 + j4 * 4), g3 = *(const float4*)(gs + 384 + k0 + j4 * 4);
                    const float4 bi = *(const float4*)(bc + li * BCS + k0 + j4 * 4), rf = *(const float4*)(gs + 512 + k0 + j4 * 4);
                    const float g0a[4] = {g0.x, g0.y, g0.z, g0.w}, g1a[4] = {g1.x, g1.y, g1.z, g1.w}, g2a[4] = {g2.x, g2.y, g2.z, g2.w}, g3a[4] = {g3.x, g3.y, g3.z, g3.w};
                    const float bia[4] = {bi.x, bi.y, bi.z, bi.w}, rfa[4] = {rf.x, rf.y, rf.z, rf.w};
#pragma unroll
                    for (int j = 0; j < 4; ++j) {
                        const float pre = d ? ((grp < 1 ? g1a[j] : 0.f) + (grp < 2 ? g2a[j] : 0.f) + (grp < 3 ? g3a[j] : 0.f))
                                            : ((grp > 0 ? g0a[j] : 0.f) + (grp > 1 ? g1a[j] : 0.f) + (grp > 2 ? g2a[j] : 0.f));
                        bcv[j4 * 4 + j] = bia[j] + pre;
                        refv[j4 * 4 + j] = rfa[j];
                    }
                }
                const unsigned qw[4] = {rqs[hseg].x, rqs[hseg].y, rqs[hseg].z, rqs[hseg].w}, kw[4] = {rks[hseg].x, rks[hseg].y, rks[hseg].z, rks[hseg].w};
                unsigned oqe[4], oke[4];
#pragma unroll
                for (int j2 = 0; j2 < 4; ++j2) {
                    const float q0 = bf_lo(qw[j2]), q1 = bf_hi(qw[j2]), kk0 = bf_lo(kw[j2]), kk1 = bf_hi(kw[j2]);
                    const float e0 = __expf(bcv[2 * j2] - refv[2 * j2]), e1 = __expf(bcv[2 * j2 + 1] - refv[2 * j2 + 1]);
                    const float r0 = __builtin_amdgcn_rcpf(e0), r1 = __builtin_amdgcn_rcpf(e1);
                    oqe[j2] = pk_bf16(q0 * e0, q1 * e1);
                    oke[j2] = pk_bf16(kk0 * r0, kk1 * r1);
                    const int kc0 = k0 + 2 * j2;
                    *(bf16_t*)(lds + KET + tile_off2(kc0, li >> 3) + (li & 7) * 2) = (bf16_t)(oke[j2] & 0xffffu);
                    *(bf16_t*)(lds + KET + tile_off2(kc0 + 1, li >> 3) + (li & 7) * 2) = (bf16_t)(oke[j2] >> 16);
                }
                const int chq = hseg * 8 + lc;
                const int so = li * 256 + ((chq ^ (li & 15)) << 4);
                *(uint4*)(lds + QE + so) = make_uint4(oqe[0], oqe[1], oqe[2], oqe[3]);
                *(uint4*)(lds + KE + so) = make_uint4(oke[0], oke[1], oke[2], oke[3]);
                *(uint4*)(rec + GT_QE + so) = make_uint4(oqe[0], oqe[1], oqe[2], oqe[3]);
            }
        }
        __syncthreads();
        {
            const int it = wv & 3, pr2 = wv >> 2;
#pragma unroll
            for (int jj = 0; jj < 2; ++jj) {
                const int jt = pr2 * 2 + jj;
                f32x4 a = {0.f, 0.f, 0.f, 0.f};
                if (d ? (jt >= it) : (jt <= it)) {
#pragma unroll
                    for (int ks = 0; ks < 4; ++ks) {
                        const int ch = ks * 4 + fq;
                        const int rj = jt * 16 + fr, ri = it * 16 + fr;
                        const bf16x8 fa = *(const bf16x8*)(lds + KE + rj * 256 + ((ch ^ (rj & 15)) << 4));
                        const bf16x8 fb = *(const bf16x8*)(lds + QE + ri * 256 + ((ch ^ (ri & 15)) << 4));
                        a = __builtin_amdgcn_mfma_f32_16x16x32_bf16(fa, fb, a, 0, 0, 0);
                    }
                }
                const int i = it * 16 + fr, j = jt * 16 + 4 * fq;
                float av[4];
#pragma unroll
                for (int e = 0; e < 4; ++e) av[e] = (d ? (j + e >= i) : (j + e <= i)) ? a[e] : 0.f;
                *(uint2*)(rec + GT_A + i * 128 + (((j >> 3) ^ (i & 7)) << 4) + (j & 7) * 2) = make_uint2(pk_bf16(av[0], av[1]), pk_bf16(av[2], av[3]));
            }
#pragma unroll
            for (int i = 0; i < 2; ++i) *(uint4*)(rec + GT_KET + i * 8192 + tid * 16) = *(const uint4*)(lds + KET + i * 8192 + tid * 16);
        }
        __syncthreads();
    }
}

DEV void phase_gla_scan(const Params& p, unsigned char* lds) {
    const int tid = tid_opaque(), lane = tid & 63, wv = tid >> 6;
    const int fr = lane & 15, fq = lane >> 4;
    unsigned char* ws = p.ws;
    constexpr int QE = 0  , KET = 32768  , AL = 65536  , VT = 81920, ST = 90112  ;
    const bf16_t* qkv = (const bf16_t*)(ws + WS_S + 4 * U_BYTES);
    const unsigned char* gt = ws;
    for (int unit = blockIdx.x; unit < 256; unit += gridDim.x) {
        const int vs = unit & 3, d = (unit >> 2) & 1, hd = (unit >> 3) & 3, b = unit >> 5;
        bf16_t* odst = d ? (bf16_t*)(ws + WS_S + 2 * U_BYTES) : (bf16_t*)(ws + WS_S + 4 * U_BYTES);
        const int old_ = d ? 1024 : 2048;
        const int li = tid >> 3, lc = tid & 7;
        auto ccof = [&](int c) -> int { return d ? (c < 4 ? 3 - c : 135 - c) : c; };
        auto dma = [&](int cc, int buf) {
            const unsigned char* rec = gt + gla_tile_off(b, hd, d, cc);
#pragma unroll
            for (int i = 0; i < 2; ++i) {
                __builtin_amdgcn_global_load_lds((const unsigned*)(rec + GT_QE + i * 8192 + tid * 16), (unsigned*)(lds + QE + buf * 16384 + i * 8192 + tid * 16), 16, 0, 0);
                __builtin_amdgcn_global_load_lds((const unsigned*)(rec + GT_KET + i * 8192 + tid * 16), (unsigned*)(lds + KET + buf * 16384 + i * 8192 + tid * 16), 16, 0, 0);
            }
            __builtin_amdgcn_global_load_lds((const unsigned*)(rec + GT_A + tid * 16), (unsigned*)(lds + AL + buf * 8192 + tid * 16), 16, 0, 0);
        };
        uint4 nv; float4 n_dl, n_el, n_er;
        auto loads = [&](int c) {
            const int cc = ccof(c);
            nv = *(const uint4*)(qkv + (size_t)(gla_row0(b, cc) + li) * 2048 + 1024 + hd * 256 + vs * 64 + lc * 8);
            const float* cst = (const float*)(gt + gla_tile_off(b, hd, d, cc) + GT_CONST);
            n_el = *(const float4*)(cst + 128 + wv * 16 + 4 * fq); n_dl = *(const float4*)(cst + 256 + wv * 16 + 4 * fq);
            if (c + 1 < 132) n_er = *(const float4*)((const float*)(gt + gla_tile_off(b, hd, d, ccof(c + 1)) + GT_CONST) + wv * 16 + 4 * fq);
            else n_er = make_float4(0.f, 0.f, 0.f, 0.f);
        };
        f32x4 accS[4];
#pragma unroll
        for (int i = 0; i < 4; ++i) accS[i] = (f32x4){0.f, 0.f, 0.f, 0.f};
        for (int i = tid; i < 32768 / 16; i += NTHREADS) *(uint4*)(lds + ST + i * 16) = make_uint4(0, 0, 0, 0);
        dma(ccof(0), 0);
        loads(0);
        for (int c = 0; c < 132; ++c) {
            const int buf = c & 1, cc = ccof(c);
            const uint4 rv = nv; const float4 dl4 = n_dl, el4 = n_el, er4 = n_er;
            asm volatile("s_waitcnt vmcnt(0)" ::: "memory");
            {
                const unsigned vw[4] = {rv.x, rv.y, rv.z, rv.w};
#pragma unroll
                for (int j2 = 0; j2 < 4; ++j2) {
                    const int vc0 = lc * 8 + 2 * j2;
                    *(bf16_t*)(lds + VT + tile_off2(vc0, li >> 3) + (li & 7) * 2) = (bf16_t)(vw[j2] & 0xffffu);
                    *(bf16_t*)(lds + VT + tile_off2(vc0 + 1, li >> 3) + (li & 7) * 2) = (bf16_t)(vw[j2] >> 16);
                }
            }
            asm volatile("s_waitcnt lgkmcnt(0)" ::: "memory"); __builtin_amdgcn_s_barrier(); asm volatile("" ::: "memory");
            if (c + 1 < 132) { dma(ccof(c + 1), buf ^ 1); loads(c + 1); }
            const int it = wv & 3, pr2 = wv >> 2;
            const int r0 = gla_row0(b, cc);
#pragma unroll
            for (int vv = 0; vv < 2; ++vv) {
                const int vt = pr2 * 2 + vv;
                f32x4 a = {0.f, 0.f, 0.f, 0.f};
#pragma unroll
                for (int ks = 0; ks < 4; ++ks) {
                    const int ch = ks * 4 + fq;
                    const int rvv = vt * 16 + fr, ri = it * 16 + fr;
                    const bf16x8 fa = *(const bf16x8*)(lds + ST + buf * 16384 + rvv * 256 + ((ch ^ (rvv & 15)) << 4));
                    const bf16x8 fb = *(const bf16x8*)(lds + QE + buf * 16384 + ri * 256 + ((ch ^ (ri & 15)) << 4));
                    a = __builtin_amdgcn_mfma_f32_16x16x32_bf16(fa, fb, a, 0, 0, 0);
                }
#pragma unroll
                for (int ks = 0; ks < 2; ++ks) {
                    const int ch = ks * 4 + fq;
                    const int rvv = vt * 16 + fr, ri = it * 16 + fr;
                    const bf16x8 fa = *(const bf16x8*)(lds + VT + tile_off2(rvv, ch));
                    const bf16x8 fb = *(const bf16x8*)(lds + AL + buf * 8192 + ri * 128 + ((ch ^ (ri & 7)) << 4));
                    a = __builtin_amdgcn_mfma_f32_16x16x32_bf16(fa, fb, a, 0, 0, 0);
                }
                const int i = it * 16 + fr, vcol = vt * 16 + 4 * fq;
                *(uint2*)(odst + (size_t)(r0 + i) * old_ + hd * 256 + vs * 64 + vcol) = make_uint2(pk_bf16(a[0], a[1]), pk_bf16(a[2], a[3]));
            }
            {
                const int kt = wv;
                bf16x8 fa[2];
#pragma unroll
                for (int ks = 0; ks < 2; ++ks) fa[ks] = *(const bf16x8*)(lds + KET + buf * 16384 + tile_off2(kt * 16 + fr, ks * 4 + fq));
#pragma unroll
                for (int vt = 0; vt < 4; ++vt) {
                    f32x4 t = {0.f, 0.f, 0.f, 0.f};
#pragma unroll
                    for (int ks = 0; ks < 2; ++ks) t = __builtin_amdgcn_mfma_f32_16x16x32_bf16(fa[ks], *(const bf16x8*)(lds + VT + tile_off2(vt * 16 + fr, ks * 4 + fq)), t, 0, 0, 0);
                    f32x4 a = accS[vt];
                    a[0] = a[0] * dl4.x + t[0] * el4.x; a[1] = a[1] * dl4.y + t[1] * el4.y; a[2] = a[2] * dl4.z + t[2] * el4.z; a[3] = a[3] * dl4.w + t[3] * el4.w;
                    accS[vt] = a;
                    const int vcol = vt * 16 + fr, kcol = kt * 16 + 4 * fq;
                    *(uint2*)(lds + ST + (buf ^ 1) * 16384 + vcol * 256 + (((kcol >> 3) ^ (vcol & 15)) << 4) + (kcol & 7) * 2) =
                        make_uint2(pk_bf16(a[0] * er4.x, a[1] * er4.y), pk_bf16(a[2] * er4.z, a[3] * er4.w));
                }
            }
            asm volatile("s_waitcnt lgkmcnt(0)" ::: "memory"); __builtin_amdgcn_s_barrier(); asm volatile("" ::: "memory");
        }
        asm volatile("s_waitcnt vmcnt(0)" ::: "memory");
        __syncthreads();
    }
}

DEV void phase_gla_readout(const Params& p) {
    const int tid = tid_opaque(), lane = tid & 63;
    const int gw = blockIdx.x * 8 + (tid >> 6), nw = gridDim.x * 8;
    unsigned char* ws = p.ws;
    const bf16_t* o0 = (const bf16_t*)(ws + WS_S + 4 * U_BYTES);
    const bf16_t* o1 = (const bf16_t*)(ws + WS_S + 2 * U_BYTES);
    const bf16_t* gb = (const bf16_t*)(ws + WS_S + 3 * U_BYTES);
    bf16_t* ao = (bf16_t*)(ws + WS_S + 0 * U_BYTES);
    const float4 hn = *(const float4*)(p.in[28] + lane * 4);
    for (int item = gw; item < NL * 4; item += nw) {
        const size_t off = (size_t)(item >> 2) * 1024 + (item & 3) * 256 + lane * 4;
        const uint2 a = *(const uint2*)(o0 + off + (size_t)(item >> 2) * 1024), b2 = *(const uint2*)(o1 + off), g2 = *(const uint2*)(gb + off);
        const float v0 = bf_lo(a.x) + bf_lo(b2.x), v1 = bf_hi(a.x) + bf_hi(b2.x), v2 = bf_lo(a.y) + bf_lo(b2.y), v3 = bf_hi(a.y) + bf_hi(b2.y);
        float ss = v0 * v0 + v1 * v1 + v2 * v2 + v3 * v3;
        ss = wave_allreduce(ss);
        const float rs = rsqrtf(ss * (1.0f / 256.0f) + 1e-6f);
        const float g0 = bf_lo(g2.x), g1 = bf_hi(g2.x), g2f = bf_lo(g2.y), g3 = bf_hi(g2.y);
        const float r0 = v0 * rs * hn.x * (g0 * sigmoidf_(g0)), r1 = v1 * rs * hn.y * (g1 * sigmoidf_(g1));
        const float r2 = v2 * rs * hn.z * (g2f * sigmoidf_(g2f)), r3 = v3 * rs * hn.w * (g3 * sigmoidf_(g3));
        *(uint2*)(ao + off) = make_uint2(pk_bf16(r0, r1), pk_bf16(r2, r3));
    }
}


#define XB_TMO      128
#define XB_XCNT(j)  (256  + 64 * (j))
#define XB_XSUB(j)  (1280 + 64 * (j))
#define XB_XGEN(j)  (2304 + 64 * (j))
#define XB_TOP      3328
#define XB_TOPGEN   3392
#define XB_SPIN_CAP (1u << 22)
DEV unsigned xb_ld(unsigned* p) { return __hip_atomic_load(p, __ATOMIC_RELAXED, __HIP_MEMORY_SCOPE_AGENT); }
DEV unsigned xb_add(unsigned* p, unsigned v) { return __hip_atomic_fetch_add(p, v, __ATOMIC_RELAXED, __HIP_MEMORY_SCOPE_AGENT); }
DEV unsigned xb_xcc_id() { return (unsigned)__builtin_amdgcn_s_getreg((3 << 11) | 20) & 0xFu; }
#define XB_SPIN(cond, bar) do { unsigned _sp = 0; while (cond) { __builtin_amdgcn_s_sleep(1); \
    if ((++_sp & 255u) == 0u) { if (xb_ld(&(bar)[XB_TMO])) break; if (_sp > XB_SPIN_CAP) { atomicAdd(&(bar)[XB_TMO], 1u); break; } } } } while (0)
DEV void xcd_barrier_complete(unsigned* bar, unsigned x, unsigned& nloc, unsigned& nx) {
    const unsigned G = gridDim.x;
    unsigned sum, cnt, mine, sp = 0u;
    for (;;) {
        sum = 0u; cnt = 0u; mine = 0u;
#pragma unroll
        for (unsigned j = 0; j < 16; ++j) { const unsigned c = xb_ld(&bar[XB_XCNT(j)]); sum += c; cnt += (c > 0u) ? 1u : 0u; mine = (j == x) ? c : mine; }
        if (sum == G) break;
        __builtin_amdgcn_s_sleep(1);
        if ((++sp & 255u) == 0u) { if (xb_ld(&bar[XB_TMO])) break; if (sp > XB_SPIN_CAP) { atomicAdd(&bar[XB_TMO], 1u); break; } }
    }
    nloc = mine > 0u ? mine : 1u; nx = cnt > 0u ? cnt : 1u;
}
DEV void xcd_barrier(unsigned* bar, volatile LAS3 unsigned* st) {
    asm volatile("s_waitcnt vmcnt(0)" ::: "memory");
    __syncthreads();
    if (tid_opaque() == 0) {
        const unsigned x = xb_xcc_id();
        __builtin_amdgcn_s_waitcnt(0);
        unsigned nloc = st[0], nx = st[1];
        if (nloc == 0u) { xcd_barrier_complete(bar, x, nloc, nx); st[0] = nloc; st[1] = nx; }
        const unsigned old = xb_add(&bar[XB_XSUB(x)], 1u);
        const unsigned gen = old / nloc;
        if (old + 1u == (gen + 1u) * nloc) {
            __builtin_amdgcn_fence(__ATOMIC_RELEASE, "agent");
            asm volatile("s_waitcnt vmcnt(0)" ::: "memory");
            const unsigned og = xb_add(&bar[XB_TOP], 1u);
            const unsigned tg = og / nx;
            if (og + 1u == (tg + 1u) * nx) xb_add(&bar[XB_TOPGEN], 1u);
            else XB_SPIN(xb_ld(&bar[XB_TOPGEN]) == tg, bar);
            __builtin_amdgcn_fence(__ATOMIC_ACQUIRE, "agent");
            xb_add(&bar[XB_XGEN(x)], 1u);
            asm volatile("s_waitcnt vmcnt(0)" ::: "memory");
        } else {
            XB_SPIN(xb_ld(&bar[XB_XGEN(x)]) == gen, bar);
            __builtin_amdgcn_fence(__ATOMIC_ACQUIRE, "agent");
            asm volatile("s_waitcnt vmcnt(0)" ::: "memory");
        }
    }
    __syncthreads();
}
#define SYNC() do { asm volatile("s_waitcnt vmcnt(0)" ::: "memory"); grid.sync(); \
    if (tid_opaque() == 0) { __builtin_amdgcn_fence(__ATOMIC_ACQUIRE, "agent"); asm volatile("s_waitcnt vmcnt(0)" ::: "memory"); } \
    __syncthreads(); } while (0)
__global__ void __launch_bounds__(NTHREADS) mega_fwd(Params p) {
    unsigned char* const lds = g_lds;
    cg::grid_group grid = cg::this_grid();
#define XBAR ((unsigned*)(p.ws + WS_BAR))
#define XST ((volatile LAS3 unsigned*)(lds + LDS_BYTES - 16))
    if ((threadIdx.x & 63) == 0) g_lds[LDS_WTAB + hw_wave_slot()] = (unsigned char)(threadIdx.x >> 6);
    if (threadIdx.x == 0) { XST[0] = 0u; XST[1] = 0u; (void)xb_add(&XBAR[XB_XCNT(xb_xcc_id())], 1u); }
    __syncthreads();
#define S0 ((bf16_t*)(p.ws + WS_S + 0 * U_BYTES))
#define SLOT(i) ((bf16_t*)(p.ws + WS_S + (size_t)(i) * U_BYTES))
#define S1 ((bf16_t*)(p.ws + WS_S + 1 * U_BYTES))
#define CTXR ((const float*)(p.ws + WS_CTXR))
    phase0(p, lds); SYNC();
#undef SYNC
#define SYNC() xcd_barrier(XBAR, XST)
    phase_normmix(p, S0, SLOT(5), SLOT(1), SLOT(2)); SYNC();
    phase_rw_proj1(p, lds, 0, SLOT(5), SLOT(3)); SYNC();
    phase_rw_proj1(p, lds, 1, SLOT(1), SLOT(5)); SYNC();
    phase_rw_proj1(p, lds, 2, SLOT(2), SLOT(1)); phase_rw_lora(p, lds); SYNC();
    REPEAT(3, phase_rw_scan(p, lds));
    phase_rw_scan(p, lds); SYNC();
    REPEAT(4, phase_rw_readout(p));
    phase_rw_readout(p); SYNC();
    REPEAT(5, phase_wo(p, lds, 0));
    phase_wo(p, lds, 0); SYNC();
    REPEAT(6, phase_normmod(p, 0, 1, p.out, CTXR, NT, S1));
    phase_normmod(p, 0, 1, p.out, CTXR, NT, S1); SYNC();
    REPEAT(7, phase_peer_select(p, lds, 0));
    phase_peer_select(p, lds, 0); SYNC();
    phase_peer_gather(p, 0, 0); SYNC();
    REPEAT(9, phase_gla_proj(p, lds));
    phase_gla_proj(p, lds); SYNC();
    REPEAT(10, phase_gla_conv(p));
    phase_gla_conv(p); SYNC();
    REPEAT(18, phase_gla_prep(p, lds));
    phase_gla_prep(p, lds); SYNC();
    REPEAT(11, phase_gla_scan(p, lds));
    phase_gla_scan(p, lds); SYNC();
    REPEAT(12, phase_gla_readout(p));
    phase_gla_readout(p); SYNC();
    phase_wo(p, lds, 1); SYNC();
    REPEAT(14, phase_normmod(p, 1, 1, p.out, CTXR, NL, S0));
    phase_normmod(p, 1, 1, p.out, CTXR, NL, S0); SYNC();
    REPEAT(15, phase_peer_select(p, lds, 1));
    phase_peer_select(p, lds, 1); SYNC();
    phase_peer_gather(p, 1, 1);
}

extern "C" void kernel_launch(void* const* d_in, const int* in_sizes, int n_in, void* d_out, int out_size, void* d_ws, size_t ws_size, hipStream_t stream) {
    static int grid_blocks = 0;
    if (grid_blocks == 0) {
        if (n_in != 35 || ws_size < WS_TOTAL) { fprintf(stderr, "kernel_launch: unexpected n_in %d or ws_size %zu (< %zu)\n", n_in, ws_size, (size_t)WS_END); grid_blocks = -1; return; }
        int dev = 0, cus = 0, per_cu = 0;
        if (hipGetDevice(&dev) != hipSuccess || hipDeviceGetAttribute(&cus, hipDeviceAttributeMultiprocessorCount, dev) != hipSuccess) { fprintf(stderr, "kernel_launch: device query failed\n"); grid_blocks = -1; return; }
        if (hipFuncSetAttribute((const void*)mega_fwd, hipFuncAttributeMaxDynamicSharedMemorySize, LDS_BYTES) != hipSuccess) { fprintf(stderr, "kernel_launch: hipFuncSetAttribute failed\n"); grid_blocks = -1; return; }
        if (hipOccupancyMaxActiveBlocksPerMultiprocessor(&per_cu, (const void*)mega_fwd, NTHREADS, LDS_BYTES) != hipSuccess || per_cu < 1) { fprintf(stderr, "kernel_launch: occupancy query says %d blocks per CU\n", per_cu); grid_blocks = -1; return; }
        grid_blocks = cus;
    }
    if (grid_blocks < 0) return;
    Params p{};
    for (int i = 0; i < 35; ++i) p.in[i] = (const float*)d_in[i];
    p.out = (float*)d_out;
    p.ws = (unsigned char*)d_ws;
    if (hipMemsetAsync((char*)d_ws + WS_BAR, 0, 16384, stream) != hipSuccess) { fprintf(stderr, "kernel_launch: hipMemsetAsync failed\n"); return; }
    void* args[] = {&p};
    hipError_t e = hipLaunchCooperativeKernel((const void*)mega_fwd, dim3(grid_blocks), dim3(NTHREADS), args, LDS_BYTES, stream);
    if (e != hipSuccess) fprintf(stderr, "kernel_launch: cooperative launch failed: %s (grid %d)\n", hipGetErrorString(e), grid_blocks);
}
```

```cpp
#include <hip/hip_runtime.h>
#include <hip/hip_cooperative_groups.h>
#include <cstdio>
#include <cstdint>
namespace cg = cooperative_groups;

#define DEV __device__ __forceinline__
#ifndef REP
#define REP 0
#endif
#define GREPS(n) ((REP == (n)) ? 2 : 1)
#define REPEAT(n, stmt) do { if (REP == (n)) { stmt; SYNC(); } } while (0)

typedef unsigned short bf16_t;
typedef short bf16x8 __attribute__((ext_vector_type(8)));
typedef float f32x4 __attribute__((ext_vector_type(4)));
typedef __bf16 bf16x2v __attribute__((ext_vector_type(2)));

constexpr int D = 1024;
constexpr int NB = 8, SEQ = 8192, CTXL = 256;
constexpr int NL = NB * SEQ, NC = NB * CTXL, NT = NL + NC;
constexpr int NTHREADS = 512;
constexpr int LDS_BYTES = 160 * 1024;

constexpr size_t U_BYTES = (size_t)NT * 1024 * 2;
constexpr size_t WS_BAR = 0;
constexpr size_t WS_MOD = 16384;
constexpr size_t WS_CTXR = WS_MOD + (size_t)2 * 9 * 6144 * 4;
constexpr size_t WS_LR = WS_CTXR + (size_t)NC * 1024 * 4;
constexpr size_t WS_BONUS = WS_LR + (size_t)NT * 32 * 4;
constexpr size_t WS_WPROJ = WS_BONUS + (size_t)2 * NT * 16 * 4;
constexpr size_t WS_W2T = WS_WPROJ + (size_t)3456 * 1024 * 2;
constexpr size_t WS_A2T = WS_W2T + (size_t)2 * 1024 * 64 * 2;
constexpr size_t WS_G2T = WS_A2T + (size_t)2 * 1024 * 64 * 2;
constexpr size_t WS_WO0 = WS_G2T + (size_t)1024 * 128 * 2;
constexpr size_t WS_WO1 = WS_WO0 + (size_t)1024 * 1024 * 2;
constexpr size_t WS_WQ = WS_WO1 + (size_t)1024 * 1024 * 2;
constexpr size_t WS_KEYS = WS_WQ + (size_t)2 * 2048 * 1024 * 2;
constexpr size_t WS_WIN = WS_KEYS + (size_t)2 * 8 * 2 * 128 * 128 * 2;
constexpr size_t WS_PU = WS_WIN + (size_t)3200 * 1024 * 2;
constexpr size_t WS_PV = WS_PU + (size_t)2 * 16384 * 1024;
constexpr size_t WS_PSC = WS_PV + (size_t)2 * 16384 * 1024;
constexpr size_t WS_S = WS_PSC + (size_t)2 * 2 * 16384 * 4;
constexpr size_t WS_END = WS_S + 6 * U_BYTES;
static_assert(WS_END <= 1073741824ull, "workspace too large");
static_assert((WS_CTXR % 256) == 0 && (WS_WPROJ % 256) == 0 && (WS_S % 256) == 0, "alignment");

struct Params {
    const float* in[35];
    float* out;
    unsigned char* ws;
    int pad0, pad1;
};

DEV float bf_lo(unsigned u) { return __uint_as_float(u << 16); }
DEV float bf_hi(unsigned u) { return __uint_as_float(u & 0xffff0000u); }
typedef float f32x2v __attribute__((ext_vector_type(2)));
DEV unsigned pk_bf16(float lo, float hi) { const f32x2v f = {lo, hi}; union { bf16x2v v; unsigned u; } x; x.v = __builtin_convertvector(f, bf16x2v); return x.u; }
template <int N> DEV float dpp_ror(float x) { return __int_as_float(__builtin_amdgcn_update_dpp(0, __float_as_int(x), 0x120 + N, 0xF, 0xF, false)); }
DEV float row16_allreduce(float x) { x += dpp_ror<8>(x); x += dpp_ror<4>(x); x += dpp_ror<2>(x); x += dpp_ror<1>(x); return x; }
DEV float wave_allreduce(float x) { x = row16_allreduce(x); x += __shfl_xor(x, 16); x += __shfl_xor(x, 32); return x; }
DEV float sigmoidf_(float x) { return 1.0f / (1.0f + __expf(-x)); }
DEV float softplusf_(float z) { return fmaxf(z, 0.f) + __logf(1.0f + __expf(-fabsf(z))); }
DEV unsigned mono_u32(float f) { unsigned u = __float_as_uint(f); return u ^ ((u >> 31) ? 0xFFFFFFFFu : 0x80000000u); }
DEV float unmono_u32(unsigned k) { unsigned u = (k & 0x80000000u) ? (k ^ 0x80000000u) : ~k; return __uint_as_float(u); }
DEV bf16x8 as_bf16x8(uint4 v) { union { uint4 u; bf16x8 b; } x; x.u = v; return x.b; }
#define LAS3 __attribute__((address_space(3)))
extern __shared__ __attribute__((aligned(16))) unsigned char g_lds[];
constexpr int LDS_WTAB = LDS_BYTES - 128;
DEV unsigned hw_wave_slot() { return (unsigned)__builtin_amdgcn_s_getreg((5 << 11) | 4) & 63u; }
DEV int tid_opaque() {
    const int wv = (int)*(const volatile unsigned char*)(g_lds + LDS_WTAB + hw_wave_slot());
    int t = (wv << 6) | (int)__builtin_amdgcn_mbcnt_hi(~0u, __builtin_amdgcn_mbcnt_lo(~0u, 0u));
    asm volatile("" : "+v"(t));
    return t;
}
DEV int mod_batch(int R) { return R < NL ? (R >> 13) : 8; }

template <int BN, class AL, class EP>
DEV void gemm_unit(unsigned char* lds, const AL& al, const bf16_t* Bt, int K, int m0, const EP& ep) {
    constexpr int NI = BN / 64;
    constexpr int A_BYTES = 128 * 128;
    constexpr int B_BYTES = BN * 128;
    const int tid = tid_opaque(), lane = tid & 63, wv = tid >> 6, wm = wv >> 2, wn = wv & 3;
    const int fr = lane & 15, fq = lane >> 4;
    unsigned char* sA = lds;
    unsigned char* sB = lds + 2 * A_BYTES;
    f32x4 acc[4][NI];
#pragma unroll
    for (int mi = 0; mi < 4; ++mi)
#pragma unroll
        for (int ni = 0; ni < NI; ++ni) acc[mi][ni] = (f32x4){0.f, 0.f, 0.f, 0.f};
    const int KT = K >> 6;
    const int drow = tid >> 3, dch = (tid & 7) ^ (drow & 7);
    const bf16_t* bsrc = Bt + (size_t)drow * K + dch * 8;
    uint4 ra[2];
    auto stage = [&](int kt, int buf) {
        const int k0 = kt * 64;
#pragma unroll
        for (int i = 0; i < BN / 64; ++i)
            __builtin_amdgcn_global_load_lds((const unsigned*)(bsrc + (size_t)(64 * i) * K + k0), (unsigned*)(sB + buf * B_BYTES + i * 8192 + tid * 16), 16, 0, 0);
        if constexpr (AL::DMA) {
#pragma unroll
            for (int i = 0; i < 2; ++i)
                __builtin_amdgcn_global_load_lds((const unsigned*)(al.A + (size_t)(m0 + drow + 64 * i) * al.lda + k0 + dch * 8), (unsigned*)(sA + buf * A_BYTES + i * 8192 + tid * 16), 16, 0, 0);
        } else {
#pragma unroll
            for (int i = 0; i < 2; ++i) { const int q = tid + 512 * i; ra[i] = al.load(m0 + (q >> 3), k0 + (q & 7) * 8); }
        }
    };
    auto commit = [&](int buf) {
        if constexpr (!AL::DMA) {
#pragma unroll
            for (int i = 0; i < 2; ++i) { const int q = tid + 512 * i, row = q >> 3, ch = q & 7; *(uint4*)(sA + buf * A_BYTES + row * 128 + ((ch ^ (row & 7)) << 4)) = ra[i]; }
        }
    };
    auto compute = [&](int buf) {
        const unsigned char* a_base = sA + buf * A_BYTES;
        const unsigned char* b_base = sB + buf * B_BYTES;
#pragma unroll
        for (int ks = 0; ks < 2; ++ks) {
            bf16x8 af[4], bfr[NI];
            const int ch = ks * 4 + fq;
#pragma unroll
            for (int mi = 0; mi < 4; ++mi) { const int row = wm * 64 + mi * 16 + fr; af[mi] = *(const bf16x8*)(a_base + row * 128 + ((ch ^ (row & 7)) << 4)); }
#pragma unroll
            for (int ni = 0; ni < NI; ++ni) { const int row = wn * (BN / 4) + ni * 16 + fr; bfr[ni] = *(const bf16x8*)(b_base + row * 128 + ((ch ^ (row & 7)) << 4)); }
#pragma unroll
            for (int mi = 0; mi < 4; ++mi)
#pragma unroll
                for (int ni = 0; ni < NI; ++ni) acc[mi][ni] = __builtin_amdgcn_mfma_f32_16x16x32_bf16(bfr[ni], af[mi], acc[mi][ni], 0, 0, 0);
        }
    };
    if constexpr (AL::DMA) {
        constexpr int STG = A_BYTES + B_BYTES;
        auto stage3 = [&](int kt, int b3) {
            const int k0 = kt * 64;
            unsigned char* base = lds + b3 * STG;
#pragma unroll
            for (int i = 0; i < BN / 64; ++i)
                __builtin_amdgcn_global_load_lds((const unsigned*)(bsrc + (size_t)(64 * i) * K + k0), (unsigned*)(base + A_BYTES + i * 8192 + tid * 16), 16, 0, 0);
#pragma unroll
            for (int i = 0; i < 2; ++i)
                __builtin_amdgcn_global_load_lds((const unsigned*)(al.A + (size_t)(m0 + drow + 64 * i) * al.lda + k0 + dch * 8), (unsigned*)(base + i * 8192 + tid * 16), 16, 0, 0);
        };
        auto compute3 = [&](int b3) {
            const unsigned char* a_base = lds + b3 * STG;
            const unsigned char* b_base = a_base + A_BYTES;
#pragma unroll
            for (int ks = 0; ks < 2; ++ks) {
                bf16x8 af[4], bfr[NI];
                const int ch = ks * 4 + fq;
#pragma unroll
                for (int mi = 0; mi < 4; ++mi) { const int row = wm * 64 + mi * 16 + fr; af[mi] = *(const bf16x8*)(a_base + row * 128 + ((ch ^ (row & 7)) << 4)); }
#pragma unroll
                for (int ni = 0; ni < NI; ++ni) { const int row = wn * (BN / 4) + ni * 16 + fr; bfr[ni] = *(const bf16x8*)(b_base + row * 128 + ((ch ^ (row & 7)) << 4)); }
#pragma unroll
                for (int mi = 0; mi < 4; ++mi)
#pragma unroll
                    for (int ni = 0; ni < NI; ++ni) acc[mi][ni] = __builtin_amdgcn_mfma_f32_16x16x32_bf16(bfr[ni], af[mi], acc[mi][ni], 0, 0, 0);
            }
        };
        stage3(0, 0);
        stage3(1, 1);
        int b3 = 0;
        for (int kt = 0; kt < KT; ++kt) {
            if (kt + 1 < KT) { if constexpr (BN == 256) asm volatile("s_waitcnt vmcnt(6)" ::: "memory"); else asm volatile("s_waitcnt vmcnt(4)" ::: "memory"); }
            else asm volatile("s_waitcnt vmcnt(0)" ::: "memory");
            asm volatile("s_waitcnt lgkmcnt(0)" ::: "memory");
            __builtin_amdgcn_s_barrier();
            asm volatile("" ::: "memory");
            const int bn = (b3 == 0) ? 2 : b3 - 1;
            if (kt + 2 < KT) stage3(kt + 2, bn);
            compute3(b3);
            b3 = (b3 == 2) ? 0 : b3 + 1;
        }
        asm volatile("s_waitcnt lgkmcnt(0)" ::: "memory");
        __builtin_amdgcn_s_barrier();
        asm volatile("" ::: "memory");
    } else {
        stage(0, 0);
        commit(0);
        asm volatile("s_waitcnt vmcnt(0)" ::: "memory");
        __syncthreads();
        for (int kt = 0; kt < KT; ++kt) {
            const int cur = kt & 1;
            const bool more = (kt + 1 < KT);
            if (more) stage(kt + 1, cur ^ 1);
            compute(cur);
            if (more) commit(cur ^ 1);
            asm volatile("s_waitcnt vmcnt(0)" ::: "memory");
            __syncthreads();
        }
    }
    ep(acc, m0, wm, wn, fr, fq);
}

struct ALoadPlain {
    static constexpr bool DMA = true;
    const bf16_t* A; int lda;
    DEV uint4 load(int R, int k) const { return *(const uint4*)(A + (size_t)R * lda + k); }
};
struct ALoadMix {
    static constexpr bool DMA = false;
    const bf16_t* h; const float* mix; const bf16_t* A; int lda;
    DEV uint4 load(int R, int k) const {
        const bf16_t* pc = h + (size_t)R * 1024 + k;
        const uint4 c = *(const uint4*)pc;
        const int t = (R < NL) ? (R & 8191) : ((R - NL) & 255);
        const int last = (R < NL) ? 8191 : 255;
        uint4 pv = *(const uint4*)(pc - (t != 0 ? 1024 : 0)), nv = *(const uint4*)(pc + (t != last ? 1024 : 0));
        if (t == 0) pv = make_uint4(0, 0, 0, 0);
        if (t == last) nv = make_uint4(0, 0, 0, 0);
        const float4 m0 = *(const float4*)(mix + k), m1 = *(const float4*)(mix + k + 4);
        const unsigned cc[4] = {c.x, c.y, c.z, c.w}, pp[4] = {pv.x, pv.y, pv.z, pv.w}, nn[4] = {nv.x, nv.y, nv.z, nv.w};
        const float mm[8] = {m0.x, m0.y, m0.z, m0.w, m1.x, m1.y, m1.z, m1.w};
        unsigned o[4];
#pragma unroll
        for (int i = 0; i < 4; ++i) {
            const float hc0 = bf_lo(cc[i]), hc1 = bf_hi(cc[i]);
            const float s0 = 0.5f * (bf_lo(pp[i]) + bf_lo(nn[i])), s1 = 0.5f * (bf_hi(pp[i]) + bf_hi(nn[i]));
            o[i] = pk_bf16(hc0 + (s0 - hc0) * mm[2 * i], hc1 + (s1 - hc1) * mm[2 * i + 1]);
        }
        return make_uint4(o[0], o[1], o[2], o[3]);
    }
};

struct TrJob { int in_idx, src_off, K, N, src_ld, dst_ld; unsigned long long dst_off; int tile0; };
constexpr int NTRJOBS = 19;
__device__ const TrJob g_trjobs[NTRJOBS] = {
    {9, 0 * 1048576, 1024, 1024, 1024, 1024, WS_WPROJ + 0ull * 1024 * 1024 * 2, 0},
    {9, 1 * 1048576, 1024, 1024, 1024, 1024, WS_WPROJ + 1ull * 1024 * 1024 * 2, 256},
    {9, 2 * 1048576, 1024, 1024, 1024, 1024, WS_WPROJ + 2ull * 1024 * 1024 * 2, 512},
    {11, 0, 1024, 64, 64, 1024, WS_WPROJ + 3072ull * 1024 * 2, 768},
    {11, 65536, 1024, 64, 64, 1024, WS_WPROJ + 3136ull * 1024 * 2, 784},
    {14, 0, 1024, 64, 64, 1024, WS_WPROJ + 3200ull * 1024 * 2, 800},
    {14, 65536, 1024, 64, 64, 1024, WS_WPROJ + 3264ull * 1024 * 2, 816},
    {16, 0, 1024, 128, 128, 1024, WS_WPROJ + 3328ull * 1024 * 2, 832},
    {12, 0, 64, 1024, 1024, 64, WS_W2T, 864},
    {12, 65536, 64, 1024, 1024, 64, WS_W2T + 1024ull * 64 * 2, 880},
    {15, 0, 64, 1024, 1024, 64, WS_A2T, 896},
    {15, 65536, 64, 1024, 1024, 64, WS_A2T + 1024ull * 64 * 2, 912},
    {17, 0, 128, 1024, 1024, 128, WS_G2T, 928},
    {23, 0, 1024, 1024, 1024, 1024, WS_WO0, 960},
    {29, 0, 1024, 1024, 1024, 1024, WS_WO1, 1216},
    {30, 0, 1024, 2048, 2048, 1024, WS_WQ, 1472},
    {30, 2097152, 1024, 2048, 2048, 1024, WS_WQ + 2048ull * 1024 * 2, 1984},
    {24, 0, 1024, 3104, 3104, 1024, WS_WIN, 2496},
    {0, 0, 0, 0, 0, 0, 0, 2496 + 16 * 49},
};
constexpr int NTRTILES = 2496 + 16 * 49;

DEV void phase0(const Params& p, unsigned char* lds) {
    const int tid = tid_opaque();
    unsigned char* ws = p.ws;
    {
        float* sc = (float*)lds;
        float* red = sc + 9 * 1024;
        float* mods = (float*)(ws + WS_MOD);
        bool have_sc = false;
        for (int task = blockIdx.x; task < 192; task += gridDim.x) {
            if (!have_sc) {
                for (int i = tid; i < 9 * 1024; i += NTHREADS) {
                    const int mb = i >> 10, k = i & 1023;
                    const float cv = mb < 8 ? p.in[1][mb * 1024 + k] : p.in[3][k];
                    sc[i] = cv / (1.0f + __expf(-cv));
                }
                have_sc = true;
            }
            __syncthreads();
            const int l = task / 96, nb = task % 96;
            const int nn = tid & 63, kg = tid >> 6;
            const float* w = p.in[4] + (size_t)l * 1024 * 6144 + nb * 64 + nn;
            float acc[9];
#pragma unroll
            for (int m = 0; m < 9; ++m) acc[m] = 0.f;
            for (int k = kg * 128; k < kg * 128 + 128; ++k) {
                const float wv = w[(size_t)k * 6144];
#pragma unroll
                for (int m = 0; m < 9; ++m) acc[m] += sc[m * 1024 + k] * wv;
            }
#pragma unroll
            for (int m = 0; m < 9; ++m) red[(kg * 9 + m) * 64 + nn] = acc[m];
            __syncthreads();
            for (int i = tid; i < 576; i += NTHREADS) {
                const int m = i >> 6, n2 = i & 63;
                float s = p.in[5][l * 6144 + nb * 64 + n2];
#pragma unroll
                for (int g = 0; g < 8; ++g) s += red[(g * 9 + m) * 64 + n2];
                mods[(size_t)(l * 9 + m) * 6144 + nb * 64 + n2] = s;
            }
            __syncthreads();
        }
        __syncthreads();
    }
    {
        float* tile = (float*)lds;
        for (int tt = blockIdx.x; tt < NTRTILES; tt += gridDim.x) {
            int j = 0;
#pragma unroll 1
            while (j + 1 < NTRJOBS && g_trjobs[j + 1].tile0 <= tt) ++j;
            const TrJob jb = g_trjobs[j];
            const int tl = tt - jb.tile0;
            const int ntn = (jb.N + 63) >> 6;
            const int k0 = (tl / ntn) * 64, n0 = (tl % ntn) * 64;
            const float* src = p.in[jb.in_idx] + jb.src_off;
            bf16_t* dst = (bf16_t*)(ws + jb.dst_off);
            {
                const int kr = tid >> 4, nc4 = (tid & 15) * 4;
#pragma unroll
                for (int i = 0; i < 2; ++i) {
                    const int kk = kr + 32 * i;
                    float4 v = make_float4(0.f, 0.f, 0.f, 0.f);
                    if (n0 + nc4 < jb.N) v = *(const float4*)(src + (size_t)(k0 + kk) * jb.src_ld + n0 + nc4);
                    tile[kk * 65 + nc4 + 0] = v.x; tile[kk * 65 + nc4 + 1] = v.y; tile[kk * 65 + nc4 + 2] = v.z; tile[kk * 65 + nc4 + 3] = v.w;
                }
            }
            __syncthreads();
            {
                const int nn = tid >> 3, kc = (tid & 7) * 8;
                if (n0 + nn < jb.N) {
                    unsigned o[4];
#pragma unroll
                    for (int i = 0; i < 4; ++i) o[i] = pk_bf16(tile[(kc + 2 * i) * 65 + nn], tile[(kc + 2 * i + 1) * 65 + nn]);
                    *(uint4*)(dst + (size_t)(n0 + nn) * jb.dst_ld + k0 + kc) = make_uint4(o[0], o[1], o[2], o[3]);
                }
            }
            __syncthreads();
        }
    }
    {
        const size_t gtid = (size_t)blockIdx.x * NTHREADS + tid, gstride = (size_t)gridDim.x * NTHREADS;
        {
            const float* src = p.in[31];
            bf16_t* dst = (bf16_t*)(ws + WS_KEYS);
            const size_t n8 = (size_t)2 * 8 * 2 * 128 * 128 / 8;
            for (size_t i = gtid; i < n8; i += gstride) {
                const float4 a = *(const float4*)(src + i * 8), b = *(const float4*)(src + i * 8 + 4);
                *(uint4*)(dst + i * 8) = make_uint4(pk_bf16(a.x, a.y), pk_bf16(a.z, a.w), pk_bf16(b.x, b.y), pk_bf16(b.z, b.w));
            }
        }
        bf16_t* wpad = (bf16_t*)(ws + WS_WIN) + (size_t)3104 * 1024;
        for (size_t i = gtid; i < (size_t)96 * 1024 / 8; i += gstride) *(uint4*)(wpad + i * 8) = make_uint4(0, 0, 0, 0);
        const int lane = tid & 63;
        const int gw = blockIdx.x * 8 + (tid >> 6), nw = gridDim.x * 8;
        float* scales = (float*)(ws + WS_PSC);
        for (int rowi = gw * 32; rowi < 2 * 32768; rowi += nw * 32)
        for (int row = rowi; row < rowi + 32; ++row) {
            const int tbl = row >> 15, r = row & 32767;
            const float* srow = p.in[32 + tbl] + (size_t)r * 1024;
            float4 v[4]; float am = 0.f;
#pragma unroll
            for (int i = 0; i < 4; ++i) { v[i] = *(const float4*)(srow + 16 * lane + 4 * i); am = fmaxf(am, fmaxf(fmaxf(fabsf(v[i].x), fabsf(v[i].y)), fmaxf(fabsf(v[i].z), fabsf(v[i].w)))); }
#pragma unroll
            for (int o = 1; o < 64; o <<= 1) am = fmaxf(am, __shfl_xor(am, o));
            const float scale = am > 0.f ? am * (1.0f / 448.0f) : 1.0f;
            const float inv = 1.0f / scale;
            unsigned w[4];
#pragma unroll
            for (int i = 0; i < 4; ++i) {
                int t = 0;
                t = __builtin_amdgcn_cvt_pk_fp8_f32(v[i].x * inv, v[i].y * inv, t, false);
                t = __builtin_amdgcn_cvt_pk_fp8_f32(v[i].z * inv, v[i].w * inv, t, true);
                w[i] = (unsigned)t;
            }
            *(uint4*)(ws + (tbl ? WS_PV : WS_PU) + ((size_t)(r >> 14) * 8 + (lane >> 3)) * (16384 * 128) + (size_t)(r & 16383) * 128 + 16 * (lane & 7)) = make_uint4(w[0], w[1], w[2], w[3]);
            if (lane == 0) scales[tbl * 32768 + r] = scale;
        }
    }
}

DEV void normmod_store(const float4 (&v)[4], float ss, const float* g, const float* shift, const float* scale, bf16_t* dst, int lane) {
    const float rs = rsqrtf(ss * (1.0f / 1024.0f) + 1e-6f);
#pragma unroll
    for (int i = 0; i < 4; ++i) {
        const int col = i * 256 + lane * 4;
        const float4 gg = *(const float4*)(g + col), sh = *(const float4*)(shift + col), sc = *(const float4*)(scale + col);
        const float y0 = v[i].x * rs * gg.x * (1.f + sc.x) + sh.x, y1 = v[i].y * rs * gg.y * (1.f + sc.y) + sh.y;
        const float y2 = v[i].z * rs * gg.z * (1.f + sc.z) + sh.z, y3 = v[i].w * rs * gg.w * (1.f + sc.w) + sh.w;
        *(uint2*)(dst + col) = make_uint2(pk_bf16(y0, y1), pk_bf16(y2, y3));
    }
}
DEV void phase_normmod(const Params& p, int layer, int which, const float* xl, const float* xc, int nrows, bf16_t* dst) {
    const int tid = tid_opaque(), lane = tid & 63;
    const int gw = blockIdx.x * 8 + (tid >> 6), nw = gridDim.x * 8;
    const float* mods = (const float*)(p.ws + WS_MOD) + (size_t)layer * 9 * 6144;
    const float* g = p.in[which ? 7 : 6] + layer * 1024;
    for (int R = gw; R < nrows; R += nw) {
        const float* xr = R < NL ? xl + (size_t)R * 1024 : xc + (size_t)(R - NL) * 1024;
        float4 v[4]; float ss = 0.f;
#pragma unroll
        for (int i = 0; i < 4; ++i) { v[i] = *(const float4*)(xr + i * 256 + lane * 4); ss += v[i].x * v[i].x + v[i].y * v[i].y + v[i].z * v[i].z + v[i].w * v[i].w; }
        ss = wave_allreduce(ss);
        const float* mrow = mods + (size_t)mod_batch(R) * 6144 + (which ? 3 : 0) * 1024;
        normmod_store(v, ss, g, mrow, mrow + 1024, dst + (size_t)R * 1024, lane);
    }
}
DEV void phase_normmix(const Params& p, bf16_t* hdst, bf16_t* xr, bf16_t* xk, bf16_t* xv) {
    const int tid = tid_opaque(), lane = tid & 63;
    const int gw = __builtin_amdgcn_readfirstlane(blockIdx.x * 8 + (tid >> 6)), nw = gridDim.x * 8;
    const float* mods = (const float*)(p.ws + WS_MOD);
    const float* g = p.in[6];
    for (int run = gw; run < NT / 8; run += nw) {
        const int R0 = run * 8;
        const int t0 = R0 < NL ? (R0 & 8191) : ((R0 - NL) & 255), slen = R0 < NL ? 8192 : 256;
        const float* mrow = mods + (size_t)mod_batch(R0) * 6144;
        float4 gg[4], sh[4], sc[4], m0[4], m2[4], m3[4];
#pragma unroll
        for (int i = 0; i < 4; ++i) {
            const int col = i * 256 + lane * 4;
            gg[i] = *(const float4*)(g + col); sh[i] = *(const float4*)(mrow + col); sc[i] = *(const float4*)(mrow + 1024 + col);
            m0[i] = *(const float4*)(p.in[8] + col); m2[i] = *(const float4*)(p.in[8] + 2 * 1024 + col); m3[i] = *(const float4*)(p.in[8] + 3 * 1024 + col);
        }
        auto hrow = [&](int R, float4 (&h)[4]) {
            const float* xrw = R < NL ? p.in[0] + (size_t)R * 1024 : p.in[2] + (size_t)(R - NL) * 1024;
            float ss = 0.f;
#pragma unroll
            for (int i = 0; i < 4; ++i) { h[i] = *(const float4*)(xrw + i * 256 + lane * 4); ss += h[i].x * h[i].x + h[i].y * h[i].y + h[i].z * h[i].z + h[i].w * h[i].w; }
            ss = wave_allreduce(ss);
            const float rs = rsqrtf(ss * (1.0f / 1024.0f) + 1e-6f);
#pragma unroll
            for (int i = 0; i < 4; ++i) {
                h[i].x = h[i].x * rs * gg[i].x * (1.f + sc[i].x) + sh[i].x; h[i].y = h[i].y * rs * gg[i].y * (1.f + sc[i].y) + sh[i].y;
                h[i].z = h[i].z * rs * gg[i].z * (1.f + sc[i].z) + sh[i].z; h[i].w = h[i].w * rs * gg[i].w * (1.f + sc[i].w) + sh[i].w;
            }
        };
        float4 hp[4], hc[4], hn[4];
        if (t0 > 0) hrow(R0 - 1, hp); else { hp[0] = hp[1] = hp[2] = hp[3] = make_float4(0.f, 0.f, 0.f, 0.f); }
        hrow(R0, hc);
#pragma unroll 1
        for (int i8 = 0; i8 < 8; ++i8) {
            const int R = R0 + i8;
            if (t0 + i8 + 1 < slen) hrow(R + 1, hn); else { hn[0] = hn[1] = hn[2] = hn[3] = make_float4(0.f, 0.f, 0.f, 0.f); }
#pragma unroll
            for (int i = 0; i < 4; ++i) {
                const size_t o = (size_t)R * 1024 + i * 256 + lane * 4;
                const float4 c = hc[i];
                const float4 xx = make_float4(0.5f * (hp[i].x + hn[i].x) - c.x, 0.5f * (hp[i].y + hn[i].y) - c.y, 0.5f * (hp[i].z + hn[i].z) - c.z, 0.5f * (hp[i].w + hn[i].w) - c.w);
                *(uint2*)(hdst + o) = make_uint2(pk_bf16(c.x, c.y), pk_bf16(c.z, c.w));
                *(uint2*)(xr + o) = make_uint2(pk_bf16(c.x + xx.x * m0[i].x, c.y + xx.y * m0[i].y), pk_bf16(c.z + xx.z * m0[i].z, c.w + xx.w * m0[i].w));
                *(uint2*)(xk + o) = make_uint2(pk_bf16(c.x + xx.x * m2[i].x, c.y + xx.y * m2[i].y), pk_bf16(c.z + xx.z * m2[i].z, c.w + xx.w * m2[i].w));
                *(uint2*)(xv + o) = make_uint2(pk_bf16(c.x + xx.x * m3[i].x, c.y + xx.y * m3[i].y), pk_bf16(c.z + xx.z * m3[i].z, c.w + xx.w * m3[i].w));
            }
#pragma unroll
            for (int i = 0; i < 4; ++i) { hp[i] = hc[i]; hc[i] = hn[i]; }
        }
    }
}

template <int BN> struct EpiBf16 {
    bf16_t* dst; int ldd; int col0; int act;
    DEV void operator()(const f32x4 (&acc)[4][BN / 64], int m0, int wm, int wn, int fr, int fq) const {
#pragma unroll
        for (int mi = 0; mi < 4; ++mi) {
            const size_t R = (size_t)(m0 + wm * 64 + mi * 16 + fr);
#pragma unroll
            for (int ni = 0; ni < BN / 64; ++ni) {
                const int col = col0 + wn * (BN / 4) + ni * 16 + 4 * fq;
                float v[4] = {acc[mi][ni][0], acc[mi][ni][1], acc[mi][ni][2], acc[mi][ni][3]};
                if (act == 1) {
#pragma unroll
                    for (int j = 0; j < 4; ++j) v[j] = tanhf(v[j]);
                } else if (act == 2) {
#pragma unroll
                    for (int j = 0; j < 4; ++j) v[j] = sigmoidf_(v[j]);
                }
                *(uint2*)(dst + R * ldd + col) = make_uint2(pk_bf16(v[0], v[1]), pk_bf16(v[2], v[3]));
            }
        }
    }
};
struct EpiResid {
    const float* xold_lat; const float* xold_ctx; float* dst_lat; float* dst_ctx; const float* gate; int col0;
    DEV void operator()(const f32x4 (&acc)[4][4], int m0, int wm, int wn, int fr, int fq) const {
#pragma unroll
        for (int mi = 0; mi < 4; ++mi) {
            const int R = m0 + wm * 64 + mi * 16 + fr;
            const float* src = R < NL ? xold_lat + (size_t)R * 1024 : xold_ctx + (size_t)(R - NL) * 1024;
            float* dst = R < NL ? dst_lat + (size_t)R * 1024 : dst_ctx + (size_t)(R - NL) * 1024;
            const float* gr = gate + (size_t)mod_batch(R) * 6144;
#pragma unroll
            for (int ni = 0; ni < 4; ++ni) {
                const int col = col0 + wn * 64 + ni * 16 + 4 * fq;
                const float4 xo = *(const float4*)(src + col), g4 = *(const float4*)(gr + col);
                *(float4*)(dst + col) = make_float4(xo.x + g4.x * acc[mi][ni][0], xo.y + g4.y * acc[mi][ni][1], xo.z + g4.z * acc[mi][ni][2], xo.w + g4.w * acc[mi][ni][3]);
            }
        }
    }
};
struct EpiLr {
    float* dst;
    DEV void operator()(const f32x4 (&acc)[4][2], int m0, int wm, int wn, int fr, int fq) const {
        if (wn != 0) return;
#pragma unroll
        for (int mi = 0; mi < 4; ++mi) {
            const size_t R = (size_t)(m0 + wm * 64 + mi * 16 + fr);
#pragma unroll
            for (int ni = 0; ni < 2; ++ni) { const int col = ni * 16 + 4 * fq; *(float4*)(dst + R * 32 + col) = make_float4(acc[mi][ni][0], acc[mi][ni][1], acc[mi][ni][2], acc[mi][ni][3]); }
        }
    }
};

namespace pg8 {
#define PG8_LAS __attribute__((address_space(3)))
constexpr int BM = 256, BK = 64, HALF = 128, HTB = HALF * BK * 2  , STAGE_BYTES = 8 * HTB, NXCD = 8, WGM = 8;

__host__ __device__ __forceinline__ int lds_byte(int r, int c) { const int st = (r >> 4) * 2 + (c >> 5), rr = r & 15, cc = c & 31, ob = rr * 64 + cc * 2; return st * 1024 + (ob ^ (((ob >> 9) & 1) << 5)); }
__host__ __device__ __forceinline__ void stage_rc(int b, int& R, int& C) { const int st = b / 1024, sb = b % 1024, swz = sb ^ (((sb >> 9) & 1) << 5); R = (st >> 1) * 16 + swz / 64; C = (st & 1) * 32 + (swz % 64) / 2; }
__host__ __device__ __forceinline__ int perm32(int rho) { const int n = rho >> 4, i = rho & 15; return 8 * (i >> 2) + 4 * n + (i & 3); }
struct Unit { int pm, pn; };
struct Gemm { const bf16_t* A; const bf16_t* Bt; int M, N, K; };
struct StaticOrder {
    int nM, nN, nwg, G, c;
    __host__ __device__ void init(int M, int N, int G_, int c_) { nM = M / BM; nN = N / BM; nwg = nM * nN; G = G_; c = c_; }
    __host__ __device__ bool next(int i, Unit& u) const {
        const long L = (long)i * G + c; if (L >= nwg) return false;
        int wgid = (int)L; { const int q = nwg / NXCD, r = nwg % NXCD, xcd = wgid % NXCD, off = wgid / NXCD; wgid = (xcd < r ? xcd * (q + 1) : r * (q + 1) + (xcd - r) * q) + off; }
        const int nig = WGM * nN, gid = wgid / nig, fm = gid * WGM, gsz = (nM - fm) < WGM ? (nM - fm) : WGM;
        u.pm = fm + ((wgid % nig) % gsz); u.pn = (wgid % nig) / gsz; return true;
    }
    __device__ __forceinline__ void a_ready(const Unit&) const {}
    __device__ __forceinline__ void done(const Unit&) const {}
};
template <class Epi, class Sched, bool STAMP = false>
__device__ __forceinline__ void gemm_phase(PG8_LAS unsigned char* lds, const Gemm g, const Sched& S, const Epi& E, unsigned long long* stamps) {
    const int tid = tid_opaque(), wid = __builtin_amdgcn_readfirstlane(tid >> 6), lane = tid & 63, wr = wid >> 2, wc = wid & 3, fr = lane & 15, fq = lane >> 4;
    const int K = g.K, nt = K / BK;
    int ts_lo = 0, ts_hi = 0, nts = 0; const unsigned long long rt_entry = STAMP ? (unsigned long long)wall_clock64() : 0ull;
#define PG8_STAMP() do { if (STAMP && wid == 0 && nts < 64) { const unsigned long long _c = (unsigned long long)clock64(); \
        ts_lo = (lane == nts) ? (int)(unsigned)_c : ts_lo; ts_hi = (lane == nts) ? (int)(unsigned)(_c >> 32) : ts_hi; ++nts; } } while (0)
    PG8_STAMP();
    unsigned voffA[2], voffB[2];
#pragma unroll
    for (int i = 0; i < 2; ++i) { int R, C; stage_rc(tid * 16 + i * 8192, R, C); const int Rb = Epi::PERM ? ((R & ~31) + perm32(R & 31)) : R;
        voffA[i] = (unsigned)(R * K + C) * 2u; voffB[i] = (unsigned)(Rb * K + C) * 2u; }
    const size_t kstep = (size_t)(BK * 2);
    const size_t hstep = (size_t)HALF * K * 2;
    const size_t tstep = 2 * hstep;
    const unsigned ldsw = (unsigned)wid * 1024u;
    const int aoff = lds_byte(wr * 64 + fr, fq * 8), boff = lds_byte(wc * 32 + fr, fq * 8);
#define PG8_SA(b, h) (((b) * 2 + (h)) * HTB)
#define PG8_SB(b, h) ((4 + (b) * 2 + (h)) * HTB)
#define PG8_STAGE(bufoff, gbase, voff) do { _Pragma("unroll") for (int _i = 0; _i < 2; ++_i) \
        __builtin_amdgcn_global_load_lds((const unsigned*)((const char*)(gbase) + (voff)[_i]), (PG8_LAS unsigned*)(lds + (bufoff) + ldsw + _i * 8192), 16, 0, 0); } while (0)
#define PG8_LDA(dst, b, h) do { _Pragma("unroll") for (int m = 0; m < 4; ++m) _Pragma("unroll") for (int k = 0; k < 2; ++k) dst[m][k] = *(const PG8_LAS bf16x8*)(lds + PG8_SA(b, h) + aoff + m * 2048 + k * 1024); } while (0)
#define PG8_LDB(dst, b, h) do { _Pragma("unroll") for (int n = 0; n < 2; ++n) _Pragma("unroll") for (int k = 0; k < 2; ++k) dst[n][k] = *(const PG8_LAS bf16x8*)(lds + PG8_SB(b, h) + boff + n * 2048 + k * 1024); } while (0)
#define PG8_MMA(ai, bj, At, Bt) do { __builtin_amdgcn_s_setprio(1); _Pragma("unroll") for (int m = 0; m < 4; ++m) _Pragma("unroll") for (int n = 0; n < 2; ++n) _Pragma("unroll") for (int k = 0; k < 2; ++k) \
        acc[ai][bj][m][n] = __builtin_amdgcn_mfma_f32_16x16x32_bf16(Bt[n][k], At[m][k], acc[ai][bj][m][n], 0, 0, 0); __builtin_amdgcn_s_setprio(0); } while (0)
#define PG8_WAIT_V(n) asm volatile("s_waitcnt vmcnt(" #n ")" ::: "memory")
#define PG8_WAIT_L(n) asm volatile("s_waitcnt lgkmcnt(" #n ")" ::: "memory")
#define PG8_BAR __builtin_amdgcn_s_barrier()
#define PG8_SCHED __builtin_amdgcn_sched_barrier(0)
    Unit cur, nxt; int ui = 0;
    if (!S.next(0, cur)) return;
    f32x4 acc[2][2][4][2];
#pragma unroll
    for (int a = 0; a < 2; ++a)
#pragma unroll
        for (int b = 0; b < 2; ++b)
#pragma unroll
            for (int m = 0; m < 4; ++m)
#pragma unroll
                for (int n = 0; n < 2; ++n) acc[a][b][m][n] = (f32x4){0.f, 0.f, 0.f, 0.f};
    bf16x8 At[4][2], B0[2][2], B1[2][2];
    const char* cA = (const char*)g.A + (size_t)cur.pm * tstep; const char* cB = (const char*)g.Bt + (size_t)cur.pn * tstep;
    S.a_ready(cur);
    PG8_STAGE(PG8_SB(0, 0), cB, voffB); PG8_STAGE(PG8_SA(0, 0), cA, voffA); PG8_STAGE(PG8_SB(0, 1), cB + hstep, voffB); PG8_STAGE(PG8_SA(0, 1), cA + hstep, voffA);
    if (wr == 1) PG8_BAR;
    PG8_WAIT_V(4); PG8_BAR;
    PG8_STAGE(PG8_SB(1, 0), cB + kstep, voffB); PG8_STAGE(PG8_SA(1, 0), cA + kstep, voffA); PG8_STAGE(PG8_SB(1, 1), cB + hstep + kstep, voffB);
    PG8_WAIT_V(6); PG8_BAR;
    PG8_STAMP();
    for (;;) {
        const bool has_next = S.next(ui + 1, nxt);
        const char* nA = has_next ? (const char*)g.A + (size_t)nxt.pm * tstep : cA; const char* nB = has_next ? (const char*)g.Bt + (size_t)nxt.pn * tstep : cB;
        for (int t = 0; t < nt; t += 2) {
            const bool last = (t == nt - 2);
            const char* a1 = cA + (size_t)(t + 1) * kstep;
            const char* a2 = last ? nA : cA + (size_t)(t + 2) * kstep; const char* b2 = last ? nB : cB + (size_t)(t + 2) * kstep;
            const char* a3 = a2 + kstep; const char* b3 = b2 + kstep;
            if (last && has_next) S.a_ready(nxt);
            PG8_LDB(B0, 0, 0); PG8_SCHED; PG8_LDA(At, 0, 0); PG8_STAGE(PG8_SA(1, 1), a1 + hstep, voffA);
            PG8_WAIT_L(8); PG8_BAR; PG8_WAIT_L(0); PG8_MMA(0, 0, At, B0); PG8_BAR; PG8_SCHED;
            PG8_LDB(B1, 0, 1); PG8_STAGE(PG8_SB(0, 0), b2, voffB);
            PG8_BAR; PG8_WAIT_L(0); PG8_MMA(0, 1, At, B1); PG8_BAR;
            PG8_LDA(At, 0, 1); PG8_STAGE(PG8_SA(0, 0), a2, voffA);
            PG8_BAR; PG8_WAIT_L(0); PG8_MMA(1, 0, At, B0); PG8_BAR; PG8_SCHED;
            PG8_STAGE(PG8_SB(0, 1), b2 + hstep, voffB);
            PG8_WAIT_V(6); PG8_BAR; PG8_MMA(1, 1, At, B1); PG8_BAR;
            PG8_LDB(B0, 1, 0); PG8_SCHED; PG8_LDA(At, 1, 0); PG8_STAGE(PG8_SA(0, 1), a2 + hstep, voffA);
            PG8_WAIT_L(8); PG8_BAR; PG8_WAIT_L(0); PG8_MMA(0, 0, At, B0); PG8_BAR; PG8_SCHED;
            PG8_LDB(B1, 1, 1); PG8_STAGE(PG8_SB(1, 0), b3, voffB);
            PG8_BAR; PG8_WAIT_L(0); PG8_MMA(0, 1, At, B1); PG8_BAR;
            PG8_LDA(At, 1, 1); PG8_STAGE(PG8_SA(1, 0), a3, voffA);
            PG8_BAR; PG8_WAIT_L(0); PG8_MMA(1, 0, At, B0); PG8_BAR; PG8_SCHED;
            PG8_STAGE(PG8_SB(1, 1), b3 + hstep, voffB);
            PG8_WAIT_V(6); PG8_BAR; PG8_MMA(1, 1, At, B1); PG8_BAR;
        }
        PG8_STAMP();
        if constexpr (!Epi::AFTER_DRAIN) { E(acc, cur, wr, wc, fr, fq); S.done(cur); }
        PG8_STAMP();
        if (!has_next) break;
#pragma unroll
        for (int a = 0; a < 2; ++a)
#pragma unroll
            for (int b = 0; b < 2; ++b)
#pragma unroll
                for (int m = 0; m < 4; ++m)
#pragma unroll
                    for (int n = 0; n < 2; ++n) acc[a][b][m][n] = (f32x4){0.f, 0.f, 0.f, 0.f};
        cur = nxt; cA = nA; cB = nB; ++ui;
    }
    PG8_WAIT_V(0);
    if (wr == 0) PG8_BAR;
    PG8_BAR;
    if constexpr (Epi::AFTER_DRAIN) { E.fused(acc, cur, wr, wc, fr, fq, lds, wid, lane); S.done(cur); }
    PG8_STAMP();
    if (STAMP && wid == 0) { stamps[lane] = lane < nts ? (((unsigned long long)(unsigned)ts_hi << 32) | (unsigned)ts_lo) : 0ull;
        if (lane == 62) stamps[62] = rt_entry; if (lane == 63) stamps[63] = (unsigned long long)wall_clock64(); }
#undef PG8_STAMP
#undef PG8_SA
#undef PG8_SB
#undef PG8_STAGE
#undef PG8_LDA
#undef PG8_LDB
#undef PG8_MMA
#undef PG8_WAIT_V
#undef PG8_WAIT_L
#undef PG8_BAR
#undef PG8_SCHED
}
struct EpiBf16Tiles {
    static constexpr bool PERM = true, AFTER_DRAIN = false;
    bf16_t* d0; int ld0; int ntile0; bf16_t* d1; int ld1;
    __device__ __forceinline__ void operator()(const f32x4 (&acc)[2][2][4][2], const Unit& u, int wr, int wc, int fr, int fq) const {
        bf16_t* base = u.pn < ntile0 ? d0 : d1; const int ld = u.pn < ntile0 ? ld0 : ld1; const int colt = (u.pn < ntile0 ? u.pn : u.pn - ntile0) * BM;
        const int row0 = u.pm * BM + wr * 64 + fr, col0 = colt + wc * 32 + 8 * fq;
#pragma unroll
        for (int ai = 0; ai < 2; ++ai)
#pragma unroll
            for (int m = 0; m < 4; ++m) { bf16_t* rowp = base + (size_t)(row0 + ai * HALF + m * 16) * ld + col0;
#pragma unroll
                for (int bj = 0; bj < 2; ++bj) { const f32x4 v0 = acc[ai][bj][m][0], v1 = acc[ai][bj][m][1];
                    *(uint4*)(rowp + bj * HALF) = make_uint4(pk_bf16(v0[0], v0[1]), pk_bf16(v0[2], v0[3]), pk_bf16(v1[0], v1[1]), pk_bf16(v1[2], v1[3])); } }
    }
};
struct EpiResid256 {
    static constexpr bool PERM = false, AFTER_DRAIN = false;
    const float* xold_lat; const float* xold_ctx; float* dst_lat; float* dst_ctx; const float* gate;
    __device__ __forceinline__ void operator()(const f32x4 (&acc)[2][2][4][2], const Unit& u, int wr, int wc, int fr, int fq) const {
        const int row0 = u.pm * BM + wr * 64 + fr, col0 = u.pn * BM + wc * 32 + 4 * fq;
#pragma unroll
        for (int ai = 0; ai < 2; ++ai)
#pragma unroll
            for (int m = 0; m < 4; ++m) {
                const int R = row0 + ai * HALF + m * 16;
                const float* src = R < NL ? xold_lat + (size_t)R * 1024 : xold_ctx + (size_t)(R - NL) * 1024;
                float* dst = R < NL ? dst_lat + (size_t)R * 1024 : dst_ctx + (size_t)(R - NL) * 1024;
                const float* gr = gate + (size_t)mod_batch(R) * 6144;
#pragma unroll
                for (int bj = 0; bj < 2; ++bj)
#pragma unroll
                    for (int n = 0; n < 2; ++n) {
                        const int col = col0 + bj * HALF + n * 16;
                        const float4 xo = *(const float4*)(src + col), g4 = *(const float4*)(gr + col);
                        const f32x4 a = acc[ai][bj][m][n];
                        *(float4*)(dst + col) = make_float4(xo.x + g4.x * a[0], xo.y + g4.y * a[1], xo.z + g4.z * a[2], xo.w + g4.w * a[3]);
                    }
            }
    }
};
}

DEV void phase_rw_proj1(const Params& p, unsigned char* lds, int which, const bf16_t* A, bf16_t* dst) {
    pg8::Gemm g{A, (const bf16_t*)(p.ws + WS_WPROJ) + (size_t)which * 1024 * 1024, NT, 1024, 1024};
    pg8::StaticOrder so; so.init(NT, 1024, gridDim.x, blockIdx.x);
    pg8::EpiBf16Tiles ep{dst, 1024, 4, dst, 1024};
    pg8::gemm_phase((PG8_LAS unsigned char*)lds, g, so, ep, nullptr);
    __syncthreads();
}
DEV void phase_rw_lora(const Params& p, unsigned char* lds) {
    unsigned char* ws = p.ws;
    const bf16_t* h = (const bf16_t*)(ws + WS_S + 0 * U_BYTES);
    const bf16_t* wproj = (const bf16_t*)(ws + WS_WPROJ);
    const int nunits = (NT / 128) * 3;
    for (int u = blockIdx.x; u < nunits; u += gridDim.x) {
        const int mt = u / 3, lg = u % 3, m0 = mt * 128;
        const int mixid = lg == 0 ? 1 : (lg == 1 ? 4 : 5);
        ALoadMix al{h, p.in[8] + mixid * 1024, h, 1024};
        EpiBf16<128> ep{(bf16_t*)(ws + WS_S + 4 * U_BYTES), 384, lg * 128, lg == 0 ? 1 : (lg == 1 ? 0 : 2)};
        gemm_unit<128>(lds, al, wproj + (size_t)(3072 + lg * 128) * 1024, 1024, m0, ep);
    }
}

template <int N> DEV float dpp_shr0(float x) { return __int_as_float(__builtin_amdgcn_update_dpp(0, __float_as_int(x), 0x110 + N, 0xF, 0xF, true)); }
template <int CTRL> DEV float dpp_quad(float x) { return __int_as_float(__builtin_amdgcn_update_dpp(0, __float_as_int(x), CTRL, 0xF, 0xF, false)); }
DEV int tile_off(int row, int ch) { return row * 128 + ((ch ^ (row & 7)) << 4); }
DEV int tile_off2(int row, int ch) { return row * 128 + ((ch ^ ((row ^ (row >> 3)) & 7)) << 4); }
DEV void phase_rw_scan(const Params& p, unsigned char* lds) {
    const int tid = tid_opaque(), lane = tid & 63;
    const int wv = __builtin_amdgcn_readfirstlane(tid >> 6);
    const int fr = lane & 15, fq = lane >> 4;
    unsigned char* ws = p.ws;
    constexpr int SH = 0, SL = 8192, AT = 16384  , RT = 20480  , BT = 24576  , KT = 28672  , BKT = 32768  , UV = 49152  , NT = 65536  ;
    constexpr int MFA = 69632, MFK = 70656, X0 = 71680, VS = 75776  , PP = 83968, PM = 88064, PI = 92160, AA = 96256  ;
    constexpr int PL = 116736  , YB = 117760, LDS_END = 121856;
    const bf16_t* rbuf = (const bf16_t*)(ws + WS_S + 3 * U_BYTES);
    const bf16_t* kbuf = (const bf16_t*)(ws + WS_S + 5 * U_BYTES);
    const bf16_t* vbuf = (const bf16_t*)(ws + WS_S + 1 * U_BYTES);
    const bf16_t* lora = (const bf16_t*)(ws + WS_S + 4 * U_BYTES);
    for (int unit = blockIdx.x; unit < 256; unit += gridDim.x) {
        const int b = unit >> 5, hh = (unit >> 1) & 15, d = unit & 1;
        bf16_t* ydst = (bf16_t*)(ws + WS_S + (size_t)(d ? 2 : 0) * U_BYTES);
        float* bonus = (float*)(ws + WS_BONUS) + (size_t)((d * NB + b) * 16 + hh) * 8448;
        const int s_e = (tid >> 4) & 15, j0 = (tid & 15) * 4;
        const int ni = wv & 3;
        auto Rof = [&](int c, int s) -> int {
            if (c < 16) { const int q = c * 16 + s; return NL + b * 256 + (d ? 255 - q : q); }
            const int q = (c - 16) * 16 + s; return b * 8192 + (d ? 8191 - q : q);
        };
        constexpr int CST = LDS_END;
        uint2 pr = make_uint2(0, 0), pk = pr, pv = pr; uint4 paw[2], paa[2];
        if (wv >= 4) {
            const int ct = (tid - 256) * 16;
            *(float4*)(lds + CST + 0 * 4096 + ct) = *(const float4*)(p.in[18] + hh * 64 + j0);
            *(float4*)(lds + CST + 1 * 4096 + ct) = *(const float4*)(p.in[19] + hh * 64 + j0);
            *(float4*)(lds + CST + 2 * 4096 + ct) = *(const float4*)(p.in[20] + hh * 64 + j0);
            *(float4*)(lds + CST + 3 * 4096 + ct) = *(const float4*)(p.in[10] + d * 1024 + hh * 64 + ni * 16 + fq * 4);
            *(float4*)(lds + CST + 4 * 4096 + ct) = *(const float4*)(p.in[13] + d * 1024 + hh * 64 + ni * 16 + fq * 4);
#pragma unroll
            for (int ks = 0; ks < 2; ++ks) {
                *(uint4*)(lds + CST + (5 + ks) * 4096 + ct) = *(const uint4*)((const bf16_t*)(ws + WS_W2T) + (size_t)d * 1024 * 64 + (size_t)(hh * 64 + ni * 16 + fr) * 64 + ks * 32 + fq * 8);
                *(uint4*)(lds + CST + (7 + ks) * 4096 + ct) = *(const uint4*)((const bf16_t*)(ws + WS_A2T) + (size_t)d * 1024 * 64 + (size_t)(hh * 64 + ni * 16 + fr) * 64 + ks * 32 + fq * 8);
            }
        }
        auto load_lora = [&](int c) {
            const size_t R2 = (size_t)Rof(c, fr);
#pragma unroll
            for (int ks = 0; ks < 2; ++ks) { paw[ks] = *(const uint4*)(lora + R2 * 384 + d * 64 + ks * 32 + fq * 8); paa[ks] = *(const uint4*)(lora + R2 * 384 + 128 + d * 64 + ks * 32 + fq * 8); }
        };
        auto load_rkv = [&](int c) {
            const size_t off = (size_t)Rof(c, s_e) * 1024 + hh * 64 + j0;
            pr = *(const uint2*)(rbuf + off); pk = *(const uint2*)(kbuf + off); pv = *(const uint2*)(vbuf + off);
        };
        auto step_up = [&](int c) {
            const int ct = (tid - 256) * 16;
            const float4 bias_w = *(const float4*)(lds + CST + 3 * 4096 + ct), bias_a = *(const float4*)(lds + CST + 4 * 4096 + ct);
            bf16x8 bfw[2], bfa[2];
#pragma unroll
            for (int ks = 0; ks < 2; ++ks) { bfw[ks] = *(const bf16x8*)(lds + CST + (5 + ks) * 4096 + ct); bfa[ks] = *(const bf16x8*)(lds + CST + (7 + ks) * 4096 + ct); }
            f32x4 accw = {0.f, 0.f, 0.f, 0.f}, acca = {0.f, 0.f, 0.f, 0.f};
#pragma unroll
            for (int ks = 0; ks < 2; ++ks) { accw = __builtin_amdgcn_mfma_f32_16x16x32_bf16(bfw[ks], as_bf16x8(paw[ks]), accw, 0, 0, 0); acca = __builtin_amdgcn_mfma_f32_16x16x32_bf16(bfa[ks], as_bf16x8(paa[ks]), acca, 0, 0, 0); }
            const int n = ni * 16 + fq * 4;
            const float bw[4] = {bias_w.x, bias_w.y, bias_w.z, bias_w.w}, ba[4] = {bias_a.x, bias_a.y, bias_a.z, bias_a.w};
            float P[4], Pm[4], Pi[4], av[4];
#pragma unroll
            for (int j = 0; j < 4; ++j) {
                const float e = 0.6065306597f * __builtin_amdgcn_rcpf(1.0f + __expf(-(accw[j] + bw[j])));
                float s = e;
                s += dpp_shr0<1>(s); s += dpp_shr0<2>(s); s += dpp_shr0<4>(s); s += dpp_shr0<8>(s);
                P[j] = __expf(-s); Pi[j] = __builtin_amdgcn_rcpf(P[j]); Pm[j] = P[j] * __expf(e);
                av[j] = __builtin_amdgcn_rcpf(1.0f + __expf(-(acca[j] + ba[j])));
            }
            const int pb = (c & 1) * 16384;
            *(float4*)(lds + PP + pb + (fr * 64 + n) * 4) = make_float4(P[0], P[1], P[2], P[3]);
            *(float4*)(lds + PM + pb + (fr * 64 + n) * 4) = make_float4(Pm[0], Pm[1], Pm[2], Pm[3]);
            *(float4*)(lds + PI + pb + (fr * 64 + n) * 4) = make_float4(Pi[0], Pi[1], Pi[2], Pi[3]);
            *(float4*)(lds + AA + pb + (fr * 64 + n) * 4) = make_float4(av[0], av[1], av[2], av[3]);
            if (fr == 15) *(float4*)(lds + PL + (c & 3) * 256 + n * 4) = make_float4(P[0], P[1], P[2], P[3]);
        };
        auto step_vec = [&](int c) {
            const int eo = (s_e * 64 + j0) * 4, pb = (c & 1) * 16384, tb = (c & 1) * 8192, ct = (tid - 256) * 16;
            const float4 kk_c = *(const float4*)(lds + CST + 0 * 4096 + ct), ka_c = *(const float4*)(lds + CST + 1 * 4096 + ct), rk_c = *(const float4*)(lds + CST + 2 * 4096 + ct);
            const float4 a4 = *(const float4*)(lds + AA + pb + eo), P4 = *(const float4*)(lds + PP + pb + eo), Pm4 = *(const float4*)(lds + PM + pb + eo), Pi4 = *(const float4*)(lds + PI + pb + eo);
            const float kx[4] = {bf_lo(pk.x), bf_hi(pk.x), bf_lo(pk.y), bf_hi(pk.y)};
            const float rx[4] = {bf_lo(pr.x), bf_hi(pr.x), bf_lo(pr.y), bf_hi(pr.y)};
            const float av[4] = {a4.x, a4.y, a4.z, a4.w}, Pv[4] = {P4.x, P4.y, P4.z, P4.w}, Pmv[4] = {Pm4.x, Pm4.y, Pm4.z, Pm4.w}, Piv[4] = {Pi4.x, Pi4.y, Pi4.z, Pi4.w};
            const float kkc[4] = {kk_c.x, kk_c.y, kk_c.z, kk_c.w}, kac[4] = {ka_c.x, ka_c.y, ka_c.z, ka_c.w}, rkc[4] = {rk_c.x, rk_c.y, rk_c.z, rk_c.w};
            float t[4], n2 = 0.f;
#pragma unroll
            for (int j = 0; j < 4; ++j) { t[j] = kx[j] * kkc[j]; n2 += t[j] * t[j]; }
            n2 = row16_allreduce(n2);
            const float inv = 1.0f / fmaxf(sqrtf(n2), 1e-12f);
            float at[4], bt[4], kt[4], rt[4], bon = 0.f;
#pragma unroll
            for (int j = 0; j < 4; ++j) {
                const float kkv = t[j] * inv;
                const float kd = kx[j] * (1.0f + (av[j] - 1.0f) * kac[j]);
                const float bq = kkv * av[j];
                bon += rx[j] * kd * rkc[j];
                at[j] = -kkv * Pmv[j]; bt[j] = bq * Piv[j]; kt[j] = kd * Piv[j]; rt[j] = rx[j] * Pv[j];
            }
            bon = row16_allreduce(bon);
            if ((tid & 15) == 0) { const int Rb = Rof(c, s_e); bonus[Rb < NL ? 256 + (Rb & 8191) : ((Rb - NL) & 255)] = bon; }
            const int ro = tile_off(s_e, j0 >> 3) + (j0 & 7) * 2;
            *(uint2*)(lds + AT + (c & 1) * 2048 + ro) = make_uint2(pk_bf16(at[0], at[1]), pk_bf16(at[2], at[3]));
            *(uint2*)(lds + RT + (c & 1) * 2048 + ro) = make_uint2(pk_bf16(rt[0], rt[1]), pk_bf16(rt[2], rt[3]));
            const unsigned b01 = pk_bf16(bt[0], bt[1]), b23 = pk_bf16(bt[2], bt[3]), k01 = pk_bf16(kt[0], kt[1]), k23 = pk_bf16(kt[2], kt[3]);
            *(uint2*)(lds + BT + (c & 1) * 2048 + ro) = make_uint2(b01, b23);
            *(uint2*)(lds + KT + (c & 1) * 2048 + ro) = make_uint2(k01, k23);
            const unsigned bw2[4] = {b01 & 0xffffu, b01 >> 16, b23 & 0xffffu, b23 >> 16}, kw2[4] = {k01 & 0xffffu, k01 >> 16, k23 & 0xffffu, k23 >> 16};
            const unsigned vw[4] = {pv.x & 0xffffu, pv.x >> 16, pv.y & 0xffffu, pv.y >> 16};
            const int e0 = (s_e & 7) * 2, cq = s_e >> 3;
#pragma unroll
            for (int j = 0; j < 4; ++j) {
                const int row = j0 + j;
                *(bf16_t*)(lds + BKT + tb + tile_off2(row, 0 + cq) + e0) = (bf16_t)bw2[j];
                *(bf16_t*)(lds + BKT + tb + tile_off2(row, 2 + cq) + e0) = (bf16_t)kw2[j];
                *(bf16_t*)(lds + BKT + tb + tile_off2(row, 4 + cq) + e0) = (bf16_t)bw2[j];
                *(bf16_t*)(lds + UV + tb + tile_off2(row, 2 + cq) + e0) = (bf16_t)vw[j];
            }
            *(float4*)(lds + VS + (c & 1) * 4096 + eo) = make_float4(bf_lo(pv.x), bf_hi(pv.x), bf_lo(pv.y), bf_hi(pv.y));
        };
        f32x4 accY = {0.f, 0.f, 0.f, 0.f};
        auto prod_S = [&](int c) {
            const int vt = wv & 3, tb = (c & 1) * 2048;
            f32x4 accX = {0.f, 0.f, 0.f, 0.f}, accR = {0.f, 0.f, 0.f, 0.f};
#pragma unroll
            for (int ks = 0; ks < 2; ++ks) {
                const int ch = ks * 4 + fq;
                const bf16x8 sh = *(const bf16x8*)(lds + SH + tile_off(vt * 16 + fr, ch)), sl = *(const bf16x8*)(lds + SL + tile_off(vt * 16 + fr, ch));
                const bf16x8 fa = *(const bf16x8*)(lds + AT + tb + tile_off(fr, ch)), frr = *(const bf16x8*)(lds + RT + tb + tile_off(fr, ch));
                accX = __builtin_amdgcn_mfma_f32_16x16x32_bf16(sh, fa, accX, 0, 0, 0);
                accR = __builtin_amdgcn_mfma_f32_16x16x32_bf16(sh, frr, accR, 0, 0, 0);
                accX = __builtin_amdgcn_mfma_f32_16x16x32_bf16(sl, fa, accX, 0, 0, 0);
                accR = __builtin_amdgcn_mfma_f32_16x16x32_bf16(sl, frr, accR, 0, 0, 0);
            }
            accY = accR;
#pragma unroll
            for (int j = 0; j < 4; ++j) *(float*)(lds + X0 + ((vt * 16 + 4 * fq + j) * 16 + fr) * 4) = accX[j];
        };
        auto prod_V = [&](int c) {
            const int tb = (c & 1) * 2048, w4 = wv & 3;
            f32x4 m = {0.f, 0.f, 0.f, 0.f};
#pragma unroll
            for (int ks = 0; ks < 2; ++ks) {
                const int ch = ks * 4 + fq;
                const bf16x8 fa = *(const bf16x8*)(lds + ((w4 & 1) ? KT : BT) + tb + tile_off(fr, ch));
                const bf16x8 fb = *(const bf16x8*)(lds + ((w4 & 2) ? RT : AT) + tb + tile_off(fr, ch));
                m = __builtin_amdgcn_mfma_f32_16x16x32_bf16(fa, fb, m, 0, 0, 0);
            }
            if (w4 < 2) {
                float* mf = (float*)(lds + (w4 ? MFK : MFA));
#pragma unroll
                for (int j = 0; j < 4; ++j) mf[(fr * 4 + j) * 4 + fq] = (4 * fq + j < fr) ? m[j] : 0.f;
            } else {
                const float m0 = (4 * fq + 0 <= fr) ? m[0] : 0.f, m1 = (4 * fq + 1 <= fr) ? m[1] : 0.f, m2 = (4 * fq + 2 <= fr) ? m[2] : 0.f, m3 = (4 * fq + 3 <= fr) ? m[3] : 0.f;
                const uint2 o = make_uint2(pk_bf16(m0, m1), pk_bf16(m2, m3));
                const int colb = (w4 == 2 ? 0 : 16) + 4 * fq;
                *(uint2*)(lds + NT + tb + tile_off(fr, colb >> 3) + (colb & 7) * 2) = o;
                if (w4 == 2) *(uint2*)(lds + NT + tb + tile_off(fr, (32 + 4 * fq) >> 3) + ((32 + 4 * fq) & 7) * 2) = o;
            }
        };
        auto step_rec = [&](int c) {
            const int v = tid >> 2, pq = tid & 3;
            float cc[16];
#pragma unroll
            for (int i = 0; i < 4; ++i) { const float4 q = *(const float4*)(lds + X0 + (v * 16 + 4 * i) * 4); cc[4 * i] = q.x; cc[4 * i + 1] = q.y; cc[4 * i + 2] = q.z; cc[4 * i + 3] = q.w; }
            float vown[4];
#pragma unroll
            for (int i = 0; i < 4; ++i) vown[i] = *(const float*)(lds + VS + (c & 1) * 4096 + ((4 * i + pq) * 64 + v) * 4);
#pragma unroll
            for (int t = 1; t < 16; ++t) {
                const float4 mk = *(const float4*)(lds + MFK + ((t * 4 + pq) * 4) * 4);
                float s = vown[0] * mk.x; s = fmaf(vown[1], mk.y, s); s = fmaf(vown[2], mk.z, s); s = fmaf(vown[3], mk.w, s);
                s += dpp_quad<0xB1>(s); s += dpp_quad<0x4E>(s);
                cc[t] += s;
            }
            float4 ma[16];
#pragma unroll
            for (int t = 1; t < 16; ++t) ma[t] = *(const float4*)(lds + MFA + ((t * 4 + pq) * 4) * 4);
            ma[0] = make_float4(0.f, 0.f, 0.f, 0.f);
            float uown[4] = {0.f, 0.f, 0.f, 0.f}, uall[16];
#pragma unroll
            for (int t = 0; t < 16; ++t) {
                float s = uown[0] * ma[t].x; s = fmaf(uown[1], ma[t].y, s); s = fmaf(uown[2], ma[t].z, s); s = fmaf(uown[3], ma[t].w, s);
                s += dpp_quad<0xB1>(s); s += dpp_quad<0x4E>(s);
                const float u = cc[t] + s;
                uall[t] = u;
                if (pq == (t & 3)) uown[t >> 2] = u;
            }
            if (pq < 2) {
                unsigned o[8];
#pragma unroll
                for (int i = 0; i < 8; ++i) {
                    const unsigned hi = pk_bf16(uall[2 * i], uall[2 * i + 1]);
                    o[i] = pq ? pk_bf16(uall[2 * i] - bf_lo(hi), uall[2 * i + 1] - bf_hi(hi)) : hi;
                }
                const int cb = pq ? 4 : 0;
                *(uint4*)(lds + UV + (c & 1) * 8192 + tile_off2(v, cb)) = make_uint4(o[0], o[1], o[2], o[3]);
                *(uint4*)(lds + UV + (c & 1) * 8192 + tile_off2(v, cb + 1)) = make_uint4(o[4], o[5], o[6], o[7]);
            }
        };
        f32x4 accS[2];
        accS[0] = (f32x4){0.f, 0.f, 0.f, 0.f}; accS[1] = (f32x4){0.f, 0.f, 0.f, 0.f};
        auto step_upd = [&](int c) {
            const int vt = wv & 3;
            bf16x8 fuv[2];
#pragma unroll
            for (int ks = 0; ks < 2; ++ks) fuv[ks] = *(const bf16x8*)(lds + UV + (c & 1) * 8192 + tile_off2(vt * 16 + fr, ks * 4 + fq));
            if (wv < 4) {
#pragma unroll
                for (int ks = 0; ks < 2; ++ks) accY = __builtin_amdgcn_mfma_f32_16x16x32_bf16(fuv[ks], *(const bf16x8*)(lds + NT + (c & 1) * 2048 + tile_off(fr, ks * 4 + fq)), accY, 0, 0, 0);
                *(float4*)(lds + YB + (fr * 64 + vt * 16 + 4 * fq) * 4) = make_float4(accY[0], accY[1], accY[2], accY[3]);
            }
#pragma unroll
            for (int k2 = 0; k2 < 2; ++k2) {
                const int kt = 2 * (wv >> 2) + k2;
                f32x4 a = accS[k2];
#pragma unroll
                for (int ks = 0; ks < 2; ++ks) a = __builtin_amdgcn_mfma_f32_16x16x32_bf16(*(const bf16x8*)(lds + BKT + (c & 1) * 8192 + tile_off2(kt * 16 + fr, ks * 4 + fq)), fuv[ks], a, 0, 0, 0);
                const float4 pl = *(const float4*)(lds + PL + (c & 3) * 256 + (kt * 16 + 4 * fq) * 4);
                a[0] *= pl.x; a[1] *= pl.y; a[2] *= pl.z; a[3] *= pl.w;
                accS[k2] = a;
                const unsigned h01 = pk_bf16(a[0], a[1]), h23 = pk_bf16(a[2], a[3]);
                const unsigned l01 = pk_bf16(a[0] - bf_lo(h01), a[1] - bf_hi(h01)), l23 = pk_bf16(a[2] - bf_lo(h23), a[3] - bf_hi(h23));
                const int kc = kt * 16 + 4 * fq;
                const int so = tile_off(vt * 16 + fr, kc >> 3) + (kc & 7) * 2;
                *(uint2*)(lds + SH + so) = make_uint2(h01, h23);
                *(uint2*)(lds + SL + so) = make_uint2(l01, l23);
            }
        };
        for (int i = tid; i < LDS_END / 16; i += NTHREADS) *(uint4*)(lds + i * 16) = make_uint4(0, 0, 0, 0);
        if (wv >= 4) { load_lora(0); load_rkv(0); }
        __syncthreads();
        if (wv >= 4) { step_up(0); load_lora(1); }
        __syncthreads();
        if (wv >= 4) { step_vec(0); step_up(1); load_rkv(1); load_lora(2); }
        __syncthreads();
        if (wv >= 4) prod_V(0);
        __syncthreads();
        auto ystore = [&](int c) {
            const float4 y4 = *(const float4*)(lds + YB + (s_e * 64 + j0) * 4);
            *(uint2*)(ydst + (size_t)Rof(c, s_e) * 1024 + hh * 64 + j0) = make_uint2(pk_bf16(y4.x, y4.y), pk_bf16(y4.z, y4.w));
        };
        if (wv < 4) {
            for (int c = 0; c < 528; ++c) {
                if (c > 0) ystore(c - 1);
                prod_S(c);
                step_rec(c);
                __syncthreads();
                step_upd(c);
                __syncthreads();
            }
        } else {
            for (int c = 0; c < 528; ++c) {
                if (c + 1 < 528) step_vec(c + 1);
                if (c + 2 < 528) { step_up(c + 2); load_rkv(c + 2); }
                if (c + 3 < 528) load_lora(c + 3);
                __syncthreads();
                step_upd(c);
                if (c + 1 < 528) prod_V(c + 1);
                __syncthreads();
            }
        }
        if (wv < 4) ystore(527);
        __syncthreads();
    }
}

DEV void phase_rw_readout(const Params& p) {
    const int tid = tid_opaque(), lane = tid & 63, wv = tid >> 6, wm = wv >> 2, wn = wv & 3;
    const int fr = lane & 15, fq = lane >> 4;
    unsigned char* ws = p.ws;
    const bf16_t* y0b = (const bf16_t*)(ws + WS_S + 0 * U_BYTES);
    const bf16_t* y1b = (const bf16_t*)(ws + WS_S + 2 * U_BYTES);
    const bf16_t* vb = (const bf16_t*)(ws + WS_S + 1 * U_BYTES);
    const bf16_t* lora = (const bf16_t*)(ws + WS_S + 4 * U_BYTES);
    const bf16_t* g2t = (const bf16_t*)(ws + WS_G2T);
    bf16_t* ao = (bf16_t*)(ws + WS_S + 5 * U_BYTES);
    const float* bon0 = (const float*)(ws + WS_BONUS);
    const float* bon1 = bon0 + (size_t)NB * 16 * 8448;
    const float* lnw = p.in[21];
    const float* lnb = p.in[22];
    const int nunits = (NT / 128) * 4;
    for (int u = blockIdx.x; u < nunits; u += gridDim.x) {
        const int mt = u >> 2, nt = u & 3, m0 = mt * 128;
        const int hh = nt * 4 + wn;
        f32x4 acc[4][4];
#pragma unroll
        for (int mi = 0; mi < 4; ++mi)
#pragma unroll
            for (int ni = 0; ni < 4; ++ni) acc[mi][ni] = (f32x4){0.f, 0.f, 0.f, 0.f};
#pragma unroll 2
        for (int ks = 0; ks < 4; ++ks) {
            bf16x8 af[4], bfr[4];
#pragma unroll
            for (int mi = 0; mi < 4; ++mi) af[mi] = *(const bf16x8*)(lora + (size_t)(m0 + wm * 64 + mi * 16 + fr) * 384 + 256 + ks * 32 + fq * 8);
#pragma unroll
            for (int ni = 0; ni < 4; ++ni) bfr[ni] = *(const bf16x8*)(g2t + (size_t)(hh * 64 + ni * 16 + fr) * 128 + ks * 32 + fq * 8);
#pragma unroll
            for (int mi = 0; mi < 4; ++mi)
#pragma unroll
                for (int ni = 0; ni < 4; ++ni) acc[mi][ni] = __builtin_amdgcn_mfma_f32_16x16x32_bf16(bfr[ni], af[mi], acc[mi][ni], 0, 0, 0);
        }
#pragma unroll
        for (int mi = 0; mi < 4; ++mi) {
            const size_t R = (size_t)(m0 + wm * 64 + mi * 16 + fr);
            float yv[4][4]; float sum = 0.f;
#pragma unroll
            for (int ni = 0; ni < 4; ++ni) {
                const int col = hh * 64 + ni * 16 + 4 * fq;
                const uint2 a = *(const uint2*)(y0b + R * 1024 + col), b2 = *(const uint2*)(y1b + R * 1024 + col);
                yv[ni][0] = bf_lo(a.x) + bf_lo(b2.x); yv[ni][1] = bf_hi(a.x) + bf_hi(b2.x); yv[ni][2] = bf_lo(a.y) + bf_lo(b2.y); yv[ni][3] = bf_hi(a.y) + bf_hi(b2.y);
                sum += (yv[ni][0] + yv[ni][1]) + (yv[ni][2] + yv[ni][3]);
            }
            sum += __shfl_xor(sum, 16); sum += __shfl_xor(sum, 32);
            const float mu = sum * (1.0f / 64.0f);
            float q = 0.f;
#pragma unroll
            for (int ni = 0; ni < 4; ++ni)
#pragma unroll
                for (int j = 0; j < 4; ++j) { const float dlt = yv[ni][j] - mu; q += dlt * dlt; }
            q += __shfl_xor(q, 16); q += __shfl_xor(q, 32);
            const float rstd = rsqrtf(q * (1.0f / 64.0f) + 64e-5f);
            const size_t bidx = (size_t)(((R < NL ? (R >> 13) : ((R - NL) >> 8)) * 16 + hh)) * 8448 + (R < NL ? 256 + (R & 8191) : ((R - NL) & 255));
            const float bs = bon0[bidx] + bon1[bidx];
#pragma unroll
            for (int ni = 0; ni < 4; ++ni) {
                const int col = hh * 64 + ni * 16 + 4 * fq;
                const uint2 vv = *(const uint2*)(vb + R * 1024 + col);
                const float4 lw = *(const float4*)(lnw + col), lb = *(const float4*)(lnb + col);
                const float o0 = ((yv[ni][0] - mu) * rstd * lw.x + lb.x + bs * bf_lo(vv.x)) * acc[mi][ni][0];
                const float o1 = ((yv[ni][1] - mu) * rstd * lw.y + lb.y + bs * bf_hi(vv.x)) * acc[mi][ni][1];
                const float o2 = ((yv[ni][2] - mu) * rstd * lw.z + lb.z + bs * bf_lo(vv.y)) * acc[mi][ni][2];
                const float o3 = ((yv[ni][3] - mu) * rstd * lw.w + lb.w + bs * bf_hi(vv.y)) * acc[mi][ni][3];
                *(uint2*)(ao + R * 1024 + col) = make_uint2(pk_bf16(o0, o1), pk_bf16(o2, o3));
            }
        }
    }
}

DEV void phase_wo(const Params& p, unsigned char* lds, int layer) {
    unsigned char* ws = p.ws;
    const bf16_t* ao = (const bf16_t*)(ws + WS_S + (size_t)(layer ? 0 : 5) * U_BYTES);
    const bf16_t* wot = (const bf16_t*)(ws + (layer ? WS_WO1 : WS_WO0));
    float* ctxr = (float*)(ws + WS_CTXR);
    const float* gate = (const float*)(ws + WS_MOD) + (size_t)layer * 9 * 6144 + 2 * 1024;
    const int M = layer ? NL : NT;
    pg8::Gemm g{ao, wot, M, 1024, 1024};
    pg8::StaticOrder so; so.init(M, 1024, gridDim.x, blockIdx.x);
    pg8::EpiResid256 ep{layer ? p.out : p.in[0], layer ? ctxr : p.in[2], p.out, ctxr, gate};
    pg8::gemm_phase((PG8_LAS unsigned char*)lds, g, so, ep, nullptr);
    __syncthreads();
}

struct EpiQTile {
    unsigned char* lds;
    DEV void operator()(const f32x4 (&acc)[4][4], int m0, int wm, int wn, int fr, int fq) const {
        const int pp = wn >> 1;
#pragma unroll
        for (int mi = 0; mi < 4; ++mi) {
            const int m = wm * 64 + mi * 16 + fr;
#pragma unroll
            for (int ni = 0; ni < 4; ++ni) {
                const int c = (wn & 1) * 64 + ni * 16 + 4 * fq;
                *(uint2*)(lds + pp * 32768 + m * 256 + (((c >> 3) ^ (m & 15)) << 4) + (c & 7) * 2) = make_uint2(pk_bf16(acc[mi][ni][0], acc[mi][ni][1]), pk_bf16(acc[mi][ni][2], acc[mi][ni][3]));
            }
        }
    }
};
DEV void phase_peer_select(const Params& p, unsigned char* lds, int layer) {
    const int tid = tid_opaque(), lane = tid & 63, wv = tid >> 6, wm = wv >> 2, wn = wv & 3;
    const int fr = lane & 15, fq = lane >> 4;
    unsigned char* ws = p.ws;
    const bf16_t* hp = (const bf16_t*)(ws + WS_S + (size_t)(layer ? 0 : 1) * U_BYTES);
    const bf16_t* wqt = (const bf16_t*)(ws + WS_WQ) + (size_t)layer * 2048 * 1024;
    const bf16_t* keys = (const bf16_t*)(ws + WS_KEYS) + (size_t)layer * 8 * 2 * 128 * 128;
    int* pl_idx = (int*)(ws + WS_S + 3 * U_BYTES);
    float* pl_gate = (float*)(ws + WS_S + 3 * U_BYTES + (size_t)NT * 128 * 4);
    unsigned* slist = (unsigned*)lds;
    unsigned* tlist = (unsigned*)(lds + 256 * 132 * 4);
    const int mtiles = layer ? NL / 128 : NT / 128;
    for (int u = blockIdx.x; u < mtiles * 8; u += gridDim.x) {
        const int mt = u >> 3, head = u & 7, m0 = mt * 128;
        ALoadPlain al{hp, 1024};
        EpiQTile ep{lds};
        gemm_unit<256>(lds, al, wqt + (size_t)head * 256 * 1024, 1024, m0, ep);
        __syncthreads();
        const int pp = wn >> 1, nk0 = (wn & 1) * 64;
        f32x4 sc[4][4];
#pragma unroll
        for (int mi = 0; mi < 4; ++mi)
#pragma unroll
            for (int ni = 0; ni < 4; ++ni) sc[mi][ni] = (f32x4){0.f, 0.f, 0.f, 0.f};
        const bf16_t* kb = keys + (size_t)(head * 2 + pp) * 16384;
#pragma unroll
        for (int ks = 0; ks < 4; ++ks) {
            bf16x8 af[4], bfr[4];
            const int ch = ks * 4 + fq;
#pragma unroll
            for (int mi = 0; mi < 4; ++mi) { const int m = wm * 64 + mi * 16 + fr; af[mi] = *(const bf16x8*)(lds + pp * 32768 + m * 256 + ((ch ^ (m & 15)) << 4)); }
#pragma unroll
            for (int ni = 0; ni < 4; ++ni) bfr[ni] = *(const bf16x8*)(kb + (size_t)(nk0 + ni * 16 + fr) * 128 + ks * 32 + fq * 8);
#pragma unroll
            for (int mi = 0; mi < 4; ++mi)
#pragma unroll
                for (int ni = 0; ni < 4; ++ni) sc[mi][ni] = __builtin_amdgcn_mfma_f32_16x16x32_bf16(bfr[ni], af[mi], sc[mi][ni], 0, 0, 0);
        }
        __syncthreads();
#pragma unroll
        for (int mi = 0; mi < 4; ++mi) {
            const int m = wm * 64 + mi * 16 + fr;
#pragma unroll
            for (int ni = 0; ni < 4; ++ni) {
                const int n = nk0 + ni * 16 + 4 * fq;
                uint4 o;
                o.x = (mono_u32(sc[mi][ni][0]) & ~127u) | (unsigned)(127 - (n + 0));
                o.y = (mono_u32(sc[mi][ni][1]) & ~127u) | (unsigned)(127 - (n + 1));
                o.z = (mono_u32(sc[mi][ni][2]) & ~127u) | (unsigned)(127 - (n + 2));
                o.w = (mono_u32(sc[mi][ni][3]) & ~127u) | (unsigned)(127 - (n + 3));
                *(uint4*)(slist + (size_t)(pp * 128 + m) * 132 + n) = o;
            }
        }
        __syncthreads();
#pragma unroll 1
        for (int ps = 0; ps < 4; ++ps) {
            const int L = ps * 64 + (tid >> 3), g8 = tid & 7;
            unsigned t[16];
            {
                const unsigned* srcp = slist + (size_t)L * 132 + g8 * 16;
#pragma unroll
                for (int i = 0; i < 4; ++i) { const uint4 v = *(const uint4*)(srcp + i * 4); t[4 * i] = v.x; t[4 * i + 1] = v.y; t[4 * i + 2] = v.z; t[4 * i + 3] = v.w; }
            }
#pragma unroll
            for (int k = 2; k <= 16; k <<= 1)
#pragma unroll
                for (int j = k >> 1; j > 0; j >>= 1)
#pragma unroll
                    for (int i = 0; i < 16; ++i) {
                        const int l = i ^ j;
                        if (l > i) {
                            const unsigned mx = max(t[i], t[l]), mn = min(t[i], t[l]);
                            if ((i & k) == 0) { t[i] = mx; t[l] = mn; } else { t[i] = mn; t[l] = mx; }
                        }
                    }
#pragma unroll
            for (int rnd = 0; rnd < 3; ++rnd) {
                unsigned c[16];
#pragma unroll
                for (int i = 0; i < 16; ++i) {
                    const int src_i = __float_as_int(__uint_as_float(t[15 - i]));
                    const int b = rnd == 0 ? __builtin_amdgcn_update_dpp(0, src_i, 0xB1, 0xF, 0xF, false)
                                : (rnd == 1 ? __builtin_amdgcn_update_dpp(0, src_i, 0x4E, 0xF, 0xF, false)
                                            : __builtin_amdgcn_update_dpp(0, src_i, 0x141, 0xF, 0xF, false));
                    c[i] = max(t[i], (unsigned)b);
                }
#pragma unroll
                for (int j = 8; j > 0; j >>= 1)
#pragma unroll
                    for (int i = 0; i < 16; ++i) {
                        const int l = i ^ j;
                        if (l > i) { const unsigned mx = max(c[i], c[l]), mn = min(c[i], c[l]); c[i] = mx; c[l] = mn; }
                    }
#pragma unroll
                for (int i = 0; i < 16; ++i) t[i] = c[i];
            }
            if (g8 == 0) {
#pragma unroll
                for (int i = 0; i < 4; ++i) *(uint4*)(tlist + L * 16 + i * 4) = make_uint4(t[4 * i], t[4 * i + 1], t[4 * i + 2], t[4 * i + 3]);
            }
        }
        __syncthreads();
        if (tid < 128) {
            float v0[16], v1[16];
#pragma unroll
            for (int i = 0; i < 16; ++i) { v0[i] = unmono_u32(tlist[tid * 16 + i] & ~127u); v1[i] = unmono_u32(tlist[(128 + tid) * 16 + i] & ~127u); }
            unsigned cd[16];
#pragma unroll
            for (int i = 0; i < 16; ++i) cd[i] = 0u;
#pragma unroll
            for (int i = 0; i < 16; ++i) {
#pragma unroll
                for (int j = 0; j < 16; ++j) {
                    if ((i + 1) * (j + 1) <= 16) {
                        unsigned x = (mono_u32(v0[i] + v1[j]) & ~255u) | (unsigned)(255 - (i * 16 + j));
#pragma unroll
                        for (int q = 0; q < 16; ++q) { const unsigned mx = max(cd[q], x); x = min(cd[q], x); cd[q] = mx; }
                    }
                }
            }
            float sv[16]; int ex[16];
#pragma unroll
            for (int q = 0; q < 16; ++q) {
                const int slot = 255 - (int)(cd[q] & 255u);
                const unsigned a = tlist[tid * 16 + (slot >> 4)], b2 = tlist[(128 + tid) * 16 + (slot & 15)];
                sv[q] = unmono_u32(a & ~127u) + unmono_u32(b2 & ~127u);
                ex[q] = (127 - (int)(a & 127u)) * 128 + (127 - (int)(b2 & 127u));
            }
            float mx = sv[0];
#pragma unroll
            for (int q = 1; q < 16; ++q) mx = fmaxf(mx, sv[q]);
            float den = 0.f;
#pragma unroll
            for (int q = 0; q < 16; ++q) { sv[q] = __expf(sv[q] - mx); den += sv[q]; }
            const float rden = 1.0f / den;
            const size_t base = ((size_t)head * NT + (m0 + tid)) * 16;
#pragma unroll
            for (int i = 0; i < 4; ++i) {
                *(int4*)(pl_idx + base + i * 4) = make_int4(ex[4 * i], ex[4 * i + 1], ex[4 * i + 2], ex[4 * i + 3]);
                *(float4*)(pl_gate + base + i * 4) = make_float4(sv[4 * i] * rden, sv[4 * i + 1] * rden, sv[4 * i + 2] * rden, sv[4 * i + 3] * rden);
            }
        }
        __syncthreads();
    }
}

typedef float f32x2 __attribute__((ext_vector_type(2)));
typedef unsigned int u32x4 __attribute__((ext_vector_type(4)));
typedef unsigned int u32x2 __attribute__((ext_vector_type(2)));
#define PS_LOAD(buf, ee, h) { _Pragma("unroll") for (int e = 0; e < 8; ++e) { \
        const u32x4 t4 = __builtin_amdgcn_raw_buffer_load_b128(rs, ((unsigned)ee[(h) * 8 + e] << 7) + ch16, 0, 0); buf[e] = make_uint4(t4.x, t4.y, t4.z, t4.w); } }
#define PS_IDX(ee, Rr) { _Pragma("unroll") for (int i = 0; i < 4; ++i) { const int4 t = *(const int4*)(pl_idx + ((size_t)sub * NT + (Rr)) * 16 + 4 * i); \
        ee[4 * i] = t.x; ee[4 * i + 1] = t.y; ee[4 * i + 2] = t.z; ee[4 * i + 3] = t.w; } }
DEV void phase_peer_u(const Params& p, int layer) {
    const int tid = tid_opaque(), lane = tid & 63, sub = lane >> 3, ch = lane & 7;
    const int ng = gridDim.x >> 3, x = blockIdx.x & 7, wq = blockIdx.x >> 3;
    if (wq < ng) {
        const int gw = __builtin_amdgcn_readfirstlane(wq * 8 + (tid >> 6)), nw = ng * 8;
        unsigned char* ws = p.ws;
        const bf16_t* hp = (const bf16_t*)(ws + WS_S + (size_t)(layer ? 0 : 1) * U_BYTES) + 128 * x + 16 * ch;
        const __amdgpu_buffer_rsrc_t rs = __builtin_amdgcn_make_buffer_rsrc((void*)(ws + WS_PU + ((size_t)layer * 8 + x) * (16384 * 128)), 0, 16384 * 128, 0x00020000);
        const int* pl_idx = (const int*)(ws + WS_S + 3 * U_BYTES);
        float* pd = (float*)(ws + WS_S + 4 * U_BYTES) + (size_t)x * NT * 128 + 2 * lane;
        const unsigned ch16 = 16u * (unsigned)ch;
        const int nrows = layer ? NL : NT;
        uint4 bufA[8], bufB[8];
        int eC[16], eN[16];
        uint4 xw0 = make_uint4(0, 0, 0, 0), xw1 = xw0;
#define PU_DOT(buf, h) { _Pragma("unroll") for (int e = 0; e < 8; ++e) { \
        const unsigned uw[4] = {buf[e].x, buf[e].y, buf[e].z, buf[e].w}; f32x2 s2 = {0.f, 0.f}; \
        _Pragma("unroll") for (int i = 0; i < 4; ++i) { \
            const f32x2 a = __builtin_amdgcn_cvt_pk_f32_fp8((int)uw[i], false), b2 = __builtin_amdgcn_cvt_pk_f32_fp8((int)uw[i], true); \
            s2 += a * x2[2 * i] + b2 * x2[2 * i + 1]; } \
        float s = s2.x + s2.y; s += dpp_quad<0xB1>(s); s += dpp_quad<0x4E>(s); s += dpp_quad<0x141>(s); \
        if (ch == (((h) * 8 + e) >> 1)) { if (((h) * 8 + e) & 1) o1 = s; else o0 = s; } } }
        int R = gw;
#pragma unroll
        for (int i = 0; i < 16; ++i) { eC[i] = 0; eN[i] = 0; }
        if (R < nrows) { PS_IDX(eC, R); xw0 = *(const uint4*)(hp + (size_t)R * 1024); xw1 = *(const uint4*)(hp + (size_t)R * 1024 + 8); PS_LOAD(bufA, eC, 0); }
        for (; R < nrows; R += nw) {
            const int Rn = R + nw;
            uint4 nx0 = make_uint4(0, 0, 0, 0), nx1 = nx0;
            if (Rn < nrows) { PS_IDX(eN, Rn); nx0 = *(const uint4*)(hp + (size_t)Rn * 1024); nx1 = *(const uint4*)(hp + (size_t)Rn * 1024 + 8); }
            PS_LOAD(bufB, eC, 1);
            f32x2 x2[8];
            x2[0] = (f32x2){bf_lo(xw0.x), bf_hi(xw0.x)}; x2[1] = (f32x2){bf_lo(xw0.y), bf_hi(xw0.y)}; x2[2] = (f32x2){bf_lo(xw0.z), bf_hi(xw0.z)}; x2[3] = (f32x2){bf_lo(xw0.w), bf_hi(xw0.w)};
            x2[4] = (f32x2){bf_lo(xw1.x), bf_hi(xw1.x)}; x2[5] = (f32x2){bf_lo(xw1.y), bf_hi(xw1.y)}; x2[6] = (f32x2){bf_lo(xw1.z), bf_hi(xw1.z)}; x2[7] = (f32x2){bf_lo(xw1.w), bf_hi(xw1.w)};
            float o0 = 0.f, o1 = 0.f;
            PU_DOT(bufA, 0);
            if (Rn < nrows) { PS_LOAD(bufA, eN, 0); }
            PU_DOT(bufB, 1);
            *(float2*)(pd + (size_t)R * 128) = make_float2(o0, o1);
#pragma unroll
            for (int i = 0; i < 16; ++i) eC[i] = eN[i];
            xw0 = nx0; xw1 = nx1;
        }
    }
}
DEV void phase_peer_c(const Params& p, int layer) {
    const int tid = tid_opaque(), lane = tid & 63, sub = lane >> 3, ch = lane & 7;
    const int gw = blockIdx.x * 8 + (tid >> 6), nw = gridDim.x * 8;
    unsigned char* ws = p.ws;
    const float* usc = (const float*)(ws + WS_PSC) + layer * 16384;
    const float* vsc = (const float*)(ws + WS_PSC) + 32768 + layer * 16384;
    const int* pl_idx = (const int*)(ws + WS_S + 3 * U_BYTES);
    const float* pl_gate = (const float*)(ws + WS_S + 3 * U_BYTES + (size_t)NT * 128 * 4);
    float* pd = (float*)(ws + WS_S + 4 * U_BYTES) + 2 * lane;
    const int nrows = layer ? NL : NT;
    for (int R = gw; R < nrows; R += nw) {
        float d0 = 0.f, d1 = 0.f;
#pragma unroll
        for (int xx = 0; xx < 8; ++xx) { const float2 t = *(const float2*)(pd + ((size_t)xx * NT + R) * 128); d0 += t.x; d1 += t.y; }
        const size_t po = ((size_t)sub * NT + R) * 16 + 2 * ch;
        const int2 e = *(const int2*)(pl_idx + po);
        const float2 g = *(const float2*)(pl_gate + po);
        d0 *= usc[e.x]; d1 *= usc[e.y];
        const float c0 = g.x * vsc[e.x] * 0.5f * d0 * (1.0f + erff(d0 * 0.70710678118f));
        const float c1 = g.y * vsc[e.y] * 0.5f * d1 * (1.0f + erff(d1 * 0.70710678118f));
        *(float2*)(pd + (size_t)R * 128) = make_float2(c0, c1);
    }
}
DEV void phase_peer_v(const Params& p, int layer) {
    const int tid = tid_opaque(), lane = tid & 63, sub = lane >> 3, ch = lane & 7;
    const int ng = gridDim.x >> 3, x = blockIdx.x & 7, wq = blockIdx.x >> 3;
    if (wq < ng) {
        const int gw = __builtin_amdgcn_readfirstlane(wq * 8 + (tid >> 6)), nw = ng * 8;
        unsigned char* ws = p.ws;
        const __amdgpu_buffer_rsrc_t rs = __builtin_amdgcn_make_buffer_rsrc((void*)(ws + WS_PV + ((size_t)layer * 8 + x) * (16384 * 128)), 0, 16384 * 128, 0x00020000);
        const int* pl_idx = (const int*)(ws + WS_S + 3 * U_BYTES);
        const float* cb = (const float*)(ws + WS_S + 4 * U_BYTES) + 16 * sub;
        float* ctxr = (float*)(ws + WS_CTXR);
        const float* mods = (const float*)(ws + WS_MOD) + (size_t)layer * 9 * 6144 + 5 * 1024;
        const unsigned ch16 = 16u * (unsigned)ch;
        const int col = 128 * x + 16 * ch + 2 * sub;
        const int nrows = layer ? NL : NT;
        uint4 bufA[8], bufB[8];
        int eC[16], eN[16];
        float cC[16], cN[16];
#define PS_CF(cc, Rr) { _Pragma("unroll") for (int i = 0; i < 4; ++i) { const float4 t = *(const float4*)(cb + (size_t)(Rr) * 128 + 4 * i); \
        cc[4 * i] = t.x; cc[4 * i + 1] = t.y; cc[4 * i + 2] = t.z; cc[4 * i + 3] = t.w; } }
#define PV_AXPY(buf, h) { _Pragma("unroll") for (int e = 0; e < 8; ++e) { \
        const float cf = cC[(h) * 8 + e]; const f32x2 cf2 = {cf, cf}; const unsigned vw[4] = {buf[e].x, buf[e].y, buf[e].z, buf[e].w}; \
        _Pragma("unroll") for (int i = 0; i < 4; ++i) { \
            const f32x2 a = __builtin_amdgcn_cvt_pk_f32_fp8((int)vw[i], false), b2 = __builtin_amdgcn_cvt_pk_f32_fp8((int)vw[i], true); \
            acc2[2 * i] += cf2 * a; acc2[2 * i + 1] += cf2 * b2; } } }
        int R = gw;
#pragma unroll
        for (int i = 0; i < 16; ++i) { eC[i] = 0; eN[i] = 0; cC[i] = 0.f; cN[i] = 0.f; }
        if (R < nrows) { PS_IDX(eC, R); PS_CF(cC, R); PS_LOAD(bufA, eC, 0); }
        for (; R < nrows; R += nw) {
            const int Rn = R + nw;
            if (Rn < nrows) { PS_IDX(eN, Rn); PS_CF(cN, Rn); }
            PS_LOAD(bufB, eC, 1);
            float* xrow = (R < NL ? p.out + (size_t)R * 1024 : ctxr + (size_t)(R - NL) * 1024) + col;
            const float2 xa = *(const float2*)xrow, ga = *(const float2*)(mods + (size_t)mod_batch(R) * 6144 + col);
            f32x2 acc2[8];
#pragma unroll
            for (int i = 0; i < 8; ++i) acc2[i] = (f32x2){0.f, 0.f};
            PV_AXPY(bufA, 0);
            if (Rn < nrows) { PS_LOAD(bufA, eN, 0); }
            PV_AXPY(bufB, 1);
            float a16[16];
#pragma unroll
            for (int i = 0; i < 8; ++i) { a16[2 * i] = acc2[i].x; a16[2 * i + 1] = acc2[i].y; }
            float s8[8], t4[4];
#pragma unroll
            for (int j = 0; j < 8; ++j) { const u32x2 r = __builtin_amdgcn_permlane32_swap(__float_as_uint(a16[j]), __float_as_uint(a16[8 + j]), false, false); s8[j] = __uint_as_float(r.x) + __uint_as_float(r.y); }
#pragma unroll
            for (int j = 0; j < 4; ++j) { const u32x2 r = __builtin_amdgcn_permlane16_swap(__float_as_uint(s8[j]), __float_as_uint(s8[4 + j]), false, false); t4[j] = __uint_as_float(r.x) + __uint_as_float(r.y); }
            const float wa0 = t4[0] + dpp_ror<8>(t4[0]), wa1 = t4[1] + dpp_ror<8>(t4[1]), wb0 = t4[2] + dpp_ror<8>(t4[2]), wb1 = t4[3] + dpp_ror<8>(t4[3]);
            const float w0 = (lane & 8) ? wb0 : wa0, w1 = (lane & 8) ? wb1 : wa1;
            *(float2*)xrow = make_float2(xa.x + ga.x * w0, xa.y + ga.y * w1);
#pragma unroll
            for (int i = 0; i < 16; ++i) { eC[i] = eN[i]; cC[i] = cN[i]; }
        }
    }
}
DEV void phase_final_norm(const Params& p) {
    const int tid = tid_opaque(), lane = tid & 63;
    const int gw = blockIdx.x * 8 + (tid >> 6), nw = gridDim.x * 8;
    const float* gn = p.in[34];
    for (int R = gw; R < NL; R += nw) {
        float* xr = p.out + (size_t)R * 1024;
        float4 v[4]; float ss = 0.f;
#pragma unroll
        for (int i = 0; i < 4; ++i) { v[i] = *(const float4*)(xr + i * 256 + lane * 4); ss += v[i].x * v[i].x + v[i].y * v[i].y + v[i].z * v[i].z + v[i].w * v[i].w; }
        ss = wave_allreduce(ss);
        const float rs = rsqrtf(ss * (1.0f / 1024.0f) + 1e-6f);
#pragma unroll
        for (int i = 0; i < 4; ++i) {
            const float4 gg = *(const float4*)(gn + i * 256 + lane * 4);
            *(float4*)(xr + i * 256 + lane * 4) = make_float4(v[i].x * rs * gg.x, v[i].y * rs * gg.y, v[i].z * rs * gg.z, v[i].w * rs * gg.w);
        }
    }
}

DEV void phase_gla_proj(const Params& p, unsigned char* lds) {
    unsigned char* ws = p.ws;
    const bf16_t* h = (const bf16_t*)(ws + WS_S + 0 * U_BYTES);
    const bf16_t* wint = (const bf16_t*)(ws + WS_WIN);
    {
        pg8::Gemm g{h, wint, NT, 3072, 1024};
        pg8::StaticOrder so; so.init(NT, 3072, gridDim.x, blockIdx.x);
        pg8::EpiBf16Tiles ep{(bf16_t*)(ws + WS_S + 1 * U_BYTES), 2048, 8, (bf16_t*)(ws + WS_S + 3 * U_BYTES), 1024};
        pg8::gemm_phase(( PG8_LAS unsigned char*)lds, g, so, ep, nullptr);
    }
    __syncthreads();
    for (int u = blockIdx.x; u < NT / 128; u += gridDim.x) {
        ALoadPlain al{h, 1024};
        EpiLr ep{(float*)(ws + WS_LR)};
        gemm_unit<128>(lds, al, wint + (size_t)3072 * 1024, 1024, u * 128, ep);
    }
}

DEV void conv_emit(const float (&acc)[8], int c, bf16_t* dst) {
    const float qs = (c < 512) ? 0.08838834764831845f : 1.0f;
    unsigned ow[4];
#pragma unroll
    for (int j = 0; j < 4; ++j) { const float a0 = acc[2 * j], a1 = acc[2 * j + 1]; ow[j] = pk_bf16(a0 * sigmoidf_(a0) * qs, a1 * sigmoidf_(a1) * qs); }
    *(uint4*)dst = make_uint4(ow[0], ow[1], ow[2], ow[3]);
}
DEV void conv_tap(float (&acc)[8], const uint4& v, const float (&w)[8]) {
    acc[0] += bf_lo(v.x) * w[0]; acc[1] += bf_hi(v.x) * w[1]; acc[2] += bf_lo(v.y) * w[2]; acc[3] += bf_hi(v.y) * w[3];
    acc[4] += bf_lo(v.z) * w[4]; acc[5] += bf_hi(v.z) * w[5]; acc[6] += bf_lo(v.w) * w[6]; acc[7] += bf_hi(v.w) * w[7];
}
DEV void phase_gla_conv(const Params& p) {
    const int tid = tid_opaque();
    unsigned char* ws = p.ws;
    const bf16_t* z = (const bf16_t*)(ws + WS_S + 1 * U_BYTES);
    bf16_t* o = (bf16_t*)(ws + WS_S + 4 * U_BYTES);
    const float* cw = p.in[25];
    const int x = tid >> 3, cl = (tid & 7) * 8;
    for (int task = blockIdx.x; task < 8 * 8 * 32; task += gridDim.x) {
        const int cb = task & 31, ys = (task >> 5) & 7, b = task >> 8;
        const int c = cb * 64 + cl;
        float w[9][8];
#pragma unroll
        for (int t = 0; t < 9; ++t) { const float4 w0 = *(const float4*)(cw + t * 2048 + c), w1 = *(const float4*)(cw + t * 2048 + c + 4); w[t][0] = w0.x; w[t][1] = w0.y; w[t][2] = w0.z; w[t][3] = w0.w; w[t][4] = w1.x; w[t][5] = w1.y; w[t][6] = w1.z; w[t][7] = w1.w; }
        const uint4 zero4 = make_uint4(0, 0, 0, 0);
        auto load_row = [&](int y, uint4 (&r)[3]) {
            if (y < 0 || y >= 128) { r[0] = zero4; r[1] = zero4; r[2] = zero4; return; }
            const bf16_t* row = z + ((size_t)b * 8192 + (size_t)y * 64 + x) * 2048 + c;
            r[1] = *(const uint4*)row;
            r[0] = (x > 0) ? *(const uint4*)(row - 2048) : zero4;
            r[2] = (x < 63) ? *(const uint4*)(row + 2048) : zero4;
        };
        uint4 r0[3], r1[3], r2[3], r3[3];
        const int y0 = ys * 16;
        load_row(y0 - 1, r0); load_row(y0, r1); load_row(y0 + 1, r2);
#pragma unroll 1
        for (int yy = 0; yy < 16; ++yy) {
            load_row(yy < 15 ? y0 + yy + 2 : -1, r3);
            float acc[8];
#pragma unroll
            for (int j = 0; j < 8; ++j) acc[j] = 0.f;
#pragma unroll
            for (int dx = 0; dx < 3; ++dx) { conv_tap(acc, r0[dx], w[dx]); conv_tap(acc, r1[dx], w[3 + dx]); conv_tap(acc, r2[dx], w[6 + dx]); }
            conv_emit(acc, c, o + ((size_t)b * 8192 + (size_t)(y0 + yy) * 64 + x) * 2048 + c);
#pragma unroll
            for (int dx = 0; dx < 3; ++dx) { r0[dx] = r1[dx]; r1[dx] = r2[dx]; r2[dx] = r3[dx]; }
        }
    }
    for (int task = blockIdx.x; task < (NC / 64) * 8; task += gridDim.x) {
        const int rb = task >> 3, cbk = task & 7;
        const int R = NL + rb * 64 + (tid >> 3);
        const int t = (R - NL) & 255;
#pragma unroll 1
        for (int i = 0; i < 4; ++i) {
            const int c = cbk * 256 + (tid & 7) * 8 + i * 64;
            float acc[8];
#pragma unroll
            for (int j = 0; j < 8; ++j) acc[j] = 0.f;
#pragma unroll
            for (int dx = -1; dx <= 1; ++dx) {
                if (t + dx >= 0 && t + dx < 256) {
                    const uint4 v = *(const uint4*)(z + (size_t)(R + dx) * 2048 + c);
                    const float* wp = cw + (3 + (dx + 1)) * 2048 + c;
                    const float4 w0 = *(const float4*)wp, w1 = *(const float4*)(wp + 4);
                    const float wv[8] = {w0.x, w0.y, w0.z, w0.w, w1.x, w1.y, w1.z, w1.w};
                    conv_tap(acc, v, wv);
                }
            }
            conv_emit(acc, c, o + (size_t)R * 2048 + c);
        }
    }
}

constexpr int GT_QE = 0, GT_KET = 16384, GT_A = 32768, GT_CONST = 40960, GT_STRIDE = 43008;
constexpr int GT_N0 = (int)((2 * U_BYTES) / GT_STRIDE);
constexpr size_t WS_TOTAL = 1073741824ull;
static_assert((size_t)(NB * 4 * 2 * 132 - GT_N0) * GT_STRIDE <= WS_TOTAL - WS_END, "tile records do not fit");
DEV size_t gla_tile_off(int b, int hd, int d, int cc) {
    const int idx = (((b * 4 + hd) * 2 + d) * 132) + cc;
    return idx < GT_N0 ? WS_S + (size_t)idx * GT_STRIDE : WS_END + (size_t)(idx - GT_N0) * GT_STRIDE;
}
DEV int gla_row0(int b, int cc) { return cc < 4 ? NL + b * 256 + cc * 64 : b * 8192 + (cc - 4) * 64; }
DEV void phase_gla_prep(const Params& p, unsigned char* lds) {
    const int tid = tid_opaque(), lane = tid & 63, wv = tid >> 6;
    const int fr = lane & 15, fq = lane >> 4;
    unsigned char* ws = p.ws;
    constexpr int QE = 0, KE = 16384, KET = 32768, BC = 49152  , GS = 82944  , LRL = 86528  , BCS = 132;
    const bf16_t* qkv = (const bf16_t*)(ws + WS_S + 4 * U_BYTES);
    const float* lrb = (const float*)(ws + WS_LR);
    unsigned char* gt = ws;
    float* bc = (float*)(lds + BC);
    float* gs = (float*)(lds + GS);
    const int li = tid >> 3, lc = tid & 7;
    const int d = blockIdx.x & 1, hd = (blockIdx.x >> 1) & 3;
    bf16x8 gkf;
    {
        unsigned w4[4] = {0u, 0u, 0u, 0u};
        if (fq < 2) {
#pragma unroll
            for (int e2 = 0; e2 < 4; ++e2) {
                const float g0 = p.in[26][(size_t)(d * 16 + 8 * fq + 2 * e2) * 512 + hd * 128 + wv * 16 + fr];
                const float g1 = p.in[26][(size_t)(d * 16 + 8 * fq + 2 * e2 + 1) * 512 + hd * 128 + wv * 16 + fr];
                w4[e2] = pk_bf16(g0, g1);
            }
        }
        gkf = as_bf16x8(make_uint4(w4[0], w4[1], w4[2], w4[3]));
    }
    const float4 gb4 = *(const float4*)(p.in[27] + d * 512 + hd * 128 + wv * 16 + 4 * fq);
    const int qstep = (int)(gridDim.x >> 3);
    uint4 nq0, nq1, nk0, nk1; float2 nl;
    auto fetch = [&](int q) {
        const size_t R = (size_t)(gla_row0(q / 132, q % 132) + li);
        const bf16_t* row = qkv + R * 2048;
        nq0 = *(const uint4*)(row + hd * 128 + lc * 8); nq1 = *(const uint4*)(row + hd * 128 + 64 + lc * 8);
        nk0 = *(const uint4*)(row + 512 + hd * 128 + lc * 8); nk1 = *(const uint4*)(row + 512 + hd * 128 + 64 + lc * 8);
        nl = *(const float2*)(lrb + R * 32 + d * 16 + lc * 2);
    };
    int q = (int)(blockIdx.x >> 3);
    if (q < NB * 132) fetch(q);
    for (; q < NB * 132; q += qstep) {
        const int cc = q % 132, b = q / 132;
        unsigned char* rec = gt + gla_tile_off(b, hd, d, cc);
        const uint4 rq0 = nq0, rq1 = nq1, rk0 = nk0, rk1 = nk1; const float2 rl = nl;
        if (q + qstep < NB * 132) fetch(q + qstep);
        *(unsigned*)(lds + LRL + li * 32 + lc * 4) = pk_bf16(rl.x, rl.y);
        __syncthreads();
        {
            const float gbv[4] = {gb4.x, gb4.y, gb4.z, gb4.w};
#pragma unroll
            for (int itl = 0; itl < 4; ++itl) {
                uint4 lr4 = *(const uint4*)(lds + LRL + (itl * 16 + fr) * 32 + (fq & 1) * 16);
                if (fq >= 2) lr4 = make_uint4(0, 0, 0, 0);
                f32x4 a = {0.f, 0.f, 0.f, 0.f};
                a = __builtin_amdgcn_mfma_f32_16x16x32_bf16(gkf, as_bf16x8(lr4), a, 0, 0, 0);
                float s[4], tot[4];
#pragma unroll
                for (int j = 0; j < 4; ++j) {
                    const float xx = a[j] + gbv[j];
                    const float la = (fminf(xx, 0.f) - __logf(1.0f + __expf(-fabsf(xx)))) * (1.0f / 16.0f);
                    float pf = la;
                    pf += dpp_shr0<1>(pf); pf += dpp_shr0<2>(pf); pf += dpp_shr0<4>(pf); pf += dpp_shr0<8>(pf);
                    tot[j] = __shfl(pf, (lane & 48) | 15);
                    s[j] = d ? (tot[j] - pf + la) : pf;
                }
                *(float4*)(bc + (itl * 16 + fr) * BCS + wv * 16 + 4 * fq) = make_float4(s[0], s[1], s[2], s[3]);
                if (fr == 15) *(float4*)(gs + itl * 128 + wv * 16 + 4 * fq) = make_float4(tot[0], tot[1], tot[2], tot[3]);
            }
        }
        __syncthreads();
        if (tid < 128) {
            const float g0 = gs[tid], g1 = gs[128 + tid], g2 = gs[256 + tid], g3 = gs[384 + tid];
            const float refc = d ? (bc[31 * BCS + tid] + g2 + g3) : (bc[32 * BCS + tid] + g0 + g1), lastc = g0 + g1 + g2 + g3;
            const float dl = __expf(lastc), er = __expf(refc), el = __expf(lastc - refc);
            gs[512 + tid] = refc;
            float* cst = (float*)(rec + GT_CONST);
            cst[tid] = er; cst[128 + tid] = el; cst[256 + tid] = dl;
        }
        __syncthreads();
        {
            const int grp = li >> 4;
            const uint4 rqs[2] = {rq0, rq1}, rks[2] = {rk0, rk1};
#pragma unroll
            for (int hseg = 0; hseg < 2; ++hseg) {
                const int k0 = hseg * 64 + lc * 8;
                float bcv[8], refv[8];
#pragma unroll
                for (int j4 = 0; j4 < 2; ++j4) {
                    const float4 g0 = *(const float4*)(gs + k0 + j4 * 4), g1 = *(const float4*)(gs + 128 + k0 + j4 * 4);
                    const float4 g2 = *(const float4*)(gs + 256 + k0 + j4 * 4), g3 = *(const float4*)(gs + 384 + k0 + j4 * 4);
                    const float4 bi = *(const float4*)(bc + li * BCS + k0 + j4 * 4), rf = *(const float4*)(gs + 512 + k0 + j4 * 4);
                    const float g0a[4] = {g0.x, g0.y, g0.z, g0.w}, g1a[4] = {g1.x, g1.y, g1.z, g1.w}, g2a[4] = {g2.x, g2.y, g2.z, g2.w}, g3a[4] = {g3.x, g3.y, g3.z, g3.w};
                    const float bia[4] = {bi.x, bi.y, bi.z, bi.w}, rfa[4] = {rf.x, rf.y, rf.z, rf.w};
#pragma unroll
                    for (int j = 0; j < 4; ++j) {
                        const float pre = d ? ((grp < 1 ? g1a[j] : 0.f) + (grp < 2 ? g2a[j] : 0.f) + (grp < 3 ? g3a[j] : 0.f))
                                            : ((grp > 0 ? g0a[j] : 0.f) + (grp > 1 ? g1a[j] : 0.f) + (grp > 2 ? g2a[j] : 0.f));
                        bcv[j4 * 4 + j] = bia[j] + pre;
                        refv[j4 * 4 + j] = rfa[j];
                    }
                }
                const unsigned qw[4] = {rqs[hseg].x, rqs[hseg].y, rqs[hseg].z, rqs[hseg].w}, kw[4] = {rks[hseg].x, rks[hseg].y, rks[hseg].z, rks[hseg].w};
                unsigned oqe[4], oke[4];
#pragma unroll
                for (int j2 = 0; j2 < 4; ++j2) {
                    const float q0 = bf_lo(qw[j2]), q1 = bf_hi(qw[j2]), kk0 = bf_lo(kw[j2]), kk1 = bf_hi(kw[j2]);
                    const float e0 = __expf(bcv[2 * j2] - refv[2 * j2]), e1 = __expf(bcv[2 * j2 + 1] - refv[2 * j2 + 1]);
                    const float r0 = __builtin_amdgcn_rcpf(e0), r1 = __builtin_amdgcn_rcpf(e1);
                    oqe[j2] = pk_bf16(q0 * e0, q1 * e1);
                    oke[j2] = pk_bf16(kk0 * r0, kk1 * r1);
                    const int kc0 = k0 + 2 * j2;
                    *(bf16_t*)(lds + KET + tile_off2(kc0, li >> 3) + (li & 7) * 2) = (bf16_t)(oke[j2] & 0xffffu);
                    *(bf16_t*)(lds + KET + tile_off2(kc0 + 1, li >> 3) + (li & 7) * 2) = (bf16_t)(oke[j2] >> 16);
                }
                const int chq = hseg * 8 + lc;
                const int so = li * 256 + ((chq ^ (li & 15)) << 4);
                *(uint4*)(lds + QE + so) = make_uint4(oqe[0], oqe[1], oqe[2], oqe[3]);
                *(uint4*)(lds + KE + so) = make_uint4(oke[0], oke[1], oke[2], oke[3]);
                *(uint4*)(rec + GT_QE + so) = make_uint4(oqe[0], oqe[1], oqe[2], oqe[3]);
            }
        }
        __syncthreads();
        {
            const int it = wv & 3, pr2 = wv >> 2;
#pragma unroll
            for (int jj = 0; jj < 2; ++jj) {
                const int jt = pr2 * 2 + jj;
                f32x4 a = {0.f, 0.f, 0.f, 0.f};
                if (d ? (jt >= it) : (jt <= it)) {
#pragma unroll
                    for (int ks = 0; ks < 4; ++ks) {
                        const int ch = ks * 4 + fq;
                        const int rj = jt * 16 + fr, ri = it * 16 + fr;
                        const bf16x8 fa = *(const bf16x8*)(lds + KE + rj * 256 + ((ch ^ (rj & 15)) << 4));
                        const bf16x8 fb = *(const bf16x8*)(lds + QE + ri * 256 + ((ch ^ (ri & 15)) << 4));
                        a = __builtin_amdgcn_mfma_f32_16x16x32_bf16(fa, fb, a, 0, 0, 0);
                    }
                }
                const int i = it * 16 + fr, j = jt * 16 + 4 * fq;
                float av[4];
#pragma unroll
                for (int e = 0; e < 4; ++e) av[e] = (d ? (j + e >= i) : (j + e <= i)) ? a[e] : 0.f;
                *(uint2*)(rec + GT_A + i * 128 + (((j >> 3) ^ (i & 7)) << 4) + (j & 7) * 2) = make_uint2(pk_bf16(av[0], av[1]), pk_bf16(av[2], av[3]));
            }
#pragma unroll
            for (int i = 0; i < 2; ++i) *(uint4*)(rec + GT_KET + i * 8192 + tid * 16) = *(const uint4*)(lds + KET + i * 8192 + tid * 16);
        }
        __syncthreads();
    }
}

DEV void phase_gla_scan(const Params& p, unsigned char* lds) {
    const int tid = tid_opaque(), lane = tid & 63, wv = tid >> 6;
    const int fr = lane & 15, fq = lane >> 4;
    unsigned char* ws = p.ws;
    constexpr int QE = 0  , KET = 32768  , AL = 65536  , VT = 81920, ST = 90112  ;
    const bf16_t* qkv = (const bf16_t*)(ws + WS_S + 4 * U_BYTES);
    const unsigned char* gt = ws;
    for (int unit = blockIdx.x; unit < 256; unit += gridDim.x) {
        const int vs = unit & 3, d = (unit >> 2) & 1, hd = (unit >> 3) & 3, b = unit >> 5;
        bf16_t* odst = d ? (bf16_t*)(ws + WS_S + 2 * U_BYTES) : (bf16_t*)(ws + WS_S + 4 * U_BYTES);
        const int old_ = d ? 1024 : 2048;
        const int li = tid >> 3, lc = tid & 7;
        auto ccof = [&](int c) -> int { return d ? (c < 4 ? 3 - c : 135 - c) : c; };
        auto dma = [&](int cc, int buf) {
            const unsigned char* rec = gt + gla_tile_off(b, hd, d, cc);
#pragma unroll
            for (int i = 0; i < 2; ++i) {
                __builtin_amdgcn_global_load_lds((const unsigned*)(rec + GT_QE + i * 8192 + tid * 16), (unsigned*)(lds + QE + buf * 16384 + i * 8192 + tid * 16), 16, 0, 0);
                __builtin_amdgcn_global_load_lds((const unsigned*)(rec + GT_KET + i * 8192 + tid * 16), (unsigned*)(lds + KET + buf * 16384 + i * 8192 + tid * 16), 16, 0, 0);
            }
            __builtin_amdgcn_global_load_lds((const unsigned*)(rec + GT_A + tid * 16), (unsigned*)(lds + AL + buf * 8192 + tid * 16), 16, 0, 0);
        };
        uint4 nv; float4 n_dl, n_el, n_er;
        auto loads = [&](int c) {
            const int cc = ccof(c);
            nv = *(const uint4*)(qkv + (size_t)(gla_row0(b, cc) + li) * 2048 + 1024 + hd * 256 + vs * 64 + lc * 8);
            const float* cst = (const float*)(gt + gla_tile_off(b, hd, d, cc) + GT_CONST);
            n_el = *(const float4*)(cst + 128 + wv * 16 + 4 * fq); n_dl = *(const float4*)(cst + 256 + wv * 16 + 4 * fq);
            if (c + 1 < 132) n_er = *(const float4*)((const float*)(gt + gla_tile_off(b, hd, d, ccof(c + 1)) + GT_CONST) + wv * 16 + 4 * fq);
            else n_er = make_float4(0.f, 0.f, 0.f, 0.f);
        };
        f32x4 accS[4];
#pragma unroll
        for (int i = 0; i < 4; ++i) accS[i] = (f32x4){0.f, 0.f, 0.f, 0.f};
        for (int i = tid; i < 32768 / 16; i += NTHREADS) *(uint4*)(lds + ST + i * 16) = make_uint4(0, 0, 0, 0);
        dma(ccof(0), 0);
        loads(0);
        for (int c = 0; c < 132; ++c) {
            const int buf = c & 1, cc = ccof(c);
            const uint4 rv = nv; const float4 dl4 = n_dl, el4 = n_el, er4 = n_er;
            asm volatile("s_waitcnt vmcnt(0)" ::: "memory");
            {
                const unsigned vw[4] = {rv.x, rv.y, rv.z, rv.w};
#pragma unroll
                for (int j2 = 0; j2 < 4; ++j2) {
                    const int vc0 = lc * 8 + 2 * j2;
                    *(bf16_t*)(lds + VT + tile_off2(vc0, li >> 3) + (li & 7) * 2) = (bf16_t)(vw[j2] & 0xffffu);
                    *(bf16_t*)(lds + VT + tile_off2(vc0 + 1, li >> 3) + (li & 7) * 2) = (bf16_t)(vw[j2] >> 16);
                }
            }
            asm volatile("s_waitcnt lgkmcnt(0)" ::: "memory"); __builtin_amdgcn_s_barrier(); asm volatile("" ::: "memory");
            if (c + 1 < 132) { dma(ccof(c + 1), buf ^ 1); loads(c + 1); }
            const int it = wv & 3, pr2 = wv >> 2;
            const int r0 = gla_row0(b, cc);
#pragma unroll
            for (int vv = 0; vv < 2; ++vv) {
                const int vt = pr2 * 2 + vv;
                f32x4 a = {0.f, 0.f, 0.f, 0.f};
#pragma unroll
                for (int ks = 0; ks < 4; ++ks) {
                    const int ch = ks * 4 + fq;
                    const int rvv = vt * 16 + fr, ri = it * 16 + fr;
                    const bf16x8 fa = *(const bf16x8*)(lds + ST + buf * 16384 + rvv * 256 + ((ch ^ (rvv & 15)) << 4));
                    const bf16x8 fb = *(const bf16x8*)(lds + QE + buf * 16384 + ri * 256 + ((ch ^ (ri & 15)) << 4));
                    a = __builtin_amdgcn_mfma_f32_16x16x32_bf16(fa, fb, a, 0, 0, 0);
                }
#pragma unroll
                for (int ks = 0; ks < 2; ++ks) {
                    const int ch = ks * 4 + fq;
                    const int rvv = vt * 16 + fr, ri = it * 16 + fr;
                    const bf16x8 fa = *(const bf16x8*)(lds + VT + tile_off2(rvv, ch));
                    const bf16x8 fb = *(const bf16x8*)(lds + AL + buf * 8192 + ri * 128 + ((ch ^ (ri & 7)) << 4));
                    a = __builtin_amdgcn_mfma_f32_16x16x32_bf16(fa, fb, a, 0, 0, 0);
                }
                const int i = it * 16 + fr, vcol = vt * 16 + 4 * fq;
                *(uint2*)(odst + (size_t)(r0 + i) * old_ + hd * 256 + vs * 64 + vcol) = make_uint2(pk_bf16(a[0], a[1]), pk_bf16(a[2], a[3]));
            }
            {
                const int kt = wv;
                bf16x8 fa[2];
#pragma unroll
                for (int ks = 0; ks < 2; ++ks) fa[ks] = *(const bf16x8*)(lds + KET + buf * 16384 + tile_off2(kt * 16 + fr, ks * 4 + fq));
#pragma unroll
                for (int vt = 0; vt < 4; ++vt) {
                    f32x4 t = {0.f, 0.f, 0.f, 0.f};
#pragma unroll
                    for (int ks = 0; ks < 2; ++ks) t = __builtin_amdgcn_mfma_f32_16x16x32_bf16(fa[ks], *(const bf16x8*)(lds + VT + tile_off2(vt * 16 + fr, ks * 4 + fq)), t, 0, 0, 0);
                    f32x4 a = accS[vt];
                    a[0] = a[0] * dl4.x + t[0] * el4.x; a[1] = a[1] * dl4.y + t[1] * el4.y; a[2] = a[2] * dl4.z + t[2] * el4.z; a[3] = a[3] * dl4.w + t[3] * el4.w;
                    accS[vt] = a;
                    const int vcol = vt * 16 + fr, kcol = kt * 16 + 4 * fq;
                    *(uint2*)(lds + ST + (buf ^ 1) * 16384 + vcol * 256 + (((kcol >> 3) ^ (vcol & 15)) << 4) + (kcol & 7) * 2) =
                        make_uint2(pk_bf16(a[0] * er4.x, a[1] * er4.y), pk_bf16(a[2] * er4.z, a[3] * er4.w));
                }
            }
            asm volatile("s_waitcnt lgkmcnt(0)" ::: "memory"); __builtin_amdgcn_s_barrier(); asm volatile("" ::: "memory");
        }
        asm volatile("s_waitcnt vmcnt(0)" ::: "memory");
        __syncthreads();
    }
}

DEV void phase_gla_readout(const Params& p) {
    const int tid = tid_opaque(), lane = tid & 63;
    const int gw = blockIdx.x * 8 + (tid >> 6), nw = gridDim.x * 8;
    unsigned char* ws = p.ws;
    const bf16_t* o0 = (const bf16_t*)(ws + WS_S + 4 * U_BYTES);
    const bf16_t* o1 = (const bf16_t*)(ws + WS_S + 2 * U_BYTES);
    const bf16_t* gb = (const bf16_t*)(ws + WS_S + 3 * U_BYTES);
    bf16_t* ao = (bf16_t*)(ws + WS_S + 0 * U_BYTES);
    const float4 hn = *(const float4*)(p.in[28] + lane * 4);
    for (int item = gw; item < NL * 4; item += nw) {
        const size_t off = (size_t)(item >> 2) * 1024 + (item & 3) * 256 + lane * 4;
        const uint2 a = *(const uint2*)(o0 + off + (size_t)(item >> 2) * 1024), b2 = *(const uint2*)(o1 + off), g2 = *(const uint2*)(gb + off);
        const float v0 = bf_lo(a.x) + bf_lo(b2.x), v1 = bf_hi(a.x) + bf_hi(b2.x), v2 = bf_lo(a.y) + bf_lo(b2.y), v3 = bf_hi(a.y) + bf_hi(b2.y);
        float ss = v0 * v0 + v1 * v1 + v2 * v2 + v3 * v3;
        ss = wave_allreduce(ss);
        const float rs = rsqrtf(ss * (1.0f / 256.0f) + 1e-6f);
        const float g0 = bf_lo(g2.x), g1 = bf_hi(g2.x), g2f = bf_lo(g2.y), g3 = bf_hi(g2.y);
        const float r0 = v0 * rs * hn.x * (g0 * sigmoidf_(g0)), r1 = v1 * rs * hn.y * (g1 * sigmoidf_(g1));
        const float r2 = v2 * rs * hn.z * (g2f * sigmoidf_(g2f)), r3 = v3 * rs * hn.w * (g3 * sigmoidf_(g3));
        *(uint2*)(ao + off) = make_uint2(pk_bf16(r0, r1), pk_bf16(r2, r3));
    }
}


#define XB_TMO      128
#define XB_XCNT(j)  (256  + 64 * (j))
#define XB_XSUB(j)  (1280 + 64 * (j))
#define XB_XGEN(j)  (2304 + 64 * (j))
#define XB_TOP      3328
#define XB_TOPGEN   3392
#define XB_SPIN_CAP (1u << 22)
DEV unsigned xb_ld(unsigned* p) { return __hip_atomic_load(p, __ATOMIC_RELAXED, __HIP_MEMORY_SCOPE_AGENT); }
DEV unsigned xb_add(unsigned* p, unsigned v) { return __hip_atomic_fetch_add(p, v, __ATOMIC_RELAXED, __HIP_MEMORY_SCOPE_AGENT); }
DEV unsigned xb_xcc_id() { return (unsigned)__builtin_amdgcn_s_getreg((3 << 11) | 20) & 0xFu; }
#define XB_SPIN(cond, bar) do { unsigned _sp = 0; while (cond) { __builtin_amdgcn_s_sleep(1); \
    if ((++_sp & 255u) == 0u) { if (xb_ld(&(bar)[XB_TMO])) break; if (_sp > XB_SPIN_CAP) { atomicAdd(&(bar)[XB_TMO], 1u); break; } } } } while (0)
DEV void xcd_barrier_complete(unsigned* bar, unsigned x, unsigned& nloc, unsigned& nx) {
    const unsigned G = gridDim.x;
    unsigned sum, cnt, mine, sp = 0u;
    for (;;) {
        sum = 0u; cnt = 0u; mine = 0u;
#pragma unroll
        for (unsigned j = 0; j < 16; ++j) { const unsigned c = xb_ld(&bar[XB_XCNT(j)]); sum += c; cnt += (c > 0u) ? 1u : 0u; mine = (j == x) ? c : mine; }
        if (sum == G) break;
        __builtin_amdgcn_s_sleep(1);
        if ((++sp & 255u) == 0u) { if (xb_ld(&bar[XB_TMO])) break; if (sp > XB_SPIN_CAP) { atomicAdd(&bar[XB_TMO], 1u); break; } }
    }
    nloc = mine > 0u ? mine : 1u; nx = cnt > 0u ? cnt : 1u;
}
DEV void xcd_barrier(unsigned* bar, volatile LAS3 unsigned* st) {
    asm volatile("s_waitcnt vmcnt(0)" ::: "memory");
    __syncthreads();
    if (tid_opaque() == 0) {
        const unsigned x = xb_xcc_id();
        __builtin_amdgcn_s_waitcnt(0);
        unsigned nloc = st[0], nx = st[1];
        if (nloc == 0u) { xcd_barrier_complete(bar, x, nloc, nx); st[0] = nloc; st[1] = nx; }
        const unsigned old = xb_add(&bar[XB_XSUB(x)], 1u);
        const unsigned gen = old / nloc;
        if (old + 1u == (gen + 1u) * nloc) {
            __builtin_amdgcn_fence(__ATOMIC_RELEASE, "agent");
            asm volatile("s_waitcnt vmcnt(0)" ::: "memory");
            const unsigned og = xb_add(&bar[XB_TOP], 1u);
            const unsigned tg = og / nx;
            if (og + 1u == (tg + 1u) * nx) xb_add(&bar[XB_TOPGEN], 1u);
            else XB_SPIN(xb_ld(&bar[XB_TOPGEN]) == tg, bar);
            __builtin_amdgcn_fence(__ATOMIC_ACQUIRE, "agent");
            xb_add(&bar[XB_XGEN(x)], 1u);
            asm volatile("s_waitcnt vmcnt(0)" ::: "memory");
        } else {
            XB_SPIN(xb_ld(&bar[XB_XGEN(x)]) == gen, bar);
            __builtin_amdgcn_fence(__ATOMIC_ACQUIRE, "agent");
            asm volatile("s_waitcnt vmcnt(0)" ::: "memory");
        }
    }
    __syncthreads();
}
#define SYNC() do { asm volatile("s_waitcnt vmcnt(0)" ::: "memory"); grid.sync(); \
    if (tid_opaque() == 0) { __builtin_amdgcn_fence(__ATOMIC_ACQUIRE, "agent"); asm volatile("s_waitcnt vmcnt(0)" ::: "memory"); } \
    __syncthreads(); } while (0)
__global__ void __launch_bounds__(NTHREADS) mega_fwd(Params p) {
    unsigned char* const lds = g_lds;
    cg::grid_group grid = cg::this_grid();
#define XBAR ((unsigned*)(p.ws + WS_BAR))
#define XST ((volatile LAS3 unsigned*)(lds + LDS_BYTES - 16))
    if ((threadIdx.x & 63) == 0) g_lds[LDS_WTAB + hw_wave_slot()] = (unsigned char)(threadIdx.x >> 6);
    if (threadIdx.x == 0) { XST[0] = 0u; XST[1] = 0u; (void)xb_add(&XBAR[XB_XCNT(xb_xcc_id())], 1u); }
    __syncthreads();
#define S0 ((bf16_t*)(p.ws + WS_S + 0 * U_BYTES))
#define SLOT(i) ((bf16_t*)(p.ws + WS_S + (size_t)(i) * U_BYTES))
#define S1 ((bf16_t*)(p.ws + WS_S + 1 * U_BYTES))
#define CTXR ((const float*)(p.ws + WS_CTXR))
    phase0(p, lds); SYNC();
#undef SYNC
#define SYNC() xcd_barrier(XBAR, XST)
    phase_normmix(p, S0, SLOT(5), SLOT(1), SLOT(2)); SYNC();
    phase_rw_proj1(p, lds, 0, SLOT(5), SLOT(3)); SYNC();
    phase_rw_proj1(p, lds, 1, SLOT(1), SLOT(5)); SYNC();
    phase_rw_proj1(p, lds, 2, SLOT(2), SLOT(1)); phase_rw_lora(p, lds); SYNC();
    REPEAT(3, phase_rw_scan(p, lds));
    phase_rw_scan(p, lds); SYNC();
    REPEAT(4, phase_rw_readout(p));
    phase_rw_readout(p); SYNC();
    REPEAT(5, phase_wo(p, lds, 0));
    phase_wo(p, lds, 0); SYNC();
    REPEAT(6, phase_normmod(p, 0, 1, p.out, CTXR, NT, S1));
    phase_normmod(p, 0, 1, p.out, CTXR, NT, S1); SYNC();
    REPEAT(7, phase_peer_select(p, lds, 0));
    phase_peer_select(p, lds, 0); SYNC();
    phase_peer_u(p, 0); SYNC();
    phase_peer_c(p, 0); SYNC();
    phase_peer_v(p, 0); SYNC();
    phase_normmod(p, 1, 0, p.out, CTXR, NT, S0); SYNC();
    REPEAT(9, phase_gla_proj(p, lds));
    phase_gla_proj(p, lds); SYNC();
    REPEAT(10, phase_gla_conv(p));
    phase_gla_conv(p); SYNC();
    REPEAT(18, phase_gla_prep(p, lds));
    phase_gla_prep(p, lds); SYNC();
    REPEAT(11, phase_gla_scan(p, lds));
    phase_gla_scan(p, lds); SYNC();
    REPEAT(12, phase_gla_readout(p));
    phase_gla_readout(p); SYNC();
    phase_wo(p, lds, 1); SYNC();
    REPEAT(14, phase_normmod(p, 1, 1, p.out, CTXR, NL, S0));
    phase_normmod(p, 1, 1, p.out, CTXR, NL, S0); SYNC();
    REPEAT(15, phase_peer_select(p, lds, 1));
    phase_peer_select(p, lds, 1); SYNC();
    phase_peer_u(p, 1); SYNC();
    phase_peer_c(p, 1); SYNC();
    phase_peer_v(p, 1); SYNC();
    phase_final_norm(p);
}

extern "C" void kernel_launch(void* const* d_in, const int* in_sizes, int n_in, void* d_out, int out_size, void* d_ws, size_t ws_size, hipStream_t stream) {
    static int grid_blocks = 0;
    if (grid_blocks == 0) {
        if (n_in != 35 || ws_size < WS_TOTAL) { fprintf(stderr, "kernel_launch: unexpected n_in %d or ws_size %zu (< %zu)\n", n_in, ws_size, (size_t)WS_END); grid_blocks = -1; return; }
        int dev = 0, cus = 0, per_cu = 0;
        if (hipGetDevice(&dev) != hipSuccess || hipDeviceGetAttribute(&cus, hipDeviceAttributeMultiprocessorCount, dev) != hipSuccess) { fprintf(stderr, "kernel_launch: device query failed\n"); grid_blocks = -1; return; }
        if (hipFuncSetAttribute((const void*)mega_fwd, hipFuncAttributeMaxDynamicSharedMemorySize, LDS_BYTES) != hipSuccess) { fprintf(stderr, "kernel_launch: hipFuncSetAttribute failed\n"); grid_blocks = -1; return; }
        if (hipOccupancyMaxActiveBlocksPerMultiprocessor(&per_cu, (const void*)mega_fwd, NTHREADS, LDS_BYTES) != hipSuccess || per_cu < 1) { fprintf(stderr, "kernel_launch: occupancy query says %d blocks per CU\n", per_cu); grid_blocks = -1; return; }
        grid_blocks = cus;
    }
    if (grid_blocks < 0) return;
    Params p{};
    for (int i = 0; i < 35; ++i) p.in[i] = (const float*)d_in[i];
    p.out = (float*)d_out;
    p.ws = (unsigned char*)d_ws;
    if (hipMemsetAsync((char*)d_ws + WS_BAR, 0, 16384, stream) != hipSuccess) { fprintf(stderr, "kernel_launch: hipMemsetAsync failed\n"); return; }
    void* args[] = {&p};
    hipError_t e = hipLaunchCooperativeKernel((const void*)mega_fwd, dim3(grid_blocks), dim3(NTHREADS), args, LDS_BYTES, stream);
    if (e != hipSuccess) fprintf(stderr, "kernel_launch: cooperative launch failed: %s (grid %d)\n", hipGetErrorString(e), grid_blocks);
}
```

```cpp
#include <hip/hip_runtime.h>
#include <hip/hip_cooperative_groups.h>
#include <cstdio>
#include <cstdint>
namespace cg = cooperative_groups;

#define DEV __device__ __forceinline__
#ifndef REP
#define REP 0
#endif
#define GREPS(n) ((REP == (n)) ? 2 : 1)
#define REPEAT(n, stmt) do { if (REP == (n)) { stmt; SYNC(); } } while (0)

typedef unsigned short bf16_t;
typedef short bf16x8 __attribute__((ext_vector_type(8)));
typedef float f32x4 __attribute__((ext_vector_type(4)));
typedef __bf16 bf16x2v __attribute__((ext_vector_type(2)));

constexpr int D = 1024;
constexpr int NB = 8, SEQ = 8192, CTXL = 256;
constexpr int NL = NB * SEQ, NC = NB * CTXL, NT = NL + NC;
constexpr int NTHREADS = 512;
constexpr int LDS_BYTES = 160 * 1024;

constexpr size_t U_BYTES = (size_t)NT * 1024 * 2;
constexpr size_t WS_BAR = 0;
constexpr size_t WS_MOD = 16384;
constexpr size_t WS_CTXR = WS_MOD + (size_t)2 * 9 * 6144 * 4;
constexpr size_t WS_LR = WS_CTXR + (size_t)NC * 1024 * 4;
constexpr size_t WS_BONUS = WS_LR + (size_t)NT * 32 * 4;
constexpr size_t WS_WPROJ = WS_BONUS + (size_t)2 * NT * 16 * 4;
constexpr size_t WS_W2T = WS_WPROJ + (size_t)3456 * 1024 * 2;
constexpr size_t WS_A2T = WS_W2T + (size_t)2 * 1024 * 64 * 2;
constexpr size_t WS_G2T = WS_A2T + (size_t)2 * 1024 * 64 * 2;
constexpr size_t WS_WO0 = WS_G2T + (size_t)1024 * 128 * 2;
constexpr size_t WS_WO1 = WS_WO0 + (size_t)1024 * 1024 * 2;
constexpr size_t WS_WQ = WS_WO1 + (size_t)1024 * 1024 * 2;
constexpr size_t WS_KEYS = WS_WQ + (size_t)2 * 2048 * 1024 * 2;
constexpr size_t WS_WIN = WS_KEYS + (size_t)2 * 8 * 2 * 128 * 128 * 2;
constexpr size_t WS_PU = WS_WIN + (size_t)3200 * 1024 * 2;
constexpr size_t WS_PV = WS_PU + (size_t)2 * 16384 * 1024;
constexpr size_t WS_PSC = WS_PV + (size_t)2 * 16384 * 1024;
constexpr size_t WS_S = WS_PSC + (size_t)2 * 2 * 16384 * 4;
constexpr size_t WS_END = WS_S + 6 * U_BYTES;
static_assert(WS_END <= 1073741824ull, "workspace too large");
static_assert((WS_CTXR % 256) == 0 && (WS_WPROJ % 256) == 0 && (WS_S % 256) == 0, "alignment");

struct Params {
    const float* in[35];
    float* out;
    unsigned char* ws;
    int pad0, pad1;
};

DEV float bf_lo(unsigned u) { return __uint_as_float(u << 16); }
DEV float bf_hi(unsigned u) { return __uint_as_float(u & 0xffff0000u); }
typedef float f32x2v __attribute__((ext_vector_type(2)));
DEV unsigned pk_bf16(float lo, float hi) { const f32x2v f = {lo, hi}; union { bf16x2v v; unsigned u; } x; x.v = __builtin_convertvector(f, bf16x2v); return x.u; }
template <int N> DEV float dpp_ror(float x) { return __int_as_float(__builtin_amdgcn_update_dpp(0, __float_as_int(x), 0x120 + N, 0xF, 0xF, false)); }
DEV float row16_allreduce(float x) { x += dpp_ror<8>(x); x += dpp_ror<4>(x); x += dpp_ror<2>(x); x += dpp_ror<1>(x); return x; }
DEV float wave_allreduce(float x) { x = row16_allreduce(x); x += __shfl_xor(x, 16); x += __shfl_xor(x, 32); return x; }
DEV float sigmoidf_(float x) { return 1.0f / (1.0f + __expf(-x)); }
DEV float softplusf_(float z) { return fmaxf(z, 0.f) + __logf(1.0f + __expf(-fabsf(z))); }
DEV unsigned mono_u32(float f) { unsigned u = __float_as_uint(f); return u ^ ((u >> 31) ? 0xFFFFFFFFu : 0x80000000u); }
DEV float unmono_u32(unsigned k) { unsigned u = (k & 0x80000000u) ? (k ^ 0x80000000u) : ~k; return __uint_as_float(u); }
DEV bf16x8 as_bf16x8(uint4 v) { union { uint4 u; bf16x8 b; } x; x.u = v; return x.b; }
#define LAS3 __attribute__((address_space(3)))
extern __shared__ __attribute__((aligned(16))) unsigned char g_lds[];
constexpr int LDS_WTAB = LDS_BYTES - 128;
DEV unsigned hw_wave_slot() { return (unsigned)__builtin_amdgcn_s_getreg((5 << 11) | 4) & 63u; }
DEV int tid_opaque() {
    const int wv = (int)*(const volatile unsigned char*)(g_lds + LDS_WTAB + hw_wave_slot());
    int t = (wv << 6) | (int)__builtin_amdgcn_mbcnt_hi(~0u, __builtin_amdgcn_mbcnt_lo(~0u, 0u));
    asm volatile("" : "+v"(t));
    return t;
}
DEV int mod_batch(int R) { return R < NL ? (R >> 13) : 8; }

template <int BN, class AL, class EP>
DEV void gemm_unit(unsigned char* lds, const AL& al, const bf16_t* Bt, int K, int m0, const EP& ep) {
    constexpr int NI = BN / 64;
    constexpr int A_BYTES = 128 * 128;
    constexpr int B_BYTES = BN * 128;
    const int tid = tid_opaque(), lane = tid & 63, wv = tid >> 6, wm = wv >> 2, wn = wv & 3;
    const int fr = lane & 15, fq = lane >> 4;
    unsigned char* sA = lds;
    unsigned char* sB = lds + 2 * A_BYTES;
    f32x4 acc[4][NI];
#pragma unroll
    for (int mi = 0; mi < 4; ++mi)
#pragma unroll
        for (int ni = 0; ni < NI; ++ni) acc[mi][ni] = (f32x4){0.f, 0.f, 0.f, 0.f};
    const int KT = K >> 6;
    const int drow = tid >> 3, dch = (tid & 7) ^ (drow & 7);
    const bf16_t* bsrc = Bt + (size_t)drow * K + dch * 8;
    uint4 ra[2];
    auto stage = [&](int kt, int buf) {
        const int k0 = kt * 64;
#pragma unroll
        for (int i = 0; i < BN / 64; ++i)
            __builtin_amdgcn_global_load_lds((const unsigned*)(bsrc + (size_t)(64 * i) * K + k0), (unsigned*)(sB + buf * B_BYTES + i * 8192 + tid * 16), 16, 0, 0);
        if constexpr (AL::DMA) {
#pragma unroll
            for (int i = 0; i < 2; ++i)
                __builtin_amdgcn_global_load_lds((const unsigned*)(al.A + (size_t)(m0 + drow + 64 * i) * al.lda + k0 + dch * 8), (unsigned*)(sA + buf * A_BYTES + i * 8192 + tid * 16), 16, 0, 0);
        } else {
#pragma unroll
            for (int i = 0; i < 2; ++i) { const int q = tid + 512 * i; ra[i] = al.load(m0 + (q >> 3), k0 + (q & 7) * 8); }
        }
    };
    auto commit = [&](int buf) {
        if constexpr (!AL::DMA) {
#pragma unroll
            for (int i = 0; i < 2; ++i) { const int q = tid + 512 * i, row = q >> 3, ch = q & 7; *(uint4*)(sA + buf * A_BYTES + row * 128 + ((ch ^ (row & 7)) << 4)) = ra[i]; }
        }
    };
    auto compute = [&](int buf) {
        const unsigned char* a_base = sA + buf * A_BYTES;
        const unsigned char* b_base = sB + buf * B_BYTES;
#pragma unroll
        for (int ks = 0; ks < 2; ++ks) {
            bf16x8 af[4], bfr[NI];
            const int ch = ks * 4 + fq;
#pragma unroll
            for (int mi = 0; mi < 4; ++mi) { const int row = wm * 64 + mi * 16 + fr; af[mi] = *(const bf16x8*)(a_base + row * 128 + ((ch ^ (row & 7)) << 4)); }
#pragma unroll
            for (int ni = 0; ni < NI; ++ni) { const int row = wn * (BN / 4) + ni * 16 + fr; bfr[ni] = *(const bf16x8*)(b_base + row * 128 + ((ch ^ (row & 7)) << 4)); }
#pragma unroll
            for (int mi = 0; mi < 4; ++mi)
#pragma unroll
                for (int ni = 0; ni < NI; ++ni) acc[mi][ni] = __builtin_amdgcn_mfma_f32_16x16x32_bf16(bfr[ni], af[mi], acc[mi][ni], 0, 0, 0);
        }
    };
    if constexpr (AL::DMA) {
        constexpr int STG = A_BYTES + B_BYTES;
        auto stage3 = [&](int kt, int b3) {
            const int k0 = kt * 64;
            unsigned char* base = lds + b3 * STG;
#pragma unroll
            for (int i = 0; i < BN / 64; ++i)
                __builtin_amdgcn_global_load_lds((const unsigned*)(bsrc + (size_t)(64 * i) * K + k0), (unsigned*)(base + A_BYTES + i * 8192 + tid * 16), 16, 0, 0);
#pragma unroll
            for (int i = 0; i < 2; ++i)
                __builtin_amdgcn_global_load_lds((const unsigned*)(al.A + (size_t)(m0 + drow + 64 * i) * al.lda + k0 + dch * 8), (unsigned*)(base + i * 8192 + tid * 16), 16, 0, 0);
        };
        auto compute3 = [&](int b3) {
            const unsigned char* a_base = lds + b3 * STG;
            const unsigned char* b_base = a_base + A_BYTES;
#pragma unroll
            for (int ks = 0; ks < 2; ++ks) {
                bf16x8 af[4], bfr[NI];
                const int ch = ks * 4 + fq;
#pragma unroll
                for (int mi = 0; mi < 4; ++mi) { const int row = wm * 64 + mi * 16 + fr; af[mi] = *(const bf16x8*)(a_base + row * 128 + ((ch ^ (row & 7)) << 4)); }
#pragma unroll
                for (int ni = 0; ni < NI; ++ni) { const int row = wn * (BN / 4) + ni * 16 + fr; bfr[ni] = *(const bf16x8*)(b_base + row * 128 + ((ch ^ (row & 7)) << 4)); }
#pragma unroll
                for (int mi = 0; mi < 4; ++mi)
#pragma unroll
                    for (int ni = 0; ni < NI; ++ni) acc[mi][ni] = __builtin_amdgcn_mfma_f32_16x16x32_bf16(bfr[ni], af[mi], acc[mi][ni], 0, 0, 0);
            }
        };
        stage3(0, 0);
        stage3(1, 1);
        int b3 = 0;
        for (int kt = 0; kt < KT; ++kt) {
            if (kt + 1 < KT) { if constexpr (BN == 256) asm volatile("s_waitcnt vmcnt(6)" ::: "memory"); else asm volatile("s_waitcnt vmcnt(4)" ::: "memory"); }
            else asm volatile("s_waitcnt vmcnt(0)" ::: "memory");
            asm volatile("s_waitcnt lgkmcnt(0)" ::: "memory");
            __builtin_amdgcn_s_barrier();
            asm volatile("" ::: "memory");
            const int bn = (b3 == 0) ? 2 : b3 - 1;
            if (kt + 2 < KT) stage3(kt + 2, bn);
            compute3(b3);
            b3 = (b3 == 2) ? 0 : b3 + 1;
        }
        asm volatile("s_waitcnt lgkmcnt(0)" ::: "memory");
        __builtin_amdgcn_s_barrier();
        asm volatile("" ::: "memory");
    } else {
        stage(0, 0);
        commit(0);
        asm volatile("s_waitcnt vmcnt(0)" ::: "memory");
        __syncthreads();
        for (int kt = 0; kt < KT; ++kt) {
            const int cur = kt & 1;
            const bool more = (kt + 1 < KT);
            if (more) stage(kt + 1, cur ^ 1);
            compute(cur);
            if (more) commit(cur ^ 1);
            asm volatile("s_waitcnt vmcnt(0)" ::: "memory");
            __syncthreads();
        }
    }
    ep(acc, m0, wm, wn, fr, fq);
}

struct ALoadPlain {
    static constexpr bool DMA = true;
    const bf16_t* A; int lda;
    DEV uint4 load(int R, int k) const { return *(const uint4*)(A + (size_t)R * lda + k); }
};
struct ALoadMix {
    static constexpr bool DMA = false;
    const bf16_t* h; const float* mix; const bf16_t* A; int lda;
    DEV uint4 load(int R, int k) const {
        const bf16_t* pc = h + (size_t)R * 1024 + k;
        const uint4 c = *(const uint4*)pc;
        const int t = (R < NL) ? (R & 8191) : ((R - NL) & 255);
        const int last = (R < NL) ? 8191 : 255;
        uint4 pv = *(const uint4*)(pc - (t != 0 ? 1024 : 0)), nv = *(const uint4*)(pc + (t != last ? 1024 : 0));
        if (t == 0) pv = make_uint4(0, 0, 0, 0);
        if (t == last) nv = make_uint4(0, 0, 0, 0);
        const float4 m0 = *(const float4*)(mix + k), m1 = *(const float4*)(mix + k + 4);
        const unsigned cc[4] = {c.x, c.y, c.z, c.w}, pp[4] = {pv.x, pv.y, pv.z, pv.w}, nn[4] = {nv.x, nv.y, nv.z, nv.w};
        const float mm[8] = {m0.x, m0.y, m0.z, m0.w, m1.x, m1.y, m1.z, m1.w};
        unsigned o[4];
#pragma unroll
        for (int i = 0; i < 4; ++i) {
            const float hc0 = bf_lo(cc[i]), hc1 = bf_hi(cc[i]);
            const float s0 = 0.5f * (bf_lo(pp[i]) + bf_lo(nn[i])), s1 = 0.5f * (bf_hi(pp[i]) + bf_hi(nn[i]));
            o[i] = pk_bf16(hc0 + (s0 - hc0) * mm[2 * i], hc1 + (s1 - hc1) * mm[2 * i + 1]);
        }
        return make_uint4(o[0], o[1], o[2], o[3]);
    }
};

struct TrJob { int in_idx, src_off, K, N, src_ld, dst_ld; unsigned long long dst_off; int tile0; };
constexpr int NTRJOBS = 19;
__device__ const TrJob g_trjobs[NTRJOBS] = {
    {9, 0 * 1048576, 1024, 1024, 1024, 1024, WS_WPROJ + 0ull * 1024 * 1024 * 2, 0},
    {9, 1 * 1048576, 1024, 1024, 1024, 1024, WS_WPROJ + 1ull * 1024 * 1024 * 2, 256},
    {9, 2 * 1048576, 1024, 1024, 1024, 1024, WS_WPROJ + 2ull * 1024 * 1024 * 2, 512},
    {11, 0, 1024, 64, 64, 1024, WS_WPROJ + 3072ull * 1024 * 2, 768},
    {11, 65536, 1024, 64, 64, 1024, WS_WPROJ + 3136ull * 1024 * 2, 784},
    {14, 0, 1024, 64, 64, 1024, WS_WPROJ + 3200ull * 1024 * 2, 800},
    {14, 65536, 1024, 64, 64, 1024, WS_WPROJ + 3264ull * 1024 * 2, 816},
    {16, 0, 1024, 128, 128, 1024, WS_WPROJ + 3328ull * 1024 * 2, 832},
    {12, 0, 64, 1024, 1024, 64, WS_W2T, 864},
    {12, 65536, 64, 1024, 1024, 64, WS_W2T + 1024ull * 64 * 2, 880},
    {15, 0, 64, 1024, 1024, 64, WS_A2T, 896},
    {15, 65536, 64, 1024, 1024, 64, WS_A2T + 1024ull * 64 * 2, 912},
    {17, 0, 128, 1024, 1024, 128, WS_G2T, 928},
    {23, 0, 1024, 1024, 1024, 1024, WS_WO0, 960},
    {29, 0, 1024, 1024, 1024, 1024, WS_WO1, 1216},
    {30, 0, 1024, 2048, 2048, 1024, WS_WQ, 1472},
    {30, 2097152, 1024, 2048, 2048, 1024, WS_WQ + 2048ull * 1024 * 2, 1984},
    {24, 0, 1024, 3104, 3104, 1024, WS_WIN, 2496},
    {0, 0, 0, 0, 0, 0, 0, 2496 + 16 * 49},
};
constexpr int NTRTILES = 2496 + 16 * 49;

DEV void phase0(const Params& p, unsigned char* lds) {
    const int tid = tid_opaque();
    unsigned char* ws = p.ws;
    {
        float* sc = (float*)lds;
        float* red = sc + 9 * 1024;
        float* mods = (float*)(ws + WS_MOD);
        bool have_sc = false;
        for (int task = blockIdx.x; task < 192; task += gridDim.x) {
            if (!have_sc) {
                for (int i = tid; i < 9 * 1024; i += NTHREADS) {
                    const int mb = i >> 10, k = i & 1023;
                    const float cv = mb < 8 ? p.in[1][mb * 1024 + k] : p.in[3][k];
                    sc[i] = cv / (1.0f + __expf(-cv));
                }
                have_sc = true;
            }
            __syncthreads();
            const int l = task / 96, nb = task % 96;
            const int nn = tid & 63, kg = tid >> 6;
            const float* w = p.in[4] + (size_t)l * 1024 * 6144 + nb * 64 + nn;
            float acc[9];
#pragma unroll
            for (int m = 0; m < 9; ++m) acc[m] = 0.f;
            for (int k = kg * 128; k < kg * 128 + 128; ++k) {
                const float wv = w[(size_t)k * 6144];
#pragma unroll
                for (int m = 0; m < 9; ++m) acc[m] += sc[m * 1024 + k] * wv;
            }
#pragma unroll
            for (int m = 0; m < 9; ++m) red[(kg * 9 + m) * 64 + nn] = acc[m];
            __syncthreads();
            for (int i = tid; i < 576; i += NTHREADS) {
                const int m = i >> 6, n2 = i & 63;
                float s = p.in[5][l * 6144 + nb * 64 + n2];
#pragma unroll
                for (int g = 0; g < 8; ++g) s += red[(g * 9 + m) * 64 + n2];
                mods[(size_t)(l * 9 + m) * 6144 + nb * 64 + n2] = s;
            }
            __syncthreads();
        }
        __syncthreads();
    }
    {
        float* tile = (float*)lds;
        for (int tt = blockIdx.x; tt < NTRTILES; tt += gridDim.x) {
            int j = 0;
#pragma unroll 1
            while (j + 1 < NTRJOBS && g_trjobs[j + 1].tile0 <= tt) ++j;
            const TrJob jb = g_trjobs[j];
            const int tl = tt - jb.tile0;
            const int ntn = (jb.N + 63) >> 6;
            const int k0 = (tl / ntn) * 64, n0 = (tl % ntn) * 64;
            const float* src = p.in[jb.in_idx] + jb.src_off;
            bf16_t* dst = (bf16_t*)(ws + jb.dst_off);
            {
                const int kr = tid >> 4, nc4 = (tid & 15) * 4;
#pragma unroll
                for (int i = 0; i < 2; ++i) {
                    const int kk = kr + 32 * i;
                    float4 v = make_float4(0.f, 0.f, 0.f, 0.f);
                    if (n0 + nc4 < jb.N) v = *(const float4*)(src + (size_t)(k0 + kk) * jb.src_ld + n0 + nc4);
                    tile[kk * 65 + nc4 + 0] = v.x; tile[kk * 65 + nc4 + 1] = v.y; tile[kk * 65 + nc4 + 2] = v.z; tile[kk * 65 + nc4 + 3] = v.w;
                }
            }
            __syncthreads();
            {
                const int nn = tid >> 3, kc = (tid & 7) * 8;
                if (n0 + nn < jb.N) {
                    unsigned o[4];
#pragma unroll
                    for (int i = 0; i < 4; ++i) o[i] = pk_bf16(tile[(kc + 2 * i) * 65 + nn], tile[(kc + 2 * i + 1) * 65 + nn]);
                    *(uint4*)(dst + (size_t)(n0 + nn) * jb.dst_ld + k0 + kc) = make_uint4(o[0], o[1], o[2], o[3]);
                }
            }
            __syncthreads();
        }
    }
    {
        const size_t gtid = (size_t)blockIdx.x * NTHREADS + tid, gstride = (size_t)gridDim.x * NTHREADS;
        {
            const float* src = p.in[31];
            bf16_t* dst = (bf16_t*)(ws + WS_KEYS);
            const size_t n8 = (size_t)2 * 8 * 2 * 128 * 128 / 8;
            for (size_t i = gtid; i < n8; i += gstride) {
                const float4 a = *(const float4*)(src + i * 8), b = *(const float4*)(src + i * 8 + 4);
                *(uint4*)(dst + i * 8) = make_uint4(pk_bf16(a.x, a.y), pk_bf16(a.z, a.w), pk_bf16(b.x, b.y), pk_bf16(b.z, b.w));
            }
        }
        bf16_t* wpad = (bf16_t*)(ws + WS_WIN) + (size_t)3104 * 1024;
        for (size_t i = gtid; i < (size_t)96 * 1024 / 8; i += gstride) *(uint4*)(wpad + i * 8) = make_uint4(0, 0, 0, 0);
        const int lane = tid & 63;
        const int gw = blockIdx.x * 8 + (tid >> 6), nw = gridDim.x * 8;
        float* scales = (float*)(ws + WS_PSC);
        for (int rowi = gw * 32; rowi < 2 * 32768; rowi += nw * 32)
        for (int row = rowi; row < rowi + 32; ++row) {
            const int tbl = row >> 15, r = row & 32767;
            const float* srow = p.in[32 + tbl] + (size_t)r * 1024;
            float4 v[4]; float am = 0.f;
#pragma unroll
            for (int i = 0; i < 4; ++i) { v[i] = *(const float4*)(srow + 16 * lane + 4 * i); am = fmaxf(am, fmaxf(fmaxf(fabsf(v[i].x), fabsf(v[i].y)), fmaxf(fabsf(v[i].z), fabsf(v[i].w)))); }
#pragma unroll
            for (int o = 1; o < 64; o <<= 1) am = fmaxf(am, __shfl_xor(am, o));
            const float scale = am > 0.f ? am * (1.0f / 448.0f) : 1.0f;
            const float inv = 1.0f / scale;
            unsigned w[4];
#pragma unroll
            for (int i = 0; i < 4; ++i) {
                int t = 0;
                t = __builtin_amdgcn_cvt_pk_fp8_f32(v[i].x * inv, v[i].y * inv, t, false);
                t = __builtin_amdgcn_cvt_pk_fp8_f32(v[i].z * inv, v[i].w * inv, t, true);
                w[i] = (unsigned)t;
            }
            *(uint4*)(ws + (tbl ? WS_PV : WS_PU) + ((size_t)(r >> 14) * 8 + (lane >> 3)) * (16384 * 128) + (size_t)(r & 16383) * 128 + 16 * (lane & 7)) = make_uint4(w[0], w[1], w[2], w[3]);
            if (lane == 0) scales[tbl * 32768 + r] = scale;
        }
    }
}

DEV void normmod_store(const float4 (&v)[4], float ss, const float* g, const float* shift, const float* scale, bf16_t* dst, unsigned char* xq, int lane) {
    const float rs = rsqrtf(ss * (1.0f / 1024.0f) + 1e-6f);
#pragma unroll
    for (int i = 0; i < 4; ++i) {
        const int col = i * 256 + lane * 4;
        const float4 gg = *(const float4*)(g + col), sh = *(const float4*)(shift + col), sc = *(const float4*)(scale + col);
        const float y0 = v[i].x * rs * gg.x * (1.f + sc.x) + sh.x, y1 = v[i].y * rs * gg.y * (1.f + sc.y) + sh.y;
        const float y2 = v[i].z * rs * gg.z * (1.f + sc.z) + sh.z, y3 = v[i].w * rs * gg.w * (1.f + sc.w) + sh.w;
        *(uint2*)(dst + col) = make_uint2(pk_bf16(y0, y1), pk_bf16(y2, y3));
        if (xq) {
            const float z0 = __builtin_amdgcn_fmed3f(4.f * y0, -448.f, 448.f), z1 = __builtin_amdgcn_fmed3f(4.f * y1, -448.f, 448.f);
            const float z2 = __builtin_amdgcn_fmed3f(4.f * y2, -448.f, 448.f), z3 = __builtin_amdgcn_fmed3f(4.f * y3, -448.f, 448.f);
            int hi = __builtin_amdgcn_cvt_pk_fp8_f32(z0, z1, 0, false); hi = __builtin_amdgcn_cvt_pk_fp8_f32(z2, z3, hi, true);
            const f32x2v h01 = __builtin_amdgcn_cvt_pk_f32_fp8(hi, false), h23 = __builtin_amdgcn_cvt_pk_f32_fp8(hi, true);
            int lo = __builtin_amdgcn_cvt_pk_fp8_f32(z0 - h01.x, z1 - h01.y, 0, false); lo = __builtin_amdgcn_cvt_pk_fp8_f32(z2 - h23.x, z3 - h23.y, lo, true);
            *(int*)(xq + col) = hi; *(int*)(xq + 1024 + col) = lo;
        }
    }
}
DEV void phase_normmod(const Params& p, int layer, int which, const float* xl, const float* xc, int nrows, bf16_t* dst, unsigned char* xq) {
    const int tid = tid_opaque(), lane = tid & 63;
    const int gw = blockIdx.x * 8 + (tid >> 6), nw = gridDim.x * 8;
    const float* mods = (const float*)(p.ws + WS_MOD) + (size_t)layer * 9 * 6144;
    const float* g = p.in[which ? 7 : 6] + layer * 1024;
    for (int R = gw; R < nrows; R += nw) {
        const float* xr = R < NL ? xl + (size_t)R * 1024 : xc + (size_t)(R - NL) * 1024;
        float4 v[4]; float ss = 0.f;
#pragma unroll
        for (int i = 0; i < 4; ++i) { v[i] = *(const float4*)(xr + i * 256 + lane * 4); ss += v[i].x * v[i].x + v[i].y * v[i].y + v[i].z * v[i].z + v[i].w * v[i].w; }
        ss = wave_allreduce(ss);
        const float* mrow = mods + (size_t)mod_batch(R) * 6144 + (which ? 3 : 0) * 1024;
        normmod_store(v, ss, g, mrow, mrow + 1024, dst + (size_t)R * 1024, xq ? xq + (size_t)R * 2048 : nullptr, lane);
    }
}
DEV void phase_normmix(const Params& p, bf16_t* hdst, bf16_t* xr, bf16_t* xk, bf16_t* xv) {
    const int tid = tid_opaque(), lane = tid & 63;
    const int gw = __builtin_amdgcn_readfirstlane(blockIdx.x * 8 + (tid >> 6)), nw = gridDim.x * 8;
    const float* mods = (const float*)(p.ws + WS_MOD);
    const float* g = p.in[6];
    for (int run = gw; run < NT / 8; run += nw) {
        const int R0 = run * 8;
        const int t0 = R0 < NL ? (R0 & 8191) : ((R0 - NL) & 255), slen = R0 < NL ? 8192 : 256;
        const float* mrow = mods + (size_t)mod_batch(R0) * 6144;
        float4 gg[4], sh[4], sc[4], m0[4], m2[4], m3[4];
#pragma unroll
        for (int i = 0; i < 4; ++i) {
            const int col = i * 256 + lane * 4;
            gg[i] = *(const float4*)(g + col); sh[i] = *(const float4*)(mrow + col); sc[i] = *(const float4*)(mrow + 1024 + col);
            m0[i] = *(const float4*)(p.in[8] + col); m2[i] = *(const float4*)(p.in[8] + 2 * 1024 + col); m3[i] = *(const float4*)(p.in[8] + 3 * 1024 + col);
        }
        auto hrow = [&](int R, float4 (&h)[4]) {
            const float* xrw = R < NL ? p.in[0] + (size_t)R * 1024 : p.in[2] + (size_t)(R - NL) * 1024;
            float ss = 0.f;
#pragma unroll
            for (int i = 0; i < 4; ++i) { h[i] = *(const float4*)(xrw + i * 256 + lane * 4); ss += h[i].x * h[i].x + h[i].y * h[i].y + h[i].z * h[i].z + h[i].w * h[i].w; }
            ss = wave_allreduce(ss);
            const float rs = rsqrtf(ss * (1.0f / 1024.0f) + 1e-6f);
#pragma unroll
            for (int i = 0; i < 4; ++i) {
                h[i].x = h[i].x * rs * gg[i].x * (1.f + sc[i].x) + sh[i].x; h[i].y = h[i].y * rs * gg[i].y * (1.f + sc[i].y) + sh[i].y;
                h[i].z = h[i].z * rs * gg[i].z * (1.f + sc[i].z) + sh[i].z; h[i].w = h[i].w * rs * gg[i].w * (1.f + sc[i].w) + sh[i].w;
            }
        };
        float4 hp[4], hc[4], hn[4];
        if (t0 > 0) hrow(R0 - 1, hp); else { hp[0] = hp[1] = hp[2] = hp[3] = make_float4(0.f, 0.f, 0.f, 0.f); }
        hrow(R0, hc);
#pragma unroll 1
        for (int i8 = 0; i8 < 8; ++i8) {
            const int R = R0 + i8;
            if (t0 + i8 + 1 < slen) hrow(R + 1, hn); else { hn[0] = hn[1] = hn[2] = hn[3] = make_float4(0.f, 0.f, 0.f, 0.f); }
#pragma unroll
            for (int i = 0; i < 4; ++i) {
                const size_t o = (size_t)R * 1024 + i * 256 + lane * 4;
                const float4 c = hc[i];
                const float4 xx = make_float4(0.5f * (hp[i].x + hn[i].x) - c.x, 0.5f * (hp[i].y + hn[i].y) - c.y, 0.5f * (hp[i].z + hn[i].z) - c.z, 0.5f * (hp[i].w + hn[i].w) - c.w);
                *(uint2*)(hdst + o) = make_uint2(pk_bf16(c.x, c.y), pk_bf16(c.z, c.w));
                *(uint2*)(xr + o) = make_uint2(pk_bf16(c.x + xx.x * m0[i].x, c.y + xx.y * m0[i].y), pk_bf16(c.z + xx.z * m0[i].z, c.w + xx.w * m0[i].w));
                *(uint2*)(xk + o) = make_uint2(pk_bf16(c.x + xx.x * m2[i].x, c.y + xx.y * m2[i].y), pk_bf16(c.z + xx.z * m2[i].z, c.w + xx.w * m2[i].w));
                *(uint2*)(xv + o) = make_uint2(pk_bf16(c.x + xx.x * m3[i].x, c.y + xx.y * m3[i].y), pk_bf16(c.z + xx.z * m3[i].z, c.w + xx.w * m3[i].w));
            }
#pragma unroll
            for (int i = 0; i < 4; ++i) { hp[i] = hc[i]; hc[i] = hn[i]; }
        }
    }
}

template <int BN> struct EpiBf16 {
    bf16_t* dst; int ldd; int col0; int act;
    DEV void operator()(const f32x4 (&acc)[4][BN / 64], int m0, int wm, int wn, int fr, int fq) const {
#pragma unroll
        for (int mi = 0; mi < 4; ++mi) {
            const size_t R = (size_t)(m0 + wm * 64 + mi * 16 + fr);
#pragma unroll
            for (int ni = 0; ni < BN / 64; ++ni) {
                const int col = col0 + wn * (BN / 4) + ni * 16 + 4 * fq;
                float v[4] = {acc[mi][ni][0], acc[mi][ni][1], acc[mi][ni][2], acc[mi][ni][3]};
                if (act == 1) {
#pragma unroll
                    for (int j = 0; j < 4; ++j) v[j] = tanhf(v[j]);
                } else if (act == 2) {
#pragma unroll
                    for (int j = 0; j < 4; ++j) v[j] = sigmoidf_(v[j]);
                }
                *(uint2*)(dst + R * ldd + col) = make_uint2(pk_bf16(v[0], v[1]), pk_bf16(v[2], v[3]));
            }
        }
    }
};
struct EpiResid {
    const float* xold_lat; const float* xold_ctx; float* dst_lat; float* dst_ctx; const float* gate; int col0;
    DEV void operator()(const f32x4 (&acc)[4][4], int m0, int wm, int wn, int fr, int fq) const {
#pragma unroll
        for (int mi = 0; mi < 4; ++mi) {
            const int R = m0 + wm * 64 + mi * 16 + fr;
            const float* src = R < NL ? xold_lat + (size_t)R * 1024 : xold_ctx + (size_t)(R - NL) * 1024;
            float* dst = R < NL ? dst_lat + (size_t)R * 1024 : dst_ctx + (size_t)(R - NL) * 1024;
            const float* gr = gate + (size_t)mod_batch(R) * 6144;
#pragma unroll
            for (int ni = 0; ni < 4; ++ni) {
                const int col = col0 + wn * 64 + ni * 16 + 4 * fq;
                const float4 xo = *(const float4*)(src + col), g4 = *(const float4*)(gr + col);
                *(float4*)(dst + col) = make_float4(xo.x + g4.x * acc[mi][ni][0], xo.y + g4.y * acc[mi][ni][1], xo.z + g4.z * acc[mi][ni][2], xo.w + g4.w * acc[mi][ni][3]);
            }
        }
    }
};
struct EpiLr {
    float* dst;
    DEV void operator()(const f32x4 (&acc)[4][2], int m0, int wm, int wn, int fr, int fq) const {
        if (wn != 0) return;
#pragma unroll
        for (int mi = 0; mi < 4; ++mi) {
            const size_t R = (size_t)(m0 + wm * 64 + mi * 16 + fr);
#pragma unroll
            for (int ni = 0; ni < 2; ++ni) { const int col = ni * 16 + 4 * fq; *(float4*)(dst + R * 32 + col) = make_float4(acc[mi][ni][0], acc[mi][ni][1], acc[mi][ni][2], acc[mi][ni][3]); }
        }
    }
};

namespace pg8 {
#define PG8_LAS __attribute__((address_space(3)))
constexpr int BM = 256, BK = 64, HALF = 128, HTB = HALF * BK * 2  , STAGE_BYTES = 8 * HTB, NXCD = 8, WGM = 8;

__host__ __device__ __forceinline__ int lds_byte(int r, int c) { const int st = (r >> 4) * 2 + (c >> 5), rr = r & 15, cc = c & 31, ob = rr * 64 + cc * 2; return st * 1024 + (ob ^ (((ob >> 9) & 1) << 5)); }
__host__ __device__ __forceinline__ void stage_rc(int b, int& R, int& C) { const int st = b / 1024, sb = b % 1024, swz = sb ^ (((sb >> 9) & 1) << 5); R = (st >> 1) * 16 + swz / 64; C = (st & 1) * 32 + (swz % 64) / 2; }
__host__ __device__ __forceinline__ int perm32(int rho) { const int n = rho >> 4, i = rho & 15; return 8 * (i >> 2) + 4 * n + (i & 3); }
struct Unit { int pm, pn; };
struct Gemm { const bf16_t* A; const bf16_t* Bt; int M, N, K; };
struct StaticOrder {
    int nM, nN, nwg, G, c;
    __host__ __device__ void init(int M, int N, int G_, int c_) { nM = M / BM; nN = N / BM; nwg = nM * nN; G = G_; c = c_; }
    __host__ __device__ bool next(int i, Unit& u) const {
        const long L = (long)i * G + c; if (L >= nwg) return false;
        int wgid = (int)L; { const int q = nwg / NXCD, r = nwg % NXCD, xcd = wgid % NXCD, off = wgid / NXCD; wgid = (xcd < r ? xcd * (q + 1) : r * (q + 1) + (xcd - r) * q) + off; }
        const int nig = WGM * nN, gid = wgid / nig, fm = gid * WGM, gsz = (nM - fm) < WGM ? (nM - fm) : WGM;
        u.pm = fm + ((wgid % nig) % gsz); u.pn = (wgid % nig) / gsz; return true;
    }
    __device__ __forceinline__ void a_ready(const Unit&) const {}
    __device__ __forceinline__ void done(const Unit&) const {}
};
template <class Epi, class Sched, bool STAMP = false>
__device__ __forceinline__ void gemm_phase(PG8_LAS unsigned char* lds, const Gemm g, const Sched& S, const Epi& E, unsigned long long* stamps) {
    const int tid = tid_opaque(), wid = __builtin_amdgcn_readfirstlane(tid >> 6), lane = tid & 63, wr = wid >> 2, wc = wid & 3, fr = lane & 15, fq = lane >> 4;
    const int K = g.K, nt = K / BK;
    int ts_lo = 0, ts_hi = 0, nts = 0; const unsigned long long rt_entry = STAMP ? (unsigned long long)wall_clock64() : 0ull;
#define PG8_STAMP() do { if (STAMP && wid == 0 && nts < 64) { const unsigned long long _c = (unsigned long long)clock64(); \
        ts_lo = (lane == nts) ? (int)(unsigned)_c : ts_lo; ts_hi = (lane == nts) ? (int)(unsigned)(_c >> 32) : ts_hi; ++nts; } } while (0)
    PG8_STAMP();
    unsigned voffA[2], voffB[2];
#pragma unroll
    for (int i = 0; i < 2; ++i) { int R, C; stage_rc(tid * 16 + i * 8192, R, C); const int Rb = Epi::PERM ? ((R & ~31) + perm32(R & 31)) : R;
        voffA[i] = (unsigned)(R * K + C) * 2u; voffB[i] = (unsigned)(Rb * K + C) * 2u; }
    const size_t kstep = (size_t)(BK * 2);
    const size_t hstep = (size_t)HALF * K * 2;
    const size_t tstep = 2 * hstep;
    const unsigned ldsw = (unsigned)wid * 1024u;
    const int aoff = lds_byte(wr * 64 + fr, fq * 8), boff = lds_byte(wc * 32 + fr, fq * 8);
#define PG8_SA(b, h) (((b) * 2 + (h)) * HTB)
#define PG8_SB(b, h) ((4 + (b) * 2 + (h)) * HTB)
#define PG8_STAGE(bufoff, gbase, voff) do { _Pragma("unroll") for (int _i = 0; _i < 2; ++_i) \
        __builtin_amdgcn_global_load_lds((const unsigned*)((const char*)(gbase) + (voff)[_i]), (PG8_LAS unsigned*)(lds + (bufoff) + ldsw + _i * 8192), 16, 0, 0); } while (0)
#define PG8_LDA(dst, b, h) do { _Pragma("unroll") for (int m = 0; m < 4; ++m) _Pragma("unroll") for (int k = 0; k < 2; ++k) dst[m][k] = *(const PG8_LAS bf16x8*)(lds + PG8_SA(b, h) + aoff + m * 2048 + k * 1024); } while (0)
#define PG8_LDB(dst, b, h) do { _Pragma("unroll") for (int n = 0; n < 2; ++n) _Pragma("unroll") for (int k = 0; k < 2; ++k) dst[n][k] = *(const PG8_LAS bf16x8*)(lds + PG8_SB(b, h) + boff + n * 2048 + k * 1024); } while (0)
#define PG8_MMA(ai, bj, At, Bt) do { __builtin_amdgcn_s_setprio(1); _Pragma("unroll") for (int m = 0; m < 4; ++m) _Pragma("unroll") for (int n = 0; n < 2; ++n) _Pragma("unroll") for (int k = 0; k < 2; ++k) \
        acc[ai][bj][m][n] = __builtin_amdgcn_mfma_f32_16x16x32_bf16(Bt[n][k], At[m][k], acc[ai][bj][m][n], 0, 0, 0); __builtin_amdgcn_s_setprio(0); } while (0)
#define PG8_WAIT_V(n) asm volatile("s_waitcnt vmcnt(" #n ")" ::: "memory")
#define PG8_WAIT_L(n) asm volatile("s_waitcnt lgkmcnt(" #n ")" ::: "memory")
#define PG8_BAR __builtin_amdgcn_s_barrier()
#define PG8_SCHED __builtin_amdgcn_sched_barrier(0)
    Unit cur, nxt; int ui = 0;
    if (!S.next(0, cur)) return;
    f32x4 acc[2][2][4][2];
#pragma unroll
    for (int a = 0; a < 2; ++a)
#pragma unroll
        for (int b = 0; b < 2; ++b)
#pragma unroll
            for (int m = 0; m < 4; ++m)
#pragma unroll
                for (int n = 0; n < 2; ++n) acc[a][b][m][n] = (f32x4){0.f, 0.f, 0.f, 0.f};
    bf16x8 At[4][2], B0[2][2], B1[2][2];
    const char* cA = (const char*)g.A + (size_t)cur.pm * tstep; const char* cB = (const char*)g.Bt + (size_t)cur.pn * tstep;
    S.a_ready(cur);
    PG8_STAGE(PG8_SB(0, 0), cB, voffB); PG8_STAGE(PG8_SA(0, 0), cA, voffA); PG8_STAGE(PG8_SB(0, 1), cB + hstep, voffB); PG8_STAGE(PG8_SA(0, 1), cA + hstep, voffA);
    if (wr == 1) PG8_BAR;
    PG8_WAIT_V(4); PG8_BAR;
    PG8_STAGE(PG8_SB(1, 0), cB + kstep, voffB); PG8_STAGE(PG8_SA(1, 0), cA + kstep, voffA); PG8_STAGE(PG8_SB(1, 1), cB + hstep + kstep, voffB);
    PG8_WAIT_V(6); PG8_BAR;
    PG8_STAMP();
    for (;;) {
        const bool has_next = S.next(ui + 1, nxt);
        const char* nA = has_next ? (const char*)g.A + (size_t)nxt.pm * tstep : cA; const char* nB = has_next ? (const char*)g.Bt + (size_t)nxt.pn * tstep : cB;
        for (int t = 0; t < nt; t += 2) {
            const bool last = (t == nt - 2);
            const char* a1 = cA + (size_t)(t + 1) * kstep;
            const char* a2 = last ? nA : cA + (size_t)(t + 2) * kstep; const char* b2 = last ? nB : cB + (size_t)(t + 2) * kstep;
            const char* a3 = a2 + kstep; const char* b3 = b2 + kstep;
            if (last && has_next) S.a_ready(nxt);
            PG8_LDB(B0, 0, 0); PG8_SCHED; PG8_LDA(At, 0, 0); PG8_STAGE(PG8_SA(1, 1), a1 + hstep, voffA);
            PG8_WAIT_L(8); PG8_BAR; PG8_WAIT_L(0); PG8_MMA(0, 0, At, B0); PG8_BAR; PG8_SCHED;
            PG8_LDB(B1, 0, 1); PG8_STAGE(PG8_SB(0, 0), b2, voffB);
            PG8_BAR; PG8_WAIT_L(0); PG8_MMA(0, 1, At, B1); PG8_BAR;
            PG8_LDA(At, 0, 1); PG8_STAGE(PG8_SA(0, 0), a2, voffA);
            PG8_BAR; PG8_WAIT_L(0); PG8_MMA(1, 0, At, B0); PG8_BAR; PG8_SCHED;
            PG8_STAGE(PG8_SB(0, 1), b2 + hstep, voffB);
            PG8_WAIT_V(6); PG8_BAR; PG8_MMA(1, 1, At, B1); PG8_BAR;
            PG8_LDB(B0, 1, 0); PG8_SCHED; PG8_LDA(At, 1, 0); PG8_STAGE(PG8_SA(0, 1), a2 + hstep, voffA);
            PG8_WAIT_L(8); PG8_BAR; PG8_WAIT_L(0); PG8_MMA(0, 0, At, B0); PG8_BAR; PG8_SCHED;
            PG8_LDB(B1, 1, 1); PG8_STAGE(PG8_SB(1, 0), b3, voffB);
            PG8_BAR; PG8_WAIT_L(0); PG8_MMA(0, 1, At, B1); PG8_BAR;
            PG8_LDA(At, 1, 1); PG8_STAGE(PG8_SA(1, 0), a3, voffA);
            PG8_BAR; PG8_WAIT_L(0); PG8_MMA(1, 0, At, B0); PG8_BAR; PG8_SCHED;
            PG8_STAGE(PG8_SB(1, 1), b3 + hstep, voffB);
            PG8_WAIT_V(6); PG8_BAR; PG8_MMA(1, 1, At, B1); PG8_BAR;
        }
        PG8_STAMP();
        if constexpr (!Epi::AFTER_DRAIN) { E(acc, cur, wr, wc, fr, fq); S.done(cur); }
        PG8_STAMP();
        if (!has_next) break;
#pragma unroll
        for (int a = 0; a < 2; ++a)
#pragma unroll
            for (int b = 0; b < 2; ++b)
#pragma unroll
                for (int m = 0; m < 4; ++m)
#pragma unroll
                    for (int n = 0; n < 2; ++n) acc[a][b][m][n] = (f32x4){0.f, 0.f, 0.f, 0.f};
        cur = nxt; cA = nA; cB = nB; ++ui;
    }
    PG8_WAIT_V(0);
    if (wr == 0) PG8_BAR;
    PG8_BAR;
    if constexpr (Epi::AFTER_DRAIN) { E.fused(acc, cur, wr, wc, fr, fq, lds, wid, lane); S.done(cur); }
    PG8_STAMP();
    if (STAMP && wid == 0) { stamps[lane] = lane < nts ? (((unsigned long long)(unsigned)ts_hi << 32) | (unsigned)ts_lo) : 0ull;
        if (lane == 62) stamps[62] = rt_entry; if (lane == 63) stamps[63] = (unsigned long long)wall_clock64(); }
#undef PG8_STAMP
#undef PG8_SA
#undef PG8_SB
#undef PG8_STAGE
#undef PG8_LDA
#undef PG8_LDB
#undef PG8_MMA
#undef PG8_WAIT_V
#undef PG8_WAIT_L
#undef PG8_BAR
#undef PG8_SCHED
}
struct EpiBf16Tiles {
    static constexpr bool PERM = true, AFTER_DRAIN = false;
    bf16_t* d0; int ld0; int ntile0; bf16_t* d1; int ld1;
    __device__ __forceinline__ void operator()(const f32x4 (&acc)[2][2][4][2], const Unit& u, int wr, int wc, int fr, int fq) const {
        bf16_t* base = u.pn < ntile0 ? d0 : d1; const int ld = u.pn < ntile0 ? ld0 : ld1; const int colt = (u.pn < ntile0 ? u.pn : u.pn - ntile0) * BM;
        const int row0 = u.pm * BM + wr * 64 + fr, col0 = colt + wc * 32 + 8 * fq;
#pragma unroll
        for (int ai = 0; ai < 2; ++ai)
#pragma unroll
            for (int m = 0; m < 4; ++m) { bf16_t* rowp = base + (size_t)(row0 + ai * HALF + m * 16) * ld + col0;
#pragma unroll
                for (int bj = 0; bj < 2; ++bj) { const f32x4 v0 = acc[ai][bj][m][0], v1 = acc[ai][bj][m][1];
                    *(uint4*)(rowp + bj * HALF) = make_uint4(pk_bf16(v0[0], v0[1]), pk_bf16(v0[2], v0[3]), pk_bf16(v1[0], v1[1]), pk_bf16(v1[2], v1[3])); } }
    }
};
struct EpiResid256 {
    static constexpr bool PERM = false, AFTER_DRAIN = false;
    const float* xold_lat; const float* xold_ctx; float* dst_lat; float* dst_ctx; const float* gate;
    __device__ __forceinline__ void operator()(const f32x4 (&acc)[2][2][4][2], const Unit& u, int wr, int wc, int fr, int fq) const {
        const int row0 = u.pm * BM + wr * 64 + fr, col0 = u.pn * BM + wc * 32 + 4 * fq;
#pragma unroll
        for (int ai = 0; ai < 2; ++ai)
#pragma unroll
            for (int m = 0; m < 4; ++m) {
                const int R = row0 + ai * HALF + m * 16;
                const float* src = R < NL ? xold_lat + (size_t)R * 1024 : xold_ctx + (size_t)(R - NL) * 1024;
                float* dst = R < NL ? dst_lat + (size_t)R * 1024 : dst_ctx + (size_t)(R - NL) * 1024;
                const float* gr = gate + (size_t)mod_batch(R) * 6144;
#pragma unroll
                for (int bj = 0; bj < 2; ++bj)
#pragma unroll
                    for (int n = 0; n < 2; ++n) {
                        const int col = col0 + bj * HALF + n * 16;
                        const float4 xo = *(const float4*)(src + col), g4 = *(const float4*)(gr + col);
                        const f32x4 a = acc[ai][bj][m][n];
                        *(float4*)(dst + col) = make_float4(xo.x + g4.x * a[0], xo.y + g4.y * a[1], xo.z + g4.z * a[2], xo.w + g4.w * a[3]);
                    }
            }
    }
};
}

DEV void phase_rw_proj1(const Params& p, unsigned char* lds, int which, const bf16_t* A, bf16_t* dst) {
    pg8::Gemm g{A, (const bf16_t*)(p.ws + WS_WPROJ) + (size_t)which * 1024 * 1024, NT, 1024, 1024};
    pg8::StaticOrder so; so.init(NT, 1024, gridDim.x, blockIdx.x);
    pg8::EpiBf16Tiles ep{dst, 1024, 4, dst, 1024};
    pg8::gemm_phase((PG8_LAS unsigned char*)lds, g, so, ep, nullptr);
    __syncthreads();
}
DEV void phase_rw_lora(const Params& p, unsigned char* lds) {
    unsigned char* ws = p.ws;
    const bf16_t* h = (const bf16_t*)(ws + WS_S + 0 * U_BYTES);
    const bf16_t* wproj = (const bf16_t*)(ws + WS_WPROJ);
    const int nunits = (NT / 128) * 3;
    for (int u = blockIdx.x; u < nunits; u += gridDim.x) {
        const int mt = u / 3, lg = u % 3, m0 = mt * 128;
        const int mixid = lg == 0 ? 1 : (lg == 1 ? 4 : 5);
        ALoadMix al{h, p.in[8] + mixid * 1024, h, 1024};
        EpiBf16<128> ep{(bf16_t*)(ws + WS_S + 4 * U_BYTES), 384, lg * 128, lg == 0 ? 1 : (lg == 1 ? 0 : 2)};
        gemm_unit<128>(lds, al, wproj + (size_t)(3072 + lg * 128) * 1024, 1024, m0, ep);
    }
}

template <int N> DEV float dpp_shr0(float x) { return __int_as_float(__builtin_amdgcn_update_dpp(0, __float_as_int(x), 0x110 + N, 0xF, 0xF, true)); }
template <int CTRL> DEV float dpp_quad(float x) { return __int_as_float(__builtin_amdgcn_update_dpp(0, __float_as_int(x), CTRL, 0xF, 0xF, false)); }
DEV int tile_off(int row, int ch) { return row * 128 + ((ch ^ (row & 7)) << 4); }
DEV int tile_off2(int row, int ch) { return row * 128 + ((ch ^ ((row ^ (row >> 3)) & 7)) << 4); }
DEV void phase_rw_scan(const Params& p, unsigned char* lds) {
    const int tid = tid_opaque(), lane = tid & 63;
    const int wv = __builtin_amdgcn_readfirstlane(tid >> 6);
    const int fr = lane & 15, fq = lane >> 4;
    unsigned char* ws = p.ws;
    constexpr int SH = 0, SL = 8192, AT = 16384  , RT = 20480  , BT = 24576  , KT = 28672  , BKT = 32768  , UV = 49152  , NT = 65536  ;
    constexpr int MFA = 69632, MFK = 70656, X0 = 71680, VS = 75776  , PP = 83968, PM = 88064, PI = 92160, AA = 96256  ;
    constexpr int PL = 116736  , YB = 117760, LDS_END = 121856;
    const bf16_t* rbuf = (const bf16_t*)(ws + WS_S + 3 * U_BYTES);
    const bf16_t* kbuf = (const bf16_t*)(ws + WS_S + 5 * U_BYTES);
    const bf16_t* vbuf = (const bf16_t*)(ws + WS_S + 1 * U_BYTES);
    const bf16_t* lora = (const bf16_t*)(ws + WS_S + 4 * U_BYTES);
    for (int unit = blockIdx.x; unit < 256; unit += gridDim.x) {
        const int b = unit >> 5, hh = (unit >> 1) & 15, d = unit & 1;
        bf16_t* ydst = (bf16_t*)(ws + WS_S + (size_t)(d ? 2 : 0) * U_BYTES);
        float* bonus = (float*)(ws + WS_BONUS) + (size_t)((d * NB + b) * 16 + hh) * 8448;
        const int s_e = (tid >> 4) & 15, j0 = (tid & 15) * 4;
        const int ni = wv & 3;
        auto Rof = [&](int c, int s) -> int {
            if (c < 16) { const int q = c * 16 + s; return NL + b * 256 + (d ? 255 - q : q); }
            const int q = (c - 16) * 16 + s; return b * 8192 + (d ? 8191 - q : q);
        };
        constexpr int CST = LDS_END;
        uint2 pr = make_uint2(0, 0), pk = pr, pv = pr; uint4 paw[2], paa[2];
        if (wv >= 4) {
            const int ct = (tid - 256) * 16;
            *(float4*)(lds + CST + 0 * 4096 + ct) = *(const float4*)(p.in[18] + hh * 64 + j0);
            *(float4*)(lds + CST + 1 * 4096 + ct) = *(const float4*)(p.in[19] + hh * 64 + j0);
            *(float4*)(lds + CST + 2 * 4096 + ct) = *(const float4*)(p.in[20] + hh * 64 + j0);
            *(float4*)(lds + CST + 3 * 4096 + ct) = *(const float4*)(p.in[10] + d * 1024 + hh * 64 + ni * 16 + fq * 4);
            *(float4*)(lds + CST + 4 * 4096 + ct) = *(const float4*)(p.in[13] + d * 1024 + hh * 64 + ni * 16 + fq * 4);
#pragma unroll
            for (int ks = 0; ks < 2; ++ks) {
                *(uint4*)(lds + CST + (5 + ks) * 4096 + ct) = *(const uint4*)((const bf16_t*)(ws + WS_W2T) + (size_t)d * 1024 * 64 + (size_t)(hh * 64 + ni * 16 + fr) * 64 + ks * 32 + fq * 8);
                *(uint4*)(lds + CST + (7 + ks) * 4096 + ct) = *(const uint4*)((const bf16_t*)(ws + WS_A2T) + (size_t)d * 1024 * 64 + (size_t)(hh * 64 + ni * 16 + fr) * 64 + ks * 32 + fq * 8);
            }
        }
        auto load_lora = [&](int c) {
            const size_t R2 = (size_t)Rof(c, fr);
#pragma unroll
            for (int ks = 0; ks < 2; ++ks) { paw[ks] = *(const uint4*)(lora + R2 * 384 + d * 64 + ks * 32 + fq * 8); paa[ks] = *(const uint4*)(lora + R2 * 384 + 128 + d * 64 + ks * 32 + fq * 8); }
        };
        auto load_rkv = [&](int c) {
            const size_t off = (size_t)Rof(c, s_e) * 1024 + hh * 64 + j0;
            pr = *(const uint2*)(rbuf + off); pk = *(const uint2*)(kbuf + off); pv = *(const uint2*)(vbuf + off);
        };
        auto step_up = [&](int c) {
            const int ct = (tid - 256) * 16;
            const float4 bias_w = *(const float4*)(lds + CST + 3 * 4096 + ct), bias_a = *(const float4*)(lds + CST + 4 * 4096 + ct);
            bf16x8 bfw[2], bfa[2];
#pragma unroll
            for (int ks = 0; ks < 2; ++ks) { bfw[ks] = *(const bf16x8*)(lds + CST + (5 + ks) * 4096 + ct); bfa[ks] = *(const bf16x8*)(lds + CST + (7 + ks) * 4096 + ct); }
            f32x4 accw = {0.f, 0.f, 0.f, 0.f}, acca = {0.f, 0.f, 0.f, 0.f};
#pragma unroll
            for (int ks = 0; ks < 2; ++ks) { accw = __builtin_amdgcn_mfma_f32_16x16x32_bf16(bfw[ks], as_bf16x8(paw[ks]), accw, 0, 0, 0); acca = __builtin_amdgcn_mfma_f32_16x16x32_bf16(bfa[ks], as_bf16x8(paa[ks]), acca, 0, 0, 0); }
            const int n = ni * 16 + fq * 4;
            const float bw[4] = {bias_w.x, bias_w.y, bias_w.z, bias_w.w}, ba[4] = {bias_a.x, bias_a.y, bias_a.z, bias_a.w};
            float P[4], Pm[4], Pi[4], av[4];
#pragma unroll
            for (int j = 0; j < 4; ++j) {
                const float e = 0.6065306597f * __builtin_amdgcn_rcpf(1.0f + __expf(-(accw[j] + bw[j])));
                float s = e;
                s += dpp_shr0<1>(s); s += dpp_shr0<2>(s); s += dpp_shr0<4>(s); s += dpp_shr0<8>(s);
                P[j] = __expf(-s); Pi[j] = __builtin_amdgcn_rcpf(P[j]); Pm[j] = P[j] * __expf(e);
                av[j] = __builtin_amdgcn_rcpf(1.0f + __expf(-(acca[j] + ba[j])));
            }
            const int pb = (c & 1) * 16384;
            *(float4*)(lds + PP + pb + (fr * 64 + n) * 4) = make_float4(P[0], P[1], P[2], P[3]);
            *(float4*)(lds + PM + pb + (fr * 64 + n) * 4) = make_float4(Pm[0], Pm[1], Pm[2], Pm[3]);
            *(float4*)(lds + PI + pb + (fr * 64 + n) * 4) = make_float4(Pi[0], Pi[1], Pi[2], Pi[3]);
            *(float4*)(lds + AA + pb + (fr * 64 + n) * 4) = make_float4(av[0], av[1], av[2], av[3]);
            if (fr == 15) *(float4*)(lds + PL + (c & 3) * 256 + n * 4) = make_float4(P[0], P[1], P[2], P[3]);
        };
        auto step_vec = [&](int c) {
            const int eo = (s_e * 64 + j0) * 4, pb = (c & 1) * 16384, tb = (c & 1) * 8192, ct = (tid - 256) * 16;
            const float4 kk_c = *(const float4*)(lds + CST + 0 * 4096 + ct), ka_c = *(const float4*)(lds + CST + 1 * 4096 + ct), rk_c = *(const float4*)(lds + CST + 2 * 4096 + ct);
            const float4 a4 = *(const float4*)(lds + AA + pb + eo), P4 = *(const float4*)(lds + PP + pb + eo), Pm4 = *(const float4*)(lds + PM + pb + eo), Pi4 = *(const float4*)(lds + PI + pb + eo);
            const float kx[4] = {bf_lo(pk.x), bf_hi(pk.x), bf_lo(pk.y), bf_hi(pk.y)};
            const float rx[4] = {bf_lo(pr.x), bf_hi(pr.x), bf_lo(pr.y), bf_hi(pr.y)};
            const float av[4] = {a4.x, a4.y, a4.z, a4.w}, Pv[4] = {P4.x, P4.y, P4.z, P4.w}, Pmv[4] = {Pm4.x, Pm4.y, Pm4.z, Pm4.w}, Piv[4] = {Pi4.x, Pi4.y, Pi4.z, Pi4.w};
            const float kkc[4] = {kk_c.x, kk_c.y, kk_c.z, kk_c.w}, kac[4] = {ka_c.x, ka_c.y, ka_c.z, ka_c.w}, rkc[4] = {rk_c.x, rk_c.y, rk_c.z, rk_c.w};
            float t[4], n2 = 0.f;
#pragma unroll
            for (int j = 0; j < 4; ++j) { t[j] = kx[j] * kkc[j]; n2 += t[j] * t[j]; }
            n2 = row16_allreduce(n2);
            const float inv = 1.0f / fmaxf(sqrtf(n2), 1e-12f);
            float at[4], bt[4], kt[4], rt[4], bon = 0.f;
#pragma unroll
            for (int j = 0; j < 4; ++j) {
                const float kkv = t[j] * inv;
                const float kd = kx[j] * (1.0f + (av[j] - 1.0f) * kac[j]);
                const float bq = kkv * av[j];
                bon += rx[j] * kd * rkc[j];
                at[j] = -kkv * Pmv[j]; bt[j] = bq * Piv[j]; kt[j] = kd * Piv[j]; rt[j] = rx[j] * Pv[j];
            }
            bon = row16_allreduce(bon);
            if ((tid & 15) == 0) { const int Rb = Rof(c, s_e); bonus[Rb < NL ? 256 + (Rb & 8191) : ((Rb - NL) & 255)] = bon; }
            const int ro = tile_off(s_e, j0 >> 3) + (j0 & 7) * 2;
            *(uint2*)(lds + AT + (c & 1) * 2048 + ro) = make_uint2(pk_bf16(at[0], at[1]), pk_bf16(at[2], at[3]));
            *(uint2*)(lds + RT + (c & 1) * 2048 + ro) = make_uint2(pk_bf16(rt[0], rt[1]), pk_bf16(rt[2], rt[3]));
            const unsigned b01 = pk_bf16(bt[0], bt[1]), b23 = pk_bf16(bt[2], bt[3]), k01 = pk_bf16(kt[0], kt[1]), k23 = pk_bf16(kt[2], kt[3]);
            *(uint2*)(lds + BT + (c & 1) * 2048 + ro) = make_uint2(b01, b23);
            *(uint2*)(lds + KT + (c & 1) * 2048 + ro) = make_uint2(k01, k23);
            const unsigned bw2[4] = {b01 & 0xffffu, b01 >> 16, b23 & 0xffffu, b23 >> 16}, kw2[4] = {k01 & 0xffffu, k01 >> 16, k23 & 0xffffu, k23 >> 16};
            const unsigned vw[4] = {pv.x & 0xffffu, pv.x >> 16, pv.y & 0xffffu, pv.y >> 16};
            const int e0 = (s_e & 7) * 2, cq = s_e >> 3;
#pragma unroll
            for (int j = 0; j < 4; ++j) {
                const int row = j0 + j;
                *(bf16_t*)(lds + BKT + tb + tile_off2(row, 0 + cq) + e0) = (bf16_t)bw2[j];
                *(bf16_t*)(lds + BKT + tb + tile_off2(row, 2 + cq) + e0) = (bf16_t)kw2[j];
                *(bf16_t*)(lds + BKT + tb + tile_off2(row, 4 + cq) + e0) = (bf16_t)bw2[j];
                *(bf16_t*)(lds + UV + tb + tile_off2(row, 2 + cq) + e0) = (bf16_t)vw[j];
            }
            *(float4*)(lds + VS + (c & 1) * 4096 + eo) = make_float4(bf_lo(pv.x), bf_hi(pv.x), bf_lo(pv.y), bf_hi(pv.y));
        };
        f32x4 accY = {0.f, 0.f, 0.f, 0.f};
        auto prod_S = [&](int c) {
            const int vt = wv & 3, tb = (c & 1) * 2048;
            f32x4 accX = {0.f, 0.f, 0.f, 0.f}, accR = {0.f, 0.f, 0.f, 0.f};
#pragma unroll
            for (int ks = 0; ks < 2; ++ks) {
                const int ch = ks * 4 + fq;
                const bf16x8 sh = *(const bf16x8*)(lds + SH + tile_off(vt * 16 + fr, ch)), sl = *(const bf16x8*)(lds + SL + tile_off(vt * 16 + fr, ch));
                const bf16x8 fa = *(const bf16x8*)(lds + AT + tb + tile_off(fr, ch)), frr = *(const bf16x8*)(lds + RT + tb + tile_off(fr, ch));
                accX = __builtin_amdgcn_mfma_f32_16x16x32_bf16(sh, fa, accX, 0, 0, 0);
                accR = __builtin_amdgcn_mfma_f32_16x16x32_bf16(sh, frr, accR, 0, 0, 0);
                accX = __builtin_amdgcn_mfma_f32_16x16x32_bf16(sl, fa, accX, 0, 0, 0);
                accR = __builtin_amdgcn_mfma_f32_16x16x32_bf16(sl, frr, accR, 0, 0, 0);
            }
            accY = accR;
#pragma unroll
            for (int j = 0; j < 4; ++j) *(float*)(lds + X0 + ((vt * 16 + 4 * fq + j) * 16 + fr) * 4) = accX[j];
        };
        auto prod_V = [&](int c) {
            const int tb = (c & 1) * 2048, w4 = wv & 3;
            f32x4 m = {0.f, 0.f, 0.f, 0.f};
#pragma unroll
            for (int ks = 0; ks < 2; ++ks) {
                const int ch = ks * 4 + fq;
                const bf16x8 fa = *(const bf16x8*)(lds + ((w4 & 1) ? KT : BT) + tb + tile_off(fr, ch));
                const bf16x8 fb = *(const bf16x8*)(lds + ((w4 & 2) ? RT : AT) + tb + tile_off(fr, ch));
                m = __builtin_amdgcn_mfma_f32_16x16x32_bf16(fa, fb, m, 0, 0, 0);
            }
            if (w4 < 2) {
                float* mf = (float*)(lds + (w4 ? MFK : MFA));
#pragma unroll
                for (int j = 0; j < 4; ++j) mf[(fr * 4 + j) * 4 + fq] = (4 * fq + j < fr) ? m[j] : 0.f;
            } else {
                const float m0 = (4 * fq + 0 <= fr) ? m[0] : 0.f, m1 = (4 * fq + 1 <= fr) ? m[1] : 0.f, m2 = (4 * fq + 2 <= fr) ? m[2] : 0.f, m3 = (4 * fq + 3 <= fr) ? m[3] : 0.f;
                const uint2 o = make_uint2(pk_bf16(m0, m1), pk_bf16(m2, m3));
                const int colb = (w4 == 2 ? 0 : 16) + 4 * fq;
                *(uint2*)(lds + NT + tb + tile_off(fr, colb >> 3) + (colb & 7) * 2) = o;
                if (w4 == 2) *(uint2*)(lds + NT + tb + tile_off(fr, (32 + 4 * fq) >> 3) + ((32 + 4 * fq) & 7) * 2) = o;
            }
        };
        auto step_rec = [&](int c) {
            const int v = tid >> 2, pq = tid & 3;
            float cc[16];
#pragma unroll
            for (int i = 0; i < 4; ++i) { const float4 q = *(const float4*)(lds + X0 + (v * 16 + 4 * i) * 4); cc[4 * i] = q.x; cc[4 * i + 1] = q.y; cc[4 * i + 2] = q.z; cc[4 * i + 3] = q.w; }
            float vown[4];
#pragma unroll
            for (int i = 0; i < 4; ++i) vown[i] = *(const float*)(lds + VS + (c & 1) * 4096 + ((4 * i + pq) * 64 + v) * 4);
#pragma unroll
            for (int t = 1; t < 16; ++t) {
                const float4 mk = *(const float4*)(lds + MFK + ((t * 4 + pq) * 4) * 4);
                float s = vown[0] * mk.x; s = fmaf(vown[1], mk.y, s); s = fmaf(vown[2], mk.z, s); s = fmaf(vown[3], mk.w, s);
                s += dpp_quad<0xB1>(s); s += dpp_quad<0x4E>(s);
                cc[t] += s;
            }
            float4 ma[16];
#pragma unroll
            for (int t = 1; t < 16; ++t) ma[t] = *(const float4*)(lds + MFA + ((t * 4 + pq) * 4) * 4);
            ma[0] = make_float4(0.f, 0.f, 0.f, 0.f);
            float uown[4] = {0.f, 0.f, 0.f, 0.f}, uall[16];
#pragma unroll
            for (int t = 0; t < 16; ++t) {
                float s = uown[0] * ma[t].x; s = fmaf(uown[1], ma[t].y, s); s = fmaf(uown[2], ma[t].z, s); s = fmaf(uown[3], ma[t].w, s);
                s += dpp_quad<0xB1>(s); s += dpp_quad<0x4E>(s);
                const float u = cc[t] + s;
                uall[t] = u;
                if (pq == (t & 3)) uown[t >> 2] = u;
            }
            if (pq < 2) {
                unsigned o[8];
#pragma unroll
                for (int i = 0; i < 8; ++i) {
                    const unsigned hi = pk_bf16(uall[2 * i], uall[2 * i + 1]);
                    o[i] = pq ? pk_bf16(uall[2 * i] - bf_lo(hi), uall[2 * i + 1] - bf_hi(hi)) : hi;
                }
                const int cb = pq ? 4 : 0;
                *(uint4*)(lds + UV + (c & 1) * 8192 + tile_off2(v, cb)) = make_uint4(o[0], o[1], o[2], o[3]);
                *(uint4*)(lds + UV + (c & 1) * 8192 + tile_off2(v, cb + 1)) = make_uint4(o[4], o[5], o[6], o[7]);
            }
        };
        f32x4 accS[2];
        accS[0] = (f32x4){0.f, 0.f, 0.f, 0.f}; accS[1] = (f32x4){0.f, 0.f, 0.f, 0.f};
        auto step_upd = [&](int c) {
            const int vt = wv & 3;
            bf16x8 fuv[2];
#pragma unroll
            for (int ks = 0; ks < 2; ++ks) fuv[ks] = *(const bf16x8*)(lds + UV + (c & 1) * 8192 + tile_off2(vt * 16 + fr, ks * 4 + fq));
            if (wv < 4) {
#pragma unroll
                for (int ks = 0; ks < 2; ++ks) accY = __builtin_amdgcn_mfma_f32_16x16x32_bf16(fuv[ks], *(const bf16x8*)(lds + NT + (c & 1) * 2048 + tile_off(fr, ks * 4 + fq)), accY, 0, 0, 0);
                *(float4*)(lds + YB + (fr * 64 + vt * 16 + 4 * fq) * 4) = make_float4(accY[0], accY[1], accY[2], accY[3]);
            }
#pragma unroll
            for (int k2 = 0; k2 < 2; ++k2) {
                const int kt = 2 * (wv >> 2) + k2;
                f32x4 a = accS[k2];
#pragma unroll
                for (int ks = 0; ks < 2; ++ks) a = __builtin_amdgcn_mfma_f32_16x16x32_bf16(*(const bf16x8*)(lds + BKT + (c & 1) * 8192 + tile_off2(kt * 16 + fr, ks * 4 + fq)), fuv[ks], a, 0, 0, 0);
                const float4 pl = *(const float4*)(lds + PL + (c & 3) * 256 + (kt * 16 + 4 * fq) * 4);
                a[0] *= pl.x; a[1] *= pl.y; a[2] *= pl.z; a[3] *= pl.w;
                accS[k2] = a;
                const unsigned h01 = pk_bf16(a[0], a[1]), h23 = pk_bf16(a[2], a[3]);
                const unsigned l01 = pk_bf16(a[0] - bf_lo(h01), a[1] - bf_hi(h01)), l23 = pk_bf16(a[2] - bf_lo(h23), a[3] - bf_hi(h23));
                const int kc = kt * 16 + 4 * fq;
                const int so = tile_off(vt * 16 + fr, kc >> 3) + (kc & 7) * 2;
                *(uint2*)(lds + SH + so) = make_uint2(h01, h23);
                *(uint2*)(lds + SL + so) = make_uint2(l01, l23);
            }
        };
        for (int i = tid; i < LDS_END / 16; i += NTHREADS) *(uint4*)(lds + i * 16) = make_uint4(0, 0, 0, 0);
        if (wv >= 4) { load_lora(0); load_rkv(0); }
        __syncthreads();
        if (wv >= 4) { step_up(0); load_lora(1); }
        __syncthreads();
        if (wv >= 4) { step_vec(0); step_up(1); load_rkv(1); load_lora(2); }
        __syncthreads();
        if (wv >= 4) prod_V(0);
        __syncthreads();
        auto ystore = [&](int c) {
            const float4 y4 = *(const float4*)(lds + YB + (s_e * 64 + j0) * 4);
            *(uint2*)(ydst + (size_t)Rof(c, s_e) * 1024 + hh * 64 + j0) = make_uint2(pk_bf16(y4.x, y4.y), pk_bf16(y4.z, y4.w));
        };
        if (wv < 4) {
            for (int c = 0; c < 528; ++c) {
                if (c > 0) ystore(c - 1);
                prod_S(c);
                step_rec(c);
                __syncthreads();
                step_upd(c);
                __syncthreads();
            }
        } else {
            for (int c = 0; c < 528; ++c) {
                if (c + 1 < 528) step_vec(c + 1);
                if (c + 2 < 528) { step_up(c + 2); load_rkv(c + 2); }
                if (c + 3 < 528) load_lora(c + 3);
                __syncthreads();
                step_upd(c);
                if (c + 1 < 528) prod_V(c + 1);
                __syncthreads();
            }
        }
        if (wv < 4) ystore(527);
        __syncthreads();
    }
}

DEV void phase_rw_readout(const Params& p) {
    const int tid = tid_opaque(), lane = tid & 63, wv = tid >> 6, wm = wv >> 2, wn = wv & 3;
    const int fr = lane & 15, fq = lane >> 4;
    unsigned char* ws = p.ws;
    const bf16_t* y0b = (const bf16_t*)(ws + WS_S + 0 * U_BYTES);
    const bf16_t* y1b = (const bf16_t*)(ws + WS_S + 2 * U_BYTES);
    const bf16_t* vb = (const bf16_t*)(ws + WS_S + 1 * U_BYTES);
    const bf16_t* lora = (const bf16_t*)(ws + WS_S + 4 * U_BYTES);
    const bf16_t* g2t = (const bf16_t*)(ws + WS_G2T);
    bf16_t* ao = (bf16_t*)(ws + WS_S + 5 * U_BYTES);
    const float* bon0 = (const float*)(ws + WS_BONUS);
    const float* bon1 = bon0 + (size_t)NB * 16 * 8448;
    const float* lnw = p.in[21];
    const float* lnb = p.in[22];
    const int nunits = (NT / 128) * 4;
    for (int u = blockIdx.x; u < nunits; u += gridDim.x) {
        const int mt = u >> 2, nt = u & 3, m0 = mt * 128;
        const int hh = nt * 4 + wn;
        f32x4 acc[4][4];
#pragma unroll
        for (int mi = 0; mi < 4; ++mi)
#pragma unroll
            for (int ni = 0; ni < 4; ++ni) acc[mi][ni] = (f32x4){0.f, 0.f, 0.f, 0.f};
#pragma unroll 2
        for (int ks = 0; ks < 4; ++ks) {
            bf16x8 af[4], bfr[4];
#pragma unroll
            for (int mi = 0; mi < 4; ++mi) af[mi] = *(const bf16x8*)(lora + (size_t)(m0 + wm * 64 + mi * 16 + fr) * 384 + 256 + ks * 32 + fq * 8);
#pragma unroll
            for (int ni = 0; ni < 4; ++ni) bfr[ni] = *(const bf16x8*)(g2t + (size_t)(hh * 64 + ni * 16 + fr) * 128 + ks * 32 + fq * 8);
#pragma unroll
            for (int mi = 0; mi < 4; ++mi)
#pragma unroll
                for (int ni = 0; ni < 4; ++ni) acc[mi][ni] = __builtin_amdgcn_mfma_f32_16x16x32_bf16(bfr[ni], af[mi], acc[mi][ni], 0, 0, 0);
        }
#pragma unroll
        for (int mi = 0; mi < 4; ++mi) {
            const size_t R = (size_t)(m0 + wm * 64 + mi * 16 + fr);
            float yv[4][4]; float sum = 0.f;
#pragma unroll
            for (int ni = 0; ni < 4; ++ni) {
                const int col = hh * 64 + ni * 16 + 4 * fq;
                const uint2 a = *(const uint2*)(y0b + R * 1024 + col), b2 = *(const uint2*)(y1b + R * 1024 + col);
                yv[ni][0] = bf_lo(a.x) + bf_lo(b2.x); yv[ni][1] = bf_hi(a.x) + bf_hi(b2.x); yv[ni][2] = bf_lo(a.y) + bf_lo(b2.y); yv[ni][3] = bf_hi(a.y) + bf_hi(b2.y);
                sum += (yv[ni][0] + yv[ni][1]) + (yv[ni][2] + yv[ni][3]);
            }
            sum += __shfl_xor(sum, 16); sum += __shfl_xor(sum, 32);
            const float mu = sum * (1.0f / 64.0f);
            float q = 0.f;
#pragma unroll
            for (int ni = 0; ni < 4; ++ni)
#pragma unroll
                for (int j = 0; j < 4; ++j) { const float dlt = yv[ni][j] - mu; q += dlt * dlt; }
            q += __shfl_xor(q, 16); q += __shfl_xor(q, 32);
            const float rstd = rsqrtf(q * (1.0f / 64.0f) + 64e-5f);
            const size_t bidx = (size_t)(((R < NL ? (R >> 13) : ((R - NL) >> 8)) * 16 + hh)) * 8448 + (R < NL ? 256 + (R & 8191) : ((R - NL) & 255));
            const float bs = bon0[bidx] + bon1[bidx];
#pragma unroll
            for (int ni = 0; ni < 4; ++ni) {
                const int col = hh * 64 + ni * 16 + 4 * fq;
                const uint2 vv = *(const uint2*)(vb + R * 1024 + col);
                const float4 lw = *(const float4*)(lnw + col), lb = *(const float4*)(lnb + col);
                const float o0 = ((yv[ni][0] - mu) * rstd * lw.x + lb.x + bs * bf_lo(vv.x)) * acc[mi][ni][0];
                const float o1 = ((yv[ni][1] - mu) * rstd * lw.y + lb.y + bs * bf_hi(vv.x)) * acc[mi][ni][1];
                const float o2 = ((yv[ni][2] - mu) * rstd * lw.z + lb.z + bs * bf_lo(vv.y)) * acc[mi][ni][2];
                const float o3 = ((yv[ni][3] - mu) * rstd * lw.w + lb.w + bs * bf_hi(vv.y)) * acc[mi][ni][3];
                *(uint2*)(ao + R * 1024 + col) = make_uint2(pk_bf16(o0, o1), pk_bf16(o2, o3));
            }
        }
    }
}

DEV void phase_wo(const Params& p, unsigned char* lds, int layer) {
    unsigned char* ws = p.ws;
    const bf16_t* ao = (const bf16_t*)(ws + WS_S + (size_t)(layer ? 0 : 5) * U_BYTES);
    const bf16_t* wot = (const bf16_t*)(ws + (layer ? WS_WO1 : WS_WO0));
    float* ctxr = (float*)(ws + WS_CTXR);
    const float* gate = (const float*)(ws + WS_MOD) + (size_t)layer * 9 * 6144 + 2 * 1024;
    const int M = layer ? NL : NT;
    pg8::Gemm g{ao, wot, M, 1024, 1024};
    pg8::StaticOrder so; so.init(M, 1024, gridDim.x, blockIdx.x);
    pg8::EpiResid256 ep{layer ? p.out : p.in[0], layer ? ctxr : p.in[2], p.out, ctxr, gate};
    pg8::gemm_phase((PG8_LAS unsigned char*)lds, g, so, ep, nullptr);
    __syncthreads();
}

struct EpiQTile {
    unsigned char* lds;
    DEV void operator()(const f32x4 (&acc)[4][4], int m0, int wm, int wn, int fr, int fq) const {
        const int pp = wn >> 1;
#pragma unroll
        for (int mi = 0; mi < 4; ++mi) {
            const int m = wm * 64 + mi * 16 + fr;
#pragma unroll
            for (int ni = 0; ni < 4; ++ni) {
                const int c = (wn & 1) * 64 + ni * 16 + 4 * fq;
                *(uint2*)(lds + pp * 32768 + m * 256 + (((c >> 3) ^ (m & 15)) << 4) + (c & 7) * 2) = make_uint2(pk_bf16(acc[mi][ni][0], acc[mi][ni][1]), pk_bf16(acc[mi][ni][2], acc[mi][ni][3]));
            }
        }
    }
};
DEV void phase_peer_select(const Params& p, unsigned char* lds, int layer) {
    const int tid = tid_opaque(), lane = tid & 63, wv = tid >> 6, wm = wv >> 2, wn = wv & 3;
    const int fr = lane & 15, fq = lane >> 4;
    unsigned char* ws = p.ws;
    const bf16_t* hp = (const bf16_t*)(ws + WS_S + (size_t)(layer ? 0 : 1) * U_BYTES);
    const bf16_t* wqt = (const bf16_t*)(ws + WS_WQ) + (size_t)layer * 2048 * 1024;
    const bf16_t* keys = (const bf16_t*)(ws + WS_KEYS) + (size_t)layer * 8 * 2 * 128 * 128;
    int* pl_idx = (int*)(ws + WS_S + 3 * U_BYTES);
    float* pl_gate = (float*)(ws + WS_S + 3 * U_BYTES + (size_t)NT * 128 * 4);
    unsigned* slist = (unsigned*)lds;
    unsigned* tlist = (unsigned*)(lds + 256 * 132 * 4);
    const int mtiles = layer ? NL / 128 : NT / 128;
    for (int u = blockIdx.x; u < mtiles * 8; u += gridDim.x) {
        const int mt = u >> 3, head = u & 7, m0 = mt * 128;
        ALoadPlain al{hp, 1024};
        EpiQTile ep{lds};
        gemm_unit<256>(lds, al, wqt + (size_t)head * 256 * 1024, 1024, m0, ep);
        __syncthreads();
        const int pp = wn >> 1, nk0 = (wn & 1) * 64;
        f32x4 sc[4][4];
#pragma unroll
        for (int mi = 0; mi < 4; ++mi)
#pragma unroll
            for (int ni = 0; ni < 4; ++ni) sc[mi][ni] = (f32x4){0.f, 0.f, 0.f, 0.f};
        const bf16_t* kb = keys + (size_t)(head * 2 + pp) * 16384;
#pragma unroll
        for (int ks = 0; ks < 4; ++ks) {
            bf16x8 af[4], bfr[4];
            const int ch = ks * 4 + fq;
#pragma unroll
            for (int mi = 0; mi < 4; ++mi) { const int m = wm * 64 + mi * 16 + fr; af[mi] = *(const bf16x8*)(lds + pp * 32768 + m * 256 + ((ch ^ (m & 15)) << 4)); }
#pragma unroll
            for (int ni = 0; ni < 4; ++ni) bfr[ni] = *(const bf16x8*)(kb + (size_t)(nk0 + ni * 16 + fr) * 128 + ks * 32 + fq * 8);
#pragma unroll
            for (int mi = 0; mi < 4; ++mi)
#pragma unroll
                for (int ni = 0; ni < 4; ++ni) sc[mi][ni] = __builtin_amdgcn_mfma_f32_16x16x32_bf16(bfr[ni], af[mi], sc[mi][ni], 0, 0, 0);
        }
        __syncthreads();
#pragma unroll
        for (int mi = 0; mi < 4; ++mi) {
            const int m = wm * 64 + mi * 16 + fr;
#pragma unroll
            for (int ni = 0; ni < 4; ++ni) {
                const int n = nk0 + ni * 16 + 4 * fq;
                uint4 o;
                o.x = (mono_u32(sc[mi][ni][0]) & ~127u) | (unsigned)(127 - (n + 0));
                o.y = (mono_u32(sc[mi][ni][1]) & ~127u) | (unsigned)(127 - (n + 1));
                o.z = (mono_u32(sc[mi][ni][2]) & ~127u) | (unsigned)(127 - (n + 2));
                o.w = (mono_u32(sc[mi][ni][3]) & ~127u) | (unsigned)(127 - (n + 3));
                *(uint4*)(slist + (size_t)(pp * 128 + m) * 132 + n) = o;
            }
        }
        __syncthreads();
#pragma unroll 1
        for (int ps = 0; ps < 4; ++ps) {
            const int L = ps * 64 + (tid >> 3), g8 = tid & 7;
            unsigned t[16];
            {
                const unsigned* srcp = slist + (size_t)L * 132 + g8 * 16;
#pragma unroll
                for (int i = 0; i < 4; ++i) { const uint4 v = *(const uint4*)(srcp + i * 4); t[4 * i] = v.x; t[4 * i + 1] = v.y; t[4 * i + 2] = v.z; t[4 * i + 3] = v.w; }
            }
#pragma unroll
            for (int k = 2; k <= 16; k <<= 1)
#pragma unroll
                for (int j = k >> 1; j > 0; j >>= 1)
#pragma unroll
                    for (int i = 0; i < 16; ++i) {
                        const int l = i ^ j;
                        if (l > i) {
                            const unsigned mx = max(t[i], t[l]), mn = min(t[i], t[l]);
                            if ((i & k) == 0) { t[i] = mx; t[l] = mn; } else { t[i] = mn; t[l] = mx; }
                        }
                    }
#pragma unroll
            for (int rnd = 0; rnd < 3; ++rnd) {
                unsigned c[16];
#pragma unroll
                for (int i = 0; i < 16; ++i) {
                    const int src_i = __float_as_int(__uint_as_float(t[15 - i]));
                    const int b = rnd == 0 ? __builtin_amdgcn_update_dpp(0, src_i, 0xB1, 0xF, 0xF, false)
                                : (rnd == 1 ? __builtin_amdgcn_update_dpp(0, src_i, 0x4E, 0xF, 0xF, false)
                                            : __builtin_amdgcn_update_dpp(0, src_i, 0x141, 0xF, 0xF, false));
                    c[i] = max(t[i], (unsigned)b);
                }
#pragma unroll
                for (int j = 8; j > 0; j >>= 1)
#pragma unroll
                    for (int i = 0; i < 16; ++i) {
                        const int l = i ^ j;
                        if (l > i) { const unsigned mx = max(c[i], c[l]), mn = min(c[i], c[l]); c[i] = mx; c[l] = mn; }
                    }
#pragma unroll
                for (int i = 0; i < 16; ++i) t[i] = c[i];
            }
            if (g8 == 0) {
#pragma unroll
                for (int i = 0; i < 4; ++i) *(uint4*)(tlist + L * 16 + i * 4) = make_uint4(t[4 * i], t[4 * i + 1], t[4 * i + 2], t[4 * i + 3]);
            }
        }
        __syncthreads();
        if (tid < 128) {
            float v0[16], v1[16];
#pragma unroll
            for (int i = 0; i < 16; ++i) { v0[i] = unmono_u32(tlist[tid * 16 + i] & ~127u); v1[i] = unmono_u32(tlist[(128 + tid) * 16 + i] & ~127u); }
            unsigned cd[16];
#pragma unroll
            for (int i = 0; i < 16; ++i) cd[i] = 0u;
#pragma unroll
            for (int i = 0; i < 16; ++i) {
#pragma unroll
                for (int j = 0; j < 16; ++j) {
                    if ((i + 1) * (j + 1) <= 16) {
                        unsigned x = (mono_u32(v0[i] + v1[j]) & ~255u) | (unsigned)(255 - (i * 16 + j));
#pragma unroll
                        for (int q = 0; q < 16; ++q) { const unsigned mx = max(cd[q], x); x = min(cd[q], x); cd[q] = mx; }
                    }
                }
            }
            float sv[16]; int ex[16];
#pragma unroll
            for (int q = 0; q < 16; ++q) {
                const int slot = 255 - (int)(cd[q] & 255u);
                const unsigned a = tlist[tid * 16 + (slot >> 4)], b2 = tlist[(128 + tid) * 16 + (slot & 15)];
                sv[q] = unmono_u32(a & ~127u) + unmono_u32(b2 & ~127u);
                ex[q] = (127 - (int)(a & 127u)) * 128 + (127 - (int)(b2 & 127u));
            }
            float mx = sv[0];
#pragma unroll
            for (int q = 1; q < 16; ++q) mx = fmaxf(mx, sv[q]);
            float den = 0.f;
#pragma unroll
            for (int q = 0; q < 16; ++q) { sv[q] = __expf(sv[q] - mx); den += sv[q]; }
            const float rden = 1.0f / den;
            const size_t base = ((size_t)head * NT + (m0 + tid)) * 16;
#pragma unroll
            for (int i = 0; i < 4; ++i) {
                *(int4*)(pl_idx + base + i * 4) = make_int4(ex[4 * i], ex[4 * i + 1], ex[4 * i + 2], ex[4 * i + 3]);
                *(float4*)(pl_gate + base + i * 4) = make_float4(sv[4 * i] * rden, sv[4 * i + 1] * rden, sv[4 * i + 2] * rden, sv[4 * i + 3] * rden);
            }
        }
        __syncthreads();
    }
}

typedef float f32x2 __attribute__((ext_vector_type(2)));
typedef unsigned int u32x4 __attribute__((ext_vector_type(4)));
typedef unsigned int u32x2 __attribute__((ext_vector_type(2)));
#define PS_LOAD(buf, ee, h) { _Pragma("unroll") for (int e = 0; e < 8; ++e) { \
        const u32x4 t4 = __builtin_amdgcn_raw_buffer_load_b128(rs, ((unsigned)ee[(h) * 8 + e] << 7) + ch16, 0, 0); buf[e] = make_uint4(t4.x, t4.y, t4.z, t4.w); } }
#define PS_IDX(ee, Rr) { _Pragma("unroll") for (int i = 0; i < 4; ++i) { const int4 t = *(const int4*)(pl_idx + ((size_t)sub * NT + (Rr)) * 16 + 4 * i); \
        ee[4 * i] = t.x; ee[4 * i + 1] = t.y; ee[4 * i + 2] = t.z; ee[4 * i + 3] = t.w; } }
DEV long pk64(unsigned lo, unsigned hi) { return (long)(((unsigned long long)hi << 32) | (unsigned long long)lo); }
DEV void phase_peer_u(const Params& p, unsigned char* lds, int layer) {
    const int tid = tid_opaque(), lane = tid & 63, wv = tid >> 6, sub = lane >> 3, ch = lane & 7, fm = lane & 15, fg = lane >> 4;
    const int ng = gridDim.x >> 3, x = blockIdx.x & 7, wq = blockIdx.x >> 3;
    if (wq < ng) {
        const int gw = __builtin_amdgcn_readfirstlane(wq * 8 + wv), nw = ng * 8;
        unsigned char* ws = p.ws;
        const unsigned char* tab = ws + WS_PU + ((size_t)layer * 8 + x) * (16384 * 128);
        const int* pl_idx = (const int*)(ws + WS_S + 3 * U_BYTES);
        const unsigned char* xq = ws + WS_S + 2 * U_BYTES + (size_t)(fm & 1) * 1024 + 128 * x + 16 * fg;
        float* pd = (float*)(ws + WS_S + 4 * U_BYTES) + (size_t)x * NT * 128 + 16 * (fm >> 1) + 4 * fg;
        unsigned char* tile = lds + wv * 16384;
        const unsigned cE16 = 16u * (unsigned)(ch ^ (sub >> 1)), cO16 = cE16 ^ 64u;
        const unsigned aoff0 = (unsigned)fm * 128u + (unsigned)((fg ^ (fm >> 1)) << 4), aoff1 = (unsigned)fm * 128u + (unsigned)(((4 + fg) ^ (fm >> 1)) << 4);
        const int nrows = layer ? NL : NT;
        int eN[16];
#define PU_DMA(ee, q) { _Pragma("unroll") for (int j = 0; j < 4; ++j) { const int jj = (q) * 4 + j; \
        __builtin_amdgcn_global_load_lds((const unsigned*)(tab + (((unsigned)ee[jj] << 7) + ((jj & 1) ? cO16 : cE16))), (unsigned*)(tile + jj * 1024 + lane * 16), 16, 0, 0); } }
        const unsigned ta0 = (unsigned)(size_t)((LAS3 unsigned char*)tile) + aoff0, ta1 = (unsigned)(size_t)((LAS3 unsigned char*)tile) + aoff1;
#define PU_MMA(q) { u32x4 a0, a1, a2, a3; \
        asm volatile("ds_read_b128 %0, %4 offset:%6\n\tds_read_b128 %1, %5 offset:%6\n\tds_read_b128 %2, %4 offset:%7\n\tds_read_b128 %3, %5 offset:%7\n\ts_waitcnt lgkmcnt(0)" \
            : "=&v"(a0), "=&v"(a1), "=&v"(a2), "=&v"(a3) : "v"(ta0), "v"(ta1), "n"((q) * 4096), "n"((q) * 4096 + 2048) : "memory"); \
        f32x4 c4 = {0.f, 0.f, 0.f, 0.f}, c5 = {0.f, 0.f, 0.f, 0.f}; \
        c4 = __builtin_amdgcn_mfma_f32_16x16x32_fp8_fp8(pk64(a0.x, a0.y), pk64(bC0.x, bC0.y), c4, 0, 0, 0); \
        c5 = __builtin_amdgcn_mfma_f32_16x16x32_fp8_fp8(pk64(a2.x, a2.y), pk64(bC0.x, bC0.y), c5, 0, 0, 0); \
        c4 = __builtin_amdgcn_mfma_f32_16x16x32_fp8_fp8(pk64(a0.z, a0.w), pk64(bC0.z, bC0.w), c4, 0, 0, 0); \
        c5 = __builtin_amdgcn_mfma_f32_16x16x32_fp8_fp8(pk64(a2.z, a2.w), pk64(bC0.z, bC0.w), c5, 0, 0, 0); \
        c4 = __builtin_amdgcn_mfma_f32_16x16x32_fp8_fp8(pk64(a1.x, a1.y), pk64(bC1.x, bC1.y), c4, 0, 0, 0); \
        c5 = __builtin_amdgcn_mfma_f32_16x16x32_fp8_fp8(pk64(a3.x, a3.y), pk64(bC1.x, bC1.y), c5, 0, 0, 0); \
        c4 = __builtin_amdgcn_mfma_f32_16x16x32_fp8_fp8(pk64(a1.z, a1.w), pk64(bC1.z, bC1.w), c4, 0, 0, 0); \
        c5 = __builtin_amdgcn_mfma_f32_16x16x32_fp8_fp8(pk64(a3.z, a3.w), pk64(bC1.z, bC1.w), c5, 0, 0, 0); \
        acc[(q) * 2] = c4; acc[(q) * 2 + 1] = c5; }
        int R = gw;
#pragma unroll
        for (int i = 0; i < 16; ++i) eN[i] = 0;
        uint4 bC0 = make_uint4(0, 0, 0, 0), bC1 = bC0;
        if (R < nrows) {
            PS_IDX(eN, R);
            PU_DMA(eN, 0); PU_DMA(eN, 1); PU_DMA(eN, 2); PU_DMA(eN, 3);
            bC0 = *(const uint4*)(xq + (size_t)R * 2048); bC1 = *(const uint4*)(xq + (size_t)R * 2048 + 64);
            const int R1 = min(R + nw, nrows - 1);
            PS_IDX(eN, R1);
            asm volatile("s_waitcnt vmcnt(0)" : "+v"(bC0.x), "+v"(bC1.x), "+v"(eN[0]), "+v"(eN[4]), "+v"(eN[8]), "+v"(eN[12]) :: "memory");
        }
        for (; R < nrows; R += nw) {
            const int Rn = R + nw, R1 = min(Rn, nrows - 1), R2 = min(Rn + nw, nrows - 1);
            const bool more = Rn < nrows;
            u32x4 i0, i1, i2, i3, nb0, nb1;
            {
                const int* iptr = pl_idx + ((size_t)sub * NT + R2) * 16;
                const unsigned char* xptr = xq + (size_t)R1 * 2048;
                asm volatile("global_load_dwordx4 %0, %6, off\n\tglobal_load_dwordx4 %1, %6, off offset:16\n\tglobal_load_dwordx4 %2, %6, off offset:32\n\tglobal_load_dwordx4 %3, %6, off offset:48\n\t"
                             "global_load_dwordx4 %4, %7, off\n\tglobal_load_dwordx4 %5, %7, off offset:64"
                             : "=&v"(i0), "=&v"(i1), "=&v"(i2), "=&v"(i3), "=&v"(nb0), "=&v"(nb1) : "v"(iptr), "v"(xptr) : "memory");
            }
            f32x4 acc[8];
#define PU_STEP(q) { if (more) asm volatile("s_waitcnt vmcnt(19)" ::: "memory"); else asm volatile("s_waitcnt vmcnt(0)" ::: "memory"); \
            PU_MMA(q); if (more) { PU_DMA(eN, q); } }
            PU_STEP(0); PU_STEP(1); PU_STEP(2); PU_STEP(3);
            f32x4 s0[4], s1[2], s2;
#pragma unroll
            for (int i = 0; i < 4; ++i)
#pragma unroll
                for (int r = 0; r < 4; ++r) s0[i][r] = (fm & 2) ? acc[2 * i + 1][r] : acc[2 * i][r];
#pragma unroll
            for (int i = 0; i < 2; ++i)
#pragma unroll
                for (int r = 0; r < 4; ++r) s1[i][r] = (fm & 4) ? s0[2 * i + 1][r] : s0[2 * i][r];
#pragma unroll
            for (int r = 0; r < 4; ++r) { const float t = (fm & 8) ? s1[1][r] : s1[0][r]; s2[r] = t + dpp_quad<0xB1>(t); }
            if (!(fm & 1)) *(float4*)(pd + (size_t)R * 128) = make_float4(s2[0], s2[1], s2[2], s2[3]);
            if (more) asm volatile("s_waitcnt vmcnt(17)" : "+v"(i0), "+v"(i1), "+v"(i2), "+v"(i3), "+v"(nb0), "+v"(nb1) :: "memory");
            else asm volatile("s_waitcnt vmcnt(0)" : "+v"(i0), "+v"(i1), "+v"(i2), "+v"(i3), "+v"(nb0), "+v"(nb1) :: "memory");
            eN[0] = i0.x; eN[1] = i0.y; eN[2] = i0.z; eN[3] = i0.w; eN[4] = i1.x; eN[5] = i1.y; eN[6] = i1.z; eN[7] = i1.w;
            eN[8] = i2.x; eN[9] = i2.y; eN[10] = i2.z; eN[11] = i2.w; eN[12] = i3.x; eN[13] = i3.y; eN[14] = i3.z; eN[15] = i3.w;
            bC0 = make_uint4(nb0.x, nb0.y, nb0.z, nb0.w); bC1 = make_uint4(nb1.x, nb1.y, nb1.z, nb1.w);
        }
        asm volatile("s_waitcnt vmcnt(0)" ::: "memory");
    }
}
DEV void phase_peer_c(const Params& p, int layer) {
    const int tid = tid_opaque(), lane = tid & 63;
    const int gw = blockIdx.x * 8 + (tid >> 6), nw = gridDim.x * 8;
    unsigned char* ws = p.ws;
    const float* usc = (const float*)(ws + WS_PSC) + layer * 16384;
    const float* vsc = (const float*)(ws + WS_PSC) + 32768 + layer * 16384;
    const int* pl_idx = (const int*)(ws + WS_S + 3 * U_BYTES);
    const float* pl_gate = (const float*)(ws + WS_S + 3 * U_BYTES + (size_t)NT * 128 * 4);
    float* pd = (float*)(ws + WS_S + 4 * U_BYTES);
    const int nrows = layer ? NL : NT;
    const int head0 = 2 * (lane & 3), kk = lane >> 2;
    for (int R = gw; R < nrows; R += nw) {
        float d0 = 0.f, d1 = 0.f;
#pragma unroll
        for (int xx = 0; xx < 8; ++xx) { const float2 t = *(const float2*)(pd + ((size_t)xx * NT + R) * 128 + 2 * lane); d0 += t.x; d1 += t.y; }
        const size_t po = ((size_t)head0 * NT + R) * 16 + kk;
        const int e0 = pl_idx[po], e1 = pl_idx[po + (size_t)NT * 16];
        const float g0 = pl_gate[po], g1 = pl_gate[po + (size_t)NT * 16];
        d0 *= usc[e0] * 0.25f; d1 *= usc[e1] * 0.25f;
        const float c0 = g0 * vsc[e0] * 0.5f * d0 * (1.0f + erff(d0 * 0.70710678118f));
        const float c1 = g1 * vsc[e1] * 0.5f * d1 * (1.0f + erff(d1 * 0.70710678118f));
        pd[(size_t)R * 128 + 16 * head0 + kk] = c0;
        pd[(size_t)R * 128 + 16 * head0 + 16 + kk] = c1;
    }
}
DEV void phase_peer_v(const Params& p, int layer) {
    const int tid = tid_opaque(), lane = tid & 63, sub = lane >> 3, ch = lane & 7;
    const int ng = gridDim.x >> 3, x = blockIdx.x & 7, wq = blockIdx.x >> 3;
    if (wq < ng) {
        const int gw = __builtin_amdgcn_readfirstlane(wq * 8 + (tid >> 6)), nw = ng * 8;
        unsigned char* ws = p.ws;
        const __amdgpu_buffer_rsrc_t rs = __builtin_amdgcn_make_buffer_rsrc((void*)(ws + WS_PV + ((size_t)layer * 8 + x) * (16384 * 128)), 0, 16384 * 128, 0x00020000);
        const int* pl_idx = (const int*)(ws + WS_S + 3 * U_BYTES);
        const float* cb = (const float*)(ws + WS_S + 4 * U_BYTES) + 16 * sub;
        float* ctxr = (float*)(ws + WS_CTXR);
        const float* mods = (const float*)(ws + WS_MOD) + (size_t)layer * 9 * 6144 + 5 * 1024;
        const unsigned ch16 = 16u * (unsigned)ch;
        const int col = 128 * x + 16 * ch + 2 * sub;
        const int nrows = layer ? NL : NT;
        uint4 bufA[8], bufB[8];
        int eC[16], eN[16];
        float cC[16], cN[16];
#define PS_CF(cc, Rr) { _Pragma("unroll") for (int i = 0; i < 4; ++i) { const float4 t = *(const float4*)(cb + (size_t)(Rr) * 128 + 4 * i); \
        cc[4 * i] = t.x; cc[4 * i + 1] = t.y; cc[4 * i + 2] = t.z; cc[4 * i + 3] = t.w; } }
#define PV_FMA(accv, av) asm("v_fma_f32 %0, %1, %2, %0" : "+v"(accv) : "v"(cf), "v"(av))
#define PV_AXPY(buf, h) { _Pragma("unroll") for (int e = 0; e < 8; ++e) { \
        const float cf = cC[(h) * 8 + e]; const unsigned vw[4] = {buf[e].x, buf[e].y, buf[e].z, buf[e].w}; \
        _Pragma("unroll") for (int i = 0; i < 4; ++i) { \
            const f32x2 a = __builtin_amdgcn_cvt_pk_f32_fp8((int)vw[i], false), b2 = __builtin_amdgcn_cvt_pk_f32_fp8((int)vw[i], true); \
            PV_FMA(a16[4 * i], a.x); PV_FMA(a16[4 * i + 1], a.y); PV_FMA(a16[4 * i + 2], b2.x); PV_FMA(a16[4 * i + 3], b2.y); } } }
        int R = gw;
#pragma unroll
        for (int i = 0; i < 16; ++i) { eC[i] = 0; eN[i] = 0; cC[i] = 0.f; cN[i] = 0.f; }
        if (R < nrows) { PS_IDX(eC, R); PS_CF(cC, R); PS_LOAD(bufA, eC, 0); }
        for (; R < nrows; R += nw) {
            const int Rn = R + nw;
            if (Rn < nrows) { PS_IDX(eN, Rn); PS_CF(cN, Rn); }
            PS_LOAD(bufB, eC, 1);
            float* xrow = (R < NL ? p.out + (size_t)R * 1024 : ctxr + (size_t)(R - NL) * 1024) + col;
            const float2 xa = *(const float2*)xrow, ga = *(const float2*)(mods + (size_t)mod_batch(R) * 6144 + col);
            float a16[16];
#pragma unroll
            for (int i = 0; i < 16; ++i) a16[i] = 0.f;
            PV_AXPY(bufA, 0);
            if (Rn < nrows) { PS_LOAD(bufA, eN, 0); }
            PV_AXPY(bufB, 1);
            float s8[8], t4[4];
#pragma unroll
            for (int j = 0; j < 8; ++j) { const u32x2 r = __builtin_amdgcn_permlane32_swap(__float_as_uint(a16[j]), __float_as_uint(a16[8 + j]), false, false); s8[j] = __uint_as_float(r.x) + __uint_as_float(r.y); }
#pragma unroll
            for (int j = 0; j < 4; ++j) { const u32x2 r = __builtin_amdgcn_permlane16_swap(__float_as_uint(s8[j]), __float_as_uint(s8[4 + j]), false, false); t4[j] = __uint_as_float(r.x) + __uint_as_float(r.y); }
            const float wa0 = t4[0] + dpp_ror<8>(t4[0]), wa1 = t4[1] + dpp_ror<8>(t4[1]), wb0 = t4[2] + dpp_ror<8>(t4[2]), wb1 = t4[3] + dpp_ror<8>(t4[3]);
            const float w0 = (lane & 8) ? wb0 : wa0, w1 = (lane & 8) ? wb1 : wa1;
            *(float2*)xrow = make_float2(xa.x + ga.x * w0, xa.y + ga.y * w1);
#pragma unroll
            for (int i = 0; i < 16; ++i) { eC[i] = eN[i]; cC[i] = cN[i]; }
        }
    }
}
DEV void phase_final_norm(const Params& p) {
    const int tid = tid_opaque(), lane = tid & 63;
    const int gw = blockIdx.x * 8 + (tid >> 6), nw = gridDim.x * 8;
    const float* gn = p.in[34];
    for (int R = gw; R < NL; R += nw) {
        float* xr = p.out + (size_t)R * 1024;
        float4 v[4]; float ss = 0.f;
#pragma unroll
        for (int i = 0; i < 4; ++i) { v[i] = *(const float4*)(xr + i * 256 + lane * 4); ss += v[i].x * v[i].x + v[i].y * v[i].y + v[i].z * v[i].z + v[i].w * v[i].w; }
        ss = wave_allreduce(ss);
        const float rs = rsqrtf(ss * (1.0f / 1024.0f) + 1e-6f);
#pragma unroll
        for (int i = 0; i < 4; ++i) {
            const float4 gg = *(const float4*)(gn + i * 256 + lane * 4);
            *(float4*)(xr + i * 256 + lane * 4) = make_float4(v[i].x * rs * gg.x, v[i].y * rs * gg.y, v[i].z * rs * gg.z, v[i].w * rs * gg.w);
        }
    }
}

DEV void phase_gla_proj(const Params& p, unsigned char* lds) {
    unsigned char* ws = p.ws;
    const bf16_t* h = (const bf16_t*)(ws + WS_S + 0 * U_BYTES);
    const bf16_t* wint = (const bf16_t*)(ws + WS_WIN);
    {
        pg8::Gemm g{h, wint, NT, 3072, 1024};
        pg8::StaticOrder so; so.init(NT, 3072, gridDim.x, blockIdx.x);
        pg8::EpiBf16Tiles ep{(bf16_t*)(ws + WS_S + 1 * U_BYTES), 2048, 8, (bf16_t*)(ws + WS_S + 3 * U_BYTES), 1024};
        pg8::gemm_phase(( PG8_LAS unsigned char*)lds, g, so, ep, nullptr);
    }
    __syncthreads();
    for (int u = blockIdx.x; u < NT / 128; u += gridDim.x) {
        ALoadPlain al{h, 1024};
        EpiLr ep{(float*)(ws + WS_LR)};
        gemm_unit<128>(lds, al, wint + (size_t)3072 * 1024, 1024, u * 128, ep);
    }
}

DEV void conv_emit(const float (&acc)[8], int c, bf16_t* dst) {
    const float qs = (c < 512) ? 0.08838834764831845f : 1.0f;
    unsigned ow[4];
#pragma unroll
    for (int j = 0; j < 4; ++j) { const float a0 = acc[2 * j], a1 = acc[2 * j + 1]; ow[j] = pk_bf16(a0 * sigmoidf_(a0) * qs, a1 * sigmoidf_(a1) * qs); }
    *(uint4*)dst = make_uint4(ow[0], ow[1], ow[2], ow[3]);
}
DEV void conv_tap(float (&acc)[8], const uint4& v, const float (&w)[8]) {
    acc[0] += bf_lo(v.x) * w[0]; acc[1] += bf_hi(v.x) * w[1]; acc[2] += bf_lo(v.y) * w[2]; acc[3] += bf_hi(v.y) * w[3];
    acc[4] += bf_lo(v.z) * w[4]; acc[5] += bf_hi(v.z) * w[5]; acc[6] += bf_lo(v.w) * w[6]; acc[7] += bf_hi(v.w) * w[7];
}
DEV void phase_gla_conv(const Params& p) {
    const int tid = tid_opaque();
    unsigned char* ws = p.ws;
    const bf16_t* z = (const bf16_t*)(ws + WS_S + 1 * U_BYTES);
    bf16_t* o = (bf16_t*)(ws + WS_S + 4 * U_BYTES);
    const float* cw = p.in[25];
    const int x = tid >> 3, cl = (tid & 7) * 8;
    for (int task = blockIdx.x; task < 8 * 8 * 32; task += gridDim.x) {
        const int cb = task & 31, ys = (task >> 5) & 7, b = task >> 8;
        const int c = cb * 64 + cl;
        float w[9][8];
#pragma unroll
        for (int t = 0; t < 9; ++t) { const float4 w0 = *(const float4*)(cw + t * 2048 + c), w1 = *(const float4*)(cw + t * 2048 + c + 4); w[t][0] = w0.x; w[t][1] = w0.y; w[t][2] = w0.z; w[t][3] = w0.w; w[t][4] = w1.x; w[t][5] = w1.y; w[t][6] = w1.z; w[t][7] = w1.w; }
        const uint4 zero4 = make_uint4(0, 0, 0, 0);
        auto load_row = [&](int y, uint4 (&r)[3]) {
            if (y < 0 || y >= 128) { r[0] = zero4; r[1] = zero4; r[2] = zero4; return; }
            const bf16_t* row = z + ((size_t)b * 8192 + (size_t)y * 64 + x) * 2048 + c;
            r[1] = *(const uint4*)row;
            r[0] = (x > 0) ? *(const uint4*)(row - 2048) : zero4;
            r[2] = (x < 63) ? *(const uint4*)(row + 2048) : zero4;
        };
        uint4 r0[3], r1[3], r2[3], r3[3];
        const int y0 = ys * 16;
        load_row(y0 - 1, r0); load_row(y0, r1); load_row(y0 + 1, r2);
#pragma unroll 1
        for (int yy = 0; yy < 16; ++yy) {
            load_row(yy < 15 ? y0 + yy + 2 : -1, r3);
            float acc[8];
#pragma unroll
            for (int j = 0; j < 8; ++j) acc[j] = 0.f;
#pragma unroll
            for (int dx = 0; dx < 3; ++dx) { conv_tap(acc, r0[dx], w[dx]); conv_tap(acc, r1[dx], w[3 + dx]); conv_tap(acc, r2[dx], w[6 + dx]); }
            conv_emit(acc, c, o + ((size_t)b * 8192 + (size_t)(y0 + yy) * 64 + x) * 2048 + c);
#pragma unroll
            for (int dx = 0; dx < 3; ++dx) { r0[dx] = r1[dx]; r1[dx] = r2[dx]; r2[dx] = r3[dx]; }
        }
    }
    for (int task = blockIdx.x; task < (NC / 64) * 8; task += gridDim.x) {
        const int rb = task >> 3, cbk = task & 7;
        const int R = NL + rb * 64 + (tid >> 3);
        const int t = (R - NL) & 255;
#pragma unroll 1
        for (int i = 0; i < 4; ++i) {
            const int c = cbk * 256 + (tid & 7) * 8 + i * 64;
            float acc[8];
#pragma unroll
            for (int j = 0; j < 8; ++j) acc[j] = 0.f;
#pragma unroll
            for (int dx = -1; dx <= 1; ++dx) {
                if (t + dx >= 0 && t + dx < 256) {
                    const uint4 v = *(const uint4*)(z + (size_t)(R + dx) * 2048 + c);
                    const float* wp = cw + (3 + (dx + 1)) * 2048 + c;
                    const float4 w0 = *(const float4*)wp, w1 = *(const float4*)(wp + 4);
                    const float wv[8] = {w0.x, w0.y, w0.z, w0.w, w1.x, w1.y, w1.z, w1.w};
                    conv_tap(acc, v, wv);
                }
            }
            conv_emit(acc, c, o + (size_t)R * 2048 + c);
        }
    }
}

constexpr int GT_QE = 0, GT_KET = 16384, GT_A = 32768, GT_CONST = 40960, GT_STRIDE = 43008;
constexpr int GT_N0 = (int)((2 * U_BYTES) / GT_STRIDE);
constexpr size_t WS_TOTAL = 1073741824ull;
static_assert((size_t)(NB * 4 * 2 * 132 - GT_N0) * GT_STRIDE <= WS_TOTAL - WS_END, "tile records do not fit");
DEV size_t gla_tile_off(int b, int hd, int d, int cc) {
    const int idx = (((b * 4 + hd) * 2 + d) * 132) + cc;
    return idx < GT_N0 ? WS_S + (size_t)idx * GT_STRIDE : WS_END + (size_t)(idx - GT_N0) * GT_STRIDE;
}
DEV int gla_row0(int b, int cc) { return cc < 4 ? NL + b * 256 + cc * 64 : b * 8192 + (cc - 4) * 64; }
DEV void phase_gla_prep(const Params& p, unsigned char* lds) {
    const int tid = tid_opaque(), lane = tid & 63, wv = tid >> 6;
    const int fr = lane & 15, fq = lane >> 4;
    unsigned char* ws = p.ws;
    constexpr int QE = 0, KE = 16384, KET = 32768, BC = 49152  , GS = 82944  , LRL = 86528  , BCS = 132;
    const bf16_t* qkv = (const bf16_t*)(ws + WS_S + 4 * U_BYTES);
    const float* lrb = (const float*)(ws + WS_LR);
    unsigned char* gt = ws;
    float* bc = (float*)(lds + BC);
    float* gs = (float*)(lds + GS);
    const int li = tid >> 3, lc = tid & 7;
    const int d = blockIdx.x & 1, hd = (blockIdx.x >> 1) & 3;
    bf16x8 gkf;
    {
        unsigned w4[4] = {0u, 0u, 0u, 0u};
        if (fq < 2) {
#pragma unroll
            for (int e2 = 0; e2 < 4; ++e2) {
                const float g0 = p.in[26][(size_t)(d * 16 + 8 * fq + 2 * e2) * 512 + hd * 128 + wv * 16 + fr];
                const float g1 = p.in[26][(size_t)(d * 16 + 8 * fq + 2 * e2 + 1) * 512 + hd * 128 + wv * 16 + fr];
                w4[e2] = pk_bf16(g0, g1);
            }
        }
        gkf = as_bf16x8(make_uint4(w4[0], w4[1], w4[2], w4[3]));
    }
    const float4 gb4 = *(const float4*)(p.in[27] + d * 512 + hd * 128 + wv * 16 + 4 * fq);
    const int qstep = (int)(gridDim.x >> 3);
    uint4 nq0, nq1, nk0, nk1; float2 nl;
    auto fetch = [&](int q) {
        const size_t R = (size_t)(gla_row0(q / 132, q % 132) + li);
        const bf16_t* row = qkv + R * 2048;
        nq0 = *(const uint4*)(row + hd * 128 + lc * 8); nq1 = *(const uint4*)(row + hd * 128 + 64 + lc * 8);
        nk0 = *(const uint4*)(row + 512 + hd * 128 + lc * 8); nk1 = *(const uint4*)(row + 512 + hd * 128 + 64 + lc * 8);
        nl = *(const float2*)(lrb + R * 32 + d * 16 + lc * 2);
    };
    int q = (int)(blockIdx.x >> 3);
    if (q < NB * 132) fetch(q);
    for (; q < NB * 132; q += qstep) {
        const int cc = q % 132, b = q / 132;
        unsigned char* rec = gt + gla_tile_off(b, hd, d, cc);
        const uint4 rq0 = nq0, rq1 = nq1, rk0 = nk0, rk1 = nk1; const float2 rl = nl;
        if (q + qstep < NB * 132) fetch(q + qstep);
        *(unsigned*)(lds + LRL + li * 32 + lc * 4) = pk_bf16(rl.x, rl.y);
        __syncthreads();
        {
            const float gbv[4] = {gb4.x, gb4.y, gb4.z, gb4.w};
#pragma unroll
            for (int itl = 0; itl < 4; ++itl) {
                uint4 lr4 = *(const uint4*)(lds + LRL + (itl * 16 + fr) * 32 + (fq & 1) * 16);
                if (fq >= 2) lr4 = make_uint4(0, 0, 0, 0);
                f32x4 a = {0.f, 0.f, 0.f, 0.f};
                a = __builtin_amdgcn_mfma_f32_16x16x32_bf16(gkf, as_bf16x8(lr4), a, 0, 0, 0);
                float s[4], tot[4];
#pragma unroll
                for (int j = 0; j < 4; ++j) {
                    const float xx = a[j] + gbv[j];
                    const float la = (fminf(xx, 0.f) - __logf(1.0f + __expf(-fabsf(xx)))) * (1.0f / 16.0f);
                    float pf = la;
                    pf += dpp_shr0<1>(pf); pf += dpp_shr0<2>(pf); pf += dpp_shr0<4>(pf); pf += dpp_shr0<8>(pf);
                    tot[j] = __shfl(pf, (lane & 48) | 15);
                    s[j] = d ? (tot[j] - pf + la) : pf;
                }
                *(float4*)(bc + (itl * 16 + fr) * BCS + wv * 16 + 4 * fq) = make_float4(s[0], s[1], s[2], s[3]);
                if (fr == 15) *(float4*)(gs + itl * 128 + wv * 16 + 4 * fq) = make_float4(tot[0], tot[1], tot[2], tot[3]);
            }
        }
        __syncthreads();
        if (tid < 128) {
            const float g0 = gs[tid], g1 = gs[128 + tid], g2 = gs[256 + tid], g3 = gs[384 + tid];
            const float refc = d ? (bc[31 * BCS + tid] + g2 + g3) : (bc[32 * BCS + tid] + g0 + g1), lastc = g0 + g1 + g2 + g3;
            const float dl = __expf(lastc), er = __expf(refc), el = __expf(lastc - refc);
            gs[512 + tid] = refc;
            float* cst = (float*)(rec + GT_CONST);
            cst[tid] = er; cst[128 + tid] = el; cst[256 + tid] = dl;
        }
        __syncthreads();
        {
            const int grp = li >> 4;
            const uint4 rqs[2] = {rq0, rq1}, rks[2] = {rk0, rk1};
#pragma unroll
            for (int hseg = 0; hseg < 2; ++hseg) {
                const int k0 = hseg * 64 + lc * 8;
                float bcv[8], refv[8];
#pragma unroll
                for (int j4 = 0; j4 < 2; ++j4) {
                    const float4 g0 = *(const float4*)(gs + k0 + j4 * 4), g1 = *(const float4*)(gs + 128 + k0 + j4 * 4);
                    const float4 g2 = *(const float4*)(gs + 256 + k0 + j4 * 4), g3 = *(const float4*)(gs + 384 + k0 + j4 * 4);
                    const float4 bi = *(const float4*)(bc + li * BCS + k0 + j4 * 4), rf = *(const float4*)(gs + 512 + k0 + j4 * 4);
                    const float g0a[4] = {g0.x, g0.y, g0.z, g0.w}, g1a[4] = {g1.x, g1.y, g1.z, g1.w}, g2a[4] = {g2.x, g2.y, g2.z, g2.w}, g3a[4] = {g3.x, g3.y, g3.z, g3.w};
                    const float bia[4] = {bi.x, bi.y, bi.z, bi.w}, rfa[4] = {rf.x, rf.y, rf.z, rf.w};
#pragma unroll
                    for (int j = 0; j < 4; ++j) {
                        const float pre = d ? ((grp < 1 ? g1a[j] : 0.f) + (grp < 2 ? g2a[j] : 0.f) + (grp < 3 ? g3a[j] : 0.f))
                                            : ((grp > 0 ? g0a[j] : 0.f) + (grp > 1 ? g1a[j] : 0.f) + (grp > 2 ? g2a[j] : 0.f));
                        bcv[j4 * 4 + j] = bia[j] + pre;
                        refv[j4 * 4 + j] = rfa[j];
                    }
                }
                const unsigned qw[4] = {rqs[hseg].x, rqs[hseg].y, rqs[hseg].z, rqs[hseg].w}, kw[4] = {rks[hseg].x, rks[hseg].y, rks[hseg].z, rks[hseg].w};
                unsigned oqe[4], oke[4];
#pragma unroll
                for (int j2 = 0; j2 < 4; ++j2) {
                    const float q0 = bf_lo(qw[j2]), q1 = bf_hi(qw[j2]), kk0 = bf_lo(kw[j2]), kk1 = bf_hi(kw[j2]);
                    const float e0 = __expf(bcv[2 * j2] - refv[2 * j2]), e1 = __expf(bcv[2 * j2 + 1] - refv[2 * j2 + 1]);
                    const float r0 = __builtin_amdgcn_rcpf(e0), r1 = __builtin_amdgcn_rcpf(e1);
                    oqe[j2] = pk_bf16(q0 * e0, q1 * e1);
                    oke[j2] = pk_bf16(kk0 * r0, kk1 * r1);
                    const int kc0 = k0 + 2 * j2;
                    *(bf16_t*)(lds + KET + tile_off2(kc0, li >> 3) + (li & 7) * 2) = (bf16_t)(oke[j2] & 0xffffu);
                    *(bf16_t*)(lds + KET + tile_off2(kc0 + 1, li >> 3) + (li & 7) * 2) = (bf16_t)(oke[j2] >> 16);
                }
                const int chq = hseg * 8 + lc;
                const int so = li * 256 + ((chq ^ (li & 15)) << 4);
                *(uint4*)(lds + QE + so) = make_uint4(oqe[0], oqe[1], oqe[2], oqe[3]);
                *(uint4*)(lds + KE + so) = make_uint4(oke[0], oke[1], oke[2], oke[3]);
                *(uint4*)(rec + GT_QE + so) = make_uint4(oqe[0], oqe[1], oqe[2], oqe[3]);
            }
        }
        __syncthreads();
        {
            const int it = wv & 3, pr2 = wv >> 2;
#pragma unroll
            for (int jj = 0; jj < 2; ++jj) {
                const int jt = pr2 * 2 + jj;
                f32x4 a = {0.f, 0.f, 0.f, 0.f};
                if (d ? (jt >= it) : (jt <= it)) {
#pragma unroll
                    for (int ks = 0; ks < 4; ++ks) {
                        const int ch = ks * 4 + fq;
                        const int rj = jt * 16 + fr, ri = it * 16 + fr;
                        const bf16x8 fa = *(const bf16x8*)(lds + KE + rj * 256 + ((ch ^ (rj & 15)) << 4));
                        const bf16x8 fb = *(const bf16x8*)(lds + QE + ri * 256 + ((ch ^ (ri & 15)) << 4));
                        a = __builtin_amdgcn_mfma_f32_16x16x32_bf16(fa, fb, a, 0, 0, 0);
                    }
                }
                const int i = it * 16 + fr, j = jt * 16 + 4 * fq;
                float av[4];
#pragma unroll
                for (int e = 0; e < 4; ++e) av[e] = (d ? (j + e >= i) : (j + e <= i)) ? a[e] : 0.f;
                *(uint2*)(rec + GT_A + i * 128 + (((j >> 3) ^ (i & 7)) << 4) + (j & 7) * 2) = make_uint2(pk_bf16(av[0], av[1]), pk_bf16(av[2], av[3]));
            }
#pragma unroll
            for (int i = 0; i < 2; ++i) *(uint4*)(rec + GT_KET + i * 8192 + tid * 16) = *(const uint4*)(lds + KET + i * 8192 + tid * 16);
        }
        __syncthreads();
    }
}

DEV void phase_gla_scan(const Params& p, unsigned char* lds) {
    const int tid = tid_opaque(), lane = tid & 63, wv = tid >> 6;
    const int fr = lane & 15, fq = lane >> 4;
    unsigned char* ws = p.ws;
    constexpr int QE = 0  , KET = 32768  , AL = 65536  , VT = 81920, ST = 90112  ;
    const bf16_t* qkv = (const bf16_t*)(ws + WS_S + 4 * U_BYTES);
    const unsigned char* gt = ws;
    for (int unit = blockIdx.x; unit < 256; unit += gridDim.x) {
        const int vs = unit & 3, d = (unit >> 2) & 1, hd = (unit >> 3) & 3, b = unit >> 5;
        bf16_t* odst = d ? (bf16_t*)(ws + WS_S + 2 * U_BYTES) : (bf16_t*)(ws + WS_S + 4 * U_BYTES);
        const int old_ = d ? 1024 : 2048;
        const int li = tid >> 3, lc = tid & 7;
        auto ccof = [&](int c) -> int { return d ? (c < 4 ? 3 - c : 135 - c) : c; };
        auto dma = [&](int cc, int buf) {
            const unsigned char* rec = gt + gla_tile_off(b, hd, d, cc);
#pragma unroll
            for (int i = 0; i < 2; ++i) {
                __builtin_amdgcn_global_load_lds((const unsigned*)(rec + GT_QE + i * 8192 + tid * 16), (unsigned*)(lds + QE + buf * 16384 + i * 8192 + tid * 16), 16, 0, 0);
                __builtin_amdgcn_global_load_lds((const unsigned*)(rec + GT_KET + i * 8192 + tid * 16), (unsigned*)(lds + KET + buf * 16384 + i * 8192 + tid * 16), 16, 0, 0);
            }
            __builtin_amdgcn_global_load_lds((const unsigned*)(rec + GT_A + tid * 16), (unsigned*)(lds + AL + buf * 8192 + tid * 16), 16, 0, 0);
        };
        uint4 nv; float4 n_dl, n_el, n_er;
        auto loads = [&](int c) {
            const int cc = ccof(c);
            nv = *(const uint4*)(qkv + (size_t)(gla_row0(b, cc) + li) * 2048 + 1024 + hd * 256 + vs * 64 + lc * 8);
            const float* cst = (const float*)(gt + gla_tile_off(b, hd, d, cc) + GT_CONST);
            n_el = *(const float4*)(cst + 128 + wv * 16 + 4 * fq); n_dl = *(const float4*)(cst + 256 + wv * 16 + 4 * fq);
            if (c + 1 < 132) n_er = *(const float4*)((const float*)(gt + gla_tile_off(b, hd, d, ccof(c + 1)) + GT_CONST) + wv * 16 + 4 * fq);
            else n_er = make_float4(0.f, 0.f, 0.f, 0.f);
        };
        f32x4 accS[4];
#pragma unroll
        for (int i = 0; i < 4; ++i) accS[i] = (f32x4){0.f, 0.f, 0.f, 0.f};
        for (int i = tid; i < 32768 / 16; i += NTHREADS) *(uint4*)(lds + ST + i * 16) = make_uint4(0, 0, 0, 0);
        dma(ccof(0), 0);
        loads(0);
        for (int c = 0; c < 132; ++c) {
            const int buf = c & 1, cc = ccof(c);
            const uint4 rv = nv; const float4 dl4 = n_dl, el4 = n_el, er4 = n_er;
            asm volatile("s_waitcnt vmcnt(0)" ::: "memory");
            {
                const unsigned vw[4] = {rv.x, rv.y, rv.z, rv.w};
#pragma unroll
                for (int j2 = 0; j2 < 4; ++j2) {
                    const int vc0 = lc * 8 + 2 * j2;
                    *(bf16_t*)(lds + VT + tile_off2(vc0, li >> 3) + (li & 7) * 2) = (bf16_t)(vw[j2] & 0xffffu);
                    *(bf16_t*)(lds + VT + tile_off2(vc0 + 1, li >> 3) + (li & 7) * 2) = (bf16_t)(vw[j2] >> 16);
                }
            }
            asm volatile("s_waitcnt lgkmcnt(0)" ::: "memory"); __builtin_amdgcn_s_barrier(); asm volatile("" ::: "memory");
            if (c + 1 < 132) { dma(ccof(c + 1), buf ^ 1); loads(c + 1); }
            const int it = wv & 3, pr2 = wv >> 2;
            const int r0 = gla_row0(b, cc);
#pragma unroll
            for (int vv = 0; vv < 2; ++vv) {
                const int vt = pr2 * 2 + vv;
                f32x4 a = {0.f, 0.f, 0.f, 0.f};
#pragma unroll
                for (int ks = 0; ks < 4; ++ks) {
                    const int ch = ks * 4 + fq;
                    const int rvv = vt * 16 + fr, ri = it * 16 + fr;
                    const bf16x8 fa = *(const bf16x8*)(lds + ST + buf * 16384 + rvv * 256 + ((ch ^ (rvv & 15)) << 4));
                    const bf16x8 fb = *(const bf16x8*)(lds + QE + buf * 16384 + ri * 256 + ((ch ^ (ri & 15)) << 4));
                    a = __builtin_amdgcn_mfma_f32_16x16x32_bf16(fa, fb, a, 0, 0, 0);
                }
#pragma unroll
                for (int ks = 0; ks < 2; ++ks) {
                    const int ch = ks * 4 + fq;
                    const int rvv = vt * 16 + fr, ri = it * 16 + fr;
                    const bf16x8 fa = *(const bf16x8*)(lds + VT + tile_off2(rvv, ch));
                    const bf16x8 fb = *(const bf16x8*)(lds + AL + buf * 8192 + ri * 128 + ((ch ^ (ri & 7)) << 4));
                    a = __builtin_amdgcn_mfma_f32_16x16x32_bf16(fa, fb, a, 0, 0, 0);
                }
                const int i = it * 16 + fr, vcol = vt * 16 + 4 * fq;
                *(uint2*)(odst + (size_t)(r0 + i) * old_ + hd * 256 + vs * 64 + vcol) = make_uint2(pk_bf16(a[0], a[1]), pk_bf16(a[2], a[3]));
            }
            {
                const int kt = wv;
                bf16x8 fa[2];
#pragma unroll
                for (int ks = 0; ks < 2; ++ks) fa[ks] = *(const bf16x8*)(lds + KET + buf * 16384 + tile_off2(kt * 16 + fr, ks * 4 + fq));
#pragma unroll
                for (int vt = 0; vt < 4; ++vt) {
                    f32x4 t = {0.f, 0.f, 0.f, 0.f};
#pragma unroll
                    for (int ks = 0; ks < 2; ++ks) t = __builtin_amdgcn_mfma_f32_16x16x32_bf16(fa[ks], *(const bf16x8*)(lds + VT + tile_off2(vt * 16 + fr, ks * 4 + fq)), t, 0, 0, 0);
                    f32x4 a = accS[vt];
                    a[0] = a[0] * dl4.x + t[0] * el4.x; a[1] = a[1] * dl4.y + t[1] * el4.y; a[2] = a[2] * dl4.z + t[2] * el4.z; a[3] = a[3] * dl4.w + t[3] * el4.w;
                    accS[vt] = a;
                    const int vcol = vt * 16 + fr, kcol = kt * 16 + 4 * fq;
                    *(uint2*)(lds + ST + (buf ^ 1) * 16384 + vcol * 256 + (((kcol >> 3) ^ (vcol & 15)) << 4) + (kcol & 7) * 2) =
                        make_uint2(pk_bf16(a[0] * er4.x, a[1] * er4.y), pk_bf16(a[2] * er4.z, a[3] * er4.w));
                }
            }
            asm volatile("s_waitcnt lgkmcnt(0)" ::: "memory"); __builtin_amdgcn_s_barrier(); asm volatile("" ::: "memory");
        }
        asm volatile("s_waitcnt vmcnt(0)" ::: "memory");
        __syncthreads();
    }
}

DEV void phase_gla_readout(const Params& p) {
    const int tid = tid_opaque(), lane = tid & 63;
    const int gw = blockIdx.x * 8 + (tid >> 6), nw = gridDim.x * 8;
    unsigned char* ws = p.ws;
    const bf16_t* o0 = (const bf16_t*)(ws + WS_S + 4 * U_BYTES);
    const bf16_t* o1 = (const bf16_t*)(ws + WS_S + 2 * U_BYTES);
    const bf16_t* gb = (const bf16_t*)(ws + WS_S + 3 * U_BYTES);
    bf16_t* ao = (bf16_t*)(ws + WS_S + 0 * U_BYTES);
    const float4 hn = *(const float4*)(p.in[28] + lane * 4);
    for (int item = gw; item < NL * 4; item += nw) {
        const size_t off = (size_t)(item >> 2) * 1024 + (item & 3) * 256 + lane * 4;
        const uint2 a = *(const uint2*)(o0 + off + (size_t)(item >> 2) * 1024), b2 = *(const uint2*)(o1 + off), g2 = *(const uint2*)(gb + off);
        const float v0 = bf_lo(a.x) + bf_lo(b2.x), v1 = bf_hi(a.x) + bf_hi(b2.x), v2 = bf_lo(a.y) + bf_lo(b2.y), v3 = bf_hi(a.y) + bf_hi(b2.y);
        float ss = v0 * v0 + v1 * v1 + v2 * v2 + v3 * v3;
        ss = wave_allreduce(ss);
        const float rs = rsqrtf(ss * (1.0f / 256.0f) + 1e-6f);
        const float g0 = bf_lo(g2.x), g1 = bf_hi(g2.x), g2f = bf_lo(g2.y), g3 = bf_hi(g2.y);
        const float r0 = v0 * rs * hn.x * (g0 * sigmoidf_(g0)), r1 = v1 * rs * hn.y * (g1 * sigmoidf_(g1));
        const float r2 = v2 * rs * hn.z * (g2f * sigmoidf_(g2f)), r3 = v3 * rs * hn.w * (g3 * sigmoidf_(g3));
        *(uint2*)(ao + off) = make_uint2(pk_bf16(r0, r1), pk_bf16(r2, r3));
    }
}


#define XB_TMO      128
#define XB_XCNT(j)  (256  + 64 * (j))
#define XB_XSUB(j)  (1280 + 64 * (j))
#define XB_XGEN(j)  (2304 + 64 * (j))
#define XB_TOP      3328
#define XB_TOPGEN   3392
#define XB_SPIN_CAP (1u << 22)
DEV unsigned xb_ld(unsigned* p) { return __hip_atomic_load(p, __ATOMIC_RELAXED, __HIP_MEMORY_SCOPE_AGENT); }
DEV unsigned xb_add(unsigned* p, unsigned v) { return __hip_atomic_fetch_add(p, v, __ATOMIC_RELAXED, __HIP_MEMORY_SCOPE_AGENT); }
DEV unsigned xb_xcc_id() { return (unsigned)__builtin_amdgcn_s_getreg((3 << 11) | 20) & 0xFu; }
#define XB_SPIN(cond, bar) do { unsigned _sp = 0; while (cond) { __builtin_amdgcn_s_sleep(1); \
    if ((++_sp & 255u) == 0u) { if (xb_ld(&(bar)[XB_TMO])) break; if (_sp > XB_SPIN_CAP) { atomicAdd(&(bar)[XB_TMO], 1u); break; } } } } while (0)
DEV void xcd_barrier_complete(unsigned* bar, unsigned x, unsigned& nloc, unsigned& nx) {
    const unsigned G = gridDim.x;
    unsigned sum, cnt, mine, sp = 0u;
    for (;;) {
        sum = 0u; cnt = 0u; mine = 0u;
#pragma unroll
        for (unsigned j = 0; j < 16; ++j) { const unsigned c = xb_ld(&bar[XB_XCNT(j)]); sum += c; cnt += (c > 0u) ? 1u : 0u; mine = (j == x) ? c : mine; }
        if (sum == G) break;
        __builtin_amdgcn_s_sleep(1);
        if ((++sp & 255u) == 0u) { if (xb_ld(&bar[XB_TMO])) break; if (sp > XB_SPIN_CAP) { atomicAdd(&bar[XB_TMO], 1u); break; } }
    }
    nloc = mine > 0u ? mine : 1u; nx = cnt > 0u ? cnt : 1u;
}
DEV void xcd_barrier(unsigned* bar, volatile LAS3 unsigned* st) {
    asm volatile("s_waitcnt vmcnt(0)" ::: "memory");
    __syncthreads();
    if (tid_opaque() == 0) {
        const unsigned x = xb_xcc_id();
        __builtin_amdgcn_s_waitcnt(0);
        unsigned nloc = st[0], nx = st[1];
        if (nloc == 0u) { xcd_barrier_complete(bar, x, nloc, nx); st[0] = nloc; st[1] = nx; }
        const unsigned old = xb_add(&bar[XB_XSUB(x)], 1u);
        const unsigned gen = old / nloc;
        if (old + 1u == (gen + 1u) * nloc) {
            __builtin_amdgcn_fence(__ATOMIC_RELEASE, "agent");
            asm volatile("s_waitcnt vmcnt(0)" ::: "memory");
            const unsigned og = xb_add(&bar[XB_TOP], 1u);
            const unsigned tg = og / nx;
            if (og + 1u == (tg + 1u) * nx) xb_add(&bar[XB_TOPGEN], 1u);
            else XB_SPIN(xb_ld(&bar[XB_TOPGEN]) == tg, bar);
            __builtin_amdgcn_fence(__ATOMIC_ACQUIRE, "agent");
            xb_add(&bar[XB_XGEN(x)], 1u);
            asm volatile("s_waitcnt vmcnt(0)" ::: "memory");
        } else {
            XB_SPIN(xb_ld(&bar[XB_XGEN(x)]) == gen, bar);
            __builtin_amdgcn_fence(__ATOMIC_ACQUIRE, "agent");
            asm volatile("s_waitcnt vmcnt(0)" ::: "memory");
        }
    }
    __syncthreads();
}
#define SYNC() do { asm volatile("s_waitcnt vmcnt(0)" ::: "memory"); grid.sync(); \
    if (tid_opaque() == 0) { __builtin_amdgcn_fence(__ATOMIC_ACQUIRE, "agent"); asm volatile("s_waitcnt vmcnt(0)" ::: "memory"); } \
    __syncthreads(); } while (0)
__global__ void __launch_bounds__(NTHREADS) mega_fwd(Params p) {
    unsigned char* const lds = g_lds;
    cg::grid_group grid = cg::this_grid();
#define XBAR ((unsigned*)(p.ws + WS_BAR))
#define XST ((volatile LAS3 unsigned*)(lds + LDS_BYTES - 16))
    if ((threadIdx.x & 63) == 0) g_lds[LDS_WTAB + hw_wave_slot()] = (unsigned char)(threadIdx.x >> 6);
    if (threadIdx.x == 0) { XST[0] = 0u; XST[1] = 0u; (void)xb_add(&XBAR[XB_XCNT(xb_xcc_id())], 1u); }
    __syncthreads();
#define S0 ((bf16_t*)(p.ws + WS_S + 0 * U_BYTES))
#define SLOT(i) ((bf16_t*)(p.ws + WS_S + (size_t)(i) * U_BYTES))
#define S1 ((bf16_t*)(p.ws + WS_S + 1 * U_BYTES))
#define CTXR ((const float*)(p.ws + WS_CTXR))
    phase0(p, lds); SYNC();
#undef SYNC
#define SYNC() xcd_barrier(XBAR, XST)
    phase_normmix(p, S0, SLOT(5), SLOT(1), SLOT(2)); SYNC();
    phase_rw_proj1(p, lds, 0, SLOT(5), SLOT(3)); SYNC();
    phase_rw_proj1(p, lds, 1, SLOT(1), SLOT(5)); SYNC();
    phase_rw_proj1(p, lds, 2, SLOT(2), SLOT(1)); phase_rw_lora(p, lds); SYNC();
    REPEAT(3, phase_rw_scan(p, lds));
    phase_rw_scan(p, lds); SYNC();
    REPEAT(4, phase_rw_readout(p));
    phase_rw_readout(p); SYNC();
    REPEAT(5, phase_wo(p, lds, 0));
    phase_wo(p, lds, 0); SYNC();
    REPEAT(6, phase_normmod(p, 0, 1, p.out, CTXR, NT, S1, (unsigned char*)SLOT(2)));
    phase_normmod(p, 0, 1, p.out, CTXR, NT, S1, (unsigned char*)SLOT(2)); SYNC();
    REPEAT(7, phase_peer_select(p, lds, 0));
    phase_peer_select(p, lds, 0); SYNC();
    phase_peer_u(p, lds, 0); SYNC();
    phase_peer_c(p, 0); SYNC();
    phase_peer_v(p, 0); SYNC();
    phase_normmod(p, 1, 0, p.out, CTXR, NT, S0, nullptr); SYNC();
    REPEAT(9, phase_gla_proj(p, lds));
    phase_gla_proj(p, lds); SYNC();
    REPEAT(10, phase_gla_conv(p));
    phase_gla_conv(p); SYNC();
    REPEAT(18, phase_gla_prep(p, lds));
    phase_gla_prep(p, lds); SYNC();
    REPEAT(11, phase_gla_scan(p, lds));
    phase_gla_scan(p, lds); SYNC();
    REPEAT(12, phase_gla_readout(p));
    phase_gla_readout(p); SYNC();
    phase_wo(p, lds, 1); SYNC();
    REPEAT(14, phase_normmod(p, 1, 1, p.out, CTXR, NL, S0, (unsigned char*)SLOT(2)));
    phase_normmod(p, 1, 1, p.out, CTXR, NL, S0, (unsigned char*)SLOT(2)); SYNC();
    REPEAT(15, phase_peer_select(p, lds, 1));
    phase_peer_select(p, lds, 1); SYNC();
    phase_peer_u(p, lds, 1); SYNC();
    phase_peer_c(p, 1); SYNC();
    phase_peer_v(p, 1); SYNC();
    phase_final_norm(p);
}

extern "C" void kernel_launch(void* const* d_in, const int* in_sizes, int n_in, void* d_out, int out_size, void* d_ws, size_t ws_size, hipStream_t stream) {
    static int grid_blocks = 0;
    if (grid_blocks == 0) {
        if (n_in != 35 || ws_size < WS_TOTAL) { fprintf(stderr, "kernel_launch: unexpected n_in %d or ws_size %zu (< %zu)\n", n_in, ws_size, (size_t)WS_END); grid_blocks = -1; return; }
        int dev = 0, cus = 0, per_cu = 0;
        if (hipGetDevice(&dev) != hipSuccess || hipDeviceGetAttribute(&cus, hipDeviceAttributeMultiprocessorCount, dev) != hipSuccess) { fprintf(stderr, "kernel_launch: device query failed\n"); grid_blocks = -1; return; }
        if (hipFuncSetAttribute((const void*)mega_fwd, hipFuncAttributeMaxDynamicSharedMemorySize, LDS_BYTES) != hipSuccess) { fprintf(stderr, "kernel_launch: hipFuncSetAttribute failed\n"); grid_blocks = -1; return; }
        if (hipOccupancyMaxActiveBlocksPerMultiprocessor(&per_cu, (const void*)mega_fwd, NTHREADS, LDS_BYTES) != hipSuccess || per_cu < 1) { fprintf(stderr, "kernel_launch: occupancy query says %d blocks per CU\n", per_cu); grid_blocks = -1; return; }
        grid_blocks = cus;
    }
    if (grid_blocks < 0) return;
    Params p{};
    for (int i = 0; i < 35; ++i) p.in[i] = (const float*)d_in[i];
    p.out = (float*)d_out;
    p.ws = (unsigned char*)d_ws;
    if (hipMemsetAsync((char*)d_ws + WS_BAR, 0, 16384, stream) != hipSuccess) { fprintf(stderr, "kernel_launch: hipMemsetAsync failed\n"); return; }
    void* args[] = {&p};
    hipError_t e = hipLaunchCooperativeKernel((const void*)mega_fwd, dim3(grid_blocks), dim3(NTHREADS), args, LDS_BYTES, stream);
    if (e != hipSuccess) fprintf(stderr, "kernel_launch: cooperative launch failed: %s (grid %d)\n", hipGetErrorString(e), grid_blocks);
}
```

```cpp
#include <hip/hip_runtime.h>
#include <hip/hip_cooperative_groups.h>
#include <cstdio>
#include <cstdint>
namespace cg = cooperative_groups;

#define DEV __device__ __forceinline__
#ifndef REP
#define REP 0
#endif
#define GREPS(n) ((REP == (n)) ? 2 : 1)
#define REPEAT(n, stmt) do { if (REP == (n)) { stmt; SYNC(); } } while (0)

typedef unsigned short bf16_t;
typedef short bf16x8 __attribute__((ext_vector_type(8)));
typedef float f32x4 __attribute__((ext_vector_type(4)));
typedef __bf16 bf16x2v __attribute__((ext_vector_type(2)));

constexpr int D = 1024;
constexpr int NB = 8, SEQ = 8192, CTXL = 256;
constexpr int NL = NB * SEQ, NC = NB * CTXL, NT = NL + NC;
constexpr int NTHREADS = 512;
constexpr int LDS_BYTES = 160 * 1024;

constexpr size_t U_BYTES = (size_t)NT * 1024 * 2;
constexpr size_t WS_BAR = 0;
constexpr size_t WS_MOD = 16384;
constexpr size_t WS_CTXR = WS_MOD + (size_t)2 * 9 * 6144 * 4;
constexpr size_t WS_LR = WS_CTXR + (size_t)NC * 1024 * 4;
constexpr size_t WS_BONUS = WS_LR + (size_t)NT * 32 * 4;
constexpr size_t WS_WPROJ = WS_BONUS + (size_t)2 * NT * 16 * 4;
constexpr size_t WS_W2T = WS_WPROJ + (size_t)3456 * 1024 * 2;
constexpr size_t WS_A2T = WS_W2T + (size_t)2 * 1024 * 64 * 2;
constexpr size_t WS_G2T = WS_A2T + (size_t)2 * 1024 * 64 * 2;
constexpr size_t WS_WO0 = WS_G2T + (size_t)1024 * 128 * 2;
constexpr size_t WS_WO1 = WS_WO0 + (size_t)1024 * 1024 * 2;
constexpr size_t WS_WQ = WS_WO1 + (size_t)1024 * 1024 * 2;
constexpr size_t WS_KEYS = WS_WQ + (size_t)2 * 2048 * 1024 * 2;
constexpr size_t WS_WIN = WS_KEYS + (size_t)2 * 8 * 2 * 128 * 128 * 2;
constexpr size_t WS_PU = WS_WIN + (size_t)3200 * 1024 * 2;
constexpr size_t WS_PV = WS_PU + (size_t)2 * 16384 * 1024;
constexpr size_t WS_PSC = WS_PV + (size_t)2 * 16384 * 1024;
constexpr size_t WS_S = WS_PSC + (size_t)2 * 2 * 16384 * 4;
constexpr size_t WS_END = WS_S + 6 * U_BYTES;
static_assert(WS_END <= 1073741824ull, "workspace too large");
static_assert((WS_CTXR % 256) == 0 && (WS_WPROJ % 256) == 0 && (WS_S % 256) == 0, "alignment");

struct Params {
    const float* in[35];
    float* out;
    unsigned char* ws;
    int pad0, pad1;
};

DEV float bf_lo(unsigned u) { return __uint_as_float(u << 16); }
DEV float bf_hi(unsigned u) { return __uint_as_float(u & 0xffff0000u); }
typedef float f32x2v __attribute__((ext_vector_type(2)));
typedef unsigned int u32x2v __attribute__((ext_vector_type(2)));
typedef short s16x4v __attribute__((ext_vector_type(4)));
DEV unsigned pk_bf16(float lo, float hi) { const f32x2v f = {lo, hi}; union { bf16x2v v; unsigned u; } x; x.v = __builtin_convertvector(f, bf16x2v); return x.u; }
template <int N> DEV float dpp_ror(float x) { return __int_as_float(__builtin_amdgcn_update_dpp(0, __float_as_int(x), 0x120 + N, 0xF, 0xF, false)); }
DEV float row16_allreduce(float x) { x += dpp_ror<8>(x); x += dpp_ror<4>(x); x += dpp_ror<2>(x); x += dpp_ror<1>(x); return x; }
DEV float wave_allreduce(float x) { x = row16_allreduce(x); x += __shfl_xor(x, 16); x += __shfl_xor(x, 32); return x; }
DEV float sigmoidf_(float x) { return 1.0f / (1.0f + __expf(-x)); }
DEV float softplusf_(float z) { return fmaxf(z, 0.f) + __logf(1.0f + __expf(-fabsf(z))); }
DEV unsigned mono_u32(float f) { unsigned u = __float_as_uint(f); return u ^ ((u >> 31) ? 0xFFFFFFFFu : 0x80000000u); }
DEV float unmono_u32(unsigned k) { unsigned u = (k & 0x80000000u) ? (k ^ 0x80000000u) : ~k; return __uint_as_float(u); }
DEV bf16x8 as_bf16x8(uint4 v) { union { uint4 u; bf16x8 b; } x; x.u = v; return x.b; }
#define LAS3 __attribute__((address_space(3)))
extern __shared__ __attribute__((aligned(16))) unsigned char g_lds[];
constexpr int LDS_WTAB = LDS_BYTES - 128;
DEV unsigned hw_wave_slot() { return (unsigned)__builtin_amdgcn_s_getreg((5 << 11) | 4) & 63u; }
DEV int tid_opaque() {
    const int wv = (int)*(const volatile unsigned char*)(g_lds + LDS_WTAB + hw_wave_slot());
    int t = (wv << 6) | (int)__builtin_amdgcn_mbcnt_hi(~0u, __builtin_amdgcn_mbcnt_lo(~0u, 0u));
    asm volatile("" : "+v"(t));
    return t;
}
DEV int mod_batch(int R) { return R < NL ? (R >> 13) : 8; }

template <int BN, class AL, class EP>
DEV void gemm_unit(unsigned char* lds, const AL& al, const bf16_t* Bt, int K, int m0, const EP& ep) {
    constexpr int NI = BN / 64;
    constexpr int A_BYTES = 128 * 128;
    constexpr int B_BYTES = BN * 128;
    const int tid = tid_opaque(), lane = tid & 63, wv = tid >> 6, wm = wv >> 2, wn = wv & 3;
    const int fr = lane & 15, fq = lane >> 4;
    unsigned char* sA = lds;
    unsigned char* sB = lds + 2 * A_BYTES;
    f32x4 acc[4][NI];
#pragma unroll
    for (int mi = 0; mi < 4; ++mi)
#pragma unroll
        for (int ni = 0; ni < NI; ++ni) acc[mi][ni] = (f32x4){0.f, 0.f, 0.f, 0.f};
    const int KT = K >> 6;
    const int drow = tid >> 3, dch = (tid & 7) ^ (drow & 7);
    const bf16_t* bsrc = Bt + (size_t)drow * K + dch * 8;
    uint4 ra[2];
    auto stage = [&](int kt, int buf) {
        const int k0 = kt * 64;
#pragma unroll
        for (int i = 0; i < BN / 64; ++i)
            __builtin_amdgcn_global_load_lds((const unsigned*)(bsrc + (size_t)(64 * i) * K + k0), (unsigned*)(sB + buf * B_BYTES + i * 8192 + tid * 16), 16, 0, 0);
        if constexpr (AL::DMA) {
#pragma unroll
            for (int i = 0; i < 2; ++i)
                __builtin_amdgcn_global_load_lds((const unsigned*)(al.A + (size_t)(m0 + drow + 64 * i) * al.lda + k0 + dch * 8), (unsigned*)(sA + buf * A_BYTES + i * 8192 + tid * 16), 16, 0, 0);
        } else {
#pragma unroll
            for (int i = 0; i < 2; ++i) { const int q = tid + 512 * i; ra[i] = al.load(m0 + (q >> 3), k0 + (q & 7) * 8); }
        }
    };
    auto commit = [&](int buf) {
        if constexpr (!AL::DMA) {
#pragma unroll
            for (int i = 0; i < 2; ++i) { const int q = tid + 512 * i, row = q >> 3, ch = q & 7; *(uint4*)(sA + buf * A_BYTES + row * 128 + ((ch ^ (row & 7)) << 4)) = ra[i]; }
        }
    };
    auto compute = [&](int buf) {
        const unsigned char* a_base = sA + buf * A_BYTES;
        const unsigned char* b_base = sB + buf * B_BYTES;
#pragma unroll
        for (int ks = 0; ks < 2; ++ks) {
            bf16x8 af[4], bfr[NI];
            const int ch = ks * 4 + fq;
#pragma unroll
            for (int mi = 0; mi < 4; ++mi) { const int row = wm * 64 + mi * 16 + fr; af[mi] = *(const bf16x8*)(a_base + row * 128 + ((ch ^ (row & 7)) << 4)); }
#pragma unroll
            for (int ni = 0; ni < NI; ++ni) { const int row = wn * (BN / 4) + ni * 16 + fr; bfr[ni] = *(const bf16x8*)(b_base + row * 128 + ((ch ^ (row & 7)) << 4)); }
#pragma unroll
            for (int mi = 0; mi < 4; ++mi)
#pragma unroll
                for (int ni = 0; ni < NI; ++ni) acc[mi][ni] = __builtin_amdgcn_mfma_f32_16x16x32_bf16(bfr[ni], af[mi], acc[mi][ni], 0, 0, 0);
        }
    };
    if constexpr (AL::DMA) {
        constexpr int STG = A_BYTES + B_BYTES;
        auto stage3 = [&](int kt, int b3) {
            const int k0 = kt * 64;
            unsigned char* base = lds + b3 * STG;
#pragma unroll
            for (int i = 0; i < BN / 64; ++i)
                __builtin_amdgcn_global_load_lds((const unsigned*)(bsrc + (size_t)(64 * i) * K + k0), (unsigned*)(base + A_BYTES + i * 8192 + tid * 16), 16, 0, 0);
#pragma unroll
            for (int i = 0; i < 2; ++i)
                __builtin_amdgcn_global_load_lds((const unsigned*)(al.A + (size_t)(m0 + drow + 64 * i) * al.lda + k0 + dch * 8), (unsigned*)(base + i * 8192 + tid * 16), 16, 0, 0);
        };
        auto compute3 = [&](int b3) {
            const unsigned char* a_base = lds + b3 * STG;
            const unsigned char* b_base = a_base + A_BYTES;
#pragma unroll
            for (int ks = 0; ks < 2; ++ks) {
                bf16x8 af[4], bfr[NI];
                const int ch = ks * 4 + fq;
#pragma unroll
                for (int mi = 0; mi < 4; ++mi) { const int row = wm * 64 + mi * 16 + fr; af[mi] = *(const bf16x8*)(a_base + row * 128 + ((ch ^ (row & 7)) << 4)); }
#pragma unroll
                for (int ni = 0; ni < NI; ++ni) { const int row = wn * (BN / 4) + ni * 16 + fr; bfr[ni] = *(const bf16x8*)(b_base + row * 128 + ((ch ^ (row & 7)) << 4)); }
#pragma unroll
                for (int mi = 0; mi < 4; ++mi)
#pragma unroll
                    for (int ni = 0; ni < NI; ++ni) acc[mi][ni] = __builtin_amdgcn_mfma_f32_16x16x32_bf16(bfr[ni], af[mi], acc[mi][ni], 0, 0, 0);
            }
        };
        stage3(0, 0);
        stage3(1, 1);
        int b3 = 0;
        for (int kt = 0; kt < KT; ++kt) {
            if (kt + 1 < KT) { if constexpr (BN == 256) asm volatile("s_waitcnt vmcnt(6)" ::: "memory"); else asm volatile("s_waitcnt vmcnt(4)" ::: "memory"); }
            else asm volatile("s_waitcnt vmcnt(0)" ::: "memory");
            asm volatile("s_waitcnt lgkmcnt(0)" ::: "memory");
            __builtin_amdgcn_s_barrier();
            asm volatile("" ::: "memory");
            const int bn = (b3 == 0) ? 2 : b3 - 1;
            if (kt + 2 < KT) stage3(kt + 2, bn);
            compute3(b3);
            b3 = (b3 == 2) ? 0 : b3 + 1;
        }
        asm volatile("s_waitcnt lgkmcnt(0)" ::: "memory");
        __builtin_amdgcn_s_barrier();
        asm volatile("" ::: "memory");
    } else {
        stage(0, 0);
        commit(0);
        asm volatile("s_waitcnt vmcnt(0)" ::: "memory");
        __syncthreads();
        for (int kt = 0; kt < KT; ++kt) {
            const int cur = kt & 1;
            const bool more = (kt + 1 < KT);
            if (more) stage(kt + 1, cur ^ 1);
            compute(cur);
            if (more) commit(cur ^ 1);
            asm volatile("s_waitcnt vmcnt(0)" ::: "memory");
            __syncthreads();
        }
    }
    ep(acc, m0, wm, wn, fr, fq);
}

struct ALoadPlain {
    static constexpr bool DMA = true;
    const bf16_t* A; int lda;
    DEV uint4 load(int R, int k) const { return *(const uint4*)(A + (size_t)R * lda + k); }
};
struct ALoadMix {
    static constexpr bool DMA = false;
    const bf16_t* h; const float* mix; const bf16_t* A; int lda;
    DEV uint4 load(int R, int k) const {
        const bf16_t* pc = h + (size_t)R * 1024 + k;
        const uint4 c = *(const uint4*)pc;
        const int t = (R < NL) ? (R & 8191) : ((R - NL) & 255);
        const int last = (R < NL) ? 8191 : 255;
        uint4 pv = *(const uint4*)(pc - (t != 0 ? 1024 : 0)), nv = *(const uint4*)(pc + (t != last ? 1024 : 0));
        if (t == 0) pv = make_uint4(0, 0, 0, 0);
        if (t == last) nv = make_uint4(0, 0, 0, 0);
        const float4 m0 = *(const float4*)(mix + k), m1 = *(const float4*)(mix + k + 4);
        const unsigned cc[4] = {c.x, c.y, c.z, c.w}, pp[4] = {pv.x, pv.y, pv.z, pv.w}, nn[4] = {nv.x, nv.y, nv.z, nv.w};
        const float mm[8] = {m0.x, m0.y, m0.z, m0.w, m1.x, m1.y, m1.z, m1.w};
        unsigned o[4];
#pragma unroll
        for (int i = 0; i < 4; ++i) {
            const float hc0 = bf_lo(cc[i]), hc1 = bf_hi(cc[i]);
            const float s0 = 0.5f * (bf_lo(pp[i]) + bf_lo(nn[i])), s1 = 0.5f * (bf_hi(pp[i]) + bf_hi(nn[i]));
            o[i] = pk_bf16(hc0 + (s0 - hc0) * mm[2 * i], hc1 + (s1 - hc1) * mm[2 * i + 1]);
        }
        return make_uint4(o[0], o[1], o[2], o[3]);
    }
};

struct TrJob { int in_idx, src_off, K, N, src_ld, dst_ld; unsigned long long dst_off; int tile0; };
constexpr int NTRJOBS = 19;
__device__ const TrJob g_trjobs[NTRJOBS] = {
    {9, 0 * 1048576, 1024, 1024, 1024, 1024, WS_WPROJ + 0ull * 1024 * 1024 * 2, 0},
    {9, 1 * 1048576, 1024, 1024, 1024, 1024, WS_WPROJ + 1ull * 1024 * 1024 * 2, 256},
    {9, 2 * 1048576, 1024, 1024, 1024, 1024, WS_WPROJ + 2ull * 1024 * 1024 * 2, 512},
    {11, 0, 1024, 64, 64, 1024, WS_WPROJ + 3072ull * 1024 * 2, 768},
    {11, 65536, 1024, 64, 64, 1024, WS_WPROJ + 3136ull * 1024 * 2, 784},
    {14, 0, 1024, 64, 64, 1024, WS_WPROJ + 3200ull * 1024 * 2, 800},
    {14, 65536, 1024, 64, 64, 1024, WS_WPROJ + 3264ull * 1024 * 2, 816},
    {16, 0, 1024, 128, 128, 1024, WS_WPROJ + 3328ull * 1024 * 2, 832},
    {12, 0, 64, 1024, 1024, 64, WS_W2T, 864},
    {12, 65536, 64, 1024, 1024, 64, WS_W2T + 1024ull * 64 * 2, 880},
    {15, 0, 64, 1024, 1024, 64, WS_A2T, 896},
    {15, 65536, 64, 1024, 1024, 64, WS_A2T + 1024ull * 64 * 2, 912},
    {17, 0, 128, 1024, 1024, 128, WS_G2T, 928},
    {23, 0, 1024, 1024, 1024, 1024, WS_WO0, 960},
    {29, 0, 1024, 1024, 1024, 1024, WS_WO1, 1216},
    {30, 0, 1024, 2048, 2048, 1024, WS_WQ, 1472},
    {30, 2097152, 1024, 2048, 2048, 1024, WS_WQ + 2048ull * 1024 * 2, 1984},
    {24, 0, 1024, 3104, 3104, 1024, WS_WIN, 2496},
    {0, 0, 0, 0, 0, 0, 0, 2496 + 16 * 49},
};
constexpr int NTRTILES = 2496 + 16 * 49;

DEV void phase0(const Params& p, unsigned char* lds) {
    const int tid = tid_opaque();
    unsigned char* ws = p.ws;
    {
        float* sc = (float*)lds;
        float* red = sc + 9 * 1024;
        float* mods = (float*)(ws + WS_MOD);
        bool have_sc = false;
        for (int task = blockIdx.x; task < 192; task += gridDim.x) {
            if (!have_sc) {
                for (int i = tid; i < 9 * 1024; i += NTHREADS) {
                    const int mb = i >> 10, k = i & 1023;
                    const float cv = mb < 8 ? p.in[1][mb * 1024 + k] : p.in[3][k];
                    sc[i] = cv / (1.0f + __expf(-cv));
                }
                have_sc = true;
            }
            __syncthreads();
            const int l = task / 96, nb = task % 96;
            const int nn = tid & 63, kg = tid >> 6;
            const float* w = p.in[4] + (size_t)l * 1024 * 6144 + nb * 64 + nn;
            float acc[9];
#pragma unroll
            for (int m = 0; m < 9; ++m) acc[m] = 0.f;
            for (int k = kg * 128; k < kg * 128 + 128; ++k) {
                const float wv = w[(size_t)k * 6144];
#pragma unroll
                for (int m = 0; m < 9; ++m) acc[m] += sc[m * 1024 + k] * wv;
            }
#pragma unroll
            for (int m = 0; m < 9; ++m) red[(kg * 9 + m) * 64 + nn] = acc[m];
            __syncthreads();
            for (int i = tid; i < 576; i += NTHREADS) {
                const int m = i >> 6, n2 = i & 63;
                float s = p.in[5][l * 6144 + nb * 64 + n2];
#pragma unroll
                for (int g = 0; g < 8; ++g) s += red[(g * 9 + m) * 64 + n2];
                mods[(size_t)(l * 9 + m) * 6144 + nb * 64 + n2] = s;
            }
            __syncthreads();
        }
        __syncthreads();
    }
    {
        float* tile = (float*)lds;
        for (int tt = blockIdx.x; tt < NTRTILES; tt += gridDim.x) {
            int j = 0;
#pragma unroll 1
            while (j + 1 < NTRJOBS && g_trjobs[j + 1].tile0 <= tt) ++j;
            const TrJob jb = g_trjobs[j];
            const int tl = tt - jb.tile0;
            const int ntn = (jb.N + 63) >> 6;
            const int k0 = (tl / ntn) * 64, n0 = (tl % ntn) * 64;
            const float* src = p.in[jb.in_idx] + jb.src_off;
            bf16_t* dst = (bf16_t*)(ws + jb.dst_off);
            {
                const int kr = tid >> 4, nc4 = (tid & 15) * 4;
#pragma unroll
                for (int i = 0; i < 2; ++i) {
                    const int kk = kr + 32 * i;
                    float4 v = make_float4(0.f, 0.f, 0.f, 0.f);
                    if (n0 + nc4 < jb.N) v = *(const float4*)(src + (size_t)(k0 + kk) * jb.src_ld + n0 + nc4);
                    tile[kk * 65 + nc4 + 0] = v.x; tile[kk * 65 + nc4 + 1] = v.y; tile[kk * 65 + nc4 + 2] = v.z; tile[kk * 65 + nc4 + 3] = v.w;
                }
            }
            __syncthreads();
            {
                const int nn = tid >> 3, kc = (tid & 7) * 8;
                if (n0 + nn < jb.N) {
                    unsigned o[4];
#pragma unroll
                    for (int i = 0; i < 4; ++i) o[i] = pk_bf16(tile[(kc + 2 * i) * 65 + nn], tile[(kc + 2 * i + 1) * 65 + nn]);
                    *(uint4*)(dst + (size_t)(n0 + nn) * jb.dst_ld + k0 + kc) = make_uint4(o[0], o[1], o[2], o[3]);
                }
            }
            __syncthreads();
        }
    }
    {
        const size_t gtid = (size_t)blockIdx.x * NTHREADS + tid, gstride = (size_t)gridDim.x * NTHREADS;
        {
            const float* src = p.in[31];
            bf16_t* dst = (bf16_t*)(ws + WS_KEYS);
            const size_t n8 = (size_t)2 * 8 * 2 * 128 * 128 / 8;
            for (size_t i = gtid; i < n8; i += gstride) {
                const float4 a = *(const float4*)(src + i * 8), b = *(const float4*)(src + i * 8 + 4);
                *(uint4*)(dst + i * 8) = make_uint4(pk_bf16(a.x, a.y), pk_bf16(a.z, a.w), pk_bf16(b.x, b.y), pk_bf16(b.z, b.w));
            }
        }
        bf16_t* wpad = (bf16_t*)(ws + WS_WIN) + (size_t)3104 * 1024;
        for (size_t i = gtid; i < (size_t)96 * 1024 / 8; i += gstride) *(uint4*)(wpad + i * 8) = make_uint4(0, 0, 0, 0);
        const int lane = tid & 63;
        const int gw = blockIdx.x * 8 + (tid >> 6), nw = gridDim.x * 8;
        float* scales = (float*)(ws + WS_PSC);
        for (int rowi = gw * 32; rowi < 2 * 32768; rowi += nw * 32)
        for (int row = rowi; row < rowi + 32; ++row) {
            const int tbl = row >> 15, r = row & 32767;
            const float* srow = p.in[32 + tbl] + (size_t)r * 1024;
            float4 v[4]; float am = 0.f;
#pragma unroll
            for (int i = 0; i < 4; ++i) { v[i] = *(const float4*)(srow + 16 * lane + 4 * i); am = fmaxf(am, fmaxf(fmaxf(fabsf(v[i].x), fabsf(v[i].y)), fmaxf(fabsf(v[i].z), fabsf(v[i].w)))); }
#pragma unroll
            for (int o = 1; o < 64; o <<= 1) am = fmaxf(am, __shfl_xor(am, o));
            const float scale = am > 0.f ? am * (1.0f / 448.0f) : 1.0f;
            const float inv = 1.0f / scale;
            unsigned w[4];
#pragma unroll
            for (int i = 0; i < 4; ++i) {
                int t = 0;
                t = __builtin_amdgcn_cvt_pk_fp8_f32(v[i].x * inv, v[i].y * inv, t, false);
                t = __builtin_amdgcn_cvt_pk_fp8_f32(v[i].z * inv, v[i].w * inv, t, true);
                w[i] = (unsigned)t;
            }
            *(uint4*)(ws + (tbl ? WS_PV : WS_PU) + ((size_t)(r >> 14) * 8 + (lane >> 3)) * (16384 * 128) + (size_t)(r & 16383) * 128 + 16 * (lane & 7)) = make_uint4(w[0], w[1], w[2], w[3]);
            if (lane == 0) scales[tbl * 32768 + r] = scale;
        }
    }
}

DEV void normmod_store(const float4 (&v)[4], float ss, const float* g, const float* shift, const float* scale, bf16_t* dst, unsigned char* xq, int lane) {
    const float rs = rsqrtf(ss * (1.0f / 1024.0f) + 1e-6f);
#pragma unroll
    for (int i = 0; i < 4; ++i) {
        const int col = i * 256 + lane * 4;
        const float4 gg = *(const float4*)(g + col), sh = *(const float4*)(shift + col), sc = *(const float4*)(scale + col);
        const float y0 = v[i].x * rs * gg.x * (1.f + sc.x) + sh.x, y1 = v[i].y * rs * gg.y * (1.f + sc.y) + sh.y;
        const float y2 = v[i].z * rs * gg.z * (1.f + sc.z) + sh.z, y3 = v[i].w * rs * gg.w * (1.f + sc.w) + sh.w;
        *(uint2*)(dst + col) = make_uint2(pk_bf16(y0, y1), pk_bf16(y2, y3));
        if (xq) {
            const float z0 = __builtin_amdgcn_fmed3f(4.f * y0, -448.f, 448.f), z1 = __builtin_amdgcn_fmed3f(4.f * y1, -448.f, 448.f);
            const float z2 = __builtin_amdgcn_fmed3f(4.f * y2, -448.f, 448.f), z3 = __builtin_amdgcn_fmed3f(4.f * y3, -448.f, 448.f);
            int hi = __builtin_amdgcn_cvt_pk_fp8_f32(z0, z1, 0, false); hi = __builtin_amdgcn_cvt_pk_fp8_f32(z2, z3, hi, true);
            const f32x2v h01 = __builtin_amdgcn_cvt_pk_f32_fp8(hi, false), h23 = __builtin_amdgcn_cvt_pk_f32_fp8(hi, true);
            int lo = __builtin_amdgcn_cvt_pk_fp8_f32(z0 - h01.x, z1 - h01.y, 0, false); lo = __builtin_amdgcn_cvt_pk_fp8_f32(z2 - h23.x, z3 - h23.y, lo, true);
            *(int*)(xq + col) = hi; *(int*)(xq + 1024 + col) = lo;
        }
    }
}
DEV void phase_normmod(const Params& p, int layer, int which, const float* xl, const float* xc, int nrows, bf16_t* dst, unsigned char* xq) {
    const int tid = tid_opaque(), lane = tid & 63;
    const int gw = blockIdx.x * 8 + (tid >> 6), nw = gridDim.x * 8;
    const float* mods = (const float*)(p.ws + WS_MOD) + (size_t)layer * 9 * 6144;
    const float* g = p.in[which ? 7 : 6] + layer * 1024;
    for (int R = gw; R < nrows; R += nw) {
        const float* xr = R < NL ? xl + (size_t)R * 1024 : xc + (size_t)(R - NL) * 1024;
        float4 v[4]; float ss = 0.f;
#pragma unroll
        for (int i = 0; i < 4; ++i) { v[i] = *(const float4*)(xr + i * 256 + lane * 4); ss += v[i].x * v[i].x + v[i].y * v[i].y + v[i].z * v[i].z + v[i].w * v[i].w; }
        ss = wave_allreduce(ss);
        const float* mrow = mods + (size_t)mod_batch(R) * 6144 + (which ? 3 : 0) * 1024;
        normmod_store(v, ss, g, mrow, mrow + 1024, dst + (size_t)R * 1024, xq ? xq + (size_t)R * 2048 : nullptr, lane);
    }
}
DEV void phase_normmix(const Params& p, bf16_t* hdst, bf16_t* xr, bf16_t* xk, bf16_t* xv) {
    const int tid = tid_opaque(), lane = tid & 63;
    const int gw = __builtin_amdgcn_readfirstlane(blockIdx.x * 8 + (tid >> 6)), nw = gridDim.x * 8;
    const float* mods = (const float*)(p.ws + WS_MOD);
    const float* g = p.in[6];
    for (int run = gw; run < NT / 8; run += nw) {
        const int R0 = run * 8;
        const int t0 = R0 < NL ? (R0 & 8191) : ((R0 - NL) & 255), slen = R0 < NL ? 8192 : 256;
        const float* mrow = mods + (size_t)mod_batch(R0) * 6144;
        float4 gg[4], sh[4], sc[4], m0[4], m2[4], m3[4];
#pragma unroll
        for (int i = 0; i < 4; ++i) {
            const int col = i * 256 + lane * 4;
            gg[i] = *(const float4*)(g + col); sh[i] = *(const float4*)(mrow + col); sc[i] = *(const float4*)(mrow + 1024 + col);
            m0[i] = *(const float4*)(p.in[8] + col); m2[i] = *(const float4*)(p.in[8] + 2 * 1024 + col); m3[i] = *(const float4*)(p.in[8] + 3 * 1024 + col);
        }
        auto hrow = [&](int R, float4 (&h)[4]) {
            const float* xrw = R < NL ? p.in[0] + (size_t)R * 1024 : p.in[2] + (size_t)(R - NL) * 1024;
            float ss = 0.f;
#pragma unroll
            for (int i = 0; i < 4; ++i) { h[i] = *(const float4*)(xrw + i * 256 + lane * 4); ss += h[i].x * h[i].x + h[i].y * h[i].y + h[i].z * h[i].z + h[i].w * h[i].w; }
            ss = wave_allreduce(ss);
            const float rs = rsqrtf(ss * (1.0f / 1024.0f) + 1e-6f);
#pragma unroll
            for (int i = 0; i < 4; ++i) {
                h[i].x = h[i].x * rs * gg[i].x * (1.f + sc[i].x) + sh[i].x; h[i].y = h[i].y * rs * gg[i].y * (1.f + sc[i].y) + sh[i].y;
                h[i].z = h[i].z * rs * gg[i].z * (1.f + sc[i].z) + sh[i].z; h[i].w = h[i].w * rs * gg[i].w * (1.f + sc[i].w) + sh[i].w;
            }
        };
        float4 hp[4], hc[4], hn[4];
        if (t0 > 0) hrow(R0 - 1, hp); else { hp[0] = hp[1] = hp[2] = hp[3] = make_float4(0.f, 0.f, 0.f, 0.f); }
        hrow(R0, hc);
#pragma unroll 1
        for (int i8 = 0; i8 < 8; ++i8) {
            const int R = R0 + i8;
            if (t0 + i8 + 1 < slen) hrow(R + 1, hn); else { hn[0] = hn[1] = hn[2] = hn[3] = make_float4(0.f, 0.f, 0.f, 0.f); }
#pragma unroll
            for (int i = 0; i < 4; ++i) {
                const size_t o = (size_t)R * 1024 + i * 256 + lane * 4;
                const float4 c = hc[i];
                const float4 xx = make_float4(0.5f * (hp[i].x + hn[i].x) - c.x, 0.5f * (hp[i].y + hn[i].y) - c.y, 0.5f * (hp[i].z + hn[i].z) - c.z, 0.5f * (hp[i].w + hn[i].w) - c.w);
                *(uint2*)(hdst + o) = make_uint2(pk_bf16(c.x, c.y), pk_bf16(c.z, c.w));
                *(uint2*)(xr + o) = make_uint2(pk_bf16(c.x + xx.x * m0[i].x, c.y + xx.y * m0[i].y), pk_bf16(c.z + xx.z * m0[i].z, c.w + xx.w * m0[i].w));
                *(uint2*)(xk + o) = make_uint2(pk_bf16(c.x + xx.x * m2[i].x, c.y + xx.y * m2[i].y), pk_bf16(c.z + xx.z * m2[i].z, c.w + xx.w * m2[i].w));
                *(uint2*)(xv + o) = make_uint2(pk_bf16(c.x + xx.x * m3[i].x, c.y + xx.y * m3[i].y), pk_bf16(c.z + xx.z * m3[i].z, c.w + xx.w * m3[i].w));
            }
#pragma unroll
            for (int i = 0; i < 4; ++i) { hp[i] = hc[i]; hc[i] = hn[i]; }
        }
    }
}

template <int BN> struct EpiBf16 {
    bf16_t* dst; int ldd; int col0; int act;
    DEV void operator()(const f32x4 (&acc)[4][BN / 64], int m0, int wm, int wn, int fr, int fq) const {
#pragma unroll
        for (int mi = 0; mi < 4; ++mi) {
            const size_t R = (size_t)(m0 + wm * 64 + mi * 16 + fr);
#pragma unroll
            for (int ni = 0; ni < BN / 64; ++ni) {
                const int col = col0 + wn * (BN / 4) + ni * 16 + 4 * fq;
                float v[4] = {acc[mi][ni][0], acc[mi][ni][1], acc[mi][ni][2], acc[mi][ni][3]};
                if (act == 1) {
#pragma unroll
                    for (int j = 0; j < 4; ++j) v[j] = tanhf(v[j]);
                } else if (act == 2) {
#pragma unroll
                    for (int j = 0; j < 4; ++j) v[j] = sigmoidf_(v[j]);
                }
                *(uint2*)(dst + R * ldd + col) = make_uint2(pk_bf16(v[0], v[1]), pk_bf16(v[2], v[3]));
            }
        }
    }
};
struct EpiResid {
    const float* xold_lat; const float* xold_ctx; float* dst_lat; float* dst_ctx; const float* gate; int col0;
    DEV void operator()(const f32x4 (&acc)[4][4], int m0, int wm, int wn, int fr, int fq) const {
#pragma unroll
        for (int mi = 0; mi < 4; ++mi) {
            const int R = m0 + wm * 64 + mi * 16 + fr;
            const float* src = R < NL ? xold_lat + (size_t)R * 1024 : xold_ctx + (size_t)(R - NL) * 1024;
            float* dst = R < NL ? dst_lat + (size_t)R * 1024 : dst_ctx + (size_t)(R - NL) * 1024;
            const float* gr = gate + (size_t)mod_batch(R) * 6144;
#pragma unroll
            for (int ni = 0; ni < 4; ++ni) {
                const int col = col0 + wn * 64 + ni * 16 + 4 * fq;
                const float4 xo = *(const float4*)(src + col), g4 = *(const float4*)(gr + col);
                *(float4*)(dst + col) = make_float4(xo.x + g4.x * acc[mi][ni][0], xo.y + g4.y * acc[mi][ni][1], xo.z + g4.z * acc[mi][ni][2], xo.w + g4.w * acc[mi][ni][3]);
            }
        }
    }
};
struct EpiLr {
    float* dst;
    DEV void operator()(const f32x4 (&acc)[4][2], int m0, int wm, int wn, int fr, int fq) const {
        if (wn != 0) return;
#pragma unroll
        for (int mi = 0; mi < 4; ++mi) {
            const size_t R = (size_t)(m0 + wm * 64 + mi * 16 + fr);
#pragma unroll
            for (int ni = 0; ni < 2; ++ni) { const int col = ni * 16 + 4 * fq; *(float4*)(dst + R * 32 + col) = make_float4(acc[mi][ni][0], acc[mi][ni][1], acc[mi][ni][2], acc[mi][ni][3]); }
        }
    }
};

namespace pg8 {
#define PG8_LAS __attribute__((address_space(3)))
constexpr int BM = 256, BK = 64, HALF = 128, HTB = HALF * BK * 2  , STAGE_BYTES = 8 * HTB, NXCD = 8, WGM = 8;

__host__ __device__ __forceinline__ int lds_byte(int r, int c) { const int st = (r >> 4) * 2 + (c >> 5), rr = r & 15, cc = c & 31, ob = rr * 64 + cc * 2; return st * 1024 + (ob ^ (((ob >> 9) & 1) << 5)); }
__host__ __device__ __forceinline__ void stage_rc(int b, int& R, int& C) { const int st = b / 1024, sb = b % 1024, swz = sb ^ (((sb >> 9) & 1) << 5); R = (st >> 1) * 16 + swz / 64; C = (st & 1) * 32 + (swz % 64) / 2; }
__host__ __device__ __forceinline__ int perm32(int rho) { const int n = rho >> 4, i = rho & 15; return 8 * (i >> 2) + 4 * n + (i & 3); }
struct Unit { int pm, pn; };
struct Gemm { const bf16_t* A; const bf16_t* Bt; int M, N, K; };
struct StaticOrder {
    int nM, nN, nwg, G, c;
    __host__ __device__ void init(int M, int N, int G_, int c_) { nM = M / BM; nN = N / BM; nwg = nM * nN; G = G_; c = c_; }
    __host__ __device__ bool next(int i, Unit& u) const {
        const long L = (long)i * G + c; if (L >= nwg) return false;
        int wgid = (int)L; { const int q = nwg / NXCD, r = nwg % NXCD, xcd = wgid % NXCD, off = wgid / NXCD; wgid = (xcd < r ? xcd * (q + 1) : r * (q + 1) + (xcd - r) * q) + off; }
        const int nig = WGM * nN, gid = wgid / nig, fm = gid * WGM, gsz = (nM - fm) < WGM ? (nM - fm) : WGM;
        u.pm = fm + ((wgid % nig) % gsz); u.pn = (wgid % nig) / gsz; return true;
    }
    __device__ __forceinline__ void a_ready(const Unit&) const {}
    __device__ __forceinline__ void done(const Unit&) const {}
};
template <class Epi, class Sched, bool STAMP = false>
__device__ __forceinline__ void gemm_phase(PG8_LAS unsigned char* lds, const Gemm g, const Sched& S, const Epi& E, unsigned long long* stamps) {
    const int tid = tid_opaque(), wid = __builtin_amdgcn_readfirstlane(tid >> 6), lane = tid & 63, wr = wid >> 2, wc = wid & 3, fr = lane & 15, fq = lane >> 4;
    const int K = g.K, nt = K / BK;
    int ts_lo = 0, ts_hi = 0, nts = 0; const unsigned long long rt_entry = STAMP ? (unsigned long long)wall_clock64() : 0ull;
#define PG8_STAMP() do { if (STAMP && wid == 0 && nts < 64) { const unsigned long long _c = (unsigned long long)clock64(); \
        ts_lo = (lane == nts) ? (int)(unsigned)_c : ts_lo; ts_hi = (lane == nts) ? (int)(unsigned)(_c >> 32) : ts_hi; ++nts; } } while (0)
    PG8_STAMP();
    unsigned voffA[2], voffB[2];
#pragma unroll
    for (int i = 0; i < 2; ++i) { int R, C; stage_rc(tid * 16 + i * 8192, R, C); const int Rb = Epi::PERM ? ((R & ~31) + perm32(R & 31)) : R;
        voffA[i] = (unsigned)(R * K + C) * 2u; voffB[i] = (unsigned)(Rb * K + C) * 2u; }
    const size_t kstep = (size_t)(BK * 2);
    const size_t hstep = (size_t)HALF * K * 2;
    const size_t tstep = 2 * hstep;
    const unsigned ldsw = (unsigned)wid * 1024u;
    const int aoff = lds_byte(wr * 64 + fr, fq * 8), boff = lds_byte(wc * 32 + fr, fq * 8);
#define PG8_SA(b, h) (((b) * 2 + (h)) * HTB)
#define PG8_SB(b, h) ((4 + (b) * 2 + (h)) * HTB)
#define PG8_STAGE(bufoff, gbase, voff) do { _Pragma("unroll") for (int _i = 0; _i < 2; ++_i) \
        __builtin_amdgcn_global_load_lds((const unsigned*)((const char*)(gbase) + (voff)[_i]), (PG8_LAS unsigned*)(lds + (bufoff) + ldsw + _i * 8192), 16, 0, 0); } while (0)
#define PG8_LDA(dst, b, h) do { _Pragma("unroll") for (int m = 0; m < 4; ++m) _Pragma("unroll") for (int k = 0; k < 2; ++k) dst[m][k] = *(const PG8_LAS bf16x8*)(lds + PG8_SA(b, h) + aoff + m * 2048 + k * 1024); } while (0)
#define PG8_LDB(dst, b, h) do { _Pragma("unroll") for (int n = 0; n < 2; ++n) _Pragma("unroll") for (int k = 0; k < 2; ++k) dst[n][k] = *(const PG8_LAS bf16x8*)(lds + PG8_SB(b, h) + boff + n * 2048 + k * 1024); } while (0)
#define PG8_MMA(ai, bj, At, Bt) do { __builtin_amdgcn_s_setprio(1); _Pragma("unroll") for (int m = 0; m < 4; ++m) _Pragma("unroll") for (int n = 0; n < 2; ++n) _Pragma("unroll") for (int k = 0; k < 2; ++k) \
        acc[ai][bj][m][n] = __builtin_amdgcn_mfma_f32_16x16x32_bf16(Bt[n][k], At[m][k], acc[ai][bj][m][n], 0, 0, 0); __builtin_amdgcn_s_setprio(0); } while (0)
#define PG8_WAIT_V(n) asm volatile("s_waitcnt vmcnt(" #n ")" ::: "memory")
#define PG8_WAIT_L(n) asm volatile("s_waitcnt lgkmcnt(" #n ")" ::: "memory")
#define PG8_BAR __builtin_amdgcn_s_barrier()
#define PG8_SCHED __builtin_amdgcn_sched_barrier(0)
    Unit cur, nxt; int ui = 0;
    if (!S.next(0, cur)) return;
    f32x4 acc[2][2][4][2];
#pragma unroll
    for (int a = 0; a < 2; ++a)
#pragma unroll
        for (int b = 0; b < 2; ++b)
#pragma unroll
            for (int m = 0; m < 4; ++m)
#pragma unroll
                for (int n = 0; n < 2; ++n) acc[a][b][m][n] = (f32x4){0.f, 0.f, 0.f, 0.f};
    bf16x8 At[4][2], B0[2][2], B1[2][2];
    const char* cA = (const char*)g.A + (size_t)cur.pm * tstep; const char* cB = (const char*)g.Bt + (size_t)cur.pn * tstep;
    S.a_ready(cur);
    PG8_STAGE(PG8_SB(0, 0), cB, voffB); PG8_STAGE(PG8_SA(0, 0), cA, voffA); PG8_STAGE(PG8_SB(0, 1), cB + hstep, voffB); PG8_STAGE(PG8_SA(0, 1), cA + hstep, voffA);
    if (wr == 1) PG8_BAR;
    PG8_WAIT_V(4); PG8_BAR;
    PG8_STAGE(PG8_SB(1, 0), cB + kstep, voffB); PG8_STAGE(PG8_SA(1, 0), cA + kstep, voffA); PG8_STAGE(PG8_SB(1, 1), cB + hstep + kstep, voffB);
    PG8_WAIT_V(6); PG8_BAR;
    PG8_STAMP();
    for (;;) {
        const bool has_next = S.next(ui + 1, nxt);
        const char* nA = has_next ? (const char*)g.A + (size_t)nxt.pm * tstep : cA; const char* nB = has_next ? (const char*)g.Bt + (size_t)nxt.pn * tstep : cB;
        for (int t = 0; t < nt; t += 2) {
            const bool last = (t == nt - 2);
            const char* a1 = cA + (size_t)(t + 1) * kstep;
            const char* a2 = last ? nA : cA + (size_t)(t + 2) * kstep; const char* b2 = last ? nB : cB + (size_t)(t + 2) * kstep;
            const char* a3 = a2 + kstep; const char* b3 = b2 + kstep;
            if (last && has_next) S.a_ready(nxt);
            PG8_LDB(B0, 0, 0); PG8_SCHED; PG8_LDA(At, 0, 0); PG8_STAGE(PG8_SA(1, 1), a1 + hstep, voffA);
            PG8_WAIT_L(8); PG8_BAR; PG8_WAIT_L(0); PG8_MMA(0, 0, At, B0); PG8_BAR; PG8_SCHED;
            PG8_LDB(B1, 0, 1); PG8_STAGE(PG8_SB(0, 0), b2, voffB);
            PG8_BAR; PG8_WAIT_L(0); PG8_MMA(0, 1, At, B1); PG8_BAR;
            PG8_LDA(At, 0, 1); PG8_STAGE(PG8_SA(0, 0), a2, voffA);
            PG8_BAR; PG8_WAIT_L(0); PG8_MMA(1, 0, At, B0); PG8_BAR; PG8_SCHED;
            PG8_STAGE(PG8_SB(0, 1), b2 + hstep, voffB);
            PG8_WAIT_V(6); PG8_BAR; PG8_MMA(1, 1, At, B1); PG8_BAR;
            PG8_LDB(B0, 1, 0); PG8_SCHED; PG8_LDA(At, 1, 0); PG8_STAGE(PG8_SA(0, 1), a2 + hstep, voffA);
            PG8_WAIT_L(8); PG8_BAR; PG8_WAIT_L(0); PG8_MMA(0, 0, At, B0); PG8_BAR; PG8_SCHED;
            PG8_LDB(B1, 1, 1); PG8_STAGE(PG8_SB(1, 0), b3, voffB);
            PG8_BAR; PG8_WAIT_L(0); PG8_MMA(0, 1, At, B1); PG8_BAR;
            PG8_LDA(At, 1, 1); PG8_STAGE(PG8_SA(1, 0), a3, voffA);
            PG8_BAR; PG8_WAIT_L(0); PG8_MMA(1, 0, At, B0); PG8_BAR; PG8_SCHED;
            PG8_STAGE(PG8_SB(1, 1), b3 + hstep, voffB);
            PG8_WAIT_V(6); PG8_BAR; PG8_MMA(1, 1, At, B1); PG8_BAR;
        }
        PG8_STAMP();
        if constexpr (!Epi::AFTER_DRAIN) { E(acc, cur, wr, wc, fr, fq); S.done(cur); }
        PG8_STAMP();
        if (!has_next) break;
#pragma unroll
        for (int a = 0; a < 2; ++a)
#pragma unroll
            for (int b = 0; b < 2; ++b)
#pragma unroll
                for (int m = 0; m < 4; ++m)
#pragma unroll
                    for (int n = 0; n < 2; ++n) acc[a][b][m][n] = (f32x4){0.f, 0.f, 0.f, 0.f};
        cur = nxt; cA = nA; cB = nB; ++ui;
    }
    PG8_WAIT_V(0);
    if (wr == 0) PG8_BAR;
    PG8_BAR;
    if constexpr (Epi::AFTER_DRAIN) { E.fused(acc, cur, wr, wc, fr, fq, lds, wid, lane); S.done(cur); }
    PG8_STAMP();
    if (STAMP && wid == 0) { stamps[lane] = lane < nts ? (((unsigned long long)(unsigned)ts_hi << 32) | (unsigned)ts_lo) : 0ull;
        if (lane == 62) stamps[62] = rt_entry; if (lane == 63) stamps[63] = (unsigned long long)wall_clock64(); }
#undef PG8_STAMP
#undef PG8_SA
#undef PG8_SB
#undef PG8_STAGE
#undef PG8_LDA
#undef PG8_LDB
#undef PG8_MMA
#undef PG8_WAIT_V
#undef PG8_WAIT_L
#undef PG8_BAR
#undef PG8_SCHED
}
struct EpiBf16Tiles {
    static constexpr bool PERM = true, AFTER_DRAIN = false;
    bf16_t* d0; int ld0; int ntile0; bf16_t* d1; int ld1;
    __device__ __forceinline__ void operator()(const f32x4 (&acc)[2][2][4][2], const Unit& u, int wr, int wc, int fr, int fq) const {
        bf16_t* base = u.pn < ntile0 ? d0 : d1; const int ld = u.pn < ntile0 ? ld0 : ld1; const int colt = (u.pn < ntile0 ? u.pn : u.pn - ntile0) * BM;
        const int row0 = u.pm * BM + wr * 64 + fr, col0 = colt + wc * 32 + 8 * fq;
#pragma unroll
        for (int ai = 0; ai < 2; ++ai)
#pragma unroll
            for (int m = 0; m < 4; ++m) { bf16_t* rowp = base + (size_t)(row0 + ai * HALF + m * 16) * ld + col0;
#pragma unroll
                for (int bj = 0; bj < 2; ++bj) { const f32x4 v0 = acc[ai][bj][m][0], v1 = acc[ai][bj][m][1];
                    *(uint4*)(rowp + bj * HALF) = make_uint4(pk_bf16(v0[0], v0[1]), pk_bf16(v0[2], v0[3]), pk_bf16(v1[0], v1[1]), pk_bf16(v1[2], v1[3])); } }
    }
};
struct EpiResid256 {
    static constexpr bool PERM = false, AFTER_DRAIN = false;
    const float* xold_lat; const float* xold_ctx; float* dst_lat; float* dst_ctx; const float* gate;
    __device__ __forceinline__ void operator()(const f32x4 (&acc)[2][2][4][2], const Unit& u, int wr, int wc, int fr, int fq) const {
        const int row0 = u.pm * BM + wr * 64 + fr, col0 = u.pn * BM + wc * 32 + 4 * fq;
#pragma unroll
        for (int ai = 0; ai < 2; ++ai)
#pragma unroll
            for (int m = 0; m < 4; ++m) {
                const int R = row0 + ai * HALF + m * 16;
                const float* src = R < NL ? xold_lat + (size_t)R * 1024 : xold_ctx + (size_t)(R - NL) * 1024;
                float* dst = R < NL ? dst_lat + (size_t)R * 1024 : dst_ctx + (size_t)(R - NL) * 1024;
                const float* gr = gate + (size_t)mod_batch(R) * 6144;
#pragma unroll
                for (int bj = 0; bj < 2; ++bj)
#pragma unroll
                    for (int n = 0; n < 2; ++n) {
                        const int col = col0 + bj * HALF + n * 16;
                        const float4 xo = *(const float4*)(src + col), g4 = *(const float4*)(gr + col);
                        const f32x4 a = acc[ai][bj][m][n];
                        *(float4*)(dst + col) = make_float4(xo.x + g4.x * a[0], xo.y + g4.y * a[1], xo.z + g4.z * a[2], xo.w + g4.w * a[3]);
                    }
            }
    }
};
}

DEV void phase_rw_proj1(const Params& p, unsigned char* lds, int which, const bf16_t* A, bf16_t* dst) {
    pg8::Gemm g{A, (const bf16_t*)(p.ws + WS_WPROJ) + (size_t)which * 1024 * 1024, NT, 1024, 1024};
    pg8::StaticOrder so; so.init(NT, 1024, gridDim.x, blockIdx.x);
    pg8::EpiBf16Tiles ep{dst, 1024, 4, dst, 1024};
    pg8::gemm_phase((PG8_LAS unsigned char*)lds, g, so, ep, nullptr);
    __syncthreads();
}
DEV void phase_rw_lora(const Params& p, unsigned char* lds) {
    unsigned char* ws = p.ws;
    const bf16_t* h = (const bf16_t*)(ws + WS_S + 0 * U_BYTES);
    const bf16_t* wproj = (const bf16_t*)(ws + WS_WPROJ);
    const int nunits = (NT / 128) * 3;
    for (int u = blockIdx.x; u < nunits; u += gridDim.x) {
        const int mt = u / 3, lg = u % 3, m0 = mt * 128;
        const int mixid = lg == 0 ? 1 : (lg == 1 ? 4 : 5);
        ALoadMix al{h, p.in[8] + mixid * 1024, h, 1024};
        EpiBf16<128> ep{(bf16_t*)(ws + WS_S + 4 * U_BYTES), 384, lg * 128, lg == 0 ? 1 : (lg == 1 ? 0 : 2)};
        gemm_unit<128>(lds, al, wproj + (size_t)(3072 + lg * 128) * 1024, 1024, m0, ep);
    }
}

template <int N> DEV float dpp_shr0(float x) { return __int_as_float(__builtin_amdgcn_update_dpp(0, __float_as_int(x), 0x110 + N, 0xF, 0xF, true)); }
template <int CTRL> DEV float dpp_quad(float x) { return __int_as_float(__builtin_amdgcn_update_dpp(0, __float_as_int(x), CTRL, 0xF, 0xF, false)); }
DEV int tile_off(int row, int ch) { return row * 128 + ((ch ^ (row & 7)) << 4); }
DEV int tile_off2(int row, int ch) { return row * 128 + ((ch ^ ((row ^ (row >> 3)) & 7)) << 4); }
DEV void phase_rw_scan(const Params& p, unsigned char* lds) {
    const int tid = tid_opaque(), lane = tid & 63;
    const int wv = __builtin_amdgcn_readfirstlane(tid >> 6);
    const int fr = lane & 15, fq = lane >> 4;
    unsigned char* ws = p.ws;
    constexpr int SH = 0, SL = 8192, AT = 16384  , RT = 20480  , BT = 24576  , KT = 28672  , BKT = 32768  , UV = 49152  , NT = 65536  ;
    constexpr int MFA = 69632, MFK = 70656, X0 = 71680, VS = 75776  , PP = 83968, PM = 88064, PI = 92160, AA = 96256  ;
    constexpr int PL = 116736  , YB = 117760, LDS_END = 121856;
    const bf16_t* rbuf = (const bf16_t*)(ws + WS_S + 3 * U_BYTES);
    const bf16_t* kbuf = (const bf16_t*)(ws + WS_S + 5 * U_BYTES);
    const bf16_t* vbuf = (const bf16_t*)(ws + WS_S + 1 * U_BYTES);
    const bf16_t* lora = (const bf16_t*)(ws + WS_S + 4 * U_BYTES);
    for (int unit = blockIdx.x; unit < 256; unit += gridDim.x) {
        const int b = unit >> 5, hh = (unit >> 1) & 15, d = unit & 1;
        bf16_t* ydst = (bf16_t*)(ws + WS_S + (size_t)(d ? 2 : 0) * U_BYTES);
        float* bonus = (float*)(ws + WS_BONUS) + (size_t)((d * NB + b) * 16 + hh) * 8448;
        const int s_e = (tid >> 4) & 15, j0 = (tid & 15) * 4;
        const int ni = wv & 3;
        auto Rof = [&](int c, int s) -> int {
            if (c < 16) { const int q = c * 16 + s; return NL + b * 256 + (d ? 255 - q : q); }
            const int q = (c - 16) * 16 + s; return b * 8192 + (d ? 8191 - q : q);
        };
        constexpr int CST = LDS_END;
        uint2 pr = make_uint2(0, 0), pk = pr, pv = pr; uint4 paw[2], paa[2];
        if (wv >= 4) {
            const int ct = (tid - 256) * 16;
            *(float4*)(lds + CST + 0 * 4096 + ct) = *(const float4*)(p.in[18] + hh * 64 + j0);
            *(float4*)(lds + CST + 1 * 4096 + ct) = *(const float4*)(p.in[19] + hh * 64 + j0);
            *(float4*)(lds + CST + 2 * 4096 + ct) = *(const float4*)(p.in[20] + hh * 64 + j0);
            *(float4*)(lds + CST + 3 * 4096 + ct) = *(const float4*)(p.in[10] + d * 1024 + hh * 64 + ni * 16 + fq * 4);
            *(float4*)(lds + CST + 4 * 4096 + ct) = *(const float4*)(p.in[13] + d * 1024 + hh * 64 + ni * 16 + fq * 4);
#pragma unroll
            for (int ks = 0; ks < 2; ++ks) {
                *(uint4*)(lds + CST + (5 + ks) * 4096 + ct) = *(const uint4*)((const bf16_t*)(ws + WS_W2T) + (size_t)d * 1024 * 64 + (size_t)(hh * 64 + ni * 16 + fr) * 64 + ks * 32 + fq * 8);
                *(uint4*)(lds + CST + (7 + ks) * 4096 + ct) = *(const uint4*)((const bf16_t*)(ws + WS_A2T) + (size_t)d * 1024 * 64 + (size_t)(hh * 64 + ni * 16 + fr) * 64 + ks * 32 + fq * 8);
            }
        }
        auto load_lora = [&](int c) {
            const size_t R2 = (size_t)Rof(c, fr);
#pragma unroll
            for (int ks = 0; ks < 2; ++ks) { paw[ks] = *(const uint4*)(lora + R2 * 384 + d * 64 + ks * 32 + fq * 8); paa[ks] = *(const uint4*)(lora + R2 * 384 + 128 + d * 64 + ks * 32 + fq * 8); }
        };
        auto load_rkv = [&](int c) {
            const size_t off = (size_t)Rof(c, s_e) * 1024 + hh * 64 + j0;
            pr = *(const uint2*)(rbuf + off); pk = *(const uint2*)(kbuf + off); pv = *(const uint2*)(vbuf + off);
        };
        auto step_up = [&](int c) {
            const int ct = (tid - 256) * 16;
            const float4 bias_w = *(const float4*)(lds + CST + 3 * 4096 + ct), bias_a = *(const float4*)(lds + CST + 4 * 4096 + ct);
            bf16x8 bfw[2], bfa[2];
#pragma unroll
            for (int ks = 0; ks < 2; ++ks) { bfw[ks] = *(const bf16x8*)(lds + CST + (5 + ks) * 4096 + ct); bfa[ks] = *(const bf16x8*)(lds + CST + (7 + ks) * 4096 + ct); }
            f32x4 accw = {0.f, 0.f, 0.f, 0.f}, acca = {0.f, 0.f, 0.f, 0.f};
#pragma unroll
            for (int ks = 0; ks < 2; ++ks) { accw = __builtin_amdgcn_mfma_f32_16x16x32_bf16(bfw[ks], as_bf16x8(paw[ks]), accw, 0, 0, 0); acca = __builtin_amdgcn_mfma_f32_16x16x32_bf16(bfa[ks], as_bf16x8(paa[ks]), acca, 0, 0, 0); }
            const int n = ni * 16 + fq * 4;
            const float bw[4] = {bias_w.x, bias_w.y, bias_w.z, bias_w.w}, ba[4] = {bias_a.x, bias_a.y, bias_a.z, bias_a.w};
            float P[4], Pm[4], Pi[4], av[4];
#pragma unroll
            for (int j = 0; j < 4; ++j) {
                const float e = 0.6065306597f * __builtin_amdgcn_rcpf(1.0f + __expf(-(accw[j] + bw[j])));
                float s = e;
                s += dpp_shr0<1>(s); s += dpp_shr0<2>(s); s += dpp_shr0<4>(s); s += dpp_shr0<8>(s);
                P[j] = __expf(-s); Pi[j] = __builtin_amdgcn_rcpf(P[j]); Pm[j] = P[j] * __expf(e);
                av[j] = __builtin_amdgcn_rcpf(1.0f + __expf(-(acca[j] + ba[j])));
            }
            const int pb = (c & 1) * 16384;
            *(float4*)(lds + PP + pb + (fr * 64 + n) * 4) = make_float4(P[0], P[1], P[2], P[3]);
            *(float4*)(lds + PM + pb + (fr * 64 + n) * 4) = make_float4(Pm[0], Pm[1], Pm[2], Pm[3]);
            *(float4*)(lds + PI + pb + (fr * 64 + n) * 4) = make_float4(Pi[0], Pi[1], Pi[2], Pi[3]);
            *(float4*)(lds + AA + pb + (fr * 64 + n) * 4) = make_float4(av[0], av[1], av[2], av[3]);
            if (fr == 15) *(float4*)(lds + PL + (c & 3) * 256 + n * 4) = make_float4(P[0], P[1], P[2], P[3]);
        };
        auto step_vec = [&](int c) {
            const int eo = (s_e * 64 + j0) * 4, pb = (c & 1) * 16384, tb = (c & 1) * 8192, ct = (tid - 256) * 16;
            const float4 kk_c = *(const float4*)(lds + CST + 0 * 4096 + ct), ka_c = *(const float4*)(lds + CST + 1 * 4096 + ct), rk_c = *(const float4*)(lds + CST + 2 * 4096 + ct);
            const float4 a4 = *(const float4*)(lds + AA + pb + eo), P4 = *(const float4*)(lds + PP + pb + eo), Pm4 = *(const float4*)(lds + PM + pb + eo), Pi4 = *(const float4*)(lds + PI + pb + eo);
            const float kx[4] = {bf_lo(pk.x), bf_hi(pk.x), bf_lo(pk.y), bf_hi(pk.y)};
            const float rx[4] = {bf_lo(pr.x), bf_hi(pr.x), bf_lo(pr.y), bf_hi(pr.y)};
            const float av[4] = {a4.x, a4.y, a4.z, a4.w}, Pv[4] = {P4.x, P4.y, P4.z, P4.w}, Pmv[4] = {Pm4.x, Pm4.y, Pm4.z, Pm4.w}, Piv[4] = {Pi4.x, Pi4.y, Pi4.z, Pi4.w};
            const float kkc[4] = {kk_c.x, kk_c.y, kk_c.z, kk_c.w}, kac[4] = {ka_c.x, ka_c.y, ka_c.z, ka_c.w}, rkc[4] = {rk_c.x, rk_c.y, rk_c.z, rk_c.w};
            float t[4], n2 = 0.f;
#pragma unroll
            for (int j = 0; j < 4; ++j) { t[j] = kx[j] * kkc[j]; n2 += t[j] * t[j]; }
            n2 = row16_allreduce(n2);
            const float inv = 1.0f / fmaxf(sqrtf(n2), 1e-12f);
            float at[4], bt[4], kt[4], rt[4], bon = 0.f;
#pragma unroll
            for (int j = 0; j < 4; ++j) {
                const float kkv = t[j] * inv;
                const float kd = kx[j] * (1.0f + (av[j] - 1.0f) * kac[j]);
                const float bq = kkv * av[j];
                bon += rx[j] * kd * rkc[j];
                at[j] = -kkv * Pmv[j]; bt[j] = bq * Piv[j]; kt[j] = kd * Piv[j]; rt[j] = rx[j] * Pv[j];
            }
            bon = row16_allreduce(bon);
            if ((tid & 15) == 0) { const int Rb = Rof(c, s_e); bonus[Rb < NL ? 256 + (Rb & 8191) : ((Rb - NL) & 255)] = bon; }
            const int ro = tile_off(s_e, j0 >> 3) + (j0 & 7) * 2;
            *(uint2*)(lds + AT + (c & 1) * 2048 + ro) = make_uint2(pk_bf16(at[0], at[1]), pk_bf16(at[2], at[3]));
            *(uint2*)(lds + RT + (c & 1) * 2048 + ro) = make_uint2(pk_bf16(rt[0], rt[1]), pk_bf16(rt[2], rt[3]));
            const unsigned b01 = pk_bf16(bt[0], bt[1]), b23 = pk_bf16(bt[2], bt[3]), k01 = pk_bf16(kt[0], kt[1]), k23 = pk_bf16(kt[2], kt[3]);
            *(uint2*)(lds + BT + (c & 1) * 2048 + ro) = make_uint2(b01, b23);
            *(uint2*)(lds + KT + (c & 1) * 2048 + ro) = make_uint2(k01, k23);
            const unsigned bw2[4] = {b01 & 0xffffu, b01 >> 16, b23 & 0xffffu, b23 >> 16}, kw2[4] = {k01 & 0xffffu, k01 >> 16, k23 & 0xffffu, k23 >> 16};
            const unsigned vw[4] = {pv.x & 0xffffu, pv.x >> 16, pv.y & 0xffffu, pv.y >> 16};
            const int e0 = (s_e & 7) * 2, cq = s_e >> 3;
#pragma unroll
            for (int j = 0; j < 4; ++j) {
                const int row = j0 + j;
                *(bf16_t*)(lds + BKT + tb + tile_off2(row, 0 + cq) + e0) = (bf16_t)bw2[j];
                *(bf16_t*)(lds + BKT + tb + tile_off2(row, 2 + cq) + e0) = (bf16_t)kw2[j];
                *(bf16_t*)(lds + BKT + tb + tile_off2(row, 4 + cq) + e0) = (bf16_t)bw2[j];
                *(bf16_t*)(lds + UV + tb + tile_off2(row, 2 + cq) + e0) = (bf16_t)vw[j];
            }
        };
        f32x4 accY = {0.f, 0.f, 0.f, 0.f};
        auto prod_S = [&](int c) {
            const int vt = wv & 3, tb = (c & 1) * 2048;
            f32x4 accX = {0.f, 0.f, 0.f, 0.f}, accR = {0.f, 0.f, 0.f, 0.f};
#pragma unroll
            for (int ks = 0; ks < 2; ++ks) {
                const int ch = ks * 4 + fq;
                const bf16x8 sh = *(const bf16x8*)(lds + SH + tile_off(vt * 16 + fr, ch)), sl = *(const bf16x8*)(lds + SL + tile_off(vt * 16 + fr, ch));
                const bf16x8 fa = *(const bf16x8*)(lds + AT + tb + tile_off(fr, ch)), frr = *(const bf16x8*)(lds + RT + tb + tile_off(fr, ch));
                accX = __builtin_amdgcn_mfma_f32_16x16x32_bf16(sh, fa, accX, 0, 0, 0);
                accR = __builtin_amdgcn_mfma_f32_16x16x32_bf16(sh, frr, accR, 0, 0, 0);
                accX = __builtin_amdgcn_mfma_f32_16x16x32_bf16(sl, fa, accX, 0, 0, 0);
                accR = __builtin_amdgcn_mfma_f32_16x16x32_bf16(sl, frr, accR, 0, 0, 0);
            }
            accY = accR;
            {
                const u32x2v av = *(const u32x2v*)(lds + UV + (c & 1) * 8192 + tile_off2(vt * 16 + fr, 2 + (fq >> 1)) + (fq & 1) * 8);
                const u32x2v mh = *(const u32x2v*)(lds + MFK + (fr * 4 + fq) * 8), ml = *(const u32x2v*)(lds + MFK + 512 + (fr * 4 + fq) * 8);
                accX = __builtin_amdgcn_mfma_f32_16x16x16bf16_1k(__builtin_bit_cast(s16x4v, av), __builtin_bit_cast(s16x4v, mh), accX, 0, 0, 0);
                accX = __builtin_amdgcn_mfma_f32_16x16x16bf16_1k(__builtin_bit_cast(s16x4v, av), __builtin_bit_cast(s16x4v, ml), accX, 0, 0, 0);
            }
#pragma unroll
            for (int j = 0; j < 4; ++j) *(float*)(lds + X0 + ((vt * 16 + 4 * fq + j) * 16 + fr) * 4) = accX[j];
        };
        auto prod_V = [&](int c) {
            const int tb = (c & 1) * 2048, w4 = wv & 3;
            f32x4 m = {0.f, 0.f, 0.f, 0.f};
#pragma unroll
            for (int ks = 0; ks < 2; ++ks) {
                const int ch = ks * 4 + fq;
                const bf16x8 fa = *(const bf16x8*)(lds + ((w4 & 1) ? KT : BT) + tb + tile_off(fr, ch));
                const bf16x8 fb = *(const bf16x8*)(lds + ((w4 & 2) ? RT : AT) + tb + tile_off(fr, ch));
                m = __builtin_amdgcn_mfma_f32_16x16x32_bf16(fa, fb, m, 0, 0, 0);
            }
            if (w4 == 0) {
                float* mf = (float*)(lds + MFA);
#pragma unroll
                for (int j = 0; j < 4; ++j) mf[(fr * 4 + j) * 4 + fq] = (4 * fq + j < fr) ? m[j] : 0.f;
            } else if (w4 == 1) {
                const float m0 = (4 * fq + 0 < fr) ? m[0] : 0.f, m1 = (4 * fq + 1 < fr) ? m[1] : 0.f, m2 = (4 * fq + 2 < fr) ? m[2] : 0.f, m3 = (4 * fq + 3 < fr) ? m[3] : 0.f;
                const unsigned h01 = pk_bf16(m0, m1), h23 = pk_bf16(m2, m3);
                *(uint2*)(lds + MFK + (fr * 4 + fq) * 8) = make_uint2(h01, h23);
                *(uint2*)(lds + MFK + 512 + (fr * 4 + fq) * 8) = make_uint2(pk_bf16(m0 - bf_lo(h01), m1 - bf_hi(h01)), pk_bf16(m2 - bf_lo(h23), m3 - bf_hi(h23)));
            } else {
                const float m0 = (4 * fq + 0 <= fr) ? m[0] : 0.f, m1 = (4 * fq + 1 <= fr) ? m[1] : 0.f, m2 = (4 * fq + 2 <= fr) ? m[2] : 0.f, m3 = (4 * fq + 3 <= fr) ? m[3] : 0.f;
                const uint2 o = make_uint2(pk_bf16(m0, m1), pk_bf16(m2, m3));
                const int colb = (w4 == 2 ? 0 : 16) + 4 * fq;
                *(uint2*)(lds + NT + tb + tile_off(fr, colb >> 3) + (colb & 7) * 2) = o;
                if (w4 == 2) *(uint2*)(lds + NT + tb + tile_off(fr, (32 + 4 * fq) >> 3) + ((32 + 4 * fq) & 7) * 2) = o;
            }
        };
        auto step_rec = [&](int c) {
            const int v = tid >> 2, pq = tid & 3;
            float cc[16];
#pragma unroll
            for (int i = 0; i < 4; ++i) { const float4 q = *(const float4*)(lds + X0 + (v * 16 + 4 * i) * 4); cc[4 * i] = q.x; cc[4 * i + 1] = q.y; cc[4 * i + 2] = q.z; cc[4 * i + 3] = q.w; }
            float4 ma[16];
#pragma unroll
            for (int t = 1; t < 16; ++t) ma[t] = *(const float4*)(lds + MFA + ((t * 4 + pq) * 4) * 4);
            ma[0] = make_float4(0.f, 0.f, 0.f, 0.f);
            float uown[4] = {0.f, 0.f, 0.f, 0.f}, uall[16];
#pragma unroll
            for (int t = 0; t < 16; ++t) {
                float s = uown[0] * ma[t].x; s = fmaf(uown[1], ma[t].y, s); s = fmaf(uown[2], ma[t].z, s); s = fmaf(uown[3], ma[t].w, s);
                s += dpp_quad<0xB1>(s); s += dpp_quad<0x4E>(s);
                const float u = cc[t] + s;
                uall[t] = u;
                if (pq == (t & 3)) uown[t >> 2] = u;
            }
            if (pq < 2) {
                unsigned o[8];
#pragma unroll
                for (int i = 0; i < 8; ++i) {
                    const unsigned hi = pk_bf16(uall[2 * i], uall[2 * i + 1]);
                    o[i] = pq ? pk_bf16(uall[2 * i] - bf_lo(hi), uall[2 * i + 1] - bf_hi(hi)) : hi;
                }
                const int cb = pq ? 4 : 0;
                *(uint4*)(lds + UV + (c & 1) * 8192 + tile_off2(v, cb)) = make_uint4(o[0], o[1], o[2], o[3]);
                *(uint4*)(lds + UV + (c & 1) * 8192 + tile_off2(v, cb + 1)) = make_uint4(o[4], o[5], o[6], o[7]);
            }
        };
        f32x4 accS[2];
        accS[0] = (f32x4){0.f, 0.f, 0.f, 0.f}; accS[1] = (f32x4){0.f, 0.f, 0.f, 0.f};
        auto step_upd = [&](int c) {
            const int vt = wv & 3;
            bf16x8 fuv[2];
#pragma unroll
            for (int ks = 0; ks < 2; ++ks) fuv[ks] = *(const bf16x8*)(lds + UV + (c & 1) * 8192 + tile_off2(vt * 16 + fr, ks * 4 + fq));
            if (wv < 4) {
#pragma unroll
                for (int ks = 0; ks < 2; ++ks) accY = __builtin_amdgcn_mfma_f32_16x16x32_bf16(fuv[ks], *(const bf16x8*)(lds + NT + (c & 1) * 2048 + tile_off(fr, ks * 4 + fq)), accY, 0, 0, 0);
                *(float4*)(lds + YB + (fr * 64 + vt * 16 + 4 * fq) * 4) = make_float4(accY[0], accY[1], accY[2], accY[3]);
            }
#pragma unroll
            for (int k2 = 0; k2 < 2; ++k2) {
                const int kt = 2 * (wv >> 2) + k2;
                f32x4 a = accS[k2];
#pragma unroll
                for (int ks = 0; ks < 2; ++ks) a = __builtin_amdgcn_mfma_f32_16x16x32_bf16(*(const bf16x8*)(lds + BKT + (c & 1) * 8192 + tile_off2(kt * 16 + fr, ks * 4 + fq)), fuv[ks], a, 0, 0, 0);
                const float4 pl = *(const float4*)(lds + PL + (c & 3) * 256 + (kt * 16 + 4 * fq) * 4);
                a[0] *= pl.x; a[1] *= pl.y; a[2] *= pl.z; a[3] *= pl.w;
                accS[k2] = a;
                const unsigned h01 = pk_bf16(a[0], a[1]), h23 = pk_bf16(a[2], a[3]);
                const unsigned l01 = pk_bf16(a[0] - bf_lo(h01), a[1] - bf_hi(h01)), l23 = pk_bf16(a[2] - bf_lo(h23), a[3] - bf_hi(h23));
                const int kc = kt * 16 + 4 * fq;
                const int so = tile_off(vt * 16 + fr, kc >> 3) + (kc & 7) * 2;
                *(uint2*)(lds + SH + so) = make_uint2(h01, h23);
                *(uint2*)(lds + SL + so) = make_uint2(l01, l23);
            }
        };
        for (int i = tid; i < LDS_END / 16; i += NTHREADS) *(uint4*)(lds + i * 16) = make_uint4(0, 0, 0, 0);
        if (wv >= 4) { load_lora(0); load_rkv(0); }
        __syncthreads();
        if (wv >= 4) { step_up(0); load_lora(1); }
        __syncthreads();
        if (wv >= 4) { step_vec(0); step_up(1); load_rkv(1); load_lora(2); }
        __syncthreads();
        if (wv >= 4) prod_V(0);
        __syncthreads();
        auto ystore = [&](int c) {
            const float4 y4 = *(const float4*)(lds + YB + (s_e * 64 + j0) * 4);
            *(uint2*)(ydst + (size_t)Rof(c, s_e) * 1024 + hh * 64 + j0) = make_uint2(pk_bf16(y4.x, y4.y), pk_bf16(y4.z, y4.w));
        };
        if (wv < 4) {
            unsigned pfd = 0;
            for (int c = 0; c < 528; ++c) {
                if (c > 0) ystore(c - 1);
                if (c + 4 < 528 && tid < 80) {
                    const bf16_t* pf;
                    if (tid < 48) { const int ten = tid >> 4; pf = (ten == 0 ? rbuf : (ten == 1 ? kbuf : vbuf)) + (size_t)Rof(c + 4, tid & 15) * 1024 + hh * 64; }
                    else { const int i = tid - 48; pf = lora + (size_t)Rof(c + 4, i >> 1) * 384 + (i & 1) * 128 + d * 64; }
                    asm volatile("global_load_dword %0, %1, off" : "=v"(pfd) : "v"(pf) : "memory");
                }
                __builtin_amdgcn_s_setprio(3);
                prod_S(c);
                step_rec(c);
                __builtin_amdgcn_s_setprio(0);
                __syncthreads();
                step_upd(c);
                __syncthreads();
                asm volatile("" :: "v"(pfd));
            }
        } else {
            for (int c = 0; c < 528; ++c) {
                if (c + 1 < 528) step_vec(c + 1);
                if (c + 2 < 528) { step_up(c + 2); load_rkv(c + 2); }
                if (c + 3 < 528) load_lora(c + 3);
                __syncthreads();
                step_upd(c);
                if (c + 1 < 528) prod_V(c + 1);
                __syncthreads();
            }
        }
        if (wv < 4) ystore(527);
        __syncthreads();
    }
}

DEV void phase_rw_readout(const Params& p) {
    const int tid = tid_opaque(), lane = tid & 63, wv = tid >> 6, wm = wv >> 2, wn = wv & 3;
    const int fr = lane & 15, fq = lane >> 4;
    unsigned char* ws = p.ws;
    const bf16_t* y0b = (const bf16_t*)(ws + WS_S + 0 * U_BYTES);
    const bf16_t* y1b = (const bf16_t*)(ws + WS_S + 2 * U_BYTES);
    const bf16_t* vb = (const bf16_t*)(ws + WS_S + 1 * U_BYTES);
    const bf16_t* lora = (const bf16_t*)(ws + WS_S + 4 * U_BYTES);
    const bf16_t* g2t = (const bf16_t*)(ws + WS_G2T);
    bf16_t* ao = (bf16_t*)(ws + WS_S + 5 * U_BYTES);
    const float* bon0 = (const float*)(ws + WS_BONUS);
    const float* bon1 = bon0 + (size_t)NB * 16 * 8448;
    const float* lnw = p.in[21];
    const float* lnb = p.in[22];
    const int nunits = (NT / 128) * 4;
    for (int u = blockIdx.x; u < nunits; u += gridDim.x) {
        const int mt = u >> 2, nt = u & 3, m0 = mt * 128;
        const int hh = nt * 4 + wn;
        f32x4 acc[4][4];
#pragma unroll
        for (int mi = 0; mi < 4; ++mi)
#pragma unroll
            for (int ni = 0; ni < 4; ++ni) acc[mi][ni] = (f32x4){0.f, 0.f, 0.f, 0.f};
#pragma unroll 2
        for (int ks = 0; ks < 4; ++ks) {
            bf16x8 af[4], bfr[4];
#pragma unroll
            for (int mi = 0; mi < 4; ++mi) af[mi] = *(const bf16x8*)(lora + (size_t)(m0 + wm * 64 + mi * 16 + fr) * 384 + 256 + ks * 32 + fq * 8);
#pragma unroll
            for (int ni = 0; ni < 4; ++ni) bfr[ni] = *(const bf16x8*)(g2t + (size_t)(hh * 64 + ni * 16 + fr) * 128 + ks * 32 + fq * 8);
#pragma unroll
            for (int mi = 0; mi < 4; ++mi)
#pragma unroll
                for (int ni = 0; ni < 4; ++ni) acc[mi][ni] = __builtin_amdgcn_mfma_f32_16x16x32_bf16(bfr[ni], af[mi], acc[mi][ni], 0, 0, 0);
        }
#pragma unroll
        for (int mi = 0; mi < 4; ++mi) {
            const size_t R = (size_t)(m0 + wm * 64 + mi * 16 + fr);
            float yv[4][4]; float sum = 0.f;
#pragma unroll
            for (int ni = 0; ni < 4; ++ni) {
                const int col = hh * 64 + ni * 16 + 4 * fq;
                const uint2 a = *(const uint2*)(y0b + R * 1024 + col), b2 = *(const uint2*)(y1b + R * 1024 + col);
                yv[ni][0] = bf_lo(a.x) + bf_lo(b2.x); yv[ni][1] = bf_hi(a.x) + bf_hi(b2.x); yv[ni][2] = bf_lo(a.y) + bf_lo(b2.y); yv[ni][3] = bf_hi(a.y) + bf_hi(b2.y);
                sum += (yv[ni][0] + yv[ni][1]) + (yv[ni][2] + yv[ni][3]);
            }
            sum += __shfl_xor(sum, 16); sum += __shfl_xor(sum, 32);
            const float mu = sum * (1.0f / 64.0f);
            float q = 0.f;
#pragma unroll
            for (int ni = 0; ni < 4; ++ni)
#pragma unroll
                for (int j = 0; j < 4; ++j) { const float dlt = yv[ni][j] - mu; q += dlt * dlt; }
            q += __shfl_xor(q, 16); q += __shfl_xor(q, 32);
            const float rstd = rsqrtf(q * (1.0f / 64.0f) + 64e-5f);
            const size_t bidx = (size_t)(((R < NL ? (R >> 13) : ((R - NL) >> 8)) * 16 + hh)) * 8448 + (R < NL ? 256 + (R & 8191) : ((R - NL) & 255));
            const float bs = bon0[bidx] + bon1[bidx];
#pragma unroll
            for (int ni = 0; ni < 4; ++ni) {
                const int col = hh * 64 + ni * 16 + 4 * fq;
                const uint2 vv = *(const uint2*)(vb + R * 1024 + col);
                const float4 lw = *(const float4*)(lnw + col), lb = *(const float4*)(lnb + col);
                const float o0 = ((yv[ni][0] - mu) * rstd * lw.x + lb.x + bs * bf_lo(vv.x)) * acc[mi][ni][0];
                const float o1 = ((yv[ni][1] - mu) * rstd * lw.y + lb.y + bs * bf_hi(vv.x)) * acc[mi][ni][1];
                const float o2 = ((yv[ni][2] - mu) * rstd * lw.z + lb.z + bs * bf_lo(vv.y)) * acc[mi][ni][2];
                const float o3 = ((yv[ni][3] - mu) * rstd * lw.w + lb.w + bs * bf_hi(vv.y)) * acc[mi][ni][3];
                *(uint2*)(ao + R * 1024 + col) = make_uint2(pk_bf16(o0, o1), pk_bf16(o2, o3));
            }
        }
    }
}

DEV void phase_wo(const Params& p, unsigned char* lds, int layer) {
    unsigned char* ws = p.ws;
    const bf16_t* ao = (const bf16_t*)(ws + WS_S + (size_t)(layer ? 0 : 5) * U_BYTES);
    const bf16_t* wot = (const bf16_t*)(ws + (layer ? WS_WO1 : WS_WO0));
    float* ctxr = (float*)(ws + WS_CTXR);
    const float* gate = (const float*)(ws + WS_MOD) + (size_t)layer * 9 * 6144 + 2 * 1024;
    const int M = layer ? NL : NT;
    pg8::Gemm g{ao, wot, M, 1024, 1024};
    pg8::StaticOrder so; so.init(M, 1024, gridDim.x, blockIdx.x);
    pg8::EpiResid256 ep{layer ? p.out : p.in[0], layer ? ctxr : p.in[2], p.out, ctxr, gate};
    pg8::gemm_phase((PG8_LAS unsigned char*)lds, g, so, ep, nullptr);
    __syncthreads();
}

struct EpiQTile {
    unsigned char* lds;
    DEV void operator()(const f32x4 (&acc)[4][4], int m0, int wm, int wn, int fr, int fq) const {
        const int pp = wn >> 1;
#pragma unroll
        for (int mi = 0; mi < 4; ++mi) {
            const int m = wm * 64 + mi * 16 + fr;
#pragma unroll
            for (int ni = 0; ni < 4; ++ni) {
                const int c = (wn & 1) * 64 + ni * 16 + 4 * fq;
                *(uint2*)(lds + pp * 32768 + m * 256 + (((c >> 3) ^ (m & 15)) << 4) + (c & 7) * 2) = make_uint2(pk_bf16(acc[mi][ni][0], acc[mi][ni][1]), pk_bf16(acc[mi][ni][2], acc[mi][ni][3]));
            }
        }
    }
};
DEV void phase_peer_select(const Params& p, unsigned char* lds, int layer) {
    const int tid = tid_opaque(), lane = tid & 63, wv = tid >> 6, wm = wv >> 2, wn = wv & 3;
    const int fr = lane & 15, fq = lane >> 4;
    unsigned char* ws = p.ws;
    const bf16_t* hp = (const bf16_t*)(ws + WS_S + (size_t)(layer ? 0 : 1) * U_BYTES);
    const bf16_t* wqt = (const bf16_t*)(ws + WS_WQ) + (size_t)layer * 2048 * 1024;
    const bf16_t* keys = (const bf16_t*)(ws + WS_KEYS) + (size_t)layer * 8 * 2 * 128 * 128;
    int* pl_idx = (int*)(ws + WS_S + 3 * U_BYTES);
    float* pl_gate = (float*)(ws + WS_S + 3 * U_BYTES + (size_t)NT * 128 * 4);
    unsigned* slist = (unsigned*)lds;
    unsigned* tlist = (unsigned*)(lds + 256 * 132 * 4);
    const int mtiles = layer ? NL / 128 : NT / 128;
    for (int u = blockIdx.x; u < mtiles * 8; u += gridDim.x) {
        const int mt = u >> 3, head = u & 7, m0 = mt * 128;
        ALoadPlain al{hp, 1024};
        EpiQTile ep{lds};
        gemm_unit<256>(lds, al, wqt + (size_t)head * 256 * 1024, 1024, m0, ep);
        __syncthreads();
        const int pp = wn >> 1, nk0 = (wn & 1) * 64;
        f32x4 sc[4][4];
#pragma unroll
        for (int mi = 0; mi < 4; ++mi)
#pragma unroll
            for (int ni = 0; ni < 4; ++ni) sc[mi][ni] = (f32x4){0.f, 0.f, 0.f, 0.f};
        const bf16_t* kb = keys + (size_t)(head * 2 + pp) * 16384;
#pragma unroll
        for (int ks = 0; ks < 4; ++ks) {
            bf16x8 af[4], bfr[4];
            const int ch = ks * 4 + fq;
#pragma unroll
            for (int mi = 0; mi < 4; ++mi) { const int m = wm * 64 + mi * 16 + fr; af[mi] = *(const bf16x8*)(lds + pp * 32768 + m * 256 + ((ch ^ (m & 15)) << 4)); }
#pragma unroll
            for (int ni = 0; ni < 4; ++ni) bfr[ni] = *(const bf16x8*)(kb + (size_t)(nk0 + ni * 16 + fr) * 128 + ks * 32 + fq * 8);
#pragma unroll
            for (int mi = 0; mi < 4; ++mi)
#pragma unroll
                for (int ni = 0; ni < 4; ++ni) sc[mi][ni] = __builtin_amdgcn_mfma_f32_16x16x32_bf16(bfr[ni], af[mi], sc[mi][ni], 0, 0, 0);
        }
        __syncthreads();
#pragma unroll
        for (int mi = 0; mi < 4; ++mi) {
            const int m = wm * 64 + mi * 16 + fr;
#pragma unroll
            for (int ni = 0; ni < 4; ++ni) {
                const int n = nk0 + ni * 16 + 4 * fq;
                uint4 o;
                o.x = (mono_u32(sc[mi][ni][0]) & ~127u) | (unsigned)(127 - (n + 0));
                o.y = (mono_u32(sc[mi][ni][1]) & ~127u) | (unsigned)(127 - (n + 1));
                o.z = (mono_u32(sc[mi][ni][2]) & ~127u) | (unsigned)(127 - (n + 2));
                o.w = (mono_u32(sc[mi][ni][3]) & ~127u) | (unsigned)(127 - (n + 3));
                *(uint4*)(slist + (size_t)(pp * 128 + m) * 132 + n) = o;
            }
        }
        __syncthreads();
#pragma unroll 1
        for (int ps = 0; ps < 4; ++ps) {
            const int L = ps * 64 + (tid >> 3), g8 = tid & 7;
            unsigned t[16];
            {
                const unsigned* srcp = slist + (size_t)L * 132 + g8 * 16;
#pragma unroll
                for (int i = 0; i < 4; ++i) { const uint4 v = *(const uint4*)(srcp + i * 4); t[4 * i] = v.x; t[4 * i + 1] = v.y; t[4 * i + 2] = v.z; t[4 * i + 3] = v.w; }
            }
#pragma unroll
            for (int k = 2; k <= 16; k <<= 1)
#pragma unroll
                for (int j = k >> 1; j > 0; j >>= 1)
#pragma unroll
                    for (int i = 0; i < 16; ++i) {
                        const int l = i ^ j;
                        if (l > i) {
                            const unsigned mx = max(t[i], t[l]), mn = min(t[i], t[l]);
                            if ((i & k) == 0) { t[i] = mx; t[l] = mn; } else { t[i] = mn; t[l] = mx; }
                        }
                    }
#pragma unroll
            for (int rnd = 0; rnd < 3; ++rnd) {
                unsigned c[16];
#pragma unroll
                for (int i = 0; i < 16; ++i) {
                    const int src_i = __float_as_int(__uint_as_float(t[15 - i]));
                    const int b = rnd == 0 ? __builtin_amdgcn_update_dpp(0, src_i, 0xB1, 0xF, 0xF, false)
                                : (rnd == 1 ? __builtin_amdgcn_update_dpp(0, src_i, 0x4E, 0xF, 0xF, false)
                                            : __builtin_amdgcn_update_dpp(0, src_i, 0x141, 0xF, 0xF, false));
                    c[i] = max(t[i], (unsigned)b);
                }
#pragma unroll
                for (int j = 8; j > 0; j >>= 1)
#pragma unroll
                    for (int i = 0; i < 16; ++i) {
                        const int l = i ^ j;
                        if (l > i) { const unsigned mx = max(c[i], c[l]), mn = min(c[i], c[l]); c[i] = mx; c[l] = mn; }
                    }
#pragma unroll
                for (int i = 0; i < 16; ++i) t[i] = c[i];
            }
            if (g8 == 0) {
#pragma unroll
                for (int i = 0; i < 4; ++i) *(uint4*)(tlist + L * 16 + i * 4) = make_uint4(t[4 * i], t[4 * i + 1], t[4 * i + 2], t[4 * i + 3]);
            }
        }
        __syncthreads();
        if (tid < 128) {
            float v0[16], v1[16];
#pragma unroll
            for (int i = 0; i < 16; ++i) { v0[i] = unmono_u32(tlist[tid * 16 + i] & ~127u); v1[i] = unmono_u32(tlist[(128 + tid) * 16 + i] & ~127u); }
            unsigned cd[16];
#pragma unroll
            for (int i = 0; i < 16; ++i) cd[i] = 0u;
#pragma unroll
            for (int i = 0; i < 16; ++i) {
#pragma unroll
                for (int j = 0; j < 16; ++j) {
                    if ((i + 1) * (j + 1) <= 16) {
                        unsigned x = (mono_u32(v0[i] + v1[j]) & ~255u) | (unsigned)(255 - (i * 16 + j));
#pragma unroll
                        for (int q = 0; q < 16; ++q) { const unsigned mx = max(cd[q], x); x = min(cd[q], x); cd[q] = mx; }
                    }
                }
            }
            float sv[16]; int ex[16];
#pragma unroll
            for (int q = 0; q < 16; ++q) {
                const int slot = 255 - (int)(cd[q] & 255u);
                const unsigned a = tlist[tid * 16 + (slot >> 4)], b2 = tlist[(128 + tid) * 16 + (slot & 15)];
                sv[q] = unmono_u32(a & ~127u) + unmono_u32(b2 & ~127u);
                ex[q] = (127 - (int)(a & 127u)) * 128 + (127 - (int)(b2 & 127u));
            }
            float mx = sv[0];
#pragma unroll
            for (int q = 1; q < 16; ++q) mx = fmaxf(mx, sv[q]);
            float den = 0.f;
#pragma unroll
            for (int q = 0; q < 16; ++q) { sv[q] = __expf(sv[q] - mx); den += sv[q]; }
            const float rden = 1.0f / den;
            const size_t base = ((size_t)head * NT + (m0 + tid)) * 16;
#pragma unroll
            for (int i = 0; i < 4; ++i) {
                *(int4*)(pl_idx + base + i * 4) = make_int4(ex[4 * i], ex[4 * i + 1], ex[4 * i + 2], ex[4 * i + 3]);
                *(float4*)(pl_gate + base + i * 4) = make_float4(sv[4 * i] * rden, sv[4 * i + 1] * rden, sv[4 * i + 2] * rden, sv[4 * i + 3] * rden);
            }
        }
        __syncthreads();
    }
}

typedef float f32x2 __attribute__((ext_vector_type(2)));
typedef unsigned int u32x4 __attribute__((ext_vector_type(4)));
typedef unsigned int u32x2 __attribute__((ext_vector_type(2)));
#define PS_LOAD(buf, ee, h) { _Pragma("unroll") for (int e = 0; e < 8; ++e) { \
        const u32x4 t4 = __builtin_amdgcn_raw_buffer_load_b128(rs, ((unsigned)ee[(h) * 8 + e] << 7) + ch16, 0, 0); buf[e] = make_uint4(t4.x, t4.y, t4.z, t4.w); } }
#define PS_IDX(ee, Rr) { _Pragma("unroll") for (int i = 0; i < 4; ++i) { const int4 t = *(const int4*)(pl_idx + ((size_t)sub * NT + (Rr)) * 16 + 4 * i); \
        ee[4 * i] = t.x; ee[4 * i + 1] = t.y; ee[4 * i + 2] = t.z; ee[4 * i + 3] = t.w; } }
DEV long pk64(unsigned lo, unsigned hi) { return (long)(((unsigned long long)hi << 32) | (unsigned long long)lo); }
DEV void phase_peer_u(const Params& p, unsigned char* lds, int layer) {
    const int tid = tid_opaque(), lane = tid & 63, wv = tid >> 6, sub = lane >> 3, ch = lane & 7, fm = lane & 15, fg = lane >> 4;
    const int ng = gridDim.x >> 3, x = blockIdx.x & 7, wq = blockIdx.x >> 3;
    if (wq < ng) {
        const int gw = __builtin_amdgcn_readfirstlane(wq * 8 + wv), nw = ng * 8;
        unsigned char* ws = p.ws;
        const unsigned char* tab = ws + WS_PU + ((size_t)layer * 8 + x) * (16384 * 128);
        const int* pl_idx = (const int*)(ws + WS_S + 3 * U_BYTES);
        const unsigned char* xq = ws + WS_S + 2 * U_BYTES + (size_t)(fm & 1) * 1024 + 128 * x + 16 * fg;
        float* pd = (float*)(ws + WS_S + 4 * U_BYTES) + (size_t)x * NT * 128 + 16 * (fm >> 1) + 4 * fg;
        unsigned char* tile = lds + wv * 16384;
        const unsigned cE16 = 16u * (unsigned)(ch ^ (sub >> 1)), cO16 = cE16 ^ 64u;
        const unsigned aoff0 = (unsigned)fm * 128u + (unsigned)((fg ^ (fm >> 1)) << 4), aoff1 = (unsigned)fm * 128u + (unsigned)(((4 + fg) ^ (fm >> 1)) << 4);
        const int nrows = layer ? NL : NT;
        int eN[16];
#define PU_DMA(ee, q) { _Pragma("unroll") for (int j = 0; j < 4; ++j) { const int jj = (q) * 4 + j; \
        __builtin_amdgcn_global_load_lds((const unsigned*)(tab + (((unsigned)ee[jj] << 7) + ((jj & 1) ? cO16 : cE16))), (unsigned*)(tile + jj * 1024 + lane * 16), 16, 0, 0); } }
        const unsigned ta0 = (unsigned)(size_t)((LAS3 unsigned char*)tile) + aoff0, ta1 = (unsigned)(size_t)((LAS3 unsigned char*)tile) + aoff1;
#define PU_MMA(q) { u32x4 a0, a1, a2, a3; \
        asm volatile("ds_read_b128 %0, %4 offset:%6\n\tds_read_b128 %1, %5 offset:%6\n\tds_read_b128 %2, %4 offset:%7\n\tds_read_b128 %3, %5 offset:%7\n\ts_waitcnt lgkmcnt(0)" \
            : "=&v"(a0), "=&v"(a1), "=&v"(a2), "=&v"(a3) : "v"(ta0), "v"(ta1), "n"((q) * 4096), "n"((q) * 4096 + 2048) : "memory"); \
        f32x4 c4 = {0.f, 0.f, 0.f, 0.f}, c5 = {0.f, 0.f, 0.f, 0.f}; \
        c4 = __builtin_amdgcn_mfma_f32_16x16x32_fp8_fp8(pk64(a0.x, a0.y), pk64(bC0.x, bC0.y), c4, 0, 0, 0); \
        c5 = __builtin_amdgcn_mfma_f32_16x16x32_fp8_fp8(pk64(a2.x, a2.y), pk64(bC0.x, bC0.y), c5, 0, 0, 0); \
        c4 = __builtin_amdgcn_mfma_f32_16x16x32_fp8_fp8(pk64(a0.z, a0.w), pk64(bC0.z, bC0.w), c4, 0, 0, 0); \
        c5 = __builtin_amdgcn_mfma_f32_16x16x32_fp8_fp8(pk64(a2.z, a2.w), pk64(bC0.z, bC0.w), c5, 0, 0, 0); \
        c4 = __builtin_amdgcn_mfma_f32_16x16x32_fp8_fp8(pk64(a1.x, a1.y), pk64(bC1.x, bC1.y), c4, 0, 0, 0); \
        c5 = __builtin_amdgcn_mfma_f32_16x16x32_fp8_fp8(pk64(a3.x, a3.y), pk64(bC1.x, bC1.y), c5, 0, 0, 0); \
        c4 = __builtin_amdgcn_mfma_f32_16x16x32_fp8_fp8(pk64(a1.z, a1.w), pk64(bC1.z, bC1.w), c4, 0, 0, 0); \
        c5 = __builtin_amdgcn_mfma_f32_16x16x32_fp8_fp8(pk64(a3.z, a3.w), pk64(bC1.z, bC1.w), c5, 0, 0, 0); \
        acc[(q) * 2] = c4; acc[(q) * 2 + 1] = c5; }
        int R = gw;
#pragma unroll
        for (int i = 0; i < 16; ++i) eN[i] = 0;
        uint4 bC0 = make_uint4(0, 0, 0, 0), bC1 = bC0;
        if (R < nrows) {
            PS_IDX(eN, R);
            PU_DMA(eN, 0); PU_DMA(eN, 1); PU_DMA(eN, 2); PU_DMA(eN, 3);
            bC0 = *(const uint4*)(xq + (size_t)R * 2048); bC1 = *(const uint4*)(xq + (size_t)R * 2048 + 64);
            const int R1 = min(R + nw, nrows - 1);
            PS_IDX(eN, R1);
            asm volatile("s_waitcnt vmcnt(0)" : "+v"(bC0.x), "+v"(bC1.x), "+v"(eN[0]), "+v"(eN[4]), "+v"(eN[8]), "+v"(eN[12]) :: "memory");
        }
        for (; R < nrows; R += nw) {
            const int Rn = R + nw, R1 = min(Rn, nrows - 1), R2 = min(Rn + nw, nrows - 1);
            const bool more = Rn < nrows;
            u32x4 i0, i1, i2, i3, nb0, nb1;
            {
                const int* iptr = pl_idx + ((size_t)sub * NT + R2) * 16;
                const unsigned char* xptr = xq + (size_t)R1 * 2048;
                asm volatile("global_load_dwordx4 %0, %6, off\n\tglobal_load_dwordx4 %1, %6, off offset:16\n\tglobal_load_dwordx4 %2, %6, off offset:32\n\tglobal_load_dwordx4 %3, %6, off offset:48\n\t"
                             "global_load_dwordx4 %4, %7, off\n\tglobal_load_dwordx4 %5, %7, off offset:64"
                             : "=&v"(i0), "=&v"(i1), "=&v"(i2), "=&v"(i3), "=&v"(nb0), "=&v"(nb1) : "v"(iptr), "v"(xptr) : "memory");
            }
            f32x4 acc[8];
#define PU_STEP(q) { if (more) asm volatile("s_waitcnt vmcnt(19)" ::: "memory"); else asm volatile("s_waitcnt vmcnt(0)" ::: "memory"); \
            PU_MMA(q); if (more) { PU_DMA(eN, q); } }
            PU_STEP(0); PU_STEP(1); PU_STEP(2); PU_STEP(3);
            f32x4 s0[4], s1[2], s2;
#pragma unroll
            for (int i = 0; i < 4; ++i)
#pragma unroll
                for (int r = 0; r < 4; ++r) s0[i][r] = (fm & 2) ? acc[2 * i + 1][r] : acc[2 * i][r];
#pragma unroll
            for (int i = 0; i < 2; ++i)
#pragma unroll
                for (int r = 0; r < 4; ++r) s1[i][r] = (fm & 4) ? s0[2 * i + 1][r] : s0[2 * i][r];
#pragma unroll
            for (int r = 0; r < 4; ++r) { const float t = (fm & 8) ? s1[1][r] : s1[0][r]; s2[r] = t + dpp_quad<0xB1>(t); }
            if (!(fm & 1)) *(float4*)(pd + (size_t)R * 128) = make_float4(s2[0], s2[1], s2[2], s2[3]);
            if (more) asm volatile("s_waitcnt vmcnt(17)" : "+v"(i0), "+v"(i1), "+v"(i2), "+v"(i3), "+v"(nb0), "+v"(nb1) :: "memory");
            else asm volatile("s_waitcnt vmcnt(0)" : "+v"(i0), "+v"(i1), "+v"(i2), "+v"(i3), "+v"(nb0), "+v"(nb1) :: "memory");
            eN[0] = i0.x; eN[1] = i0.y; eN[2] = i0.z; eN[3] = i0.w; eN[4] = i1.x; eN[5] = i1.y; eN[6] = i1.z; eN[7] = i1.w;
            eN[8] = i2.x; eN[9] = i2.y; eN[10] = i2.z; eN[11] = i2.w; eN[12] = i3.x; eN[13] = i3.y; eN[14] = i3.z; eN[15] = i3.w;
            bC0 = make_uint4(nb0.x, nb0.y, nb0.z, nb0.w); bC1 = make_uint4(nb1.x, nb1.y, nb1.z, nb1.w);
        }
        asm volatile("s_waitcnt vmcnt(0)" ::: "memory");
    }
}
DEV void phase_peer_c(const Params& p, int layer) {
    const int tid = tid_opaque(), lane = tid & 63;
    const int gw = blockIdx.x * 8 + (tid >> 6), nw = gridDim.x * 8;
    unsigned char* ws = p.ws;
    const float* usc = (const float*)(ws + WS_PSC) + layer * 16384;
    const float* vsc = (const float*)(ws + WS_PSC) + 32768 + layer * 16384;
    const int* pl_idx = (const int*)(ws + WS_S + 3 * U_BYTES);
    const float* pl_gate = (const float*)(ws + WS_S + 3 * U_BYTES + (size_t)NT * 128 * 4);
    float* pd = (float*)(ws + WS_S + 4 * U_BYTES);
    const int nrows = layer ? NL : NT;
    const int head0 = 2 * (lane & 3), kk = lane >> 2;
    for (int R = gw; R < nrows; R += nw) {
        float d0 = 0.f, d1 = 0.f;
#pragma unroll
        for (int xx = 0; xx < 8; ++xx) { const float2 t = *(const float2*)(pd + ((size_t)xx * NT + R) * 128 + 2 * lane); d0 += t.x; d1 += t.y; }
        const size_t po = ((size_t)head0 * NT + R) * 16 + kk;
        const int e0 = pl_idx[po], e1 = pl_idx[po + (size_t)NT * 16];
        const float g0 = pl_gate[po], g1 = pl_gate[po + (size_t)NT * 16];
        d0 *= usc[e0] * 0.25f; d1 *= usc[e1] * 0.25f;
        const float c0 = g0 * vsc[e0] * 0.5f * d0 * (1.0f + erff(d0 * 0.70710678118f));
        const float c1 = g1 * vsc[e1] * 0.5f * d1 * (1.0f + erff(d1 * 0.70710678118f));
        pd[(size_t)R * 128 + 16 * head0 + kk] = c0;
        pd[(size_t)R * 128 + 16 * head0 + 16 + kk] = c1;
    }
}
DEV void phase_peer_v(const Params& p, int layer) {
    const int tid = tid_opaque(), lane = tid & 63, sub = lane >> 3, ch = lane & 7;
    const int ng = gridDim.x >> 3, x = blockIdx.x & 7, wq = blockIdx.x >> 3;
    if (wq < ng) {
        const int gw = __builtin_amdgcn_readfirstlane(wq * 8 + (tid >> 6)), nw = ng * 8;
        unsigned char* ws = p.ws;
        const __amdgpu_buffer_rsrc_t rs = __builtin_amdgcn_make_buffer_rsrc((void*)(ws + WS_PV + ((size_t)layer * 8 + x) * (16384 * 128)), 0, 16384 * 128, 0x00020000);
        const int* pl_idx = (const int*)(ws + WS_S + 3 * U_BYTES);
        const float* cb = (const float*)(ws + WS_S + 4 * U_BYTES) + 16 * sub;
        float* ctxr = (float*)(ws + WS_CTXR);
        const float* mods = (const float*)(ws + WS_MOD) + (size_t)layer * 9 * 6144 + 5 * 1024;
        const unsigned ch16 = 16u * (unsigned)ch;
        const int col = 128 * x + 16 * ch + 2 * sub;
        const int nrows = layer ? NL : NT;
        uint4 bufA[8], bufB[8];
        int eC[16], eN[16];
        float cC[16], cN[16];
#define PS_CF(cc, Rr) { _Pragma("unroll") for (int i = 0; i < 4; ++i) { const float4 t = *(const float4*)(cb + (size_t)(Rr) * 128 + 4 * i); \
        cc[4 * i] = t.x; cc[4 * i + 1] = t.y; cc[4 * i + 2] = t.z; cc[4 * i + 3] = t.w; } }
#define PV_FMA(accv, av) asm("v_fma_f32 %0, %1, %2, %0" : "+v"(accv) : "v"(cf), "v"(av))
#define PV_AXPY(buf, h) { _Pragma("unroll") for (int e = 0; e < 8; ++e) { \
        const float cf = cC[(h) * 8 + e]; const unsigned vw[4] = {buf[e].x, buf[e].y, buf[e].z, buf[e].w}; \
        _Pragma("unroll") for (int i = 0; i < 4; ++i) { \
            const f32x2 a = __builtin_amdgcn_cvt_pk_f32_fp8((int)vw[i], false), b2 = __builtin_amdgcn_cvt_pk_f32_fp8((int)vw[i], true); \
            PV_FMA(a16[4 * i], a.x); PV_FMA(a16[4 * i + 1], a.y); PV_FMA(a16[4 * i + 2], b2.x); PV_FMA(a16[4 * i + 3], b2.y); } } }
        int R = gw;
#pragma unroll
        for (int i = 0; i < 16; ++i) { eC[i] = 0; eN[i] = 0; cC[i] = 0.f; cN[i] = 0.f; }
        if (R < nrows) { PS_IDX(eC, R); PS_CF(cC, R); PS_LOAD(bufA, eC, 0); }
        for (; R < nrows; R += nw) {
            const int Rn = R + nw;
            if (Rn < nrows) { PS_IDX(eN, Rn); PS_CF(cN, Rn); }
            PS_LOAD(bufB, eC, 1);
            float* xrow = (R < NL ? p.out + (size_t)R * 1024 : ctxr + (size_t)(R - NL) * 1024) + col;
            const float2 xa = *(const float2*)xrow, ga = *(const float2*)(mods + (size_t)mod_batch(R) * 6144 + col);
            float a16[16];
#pragma unroll
            for (int i = 0; i < 16; ++i) a16[i] = 0.f;
            PV_AXPY(bufA, 0);
            if (Rn < nrows) { PS_LOAD(bufA, eN, 0); }
            PV_AXPY(bufB, 1);
            float s8[8], t4[4];
#pragma unroll
            for (int j = 0; j < 8; ++j) { const u32x2 r = __builtin_amdgcn_permlane32_swap(__float_as_uint(a16[j]), __float_as_uint(a16[8 + j]), false, false); s8[j] = __uint_as_float(r.x) + __uint_as_float(r.y); }
#pragma unroll
            for (int j = 0; j < 4; ++j) { const u32x2 r = __builtin_amdgcn_permlane16_swap(__float_as_uint(s8[j]), __float_as_uint(s8[4 + j]), false, false); t4[j] = __uint_as_float(r.x) + __uint_as_float(r.y); }
            const float wa0 = t4[0] + dpp_ror<8>(t4[0]), wa1 = t4[1] + dpp_ror<8>(t4[1]), wb0 = t4[2] + dpp_ror<8>(t4[2]), wb1 = t4[3] + dpp_ror<8>(t4[3]);
            const float w0 = (lane & 8) ? wb0 : wa0, w1 = (lane & 8) ? wb1 : wa1;
            *(float2*)xrow = make_float2(xa.x + ga.x * w0, xa.y + ga.y * w1);
#pragma unroll
            for (int i = 0; i < 16; ++i) { eC[i] = eN[i]; cC[i] = cN[i]; }
        }
    }
}
DEV void phase_final_norm(const Params& p) {
    const int tid = tid_opaque(), lane = tid & 63;
    const int gw = blockIdx.x * 8 + (tid >> 6), nw = gridDim.x * 8;
    const float* gn = p.in[34];
    for (int R = gw; R < NL; R += nw) {
        float* xr = p.out + (size_t)R * 1024;
        float4 v[4]; float ss = 0.f;
#pragma unroll
        for (int i = 0; i < 4; ++i) { v[i] = *(const float4*)(xr + i * 256 + lane * 4); ss += v[i].x * v[i].x + v[i].y * v[i].y + v[i].z * v[i].z + v[i].w * v[i].w; }
        ss = wave_allreduce(ss);
        const float rs = rsqrtf(ss * (1.0f / 1024.0f) + 1e-6f);
#pragma unroll
        for (int i = 0; i < 4; ++i) {
            const float4 gg = *(const float4*)(gn + i * 256 + lane * 4);
            *(float4*)(xr + i * 256 + lane * 4) = make_float4(v[i].x * rs * gg.x, v[i].y * rs * gg.y, v[i].z * rs * gg.z, v[i].w * rs * gg.w);
        }
    }
}

DEV void phase_gla_proj(const Params& p, unsigned char* lds) {
    unsigned char* ws = p.ws;
    const bf16_t* h = (const bf16_t*)(ws + WS_S + 0 * U_BYTES);
    const bf16_t* wint = (const bf16_t*)(ws + WS_WIN);
    {
        pg8::Gemm g{h, wint, NT, 3072, 1024};
        pg8::StaticOrder so; so.init(NT, 3072, gridDim.x, blockIdx.x);
        pg8::EpiBf16Tiles ep{(bf16_t*)(ws + WS_S + 1 * U_BYTES), 2048, 8, (bf16_t*)(ws + WS_S + 3 * U_BYTES), 1024};
        pg8::gemm_phase(( PG8_LAS unsigned char*)lds, g, so, ep, nullptr);
    }
    __syncthreads();
    for (int u = blockIdx.x; u < NT / 128; u += gridDim.x) {
        ALoadPlain al{h, 1024};
        EpiLr ep{(float*)(ws + WS_LR)};
        gemm_unit<128>(lds, al, wint + (size_t)3072 * 1024, 1024, u * 128, ep);
    }
}

DEV void conv_emit(const float (&acc)[8], int c, bf16_t* dst) {
    const float qs = (c < 512) ? 0.08838834764831845f : 1.0f;
    unsigned ow[4];
#pragma unroll
    for (int j = 0; j < 4; ++j) { const float a0 = acc[2 * j], a1 = acc[2 * j + 1]; ow[j] = pk_bf16(a0 * sigmoidf_(a0) * qs, a1 * sigmoidf_(a1) * qs); }
    *(uint4*)dst = make_uint4(ow[0], ow[1], ow[2], ow[3]);
}
DEV void conv_tap(float (&acc)[8], const uint4& v, const float (&w)[8]) {
    acc[0] += bf_lo(v.x) * w[0]; acc[1] += bf_hi(v.x) * w[1]; acc[2] += bf_lo(v.y) * w[2]; acc[3] += bf_hi(v.y) * w[3];
    acc[4] += bf_lo(v.z) * w[4]; acc[5] += bf_hi(v.z) * w[5]; acc[6] += bf_lo(v.w) * w[6]; acc[7] += bf_hi(v.w) * w[7];
}
DEV void phase_gla_conv(const Params& p) {
    const int tid = tid_opaque();
    unsigned char* ws = p.ws;
    const bf16_t* z = (const bf16_t*)(ws + WS_S + 1 * U_BYTES);
    bf16_t* o = (bf16_t*)(ws + WS_S + 4 * U_BYTES);
    const float* cw = p.in[25];
    const int x = tid >> 3, cl = (tid & 7) * 8;
    for (int task = blockIdx.x; task < 8 * 8 * 32; task += gridDim.x) {
        const int cb = task & 31, ys = (task >> 5) & 7, b = task >> 8;
        const int c = cb * 64 + cl;
        float w[9][8];
#pragma unroll
        for (int t = 0; t < 9; ++t) { const float4 w0 = *(const float4*)(cw + t * 2048 + c), w1 = *(const float4*)(cw + t * 2048 + c + 4); w[t][0] = w0.x; w[t][1] = w0.y; w[t][2] = w0.z; w[t][3] = w0.w; w[t][4] = w1.x; w[t][5] = w1.y; w[t][6] = w1.z; w[t][7] = w1.w; }
        const uint4 zero4 = make_uint4(0, 0, 0, 0);
        auto load_row = [&](int y, uint4 (&r)[3]) {
            if (y < 0 || y >= 128) { r[0] = zero4; r[1] = zero4; r[2] = zero4; return; }
            const bf16_t* row = z + ((size_t)b * 8192 + (size_t)y * 64 + x) * 2048 + c;
            r[1] = *(const uint4*)row;
            r[0] = (x > 0) ? *(const uint4*)(row - 2048) : zero4;
            r[2] = (x < 63) ? *(const uint4*)(row + 2048) : zero4;
        };
        uint4 r0[3], r1[3], r2[3], r3[3], r4[3];
        const int y0 = ys * 16;
        load_row(y0 - 1, r0); load_row(y0, r1); load_row(y0 + 1, r2); load_row(y0 + 2, r3);
#pragma unroll 1
        for (int yy = 0; yy < 16; ++yy) {
            load_row(yy < 14 ? y0 + yy + 3 : -1, r4);
            float acc[8];
#pragma unroll
            for (int j = 0; j < 8; ++j) acc[j] = 0.f;
#pragma unroll
            for (int dx = 0; dx < 3; ++dx) { conv_tap(acc, r0[dx], w[dx]); conv_tap(acc, r1[dx], w[3 + dx]); conv_tap(acc, r2[dx], w[6 + dx]); }
            conv_emit(acc, c, o + ((size_t)b * 8192 + (size_t)(y0 + yy) * 64 + x) * 2048 + c);
#pragma unroll
            for (int dx = 0; dx < 3; ++dx) { r0[dx] = r1[dx]; r1[dx] = r2[dx]; r2[dx] = r3[dx]; r3[dx] = r4[dx]; }
        }
    }
    for (int task = blockIdx.x; task < (NC / 64) * 8; task += gridDim.x) {
        const int rb = task >> 3, cbk = task & 7;
        const int R = NL + rb * 64 + (tid >> 3);
        const int t = (R - NL) & 255;
#pragma unroll 1
        for (int i = 0; i < 4; ++i) {
            const int c = cbk * 256 + (tid & 7) * 8 + i * 64;
            float acc[8];
#pragma unroll
            for (int j = 0; j < 8; ++j) acc[j] = 0.f;
#pragma unroll
            for (int dx = -1; dx <= 1; ++dx) {
                if (t + dx >= 0 && t + dx < 256) {
                    const uint4 v = *(const uint4*)(z + (size_t)(R + dx) * 2048 + c);
                    const float* wp = cw + (3 + (dx + 1)) * 2048 + c;
                    const float4 w0 = *(const float4*)wp, w1 = *(const float4*)(wp + 4);
                    const float wv[8] = {w0.x, w0.y, w0.z, w0.w, w1.x, w1.y, w1.z, w1.w};
                    conv_tap(acc, v, wv);
                }
            }
            conv_emit(acc, c, o + (size_t)R * 2048 + c);
        }
    }
}

constexpr int GT_QE = 0, GT_KET = 16384, GT_A = 32768, GT_CONST = 40960, GT_STRIDE = 43008;
constexpr int GT_N0 = (int)((2 * U_BYTES) / GT_STRIDE);
constexpr size_t WS_TOTAL = 1073741824ull;
static_assert((size_t)(NB * 4 * 2 * 132 - GT_N0) * GT_STRIDE <= WS_TOTAL - WS_END, "tile records do not fit");
DEV size_t gla_tile_off(int b, int hd, int d, int cc) {
    const int idx = (((b * 4 + hd) * 2 + d) * 132) + cc;
    return idx < GT_N0 ? WS_S + (size_t)idx * GT_STRIDE : WS_END + (size_t)(idx - GT_N0) * GT_STRIDE;
}
DEV int gla_row0(int b, int cc) { return cc < 4 ? NL + b * 256 + cc * 64 : b * 8192 + (cc - 4) * 64; }
DEV void phase_gla_prep(const Params& p, unsigned char* lds) {
    const int tid = tid_opaque(), lane = tid & 63, wv = tid >> 6;
    const int fr = lane & 15, fq = lane >> 4;
    unsigned char* ws = p.ws;
    constexpr int QE = 0, KE = 16384, KET = 32768, BC = 49152  , GS = 82944  , LRL = 86528  , BCS = 132;
    const bf16_t* qkv = (const bf16_t*)(ws + WS_S + 4 * U_BYTES);
    const float* lrb = (const float*)(ws + WS_LR);
    unsigned char* gt = ws;
    float* bc = (float*)(lds + BC);
    float* gs = (float*)(lds + GS);
    const int li = tid >> 3, lc = tid & 7;
    const int d = blockIdx.x & 1, hd = (blockIdx.x >> 1) & 3;
    bf16x8 gkf;
    {
        unsigned w4[4] = {0u, 0u, 0u, 0u};
        if (fq < 2) {
#pragma unroll
            for (int e2 = 0; e2 < 4; ++e2) {
                const float g0 = p.in[26][(size_t)(d * 16 + 8 * fq + 2 * e2) * 512 + hd * 128 + wv * 16 + fr];
                const float g1 = p.in[26][(size_t)(d * 16 + 8 * fq + 2 * e2 + 1) * 512 + hd * 128 + wv * 16 + fr];
                w4[e2] = pk_bf16(g0, g1);
            }
        }
        gkf = as_bf16x8(make_uint4(w4[0], w4[1], w4[2], w4[3]));
    }
    const float4 gb4 = *(const float4*)(p.in[27] + d * 512 + hd * 128 + wv * 16 + 4 * fq);
    const int qstep = (int)(gridDim.x >> 3);
    uint4 nq0, nq1, nk0, nk1; float2 nl;
    auto fetch = [&](int q) {
        const size_t R = (size_t)(gla_row0(q / 132, q % 132) + li);
        const bf16_t* row = qkv + R * 2048;
        nq0 = *(const uint4*)(row + hd * 128 + lc * 8); nq1 = *(const uint4*)(row + hd * 128 + 64 + lc * 8);
        nk0 = *(const uint4*)(row + 512 + hd * 128 + lc * 8); nk1 = *(const uint4*)(row + 512 + hd * 128 + 64 + lc * 8);
        nl = *(const float2*)(lrb + R * 32 + d * 16 + lc * 2);
    };
    int q = (int)(blockIdx.x >> 3);
    if (q < NB * 132) fetch(q);
    for (; q < NB * 132; q += qstep) {
        const int cc = q % 132, b = q / 132;
        unsigned char* rec = gt + gla_tile_off(b, hd, d, cc);
        const uint4 rq0 = nq0, rq1 = nq1, rk0 = nk0, rk1 = nk1; const float2 rl = nl;
        if (q + qstep < NB * 132) fetch(q + qstep);
        *(unsigned*)(lds + LRL + li * 32 + lc * 4) = pk_bf16(rl.x, rl.y);
        __syncthreads();
        {
            const float gbv[4] = {gb4.x, gb4.y, gb4.z, gb4.w};
#pragma unroll
            for (int itl = 0; itl < 4; ++itl) {
                uint4 lr4 = *(const uint4*)(lds + LRL + (itl * 16 + fr) * 32 + (fq & 1) * 16);
                if (fq >= 2) lr4 = make_uint4(0, 0, 0, 0);
                f32x4 a = {0.f, 0.f, 0.f, 0.f};
                a = __builtin_amdgcn_mfma_f32_16x16x32_bf16(gkf, as_bf16x8(lr4), a, 0, 0, 0);
                float s[4], tot[4];
#pragma unroll
                for (int j = 0; j < 4; ++j) {
                    const float xx = a[j] + gbv[j];
                    const float la = (fminf(xx, 0.f) - __logf(1.0f + __expf(-fabsf(xx)))) * (1.0f / 16.0f);
                    float pf = la;
                    pf += dpp_shr0<1>(pf); pf += dpp_shr0<2>(pf); pf += dpp_shr0<4>(pf); pf += dpp_shr0<8>(pf);
                    tot[j] = __shfl(pf, (lane & 48) | 15);
                    s[j] = d ? (tot[j] - pf + la) : pf;
                }
                *(float4*)(bc + (itl * 16 + fr) * BCS + wv * 16 + 4 * fq) = make_float4(s[0], s[1], s[2], s[3]);
                if (fr == 15) *(float4*)(gs + itl * 128 + wv * 16 + 4 * fq) = make_float4(tot[0], tot[1], tot[2], tot[3]);
            }
        }
        __syncthreads();
        if (tid < 128) {
            const float g0 = gs[tid], g1 = gs[128 + tid], g2 = gs[256 + tid], g3 = gs[384 + tid];
            const float refc = d ? (bc[31 * BCS + tid] + g2 + g3) : (bc[32 * BCS + tid] + g0 + g1), lastc = g0 + g1 + g2 + g3;
            const float dl = __expf(lastc), er = __expf(refc), el = __expf(lastc - refc);
            gs[512 + tid] = refc;
            float* cst = (float*)(rec + GT_CONST);
            cst[tid] = er; cst[128 + tid] = el; cst[256 + tid] = dl;
        }
        __syncthreads();
        {
            const int grp = li >> 4;
            const uint4 rqs[2] = {rq0, rq1}, rks[2] = {rk0, rk1};
#pragma unroll
            for (int hseg = 0; hseg < 2; ++hseg) {
                const int k0 = hseg * 64 + lc * 8;
                float bcv[8], refv[8];
#pragma unroll
                for (int j4 = 0; j4 < 2; ++j4) {
                    const float4 g0 = *(const float4*)(gs + k0 + j4 * 4), g1 = *(const float4*)(gs + 128 + k0 + j4 * 4);
                    const float4 g2 = *(const float4*)(gs + 256 + k0 + j4 * 4), g3 = *(const float4*)(gs + 384 + k0 + j4 * 4);
                    const float4 bi = *(const float4*)(bc + li * BCS + k0 + j4 * 4), rf = *(const float4*)(gs + 512 + k0 + j4 * 4);
                    const float g0a[4] = {g0.x, g0.y, g0.z, g0.w}, g1a[4] = {g1.x, g1.y, g1.z, g1.w}, g2a[4] = {g2.x, g2.y, g2.z, g2.w}, g3a[4] = {g3.x, g3.y, g3.z, g3.w};
                    const float bia[4] = {bi.x, bi.y, bi.z, bi.w}, rfa[4] = {rf.x, rf.y, rf.z, rf.w};
#pragma unroll
                    for (int j = 0; j < 4; ++j) {
                        const float pre = d ? ((grp < 1 ? g1a[j] : 0.f) + (grp < 2 ? g2a[j] : 0.f) + (grp < 3 ? g3a[j] : 0.f))
                                            : ((grp > 0 ? g0a[j] : 0.f) + (grp > 1 ? g1a[j] : 0.f) + (grp > 2 ? g2a[j] : 0.f));
                        bcv[j4 * 4 + j] = bia[j] + pre;
                        refv[j4 * 4 + j] = rfa[j];
                    }
                }
                const unsigned qw[4] = {rqs[hseg].x, rqs[hseg].y, rqs[hseg].z, rqs[hseg].w}, kw[4] = {rks[hseg].x, rks[hseg].y, rks[hseg].z, rks[hseg].w};
                unsigned oqe[4], oke[4];
#pragma unroll
                for (int j2 = 0; j2 < 4; ++j2) {
                    const float q0 = bf_lo(qw[j2]), q1 = bf_hi(qw[j2]), kk0 = bf_lo(kw[j2]), kk1 = bf_hi(kw[j2]);
                    const float e0 = __expf(bcv[2 * j2] - refv[2 * j2]), e1 = __expf(bcv[2 * j2 + 1] - refv[2 * j2 + 1]);
                    const float r0 = __builtin_amdgcn_rcpf(e0), r1 = __builtin_amdgcn_rcpf(e1);
                    oqe[j2] = pk_bf16(q0 * e0, q1 * e1);
                    oke[j2] = pk_bf16(kk0 * r0, kk1 * r1);
                    const int kc0 = k0 + 2 * j2;
                    *(bf16_t*)(lds + KET + tile_off2(kc0, li >> 3) + (li & 7) * 2) = (bf16_t)(oke[j2] & 0xffffu);
                    *(bf16_t*)(lds + KET + tile_off2(kc0 + 1, li >> 3) + (li & 7) * 2) = (bf16_t)(oke[j2] >> 16);
                }
                const int chq = hseg * 8 + lc;
                const int so = li * 256 + ((chq ^ (li & 15)) << 4);
                *(uint4*)(lds + QE + so) = make_uint4(oqe[0], oqe[1], oqe[2], oqe[3]);
                *(uint4*)(lds + KE + so) = make_uint4(oke[0], oke[1], oke[2], oke[3]);
                *(uint4*)(rec + GT_QE + so) = make_uint4(oqe[0], oqe[1], oqe[2], oqe[3]);
            }
        }
        __syncthreads();
        {
            const int it = wv & 3, pr2 = wv >> 2;
#pragma unroll
            for (int jj = 0; jj < 2; ++jj) {
                const int jt = pr2 * 2 + jj;
                f32x4 a = {0.f, 0.f, 0.f, 0.f};
                if (d ? (jt >= it) : (jt <= it)) {
#pragma unroll
                    for (int ks = 0; ks < 4; ++ks) {
                        const int ch = ks * 4 + fq;
                        const int rj = jt * 16 + fr, ri = it * 16 + fr;
                        const bf16x8 fa = *(const bf16x8*)(lds + KE + rj * 256 + ((ch ^ (rj & 15)) << 4));
                        const bf16x8 fb = *(const bf16x8*)(lds + QE + ri * 256 + ((ch ^ (ri & 15)) << 4));
                        a = __builtin_amdgcn_mfma_f32_16x16x32_bf16(fa, fb, a, 0, 0, 0);
                    }
                }
                const int i = it * 16 + fr, j = jt * 16 + 4 * fq;
                float av[4];
#pragma unroll
                for (int e = 0; e < 4; ++e) av[e] = (d ? (j + e >= i) : (j + e <= i)) ? a[e] : 0.f;
                *(uint2*)(rec + GT_A + i * 128 + (((j >> 3) ^ (i & 7)) << 4) + (j & 7) * 2) = make_uint2(pk_bf16(av[0], av[1]), pk_bf16(av[2], av[3]));
            }
#pragma unroll
            for (int i = 0; i < 2; ++i) *(uint4*)(rec + GT_KET + i * 8192 + tid * 16) = *(const uint4*)(lds + KET + i * 8192 + tid * 16);
        }
        __syncthreads();
    }
}

DEV void phase_gla_scan(const Params& p, unsigned char* lds) {
    const int tid = tid_opaque(), lane = tid & 63, wv = tid >> 6;
    const int fr = lane & 15, fq = lane >> 4;
    unsigned char* ws = p.ws;
    constexpr int QE = 0  , KET = 32768  , AL = 65536  , VT = 81920, ST = 90112  ;
    const bf16_t* qkv = (const bf16_t*)(ws + WS_S + 4 * U_BYTES);
    const unsigned char* gt = ws;
    for (int unit = blockIdx.x; unit < 256; unit += gridDim.x) {
        const int vs = unit & 3, d = (unit >> 2) & 1, hd = (unit >> 3) & 3, b = unit >> 5;
        bf16_t* odst = d ? (bf16_t*)(ws + WS_S + 2 * U_BYTES) : (bf16_t*)(ws + WS_S + 4 * U_BYTES);
        const int old_ = d ? 1024 : 2048;
        const int li = tid >> 3, lc = tid & 7;
        auto ccof = [&](int c) -> int { return d ? (c < 4 ? 3 - c : 135 - c) : c; };
        auto dma = [&](int cc, int buf) {
            const unsigned char* rec = gt + gla_tile_off(b, hd, d, cc);
#pragma unroll
            for (int i = 0; i < 2; ++i) {
                __builtin_amdgcn_global_load_lds((const unsigned*)(rec + GT_QE + i * 8192 + tid * 16), (unsigned*)(lds + QE + buf * 16384 + i * 8192 + tid * 16), 16, 0, 0);
                __builtin_amdgcn_global_load_lds((const unsigned*)(rec + GT_KET + i * 8192 + tid * 16), (unsigned*)(lds + KET + buf * 16384 + i * 8192 + tid * 16), 16, 0, 0);
            }
            __builtin_amdgcn_global_load_lds((const unsigned*)(rec + GT_A + tid * 16), (unsigned*)(lds + AL + buf * 8192 + tid * 16), 16, 0, 0);
        };
        uint4 nv; float4 n_dl, n_el, n_er;
        auto loads = [&](int c) {
            const int cc = ccof(c);
            nv = *(const uint4*)(qkv + (size_t)(gla_row0(b, cc) + li) * 2048 + 1024 + hd * 256 + vs * 64 + lc * 8);
            const float* cst = (const float*)(gt + gla_tile_off(b, hd, d, cc) + GT_CONST);
            n_el = *(const float4*)(cst + 128 + wv * 16 + 4 * fq); n_dl = *(const float4*)(cst + 256 + wv * 16 + 4 * fq);
            if (c + 1 < 132) n_er = *(const float4*)((const float*)(gt + gla_tile_off(b, hd, d, ccof(c + 1)) + GT_CONST) + wv * 16 + 4 * fq);
            else n_er = make_float4(0.f, 0.f, 0.f, 0.f);
        };
        f32x4 accS[4];
#pragma unroll
        for (int i = 0; i < 4; ++i) accS[i] = (f32x4){0.f, 0.f, 0.f, 0.f};
        for (int i = tid; i < 32768 / 16; i += NTHREADS) *(uint4*)(lds + ST + i * 16) = make_uint4(0, 0, 0, 0);
        dma(ccof(0), 0);
        loads(0);
        for (int c = 0; c < 132; ++c) {
            const int buf = c & 1, cc = ccof(c);
            const uint4 rv = nv; const float4 dl4 = n_dl, el4 = n_el, er4 = n_er;
            asm volatile("s_waitcnt vmcnt(0)" ::: "memory");
            {
                const unsigned vw[4] = {rv.x, rv.y, rv.z, rv.w};
#pragma unroll
                for (int j2 = 0; j2 < 4; ++j2) {
                    const int vc0 = lc * 8 + 2 * j2;
                    *(bf16_t*)(lds + VT + tile_off2(vc0, li >> 3) + (li & 7) * 2) = (bf16_t)(vw[j2] & 0xffffu);
                    *(bf16_t*)(lds + VT + tile_off2(vc0 + 1, li >> 3) + (li & 7) * 2) = (bf16_t)(vw[j2] >> 16);
                }
            }
            asm volatile("s_waitcnt lgkmcnt(0)" ::: "memory"); __builtin_amdgcn_s_barrier(); asm volatile("" ::: "memory");
            if (c + 1 < 132) { dma(ccof(c + 1), buf ^ 1); loads(c + 1); }
            const int it = wv & 3, pr2 = wv >> 2;
            const int r0 = gla_row0(b, cc);
#pragma unroll
            for (int vv = 0; vv < 2; ++vv) {
                const int vt = pr2 * 2 + vv;
                f32x4 a = {0.f, 0.f, 0.f, 0.f};
#pragma unroll
                for (int ks = 0; ks < 4; ++ks) {
                    const int ch = ks * 4 + fq;
                    const int rvv = vt * 16 + fr, ri = it * 16 + fr;
                    const bf16x8 fa = *(const bf16x8*)(lds + ST + buf * 16384 + rvv * 256 + ((ch ^ (rvv & 15)) << 4));
                    const bf16x8 fb = *(const bf16x8*)(lds + QE + buf * 16384 + ri * 256 + ((ch ^ (ri & 15)) << 4));
                    a = __builtin_amdgcn_mfma_f32_16x16x32_bf16(fa, fb, a, 0, 0, 0);
                }
#pragma unroll
                for (int ks = 0; ks < 2; ++ks) {
                    const int ch = ks * 4 + fq;
                    const int rvv = vt * 16 + fr, ri = it * 16 + fr;
                    const bf16x8 fa = *(const bf16x8*)(lds + VT + tile_off2(rvv, ch));
                    const bf16x8 fb = *(const bf16x8*)(lds + AL + buf * 8192 + ri * 128 + ((ch ^ (ri & 7)) << 4));
                    a = __builtin_amdgcn_mfma_f32_16x16x32_bf16(fa, fb, a, 0, 0, 0);
                }
                const int i = it * 16 + fr, vcol = vt * 16 + 4 * fq;
                *(uint2*)(odst + (size_t)(r0 + i) * old_ + hd * 256 + vs * 64 + vcol) = make_uint2(pk_bf16(a[0], a[1]), pk_bf16(a[2], a[3]));
            }
            {
                const int kt = wv;
                bf16x8 fa[2];
#pragma unroll
                for (int ks = 0; ks < 2; ++ks) fa[ks] = *(const bf16x8*)(lds + KET + buf * 16384 + tile_off2(kt * 16 + fr, ks * 4 + fq));
#pragma unroll
                for (int vt = 0; vt < 4; ++vt) {
                    f32x4 t = {0.f, 0.f, 0.f, 0.f};
#pragma unroll
                    for (int ks = 0; ks < 2; ++ks) t = __builtin_amdgcn_mfma_f32_16x16x32_bf16(fa[ks], *(const bf16x8*)(lds + VT + tile_off2(vt * 16 + fr, ks * 4 + fq)), t, 0, 0, 0);
                    f32x4 a = accS[vt];
                    a[0] = a[0] * dl4.x + t[0] * el4.x; a[1] = a[1] * dl4.y + t[1] * el4.y; a[2] = a[2] * dl4.z + t[2] * el4.z; a[3] = a[3] * dl4.w + t[3] * el4.w;
                    accS[vt] = a;
                    const int vcol = vt * 16 + fr, kcol = kt * 16 + 4 * fq;
                    *(uint2*)(lds + ST + (buf ^ 1) * 16384 + vcol * 256 + (((kcol >> 3) ^ (vcol & 15)) << 4) + (kcol & 7) * 2) =
                        make_uint2(pk_bf16(a[0] * er4.x, a[1] * er4.y), pk_bf16(a[2] * er4.z, a[3] * er4.w));
                }
            }
            asm volatile("s_waitcnt lgkmcnt(0)" ::: "memory"); __builtin_amdgcn_s_barrier(); asm volatile("" ::: "memory");
        }
        asm volatile("s_waitcnt vmcnt(0)" ::: "memory");
        __syncthreads();
    }
}

DEV void phase_gla_readout(const Params& p) {
    const int tid = tid_opaque(), lane = tid & 63;
    const int gw = blockIdx.x * 8 + (tid >> 6), nw = gridDim.x * 8;
    unsigned char* ws = p.ws;
    const bf16_t* o0 = (const bf16_t*)(ws + WS_S + 4 * U_BYTES);
    const bf16_t* o1 = (const bf16_t*)(ws + WS_S + 2 * U_BYTES);
    const bf16_t* gb = (const bf16_t*)(ws + WS_S + 3 * U_BYTES);
    bf16_t* ao = (bf16_t*)(ws + WS_S + 0 * U_BYTES);
    const float4 hn = *(const float4*)(p.in[28] + lane * 4);
    for (int item = gw; item < NL * 4; item += nw) {
        const size_t off = (size_t)(item >> 2) * 1024 + (item & 3) * 256 + lane * 4;
        const uint2 a = *(const uint2*)(o0 + off + (size_t)(item >> 2) * 1024), b2 = *(const uint2*)(o1 + off), g2 = *(const uint2*)(gb + off);
        const float v0 = bf_lo(a.x) + bf_lo(b2.x), v1 = bf_hi(a.x) + bf_hi(b2.x), v2 = bf_lo(a.y) + bf_lo(b2.y), v3 = bf_hi(a.y) + bf_hi(b2.y);
        float ss = v0 * v0 + v1 * v1 + v2 * v2 + v3 * v3;
        ss = wave_allreduce(ss);
        const float rs = rsqrtf(ss * (1.0f / 256.0f) + 1e-6f);
        const float g0 = bf_lo(g2.x), g1 = bf_hi(g2.x), g2f = bf_lo(g2.y), g3 = bf_hi(g2.y);
        const float r0 = v0 * rs * hn.x * (g0 * sigmoidf_(g0)), r1 = v1 * rs * hn.y * (g1 * sigmoidf_(g1));
        const float r2 = v2 * rs * hn.z * (g2f * sigmoidf_(g2f)), r3 = v3 * rs * hn.w * (g3 * sigmoidf_(g3));
        *(uint2*)(ao + off) = make_uint2(pk_bf16(r0, r1), pk_bf16(r2, r3));
    }
}


#define XB_TMO      128
#define XB_XCNT(j)  (256  + 64 * (j))
#define XB_XSUB(j)  (1280 + 64 * (j))
#define XB_XGEN(j)  (2304 + 64 * (j))
#define XB_TOP      3328
#define XB_TOPGEN   3392
#define XB_SPIN_CAP (1u << 22)
DEV unsigned xb_ld(unsigned* p) { return __hip_atomic_load(p, __ATOMIC_RELAXED, __HIP_MEMORY_SCOPE_AGENT); }
DEV unsigned xb_add(unsigned* p, unsigned v) { return __hip_atomic_fetch_add(p, v, __ATOMIC_RELAXED, __HIP_MEMORY_SCOPE_AGENT); }
DEV unsigned xb_xcc_id() { return (unsigned)__builtin_amdgcn_s_getreg((3 << 11) | 20) & 0xFu; }
#define XB_SPIN(cond, bar) do { unsigned _sp = 0; while (cond) { __builtin_amdgcn_s_sleep(1); \
    if ((++_sp & 255u) == 0u) { if (xb_ld(&(bar)[XB_TMO])) break; if (_sp > XB_SPIN_CAP) { atomicAdd(&(bar)[XB_TMO], 1u); break; } } } } while (0)
DEV void xcd_barrier_complete(unsigned* bar, unsigned x, unsigned& nloc, unsigned& nx) {
    const unsigned G = gridDim.x;
    unsigned sum, cnt, mine, sp = 0u;
    for (;;) {
        sum = 0u; cnt = 0u; mine = 0u;
#pragma unroll
        for (unsigned j = 0; j < 16; ++j) { const unsigned c = xb_ld(&bar[XB_XCNT(j)]); sum += c; cnt += (c > 0u) ? 1u : 0u; mine = (j == x) ? c : mine; }
        if (sum == G) break;
        __builtin_amdgcn_s_sleep(1);
        if ((++sp & 255u) == 0u) { if (xb_ld(&bar[XB_TMO])) break; if (sp > XB_SPIN_CAP) { atomicAdd(&bar[XB_TMO], 1u); break; } }
    }
    nloc = mine > 0u ? mine : 1u; nx = cnt > 0u ? cnt : 1u;
}
DEV void xcd_barrier(unsigned* bar, volatile LAS3 unsigned* st) {
    asm volatile("s_waitcnt vmcnt(0)" ::: "memory");
    __syncthreads();
    if (tid_opaque() == 0) {
        const unsigned x = xb_xcc_id();
        __builtin_amdgcn_s_waitcnt(0);
        unsigned nloc = st[0], nx = st[1];
        if (nloc == 0u) { xcd_barrier_complete(bar, x, nloc, nx); st[0] = nloc; st[1] = nx; }
        const unsigned old = xb_add(&bar[XB_XSUB(x)], 1u);
        const unsigned gen = old / nloc;
        if (old + 1u == (gen + 1u) * nloc) {
            __builtin_amdgcn_fence(__ATOMIC_RELEASE, "agent");
            asm volatile("s_waitcnt vmcnt(0)" ::: "memory");
            const unsigned og = xb_add(&bar[XB_TOP], 1u);
            const unsigned tg = og / nx;
            if (og + 1u == (tg + 1u) * nx) xb_add(&bar[XB_TOPGEN], 1u);
            else XB_SPIN(xb_ld(&bar[XB_TOPGEN]) == tg, bar);
            __builtin_amdgcn_fence(__ATOMIC_ACQUIRE, "agent");
            xb_add(&bar[XB_XGEN(x)], 1u);
            asm volatile("s_waitcnt vmcnt(0)" ::: "memory");
        } else {
            XB_SPIN(xb_ld(&bar[XB_XGEN(x)]) == gen, bar);
            __builtin_amdgcn_fence(__ATOMIC_ACQUIRE, "agent");
            asm volatile("s_waitcnt vmcnt(0)" ::: "memory");
        }
    }
    __syncthreads();
}
#define SYNC() do { asm volatile("s_waitcnt vmcnt(0)" ::: "memory"); grid.sync(); \
    if (tid_opaque() == 0) { __builtin_amdgcn_fence(__ATOMIC_ACQUIRE, "agent"); asm volatile("s_waitcnt vmcnt(0)" ::: "memory"); } \
    __syncthreads(); } while (0)
__global__ void __launch_bounds__(NTHREADS) mega_fwd(Params p) {
    unsigned char* const lds = g_lds;
    cg::grid_group grid = cg::this_grid();
#define XBAR ((unsigned*)(p.ws + WS_BAR))
#define XST ((volatile LAS3 unsigned*)(lds + LDS_BYTES - 16))
    if ((threadIdx.x & 63) == 0) g_lds[LDS_WTAB + hw_wave_slot()] = (unsigned char)(threadIdx.x >> 6);
    if (threadIdx.x == 0) { XST[0] = 0u; XST[1] = 0u; (void)xb_add(&XBAR[XB_XCNT(xb_xcc_id())], 1u); }
    __syncthreads();
#define S0 ((bf16_t*)(p.ws + WS_S + 0 * U_BYTES))
#define SLOT(i) ((bf16_t*)(p.ws + WS_S + (size_t)(i) * U_BYTES))
#define S1 ((bf16_t*)(p.ws + WS_S + 1 * U_BYTES))
#define CTXR ((const float*)(p.ws + WS_CTXR))
    phase0(p, lds); SYNC();
#undef SYNC
#define SYNC() xcd_barrier(XBAR, XST)
    phase_normmix(p, S0, SLOT(5), SLOT(1), SLOT(2)); SYNC();
    phase_rw_proj1(p, lds, 0, SLOT(5), SLOT(3)); SYNC();
    phase_rw_proj1(p, lds, 1, SLOT(1), SLOT(5)); SYNC();
    phase_rw_proj1(p, lds, 2, SLOT(2), SLOT(1)); phase_rw_lora(p, lds); SYNC();
    REPEAT(3, phase_rw_scan(p, lds));
    phase_rw_scan(p, lds); SYNC();
    REPEAT(4, phase_rw_readout(p));
    phase_rw_readout(p); SYNC();
    REPEAT(5, phase_wo(p, lds, 0));
    phase_wo(p, lds, 0); SYNC();
    REPEAT(6, phase_normmod(p, 0, 1, p.out, CTXR, NT, S1, (unsigned char*)SLOT(2)));
    phase_normmod(p, 0, 1, p.out, CTXR, NT, S1, (unsigned char*)SLOT(2)); SYNC();
    REPEAT(7, phase_peer_select(p, lds, 0));
    phase_peer_select(p, lds, 0); SYNC();
    phase_peer_u(p, lds, 0); SYNC();
    phase_peer_c(p, 0); SYNC();
    phase_peer_v(p, 0); SYNC();
    phase_normmod(p, 1, 0, p.out, CTXR, NT, S0, nullptr); SYNC();
    REPEAT(9, phase_gla_proj(p, lds));
    phase_gla_proj(p, lds); SYNC();
    REPEAT(10, phase_gla_conv(p));
    phase_gla_conv(p); SYNC();
    REPEAT(18, phase_gla_prep(p, lds));
    phase_gla_prep(p, lds); SYNC();
    REPEAT(11, phase_gla_scan(p, lds));
    phase_gla_scan(p, lds); SYNC();
    REPEAT(12, phase_gla_readout(p));
    phase_gla_readout(p); SYNC();
    phase_wo(p, lds, 1); SYNC();
    REPEAT(14, phase_normmod(p, 1, 1, p.out, CTXR, NL, S0, (unsigned char*)SLOT(2)));
    phase_normmod(p, 1, 1, p.out, CTXR, NL, S0, (unsigned char*)SLOT(2)); SYNC();
    REPEAT(15, phase_peer_select(p, lds, 1));
    phase_peer_select(p, lds, 1); SYNC();
    phase_peer_u(p, lds, 1); SYNC();
    phase_peer_c(p, 1); SYNC();
    phase_peer_v(p, 1); SYNC();
    phase_final_norm(p);
}

extern "C" void kernel_launch(void* const* d_in, const int* in_sizes, int n_in, void* d_out, int out_size, void* d_ws, size_t ws_size, hipStream_t stream) {
    static int grid_blocks = 0;
    if (grid_blocks == 0) {
        if (n_in != 35 || ws_size < WS_TOTAL) { fprintf(stderr, "kernel_launch: unexpected n_in %d or ws_size %zu (< %zu)\n", n_in, ws_size, (size_t)WS_END); grid_blocks = -1; return; }
        int dev = 0, cus = 0, per_cu = 0;
        if (hipGetDevice(&dev) != hipSuccess || hipDeviceGetAttribute(&cus, hipDeviceAttributeMultiprocessorCount, dev) != hipSuccess) { fprintf(stderr, "kernel_launch: device query failed\n"); grid_blocks = -1; return; }
        if (hipFuncSetAttribute((const void*)mega_fwd, hipFuncAttributeMaxDynamicSharedMemorySize, LDS_BYTES) != hipSuccess) { fprintf(stderr, "kernel_launch: hipFuncSetAttribute failed\n"); grid_blocks = -1; return; }
        if (hipOccupancyMaxActiveBlocksPerMultiprocessor(&per_cu, (const void*)mega_fwd, NTHREADS, LDS_BYTES) != hipSuccess || per_cu < 1) { fprintf(stderr, "kernel_launch: occupancy query says %d blocks per CU\n", per_cu); grid_blocks = -1; return; }
        grid_blocks = cus;
    }
    if (grid_blocks < 0) return;
    Params p{};
    for (int i = 0; i < 35; ++i) p.in[i] = (const float*)d_in[i];
    p.out = (float*)d_out;
    p.ws = (unsigned char*)d_ws;
    if (hipMemsetAsync((char*)d_ws + WS_BAR, 0, 16384, stream) != hipSuccess) { fprintf(stderr, "kernel_launch: hipMemsetAsync failed\n"); return; }
    void* args[] = {&p};
    hipError_t e = hipLaunchCooperativeKernel((const void*)mega_fwd, dim3(grid_blocks), dim3(NTHREADS), args, LDS_BYTES, stream);
    if (e != hipSuccess) fprintf(stderr, "kernel_launch: cooperative launch failed: %s (grid %d)\n", hipGetErrorString(e), grid_blocks);
}
```

```cpp
#include <hip/hip_runtime.h>
#include <hip/hip_cooperative_groups.h>
#include <cstdio>
#include <cstdint>
namespace cg = cooperative_groups;

#define DEV __device__ __forceinline__
#ifndef REP
#define REP 0
#endif
#define GREPS(n) ((REP == (n)) ? 2 : 1)
#define REPEAT(n, stmt) do { if (REP == (n)) { stmt; SYNC(); } } while (0)

typedef unsigned short bf16_t;
typedef short bf16x8 __attribute__((ext_vector_type(8)));
typedef float f32x4 __attribute__((ext_vector_type(4)));
typedef __bf16 bf16x2v __attribute__((ext_vector_type(2)));

constexpr int D = 1024;
constexpr int NB = 8, SEQ = 8192, CTXL = 256;
constexpr int NL = NB * SEQ, NC = NB * CTXL, NT = NL + NC;
constexpr int NTHREADS = 512;
constexpr int LDS_BYTES = 160 * 1024;

constexpr size_t U_BYTES = (size_t)NT * 1024 * 2;
constexpr size_t WS_BAR = 0;
constexpr size_t WS_MOD = 16384;
constexpr size_t WS_CTXR = WS_MOD + (size_t)2 * 9 * 6144 * 4;
constexpr size_t WS_LR = WS_CTXR + (size_t)NC * 1024 * 4;
constexpr size_t WS_BONUS = WS_LR + (size_t)NT * 32 * 4;
constexpr size_t WS_WPROJ = WS_BONUS + (size_t)2 * NT * 16 * 4;
constexpr size_t WS_W2T = WS_WPROJ + (size_t)3456 * 1024 * 2;
constexpr size_t WS_A2T = WS_W2T + (size_t)2 * 1024 * 64 * 2;
constexpr size_t WS_G2T = WS_A2T + (size_t)2 * 1024 * 64 * 2;
constexpr size_t WS_WO0 = WS_G2T + (size_t)1024 * 128 * 2;
constexpr size_t WS_WO1 = WS_WO0 + (size_t)1024 * 1024 * 2;
constexpr size_t WS_WQ = WS_WO1 + (size_t)1024 * 1024 * 2;
constexpr size_t WS_KEYS = WS_WQ + (size_t)2 * 2048 * 1024 * 2;
constexpr size_t WS_WIN = WS_KEYS + (size_t)2 * 8 * 2 * 128 * 128 * 2;
constexpr size_t WS_PU = WS_WIN + (size_t)3200 * 1024 * 2;
constexpr size_t WS_PV = WS_PU + (size_t)2 * 16384 * 1024;
constexpr size_t WS_PSC = WS_PV + (size_t)2 * 16384 * 1024;
constexpr size_t WS_S = WS_PSC + (size_t)2 * 2 * 16384 * 4;
constexpr size_t WS_END = WS_S + 6 * U_BYTES;
static_assert(WS_END <= 1073741824ull, "workspace too large");
static_assert((WS_CTXR % 256) == 0 && (WS_WPROJ % 256) == 0 && (WS_S % 256) == 0, "alignment");

struct Params {
    const float* in[35];
    float* out;
    unsigned char* ws;
    int pad0, pad1;
};

DEV float bf_lo(unsigned u) { return __uint_as_float(u << 16); }
DEV float bf_hi(unsigned u) { return __uint_as_float(u & 0xffff0000u); }
typedef float f32x2v __attribute__((ext_vector_type(2)));
typedef unsigned int u32x2v __attribute__((ext_vector_type(2)));
typedef short s16x4v __attribute__((ext_vector_type(4)));
DEV unsigned pk_bf16(float lo, float hi) { const f32x2v f = {lo, hi}; union { bf16x2v v; unsigned u; } x; x.v = __builtin_convertvector(f, bf16x2v); return x.u; }
template <int N> DEV float dpp_ror(float x) { return __int_as_float(__builtin_amdgcn_update_dpp(0, __float_as_int(x), 0x120 + N, 0xF, 0xF, false)); }
DEV float row16_allreduce(float x) { x += dpp_ror<8>(x); x += dpp_ror<4>(x); x += dpp_ror<2>(x); x += dpp_ror<1>(x); return x; }
DEV float wave_allreduce(float x) { x = row16_allreduce(x); x += __shfl_xor(x, 16); x += __shfl_xor(x, 32); return x; }
DEV float sigmoidf_(float x) { return 1.0f / (1.0f + __expf(-x)); }
DEV float softplusf_(float z) { return fmaxf(z, 0.f) + __logf(1.0f + __expf(-fabsf(z))); }
DEV unsigned mono_u32(float f) { unsigned u = __float_as_uint(f); return u ^ ((u >> 31) ? 0xFFFFFFFFu : 0x80000000u); }
DEV float unmono_u32(unsigned k) { unsigned u = (k & 0x80000000u) ? (k ^ 0x80000000u) : ~k; return __uint_as_float(u); }
DEV bf16x8 as_bf16x8(uint4 v) { union { uint4 u; bf16x8 b; } x; x.u = v; return x.b; }
#define LAS3 __attribute__((address_space(3)))
extern __shared__ __attribute__((aligned(16))) unsigned char g_lds[];
constexpr int LDS_WTAB = LDS_BYTES - 128;
DEV unsigned hw_wave_slot() { return (unsigned)__builtin_amdgcn_s_getreg((5 << 11) | 4) & 63u; }
DEV int tid_opaque() {
    const int wv = (int)*(const volatile unsigned char*)(g_lds + LDS_WTAB + hw_wave_slot());
    int t = (wv << 6) | (int)__builtin_amdgcn_mbcnt_hi(~0u, __builtin_amdgcn_mbcnt_lo(~0u, 0u));
    asm volatile("" : "+v"(t));
    return t;
}
DEV int mod_batch(int R) { return R < NL ? (R >> 13) : 8; }

template <int BN, class AL, class EP>
DEV void gemm_unit(unsigned char* lds, const AL& al, const bf16_t* Bt, int K, int m0, const EP& ep) {
    constexpr int NI = BN / 64;
    constexpr int A_BYTES = 128 * 128;
    constexpr int B_BYTES = BN * 128;
    const int tid = tid_opaque(), lane = tid & 63, wv = tid >> 6, wm = wv >> 2, wn = wv & 3;
    const int fr = lane & 15, fq = lane >> 4;
    unsigned char* sA = lds;
    unsigned char* sB = lds + 2 * A_BYTES;
    f32x4 acc[4][NI];
#pragma unroll
    for (int mi = 0; mi < 4; ++mi)
#pragma unroll
        for (int ni = 0; ni < NI; ++ni) acc[mi][ni] = (f32x4){0.f, 0.f, 0.f, 0.f};
    const int KT = K >> 6;
    const int drow = tid >> 3, dch = (tid & 7) ^ (drow & 7);
    const bf16_t* bsrc = Bt + (size_t)drow * K + dch * 8;
    uint4 ra[2];
    auto stage = [&](int kt, int buf) {
        const int k0 = kt * 64;
#pragma unroll
        for (int i = 0; i < BN / 64; ++i)
            __builtin_amdgcn_global_load_lds((const unsigned*)(bsrc + (size_t)(64 * i) * K + k0), (unsigned*)(sB + buf * B_BYTES + i * 8192 + tid * 16), 16, 0, 0);
        if constexpr (AL::DMA) {
#pragma unroll
            for (int i = 0; i < 2; ++i)
                __builtin_amdgcn_global_load_lds((const unsigned*)(al.A + (size_t)(m0 + drow + 64 * i) * al.lda + k0 + dch * 8), (unsigned*)(sA + buf * A_BYTES + i * 8192 + tid * 16), 16, 0, 0);
        } else {
#pragma unroll
            for (int i = 0; i < 2; ++i) { const int q = tid + 512 * i; ra[i] = al.load(m0 + (q >> 3), k0 + (q & 7) * 8); }
        }
    };
    auto commit = [&](int buf) {
        if constexpr (!AL::DMA) {
#pragma unroll
            for (int i = 0; i < 2; ++i) { const int q = tid + 512 * i, row = q >> 3, ch = q & 7; *(uint4*)(sA + buf * A_BYTES + row * 128 + ((ch ^ (row & 7)) << 4)) = ra[i]; }
        }
    };
    auto compute = [&](int buf) {
        const unsigned char* a_base = sA + buf * A_BYTES;
        const unsigned char* b_base = sB + buf * B_BYTES;
#pragma unroll
        for (int ks = 0; ks < 2; ++ks) {
            bf16x8 af[4], bfr[NI];
            const int ch = ks * 4 + fq;
#pragma unroll
            for (int mi = 0; mi < 4; ++mi) { const int row = wm * 64 + mi * 16 + fr; af[mi] = *(const bf16x8*)(a_base + row * 128 + ((ch ^ (row & 7)) << 4)); }
#pragma unroll
            for (int ni = 0; ni < NI; ++ni) { const int row = wn * (BN / 4) + ni * 16 + fr; bfr[ni] = *(const bf16x8*)(b_base + row * 128 + ((ch ^ (row & 7)) << 4)); }
#pragma unroll
            for (int mi = 0; mi < 4; ++mi)
#pragma unroll
                for (int ni = 0; ni < NI; ++ni) acc[mi][ni] = __builtin_amdgcn_mfma_f32_16x16x32_bf16(bfr[ni], af[mi], acc[mi][ni], 0, 0, 0);
        }
    };
    if constexpr (AL::DMA) {
        constexpr int STG = A_BYTES + B_BYTES;
        auto stage3 = [&](int kt, int b3) {
            const int k0 = kt * 64;
            unsigned char* base = lds + b3 * STG;
#pragma unroll
            for (int i = 0; i < BN / 64; ++i)
                __builtin_amdgcn_global_load_lds((const unsigned*)(bsrc + (size_t)(64 * i) * K + k0), (unsigned*)(base + A_BYTES + i * 8192 + tid * 16), 16, 0, 0);
#pragma unroll
            for (int i = 0; i < 2; ++i)
                __builtin_amdgcn_global_load_lds((const unsigned*)(al.A + (size_t)(m0 + drow + 64 * i) * al.lda + k0 + dch * 8), (unsigned*)(base + i * 8192 + tid * 16), 16, 0, 0);
        };
        auto compute3 = [&](int b3) {
            const unsigned char* a_base = lds + b3 * STG;
            const unsigned char* b_base = a_base + A_BYTES;
#pragma unroll
            for (int ks = 0; ks < 2; ++ks) {
                bf16x8 af[4], bfr[NI];
                const int ch = ks * 4 + fq;
#pragma unroll
                for (int mi = 0; mi < 4; ++mi) { const int row = wm * 64 + mi * 16 + fr; af[mi] = *(const bf16x8*)(a_base + row * 128 + ((ch ^ (row & 7)) << 4)); }
#pragma unroll
                for (int ni = 0; ni < NI; ++ni) { const int row = wn * (BN / 4) + ni * 16 + fr; bfr[ni] = *(const bf16x8*)(b_base + row * 128 + ((ch ^ (row & 7)) << 4)); }
#pragma unroll
                for (int mi = 0; mi < 4; ++mi)
#pragma unroll
                    for (int ni = 0; ni < NI; ++ni) acc[mi][ni] = __builtin_amdgcn_mfma_f32_16x16x32_bf16(bfr[ni], af[mi], acc[mi][ni], 0, 0, 0);
            }
        };
        stage3(0, 0);
        stage3(1, 1);
        int b3 = 0;
        for (int kt = 0; kt < KT; ++kt) {
            if (kt + 1 < KT) { if constexpr (BN == 256) asm volatile("s_waitcnt vmcnt(6)" ::: "memory"); else asm volatile("s_waitcnt vmcnt(4)" ::: "memory"); }
            else asm volatile("s_waitcnt vmcnt(0)" ::: "memory");
            asm volatile("s_waitcnt lgkmcnt(0)" ::: "memory");
            __builtin_amdgcn_s_barrier();
            asm volatile("" ::: "memory");
            const int bn = (b3 == 0) ? 2 : b3 - 1;
            if (kt + 2 < KT) stage3(kt + 2, bn);
            compute3(b3);
            b3 = (b3 == 2) ? 0 : b3 + 1;
        }
        asm volatile("s_waitcnt lgkmcnt(0)" ::: "memory");
        __builtin_amdgcn_s_barrier();
        asm volatile("" ::: "memory");
    } else {
        stage(0, 0);
        commit(0);
        asm volatile("s_waitcnt vmcnt(0)" ::: "memory");
        __syncthreads();
        for (int kt = 0; kt < KT; ++kt) {
            const int cur = kt & 1;
            const bool more = (kt + 1 < KT);
            if (more) stage(kt + 1, cur ^ 1);
            compute(cur);
            if (more) commit(cur ^ 1);
            asm volatile("s_waitcnt vmcnt(0)" ::: "memory");
            __syncthreads();
        }
    }
    ep(acc, m0, wm, wn, fr, fq);
}

struct ALoadPlain {
    static constexpr bool DMA = true;
    const bf16_t* A; int lda;
    DEV uint4 load(int R, int k) const { return *(const uint4*)(A + (size_t)R * lda + k); }
};
struct ALoadMix {
    static constexpr bool DMA = false;
    const bf16_t* h; const float* mix; const bf16_t* A; int lda;
    DEV uint4 load(int R, int k) const {
        const bf16_t* pc = h + (size_t)R * 1024 + k;
        const uint4 c = *(const uint4*)pc;
        const int t = (R < NL) ? (R & 8191) : ((R - NL) & 255);
        const int last = (R < NL) ? 8191 : 255;
        uint4 pv = *(const uint4*)(pc - (t != 0 ? 1024 : 0)), nv = *(const uint4*)(pc + (t != last ? 1024 : 0));
        if (t == 0) pv = make_uint4(0, 0, 0, 0);
        if (t == last) nv = make_uint4(0, 0, 0, 0);
        const float4 m0 = *(const float4*)(mix + k), m1 = *(const float4*)(mix + k + 4);
        const unsigned cc[4] = {c.x, c.y, c.z, c.w}, pp[4] = {pv.x, pv.y, pv.z, pv.w}, nn[4] = {nv.x, nv.y, nv.z, nv.w};
        const float mm[8] = {m0.x, m0.y, m0.z, m0.w, m1.x, m1.y, m1.z, m1.w};
        unsigned o[4];
#pragma unroll
        for (int i = 0; i < 4; ++i) {
            const float hc0 = bf_lo(cc[i]), hc1 = bf_hi(cc[i]);
            const float s0 = 0.5f * (bf_lo(pp[i]) + bf_lo(nn[i])), s1 = 0.5f * (bf_hi(pp[i]) + bf_hi(nn[i]));
            o[i] = pk_bf16(hc0 + (s0 - hc0) * mm[2 * i], hc1 + (s1 - hc1) * mm[2 * i + 1]);
        }
        return make_uint4(o[0], o[1], o[2], o[3]);
    }
};

struct TrJob { int in_idx, src_off, K, N, src_ld, dst_ld; unsigned long long dst_off; int tile0; };
constexpr int NTRJOBS = 19;
__device__ const TrJob g_trjobs[NTRJOBS] = {
    {9, 0 * 1048576, 1024, 1024, 1024, 1024, WS_WPROJ + 0ull * 1024 * 1024 * 2, 0},
    {9, 1 * 1048576, 1024, 1024, 1024, 1024, WS_WPROJ + 1ull * 1024 * 1024 * 2, 256},
    {9, 2 * 1048576, 1024, 1024, 1024, 1024, WS_WPROJ + 2ull * 1024 * 1024 * 2, 512},
    {11, 0, 1024, 64, 64, 1024, WS_WPROJ + 3072ull * 1024 * 2, 768},
    {11, 65536, 1024, 64, 64, 1024, WS_WPROJ + 3136ull * 1024 * 2, 784},
    {14, 0, 1024, 64, 64, 1024, WS_WPROJ + 3200ull * 1024 * 2, 800},
    {14, 65536, 1024, 64, 64, 1024, WS_WPROJ + 3264ull * 1024 * 2, 816},
    {16, 0, 1024, 128, 128, 1024, WS_WPROJ + 3328ull * 1024 * 2, 832},
    {12, 0, 64, 1024, 1024, 64, WS_W2T, 864},
    {12, 65536, 64, 1024, 1024, 64, WS_W2T + 1024ull * 64 * 2, 880},
    {15, 0, 64, 1024, 1024, 64, WS_A2T, 896},
    {15, 65536, 64, 1024, 1024, 64, WS_A2T + 1024ull * 64 * 2, 912},
    {17, 0, 128, 1024, 1024, 128, WS_G2T, 928},
    {23, 0, 1024, 1024, 1024, 1024, WS_WO0, 960},
    {29, 0, 1024, 1024, 1024, 1024, WS_WO1, 1216},
    {30, 0, 1024, 2048, 2048, 1024, WS_WQ, 1472},
    {30, 2097152, 1024, 2048, 2048, 1024, WS_WQ + 2048ull * 1024 * 2, 1984},
    {24, 0, 1024, 3104, 3104, 1024, WS_WIN, 2496},
    {0, 0, 0, 0, 0, 0, 0, 2496 + 16 * 49},
};
constexpr int NTRTILES = 2496 + 16 * 49;

DEV void phase0(const Params& p, unsigned char* lds) {
    const int tid = tid_opaque();
    unsigned char* ws = p.ws;
    {
        float* sc = (float*)lds;
        float* red = sc + 9 * 1024;
        float* mods = (float*)(ws + WS_MOD);
        bool have_sc = false;
        for (int task = blockIdx.x; task < 192; task += gridDim.x) {
            if (!have_sc) {
                for (int i = tid; i < 9 * 1024; i += NTHREADS) {
                    const int mb = i >> 10, k = i & 1023;
                    const float cv = mb < 8 ? p.in[1][mb * 1024 + k] : p.in[3][k];
                    sc[i] = cv / (1.0f + __expf(-cv));
                }
                have_sc = true;
            }
            __syncthreads();
            const int l = task / 96, nb = task % 96;
            const int nn = tid & 63, kg = tid >> 6;
            const float* w = p.in[4] + (size_t)l * 1024 * 6144 + nb * 64 + nn;
            float acc[9];
#pragma unroll
            for (int m = 0; m < 9; ++m) acc[m] = 0.f;
            for (int k = kg * 128; k < kg * 128 + 128; ++k) {
                const float wv = w[(size_t)k * 6144];
#pragma unroll
                for (int m = 0; m < 9; ++m) acc[m] += sc[m * 1024 + k] * wv;
            }
#pragma unroll
            for (int m = 0; m < 9; ++m) red[(kg * 9 + m) * 64 + nn] = acc[m];
            __syncthreads();
            for (int i = tid; i < 576; i += NTHREADS) {
                const int m = i >> 6, n2 = i & 63;
                float s = p.in[5][l * 6144 + nb * 64 + n2];
#pragma unroll
                for (int g = 0; g < 8; ++g) s += red[(g * 9 + m) * 64 + n2];
                mods[(size_t)(l * 9 + m) * 6144 + nb * 64 + n2] = s;
            }
            __syncthreads();
        }
        __syncthreads();
    }
    {
        float* tile = (float*)lds;
        for (int tt = blockIdx.x; tt < NTRTILES; tt += gridDim.x) {
            int j = 0;
#pragma unroll 1
            while (j + 1 < NTRJOBS && g_trjobs[j + 1].tile0 <= tt) ++j;
            const TrJob jb = g_trjobs[j];
            const int tl = tt - jb.tile0;
            const int ntn = (jb.N + 63) >> 6;
            const int k0 = (tl / ntn) * 64, n0 = (tl % ntn) * 64;
            const float* src = p.in[jb.in_idx] + jb.src_off;
            bf16_t* dst = (bf16_t*)(ws + jb.dst_off);
            {
                const int kr = tid >> 4, nc4 = (tid & 15) * 4;
#pragma unroll
                for (int i = 0; i < 2; ++i) {
                    const int kk = kr + 32 * i;
                    float4 v = make_float4(0.f, 0.f, 0.f, 0.f);
                    if (n0 + nc4 < jb.N) v = *(const float4*)(src + (size_t)(k0 + kk) * jb.src_ld + n0 + nc4);
                    tile[kk * 65 + nc4 + 0] = v.x; tile[kk * 65 + nc4 + 1] = v.y; tile[kk * 65 + nc4 + 2] = v.z; tile[kk * 65 + nc4 + 3] = v.w;
                }
            }
            __syncthreads();
            {
                const int nn = tid >> 3, kc = (tid & 7) * 8;
                if (n0 + nn < jb.N) {
                    unsigned o[4];
#pragma unroll
                    for (int i = 0; i < 4; ++i) o[i] = pk_bf16(tile[(kc + 2 * i) * 65 + nn], tile[(kc + 2 * i + 1) * 65 + nn]);
                    *(uint4*)(dst + (size_t)(n0 + nn) * jb.dst_ld + k0 + kc) = make_uint4(o[0], o[1], o[2], o[3]);
                }
            }
            __syncthreads();
        }
    }
    {
        const size_t gtid = (size_t)blockIdx.x * NTHREADS + tid, gstride = (size_t)gridDim.x * NTHREADS;
        {
            const float* src = p.in[31];
            bf16_t* dst = (bf16_t*)(ws + WS_KEYS);
            const size_t n8 = (size_t)2 * 8 * 2 * 128 * 128 / 8;
            for (size_t i = gtid; i < n8; i += gstride) {
                const float4 a = *(const float4*)(src + i * 8), b = *(const float4*)(src + i * 8 + 4);
                *(uint4*)(dst + i * 8) = make_uint4(pk_bf16(a.x, a.y), pk_bf16(a.z, a.w), pk_bf16(b.x, b.y), pk_bf16(b.z, b.w));
            }
        }
        bf16_t* wpad = (bf16_t*)(ws + WS_WIN) + (size_t)3104 * 1024;
        for (size_t i = gtid; i < (size_t)96 * 1024 / 8; i += gstride) *(uint4*)(wpad + i * 8) = make_uint4(0, 0, 0, 0);
        const int lane = tid & 63;
        const int gw = blockIdx.x * 8 + (tid >> 6), nw = gridDim.x * 8;
        float* scales = (float*)(ws + WS_PSC);
        for (int rowi = gw * 32; rowi < 2 * 32768; rowi += nw * 32)
        for (int row2 = rowi; row2 < rowi + 32; row2 += 4) {
            float4 v[4][4]; float am[4];
#pragma unroll
            for (int q = 0; q < 4; ++q) {
                const int row = row2 + q, tbl = row >> 15, r = row & 32767;
                const float* srow = p.in[32 + tbl] + (size_t)r * 1024;
                am[q] = 0.f;
#pragma unroll
                for (int i = 0; i < 4; ++i) { v[q][i] = *(const float4*)(srow + 16 * lane + 4 * i); am[q] = fmaxf(am[q], fmaxf(fmaxf(fabsf(v[q][i].x), fabsf(v[q][i].y)), fmaxf(fabsf(v[q][i].z), fabsf(v[q][i].w)))); }
            }
#pragma unroll
            for (int o = 1; o < 64; o <<= 1) { const float a0 = __shfl_xor(am[0], o), a1 = __shfl_xor(am[1], o), a2 = __shfl_xor(am[2], o), a3 = __shfl_xor(am[3], o); am[0] = fmaxf(am[0], a0); am[1] = fmaxf(am[1], a1); am[2] = fmaxf(am[2], a2); am[3] = fmaxf(am[3], a3); }
#pragma unroll
            for (int q = 0; q < 4; ++q) {
                const int row = row2 + q, tbl = row >> 15, r = row & 32767;
                const float scale = am[q] > 0.f ? am[q] * (1.0f / 448.0f) : 1.0f;
                const float inv = 1.0f / scale;
                unsigned w[4];
#pragma unroll
                for (int i = 0; i < 4; ++i) {
                    int t = 0;
                    t = __builtin_amdgcn_cvt_pk_fp8_f32(v[q][i].x * inv, v[q][i].y * inv, t, false);
                    t = __builtin_amdgcn_cvt_pk_fp8_f32(v[q][i].z * inv, v[q][i].w * inv, t, true);
                    w[i] = (unsigned)t;
                }
                *(uint4*)(ws + (tbl ? WS_PV : WS_PU) + ((size_t)(r >> 14) * 8 + (lane >> 3)) * (16384 * 128) + (size_t)(r & 16383) * 128 + 16 * (lane & 7)) = make_uint4(w[0], w[1], w[2], w[3]);
                if (lane == 0) scales[tbl * 32768 + r] = scale;
            }
        }
    }
}

DEV void normmod_store(const float4 (&v)[4], float ss, const float* g, const float* shift, const float* scale, bf16_t* dst, unsigned char* xq, int lane) {
    const float rs = rsqrtf(ss * (1.0f / 1024.0f) + 1e-6f);
#pragma unroll
    for (int i = 0; i < 4; ++i) {
        const int col = i * 256 + lane * 4;
        const float4 gg = *(const float4*)(g + col), sh = *(const float4*)(shift + col), sc = *(const float4*)(scale + col);
        const float y0 = v[i].x * rs * gg.x * (1.f + sc.x) + sh.x, y1 = v[i].y * rs * gg.y * (1.f + sc.y) + sh.y;
        const float y2 = v[i].z * rs * gg.z * (1.f + sc.z) + sh.z, y3 = v[i].w * rs * gg.w * (1.f + sc.w) + sh.w;
        *(uint2*)(dst + col) = make_uint2(pk_bf16(y0, y1), pk_bf16(y2, y3));
        if (xq) {
            const float z0 = __builtin_amdgcn_fmed3f(4.f * y0, -448.f, 448.f), z1 = __builtin_amdgcn_fmed3f(4.f * y1, -448.f, 448.f);
            const float z2 = __builtin_amdgcn_fmed3f(4.f * y2, -448.f, 448.f), z3 = __builtin_amdgcn_fmed3f(4.f * y3, -448.f, 448.f);
            int hi = __builtin_amdgcn_cvt_pk_fp8_f32(z0, z1, 0, false); hi = __builtin_amdgcn_cvt_pk_fp8_f32(z2, z3, hi, true);
            const f32x2v h01 = __builtin_amdgcn_cvt_pk_f32_fp8(hi, false), h23 = __builtin_amdgcn_cvt_pk_f32_fp8(hi, true);
            int lo = __builtin_amdgcn_cvt_pk_fp8_f32(z0 - h01.x, z1 - h01.y, 0, false); lo = __builtin_amdgcn_cvt_pk_fp8_f32(z2 - h23.x, z3 - h23.y, lo, true);
            *(int*)(xq + col) = hi; *(int*)(xq + 1024 + col) = lo;
        }
    }
}
DEV void phase_normmod(const Params& p, int layer, int which, const float* xl, const float* xc, int nrows, bf16_t* dst, unsigned char* xq) {
    const int tid = tid_opaque(), lane = tid & 63;
    const int gw = blockIdx.x * 8 + (tid >> 6), nw = gridDim.x * 8;
    const float* mods = (const float*)(p.ws + WS_MOD) + (size_t)layer * 9 * 6144;
    const float* g = p.in[which ? 7 : 6] + layer * 1024;
    for (int R = gw; R < nrows; R += nw) {
        const float* xr = R < NL ? xl + (size_t)R * 1024 : xc + (size_t)(R - NL) * 1024;
        float4 v[4]; float ss = 0.f;
#pragma unroll
        for (int i = 0; i < 4; ++i) { v[i] = *(const float4*)(xr + i * 256 + lane * 4); ss += v[i].x * v[i].x + v[i].y * v[i].y + v[i].z * v[i].z + v[i].w * v[i].w; }
        ss = wave_allreduce(ss);
        const float* mrow = mods + (size_t)mod_batch(R) * 6144 + (which ? 3 : 0) * 1024;
        normmod_store(v, ss, g, mrow, mrow + 1024, dst + (size_t)R * 1024, xq ? xq + (size_t)R * 2048 : nullptr, lane);
    }
}
DEV void phase_normmix(const Params& p, bf16_t* hdst, bf16_t* xr, bf16_t* xk, bf16_t* xv) {
    const int tid = tid_opaque(), lane = tid & 63;
    const int gw = __builtin_amdgcn_readfirstlane(blockIdx.x * 8 + (tid >> 6)), nw = gridDim.x * 8;
    const float* mods = (const float*)(p.ws + WS_MOD);
    const float* g = p.in[6];
    for (int run = gw; run < NT / 8; run += nw) {
        const int R0 = run * 8;
        const int t0 = R0 < NL ? (R0 & 8191) : ((R0 - NL) & 255), slen = R0 < NL ? 8192 : 256;
        const float* mrow = mods + (size_t)mod_batch(R0) * 6144;
        float4 gg[4], sh[4], sc[4], m0[4], m2[4], m3[4];
#pragma unroll
        for (int i = 0; i < 4; ++i) {
            const int col = i * 256 + lane * 4;
            gg[i] = *(const float4*)(g + col); sh[i] = *(const float4*)(mrow + col); sc[i] = *(const float4*)(mrow + 1024 + col);
            m0[i] = *(const float4*)(p.in[8] + col); m2[i] = *(const float4*)(p.in[8] + 2 * 1024 + col); m3[i] = *(const float4*)(p.in[8] + 3 * 1024 + col);
        }
        auto hrow = [&](int R, float4 (&h)[4]) {
            const float* xrw = R < NL ? p.in[0] + (size_t)R * 1024 : p.in[2] + (size_t)(R - NL) * 1024;
            float ss = 0.f;
#pragma unroll
            for (int i = 0; i < 4; ++i) { h[i] = *(const float4*)(xrw + i * 256 + lane * 4); ss += h[i].x * h[i].x + h[i].y * h[i].y + h[i].z * h[i].z + h[i].w * h[i].w; }
            ss = wave_allreduce(ss);
            const float rs = rsqrtf(ss * (1.0f / 1024.0f) + 1e-6f);
#pragma unroll
            for (int i = 0; i < 4; ++i) {
                h[i].x = h[i].x * rs * gg[i].x * (1.f + sc[i].x) + sh[i].x; h[i].y = h[i].y * rs * gg[i].y * (1.f + sc[i].y) + sh[i].y;
                h[i].z = h[i].z * rs * gg[i].z * (1.f + sc[i].z) + sh[i].z; h[i].w = h[i].w * rs * gg[i].w * (1.f + sc[i].w) + sh[i].w;
            }
        };
        float4 hp[4], hc[4], hn[4];
        if (t0 > 0) hrow(R0 - 1, hp); else { hp[0] = hp[1] = hp[2] = hp[3] = make_float4(0.f, 0.f, 0.f, 0.f); }
        hrow(R0, hc);
#pragma unroll 1
        for (int i8 = 0; i8 < 8; ++i8) {
            const int R = R0 + i8;
            if (t0 + i8 + 1 < slen) hrow(R + 1, hn); else { hn[0] = hn[1] = hn[2] = hn[3] = make_float4(0.f, 0.f, 0.f, 0.f); }
#pragma unroll
            for (int i = 0; i < 4; ++i) {
                const size_t o = (size_t)R * 1024 + i * 256 + lane * 4;
                const float4 c = hc[i];
                const float4 xx = make_float4(0.5f * (hp[i].x + hn[i].x) - c.x, 0.5f * (hp[i].y + hn[i].y) - c.y, 0.5f * (hp[i].z + hn[i].z) - c.z, 0.5f * (hp[i].w + hn[i].w) - c.w);
                *(uint2*)(hdst + o) = make_uint2(pk_bf16(c.x, c.y), pk_bf16(c.z, c.w));
                *(uint2*)(xr + o) = make_uint2(pk_bf16(c.x + xx.x * m0[i].x, c.y + xx.y * m0[i].y), pk_bf16(c.z + xx.z * m0[i].z, c.w + xx.w * m0[i].w));
                *(uint2*)(xk + o) = make_uint2(pk_bf16(c.x + xx.x * m2[i].x, c.y + xx.y * m2[i].y), pk_bf16(c.z + xx.z * m2[i].z, c.w + xx.w * m2[i].w));
                *(uint2*)(xv + o) = make_uint2(pk_bf16(c.x + xx.x * m3[i].x, c.y + xx.y * m3[i].y), pk_bf16(c.z + xx.z * m3[i].z, c.w + xx.w * m3[i].w));
            }
#pragma unroll
            for (int i = 0; i < 4; ++i) { hp[i] = hc[i]; hc[i] = hn[i]; }
        }
    }
}

template <int BN> struct EpiBf16 {
    bf16_t* dst; int ldd; int col0; int act;
    DEV void operator()(const f32x4 (&acc)[4][BN / 64], int m0, int wm, int wn, int fr, int fq) const {
#pragma unroll
        for (int mi = 0; mi < 4; ++mi) {
            const size_t R = (size_t)(m0 + wm * 64 + mi * 16 + fr);
#pragma unroll
            for (int ni = 0; ni < BN / 64; ++ni) {
                const int col = col0 + wn * (BN / 4) + ni * 16 + 4 * fq;
                float v[4] = {acc[mi][ni][0], acc[mi][ni][1], acc[mi][ni][2], acc[mi][ni][3]};
                if (act == 1) {
#pragma unroll
                    for (int j = 0; j < 4; ++j) v[j] = tanhf(v[j]);
                } else if (act == 2) {
#pragma unroll
                    for (int j = 0; j < 4; ++j) v[j] = sigmoidf_(v[j]);
                }
                *(uint2*)(dst + R * ldd + col) = make_uint2(pk_bf16(v[0], v[1]), pk_bf16(v[2], v[3]));
            }
        }
    }
};
struct EpiResid {
    const float* xold_lat; const float* xold_ctx; float* dst_lat; float* dst_ctx; const float* gate; int col0;
    DEV void operator()(const f32x4 (&acc)[4][4], int m0, int wm, int wn, int fr, int fq) const {
#pragma unroll
        for (int mi = 0; mi < 4; ++mi) {
            const int R = m0 + wm * 64 + mi * 16 + fr;
            const float* src = R < NL ? xold_lat + (size_t)R * 1024 : xold_ctx + (size_t)(R - NL) * 1024;
            float* dst = R < NL ? dst_lat + (size_t)R * 1024 : dst_ctx + (size_t)(R - NL) * 1024;
            const float* gr = gate + (size_t)mod_batch(R) * 6144;
#pragma unroll
            for (int ni = 0; ni < 4; ++ni) {
                const int col = col0 + wn * 64 + ni * 16 + 4 * fq;
                const float4 xo = *(const float4*)(src + col), g4 = *(const float4*)(gr + col);
                *(float4*)(dst + col) = make_float4(xo.x + g4.x * acc[mi][ni][0], xo.y + g4.y * acc[mi][ni][1], xo.z + g4.z * acc[mi][ni][2], xo.w + g4.w * acc[mi][ni][3]);
            }
        }
    }
};
struct EpiLr {
    float* dst;
    DEV void operator()(const f32x4 (&acc)[4][2], int m0, int wm, int wn, int fr, int fq) const {
        if (wn != 0) return;
#pragma unroll
        for (int mi = 0; mi < 4; ++mi) {
            const size_t R = (size_t)(m0 + wm * 64 + mi * 16 + fr);
#pragma unroll
            for (int ni = 0; ni < 2; ++ni) { const int col = ni * 16 + 4 * fq; *(float4*)(dst + R * 32 + col) = make_float4(acc[mi][ni][0], acc[mi][ni][1], acc[mi][ni][2], acc[mi][ni][3]); }
        }
    }
};

namespace pg8 {
#define PG8_LAS __attribute__((address_space(3)))
constexpr int BM = 256, BK = 64, HALF = 128, HTB = HALF * BK * 2  , STAGE_BYTES = 8 * HTB, NXCD = 8, WGM = 8;

__host__ __device__ __forceinline__ int lds_byte(int r, int c) { const int st = (r >> 4) * 2 + (c >> 5), rr = r & 15, cc = c & 31, ob = rr * 64 + cc * 2; return st * 1024 + (ob ^ (((ob >> 9) & 1) << 5)); }
__host__ __device__ __forceinline__ void stage_rc(int b, int& R, int& C) { const int st = b / 1024, sb = b % 1024, swz = sb ^ (((sb >> 9) & 1) << 5); R = (st >> 1) * 16 + swz / 64; C = (st & 1) * 32 + (swz % 64) / 2; }
__host__ __device__ __forceinline__ int perm32(int rho) { const int n = rho >> 4, i = rho & 15; return 8 * (i >> 2) + 4 * n + (i & 3); }
struct Unit { int pm, pn; };
struct Gemm { const bf16_t* A; const bf16_t* Bt; int M, N, K; };
struct StaticOrder {
    int nM, nN, nwg, G, c;
    __host__ __device__ void init(int M, int N, int G_, int c_) { nM = M / BM; nN = N / BM; nwg = nM * nN; G = G_; c = c_; }
    __host__ __device__ bool next(int i, Unit& u) const {
        const long L = (long)i * G + c; if (L >= nwg) return false;
        int wgid = (int)L; { const int q = nwg / NXCD, r = nwg % NXCD, xcd = wgid % NXCD, off = wgid / NXCD; wgid = (xcd < r ? xcd * (q + 1) : r * (q + 1) + (xcd - r) * q) + off; }
        const int nig = WGM * nN, gid = wgid / nig, fm = gid * WGM, gsz = (nM - fm) < WGM ? (nM - fm) : WGM;
        u.pm = fm + ((wgid % nig) % gsz); u.pn = (wgid % nig) / gsz; return true;
    }
    __device__ __forceinline__ void a_ready(const Unit&) const {}
    __device__ __forceinline__ void done(const Unit&) const {}
};
template <class Epi, class Sched, bool STAMP = false>
__device__ __forceinline__ void gemm_phase(PG8_LAS unsigned char* lds, const Gemm g, const Sched& S, const Epi& E, unsigned long long* stamps) {
    const int tid = tid_opaque(), wid = __builtin_amdgcn_readfirstlane(tid >> 6), lane = tid & 63, wr = wid >> 2, wc = wid & 3, fr = lane & 15, fq = lane >> 4;
    const int K = g.K, nt = K / BK;
    int ts_lo = 0, ts_hi = 0, nts = 0; const unsigned long long rt_entry = STAMP ? (unsigned long long)wall_clock64() : 0ull;
#define PG8_STAMP() do { if (STAMP && wid == 0 && nts < 64) { const unsigned long long _c = (unsigned long long)clock64(); \
        ts_lo = (lane == nts) ? (int)(unsigned)_c : ts_lo; ts_hi = (lane == nts) ? (int)(unsigned)(_c >> 32) : ts_hi; ++nts; } } while (0)
    PG8_STAMP();
    unsigned voffA[2], voffB[2];
#pragma unroll
    for (int i = 0; i < 2; ++i) { int R, C; stage_rc(tid * 16 + i * 8192, R, C); const int Rb = Epi::PERM ? ((R & ~31) + perm32(R & 31)) : R;
        voffA[i] = (unsigned)(R * K + C) * 2u; voffB[i] = (unsigned)(Rb * K + C) * 2u; }
    const size_t kstep = (size_t)(BK * 2);
    const size_t hstep = (size_t)HALF * K * 2;
    const size_t tstep = 2 * hstep;
    const unsigned ldsw = (unsigned)wid * 1024u;
    const int aoff = lds_byte(wr * 64 + fr, fq * 8), boff = lds_byte(wc * 32 + fr, fq * 8);
#define PG8_SA(b, h) (((b) * 2 + (h)) * HTB)
#define PG8_SB(b, h) ((4 + (b) * 2 + (h)) * HTB)
#define PG8_STAGE(bufoff, gbase, voff) do { _Pragma("unroll") for (int _i = 0; _i < 2; ++_i) \
        __builtin_amdgcn_global_load_lds((const unsigned*)((const char*)(gbase) + (voff)[_i]), (PG8_LAS unsigned*)(lds + (bufoff) + ldsw + _i * 8192), 16, 0, 0); } while (0)
#define PG8_LDA(dst, b, h) do { _Pragma("unroll") for (int m = 0; m < 4; ++m) _Pragma("unroll") for (int k = 0; k < 2; ++k) dst[m][k] = *(const PG8_LAS bf16x8*)(lds + PG8_SA(b, h) + aoff + m * 2048 + k * 1024); } while (0)
#define PG8_LDB(dst, b, h) do { _Pragma("unroll") for (int n = 0; n < 2; ++n) _Pragma("unroll") for (int k = 0; k < 2; ++k) dst[n][k] = *(const PG8_LAS bf16x8*)(lds + PG8_SB(b, h) + boff + n * 2048 + k * 1024); } while (0)
#define PG8_MMA(ai, bj, At, Bt) do { __builtin_amdgcn_s_setprio(1); _Pragma("unroll") for (int m = 0; m < 4; ++m) _Pragma("unroll") for (int n = 0; n < 2; ++n) _Pragma("unroll") for (int k = 0; k < 2; ++k) \
        acc[ai][bj][m][n] = __builtin_amdgcn_mfma_f32_16x16x32_bf16(Bt[n][k], At[m][k], acc[ai][bj][m][n], 0, 0, 0); __builtin_amdgcn_s_setprio(0); } while (0)
#define PG8_WAIT_V(n) asm volatile("s_waitcnt vmcnt(" #n ")" ::: "memory")
#define PG8_WAIT_L(n) asm volatile("s_waitcnt lgkmcnt(" #n ")" ::: "memory")
#define PG8_BAR __builtin_amdgcn_s_barrier()
#define PG8_SCHED __builtin_amdgcn_sched_barrier(0)
    Unit cur, nxt; int ui = 0;
    if (!S.next(0, cur)) return;
    f32x4 acc[2][2][4][2];
#pragma unroll
    for (int a = 0; a < 2; ++a)
#pragma unroll
        for (int b = 0; b < 2; ++b)
#pragma unroll
            for (int m = 0; m < 4; ++m)
#pragma unroll
                for (int n = 0; n < 2; ++n) acc[a][b][m][n] = (f32x4){0.f, 0.f, 0.f, 0.f};
    bf16x8 At[4][2], B0[2][2], B1[2][2];
    const char* cA = (const char*)g.A + (size_t)cur.pm * tstep; const char* cB = (const char*)g.Bt + (size_t)cur.pn * tstep;
    S.a_ready(cur);
    PG8_STAGE(PG8_SB(0, 0), cB, voffB); PG8_STAGE(PG8_SA(0, 0), cA, voffA); PG8_STAGE(PG8_SB(0, 1), cB + hstep, voffB); PG8_STAGE(PG8_SA(0, 1), cA + hstep, voffA);
    if (wr == 1) PG8_BAR;
    PG8_WAIT_V(4); PG8_BAR;
    PG8_STAGE(PG8_SB(1, 0), cB + kstep, voffB); PG8_STAGE(PG8_SA(1, 0), cA + kstep, voffA); PG8_STAGE(PG8_SB(1, 1), cB + hstep + kstep, voffB);
    PG8_WAIT_V(6); PG8_BAR;
    PG8_STAMP();
    for (;;) {
        const bool has_next = S.next(ui + 1, nxt);
        const char* nA = has_next ? (const char*)g.A + (size_t)nxt.pm * tstep : cA; const char* nB = has_next ? (const char*)g.Bt + (size_t)nxt.pn * tstep : cB;
        for (int t = 0; t < nt; t += 2) {
            const bool last = (t == nt - 2);
            const char* a1 = cA + (size_t)(t + 1) * kstep;
            const char* a2 = last ? nA : cA + (size_t)(t + 2) * kstep; const char* b2 = last ? nB : cB + (size_t)(t + 2) * kstep;
            const char* a3 = a2 + kstep; const char* b3 = b2 + kstep;
            if (last && has_next) S.a_ready(nxt);
            PG8_LDB(B0, 0, 0); PG8_SCHED; PG8_LDA(At, 0, 0); PG8_STAGE(PG8_SA(1, 1), a1 + hstep, voffA);
            PG8_WAIT_L(8); PG8_BAR; PG8_WAIT_L(0); PG8_MMA(0, 0, At, B0); PG8_BAR; PG8_SCHED;
            PG8_LDB(B1, 0, 1); PG8_STAGE(PG8_SB(0, 0), b2, voffB);
            PG8_BAR; PG8_WAIT_L(0); PG8_MMA(0, 1, At, B1); PG8_BAR;
            PG8_LDA(At, 0, 1); PG8_STAGE(PG8_SA(0, 0), a2, voffA);
            PG8_BAR; PG8_WAIT_L(0); PG8_MMA(1, 0, At, B0); PG8_BAR; PG8_SCHED;
            PG8_STAGE(PG8_SB(0, 1), b2 + hstep, voffB);
            PG8_WAIT_V(6); PG8_BAR; PG8_MMA(1, 1, At, B1); PG8_BAR;
            PG8_LDB(B0, 1, 0); PG8_SCHED; PG8_LDA(At, 1, 0); PG8_STAGE(PG8_SA(0, 1), a2 + hstep, voffA);
            PG8_WAIT_L(8); PG8_BAR; PG8_WAIT_L(0); PG8_MMA(0, 0, At, B0); PG8_BAR; PG8_SCHED;
            PG8_LDB(B1, 1, 1); PG8_STAGE(PG8_SB(1, 0), b3, voffB);
            PG8_BAR; PG8_WAIT_L(0); PG8_MMA(0, 1, At, B1); PG8_BAR;
            PG8_LDA(At, 1, 1); PG8_STAGE(PG8_SA(1, 0), a3, voffA);
            PG8_BAR; PG8_WAIT_L(0); PG8_MMA(1, 0, At, B0); PG8_BAR; PG8_SCHED;
            PG8_STAGE(PG8_SB(1, 1), b3 + hstep, voffB);
            PG8_WAIT_V(6); PG8_BAR; PG8_MMA(1, 1, At, B1); PG8_BAR;
        }
        PG8_STAMP();
        if constexpr (!Epi::AFTER_DRAIN) { E(acc, cur, wr, wc, fr, fq); S.done(cur); }
        PG8_STAMP();
        if (!has_next) break;
#pragma unroll
        for (int a = 0; a < 2; ++a)
#pragma unroll
            for (int b = 0; b < 2; ++b)
#pragma unroll
                for (int m = 0; m < 4; ++m)
#pragma unroll
                    for (int n = 0; n < 2; ++n) acc[a][b][m][n] = (f32x4){0.f, 0.f, 0.f, 0.f};
        cur = nxt; cA = nA; cB = nB; ++ui;
    }
    PG8_WAIT_V(0);
    if (wr == 0) PG8_BAR;
    PG8_BAR;
    if constexpr (Epi::AFTER_DRAIN) { E.fused(acc, cur, wr, wc, fr, fq, lds, wid, lane); S.done(cur); }
    PG8_STAMP();
    if (STAMP && wid == 0) { stamps[lane] = lane < nts ? (((unsigned long long)(unsigned)ts_hi << 32) | (unsigned)ts_lo) : 0ull;
        if (lane == 62) stamps[62] = rt_entry; if (lane == 63) stamps[63] = (unsigned long long)wall_clock64(); }
#undef PG8_STAMP
#undef PG8_SA
#undef PG8_SB
#undef PG8_STAGE
#undef PG8_LDA
#undef PG8_LDB
#undef PG8_MMA
#undef PG8_WAIT_V
#undef PG8_WAIT_L
#undef PG8_BAR
#undef PG8_SCHED
}
struct EpiBf16Tiles {
    static constexpr bool PERM = true, AFTER_DRAIN = false;
    bf16_t* d0; int ld0; int ntile0; bf16_t* d1; int ld1;
    __device__ __forceinline__ void operator()(const f32x4 (&acc)[2][2][4][2], const Unit& u, int wr, int wc, int fr, int fq) const {
        bf16_t* base = u.pn < ntile0 ? d0 : d1; const int ld = u.pn < ntile0 ? ld0 : ld1; const int colt = (u.pn < ntile0 ? u.pn : u.pn - ntile0) * BM;
        const int row0 = u.pm * BM + wr * 64 + fr, col0 = colt + wc * 32 + 8 * fq;
#pragma unroll
        for (int ai = 0; ai < 2; ++ai)
#pragma unroll
            for (int m = 0; m < 4; ++m) { bf16_t* rowp = base + (size_t)(row0 + ai * HALF + m * 16) * ld + col0;
#pragma unroll
                for (int bj = 0; bj < 2; ++bj) { const f32x4 v0 = acc[ai][bj][m][0], v1 = acc[ai][bj][m][1];
                    *(uint4*)(rowp + bj * HALF) = make_uint4(pk_bf16(v0[0], v0[1]), pk_bf16(v0[2], v0[3]), pk_bf16(v1[0], v1[1]), pk_bf16(v1[2], v1[3])); } }
    }
};
struct EpiResid256 {
    static constexpr bool PERM = false, AFTER_DRAIN = false;
    const float* xold_lat; const float* xold_ctx; float* dst_lat; float* dst_ctx; const float* gate;
    __device__ __forceinline__ void operator()(const f32x4 (&acc)[2][2][4][2], const Unit& u, int wr, int wc, int fr, int fq) const {
        const int row0 = u.pm * BM + wr * 64 + fr, col0 = u.pn * BM + wc * 32 + 4 * fq;
#pragma unroll
        for (int ai = 0; ai < 2; ++ai)
#pragma unroll
            for (int m = 0; m < 4; ++m) {
                const int R = row0 + ai * HALF + m * 16;
                const float* src = R < NL ? xold_lat + (size_t)R * 1024 : xold_ctx + (size_t)(R - NL) * 1024;
                float* dst = R < NL ? dst_lat + (size_t)R * 1024 : dst_ctx + (size_t)(R - NL) * 1024;
                const float* gr = gate + (size_t)mod_batch(R) * 6144;
#pragma unroll
                for (int bj = 0; bj < 2; ++bj)
#pragma unroll
                    for (int n = 0; n < 2; ++n) {
                        const int col = col0 + bj * HALF + n * 16;
                        const float4 xo = *(const float4*)(src + col), g4 = *(const float4*)(gr + col);
                        const f32x4 a = acc[ai][bj][m][n];
                        *(float4*)(dst + col) = make_float4(xo.x + g4.x * a[0], xo.y + g4.y * a[1], xo.z + g4.z * a[2], xo.w + g4.w * a[3]);
                    }
            }
    }
};
}

DEV void phase_rw_proj1(const Params& p, unsigned char* lds, int which, const bf16_t* A, bf16_t* dst) {
    pg8::Gemm g{A, (const bf16_t*)(p.ws + WS_WPROJ) + (size_t)which * 1024 * 1024, NT, 1024, 1024};
    pg8::StaticOrder so; so.init(NT, 1024, gridDim.x, blockIdx.x);
    pg8::EpiBf16Tiles ep{dst, 1024, 4, dst, 1024};
    pg8::gemm_phase((PG8_LAS unsigned char*)lds, g, so, ep, nullptr);
    __syncthreads();
}
DEV void phase_rw_lora(const Params& p, unsigned char* lds) {
    unsigned char* ws = p.ws;
    const bf16_t* h = (const bf16_t*)(ws + WS_S + 0 * U_BYTES);
    const bf16_t* wproj = (const bf16_t*)(ws + WS_WPROJ);
    const int nunits = (NT / 128) * 3;
    for (int u = blockIdx.x; u < nunits; u += gridDim.x) {
        const int mt = u / 3, lg = u % 3, m0 = mt * 128;
        const int mixid = lg == 0 ? 1 : (lg == 1 ? 4 : 5);
        ALoadMix al{h, p.in[8] + mixid * 1024, h, 1024};
        EpiBf16<128> ep{(bf16_t*)(ws + WS_S + 4 * U_BYTES), 384, lg * 128, lg == 0 ? 1 : (lg == 1 ? 0 : 2)};
        gemm_unit<128>(lds, al, wproj + (size_t)(3072 + lg * 128) * 1024, 1024, m0, ep);
    }
}

template <int N> DEV float dpp_shr0(float x) { return __int_as_float(__builtin_amdgcn_update_dpp(0, __float_as_int(x), 0x110 + N, 0xF, 0xF, true)); }
template <int CTRL> DEV float dpp_quad(float x) { return __int_as_float(__builtin_amdgcn_update_dpp(0, __float_as_int(x), CTRL, 0xF, 0xF, false)); }
DEV int tile_off(int row, int ch) { return row * 128 + ((ch ^ (row & 7)) << 4); }
DEV int tile_off2(int row, int ch) { return row * 128 + ((ch ^ ((row ^ (row >> 3)) & 7)) << 4); }
DEV void phase_rw_scan(const Params& p, unsigned char* lds) {
    const int tid = tid_opaque(), lane = tid & 63;
    const int wv = __builtin_amdgcn_readfirstlane(tid >> 6);
    const int fr = lane & 15, fq = lane >> 4;
    unsigned char* ws = p.ws;
    constexpr int SH = 0, SL = 8192, AT = 16384  , RT = 20480  , BT = 24576  , KT = 28672  , BKT = 32768  , UV = 49152  , NT = 65536  ;
    constexpr int MFA = 69632, MFK = 70656, X0 = 71680, VS = 75776  , PP = 83968, PM = 88064, PI = 92160, AA = 96256  ;
    constexpr int PL = 116736  , YB = 117760, LDS_END = 121856;
    const bf16_t* rbuf = (const bf16_t*)(ws + WS_S + 3 * U_BYTES);
    const bf16_t* kbuf = (const bf16_t*)(ws + WS_S + 5 * U_BYTES);
    const bf16_t* vbuf = (const bf16_t*)(ws + WS_S + 1 * U_BYTES);
    const bf16_t* lora = (const bf16_t*)(ws + WS_S + 4 * U_BYTES);
    for (int unit = blockIdx.x; unit < 256; unit += gridDim.x) {
        const int b = unit >> 5, hh = (unit >> 1) & 15, d = unit & 1;
        bf16_t* ydst = (bf16_t*)(ws + WS_S + (size_t)(d ? 2 : 0) * U_BYTES);
        float* bonus = (float*)(ws + WS_BONUS) + (size_t)((d * NB + b) * 16 + hh) * 8448;
        const int s_e = (tid >> 4) & 15, j0 = (tid & 15) * 4;
        const int ni = wv & 3;
        auto Rof = [&](int c, int s) -> int {
            if (c < 16) { const int q = c * 16 + s; return NL + b * 256 + (d ? 255 - q : q); }
            const int q = (c - 16) * 16 + s; return b * 8192 + (d ? 8191 - q : q);
        };
        constexpr int CST = LDS_END;
        uint2 pr = make_uint2(0, 0), pk = pr, pv = pr; uint4 paw[2], paa[2];
        if (wv >= 4) {
            const int ct = (tid - 256) * 16;
            *(float4*)(lds + CST + 0 * 4096 + ct) = *(const float4*)(p.in[18] + hh * 64 + j0);
            *(float4*)(lds + CST + 1 * 4096 + ct) = *(const float4*)(p.in[19] + hh * 64 + j0);
            *(float4*)(lds + CST + 2 * 4096 + ct) = *(const float4*)(p.in[20] + hh * 64 + j0);
            *(float4*)(lds + CST + 3 * 4096 + ct) = *(const float4*)(p.in[10] + d * 1024 + hh * 64 + ni * 16 + fq * 4);
            *(float4*)(lds + CST + 4 * 4096 + ct) = *(const float4*)(p.in[13] + d * 1024 + hh * 64 + ni * 16 + fq * 4);
#pragma unroll
            for (int ks = 0; ks < 2; ++ks) {
                *(uint4*)(lds + CST + (5 + ks) * 4096 + ct) = *(const uint4*)((const bf16_t*)(ws + WS_W2T) + (size_t)d * 1024 * 64 + (size_t)(hh * 64 + ni * 16 + fr) * 64 + ks * 32 + fq * 8);
                *(uint4*)(lds + CST + (7 + ks) * 4096 + ct) = *(const uint4*)((const bf16_t*)(ws + WS_A2T) + (size_t)d * 1024 * 64 + (size_t)(hh * 64 + ni * 16 + fr) * 64 + ks * 32 + fq * 8);
            }
        }
        auto load_lora = [&](int c) {
            const size_t R2 = (size_t)Rof(c, fr);
#pragma unroll
            for (int ks = 0; ks < 2; ++ks) { paw[ks] = *(const uint4*)(lora + R2 * 384 + d * 64 + ks * 32 + fq * 8); paa[ks] = *(const uint4*)(lora + R2 * 384 + 128 + d * 64 + ks * 32 + fq * 8); }
        };
        auto load_rkv = [&](int c) {
            const size_t off = (size_t)Rof(c, s_e) * 1024 + hh * 64 + j0;
            pr = *(const uint2*)(rbuf + off); pk = *(const uint2*)(kbuf + off); pv = *(const uint2*)(vbuf + off);
        };
        auto step_up = [&](int c) {
            const int ct = (tid - 256) * 16;
            const float4 bias_w = *(const float4*)(lds + CST + 3 * 4096 + ct), bias_a = *(const float4*)(lds + CST + 4 * 4096 + ct);
            bf16x8 bfw[2], bfa[2];
#pragma unroll
            for (int ks = 0; ks < 2; ++ks) { bfw[ks] = *(const bf16x8*)(lds + CST + (5 + ks) * 4096 + ct); bfa[ks] = *(const bf16x8*)(lds + CST + (7 + ks) * 4096 + ct); }
            f32x4 accw = {0.f, 0.f, 0.f, 0.f}, acca = {0.f, 0.f, 0.f, 0.f};
#pragma unroll
            for (int ks = 0; ks < 2; ++ks) { accw = __builtin_amdgcn_mfma_f32_16x16x32_bf16(bfw[ks], as_bf16x8(paw[ks]), accw, 0, 0, 0); acca = __builtin_amdgcn_mfma_f32_16x16x32_bf16(bfa[ks], as_bf16x8(paa[ks]), acca, 0, 0, 0); }
            const int n = ni * 16 + fq * 4;
            const float bw[4] = {bias_w.x, bias_w.y, bias_w.z, bias_w.w}, ba[4] = {bias_a.x, bias_a.y, bias_a.z, bias_a.w};
            float P[4], Pm[4], Pi[4], av[4];
#pragma unroll
            for (int j = 0; j < 4; ++j) {
                const float e = 0.6065306597f * __builtin_amdgcn_rcpf(1.0f + __expf(-(accw[j] + bw[j])));
                float s = e;
                s += dpp_shr0<1>(s); s += dpp_shr0<2>(s); s += dpp_shr0<4>(s); s += dpp_shr0<8>(s);
                P[j] = __expf(-s); Pi[j] = __builtin_amdgcn_rcpf(P[j]); Pm[j] = P[j] * __expf(e);
                av[j] = __builtin_amdgcn_rcpf(1.0f + __expf(-(acca[j] + ba[j])));
            }
            const int pb = (c & 1) * 16384;
            *(float4*)(lds + PP + pb + (fr * 64 + n) * 4) = make_float4(P[0], P[1], P[2], P[3]);
            *(float4*)(lds + PM + pb + (fr * 64 + n) * 4) = make_float4(Pm[0], Pm[1], Pm[2], Pm[3]);
            *(float4*)(lds + PI + pb + (fr * 64 + n) * 4) = make_float4(Pi[0], Pi[1], Pi[2], Pi[3]);
            *(float4*)(lds + AA + pb + (fr * 64 + n) * 4) = make_float4(av[0], av[1], av[2], av[3]);
            if (fr == 15) *(float4*)(lds + PL + (c & 3) * 256 + n * 4) = make_float4(P[0], P[1], P[2], P[3]);
        };
        auto step_vec = [&](int c) {
            const int eo = (s_e * 64 + j0) * 4, pb = (c & 1) * 16384, tb = (c & 1) * 8192, ct = (tid - 256) * 16;
            const float4 kk_c = *(const float4*)(lds + CST + 0 * 4096 + ct), ka_c = *(const float4*)(lds + CST + 1 * 4096 + ct), rk_c = *(const float4*)(lds + CST + 2 * 4096 + ct);
            const float4 a4 = *(const float4*)(lds + AA + pb + eo), P4 = *(const float4*)(lds + PP + pb + eo), Pm4 = *(const float4*)(lds + PM + pb + eo), Pi4 = *(const float4*)(lds + PI + pb + eo);
            const float kx[4] = {bf_lo(pk.x), bf_hi(pk.x), bf_lo(pk.y), bf_hi(pk.y)};
            const float rx[4] = {bf_lo(pr.x), bf_hi(pr.x), bf_lo(pr.y), bf_hi(pr.y)};
            const float av[4] = {a4.x, a4.y, a4.z, a4.w}, Pv[4] = {P4.x, P4.y, P4.z, P4.w}, Pmv[4] = {Pm4.x, Pm4.y, Pm4.z, Pm4.w}, Piv[4] = {Pi4.x, Pi4.y, Pi4.z, Pi4.w};
            const float kkc[4] = {kk_c.x, kk_c.y, kk_c.z, kk_c.w}, kac[4] = {ka_c.x, ka_c.y, ka_c.z, ka_c.w}, rkc[4] = {rk_c.x, rk_c.y, rk_c.z, rk_c.w};
            float t[4], n2 = 0.f;
#pragma unroll
            for (int j = 0; j < 4; ++j) { t[j] = kx[j] * kkc[j]; n2 += t[j] * t[j]; }
            n2 = row16_allreduce(n2);
            const float inv = 1.0f / fmaxf(sqrtf(n2), 1e-12f);
            float at[4], bt[4], kt[4], rt[4], bon = 0.f;
#pragma unroll
            for (int j = 0; j < 4; ++j) {
                const float kkv = t[j] * inv;
                const float kd = kx[j] * (1.0f + (av[j] - 1.0f) * kac[j]);
                const float bq = kkv * av[j];
                bon += rx[j] * kd * rkc[j];
                at[j] = -kkv * Pmv[j]; bt[j] = bq * Piv[j]; kt[j] = kd * Piv[j]; rt[j] = rx[j] * Pv[j];
            }
            bon = row16_allreduce(bon);
            if ((tid & 15) == 0) { const int Rb = Rof(c, s_e); bonus[Rb < NL ? 256 + (Rb & 8191) : ((Rb - NL) & 255)] = bon; }
            const int ro = tile_off(s_e, j0 >> 3) + (j0 & 7) * 2;
            *(uint2*)(lds + AT + (c & 1) * 2048 + ro) = make_uint2(pk_bf16(at[0], at[1]), pk_bf16(at[2], at[3]));
            *(uint2*)(lds + RT + (c & 1) * 2048 + ro) = make_uint2(pk_bf16(rt[0], rt[1]), pk_bf16(rt[2], rt[3]));
            const unsigned b01 = pk_bf16(bt[0], bt[1]), b23 = pk_bf16(bt[2], bt[3]), k01 = pk_bf16(kt[0], kt[1]), k23 = pk_bf16(kt[2], kt[3]);
            *(uint2*)(lds + BT + (c & 1) * 2048 + ro) = make_uint2(b01, b23);
            *(uint2*)(lds + KT + (c & 1) * 2048 + ro) = make_uint2(k01, k23);
            const unsigned bw2[4] = {b01 & 0xffffu, b01 >> 16, b23 & 0xffffu, b23 >> 16}, kw2[4] = {k01 & 0xffffu, k01 >> 16, k23 & 0xffffu, k23 >> 16};
            const unsigned vw[4] = {pv.x & 0xffffu, pv.x >> 16, pv.y & 0xffffu, pv.y >> 16};
            const int e0 = (s_e & 7) * 2, cq = s_e >> 3;
#pragma unroll
            for (int j = 0; j < 4; ++j) {
                const int row = j0 + j;
                *(bf16_t*)(lds + BKT + tb + tile_off2(row, 0 + cq) + e0) = (bf16_t)bw2[j];
                *(bf16_t*)(lds + BKT + tb + tile_off2(row, 2 + cq) + e0) = (bf16_t)kw2[j];
                *(bf16_t*)(lds + BKT + tb + tile_off2(row, 4 + cq) + e0) = (bf16_t)bw2[j];
                *(bf16_t*)(lds + UV + tb + tile_off2(row, 2 + cq) + e0) = (bf16_t)vw[j];
            }
        };
        f32x4 accY = {0.f, 0.f, 0.f, 0.f};
        auto prod_S = [&](int c) {
            const int vt = wv & 3, tb = (c & 1) * 2048;
            f32x4 accX = {0.f, 0.f, 0.f, 0.f}, accR = {0.f, 0.f, 0.f, 0.f};
#pragma unroll
            for (int ks = 0; ks < 2; ++ks) {
                const int ch = ks * 4 + fq;
                const bf16x8 sh = *(const bf16x8*)(lds + SH + tile_off(vt * 16 + fr, ch)), sl = *(const bf16x8*)(lds + SL + tile_off(vt * 16 + fr, ch));
                const bf16x8 fa = *(const bf16x8*)(lds + AT + tb + tile_off(fr, ch)), frr = *(const bf16x8*)(lds + RT + tb + tile_off(fr, ch));
                accX = __builtin_amdgcn_mfma_f32_16x16x32_bf16(sh, fa, accX, 0, 0, 0);
                accR = __builtin_amdgcn_mfma_f32_16x16x32_bf16(sh, frr, accR, 0, 0, 0);
                accX = __builtin_amdgcn_mfma_f32_16x16x32_bf16(sl, fa, accX, 0, 0, 0);
                accR = __builtin_amdgcn_mfma_f32_16x16x32_bf16(sl, frr, accR, 0, 0, 0);
            }
            accY = accR;
            {
                const u32x2v av = *(const u32x2v*)(lds + UV + (c & 1) * 8192 + tile_off2(vt * 16 + fr, 2 + (fq >> 1)) + (fq & 1) * 8);
                const u32x2v mh = *(const u32x2v*)(lds + MFK + (fr * 4 + fq) * 8), ml = *(const u32x2v*)(lds + MFK + 512 + (fr * 4 + fq) * 8);
                accX = __builtin_amdgcn_mfma_f32_16x16x16bf16_1k(__builtin_bit_cast(s16x4v, av), __builtin_bit_cast(s16x4v, mh), accX, 0, 0, 0);
                accX = __builtin_amdgcn_mfma_f32_16x16x16bf16_1k(__builtin_bit_cast(s16x4v, av), __builtin_bit_cast(s16x4v, ml), accX, 0, 0, 0);
            }
#pragma unroll
            for (int j = 0; j < 4; ++j) *(float*)(lds + X0 + ((vt * 16 + 4 * fq + j) * 16 + fr) * 4) = accX[j];
        };
        auto prod_V = [&](int c) {
            const int tb = (c & 1) * 2048, w4 = wv & 3;
            f32x4 m = {0.f, 0.f, 0.f, 0.f};
#pragma unroll
            for (int ks = 0; ks < 2; ++ks) {
                const int ch = ks * 4 + fq;
                const bf16x8 fa = *(const bf16x8*)(lds + ((w4 & 1) ? KT : BT) + tb + tile_off(fr, ch));
                const bf16x8 fb = *(const bf16x8*)(lds + ((w4 & 2) ? RT : AT) + tb + tile_off(fr, ch));
                m = __builtin_amdgcn_mfma_f32_16x16x32_bf16(fa, fb, m, 0, 0, 0);
            }
            if (w4 == 0) {
                float* mf = (float*)(lds + MFA);
#pragma unroll
                for (int j = 0; j < 4; ++j) mf[(fr * 4 + j) * 4 + fq] = (4 * fq + j < fr) ? m[j] : 0.f;
            } else if (w4 == 1) {
                const float m0 = (4 * fq + 0 < fr) ? m[0] : 0.f, m1 = (4 * fq + 1 < fr) ? m[1] : 0.f, m2 = (4 * fq + 2 < fr) ? m[2] : 0.f, m3 = (4 * fq + 3 < fr) ? m[3] : 0.f;
                const unsigned h01 = pk_bf16(m0, m1), h23 = pk_bf16(m2, m3);
                *(uint2*)(lds + MFK + (fr * 4 + fq) * 8) = make_uint2(h01, h23);
                *(uint2*)(lds + MFK + 512 + (fr * 4 + fq) * 8) = make_uint2(pk_bf16(m0 - bf_lo(h01), m1 - bf_hi(h01)), pk_bf16(m2 - bf_lo(h23), m3 - bf_hi(h23)));
            } else {
                const float m0 = (4 * fq + 0 <= fr) ? m[0] : 0.f, m1 = (4 * fq + 1 <= fr) ? m[1] : 0.f, m2 = (4 * fq + 2 <= fr) ? m[2] : 0.f, m3 = (4 * fq + 3 <= fr) ? m[3] : 0.f;
                const uint2 o = make_uint2(pk_bf16(m0, m1), pk_bf16(m2, m3));
                const int colb = (w4 == 2 ? 0 : 16) + 4 * fq;
                *(uint2*)(lds + NT + tb + tile_off(fr, colb >> 3) + (colb & 7) * 2) = o;
                if (w4 == 2) *(uint2*)(lds + NT + tb + tile_off(fr, (32 + 4 * fq) >> 3) + ((32 + 4 * fq) & 7) * 2) = o;
            }
        };
        auto step_rec = [&](int c) {
            const int v = tid >> 2, pq = tid & 3;
            float cc[16];
#pragma unroll
            for (int i = 0; i < 4; ++i) { const float4 q = *(const float4*)(lds + X0 + (v * 16 + 4 * i) * 4); cc[4 * i] = q.x; cc[4 * i + 1] = q.y; cc[4 * i + 2] = q.z; cc[4 * i + 3] = q.w; }
            float4 ma[16];
#pragma unroll
            for (int t = 1; t < 16; ++t) ma[t] = *(const float4*)(lds + MFA + ((t * 4 + pq) * 4) * 4);
            ma[0] = make_float4(0.f, 0.f, 0.f, 0.f);
            float uown[4] = {0.f, 0.f, 0.f, 0.f}, uall[16];
#pragma unroll
            for (int t = 0; t < 16; ++t) {
                float s = uown[0] * ma[t].x; s = fmaf(uown[1], ma[t].y, s); s = fmaf(uown[2], ma[t].z, s); s = fmaf(uown[3], ma[t].w, s);
                s += dpp_quad<0xB1>(s); s += dpp_quad<0x4E>(s);
                const float u = cc[t] + s;
                uall[t] = u;
                if (pq == (t & 3)) uown[t >> 2] = u;
            }
            if (pq < 2) {
                unsigned o[8];
#pragma unroll
                for (int i = 0; i < 8; ++i) {
                    const unsigned hi = pk_bf16(uall[2 * i], uall[2 * i + 1]);
                    o[i] = pq ? pk_bf16(uall[2 * i] - bf_lo(hi), uall[2 * i + 1] - bf_hi(hi)) : hi;
                }
                const int cb = pq ? 4 : 0;
                *(uint4*)(lds + UV + (c & 1) * 8192 + tile_off2(v, cb)) = make_uint4(o[0], o[1], o[2], o[3]);
                *(uint4*)(lds + UV + (c & 1) * 8192 + tile_off2(v, cb + 1)) = make_uint4(o[4], o[5], o[6], o[7]);
            }
        };
        f32x4 accS[2];
        accS[0] = (f32x4){0.f, 0.f, 0.f, 0.f}; accS[1] = (f32x4){0.f, 0.f, 0.f, 0.f};
        auto step_upd = [&](int c) {
            const int vt = wv & 3;
            bf16x8 fuv[2];
#pragma unroll
            for (int ks = 0; ks < 2; ++ks) fuv[ks] = *(const bf16x8*)(lds + UV + (c & 1) * 8192 + tile_off2(vt * 16 + fr, ks * 4 + fq));
            if (wv < 4) {
#pragma unroll
                for (int ks = 0; ks < 2; ++ks) accY = __builtin_amdgcn_mfma_f32_16x16x32_bf16(fuv[ks], *(const bf16x8*)(lds + NT + (c & 1) * 2048 + tile_off(fr, ks * 4 + fq)), accY, 0, 0, 0);
                *(float4*)(lds + YB + (fr * 64 + vt * 16 + 4 * fq) * 4) = make_float4(accY[0], accY[1], accY[2], accY[3]);
            }
#pragma unroll
            for (int k2 = 0; k2 < 2; ++k2) {
                const int kt = 2 * (wv >> 2) + k2;
                f32x4 a = accS[k2];
#pragma unroll
                for (int ks = 0; ks < 2; ++ks) a = __builtin_amdgcn_mfma_f32_16x16x32_bf16(*(const bf16x8*)(lds + BKT + (c & 1) * 8192 + tile_off2(kt * 16 + fr, ks * 4 + fq)), fuv[ks], a, 0, 0, 0);
                const float4 pl = *(const float4*)(lds + PL + (c & 3) * 256 + (kt * 16 + 4 * fq) * 4);
                a[0] *= pl.x; a[1] *= pl.y; a[2] *= pl.z; a[3] *= pl.w;
                accS[k2] = a;
                const unsigned h01 = pk_bf16(a[0], a[1]), h23 = pk_bf16(a[2], a[3]);
                const unsigned l01 = pk_bf16(a[0] - bf_lo(h01), a[1] - bf_hi(h01)), l23 = pk_bf16(a[2] - bf_lo(h23), a[3] - bf_hi(h23));
                const int kc = kt * 16 + 4 * fq;
                const int so = tile_off(vt * 16 + fr, kc >> 3) + (kc & 7) * 2;
                *(uint2*)(lds + SH + so) = make_uint2(h01, h23);
                *(uint2*)(lds + SL + so) = make_uint2(l01, l23);
            }
        };
        for (int i = tid; i < LDS_END / 16; i += NTHREADS) *(uint4*)(lds + i * 16) = make_uint4(0, 0, 0, 0);
        if (wv >= 4) { load_lora(0); load_rkv(0); }
        __syncthreads();
        if (wv >= 4) { step_up(0); load_lora(1); }
        __syncthreads();
        if (wv >= 4) { step_vec(0); step_up(1); load_rkv(1); load_lora(2); }
        __syncthreads();
        if (wv >= 4) prod_V(0);
        __syncthreads();
        auto ystore = [&](int c) {
            const float4 y4 = *(const float4*)(lds + YB + (s_e * 64 + j0) * 4);
            *(uint2*)(ydst + (size_t)Rof(c, s_e) * 1024 + hh * 64 + j0) = make_uint2(pk_bf16(y4.x, y4.y), pk_bf16(y4.z, y4.w));
        };
        if (wv < 4) {
            unsigned pfd = 0;
            for (int c = 0; c < 528; ++c) {
                if (c > 0) ystore(c - 1);
                if (c + 4 < 528 && tid < 80) {
                    const bf16_t* pf;
                    if (tid < 48) { const int ten = tid >> 4; pf = (ten == 0 ? rbuf : (ten == 1 ? kbuf : vbuf)) + (size_t)Rof(c + 4, tid & 15) * 1024 + hh * 64; }
                    else { const int i = tid - 48; pf = lora + (size_t)Rof(c + 4, i >> 1) * 384 + (i & 1) * 128 + d * 64; }
                    asm volatile("global_load_dword %0, %1, off" : "=v"(pfd) : "v"(pf) : "memory");
                }
                __builtin_amdgcn_s_setprio(3);
                prod_S(c);
                step_rec(c);
                __builtin_amdgcn_s_setprio(0);
                __syncthreads();
                step_upd(c);
                __syncthreads();
                asm volatile("" :: "v"(pfd));
            }
        } else {
            for (int c = 0; c < 528; ++c) {
                if (c + 1 < 528) step_vec(c + 1);
                if (c + 2 < 528) { step_up(c + 2); load_rkv(c + 2); }
                if (c + 3 < 528) load_lora(c + 3);
                __syncthreads();
                step_upd(c);
                if (c + 1 < 528) prod_V(c + 1);
                __syncthreads();
            }
        }
        if (wv < 4) ystore(527);
        __syncthreads();
    }
}

DEV void phase_rw_readout(const Params& p) {
    const int tid = tid_opaque(), lane = tid & 63, wv = tid >> 6, wm = wv >> 2, wn = wv & 3;
    const int fr = lane & 15, fq = lane >> 4;
    unsigned char* ws = p.ws;
    const bf16_t* y0b = (const bf16_t*)(ws + WS_S + 0 * U_BYTES);
    const bf16_t* y1b = (const bf16_t*)(ws + WS_S + 2 * U_BYTES);
    const bf16_t* vb = (const bf16_t*)(ws + WS_S + 1 * U_BYTES);
    const bf16_t* lora = (const bf16_t*)(ws + WS_S + 4 * U_BYTES);
    const bf16_t* g2t = (const bf16_t*)(ws + WS_G2T);
    bf16_t* ao = (bf16_t*)(ws + WS_S + 5 * U_BYTES);
    const float* bon0 = (const float*)(ws + WS_BONUS);
    const float* bon1 = bon0 + (size_t)NB * 16 * 8448;
    const float* lnw = p.in[21];
    const float* lnb = p.in[22];
    const int nunits = (NT / 128) * 4;
    for (int u = blockIdx.x; u < nunits; u += gridDim.x) {
        const int mt = u >> 2, nt = u & 3, m0 = mt * 128;
        const int hh = nt * 4 + wn;
        f32x4 acc[4][4];
#pragma unroll
        for (int mi = 0; mi < 4; ++mi)
#pragma unroll
            for (int ni = 0; ni < 4; ++ni) acc[mi][ni] = (f32x4){0.f, 0.f, 0.f, 0.f};
#pragma unroll 2
        for (int ks = 0; ks < 4; ++ks) {
            bf16x8 af[4], bfr[4];
#pragma unroll
            for (int mi = 0; mi < 4; ++mi) af[mi] = *(const bf16x8*)(lora + (size_t)(m0 + wm * 64 + mi * 16 + fr) * 384 + 256 + ks * 32 + fq * 8);
#pragma unroll
            for (int ni = 0; ni < 4; ++ni) bfr[ni] = *(const bf16x8*)(g2t + (size_t)(hh * 64 + ni * 16 + fr) * 128 + ks * 32 + fq * 8);
#pragma unroll
            for (int mi = 0; mi < 4; ++mi)
#pragma unroll
                for (int ni = 0; ni < 4; ++ni) acc[mi][ni] = __builtin_amdgcn_mfma_f32_16x16x32_bf16(bfr[ni], af[mi], acc[mi][ni], 0, 0, 0);
        }
#pragma unroll
        for (int mi = 0; mi < 4; ++mi) {
            const size_t R = (size_t)(m0 + wm * 64 + mi * 16 + fr);
            float yv[4][4]; float sum = 0.f;
#pragma unroll
            for (int ni = 0; ni < 4; ++ni) {
                const int col = hh * 64 + ni * 16 + 4 * fq;
                const uint2 a = *(const uint2*)(y0b + R * 1024 + col), b2 = *(const uint2*)(y1b + R * 1024 + col);
                yv[ni][0] = bf_lo(a.x) + bf_lo(b2.x); yv[ni][1] = bf_hi(a.x) + bf_hi(b2.x); yv[ni][2] = bf_lo(a.y) + bf_lo(b2.y); yv[ni][3] = bf_hi(a.y) + bf_hi(b2.y);
                sum += (yv[ni][0] + yv[ni][1]) + (yv[ni][2] + yv[ni][3]);
            }
            sum += __shfl_xor(sum, 16); sum += __shfl_xor(sum, 32);
            const float mu = sum * (1.0f / 64.0f);
            float q = 0.f;
#pragma unroll
            for (int ni = 0; ni < 4; ++ni)
#pragma unroll
                for (int j = 0; j < 4; ++j) { const float dlt = yv[ni][j] - mu; q += dlt * dlt; }
            q += __shfl_xor(q, 16); q += __shfl_xor(q, 32);
            const float rstd = rsqrtf(q * (1.0f / 64.0f) + 64e-5f);
            const size_t bidx = (size_t)(((R < NL ? (R >> 13) : ((R - NL) >> 8)) * 16 + hh)) * 8448 + (R < NL ? 256 + (R & 8191) : ((R - NL) & 255));
            const float bs = bon0[bidx] + bon1[bidx];
#pragma unroll
            for (int ni = 0; ni < 4; ++ni) {
                const int col = hh * 64 + ni * 16 + 4 * fq;
                const uint2 vv = *(const uint2*)(vb + R * 1024 + col);
                const float4 lw = *(const float4*)(lnw + col), lb = *(const float4*)(lnb + col);
                const float o0 = ((yv[ni][0] - mu) * rstd * lw.x + lb.x + bs * bf_lo(vv.x)) * acc[mi][ni][0];
                const float o1 = ((yv[ni][1] - mu) * rstd * lw.y + lb.y + bs * bf_hi(vv.x)) * acc[mi][ni][1];
                const float o2 = ((yv[ni][2] - mu) * rstd * lw.z + lb.z + bs * bf_lo(vv.y)) * acc[mi][ni][2];
                const float o3 = ((yv[ni][3] - mu) * rstd * lw.w + lb.w + bs * bf_hi(vv.y)) * acc[mi][ni][3];
                *(uint2*)(ao + R * 1024 + col) = make_uint2(pk_bf16(o0, o1), pk_bf16(o2, o3));
            }
        }
    }
}

DEV void phase_wo(const Params& p, unsigned char* lds, int layer) {
    unsigned char* ws = p.ws;
    const bf16_t* ao = (const bf16_t*)(ws + WS_S + (size_t)(layer ? 0 : 5) * U_BYTES);
    const bf16_t* wot = (const bf16_t*)(ws + (layer ? WS_WO1 : WS_WO0));
    float* ctxr = (float*)(ws + WS_CTXR);
    const float* gate = (const float*)(ws + WS_MOD) + (size_t)layer * 9 * 6144 + 2 * 1024;
    const int M = layer ? NL : NT;
    pg8::Gemm g{ao, wot, M, 1024, 1024};
    pg8::StaticOrder so; so.init(M, 1024, gridDim.x, blockIdx.x);
    pg8::EpiResid256 ep{layer ? p.out : p.in[0], layer ? ctxr : p.in[2], p.out, ctxr, gate};
    pg8::gemm_phase((PG8_LAS unsigned char*)lds, g, so, ep, nullptr);
    __syncthreads();
}

struct EpiQTile {
    unsigned char* lds;
    DEV void operator()(const f32x4 (&acc)[4][4], int m0, int wm, int wn, int fr, int fq) const {
        const int pp = wn >> 1;
#pragma unroll
        for (int mi = 0; mi < 4; ++mi) {
            const int m = wm * 64 + mi * 16 + fr;
#pragma unroll
            for (int ni = 0; ni < 4; ++ni) {
                const int c = (wn & 1) * 64 + ni * 16 + 4 * fq;
                *(uint2*)(lds + pp * 32768 + m * 256 + (((c >> 3) ^ (m & 15)) << 4) + (c & 7) * 2) = make_uint2(pk_bf16(acc[mi][ni][0], acc[mi][ni][1]), pk_bf16(acc[mi][ni][2], acc[mi][ni][3]));
            }
        }
    }
};
DEV void phase_peer_select(const Params& p, unsigned char* lds, int layer) {
    const int tid = tid_opaque(), lane = tid & 63, wv = tid >> 6, wm = wv >> 2, wn = wv & 3;
    const int fr = lane & 15, fq = lane >> 4;
    unsigned char* ws = p.ws;
    const bf16_t* hp = (const bf16_t*)(ws + WS_S + (size_t)(layer ? 0 : 1) * U_BYTES);
    const bf16_t* wqt = (const bf16_t*)(ws + WS_WQ) + (size_t)layer * 2048 * 1024;
    const bf16_t* keys = (const bf16_t*)(ws + WS_KEYS) + (size_t)layer * 8 * 2 * 128 * 128;
    int* pl_idx = (int*)(ws + WS_S + 3 * U_BYTES);
    float* pl_gate = (float*)(ws + WS_S + 3 * U_BYTES + (size_t)NT * 128 * 4);
    unsigned* slist = (unsigned*)lds;
    unsigned* tlist = (unsigned*)(lds + 256 * 132 * 4);
    const int mtiles = layer ? NL / 128 : NT / 128;
    for (int u = blockIdx.x; u < mtiles * 8; u += gridDim.x) {
        const int mt = u >> 3, head = u & 7, m0 = mt * 128;
        ALoadPlain al{hp, 1024};
        EpiQTile ep{lds};
        gemm_unit<256>(lds, al, wqt + (size_t)head * 256 * 1024, 1024, m0, ep);
        __syncthreads();
        const int pp = wn >> 1, nk0 = (wn & 1) * 64;
        f32x4 sc[4][4];
#pragma unroll
        for (int mi = 0; mi < 4; ++mi)
#pragma unroll
            for (int ni = 0; ni < 4; ++ni) sc[mi][ni] = (f32x4){0.f, 0.f, 0.f, 0.f};
        const bf16_t* kb = keys + (size_t)(head * 2 + pp) * 16384;
#pragma unroll
        for (int ks = 0; ks < 4; ++ks) {
            bf16x8 af[4], bfr[4];
            const int ch = ks * 4 + fq;
#pragma unroll
            for (int mi = 0; mi < 4; ++mi) { const int m = wm * 64 + mi * 16 + fr; af[mi] = *(const bf16x8*)(lds + pp * 32768 + m * 256 + ((ch ^ (m & 15)) << 4)); }
#pragma unroll
            for (int ni = 0; ni < 4; ++ni) bfr[ni] = *(const bf16x8*)(kb + (size_t)(nk0 + ni * 16 + fr) * 128 + ks * 32 + fq * 8);
#pragma unroll
            for (int mi = 0; mi < 4; ++mi)
#pragma unroll
                for (int ni = 0; ni < 4; ++ni) sc[mi][ni] = __builtin_amdgcn_mfma_f32_16x16x32_bf16(bfr[ni], af[mi], sc[mi][ni], 0, 0, 0);
        }
        __syncthreads();
#pragma unroll
        for (int mi = 0; mi < 4; ++mi) {
            const int m = wm * 64 + mi * 16 + fr;
#pragma unroll
            for (int ni = 0; ni < 4; ++ni) {
                const int n = nk0 + ni * 16 + 4 * fq;
                uint4 o;
                o.x = (mono_u32(sc[mi][ni][0]) & ~127u) | (unsigned)(127 - (n + 0));
                o.y = (mono_u32(sc[mi][ni][1]) & ~127u) | (unsigned)(127 - (n + 1));
                o.z = (mono_u32(sc[mi][ni][2]) & ~127u) | (unsigned)(127 - (n + 2));
                o.w = (mono_u32(sc[mi][ni][3]) & ~127u) | (unsigned)(127 - (n + 3));
                *(uint4*)(slist + (size_t)(pp * 128 + m) * 132 + n) = o;
            }
        }
        __syncthreads();
#pragma unroll 1
        for (int ps = 0; ps < 4; ++ps) {
            const int L = ps * 64 + (tid >> 3), g8 = tid & 7;
            unsigned t[16];
            {
                const unsigned* srcp = slist + (size_t)L * 132 + g8 * 16;
#pragma unroll
                for (int i = 0; i < 4; ++i) { const uint4 v = *(const uint4*)(srcp + i * 4); t[4 * i] = v.x; t[4 * i + 1] = v.y; t[4 * i + 2] = v.z; t[4 * i + 3] = v.w; }
            }
#pragma unroll
            for (int k = 2; k <= 16; k <<= 1)
#pragma unroll
                for (int j = k >> 1; j > 0; j >>= 1)
#pragma unroll
                    for (int i = 0; i < 16; ++i) {
                        const int l = i ^ j;
                        if (l > i) {
                            const unsigned mx = max(t[i], t[l]), mn = min(t[i], t[l]);
                            if ((i & k) == 0) { t[i] = mx; t[l] = mn; } else { t[i] = mn; t[l] = mx; }
                        }
                    }
#pragma unroll
            for (int rnd = 0; rnd < 3; ++rnd) {
                unsigned c[16];
#pragma unroll
                for (int i = 0; i < 16; ++i) {
                    const int src_i = __float_as_int(__uint_as_float(t[15 - i]));
                    const int b = rnd == 0 ? __builtin_amdgcn_update_dpp(0, src_i, 0xB1, 0xF, 0xF, false)
                                : (rnd == 1 ? __builtin_amdgcn_update_dpp(0, src_i, 0x4E, 0xF, 0xF, false)
                                            : __builtin_amdgcn_update_dpp(0, src_i, 0x141, 0xF, 0xF, false));
                    c[i] = max(t[i], (unsigned)b);
                }
#pragma unroll
                for (int j = 8; j > 0; j >>= 1)
#pragma unroll
                    for (int i = 0; i < 16; ++i) {
                        const int l = i ^ j;
                        if (l > i) { const unsigned mx = max(c[i], c[l]), mn = min(c[i], c[l]); c[i] = mx; c[l] = mn; }
                    }
#pragma unroll
                for (int i = 0; i < 16; ++i) t[i] = c[i];
            }
            if (g8 == 0) {
#pragma unroll
                for (int i = 0; i < 4; ++i) *(uint4*)(tlist + L * 16 + i * 4) = make_uint4(t[4 * i], t[4 * i + 1], t[4 * i + 2], t[4 * i + 3]);
            }
        }
        __syncthreads();
        if (tid < 128) {
            float v0[16], v1[16];
#pragma unroll
            for (int i = 0; i < 16; ++i) { v0[i] = unmono_u32(tlist[tid * 16 + i] & ~127u); v1[i] = unmono_u32(tlist[(128 + tid) * 16 + i] & ~127u); }
            unsigned cd[16];
#pragma unroll
            for (int i = 0; i < 16; ++i) cd[i] = 0u;
#pragma unroll
            for (int i = 0; i < 16; ++i) {
#pragma unroll
                for (int j = 0; j < 16; ++j) {
                    if ((i + 1) * (j + 1) <= 16) {
                        unsigned x = (mono_u32(v0[i] + v1[j]) & ~255u) | (unsigned)(255 - (i * 16 + j));
#pragma unroll
                        for (int q = 0; q < 16; ++q) { const unsigned mx = max(cd[q], x); x = min(cd[q], x); cd[q] = mx; }
                    }
                }
            }
            float sv[16]; int ex[16];
#pragma unroll
            for (int q = 0; q < 16; ++q) {
                const int slot = 255 - (int)(cd[q] & 255u);
                const unsigned a = tlist[tid * 16 + (slot >> 4)], b2 = tlist[(128 + tid) * 16 + (slot & 15)];
                sv[q] = unmono_u32(a & ~127u) + unmono_u32(b2 & ~127u);
                ex[q] = (127 - (int)(a & 127u)) * 128 + (127 - (int)(b2 & 127u));
            }
            float mx = sv[0];
#pragma unroll
            for (int q = 1; q < 16; ++q) mx = fmaxf(mx, sv[q]);
            float den = 0.f;
#pragma unroll
            for (int q = 0; q < 16; ++q) { sv[q] = __expf(sv[q] - mx); den += sv[q]; }
            const float rden = 1.0f / den;
            const size_t base = ((size_t)head * NT + (m0 + tid)) * 16;
#pragma unroll
            for (int i = 0; i < 4; ++i) {
                *(int4*)(pl_idx + base + i * 4) = make_int4(ex[4 * i], ex[4 * i + 1], ex[4 * i + 2], ex[4 * i + 3]);
                *(float4*)(pl_gate + base + i * 4) = make_float4(sv[4 * i] * rden, sv[4 * i + 1] * rden, sv[4 * i + 2] * rden, sv[4 * i + 3] * rden);
            }
        }
        __syncthreads();
    }
}

typedef float f32x2 __attribute__((ext_vector_type(2)));
typedef unsigned int u32x4 __attribute__((ext_vector_type(4)));
typedef unsigned int u32x2 __attribute__((ext_vector_type(2)));
#define PS_LOAD(buf, ee, h) { _Pragma("unroll") for (int e = 0; e < 8; ++e) { \
        const u32x4 t4 = __builtin_amdgcn_raw_buffer_load_b128(rs, ((unsigned)ee[(h) * 8 + e] << 7) + ch16, 0, 0); buf[e] = make_uint4(t4.x, t4.y, t4.z, t4.w); } }
#define PS_IDX(ee, Rr) { _Pragma("unroll") for (int i = 0; i < 4; ++i) { const int4 t = *(const int4*)(pl_idx + ((size_t)sub * NT + (Rr)) * 16 + 4 * i); \
        ee[4 * i] = t.x; ee[4 * i + 1] = t.y; ee[4 * i + 2] = t.z; ee[4 * i + 3] = t.w; } }
DEV long pk64(unsigned lo, unsigned hi) { return (long)(((unsigned long long)hi << 32) | (unsigned long long)lo); }
DEV void phase_peer_u(const Params& p, unsigned char* lds, int layer) {
    const int tid = tid_opaque(), lane = tid & 63, wv = tid >> 6, sub = lane >> 3, ch = lane & 7, fm = lane & 15, fg = lane >> 4;
    const int ng = gridDim.x >> 3, x = blockIdx.x & 7, wq = blockIdx.x >> 3;
    if (wq < ng) {
        const int gw = __builtin_amdgcn_readfirstlane(wq * 8 + wv), nw = ng * 8;
        unsigned char* ws = p.ws;
        const unsigned char* tab = ws + WS_PU + ((size_t)layer * 8 + x) * (16384 * 128);
        const int* pl_idx = (const int*)(ws + WS_S + 3 * U_BYTES);
        const unsigned char* xq = ws + WS_S + 2 * U_BYTES + (size_t)(fm & 1) * 1024 + 128 * x + 16 * fg;
        bf16_t* pd = (bf16_t*)(ws + WS_S + 5 * U_BYTES) + (size_t)x * NT * 128 + 16 * (fm >> 1) + 4 * fg;
        unsigned char* tile = lds + wv * 16384;
        const unsigned cE16 = 16u * (unsigned)(ch ^ (sub >> 1)), cO16 = cE16 ^ 64u;
        const unsigned aoff0 = (unsigned)fm * 128u + (unsigned)((fg ^ (fm >> 1)) << 4), aoff1 = (unsigned)fm * 128u + (unsigned)(((4 + fg) ^ (fm >> 1)) << 4);
        const int nrows = layer ? NL : NT;
        int eN[16];
#define PU_DMA(ee, q) { _Pragma("unroll") for (int j = 0; j < 4; ++j) { const int jj = (q) * 4 + j; \
        __builtin_amdgcn_global_load_lds((const unsigned*)(tab + (((unsigned)ee[jj] << 7) + ((jj & 1) ? cO16 : cE16))), (unsigned*)(tile + jj * 1024 + lane * 16), 16, 0, 0); } }
        const unsigned ta0 = (unsigned)(size_t)((LAS3 unsigned char*)tile) + aoff0, ta1 = (unsigned)(size_t)((LAS3 unsigned char*)tile) + aoff1;
#define PU_MMA(q) { u32x4 a0, a1, a2, a3; \
        asm volatile("ds_read_b128 %0, %4 offset:%6\n\tds_read_b128 %1, %5 offset:%6\n\tds_read_b128 %2, %4 offset:%7\n\tds_read_b128 %3, %5 offset:%7\n\ts_waitcnt lgkmcnt(0)" \
            : "=&v"(a0), "=&v"(a1), "=&v"(a2), "=&v"(a3) : "v"(ta0), "v"(ta1), "n"((q) * 4096), "n"((q) * 4096 + 2048) : "memory"); \
        f32x4 c4 = {0.f, 0.f, 0.f, 0.f}, c5 = {0.f, 0.f, 0.f, 0.f}; \
        c4 = __builtin_amdgcn_mfma_f32_16x16x32_fp8_fp8(pk64(a0.x, a0.y), pk64(bC0.x, bC0.y), c4, 0, 0, 0); \
        c5 = __builtin_amdgcn_mfma_f32_16x16x32_fp8_fp8(pk64(a2.x, a2.y), pk64(bC0.x, bC0.y), c5, 0, 0, 0); \
        c4 = __builtin_amdgcn_mfma_f32_16x16x32_fp8_fp8(pk64(a0.z, a0.w), pk64(bC0.z, bC0.w), c4, 0, 0, 0); \
        c5 = __builtin_amdgcn_mfma_f32_16x16x32_fp8_fp8(pk64(a2.z, a2.w), pk64(bC0.z, bC0.w), c5, 0, 0, 0); \
        c4 = __builtin_amdgcn_mfma_f32_16x16x32_fp8_fp8(pk64(a1.x, a1.y), pk64(bC1.x, bC1.y), c4, 0, 0, 0); \
        c5 = __builtin_amdgcn_mfma_f32_16x16x32_fp8_fp8(pk64(a3.x, a3.y), pk64(bC1.x, bC1.y), c5, 0, 0, 0); \
        c4 = __builtin_amdgcn_mfma_f32_16x16x32_fp8_fp8(pk64(a1.z, a1.w), pk64(bC1.z, bC1.w), c4, 0, 0, 0); \
        c5 = __builtin_amdgcn_mfma_f32_16x16x32_fp8_fp8(pk64(a3.z, a3.w), pk64(bC1.z, bC1.w), c5, 0, 0, 0); \
        acc[(q) * 2] = c4; acc[(q) * 2 + 1] = c5; }
        int R = gw;
#pragma unroll
        for (int i = 0; i < 16; ++i) eN[i] = 0;
        uint4 bC0 = make_uint4(0, 0, 0, 0), bC1 = bC0;
        if (R < nrows) {
            PS_IDX(eN, R);
            PU_DMA(eN, 0); PU_DMA(eN, 1); PU_DMA(eN, 2); PU_DMA(eN, 3);
            bC0 = *(const uint4*)(xq + (size_t)R * 2048); bC1 = *(const uint4*)(xq + (size_t)R * 2048 + 64);
            const int R1 = min(R + nw, nrows - 1);
            PS_IDX(eN, R1);
            asm volatile("s_waitcnt vmcnt(0)" : "+v"(bC0.x), "+v"(bC1.x), "+v"(eN[0]), "+v"(eN[4]), "+v"(eN[8]), "+v"(eN[12]) :: "memory");
        }
        for (; R < nrows; R += nw) {
            const int Rn = R + nw, R1 = min(Rn, nrows - 1), R2 = min(Rn + nw, nrows - 1);
            const bool more = Rn < nrows;
            u32x4 i0, i1, i2, i3, nb0, nb1;
            {
                const int* iptr = pl_idx + ((size_t)sub * NT + R2) * 16;
                const unsigned char* xptr = xq + (size_t)R1 * 2048;
                asm volatile("global_load_dwordx4 %0, %6, off\n\tglobal_load_dwordx4 %1, %6, off offset:16\n\tglobal_load_dwordx4 %2, %6, off offset:32\n\tglobal_load_dwordx4 %3, %6, off offset:48\n\t"
                             "global_load_dwordx4 %4, %7, off\n\tglobal_load_dwordx4 %5, %7, off offset:64"
                             : "=&v"(i0), "=&v"(i1), "=&v"(i2), "=&v"(i3), "=&v"(nb0), "=&v"(nb1) : "v"(iptr), "v"(xptr) : "memory");
            }
            f32x4 acc[8];
#define PU_STEP(q) { if (more) asm volatile("s_waitcnt vmcnt(19)" ::: "memory"); else asm volatile("s_waitcnt vmcnt(0)" ::: "memory"); \
            PU_MMA(q); if (more) { PU_DMA(eN, q); } }
            PU_STEP(0); PU_STEP(1); PU_STEP(2); PU_STEP(3);
            f32x4 s0[4], s1[2], s2;
#pragma unroll
            for (int i = 0; i < 4; ++i)
#pragma unroll
                for (int r = 0; r < 4; ++r) s0[i][r] = (fm & 2) ? acc[2 * i + 1][r] : acc[2 * i][r];
#pragma unroll
            for (int i = 0; i < 2; ++i)
#pragma unroll
                for (int r = 0; r < 4; ++r) s1[i][r] = (fm & 4) ? s0[2 * i + 1][r] : s0[2 * i][r];
#pragma unroll
            for (int r = 0; r < 4; ++r) { const float t = (fm & 8) ? s1[1][r] : s1[0][r]; s2[r] = t + dpp_quad<0xB1>(t); }
            if (!(fm & 1)) *(uint2*)(pd + (size_t)R * 128) = make_uint2(pk_bf16(s2[0], s2[1]), pk_bf16(s2[2], s2[3]));
            if (more) asm volatile("s_waitcnt vmcnt(17)" : "+v"(i0), "+v"(i1), "+v"(i2), "+v"(i3), "+v"(nb0), "+v"(nb1) :: "memory");
            else asm volatile("s_waitcnt vmcnt(0)" : "+v"(i0), "+v"(i1), "+v"(i2), "+v"(i3), "+v"(nb0), "+v"(nb1) :: "memory");
            eN[0] = i0.x; eN[1] = i0.y; eN[2] = i0.z; eN[3] = i0.w; eN[4] = i1.x; eN[5] = i1.y; eN[6] = i1.z; eN[7] = i1.w;
            eN[8] = i2.x; eN[9] = i2.y; eN[10] = i2.z; eN[11] = i2.w; eN[12] = i3.x; eN[13] = i3.y; eN[14] = i3.z; eN[15] = i3.w;
            bC0 = make_uint4(nb0.x, nb0.y, nb0.z, nb0.w); bC1 = make_uint4(nb1.x, nb1.y, nb1.z, nb1.w);
        }
        asm volatile("s_waitcnt vmcnt(0)" ::: "memory");
    }
}
DEV void phase_peer_c(const Params& p, int layer) {
    const int tid = tid_opaque(), lane = tid & 63;
    const int gw = blockIdx.x * 8 + (tid >> 6), nw = gridDim.x * 8;
    unsigned char* ws = p.ws;
    const float* usc = (const float*)(ws + WS_PSC) + layer * 16384;
    const float* vsc = (const float*)(ws + WS_PSC) + 32768 + layer * 16384;
    const int* pl_idx = (const int*)(ws + WS_S + 3 * U_BYTES);
    const float* pl_gate = (const float*)(ws + WS_S + 3 * U_BYTES + (size_t)NT * 128 * 4);
    float* pd = (float*)(ws + WS_S + 4 * U_BYTES);
    const bf16_t* pdh = (const bf16_t*)(ws + WS_S + 5 * U_BYTES);
    const int nrows = layer ? NL : NT;
    const int head0 = 2 * (lane & 3), kk = lane >> 2;
    for (int R = gw; R < nrows; R += nw) {
        float d0 = 0.f, d1 = 0.f;
#pragma unroll
        for (int xx = 0; xx < 8; ++xx) { const unsigned t = *(const unsigned*)(pdh + ((size_t)xx * NT + R) * 128 + 2 * lane); d0 += bf_lo(t); d1 += bf_hi(t); }
        const size_t po = ((size_t)head0 * NT + R) * 16 + kk;
        const int e0 = pl_idx[po], e1 = pl_idx[po + (size_t)NT * 16];
        const float g0 = pl_gate[po], g1 = pl_gate[po + (size_t)NT * 16];
        d0 *= usc[e0] * 0.25f; d1 *= usc[e1] * 0.25f;
        const float c0 = g0 * vsc[e0] * 0.5f * d0 * (1.0f + erff(d0 * 0.70710678118f));
        const float c1 = g1 * vsc[e1] * 0.5f * d1 * (1.0f + erff(d1 * 0.70710678118f));
        pd[(size_t)R * 128 + 16 * head0 + kk] = c0;
        pd[(size_t)R * 128 + 16 * head0 + 16 + kk] = c1;
    }
}
DEV void phase_peer_v(const Params& p, int layer) {
    const int tid = tid_opaque(), lane = tid & 63, sub = lane >> 3, ch = lane & 7;
    const int ng = gridDim.x >> 3, x = blockIdx.x & 7, wq = blockIdx.x >> 3;
    if (wq < ng) {
        const int gw = __builtin_amdgcn_readfirstlane(wq * 8 + (tid >> 6)), nw = ng * 8;
        unsigned char* ws = p.ws;
        const __amdgpu_buffer_rsrc_t rs = __builtin_amdgcn_make_buffer_rsrc((void*)(ws + WS_PV + ((size_t)layer * 8 + x) * (16384 * 128)), 0, 16384 * 128, 0x00020000);
        const int* pl_idx = (const int*)(ws + WS_S + 3 * U_BYTES);
        const float* cb = (const float*)(ws + WS_S + 4 * U_BYTES) + 16 * sub;
        float* ctxr = (float*)(ws + WS_CTXR);
        const float* mods = (const float*)(ws + WS_MOD) + (size_t)layer * 9 * 6144 + 5 * 1024;
        const unsigned ch16 = 16u * (unsigned)ch;
        const int col = 128 * x + 16 * ch + 2 * sub;
        const int nrows = layer ? NL : NT;
        uint4 bufA[8], bufB[8];
        int eC[16], eN[16];
        float cC[16], cN[16];
#define PS_CF(cc, Rr) { _Pragma("unroll") for (int i = 0; i < 4; ++i) { const float4 t = *(const float4*)(cb + (size_t)(Rr) * 128 + 4 * i); \
        cc[4 * i] = t.x; cc[4 * i + 1] = t.y; cc[4 * i + 2] = t.z; cc[4 * i + 3] = t.w; } }
#define PV_FMA(accv, av) asm("v_fma_f32 %0, %1, %2, %0" : "+v"(accv) : "v"(cf), "v"(av))
#define PV_AXPY(buf, h) { _Pragma("unroll") for (int e = 0; e < 8; ++e) { \
        const float cf = cC[(h) * 8 + e]; const unsigned vw[4] = {buf[e].x, buf[e].y, buf[e].z, buf[e].w}; \
        _Pragma("unroll") for (int i = 0; i < 4; ++i) { \
            const f32x2 a = __builtin_amdgcn_cvt_pk_f32_fp8((int)vw[i], false), b2 = __builtin_amdgcn_cvt_pk_f32_fp8((int)vw[i], true); \
            PV_FMA(a16[4 * i], a.x); PV_FMA(a16[4 * i + 1], a.y); PV_FMA(a16[4 * i + 2], b2.x); PV_FMA(a16[4 * i + 3], b2.y); } } }
        int R = gw;
#pragma unroll
        for (int i = 0; i < 16; ++i) { eC[i] = 0; eN[i] = 0; cC[i] = 0.f; cN[i] = 0.f; }
        if (R < nrows) { PS_IDX(eC, R); PS_CF(cC, R); PS_LOAD(bufA, eC, 0); }
        for (; R < nrows; R += nw) {
            const int Rn = R + nw;
            if (Rn < nrows) { PS_IDX(eN, Rn); PS_CF(cN, Rn); }
            PS_LOAD(bufB, eC, 1);
            float* xrow = (R < NL ? p.out + (size_t)R * 1024 : ctxr + (size_t)(R - NL) * 1024) + col;
            const float2 xa = *(const float2*)xrow, ga = *(const float2*)(mods + (size_t)mod_batch(R) * 6144 + col);
            float a16[16];
#pragma unroll
            for (int i = 0; i < 16; ++i) a16[i] = 0.f;
            PV_AXPY(bufA, 0);
            if (Rn < nrows) { PS_LOAD(bufA, eN, 0); }
            PV_AXPY(bufB, 1);
            float s8[8], t4[4];
#pragma unroll
            for (int j = 0; j < 8; ++j) { const u32x2 r = __builtin_amdgcn_permlane32_swap(__float_as_uint(a16[j]), __float_as_uint(a16[8 + j]), false, false); s8[j] = __uint_as_float(r.x) + __uint_as_float(r.y); }
#pragma unroll
            for (int j = 0; j < 4; ++j) { const u32x2 r = __builtin_amdgcn_permlane16_swap(__float_as_uint(s8[j]), __float_as_uint(s8[4 + j]), false, false); t4[j] = __uint_as_float(r.x) + __uint_as_float(r.y); }
            const float wa0 = t4[0] + dpp_ror<8>(t4[0]), wa1 = t4[1] + dpp_ror<8>(t4[1]), wb0 = t4[2] + dpp_ror<8>(t4[2]), wb1 = t4[3] + dpp_ror<8>(t4[3]);
            const float w0 = (lane & 8) ? wb0 : wa0, w1 = (lane & 8) ? wb1 : wa1;
            *(float2*)xrow = make_float2(xa.x + ga.x * w0, xa.y + ga.y * w1);
#pragma unroll
            for (int i = 0; i < 16; ++i) { eC[i] = eN[i]; cC[i] = cN[i]; }
        }
    }
}
DEV void phase_final_norm(const Params& p) {
    const int tid = tid_opaque(), lane = tid & 63;
    const int gw = blockIdx.x * 8 + (tid >> 6), nw = gridDim.x * 8;
    const float* gn = p.in[34];
    for (int R = gw; R < NL; R += nw) {
        float* xr = p.out + (size_t)R * 1024;
        float4 v[4]; float ss = 0.f;
#pragma unroll
        for (int i = 0; i < 4; ++i) { v[i] = *(const float4*)(xr + i * 256 + lane * 4); ss += v[i].x * v[i].x + v[i].y * v[i].y + v[i].z * v[i].z + v[i].w * v[i].w; }
        ss = wave_allreduce(ss);
        const float rs = rsqrtf(ss * (1.0f / 1024.0f) + 1e-6f);
#pragma unroll
        for (int i = 0; i < 4; ++i) {
            const float4 gg = *(const float4*)(gn + i * 256 + lane * 4);
            *(float4*)(xr + i * 256 + lane * 4) = make_float4(v[i].x * rs * gg.x, v[i].y * rs * gg.y, v[i].z * rs * gg.z, v[i].w * rs * gg.w);
        }
    }
}

DEV void phase_gla_proj(const Params& p, unsigned char* lds) {
    unsigned char* ws = p.ws;
    const bf16_t* h = (const bf16_t*)(ws + WS_S + 0 * U_BYTES);
    const bf16_t* wint = (const bf16_t*)(ws + WS_WIN);
    {
        pg8::Gemm g{h, wint, NT, 3072, 1024};
        pg8::StaticOrder so; so.init(NT, 3072, gridDim.x, blockIdx.x);
        pg8::EpiBf16Tiles ep{(bf16_t*)(ws + WS_S + 1 * U_BYTES), 2048, 8, (bf16_t*)(ws + WS_S + 3 * U_BYTES), 1024};
        pg8::gemm_phase(( PG8_LAS unsigned char*)lds, g, so, ep, nullptr);
    }
    __syncthreads();
    for (int u = blockIdx.x; u < NT / 128; u += gridDim.x) {
        ALoadPlain al{h, 1024};
        EpiLr ep{(float*)(ws + WS_LR)};
        gemm_unit<128>(lds, al, wint + (size_t)3072 * 1024, 1024, u * 128, ep);
    }
}

DEV void conv_emit(const float (&acc)[8], int c, bf16_t* dst) {
    const float qs = (c < 512) ? 0.08838834764831845f : 1.0f;
    unsigned ow[4];
#pragma unroll
    for (int j = 0; j < 4; ++j) { const float a0 = acc[2 * j], a1 = acc[2 * j + 1]; ow[j] = pk_bf16(a0 * sigmoidf_(a0) * qs, a1 * sigmoidf_(a1) * qs); }
    *(uint4*)dst = make_uint4(ow[0], ow[1], ow[2], ow[3]);
}
DEV void conv_tap(float (&acc)[8], const uint4& v, const float (&w)[8]) {
    acc[0] += bf_lo(v.x) * w[0]; acc[1] += bf_hi(v.x) * w[1]; acc[2] += bf_lo(v.y) * w[2]; acc[3] += bf_hi(v.y) * w[3];
    acc[4] += bf_lo(v.z) * w[4]; acc[5] += bf_hi(v.z) * w[5]; acc[6] += bf_lo(v.w) * w[6]; acc[7] += bf_hi(v.w) * w[7];
}
DEV void phase_gla_conv(const Params& p) {
    const int tid = tid_opaque();
    unsigned char* ws = p.ws;
    const bf16_t* z = (const bf16_t*)(ws + WS_S + 1 * U_BYTES);
    bf16_t* o = (bf16_t*)(ws + WS_S + 4 * U_BYTES);
    const float* cw = p.in[25];
    const int x = tid >> 3, cl = (tid & 7) * 8;
    for (int task = blockIdx.x; task < 8 * 8 * 32; task += gridDim.x) {
        const int cb = task & 31, ys = (task >> 5) & 7, b = task >> 8;
        const int c = cb * 64 + cl;
        float w[9][8];
#pragma unroll
        for (int t = 0; t < 9; ++t) { const float4 w0 = *(const float4*)(cw + t * 2048 + c), w1 = *(const float4*)(cw + t * 2048 + c + 4); w[t][0] = w0.x; w[t][1] = w0.y; w[t][2] = w0.z; w[t][3] = w0.w; w[t][4] = w1.x; w[t][5] = w1.y; w[t][6] = w1.z; w[t][7] = w1.w; }
        const uint4 zero4 = make_uint4(0, 0, 0, 0);
        auto load_row = [&](int y, uint4 (&r)[3]) {
            if (y < 0 || y >= 128) { r[0] = zero4; r[1] = zero4; r[2] = zero4; return; }
            const bf16_t* row = z + ((size_t)b * 8192 + (size_t)y * 64 + x) * 2048 + c;
            r[1] = *(const uint4*)row;
            r[0] = (x > 0) ? *(const uint4*)(row - 2048) : zero4;
            r[2] = (x < 63) ? *(const uint4*)(row + 2048) : zero4;
        };
        uint4 r0[3], r1[3], r2[3], r3[3], r4[3];
        const int y0 = ys * 16;
        load_row(y0 - 1, r0); load_row(y0, r1); load_row(y0 + 1, r2); load_row(y0 + 2, r3);
#pragma unroll 1
        for (int yy = 0; yy < 16; ++yy) {
            load_row(yy < 14 ? y0 + yy + 3 : -1, r4);
            float acc[8];
#pragma unroll
            for (int j = 0; j < 8; ++j) acc[j] = 0.f;
#pragma unroll
            for (int dx = 0; dx < 3; ++dx) { conv_tap(acc, r0[dx], w[dx]); conv_tap(acc, r1[dx], w[3 + dx]); conv_tap(acc, r2[dx], w[6 + dx]); }
            conv_emit(acc, c, o + ((size_t)b * 8192 + (size_t)(y0 + yy) * 64 + x) * 2048 + c);
#pragma unroll
            for (int dx = 0; dx < 3; ++dx) { r0[dx] = r1[dx]; r1[dx] = r2[dx]; r2[dx] = r3[dx]; r3[dx] = r4[dx]; }
        }
    }
    for (int task = blockIdx.x; task < (NC / 64) * 8; task += gridDim.x) {
        const int rb = task >> 3, cbk = task & 7;
        const int R = NL + rb * 64 + (tid >> 3);
        const int t = (R - NL) & 255;
#pragma unroll 1
        for (int i = 0; i < 4; ++i) {
            const int c = cbk * 256 + (tid & 7) * 8 + i * 64;
            float acc[8];
#pragma unroll
            for (int j = 0; j < 8; ++j) acc[j] = 0.f;
#pragma unroll
            for (int dx = -1; dx <= 1; ++dx) {
                if (t + dx >= 0 && t + dx < 256) {
                    const uint4 v = *(const uint4*)(z + (size_t)(R + dx) * 2048 + c);
                    const float* wp = cw + (3 + (dx + 1)) * 2048 + c;
                    const float4 w0 = *(const float4*)wp, w1 = *(const float4*)(wp + 4);
                    const float wv[8] = {w0.x, w0.y, w0.z, w0.w, w1.x, w1.y, w1.z, w1.w};
                    conv_tap(acc, v, wv);
                }
            }
            conv_emit(acc, c, o + (size_t)R * 2048 + c);
        }
    }
}

constexpr int GT_QE = 0, GT_KET = 16384, GT_A = 32768, GT_CONST = 40960, GT_STRIDE = 43008;
constexpr int GT_N0 = (int)((2 * U_BYTES) / GT_STRIDE);
constexpr size_t WS_TOTAL = 1073741824ull;
static_assert((size_t)(NB * 4 * 2 * 132 - GT_N0) * GT_STRIDE <= WS_TOTAL - WS_END, "tile records do not fit");
DEV size_t gla_tile_off(int b, int hd, int d, int cc) {
    const int idx = (((b * 4 + hd) * 2 + d) * 132) + cc;
    return idx < GT_N0 ? WS_S + (size_t)idx * GT_STRIDE : WS_END + (size_t)(idx - GT_N0) * GT_STRIDE;
}
DEV int gla_row0(int b, int cc) { return cc < 4 ? NL + b * 256 + cc * 64 : b * 8192 + (cc - 4) * 64; }
DEV void phase_gla_prep(const Params& p, unsigned char* lds) {
    const int tid = tid_opaque(), lane = tid & 63, wv = tid >> 6;
    const int fr = lane & 15, fq = lane >> 4;
    unsigned char* ws = p.ws;
    constexpr int QE = 0, KE = 16384, KET = 32768, BC = 49152  , GS = 82944  , LRL = 86528  , BCS = 132;
    const bf16_t* qkv = (const bf16_t*)(ws + WS_S + 4 * U_BYTES);
    const float* lrb = (const float*)(ws + WS_LR);
    unsigned char* gt = ws;
    float* bc = (float*)(lds + BC);
    float* gs = (float*)(lds + GS);
    const int li = tid >> 3, lc = tid & 7;
    const int d = blockIdx.x & 1, hd = (blockIdx.x >> 1) & 3;
    bf16x8 gkf;
    {
        unsigned w4[4] = {0u, 0u, 0u, 0u};
        if (fq < 2) {
#pragma unroll
            for (int e2 = 0; e2 < 4; ++e2) {
                const float g0 = p.in[26][(size_t)(d * 16 + 8 * fq + 2 * e2) * 512 + hd * 128 + wv * 16 + fr];
                const float g1 = p.in[26][(size_t)(d * 16 + 8 * fq + 2 * e2 + 1) * 512 + hd * 128 + wv * 16 + fr];
                w4[e2] = pk_bf16(g0, g1);
            }
        }
        gkf = as_bf16x8(make_uint4(w4[0], w4[1], w4[2], w4[3]));
    }
    const float4 gb4 = *(const float4*)(p.in[27] + d * 512 + hd * 128 + wv * 16 + 4 * fq);
    const int qstep = (int)(gridDim.x >> 3);
    uint4 nq0, nq1, nk0, nk1; float2 nl;
    auto fetch = [&](int q) {
        const size_t R = (size_t)(gla_row0(q / 132, q % 132) + li);
        const bf16_t* row = qkv + R * 2048;
        nq0 = *(const uint4*)(row + hd * 128 + lc * 8); nq1 = *(const uint4*)(row + hd * 128 + 64 + lc * 8);
        nk0 = *(const uint4*)(row + 512 + hd * 128 + lc * 8); nk1 = *(const uint4*)(row + 512 + hd * 128 + 64 + lc * 8);
        nl = *(const float2*)(lrb + R * 32 + d * 16 + lc * 2);
    };
    int q = (int)(blockIdx.x >> 3);
    if (q < NB * 132) fetch(q);
    for (; q < NB * 132; q += qstep) {
        const int cc = q % 132, b = q / 132;
        unsigned char* rec = gt + gla_tile_off(b, hd, d, cc);
        const uint4 rq0 = nq0, rq1 = nq1, rk0 = nk0, rk1 = nk1; const float2 rl = nl;
        if (q + qstep < NB * 132) fetch(q + qstep);
        *(unsigned*)(lds + LRL + li * 32 + lc * 4) = pk_bf16(rl.x, rl.y);
        __syncthreads();
        {
            const float gbv[4] = {gb4.x, gb4.y, gb4.z, gb4.w};
#pragma unroll
            for (int itl = 0; itl < 4; ++itl) {
                uint4 lr4 = *(const uint4*)(lds + LRL + (itl * 16 + fr) * 32 + (fq & 1) * 16);
                if (fq >= 2) lr4 = make_uint4(0, 0, 0, 0);
                f32x4 a = {0.f, 0.f, 0.f, 0.f};
                a = __builtin_amdgcn_mfma_f32_16x16x32_bf16(gkf, as_bf16x8(lr4), a, 0, 0, 0);
                float s[4], tot[4];
#pragma unroll
                for (int j = 0; j < 4; ++j) {
                    const float xx = a[j] + gbv[j];
                    const float la = (fminf(xx, 0.f) - __logf(1.0f + __expf(-fabsf(xx)))) * (1.0f / 16.0f);
                    float pf = la;
                    pf += dpp_shr0<1>(pf); pf += dpp_shr0<2>(pf); pf += dpp_shr0<4>(pf); pf += dpp_shr0<8>(pf);
                    tot[j] = __shfl(pf, (lane & 48) | 15);
                    s[j] = d ? (tot[j] - pf + la) : pf;
                }
                *(float4*)(bc + (itl * 16 + fr) * BCS + wv * 16 + 4 * fq) = make_float4(s[0], s[1], s[2], s[3]);
                if (fr == 15) *(float4*)(gs + itl * 128 + wv * 16 + 4 * fq) = make_float4(tot[0], tot[1], tot[2], tot[3]);
            }
        }
        __syncthreads();
        if (tid < 128) {
            const float g0 = gs[tid], g1 = gs[128 + tid], g2 = gs[256 + tid], g3 = gs[384 + tid];
            const float refc = d ? (bc[31 * BCS + tid] + g2 + g3) : (bc[32 * BCS + tid] + g0 + g1), lastc = g0 + g1 + g2 + g3;
            const float dl = __expf(lastc), er = __expf(refc), el = __expf(lastc - refc);
            gs[512 + tid] = refc;
            float* cst = (float*)(rec + GT_CONST);
            cst[tid] = er; cst[128 + tid] = el; cst[256 + tid] = dl;
        }
        __syncthreads();
        {
            const int grp = li >> 4;
            const uint4 rqs[2] = {rq0, rq1}, rks[2] = {rk0, rk1};
#pragma unroll
            for (int hseg = 0; hseg < 2; ++hseg) {
                const int k0 = hseg * 64 + lc * 8;
                float bcv[8], refv[8];
#pragma unroll
                for (int j4 = 0; j4 < 2; ++j4) {
                    const float4 g0 = *(const float4*)(gs + k0 + j4 * 4), g1 = *(const float4*)(gs + 128 + k0 + j4 * 4);
                    const float4 g2 = *(const float4*)(gs + 256 + k0 + j4 * 4), g3 = *(const float4*)(gs + 384 + k0 + j4 * 4);
                    const float4 bi = *(const float4*)(bc + li * BCS + k0 + j4 * 4), rf = *(const float4*)(gs + 512 + k0 + j4 * 4);
                    const float g0a[4] = {g0.x, g0.y, g0.z, g0.w}, g1a[4] = {g1.x, g1.y, g1.z, g1.w}, g2a[4] = {g2.x, g2.y, g2.z, g2.w}, g3a[4] = {g3.x, g3.y, g3.z, g3.w};
                    const float bia[4] = {bi.x, bi.y, bi.z, bi.w}, rfa[4] = {rf.x, rf.y, rf.z, rf.w};
#pragma unroll
                    for (int j = 0; j < 4; ++j) {
                        const float pre = d ? ((grp < 1 ? g1a[j] : 0.f) + (grp < 2 ? g2a[j] : 0.f) + (grp < 3 ? g3a[j] : 0.f))
                                            : ((grp > 0 ? g0a[j] : 0.f) + (grp > 1 ? g1a[j] : 0.f) + (grp > 2 ? g2a[j] : 0.f));
                        bcv[j4 * 4 + j] = bia[j] + pre;
                        refv[j4 * 4 + j] = rfa[j];
                    }
                }
                const unsigned qw[4] = {rqs[hseg].x, rqs[hseg].y, rqs[hseg].z, rqs[hseg].w}, kw[4] = {rks[hseg].x, rks[hseg].y, rks[hseg].z, rks[hseg].w};
                unsigned oqe[4], oke[4];
#pragma unroll
                for (int j2 = 0; j2 < 4; ++j2) {
                    const float q0 = bf_lo(qw[j2]), q1 = bf_hi(qw[j2]), kk0 = bf_lo(kw[j2]), kk1 = bf_hi(kw[j2]);
                    const float e0 = __expf(bcv[2 * j2] - refv[2 * j2]), e1 = __expf(bcv[2 * j2 + 1] - refv[2 * j2 + 1]);
                    const float r0 = __builtin_amdgcn_rcpf(e0), r1 = __builtin_amdgcn_rcpf(e1);
                    oqe[j2] = pk_bf16(q0 * e0, q1 * e1);
                    oke[j2] = pk_bf16(kk0 * r0, kk1 * r1);
                    const int kc0 = k0 + 2 * j2;
                    *(bf16_t*)(lds + KET + tile_off2(kc0, li >> 3) + (li & 7) * 2) = (bf16_t)(oke[j2] & 0xffffu);
                    *(bf16_t*)(lds + KET + tile_off2(kc0 + 1, li >> 3) + (li & 7) * 2) = (bf16_t)(oke[j2] >> 16);
                }
                const int chq = hseg * 8 + lc;
                const int so = li * 256 + ((chq ^ (li & 15)) << 4);
                *(uint4*)(lds + QE + so) = make_uint4(oqe[0], oqe[1], oqe[2], oqe[3]);
                *(uint4*)(lds + KE + so) = make_uint4(oke[0], oke[1], oke[2], oke[3]);
                *(uint4*)(rec + GT_QE + so) = make_uint4(oqe[0], oqe[1], oqe[2], oqe[3]);
            }
        }
        __syncthreads();
        {
            const int it = wv & 3, pr2 = wv >> 2;
#pragma unroll
            for (int jj = 0; jj < 2; ++jj) {
                const int jt = pr2 * 2 + jj;
                f32x4 a = {0.f, 0.f, 0.f, 0.f};
                if (d ? (jt >= it) : (jt <= it)) {
#pragma unroll
                    for (int ks = 0; ks < 4; ++ks) {
                        const int ch = ks * 4 + fq;
                        const int rj = jt * 16 + fr, ri = it * 16 + fr;
                        const bf16x8 fa = *(const bf16x8*)(lds + KE + rj * 256 + ((ch ^ (rj & 15)) << 4));
                        const bf16x8 fb = *(const bf16x8*)(lds + QE + ri * 256 + ((ch ^ (ri & 15)) << 4));
                        a = __builtin_amdgcn_mfma_f32_16x16x32_bf16(fa, fb, a, 0, 0, 0);
                    }
                }
                const int i = it * 16 + fr, j = jt * 16 + 4 * fq;
                float av[4];
#pragma unroll
                for (int e = 0; e < 4; ++e) av[e] = (d ? (j + e >= i) : (j + e <= i)) ? a[e] : 0.f;
                *(uint2*)(rec + GT_A + i * 128 + (((j >> 3) ^ (i & 7)) << 4) + (j & 7) * 2) = make_uint2(pk_bf16(av[0], av[1]), pk_bf16(av[2], av[3]));
            }
#pragma unroll
            for (int i = 0; i < 2; ++i) *(uint4*)(rec + GT_KET + i * 8192 + tid * 16) = *(const uint4*)(lds + KET + i * 8192 + tid * 16);
        }
        __syncthreads();
    }
}

DEV void phase_gla_scan(const Params& p, unsigned char* lds) {
    const int tid = tid_opaque(), lane = tid & 63, wv = tid >> 6;
    const int fr = lane & 15, fq = lane >> 4;
    unsigned char* ws = p.ws;
    constexpr int QE = 0  , KET = 32768  , AL = 65536  , VT = 81920, ST = 90112  ;
    const bf16_t* qkv = (const bf16_t*)(ws + WS_S + 4 * U_BYTES);
    const unsigned char* gt = ws;
    for (int unit = blockIdx.x; unit < 256; unit += gridDim.x) {
        const int vs = unit & 3, d = (unit >> 2) & 1, hd = (unit >> 3) & 3, b = unit >> 5;
        bf16_t* odst = d ? (bf16_t*)(ws + WS_S + 2 * U_BYTES) : (bf16_t*)(ws + WS_S + 4 * U_BYTES);
        const int old_ = d ? 1024 : 2048;
        const int li = tid >> 3, lc = tid & 7;
        auto ccof = [&](int c) -> int { return d ? (c < 4 ? 3 - c : 135 - c) : c; };
        auto dma = [&](int cc, int buf) {
            const unsigned char* rec = gt + gla_tile_off(b, hd, d, cc);
#pragma unroll
            for (int i = 0; i < 2; ++i) {
                __builtin_amdgcn_global_load_lds((const unsigned*)(rec + GT_QE + i * 8192 + tid * 16), (unsigned*)(lds + QE + buf * 16384 + i * 8192 + tid * 16), 16, 0, 0);
                __builtin_amdgcn_global_load_lds((const unsigned*)(rec + GT_KET + i * 8192 + tid * 16), (unsigned*)(lds + KET + buf * 16384 + i * 8192 + tid * 16), 16, 0, 0);
            }
            __builtin_amdgcn_global_load_lds((const unsigned*)(rec + GT_A + tid * 16), (unsigned*)(lds + AL + buf * 8192 + tid * 16), 16, 0, 0);
        };
        uint4 nv; float4 n_dl, n_el, n_er;
        auto loads = [&](int c) {
            const int cc = ccof(c);
            nv = *(const uint4*)(qkv + (size_t)(gla_row0(b, cc) + li) * 2048 + 1024 + hd * 256 + vs * 64 + lc * 8);
            const float* cst = (const float*)(gt + gla_tile_off(b, hd, d, cc) + GT_CONST);
            n_el = *(const float4*)(cst + 128 + wv * 16 + 4 * fq); n_dl = *(const float4*)(cst + 256 + wv * 16 + 4 * fq);
            if (c + 1 < 132) n_er = *(const float4*)((const float*)(gt + gla_tile_off(b, hd, d, ccof(c + 1)) + GT_CONST) + wv * 16 + 4 * fq);
            else n_er = make_float4(0.f, 0.f, 0.f, 0.f);
        };
        f32x4 accS[4];
#pragma unroll
        for (int i = 0; i < 4; ++i) accS[i] = (f32x4){0.f, 0.f, 0.f, 0.f};
        for (int i = tid; i < 32768 / 16; i += NTHREADS) *(uint4*)(lds + ST + i * 16) = make_uint4(0, 0, 0, 0);
        dma(ccof(0), 0);
        loads(0);
        for (int c = 0; c < 132; ++c) {
            const int buf = c & 1, cc = ccof(c);
            const uint4 rv = nv; const float4 dl4 = n_dl, el4 = n_el, er4 = n_er;
            asm volatile("s_waitcnt vmcnt(0)" ::: "memory");
            {
                const unsigned vw[4] = {rv.x, rv.y, rv.z, rv.w};
#pragma unroll
                for (int j2 = 0; j2 < 4; ++j2) {
                    const int vc0 = lc * 8 + 2 * j2;
                    *(bf16_t*)(lds + VT + tile_off2(vc0, li >> 3) + (li & 7) * 2) = (bf16_t)(vw[j2] & 0xffffu);
                    *(bf16_t*)(lds + VT + tile_off2(vc0 + 1, li >> 3) + (li & 7) * 2) = (bf16_t)(vw[j2] >> 16);
                }
            }
            asm volatile("s_waitcnt lgkmcnt(0)" ::: "memory"); __builtin_amdgcn_s_barrier(); asm volatile("" ::: "memory");
            if (c + 1 < 132) { dma(ccof(c + 1), buf ^ 1); loads(c + 1); }
            const int it = wv & 3, pr2 = wv >> 2;
            const int r0 = gla_row0(b, cc);
#pragma unroll
            for (int vv = 0; vv < 2; ++vv) {
                const int vt = pr2 * 2 + vv;
                f32x4 a = {0.f, 0.f, 0.f, 0.f};
#pragma unroll
                for (int ks = 0; ks < 4; ++ks) {
                    const int ch = ks * 4 + fq;
                    const int rvv = vt * 16 + fr, ri = it * 16 + fr;
                    const bf16x8 fa = *(const bf16x8*)(lds + ST + buf * 16384 + rvv * 256 + ((ch ^ (rvv & 15)) << 4));
                    const bf16x8 fb = *(const bf16x8*)(lds + QE + buf * 16384 + ri * 256 + ((ch ^ (ri & 15)) << 4));
                    a = __builtin_amdgcn_mfma_f32_16x16x32_bf16(fa, fb, a, 0, 0, 0);
                }
#pragma unroll
                for (int ks = 0; ks < 2; ++ks) {
                    const int ch = ks * 4 + fq;
                    const int rvv = vt * 16 + fr, ri = it * 16 + fr;
                    const bf16x8 fa = *(const bf16x8*)(lds + VT + tile_off2(rvv, ch));
                    const bf16x8 fb = *(const bf16x8*)(lds + AL + buf * 8192 + ri * 128 + ((ch ^ (ri & 7)) << 4));
                    a = __builtin_amdgcn_mfma_f32_16x16x32_bf16(fa, fb, a, 0, 0, 0);
                }
                const int i = it * 16 + fr, vcol = vt * 16 + 4 * fq;
                *(uint2*)(odst + (size_t)(r0 + i) * old_ + hd * 256 + vs * 64 + vcol) = make_uint2(pk_bf16(a[0], a[1]), pk_bf16(a[2], a[3]));
            }
            {
                const int kt = wv;
                bf16x8 fa[2];
#pragma unroll
                for (int ks = 0; ks < 2; ++ks) fa[ks] = *(const bf16x8*)(lds + KET + buf * 16384 + tile_off2(kt * 16 + fr, ks * 4 + fq));
#pragma unroll
                for (int vt = 0; vt < 4; ++vt) {
                    f32x4 t = {0.f, 0.f, 0.f, 0.f};
#pragma unroll
                    for (int ks = 0; ks < 2; ++ks) t = __builtin_amdgcn_mfma_f32_16x16x32_bf16(fa[ks], *(const bf16x8*)(lds + VT + tile_off2(vt * 16 + fr, ks * 4 + fq)), t, 0, 0, 0);
                    f32x4 a = accS[vt];
                    a[0] = a[0] * dl4.x + t[0] * el4.x; a[1] = a[1] * dl4.y + t[1] * el4.y; a[2] = a[2] * dl4.z + t[2] * el4.z; a[3] = a[3] * dl4.w + t[3] * el4.w;
                    accS[vt] = a;
                    const int vcol = vt * 16 + fr, kcol = kt * 16 + 4 * fq;
                    *(uint2*)(lds + ST + (buf ^ 1) * 16384 + vcol * 256 + (((kcol >> 3) ^ (vcol & 15)) << 4) + (kcol & 7) * 2) =
                        make_uint2(pk_bf16(a[0] * er4.x, a[1] * er4.y), pk_bf16(a[2] * er4.z, a[3] * er4.w));
                }
            }
            asm volatile("s_waitcnt lgkmcnt(0)" ::: "memory"); __builtin_amdgcn_s_barrier(); asm volatile("" ::: "memory");
        }
        asm volatile("s_waitcnt vmcnt(0)" ::: "memory");
        __syncthreads();
    }
}

DEV void phase_gla_readout(const Params& p) {
    const int tid = tid_opaque(), lane = tid & 63;
    const int gw = blockIdx.x * 8 + (tid >> 6), nw = gridDim.x * 8;
    unsigned char* ws = p.ws;
    const bf16_t* o0 = (const bf16_t*)(ws + WS_S + 4 * U_BYTES);
    const bf16_t* o1 = (const bf16_t*)(ws + WS_S + 2 * U_BYTES);
    const bf16_t* gb = (const bf16_t*)(ws + WS_S + 3 * U_BYTES);
    bf16_t* ao = (bf16_t*)(ws + WS_S + 0 * U_BYTES);
    const float4 hn = *(const float4*)(p.in[28] + lane * 4);
    for (int item = gw; item < NL * 4; item += nw) {
        const size_t off = (size_t)(item >> 2) * 1024 + (item & 3) * 256 + lane * 4;
        const uint2 a = *(const uint2*)(o0 + off + (size_t)(item >> 2) * 1024), b2 = *(const uint2*)(o1 + off), g2 = *(const uint2*)(gb + off);
        const float v0 = bf_lo(a.x) + bf_lo(b2.x), v1 = bf_hi(a.x) + bf_hi(b2.x), v2 = bf_lo(a.y) + bf_lo(b2.y), v3 = bf_hi(a.y) + bf_hi(b2.y);
        float ss = v0 * v0 + v1 * v1 + v2 * v2 + v3 * v3;
        ss = wave_allreduce(ss);
        const float rs = rsqrtf(ss * (1.0f / 256.0f) + 1e-6f);
        const float g0 = bf_lo(g2.x), g1 = bf_hi(g2.x), g2f = bf_lo(g2.y), g3 = bf_hi(g2.y);
        const float r0 = v0 * rs * hn.x * (g0 * sigmoidf_(g0)), r1 = v1 * rs * hn.y * (g1 * sigmoidf_(g1));
        const float r2 = v2 * rs * hn.z * (g2f * sigmoidf_(g2f)), r3 = v3 * rs * hn.w * (g3 * sigmoidf_(g3));
        *(uint2*)(ao + off) = make_uint2(pk_bf16(r0, r1), pk_bf16(r2, r3));
    }
}


#define XB_TMO      128
#define XB_XCNT(j)  (256  + 64 * (j))
#define XB_XSUB(j)  (1280 + 64 * (j))
#define XB_XGEN(j)  (2304 + 64 * (j))
#define XB_TOP      3328
#define XB_TOPGEN   3392
#define XB_SPIN_CAP (1u << 22)
DEV unsigned xb_ld(unsigned* p) { return __hip_atomic_load(p, __ATOMIC_RELAXED, __HIP_MEMORY_SCOPE_AGENT); }
DEV unsigned xb_add(unsigned* p, unsigned v) { return __hip_atomic_fetch_add(p, v, __ATOMIC_RELAXED, __HIP_MEMORY_SCOPE_AGENT); }
DEV unsigned xb_xcc_id() { return (unsigned)__builtin_amdgcn_s_getreg((3 << 11) | 20) & 0xFu; }
#define XB_SPIN(cond, bar) do { unsigned _sp = 0; while (cond) { __builtin_amdgcn_s_sleep(1); \
    if ((++_sp & 255u) == 0u) { if (xb_ld(&(bar)[XB_TMO])) break; if (_sp > XB_SPIN_CAP) { atomicAdd(&(bar)[XB_TMO], 1u); break; } } } } while (0)
DEV void xcd_barrier_complete(unsigned* bar, unsigned x, unsigned& nloc, unsigned& nx) {
    const unsigned G = gridDim.x;
    unsigned sum, cnt, mine, sp = 0u;
    for (;;) {
        sum = 0u; cnt = 0u; mine = 0u;
#pragma unroll
        for (unsigned j = 0; j < 16; ++j) { const unsigned c = xb_ld(&bar[XB_XCNT(j)]); sum += c; cnt += (c > 0u) ? 1u : 0u; mine = (j == x) ? c : mine; }
        if (sum == G) break;
        __builtin_amdgcn_s_sleep(1);
        if ((++sp & 255u) == 0u) { if (xb_ld(&bar[XB_TMO])) break; if (sp > XB_SPIN_CAP) { atomicAdd(&bar[XB_TMO], 1u); break; } }
    }
    nloc = mine > 0u ? mine : 1u; nx = cnt > 0u ? cnt : 1u;
}
DEV void xcd_barrier(unsigned* bar, volatile LAS3 unsigned* st) {
    asm volatile("s_waitcnt vmcnt(0)" ::: "memory");
    __syncthreads();
    if (tid_opaque() == 0) {
        const unsigned x = xb_xcc_id();
        __builtin_amdgcn_s_waitcnt(0);
        unsigned nloc = st[0], nx = st[1];
        if (nloc == 0u) { xcd_barrier_complete(bar, x, nloc, nx); st[0] = nloc; st[1] = nx; }
        const unsigned old = xb_add(&bar[XB_XSUB(x)], 1u);
        const unsigned gen = old / nloc;
        if (old + 1u == (gen + 1u) * nloc) {
            __builtin_amdgcn_fence(__ATOMIC_RELEASE, "agent");
            asm volatile("s_waitcnt vmcnt(0)" ::: "memory");
            const unsigned og = xb_add(&bar[XB_TOP], 1u);
            const unsigned tg = og / nx;
            if (og + 1u == (tg + 1u) * nx) xb_add(&bar[XB_TOPGEN], 1u);
            else XB_SPIN(xb_ld(&bar[XB_TOPGEN]) == tg, bar);
            __builtin_amdgcn_fence(__ATOMIC_ACQUIRE, "agent");
            xb_add(&bar[XB_XGEN(x)], 1u);
            asm volatile("s_waitcnt vmcnt(0)" ::: "memory");
        } else {
            XB_SPIN(xb_ld(&bar[XB_XGEN(x)]) == gen, bar);
            __builtin_amdgcn_fence(__ATOMIC_ACQUIRE, "agent");
            asm volatile("s_waitcnt vmcnt(0)" ::: "memory");
        }
    }
    __syncthreads();
}
#define SYNC() do { asm volatile("s_waitcnt vmcnt(0)" ::: "memory"); grid.sync(); \
    if (tid_opaque() == 0) { __builtin_amdgcn_fence(__ATOMIC_ACQUIRE, "agent"); asm volatile("s_waitcnt vmcnt(0)" ::: "memory"); } \
    __syncthreads(); } while (0)
__global__ void __launch_bounds__(NTHREADS) mega_fwd(Params p) {
    unsigned char* const lds = g_lds;
    cg::grid_group grid = cg::this_grid();
#define XBAR ((unsigned*)(p.ws + WS_BAR))
#define XST ((volatile LAS3 unsigned*)(lds + LDS_BYTES - 16))
    if ((threadIdx.x & 63) == 0) g_lds[LDS_WTAB + hw_wave_slot()] = (unsigned char)(threadIdx.x >> 6);
    if (threadIdx.x == 0) { XST[0] = 0u; XST[1] = 0u; (void)xb_add(&XBAR[XB_XCNT(xb_xcc_id())], 1u); }
    __syncthreads();
#define S0 ((bf16_t*)(p.ws + WS_S + 0 * U_BYTES))
#define SLOT(i) ((bf16_t*)(p.ws + WS_S + (size_t)(i) * U_BYTES))
#define S1 ((bf16_t*)(p.ws + WS_S + 1 * U_BYTES))
#define CTXR ((const float*)(p.ws + WS_CTXR))
    phase0(p, lds); SYNC();
#undef SYNC
#define SYNC() xcd_barrier(XBAR, XST)
    phase_normmix(p, S0, SLOT(5), SLOT(1), SLOT(2)); SYNC();
    phase_rw_proj1(p, lds, 0, SLOT(5), SLOT(3)); SYNC();
    phase_rw_proj1(p, lds, 1, SLOT(1), SLOT(5)); SYNC();
    phase_rw_proj1(p, lds, 2, SLOT(2), SLOT(1)); phase_rw_lora(p, lds); SYNC();
    REPEAT(3, phase_rw_scan(p, lds));
    phase_rw_scan(p, lds); SYNC();
    REPEAT(4, phase_rw_readout(p));
    phase_rw_readout(p); SYNC();
    REPEAT(5, phase_wo(p, lds, 0));
    phase_wo(p, lds, 0); SYNC();
    REPEAT(6, phase_normmod(p, 0, 1, p.out, CTXR, NT, S1, (unsigned char*)SLOT(2)));
    phase_normmod(p, 0, 1, p.out, CTXR, NT, S1, (unsigned char*)SLOT(2)); SYNC();
    REPEAT(7, phase_peer_select(p, lds, 0));
    phase_peer_select(p, lds, 0); SYNC();
    phase_peer_u(p, lds, 0); SYNC();
    phase_peer_c(p, 0); SYNC();
    phase_peer_v(p, 0); SYNC();
    phase_normmod(p, 1, 0, p.out, CTXR, NT, S0, nullptr); SYNC();
    REPEAT(9, phase_gla_proj(p, lds));
    phase_gla_proj(p, lds); SYNC();
    REPEAT(10, phase_gla_conv(p));
    phase_gla_conv(p); SYNC();
    REPEAT(18, phase_gla_prep(p, lds));
    phase_gla_prep(p, lds); SYNC();
    REPEAT(11, phase_gla_scan(p, lds));
    phase_gla_scan(p, lds); SYNC();
    REPEAT(12, phase_gla_readout(p));
    phase_gla_readout(p); SYNC();
    phase_wo(p, lds, 1); SYNC();
    REPEAT(14, phase_normmod(p, 1, 1, p.out, CTXR, NL, S0, (unsigned char*)SLOT(2)));
    phase_normmod(p, 1, 1, p.out, CTXR, NL, S0, (unsigned char*)SLOT(2)); SYNC();
    REPEAT(15, phase_peer_select(p, lds, 1));
    phase_peer_select(p, lds, 1); SYNC();
    phase_peer_u(p, lds, 1); SYNC();
    phase_peer_c(p, 1); SYNC();
    phase_peer_v(p, 1); SYNC();
    phase_final_norm(p);
}

extern "C" void kernel_launch(void* const* d_in, const int* in_sizes, int n_in, void* d_out, int out_size, void* d_ws, size_t ws_size, hipStream_t stream) {
    static int grid_blocks = 0;
    if (grid_blocks == 0) {
        if (n_in != 35 || ws_size < WS_TOTAL) { fprintf(stderr, "kernel_launch: unexpected n_in %d or ws_size %zu (< %zu)\n", n_in, ws_size, (size_t)WS_END); grid_blocks = -1; return; }
        int dev = 0, cus = 0, per_cu = 0;
        if (hipGetDevice(&dev) != hipSuccess || hipDeviceGetAttribute(&cus, hipDeviceAttributeMultiprocessorCount, dev) != hipSuccess) { fprintf(stderr, "kernel_launch: device query failed\n"); grid_blocks = -1; return; }
        if (hipFuncSetAttribute((const void*)mega_fwd, hipFuncAttributeMaxDynamicSharedMemorySize, LDS_BYTES) != hipSuccess) { fprintf(stderr, "kernel_launch: hipFuncSetAttribute failed\n"); grid_blocks = -1; return; }
        if (hipOccupancyMaxActiveBlocksPerMultiprocessor(&per_cu, (const void*)mega_fwd, NTHREADS, LDS_BYTES) != hipSuccess || per_cu < 1) { fprintf(stderr, "kernel_launch: occupancy query says %d blocks per CU\n", per_cu); grid_blocks = -1; return; }
        grid_blocks = cus;
    }
    if (grid_blocks < 0) return;
    Params p{};
    for (int i = 0; i < 35; ++i) p.in[i] = (const float*)d_in[i];
    p.out = (float*)d_out;
    p.ws = (unsigned char*)d_ws;
    if (hipMemsetAsync((char*)d_ws + WS_BAR, 0, 16384, stream) != hipSuccess) { fprintf(stderr, "kernel_launch: hipMemsetAsync failed\n"); return; }
    void* args[] = {&p};
    hipError_t e = hipLaunchCooperativeKernel((const void*)mega_fwd, dim3(grid_blocks), dim3(NTHREADS), args, LDS_BYTES, stream);
    if (e != hipSuccess) fprintf(stderr, "kernel_launch: cooperative launch failed: %s (grid %d)\n", hipGetErrorString(e), grid_blocks);
}
```

```cpp
#include <hip/hip_runtime.h>
#include <hip/hip_cooperative_groups.h>
#include <cstdio>
#include <cstdint>
namespace cg = cooperative_groups;

#define DEV __device__ __forceinline__
#ifndef REP
#define REP 0
#endif
#define GREPS(n) ((REP == (n)) ? 2 : 1)
#define REPEAT(n, stmt) do { if (REP == (n)) { stmt; SYNC(); } } while (0)

typedef unsigned short bf16_t;
typedef short bf16x8 __attribute__((ext_vector_type(8)));
typedef float f32x4 __attribute__((ext_vector_type(4)));
typedef __bf16 bf16x2v __attribute__((ext_vector_type(2)));

constexpr int D = 1024;
constexpr int NB = 8, SEQ = 8192, CTXL = 256;
constexpr int NL = NB * SEQ, NC = NB * CTXL, NT = NL + NC;
constexpr int NTHREADS = 512;
constexpr int LDS_BYTES = 160 * 1024;

constexpr size_t U_BYTES = (size_t)NT * 1024 * 2;
constexpr size_t WS_BAR = 0;
constexpr size_t WS_MOD = 16384;
constexpr size_t WS_CTXR = WS_MOD + (size_t)2 * 9 * 6144 * 4;
constexpr size_t WS_LR = WS_CTXR + (size_t)NC * 1024 * 4;
constexpr size_t WS_BONUS = WS_LR + (size_t)NT * 32 * 4;
constexpr size_t WS_WPROJ = WS_BONUS + (size_t)2 * NT * 16 * 4;
constexpr size_t WS_W2T = WS_WPROJ + (size_t)3456 * 1024 * 2;
constexpr size_t WS_A2T = WS_W2T + (size_t)2 * 1024 * 64 * 2;
constexpr size_t WS_G2T = WS_A2T + (size_t)2 * 1024 * 64 * 2;
constexpr size_t WS_WO0 = WS_G2T + (size_t)1024 * 128 * 2;
constexpr size_t WS_WO1 = WS_WO0 + (size_t)1024 * 1024 * 2;
constexpr size_t WS_WQ = WS_WO1 + (size_t)1024 * 1024 * 2;
constexpr size_t WS_KEYS = WS_WQ + (size_t)2 * 2048 * 1024 * 2;
constexpr size_t WS_WIN = WS_KEYS + (size_t)2 * 8 * 2 * 128 * 128 * 2;
constexpr size_t WS_PU = WS_WIN + (size_t)3200 * 1024 * 2;
constexpr size_t WS_PV = WS_PU + (size_t)2 * 16384 * 1024;
constexpr size_t WS_PSC = WS_PV + (size_t)2 * 16384 * 1024;
constexpr size_t WS_S = WS_PSC + (size_t)2 * 2 * 16384 * 4;
constexpr size_t WS_END = WS_S + 6 * U_BYTES;
static_assert(WS_END <= 1073741824ull, "workspace too large");
static_assert((WS_CTXR % 256) == 0 && (WS_WPROJ % 256) == 0 && (WS_S % 256) == 0, "alignment");

struct Params {
    const float* in[35];
    float* out;
    unsigned char* ws;
    int pad0, pad1;
};

DEV float bf_lo(unsigned u) { return __uint_as_float(u << 16); }
DEV float bf_hi(unsigned u) { return __uint_as_float(u & 0xffff0000u); }
typedef float f32x2v __attribute__((ext_vector_type(2)));
typedef unsigned int u32x2v __attribute__((ext_vector_type(2)));
typedef short s16x4v __attribute__((ext_vector_type(4)));
DEV unsigned pk_bf16(float lo, float hi) { const f32x2v f = {lo, hi}; union { bf16x2v v; unsigned u; } x; x.v = __builtin_convertvector(f, bf16x2v); return x.u; }
template <int N> DEV float dpp_ror(float x) { return __int_as_float(__builtin_amdgcn_update_dpp(0, __float_as_int(x), 0x120 + N, 0xF, 0xF, false)); }
DEV float row16_allreduce(float x) { x += dpp_ror<8>(x); x += dpp_ror<4>(x); x += dpp_ror<2>(x); x += dpp_ror<1>(x); return x; }
DEV float wave_allreduce(float x) { x = row16_allreduce(x); x += __shfl_xor(x, 16); x += __shfl_xor(x, 32); return x; }
DEV float sigmoidf_(float x) { return 1.0f / (1.0f + __expf(-x)); }
DEV float softplusf_(float z) { return fmaxf(z, 0.f) + __logf(1.0f + __expf(-fabsf(z))); }
DEV unsigned mono_u32(float f) { unsigned u = __float_as_uint(f); return u ^ ((u >> 31) ? 0xFFFFFFFFu : 0x80000000u); }
DEV float unmono_u32(unsigned k) { unsigned u = (k & 0x80000000u) ? (k ^ 0x80000000u) : ~k; return __uint_as_float(u); }
DEV bf16x8 as_bf16x8(uint4 v) { union { uint4 u; bf16x8 b; } x; x.u = v; return x.b; }
#define LAS3 __attribute__((address_space(3)))
extern __shared__ __attribute__((aligned(16))) unsigned char g_lds[];
constexpr int LDS_WTAB = LDS_BYTES - 128;
DEV unsigned hw_wave_slot() { return (unsigned)__builtin_amdgcn_s_getreg((5 << 11) | 4) & 63u; }
DEV int tid_opaque() {
    const int wv = (int)*(const volatile unsigned char*)(g_lds + LDS_WTAB + hw_wave_slot());
    int t = (wv << 6) | (int)__builtin_amdgcn_mbcnt_hi(~0u, __builtin_amdgcn_mbcnt_lo(~0u, 0u));
    asm volatile("" : "+v"(t));
    return t;
}
DEV int mod_batch(int R) { return R < NL ? (R >> 13) : 8; }

template <int BN, class AL, class EP>
DEV void gemm_unit(unsigned char* lds, const AL& al, const bf16_t* Bt, int K, int m0, const EP& ep) {
    constexpr int NI = BN / 64;
    constexpr int A_BYTES = 128 * 128;
    constexpr int B_BYTES = BN * 128;
    const int tid = tid_opaque(), lane = tid & 63, wv = tid >> 6, wm = wv >> 2, wn = wv & 3;
    const int fr = lane & 15, fq = lane >> 4;
    unsigned char* sA = lds;
    unsigned char* sB = lds + 2 * A_BYTES;
    f32x4 acc[4][NI];
#pragma unroll
    for (int mi = 0; mi < 4; ++mi)
#pragma unroll
        for (int ni = 0; ni < NI; ++ni) acc[mi][ni] = (f32x4){0.f, 0.f, 0.f, 0.f};
    const int KT = K >> 6;
    const int drow = tid >> 3, dch = (tid & 7) ^ (drow & 7);
    const bf16_t* bsrc = Bt + (size_t)drow * K + dch * 8;
    uint4 ra[2];
    auto stage = [&](int kt, int buf) {
        const int k0 = kt * 64;
#pragma unroll
        for (int i = 0; i < BN / 64; ++i)
            __builtin_amdgcn_global_load_lds((const unsigned*)(bsrc + (size_t)(64 * i) * K + k0), (unsigned*)(sB + buf * B_BYTES + i * 8192 + tid * 16), 16, 0, 0);
        if constexpr (AL::DMA) {
#pragma unroll
            for (int i = 0; i < 2; ++i)
                __builtin_amdgcn_global_load_lds((const unsigned*)(al.A + (size_t)(m0 + drow + 64 * i) * al.lda + k0 + dch * 8), (unsigned*)(sA + buf * A_BYTES + i * 8192 + tid * 16), 16, 0, 0);
        } else {
#pragma unroll
            for (int i = 0; i < 2; ++i) { const int q = tid + 512 * i; ra[i] = al.load(m0 + (q >> 3), k0 + (q & 7) * 8); }
        }
    };
    auto commit = [&](int buf) {
        if constexpr (!AL::DMA) {
#pragma unroll
            for (int i = 0; i < 2; ++i) { const int q = tid + 512 * i, row = q >> 3, ch = q & 7; *(uint4*)(sA + buf * A_BYTES + row * 128 + ((ch ^ (row & 7)) << 4)) = ra[i]; }
        }
    };
    auto compute = [&](int buf) {
        const unsigned char* a_base = sA + buf * A_BYTES;
        const unsigned char* b_base = sB + buf * B_BYTES;
#pragma unroll
        for (int ks = 0; ks < 2; ++ks) {
            bf16x8 af[4], bfr[NI];
            const int ch = ks * 4 + fq;
#pragma unroll
            for (int mi = 0; mi < 4; ++mi) { const int row = wm * 64 + mi * 16 + fr; af[mi] = *(const bf16x8*)(a_base + row * 128 + ((ch ^ (row & 7)) << 4)); }
#pragma unroll
            for (int ni = 0; ni < NI; ++ni) { const int row = wn * (BN / 4) + ni * 16 + fr; bfr[ni] = *(const bf16x8*)(b_base + row * 128 + ((ch ^ (row & 7)) << 4)); }
#pragma unroll
            for (int mi = 0; mi < 4; ++mi)
#pragma unroll
                for (int ni = 0; ni < NI; ++ni) acc[mi][ni] = __builtin_amdgcn_mfma_f32_16x16x32_bf16(bfr[ni], af[mi], acc[mi][ni], 0, 0, 0);
        }
    };
    if constexpr (AL::DMA) {
        constexpr int STG = A_BYTES + B_BYTES;
        auto stage3 = [&](int kt, int b3) {
            const int k0 = kt * 64;
            unsigned char* base = lds + b3 * STG;
#pragma unroll
            for (int i = 0; i < BN / 64; ++i)
                __builtin_amdgcn_global_load_lds((const unsigned*)(bsrc + (size_t)(64 * i) * K + k0), (unsigned*)(base + A_BYTES + i * 8192 + tid * 16), 16, 0, 0);
#pragma unroll
            for (int i = 0; i < 2; ++i)
                __builtin_amdgcn_global_load_lds((const unsigned*)(al.A + (size_t)(m0 + drow + 64 * i) * al.lda + k0 + dch * 8), (unsigned*)(base + i * 8192 + tid * 16), 16, 0, 0);
        };
        auto compute3 = [&](int b3) {
            const unsigned char* a_base = lds + b3 * STG;
            const unsigned char* b_base = a_base + A_BYTES;
#pragma unroll
            for (int ks = 0; ks < 2; ++ks) {
                bf16x8 af[4], bfr[NI];
                const int ch = ks * 4 + fq;
#pragma unroll
                for (int mi = 0; mi < 4; ++mi) { const int row = wm * 64 + mi * 16 + fr; af[mi] = *(const bf16x8*)(a_base + row * 128 + ((ch ^ (row & 7)) << 4)); }
#pragma unroll
                for (int ni = 0; ni < NI; ++ni) { const int row = wn * (BN / 4) + ni * 16 + fr; bfr[ni] = *(const bf16x8*)(b_base + row * 128 + ((ch ^ (row & 7)) << 4)); }
#pragma unroll
                for (int mi = 0; mi < 4; ++mi)
#pragma unroll
                    for (int ni = 0; ni < NI; ++ni) acc[mi][ni] = __builtin_amdgcn_mfma_f32_16x16x32_bf16(bfr[ni], af[mi], acc[mi][ni], 0, 0, 0);
            }
        };
        stage3(0, 0);
        stage3(1, 1);
        int b3 = 0;
        for (int kt = 0; kt < KT; ++kt) {
            if (kt + 1 < KT) { if constexpr (BN == 256) asm volatile("s_waitcnt vmcnt(6)" ::: "memory"); else asm volatile("s_waitcnt vmcnt(4)" ::: "memory"); }
            else asm volatile("s_waitcnt vmcnt(0)" ::: "memory");
            asm volatile("s_waitcnt lgkmcnt(0)" ::: "memory");
            __builtin_amdgcn_s_barrier();
            asm volatile("" ::: "memory");
            const int bn = (b3 == 0) ? 2 : b3 - 1;
            if (kt + 2 < KT) stage3(kt + 2, bn);
            compute3(b3);
            b3 = (b3 == 2) ? 0 : b3 + 1;
        }
        asm volatile("s_waitcnt lgkmcnt(0)" ::: "memory");
        __builtin_amdgcn_s_barrier();
        asm volatile("" ::: "memory");
    } else {
        stage(0, 0);
        commit(0);
        asm volatile("s_waitcnt vmcnt(0)" ::: "memory");
        __syncthreads();
        for (int kt = 0; kt < KT; ++kt) {
            const int cur = kt & 1;
            const bool more = (kt + 1 < KT);
            if (more) stage(kt + 1, cur ^ 1);
            compute(cur);
            if (more) commit(cur ^ 1);
            asm volatile("s_waitcnt vmcnt(0)" ::: "memory");
            __syncthreads();
        }
    }
    ep(acc, m0, wm, wn, fr, fq);
}

struct ALoadPlain {
    static constexpr bool DMA = true;
    const bf16_t* A; int lda;
    DEV uint4 load(int R, int k) const { return *(const uint4*)(A + (size_t)R * lda + k); }
};
struct ALoadMix {
    static constexpr bool DMA = false;
    const bf16_t* h; const float* mix; const bf16_t* A; int lda;
    DEV uint4 load(int R, int k) const {
        const bf16_t* pc = h + (size_t)R * 1024 + k;
        const uint4 c = *(const uint4*)pc;
        const int t = (R < NL) ? (R & 8191) : ((R - NL) & 255);
        const int last = (R < NL) ? 8191 : 255;
        uint4 pv = *(const uint4*)(pc - (t != 0 ? 1024 : 0)), nv = *(const uint4*)(pc + (t != last ? 1024 : 0));
        if (t == 0) pv = make_uint4(0, 0, 0, 0);
        if (t == last) nv = make_uint4(0, 0, 0, 0);
        const float4 m0 = *(const float4*)(mix + k), m1 = *(const float4*)(mix + k + 4);
        const unsigned cc[4] = {c.x, c.y, c.z, c.w}, pp[4] = {pv.x, pv.y, pv.z, pv.w}, nn[4] = {nv.x, nv.y, nv.z, nv.w};
        const float mm[8] = {m0.x, m0.y, m0.z, m0.w, m1.x, m1.y, m1.z, m1.w};
        unsigned o[4];
#pragma unroll
        for (int i = 0; i < 4; ++i) {
            const float hc0 = bf_lo(cc[i]), hc1 = bf_hi(cc[i]);
            const float s0 = 0.5f * (bf_lo(pp[i]) + bf_lo(nn[i])), s1 = 0.5f * (bf_hi(pp[i]) + bf_hi(nn[i]));
            o[i] = pk_bf16(hc0 + (s0 - hc0) * mm[2 * i], hc1 + (s1 - hc1) * mm[2 * i + 1]);
        }
        return make_uint4(o[0], o[1], o[2], o[3]);
    }
};

struct TrJob { int in_idx, src_off, K, N, src_ld, dst_ld; unsigned long long dst_off; int tile0; };
constexpr int NTRJOBS = 19;
__device__ const TrJob g_trjobs[NTRJOBS] = {
    {9, 0 * 1048576, 1024, 1024, 1024, 1024, WS_WPROJ + 0ull * 1024 * 1024 * 2, 0},
    {9, 1 * 1048576, 1024, 1024, 1024, 1024, WS_WPROJ + 1ull * 1024 * 1024 * 2, 256},
    {9, 2 * 1048576, 1024, 1024, 1024, 1024, WS_WPROJ + 2ull * 1024 * 1024 * 2, 512},
    {11, 0, 1024, 64, 64, 1024, WS_WPROJ + 3072ull * 1024 * 2, 768},
    {11, 65536, 1024, 64, 64, 1024, WS_WPROJ + 3136ull * 1024 * 2, 784},
    {14, 0, 1024, 64, 64, 1024, WS_WPROJ + 3200ull * 1024 * 2, 800},
    {14, 65536, 1024, 64, 64, 1024, WS_WPROJ + 3264ull * 1024 * 2, 816},
    {16, 0, 1024, 128, 128, 1024, WS_WPROJ + 3328ull * 1024 * 2, 832},
    {12, 0, 64, 1024, 1024, 64, WS_W2T, 864},
    {12, 65536, 64, 1024, 1024, 64, WS_W2T + 1024ull * 64 * 2, 880},
    {15, 0, 64, 1024, 1024, 64, WS_A2T, 896},
    {15, 65536, 64, 1024, 1024, 64, WS_A2T + 1024ull * 64 * 2, 912},
    {17, 0, 128, 1024, 1024, 128, WS_G2T, 928},
    {23, 0, 1024, 1024, 1024, 1024, WS_WO0, 960},
    {29, 0, 1024, 1024, 1024, 1024, WS_WO1, 1216},
    {30, 0, 1024, 2048, 2048, 1024, WS_WQ, 1472},
    {30, 2097152, 1024, 2048, 2048, 1024, WS_WQ + 2048ull * 1024 * 2, 1984},
    {24, 0, 1024, 3104, 3104, 1024, WS_WIN, 2496},
    {0, 0, 0, 0, 0, 0, 0, 2496 + 16 * 49},
};
constexpr int NTRTILES = 2496 + 16 * 49;

DEV void phase0(const Params& p, unsigned char* lds) {
    const int tid = tid_opaque();
    unsigned char* ws = p.ws;
    {
        float* sc = (float*)lds;
        float* red = sc + 9 * 1024;
        float* mods = (float*)(ws + WS_MOD);
        bool have_sc = false;
        for (int task = blockIdx.x; task < 192; task += gridDim.x) {
            if (!have_sc) {
                for (int i = tid; i < 9 * 1024; i += NTHREADS) {
                    const int mb = i >> 10, k = i & 1023;
                    const float cv = mb < 8 ? p.in[1][mb * 1024 + k] : p.in[3][k];
                    sc[i] = cv / (1.0f + __expf(-cv));
                }
                have_sc = true;
            }
            __syncthreads();
            const int l = task / 96, nb = task % 96;
            const int nn = tid & 63, kg = tid >> 6;
            const float* w = p.in[4] + (size_t)l * 1024 * 6144 + nb * 64 + nn;
            float acc[9];
#pragma unroll
            for (int m = 0; m < 9; ++m) acc[m] = 0.f;
            for (int k = kg * 128; k < kg * 128 + 128; ++k) {
                const float wv = w[(size_t)k * 6144];
#pragma unroll
                for (int m = 0; m < 9; ++m) acc[m] += sc[m * 1024 + k] * wv;
            }
#pragma unroll
            for (int m = 0; m < 9; ++m) red[(kg * 9 + m) * 64 + nn] = acc[m];
            __syncthreads();
            for (int i = tid; i < 576; i += NTHREADS) {
                const int m = i >> 6, n2 = i & 63;
                float s = p.in[5][l * 6144 + nb * 64 + n2];
#pragma unroll
                for (int g = 0; g < 8; ++g) s += red[(g * 9 + m) * 64 + n2];
                mods[(size_t)(l * 9 + m) * 6144 + nb * 64 + n2] = s;
            }
            __syncthreads();
        }
        __syncthreads();
    }
    {
        float* tile = (float*)lds;
        for (int tt = blockIdx.x; tt < NTRTILES; tt += gridDim.x) {
            int j = 0;
#pragma unroll 1
            while (j + 1 < NTRJOBS && g_trjobs[j + 1].tile0 <= tt) ++j;
            const TrJob jb = g_trjobs[j];
            const int tl = tt - jb.tile0;
            const int ntn = (jb.N + 63) >> 6;
            const int k0 = (tl / ntn) * 64, n0 = (tl % ntn) * 64;
            const float* src = p.in[jb.in_idx] + jb.src_off;
            bf16_t* dst = (bf16_t*)(ws + jb.dst_off);
            {
                const int kr = tid >> 4, nc4 = (tid & 15) * 4;
#pragma unroll
                for (int i = 0; i < 2; ++i) {
                    const int kk = kr + 32 * i;
                    float4 v = make_float4(0.f, 0.f, 0.f, 0.f);
                    if (n0 + nc4 < jb.N) v = *(const float4*)(src + (size_t)(k0 + kk) * jb.src_ld + n0 + nc4);
                    tile[kk * 65 + nc4 + 0] = v.x; tile[kk * 65 + nc4 + 1] = v.y; tile[kk * 65 + nc4 + 2] = v.z; tile[kk * 65 + nc4 + 3] = v.w;
                }
            }
            __syncthreads();
            {
                const int nn = tid >> 3, kc = (tid & 7) * 8;
                if (n0 + nn < jb.N) {
                    unsigned o[4];
#pragma unroll
                    for (int i = 0; i < 4; ++i) o[i] = pk_bf16(tile[(kc + 2 * i) * 65 + nn], tile[(kc + 2 * i + 1) * 65 + nn]);
                    *(uint4*)(dst + (size_t)(n0 + nn) * jb.dst_ld + k0 + kc) = make_uint4(o[0], o[1], o[2], o[3]);
                }
            }
            __syncthreads();
        }
    }
    {
        const size_t gtid = (size_t)blockIdx.x * NTHREADS + tid, gstride = (size_t)gridDim.x * NTHREADS;
        {
            const float* src = p.in[31];
            bf16_t* dst = (bf16_t*)(ws + WS_KEYS);
            const size_t n8 = (size_t)2 * 8 * 2 * 128 * 128 / 8;
            for (size_t i = gtid; i < n8; i += gstride) {
                const float4 a = *(const float4*)(src + i * 8), b = *(const float4*)(src + i * 8 + 4);
                *(uint4*)(dst + i * 8) = make_uint4(pk_bf16(a.x, a.y), pk_bf16(a.z, a.w), pk_bf16(b.x, b.y), pk_bf16(b.z, b.w));
            }
        }
        bf16_t* wpad = (bf16_t*)(ws + WS_WIN) + (size_t)3104 * 1024;
        for (size_t i = gtid; i < (size_t)96 * 1024 / 8; i += gstride) *(uint4*)(wpad + i * 8) = make_uint4(0, 0, 0, 0);
        const int lane = tid & 63;
        const int gw = blockIdx.x * 8 + (tid >> 6), nw = gridDim.x * 8;
        float* scales = (float*)(ws + WS_PSC);
        for (int rowi = gw * 32; rowi < 2 * 32768; rowi += nw * 32)
        for (int row2 = rowi; row2 < rowi + 32; row2 += 4) {
            float4 v[4][4]; float am[4];
#pragma unroll
            for (int q = 0; q < 4; ++q) {
                const int row = row2 + q, tbl = row >> 15, r = row & 32767;
                const float* srow = p.in[32 + tbl] + (size_t)r * 1024;
                am[q] = 0.f;
#pragma unroll
                for (int i = 0; i < 4; ++i) { v[q][i] = *(const float4*)(srow + 16 * lane + 4 * i); am[q] = fmaxf(am[q], fmaxf(fmaxf(fabsf(v[q][i].x), fabsf(v[q][i].y)), fmaxf(fabsf(v[q][i].z), fabsf(v[q][i].w)))); }
            }
#pragma unroll
            for (int o = 1; o < 64; o <<= 1) { const float a0 = __shfl_xor(am[0], o), a1 = __shfl_xor(am[1], o), a2 = __shfl_xor(am[2], o), a3 = __shfl_xor(am[3], o); am[0] = fmaxf(am[0], a0); am[1] = fmaxf(am[1], a1); am[2] = fmaxf(am[2], a2); am[3] = fmaxf(am[3], a3); }
#pragma unroll
            for (int q = 0; q < 4; ++q) {
                const int row = row2 + q, tbl = row >> 15, r = row & 32767;
                const float scale = am[q] > 0.f ? am[q] * (1.0f / 448.0f) : 1.0f;
                const float inv = 1.0f / scale;
                unsigned w[4];
#pragma unroll
                for (int i = 0; i < 4; ++i) {
                    int t = 0;
                    t = __builtin_amdgcn_cvt_pk_fp8_f32(v[q][i].x * inv, v[q][i].y * inv, t, false);
                    t = __builtin_amdgcn_cvt_pk_fp8_f32(v[q][i].z * inv, v[q][i].w * inv, t, true);
                    w[i] = (unsigned)t;
                }
                *(uint4*)(ws + (tbl ? WS_PV : WS_PU) + ((size_t)(r >> 14) * 8 + (lane >> 3)) * (16384 * 128) + (size_t)(r & 16383) * 128 + 16 * (lane & 7)) = make_uint4(w[0], w[1], w[2], w[3]);
                if (lane == 0) scales[tbl * 32768 + r] = scale;
            }
        }
    }
}

DEV void normmod_store(const float4 (&v)[4], float ss, const float* g, const float* shift, const float* scale, bf16_t* dst, unsigned char* xq, int lane) {
    const float rs = rsqrtf(ss * (1.0f / 1024.0f) + 1e-6f);
#pragma unroll
    for (int i = 0; i < 4; ++i) {
        const int col = i * 256 + lane * 4;
        const float4 gg = *(const float4*)(g + col), sh = *(const float4*)(shift + col), sc = *(const float4*)(scale + col);
        const float y0 = v[i].x * rs * gg.x * (1.f + sc.x) + sh.x, y1 = v[i].y * rs * gg.y * (1.f + sc.y) + sh.y;
        const float y2 = v[i].z * rs * gg.z * (1.f + sc.z) + sh.z, y3 = v[i].w * rs * gg.w * (1.f + sc.w) + sh.w;
        *(uint2*)(dst + col) = make_uint2(pk_bf16(y0, y1), pk_bf16(y2, y3));
        if (xq) {
            const float z0 = __builtin_amdgcn_fmed3f(4.f * y0, -448.f, 448.f), z1 = __builtin_amdgcn_fmed3f(4.f * y1, -448.f, 448.f);
            const float z2 = __builtin_amdgcn_fmed3f(4.f * y2, -448.f, 448.f), z3 = __builtin_amdgcn_fmed3f(4.f * y3, -448.f, 448.f);
            int hi = __builtin_amdgcn_cvt_pk_fp8_f32(z0, z1, 0, false); hi = __builtin_amdgcn_cvt_pk_fp8_f32(z2, z3, hi, true);
            const f32x2v h01 = __builtin_amdgcn_cvt_pk_f32_fp8(hi, false), h23 = __builtin_amdgcn_cvt_pk_f32_fp8(hi, true);
            int lo = __builtin_amdgcn_cvt_pk_fp8_f32(z0 - h01.x, z1 - h01.y, 0, false); lo = __builtin_amdgcn_cvt_pk_fp8_f32(z2 - h23.x, z3 - h23.y, lo, true);
            *(int*)(xq + col) = hi; *(int*)(xq + 1024 + col) = lo;
        }
    }
}
DEV void phase_normmod(const Params& p, int layer, int which, const float* xl, const float* xc, int nrows, bf16_t* dst, unsigned char* xq) {
    const int tid = tid_opaque(), lane = tid & 63;
    const int gw = blockIdx.x * 8 + (tid >> 6), nw = gridDim.x * 8;
    const float* mods = (const float*)(p.ws + WS_MOD) + (size_t)layer * 9 * 6144;
    const float* g = p.in[which ? 7 : 6] + layer * 1024;
    for (int R = gw; R < nrows; R += nw) {
        const float* xr = R < NL ? xl + (size_t)R * 1024 : xc + (size_t)(R - NL) * 1024;
        float4 v[4]; float ss = 0.f;
#pragma unroll
        for (int i = 0; i < 4; ++i) { v[i] = *(const float4*)(xr + i * 256 + lane * 4); ss += v[i].x * v[i].x + v[i].y * v[i].y + v[i].z * v[i].z + v[i].w * v[i].w; }
        ss = wave_allreduce(ss);
        const float* mrow = mods + (size_t)mod_batch(R) * 6144 + (which ? 3 : 0) * 1024;
        normmod_store(v, ss, g, mrow, mrow + 1024, dst + (size_t)R * 1024, xq ? xq + (size_t)R * 2048 : nullptr, lane);
    }
}
DEV void phase_normmix(const Params& p, bf16_t* hdst, bf16_t* xr, bf16_t* xk, bf16_t* xv) {
    const int tid = tid_opaque(), lane = tid & 63;
    const int gw = __builtin_amdgcn_readfirstlane(blockIdx.x * 8 + (tid >> 6)), nw = gridDim.x * 8;
    const float* mods = (const float*)(p.ws + WS_MOD);
    const float* g = p.in[6];
    for (int run = gw; run < NT / 8; run += nw) {
        const int R0 = run * 8;
        const int t0 = R0 < NL ? (R0 & 8191) : ((R0 - NL) & 255), slen = R0 < NL ? 8192 : 256;
        const float* mrow = mods + (size_t)mod_batch(R0) * 6144;
        float4 gg[4], sh[4], sc[4], m0[4], m2[4], m3[4];
#pragma unroll
        for (int i = 0; i < 4; ++i) {
            const int col = i * 256 + lane * 4;
            gg[i] = *(const float4*)(g + col); sh[i] = *(const float4*)(mrow + col); sc[i] = *(const float4*)(mrow + 1024 + col);
            m0[i] = *(const float4*)(p.in[8] + col); m2[i] = *(const float4*)(p.in[8] + 2 * 1024 + col); m3[i] = *(const float4*)(p.in[8] + 3 * 1024 + col);
        }
        auto hrow = [&](int R, float4 (&h)[4]) {
            const float* xrw = R < NL ? p.in[0] + (size_t)R * 1024 : p.in[2] + (size_t)(R - NL) * 1024;
            float ss = 0.f;
#pragma unroll
            for (int i = 0; i < 4; ++i) { h[i] = *(const float4*)(xrw + i * 256 + lane * 4); ss += h[i].x * h[i].x + h[i].y * h[i].y + h[i].z * h[i].z + h[i].w * h[i].w; }
            ss = wave_allreduce(ss);
            const float rs = rsqrtf(ss * (1.0f / 1024.0f) + 1e-6f);
#pragma unroll
            for (int i = 0; i < 4; ++i) {
                h[i].x = h[i].x * rs * gg[i].x * (1.f + sc[i].x) + sh[i].x; h[i].y = h[i].y * rs * gg[i].y * (1.f + sc[i].y) + sh[i].y;
                h[i].z = h[i].z * rs * gg[i].z * (1.f + sc[i].z) + sh[i].z; h[i].w = h[i].w * rs * gg[i].w * (1.f + sc[i].w) + sh[i].w;
            }
        };
        float4 hp[4], hc[4], hn[4];
        if (t0 > 0) hrow(R0 - 1, hp); else { hp[0] = hp[1] = hp[2] = hp[3] = make_float4(0.f, 0.f, 0.f, 0.f); }
        hrow(R0, hc);
#pragma unroll 1
        for (int i8 = 0; i8 < 8; ++i8) {
            const int R = R0 + i8;
            if (t0 + i8 + 1 < slen) hrow(R + 1, hn); else { hn[0] = hn[1] = hn[2] = hn[3] = make_float4(0.f, 0.f, 0.f, 0.f); }
#pragma unroll
            for (int i = 0; i < 4; ++i) {
                const size_t o = (size_t)R * 1024 + i * 256 + lane * 4;
                const float4 c = hc[i];
                const float4 xx = make_float4(0.5f * (hp[i].x + hn[i].x) - c.x, 0.5f * (hp[i].y + hn[i].y) - c.y, 0.5f * (hp[i].z + hn[i].z) - c.z, 0.5f * (hp[i].w + hn[i].w) - c.w);
                *(uint2*)(hdst + o) = make_uint2(pk_bf16(c.x, c.y), pk_bf16(c.z, c.w));
                *(uint2*)(xr + o) = make_uint2(pk_bf16(c.x + xx.x * m0[i].x, c.y + xx.y * m0[i].y), pk_bf16(c.z + xx.z * m0[i].z, c.w + xx.w * m0[i].w));
                *(uint2*)(xk + o) = make_uint2(pk_bf16(c.x + xx.x * m2[i].x, c.y + xx.y * m2[i].y), pk_bf16(c.z + xx.z * m2[i].z, c.w + xx.w * m2[i].w));
                *(uint2*)(xv + o) = make_uint2(pk_bf16(c.x + xx.x * m3[i].x, c.y + xx.y * m3[i].y), pk_bf16(c.z + xx.z * m3[i].z, c.w + xx.w * m3[i].w));
            }
#pragma unroll
            for (int i = 0; i < 4; ++i) { hp[i] = hc[i]; hc[i] = hn[i]; }
        }
    }
}

template <int BN> struct EpiBf16 {
    bf16_t* dst; int ldd; int col0; int act;
    DEV void operator()(const f32x4 (&acc)[4][BN / 64], int m0, int wm, int wn, int fr, int fq) const {
#pragma unroll
        for (int mi = 0; mi < 4; ++mi) {
            const size_t R = (size_t)(m0 + wm * 64 + mi * 16 + fr);
#pragma unroll
            for (int ni = 0; ni < BN / 64; ++ni) {
                const int col = col0 + wn * (BN / 4) + ni * 16 + 4 * fq;
                float v[4] = {acc[mi][ni][0], acc[mi][ni][1], acc[mi][ni][2], acc[mi][ni][3]};
                if (act == 1) {
#pragma unroll
                    for (int j = 0; j < 4; ++j) v[j] = tanhf(v[j]);
                } else if (act == 2) {
#pragma unroll
                    for (int j = 0; j < 4; ++j) v[j] = sigmoidf_(v[j]);
                }
                *(uint2*)(dst + R * ldd + col) = make_uint2(pk_bf16(v[0], v[1]), pk_bf16(v[2], v[3]));
            }
        }
    }
};
struct EpiResid {
    const float* xold_lat; const float* xold_ctx; float* dst_lat; float* dst_ctx; const float* gate; int col0;
    DEV void operator()(const f32x4 (&acc)[4][4], int m0, int wm, int wn, int fr, int fq) const {
#pragma unroll
        for (int mi = 0; mi < 4; ++mi) {
            const int R = m0 + wm * 64 + mi * 16 + fr;
            const float* src = R < NL ? xold_lat + (size_t)R * 1024 : xold_ctx + (size_t)(R - NL) * 1024;
            float* dst = R < NL ? dst_lat + (size_t)R * 1024 : dst_ctx + (size_t)(R - NL) * 1024;
            const float* gr = gate + (size_t)mod_batch(R) * 6144;
#pragma unroll
            for (int ni = 0; ni < 4; ++ni) {
                const int col = col0 + wn * 64 + ni * 16 + 4 * fq;
                const float4 xo = *(const float4*)(src + col), g4 = *(const float4*)(gr + col);
                *(float4*)(dst + col) = make_float4(xo.x + g4.x * acc[mi][ni][0], xo.y + g4.y * acc[mi][ni][1], xo.z + g4.z * acc[mi][ni][2], xo.w + g4.w * acc[mi][ni][3]);
            }
        }
    }
};
struct EpiLr {
    float* dst;
    DEV void operator()(const f32x4 (&acc)[4][2], int m0, int wm, int wn, int fr, int fq) const {
        if (wn != 0) return;
#pragma unroll
        for (int mi = 0; mi < 4; ++mi) {
            const size_t R = (size_t)(m0 + wm * 64 + mi * 16 + fr);
#pragma unroll
            for (int ni = 0; ni < 2; ++ni) { const int col = ni * 16 + 4 * fq; *(float4*)(dst + R * 32 + col) = make_float4(acc[mi][ni][0], acc[mi][ni][1], acc[mi][ni][2], acc[mi][ni][3]); }
        }
    }
};

namespace pg8 {
#define PG8_LAS __attribute__((address_space(3)))
constexpr int BM = 256, BK = 64, HALF = 128, HTB = HALF * BK * 2  , STAGE_BYTES = 8 * HTB, NXCD = 8, WGM = 8;

__host__ __device__ __forceinline__ int lds_byte(int r, int c) { const int st = (r >> 4) * 2 + (c >> 5), rr = r & 15, cc = c & 31, ob = rr * 64 + cc * 2; return st * 1024 + (ob ^ (((ob >> 9) & 1) << 5)); }
__host__ __device__ __forceinline__ void stage_rc(int b, int& R, int& C) { const int st = b / 1024, sb = b % 1024, swz = sb ^ (((sb >> 9) & 1) << 5); R = (st >> 1) * 16 + swz / 64; C = (st & 1) * 32 + (swz % 64) / 2; }
__host__ __device__ __forceinline__ int perm32(int rho) { const int n = rho >> 4, i = rho & 15; return 8 * (i >> 2) + 4 * n + (i & 3); }
struct Unit { int pm, pn; };
struct Gemm { const bf16_t* A; const bf16_t* Bt; int M, N, K; };
struct StaticOrder {
    int nM, nN, nwg, G, c;
    __host__ __device__ void init(int M, int N, int G_, int c_) { nM = M / BM; nN = N / BM; nwg = nM * nN; G = G_; c = c_; }
    __host__ __device__ bool next(int i, Unit& u) const {
        const long L = (long)i * G + c; if (L >= nwg) return false;
        int wgid = (int)L; { const int q = nwg / NXCD, r = nwg % NXCD, xcd = wgid % NXCD, off = wgid / NXCD; wgid = (xcd < r ? xcd * (q + 1) : r * (q + 1) + (xcd - r) * q) + off; }
        const int nig = WGM * nN, gid = wgid / nig, fm = gid * WGM, gsz = (nM - fm) < WGM ? (nM - fm) : WGM;
        u.pm = fm + ((wgid % nig) % gsz); u.pn = (wgid % nig) / gsz; return true;
    }
    __device__ __forceinline__ void a_ready(const Unit&) const {}
    __device__ __forceinline__ void done(const Unit&) const {}
};
template <class Epi, class Sched, bool STAMP = false>
__device__ __forceinline__ void gemm_phase(PG8_LAS unsigned char* lds, const Gemm g, const Sched& S, const Epi& E, unsigned long long* stamps) {
    const int tid = tid_opaque(), wid = __builtin_amdgcn_readfirstlane(tid >> 6), lane = tid & 63, wr = wid >> 2, wc = wid & 3, fr = lane & 15, fq = lane >> 4;
    const int K = g.K, nt = K / BK;
    int ts_lo = 0, ts_hi = 0, nts = 0; const unsigned long long rt_entry = STAMP ? (unsigned long long)wall_clock64() : 0ull;
#define PG8_STAMP() do { if (STAMP && wid == 0 && nts < 64) { const unsigned long long _c = (unsigned long long)clock64(); \
        ts_lo = (lane == nts) ? (int)(unsigned)_c : ts_lo; ts_hi = (lane == nts) ? (int)(unsigned)(_c >> 32) : ts_hi; ++nts; } } while (0)
    PG8_STAMP();
    unsigned voffA[2], voffB[2];
#pragma unroll
    for (int i = 0; i < 2; ++i) { int R, C; stage_rc(tid * 16 + i * 8192, R, C); const int Rb = Epi::PERM ? ((R & ~31) + perm32(R & 31)) : R;
        voffA[i] = (unsigned)(R * K + C) * 2u; voffB[i] = (unsigned)(Rb * K + C) * 2u; }
    const size_t kstep = (size_t)(BK * 2);
    const size_t hstep = (size_t)HALF * K * 2;
    const size_t tstep = 2 * hstep;
    const unsigned ldsw = (unsigned)wid * 1024u;
    const int aoff = lds_byte(wr * 64 + fr, fq * 8), boff = lds_byte(wc * 32 + fr, fq * 8);
#define PG8_SA(b, h) (((b) * 2 + (h)) * HTB)
#define PG8_SB(b, h) ((4 + (b) * 2 + (h)) * HTB)
#define PG8_STAGE(bufoff, gbase, voff) do { _Pragma("unroll") for (int _i = 0; _i < 2; ++_i) \
        __builtin_amdgcn_global_load_lds((const unsigned*)((const char*)(gbase) + (voff)[_i]), (PG8_LAS unsigned*)(lds + (bufoff) + ldsw + _i * 8192), 16, 0, 0); } while (0)
#define PG8_LDA(dst, b, h) do { _Pragma("unroll") for (int m = 0; m < 4; ++m) _Pragma("unroll") for (int k = 0; k < 2; ++k) dst[m][k] = *(const PG8_LAS bf16x8*)(lds + PG8_SA(b, h) + aoff + m * 2048 + k * 1024); } while (0)
#define PG8_LDB(dst, b, h) do { _Pragma("unroll") for (int n = 0; n < 2; ++n) _Pragma("unroll") for (int k = 0; k < 2; ++k) dst[n][k] = *(const PG8_LAS bf16x8*)(lds + PG8_SB(b, h) + boff + n * 2048 + k * 1024); } while (0)
#define PG8_MMA(ai, bj, At, Bt) do { __builtin_amdgcn_s_setprio(1); _Pragma("unroll") for (int m = 0; m < 4; ++m) _Pragma("unroll") for (int n = 0; n < 2; ++n) _Pragma("unroll") for (int k = 0; k < 2; ++k) \
        acc[ai][bj][m][n] = __builtin_amdgcn_mfma_f32_16x16x32_bf16(Bt[n][k], At[m][k], acc[ai][bj][m][n], 0, 0, 0); __builtin_amdgcn_s_setprio(0); } while (0)
#define PG8_WAIT_V(n) asm volatile("s_waitcnt vmcnt(" #n ")" ::: "memory")
#define PG8_WAIT_L(n) asm volatile("s_waitcnt lgkmcnt(" #n ")" ::: "memory")
#define PG8_BAR __builtin_amdgcn_s_barrier()
#define PG8_SCHED __builtin_amdgcn_sched_barrier(0)
    Unit cur, nxt; int ui = 0;
    if (!S.next(0, cur)) return;
    f32x4 acc[2][2][4][2];
#pragma unroll
    for (int a = 0; a < 2; ++a)
#pragma unroll
        for (int b = 0; b < 2; ++b)
#pragma unroll
            for (int m = 0; m < 4; ++m)
#pragma unroll
                for (int n = 0; n < 2; ++n) acc[a][b][m][n] = (f32x4){0.f, 0.f, 0.f, 0.f};
    bf16x8 At[4][2], B0[2][2], B1[2][2];
    const char* cA = (const char*)g.A + (size_t)cur.pm * tstep; const char* cB = (const char*)g.Bt + (size_t)cur.pn * tstep;
    S.a_ready(cur);
    PG8_STAGE(PG8_SB(0, 0), cB, voffB); PG8_STAGE(PG8_SA(0, 0), cA, voffA); PG8_STAGE(PG8_SB(0, 1), cB + hstep, voffB); PG8_STAGE(PG8_SA(0, 1), cA + hstep, voffA);
    if (wr == 1) PG8_BAR;
    PG8_WAIT_V(4); PG8_BAR;
    PG8_STAGE(PG8_SB(1, 0), cB + kstep, voffB); PG8_STAGE(PG8_SA(1, 0), cA + kstep, voffA); PG8_STAGE(PG8_SB(1, 1), cB + hstep + kstep, voffB);
    PG8_WAIT_V(6); PG8_BAR;
    PG8_STAMP();
    for (;;) {
        const bool has_next = S.next(ui + 1, nxt);
        const char* nA = has_next ? (const char*)g.A + (size_t)nxt.pm * tstep : cA; const char* nB = has_next ? (const char*)g.Bt + (size_t)nxt.pn * tstep : cB;
        for (int t = 0; t < nt; t += 2) {
            const bool last = (t == nt - 2);
            const char* a1 = cA + (size_t)(t + 1) * kstep;
            const char* a2 = last ? nA : cA + (size_t)(t + 2) * kstep; const char* b2 = last ? nB : cB + (size_t)(t + 2) * kstep;
            const char* a3 = a2 + kstep; const char* b3 = b2 + kstep;
            if (last && has_next) S.a_ready(nxt);
            PG8_LDB(B0, 0, 0); PG8_SCHED; PG8_LDA(At, 0, 0); PG8_STAGE(PG8_SA(1, 1), a1 + hstep, voffA);
            PG8_WAIT_L(8); PG8_BAR; PG8_WAIT_L(0); PG8_MMA(0, 0, At, B0); PG8_BAR; PG8_SCHED;
            PG8_LDB(B1, 0, 1); PG8_STAGE(PG8_SB(0, 0), b2, voffB);
            PG8_BAR; PG8_WAIT_L(0); PG8_MMA(0, 1, At, B1); PG8_BAR;
            PG8_LDA(At, 0, 1); PG8_STAGE(PG8_SA(0, 0), a2, voffA);
            PG8_BAR; PG8_WAIT_L(0); PG8_MMA(1, 0, At, B0); PG8_BAR; PG8_SCHED;
            PG8_STAGE(PG8_SB(0, 1), b2 + hstep, voffB);
            PG8_WAIT_V(6); PG8_BAR; PG8_MMA(1, 1, At, B1); PG8_BAR;
            PG8_LDB(B0, 1, 0); PG8_SCHED; PG8_LDA(At, 1, 0); PG8_STAGE(PG8_SA(0, 1), a2 + hstep, voffA);
            PG8_WAIT_L(8); PG8_BAR; PG8_WAIT_L(0); PG8_MMA(0, 0, At, B0); PG8_BAR; PG8_SCHED;
            PG8_LDB(B1, 1, 1); PG8_STAGE(PG8_SB(1, 0), b3, voffB);
            PG8_BAR; PG8_WAIT_L(0); PG8_MMA(0, 1, At, B1); PG8_BAR;
            PG8_LDA(At, 1, 1); PG8_STAGE(PG8_SA(1, 0), a3, voffA);
            PG8_BAR; PG8_WAIT_L(0); PG8_MMA(1, 0, At, B0); PG8_BAR; PG8_SCHED;
            PG8_STAGE(PG8_SB(1, 1), b3 + hstep, voffB);
            PG8_WAIT_V(6); PG8_BAR; PG8_MMA(1, 1, At, B1); PG8_BAR;
        }
        PG8_STAMP();
        if constexpr (!Epi::AFTER_DRAIN) { E(acc, cur, wr, wc, fr, fq); S.done(cur); }
        PG8_STAMP();
        if (!has_next) break;
#pragma unroll
        for (int a = 0; a < 2; ++a)
#pragma unroll
            for (int b = 0; b < 2; ++b)
#pragma unroll
                for (int m = 0; m < 4; ++m)
#pragma unroll
                    for (int n = 0; n < 2; ++n) acc[a][b][m][n] = (f32x4){0.f, 0.f, 0.f, 0.f};
        cur = nxt; cA = nA; cB = nB; ++ui;
    }
    PG8_WAIT_V(0);
    if (wr == 0) PG8_BAR;
    PG8_BAR;
    if constexpr (Epi::AFTER_DRAIN) { E.fused(acc, cur, wr, wc, fr, fq, lds, wid, lane); S.done(cur); }
    PG8_STAMP();
    if (STAMP && wid == 0) { stamps[lane] = lane < nts ? (((unsigned long long)(unsigned)ts_hi << 32) | (unsigned)ts_lo) : 0ull;
        if (lane == 62) stamps[62] = rt_entry; if (lane == 63) stamps[63] = (unsigned long long)wall_clock64(); }
#undef PG8_STAMP
#undef PG8_SA
#undef PG8_SB
#undef PG8_STAGE
#undef PG8_LDA
#undef PG8_LDB
#undef PG8_MMA
#undef PG8_WAIT_V
#undef PG8_WAIT_L
#undef PG8_BAR
#undef PG8_SCHED
}
struct EpiBf16Tiles {
    static constexpr bool PERM = true, AFTER_DRAIN = false;
    bf16_t* d0; int ld0; int ntile0; bf16_t* d1; int ld1;
    __device__ __forceinline__ void operator()(const f32x4 (&acc)[2][2][4][2], const Unit& u, int wr, int wc, int fr, int fq) const {
        bf16_t* base = u.pn < ntile0 ? d0 : d1; const int ld = u.pn < ntile0 ? ld0 : ld1; const int colt = (u.pn < ntile0 ? u.pn : u.pn - ntile0) * BM;
        const int row0 = u.pm * BM + wr * 64 + fr, col0 = colt + wc * 32 + 8 * fq;
#pragma unroll
        for (int ai = 0; ai < 2; ++ai)
#pragma unroll
            for (int m = 0; m < 4; ++m) { bf16_t* rowp = base + (size_t)(row0 + ai * HALF + m * 16) * ld + col0;
#pragma unroll
                for (int bj = 0; bj < 2; ++bj) { const f32x4 v0 = acc[ai][bj][m][0], v1 = acc[ai][bj][m][1];
                    *(uint4*)(rowp + bj * HALF) = make_uint4(pk_bf16(v0[0], v0[1]), pk_bf16(v0[2], v0[3]), pk_bf16(v1[0], v1[1]), pk_bf16(v1[2], v1[3])); } }
    }
};
struct EpiResid256 {
    static constexpr bool PERM = false, AFTER_DRAIN = false;
    const float* xold_lat; const float* xold_ctx; float* dst_lat; float* dst_ctx; const float* gate;
    __device__ __forceinline__ void operator()(const f32x4 (&acc)[2][2][4][2], const Unit& u, int wr, int wc, int fr, int fq) const {
        const int row0 = u.pm * BM + wr * 64 + fr, col0 = u.pn * BM + wc * 32 + 4 * fq;
#pragma unroll
        for (int ai = 0; ai < 2; ++ai)
#pragma unroll
            for (int m = 0; m < 4; ++m) {
                const int R = row0 + ai * HALF + m * 16;
                const float* src = R < NL ? xold_lat + (size_t)R * 1024 : xold_ctx + (size_t)(R - NL) * 1024;
                float* dst = R < NL ? dst_lat + (size_t)R * 1024 : dst_ctx + (size_t)(R - NL) * 1024;
                const float* gr = gate + (size_t)mod_batch(R) * 6144;
#pragma unroll
                for (int bj = 0; bj < 2; ++bj)
#pragma unroll
                    for (int n = 0; n < 2; ++n) {
                        const int col = col0 + bj * HALF + n * 16;
                        const float4 xo = *(const float4*)(src + col), g4 = *(const float4*)(gr + col);
                        const f32x4 a = acc[ai][bj][m][n];
                        *(float4*)(dst + col) = make_float4(xo.x + g4.x * a[0], xo.y + g4.y * a[1], xo.z + g4.z * a[2], xo.w + g4.w * a[3]);
                    }
            }
    }
};
}

DEV void phase_rw_proj1(const Params& p, unsigned char* lds, int which, const bf16_t* A, bf16_t* dst) {
    pg8::Gemm g{A, (const bf16_t*)(p.ws + WS_WPROJ) + (size_t)which * 1024 * 1024, NT, 1024, 1024};
    pg8::StaticOrder so; so.init(NT, 1024, gridDim.x, blockIdx.x);
    pg8::EpiBf16Tiles ep{dst, 1024, 4, dst, 1024};
    pg8::gemm_phase((PG8_LAS unsigned char*)lds, g, so, ep, nullptr);
    __syncthreads();
}
DEV void phase_rw_lora(const Params& p, unsigned char* lds) {
    unsigned char* ws = p.ws;
    const bf16_t* h = (const bf16_t*)(ws + WS_S + 0 * U_BYTES);
    const bf16_t* wproj = (const bf16_t*)(ws + WS_WPROJ);
    const int nunits = (NT / 128) * 3;
    for (int u = blockIdx.x; u < nunits; u += gridDim.x) {
        const int mt = u / 3, lg = u % 3, m0 = mt * 128;
        const int mixid = lg == 0 ? 1 : (lg == 1 ? 4 : 5);
        ALoadMix al{h, p.in[8] + mixid * 1024, h, 1024};
        EpiBf16<128> ep{(bf16_t*)(ws + WS_S + 4 * U_BYTES), 384, lg * 128, lg == 0 ? 1 : (lg == 1 ? 0 : 2)};
        gemm_unit<128>(lds, al, wproj + (size_t)(3072 + lg * 128) * 1024, 1024, m0, ep);
    }
}

template <int N> DEV float dpp_shr0(float x) { return __int_as_float(__builtin_amdgcn_update_dpp(0, __float_as_int(x), 0x110 + N, 0xF, 0xF, true)); }
template <int CTRL> DEV float dpp_quad(float x) { return __int_as_float(__builtin_amdgcn_update_dpp(0, __float_as_int(x), CTRL, 0xF, 0xF, false)); }
DEV int tile_off(int row, int ch) { return row * 128 + ((ch ^ (row & 7)) << 4); }
DEV int tile_off2(int row, int ch) { return row * 128 + ((ch ^ ((row ^ (row >> 3)) & 7)) << 4); }
DEV void phase_rw_scan(const Params& p, unsigned char* lds) {
    const int tid = tid_opaque(), lane = tid & 63;
    const int wv = __builtin_amdgcn_readfirstlane(tid >> 6);
    const int fr = lane & 15, fq = lane >> 4;
    unsigned char* ws = p.ws;
    constexpr int SH = 0, SL = 8192, AT = 16384  , RT = 20480  , BT = 24576  , KT = 28672  , BKT = 32768  , UV = 49152  , NT = 65536  ;
    constexpr int MFA = 69632, MFK = 70656, X0 = 71680, VS = 75776  , PP = 83968, PM = 88064, PI = 92160, AA = 96256  ;
    constexpr int PL = 116736  , YB = 117760, LDS_END = 121856;
    const bf16_t* rbuf = (const bf16_t*)(ws + WS_S + 3 * U_BYTES);
    const bf16_t* kbuf = (const bf16_t*)(ws + WS_S + 5 * U_BYTES);
    const bf16_t* vbuf = (const bf16_t*)(ws + WS_S + 1 * U_BYTES);
    const bf16_t* lora = (const bf16_t*)(ws + WS_S + 4 * U_BYTES);
    for (int unit = blockIdx.x; unit < 256; unit += gridDim.x) {
        const int b = unit >> 5, hh = (unit >> 1) & 15, d = unit & 1;
        bf16_t* ydst = (bf16_t*)(ws + WS_S + (size_t)(d ? 2 : 0) * U_BYTES);
        float* bonus = (float*)(ws + WS_BONUS) + (size_t)((d * NB + b) * 16 + hh) * 8448;
        const int s_e = (tid >> 4) & 15, j0 = (tid & 15) * 4;
        const int ni = wv & 3;
        auto Rof = [&](int c, int s) -> int {
            if (c < 16) { const int q = c * 16 + s; return NL + b * 256 + (d ? 255 - q : q); }
            const int q = (c - 16) * 16 + s; return b * 8192 + (d ? 8191 - q : q);
        };
        constexpr int CST = LDS_END;
        uint2 pr = make_uint2(0, 0), pk = pr, pv = pr; uint4 paw[2], paa[2];
        if (wv >= 4) {
            const int ct = (tid - 256) * 16;
            *(float4*)(lds + CST + 0 * 4096 + ct) = *(const float4*)(p.in[18] + hh * 64 + j0);
            *(float4*)(lds + CST + 1 * 4096 + ct) = *(const float4*)(p.in[19] + hh * 64 + j0);
            *(float4*)(lds + CST + 2 * 4096 + ct) = *(const float4*)(p.in[20] + hh * 64 + j0);
            *(float4*)(lds + CST + 3 * 4096 + ct) = *(const float4*)(p.in[10] + d * 1024 + hh * 64 + ni * 16 + fq * 4);
            *(float4*)(lds + CST + 4 * 4096 + ct) = *(const float4*)(p.in[13] + d * 1024 + hh * 64 + ni * 16 + fq * 4);
#pragma unroll
            for (int ks = 0; ks < 2; ++ks) {
                *(uint4*)(lds + CST + (5 + ks) * 4096 + ct) = *(const uint4*)((const bf16_t*)(ws + WS_W2T) + (size_t)d * 1024 * 64 + (size_t)(hh * 64 + ni * 16 + fr) * 64 + ks * 32 + fq * 8);
                *(uint4*)(lds + CST + (7 + ks) * 4096 + ct) = *(const uint4*)((const bf16_t*)(ws + WS_A2T) + (size_t)d * 1024 * 64 + (size_t)(hh * 64 + ni * 16 + fr) * 64 + ks * 32 + fq * 8);
            }
        }
        auto load_lora = [&](int c) {
            const size_t R2 = (size_t)Rof(c, fr);
#pragma unroll
            for (int ks = 0; ks < 2; ++ks) { paw[ks] = *(const uint4*)(lora + R2 * 384 + d * 64 + ks * 32 + fq * 8); paa[ks] = *(const uint4*)(lora + R2 * 384 + 128 + d * 64 + ks * 32 + fq * 8); }
        };
        auto load_rkv = [&](int c) {
            const size_t off = (size_t)Rof(c, s_e) * 1024 + hh * 64 + j0;
            pr = *(const uint2*)(rbuf + off); pk = *(const uint2*)(kbuf + off); pv = *(const uint2*)(vbuf + off);
        };
        auto step_up = [&](int c) {
            const int ct = (tid - 256) * 16;
            const float4 bias_w = *(const float4*)(lds + CST + 3 * 4096 + ct), bias_a = *(const float4*)(lds + CST + 4 * 4096 + ct);
            bf16x8 bfw[2], bfa[2];
#pragma unroll
            for (int ks = 0; ks < 2; ++ks) { bfw[ks] = *(const bf16x8*)(lds + CST + (5 + ks) * 4096 + ct); bfa[ks] = *(const bf16x8*)(lds + CST + (7 + ks) * 4096 + ct); }
            f32x4 accw = {0.f, 0.f, 0.f, 0.f}, acca = {0.f, 0.f, 0.f, 0.f};
#pragma unroll
            for (int ks = 0; ks < 2; ++ks) { accw = __builtin_amdgcn_mfma_f32_16x16x32_bf16(bfw[ks], as_bf16x8(paw[ks]), accw, 0, 0, 0); acca = __builtin_amdgcn_mfma_f32_16x16x32_bf16(bfa[ks], as_bf16x8(paa[ks]), acca, 0, 0, 0); }
            const int n = ni * 16 + fq * 4;
            const float bw[4] = {bias_w.x, bias_w.y, bias_w.z, bias_w.w}, ba[4] = {bias_a.x, bias_a.y, bias_a.z, bias_a.w};
            float P[4], Pm[4], Pi[4], av[4];
#pragma unroll
            for (int j = 0; j < 4; ++j) {
                const float e = 0.6065306597f * __builtin_amdgcn_rcpf(1.0f + __expf(-(accw[j] + bw[j])));
                float s = e;
                s += dpp_shr0<1>(s); s += dpp_shr0<2>(s); s += dpp_shr0<4>(s); s += dpp_shr0<8>(s);
                P[j] = __expf(-s); Pi[j] = __builtin_amdgcn_rcpf(P[j]); Pm[j] = P[j] * __expf(e);
                av[j] = __builtin_amdgcn_rcpf(1.0f + __expf(-(acca[j] + ba[j])));
            }
            const int pb = (c & 1) * 16384;
            *(float4*)(lds + PP + pb + (fr * 64 + n) * 4) = make_float4(P[0], P[1], P[2], P[3]);
            *(float4*)(lds + PM + pb + (fr * 64 + n) * 4) = make_float4(Pm[0], Pm[1], Pm[2], Pm[3]);
            *(float4*)(lds + PI + pb + (fr * 64 + n) * 4) = make_float4(Pi[0], Pi[1], Pi[2], Pi[3]);
            *(float4*)(lds + AA + pb + (fr * 64 + n) * 4) = make_float4(av[0], av[1], av[2], av[3]);
            if (fr == 15) *(float4*)(lds + PL + (c & 3) * 256 + n * 4) = make_float4(P[0], P[1], P[2], P[3]);
        };
        auto step_vec = [&](int c) {
            const int eo = (s_e * 64 + j0) * 4, pb = (c & 1) * 16384, tb = (c & 1) * 8192, ct = (tid - 256) * 16;
            const float4 kk_c = *(const float4*)(lds + CST + 0 * 4096 + ct), ka_c = *(const float4*)(lds + CST + 1 * 4096 + ct), rk_c = *(const float4*)(lds + CST + 2 * 4096 + ct);
            const float4 a4 = *(const float4*)(lds + AA + pb + eo), P4 = *(const float4*)(lds + PP + pb + eo), Pm4 = *(const float4*)(lds + PM + pb + eo), Pi4 = *(const float4*)(lds + PI + pb + eo);
            const float kx[4] = {bf_lo(pk.x), bf_hi(pk.x), bf_lo(pk.y), bf_hi(pk.y)};
            const float rx[4] = {bf_lo(pr.x), bf_hi(pr.x), bf_lo(pr.y), bf_hi(pr.y)};
            const float av[4] = {a4.x, a4.y, a4.z, a4.w}, Pv[4] = {P4.x, P4.y, P4.z, P4.w}, Pmv[4] = {Pm4.x, Pm4.y, Pm4.z, Pm4.w}, Piv[4] = {Pi4.x, Pi4.y, Pi4.z, Pi4.w};
            const float kkc[4] = {kk_c.x, kk_c.y, kk_c.z, kk_c.w}, kac[4] = {ka_c.x, ka_c.y, ka_c.z, ka_c.w}, rkc[4] = {rk_c.x, rk_c.y, rk_c.z, rk_c.w};
            float t[4], n2 = 0.f;
#pragma unroll
            for (int j = 0; j < 4; ++j) { t[j] = kx[j] * kkc[j]; n2 += t[j] * t[j]; }
            n2 = row16_allreduce(n2);
            const float inv = 1.0f / fmaxf(sqrtf(n2), 1e-12f);
            float at[4], bt[4], kt[4], rt[4], bon = 0.f;
#pragma unroll
            for (int j = 0; j < 4; ++j) {
                const float kkv = t[j] * inv;
                const float kd = kx[j] * (1.0f + (av[j] - 1.0f) * kac[j]);
                const float bq = kkv * av[j];
                bon += rx[j] * kd * rkc[j];
                at[j] = -kkv * Pmv[j]; bt[j] = bq * Piv[j]; kt[j] = kd * Piv[j]; rt[j] = rx[j] * Pv[j];
            }
            bon = row16_allreduce(bon);
            if ((tid & 15) == 0) { const int Rb = Rof(c, s_e); bonus[Rb < NL ? 256 + (Rb & 8191) : ((Rb - NL) & 255)] = bon; }
            const int ro = tile_off(s_e, j0 >> 3) + (j0 & 7) * 2;
            *(uint2*)(lds + AT + (c & 1) * 2048 + ro) = make_uint2(pk_bf16(at[0], at[1]), pk_bf16(at[2], at[3]));
            *(uint2*)(lds + RT + (c & 1) * 2048 + ro) = make_uint2(pk_bf16(rt[0], rt[1]), pk_bf16(rt[2], rt[3]));
            const unsigned b01 = pk_bf16(bt[0], bt[1]), b23 = pk_bf16(bt[2], bt[3]), k01 = pk_bf16(kt[0], kt[1]), k23 = pk_bf16(kt[2], kt[3]);
            *(uint2*)(lds + BT + (c & 1) * 2048 + ro) = make_uint2(b01, b23);
            *(uint2*)(lds + KT + (c & 1) * 2048 + ro) = make_uint2(k01, k23);
            const unsigned bw2[4] = {b01 & 0xffffu, b01 >> 16, b23 & 0xffffu, b23 >> 16}, kw2[4] = {k01 & 0xffffu, k01 >> 16, k23 & 0xffffu, k23 >> 16};
            const unsigned vw[4] = {pv.x & 0xffffu, pv.x >> 16, pv.y & 0xffffu, pv.y >> 16};
            const int e0 = (s_e & 7) * 2, cq = s_e >> 3;
#pragma unroll
            for (int j = 0; j < 4; ++j) {
                const int row = j0 + j;
                *(bf16_t*)(lds + BKT + tb + tile_off2(row, 0 + cq) + e0) = (bf16_t)bw2[j];
                *(bf16_t*)(lds + BKT + tb + tile_off2(row, 2 + cq) + e0) = (bf16_t)kw2[j];
                *(bf16_t*)(lds + BKT + tb + tile_off2(row, 4 + cq) + e0) = (bf16_t)bw2[j];
                *(bf16_t*)(lds + UV + tb + tile_off2(row, 2 + cq) + e0) = (bf16_t)vw[j];
            }
        };
        f32x4 accY = {0.f, 0.f, 0.f, 0.f};
        auto prod_S = [&](int c) {
            const int vt = wv & 3, tb = (c & 1) * 2048;
            f32x4 accX = {0.f, 0.f, 0.f, 0.f}, accR = {0.f, 0.f, 0.f, 0.f};
#pragma unroll
            for (int ks = 0; ks < 2; ++ks) {
                const int ch = ks * 4 + fq;
                const bf16x8 sh = *(const bf16x8*)(lds + SH + tile_off(vt * 16 + fr, ch)), sl = *(const bf16x8*)(lds + SL + tile_off(vt * 16 + fr, ch));
                const bf16x8 fa = *(const bf16x8*)(lds + AT + tb + tile_off(fr, ch)), frr = *(const bf16x8*)(lds + RT + tb + tile_off(fr, ch));
                accX = __builtin_amdgcn_mfma_f32_16x16x32_bf16(sh, fa, accX, 0, 0, 0);
                accR = __builtin_amdgcn_mfma_f32_16x16x32_bf16(sh, frr, accR, 0, 0, 0);
                accX = __builtin_amdgcn_mfma_f32_16x16x32_bf16(sl, fa, accX, 0, 0, 0);
                accR = __builtin_amdgcn_mfma_f32_16x16x32_bf16(sl, frr, accR, 0, 0, 0);
            }
            accY = accR;
            {
                const u32x2v av = *(const u32x2v*)(lds + UV + (c & 1) * 8192 + tile_off2(vt * 16 + fr, 2 + (fq >> 1)) + (fq & 1) * 8);
                const u32x2v mh = *(const u32x2v*)(lds + MFK + (fr * 4 + fq) * 8), ml = *(const u32x2v*)(lds + MFK + 512 + (fr * 4 + fq) * 8);
                accX = __builtin_amdgcn_mfma_f32_16x16x16bf16_1k(__builtin_bit_cast(s16x4v, av), __builtin_bit_cast(s16x4v, mh), accX, 0, 0, 0);
                accX = __builtin_amdgcn_mfma_f32_16x16x16bf16_1k(__builtin_bit_cast(s16x4v, av), __builtin_bit_cast(s16x4v, ml), accX, 0, 0, 0);
            }
#pragma unroll
            for (int j = 0; j < 4; ++j) *(float*)(lds + X0 + ((vt * 16 + 4 * fq + j) * 16 + fr) * 4) = accX[j];
        };
        auto prod_V = [&](int c) {
            const int tb = (c & 1) * 2048, w4 = wv & 3;
            f32x4 m = {0.f, 0.f, 0.f, 0.f};
#pragma unroll
            for (int ks = 0; ks < 2; ++ks) {
                const int ch = ks * 4 + fq;
                const bf16x8 fa = *(const bf16x8*)(lds + ((w4 & 1) ? KT : BT) + tb + tile_off(fr, ch));
                const bf16x8 fb = *(const bf16x8*)(lds + ((w4 & 2) ? RT : AT) + tb + tile_off(fr, ch));
                m = __builtin_amdgcn_mfma_f32_16x16x32_bf16(fa, fb, m, 0, 0, 0);
            }
            if (w4 == 0) {
                float* mf = (float*)(lds + MFA);
#pragma unroll
                for (int j = 0; j < 4; ++j) mf[(fr * 4 + j) * 4 + fq] = (4 * fq + j < fr) ? m[j] : 0.f;
            } else if (w4 == 1) {
                const float m0 = (4 * fq + 0 < fr) ? m[0] : 0.f, m1 = (4 * fq + 1 < fr) ? m[1] : 0.f, m2 = (4 * fq + 2 < fr) ? m[2] : 0.f, m3 = (4 * fq + 3 < fr) ? m[3] : 0.f;
                const unsigned h01 = pk_bf16(m0, m1), h23 = pk_bf16(m2, m3);
                *(uint2*)(lds + MFK + (fr * 4 + fq) * 8) = make_uint2(h01, h23);
                *(uint2*)(lds + MFK + 512 + (fr * 4 + fq) * 8) = make_uint2(pk_bf16(m0 - bf_lo(h01), m1 - bf_hi(h01)), pk_bf16(m2 - bf_lo(h23), m3 - bf_hi(h23)));
            } else {
                const float m0 = (4 * fq + 0 <= fr) ? m[0] : 0.f, m1 = (4 * fq + 1 <= fr) ? m[1] : 0.f, m2 = (4 * fq + 2 <= fr) ? m[2] : 0.f, m3 = (4 * fq + 3 <= fr) ? m[3] : 0.f;
                const uint2 o = make_uint2(pk_bf16(m0, m1), pk_bf16(m2, m3));
                const int colb = (w4 == 2 ? 0 : 16) + 4 * fq;
                *(uint2*)(lds + NT + tb + tile_off(fr, colb >> 3) + (colb & 7) * 2) = o;
                if (w4 == 2) *(uint2*)(lds + NT + tb + tile_off(fr, (32 + 4 * fq) >> 3) + ((32 + 4 * fq) & 7) * 2) = o;
            }
        };
        auto step_rec = [&](int c) {
            const int v = tid >> 2, pq = tid & 3;
            float cc[16];
#pragma unroll
            for (int i = 0; i < 4; ++i) { const float4 q = *(const float4*)(lds + X0 + (v * 16 + 4 * i) * 4); cc[4 * i] = q.x; cc[4 * i + 1] = q.y; cc[4 * i + 2] = q.z; cc[4 * i + 3] = q.w; }
            float4 ma[16];
#pragma unroll
            for (int t = 1; t < 16; ++t) ma[t] = *(const float4*)(lds + MFA + ((t * 4 + pq) * 4) * 4);
            ma[0] = make_float4(0.f, 0.f, 0.f, 0.f);
            float uown[4] = {0.f, 0.f, 0.f, 0.f}, uall[16];
#pragma unroll
            for (int t = 0; t < 16; ++t) {
                float s = uown[0] * ma[t].x; s = fmaf(uown[1], ma[t].y, s); s = fmaf(uown[2], ma[t].z, s); s = fmaf(uown[3], ma[t].w, s);
                s += dpp_quad<0xB1>(s); s += dpp_quad<0x4E>(s);
                const float u = cc[t] + s;
                uall[t] = u;
                if (pq == (t & 3)) uown[t >> 2] = u;
            }
            if (pq < 2) {
                unsigned o[8];
#pragma unroll
                for (int i = 0; i < 8; ++i) {
                    const unsigned hi = pk_bf16(uall[2 * i], uall[2 * i + 1]);
                    o[i] = pq ? pk_bf16(uall[2 * i] - bf_lo(hi), uall[2 * i + 1] - bf_hi(hi)) : hi;
                }
                const int cb = pq ? 4 : 0;
                *(uint4*)(lds + UV + (c & 1) * 8192 + tile_off2(v, cb)) = make_uint4(o[0], o[1], o[2], o[3]);
                *(uint4*)(lds + UV + (c & 1) * 8192 + tile_off2(v, cb + 1)) = make_uint4(o[4], o[5], o[6], o[7]);
            }
        };
        f32x4 accS[2];
        accS[0] = (f32x4){0.f, 0.f, 0.f, 0.f}; accS[1] = (f32x4){0.f, 0.f, 0.f, 0.f};
        auto step_upd = [&](int c) {
            const int vt = wv & 3;
            bf16x8 fuv[2];
#pragma unroll
            for (int ks = 0; ks < 2; ++ks) fuv[ks] = *(const bf16x8*)(lds + UV + (c & 1) * 8192 + tile_off2(vt * 16 + fr, ks * 4 + fq));
            if (wv < 4) {
#pragma unroll
                for (int ks = 0; ks < 2; ++ks) accY = __builtin_amdgcn_mfma_f32_16x16x32_bf16(fuv[ks], *(const bf16x8*)(lds + NT + (c & 1) * 2048 + tile_off(fr, ks * 4 + fq)), accY, 0, 0, 0);
                *(float4*)(lds + YB + (fr * 64 + vt * 16 + 4 * fq) * 4) = make_float4(accY[0], accY[1], accY[2], accY[3]);
            }
#pragma unroll
            for (int k2 = 0; k2 < 2; ++k2) {
                const int kt = 2 * (wv >> 2) + k2;
                f32x4 a = accS[k2];
#pragma unroll
                for (int ks = 0; ks < 2; ++ks) a = __builtin_amdgcn_mfma_f32_16x16x32_bf16(*(const bf16x8*)(lds + BKT + (c & 1) * 8192 + tile_off2(kt * 16 + fr, ks * 4 + fq)), fuv[ks], a, 0, 0, 0);
                const float4 pl = *(const float4*)(lds + PL + (c & 3) * 256 + (kt * 16 + 4 * fq) * 4);
                a[0] *= pl.x; a[1] *= pl.y; a[2] *= pl.z; a[3] *= pl.w;
                accS[k2] = a;
                const unsigned h01 = pk_bf16(a[0], a[1]), h23 = pk_bf16(a[2], a[3]);
                const unsigned l01 = pk_bf16(a[0] - bf_lo(h01), a[1] - bf_hi(h01)), l23 = pk_bf16(a[2] - bf_lo(h23), a[3] - bf_hi(h23));
                const int kc = kt * 16 + 4 * fq;
                const int so = tile_off(vt * 16 + fr, kc >> 3) + (kc & 7) * 2;
                *(uint2*)(lds + SH + so) = make_uint2(h01, h23);
                *(uint2*)(lds + SL + so) = make_uint2(l01, l23);
            }
        };
        for (int i = tid; i < LDS_END / 16; i += NTHREADS) *(uint4*)(lds + i * 16) = make_uint4(0, 0, 0, 0);
        if (wv >= 4) { load_lora(0); load_rkv(0); }
        __syncthreads();
        if (wv >= 4) { step_up(0); load_lora(1); }
        __syncthreads();
        if (wv >= 4) { step_vec(0); step_up(1); load_rkv(1); load_lora(2); }
        __syncthreads();
        if (wv >= 4) prod_V(0);
        __syncthreads();
        auto ystore = [&](int c) {
            const float4 y4 = *(const float4*)(lds + YB + (s_e * 64 + j0) * 4);
            *(uint2*)(ydst + (size_t)Rof(c, s_e) * 1024 + hh * 64 + j0) = make_uint2(pk_bf16(y4.x, y4.y), pk_bf16(y4.z, y4.w));
        };
        if (wv < 4) {
            unsigned pfd = 0;
            for (int c = 0; c < 528; ++c) {
                if (c > 0) ystore(c - 1);
                if (c + 4 < 528 && tid < 80) {
                    const bf16_t* pf;
                    if (tid < 48) { const int ten = tid >> 4; pf = (ten == 0 ? rbuf : (ten == 1 ? kbuf : vbuf)) + (size_t)Rof(c + 4, tid & 15) * 1024 + hh * 64; }
                    else { const int i = tid - 48; pf = lora + (size_t)Rof(c + 4, i >> 1) * 384 + (i & 1) * 128 + d * 64; }
                    asm volatile("global_load_dword %0, %1, off" : "=v"(pfd) : "v"(pf) : "memory");
                }
                __builtin_amdgcn_s_setprio(3);
                prod_S(c);
                step_rec(c);
                __builtin_amdgcn_s_setprio(0);
                __syncthreads();
                step_upd(c);
                __syncthreads();
                asm volatile("" :: "v"(pfd));
            }
        } else {
            for (int c = 0; c < 528; ++c) {
                if (c + 1 < 528) step_vec(c + 1);
                if (c + 2 < 528) { step_up(c + 2); load_rkv(c + 2); }
                if (c + 3 < 528) load_lora(c + 3);
                __syncthreads();
                step_upd(c);
                if (c + 1 < 528) prod_V(c + 1);
                __syncthreads();
            }
        }
        if (wv < 4) ystore(527);
        __syncthreads();
    }
}

DEV void phase_rw_readout(const Params& p) {
    const int tid = tid_opaque(), lane = tid & 63, wv = tid >> 6, wm = wv >> 2, wn = wv & 3;
    const int fr = lane & 15, fq = lane >> 4;
    unsigned char* ws = p.ws;
    const bf16_t* y0b = (const bf16_t*)(ws + WS_S + 0 * U_BYTES);
    const bf16_t* y1b = (const bf16_t*)(ws + WS_S + 2 * U_BYTES);
    const bf16_t* vb = (const bf16_t*)(ws + WS_S + 1 * U_BYTES);
    const bf16_t* lora = (const bf16_t*)(ws + WS_S + 4 * U_BYTES);
    const bf16_t* g2t = (const bf16_t*)(ws + WS_G2T);
    bf16_t* ao = (bf16_t*)(ws + WS_S + 5 * U_BYTES);
    const float* bon0 = (const float*)(ws + WS_BONUS);
    const float* bon1 = bon0 + (size_t)NB * 16 * 8448;
    const float* lnw = p.in[21];
    const float* lnb = p.in[22];
    const int nunits = (NT / 128) * 4;
    for (int u = blockIdx.x; u < nunits; u += gridDim.x) {
        const int mt = u >> 2, nt = u & 3, m0 = mt * 128;
        const int hh = nt * 4 + wn;
        f32x4 acc[4][4];
#pragma unroll
        for (int mi = 0; mi < 4; ++mi)
#pragma unroll
            for (int ni = 0; ni < 4; ++ni) acc[mi][ni] = (f32x4){0.f, 0.f, 0.f, 0.f};
#pragma unroll 2
        for (int ks = 0; ks < 4; ++ks) {
            bf16x8 af[4], bfr[4];
#pragma unroll
            for (int mi = 0; mi < 4; ++mi) af[mi] = *(const bf16x8*)(lora + (size_t)(m0 + wm * 64 + mi * 16 + fr) * 384 + 256 + ks * 32 + fq * 8);
#pragma unroll
            for (int ni = 0; ni < 4; ++ni) bfr[ni] = *(const bf16x8*)(g2t + (size_t)(hh * 64 + ni * 16 + fr) * 128 + ks * 32 + fq * 8);
#pragma unroll
            for (int mi = 0; mi < 4; ++mi)
#pragma unroll
                for (int ni = 0; ni < 4; ++ni) acc[mi][ni] = __builtin_amdgcn_mfma_f32_16x16x32_bf16(bfr[ni], af[mi], acc[mi][ni], 0, 0, 0);
        }
#pragma unroll
        for (int mi = 0; mi < 4; ++mi) {
            const size_t R = (size_t)(m0 + wm * 64 + mi * 16 + fr);
            float yv[4][4]; float sum = 0.f;
#pragma unroll
            for (int ni = 0; ni < 4; ++ni) {
                const int col = hh * 64 + ni * 16 + 4 * fq;
                const uint2 a = *(const uint2*)(y0b + R * 1024 + col), b2 = *(const uint2*)(y1b + R * 1024 + col);
                yv[ni][0] = bf_lo(a.x) + bf_lo(b2.x); yv[ni][1] = bf_hi(a.x) + bf_hi(b2.x); yv[ni][2] = bf_lo(a.y) + bf_lo(b2.y); yv[ni][3] = bf_hi(a.y) + bf_hi(b2.y);
                sum += (yv[ni][0] + yv[ni][1]) + (yv[ni][2] + yv[ni][3]);
            }
            sum += __shfl_xor(sum, 16); sum += __shfl_xor(sum, 32);
            const float mu = sum * (1.0f / 64.0f);
            float q = 0.f;
#pragma unroll
            for (int ni = 0; ni < 4; ++ni)
#pragma unroll
                for (int j = 0; j < 4; ++j) { const float dlt = yv[ni][j] - mu; q += dlt * dlt; }
            q += __shfl_xor(q, 16); q += __shfl_xor(q, 32);
            const float rstd = rsqrtf(q * (1.0f / 64.0f) + 64e-5f);
            const size_t bidx = (size_t)(((R < NL ? (R >> 13) : ((R - NL) >> 8)) * 16 + hh)) * 8448 + (R < NL ? 256 + (R & 8191) : ((R - NL) & 255));
            const float bs = bon0[bidx] + bon1[bidx];
#pragma unroll
            for (int ni = 0; ni < 4; ++ni) {
                const int col = hh * 64 + ni * 16 + 4 * fq;
                const uint2 vv = *(const uint2*)(vb + R * 1024 + col);
                const float4 lw = *(const float4*)(lnw + col), lb = *(const float4*)(lnb + col);
                const float o0 = ((yv[ni][0] - mu) * rstd * lw.x + lb.x + bs * bf_lo(vv.x)) * acc[mi][ni][0];
                const float o1 = ((yv[ni][1] - mu) * rstd * lw.y + lb.y + bs * bf_hi(vv.x)) * acc[mi][ni][1];
                const float o2 = ((yv[ni][2] - mu) * rstd * lw.z + lb.z + bs * bf_lo(vv.y)) * acc[mi][ni][2];
                const float o3 = ((yv[ni][3] - mu) * rstd * lw.w + lb.w + bs * bf_hi(vv.y)) * acc[mi][ni][3];
                *(uint2*)(ao + R * 1024 + col) = make_uint2(pk_bf16(o0, o1), pk_bf16(o2, o3));
            }
        }
    }
}

DEV void phase_wo(const Params& p, unsigned char* lds, int layer) {
    unsigned char* ws = p.ws;
    const bf16_t* ao = (const bf16_t*)(ws + WS_S + (size_t)(layer ? 0 : 5) * U_BYTES);
    const bf16_t* wot = (const bf16_t*)(ws + (layer ? WS_WO1 : WS_WO0));
    float* ctxr = (float*)(ws + WS_CTXR);
    const float* gate = (const float*)(ws + WS_MOD) + (size_t)layer * 9 * 6144 + 2 * 1024;
    const int M = layer ? NL : NT;
    pg8::Gemm g{ao, wot, M, 1024, 1024};
    pg8::StaticOrder so; so.init(M, 1024, gridDim.x, blockIdx.x);
    pg8::EpiResid256 ep{layer ? p.out : p.in[0], layer ? ctxr : p.in[2], p.out, ctxr, gate};
    pg8::gemm_phase((PG8_LAS unsigned char*)lds, g, so, ep, nullptr);
    __syncthreads();
}

struct EpiQTile {
    unsigned char* lds;
    DEV void operator()(const f32x4 (&acc)[4][4], int m0, int wm, int wn, int fr, int fq) const {
        const int pp = wn >> 1;
#pragma unroll
        for (int mi = 0; mi < 4; ++mi) {
            const int m = wm * 64 + mi * 16 + fr;
#pragma unroll
            for (int ni = 0; ni < 4; ++ni) {
                const int c = (wn & 1) * 64 + ni * 16 + 4 * fq;
                *(uint2*)(lds + pp * 32768 + m * 256 + (((c >> 3) ^ (m & 15)) << 4) + (c & 7) * 2) = make_uint2(pk_bf16(acc[mi][ni][0], acc[mi][ni][1]), pk_bf16(acc[mi][ni][2], acc[mi][ni][3]));
            }
        }
    }
};
DEV void phase_peer_select(const Params& p, unsigned char* lds, int layer) {
    const int tid = tid_opaque(), lane = tid & 63, wv = tid >> 6, wm = wv >> 2, wn = wv & 3;
    const int fr = lane & 15, fq = lane >> 4;
    unsigned char* ws = p.ws;
    const bf16_t* hp = (const bf16_t*)(ws + WS_S + (size_t)(layer ? 0 : 1) * U_BYTES);
    const bf16_t* wqt = (const bf16_t*)(ws + WS_WQ) + (size_t)layer * 2048 * 1024;
    const bf16_t* keys = (const bf16_t*)(ws + WS_KEYS) + (size_t)layer * 8 * 2 * 128 * 128;
    int* pl_idx = (int*)(ws + WS_S + 3 * U_BYTES);
    float* pl_gate = (float*)(ws + WS_S + 3 * U_BYTES + (size_t)NT * 128 * 4);
    unsigned* slist = (unsigned*)lds;
    unsigned* tlist = (unsigned*)(lds + 256 * 132 * 4);
    const int mtiles = layer ? NL / 128 : NT / 128;
    for (int u = blockIdx.x; u < mtiles * 8; u += gridDim.x) {
        const int mt = u >> 3, head = u & 7, m0 = mt * 128;
        ALoadPlain al{hp, 1024};
        EpiQTile ep{lds};
        gemm_unit<256>(lds, al, wqt + (size_t)head * 256 * 1024, 1024, m0, ep);
        __syncthreads();
        const int pp = wn >> 1, nk0 = (wn & 1) * 64;
        f32x4 sc[4][4];
#pragma unroll
        for (int mi = 0; mi < 4; ++mi)
#pragma unroll
            for (int ni = 0; ni < 4; ++ni) sc[mi][ni] = (f32x4){0.f, 0.f, 0.f, 0.f};
        const bf16_t* kb = keys + (size_t)(head * 2 + pp) * 16384;
#pragma unroll
        for (int ks = 0; ks < 4; ++ks) {
            bf16x8 af[4], bfr[4];
            const int ch = ks * 4 + fq;
#pragma unroll
            for (int mi = 0; mi < 4; ++mi) { const int m = wm * 64 + mi * 16 + fr; af[mi] = *(const bf16x8*)(lds + pp * 32768 + m * 256 + ((ch ^ (m & 15)) << 4)); }
#pragma unroll
            for (int ni = 0; ni < 4; ++ni) bfr[ni] = *(const bf16x8*)(kb + (size_t)(nk0 + ni * 16 + fr) * 128 + ks * 32 + fq * 8);
#pragma unroll
            for (int mi = 0; mi < 4; ++mi)
#pragma unroll
                for (int ni = 0; ni < 4; ++ni) sc[mi][ni] = __builtin_amdgcn_mfma_f32_16x16x32_bf16(bfr[ni], af[mi], sc[mi][ni], 0, 0, 0);
        }
        __syncthreads();
#pragma unroll
        for (int mi = 0; mi < 4; ++mi) {
            const int m = wm * 64 + mi * 16 + fr;
#pragma unroll
            for (int ni = 0; ni < 4; ++ni) {
                const int n = nk0 + ni * 16 + 4 * fq;
                uint4 o;
                o.x = (mono_u32(sc[mi][ni][0]) & ~127u) | (unsigned)(127 - (n + 0));
                o.y = (mono_u32(sc[mi][ni][1]) & ~127u) | (unsigned)(127 - (n + 1));
                o.z = (mono_u32(sc[mi][ni][2]) & ~127u) | (unsigned)(127 - (n + 2));
                o.w = (mono_u32(sc[mi][ni][3]) & ~127u) | (unsigned)(127 - (n + 3));
                *(uint4*)(slist + (size_t)(pp * 128 + m) * 132 + n) = o;
            }
        }
        __syncthreads();
#pragma unroll 1
        for (int ps = 0; ps < 4; ++ps) {
            const int L = ps * 64 + (tid >> 3), g8 = tid & 7;
            unsigned t[16];
            {
                const unsigned* srcp = slist + (size_t)L * 132 + g8 * 16;
#pragma unroll
                for (int i = 0; i < 4; ++i) { const uint4 v = *(const uint4*)(srcp + i * 4); t[4 * i] = v.x; t[4 * i + 1] = v.y; t[4 * i + 2] = v.z; t[4 * i + 3] = v.w; }
            }
#pragma unroll
            for (int k = 2; k <= 16; k <<= 1)
#pragma unroll
                for (int j = k >> 1; j > 0; j >>= 1)
#pragma unroll
                    for (int i = 0; i < 16; ++i) {
                        const int l = i ^ j;
                        if (l > i) {
                            const unsigned mx = max(t[i], t[l]), mn = min(t[i], t[l]);
                            if ((i & k) == 0) { t[i] = mx; t[l] = mn; } else { t[i] = mn; t[l] = mx; }
                        }
                    }
#pragma unroll
            for (int rnd = 0; rnd < 3; ++rnd) {
                unsigned c[16];
#pragma unroll
                for (int i = 0; i < 16; ++i) {
                    const int src_i = __float_as_int(__uint_as_float(t[15 - i]));
                    const int b = rnd == 0 ? __builtin_amdgcn_update_dpp(0, src_i, 0xB1, 0xF, 0xF, false)
                                : (rnd == 1 ? __builtin_amdgcn_update_dpp(0, src_i, 0x4E, 0xF, 0xF, false)
                                            : __builtin_amdgcn_update_dpp(0, src_i, 0x141, 0xF, 0xF, false));
                    c[i] = max(t[i], (unsigned)b);
                }
#pragma unroll
                for (int j = 8; j > 0; j >>= 1)
#pragma unroll
                    for (int i = 0; i < 16; ++i) {
                        const int l = i ^ j;
                        if (l > i) { const unsigned mx = max(c[i], c[l]), mn = min(c[i], c[l]); c[i] = mx; c[l] = mn; }
                    }
#pragma unroll
                for (int i = 0; i < 16; ++i) t[i] = c[i];
            }
            if (g8 == 0) {
#pragma unroll
                for (int i = 0; i < 4; ++i) *(uint4*)(tlist + L * 16 + i * 4) = make_uint4(t[4 * i], t[4 * i + 1], t[4 * i + 2], t[4 * i + 3]);
            }
        }
        __syncthreads();
        if (tid < 128) {
            float v0[16], v1[16];
#pragma unroll
            for (int i = 0; i < 16; ++i) { v0[i] = unmono_u32(tlist[tid * 16 + i] & ~127u); v1[i] = unmono_u32(tlist[(128 + tid) * 16 + i] & ~127u); }
            unsigned cd[16];
#pragma unroll
            for (int i = 0; i < 16; ++i) cd[i] = 0u;
#pragma unroll
            for (int i = 0; i < 16; ++i) {
#pragma unroll
                for (int j = 0; j < 16; ++j) {
                    if ((i + 1) * (j + 1) <= 16) {
                        unsigned x = (mono_u32(v0[i] + v1[j]) & ~255u) | (unsigned)(255 - (i * 16 + j));
#pragma unroll
                        for (int q = (i + 1) * (j + 1) - 1; q < 16; ++q) { const unsigned mx = max(cd[q], x); x = min(cd[q], x); cd[q] = mx; }
                    }
                }
            }
            float sv[16]; int ex[16];
#pragma unroll
            for (int q = 0; q < 16; ++q) {
                const int slot = 255 - (int)(cd[q] & 255u);
                const unsigned a = tlist[tid * 16 + (slot >> 4)], b2 = tlist[(128 + tid) * 16 + (slot & 15)];
                sv[q] = unmono_u32(a & ~127u) + unmono_u32(b2 & ~127u);
                ex[q] = (127 - (int)(a & 127u)) * 128 + (127 - (int)(b2 & 127u));
            }
            float mx = sv[0];
#pragma unroll
            for (int q = 1; q < 16; ++q) mx = fmaxf(mx, sv[q]);
            float den = 0.f;
#pragma unroll
            for (int q = 0; q < 16; ++q) { sv[q] = __expf(sv[q] - mx); den += sv[q]; }
            const float rden = 1.0f / den;
            const size_t base = ((size_t)head * NT + (m0 + tid)) * 16;
#pragma unroll
            for (int i = 0; i < 4; ++i) {
                *(int4*)(pl_idx + base + i * 4) = make_int4(ex[4 * i], ex[4 * i + 1], ex[4 * i + 2], ex[4 * i + 3]);
                *(float4*)(pl_gate + base + i * 4) = make_float4(sv[4 * i] * rden, sv[4 * i + 1] * rden, sv[4 * i + 2] * rden, sv[4 * i + 3] * rden);
            }
        }
        __syncthreads();
    }
}

typedef float f32x2 __attribute__((ext_vector_type(2)));
typedef unsigned int u32x4 __attribute__((ext_vector_type(4)));
typedef unsigned int u32x2 __attribute__((ext_vector_type(2)));
#define PS_LOAD(buf, ee, h) { _Pragma("unroll") for (int e = 0; e < 8; ++e) { \
        const u32x4 t4 = __builtin_amdgcn_raw_buffer_load_b128(rs, ((unsigned)ee[(h) * 8 + e] << 7) + ch16, 0, 0); buf[e] = make_uint4(t4.x, t4.y, t4.z, t4.w); } }
#define PS_IDX(ee, Rr) { _Pragma("unroll") for (int i = 0; i < 4; ++i) { const int4 t = *(const int4*)(pl_idx + ((size_t)sub * NT + (Rr)) * 16 + 4 * i); \
        ee[4 * i] = t.x; ee[4 * i + 1] = t.y; ee[4 * i + 2] = t.z; ee[4 * i + 3] = t.w; } }
DEV long pk64(unsigned lo, unsigned hi) { return (long)(((unsigned long long)hi << 32) | (unsigned long long)lo); }
DEV void phase_peer_u(const Params& p, unsigned char* lds, int layer) {
    const int tid = tid_opaque(), lane = tid & 63, wv = tid >> 6, sub = lane >> 3, ch = lane & 7, fm = lane & 15, fg = lane >> 4;
    const int ng = gridDim.x >> 3, x = blockIdx.x & 7, wq = blockIdx.x >> 3;
    if (wq < ng) {
        const int gw = __builtin_amdgcn_readfirstlane(wq * 8 + wv), nw = ng * 8;
        unsigned char* ws = p.ws;
        const unsigned char* tab = ws + WS_PU + ((size_t)layer * 8 + x) * (16384 * 128);
        const int* pl_idx = (const int*)(ws + WS_S + 3 * U_BYTES);
        const unsigned char* xq = ws + WS_S + 2 * U_BYTES + (size_t)(fm & 1) * 1024 + 128 * x + 16 * fg;
        bf16_t* pd = (bf16_t*)(ws + WS_S + 5 * U_BYTES) + (size_t)x * NT * 128 + 16 * (fm >> 1) + 4 * fg;
        unsigned char* tile = lds + wv * 16384;
        const unsigned cE16 = 16u * (unsigned)(ch ^ (sub >> 1)), cO16 = cE16 ^ 64u;
        const unsigned aoff0 = (unsigned)fm * 128u + (unsigned)((fg ^ (fm >> 1)) << 4), aoff1 = (unsigned)fm * 128u + (unsigned)(((4 + fg) ^ (fm >> 1)) << 4);
        const int nrows = layer ? NL : NT;
        int eN[16];
#define PU_DMA(ee, q) { _Pragma("unroll") for (int j = 0; j < 4; ++j) { const int jj = (q) * 4 + j; \
        __builtin_amdgcn_global_load_lds((const unsigned*)(tab + (((unsigned)ee[jj] << 7) + ((jj & 1) ? cO16 : cE16))), (unsigned*)(tile + jj * 1024 + lane * 16), 16, 0, 0); } }
        const unsigned ta0 = (unsigned)(size_t)((LAS3 unsigned char*)tile) + aoff0, ta1 = (unsigned)(size_t)((LAS3 unsigned char*)tile) + aoff1;
#define PU_MMA(q) { u32x4 a0, a1, a2, a3; \
        asm volatile("ds_read_b128 %0, %4 offset:%6\n\tds_read_b128 %1, %5 offset:%6\n\tds_read_b128 %2, %4 offset:%7\n\tds_read_b128 %3, %5 offset:%7\n\ts_waitcnt lgkmcnt(0)" \
            : "=&v"(a0), "=&v"(a1), "=&v"(a2), "=&v"(a3) : "v"(ta0), "v"(ta1), "n"((q) * 4096), "n"((q) * 4096 + 2048) : "memory"); \
        f32x4 c4 = {0.f, 0.f, 0.f, 0.f}, c5 = {0.f, 0.f, 0.f, 0.f}; \
        c4 = __builtin_amdgcn_mfma_f32_16x16x32_fp8_fp8(pk64(a0.x, a0.y), pk64(bC0.x, bC0.y), c4, 0, 0, 0); \
        c5 = __builtin_amdgcn_mfma_f32_16x16x32_fp8_fp8(pk64(a2.x, a2.y), pk64(bC0.x, bC0.y), c5, 0, 0, 0); \
        c4 = __builtin_amdgcn_mfma_f32_16x16x32_fp8_fp8(pk64(a0.z, a0.w), pk64(bC0.z, bC0.w), c4, 0, 0, 0); \
        c5 = __builtin_amdgcn_mfma_f32_16x16x32_fp8_fp8(pk64(a2.z, a2.w), pk64(bC0.z, bC0.w), c5, 0, 0, 0); \
        c4 = __builtin_amdgcn_mfma_f32_16x16x32_fp8_fp8(pk64(a1.x, a1.y), pk64(bC1.x, bC1.y), c4, 0, 0, 0); \
        c5 = __builtin_amdgcn_mfma_f32_16x16x32_fp8_fp8(pk64(a3.x, a3.y), pk64(bC1.x, bC1.y), c5, 0, 0, 0); \
        c4 = __builtin_amdgcn_mfma_f32_16x16x32_fp8_fp8(pk64(a1.z, a1.w), pk64(bC1.z, bC1.w), c4, 0, 0, 0); \
        c5 = __builtin_amdgcn_mfma_f32_16x16x32_fp8_fp8(pk64(a3.z, a3.w), pk64(bC1.z, bC1.w), c5, 0, 0, 0); \
        acc[(q) * 2] = c4; acc[(q) * 2 + 1] = c5; }
        int R = gw;
#pragma unroll
        for (int i = 0; i < 16; ++i) eN[i] = 0;
        uint4 bC0 = make_uint4(0, 0, 0, 0), bC1 = bC0;
        if (R < nrows) {
            PS_IDX(eN, R);
            PU_DMA(eN, 0); PU_DMA(eN, 1); PU_DMA(eN, 2); PU_DMA(eN, 3);
            bC0 = *(const uint4*)(xq + (size_t)R * 2048); bC1 = *(const uint4*)(xq + (size_t)R * 2048 + 64);
            const int R1 = min(R + nw, nrows - 1);
            PS_IDX(eN, R1);
            asm volatile("s_waitcnt vmcnt(0)" : "+v"(bC0.x), "+v"(bC1.x), "+v"(eN[0]), "+v"(eN[4]), "+v"(eN[8]), "+v"(eN[12]) :: "memory");
        }
        for (; R < nrows; R += nw) {
            const int Rn = R + nw, R1 = min(Rn, nrows - 1), R2 = min(Rn + nw, nrows - 1);
            const bool more = Rn < nrows;
            u32x4 i0, i1, i2, i3, nb0, nb1;
            {
                const int* iptr = pl_idx + ((size_t)sub * NT + R2) * 16;
                const unsigned char* xptr = xq + (size_t)R1 * 2048;
                asm volatile("global_load_dwordx4 %0, %6, off\n\tglobal_load_dwordx4 %1, %6, off offset:16\n\tglobal_load_dwordx4 %2, %6, off offset:32\n\tglobal_load_dwordx4 %3, %6, off offset:48\n\t"
                             "global_load_dwordx4 %4, %7, off\n\tglobal_load_dwordx4 %5, %7, off offset:64"
                             : "=&v"(i0), "=&v"(i1), "=&v"(i2), "=&v"(i3), "=&v"(nb0), "=&v"(nb1) : "v"(iptr), "v"(xptr) : "memory");
            }
            f32x4 acc[8];
#define PU_STEP(q) { if (more) asm volatile("s_waitcnt vmcnt(19)" ::: "memory"); else asm volatile("s_waitcnt vmcnt(0)" ::: "memory"); \
            PU_MMA(q); if (more) { PU_DMA(eN, q); } }
            PU_STEP(0); PU_STEP(1); PU_STEP(2); PU_STEP(3);
            f32x4 s0[4], s1[2], s2;
#pragma unroll
            for (int i = 0; i < 4; ++i)
#pragma unroll
                for (int r = 0; r < 4; ++r) s0[i][r] = (fm & 2) ? acc[2 * i + 1][r] : acc[2 * i][r];
#pragma unroll
            for (int i = 0; i < 2; ++i)
#pragma unroll
                for (int r = 0; r < 4; ++r) s1[i][r] = (fm & 4) ? s0[2 * i + 1][r] : s0[2 * i][r];
#pragma unroll
            for (int r = 0; r < 4; ++r) { const float t = (fm & 8) ? s1[1][r] : s1[0][r]; s2[r] = t + dpp_quad<0xB1>(t); }
            if (!(fm & 1)) *(uint2*)(pd + (size_t)R * 128) = make_uint2(pk_bf16(s2[0], s2[1]), pk_bf16(s2[2], s2[3]));
            if (more) asm volatile("s_waitcnt vmcnt(17)" : "+v"(i0), "+v"(i1), "+v"(i2), "+v"(i3), "+v"(nb0), "+v"(nb1) :: "memory");
            else asm volatile("s_waitcnt vmcnt(0)" : "+v"(i0), "+v"(i1), "+v"(i2), "+v"(i3), "+v"(nb0), "+v"(nb1) :: "memory");
            eN[0] = i0.x; eN[1] = i0.y; eN[2] = i0.z; eN[3] = i0.w; eN[4] = i1.x; eN[5] = i1.y; eN[6] = i1.z; eN[7] = i1.w;
            eN[8] = i2.x; eN[9] = i2.y; eN[10] = i2.z; eN[11] = i2.w; eN[12] = i3.x; eN[13] = i3.y; eN[14] = i3.z; eN[15] = i3.w;
            bC0 = make_uint4(nb0.x, nb0.y, nb0.z, nb0.w); bC1 = make_uint4(nb1.x, nb1.y, nb1.z, nb1.w);
        }
        asm volatile("s_waitcnt vmcnt(0)" ::: "memory");
    }
}
DEV void phase_peer_c(const Params& p, int layer) {
    const int tid = tid_opaque(), lane = tid & 63;
    const int gw = blockIdx.x * 8 + (tid >> 6), nw = gridDim.x * 8;
    unsigned char* ws = p.ws;
    const float* usc = (const float*)(ws + WS_PSC) + layer * 16384;
    const float* vsc = (const float*)(ws + WS_PSC) + 32768 + layer * 16384;
    const int* pl_idx = (const int*)(ws + WS_S + 3 * U_BYTES);
    const float* pl_gate = (const float*)(ws + WS_S + 3 * U_BYTES + (size_t)NT * 128 * 4);
    float* pd = (float*)(ws + WS_S + 4 * U_BYTES);
    const bf16_t* pdh = (const bf16_t*)(ws + WS_S + 5 * U_BYTES);
    const int nrows = layer ? NL : NT;
    const int head0 = 2 * (lane & 3), kk = lane >> 2;
    for (int R = gw; R < nrows; R += nw) {
        float d0 = 0.f, d1 = 0.f;
#pragma unroll
        for (int xx = 0; xx < 8; ++xx) { const unsigned t = *(const unsigned*)(pdh + ((size_t)xx * NT + R) * 128 + 2 * lane); d0 += bf_lo(t); d1 += bf_hi(t); }
        const size_t po = ((size_t)head0 * NT + R) * 16 + kk;
        const int e0 = pl_idx[po], e1 = pl_idx[po + (size_t)NT * 16];
        const float g0 = pl_gate[po], g1 = pl_gate[po + (size_t)NT * 16];
        d0 *= usc[e0] * 0.25f; d1 *= usc[e1] * 0.25f;
        const float c0 = g0 * vsc[e0] * 0.5f * d0 * (1.0f + erff(d0 * 0.70710678118f));
        const float c1 = g1 * vsc[e1] * 0.5f * d1 * (1.0f + erff(d1 * 0.70710678118f));
        pd[(size_t)R * 128 + 16 * head0 + kk] = c0;
        pd[(size_t)R * 128 + 16 * head0 + 16 + kk] = c1;
    }
}
DEV void phase_peer_v(const Params& p, int layer) {
    const int tid = tid_opaque(), lane = tid & 63, sub = lane >> 3, ch = lane & 7;
    const int ng = gridDim.x >> 3, x = blockIdx.x & 7, wq = blockIdx.x >> 3;
    if (wq < ng) {
        const int gw = __builtin_amdgcn_readfirstlane(wq * 8 + (tid >> 6)), nw = ng * 8;
        unsigned char* ws = p.ws;
        const __amdgpu_buffer_rsrc_t rs = __builtin_amdgcn_make_buffer_rsrc((void*)(ws + WS_PV + ((size_t)layer * 8 + x) * (16384 * 128)), 0, 16384 * 128, 0x00020000);
        const int* pl_idx = (const int*)(ws + WS_S + 3 * U_BYTES);
        const float* cb = (const float*)(ws + WS_S + 4 * U_BYTES) + 16 * sub;
        float* ctxr = (float*)(ws + WS_CTXR);
        const float* mods = (const float*)(ws + WS_MOD) + (size_t)layer * 9 * 6144 + 5 * 1024;
        const unsigned ch16 = 16u * (unsigned)ch;
        const int col = 128 * x + 16 * ch + 2 * sub;
        const int nrows = layer ? NL : NT;
        uint4 bufA[8], bufB[8];
        int eC[16], eN[16];
        float cC[16], cN[16];
#define PS_CF(cc, Rr) { _Pragma("unroll") for (int i = 0; i < 4; ++i) { const float4 t = *(const float4*)(cb + (size_t)(Rr) * 128 + 4 * i); \
        cc[4 * i] = t.x; cc[4 * i + 1] = t.y; cc[4 * i + 2] = t.z; cc[4 * i + 3] = t.w; } }
#define PV_FMA(accv, av) asm("v_fma_f32 %0, %1, %2, %0" : "+v"(accv) : "v"(cf), "v"(av))
#define PV_AXPY(buf, h) { _Pragma("unroll") for (int e = 0; e < 8; ++e) { \
        const float cf = cC[(h) * 8 + e]; const unsigned vw[4] = {buf[e].x, buf[e].y, buf[e].z, buf[e].w}; \
        _Pragma("unroll") for (int i = 0; i < 4; ++i) { \
            const f32x2 a = __builtin_amdgcn_cvt_pk_f32_fp8((int)vw[i], false), b2 = __builtin_amdgcn_cvt_pk_f32_fp8((int)vw[i], true); \
            PV_FMA(a16[4 * i], a.x); PV_FMA(a16[4 * i + 1], a.y); PV_FMA(a16[4 * i + 2], b2.x); PV_FMA(a16[4 * i + 3], b2.y); } } }
        int R = gw;
#pragma unroll
        for (int i = 0; i < 16; ++i) { eC[i] = 0; eN[i] = 0; cC[i] = 0.f; cN[i] = 0.f; }
        if (R < nrows) { PS_IDX(eC, R); PS_CF(cC, R); PS_LOAD(bufA, eC, 0); }
        for (; R < nrows; R += nw) {
            const int Rn = R + nw;
            if (Rn < nrows) { PS_IDX(eN, Rn); PS_CF(cN, Rn); }
            PS_LOAD(bufB, eC, 1);
            float* xrow = (R < NL ? p.out + (size_t)R * 1024 : ctxr + (size_t)(R - NL) * 1024) + col;
            const float2 xa = *(const float2*)xrow, ga = *(const float2*)(mods + (size_t)mod_batch(R) * 6144 + col);
            float a16[16];
#pragma unroll
            for (int i = 0; i < 16; ++i) a16[i] = 0.f;
            PV_AXPY(bufA, 0);
            if (Rn < nrows) { PS_LOAD(bufA, eN, 0); }
            PV_AXPY(bufB, 1);
            float s8[8], t4[4];
#pragma unroll
            for (int j = 0; j < 8; ++j) { const u32x2 r = __builtin_amdgcn_permlane32_swap(__float_as_uint(a16[j]), __float_as_uint(a16[8 + j]), false, false); s8[j] = __uint_as_float(r.x) + __uint_as_float(r.y); }
#pragma unroll
            for (int j = 0; j < 4; ++j) { const u32x2 r = __builtin_amdgcn_permlane16_swap(__float_as_uint(s8[j]), __float_as_uint(s8[4 + j]), false, false); t4[j] = __uint_as_float(r.x) + __uint_as_float(r.y); }
            const float wa0 = t4[0] + dpp_ror<8>(t4[0]), wa1 = t4[1] + dpp_ror<8>(t4[1]), wb0 = t4[2] + dpp_ror<8>(t4[2]), wb1 = t4[3] + dpp_ror<8>(t4[3]);
            const float w0 = (lane & 8) ? wb0 : wa0, w1 = (lane & 8) ? wb1 : wa1;
            *(float2*)xrow = make_float2(xa.x + ga.x * w0, xa.y + ga.y * w1);
#pragma unroll
            for (int i = 0; i < 16; ++i) { eC[i] = eN[i]; cC[i] = cN[i]; }
        }
    }
}
DEV void phase_final_norm(const Params& p) {
    const int tid = tid_opaque(), lane = tid & 63;
    const int gw = blockIdx.x * 8 + (tid >> 6), nw = gridDim.x * 8;
    const float* gn = p.in[34];
    for (int R = gw; R < NL; R += nw) {
        float* xr = p.out + (size_t)R * 1024;
        float4 v[4]; float ss = 0.f;
#pragma unroll
        for (int i = 0; i < 4; ++i) { v[i] = *(const float4*)(xr + i * 256 + lane * 4); ss += v[i].x * v[i].x + v[i].y * v[i].y + v[i].z * v[i].z + v[i].w * v[i].w; }
        ss = wave_allreduce(ss);
        const float rs = rsqrtf(ss * (1.0f / 1024.0f) + 1e-6f);
#pragma unroll
        for (int i = 0; i < 4; ++i) {
            const float4 gg = *(const float4*)(gn + i * 256 + lane * 4);
            *(float4*)(xr + i * 256 + lane * 4) = make_float4(v[i].x * rs * gg.x, v[i].y * rs * gg.y, v[i].z * rs * gg.z, v[i].w * rs * gg.w);
        }
    }
}

DEV void phase_gla_proj(const Params& p, unsigned char* lds) {
    unsigned char* ws = p.ws;
    const bf16_t* h = (const bf16_t*)(ws + WS_S + 0 * U_BYTES);
    const bf16_t* wint = (const bf16_t*)(ws + WS_WIN);
    {
        pg8::Gemm g{h, wint, NT, 3072, 1024};
        pg8::StaticOrder so; so.init(NT, 3072, gridDim.x, blockIdx.x);
        pg8::EpiBf16Tiles ep{(bf16_t*)(ws + WS_S + 1 * U_BYTES), 2048, 8, (bf16_t*)(ws + WS_S + 3 * U_BYTES), 1024};
        pg8::gemm_phase(( PG8_LAS unsigned char*)lds, g, so, ep, nullptr);
    }
    __syncthreads();
    for (int u = blockIdx.x; u < NT / 128; u += gridDim.x) {
        ALoadPlain al{h, 1024};
        EpiLr ep{(float*)(ws + WS_LR)};
        gemm_unit<128>(lds, al, wint + (size_t)3072 * 1024, 1024, u * 128, ep);
    }
}

DEV void conv_emit(const float (&acc)[8], int c, bf16_t* dst) {
    const float qs = (c < 512) ? 0.08838834764831845f : 1.0f;
    unsigned ow[4];
#pragma unroll
    for (int j = 0; j < 4; ++j) { const float a0 = acc[2 * j], a1 = acc[2 * j + 1]; ow[j] = pk_bf16(a0 * sigmoidf_(a0) * qs, a1 * sigmoidf_(a1) * qs); }
    *(uint4*)dst = make_uint4(ow[0], ow[1], ow[2], ow[3]);
}
DEV void conv_tap(float (&acc)[8], const uint4& v, const float (&w)[8]) {
    acc[0] += bf_lo(v.x) * w[0]; acc[1] += bf_hi(v.x) * w[1]; acc[2] += bf_lo(v.y) * w[2]; acc[3] += bf_hi(v.y) * w[3];
    acc[4] += bf_lo(v.z) * w[4]; acc[5] += bf_hi(v.z) * w[5]; acc[6] += bf_lo(v.w) * w[6]; acc[7] += bf_hi(v.w) * w[7];
}
DEV void phase_gla_conv(const Params& p) {
    const int tid = tid_opaque();
    unsigned char* ws = p.ws;
    const bf16_t* z = (const bf16_t*)(ws + WS_S + 1 * U_BYTES);
    bf16_t* o = (bf16_t*)(ws + WS_S + 4 * U_BYTES);
    const float* cw = p.in[25];
    const int x = tid >> 3, cl = (tid & 7) * 8;
    for (int task = blockIdx.x; task < 8 * 32; task += gridDim.x) {
        const int cb = task & 31, b = task >> 5;
        const int c = cb * 64 + cl;
        float w[9][8];
#pragma unroll
        for (int t = 0; t < 9; ++t) { const float4 w0 = *(const float4*)(cw + t * 2048 + c), w1 = *(const float4*)(cw + t * 2048 + c + 4); w[t][0] = w0.x; w[t][1] = w0.y; w[t][2] = w0.z; w[t][3] = w0.w; w[t][4] = w1.x; w[t][5] = w1.y; w[t][6] = w1.z; w[t][7] = w1.w; }
        const uint4 zero4 = make_uint4(0, 0, 0, 0);
        auto load_row = [&](int y, uint4 (&r)[3]) {
            if (y < 0 || y >= 128) { r[0] = zero4; r[1] = zero4; r[2] = zero4; return; }
            const bf16_t* row = z + ((size_t)b * 8192 + (size_t)y * 64 + x) * 2048 + c;
            r[1] = *(const uint4*)row;
            r[0] = (x > 0) ? *(const uint4*)(row - 2048) : zero4;
            r[2] = (x < 63) ? *(const uint4*)(row + 2048) : zero4;
        };
        uint4 r0[3], r1[3], r2[3], r3[3], r4[3];
        const int y0 = 0;
        load_row(y0 - 1, r0); load_row(y0, r1); load_row(y0 + 1, r2); load_row(y0 + 2, r3);
#pragma unroll 1
        for (int yy = 0; yy < 128; ++yy) {
            load_row(y0 + yy + 3, r4);
            float acc[8];
#pragma unroll
            for (int j = 0; j < 8; ++j) acc[j] = 0.f;
#pragma unroll
            for (int dx = 0; dx < 3; ++dx) { conv_tap(acc, r0[dx], w[dx]); conv_tap(acc, r1[dx], w[3 + dx]); conv_tap(acc, r2[dx], w[6 + dx]); }
            conv_emit(acc, c, o + ((size_t)b * 8192 + (size_t)(y0 + yy) * 64 + x) * 2048 + c);
#pragma unroll
            for (int dx = 0; dx < 3; ++dx) { r0[dx] = r1[dx]; r1[dx] = r2[dx]; r2[dx] = r3[dx]; r3[dx] = r4[dx]; }
        }
    }
    for (int task = blockIdx.x; task < (NC / 64) * 8; task += gridDim.x) {
        const int rb = task >> 3, cbk = task & 7;
        const int R = NL + rb * 64 + (tid >> 3);
        const int t = (R - NL) & 255;
#pragma unroll 1
        for (int i = 0; i < 4; ++i) {
            const int c = cbk * 256 + (tid & 7) * 8 + i * 64;
            float acc[8];
#pragma unroll
            for (int j = 0; j < 8; ++j) acc[j] = 0.f;
#pragma unroll
            for (int dx = -1; dx <= 1; ++dx) {
                if (t + dx >= 0 && t + dx < 256) {
                    const uint4 v = *(const uint4*)(z + (size_t)(R + dx) * 2048 + c);
                    const float* wp = cw + (3 + (dx + 1)) * 2048 + c;
                    const float4 w0 = *(const float4*)wp, w1 = *(const float4*)(wp + 4);
                    const float wv[8] = {w0.x, w0.y, w0.z, w0.w, w1.x, w1.y, w1.z, w1.w};
                    conv_tap(acc, v, wv);
                }
            }
            conv_emit(acc, c, o + (size_t)R * 2048 + c);
        }
    }
}

constexpr int GT_QE = 0, GT_KET = 16384, GT_A = 32768, GT_CONST = 40960, GT_STRIDE = 43008;
constexpr int GT_N0 = (int)((2 * U_BYTES) / GT_STRIDE);
constexpr size_t WS_TOTAL = 1073741824ull;
static_assert((size_t)(NB * 4 * 2 * 132 - GT_N0) * GT_STRIDE <= WS_TOTAL - WS_END, "tile records do not fit");
DEV size_t gla_tile_off(int b, int hd, int d, int cc) {
    const int idx = (((b * 4 + hd) * 2 + d) * 132) + cc;
    return idx < GT_N0 ? WS_S + (size_t)idx * GT_STRIDE : WS_END + (size_t)(idx - GT_N0) * GT_STRIDE;
}
DEV int gla_row0(int b, int cc) { return cc < 4 ? NL + b * 256 + cc * 64 : b * 8192 + (cc - 4) * 64; }
DEV void phase_gla_prep(const Params& p, unsigned char* lds) {
    const int tid = tid_opaque(), lane = tid & 63, wv = tid >> 6;
    const int fr = lane & 15, fq = lane >> 4;
    unsigned char* ws = p.ws;
    constexpr int QE = 0, KE = 16384, KET = 32768, BC = 49152  , GS = 82944  , LRL = 86528  , BCS = 132;
    const bf16_t* qkv = (const bf16_t*)(ws + WS_S + 4 * U_BYTES);
    const float* lrb = (const float*)(ws + WS_LR);
    unsigned char* gt = ws;
    float* bc = (float*)(lds + BC);
    float* gs = (float*)(lds + GS);
    const int li = tid >> 3, lc = tid & 7;
    const int d = blockIdx.x & 1, hd = (blockIdx.x >> 1) & 3;
    bf16x8 gkf;
    {
        unsigned w4[4] = {0u, 0u, 0u, 0u};
        if (fq < 2) {
#pragma unroll
            for (int e2 = 0; e2 < 4; ++e2) {
                const float g0 = p.in[26][(size_t)(d * 16 + 8 * fq + 2 * e2) * 512 + hd * 128 + wv * 16 + fr];
                const float g1 = p.in[26][(size_t)(d * 16 + 8 * fq + 2 * e2 + 1) * 512 + hd * 128 + wv * 16 + fr];
                w4[e2] = pk_bf16(g0, g1);
            }
        }
        gkf = as_bf16x8(make_uint4(w4[0], w4[1], w4[2], w4[3]));
    }
    const float4 gb4 = *(const float4*)(p.in[27] + d * 512 + hd * 128 + wv * 16 + 4 * fq);
    const int qstep = (int)(gridDim.x >> 3);
    uint4 nq0, nq1, nk0, nk1; float2 nl;
    auto fetch = [&](int q) {
        const size_t R = (size_t)(gla_row0(q / 132, q % 132) + li);
        const bf16_t* row = qkv + R * 2048;
        nq0 = *(const uint4*)(row + hd * 128 + lc * 8); nq1 = *(const uint4*)(row + hd * 128 + 64 + lc * 8);
        nk0 = *(const uint4*)(row + 512 + hd * 128 + lc * 8); nk1 = *(const uint4*)(row + 512 + hd * 128 + 64 + lc * 8);
        nl = *(const float2*)(lrb + R * 32 + d * 16 + lc * 2);
    };
    int q = (int)(blockIdx.x >> 3);
    if (q < NB * 132) fetch(q);
    for (; q < NB * 132; q += qstep) {
        const int cc = q % 132, b = q / 132;
        unsigned char* rec = gt + gla_tile_off(b, hd, d, cc);
        const uint4 rq0 = nq0, rq1 = nq1, rk0 = nk0, rk1 = nk1; const float2 rl = nl;
        if (q + qstep < NB * 132) fetch(q + qstep);
        *(unsigned*)(lds + LRL + li * 32 + lc * 4) = pk_bf16(rl.x, rl.y);
        __syncthreads();
        {
            const float gbv[4] = {gb4.x, gb4.y, gb4.z, gb4.w};
#pragma unroll
            for (int itl = 0; itl < 4; ++itl) {
                uint4 lr4 = *(const uint4*)(lds + LRL + (itl * 16 + fr) * 32 + (fq & 1) * 16);
                if (fq >= 2) lr4 = make_uint4(0, 0, 0, 0);
                f32x4 a = {0.f, 0.f, 0.f, 0.f};
                a = __builtin_amdgcn_mfma_f32_16x16x32_bf16(gkf, as_bf16x8(lr4), a, 0, 0, 0);
                float s[4], tot[4];
#pragma unroll
                for (int j = 0; j < 4; ++j) {
                    const float xx = a[j] + gbv[j];
                    const float la = (fminf(xx, 0.f) - __logf(1.0f + __expf(-fabsf(xx)))) * (1.0f / 16.0f);
                    float pf = la;
                    pf += dpp_shr0<1>(pf); pf += dpp_shr0<2>(pf); pf += dpp_shr0<4>(pf); pf += dpp_shr0<8>(pf);
                    tot[j] = __shfl(pf, (lane & 48) | 15);
                    s[j] = d ? (tot[j] - pf + la) : pf;
                }
                *(float4*)(bc + (itl * 16 + fr) * BCS + wv * 16 + 4 * fq) = make_float4(s[0], s[1], s[2], s[3]);
                if (fr == 15) *(float4*)(gs + itl * 128 + wv * 16 + 4 * fq) = make_float4(tot[0], tot[1], tot[2], tot[3]);
            }
        }
        __syncthreads();
        if (tid < 128) {
            const float g0 = gs[tid], g1 = gs[128 + tid], g2 = gs[256 + tid], g3 = gs[384 + tid];
            const float refc = d ? (bc[31 * BCS + tid] + g2 + g3) : (bc[32 * BCS + tid] + g0 + g1), lastc = g0 + g1 + g2 + g3;
            const float dl = __expf(lastc), er = __expf(refc), el = __expf(lastc - refc);
            gs[512 + tid] = refc;
            float* cst = (float*)(rec + GT_CONST);
            cst[tid] = er; cst[128 + tid] = el; cst[256 + tid] = dl;
        }
        __syncthreads();
        {
            const int grp = li >> 4;
            const uint4 rqs[2] = {rq0, rq1}, rks[2] = {rk0, rk1};
#pragma unroll
            for (int hseg = 0; hseg < 2; ++hseg) {
                const int k0 = hseg * 64 + lc * 8;
                float bcv[8], refv[8];
#pragma unroll
                for (int j4 = 0; j4 < 2; ++j4) {
                    const float4 g0 = *(const float4*)(gs + k0 + j4 * 4), g1 = *(const float4*)(gs + 128 + k0 + j4 * 4);
                    const float4 g2 = *(const float4*)(gs + 256 + k0 + j4 * 4), g3 = *(const float4*)(gs + 384 + k0 + j4 * 4);
                    const float4 bi = *(const float4*)(bc + li * BCS + k0 + j4 * 4), rf = *(const float4*)(gs + 512 + k0 + j4 * 4);
                    const float g0a[4] = {g0.x, g0.y, g0.z, g0.w}, g1a[4] = {g1.x, g1.y, g1.z, g1.w}, g2a[4] = {g2.x, g2.y, g2.z, g2.w}, g3a[4] = {g3.x, g3.y, g3.z, g3.w};
                    const float bia[4] = {bi.x, bi.y, bi.z, bi.w}, rfa[4] = {rf.x, rf.y, rf.z, rf.w};
#pragma unroll
                    for (int j = 0; j < 4; ++j) {
                        const float pre = d ? ((grp < 1 ? g1a[j] : 0.f) + (grp < 2 ? g2a[j] : 0.f) + (grp < 3 ? g3a[j] : 0.f))
                                            : ((grp > 0 ? g0a[j] : 0.f) + (grp > 1 ? g1a[j] : 0.f) + (grp > 2 ? g2a[j] : 0.f));
                        bcv[j4 * 4 + j] = bia[j] + pre;
                        refv[j4 * 4 + j] = rfa[j];
                    }
                }
                const unsigned qw[4] = {rqs[hseg].x, rqs[hseg].y, rqs[hseg].z, rqs[hseg].w}, kw[4] = {rks[hseg].x, rks[hseg].y, rks[hseg].z, rks[hseg].w};
                unsigned oqe[4], oke[4];
#pragma unroll
                for (int j2 = 0; j2 < 4; ++j2) {
                    const float q0 = bf_lo(qw[j2]), q1 = bf_hi(qw[j2]), kk0 = bf_lo(kw[j2]), kk1 = bf_hi(kw[j2]);
                    const float e0 = __expf(bcv[2 * j2] - refv[2 * j2]), e1 = __expf(bcv[2 * j2 + 1] - refv[2 * j2 + 1]);
                    const float r0 = __builtin_amdgcn_rcpf(e0), r1 = __builtin_amdgcn_rcpf(e1);
                    oqe[j2] = pk_bf16(q0 * e0, q1 * e1);
                    oke[j2] = pk_bf16(kk0 * r0, kk1 * r1);
                    const int kc0 = k0 + 2 * j2;
                    *(bf16_t*)(lds + KET + tile_off2(kc0, li >> 3) + (li & 7) * 2) = (bf16_t)(oke[j2] & 0xffffu);
                    *(bf16_t*)(lds + KET + tile_off2(kc0 + 1, li >> 3) + (li & 7) * 2) = (bf16_t)(oke[j2] >> 16);
                }
                const int chq = hseg * 8 + lc;
                const int so = li * 256 + ((chq ^ (li & 15)) << 4);
                *(uint4*)(lds + QE + so) = make_uint4(oqe[0], oqe[1], oqe[2], oqe[3]);
                *(uint4*)(lds + KE + so) = make_uint4(oke[0], oke[1], oke[2], oke[3]);
                *(uint4*)(rec + GT_QE + so) = make_uint4(oqe[0], oqe[1], oqe[2], oqe[3]);
            }
        }
        __syncthreads();
        {
            const int it = wv & 3, pr2 = wv >> 2;
#pragma unroll
            for (int jj = 0; jj < 2; ++jj) {
                const int jt = pr2 * 2 + jj;
                f32x4 a = {0.f, 0.f, 0.f, 0.f};
                if (d ? (jt >= it) : (jt <= it)) {
#pragma unroll
                    for (int ks = 0; ks < 4; ++ks) {
                        const int ch = ks * 4 + fq;
                        const int rj = jt * 16 + fr, ri = it * 16 + fr;
                        const bf16x8 fa = *(const bf16x8*)(lds + KE + rj * 256 + ((ch ^ (rj & 15)) << 4));
                        const bf16x8 fb = *(const bf16x8*)(lds + QE + ri * 256 + ((ch ^ (ri & 15)) << 4));
                        a = __builtin_amdgcn_mfma_f32_16x16x32_bf16(fa, fb, a, 0, 0, 0);
                    }
                }
                const int i = it * 16 + fr, j = jt * 16 + 4 * fq;
                float av[4];
#pragma unroll
                for (int e = 0; e < 4; ++e) av[e] = (d ? (j + e >= i) : (j + e <= i)) ? a[e] : 0.f;
                *(uint2*)(rec + GT_A + i * 128 + (((j >> 3) ^ (i & 7)) << 4) + (j & 7) * 2) = make_uint2(pk_bf16(av[0], av[1]), pk_bf16(av[2], av[3]));
            }
#pragma unroll
            for (int i = 0; i < 2; ++i) *(uint4*)(rec + GT_KET + i * 8192 + tid * 16) = *(const uint4*)(lds + KET + i * 8192 + tid * 16);
        }
        __syncthreads();
    }
}

DEV void phase_gla_scan(const Params& p, unsigned char* lds) {
    const int tid = tid_opaque(), lane = tid & 63, wv = tid >> 6;
    const int fr = lane & 15, fq = lane >> 4;
    unsigned char* ws = p.ws;
    constexpr int QE = 0  , KET = 32768  , AL = 65536  , VT = 81920, ST = 90112  ;
    const bf16_t* qkv = (const bf16_t*)(ws + WS_S + 4 * U_BYTES);
    const unsigned char* gt = ws;
    for (int unit = blockIdx.x; unit < 256; unit += gridDim.x) {
        const int vs = unit & 3, d = (unit >> 2) & 1, hd = (unit >> 3) & 3, b = unit >> 5;
        bf16_t* odst = d ? (bf16_t*)(ws + WS_S + 2 * U_BYTES) : (bf16_t*)(ws + WS_S + 4 * U_BYTES);
        const int old_ = d ? 1024 : 2048;
        const int li = tid >> 3, lc = tid & 7;
        auto ccof = [&](int c) -> int { return d ? (c < 4 ? 3 - c : 135 - c) : c; };
        auto dma = [&](int cc, int buf) {
            const unsigned char* rec = gt + gla_tile_off(b, hd, d, cc);
#pragma unroll
            for (int i = 0; i < 2; ++i) {
                __builtin_amdgcn_global_load_lds((const unsigned*)(rec + GT_QE + i * 8192 + tid * 16), (unsigned*)(lds + QE + buf * 16384 + i * 8192 + tid * 16), 16, 0, 0);
                __builtin_amdgcn_global_load_lds((const unsigned*)(rec + GT_KET + i * 8192 + tid * 16), (unsigned*)(lds + KET + buf * 16384 + i * 8192 + tid * 16), 16, 0, 0);
            }
            __builtin_amdgcn_global_load_lds((const unsigned*)(rec + GT_A + tid * 16), (unsigned*)(lds + AL + buf * 8192 + tid * 16), 16, 0, 0);
        };
        uint4 nv; float4 n_dl, n_el, n_er;
        auto loads = [&](int c) {
            const int cc = ccof(c);
            nv = *(const uint4*)(qkv + (size_t)(gla_row0(b, cc) + li) * 2048 + 1024 + hd * 256 + vs * 64 + lc * 8);
            const float* cst = (const float*)(gt + gla_tile_off(b, hd, d, cc) + GT_CONST);
            n_el = *(const float4*)(cst + 128 + wv * 16 + 4 * fq); n_dl = *(const float4*)(cst + 256 + wv * 16 + 4 * fq);
            if (c + 1 < 132) n_er = *(const float4*)((const float*)(gt + gla_tile_off(b, hd, d, ccof(c + 1)) + GT_CONST) + wv * 16 + 4 * fq);
            else n_er = make_float4(0.f, 0.f, 0.f, 0.f);
        };
        f32x4 accS[4];
#pragma unroll
        for (int i = 0; i < 4; ++i) accS[i] = (f32x4){0.f, 0.f, 0.f, 0.f};
        for (int i = tid; i < 32768 / 16; i += NTHREADS) *(uint4*)(lds + ST + i * 16) = make_uint4(0, 0, 0, 0);
        dma(ccof(0), 0);
        loads(0);
        for (int c = 0; c < 132; ++c) {
            const int buf = c & 1, cc = ccof(c);
            const uint4 rv = nv; const float4 dl4 = n_dl, el4 = n_el, er4 = n_er;
            asm volatile("s_waitcnt vmcnt(0)" ::: "memory");
            {
                const unsigned vw[4] = {rv.x, rv.y, rv.z, rv.w};
#pragma unroll
                for (int j2 = 0; j2 < 4; ++j2) {
                    const int vc0 = lc * 8 + 2 * j2;
                    *(bf16_t*)(lds + VT + tile_off2(vc0, li >> 3) + (li & 7) * 2) = (bf16_t)(vw[j2] & 0xffffu);
                    *(bf16_t*)(lds + VT + tile_off2(vc0 + 1, li >> 3) + (li & 7) * 2) = (bf16_t)(vw[j2] >> 16);
                }
            }
            asm volatile("s_waitcnt lgkmcnt(0)" ::: "memory"); __builtin_amdgcn_s_barrier(); asm volatile("" ::: "memory");
            if (c + 1 < 132) { dma(ccof(c + 1), buf ^ 1); loads(c + 1); }
            const int it = wv & 3, pr2 = wv >> 2;
            const int r0 = gla_row0(b, cc);
#pragma unroll
            for (int vv = 0; vv < 2; ++vv) {
                const int vt = pr2 * 2 + vv;
                f32x4 a = {0.f, 0.f, 0.f, 0.f};
#pragma unroll
                for (int ks = 0; ks < 4; ++ks) {
                    const int ch = ks * 4 + fq;
                    const int rvv = vt * 16 + fr, ri = it * 16 + fr;
                    const bf16x8 fa = *(const bf16x8*)(lds + ST + buf * 16384 + rvv * 256 + ((ch ^ (rvv & 15)) << 4));
                    const bf16x8 fb = *(const bf16x8*)(lds + QE + buf * 16384 + ri * 256 + ((ch ^ (ri & 15)) << 4));
                    a = __builtin_amdgcn_mfma_f32_16x16x32_bf16(fa, fb, a, 0, 0, 0);
                }
#pragma unroll
                for (int ks = 0; ks < 2; ++ks) {
                    const int ch = ks * 4 + fq;
                    const int rvv = vt * 16 + fr, ri = it * 16 + fr;
                    const bf16x8 fa = *(const bf16x8*)(lds + VT + tile_off2(rvv, ch));
                    const bf16x8 fb = *(const bf16x8*)(lds + AL + buf * 8192 + ri * 128 + ((ch ^ (ri & 7)) << 4));
                    a = __builtin_amdgcn_mfma_f32_16x16x32_bf16(fa, fb, a, 0, 0, 0);
                }
                const int i = it * 16 + fr, vcol = vt * 16 + 4 * fq;
                *(uint2*)(odst + (size_t)(r0 + i) * old_ + hd * 256 + vs * 64 + vcol) = make_uint2(pk_bf16(a[0], a[1]), pk_bf16(a[2], a[3]));
            }
            {
                const int kt = wv;
                bf16x8 fa[2];
#pragma unroll
                for (int ks = 0; ks < 2; ++ks) fa[ks] = *(const bf16x8*)(lds + KET + buf * 16384 + tile_off2(kt * 16 + fr, ks * 4 + fq));
#pragma unroll
                for (int vt = 0; vt < 4; ++vt) {
                    f32x4 t = {0.f, 0.f, 0.f, 0.f};
#pragma unroll
                    for (int ks = 0; ks < 2; ++ks) t = __builtin_amdgcn_mfma_f32_16x16x32_bf16(fa[ks], *(const bf16x8*)(lds + VT + tile_off2(vt * 16 + fr, ks * 4 + fq)), t, 0, 0, 0);
                    f32x4 a = accS[vt];
                    a[0] = a[0] * dl4.x + t[0] * el4.x; a[1] = a[1] * dl4.y + t[1] * el4.y; a[2] = a[2] * dl4.z + t[2] * el4.z; a[3] = a[3] * dl4.w + t[3] * el4.w;
                    accS[vt] = a;
                    const int vcol = vt * 16 + fr, kcol = kt * 16 + 4 * fq;
                    *(uint2*)(lds + ST + (buf ^ 1) * 16384 + vcol * 256 + (((kcol >> 3) ^ (vcol & 15)) << 4) + (kcol & 7) * 2) =
                        make_uint2(pk_bf16(a[0] * er4.x, a[1] * er4.y), pk_bf16(a[2] * er4.z, a[3] * er4.w));
                }
            }
            asm volatile("s_waitcnt lgkmcnt(0)" ::: "memory"); __builtin_amdgcn_s_barrier(); asm volatile("" ::: "memory");
        }
        asm volatile("s_waitcnt vmcnt(0)" ::: "memory");
        __syncthreads();
    }
}

DEV void phase_gla_readout(const Params& p) {
    const int tid = tid_opaque(), lane = tid & 63;
    const int gw = blockIdx.x * 8 + (tid >> 6), nw = gridDim.x * 8;
    unsigned char* ws = p.ws;
    const bf16_t* o0 = (const bf16_t*)(ws + WS_S + 4 * U_BYTES);
    const bf16_t* o1 = (const bf16_t*)(ws + WS_S + 2 * U_BYTES);
    const bf16_t* gb = (const bf16_t*)(ws + WS_S + 3 * U_BYTES);
    bf16_t* ao = (bf16_t*)(ws + WS_S + 0 * U_BYTES);
    const float4 hn = *(const float4*)(p.in[28] + lane * 4);
    for (int item = gw; item < NL * 4; item += nw) {
        const size_t off = (size_t)(item >> 2) * 1024 + (item & 3) * 256 + lane * 4;
        const uint2 a = *(const uint2*)(o0 + off + (size_t)(item >> 2) * 1024), b2 = *(const uint2*)(o1 + off), g2 = *(const uint2*)(gb + off);
        const float v0 = bf_lo(a.x) + bf_lo(b2.x), v1 = bf_hi(a.x) + bf_hi(b2.x), v2 = bf_lo(a.y) + bf_lo(b2.y), v3 = bf_hi(a.y) + bf_hi(b2.y);
        float ss = v0 * v0 + v1 * v1 + v2 * v2 + v3 * v3;
        ss = wave_allreduce(ss);
        const float rs = rsqrtf(ss * (1.0f / 256.0f) + 1e-6f);
        const float g0 = bf_lo(g2.x), g1 = bf_hi(g2.x), g2f = bf_lo(g2.y), g3 = bf_hi(g2.y);
        const float r0 = v0 * rs * hn.x * (g0 * sigmoidf_(g0)), r1 = v1 * rs * hn.y * (g1 * sigmoidf_(g1));
        const float r2 = v2 * rs * hn.z * (g2f * sigmoidf_(g2f)), r3 = v3 * rs * hn.w * (g3 * sigmoidf_(g3));
        *(uint2*)(ao + off) = make_uint2(pk_bf16(r0, r1), pk_bf16(r2, r3));
    }
}


#define XB_TMO      128
#define XB_XCNT(j)  (256  + 64 * (j))
#define XB_XSUB(j)  (1280 + 64 * (j))
#define XB_XGEN(j)  (2304 + 64 * (j))
#define XB_TOP      3328
#define XB_TOPGEN   3392
#define XB_SPIN_CAP (1u << 22)
DEV unsigned xb_ld(unsigned* p) { return __hip_atomic_load(p, __ATOMIC_RELAXED, __HIP_MEMORY_SCOPE_AGENT); }
DEV unsigned xb_add(unsigned* p, unsigned v) { return __hip_atomic_fetch_add(p, v, __ATOMIC_RELAXED, __HIP_MEMORY_SCOPE_AGENT); }
DEV unsigned xb_xcc_id() { return (unsigned)__builtin_amdgcn_s_getreg((3 << 11) | 20) & 0xFu; }
#define XB_SPIN(cond, bar) do { unsigned _sp = 0; while (cond) { __builtin_amdgcn_s_sleep(1); \
    if ((++_sp & 255u) == 0u) { if (xb_ld(&(bar)[XB_TMO])) break; if (_sp > XB_SPIN_CAP) { atomicAdd(&(bar)[XB_TMO], 1u); break; } } } } while (0)
DEV void xcd_barrier_complete(unsigned* bar, unsigned x, unsigned& nloc, unsigned& nx) {
    const unsigned G = gridDim.x;
    unsigned sum, cnt, mine, sp = 0u;
    for (;;) {
        sum = 0u; cnt = 0u; mine = 0u;
#pragma unroll
        for (unsigned j = 0; j < 16; ++j) { const unsigned c = xb_ld(&bar[XB_XCNT(j)]); sum += c; cnt += (c > 0u) ? 1u : 0u; mine = (j == x) ? c : mine; }
        if (sum == G) break;
        __builtin_amdgcn_s_sleep(1);
        if ((++sp & 255u) == 0u) { if (xb_ld(&bar[XB_TMO])) break; if (sp > XB_SPIN_CAP) { atomicAdd(&bar[XB_TMO], 1u); break; } }
    }
    nloc = mine > 0u ? mine : 1u; nx = cnt > 0u ? cnt : 1u;
}
DEV void xcd_barrier(unsigned* bar, volatile LAS3 unsigned* st) {
    asm volatile("s_waitcnt vmcnt(0)" ::: "memory");
    __syncthreads();
    if (tid_opaque() == 0) {
        const unsigned x = xb_xcc_id();
        __builtin_amdgcn_s_waitcnt(0);
        unsigned nloc = st[0], nx = st[1];
        if (nloc == 0u) { xcd_barrier_complete(bar, x, nloc, nx); st[0] = nloc; st[1] = nx; }
        const unsigned old = xb_add(&bar[XB_XSUB(x)], 1u);
        const unsigned gen = old / nloc;
        if (old + 1u == (gen + 1u) * nloc) {
            __builtin_amdgcn_fence(__ATOMIC_RELEASE, "agent");
            asm volatile("s_waitcnt vmcnt(0)" ::: "memory");
            const unsigned og = xb_add(&bar[XB_TOP], 1u);
            const unsigned tg = og / nx;
            if (og + 1u == (tg + 1u) * nx) xb_add(&bar[XB_TOPGEN], 1u);
            else XB_SPIN(xb_ld(&bar[XB_TOPGEN]) == tg, bar);
            __builtin_amdgcn_fence(__ATOMIC_ACQUIRE, "agent");
            xb_add(&bar[XB_XGEN(x)], 1u);
            asm volatile("s_waitcnt vmcnt(0)" ::: "memory");
        } else {
            XB_SPIN(xb_ld(&bar[XB_XGEN(x)]) == gen, bar);
            __builtin_amdgcn_fence(__ATOMIC_ACQUIRE, "agent");
            asm volatile("s_waitcnt vmcnt(0)" ::: "memory");
        }
    }
    __syncthreads();
}
#define SYNC() do { asm volatile("s_waitcnt vmcnt(0)" ::: "memory"); grid.sync(); \
    if (tid_opaque() == 0) { __builtin_amdgcn_fence(__ATOMIC_ACQUIRE, "agent"); asm volatile("s_waitcnt vmcnt(0)" ::: "memory"); } \
    __syncthreads(); } while (0)
__global__ void __launch_bounds__(NTHREADS) mega_fwd(Params p) {
    unsigned char* const lds = g_lds;
    cg::grid_group grid = cg::this_grid();
#define XBAR ((unsigned*)(p.ws + WS_BAR))
#define XST ((volatile LAS3 unsigned*)(lds + LDS_BYTES - 16))
    if ((threadIdx.x & 63) == 0) g_lds[LDS_WTAB + hw_wave_slot()] = (unsigned char)(threadIdx.x >> 6);
    if (threadIdx.x == 0) { XST[0] = 0u; XST[1] = 0u; (void)xb_add(&XBAR[XB_XCNT(xb_xcc_id())], 1u); }
    __syncthreads();
#define S0 ((bf16_t*)(p.ws + WS_S + 0 * U_BYTES))
#define SLOT(i) ((bf16_t*)(p.ws + WS_S + (size_t)(i) * U_BYTES))
#define S1 ((bf16_t*)(p.ws + WS_S + 1 * U_BYTES))
#define CTXR ((const float*)(p.ws + WS_CTXR))
    phase0(p, lds); SYNC();
#undef SYNC
#define SYNC() xcd_barrier(XBAR, XST)
    phase_normmix(p, S0, SLOT(5), SLOT(1), SLOT(2)); SYNC();
    phase_rw_proj1(p, lds, 0, SLOT(5), SLOT(3)); SYNC();
    phase_rw_proj1(p, lds, 1, SLOT(1), SLOT(5)); SYNC();
    phase_rw_proj1(p, lds, 2, SLOT(2), SLOT(1)); phase_rw_lora(p, lds); SYNC();
    REPEAT(3, phase_rw_scan(p, lds));
    phase_rw_scan(p, lds); SYNC();
    REPEAT(4, phase_rw_readout(p));
    phase_rw_readout(p); SYNC();
    REPEAT(5, phase_wo(p, lds, 0));
    phase_wo(p, lds, 0); SYNC();
    REPEAT(6, phase_normmod(p, 0, 1, p.out, CTXR, NT, S1, (unsigned char*)SLOT(2)));
    phase_normmod(p, 0, 1, p.out, CTXR, NT, S1, (unsigned char*)SLOT(2)); SYNC();
    REPEAT(7, phase_peer_select(p, lds, 0));
    phase_peer_select(p, lds, 0); SYNC();
    phase_peer_u(p, lds, 0); SYNC();
    phase_peer_c(p, 0); SYNC();
    phase_peer_v(p, 0); SYNC();
    phase_normmod(p, 1, 0, p.out, CTXR, NT, S0, nullptr); SYNC();
    REPEAT(9, phase_gla_proj(p, lds));
    phase_gla_proj(p, lds); SYNC();
    REPEAT(10, phase_gla_conv(p));
    phase_gla_conv(p); SYNC();
    REPEAT(18, phase_gla_prep(p, lds));
    phase_gla_prep(p, lds); SYNC();
    REPEAT(11, phase_gla_scan(p, lds));
    phase_gla_scan(p, lds); SYNC();
    REPEAT(12, phase_gla_readout(p));
    phase_gla_readout(p); SYNC();
    phase_wo(p, lds, 1); SYNC();
    REPEAT(14, phase_normmod(p, 1, 1, p.out, CTXR, NL, S0, (unsigned char*)SLOT(2)));
    phase_normmod(p, 1, 1, p.out, CTXR, NL, S0, (unsigned char*)SLOT(2)); SYNC();
    REPEAT(15, phase_peer_select(p, lds, 1));
    phase_peer_select(p, lds, 1); SYNC();
    phase_peer_u(p, lds, 1); SYNC();
    phase_peer_c(p, 1); SYNC();
    phase_peer_v(p, 1); SYNC();
    phase_final_norm(p);
}

extern "C" void kernel_launch(void* const* d_in, const int* in_sizes, int n_in, void* d_out, int out_size, void* d_ws, size_t ws_size, hipStream_t stream) {
    static int grid_blocks = 0;
    if (grid_blocks == 0) {
        if (n_in != 35 || ws_size < WS_TOTAL) { fprintf(stderr, "kernel_launch: unexpected n_in %d or ws_size %zu (< %zu)\n", n_in, ws_size, (size_t)WS_END); grid_blocks = -1; return; }
        int dev = 0, cus = 0, per_cu = 0;
        if (hipGetDevice(&dev) != hipSuccess || hipDeviceGetAttribute(&cus, hipDeviceAttributeMultiprocessorCount, dev) != hipSuccess) { fprintf(stderr, "kernel_launch: device query failed\n"); grid_blocks = -1; return; }
        if (hipFuncSetAttribute((const void*)mega_fwd, hipFuncAttributeMaxDynamicSharedMemorySize, LDS_BYTES) != hipSuccess) { fprintf(stderr, "kernel_launch: hipFuncSetAttribute failed\n"); grid_blocks = -1; return; }
        if (hipOccupancyMaxActiveBlocksPerMultiprocessor(&per_cu, (const void*)mega_fwd, NTHREADS, LDS_BYTES) != hipSuccess || per_cu < 1) { fprintf(stderr, "kernel_launch: occupancy query says %d blocks per CU\n", per_cu); grid_blocks = -1; return; }
        grid_blocks = cus;
    }
    if (grid_blocks < 0) return;
    Params p{};
    for (int i = 0; i < 35; ++i) p.in[i] = (const float*)d_in[i];
    p.out = (float*)d_out;
    p.ws = (unsigned char*)d_ws;
    if (hipMemsetAsync((char*)d_ws + WS_BAR, 0, 16384, stream) != hipSuccess) { fprintf(stderr, "kernel_launch: hipMemsetAsync failed\n"); return; }
    void* args[] = {&p};
    hipError_t e = hipLaunchCooperativeKernel((const void*)mega_fwd, dim3(grid_blocks), dim3(NTHREADS), args, LDS_BYTES, stream);
    if (e != hipSuccess) fprintf(stderr, "kernel_launch: cooperative launch failed: %s (grid %d)\n", hipGetErrorString(e), grid_blocks);
}
```

```cpp
#include <hip/hip_runtime.h>
#include <hip/hip_cooperative_groups.h>
#include <cstdio>
#include <cstdint>
namespace cg = cooperative_groups;

#define DEV __device__ __forceinline__
#ifndef REP
#define REP 0
#endif
#define GREPS(n) ((REP == (n)) ? 2 : 1)
#define REPEAT(n, stmt) do { if (REP == (n)) { stmt; SYNC(); } } while (0)

typedef unsigned short bf16_t;
typedef short bf16x8 __attribute__((ext_vector_type(8)));
typedef float f32x4 __attribute__((ext_vector_type(4)));
typedef __bf16 bf16x2v __attribute__((ext_vector_type(2)));

constexpr int D = 1024;
constexpr int NB = 8, SEQ = 8192, CTXL = 256;
constexpr int NL = NB * SEQ, NC = NB * CTXL, NT = NL + NC;
constexpr int NTHREADS = 512;
constexpr int LDS_BYTES = 160 * 1024;

constexpr size_t U_BYTES = (size_t)NT * 1024 * 2;
constexpr size_t WS_BAR = 0;
constexpr size_t WS_MOD = 16384;
constexpr size_t WS_CTXR = WS_MOD + (size_t)2 * 9 * 6144 * 4;
constexpr size_t WS_LR = WS_CTXR + (size_t)NC * 1024 * 4;
constexpr size_t WS_BONUS = WS_LR + (size_t)NT * 32 * 4;
constexpr size_t WS_WPROJ = WS_BONUS + (size_t)2 * NT * 16 * 4;
constexpr size_t WS_W2T = WS_WPROJ + (size_t)3456 * 1024 * 2;
constexpr size_t WS_A2T = WS_W2T + (size_t)2 * 1024 * 64 * 2;
constexpr size_t WS_G2T = WS_A2T + (size_t)2 * 1024 * 64 * 2;
constexpr size_t WS_WO0 = WS_G2T + (size_t)1024 * 128 * 2;
constexpr size_t WS_WO1 = WS_WO0 + (size_t)1024 * 1024 * 2;
constexpr size_t WS_WQ = WS_WO1 + (size_t)1024 * 1024 * 2;
constexpr size_t WS_KEYS = WS_WQ + (size_t)2 * 2048 * 1024 * 2;
constexpr size_t WS_WIN = WS_KEYS + (size_t)2 * 8 * 2 * 128 * 128 * 2;
constexpr size_t WS_PU = WS_WIN + (size_t)3200 * 1024 * 2;
constexpr size_t WS_PV = WS_PU + (size_t)2 * 16384 * 1024;
constexpr size_t WS_PSC = WS_PV + (size_t)2 * 16384 * 1024;
constexpr size_t WS_S = WS_PSC + (size_t)2 * 2 * 16384 * 4;
constexpr size_t WS_END = WS_S + 6 * U_BYTES;
static_assert(WS_END <= 1073741824ull, "workspace too large");
static_assert((WS_CTXR % 256) == 0 && (WS_WPROJ % 256) == 0 && (WS_S % 256) == 0, "alignment");

struct Params {
    const float* in[35];
    float* out;
    unsigned char* ws;
    int pad0, pad1;
};

DEV float bf_lo(unsigned u) { return __uint_as_float(u << 16); }
DEV float bf_hi(unsigned u) { return __uint_as_float(u & 0xffff0000u); }
typedef float f32x2v __attribute__((ext_vector_type(2)));
typedef unsigned int u32x2v __attribute__((ext_vector_type(2)));
typedef short s16x4v __attribute__((ext_vector_type(4)));
DEV unsigned pk_bf16(float lo, float hi) { const f32x2v f = {lo, hi}; union { bf16x2v v; unsigned u; } x; x.v = __builtin_convertvector(f, bf16x2v); return x.u; }
template <int N> DEV float dpp_ror(float x) { return __int_as_float(__builtin_amdgcn_update_dpp(0, __float_as_int(x), 0x120 + N, 0xF, 0xF, false)); }
DEV float row16_allreduce(float x) { x += dpp_ror<8>(x); x += dpp_ror<4>(x); x += dpp_ror<2>(x); x += dpp_ror<1>(x); return x; }
DEV float wave_allreduce(float x) { x = row16_allreduce(x); x += __shfl_xor(x, 16); x += __shfl_xor(x, 32); return x; }
DEV float sigmoidf_(float x) { return 1.0f / (1.0f + __expf(-x)); }
DEV float softplusf_(float z) { return fmaxf(z, 0.f) + __logf(1.0f + __expf(-fabsf(z))); }
DEV unsigned mono_u32(float f) { unsigned u = __float_as_uint(f); return u ^ ((u >> 31) ? 0xFFFFFFFFu : 0x80000000u); }
DEV float unmono_u32(unsigned k) { unsigned u = (k & 0x80000000u) ? (k ^ 0x80000000u) : ~k; return __uint_as_float(u); }
DEV bf16x8 as_bf16x8(uint4 v) { union { uint4 u; bf16x8 b; } x; x.u = v; return x.b; }
#define LAS3 __attribute__((address_space(3)))
extern __shared__ __attribute__((aligned(16))) unsigned char g_lds[];
constexpr int LDS_WTAB = LDS_BYTES - 128;
DEV unsigned hw_wave_slot() { return (unsigned)__builtin_amdgcn_s_getreg((5 << 11) | 4) & 63u; }
DEV int tid_opaque() {
    const int wv = (int)*(const volatile unsigned char*)(g_lds + LDS_WTAB + hw_wave_slot());
    int t = (wv << 6) | (int)__builtin_amdgcn_mbcnt_hi(~0u, __builtin_amdgcn_mbcnt_lo(~0u, 0u));
    asm volatile("" : "+v"(t));
    return t;
}
DEV int mod_batch(int R) { return R < NL ? (R >> 13) : 8; }

template <int BN, class AL, class EP>
DEV void gemm_unit(unsigned char* lds, const AL& al, const bf16_t* Bt, int K, int m0, const EP& ep) {
    constexpr int NI = BN / 64;
    constexpr int A_BYTES = 128 * 128;
    constexpr int B_BYTES = BN * 128;
    const int tid = tid_opaque(), lane = tid & 63, wv = tid >> 6, wm = wv >> 2, wn = wv & 3;
    const int fr = lane & 15, fq = lane >> 4;
    unsigned char* sA = lds;
    unsigned char* sB = lds + 2 * A_BYTES;
    f32x4 acc[4][NI];
#pragma unroll
    for (int mi = 0; mi < 4; ++mi)
#pragma unroll
        for (int ni = 0; ni < NI; ++ni) acc[mi][ni] = (f32x4){0.f, 0.f, 0.f, 0.f};
    const int KT = K >> 6;
    const int drow = tid >> 3, dch = (tid & 7) ^ (drow & 7);
    const bf16_t* bsrc = Bt + (size_t)drow * K + dch * 8;
    uint4 ra[2];
    auto stage = [&](int kt, int buf) {
        const int k0 = kt * 64;
#pragma unroll
        for (int i = 0; i < BN / 64; ++i)
            __builtin_amdgcn_global_load_lds((const unsigned*)(bsrc + (size_t)(64 * i) * K + k0), (unsigned*)(sB + buf * B_BYTES + i * 8192 + tid * 16), 16, 0, 0);
        if constexpr (AL::DMA) {
#pragma unroll
            for (int i = 0; i < 2; ++i)
                __builtin_amdgcn_global_load_lds((const unsigned*)(al.A + (size_t)(m0 + drow + 64 * i) * al.lda + k0 + dch * 8), (unsigned*)(sA + buf * A_BYTES + i * 8192 + tid * 16), 16, 0, 0);
        } else {
#pragma unroll
            for (int i = 0; i < 2; ++i) { const int q = tid + 512 * i; ra[i] = al.load(m0 + (q >> 3), k0 + (q & 7) * 8); }
        }
    };
    auto commit = [&](int buf) {
        if constexpr (!AL::DMA) {
#pragma unroll
            for (int i = 0; i < 2; ++i) { const int q = tid + 512 * i, row = q >> 3, ch = q & 7; *(uint4*)(sA + buf * A_BYTES + row * 128 + ((ch ^ (row & 7)) << 4)) = ra[i]; }
        }
    };
    auto compute = [&](int buf) {
        const unsigned char* a_base = sA + buf * A_BYTES;
        const unsigned char* b_base = sB + buf * B_BYTES;
#pragma unroll
        for (int ks = 0; ks < 2; ++ks) {
            bf16x8 af[4], bfr[NI];
            const int ch = ks * 4 + fq;
#pragma unroll
            for (int mi = 0; mi < 4; ++mi) { const int row = wm * 64 + mi * 16 + fr; af[mi] = *(const bf16x8*)(a_base + row * 128 + ((ch ^ (row & 7)) << 4)); }
#pragma unroll
            for (int ni = 0; ni < NI; ++ni) { const int row = wn * (BN / 4) + ni * 16 + fr; bfr[ni] = *(const bf16x8*)(b_base + row * 128 + ((ch ^ (row & 7)) << 4)); }
#pragma unroll
            for (int mi = 0; mi < 4; ++mi)
#pragma unroll
                for (int ni = 0; ni < NI; ++ni) acc[mi][ni] = __builtin_amdgcn_mfma_f32_16x16x32_bf16(bfr[ni], af[mi], acc[mi][ni], 0, 0, 0);
        }
    };
    if constexpr (AL::DMA) {
        constexpr int STG = A_BYTES + B_BYTES;
        auto stage3 = [&](int kt, int b3) {
            const int k0 = kt * 64;
            unsigned char* base = lds + b3 * STG;
#pragma unroll
            for (int i = 0; i < BN / 64; ++i)
                __builtin_amdgcn_global_load_lds((const unsigned*)(bsrc + (size_t)(64 * i) * K + k0), (unsigned*)(base + A_BYTES + i * 8192 + tid * 16), 16, 0, 0);
#pragma unroll
            for (int i = 0; i < 2; ++i)
                __builtin_amdgcn_global_load_lds((const unsigned*)(al.A + (size_t)(m0 + drow + 64 * i) * al.lda + k0 + dch * 8), (unsigned*)(base + i * 8192 + tid * 16), 16, 0, 0);
        };
        auto compute3 = [&](int b3) {
            const unsigned char* a_base = lds + b3 * STG;
            const unsigned char* b_base = a_base + A_BYTES;
#pragma unroll
            for (int ks = 0; ks < 2; ++ks) {
                bf16x8 af[4], bfr[NI];
                const int ch = ks * 4 + fq;
#pragma unroll
                for (int mi = 0; mi < 4; ++mi) { const int row = wm * 64 + mi * 16 + fr; af[mi] = *(const bf16x8*)(a_base + row * 128 + ((ch ^ (row & 7)) << 4)); }
#pragma unroll
                for (int ni = 0; ni < NI; ++ni) { const int row = wn * (BN / 4) + ni * 16 + fr; bfr[ni] = *(const bf16x8*)(b_base + row * 128 + ((ch ^ (row & 7)) << 4)); }
#pragma unroll
                for (int mi = 0; mi < 4; ++mi)
#pragma unroll
                    for (int ni = 0; ni < NI; ++ni) acc[mi][ni] = __builtin_amdgcn_mfma_f32_16x16x32_bf16(bfr[ni], af[mi], acc[mi][ni], 0, 0, 0);
            }
        };
        stage3(0, 0);
        stage3(1, 1);
        int b3 = 0;
        for (int kt = 0; kt < KT; ++kt) {
            if (kt + 1 < KT) { if constexpr (BN == 256) asm volatile("s_waitcnt vmcnt(6)" ::: "memory"); else asm volatile("s_waitcnt vmcnt(4)" ::: "memory"); }
            else asm volatile("s_waitcnt vmcnt(0)" ::: "memory");
            asm volatile("s_waitcnt lgkmcnt(0)" ::: "memory");
            __builtin_amdgcn_s_barrier();
            asm volatile("" ::: "memory");
            const int bn = (b3 == 0) ? 2 : b3 - 1;
            if (kt + 2 < KT) stage3(kt + 2, bn);
            compute3(b3);
            b3 = (b3 == 2) ? 0 : b3 + 1;
        }
        asm volatile("s_waitcnt lgkmcnt(0)" ::: "memory");
        __builtin_amdgcn_s_barrier();
        asm volatile("" ::: "memory");
    } else {
        stage(0, 0);
        commit(0);
        asm volatile("s_waitcnt vmcnt(0)" ::: "memory");
        __syncthreads();
        for (int kt = 0; kt < KT; ++kt) {
            const int cur = kt & 1;
            const bool more = (kt + 1 < KT);
            if (more) stage(kt + 1, cur ^ 1);
            compute(cur);
            if (more) commit(cur ^ 1);
            asm volatile("s_waitcnt vmcnt(0)" ::: "memory");
            __syncthreads();
        }
    }
    ep(acc, m0, wm, wn, fr, fq);
}

struct ALoadPlain {
    static constexpr bool DMA = true;
    const bf16_t* A; int lda;
    DEV uint4 load(int R, int k) const { return *(const uint4*)(A + (size_t)R * lda + k); }
};
struct ALoadMix {
    static constexpr bool DMA = false;
    const bf16_t* h; const float* mix; const bf16_t* A; int lda;
    DEV uint4 load(int R, int k) const {
        const bf16_t* pc = h + (size_t)R * 1024 + k;
        const uint4 c = *(const uint4*)pc;
        const int t = (R < NL) ? (R & 8191) : ((R - NL) & 255);
        const int last = (R < NL) ? 8191 : 255;
        uint4 pv = *(const uint4*)(pc - (t != 0 ? 1024 : 0)), nv = *(const uint4*)(pc + (t != last ? 1024 : 0));
        if (t == 0) pv = make_uint4(0, 0, 0, 0);
        if (t == last) nv = make_uint4(0, 0, 0, 0);
        const float4 m0 = *(const float4*)(mix + k), m1 = *(const float4*)(mix + k + 4);
        const unsigned cc[4] = {c.x, c.y, c.z, c.w}, pp[4] = {pv.x, pv.y, pv.z, pv.w}, nn[4] = {nv.x, nv.y, nv.z, nv.w};
        const float mm[8] = {m0.x, m0.y, m0.z, m0.w, m1.x, m1.y, m1.z, m1.w};
        unsigned o[4];
#pragma unroll
        for (int i = 0; i < 4; ++i) {
            const float hc0 = bf_lo(cc[i]), hc1 = bf_hi(cc[i]);
            const float s0 = 0.5f * (bf_lo(pp[i]) + bf_lo(nn[i])), s1 = 0.5f * (bf_hi(pp[i]) + bf_hi(nn[i]));
            o[i] = pk_bf16(hc0 + (s0 - hc0) * mm[2 * i], hc1 + (s1 - hc1) * mm[2 * i + 1]);
        }
        return make_uint4(o[0], o[1], o[2], o[3]);
    }
};

struct TrJob { int in_idx, src_off, K, N, src_ld, dst_ld; unsigned long long dst_off; int tile0; };
constexpr int NTRJOBS = 19;
__device__ const TrJob g_trjobs[NTRJOBS] = {
    {9, 0 * 1048576, 1024, 1024, 1024, 1024, WS_WPROJ + 0ull * 1024 * 1024 * 2, 0},
    {9, 1 * 1048576, 1024, 1024, 1024, 1024, WS_WPROJ + 1ull * 1024 * 1024 * 2, 256},
    {9, 2 * 1048576, 1024, 1024, 1024, 1024, WS_WPROJ + 2ull * 1024 * 1024 * 2, 512},
    {11, 0, 1024, 64, 64, 1024, WS_WPROJ + 3072ull * 1024 * 2, 768},
    {11, 65536, 1024, 64, 64, 1024, WS_WPROJ + 3136ull * 1024 * 2, 784},
    {14, 0, 1024, 64, 64, 1024, WS_WPROJ + 3200ull * 1024 * 2, 800},
    {14, 65536, 1024, 64, 64, 1024, WS_WPROJ + 3264ull * 1024 * 2, 816},
    {16, 0, 1024, 128, 128, 1024, WS_WPROJ + 3328ull * 1024 * 2, 832},
    {12, 0, 64, 1024, 1024, 64, WS_W2T, 864},
    {12, 65536, 64, 1024, 1024, 64, WS_W2T + 1024ull * 64 * 2, 880},
    {15, 0, 64, 1024, 1024, 64, WS_A2T, 896},
    {15, 65536, 64, 1024, 1024, 64, WS_A2T + 1024ull * 64 * 2, 912},
    {17, 0, 128, 1024, 1024, 128, WS_G2T, 928},
    {23, 0, 1024, 1024, 1024, 1024, WS_WO0, 960},
    {29, 0, 1024, 1024, 1024, 1024, WS_WO1, 1216},
    {30, 0, 1024, 2048, 2048, 1024, WS_WQ, 1472},
    {30, 2097152, 1024, 2048, 2048, 1024, WS_WQ + 2048ull * 1024 * 2, 1984},
    {24, 0, 1024, 3104, 3104, 1024, WS_WIN, 2496},
    {0, 0, 0, 0, 0, 0, 0, 2496 + 16 * 49},
};
constexpr int NTRTILES = 2496 + 16 * 49;

DEV void phase0(const Params& p, unsigned char* lds) {
    const int tid = tid_opaque();
    unsigned char* ws = p.ws;
    {
        float* sc = (float*)lds;
        float* red = sc + 9 * 1024;
        float* mods = (float*)(ws + WS_MOD);
        bool have_sc = false;
        for (int task = blockIdx.x; task < 192; task += gridDim.x) {
            if (!have_sc) {
                for (int i = tid; i < 9 * 1024; i += NTHREADS) {
                    const int mb = i >> 10, k = i & 1023;
                    const float cv = mb < 8 ? p.in[1][mb * 1024 + k] : p.in[3][k];
                    sc[i] = cv / (1.0f + __expf(-cv));
                }
                have_sc = true;
            }
            __syncthreads();
            const int l = task / 96, nb = task % 96;
            const int nn = tid & 63, kg = tid >> 6;
            const float* w = p.in[4] + (size_t)l * 1024 * 6144 + nb * 64 + nn;
            float acc[9];
#pragma unroll
            for (int m = 0; m < 9; ++m) acc[m] = 0.f;
            for (int k = kg * 128; k < kg * 128 + 128; ++k) {
                const float wv = w[(size_t)k * 6144];
#pragma unroll
                for (int m = 0; m < 9; ++m) acc[m] += sc[m * 1024 + k] * wv;
            }
#pragma unroll
            for (int m = 0; m < 9; ++m) red[(kg * 9 + m) * 64 + nn] = acc[m];
            __syncthreads();
            for (int i = tid; i < 576; i += NTHREADS) {
                const int m = i >> 6, n2 = i & 63;
                float s = p.in[5][l * 6144 + nb * 64 + n2];
#pragma unroll
                for (int g = 0; g < 8; ++g) s += red[(g * 9 + m) * 64 + n2];
                mods[(size_t)(l * 9 + m) * 6144 + nb * 64 + n2] = s;
            }
            __syncthreads();
        }
        __syncthreads();
    }
    {
        float* tile = (float*)lds;
        for (int tt = blockIdx.x; tt < NTRTILES; tt += gridDim.x) {
            int j = 0;
#pragma unroll 1
            while (j + 1 < NTRJOBS && g_trjobs[j + 1].tile0 <= tt) ++j;
            const TrJob jb = g_trjobs[j];
            const int tl = tt - jb.tile0;
            const int ntn = (jb.N + 63) >> 6;
            const int k0 = (tl / ntn) * 64, n0 = (tl % ntn) * 64;
            const float* src = p.in[jb.in_idx] + jb.src_off;
            bf16_t* dst = (bf16_t*)(ws + jb.dst_off);
            {
                const int kr = tid >> 4, nc4 = (tid & 15) * 4;
#pragma unroll
                for (int i = 0; i < 2; ++i) {
                    const int kk = kr + 32 * i;
                    float4 v = make_float4(0.f, 0.f, 0.f, 0.f);
                    if (n0 + nc4 < jb.N) v = *(const float4*)(src + (size_t)(k0 + kk) * jb.src_ld + n0 + nc4);
                    tile[kk * 65 + nc4 + 0] = v.x; tile[kk * 65 + nc4 + 1] = v.y; tile[kk * 65 + nc4 + 2] = v.z; tile[kk * 65 + nc4 + 3] = v.w;
                }
            }
            __syncthreads();
            {
                const int nn = tid >> 3, kc = (tid & 7) * 8;
                if (n0 + nn < jb.N) {
                    unsigned o[4];
#pragma unroll
                    for (int i = 0; i < 4; ++i) o[i] = pk_bf16(tile[(kc + 2 * i) * 65 + nn], tile[(kc + 2 * i + 1) * 65 + nn]);
                    *(uint4*)(dst + (size_t)(n0 + nn) * jb.dst_ld + k0 + kc) = make_uint4(o[0], o[1], o[2], o[3]);
                }
            }
            __syncthreads();
        }
    }
    {
        const size_t gtid = (size_t)blockIdx.x * NTHREADS + tid, gstride = (size_t)gridDim.x * NTHREADS;
        {
            const float* src = p.in[31];
            bf16_t* dst = (bf16_t*)(ws + WS_KEYS);
            const size_t n8 = (size_t)2 * 8 * 2 * 128 * 128 / 8;
            for (size_t i = gtid; i < n8; i += gstride) {
                const float4 a = *(const float4*)(src + i * 8), b = *(const float4*)(src + i * 8 + 4);
                *(uint4*)(dst + i * 8) = make_uint4(pk_bf16(a.x, a.y), pk_bf16(a.z, a.w), pk_bf16(b.x, b.y), pk_bf16(b.z, b.w));
            }
        }
        bf16_t* wpad = (bf16_t*)(ws + WS_WIN) + (size_t)3104 * 1024;
        for (size_t i = gtid; i < (size_t)96 * 1024 / 8; i += gstride) *(uint4*)(wpad + i * 8) = make_uint4(0, 0, 0, 0);
        const int lane = tid & 63;
        const int gw = blockIdx.x * 8 + (tid >> 6), nw = gridDim.x * 8;
        float* scales = (float*)(ws + WS_PSC);
        for (int rowi = gw * 32; rowi < 2 * 32768; rowi += nw * 32)
        for (int row2 = rowi; row2 < rowi + 32; row2 += 4) {
            float4 v[4][4]; float am[4];
#pragma unroll
            for (int q = 0; q < 4; ++q) {
                const int row = row2 + q, tbl = row >> 15, r = row & 32767;
                const float* srow = p.in[32 + tbl] + (size_t)r * 1024;
                am[q] = 0.f;
#pragma unroll
                for (int i = 0; i < 4; ++i) { v[q][i] = *(const float4*)(srow + 16 * lane + 4 * i); am[q] = fmaxf(am[q], fmaxf(fmaxf(fabsf(v[q][i].x), fabsf(v[q][i].y)), fmaxf(fabsf(v[q][i].z), fabsf(v[q][i].w)))); }
            }
#pragma unroll
            for (int o = 1; o < 64; o <<= 1) { const float a0 = __shfl_xor(am[0], o), a1 = __shfl_xor(am[1], o), a2 = __shfl_xor(am[2], o), a3 = __shfl_xor(am[3], o); am[0] = fmaxf(am[0], a0); am[1] = fmaxf(am[1], a1); am[2] = fmaxf(am[2], a2); am[3] = fmaxf(am[3], a3); }
#pragma unroll
            for (int q = 0; q < 4; ++q) {
                const int row = row2 + q, tbl = row >> 15, r = row & 32767;
                const float scale = am[q] > 0.f ? am[q] * (1.0f / 448.0f) : 1.0f;
                const float inv = 1.0f / scale;
                unsigned w[4];
#pragma unroll
                for (int i = 0; i < 4; ++i) {
                    int t = 0;
                    t = __builtin_amdgcn_cvt_pk_fp8_f32(v[q][i].x * inv, v[q][i].y * inv, t, false);
                    t = __builtin_amdgcn_cvt_pk_fp8_f32(v[q][i].z * inv, v[q][i].w * inv, t, true);
                    w[i] = (unsigned)t;
                }
                *(uint4*)(ws + (tbl ? WS_PV : WS_PU) + ((size_t)(r >> 14) * 8 + (lane >> 3)) * (16384 * 128) + (size_t)(r & 16383) * 128 + 16 * (lane & 7)) = make_uint4(w[0], w[1], w[2], w[3]);
                if (lane == 0) scales[tbl * 32768 + r] = scale;
            }
        }
    }
}

DEV void normmod_store(const float4 (&v)[4], float ss, const float* g, const float* shift, const float* scale, bf16_t* dst, unsigned char* xq, int lane) {
    const float rs = rsqrtf(ss * (1.0f / 1024.0f) + 1e-6f);
#pragma unroll
    for (int i = 0; i < 4; ++i) {
        const int col = i * 256 + lane * 4;
        const float4 gg = *(const float4*)(g + col), sh = *(const float4*)(shift + col), sc = *(const float4*)(scale + col);
        const float y0 = v[i].x * rs * gg.x * (1.f + sc.x) + sh.x, y1 = v[i].y * rs * gg.y * (1.f + sc.y) + sh.y;
        const float y2 = v[i].z * rs * gg.z * (1.f + sc.z) + sh.z, y3 = v[i].w * rs * gg.w * (1.f + sc.w) + sh.w;
        *(uint2*)(dst + col) = make_uint2(pk_bf16(y0, y1), pk_bf16(y2, y3));
        if (xq) {
            const float z0 = __builtin_amdgcn_fmed3f(4.f * y0, -448.f, 448.f), z1 = __builtin_amdgcn_fmed3f(4.f * y1, -448.f, 448.f);
            const float z2 = __builtin_amdgcn_fmed3f(4.f * y2, -448.f, 448.f), z3 = __builtin_amdgcn_fmed3f(4.f * y3, -448.f, 448.f);
            int hi = __builtin_amdgcn_cvt_pk_fp8_f32(z0, z1, 0, false); hi = __builtin_amdgcn_cvt_pk_fp8_f32(z2, z3, hi, true);
            const f32x2v h01 = __builtin_amdgcn_cvt_pk_f32_fp8(hi, false), h23 = __builtin_amdgcn_cvt_pk_f32_fp8(hi, true);
            int lo = __builtin_amdgcn_cvt_pk_fp8_f32(z0 - h01.x, z1 - h01.y, 0, false); lo = __builtin_amdgcn_cvt_pk_fp8_f32(z2 - h23.x, z3 - h23.y, lo, true);
            *(int*)(xq + col) = hi; *(int*)(xq + 1024 + col) = lo;
        }
    }
}
DEV void phase_normmod(const Params& p, int layer, int which, const float* xl, const float* xc, int nrows, bf16_t* dst, unsigned char* xq) {
    const int tid = tid_opaque(), lane = tid & 63;
    const int gw = blockIdx.x * 8 + (tid >> 6), nw = gridDim.x * 8;
    const float* mods = (const float*)(p.ws + WS_MOD) + (size_t)layer * 9 * 6144;
    const float* g = p.in[which ? 7 : 6] + layer * 1024;
    for (int R = gw; R < nrows; R += nw) {
        const float* xr = R < NL ? xl + (size_t)R * 1024 : xc + (size_t)(R - NL) * 1024;
        float4 v[4]; float ss = 0.f;
#pragma unroll
        for (int i = 0; i < 4; ++i) { v[i] = *(const float4*)(xr + i * 256 + lane * 4); ss += v[i].x * v[i].x + v[i].y * v[i].y + v[i].z * v[i].z + v[i].w * v[i].w; }
        ss = wave_allreduce(ss);
        const float* mrow = mods + (size_t)mod_batch(R) * 6144 + (which ? 3 : 0) * 1024;
        normmod_store(v, ss, g, mrow, mrow + 1024, dst + (size_t)R * 1024, xq ? xq + (size_t)R * 2048 : nullptr, lane);
    }
}
DEV void phase_normmix(const Params& p, bf16_t* hdst, bf16_t* xr, bf16_t* xk, bf16_t* xv) {
    const int tid = tid_opaque(), lane = tid & 63;
    const int gw = __builtin_amdgcn_readfirstlane(blockIdx.x * 8 + (tid >> 6)), nw = gridDim.x * 8;
    const float* mods = (const float*)(p.ws + WS_MOD);
    const float* g = p.in[6];
    for (int run = gw; run < NT / 8; run += nw) {
        const int R0 = run * 8;
        const int t0 = R0 < NL ? (R0 & 8191) : ((R0 - NL) & 255), slen = R0 < NL ? 8192 : 256;
        const float* mrow = mods + (size_t)mod_batch(R0) * 6144;
        float4 gg[4], sh[4], sc[4], m0[4], m2[4], m3[4];
#pragma unroll
        for (int i = 0; i < 4; ++i) {
            const int col = i * 256 + lane * 4;
            gg[i] = *(const float4*)(g + col); sh[i] = *(const float4*)(mrow + col); sc[i] = *(const float4*)(mrow + 1024 + col);
            m0[i] = *(const float4*)(p.in[8] + col); m2[i] = *(const float4*)(p.in[8] + 2 * 1024 + col); m3[i] = *(const float4*)(p.in[8] + 3 * 1024 + col);
        }
        auto hrow = [&](int R, float4 (&h)[4]) {
            const float* xrw = R < NL ? p.in[0] + (size_t)R * 1024 : p.in[2] + (size_t)(R - NL) * 1024;
            float ss = 0.f;
#pragma unroll
            for (int i = 0; i < 4; ++i) { h[i] = *(const float4*)(xrw + i * 256 + lane * 4); ss += h[i].x * h[i].x + h[i].y * h[i].y + h[i].z * h[i].z + h[i].w * h[i].w; }
            ss = wave_allreduce(ss);
            const float rs = rsqrtf(ss * (1.0f / 1024.0f) + 1e-6f);
#pragma unroll
            for (int i = 0; i < 4; ++i) {
                h[i].x = h[i].x * rs * gg[i].x * (1.f + sc[i].x) + sh[i].x; h[i].y = h[i].y * rs * gg[i].y * (1.f + sc[i].y) + sh[i].y;
                h[i].z = h[i].z * rs * gg[i].z * (1.f + sc[i].z) + sh[i].z; h[i].w = h[i].w * rs * gg[i].w * (1.f + sc[i].w) + sh[i].w;
            }
        };
        float4 hp[4], hc[4], hn[4];
        if (t0 > 0) hrow(R0 - 1, hp); else { hp[0] = hp[1] = hp[2] = hp[3] = make_float4(0.f, 0.f, 0.f, 0.f); }
        hrow(R0, hc);
#pragma unroll 1
        for (int i8 = 0; i8 < 8; ++i8) {
            const int R = R0 + i8;
            if (t0 + i8 + 1 < slen) hrow(R + 1, hn); else { hn[0] = hn[1] = hn[2] = hn[3] = make_float4(0.f, 0.f, 0.f, 0.f); }
#pragma unroll
            for (int i = 0; i < 4; ++i) {
                const size_t o = (size_t)R * 1024 + i * 256 + lane * 4;
                const float4 c = hc[i];
                const float4 xx = make_float4(0.5f * (hp[i].x + hn[i].x) - c.x, 0.5f * (hp[i].y + hn[i].y) - c.y, 0.5f * (hp[i].z + hn[i].z) - c.z, 0.5f * (hp[i].w + hn[i].w) - c.w);
                *(uint2*)(hdst + o) = make_uint2(pk_bf16(c.x, c.y), pk_bf16(c.z, c.w));
                *(uint2*)(xr + o) = make_uint2(pk_bf16(c.x + xx.x * m0[i].x, c.y + xx.y * m0[i].y), pk_bf16(c.z + xx.z * m0[i].z, c.w + xx.w * m0[i].w));
                *(uint2*)(xk + o) = make_uint2(pk_bf16(c.x + xx.x * m2[i].x, c.y + xx.y * m2[i].y), pk_bf16(c.z + xx.z * m2[i].z, c.w + xx.w * m2[i].w));
                *(uint2*)(xv + o) = make_uint2(pk_bf16(c.x + xx.x * m3[i].x, c.y + xx.y * m3[i].y), pk_bf16(c.z + xx.z * m3[i].z, c.w + xx.w * m3[i].w));
            }
#pragma unroll
            for (int i = 0; i < 4; ++i) { hp[i] = hc[i]; hc[i] = hn[i]; }
        }
    }
}

template <int BN> struct EpiBf16 {
    bf16_t* dst; int ldd; int col0; int act;
    DEV void operator()(const f32x4 (&acc)[4][BN / 64], int m0, int wm, int wn, int fr, int fq) const {
#pragma unroll
        for (int mi = 0; mi < 4; ++mi) {
            const size_t R = (size_t)(m0 + wm * 64 + mi * 16 + fr);
#pragma unroll
            for (int ni = 0; ni < BN / 64; ++ni) {
                const int col = col0 + wn * (BN / 4) + ni * 16 + 4 * fq;
                float v[4] = {acc[mi][ni][0], acc[mi][ni][1], acc[mi][ni][2], acc[mi][ni][3]};
                if (act == 1) {
#pragma unroll
                    for (int j = 0; j < 4; ++j) v[j] = tanhf(v[j]);
                } else if (act == 2) {
#pragma unroll
                    for (int j = 0; j < 4; ++j) v[j] = sigmoidf_(v[j]);
                }
                *(uint2*)(dst + R * ldd + col) = make_uint2(pk_bf16(v[0], v[1]), pk_bf16(v[2], v[3]));
            }
        }
    }
};
struct EpiResid {
    const float* xold_lat; const float* xold_ctx; float* dst_lat; float* dst_ctx; const float* gate; int col0;
    DEV void operator()(const f32x4 (&acc)[4][4], int m0, int wm, int wn, int fr, int fq) const {
#pragma unroll
        for (int mi = 0; mi < 4; ++mi) {
            const int R = m0 + wm * 64 + mi * 16 + fr;
            const float* src = R < NL ? xold_lat + (size_t)R * 1024 : xold_ctx + (size_t)(R - NL) * 1024;
            float* dst = R < NL ? dst_lat + (size_t)R * 1024 : dst_ctx + (size_t)(R - NL) * 1024;
            const float* gr = gate + (size_t)mod_batch(R) * 6144;
#pragma unroll
            for (int ni = 0; ni < 4; ++ni) {
                const int col = col0 + wn * 64 + ni * 16 + 4 * fq;
                const float4 xo = *(const float4*)(src + col), g4 = *(const float4*)(gr + col);
                *(float4*)(dst + col) = make_float4(xo.x + g4.x * acc[mi][ni][0], xo.y + g4.y * acc[mi][ni][1], xo.z + g4.z * acc[mi][ni][2], xo.w + g4.w * acc[mi][ni][3]);
            }
        }
    }
};
struct EpiLr {
    float* dst;
    DEV void operator()(const f32x4 (&acc)[4][2], int m0, int wm, int wn, int fr, int fq) const {
        if (wn != 0) return;
#pragma unroll
        for (int mi = 0; mi < 4; ++mi) {
            const size_t R = (size_t)(m0 + wm * 64 + mi * 16 + fr);
#pragma unroll
            for (int ni = 0; ni < 2; ++ni) { const int col = ni * 16 + 4 * fq; *(float4*)(dst + R * 32 + col) = make_float4(acc[mi][ni][0], acc[mi][ni][1], acc[mi][ni][2], acc[mi][ni][3]); }
        }
    }
};

namespace pg8 {
#define PG8_LAS __attribute__((address_space(3)))
constexpr int BM = 256, BK = 64, HALF = 128, HTB = HALF * BK * 2  , STAGE_BYTES = 8 * HTB, NXCD = 8, WGM = 8;

__host__ __device__ __forceinline__ int lds_byte(int r, int c) { const int st = (r >> 4) * 2 + (c >> 5), rr = r & 15, cc = c & 31, ob = rr * 64 + cc * 2; return st * 1024 + (ob ^ (((ob >> 9) & 1) << 5)); }
__host__ __device__ __forceinline__ void stage_rc(int b, int& R, int& C) { const int st = b / 1024, sb = b % 1024, swz = sb ^ (((sb >> 9) & 1) << 5); R = (st >> 1) * 16 + swz / 64; C = (st & 1) * 32 + (swz % 64) / 2; }
__host__ __device__ __forceinline__ int perm32(int rho) { const int n = rho >> 4, i = rho & 15; return 8 * (i >> 2) + 4 * n + (i & 3); }
struct Unit { int pm, pn; };
struct Gemm { const bf16_t* A; const bf16_t* Bt; int M, N, K; };
struct StaticOrder {
    int nM, nN, nwg, G, c;
    __host__ __device__ void init(int M, int N, int G_, int c_) { nM = M / BM; nN = N / BM; nwg = nM * nN; G = G_; c = c_; }
    __host__ __device__ bool next(int i, Unit& u) const {
        const long L = (long)i * G + c; if (L >= nwg) return false;
        int wgid = (int)L; { const int q = nwg / NXCD, r = nwg % NXCD, xcd = wgid % NXCD, off = wgid / NXCD; wgid = (xcd < r ? xcd * (q + 1) : r * (q + 1) + (xcd - r) * q) + off; }
        const int nig = WGM * nN, gid = wgid / nig, fm = gid * WGM, gsz = (nM - fm) < WGM ? (nM - fm) : WGM;
        u.pm = fm + ((wgid % nig) % gsz); u.pn = (wgid % nig) / gsz; return true;
    }
    __device__ __forceinline__ void a_ready(const Unit&) const {}
    __device__ __forceinline__ void done(const Unit&) const {}
};
template <class Epi, class Sched, bool STAMP = false>
__device__ __forceinline__ void gemm_phase(PG8_LAS unsigned char* lds, const Gemm g, const Sched& S, const Epi& E, unsigned long long* stamps) {
    const int tid = tid_opaque(), wid = __builtin_amdgcn_readfirstlane(tid >> 6), lane = tid & 63, wr = wid >> 2, wc = wid & 3, fr = lane & 15, fq = lane >> 4;
    const int K = g.K, nt = K / BK;
    int ts_lo = 0, ts_hi = 0, nts = 0; const unsigned long long rt_entry = STAMP ? (unsigned long long)wall_clock64() : 0ull;
#define PG8_STAMP() do { if (STAMP && wid == 0 && nts < 64) { const unsigned long long _c = (unsigned long long)clock64(); \
        ts_lo = (lane == nts) ? (int)(unsigned)_c : ts_lo; ts_hi = (lane == nts) ? (int)(unsigned)(_c >> 32) : ts_hi; ++nts; } } while (0)
    PG8_STAMP();
    unsigned voffA[2], voffB[2];
#pragma unroll
    for (int i = 0; i < 2; ++i) { int R, C; stage_rc(tid * 16 + i * 8192, R, C); const int Rb = Epi::PERM ? ((R & ~31) + perm32(R & 31)) : R;
        voffA[i] = (unsigned)(R * K + C) * 2u; voffB[i] = (unsigned)(Rb * K + C) * 2u; }
    const size_t kstep = (size_t)(BK * 2);
    const size_t hstep = (size_t)HALF * K * 2;
    const size_t tstep = 2 * hstep;
    const unsigned ldsw = (unsigned)wid * 1024u;
    const int aoff = lds_byte(wr * 64 + fr, fq * 8), boff = lds_byte(wc * 32 + fr, fq * 8);
#define PG8_SA(b, h) (((b) * 2 + (h)) * HTB)
#define PG8_SB(b, h) ((4 + (b) * 2 + (h)) * HTB)
#define PG8_STAGE(bufoff, gbase, voff) do { _Pragma("unroll") for (int _i = 0; _i < 2; ++_i) \
        __builtin_amdgcn_global_load_lds((const unsigned*)((const char*)(gbase) + (voff)[_i]), (PG8_LAS unsigned*)(lds + (bufoff) + ldsw + _i * 8192), 16, 0, 0); } while (0)
#define PG8_LDA(dst, b, h) do { _Pragma("unroll") for (int m = 0; m < 4; ++m) _Pragma("unroll") for (int k = 0; k < 2; ++k) dst[m][k] = *(const PG8_LAS bf16x8*)(lds + PG8_SA(b, h) + aoff + m * 2048 + k * 1024); } while (0)
#define PG8_LDB(dst, b, h) do { _Pragma("unroll") for (int n = 0; n < 2; ++n) _Pragma("unroll") for (int k = 0; k < 2; ++k) dst[n][k] = *(const PG8_LAS bf16x8*)(lds + PG8_SB(b, h) + boff + n * 2048 + k * 1024); } while (0)
#define PG8_MMA(ai, bj, At, Bt) do { __builtin_amdgcn_s_setprio(1); _Pragma("unroll") for (int m = 0; m < 4; ++m) _Pragma("unroll") for (int n = 0; n < 2; ++n) _Pragma("unroll") for (int k = 0; k < 2; ++k) \
        acc[ai][bj][m][n] = __builtin_amdgcn_mfma_f32_16x16x32_bf16(Bt[n][k], At[m][k], acc[ai][bj][m][n], 0, 0, 0); __builtin_amdgcn_s_setprio(0); } while (0)
#define PG8_WAIT_V(n) asm volatile("s_waitcnt vmcnt(" #n ")" ::: "memory")
#define PG8_WAIT_L(n) asm volatile("s_waitcnt lgkmcnt(" #n ")" ::: "memory")
#define PG8_BAR __builtin_amdgcn_s_barrier()
#define PG8_SCHED __builtin_amdgcn_sched_barrier(0)
    Unit cur, nxt; int ui = 0;
    if (!S.next(0, cur)) return;
    f32x4 acc[2][2][4][2];
#pragma unroll
    for (int a = 0; a < 2; ++a)
#pragma unroll
        for (int b = 0; b < 2; ++b)
#pragma unroll
            for (int m = 0; m < 4; ++m)
#pragma unroll
                for (int n = 0; n < 2; ++n) acc[a][b][m][n] = (f32x4){0.f, 0.f, 0.f, 0.f};
    bf16x8 At[4][2], B0[2][2], B1[2][2];
    const char* cA = (const char*)g.A + (size_t)cur.pm * tstep; const char* cB = (const char*)g.Bt + (size_t)cur.pn * tstep;
    S.a_ready(cur);
    PG8_STAGE(PG8_SB(0, 0), cB, voffB); PG8_STAGE(PG8_SA(0, 0), cA, voffA); PG8_STAGE(PG8_SB(0, 1), cB + hstep, voffB); PG8_STAGE(PG8_SA(0, 1), cA + hstep, voffA);
    if (wr == 1) PG8_BAR;
    PG8_WAIT_V(4); PG8_BAR;
    PG8_STAGE(PG8_SB(1, 0), cB + kstep, voffB); PG8_STAGE(PG8_SA(1, 0), cA + kstep, voffA); PG8_STAGE(PG8_SB(1, 1), cB + hstep + kstep, voffB);
    PG8_WAIT_V(6); PG8_BAR;
    PG8_STAMP();
    for (;;) {
        const bool has_next = S.next(ui + 1, nxt);
        const char* nA = has_next ? (const char*)g.A + (size_t)nxt.pm * tstep : cA; const char* nB = has_next ? (const char*)g.Bt + (size_t)nxt.pn * tstep : cB;
        for (int t = 0; t < nt; t += 2) {
            const bool last = (t == nt - 2);
            const char* a1 = cA + (size_t)(t + 1) * kstep;
            const char* a2 = last ? nA : cA + (size_t)(t + 2) * kstep; const char* b2 = last ? nB : cB + (size_t)(t + 2) * kstep;
            const char* a3 = a2 + kstep; const char* b3 = b2 + kstep;
            if (last && has_next) S.a_ready(nxt);
            PG8_LDB(B0, 0, 0); PG8_SCHED; PG8_LDA(At, 0, 0); PG8_STAGE(PG8_SA(1, 1), a1 + hstep, voffA);
            PG8_WAIT_L(8); PG8_BAR; PG8_WAIT_L(0); PG8_MMA(0, 0, At, B0); PG8_BAR; PG8_SCHED;
            PG8_LDB(B1, 0, 1); PG8_STAGE(PG8_SB(0, 0), b2, voffB);
            PG8_BAR; PG8_WAIT_L(0); PG8_MMA(0, 1, At, B1); PG8_BAR;
            PG8_LDA(At, 0, 1); PG8_STAGE(PG8_SA(0, 0), a2, voffA);
            PG8_BAR; PG8_WAIT_L(0); PG8_MMA(1, 0, At, B0); PG8_BAR; PG8_SCHED;
            PG8_STAGE(PG8_SB(0, 1), b2 + hstep, voffB);
            PG8_WAIT_V(6); PG8_BAR; PG8_MMA(1, 1, At, B1); PG8_BAR;
            PG8_LDB(B0, 1, 0); PG8_SCHED; PG8_LDA(At, 1, 0); PG8_STAGE(PG8_SA(0, 1), a2 + hstep, voffA);
            PG8_WAIT_L(8); PG8_BAR; PG8_WAIT_L(0); PG8_MMA(0, 0, At, B0); PG8_BAR; PG8_SCHED;
            PG8_LDB(B1, 1, 1); PG8_STAGE(PG8_SB(1, 0), b3, voffB);
            PG8_BAR; PG8_WAIT_L(0); PG8_MMA(0, 1, At, B1); PG8_BAR;
            PG8_LDA(At, 1, 1); PG8_STAGE(PG8_SA(1, 0), a3, voffA);
            PG8_BAR; PG8_WAIT_L(0); PG8_MMA(1, 0, At, B0); PG8_BAR; PG8_SCHED;
            PG8_STAGE(PG8_SB(1, 1), b3 + hstep, voffB);
            PG8_WAIT_V(6); PG8_BAR; PG8_MMA(1, 1, At, B1); PG8_BAR;
        }
        PG8_STAMP();
        if constexpr (!Epi::AFTER_DRAIN) { E(acc, cur, wr, wc, fr, fq); S.done(cur); }
        PG8_STAMP();
        if (!has_next) break;
#pragma unroll
        for (int a = 0; a < 2; ++a)
#pragma unroll
            for (int b = 0; b < 2; ++b)
#pragma unroll
                for (int m = 0; m < 4; ++m)
#pragma unroll
                    for (int n = 0; n < 2; ++n) acc[a][b][m][n] = (f32x4){0.f, 0.f, 0.f, 0.f};
        cur = nxt; cA = nA; cB = nB; ++ui;
    }
    PG8_WAIT_V(0);
    if (wr == 0) PG8_BAR;
    PG8_BAR;
    if constexpr (Epi::AFTER_DRAIN) { E.fused(acc, cur, wr, wc, fr, fq, lds, wid, lane); S.done(cur); }
    PG8_STAMP();
    if (STAMP && wid == 0) { stamps[lane] = lane < nts ? (((unsigned long long)(unsigned)ts_hi << 32) | (unsigned)ts_lo) : 0ull;
        if (lane == 62) stamps[62] = rt_entry; if (lane == 63) stamps[63] = (unsigned long long)wall_clock64(); }
#undef PG8_STAMP
#undef PG8_SA
#undef PG8_SB
#undef PG8_STAGE
#undef PG8_LDA
#undef PG8_LDB
#undef PG8_MMA
#undef PG8_WAIT_V
#undef PG8_WAIT_L
#undef PG8_BAR
#undef PG8_SCHED
}
struct EpiBf16Tiles {
    static constexpr bool PERM = true, AFTER_DRAIN = false;
    bf16_t* d0; int ld0; int ntile0; bf16_t* d1; int ld1;
    __device__ __forceinline__ void operator()(const f32x4 (&acc)[2][2][4][2], const Unit& u, int wr, int wc, int fr, int fq) const {
        bf16_t* base = u.pn < ntile0 ? d0 : d1; const int ld = u.pn < ntile0 ? ld0 : ld1; const int colt = (u.pn < ntile0 ? u.pn : u.pn - ntile0) * BM;
        const int row0 = u.pm * BM + wr * 64 + fr, col0 = colt + wc * 32 + 8 * fq;
#pragma unroll
        for (int ai = 0; ai < 2; ++ai)
#pragma unroll
            for (int m = 0; m < 4; ++m) { bf16_t* rowp = base + (size_t)(row0 + ai * HALF + m * 16) * ld + col0;
#pragma unroll
                for (int bj = 0; bj < 2; ++bj) { const f32x4 v0 = acc[ai][bj][m][0], v1 = acc[ai][bj][m][1];
                    *(uint4*)(rowp + bj * HALF) = make_uint4(pk_bf16(v0[0], v0[1]), pk_bf16(v0[2], v0[3]), pk_bf16(v1[0], v1[1]), pk_bf16(v1[2], v1[3])); } }
    }
};
struct EpiResid256 {
    static constexpr bool PERM = false, AFTER_DRAIN = false;
    const float* xold_lat; const float* xold_ctx; float* dst_lat; float* dst_ctx; const float* gate;
    __device__ __forceinline__ void operator()(const f32x4 (&acc)[2][2][4][2], const Unit& u, int wr, int wc, int fr, int fq) const {
        const int row0 = u.pm * BM + wr * 64 + fr, col0 = u.pn * BM + wc * 32 + 4 * fq;
#pragma unroll
        for (int ai = 0; ai < 2; ++ai)
#pragma unroll
            for (int m = 0; m < 4; ++m) {
                const int R = row0 + ai * HALF + m * 16;
                const float* src = R < NL ? xold_lat + (size_t)R * 1024 : xold_ctx + (size_t)(R - NL) * 1024;
                float* dst = R < NL ? dst_lat + (size_t)R * 1024 : dst_ctx + (size_t)(R - NL) * 1024;
                const float* gr = gate + (size_t)mod_batch(R) * 6144;
#pragma unroll
                for (int bj = 0; bj < 2; ++bj)
#pragma unroll
                    for (int n = 0; n < 2; ++n) {
                        const int col = col0 + bj * HALF + n * 16;
                        const float4 xo = *(const float4*)(src + col), g4 = *(const float4*)(gr + col);
                        const f32x4 a = acc[ai][bj][m][n];
                        *(float4*)(dst + col) = make_float4(xo.x + g4.x * a[0], xo.y + g4.y * a[1], xo.z + g4.z * a[2], xo.w + g4.w * a[3]);
                    }
            }
    }
};
}

DEV void phase_rw_proj1(const Params& p, unsigned char* lds, int which, const bf16_t* A, bf16_t* dst) {
    pg8::Gemm g{A, (const bf16_t*)(p.ws + WS_WPROJ) + (size_t)which * 1024 * 1024, NT, 1024, 1024};
    pg8::StaticOrder so; so.init(NT, 1024, gridDim.x, blockIdx.x);
    pg8::EpiBf16Tiles ep{dst, 1024, 4, dst, 1024};
    pg8::gemm_phase((PG8_LAS unsigned char*)lds, g, so, ep, nullptr);
    __syncthreads();
}
DEV void phase_rw_lora(const Params& p, unsigned char* lds) {
    unsigned char* ws = p.ws;
    const bf16_t* h = (const bf16_t*)(ws + WS_S + 0 * U_BYTES);
    const bf16_t* wproj = (const bf16_t*)(ws + WS_WPROJ);
    const int nunits = (NT / 128) * 3;
    for (int u = blockIdx.x; u < nunits; u += gridDim.x) {
        const int mt = u / 3, lg = u % 3, m0 = mt * 128;
        const int mixid = lg == 0 ? 1 : (lg == 1 ? 4 : 5);
        ALoadMix al{h, p.in[8] + mixid * 1024, h, 1024};
        EpiBf16<128> ep{(bf16_t*)(ws + WS_S + 4 * U_BYTES), 384, lg * 128, lg == 0 ? 1 : (lg == 1 ? 0 : 2)};
        gemm_unit<128>(lds, al, wproj + (size_t)(3072 + lg * 128) * 1024, 1024, m0, ep);
    }
}

template <int N> DEV float dpp_shr0(float x) { return __int_as_float(__builtin_amdgcn_update_dpp(0, __float_as_int(x), 0x110 + N, 0xF, 0xF, true)); }
template <int CTRL> DEV float dpp_quad(float x) { return __int_as_float(__builtin_amdgcn_update_dpp(0, __float_as_int(x), CTRL, 0xF, 0xF, false)); }
DEV int tile_off(int row, int ch) { return row * 128 + ((ch ^ (row & 7)) << 4); }
DEV int tile_off2(int row, int ch) { return row * 128 + ((ch ^ ((row ^ (row >> 3)) & 7)) << 4); }
DEV void phase_rw_scan(const Params& p, unsigned char* lds) {
    const int tid = tid_opaque(), lane = tid & 63;
    const int wv = __builtin_amdgcn_readfirstlane(tid >> 6);
    const int fr = lane & 15, fq = lane >> 4;
    unsigned char* ws = p.ws;
    constexpr int SH = 0, SL = 8192, AT = 16384  , RT = 20480  , BT = 24576  , KT = 28672  , BKT = 32768  , UV = 49152  , NT = 65536  ;
    constexpr int MFA = 69632, MFK = 70656, X0 = 71680, VS = 75776  , PP = 83968, PM = 88064, PI = 92160, AA = 96256  ;
    constexpr int PL = 116736  , YB = 117760, LDS_END = 121856;
    const bf16_t* rbuf = (const bf16_t*)(ws + WS_S + 3 * U_BYTES);
    const bf16_t* kbuf = (const bf16_t*)(ws + WS_S + 5 * U_BYTES);
    const bf16_t* vbuf = (const bf16_t*)(ws + WS_S + 1 * U_BYTES);
    const bf16_t* lora = (const bf16_t*)(ws + WS_S + 4 * U_BYTES);
    for (int unit = blockIdx.x; unit < 256; unit += gridDim.x) {
        const int b = unit >> 5, hh = (unit >> 1) & 15, d = unit & 1;
        bf16_t* ydst = (bf16_t*)(ws + WS_S + (size_t)(d ? 2 : 0) * U_BYTES);
        float* bonus = (float*)(ws + WS_BONUS) + (size_t)((d * NB + b) * 16 + hh) * 8448;
        const int s_e = (tid >> 4) & 15, j0 = (tid & 15) * 4;
        const int ni = wv & 3;
        auto Rof = [&](int c, int s) -> int {
            if (c < 16) { const int q = c * 16 + s; return NL + b * 256 + (d ? 255 - q : q); }
            const int q = (c - 16) * 16 + s; return b * 8192 + (d ? 8191 - q : q);
        };
        constexpr int CST = LDS_END;
        uint2 pr = make_uint2(0, 0), pk = pr, pv = pr; uint4 paw[2], paa[2];
        if (wv >= 4) {
            const int ct = (tid - 256) * 16;
            *(float4*)(lds + CST + 0 * 4096 + ct) = *(const float4*)(p.in[18] + hh * 64 + j0);
            *(float4*)(lds + CST + 1 * 4096 + ct) = *(const float4*)(p.in[19] + hh * 64 + j0);
            *(float4*)(lds + CST + 2 * 4096 + ct) = *(const float4*)(p.in[20] + hh * 64 + j0);
            *(float4*)(lds + CST + 3 * 4096 + ct) = *(const float4*)(p.in[10] + d * 1024 + hh * 64 + ni * 16 + fq * 4);
            *(float4*)(lds + CST + 4 * 4096 + ct) = *(const float4*)(p.in[13] + d * 1024 + hh * 64 + ni * 16 + fq * 4);
#pragma unroll
            for (int ks = 0; ks < 2; ++ks) {
                *(uint4*)(lds + CST + (5 + ks) * 4096 + ct) = *(const uint4*)((const bf16_t*)(ws + WS_W2T) + (size_t)d * 1024 * 64 + (size_t)(hh * 64 + ni * 16 + fr) * 64 + ks * 32 + fq * 8);
                *(uint4*)(lds + CST + (7 + ks) * 4096 + ct) = *(const uint4*)((const bf16_t*)(ws + WS_A2T) + (size_t)d * 1024 * 64 + (size_t)(hh * 64 + ni * 16 + fr) * 64 + ks * 32 + fq * 8);
            }
        }
        auto load_lora = [&](int c) {
            const size_t R2 = (size_t)Rof(c, fr);
#pragma unroll
            for (int ks = 0; ks < 2; ++ks) { paw[ks] = *(const uint4*)(lora + R2 * 384 + d * 64 + ks * 32 + fq * 8); paa[ks] = *(const uint4*)(lora + R2 * 384 + 128 + d * 64 + ks * 32 + fq * 8); }
        };
        auto load_rkv = [&](int c) {
            const size_t off = (size_t)Rof(c, s_e) * 1024 + hh * 64 + j0;
            pr = *(const uint2*)(rbuf + off); pk = *(const uint2*)(kbuf + off); pv = *(const uint2*)(vbuf + off);
        };
        auto step_up = [&](int c) {
            const int ct = (tid - 256) * 16;
            const float4 bias_w = *(const float4*)(lds + CST + 3 * 4096 + ct), bias_a = *(const float4*)(lds + CST + 4 * 4096 + ct);
            bf16x8 bfw[2], bfa[2];
#pragma unroll
            for (int ks = 0; ks < 2; ++ks) { bfw[ks] = *(const bf16x8*)(lds + CST + (5 + ks) * 4096 + ct); bfa[ks] = *(const bf16x8*)(lds + CST + (7 + ks) * 4096 + ct); }
            f32x4 accw = {0.f, 0.f, 0.f, 0.f}, acca = {0.f, 0.f, 0.f, 0.f};
#pragma unroll
            for (int ks = 0; ks < 2; ++ks) { accw = __builtin_amdgcn_mfma_f32_16x16x32_bf16(bfw[ks], as_bf16x8(paw[ks]), accw, 0, 0, 0); acca = __builtin_amdgcn_mfma_f32_16x16x32_bf16(bfa[ks], as_bf16x8(paa[ks]), acca, 0, 0, 0); }
            const int n = ni * 16 + fq * 4;
            const float bw[4] = {bias_w.x, bias_w.y, bias_w.z, bias_w.w}, ba[4] = {bias_a.x, bias_a.y, bias_a.z, bias_a.w};
            float P[4], Pm[4], Pi[4], av[4];
#pragma unroll
            for (int j = 0; j < 4; ++j) {
                const float e = 0.6065306597f * __builtin_amdgcn_rcpf(1.0f + __expf(-(accw[j] + bw[j])));
                float s = e;
                s += dpp_shr0<1>(s); s += dpp_shr0<2>(s); s += dpp_shr0<4>(s); s += dpp_shr0<8>(s);
                P[j] = __expf(-s); Pi[j] = __builtin_amdgcn_rcpf(P[j]); Pm[j] = P[j] * __expf(e);
                av[j] = __builtin_amdgcn_rcpf(1.0f + __expf(-(acca[j] + ba[j])));
            }
            const int pb = (c & 1) * 16384;
            *(float4*)(lds + PP + pb + (fr * 64 + n) * 4) = make_float4(P[0], P[1], P[2], P[3]);
            *(float4*)(lds + PM + pb + (fr * 64 + n) * 4) = make_float4(Pm[0], Pm[1], Pm[2], Pm[3]);
            *(float4*)(lds + PI + pb + (fr * 64 + n) * 4) = make_float4(Pi[0], Pi[1], Pi[2], Pi[3]);
            *(float4*)(lds + AA + pb + (fr * 64 + n) * 4) = make_float4(av[0], av[1], av[2], av[3]);
            if (fr == 15) *(float4*)(lds + PL + (c & 3) * 256 + n * 4) = make_float4(P[0], P[1], P[2], P[3]);
        };
        auto step_vec = [&](int c) {
            const int eo = (s_e * 64 + j0) * 4, pb = (c & 1) * 16384, tb = (c & 1) * 8192, ct = (tid - 256) * 16;
            const float4 kk_c = *(const float4*)(lds + CST + 0 * 4096 + ct), ka_c = *(const float4*)(lds + CST + 1 * 4096 + ct), rk_c = *(const float4*)(lds + CST + 2 * 4096 + ct);
            const float4 a4 = *(const float4*)(lds + AA + pb + eo), P4 = *(const float4*)(lds + PP + pb + eo), Pm4 = *(const float4*)(lds + PM + pb + eo), Pi4 = *(const float4*)(lds + PI + pb + eo);
            const float kx[4] = {bf_lo(pk.x), bf_hi(pk.x), bf_lo(pk.y), bf_hi(pk.y)};
            const float rx[4] = {bf_lo(pr.x), bf_hi(pr.x), bf_lo(pr.y), bf_hi(pr.y)};
            const float av[4] = {a4.x, a4.y, a4.z, a4.w}, Pv[4] = {P4.x, P4.y, P4.z, P4.w}, Pmv[4] = {Pm4.x, Pm4.y, Pm4.z, Pm4.w}, Piv[4] = {Pi4.x, Pi4.y, Pi4.z, Pi4.w};
            const float kkc[4] = {kk_c.x, kk_c.y, kk_c.z, kk_c.w}, kac[4] = {ka_c.x, ka_c.y, ka_c.z, ka_c.w}, rkc[4] = {rk_c.x, rk_c.y, rk_c.z, rk_c.w};
            float t[4], n2 = 0.f;
#pragma unroll
            for (int j = 0; j < 4; ++j) { t[j] = kx[j] * kkc[j]; n2 += t[j] * t[j]; }
            n2 = row16_allreduce(n2);
            const float inv = 1.0f / fmaxf(sqrtf(n2), 1e-12f);
            float at[4], bt[4], kt[4], rt[4], bon = 0.f;
#pragma unroll
            for (int j = 0; j < 4; ++j) {
                const float kkv = t[j] * inv;
                const float kd = kx[j] * (1.0f + (av[j] - 1.0f) * kac[j]);
                const float bq = kkv * av[j];
                bon += rx[j] * kd * rkc[j];
                at[j] = -kkv * Pmv[j]; bt[j] = bq * Piv[j]; kt[j] = kd * Piv[j]; rt[j] = rx[j] * Pv[j];
            }
            bon = row16_allreduce(bon);
            if ((tid & 15) == 0) { const int Rb = Rof(c, s_e); bonus[Rb < NL ? 256 + (Rb & 8191) : ((Rb - NL) & 255)] = bon; }
            const int ro = tile_off(s_e, j0 >> 3) + (j0 & 7) * 2;
            *(uint2*)(lds + AT + (c & 1) * 2048 + ro) = make_uint2(pk_bf16(at[0], at[1]), pk_bf16(at[2], at[3]));
            *(uint2*)(lds + RT + (c & 1) * 2048 + ro) = make_uint2(pk_bf16(rt[0], rt[1]), pk_bf16(rt[2], rt[3]));
            const unsigned b01 = pk_bf16(bt[0], bt[1]), b23 = pk_bf16(bt[2], bt[3]), k01 = pk_bf16(kt[0], kt[1]), k23 = pk_bf16(kt[2], kt[3]);
            *(uint2*)(lds + BT + (c & 1) * 2048 + ro) = make_uint2(b01, b23);
            *(uint2*)(lds + KT + (c & 1) * 2048 + ro) = make_uint2(k01, k23);
            const unsigned bw2[4] = {b01 & 0xffffu, b01 >> 16, b23 & 0xffffu, b23 >> 16}, kw2[4] = {k01 & 0xffffu, k01 >> 16, k23 & 0xffffu, k23 >> 16};
            const unsigned vw[4] = {pv.x & 0xffffu, pv.x >> 16, pv.y & 0xffffu, pv.y >> 16};
            const int e0 = (s_e & 7) * 2, cq = s_e >> 3;
#pragma unroll
            for (int j = 0; j < 4; ++j) {
                const int row = j0 + j;
                *(bf16_t*)(lds + BKT + tb + tile_off2(row, 0 + cq) + e0) = (bf16_t)bw2[j];
                *(bf16_t*)(lds + BKT + tb + tile_off2(row, 2 + cq) + e0) = (bf16_t)kw2[j];
                *(bf16_t*)(lds + BKT + tb + tile_off2(row, 4 + cq) + e0) = (bf16_t)bw2[j];
                *(bf16_t*)(lds + UV + tb + tile_off2(row, 2 + cq) + e0) = (bf16_t)vw[j];
            }
        };
        f32x4 accY = {0.f, 0.f, 0.f, 0.f};
        auto prod_S = [&](int c) {
            const int vt = wv & 3, tb = (c & 1) * 2048;
            f32x4 accX = {0.f, 0.f, 0.f, 0.f}, accR = {0.f, 0.f, 0.f, 0.f};
#pragma unroll
            for (int ks = 0; ks < 2; ++ks) {
                const int ch = ks * 4 + fq;
                const bf16x8 sh = *(const bf16x8*)(lds + SH + tile_off(vt * 16 + fr, ch)), sl = *(const bf16x8*)(lds + SL + tile_off(vt * 16 + fr, ch));
                const bf16x8 fa = *(const bf16x8*)(lds + AT + tb + tile_off(fr, ch)), frr = *(const bf16x8*)(lds + RT + tb + tile_off(fr, ch));
                accX = __builtin_amdgcn_mfma_f32_16x16x32_bf16(sh, fa, accX, 0, 0, 0);
                accR = __builtin_amdgcn_mfma_f32_16x16x32_bf16(sh, frr, accR, 0, 0, 0);
                accX = __builtin_amdgcn_mfma_f32_16x16x32_bf16(sl, fa, accX, 0, 0, 0);
                accR = __builtin_amdgcn_mfma_f32_16x16x32_bf16(sl, frr, accR, 0, 0, 0);
            }
            accY = accR;
            {
                const u32x2v av = *(const u32x2v*)(lds + UV + (c & 1) * 8192 + tile_off2(vt * 16 + fr, 2 + (fq >> 1)) + (fq & 1) * 8);
                const u32x2v mh = *(const u32x2v*)(lds + MFK + (fr * 4 + fq) * 8), ml = *(const u32x2v*)(lds + MFK + 512 + (fr * 4 + fq) * 8);
                accX = __builtin_amdgcn_mfma_f32_16x16x16bf16_1k(__builtin_bit_cast(s16x4v, av), __builtin_bit_cast(s16x4v, mh), accX, 0, 0, 0);
                accX = __builtin_amdgcn_mfma_f32_16x16x16bf16_1k(__builtin_bit_cast(s16x4v, av), __builtin_bit_cast(s16x4v, ml), accX, 0, 0, 0);
            }
#pragma unroll
            for (int j = 0; j < 4; ++j) *(float*)(lds + X0 + ((vt * 16 + 4 * fq + j) * 16 + fr) * 4) = accX[j];
        };
        auto prod_V = [&](int c) {
            const int tb = (c & 1) * 2048, w4 = wv & 3;
            f32x4 m = {0.f, 0.f, 0.f, 0.f};
#pragma unroll
            for (int ks = 0; ks < 2; ++ks) {
                const int ch = ks * 4 + fq;
                const bf16x8 fa = *(const bf16x8*)(lds + ((w4 & 1) ? KT : BT) + tb + tile_off(fr, ch));
                const bf16x8 fb = *(const bf16x8*)(lds + ((w4 & 2) ? RT : AT) + tb + tile_off(fr, ch));
                m = __builtin_amdgcn_mfma_f32_16x16x32_bf16(fa, fb, m, 0, 0, 0);
            }
            if (w4 == 0) {
                float* mf = (float*)(lds + MFA);
#pragma unroll
                for (int j = 0; j < 4; ++j) mf[(fr * 4 + j) * 4 + fq] = (4 * fq + j < fr) ? m[j] : 0.f;
            } else if (w4 == 1) {
                const float m0 = (4 * fq + 0 < fr) ? m[0] : 0.f, m1 = (4 * fq + 1 < fr) ? m[1] : 0.f, m2 = (4 * fq + 2 < fr) ? m[2] : 0.f, m3 = (4 * fq + 3 < fr) ? m[3] : 0.f;
                const unsigned h01 = pk_bf16(m0, m1), h23 = pk_bf16(m2, m3);
                *(uint2*)(lds + MFK + (fr * 4 + fq) * 8) = make_uint2(h01, h23);
                *(uint2*)(lds + MFK + 512 + (fr * 4 + fq) * 8) = make_uint2(pk_bf16(m0 - bf_lo(h01), m1 - bf_hi(h01)), pk_bf16(m2 - bf_lo(h23), m3 - bf_hi(h23)));
            } else {
                const float m0 = (4 * fq + 0 <= fr) ? m[0] : 0.f, m1 = (4 * fq + 1 <= fr) ? m[1] : 0.f, m2 = (4 * fq + 2 <= fr) ? m[2] : 0.f, m3 = (4 * fq + 3 <= fr) ? m[3] : 0.f;
                const uint2 o = make_uint2(pk_bf16(m0, m1), pk_bf16(m2, m3));
                const int colb = (w4 == 2 ? 0 : 16) + 4 * fq;
                *(uint2*)(lds + NT + tb + tile_off(fr, colb >> 3) + (colb & 7) * 2) = o;
                if (w4 == 2) *(uint2*)(lds + NT + tb + tile_off(fr, (32 + 4 * fq) >> 3) + ((32 + 4 * fq) & 7) * 2) = o;
            }
        };
        auto step_rec = [&](int c) {
            const int v = tid >> 2, pq = tid & 3;
            float cc[16];
#pragma unroll
            for (int i = 0; i < 4; ++i) { const float4 q = *(const float4*)(lds + X0 + (v * 16 + 4 * i) * 4); cc[4 * i] = q.x; cc[4 * i + 1] = q.y; cc[4 * i + 2] = q.z; cc[4 * i + 3] = q.w; }
            float4 ma[16];
#pragma unroll
            for (int t = 1; t < 16; ++t) ma[t] = *(const float4*)(lds + MFA + ((t * 4 + pq) * 4) * 4);
            ma[0] = make_float4(0.f, 0.f, 0.f, 0.f);
            float uown[4] = {0.f, 0.f, 0.f, 0.f}, uall[16];
#pragma unroll
            for (int t = 0; t < 16; ++t) {
                float s = uown[0] * ma[t].x; s = fmaf(uown[1], ma[t].y, s); s = fmaf(uown[2], ma[t].z, s); s = fmaf(uown[3], ma[t].w, s);
                s += dpp_quad<0xB1>(s); s += dpp_quad<0x4E>(s);
                const float u = cc[t] + s;
                uall[t] = u;
                if (pq == (t & 3)) uown[t >> 2] = u;
            }
            if (pq < 2) {
                unsigned o[8];
#pragma unroll
                for (int i = 0; i < 8; ++i) {
                    const unsigned hi = pk_bf16(uall[2 * i], uall[2 * i + 1]);
                    o[i] = pq ? pk_bf16(uall[2 * i] - bf_lo(hi), uall[2 * i + 1] - bf_hi(hi)) : hi;
                }
                const int cb = pq ? 4 : 0;
                *(uint4*)(lds + UV + (c & 1) * 8192 + tile_off2(v, cb)) = make_uint4(o[0], o[1], o[2], o[3]);
                *(uint4*)(lds + UV + (c & 1) * 8192 + tile_off2(v, cb + 1)) = make_uint4(o[4], o[5], o[6], o[7]);
            }
        };
        f32x4 accS[2];
        accS[0] = (f32x4){0.f, 0.f, 0.f, 0.f}; accS[1] = (f32x4){0.f, 0.f, 0.f, 0.f};
        auto step_upd = [&](int c) {
            const int vt = wv & 3;
            bf16x8 fuv[2];
#pragma unroll
            for (int ks = 0; ks < 2; ++ks) fuv[ks] = *(const bf16x8*)(lds + UV + (c & 1) * 8192 + tile_off2(vt * 16 + fr, ks * 4 + fq));
            if (wv < 4) {
#pragma unroll
                for (int ks = 0; ks < 2; ++ks) accY = __builtin_amdgcn_mfma_f32_16x16x32_bf16(fuv[ks], *(const bf16x8*)(lds + NT + (c & 1) * 2048 + tile_off(fr, ks * 4 + fq)), accY, 0, 0, 0);
                *(float4*)(lds + YB + (fr * 64 + vt * 16 + 4 * fq) * 4) = make_float4(accY[0], accY[1], accY[2], accY[3]);
            }
#pragma unroll
            for (int k2 = 0; k2 < 2; ++k2) {
                const int kt = 2 * (wv >> 2) + k2;
                f32x4 a = accS[k2];
#pragma unroll
                for (int ks = 0; ks < 2; ++ks) a = __builtin_amdgcn_mfma_f32_16x16x32_bf16(*(const bf16x8*)(lds + BKT + (c & 1) * 8192 + tile_off2(kt * 16 + fr, ks * 4 + fq)), fuv[ks], a, 0, 0, 0);
                const float4 pl = *(const float4*)(lds + PL + (c & 3) * 256 + (kt * 16 + 4 * fq) * 4);
                a[0] *= pl.x; a[1] *= pl.y; a[2] *= pl.z; a[3] *= pl.w;
                accS[k2] = a;
                const unsigned h01 = pk_bf16(a[0], a[1]), h23 = pk_bf16(a[2], a[3]);
                const unsigned l01 = pk_bf16(a[0] - bf_lo(h01), a[1] - bf_hi(h01)), l23 = pk_bf16(a[2] - bf_lo(h23), a[3] - bf_hi(h23));
                const int kc = kt * 16 + 4 * fq;
                const int so = tile_off(vt * 16 + fr, kc >> 3) + (kc & 7) * 2;
                *(uint2*)(lds + SH + so) = make_uint2(h01, h23);
                *(uint2*)(lds + SL + so) = make_uint2(l01, l23);
            }
        };
        for (int i = tid; i < LDS_END / 16; i += NTHREADS) *(uint4*)(lds + i * 16) = make_uint4(0, 0, 0, 0);
        if (wv >= 4) { load_lora(0); load_rkv(0); }
        __syncthreads();
        if (wv >= 4) { step_up(0); load_lora(1); }
        __syncthreads();
        if (wv >= 4) { step_vec(0); step_up(1); load_rkv(1); load_lora(2); }
        __syncthreads();
        if (wv >= 4) prod_V(0);
        __syncthreads();
        auto ystore = [&](int c) {
            const float4 y4 = *(const float4*)(lds + YB + (s_e * 64 + j0) * 4);
            *(uint2*)(ydst + (size_t)Rof(c, s_e) * 1024 + hh * 64 + j0) = make_uint2(pk_bf16(y4.x, y4.y), pk_bf16(y4.z, y4.w));
        };
        if (wv < 4) {
            unsigned pfd = 0;
            for (int c = 0; c < 528; ++c) {
                if (c > 0) ystore(c - 1);
                if (c + 4 < 528 && tid < 80) {
                    const bf16_t* pf;
                    if (tid < 48) { const int ten = tid >> 4; pf = (ten == 0 ? rbuf : (ten == 1 ? kbuf : vbuf)) + (size_t)Rof(c + 4, tid & 15) * 1024 + hh * 64; }
                    else { const int i = tid - 48; pf = lora + (size_t)Rof(c + 4, i >> 1) * 384 + (i & 1) * 128 + d * 64; }
                    asm volatile("global_load_dword %0, %1, off" : "=v"(pfd) : "v"(pf) : "memory");
                }
                __builtin_amdgcn_s_setprio(3);
                prod_S(c);
                step_rec(c);
                __builtin_amdgcn_s_setprio(0);
                __syncthreads();
                step_upd(c);
                __syncthreads();
                asm volatile("" :: "v"(pfd));
            }
        } else {
            for (int c = 0; c < 528; ++c) {
                if (c + 1 < 528) step_vec(c + 1);
                if (c + 2 < 528) { step_up(c + 2); load_rkv(c + 2); }
                if (c + 3 < 528) load_lora(c + 3);
                __syncthreads();
                step_upd(c);
                if (c + 1 < 528) prod_V(c + 1);
                __syncthreads();
            }
        }
        if (wv < 4) ystore(527);
        __syncthreads();
    }
}

DEV void phase_rw_readout(const Params& p) {
    const int tid = tid_opaque(), lane = tid & 63, wv = tid >> 6, wm = wv >> 2, wn = wv & 3;
    const int fr = lane & 15, fq = lane >> 4;
    unsigned char* ws = p.ws;
    const bf16_t* y0b = (const bf16_t*)(ws + WS_S + 0 * U_BYTES);
    const bf16_t* y1b = (const bf16_t*)(ws + WS_S + 2 * U_BYTES);
    const bf16_t* vb = (const bf16_t*)(ws + WS_S + 1 * U_BYTES);
    const bf16_t* lora = (const bf16_t*)(ws + WS_S + 4 * U_BYTES);
    const bf16_t* g2t = (const bf16_t*)(ws + WS_G2T);
    bf16_t* ao = (bf16_t*)(ws + WS_S + 5 * U_BYTES);
    const float* bon0 = (const float*)(ws + WS_BONUS);
    const float* bon1 = bon0 + (size_t)NB * 16 * 8448;
    const float* lnw = p.in[21];
    const float* lnb = p.in[22];
    const int nunits = (NT / 128) * 4;
    for (int u = blockIdx.x; u < nunits; u += gridDim.x) {
        const int mt = u >> 2, nt = u & 3, m0 = mt * 128;
        const int hh = nt * 4 + wn;
        f32x4 acc[4][4];
#pragma unroll
        for (int mi = 0; mi < 4; ++mi)
#pragma unroll
            for (int ni = 0; ni < 4; ++ni) acc[mi][ni] = (f32x4){0.f, 0.f, 0.f, 0.f};
#pragma unroll 2
        for (int ks = 0; ks < 4; ++ks) {
            bf16x8 af[4], bfr[4];
#pragma unroll
            for (int mi = 0; mi < 4; ++mi) af[mi] = *(const bf16x8*)(lora + (size_t)(m0 + wm * 64 + mi * 16 + fr) * 384 + 256 + ks * 32 + fq * 8);
#pragma unroll
            for (int ni = 0; ni < 4; ++ni) bfr[ni] = *(const bf16x8*)(g2t + (size_t)(hh * 64 + ni * 16 + fr) * 128 + ks * 32 + fq * 8);
#pragma unroll
            for (int mi = 0; mi < 4; ++mi)
#pragma unroll
                for (int ni = 0; ni < 4; ++ni) acc[mi][ni] = __builtin_amdgcn_mfma_f32_16x16x32_bf16(bfr[ni], af[mi], acc[mi][ni], 0, 0, 0);
        }
#pragma unroll
        for (int mi = 0; mi < 4; ++mi) {
            const size_t R = (size_t)(m0 + wm * 64 + mi * 16 + fr);
            float yv[4][4]; float sum = 0.f;
#pragma unroll
            for (int ni = 0; ni < 4; ++ni) {
                const int col = hh * 64 + ni * 16 + 4 * fq;
                const uint2 a = *(const uint2*)(y0b + R * 1024 + col), b2 = *(const uint2*)(y1b + R * 1024 + col);
                yv[ni][0] = bf_lo(a.x) + bf_lo(b2.x); yv[ni][1] = bf_hi(a.x) + bf_hi(b2.x); yv[ni][2] = bf_lo(a.y) + bf_lo(b2.y); yv[ni][3] = bf_hi(a.y) + bf_hi(b2.y);
                sum += (yv[ni][0] + yv[ni][1]) + (yv[ni][2] + yv[ni][3]);
            }
            sum += __shfl_xor(sum, 16); sum += __shfl_xor(sum, 32);
            const float mu = sum * (1.0f / 64.0f);
            float q = 0.f;
#pragma unroll
            for (int ni = 0; ni < 4; ++ni)
#pragma unroll
                for (int j = 0; j < 4; ++j) { const float dlt = yv[ni][j] - mu; q += dlt * dlt; }
            q += __shfl_xor(q, 16); q += __shfl_xor(q, 32);
            const float rstd = rsqrtf(q * (1.0f / 64.0f) + 64e-5f);
            const size_t bidx = (size_t)(((R < NL ? (R >> 13) : ((R - NL) >> 8)) * 16 + hh)) * 8448 + (R < NL ? 256 + (R & 8191) : ((R - NL) & 255));
            const float bs = bon0[bidx] + bon1[bidx];
#pragma unroll
            for (int ni = 0; ni < 4; ++ni) {
                const int col = hh * 64 + ni * 16 + 4 * fq;
                const uint2 vv = *(const uint2*)(vb + R * 1024 + col);
                const float4 lw = *(const float4*)(lnw + col), lb = *(const float4*)(lnb + col);
                const float o0 = ((yv[ni][0] - mu) * rstd * lw.x + lb.x + bs * bf_lo(vv.x)) * acc[mi][ni][0];
                const float o1 = ((yv[ni][1] - mu) * rstd * lw.y + lb.y + bs * bf_hi(vv.x)) * acc[mi][ni][1];
                const float o2 = ((yv[ni][2] - mu) * rstd * lw.z + lb.z + bs * bf_lo(vv.y)) * acc[mi][ni][2];
                const float o3 = ((yv[ni][3] - mu) * rstd * lw.w + lb.w + bs * bf_hi(vv.y)) * acc[mi][ni][3];
                *(uint2*)(ao + R * 1024 + col) = make_uint2(pk_bf16(o0, o1), pk_bf16(o2, o3));
            }
        }
    }
}

DEV void phase_wo(const Params& p, unsigned char* lds, int layer) {
    unsigned char* ws = p.ws;
    const bf16_t* ao = (const bf16_t*)(ws + WS_S + (size_t)(layer ? 0 : 5) * U_BYTES);
    const bf16_t* wot = (const bf16_t*)(ws + (layer ? WS_WO1 : WS_WO0));
    float* ctxr = (float*)(ws + WS_CTXR);
    const float* gate = (const float*)(ws + WS_MOD) + (size_t)layer * 9 * 6144 + 2 * 1024;
    const int M = layer ? NL : NT;
    pg8::Gemm g{ao, wot, M, 1024, 1024};
    pg8::StaticOrder so; so.init(M, 1024, gridDim.x, blockIdx.x);
    pg8::EpiResid256 ep{layer ? p.out : p.in[0], layer ? ctxr : p.in[2], p.out, ctxr, gate};
    pg8::gemm_phase((PG8_LAS unsigned char*)lds, g, so, ep, nullptr);
    __syncthreads();
}

struct EpiQTile {
    unsigned char* lds;
    DEV void operator()(const f32x4 (&acc)[4][4], int m0, int wm, int wn, int fr, int fq) const {
        const int pp = wn >> 1;
#pragma unroll
        for (int mi = 0; mi < 4; ++mi) {
            const int m = wm * 64 + mi * 16 + fr;
#pragma unroll
            for (int ni = 0; ni < 4; ++ni) {
                const int c = (wn & 1) * 64 + ni * 16 + 4 * fq;
                *(uint2*)(lds + pp * 32768 + m * 256 + (((c >> 3) ^ (m & 15)) << 4) + (c & 7) * 2) = make_uint2(pk_bf16(acc[mi][ni][0], acc[mi][ni][1]), pk_bf16(acc[mi][ni][2], acc[mi][ni][3]));
            }
        }
    }
};
DEV void phase_peer_select(const Params& p, unsigned char* lds, int layer) {
    const int tid = tid_opaque(), lane = tid & 63, wv = tid >> 6, wm = wv >> 2, wn = wv & 3;
    const int fr = lane & 15, fq = lane >> 4;
    unsigned char* ws = p.ws;
    const bf16_t* hp = (const bf16_t*)(ws + WS_S + (size_t)(layer ? 0 : 1) * U_BYTES);
    const bf16_t* wqt = (const bf16_t*)(ws + WS_WQ) + (size_t)layer * 2048 * 1024;
    const bf16_t* keys = (const bf16_t*)(ws + WS_KEYS) + (size_t)layer * 8 * 2 * 128 * 128;
    int* pl_idx = (int*)(ws + WS_S + 3 * U_BYTES);
    float* pl_gate = (float*)(ws + WS_S + 3 * U_BYTES + (size_t)NT * 128 * 4);
    unsigned* slist = (unsigned*)lds;
    unsigned* tlist = (unsigned*)(lds + 256 * 132 * 4);
    const int mtiles = layer ? NL / 128 : NT / 128;
    for (int u = blockIdx.x; u < mtiles * 8; u += gridDim.x) {
        const int mt = u >> 3, head = u & 7, m0 = mt * 128;
        ALoadPlain al{hp, 1024};
        EpiQTile ep{lds};
        gemm_unit<256>(lds, al, wqt + (size_t)head * 256 * 1024, 1024, m0, ep);
        __syncthreads();
        const int pp = wn >> 1, nk0 = (wn & 1) * 64;
        f32x4 sc[4][4];
#pragma unroll
        for (int mi = 0; mi < 4; ++mi)
#pragma unroll
            for (int ni = 0; ni < 4; ++ni) sc[mi][ni] = (f32x4){0.f, 0.f, 0.f, 0.f};
        const bf16_t* kb = keys + (size_t)(head * 2 + pp) * 16384;
#pragma unroll
        for (int ks = 0; ks < 4; ++ks) {
            bf16x8 af[4], bfr[4];
            const int ch = ks * 4 + fq;
#pragma unroll
            for (int mi = 0; mi < 4; ++mi) { const int m = wm * 64 + mi * 16 + fr; af[mi] = *(const bf16x8*)(lds + pp * 32768 + m * 256 + ((ch ^ (m & 15)) << 4)); }
#pragma unroll
            for (int ni = 0; ni < 4; ++ni) bfr[ni] = *(const bf16x8*)(kb + (size_t)(nk0 + ni * 16 + fr) * 128 + ks * 32 + fq * 8);
#pragma unroll
            for (int mi = 0; mi < 4; ++mi)
#pragma unroll
                for (int ni = 0; ni < 4; ++ni) sc[mi][ni] = __builtin_amdgcn_mfma_f32_16x16x32_bf16(bfr[ni], af[mi], sc[mi][ni], 0, 0, 0);
        }
        __syncthreads();
#pragma unroll
        for (int mi = 0; mi < 4; ++mi) {
            const int m = wm * 64 + mi * 16 + fr;
#pragma unroll
            for (int ni = 0; ni < 4; ++ni) {
                const int n = nk0 + ni * 16 + 4 * fq;
                uint4 o;
                o.x = (mono_u32(sc[mi][ni][0]) & ~127u) | (unsigned)(127 - (n + 0));
                o.y = (mono_u32(sc[mi][ni][1]) & ~127u) | (unsigned)(127 - (n + 1));
                o.z = (mono_u32(sc[mi][ni][2]) & ~127u) | (unsigned)(127 - (n + 2));
                o.w = (mono_u32(sc[mi][ni][3]) & ~127u) | (unsigned)(127 - (n + 3));
                *(uint4*)(slist + (size_t)(pp * 128 + m) * 132 + n) = o;
            }
        }
        __syncthreads();
        {
            const int L = tid >> 1, g2 = tid & 1;
            unsigned t[64];
            {
                const unsigned* srcp = slist + (size_t)L * 132 + g2 * 64;
#pragma unroll
                for (int i = 0; i < 16; ++i) { const uint4 v = *(const uint4*)(srcp + i * 4); t[4 * i] = v.x; t[4 * i + 1] = v.y; t[4 * i + 2] = v.z; t[4 * i + 3] = v.w; }
            }
#pragma unroll
            for (int o = 0; o < 64; o += 16) {
#pragma unroll
                for (int k = 2; k <= 16; k <<= 1)
#pragma unroll
                    for (int j = k >> 1; j > 0; j >>= 1)
#pragma unroll
                        for (int i = 0; i < 16; ++i) {
                            const int l = i ^ j;
                            if (l > i) {
                                const unsigned mx = max(t[o + i], t[o + l]), mn = min(t[o + i], t[o + l]);
                                if ((i & k) == 0) { t[o + i] = mx; t[o + l] = mn; } else { t[o + i] = mn; t[o + l] = mx; }
                            }
                        }
            }
#pragma unroll
            for (int rnd = 0; rnd < 4; ++rnd) {
                const int oa = rnd == 1 ? 32 : 0, ob = rnd == 0 ? 16 : (rnd == 1 ? 48 : 32);
                unsigned c[16];
#pragma unroll
                for (int i = 0; i < 16; ++i) {
                    unsigned b;
                    if (rnd < 3) b = t[ob + 15 - i];
                    else b = (unsigned)__builtin_amdgcn_update_dpp(0, (int)t[15 - i], 0xB1, 0xF, 0xF, false);
                    c[i] = max(t[oa + i], b);
                }
#pragma unroll
                for (int j = 8; j > 0; j >>= 1)
#pragma unroll
                    for (int i = 0; i < 16; ++i) {
                        const int l = i ^ j;
                        if (l > i) { const unsigned mx = max(c[i], c[l]), mn = min(c[i], c[l]); c[i] = mx; c[l] = mn; }
                    }
#pragma unroll
                for (int i = 0; i < 16; ++i) t[oa + i] = c[i];
            }
            if (g2 == 0) {
#pragma unroll
                for (int i = 0; i < 4; ++i) *(uint4*)(tlist + L * 16 + i * 4) = make_uint4(t[4 * i], t[4 * i + 1], t[4 * i + 2], t[4 * i + 3]);
            }
        }
        __syncthreads();
        if (tid < 128) {
            float v0[16], v1[16];
#pragma unroll
            for (int i = 0; i < 16; ++i) { v0[i] = unmono_u32(tlist[tid * 16 + i] & ~127u); v1[i] = unmono_u32(tlist[(128 + tid) * 16 + i] & ~127u); }
            unsigned cd[16];
#pragma unroll
            for (int i = 0; i < 16; ++i) cd[i] = 0u;
#pragma unroll
            for (int i = 0; i < 16; ++i) {
#pragma unroll
                for (int j = 0; j < 16; ++j) {
                    if ((i + 1) * (j + 1) <= 16) {
                        unsigned x = (mono_u32(v0[i] + v1[j]) & ~255u) | (unsigned)(255 - (i * 16 + j));
#pragma unroll
                        for (int q = (i + 1) * (j + 1) - 1; q < 16; ++q) { const unsigned mx = max(cd[q], x); x = min(cd[q], x); cd[q] = mx; }
                    }
                }
            }
            float sv[16]; int ex[16];
#pragma unroll
            for (int q = 0; q < 16; ++q) {
                const int slot = 255 - (int)(cd[q] & 255u);
                const unsigned a = tlist[tid * 16 + (slot >> 4)], b2 = tlist[(128 + tid) * 16 + (slot & 15)];
                sv[q] = unmono_u32(a & ~127u) + unmono_u32(b2 & ~127u);
                ex[q] = (127 - (int)(a & 127u)) * 128 + (127 - (int)(b2 & 127u));
            }
            float mx = sv[0];
#pragma unroll
            for (int q = 1; q < 16; ++q) mx = fmaxf(mx, sv[q]);
            float den = 0.f;
#pragma unroll
            for (int q = 0; q < 16; ++q) { sv[q] = __expf(sv[q] - mx); den += sv[q]; }
            const float rden = 1.0f / den;
            const size_t base = ((size_t)head * NT + (m0 + tid)) * 16;
#pragma unroll
            for (int i = 0; i < 4; ++i) {
                *(int4*)(pl_idx + base + i * 4) = make_int4(ex[4 * i], ex[4 * i + 1], ex[4 * i + 2], ex[4 * i + 3]);
                *(float4*)(pl_gate + base + i * 4) = make_float4(sv[4 * i] * rden, sv[4 * i + 1] * rden, sv[4 * i + 2] * rden, sv[4 * i + 3] * rden);
            }
        }
        __syncthreads();
    }
}

typedef float f32x2 __attribute__((ext_vector_type(2)));
typedef unsigned int u32x4 __attribute__((ext_vector_type(4)));
typedef unsigned int u32x2 __attribute__((ext_vector_type(2)));
#define PS_LOAD(buf, ee, h) { _Pragma("unroll") for (int e = 0; e < 8; ++e) { \
        const u32x4 t4 = __builtin_amdgcn_raw_buffer_load_b128(rs, ((unsigned)ee[(h) * 8 + e] << 7) + ch16, 0, 0); buf[e] = make_uint4(t4.x, t4.y, t4.z, t4.w); } }
#define PS_IDX(ee, Rr) { _Pragma("unroll") for (int i = 0; i < 4; ++i) { const int4 t = *(const int4*)(pl_idx + ((size_t)sub * NT + (Rr)) * 16 + 4 * i); \
        ee[4 * i] = t.x; ee[4 * i + 1] = t.y; ee[4 * i + 2] = t.z; ee[4 * i + 3] = t.w; } }
DEV long pk64(unsigned lo, unsigned hi) { return (long)(((unsigned long long)hi << 32) | (unsigned long long)lo); }
DEV void phase_peer_u(const Params& p, unsigned char* lds, int layer) {
    const int tid = tid_opaque(), lane = tid & 63, wv = tid >> 6, sub = lane >> 3, ch = lane & 7, fm = lane & 15, fg = lane >> 4;
    const int ng = gridDim.x >> 3, x = blockIdx.x & 7, wq = blockIdx.x >> 3;
    if (wq < ng) {
        const int gw = __builtin_amdgcn_readfirstlane(wq * 8 + wv), nw = ng * 8;
        unsigned char* ws = p.ws;
        const unsigned char* tab = ws + WS_PU + ((size_t)layer * 8 + x) * (16384 * 128);
        const int* pl_idx = (const int*)(ws + WS_S + 3 * U_BYTES);
        const unsigned char* xq = ws + WS_S + 2 * U_BYTES + (size_t)(fm & 1) * 1024 + 128 * x + 16 * fg;
        bf16_t* pd = (bf16_t*)(ws + WS_S + 5 * U_BYTES) + (size_t)x * NT * 128 + 16 * (fm >> 1) + 4 * fg;
        unsigned char* tile = lds + wv * 16384;
        const unsigned cE16 = 16u * (unsigned)(ch ^ (sub >> 1)), cO16 = cE16 ^ 64u;
        const unsigned aoff0 = (unsigned)fm * 128u + (unsigned)((fg ^ (fm >> 1)) << 4), aoff1 = (unsigned)fm * 128u + (unsigned)(((4 + fg) ^ (fm >> 1)) << 4);
        const int nrows = layer ? NL : NT;
        int eN[16];
#define PU_DMA(ee, q) { _Pragma("unroll") for (int j = 0; j < 4; ++j) { const int jj = (q) * 4 + j; \
        __builtin_amdgcn_global_load_lds((const unsigned*)(tab + (((unsigned)ee[jj] << 7) + ((jj & 1) ? cO16 : cE16))), (unsigned*)(tile + jj * 1024 + lane * 16), 16, 0, 0); } }
        const unsigned ta0 = (unsigned)(size_t)((LAS3 unsigned char*)tile) + aoff0, ta1 = (unsigned)(size_t)((LAS3 unsigned char*)tile) + aoff1;
#define PU_MMA(q) { u32x4 a0, a1, a2, a3; \
        asm volatile("ds_read_b128 %0, %4 offset:%6\n\tds_read_b128 %1, %5 offset:%6\n\tds_read_b128 %2, %4 offset:%7\n\tds_read_b128 %3, %5 offset:%7\n\ts_waitcnt lgkmcnt(0)" \
            : "=&v"(a0), "=&v"(a1), "=&v"(a2), "=&v"(a3) : "v"(ta0), "v"(ta1), "n"((q) * 4096), "n"((q) * 4096 + 2048) : "memory"); \
        f32x4 c4 = {0.f, 0.f, 0.f, 0.f}, c5 = {0.f, 0.f, 0.f, 0.f}; \
        c4 = __builtin_amdgcn_mfma_f32_16x16x32_fp8_fp8(pk64(a0.x, a0.y), pk64(bC0.x, bC0.y), c4, 0, 0, 0); \
        c5 = __builtin_amdgcn_mfma_f32_16x16x32_fp8_fp8(pk64(a2.x, a2.y), pk64(bC0.x, bC0.y), c5, 0, 0, 0); \
        c4 = __builtin_amdgcn_mfma_f32_16x16x32_fp8_fp8(pk64(a0.z, a0.w), pk64(bC0.z, bC0.w), c4, 0, 0, 0); \
        c5 = __builtin_amdgcn_mfma_f32_16x16x32_fp8_fp8(pk64(a2.z, a2.w), pk64(bC0.z, bC0.w), c5, 0, 0, 0); \
        c4 = __builtin_amdgcn_mfma_f32_16x16x32_fp8_fp8(pk64(a1.x, a1.y), pk64(bC1.x, bC1.y), c4, 0, 0, 0); \
        c5 = __builtin_amdgcn_mfma_f32_16x16x32_fp8_fp8(pk64(a3.x, a3.y), pk64(bC1.x, bC1.y), c5, 0, 0, 0); \
        c4 = __builtin_amdgcn_mfma_f32_16x16x32_fp8_fp8(pk64(a1.z, a1.w), pk64(bC1.z, bC1.w), c4, 0, 0, 0); \
        c5 = __builtin_amdgcn_mfma_f32_16x16x32_fp8_fp8(pk64(a3.z, a3.w), pk64(bC1.z, bC1.w), c5, 0, 0, 0); \
        acc[(q) * 2] = c4; acc[(q) * 2 + 1] = c5; }
        int R = gw;
#pragma unroll
        for (int i = 0; i < 16; ++i) eN[i] = 0;
        uint4 bC0 = make_uint4(0, 0, 0, 0), bC1 = bC0;
        if (R < nrows) {
            PS_IDX(eN, R);
            PU_DMA(eN, 0); PU_DMA(eN, 1); PU_DMA(eN, 2); PU_DMA(eN, 3);
            bC0 = *(const uint4*)(xq + (size_t)R * 2048); bC1 = *(const uint4*)(xq + (size_t)R * 2048 + 64);
            const int R1 = min(R + nw, nrows - 1);
            PS_IDX(eN, R1);
            asm volatile("s_waitcnt vmcnt(0)" : "+v"(bC0.x), "+v"(bC1.x), "+v"(eN[0]), "+v"(eN[4]), "+v"(eN[8]), "+v"(eN[12]) :: "memory");
        }
        for (; R < nrows; R += nw) {
            const int Rn = R + nw, R1 = min(Rn, nrows - 1), R2 = min(Rn + nw, nrows - 1);
            const bool more = Rn < nrows;
            u32x4 i0, i1, i2, i3, nb0, nb1;
            {
                const int* iptr = pl_idx + ((size_t)sub * NT + R2) * 16;
                const unsigned char* xptr = xq + (size_t)R1 * 2048;
                asm volatile("global_load_dwordx4 %0, %6, off\n\tglobal_load_dwordx4 %1, %6, off offset:16\n\tglobal_load_dwordx4 %2, %6, off offset:32\n\tglobal_load_dwordx4 %3, %6, off offset:48\n\t"
                             "global_load_dwordx4 %4, %7, off\n\tglobal_load_dwordx4 %5, %7, off offset:64"
                             : "=&v"(i0), "=&v"(i1), "=&v"(i2), "=&v"(i3), "=&v"(nb0), "=&v"(nb1) : "v"(iptr), "v"(xptr) : "memory");
            }
            f32x4 acc[8];
#define PU_STEP(q) { if (more) asm volatile("s_waitcnt vmcnt(19)" ::: "memory"); else asm volatile("s_waitcnt vmcnt(0)" ::: "memory"); \
            PU_MMA(q); if (more) { PU_DMA(eN, q); } }
            PU_STEP(0); PU_STEP(1); PU_STEP(2); PU_STEP(3);
            f32x4 s0[4], s1[2], s2;
#pragma unroll
            for (int i = 0; i < 4; ++i)
#pragma unroll
                for (int r = 0; r < 4; ++r) s0[i][r] = (fm & 2) ? acc[2 * i + 1][r] : acc[2 * i][r];
#pragma unroll
            for (int i = 0; i < 2; ++i)
#pragma unroll
                for (int r = 0; r < 4; ++r) s1[i][r] = (fm & 4) ? s0[2 * i + 1][r] : s0[2 * i][r];
#pragma unroll
            for (int r = 0; r < 4; ++r) { const float t = (fm & 8) ? s1[1][r] : s1[0][r]; s2[r] = t + dpp_quad<0xB1>(t); }
            if (!(fm & 1)) *(uint2*)(pd + (size_t)R * 128) = make_uint2(pk_bf16(s2[0], s2[1]), pk_bf16(s2[2], s2[3]));
            if (more) asm volatile("s_waitcnt vmcnt(17)" : "+v"(i0), "+v"(i1), "+v"(i2), "+v"(i3), "+v"(nb0), "+v"(nb1) :: "memory");
            else asm volatile("s_waitcnt vmcnt(0)" : "+v"(i0), "+v"(i1), "+v"(i2), "+v"(i3), "+v"(nb0), "+v"(nb1) :: "memory");
            eN[0] = i0.x; eN[1] = i0.y; eN[2] = i0.z; eN[3] = i0.w; eN[4] = i1.x; eN[5] = i1.y; eN[6] = i1.z; eN[7] = i1.w;
            eN[8] = i2.x; eN[9] = i2.y; eN[10] = i2.z; eN[11] = i2.w; eN[12] = i3.x; eN[13] = i3.y; eN[14] = i3.z; eN[15] = i3.w;
            bC0 = make_uint4(nb0.x, nb0.y, nb0.z, nb0.w); bC1 = make_uint4(nb1.x, nb1.y, nb1.z, nb1.w);
        }
        asm volatile("s_waitcnt vmcnt(0)" ::: "memory");
    }
}
DEV void phase_peer_c(const Params& p, int layer) {
    const int tid = tid_opaque(), lane = tid & 63;
    const int gw = blockIdx.x * 8 + (tid >> 6), nw = gridDim.x * 8;
    unsigned char* ws = p.ws;
    const float* usc = (const float*)(ws + WS_PSC) + layer * 16384;
    const float* vsc = (const float*)(ws + WS_PSC) + 32768 + layer * 16384;
    const int* pl_idx = (const int*)(ws + WS_S + 3 * U_BYTES);
    const float* pl_gate = (const float*)(ws + WS_S + 3 * U_BYTES + (size_t)NT * 128 * 4);
    float* pd = (float*)(ws + WS_S + 4 * U_BYTES);
    const bf16_t* pdh = (const bf16_t*)(ws + WS_S + 5 * U_BYTES);
    const int nrows = layer ? NL : NT;
    const int head0 = 2 * (lane & 3), kk = lane >> 2;
    for (int R = gw; R < nrows; R += nw) {
        float d0 = 0.f, d1 = 0.f;
#pragma unroll
        for (int xx = 0; xx < 8; ++xx) { const unsigned t = *(const unsigned*)(pdh + ((size_t)xx * NT + R) * 128 + 2 * lane); d0 += bf_lo(t); d1 += bf_hi(t); }
        const size_t po = ((size_t)head0 * NT + R) * 16 + kk;
        const int e0 = pl_idx[po], e1 = pl_idx[po + (size_t)NT * 16];
        const float g0 = pl_gate[po], g1 = pl_gate[po + (size_t)NT * 16];
        d0 *= usc[e0] * 0.25f; d1 *= usc[e1] * 0.25f;
        const float c0 = g0 * vsc[e0] * 0.5f * d0 * (1.0f + erff(d0 * 0.70710678118f));
        const float c1 = g1 * vsc[e1] * 0.5f * d1 * (1.0f + erff(d1 * 0.70710678118f));
        pd[(size_t)R * 128 + 16 * head0 + kk] = c0;
        pd[(size_t)R * 128 + 16 * head0 + 16 + kk] = c1;
    }
}
DEV void phase_peer_v(const Params& p, int layer) {
    const int tid = tid_opaque(), lane = tid & 63, sub = lane >> 3, ch = lane & 7;
    const int ng = gridDim.x >> 3, x = blockIdx.x & 7, wq = blockIdx.x >> 3;
    if (wq < ng) {
        const int gw = __builtin_amdgcn_readfirstlane(wq * 8 + (tid >> 6)), nw = ng * 8;
        unsigned char* ws = p.ws;
        const __amdgpu_buffer_rsrc_t rs = __builtin_amdgcn_make_buffer_rsrc((void*)(ws + WS_PV + ((size_t)layer * 8 + x) * (16384 * 128)), 0, 16384 * 128, 0x00020000);
        const int* pl_idx = (const int*)(ws + WS_S + 3 * U_BYTES);
        const float* cb = (const float*)(ws + WS_S + 4 * U_BYTES) + 16 * sub;
        float* ctxr = (float*)(ws + WS_CTXR);
        const float* mods = (const float*)(ws + WS_MOD) + (size_t)layer * 9 * 6144 + 5 * 1024;
        const unsigned ch16 = 16u * (unsigned)ch;
        const int col = 128 * x + 16 * ch + 2 * sub;
        const int nrows = layer ? NL : NT;
        uint4 bufA[8], bufB[8];
        int eC[16], eN[16];
        float cC[16], cN[16];
#define PS_CF(cc, Rr) { _Pragma("unroll") for (int i = 0; i < 4; ++i) { const float4 t = *(const float4*)(cb + (size_t)(Rr) * 128 + 4 * i); \
        cc[4 * i] = t.x; cc[4 * i + 1] = t.y; cc[4 * i + 2] = t.z; cc[4 * i + 3] = t.w; } }
#define PV_FMA(accv, av) asm("v_fma_f32 %0, %1, %2, %0" : "+v"(accv) : "v"(cf), "v"(av))
#define PV_AXPY(buf, h) { _Pragma("unroll") for (int e = 0; e < 8; ++e) { \
        const float cf = cC[(h) * 8 + e]; const unsigned vw[4] = {buf[e].x, buf[e].y, buf[e].z, buf[e].w}; \
        _Pragma("unroll") for (int i = 0; i < 4; ++i) { \
            const f32x2 a = __builtin_amdgcn_cvt_pk_f32_fp8((int)vw[i], false), b2 = __builtin_amdgcn_cvt_pk_f32_fp8((int)vw[i], true); \
            PV_FMA(a16[4 * i], a.x); PV_FMA(a16[4 * i + 1], a.y); PV_FMA(a16[4 * i + 2], b2.x); PV_FMA(a16[4 * i + 3], b2.y); } } }
        int R = gw;
#pragma unroll
        for (int i = 0; i < 16; ++i) { eC[i] = 0; eN[i] = 0; cC[i] = 0.f; cN[i] = 0.f; }
        if (R < nrows) { PS_IDX(eC, R); PS_CF(cC, R); PS_LOAD(bufA, eC, 0); }
        for (; R < nrows; R += nw) {
            const int Rn = R + nw;
            if (Rn < nrows) { PS_IDX(eN, Rn); PS_CF(cN, Rn); }
            PS_LOAD(bufB, eC, 1);
            float* xrow = (R < NL ? p.out + (size_t)R * 1024 : ctxr + (size_t)(R - NL) * 1024) + col;
            const float2 xa = *(const float2*)xrow, ga = *(const float2*)(mods + (size_t)mod_batch(R) * 6144 + col);
            float a16[16];
#pragma unroll
            for (int i = 0; i < 16; ++i) a16[i] = 0.f;
            PV_AXPY(bufA, 0);
            if (Rn < nrows) { PS_LOAD(bufA, eN, 0); }
            PV_AXPY(bufB, 1);
            float s8[8], t4[4];
#pragma unroll
            for (int j = 0; j < 8; ++j) { const u32x2 r = __builtin_amdgcn_permlane32_swap(__float_as_uint(a16[j]), __float_as_uint(a16[8 + j]), false, false); s8[j] = __uint_as_float(r.x) + __uint_as_float(r.y); }
#pragma unroll
            for (int j = 0; j < 4; ++j) { const u32x2 r = __builtin_amdgcn_permlane16_swap(__float_as_uint(s8[j]), __float_as_uint(s8[4 + j]), false, false); t4[j] = __uint_as_float(r.x) + __uint_as_float(r.y); }
            const float wa0 = t4[0] + dpp_ror<8>(t4[0]), wa1 = t4[1] + dpp_ror<8>(t4[1]), wb0 = t4[2] + dpp_ror<8>(t4[2]), wb1 = t4[3] + dpp_ror<8>(t4[3]);
            const float w0 = (lane & 8) ? wb0 : wa0, w1 = (lane & 8) ? wb1 : wa1;
            *(float2*)xrow = make_float2(xa.x + ga.x * w0, xa.y + ga.y * w1);
#pragma unroll
            for (int i = 0; i < 16; ++i) { eC[i] = eN[i]; cC[i] = cN[i]; }
        }
    }
}
DEV void phase_final_norm(const Params& p) {
    const int tid = tid_opaque(), lane = tid & 63;
    const int gw = blockIdx.x * 8 + (tid >> 6), nw = gridDim.x * 8;
    const float* gn = p.in[34];
    for (int R = gw; R < NL; R += nw) {
        float* xr = p.out + (size_t)R * 1024;
        float4 v[4]; float ss = 0.f;
#pragma unroll
        for (int i = 0; i < 4; ++i) { v[i] = *(const float4*)(xr + i * 256 + lane * 4); ss += v[i].x * v[i].x + v[i].y * v[i].y + v[i].z * v[i].z + v[i].w * v[i].w; }
        ss = wave_allreduce(ss);
        const float rs = rsqrtf(ss * (1.0f / 1024.0f) + 1e-6f);
#pragma unroll
        for (int i = 0; i < 4; ++i) {
            const float4 gg = *(const float4*)(gn + i * 256 + lane * 4);
            *(float4*)(xr + i * 256 + lane * 4) = make_float4(v[i].x * rs * gg.x, v[i].y * rs * gg.y, v[i].z * rs * gg.z, v[i].w * rs * gg.w);
        }
    }
}

DEV void phase_gla_proj(const Params& p, unsigned char* lds) {
    unsigned char* ws = p.ws;
    const bf16_t* h = (const bf16_t*)(ws + WS_S + 0 * U_BYTES);
    const bf16_t* wint = (const bf16_t*)(ws + WS_WIN);
    {
        pg8::Gemm g{h, wint, NT, 3072, 1024};
        pg8::StaticOrder so; so.init(NT, 3072, gridDim.x, blockIdx.x);
        pg8::EpiBf16Tiles ep{(bf16_t*)(ws + WS_S + 1 * U_BYTES), 2048, 8, (bf16_t*)(ws + WS_S + 3 * U_BYTES), 1024};
        pg8::gemm_phase(( PG8_LAS unsigned char*)lds, g, so, ep, nullptr);
    }
    __syncthreads();
    for (int u = blockIdx.x; u < NT / 128; u += gridDim.x) {
        ALoadPlain al{h, 1024};
        EpiLr ep{(float*)(ws + WS_LR)};
        gemm_unit<128>(lds, al, wint + (size_t)3072 * 1024, 1024, u * 128, ep);
    }
}

DEV void conv_emit(const float (&acc)[8], int c, bf16_t* dst) {
    const float qs = (c < 512) ? 0.08838834764831845f : 1.0f;
    unsigned ow[4];
#pragma unroll
    for (int j = 0; j < 4; ++j) { const float a0 = acc[2 * j], a1 = acc[2 * j + 1]; ow[j] = pk_bf16(a0 * sigmoidf_(a0) * qs, a1 * sigmoidf_(a1) * qs); }
    *(uint4*)dst = make_uint4(ow[0], ow[1], ow[2], ow[3]);
}
DEV void conv_tap(float (&acc)[8], const uint4& v, const float (&w)[8]) {
    acc[0] += bf_lo(v.x) * w[0]; acc[1] += bf_hi(v.x) * w[1]; acc[2] += bf_lo(v.y) * w[2]; acc[3] += bf_hi(v.y) * w[3];
    acc[4] += bf_lo(v.z) * w[4]; acc[5] += bf_hi(v.z) * w[5]; acc[6] += bf_lo(v.w) * w[6]; acc[7] += bf_hi(v.w) * w[7];
}
DEV void phase_gla_conv(const Params& p) {
    const int tid = tid_opaque();
    unsigned char* ws = p.ws;
    const bf16_t* z = (const bf16_t*)(ws + WS_S + 1 * U_BYTES);
    bf16_t* o = (bf16_t*)(ws + WS_S + 4 * U_BYTES);
    const float* cw = p.in[25];
    const int x = tid >> 3, cl = (tid & 7) * 8;
    for (int task = blockIdx.x; task < 8 * 32; task += gridDim.x) {
        const int cb = task & 31, b = task >> 5;
        const int c = cb * 64 + cl;
        float w[9][8];
#pragma unroll
        for (int t = 0; t < 9; ++t) { const float4 w0 = *(const float4*)(cw + t * 2048 + c), w1 = *(const float4*)(cw + t * 2048 + c + 4); w[t][0] = w0.x; w[t][1] = w0.y; w[t][2] = w0.z; w[t][3] = w0.w; w[t][4] = w1.x; w[t][5] = w1.y; w[t][6] = w1.z; w[t][7] = w1.w; }
        const uint4 zero4 = make_uint4(0, 0, 0, 0);
        auto load_row = [&](int y, uint4 (&r)[3]) {
            if (y < 0 || y >= 128) { r[0] = zero4; r[1] = zero4; r[2] = zero4; return; }
            const bf16_t* row = z + ((size_t)b * 8192 + (size_t)y * 64 + x) * 2048 + c;
            r[1] = *(const uint4*)row;
            r[0] = (x > 0) ? *(const uint4*)(row - 2048) : zero4;
            r[2] = (x < 63) ? *(const uint4*)(row + 2048) : zero4;
        };
        uint4 r0[3], r1[3], r2[3], r3[3], r4[3];
        const int y0 = 0;
        load_row(y0 - 1, r0); load_row(y0, r1); load_row(y0 + 1, r2); load_row(y0 + 2, r3);
#pragma unroll 1
        for (int yy = 0; yy < 128; ++yy) {
            load_row(y0 + yy + 3, r4);
            float acc[8];
#pragma unroll
            for (int j = 0; j < 8; ++j) acc[j] = 0.f;
#pragma unroll
            for (int dx = 0; dx < 3; ++dx) { conv_tap(acc, r0[dx], w[dx]); conv_tap(acc, r1[dx], w[3 + dx]); conv_tap(acc, r2[dx], w[6 + dx]); }
            conv_emit(acc, c, o + ((size_t)b * 8192 + (size_t)(y0 + yy) * 64 + x) * 2048 + c);
#pragma unroll
            for (int dx = 0; dx < 3; ++dx) { r0[dx] = r1[dx]; r1[dx] = r2[dx]; r2[dx] = r3[dx]; r3[dx] = r4[dx]; }
        }
    }
    for (int task = blockIdx.x; task < (NC / 64) * 8; task += gridDim.x) {
        const int rb = task >> 3, cbk = task & 7;
        const int R = NL + rb * 64 + (tid >> 3);
        const int t = (R - NL) & 255;
#pragma unroll 1
        for (int i = 0; i < 4; ++i) {
            const int c = cbk * 256 + (tid & 7) * 8 + i * 64;
            float acc[8];
#pragma unroll
            for (int j = 0; j < 8; ++j) acc[j] = 0.f;
#pragma unroll
            for (int dx = -1; dx <= 1; ++dx) {
                if (t + dx >= 0 && t + dx < 256) {
                    const uint4 v = *(const uint4*)(z + (size_t)(R + dx) * 2048 + c);
                    const float* wp = cw + (3 + (dx + 1)) * 2048 + c;
                    const float4 w0 = *(const float4*)wp, w1 = *(const float4*)(wp + 4);
                    const float wv[8] = {w0.x, w0.y, w0.z, w0.w, w1.x, w1.y, w1.z, w1.w};
                    conv_tap(acc, v, wv);
                }
            }
            conv_emit(acc, c, o + (size_t)R * 2048 + c);
        }
    }
}

constexpr int GT_QE = 0, GT_KET = 16384, GT_A = 32768, GT_CONST = 40960, GT_STRIDE = 43008;
constexpr int GT_N0 = (int)((2 * U_BYTES) / GT_STRIDE);
constexpr size_t WS_TOTAL = 1073741824ull;
static_assert((size_t)(NB * 4 * 2 * 132 - GT_N0) * GT_STRIDE <= WS_TOTAL - WS_END, "tile records do not fit");
DEV size_t gla_tile_off(int b, int hd, int d, int cc) {
    const int idx = (((b * 4 + hd) * 2 + d) * 132) + cc;
    return idx < GT_N0 ? WS_S + (size_t)idx * GT_STRIDE : WS_END + (size_t)(idx - GT_N0) * GT_STRIDE;
}
DEV int gla_row0(int b, int cc) { return cc < 4 ? NL + b * 256 + cc * 64 : b * 8192 + (cc - 4) * 64; }
DEV void phase_gla_prep(const Params& p, unsigned char* lds) {
    const int tid = tid_opaque(), lane = tid & 63, wv = tid >> 6;
    const int fr = lane & 15, fq = lane >> 4;
    unsigned char* ws = p.ws;
    constexpr int QE = 0, KE = 16384, KET = 32768, BC = 49152  , GS = 82944  , LRL = 86528  , BCS = 132;
    const bf16_t* qkv = (const bf16_t*)(ws + WS_S + 4 * U_BYTES);
    const float* lrb = (const float*)(ws + WS_LR);
    unsigned char* gt = ws;
    float* bc = (float*)(lds + BC);
    float* gs = (float*)(lds + GS);
    const int li = tid >> 3, lc = tid & 7;
    const int d = blockIdx.x & 1, hd = (blockIdx.x >> 1) & 3;
    bf16x8 gkf;
    {
        unsigned w4[4] = {0u, 0u, 0u, 0u};
        if (fq < 2) {
#pragma unroll
            for (int e2 = 0; e2 < 4; ++e2) {
                const float g0 = p.in[26][(size_t)(d * 16 + 8 * fq + 2 * e2) * 512 + hd * 128 + wv * 16 + fr];
                const float g1 = p.in[26][(size_t)(d * 16 + 8 * fq + 2 * e2 + 1) * 512 + hd * 128 + wv * 16 + fr];
                w4[e2] = pk_bf16(g0, g1);
            }
        }
        gkf = as_bf16x8(make_uint4(w4[0], w4[1], w4[2], w4[3]));
    }
    const float4 gb4 = *(const float4*)(p.in[27] + d * 512 + hd * 128 + wv * 16 + 4 * fq);
    const int qstep = (int)(gridDim.x >> 3);
    uint4 nq0, nq1, nk0, nk1; float2 nl;
    auto fetch = [&](int q) {
        const size_t R = (size_t)(gla_row0(q / 132, q % 132) + li);
        const bf16_t* row = qkv + R * 2048;
        nq0 = *(const uint4*)(row + hd * 128 + lc * 8); nq1 = *(const uint4*)(row + hd * 128 + 64 + lc * 8);
        nk0 = *(const uint4*)(row + 512 + hd * 128 + lc * 8); nk1 = *(const uint4*)(row + 512 + hd * 128 + 64 + lc * 8);
        nl = *(const float2*)(lrb + R * 32 + d * 16 + lc * 2);
    };
    int q = (int)(blockIdx.x >> 3);
    if (q < NB * 132) fetch(q);
    for (; q < NB * 132; q += qstep) {
        const int cc = q % 132, b = q / 132;
        unsigned char* rec = gt + gla_tile_off(b, hd, d, cc);
        const uint4 rq0 = nq0, rq1 = nq1, rk0 = nk0, rk1 = nk1; const float2 rl = nl;
        if (q + qstep < NB * 132) fetch(q + qstep);
        *(unsigned*)(lds + LRL + li * 32 + lc * 4) = pk_bf16(rl.x, rl.y);
        __syncthreads();
        {
            const float gbv[4] = {gb4.x, gb4.y, gb4.z, gb4.w};
#pragma unroll
            for (int itl = 0; itl < 4; ++itl) {
                uint4 lr4 = *(const uint4*)(lds + LRL + (itl * 16 + fr) * 32 + (fq & 1) * 16);
                if (fq >= 2) lr4 = make_uint4(0, 0, 0, 0);
                f32x4 a = {0.f, 0.f, 0.f, 0.f};
                a = __builtin_amdgcn_mfma_f32_16x16x32_bf16(gkf, as_bf16x8(lr4), a, 0, 0, 0);
                float s[4], tot[4];
#pragma unroll
                for (int j = 0; j < 4; ++j) {
                    const float xx = a[j] + gbv[j];
                    const float la = (fminf(xx, 0.f) - __logf(1.0f + __expf(-fabsf(xx)))) * (1.0f / 16.0f);
                    float pf = la;
                    pf += dpp_shr0<1>(pf); pf += dpp_shr0<2>(pf); pf += dpp_shr0<4>(pf); pf += dpp_shr0<8>(pf);
                    tot[j] = __shfl(pf, (lane & 48) | 15);
                    s[j] = d ? (tot[j] - pf + la) : pf;
                }
                *(float4*)(bc + (itl * 16 + fr) * BCS + wv * 16 + 4 * fq) = make_float4(s[0], s[1], s[2], s[3]);
                if (fr == 15) *(float4*)(gs + itl * 128 + wv * 16 + 4 * fq) = make_float4(tot[0], tot[1], tot[2], tot[3]);
            }
        }
        __syncthreads();
        if (tid < 128) {
            const float g0 = gs[tid], g1 = gs[128 + tid], g2 = gs[256 + tid], g3 = gs[384 + tid];
            const float refc = d ? (bc[31 * BCS + tid] + g2 + g3) : (bc[32 * BCS + tid] + g0 + g1), lastc = g0 + g1 + g2 + g3;
            const float dl = __expf(lastc), er = __expf(refc), el = __expf(lastc - refc);
            gs[512 + tid] = refc;
            float* cst = (float*)(rec + GT_CONST);
            cst[tid] = er; cst[128 + tid] = el; cst[256 + tid] = dl;
        }
        __syncthreads();
        {
            const int grp = li >> 4;
            const uint4 rqs[2] = {rq0, rq1}, rks[2] = {rk0, rk1};
#pragma unroll
            for (int hseg = 0; hseg < 2; ++hseg) {
                const int k0 = hseg * 64 + lc * 8;
                float bcv[8], refv[8];
#pragma unroll
                for (int j4 = 0; j4 < 2; ++j4) {
                    const float4 g0 = *(const float4*)(gs + k0 + j4 * 4), g1 = *(const float4*)(gs + 128 + k0 + j4 * 4);
                    const float4 g2 = *(const float4*)(gs + 256 + k0 + j4 * 4), g3 = *(const float4*)(gs + 384 + k0 + j4 * 4);
                    const float4 bi = *(const float4*)(bc + li * BCS + k0 + j4 * 4), rf = *(const float4*)(gs + 512 + k0 + j4 * 4);
                    const float g0a[4] = {g0.x, g0.y, g0.z, g0.w}, g1a[4] = {g1.x, g1.y, g1.z, g1.w}, g2a[4] = {g2.x, g2.y, g2.z, g2.w}, g3a[4] = {g3.x, g3.y, g3.z, g3.w};
                    const float bia[4] = {bi.x, bi.y, bi.z, bi.w}, rfa[4] = {rf.x, rf.y, rf.z, rf.w};
#pragma unroll
                    for (int j = 0; j < 4; ++j) {
                        const float pre = d ? ((grp < 1 ? g1a[j] : 0.f) + (grp < 2 ? g2a[j] : 0.f) + (grp < 3 ? g3a[j] : 0.f))
                                            : ((grp > 0 ? g0a[j] : 0.f) + (grp > 1 ? g1a[j] : 0.f) + (grp > 2 ? g2a[j] : 0.f));
                        bcv[j4 * 4 + j] = bia[j] + pre;
                        refv[j4 * 4 + j] = rfa[j];
                    }
                }
                const unsigned qw[4] = {rqs[hseg].x, rqs[hseg].y, rqs[hseg].z, rqs[hseg].w}, kw[4] = {rks[hseg].x, rks[hseg].y, rks[hseg].z, rks[hseg].w};
                unsigned oqe[4], oke[4];
#pragma unroll
                for (int j2 = 0; j2 < 4; ++j2) {
                    const float q0 = bf_lo(qw[j2]), q1 = bf_hi(qw[j2]), kk0 = bf_lo(kw[j2]), kk1 = bf_hi(kw[j2]);
                    const float e0 = __expf(bcv[2 * j2] - refv[2 * j2]), e1 = __expf(bcv[2 * j2 + 1] - refv[2 * j2 + 1]);
                    const float r0 = __builtin_amdgcn_rcpf(e0), r1 = __builtin_amdgcn_rcpf(e1);
                    oqe[j2] = pk_bf16(q0 * e0, q1 * e1);
                    oke[j2] = pk_bf16(kk0 * r0, kk1 * r1);
                    const int kc0 = k0 + 2 * j2;
                    *(bf16_t*)(lds + KET + tile_off2(kc0, li >> 3) + (li & 7) * 2) = (bf16_t)(oke[j2] & 0xffffu);
                    *(bf16_t*)(lds + KET + tile_off2(kc0 + 1, li >> 3) + (li & 7) * 2) = (bf16_t)(oke[j2] >> 16);
                }
                const int chq = hseg * 8 + lc;
                const int so = li * 256 + ((chq ^ (li & 15)) << 4);
                *(uint4*)(lds + QE + so) = make_uint4(oqe[0], oqe[1], oqe[2], oqe[3]);
                *(uint4*)(lds + KE + so) = make_uint4(oke[0], oke[1], oke[2], oke[3]);
                *(uint4*)(rec + GT_QE + so) = make_uint4(oqe[0], oqe[1], oqe[2], oqe[3]);
            }
        }
        __syncthreads();
        {
            const int it = wv & 3, pr2 = wv >> 2;
#pragma unroll
            for (int jj = 0; jj < 2; ++jj) {
                const int jt = pr2 * 2 + jj;
                f32x4 a = {0.f, 0.f, 0.f, 0.f};
                if (d ? (jt >= it) : (jt <= it)) {
#pragma unroll
                    for (int ks = 0; ks < 4; ++ks) {
                        const int ch = ks * 4 + fq;
                        const int rj = jt * 16 + fr, ri = it * 16 + fr;
                        const bf16x8 fa = *(const bf16x8*)(lds + KE + rj * 256 + ((ch ^ (rj & 15)) << 4));
                        const bf16x8 fb = *(const bf16x8*)(lds + QE + ri * 256 + ((ch ^ (ri & 15)) << 4));
                        a = __builtin_amdgcn_mfma_f32_16x16x32_bf16(fa, fb, a, 0, 0, 0);
                    }
                }
                const int i = it * 16 + fr, j = jt * 16 + 4 * fq;
                float av[4];
#pragma unroll
                for (int e = 0; e < 4; ++e) av[e] = (d ? (j + e >= i) : (j + e <= i)) ? a[e] : 0.f;
                *(uint2*)(rec + GT_A + i * 128 + (((j >> 3) ^ (i & 7)) << 4) + (j & 7) * 2) = make_uint2(pk_bf16(av[0], av[1]), pk_bf16(av[2], av[3]));
            }
#pragma unroll
            for (int i = 0; i < 2; ++i) *(uint4*)(rec + GT_KET + i * 8192 + tid * 16) = *(const uint4*)(lds + KET + i * 8192 + tid * 16);
        }
        __syncthreads();
    }
}

DEV void phase_gla_scan(const Params& p, unsigned char* lds) {
    const int tid = tid_opaque(), lane = tid & 63, wv = tid >> 6;
    const int fr = lane & 15, fq = lane >> 4;
    unsigned char* ws = p.ws;
    constexpr int QE = 0  , KET = 32768  , AL = 65536  , VT = 81920, ST = 90112  ;
    const bf16_t* qkv = (const bf16_t*)(ws + WS_S + 4 * U_BYTES);
    const unsigned char* gt = ws;
    for (int unit = blockIdx.x; unit < 256; unit += gridDim.x) {
        const int vs = unit & 3, d = (unit >> 2) & 1, hd = (unit >> 3) & 3, b = unit >> 5;
        bf16_t* odst = d ? (bf16_t*)(ws + WS_S + 2 * U_BYTES) : (bf16_t*)(ws + WS_S + 4 * U_BYTES);
        const int old_ = d ? 1024 : 2048;
        const int li = tid >> 3, lc = tid & 7;
        auto ccof = [&](int c) -> int { return d ? (c < 4 ? 3 - c : 135 - c) : c; };
        auto dma = [&](int cc, int buf) {
            const unsigned char* rec = gt + gla_tile_off(b, hd, d, cc);
#pragma unroll
            for (int i = 0; i < 2; ++i) {
                __builtin_amdgcn_global_load_lds((const unsigned*)(rec + GT_QE + i * 8192 + tid * 16), (unsigned*)(lds + QE + buf * 16384 + i * 8192 + tid * 16), 16, 0, 0);
                __builtin_amdgcn_global_load_lds((const unsigned*)(rec + GT_KET + i * 8192 + tid * 16), (unsigned*)(lds + KET + buf * 16384 + i * 8192 + tid * 16), 16, 0, 0);
            }
            __builtin_amdgcn_global_load_lds((const unsigned*)(rec + GT_A + tid * 16), (unsigned*)(lds + AL + buf * 8192 + tid * 16), 16, 0, 0);
        };
        uint4 nv; float4 n_dl, n_el, n_er;
        auto loads = [&](int c) {
            const int cc = ccof(c);
            nv = *(const uint4*)(qkv + (size_t)(gla_row0(b, cc) + li) * 2048 + 1024 + hd * 256 + vs * 64 + lc * 8);
            const float* cst = (const float*)(gt + gla_tile_off(b, hd, d, cc) + GT_CONST);
            n_el = *(const float4*)(cst + 128 + wv * 16 + 4 * fq); n_dl = *(const float4*)(cst + 256 + wv * 16 + 4 * fq);
            if (c + 1 < 132) n_er = *(const float4*)((const float*)(gt + gla_tile_off(b, hd, d, ccof(c + 1)) + GT_CONST) + wv * 16 + 4 * fq);
            else n_er = make_float4(0.f, 0.f, 0.f, 0.f);
        };
        f32x4 accS[4];
#pragma unroll
        for (int i = 0; i < 4; ++i) accS[i] = (f32x4){0.f, 0.f, 0.f, 0.f};
        for (int i = tid; i < 32768 / 16; i += NTHREADS) *(uint4*)(lds + ST + i * 16) = make_uint4(0, 0, 0, 0);
        dma(ccof(0), 0);
        loads(0);
        for (int c = 0; c < 132; ++c) {
            const int buf = c & 1, cc = ccof(c);
            const uint4 rv = nv; const float4 dl4 = n_dl, el4 = n_el, er4 = n_er;
            asm volatile("s_waitcnt vmcnt(0)" ::: "memory");
            {
                const unsigned vw[4] = {rv.x, rv.y, rv.z, rv.w};
#pragma unroll
                for (int j2 = 0; j2 < 4; ++j2) {
                    const int vc0 = lc * 8 + 2 * j2;
                    *(bf16_t*)(lds + VT + tile_off2(vc0, li >> 3) + (li & 7) * 2) = (bf16_t)(vw[j2] & 0xffffu);
                    *(bf16_t*)(lds + VT + tile_off2(vc0 + 1, li >> 3) + (li & 7) * 2) = (bf16_t)(vw[j2] >> 16);
                }
            }
            asm volatile("s_waitcnt lgkmcnt(0)" ::: "memory"); __builtin_amdgcn_s_barrier(); asm volatile("" ::: "memory");
            if (c + 1 < 132) { dma(ccof(c + 1), buf ^ 1); loads(c + 1); }
            const int it = wv & 3, pr2 = wv >> 2;
            const int r0 = gla_row0(b, cc);
#pragma unroll
            for (int vv = 0; vv < 2; ++vv) {
                const int vt = pr2 * 2 + vv;
                f32x4 a = {0.f, 0.f, 0.f, 0.f};
#pragma unroll
                for (int ks = 0; ks < 4; ++ks) {
                    const int ch = ks * 4 + fq;
                    const int rvv = vt * 16 + fr, ri = it * 16 + fr;
                    const bf16x8 fa = *(const bf16x8*)(lds + ST + buf * 16384 + rvv * 256 + ((ch ^ (rvv & 15)) << 4));
                    const bf16x8 fb = *(const bf16x8*)(lds + QE + buf * 16384 + ri * 256 + ((ch ^ (ri & 15)) << 4));
                    a = __builtin_amdgcn_mfma_f32_16x16x32_bf16(fa, fb, a, 0, 0, 0);
                }
#pragma unroll
                for (int ks = 0; ks < 2; ++ks) {
                    const int ch = ks * 4 + fq;
                    const int rvv = vt * 16 + fr, ri = it * 16 + fr;
                    const bf16x8 fa = *(const bf16x8*)(lds + VT + tile_off2(rvv, ch));
                    const bf16x8 fb = *(const bf16x8*)(lds + AL + buf * 8192 + ri * 128 + ((ch ^ (ri & 7)) << 4));
                    a = __builtin_amdgcn_mfma_f32_16x16x32_bf16(fa, fb, a, 0, 0, 0);
                }
                const int i = it * 16 + fr, vcol = vt * 16 + 4 * fq;
                *(uint2*)(odst + (size_t)(r0 + i) * old_ + hd * 256 + vs * 64 + vcol) = make_uint2(pk_bf16(a[0], a[1]), pk_bf16(a[2], a[3]));
            }
            {
                const int kt = wv;
                bf16x8 fa[2];
#pragma unroll
                for (int ks = 0; ks < 2; ++ks) fa[ks] = *(const bf16x8*)(lds + KET + buf * 16384 + tile_off2(kt * 16 + fr, ks * 4 + fq));
#pragma unroll
                for (int vt = 0; vt < 4; ++vt) {
                    f32x4 t = {0.f, 0.f, 0.f, 0.f};
#pragma unroll
                    for (int ks = 0; ks < 2; ++ks) t = __builtin_amdgcn_mfma_f32_16x16x32_bf16(fa[ks], *(const bf16x8*)(lds + VT + tile_off2(vt * 16 + fr, ks * 4 + fq)), t, 0, 0, 0);
                    f32x4 a = accS[vt];
                    a[0] = a[0] * dl4.x + t[0] * el4.x; a[1] = a[1] * dl4.y + t[1] * el4.y; a[2] = a[2] * dl4.z + t[2] * el4.z; a[3] = a[3] * dl4.w + t[3] * el4.w;
                    accS[vt] = a;
                    const int vcol = vt * 16 + fr, kcol = kt * 16 + 4 * fq;
                    *(uint2*)(lds + ST + (buf ^ 1) * 16384 + vcol * 256 + (((kcol >> 3) ^ (vcol & 15)) << 4) + (kcol & 7) * 2) =
                        make_uint2(pk_bf16(a[0] * er4.x, a[1] * er4.y), pk_bf16(a[2] * er4.z, a[3] * er4.w));
                }
            }
            asm volatile("s_waitcnt lgkmcnt(0)" ::: "memory"); __builtin_amdgcn_s_barrier(); asm volatile("" ::: "memory");
        }
        asm volatile("s_waitcnt vmcnt(0)" ::: "memory");
        __syncthreads();
    }
}

DEV void phase_gla_readout(const Params& p) {
    const int tid = tid_opaque(), lane = tid & 63;
    const int gw = blockIdx.x * 8 + (tid >> 6), nw = gridDim.x * 8;
    unsigned char* ws = p.ws;
    const bf16_t* o0 = (const bf16_t*)(ws + WS_S + 4 * U_BYTES);
    const bf16_t* o1 = (const bf16_t*)(ws + WS_S + 2 * U_BYTES);
    const bf16_t* gb = (const bf16_t*)(ws + WS_S + 3 * U_BYTES);
    bf16_t* ao = (bf16_t*)(ws + WS_S + 0 * U_BYTES);
    const float4 hn = *(const float4*)(p.in[28] + lane * 4);
    for (int item = gw; item < NL * 4; item += nw) {
        const size_t off = (size_t)(item >> 2) * 1024 + (item & 3) * 256 + lane * 4;
        const uint2 a = *(const uint2*)(o0 + off + (size_t)(item >> 2) * 1024), b2 = *(const uint2*)(o1 + off), g2 = *(const uint2*)(gb + off);
        const float v0 = bf_lo(a.x) + bf_lo(b2.x), v1 = bf_hi(a.x) + bf_hi(b2.x), v2 = bf_lo(a.y) + bf_lo(b2.y), v3 = bf_hi(a.y) + bf_hi(b2.y);
        float ss = v0 * v0 + v1 * v1 + v2 * v2 + v3 * v3;
        ss = wave_allreduce(ss);
        const float rs = rsqrtf(ss * (1.0f / 256.0f) + 1e-6f);
        const float g0 = bf_lo(g2.x), g1 = bf_hi(g2.x), g2f = bf_lo(g2.y), g3 = bf_hi(g2.y);
        const float r0 = v0 * rs * hn.x * (g0 * sigmoidf_(g0)), r1 = v1 * rs * hn.y * (g1 * sigmoidf_(g1));
        const float r2 = v2 * rs * hn.z * (g2f * sigmoidf_(g2f)), r3 = v3 * rs * hn.w * (g3 * sigmoidf_(g3));
        *(uint2*)(ao + off) = make_uint2(pk_bf16(r0, r1), pk_bf16(r2, r3));
    }
}


#define XB_TMO      128
#define XB_XCNT(j)  (256  + 64 * (j))
#define XB_XSUB(j)  (1280 + 64 * (j))
#define XB_XGEN(j)  (2304 + 64 * (j))
#define XB_TOP      3328
#define XB_TOPGEN   3392
#define XB_SPIN_CAP (1u << 22)
DEV unsigned xb_ld(unsigned* p) { return __hip_atomic_load(p, __ATOMIC_RELAXED, __HIP_MEMORY_SCOPE_AGENT); }
DEV unsigned xb_add(unsigned* p, unsigned v) { return __hip_atomic_fetch_add(p, v, __ATOMIC_RELAXED, __HIP_MEMORY_SCOPE_AGENT); }
DEV unsigned xb_xcc_id() { return (unsigned)__builtin_amdgcn_s_getreg((3 << 11) | 20) & 0xFu; }
#define XB_SPIN(cond, bar) do { unsigned _sp = 0; while (cond) { __builtin_amdgcn_s_sleep(1); \
    if ((++_sp & 255u) == 0u) { if (xb_ld(&(bar)[XB_TMO])) break; if (_sp > XB_SPIN_CAP) { atomicAdd(&(bar)[XB_TMO], 1u); break; } } } } while (0)
DEV void xcd_barrier_complete(unsigned* bar, unsigned x, unsigned& nloc, unsigned& nx) {
    const unsigned G = gridDim.x;
    unsigned sum, cnt, mine, sp = 0u;
    for (;;) {
        sum = 0u; cnt = 0u; mine = 0u;
#pragma unroll
        for (unsigned j = 0; j < 16; ++j) { const unsigned c = xb_ld(&bar[XB_XCNT(j)]); sum += c; cnt += (c > 0u) ? 1u : 0u; mine = (j == x) ? c : mine; }
        if (sum == G) break;
        __builtin_amdgcn_s_sleep(1);
        if ((++sp & 255u) == 0u) { if (xb_ld(&bar[XB_TMO])) break; if (sp > XB_SPIN_CAP) { atomicAdd(&bar[XB_TMO], 1u); break; } }
    }
    nloc = mine > 0u ? mine : 1u; nx = cnt > 0u ? cnt : 1u;
}
DEV void xcd_barrier(unsigned* bar, volatile LAS3 unsigned* st) {
    asm volatile("s_waitcnt vmcnt(0)" ::: "memory");
    __syncthreads();
    if (tid_opaque() == 0) {
        const unsigned x = xb_xcc_id();
        __builtin_amdgcn_s_waitcnt(0);
        unsigned nloc = st[0], nx = st[1];
        if (nloc == 0u) { xcd_barrier_complete(bar, x, nloc, nx); st[0] = nloc; st[1] = nx; }
        const unsigned old = xb_add(&bar[XB_XSUB(x)], 1u);
        const unsigned gen = old / nloc;
        if (old + 1u == (gen + 1u) * nloc) {
            __builtin_amdgcn_fence(__ATOMIC_RELEASE, "agent");
            asm volatile("s_waitcnt vmcnt(0)" ::: "memory");
            const unsigned og = xb_add(&bar[XB_TOP], 1u);
            const unsigned tg = og / nx;
            if (og + 1u == (tg + 1u) * nx) xb_add(&bar[XB_TOPGEN], 1u);
            else XB_SPIN(xb_ld(&bar[XB_TOPGEN]) == tg, bar);
            __builtin_amdgcn_fence(__ATOMIC_ACQUIRE, "agent");
            xb_add(&bar[XB_XGEN(x)], 1u);
            asm volatile("s_waitcnt vmcnt(0)" ::: "memory");
        } else {
            XB_SPIN(xb_ld(&bar[XB_XGEN(x)]) == gen, bar);
            __builtin_amdgcn_fence(__ATOMIC_ACQUIRE, "agent");
            asm volatile("s_waitcnt vmcnt(0)" ::: "memory");
        }
    }
    __syncthreads();
}
#define SYNC() do { asm volatile("s_waitcnt vmcnt(0)" ::: "memory"); grid.sync(); \
    if (tid_opaque() == 0) { __builtin_amdgcn_fence(__ATOMIC_ACQUIRE, "agent"); asm volatile("s_waitcnt vmcnt(0)" ::: "memory"); } \
    __syncthreads(); } while (0)
__global__ void __launch_bounds__(NTHREADS) mega_fwd(Params p) {
    unsigned char* const lds = g_lds;
    cg::grid_group grid = cg::this_grid();
#define XBAR ((unsigned*)(p.ws + WS_BAR))
#define XST ((volatile LAS3 unsigned*)(lds + LDS_BYTES - 16))
    if ((threadIdx.x & 63) == 0) g_lds[LDS_WTAB + hw_wave_slot()] = (unsigned char)(threadIdx.x >> 6);
    if (threadIdx.x == 0) { XST[0] = 0u; XST[1] = 0u; (void)xb_add(&XBAR[XB_XCNT(xb_xcc_id())], 1u); }
    __syncthreads();
#define S0 ((bf16_t*)(p.ws + WS_S + 0 * U_BYTES))
#define SLOT(i) ((bf16_t*)(p.ws + WS_S + (size_t)(i) * U_BYTES))
#define S1 ((bf16_t*)(p.ws + WS_S + 1 * U_BYTES))
#define CTXR ((const float*)(p.ws + WS_CTXR))
    phase0(p, lds); SYNC();
#undef SYNC
#define SYNC() xcd_barrier(XBAR, XST)
    phase_normmix(p, S0, SLOT(5), SLOT(1), SLOT(2)); SYNC();
    phase_rw_proj1(p, lds, 0, SLOT(5), SLOT(3)); SYNC();
    phase_rw_proj1(p, lds, 1, SLOT(1), SLOT(5)); SYNC();
    phase_rw_proj1(p, lds, 2, SLOT(2), SLOT(1)); phase_rw_lora(p, lds); SYNC();
    REPEAT(3, phase_rw_scan(p, lds));
    phase_rw_scan(p, lds); SYNC();
    REPEAT(4, phase_rw_readout(p));
    phase_rw_readout(p); SYNC();
    REPEAT(5, phase_wo(p, lds, 0));
    phase_wo(p, lds, 0); SYNC();
    REPEAT(6, phase_normmod(p, 0, 1, p.out, CTXR, NT, S1, (unsigned char*)SLOT(2)));
    phase_normmod(p, 0, 1, p.out, CTXR, NT, S1, (unsigned char*)SLOT(2)); SYNC();
    REPEAT(7, phase_peer_select(p, lds, 0));
    phase_peer_select(p, lds, 0); SYNC();
    phase_peer_u(p, lds, 0); SYNC();
    phase_peer_c(p, 0); SYNC();
    phase_peer_v(p, 0); SYNC();
    phase_normmod(p, 1, 0, p.out, CTXR, NT, S0, nullptr); SYNC();
    REPEAT(9, phase_gla_proj(p, lds));
    phase_gla_proj(p, lds); SYNC();
    REPEAT(10, phase_gla_conv(p));
    phase_gla_conv(p); SYNC();
    REPEAT(18, phase_gla_prep(p, lds));
    phase_gla_prep(p, lds); SYNC();
    REPEAT(11, phase_gla_scan(p, lds));
    phase_gla_scan(p, lds); SYNC();
    REPEAT(12, phase_gla_readout(p));
    phase_gla_readout(p); SYNC();
    phase_wo(p, lds, 1); SYNC();
    REPEAT(14, phase_normmod(p, 1, 1, p.out, CTXR, NL, S0, (unsigned char*)SLOT(2)));
    phase_normmod(p, 1, 1, p.out, CTXR, NL, S0, (unsigned char*)SLOT(2)); SYNC();
    REPEAT(15, phase_peer_select(p, lds, 1));
    phase_peer_select(p, lds, 1); SYNC();
    phase_peer_u(p, lds, 1); SYNC();
    phase_peer_c(p, 1); SYNC();
    phase_peer_v(p, 1); SYNC();
    phase_final_norm(p);
}

extern "C" void kernel_launch(void* const* d_in, const int* in_sizes, int n_in, void* d_out, int out_size, void* d_ws, size_t ws_size, hipStream_t stream) {
    static int grid_blocks = 0;
    if (grid_blocks == 0) {
        if (n_in != 35 || ws_size < WS_TOTAL) { fprintf(stderr, "kernel_launch: unexpected n_in %d or ws_size %zu (< %zu)\n", n_in, ws_size, (size_t)WS_END); grid_blocks = -1; return; }
        int dev = 0, cus = 0, per_cu = 0;
        if (hipGetDevice(&dev) != hipSuccess || hipDeviceGetAttribute(&cus, hipDeviceAttributeMultiprocessorCount, dev) != hipSuccess) { fprintf(stderr, "kernel_launch: device query failed\n"); grid_blocks = -1; return; }
        if (hipFuncSetAttribute((const void*)mega_fwd, hipFuncAttributeMaxDynamicSharedMemorySize, LDS_BYTES) != hipSuccess) { fprintf(stderr, "kernel_launch: hipFuncSetAttribute failed\n"); grid_blocks = -1; return; }
        if (hipOccupancyMaxActiveBlocksPerMultiprocessor(&per_cu, (const void*)mega_fwd, NTHREADS, LDS_BYTES) != hipSuccess || per_cu < 1) { fprintf(stderr, "kernel_launch: occupancy query says %d blocks per CU\n", per_cu); grid_blocks = -1; return; }
        grid_blocks = cus;
    }
    if (grid_blocks < 0) return;
    Params p{};
    for (int i = 0; i < 35; ++i) p.in[i] = (const float*)d_in[i];
    p.out = (float*)d_out;
    p.ws = (unsigned char*)d_ws;
    if (hipMemsetAsync((char*)d_ws + WS_BAR, 0, 16384, stream) != hipSuccess) { fprintf(stderr, "kernel_launch: hipMemsetAsync failed\n"); return; }
    void* args[] = {&p};
    hipError_t e = hipLaunchCooperativeKernel((const void*)mega_fwd, dim3(grid_blocks), dim3(NTHREADS), args, LDS_BYTES, stream);
    if (e != hipSuccess) fprintf(stderr, "kernel_launch: cooperative launch failed: %s (grid %d)\n", hipGetErrorString(e), grid_blocks);
}
```

```cpp
#include <hip/hip_runtime.h>
#include <hip/hip_cooperative_groups.h>
#include <cstdio>
#include <cstdint>
namespace cg = cooperative_groups;

#define DEV __device__ __forceinline__
#ifndef REP
#define REP 0
#endif
#define GREPS(n) ((REP == (n)) ? 2 : 1)
#define REPEAT(n, stmt) do { if (REP == (n)) { stmt; SYNC(); } } while (0)

typedef unsigned short bf16_t;
typedef short bf16x8 __attribute__((ext_vector_type(8)));
typedef float f32x4 __attribute__((ext_vector_type(4)));
typedef __bf16 bf16x2v __attribute__((ext_vector_type(2)));

constexpr int D = 1024;
constexpr int NB = 8, SEQ = 8192, CTXL = 256;
constexpr int NL = NB * SEQ, NC = NB * CTXL, NT = NL + NC;
constexpr int NTHREADS = 512;
constexpr int LDS_BYTES = 160 * 1024;

constexpr size_t U_BYTES = (size_t)NT * 1024 * 2;
constexpr size_t WS_BAR = 0;
constexpr size_t WS_MOD = 16384;
constexpr size_t WS_CTXR = WS_MOD + (size_t)2 * 9 * 6144 * 4;
constexpr size_t WS_LR = WS_CTXR + (size_t)NC * 1024 * 4;
constexpr size_t WS_BONUS = WS_LR + (size_t)NT * 32 * 4;
constexpr size_t WS_WPROJ = WS_BONUS + (size_t)2 * NT * 16 * 4;
constexpr size_t WS_W2T = WS_WPROJ + (size_t)3456 * 1024 * 2;
constexpr size_t WS_A2T = WS_W2T + (size_t)2 * 1024 * 64 * 2;
constexpr size_t WS_G2T = WS_A2T + (size_t)2 * 1024 * 64 * 2;
constexpr size_t WS_WO0 = WS_G2T + (size_t)1024 * 128 * 2;
constexpr size_t WS_WO1 = WS_WO0 + (size_t)1024 * 1024 * 2;
constexpr size_t WS_WQ = WS_WO1 + (size_t)1024 * 1024 * 2;
constexpr size_t WS_KEYS = WS_WQ + (size_t)2 * 2048 * 1024 * 2;
constexpr size_t WS_WIN = WS_KEYS + (size_t)2 * 8 * 2 * 128 * 128 * 2;
constexpr size_t WS_PU = WS_WIN + (size_t)3200 * 1024 * 2;
constexpr size_t WS_PV = WS_PU + (size_t)2 * 16384 * 1024;
constexpr size_t WS_PSC = WS_PV + (size_t)2 * 16384 * 1024;
constexpr size_t WS_S = WS_PSC + (size_t)2 * 2 * 16384 * 4;
constexpr size_t WS_END = WS_S + 6 * U_BYTES;
static_assert(WS_END <= 1073741824ull, "workspace too large");
static_assert((WS_CTXR % 256) == 0 && (WS_WPROJ % 256) == 0 && (WS_S % 256) == 0, "alignment");

struct Params {
    const float* in[35];
    float* out;
    unsigned char* ws;
    int pad0, pad1;
};

DEV float bf_lo(unsigned u) { return __uint_as_float(u << 16); }
DEV float bf_hi(unsigned u) { return __uint_as_float(u & 0xffff0000u); }
typedef float f32x2v __attribute__((ext_vector_type(2)));
typedef unsigned int u32x2v __attribute__((ext_vector_type(2)));
typedef short s16x4v __attribute__((ext_vector_type(4)));
DEV unsigned pk_bf16(float lo, float hi) { const f32x2v f = {lo, hi}; union { bf16x2v v; unsigned u; } x; x.v = __builtin_convertvector(f, bf16x2v); return x.u; }
template <int N> DEV float dpp_ror(float x) { return __int_as_float(__builtin_amdgcn_update_dpp(0, __float_as_int(x), 0x120 + N, 0xF, 0xF, false)); }
DEV float row16_allreduce(float x) { x += dpp_ror<8>(x); x += dpp_ror<4>(x); x += dpp_ror<2>(x); x += dpp_ror<1>(x); return x; }
DEV float wave_allreduce(float x) { x = row16_allreduce(x); x += __shfl_xor(x, 16); x += __shfl_xor(x, 32); return x; }
DEV float sigmoidf_(float x) { return 1.0f / (1.0f + __expf(-x)); }
DEV float softplusf_(float z) { return fmaxf(z, 0.f) + __logf(1.0f + __expf(-fabsf(z))); }
DEV unsigned mono_u32(float f) { unsigned u = __float_as_uint(f); return u ^ ((u >> 31) ? 0xFFFFFFFFu : 0x80000000u); }
DEV float unmono_u32(unsigned k) { unsigned u = (k & 0x80000000u) ? (k ^ 0x80000000u) : ~k; return __uint_as_float(u); }
DEV bf16x8 as_bf16x8(uint4 v) { union { uint4 u; bf16x8 b; } x; x.u = v; return x.b; }
#define LAS3 __attribute__((address_space(3)))
extern __shared__ __attribute__((aligned(16))) unsigned char g_lds[];
constexpr int LDS_WTAB = LDS_BYTES - 128;
DEV unsigned hw_wave_slot() { return (unsigned)__builtin_amdgcn_s_getreg((5 << 11) | 4) & 63u; }
DEV int tid_opaque() {
    const int wv = (int)*(const volatile unsigned char*)(g_lds + LDS_WTAB + hw_wave_slot());
    int t = (wv << 6) | (int)__builtin_amdgcn_mbcnt_hi(~0u, __builtin_amdgcn_mbcnt_lo(~0u, 0u));
    asm volatile("" : "+v"(t));
    return t;
}
DEV int mod_batch(int R) { return R < NL ? (R >> 13) : 8; }

template <int BN, class AL, class EP>
DEV void gemm_unit(unsigned char* lds, const AL& al, const bf16_t* Bt, int K, int m0, const EP& ep) {
    constexpr int NI = BN / 64;
    constexpr int A_BYTES = 128 * 128;
    constexpr int B_BYTES = BN * 128;
    const int tid = tid_opaque(), lane = tid & 63, wv = tid >> 6, wm = wv >> 2, wn = wv & 3;
    const int fr = lane & 15, fq = lane >> 4;
    unsigned char* sA = lds;
    unsigned char* sB = lds + 2 * A_BYTES;
    f32x4 acc[4][NI];
#pragma unroll
    for (int mi = 0; mi < 4; ++mi)
#pragma unroll
        for (int ni = 0; ni < NI; ++ni) acc[mi][ni] = (f32x4){0.f, 0.f, 0.f, 0.f};
    const int KT = K >> 6;
    const int drow = tid >> 3, dch = (tid & 7) ^ (drow & 7);
    const bf16_t* bsrc = Bt + (size_t)drow * K + dch * 8;
    uint4 ra[2];
    auto stage = [&](int kt, int buf) {
        const int k0 = kt * 64;
#pragma unroll
        for (int i = 0; i < BN / 64; ++i)
            __builtin_amdgcn_global_load_lds((const unsigned*)(bsrc + (size_t)(64 * i) * K + k0), (unsigned*)(sB + buf * B_BYTES + i * 8192 + tid * 16), 16, 0, 0);
        if constexpr (AL::DMA) {
#pragma unroll
            for (int i = 0; i < 2; ++i)
                __builtin_amdgcn_global_load_lds((const unsigned*)(al.A + (size_t)(m0 + drow + 64 * i) * al.lda + k0 + dch * 8), (unsigned*)(sA + buf * A_BYTES + i * 8192 + tid * 16), 16, 0, 0);
        } else {
#pragma unroll
            for (int i = 0; i < 2; ++i) { const int q = tid + 512 * i; ra[i] = al.load(m0 + (q >> 3), k0 + (q & 7) * 8); }
        }
    };
    auto commit = [&](int buf) {
        if constexpr (!AL::DMA) {
#pragma unroll
            for (int i = 0; i < 2; ++i) { const int q = tid + 512 * i, row = q >> 3, ch = q & 7; *(uint4*)(sA + buf * A_BYTES + row * 128 + ((ch ^ (row & 7)) << 4)) = ra[i]; }
        }
    };
    auto compute = [&](int buf) {
        const unsigned char* a_base = sA + buf * A_BYTES;
        const unsigned char* b_base = sB + buf * B_BYTES;
#pragma unroll
        for (int ks = 0; ks < 2; ++ks) {
            bf16x8 af[4], bfr[NI];
            const int ch = ks * 4 + fq;
#pragma unroll
            for (int mi = 0; mi < 4; ++mi) { const int row = wm * 64 + mi * 16 + fr; af[mi] = *(const bf16x8*)(a_base + row * 128 + ((ch ^ (row & 7)) << 4)); }
#pragma unroll
            for (int ni = 0; ni < NI; ++ni) { const int row = wn * (BN / 4) + ni * 16 + fr; bfr[ni] = *(const bf16x8*)(b_base + row * 128 + ((ch ^ (row & 7)) << 4)); }
#pragma unroll
            for (int mi = 0; mi < 4; ++mi)
#pragma unroll
                for (int ni = 0; ni < NI; ++ni) acc[mi][ni] = __builtin_amdgcn_mfma_f32_16x16x32_bf16(bfr[ni], af[mi], acc[mi][ni], 0, 0, 0);
        }
    };
    if constexpr (AL::DMA) {
        constexpr int STG = A_BYTES + B_BYTES;
        auto stage3 = [&](int kt, int b3) {
            const int k0 = kt * 64;
            unsigned char* base = lds + b3 * STG;
#pragma unroll
            for (int i = 0; i < BN / 64; ++i)
                __builtin_amdgcn_global_load_lds((const unsigned*)(bsrc + (size_t)(64 * i) * K + k0), (unsigned*)(base + A_BYTES + i * 8192 + tid * 16), 16, 0, 0);
#pragma unroll
            for (int i = 0; i < 2; ++i)
                __builtin_amdgcn_global_load_lds((const unsigned*)(al.A + (size_t)(m0 + drow + 64 * i) * al.lda + k0 + dch * 8), (unsigned*)(base + i * 8192 + tid * 16), 16, 0, 0);
        };
        auto compute3 = [&](int b3) {
            const unsigned char* a_base = lds + b3 * STG;
            const unsigned char* b_base = a_base + A_BYTES;
#pragma unroll
            for (int ks = 0; ks < 2; ++ks) {
                bf16x8 af[4], bfr[NI];
                const int ch = ks * 4 + fq;
#pragma unroll
                for (int mi = 0; mi < 4; ++mi) { const int row = wm * 64 + mi * 16 + fr; af[mi] = *(const bf16x8*)(a_base + row * 128 + ((ch ^ (row & 7)) << 4)); }
#pragma unroll
                for (int ni = 0; ni < NI; ++ni) { const int row = wn * (BN / 4) + ni * 16 + fr; bfr[ni] = *(const bf16x8*)(b_base + row * 128 + ((ch ^ (row & 7)) << 4)); }
#pragma unroll
                for (int mi = 0; mi < 4; ++mi)
#pragma unroll
                    for (int ni = 0; ni < NI; ++ni) acc[mi][ni] = __builtin_amdgcn_mfma_f32_16x16x32_bf16(bfr[ni], af[mi], acc[mi][ni], 0, 0, 0);
            }
        };
        stage3(0, 0);
        stage3(1, 1);
        int b3 = 0;
        for (int kt = 0; kt < KT; ++kt) {
            if (kt + 1 < KT) { if constexpr (BN == 256) asm volatile("s_waitcnt vmcnt(6)" ::: "memory"); else asm volatile("s_waitcnt vmcnt(4)" ::: "memory"); }
            else asm volatile("s_waitcnt vmcnt(0)" ::: "memory");
            asm volatile("s_waitcnt lgkmcnt(0)" ::: "memory");
            __builtin_amdgcn_s_barrier();
            asm volatile("" ::: "memory");
            const int bn = (b3 == 0) ? 2 : b3 - 1;
            if (kt + 2 < KT) stage3(kt + 2, bn);
            compute3(b3);
            b3 = (b3 == 2) ? 0 : b3 + 1;
        }
        asm volatile("s_waitcnt lgkmcnt(0)" ::: "memory");
        __builtin_amdgcn_s_barrier();
        asm volatile("" ::: "memory");
    } else {
        stage(0, 0);
        commit(0);
        asm volatile("s_waitcnt vmcnt(0)" ::: "memory");
        __syncthreads();
        for (int kt = 0; kt < KT; ++kt) {
            const int cur = kt & 1;
            const bool more = (kt + 1 < KT);
            if (more) stage(kt + 1, cur ^ 1);
            compute(cur);
            if (more) commit(cur ^ 1);
            asm volatile("s_waitcnt vmcnt(0)" ::: "memory");
            __syncthreads();
        }
    }
    ep(acc, m0, wm, wn, fr, fq);
}

struct ALoadPlain {
    static constexpr bool DMA = true;
    const bf16_t* A; int lda;
    DEV uint4 load(int R, int k) const { return *(const uint4*)(A + (size_t)R * lda + k); }
};
struct ALoadMix {
    static constexpr bool DMA = false;
    const bf16_t* h; const float* mix; const bf16_t* A; int lda;
    DEV uint4 load(int R, int k) const {
        const bf16_t* pc = h + (size_t)R * 1024 + k;
        const uint4 c = *(const uint4*)pc;
        const int t = (R < NL) ? (R & 8191) : ((R - NL) & 255);
        const int last = (R < NL) ? 8191 : 255;
        uint4 pv = *(const uint4*)(pc - (t != 0 ? 1024 : 0)), nv = *(const uint4*)(pc + (t != last ? 1024 : 0));
        if (t == 0) pv = make_uint4(0, 0, 0, 0);
        if (t == last) nv = make_uint4(0, 0, 0, 0);
        const float4 m0 = *(const float4*)(mix + k), m1 = *(const float4*)(mix + k + 4);
        const unsigned cc[4] = {c.x, c.y, c.z, c.w}, pp[4] = {pv.x, pv.y, pv.z, pv.w}, nn[4] = {nv.x, nv.y, nv.z, nv.w};
        const float mm[8] = {m0.x, m0.y, m0.z, m0.w, m1.x, m1.y, m1.z, m1.w};
        unsigned o[4];
#pragma unroll
        for (int i = 0; i < 4; ++i) {
            const float hc0 = bf_lo(cc[i]), hc1 = bf_hi(cc[i]);
            const float s0 = 0.5f * (bf_lo(pp[i]) + bf_lo(nn[i])), s1 = 0.5f * (bf_hi(pp[i]) + bf_hi(nn[i]));
            o[i] = pk_bf16(hc0 + (s0 - hc0) * mm[2 * i], hc1 + (s1 - hc1) * mm[2 * i + 1]);
        }
        return make_uint4(o[0], o[1], o[2], o[3]);
    }
};

struct TrJob { int in_idx, src_off, K, N, src_ld, dst_ld; unsigned long long dst_off; int tile0; };
constexpr int NTRJOBS = 19;
__device__ const TrJob g_trjobs[NTRJOBS] = {
    {9, 0 * 1048576, 1024, 1024, 1024, 1024, WS_WPROJ + 0ull * 1024 * 1024 * 2, 0},
    {9, 1 * 1048576, 1024, 1024, 1024, 1024, WS_WPROJ + 1ull * 1024 * 1024 * 2, 256},
    {9, 2 * 1048576, 1024, 1024, 1024, 1024, WS_WPROJ + 2ull * 1024 * 1024 * 2, 512},
    {11, 0, 1024, 64, 64, 1024, WS_WPROJ + 3072ull * 1024 * 2, 768},
    {11, 65536, 1024, 64, 64, 1024, WS_WPROJ + 3136ull * 1024 * 2, 784},
    {14, 0, 1024, 64, 64, 1024, WS_WPROJ + 3200ull * 1024 * 2, 800},
    {14, 65536, 1024, 64, 64, 1024, WS_WPROJ + 3264ull * 1024 * 2, 816},
    {16, 0, 1024, 128, 128, 1024, WS_WPROJ + 3328ull * 1024 * 2, 832},
    {12, 0, 64, 1024, 1024, 64, WS_W2T, 864},
    {12, 65536, 64, 1024, 1024, 64, WS_W2T + 1024ull * 64 * 2, 880},
    {15, 0, 64, 1024, 1024, 64, WS_A2T, 896},
    {15, 65536, 64, 1024, 1024, 64, WS_A2T + 1024ull * 64 * 2, 912},
    {17, 0, 128, 1024, 1024, 128, WS_G2T, 928},
    {23, 0, 1024, 1024, 1024, 1024, WS_WO0, 960},
    {29, 0, 1024, 1024, 1024, 1024, WS_WO1, 1216},
    {30, 0, 1024, 2048, 2048, 1024, WS_WQ, 1472},
    {30, 2097152, 1024, 2048, 2048, 1024, WS_WQ + 2048ull * 1024 * 2, 1984},
    {24, 0, 1024, 3104, 3104, 1024, WS_WIN, 2496},
    {0, 0, 0, 0, 0, 0, 0, 2496 + 16 * 49},
};
constexpr int NTRTILES = 2496 + 16 * 49;

DEV void phase0(const Params& p, unsigned char* lds) {
    const int tid = tid_opaque();
    unsigned char* ws = p.ws;
    {
        float* sc = (float*)lds;
        float* red = sc + 9 * 1024;
        float* mods = (float*)(ws + WS_MOD);
        bool have_sc = false;
        for (int task = blockIdx.x; task < 192; task += gridDim.x) {
            if (!have_sc) {
                for (int i = tid; i < 9 * 1024; i += NTHREADS) {
                    const int mb = i >> 10, k = i & 1023;
                    const float cv = mb < 8 ? p.in[1][mb * 1024 + k] : p.in[3][k];
                    sc[i] = cv / (1.0f + __expf(-cv));
                }
                have_sc = true;
            }
            __syncthreads();
            const int l = task / 96, nb = task % 96;
            const int nn = tid & 63, kg = tid >> 6;
            const float* w = p.in[4] + (size_t)l * 1024 * 6144 + nb * 64 + nn;
            float acc[9];
#pragma unroll
            for (int m = 0; m < 9; ++m) acc[m] = 0.f;
            for (int k = kg * 128; k < kg * 128 + 128; ++k) {
                const float wv = w[(size_t)k * 6144];
#pragma unroll
                for (int m = 0; m < 9; ++m) acc[m] += sc[m * 1024 + k] * wv;
            }
#pragma unroll
            for (int m = 0; m < 9; ++m) red[(kg * 9 + m) * 64 + nn] = acc[m];
            __syncthreads();
            for (int i = tid; i < 576; i += NTHREADS) {
                const int m = i >> 6, n2 = i & 63;
                float s = p.in[5][l * 6144 + nb * 64 + n2];
#pragma unroll
                for (int g = 0; g < 8; ++g) s += red[(g * 9 + m) * 64 + n2];
                mods[(size_t)(l * 9 + m) * 6144 + nb * 64 + n2] = s;
            }
            __syncthreads();
        }
        __syncthreads();
    }
    {
        float* tile = (float*)lds;
        for (int tt = blockIdx.x; tt < NTRTILES; tt += gridDim.x) {
            int j = 0;
#pragma unroll 1
            while (j + 1 < NTRJOBS && g_trjobs[j + 1].tile0 <= tt) ++j;
            const TrJob jb = g_trjobs[j];
            const int tl = tt - jb.tile0;
            const int ntn = (jb.N + 63) >> 6;
            const int k0 = (tl / ntn) * 64, n0 = (tl % ntn) * 64;
            const float* src = p.in[jb.in_idx] + jb.src_off;
            bf16_t* dst = (bf16_t*)(ws + jb.dst_off);
            {
                const int kr = tid >> 4, nc4 = (tid & 15) * 4;
#pragma unroll
                for (int i = 0; i < 2; ++i) {
                    const int kk = kr + 32 * i;
                    float4 v = make_float4(0.f, 0.f, 0.f, 0.f);
                    if (n0 + nc4 < jb.N) v = *(const float4*)(src + (size_t)(k0 + kk) * jb.src_ld + n0 + nc4);
                    tile[kk * 65 + nc4 + 0] = v.x; tile[kk * 65 + nc4 + 1] = v.y; tile[kk * 65 + nc4 + 2] = v.z; tile[kk * 65 + nc4 + 3] = v.w;
                }
            }
            __syncthreads();
            {
                const int nn = tid >> 3, kc = (tid & 7) * 8;
                if (n0 + nn < jb.N) {
                    unsigned o[4];
#pragma unroll
                    for (int i = 0; i < 4; ++i) o[i] = pk_bf16(tile[(kc + 2 * i) * 65 + nn], tile[(kc + 2 * i + 1) * 65 + nn]);
                    *(uint4*)(dst + (size_t)(n0 + nn) * jb.dst_ld + k0 + kc) = make_uint4(o[0], o[1], o[2], o[3]);
                }
            }
            __syncthreads();
        }
    }
    {
        const size_t gtid = (size_t)blockIdx.x * NTHREADS + tid, gstride = (size_t)gridDim.x * NTHREADS;
        {
            const float* src = p.in[31];
            bf16_t* dst = (bf16_t*)(ws + WS_KEYS);
            const size_t n8 = (size_t)2 * 8 * 2 * 128 * 128 / 8;
            for (size_t i = gtid; i < n8; i += gstride) {
                const float4 a = *(const float4*)(src + i * 8), b = *(const float4*)(src + i * 8 + 4);
                *(uint4*)(dst + i * 8) = make_uint4(pk_bf16(a.x, a.y), pk_bf16(a.z, a.w), pk_bf16(b.x, b.y), pk_bf16(b.z, b.w));
            }
        }
        bf16_t* wpad = (bf16_t*)(ws + WS_WIN) + (size_t)3104 * 1024;
        for (size_t i = gtid; i < (size_t)96 * 1024 / 8; i += gstride) *(uint4*)(wpad + i * 8) = make_uint4(0, 0, 0, 0);
        const int lane = tid & 63;
        const int gw = blockIdx.x * 8 + (tid >> 6), nw = gridDim.x * 8;
        float* scales = (float*)(ws + WS_PSC);
        for (int rowi = gw * 32; rowi < 2 * 32768; rowi += nw * 32)
        for (int row2 = rowi; row2 < rowi + 32; row2 += 4) {
            float4 v[4][4]; float am[4];
#pragma unroll
            for (int q = 0; q < 4; ++q) {
                const int row = row2 + q, tbl = row >> 15, r = row & 32767;
                const float* srow = p.in[32 + tbl] + (size_t)r * 1024;
                am[q] = 0.f;
#pragma unroll
                for (int i = 0; i < 4; ++i) { v[q][i] = *(const float4*)(srow + 16 * lane + 4 * i); am[q] = fmaxf(am[q], fmaxf(fmaxf(fabsf(v[q][i].x), fabsf(v[q][i].y)), fmaxf(fabsf(v[q][i].z), fabsf(v[q][i].w)))); }
            }
#pragma unroll
            for (int o = 1; o < 64; o <<= 1) { const float a0 = __shfl_xor(am[0], o), a1 = __shfl_xor(am[1], o), a2 = __shfl_xor(am[2], o), a3 = __shfl_xor(am[3], o); am[0] = fmaxf(am[0], a0); am[1] = fmaxf(am[1], a1); am[2] = fmaxf(am[2], a2); am[3] = fmaxf(am[3], a3); }
#pragma unroll
            for (int q = 0; q < 4; ++q) {
                const int row = row2 + q, tbl = row >> 15, r = row & 32767;
                const float scale = am[q] > 0.f ? am[q] * (1.0f / 448.0f) : 1.0f;
                const float inv = 1.0f / scale;
                unsigned w[4];
#pragma unroll
                for (int i = 0; i < 4; ++i) {
                    int t = 0;
                    t = __builtin_amdgcn_cvt_pk_fp8_f32(v[q][i].x * inv, v[q][i].y * inv, t, false);
                    t = __builtin_amdgcn_cvt_pk_fp8_f32(v[q][i].z * inv, v[q][i].w * inv, t, true);
                    w[i] = (unsigned)t;
                }
                *(uint4*)(ws + (tbl ? WS_PV : WS_PU) + ((size_t)(r >> 14) * 8 + (lane >> 3)) * (16384 * 128) + (size_t)(r & 16383) * 128 + 16 * (lane & 7)) = make_uint4(w[0], w[1], w[2], w[3]);
                if (lane == 0) scales[tbl * 32768 + r] = scale;
            }
        }
    }
}

DEV void normmod_store(const float4 (&v)[4], float ss, const float* g, const float* shift, const float* scale, bf16_t* dst, unsigned char* xq, int lane) {
    const float rs = rsqrtf(ss * (1.0f / 1024.0f) + 1e-6f);
#pragma unroll
    for (int i = 0; i < 4; ++i) {
        const int col = i * 256 + lane * 4;
        const float4 gg = *(const float4*)(g + col), sh = *(const float4*)(shift + col), sc = *(const float4*)(scale + col);
        const float y0 = v[i].x * rs * gg.x * (1.f + sc.x) + sh.x, y1 = v[i].y * rs * gg.y * (1.f + sc.y) + sh.y;
        const float y2 = v[i].z * rs * gg.z * (1.f + sc.z) + sh.z, y3 = v[i].w * rs * gg.w * (1.f + sc.w) + sh.w;
        *(uint2*)(dst + col) = make_uint2(pk_bf16(y0, y1), pk_bf16(y2, y3));
        if (xq) {
            const float z0 = __builtin_amdgcn_fmed3f(4.f * y0, -448.f, 448.f), z1 = __builtin_amdgcn_fmed3f(4.f * y1, -448.f, 448.f);
            const float z2 = __builtin_amdgcn_fmed3f(4.f * y2, -448.f, 448.f), z3 = __builtin_amdgcn_fmed3f(4.f * y3, -448.f, 448.f);
            int hi = __builtin_amdgcn_cvt_pk_fp8_f32(z0, z1, 0, false); hi = __builtin_amdgcn_cvt_pk_fp8_f32(z2, z3, hi, true);
            const f32x2v h01 = __builtin_amdgcn_cvt_pk_f32_fp8(hi, false), h23 = __builtin_amdgcn_cvt_pk_f32_fp8(hi, true);
            int lo = __builtin_amdgcn_cvt_pk_fp8_f32(z0 - h01.x, z1 - h01.y, 0, false); lo = __builtin_amdgcn_cvt_pk_fp8_f32(z2 - h23.x, z3 - h23.y, lo, true);
            *(int*)(xq + col) = hi; *(int*)(xq + 1024 + col) = lo;
        }
    }
}
DEV void phase_normmod(const Params& p, int layer, int which, const float* xl, const float* xc, int nrows, bf16_t* dst, unsigned char* xq) {
    const int tid = tid_opaque(), lane = tid & 63;
    const int gw = blockIdx.x * 8 + (tid >> 6), nw = gridDim.x * 8;
    const float* mods = (const float*)(p.ws + WS_MOD) + (size_t)layer * 9 * 6144;
    const float* g = p.in[which ? 7 : 6] + layer * 1024;
    for (int R = gw; R < nrows; R += nw) {
        const float* xr = R < NL ? xl + (size_t)R * 1024 : xc + (size_t)(R - NL) * 1024;
        float4 v[4]; float ss = 0.f;
#pragma unroll
        for (int i = 0; i < 4; ++i) { v[i] = *(const float4*)(xr + i * 256 + lane * 4); ss += v[i].x * v[i].x + v[i].y * v[i].y + v[i].z * v[i].z + v[i].w * v[i].w; }
        ss = wave_allreduce(ss);
        const float* mrow = mods + (size_t)mod_batch(R) * 6144 + (which ? 3 : 0) * 1024;
        normmod_store(v, ss, g, mrow, mrow + 1024, dst + (size_t)R * 1024, xq ? xq + (size_t)R * 2048 : nullptr, lane);
    }
}
DEV void phase_normmix(const Params& p, bf16_t* hdst, bf16_t* xr, bf16_t* xk, bf16_t* xv) {
    const int tid = tid_opaque(), lane = tid & 63;
    const int gw = __builtin_amdgcn_readfirstlane(blockIdx.x * 8 + (tid >> 6)), nw = gridDim.x * 8;
    const float* mods = (const float*)(p.ws + WS_MOD);
    const float* g = p.in[6];
    for (int run = gw; run < NT / 8; run += nw) {
        const int R0 = run * 8;
        const int t0 = R0 < NL ? (R0 & 8191) : ((R0 - NL) & 255), slen = R0 < NL ? 8192 : 256;
        const float* mrow = mods + (size_t)mod_batch(R0) * 6144;
        float4 gg[4], sh[4], sc[4], m0[4], m2[4], m3[4];
#pragma unroll
        for (int i = 0; i < 4; ++i) {
            const int col = i * 256 + lane * 4;
            gg[i] = *(const float4*)(g + col); sh[i] = *(const float4*)(mrow + col); sc[i] = *(const float4*)(mrow + 1024 + col);
            m0[i] = *(const float4*)(p.in[8] + col); m2[i] = *(const float4*)(p.in[8] + 2 * 1024 + col); m3[i] = *(const float4*)(p.in[8] + 3 * 1024 + col);
        }
        auto hrow = [&](int R, float4 (&h)[4]) {
            const float* xrw = R < NL ? p.in[0] + (size_t)R * 1024 : p.in[2] + (size_t)(R - NL) * 1024;
            float ss = 0.f;
#pragma unroll
            for (int i = 0; i < 4; ++i) { h[i] = *(const float4*)(xrw + i * 256 + lane * 4); ss += h[i].x * h[i].x + h[i].y * h[i].y + h[i].z * h[i].z + h[i].w * h[i].w; }
            ss = wave_allreduce(ss);
            const float rs = rsqrtf(ss * (1.0f / 1024.0f) + 1e-6f);
#pragma unroll
            for (int i = 0; i < 4; ++i) {
                h[i].x = h[i].x * rs * gg[i].x * (1.f + sc[i].x) + sh[i].x; h[i].y = h[i].y * rs * gg[i].y * (1.f + sc[i].y) + sh[i].y;
                h[i].z = h[i].z * rs * gg[i].z * (1.f + sc[i].z) + sh[i].z; h[i].w = h[i].w * rs * gg[i].w * (1.f + sc[i].w) + sh[i].w;
            }
        };
        float4 hp[4], hc[4], hn[4];
        if (t0 > 0) hrow(R0 - 1, hp); else { hp[0] = hp[1] = hp[2] = hp[3] = make_float4(0.f, 0.f, 0.f, 0.f); }
        hrow(R0, hc);
#pragma unroll 1
        for (int i8 = 0; i8 < 8; ++i8) {
            const int R = R0 + i8;
            if (t0 + i8 + 1 < slen) hrow(R + 1, hn); else { hn[0] = hn[1] = hn[2] = hn[3] = make_float4(0.f, 0.f, 0.f, 0.f); }
#pragma unroll
            for (int i = 0; i < 4; ++i) {
                const size_t o = (size_t)R * 1024 + i * 256 + lane * 4;
                const float4 c = hc[i];
                const float4 xx = make_float4(0.5f * (hp[i].x + hn[i].x) - c.x, 0.5f * (hp[i].y + hn[i].y) - c.y, 0.5f * (hp[i].z + hn[i].z) - c.z, 0.5f * (hp[i].w + hn[i].w) - c.w);
                *(uint2*)(hdst + o) = make_uint2(pk_bf16(c.x, c.y), pk_bf16(c.z, c.w));
                *(uint2*)(xr + o) = make_uint2(pk_bf16(c.x + xx.x * m0[i].x, c.y + xx.y * m0[i].y), pk_bf16(c.z + xx.z * m0[i].z, c.w + xx.w * m0[i].w));
                *(uint2*)(xk + o) = make_uint2(pk_bf16(c.x + xx.x * m2[i].x, c.y + xx.y * m2[i].y), pk_bf16(c.z + xx.z * m2[i].z, c.w + xx.w * m2[i].w));
                *(uint2*)(xv + o) = make_uint2(pk_bf16(c.x + xx.x * m3[i].x, c.y + xx.y * m3[i].y), pk_bf16(c.z + xx.z * m3[i].z, c.w + xx.w * m3[i].w));
            }
#pragma unroll
            for (int i = 0; i < 4; ++i) { hp[i] = hc[i]; hc[i] = hn[i]; }
        }
    }
}

template <int BN> struct EpiBf16 {
    bf16_t* dst; int ldd; int col0; int act;
    DEV void operator()(const f32x4 (&acc)[4][BN / 64], int m0, int wm, int wn, int fr, int fq) const {
#pragma unroll
        for (int mi = 0; mi < 4; ++mi) {
            const size_t R = (size_t)(m0 + wm * 64 + mi * 16 + fr);
#pragma unroll
            for (int ni = 0; ni < BN / 64; ++ni) {
                const int col = col0 + wn * (BN / 4) + ni * 16 + 4 * fq;
                float v[4] = {acc[mi][ni][0], acc[mi][ni][1], acc[mi][ni][2], acc[mi][ni][3]};
                if (act == 1) {
#pragma unroll
                    for (int j = 0; j < 4; ++j) v[j] = tanhf(v[j]);
                } else if (act == 2) {
#pragma unroll
                    for (int j = 0; j < 4; ++j) v[j] = sigmoidf_(v[j]);
                }
                *(uint2*)(dst + R * ldd + col) = make_uint2(pk_bf16(v[0], v[1]), pk_bf16(v[2], v[3]));
            }
        }
    }
};
struct EpiResid {
    const float* xold_lat; const float* xold_ctx; float* dst_lat; float* dst_ctx; const float* gate; int col0;
    DEV void operator()(const f32x4 (&acc)[4][4], int m0, int wm, int wn, int fr, int fq) const {
#pragma unroll
        for (int mi = 0; mi < 4; ++mi) {
            const int R = m0 + wm * 64 + mi * 16 + fr;
            const float* src = R < NL ? xold_lat + (size_t)R * 1024 : xold_ctx + (size_t)(R - NL) * 1024;
            float* dst = R < NL ? dst_lat + (size_t)R * 1024 : dst_ctx + (size_t)(R - NL) * 1024;
            const float* gr = gate + (size_t)mod_batch(R) * 6144;
#pragma unroll
            for (int ni = 0; ni < 4; ++ni) {
                const int col = col0 + wn * 64 + ni * 16 + 4 * fq;
                const float4 xo = *(const float4*)(src + col), g4 = *(const float4*)(gr + col);
                *(float4*)(dst + col) = make_float4(xo.x + g4.x * acc[mi][ni][0], xo.y + g4.y * acc[mi][ni][1], xo.z + g4.z * acc[mi][ni][2], xo.w + g4.w * acc[mi][ni][3]);
            }
        }
    }
};
struct EpiLr {
    float* dst;
    DEV void operator()(const f32x4 (&acc)[4][2], int m0, int wm, int wn, int fr, int fq) const {
        if (wn != 0) return;
#pragma unroll
        for (int mi = 0; mi < 4; ++mi) {
            const size_t R = (size_t)(m0 + wm * 64 + mi * 16 + fr);
#pragma unroll
            for (int ni = 0; ni < 2; ++ni) { const int col = ni * 16 + 4 * fq; *(float4*)(dst + R * 32 + col) = make_float4(acc[mi][ni][0], acc[mi][ni][1], acc[mi][ni][2], acc[mi][ni][3]); }
        }
    }
};

namespace pg8 {
#define PG8_LAS __attribute__((address_space(3)))
constexpr int BM = 256, BK = 64, HALF = 128, HTB = HALF * BK * 2  , STAGE_BYTES = 8 * HTB, NXCD = 8, WGM = 8;

__host__ __device__ __forceinline__ int lds_byte(int r, int c) { const int st = (r >> 4) * 2 + (c >> 5), rr = r & 15, cc = c & 31, ob = rr * 64 + cc * 2; return st * 1024 + (ob ^ (((ob >> 9) & 1) << 5)); }
__host__ __device__ __forceinline__ void stage_rc(int b, int& R, int& C) { const int st = b / 1024, sb = b % 1024, swz = sb ^ (((sb >> 9) & 1) << 5); R = (st >> 1) * 16 + swz / 64; C = (st & 1) * 32 + (swz % 64) / 2; }
__host__ __device__ __forceinline__ int perm32(int rho) { const int n = rho >> 4, i = rho & 15; return 8 * (i >> 2) + 4 * n + (i & 3); }
struct Unit { int pm, pn; };
struct Gemm { const bf16_t* A; const bf16_t* Bt; int M, N, K; };
struct StaticOrder {
    int nM, nN, nwg, G, c;
    __host__ __device__ void init(int M, int N, int G_, int c_) { nM = M / BM; nN = N / BM; nwg = nM * nN; G = G_; c = c_; }
    __host__ __device__ bool next(int i, Unit& u) const {
        const long L = (long)i * G + c; if (L >= nwg) return false;
        int wgid = (int)L; { const int q = nwg / NXCD, r = nwg % NXCD, xcd = wgid % NXCD, off = wgid / NXCD; wgid = (xcd < r ? xcd * (q + 1) : r * (q + 1) + (xcd - r) * q) + off; }
        const int nig = WGM * nN, gid = wgid / nig, fm = gid * WGM, gsz = (nM - fm) < WGM ? (nM - fm) : WGM;
        u.pm = fm + ((wgid % nig) % gsz); u.pn = (wgid % nig) / gsz; return true;
    }
    __device__ __forceinline__ void a_ready(const Unit&) const {}
    __device__ __forceinline__ void done(const Unit&) const {}
};
template <class Epi, class Sched, bool STAMP = false>
__device__ __forceinline__ void gemm_phase(PG8_LAS unsigned char* lds, const Gemm g, const Sched& S, const Epi& E, unsigned long long* stamps) {
    const int tid = tid_opaque(), wid = __builtin_amdgcn_readfirstlane(tid >> 6), lane = tid & 63, wr = wid >> 2, wc = wid & 3, fr = lane & 15, fq = lane >> 4;
    const int K = g.K, nt = K / BK;
    int ts_lo = 0, ts_hi = 0, nts = 0; const unsigned long long rt_entry = STAMP ? (unsigned long long)wall_clock64() : 0ull;
#define PG8_STAMP() do { if (STAMP && wid == 0 && nts < 64) { const unsigned long long _c = (unsigned long long)clock64(); \
        ts_lo = (lane == nts) ? (int)(unsigned)_c : ts_lo; ts_hi = (lane == nts) ? (int)(unsigned)(_c >> 32) : ts_hi; ++nts; } } while (0)
    PG8_STAMP();
    unsigned voffA[2], voffB[2];
#pragma unroll
    for (int i = 0; i < 2; ++i) { int R, C; stage_rc(tid * 16 + i * 8192, R, C); const int Rb = Epi::PERM ? ((R & ~31) + perm32(R & 31)) : R;
        voffA[i] = (unsigned)(R * K + C) * 2u; voffB[i] = (unsigned)(Rb * K + C) * 2u; }
    const size_t kstep = (size_t)(BK * 2);
    const size_t hstep = (size_t)HALF * K * 2;
    const size_t tstep = 2 * hstep;
    const unsigned ldsw = (unsigned)wid * 1024u;
    const int aoff = lds_byte(wr * 64 + fr, fq * 8), boff = lds_byte(wc * 32 + fr, fq * 8);
#define PG8_SA(b, h) (((b) * 2 + (h)) * HTB)
#define PG8_SB(b, h) ((4 + (b) * 2 + (h)) * HTB)
#define PG8_STAGE(bufoff, gbase, voff) do { _Pragma("unroll") for (int _i = 0; _i < 2; ++_i) \
        __builtin_amdgcn_global_load_lds((const unsigned*)((const char*)(gbase) + (voff)[_i]), (PG8_LAS unsigned*)(lds + (bufoff) + ldsw + _i * 8192), 16, 0, 0); } while (0)
#define PG8_LDA(dst, b, h) do { _Pragma("unroll") for (int m = 0; m < 4; ++m) _Pragma("unroll") for (int k = 0; k < 2; ++k) dst[m][k] = *(const PG8_LAS bf16x8*)(lds + PG8_SA(b, h) + aoff + m * 2048 + k * 1024); } while (0)
#define PG8_LDB(dst, b, h) do { _Pragma("unroll") for (int n = 0; n < 2; ++n) _Pragma("unroll") for (int k = 0; k < 2; ++k) dst[n][k] = *(const PG8_LAS bf16x8*)(lds + PG8_SB(b, h) + boff + n * 2048 + k * 1024); } while (0)
#define PG8_MMA(ai, bj, At, Bt) do { __builtin_amdgcn_s_setprio(1); _Pragma("unroll") for (int m = 0; m < 4; ++m) _Pragma("unroll") for (int n = 0; n < 2; ++n) _Pragma("unroll") for (int k = 0; k < 2; ++k) \
        acc[ai][bj][m][n] = __builtin_amdgcn_mfma_f32_16x16x32_bf16(Bt[n][k], At[m][k], acc[ai][bj][m][n], 0, 0, 0); __builtin_amdgcn_s_setprio(0); } while (0)
#define PG8_WAIT_V(n) asm volatile("s_waitcnt vmcnt(" #n ")" ::: "memory")
#define PG8_WAIT_L(n) asm volatile("s_waitcnt lgkmcnt(" #n ")" ::: "memory")
#define PG8_BAR __builtin_amdgcn_s_barrier()
#define PG8_SCHED __builtin_amdgcn_sched_barrier(0)
    Unit cur, nxt; int ui = 0;
    if (!S.next(0, cur)) return;
    f32x4 acc[2][2][4][2];
#pragma unroll
    for (int a = 0; a < 2; ++a)
#pragma unroll
        for (int b = 0; b < 2; ++b)
#pragma unroll
            for (int m = 0; m < 4; ++m)
#pragma unroll
                for (int n = 0; n < 2; ++n) acc[a][b][m][n] = (f32x4){0.f, 0.f, 0.f, 0.f};
    bf16x8 At[4][2], B0[2][2], B1[2][2];
    const char* cA = (const char*)g.A + (size_t)cur.pm * tstep; const char* cB = (const char*)g.Bt + (size_t)cur.pn * tstep;
    S.a_ready(cur);
    PG8_STAGE(PG8_SB(0, 0), cB, voffB); PG8_STAGE(PG8_SA(0, 0), cA, voffA); PG8_STAGE(PG8_SB(0, 1), cB + hstep, voffB); PG8_STAGE(PG8_SA(0, 1), cA + hstep, voffA);
    if (wr == 1) PG8_BAR;
    PG8_WAIT_V(4); PG8_BAR;
    PG8_STAGE(PG8_SB(1, 0), cB + kstep, voffB); PG8_STAGE(PG8_SA(1, 0), cA + kstep, voffA); PG8_STAGE(PG8_SB(1, 1), cB + hstep + kstep, voffB);
    PG8_WAIT_V(6); PG8_BAR;
    PG8_STAMP();
    for (;;) {
        const bool has_next = S.next(ui + 1, nxt);
        const char* nA = has_next ? (const char*)g.A + (size_t)nxt.pm * tstep : cA; const char* nB = has_next ? (const char*)g.Bt + (size_t)nxt.pn * tstep : cB;
        for (int t = 0; t < nt; t += 2) {
            const bool last = (t == nt - 2);
            const char* a1 = cA + (size_t)(t + 1) * kstep;
            const char* a2 = last ? nA : cA + (size_t)(t + 2) * kstep; const char* b2 = last ? nB : cB + (size_t)(t + 2) * kstep;
            const char* a3 = a2 + kstep; const char* b3 = b2 + kstep;
            if (last && has_next) S.a_ready(nxt);
            PG8_LDB(B0, 0, 0); PG8_SCHED; PG8_LDA(At, 0, 0); PG8_STAGE(PG8_SA(1, 1), a1 + hstep, voffA);
            PG8_WAIT_L(8); PG8_BAR; PG8_WAIT_L(0); PG8_MMA(0, 0, At, B0); PG8_BAR; PG8_SCHED;
            PG8_LDB(B1, 0, 1); PG8_STAGE(PG8_SB(0, 0), b2, voffB);
            PG8_BAR; PG8_WAIT_L(0); PG8_MMA(0, 1, At, B1); PG8_BAR;
            PG8_LDA(At, 0, 1); PG8_STAGE(PG8_SA(0, 0), a2, voffA);
            PG8_BAR; PG8_WAIT_L(0); PG8_MMA(1, 0, At, B0); PG8_BAR; PG8_SCHED;
            PG8_STAGE(PG8_SB(0, 1), b2 + hstep, voffB);
            PG8_WAIT_V(6); PG8_BAR; PG8_MMA(1, 1, At, B1); PG8_BAR;
            PG8_LDB(B0, 1, 0); PG8_SCHED; PG8_LDA(At, 1, 0); PG8_STAGE(PG8_SA(0, 1), a2 + hstep, voffA);
            PG8_WAIT_L(8); PG8_BAR; PG8_WAIT_L(0); PG8_MMA(0, 0, At, B0); PG8_BAR; PG8_SCHED;
            PG8_LDB(B1, 1, 1); PG8_STAGE(PG8_SB(1, 0), b3, voffB);
            PG8_BAR; PG8_WAIT_L(0); PG8_MMA(0, 1, At, B1); PG8_BAR;
            PG8_LDA(At, 1, 1); PG8_STAGE(PG8_SA(1, 0), a3, voffA);
            PG8_BAR; PG8_WAIT_L(0); PG8_MMA(1, 0, At, B0); PG8_BAR; PG8_SCHED;
            PG8_STAGE(PG8_SB(1, 1), b3 + hstep, voffB);
            PG8_WAIT_V(6); PG8_BAR; PG8_MMA(1, 1, At, B1); PG8_BAR;
        }
        PG8_STAMP();
        if constexpr (!Epi::AFTER_DRAIN) { E(acc, cur, wr, wc, fr, fq); S.done(cur); }
        PG8_STAMP();
        if (!has_next) break;
#pragma unroll
        for (int a = 0; a < 2; ++a)
#pragma unroll
            for (int b = 0; b < 2; ++b)
#pragma unroll
                for (int m = 0; m < 4; ++m)
#pragma unroll
                    for (int n = 0; n < 2; ++n) acc[a][b][m][n] = (f32x4){0.f, 0.f, 0.f, 0.f};
        cur = nxt; cA = nA; cB = nB; ++ui;
    }
    PG8_WAIT_V(0);
    if (wr == 0) PG8_BAR;
    PG8_BAR;
    if constexpr (Epi::AFTER_DRAIN) { E.fused(acc, cur, wr, wc, fr, fq, lds, wid, lane); S.done(cur); }
    PG8_STAMP();
    if (STAMP && wid == 0) { stamps[lane] = lane < nts ? (((unsigned long long)(unsigned)ts_hi << 32) | (unsigned)ts_lo) : 0ull;
        if (lane == 62) stamps[62] = rt_entry; if (lane == 63) stamps[63] = (unsigned long long)wall_clock64(); }
#undef PG8_STAMP
#undef PG8_SA
#undef PG8_SB
#undef PG8_STAGE
#undef PG8_LDA
#undef PG8_LDB
#undef PG8_MMA
#undef PG8_WAIT_V
#undef PG8_WAIT_L
#undef PG8_BAR
#undef PG8_SCHED
}
struct EpiBf16Tiles {
    static constexpr bool PERM = true, AFTER_DRAIN = false;
    bf16_t* d0; int ld0; int ntile0; bf16_t* d1; int ld1;
    __device__ __forceinline__ void operator()(const f32x4 (&acc)[2][2][4][2], const Unit& u, int wr, int wc, int fr, int fq) const {
        bf16_t* base = u.pn < ntile0 ? d0 : d1; const int ld = u.pn < ntile0 ? ld0 : ld1; const int colt = (u.pn < ntile0 ? u.pn : u.pn - ntile0) * BM;
        const int row0 = u.pm * BM + wr * 64 + fr, col0 = colt + wc * 32 + 8 * fq;
#pragma unroll
        for (int ai = 0; ai < 2; ++ai)
#pragma unroll
            for (int m = 0; m < 4; ++m) { bf16_t* rowp = base + (size_t)(row0 + ai * HALF + m * 16) * ld + col0;
#pragma unroll
                for (int bj = 0; bj < 2; ++bj) { const f32x4 v0 = acc[ai][bj][m][0], v1 = acc[ai][bj][m][1];
                    *(uint4*)(rowp + bj * HALF) = make_uint4(pk_bf16(v0[0], v0[1]), pk_bf16(v0[2], v0[3]), pk_bf16(v1[0], v1[1]), pk_bf16(v1[2], v1[3])); } }
    }
};
struct EpiResid256 {
    static constexpr bool PERM = false, AFTER_DRAIN = false;
    const float* xold_lat; const float* xold_ctx; float* dst_lat; float* dst_ctx; const float* gate;
    __device__ __forceinline__ void operator()(const f32x4 (&acc)[2][2][4][2], const Unit& u, int wr, int wc, int fr, int fq) const {
        const int row0 = u.pm * BM + wr * 64 + fr, col0 = u.pn * BM + wc * 32 + 4 * fq;
#pragma unroll
        for (int ai = 0; ai < 2; ++ai)
#pragma unroll
            for (int m = 0; m < 4; ++m) {
                const int R = row0 + ai * HALF + m * 16;
                const float* src = R < NL ? xold_lat + (size_t)R * 1024 : xold_ctx + (size_t)(R - NL) * 1024;
                float* dst = R < NL ? dst_lat + (size_t)R * 1024 : dst_ctx + (size_t)(R - NL) * 1024;
                const float* gr = gate + (size_t)mod_batch(R) * 6144;
#pragma unroll
                for (int bj = 0; bj < 2; ++bj)
#pragma unroll
                    for (int n = 0; n < 2; ++n) {
                        const int col = col0 + bj * HALF + n * 16;
                        const float4 xo = *(const float4*)(src + col), g4 = *(const float4*)(gr + col);
                        const f32x4 a = acc[ai][bj][m][n];
                        *(float4*)(dst + col) = make_float4(xo.x + g4.x * a[0], xo.y + g4.y * a[1], xo.z + g4.z * a[2], xo.w + g4.w * a[3]);
                    }
            }
    }
};
}

DEV void phase_rw_proj1(const Params& p, unsigned char* lds, int which, const bf16_t* A, bf16_t* dst) {
    pg8::Gemm g{A, (const bf16_t*)(p.ws + WS_WPROJ) + (size_t)which * 1024 * 1024, NT, 1024, 1024};
    pg8::StaticOrder so; so.init(NT, 1024, gridDim.x, blockIdx.x);
    pg8::EpiBf16Tiles ep{dst, 1024, 4, dst, 1024};
    pg8::gemm_phase((PG8_LAS unsigned char*)lds, g, so, ep, nullptr);
    __syncthreads();
}
DEV void phase_rw_lora(const Params& p, unsigned char* lds) {
    unsigned char* ws = p.ws;
    const bf16_t* h = (const bf16_t*)(ws + WS_S + 0 * U_BYTES);
    const bf16_t* wproj = (const bf16_t*)(ws + WS_WPROJ);
    const int nunits = (NT / 128) * 3;
    for (int u = blockIdx.x; u < nunits; u += gridDim.x) {
        const int mt = u / 3, lg = u % 3, m0 = mt * 128;
        const int mixid = lg == 0 ? 1 : (lg == 1 ? 4 : 5);
        ALoadMix al{h, p.in[8] + mixid * 1024, h, 1024};
        EpiBf16<128> ep{(bf16_t*)(ws + WS_S + 4 * U_BYTES), 384, lg * 128, lg == 0 ? 1 : (lg == 1 ? 0 : 2)};
        gemm_unit<128>(lds, al, wproj + (size_t)(3072 + lg * 128) * 1024, 1024, m0, ep);
    }
}

template <int N> DEV float dpp_shr0(float x) { return __int_as_float(__builtin_amdgcn_update_dpp(0, __float_as_int(x), 0x110 + N, 0xF, 0xF, true)); }
template <int CTRL> DEV float dpp_quad(float x) { return __int_as_float(__builtin_amdgcn_update_dpp(0, __float_as_int(x), CTRL, 0xF, 0xF, false)); }
DEV int tile_off(int row, int ch) { return row * 128 + ((ch ^ (row & 7)) << 4); }
DEV int tile_off2(int row, int ch) { return row * 128 + ((ch ^ ((row ^ (row >> 3)) & 7)) << 4); }
DEV void phase_rw_scan(const Params& p, unsigned char* lds) {
    const int tid = tid_opaque(), lane = tid & 63;
    const int wv = __builtin_amdgcn_readfirstlane(tid >> 6);
    const int fr = lane & 15, fq = lane >> 4;
    unsigned char* ws = p.ws;
    constexpr int SH = 0, SL = 8192, AT = 16384  , RT = 20480  , BT = 24576  , KT = 28672  , BKT = 32768  , UV = 49152  , NT = 65536  ;
    constexpr int MFA = 69632, MFK = 70656, X0 = 71680, VS = 75776  , PP = 83968, PM = 88064, PI = 92160, AA = 96256  ;
    constexpr int PL = 116736  , YB = 117760, LDS_END = 121856;
    const bf16_t* rbuf = (const bf16_t*)(ws + WS_S + 3 * U_BYTES);
    const bf16_t* kbuf = (const bf16_t*)(ws + WS_S + 5 * U_BYTES);
    const bf16_t* vbuf = (const bf16_t*)(ws + WS_S + 1 * U_BYTES);
    const bf16_t* lora = (const bf16_t*)(ws + WS_S + 4 * U_BYTES);
    for (int unit = blockIdx.x; unit < 256; unit += gridDim.x) {
        const int b = unit >> 5, hh = (unit >> 1) & 15, d = unit & 1;
        bf16_t* ydst = (bf16_t*)(ws + WS_S + (size_t)(d ? 2 : 0) * U_BYTES);
        float* bonus = (float*)(ws + WS_BONUS) + (size_t)((d * NB + b) * 16 + hh) * 8448;
        const int s_e = (tid >> 4) & 15, j0 = (tid & 15) * 4;
        const int ni = wv & 3;
        auto Rof = [&](int c, int s) -> int {
            if (c < 16) { const int q = c * 16 + s; return NL + b * 256 + (d ? 255 - q : q); }
            const int q = (c - 16) * 16 + s; return b * 8192 + (d ? 8191 - q : q);
        };
        constexpr int CST = LDS_END;
        uint2 pr = make_uint2(0, 0), pk = pr, pv = pr; uint4 paw[2], paa[2];
        if (wv >= 4) {
            const int ct = (tid - 256) * 16;
            *(float4*)(lds + CST + 0 * 4096 + ct) = *(const float4*)(p.in[18] + hh * 64 + j0);
            *(float4*)(lds + CST + 1 * 4096 + ct) = *(const float4*)(p.in[19] + hh * 64 + j0);
            *(float4*)(lds + CST + 2 * 4096 + ct) = *(const float4*)(p.in[20] + hh * 64 + j0);
            *(float4*)(lds + CST + 3 * 4096 + ct) = *(const float4*)(p.in[10] + d * 1024 + hh * 64 + ni * 16 + fq * 4);
            *(float4*)(lds + CST + 4 * 4096 + ct) = *(const float4*)(p.in[13] + d * 1024 + hh * 64 + ni * 16 + fq * 4);
#pragma unroll
            for (int ks = 0; ks < 2; ++ks) {
                *(uint4*)(lds + CST + (5 + ks) * 4096 + ct) = *(const uint4*)((const bf16_t*)(ws + WS_W2T) + (size_t)d * 1024 * 64 + (size_t)(hh * 64 + ni * 16 + fr) * 64 + ks * 32 + fq * 8);
                *(uint4*)(lds + CST + (7 + ks) * 4096 + ct) = *(const uint4*)((const bf16_t*)(ws + WS_A2T) + (size_t)d * 1024 * 64 + (size_t)(hh * 64 + ni * 16 + fr) * 64 + ks * 32 + fq * 8);
            }
        }
        auto load_lora = [&](int c) {
            const size_t R2 = (size_t)Rof(c, fr);
#pragma unroll
            for (int ks = 0; ks < 2; ++ks) { paw[ks] = *(const uint4*)(lora + R2 * 384 + d * 64 + ks * 32 + fq * 8); paa[ks] = *(const uint4*)(lora + R2 * 384 + 128 + d * 64 + ks * 32 + fq * 8); }
        };
        auto load_rkv = [&](int c) {
            const size_t off = (size_t)Rof(c, s_e) * 1024 + hh * 64 + j0;
            pr = *(const uint2*)(rbuf + off); pk = *(const uint2*)(kbuf + off); pv = *(const uint2*)(vbuf + off);
        };
        auto step_up = [&](int c) {
            const int ct = (tid - 256) * 16;
            const float4 bias_w = *(const float4*)(lds + CST + 3 * 4096 + ct), bias_a = *(const float4*)(lds + CST + 4 * 4096 + ct);
            bf16x8 bfw[2], bfa[2];
#pragma unroll
            for (int ks = 0; ks < 2; ++ks) { bfw[ks] = *(const bf16x8*)(lds + CST + (5 + ks) * 4096 + ct); bfa[ks] = *(const bf16x8*)(lds + CST + (7 + ks) * 4096 + ct); }
            f32x4 accw = {0.f, 0.f, 0.f, 0.f}, acca = {0.f, 0.f, 0.f, 0.f};
#pragma unroll
            for (int ks = 0; ks < 2; ++ks) { accw = __builtin_amdgcn_mfma_f32_16x16x32_bf16(bfw[ks], as_bf16x8(paw[ks]), accw, 0, 0, 0); acca = __builtin_amdgcn_mfma_f32_16x16x32_bf16(bfa[ks], as_bf16x8(paa[ks]), acca, 0, 0, 0); }
            const int n = ni * 16 + fq * 4;
            const float bw[4] = {bias_w.x, bias_w.y, bias_w.z, bias_w.w}, ba[4] = {bias_a.x, bias_a.y, bias_a.z, bias_a.w};
            float P[4], Pm[4], Pi[4], av[4];
#pragma unroll
            for (int j = 0; j < 4; ++j) {
                const float e = 0.6065306597f * __builtin_amdgcn_rcpf(1.0f + __expf(-(accw[j] + bw[j])));
                float s = e;
                s += dpp_shr0<1>(s); s += dpp_shr0<2>(s); s += dpp_shr0<4>(s); s += dpp_shr0<8>(s);
                P[j] = __expf(-s); Pi[j] = __builtin_amdgcn_rcpf(P[j]); Pm[j] = P[j] * __expf(e);
                av[j] = __builtin_amdgcn_rcpf(1.0f + __expf(-(acca[j] + ba[j])));
            }
            const int pb = (c & 1) * 16384;
            *(float4*)(lds + PP + pb + (fr * 64 + n) * 4) = make_float4(P[0], P[1], P[2], P[3]);
            *(float4*)(lds + PM + pb + (fr * 64 + n) * 4) = make_float4(Pm[0], Pm[1], Pm[2], Pm[3]);
            *(float4*)(lds + PI + pb + (fr * 64 + n) * 4) = make_float4(Pi[0], Pi[1], Pi[2], Pi[3]);
            *(float4*)(lds + AA + pb + (fr * 64 + n) * 4) = make_float4(av[0], av[1], av[2], av[3]);
            if (fr == 15) *(float4*)(lds + PL + (c & 3) * 256 + n * 4) = make_float4(P[0], P[1], P[2], P[3]);
        };
        auto step_vec = [&](int c) {
            const int eo = (s_e * 64 + j0) * 4, pb = (c & 1) * 16384, tb = (c & 1) * 8192, ct = (tid - 256) * 16;
            const float4 kk_c = *(const float4*)(lds + CST + 0 * 4096 + ct), ka_c = *(const float4*)(lds + CST + 1 * 4096 + ct), rk_c = *(const float4*)(lds + CST + 2 * 4096 + ct);
            const float4 a4 = *(const float4*)(lds + AA + pb + eo), P4 = *(const float4*)(lds + PP + pb + eo), Pm4 = *(const float4*)(lds + PM + pb + eo), Pi4 = *(const float4*)(lds + PI + pb + eo);
            const float kx[4] = {bf_lo(pk.x), bf_hi(pk.x), bf_lo(pk.y), bf_hi(pk.y)};
            const float rx[4] = {bf_lo(pr.x), bf_hi(pr.x), bf_lo(pr.y), bf_hi(pr.y)};
            const float av[4] = {a4.x, a4.y, a4.z, a4.w}, Pv[4] = {P4.x, P4.y, P4.z, P4.w}, Pmv[4] = {Pm4.x, Pm4.y, Pm4.z, Pm4.w}, Piv[4] = {Pi4.x, Pi4.y, Pi4.z, Pi4.w};
            const float kkc[4] = {kk_c.x, kk_c.y, kk_c.z, kk_c.w}, kac[4] = {ka_c.x, ka_c.y, ka_c.z, ka_c.w}, rkc[4] = {rk_c.x, rk_c.y, rk_c.z, rk_c.w};
            float t[4], n2 = 0.f;
#pragma unroll
            for (int j = 0; j < 4; ++j) { t[j] = kx[j] * kkc[j]; n2 += t[j] * t[j]; }
            n2 = row16_allreduce(n2);
            const float inv = 1.0f / fmaxf(sqrtf(n2), 1e-12f);
            float at[4], bt[4], kt[4], rt[4], bon = 0.f;
#pragma unroll
            for (int j = 0; j < 4; ++j) {
                const float kkv = t[j] * inv;
                const float kd = kx[j] * (1.0f + (av[j] - 1.0f) * kac[j]);
                const float bq = kkv * av[j];
                bon += rx[j] * kd * rkc[j];
                at[j] = -kkv * Pmv[j]; bt[j] = bq * Piv[j]; kt[j] = kd * Piv[j]; rt[j] = rx[j] * Pv[j];
            }
            bon = row16_allreduce(bon);
            if ((tid & 15) == 0) { const int Rb = Rof(c, s_e); bonus[Rb < NL ? 256 + (Rb & 8191) : ((Rb - NL) & 255)] = bon; }
            const int ro = tile_off(s_e, j0 >> 3) + (j0 & 7) * 2;
            *(uint2*)(lds + AT + (c & 1) * 2048 + ro) = make_uint2(pk_bf16(at[0], at[1]), pk_bf16(at[2], at[3]));
            *(uint2*)(lds + RT + (c & 1) * 2048 + ro) = make_uint2(pk_bf16(rt[0], rt[1]), pk_bf16(rt[2], rt[3]));
            const unsigned b01 = pk_bf16(bt[0], bt[1]), b23 = pk_bf16(bt[2], bt[3]), k01 = pk_bf16(kt[0], kt[1]), k23 = pk_bf16(kt[2], kt[3]);
            *(uint2*)(lds + BT + (c & 1) * 2048 + ro) = make_uint2(b01, b23);
            *(uint2*)(lds + KT + (c & 1) * 2048 + ro) = make_uint2(k01, k23);
            const unsigned bw2[4] = {b01 & 0xffffu, b01 >> 16, b23 & 0xffffu, b23 >> 16}, kw2[4] = {k01 & 0xffffu, k01 >> 16, k23 & 0xffffu, k23 >> 16};
            const unsigned vw[4] = {pv.x & 0xffffu, pv.x >> 16, pv.y & 0xffffu, pv.y >> 16};
            const int e0 = (s_e & 7) * 2, cq = s_e >> 3;
#pragma unroll
            for (int j = 0; j < 4; ++j) {
                const int row = j0 + j;
                *(bf16_t*)(lds + BKT + tb + tile_off2(row, 0 + cq) + e0) = (bf16_t)bw2[j];
                *(bf16_t*)(lds + BKT + tb + tile_off2(row, 2 + cq) + e0) = (bf16_t)kw2[j];
                *(bf16_t*)(lds + BKT + tb + tile_off2(row, 4 + cq) + e0) = (bf16_t)bw2[j];
                *(bf16_t*)(lds + UV + tb + tile_off2(row, 2 + cq) + e0) = (bf16_t)vw[j];
            }
        };
        f32x4 accY = {0.f, 0.f, 0.f, 0.f};
        auto prod_S = [&](int c) {
            const int vt = wv & 3, tb = (c & 1) * 2048;
            f32x4 accX = {0.f, 0.f, 0.f, 0.f}, accR = {0.f, 0.f, 0.f, 0.f};
#pragma unroll
            for (int ks = 0; ks < 2; ++ks) {
                const int ch = ks * 4 + fq;
                const bf16x8 sh = *(const bf16x8*)(lds + SH + tile_off(vt * 16 + fr, ch)), sl = *(const bf16x8*)(lds + SL + tile_off(vt * 16 + fr, ch));
                const bf16x8 fa = *(const bf16x8*)(lds + AT + tb + tile_off(fr, ch)), frr = *(const bf16x8*)(lds + RT + tb + tile_off(fr, ch));
                accX = __builtin_amdgcn_mfma_f32_16x16x32_bf16(sh, fa, accX, 0, 0, 0);
                accR = __builtin_amdgcn_mfma_f32_16x16x32_bf16(sh, frr, accR, 0, 0, 0);
                accX = __builtin_amdgcn_mfma_f32_16x16x32_bf16(sl, fa, accX, 0, 0, 0);
                accR = __builtin_amdgcn_mfma_f32_16x16x32_bf16(sl, frr, accR, 0, 0, 0);
            }
            accY = accR;
            {
                const u32x2v av = *(const u32x2v*)(lds + UV + (c & 1) * 8192 + tile_off2(vt * 16 + fr, 2 + (fq >> 1)) + (fq & 1) * 8);
                const u32x2v mh = *(const u32x2v*)(lds + MFK + (fr * 4 + fq) * 8), ml = *(const u32x2v*)(lds + MFK + 512 + (fr * 4 + fq) * 8);
                accX = __builtin_amdgcn_mfma_f32_16x16x16bf16_1k(__builtin_bit_cast(s16x4v, av), __builtin_bit_cast(s16x4v, mh), accX, 0, 0, 0);
                accX = __builtin_amdgcn_mfma_f32_16x16x16bf16_1k(__builtin_bit_cast(s16x4v, av), __builtin_bit_cast(s16x4v, ml), accX, 0, 0, 0);
            }
#pragma unroll
            for (int j = 0; j < 4; ++j) *(float*)(lds + X0 + ((vt * 16 + 4 * fq + j) * 16 + fr) * 4) = accX[j];
        };
        auto prod_V = [&](int c) {
            const int tb = (c & 1) * 2048, w4 = wv & 3;
            f32x4 m = {0.f, 0.f, 0.f, 0.f};
#pragma unroll
            for (int ks = 0; ks < 2; ++ks) {
                const int ch = ks * 4 + fq;
                const bf16x8 fa = *(const bf16x8*)(lds + ((w4 & 1) ? KT : BT) + tb + tile_off(fr, ch));
                const bf16x8 fb = *(const bf16x8*)(lds + ((w4 & 2) ? RT : AT) + tb + tile_off(fr, ch));
                m = __builtin_amdgcn_mfma_f32_16x16x32_bf16(fa, fb, m, 0, 0, 0);
            }
            if (w4 == 0) {
                float* mf = (float*)(lds + MFA);
#pragma unroll
                for (int j = 0; j < 4; ++j) mf[(fr * 4 + j) * 4 + fq] = (4 * fq + j < fr) ? m[j] : 0.f;
            } else if (w4 == 1) {
                const float m0 = (4 * fq + 0 < fr) ? m[0] : 0.f, m1 = (4 * fq + 1 < fr) ? m[1] : 0.f, m2 = (4 * fq + 2 < fr) ? m[2] : 0.f, m3 = (4 * fq + 3 < fr) ? m[3] : 0.f;
                const unsigned h01 = pk_bf16(m0, m1), h23 = pk_bf16(m2, m3);
                *(uint2*)(lds + MFK + (fr * 4 + fq) * 8) = make_uint2(h01, h23);
                *(uint2*)(lds + MFK + 512 + (fr * 4 + fq) * 8) = make_uint2(pk_bf16(m0 - bf_lo(h01), m1 - bf_hi(h01)), pk_bf16(m2 - bf_lo(h23), m3 - bf_hi(h23)));
            } else {
                const float m0 = (4 * fq + 0 <= fr) ? m[0] : 0.f, m1 = (4 * fq + 1 <= fr) ? m[1] : 0.f, m2 = (4 * fq + 2 <= fr) ? m[2] : 0.f, m3 = (4 * fq + 3 <= fr) ? m[3] : 0.f;
                const uint2 o = make_uint2(pk_bf16(m0, m1), pk_bf16(m2, m3));
                const int colb = (w4 == 2 ? 0 : 16) + 4 * fq;
                *(uint2*)(lds + NT + tb + tile_off(fr, colb >> 3) + (colb & 7) * 2) = o;
                if (w4 == 2) *(uint2*)(lds + NT + tb + tile_off(fr, (32 + 4 * fq) >> 3) + ((32 + 4 * fq) & 7) * 2) = o;
            }
        };
        auto step_rec = [&](int c) {
            const int v = tid >> 2, pq = tid & 3;
            float cc[16];
#pragma unroll
            for (int i = 0; i < 4; ++i) { const float4 q = *(const float4*)(lds + X0 + (v * 16 + 4 * i) * 4); cc[4 * i] = q.x; cc[4 * i + 1] = q.y; cc[4 * i + 2] = q.z; cc[4 * i + 3] = q.w; }
            float4 ma[16];
#pragma unroll
            for (int t = 1; t < 16; ++t) ma[t] = *(const float4*)(lds + MFA + ((t * 4 + pq) * 4) * 4);
            ma[0] = make_float4(0.f, 0.f, 0.f, 0.f);
            float uown[4] = {0.f, 0.f, 0.f, 0.f}, uall[16];
#pragma unroll
            for (int t = 0; t < 16; ++t) {
                float s = uown[0] * ma[t].x; s = fmaf(uown[1], ma[t].y, s); s = fmaf(uown[2], ma[t].z, s); s = fmaf(uown[3], ma[t].w, s);
                s += dpp_quad<0xB1>(s); s += dpp_quad<0x4E>(s);
                const float u = cc[t] + s;
                uall[t] = u;
                if (pq == (t & 3)) uown[t >> 2] = u;
            }
            if (pq < 2) {
                unsigned o[8];
#pragma unroll
                for (int i = 0; i < 8; ++i) {
                    const unsigned hi = pk_bf16(uall[2 * i], uall[2 * i + 1]);
                    o[i] = pq ? pk_bf16(uall[2 * i] - bf_lo(hi), uall[2 * i + 1] - bf_hi(hi)) : hi;
                }
                const int cb = pq ? 4 : 0;
                *(uint4*)(lds + UV + (c & 1) * 8192 + tile_off2(v, cb)) = make_uint4(o[0], o[1], o[2], o[3]);
                *(uint4*)(lds + UV + (c & 1) * 8192 + tile_off2(v, cb + 1)) = make_uint4(o[4], o[5], o[6], o[7]);
            }
        };
        f32x4 accS[2];
        accS[0] = (f32x4){0.f, 0.f, 0.f, 0.f}; accS[1] = (f32x4){0.f, 0.f, 0.f, 0.f};
        auto step_upd = [&](int c) {
            const int vt = wv & 3;
            bf16x8 fuv[2];
#pragma unroll
            for (int ks = 0; ks < 2; ++ks) fuv[ks] = *(const bf16x8*)(lds + UV + (c & 1) * 8192 + tile_off2(vt * 16 + fr, ks * 4 + fq));
            if (wv < 4) {
#pragma unroll
                for (int ks = 0; ks < 2; ++ks) accY = __builtin_amdgcn_mfma_f32_16x16x32_bf16(fuv[ks], *(const bf16x8*)(lds + NT + (c & 1) * 2048 + tile_off(fr, ks * 4 + fq)), accY, 0, 0, 0);
                *(float4*)(lds + YB + (fr * 64 + vt * 16 + 4 * fq) * 4) = make_float4(accY[0], accY[1], accY[2], accY[3]);
            }
#pragma unroll
            for (int k2 = 0; k2 < 2; ++k2) {
                const int kt = 2 * (wv >> 2) + k2;
                f32x4 a = accS[k2];
#pragma unroll
                for (int ks = 0; ks < 2; ++ks) a = __builtin_amdgcn_mfma_f32_16x16x32_bf16(*(const bf16x8*)(lds + BKT + (c & 1) * 8192 + tile_off2(kt * 16 + fr, ks * 4 + fq)), fuv[ks], a, 0, 0, 0);
                const float4 pl = *(const float4*)(lds + PL + (c & 3) * 256 + (kt * 16 + 4 * fq) * 4);
                a[0] *= pl.x; a[1] *= pl.y; a[2] *= pl.z; a[3] *= pl.w;
                accS[k2] = a;
                const unsigned h01 = pk_bf16(a[0], a[1]), h23 = pk_bf16(a[2], a[3]);
                const unsigned l01 = pk_bf16(a[0] - bf_lo(h01), a[1] - bf_hi(h01)), l23 = pk_bf16(a[2] - bf_lo(h23), a[3] - bf_hi(h23));
                const int kc = kt * 16 + 4 * fq;
                const int so = tile_off(vt * 16 + fr, kc >> 3) + (kc & 7) * 2;
                *(uint2*)(lds + SH + so) = make_uint2(h01, h23);
                *(uint2*)(lds + SL + so) = make_uint2(l01, l23);
            }
        };
        for (int i = tid; i < LDS_END / 16; i += NTHREADS) *(uint4*)(lds + i * 16) = make_uint4(0, 0, 0, 0);
        if (wv >= 4) { load_lora(0); load_rkv(0); }
        __syncthreads();
        if (wv >= 4) { step_up(0); load_lora(1); }
        __syncthreads();
        if (wv >= 4) { step_vec(0); step_up(1); load_rkv(1); load_lora(2); }
        __syncthreads();
        if (wv >= 4) prod_V(0);
        __syncthreads();
        auto ystore = [&](int c) {
            const float4 y4 = *(const float4*)(lds + YB + (s_e * 64 + j0) * 4);
            *(uint2*)(ydst + (size_t)Rof(c, s_e) * 1024 + hh * 64 + j0) = make_uint2(pk_bf16(y4.x, y4.y), pk_bf16(y4.z, y4.w));
        };
        if (wv < 4) {
            unsigned pfd = 0;
            for (int c = 0; c < 528; ++c) {
                if (c > 0) ystore(c - 1);
                if (c + 4 < 528 && tid < 80) {
                    const bf16_t* pf;
                    if (tid < 48) { const int ten = tid >> 4; pf = (ten == 0 ? rbuf : (ten == 1 ? kbuf : vbuf)) + (size_t)Rof(c + 4, tid & 15) * 1024 + hh * 64; }
                    else { const int i = tid - 48; pf = lora + (size_t)Rof(c + 4, i >> 1) * 384 + (i & 1) * 128 + d * 64; }
                    asm volatile("global_load_dword %0, %1, off" : "=v"(pfd) : "v"(pf) : "memory");
                }
                __builtin_amdgcn_s_setprio(3);
                prod_S(c);
                step_rec(c);
                __builtin_amdgcn_s_setprio(0);
                __syncthreads();
                step_upd(c);
                __syncthreads();
                asm volatile("" :: "v"(pfd));
            }
        } else {
            for (int c = 0; c < 528; ++c) {
                if (c + 1 < 528) step_vec(c + 1);
                if (c + 2 < 528) { step_up(c + 2); load_rkv(c + 2); }
                if (c + 3 < 528) load_lora(c + 3);
                __syncthreads();
                step_upd(c);
                if (c + 1 < 528) prod_V(c + 1);
                __syncthreads();
            }
        }
        if (wv < 4) ystore(527);
        __syncthreads();
    }
}

DEV void phase_rw_readout(const Params& p) {
    const int tid = tid_opaque(), lane = tid & 63, wv = tid >> 6, wm = wv >> 2, wn = wv & 3;
    const int fr = lane & 15, fq = lane >> 4;
    unsigned char* ws = p.ws;
    const bf16_t* y0b = (const bf16_t*)(ws + WS_S + 0 * U_BYTES);
    const bf16_t* y1b = (const bf16_t*)(ws + WS_S + 2 * U_BYTES);
    const bf16_t* vb = (const bf16_t*)(ws + WS_S + 1 * U_BYTES);
    const bf16_t* lora = (const bf16_t*)(ws + WS_S + 4 * U_BYTES);
    const bf16_t* g2t = (const bf16_t*)(ws + WS_G2T);
    bf16_t* ao = (bf16_t*)(ws + WS_S + 5 * U_BYTES);
    const float* bon0 = (const float*)(ws + WS_BONUS);
    const float* bon1 = bon0 + (size_t)NB * 16 * 8448;
    const float* lnw = p.in[21];
    const float* lnb = p.in[22];
    const int nunits = (NT / 128) * 4;
    for (int u = blockIdx.x; u < nunits; u += gridDim.x) {
        const int mt = u >> 2, nt = u & 3, m0 = mt * 128;
        const int hh = nt * 4 + wn;
        f32x4 acc[4][4];
#pragma unroll
        for (int mi = 0; mi < 4; ++mi)
#pragma unroll
            for (int ni = 0; ni < 4; ++ni) acc[mi][ni] = (f32x4){0.f, 0.f, 0.f, 0.f};
#pragma unroll 2
        for (int ks = 0; ks < 4; ++ks) {
            bf16x8 af[4], bfr[4];
#pragma unroll
            for (int mi = 0; mi < 4; ++mi) af[mi] = *(const bf16x8*)(lora + (size_t)(m0 + wm * 64 + mi * 16 + fr) * 384 + 256 + ks * 32 + fq * 8);
#pragma unroll
            for (int ni = 0; ni < 4; ++ni) bfr[ni] = *(const bf16x8*)(g2t + (size_t)(hh * 64 + 16 * (fr >> 2) + 4 * ni + (fr & 3)) * 128 + ks * 32 + fq * 8);
#pragma unroll
            for (int mi = 0; mi < 4; ++mi)
#pragma unroll
                for (int ni = 0; ni < 4; ++ni) acc[mi][ni] = __builtin_amdgcn_mfma_f32_16x16x32_bf16(bfr[ni], af[mi], acc[mi][ni], 0, 0, 0);
        }
#pragma unroll
        for (int mi = 0; mi < 4; ++mi) {
            const size_t R = (size_t)(m0 + wm * 64 + mi * 16 + fr);
            float yv[4][4]; float sum = 0.f;
            const int colb = hh * 64 + 16 * fq;
            {
                const uint4 a0 = *(const uint4*)(y0b + R * 1024 + colb), a1 = *(const uint4*)(y0b + R * 1024 + colb + 8);
                const uint4 c0 = *(const uint4*)(y1b + R * 1024 + colb), c1 = *(const uint4*)(y1b + R * 1024 + colb + 8);
                const unsigned aw[8] = {a0.x, a0.y, a0.z, a0.w, a1.x, a1.y, a1.z, a1.w}, cw[8] = {c0.x, c0.y, c0.z, c0.w, c1.x, c1.y, c1.z, c1.w};
#pragma unroll
                for (int ni = 0; ni < 4; ++ni) {
                    yv[ni][0] = bf_lo(aw[2 * ni]) + bf_lo(cw[2 * ni]); yv[ni][1] = bf_hi(aw[2 * ni]) + bf_hi(cw[2 * ni]);
                    yv[ni][2] = bf_lo(aw[2 * ni + 1]) + bf_lo(cw[2 * ni + 1]); yv[ni][3] = bf_hi(aw[2 * ni + 1]) + bf_hi(cw[2 * ni + 1]);
                    sum += (yv[ni][0] + yv[ni][1]) + (yv[ni][2] + yv[ni][3]);
                }
            }
            sum += __shfl_xor(sum, 16); sum += __shfl_xor(sum, 32);
            const float mu = sum * (1.0f / 64.0f);
            float q = 0.f;
#pragma unroll
            for (int ni = 0; ni < 4; ++ni)
#pragma unroll
                for (int j = 0; j < 4; ++j) { const float dlt = yv[ni][j] - mu; q += dlt * dlt; }
            q += __shfl_xor(q, 16); q += __shfl_xor(q, 32);
            const float rstd = rsqrtf(q * (1.0f / 64.0f) + 64e-5f);
            const size_t bidx = (size_t)(((R < NL ? (R >> 13) : ((R - NL) >> 8)) * 16 + hh)) * 8448 + (R < NL ? 256 + (R & 8191) : ((R - NL) & 255));
            const float bs = bon0[bidx] + bon1[bidx];
            const uint4 v0 = *(const uint4*)(vb + R * 1024 + colb), v1 = *(const uint4*)(vb + R * 1024 + colb + 8);
            const unsigned vw[8] = {v0.x, v0.y, v0.z, v0.w, v1.x, v1.y, v1.z, v1.w};
            unsigned ow[8];
#pragma unroll
            for (int ni = 0; ni < 4; ++ni) {
                const int col = colb + 4 * ni;
                const float4 lw = *(const float4*)(lnw + col), lb = *(const float4*)(lnb + col);
                const float o0 = ((yv[ni][0] - mu) * rstd * lw.x + lb.x + bs * bf_lo(vw[2 * ni])) * acc[mi][ni][0];
                const float o1 = ((yv[ni][1] - mu) * rstd * lw.y + lb.y + bs * bf_hi(vw[2 * ni])) * acc[mi][ni][1];
                const float o2 = ((yv[ni][2] - mu) * rstd * lw.z + lb.z + bs * bf_lo(vw[2 * ni + 1])) * acc[mi][ni][2];
                const float o3 = ((yv[ni][3] - mu) * rstd * lw.w + lb.w + bs * bf_hi(vw[2 * ni + 1])) * acc[mi][ni][3];
                ow[2 * ni] = pk_bf16(o0, o1); ow[2 * ni + 1] = pk_bf16(o2, o3);
            }
            *(uint4*)(ao + R * 1024 + colb) = make_uint4(ow[0], ow[1], ow[2], ow[3]);
            *(uint4*)(ao + R * 1024 + colb + 8) = make_uint4(ow[4], ow[5], ow[6], ow[7]);
        }
    }
}

DEV void phase_wo(const Params& p, unsigned char* lds, int layer) {
    unsigned char* ws = p.ws;
    const bf16_t* ao = (const bf16_t*)(ws + WS_S + (size_t)(layer ? 0 : 5) * U_BYTES);
    const bf16_t* wot = (const bf16_t*)(ws + (layer ? WS_WO1 : WS_WO0));
    float* ctxr = (float*)(ws + WS_CTXR);
    const float* gate = (const float*)(ws + WS_MOD) + (size_t)layer * 9 * 6144 + 2 * 1024;
    const int M = layer ? NL : NT;
    pg8::Gemm g{ao, wot, M, 1024, 1024};
    pg8::StaticOrder so; so.init(M, 1024, gridDim.x, blockIdx.x);
    pg8::EpiResid256 ep{layer ? p.out : p.in[0], layer ? ctxr : p.in[2], p.out, ctxr, gate};
    pg8::gemm_phase((PG8_LAS unsigned char*)lds, g, so, ep, nullptr);
    __syncthreads();
}

struct EpiQTile {
    unsigned char* lds;
    DEV void operator()(const f32x4 (&acc)[4][4], int m0, int wm, int wn, int fr, int fq) const {
        const int pp = wn >> 1;
#pragma unroll
        for (int mi = 0; mi < 4; ++mi) {
            const int m = wm * 64 + mi * 16 + fr;
#pragma unroll
            for (int ni = 0; ni < 4; ++ni) {
                const int c = (wn & 1) * 64 + ni * 16 + 4 * fq;
                *(uint2*)(lds + pp * 32768 + m * 256 + (((c >> 3) ^ (m & 15)) << 4) + (c & 7) * 2) = make_uint2(pk_bf16(acc[mi][ni][0], acc[mi][ni][1]), pk_bf16(acc[mi][ni][2], acc[mi][ni][3]));
            }
        }
    }
};
DEV void phase_peer_select(const Params& p, unsigned char* lds, int layer) {
    const int tid = tid_opaque(), lane = tid & 63, wv = tid >> 6, wm = wv >> 2, wn = wv & 3;
    const int fr = lane & 15, fq = lane >> 4;
    unsigned char* ws = p.ws;
    const bf16_t* hp = (const bf16_t*)(ws + WS_S + (size_t)(layer ? 0 : 1) * U_BYTES);
    const bf16_t* wqt = (const bf16_t*)(ws + WS_WQ) + (size_t)layer * 2048 * 1024;
    const bf16_t* keys = (const bf16_t*)(ws + WS_KEYS) + (size_t)layer * 8 * 2 * 128 * 128;
    int* pl_idx = (int*)(ws + WS_S + 3 * U_BYTES);
    float* pl_gate = (float*)(ws + WS_S + 3 * U_BYTES + (size_t)NT * 128 * 4);
    unsigned* slist = (unsigned*)lds;
    unsigned* tlist = (unsigned*)(lds + 256 * 132 * 4);
    const int mtiles = layer ? NL / 128 : NT / 128;
    for (int u = blockIdx.x; u < mtiles * 8; u += gridDim.x) {
        const int mt = u >> 3, head = u & 7, m0 = mt * 128;
        ALoadPlain al{hp, 1024};
        EpiQTile ep{lds};
        gemm_unit<256>(lds, al, wqt + (size_t)head * 256 * 1024, 1024, m0, ep);
        __syncthreads();
        const int pp = wn >> 1, nk0 = (wn & 1) * 64;
        f32x4 sc[4][4];
#pragma unroll
        for (int mi = 0; mi < 4; ++mi)
#pragma unroll
            for (int ni = 0; ni < 4; ++ni) sc[mi][ni] = (f32x4){0.f, 0.f, 0.f, 0.f};
        const bf16_t* kb = keys + (size_t)(head * 2 + pp) * 16384;
#pragma unroll
        for (int ks = 0; ks < 4; ++ks) {
            bf16x8 af[4], bfr[4];
            const int ch = ks * 4 + fq;
#pragma unroll
            for (int mi = 0; mi < 4; ++mi) { const int m = wm * 64 + mi * 16 + fr; af[mi] = *(const bf16x8*)(lds + pp * 32768 + m * 256 + ((ch ^ (m & 15)) << 4)); }
#pragma unroll
            for (int ni = 0; ni < 4; ++ni) bfr[ni] = *(const bf16x8*)(kb + (size_t)(nk0 + ni * 16 + fr) * 128 + ks * 32 + fq * 8);
#pragma unroll
            for (int mi = 0; mi < 4; ++mi)
#pragma unroll
                for (int ni = 0; ni < 4; ++ni) sc[mi][ni] = __builtin_amdgcn_mfma_f32_16x16x32_bf16(bfr[ni], af[mi], sc[mi][ni], 0, 0, 0);
        }
        __syncthreads();
#pragma unroll
        for (int mi = 0; mi < 4; ++mi) {
            const int m = wm * 64 + mi * 16 + fr;
#pragma unroll
            for (int ni = 0; ni < 4; ++ni) {
                const int n = nk0 + ni * 16 + 4 * fq;
                uint4 o;
                o.x = (mono_u32(sc[mi][ni][0]) & ~127u) | (unsigned)(127 - (n + 0));
                o.y = (mono_u32(sc[mi][ni][1]) & ~127u) | (unsigned)(127 - (n + 1));
                o.z = (mono_u32(sc[mi][ni][2]) & ~127u) | (unsigned)(127 - (n + 2));
                o.w = (mono_u32(sc[mi][ni][3]) & ~127u) | (unsigned)(127 - (n + 3));
                *(uint4*)(slist + (size_t)(pp * 128 + m) * 132 + n) = o;
            }
        }
        __syncthreads();
        {
            const int L = tid >> 1, g2 = tid & 1;
            unsigned t[64];
            {
                const unsigned* srcp = slist + (size_t)L * 132 + g2 * 64;
#pragma unroll
                for (int i = 0; i < 16; ++i) { const uint4 v = *(const uint4*)(srcp + i * 4); t[4 * i] = v.x; t[4 * i + 1] = v.y; t[4 * i + 2] = v.z; t[4 * i + 3] = v.w; }
            }
#pragma unroll
            for (int o = 0; o < 64; o += 16) {
#pragma unroll
                for (int pp2 = 1; pp2 < 16; pp2 <<= 1)
#pragma unroll
                    for (int k = pp2; k >= 1; k >>= 1)
#pragma unroll
                        for (int j = k % pp2; j <= 15 - k; j += 2 * k)
#pragma unroll
                            for (int i = 0; i < k; ++i) {
                                if (i + j + k <= 15 && (i + j) / (2 * pp2) == (i + j + k) / (2 * pp2)) {
                                    const unsigned mx = max(t[o + i + j], t[o + i + j + k]), mn = min(t[o + i + j], t[o + i + j + k]);
                                    t[o + i + j] = mx; t[o + i + j + k] = mn;
                                }
                            }
            }
#pragma unroll
            for (int rnd = 0; rnd < 4; ++rnd) {
                const int oa = rnd == 1 ? 32 : 0, ob = rnd == 0 ? 16 : (rnd == 1 ? 48 : 32);
                unsigned c[16];
#pragma unroll
                for (int i = 0; i < 16; ++i) {
                    unsigned b;
                    if (rnd < 3) b = t[ob + 15 - i];
                    else b = (unsigned)__builtin_amdgcn_update_dpp(0, (int)t[15 - i], 0xB1, 0xF, 0xF, false);
                    c[i] = max(t[oa + i], b);
                }
#pragma unroll
                for (int j = 8; j > 0; j >>= 1)
#pragma unroll
                    for (int i = 0; i < 16; ++i) {
                        const int l = i ^ j;
                        if (l > i) { const unsigned mx = max(c[i], c[l]), mn = min(c[i], c[l]); c[i] = mx; c[l] = mn; }
                    }
#pragma unroll
                for (int i = 0; i < 16; ++i) t[oa + i] = c[i];
            }
            if (g2 == 0) {
#pragma unroll
                for (int i = 0; i < 4; ++i) *(uint4*)(tlist + L * 16 + i * 4) = make_uint4(t[4 * i], t[4 * i + 1], t[4 * i + 2], t[4 * i + 3]);
            }
        }
        __syncthreads();
        if (tid < 128) {
            float v0[16], v1[16];
#pragma unroll
            for (int i = 0; i < 16; ++i) { v0[i] = unmono_u32(tlist[tid * 16 + i] & ~127u); v1[i] = unmono_u32(tlist[(128 + tid) * 16 + i] & ~127u); }
            unsigned cd[16];
#pragma unroll
            for (int i = 0; i < 16; ++i) cd[i] = 0u;
#pragma unroll
            for (int i = 0; i < 16; ++i) {
#pragma unroll
                for (int j = 0; j < 16; ++j) {
                    if ((i + 1) * (j + 1) <= 16) {
                        unsigned x = (mono_u32(v0[i] + v1[j]) & ~255u) | (unsigned)(255 - (i * 16 + j));
#pragma unroll
                        for (int q = (i + 1) * (j + 1) - 1; q < 16; ++q) { const unsigned mx = max(cd[q], x); x = min(cd[q], x); cd[q] = mx; }
                    }
                }
            }
            float sv[16]; int ex[16];
#pragma unroll
            for (int q = 0; q < 16; ++q) {
                const int slot = 255 - (int)(cd[q] & 255u);
                const unsigned a = tlist[tid * 16 + (slot >> 4)], b2 = tlist[(128 + tid) * 16 + (slot & 15)];
                sv[q] = unmono_u32(a & ~127u) + unmono_u32(b2 & ~127u);
                ex[q] = (127 - (int)(a & 127u)) * 128 + (127 - (int)(b2 & 127u));
            }
            float mx = sv[0];
#pragma unroll
            for (int q = 1; q < 16; ++q) mx = fmaxf(mx, sv[q]);
            float den = 0.f;
#pragma unroll
            for (int q = 0; q < 16; ++q) { sv[q] = __expf(sv[q] - mx); den += sv[q]; }
            const float rden = 1.0f / den;
            const size_t base = ((size_t)head * NT + (m0 + tid)) * 16;
#pragma unroll
            for (int i = 0; i < 4; ++i) {
                *(int4*)(pl_idx + base + i * 4) = make_int4(ex[4 * i], ex[4 * i + 1], ex[4 * i + 2], ex[4 * i + 3]);
                *(float4*)(pl_gate + base + i * 4) = make_float4(sv[4 * i] * rden, sv[4 * i + 1] * rden, sv[4 * i + 2] * rden, sv[4 * i + 3] * rden);
            }
        }
        __syncthreads();
    }
}

typedef float f32x2 __attribute__((ext_vector_type(2)));
typedef unsigned int u32x4 __attribute__((ext_vector_type(4)));
typedef unsigned int u32x2 __attribute__((ext_vector_type(2)));
#define PS_LOAD(buf, ee, h) { _Pragma("unroll") for (int e = 0; e < 8; ++e) { \
        const u32x4 t4 = __builtin_amdgcn_raw_buffer_load_b128(rs, ((unsigned)ee[(h) * 8 + e] << 7) + ch16, 0, 0); buf[e] = make_uint4(t4.x, t4.y, t4.z, t4.w); } }
#define PS_IDX(ee, Rr) { _Pragma("unroll") for (int i = 0; i < 4; ++i) { const int4 t = *(const int4*)(pl_idx + ((size_t)sub * NT + (Rr)) * 16 + 4 * i); \
        ee[4 * i] = t.x; ee[4 * i + 1] = t.y; ee[4 * i + 2] = t.z; ee[4 * i + 3] = t.w; } }
DEV long pk64(unsigned lo, unsigned hi) { return (long)(((unsigned long long)hi << 32) | (unsigned long long)lo); }
DEV void phase_peer_u(const Params& p, unsigned char* lds, int layer) {
    const int tid = tid_opaque(), lane = tid & 63, wv = tid >> 6, sub = lane >> 3, ch = lane & 7, fm = lane & 15, fg = lane >> 4;
    const int ng = gridDim.x >> 3, x = blockIdx.x & 7, wq = blockIdx.x >> 3;
    if (wq < ng) {
        const int gw = __builtin_amdgcn_readfirstlane(wq * 8 + wv), nw = ng * 8;
        unsigned char* ws = p.ws;
        const unsigned char* tab = ws + WS_PU + ((size_t)layer * 8 + x) * (16384 * 128);
        const int* pl_idx = (const int*)(ws + WS_S + 3 * U_BYTES);
        const unsigned char* xq = ws + WS_S + 2 * U_BYTES + (size_t)(fm & 1) * 1024 + 128 * x + 16 * fg;
        bf16_t* pd = (bf16_t*)(ws + WS_S + 5 * U_BYTES) + (size_t)x * NT * 128 + 16 * (fm >> 1) + 4 * fg;
        unsigned char* tile = lds + wv * 16384;
        const unsigned cE16 = 16u * (unsigned)(ch ^ (sub >> 1)), cO16 = cE16 ^ 64u;
        const unsigned aoff0 = (unsigned)fm * 128u + (unsigned)((fg ^ (fm >> 1)) << 4), aoff1 = (unsigned)fm * 128u + (unsigned)(((4 + fg) ^ (fm >> 1)) << 4);
        const int nrows = layer ? NL : NT;
        int eN[16];
#define PU_DMA(ee, q) { _Pragma("unroll") for (int j = 0; j < 4; ++j) { const int jj = (q) * 4 + j; \
        __builtin_amdgcn_global_load_lds((const unsigned*)(tab + (((unsigned)ee[jj] << 7) + ((jj & 1) ? cO16 : cE16))), (unsigned*)(tile + jj * 1024 + lane * 16), 16, 0, 0); } }
        const unsigned ta0 = (unsigned)(size_t)((LAS3 unsigned char*)tile) + aoff0, ta1 = (unsigned)(size_t)((LAS3 unsigned char*)tile) + aoff1;
#define PU_MMA(q) { u32x4 a0, a1, a2, a3; \
        asm volatile("ds_read_b128 %0, %4 offset:%6\n\tds_read_b128 %1, %5 offset:%6\n\tds_read_b128 %2, %4 offset:%7\n\tds_read_b128 %3, %5 offset:%7\n\ts_waitcnt lgkmcnt(0)" \
            : "=&v"(a0), "=&v"(a1), "=&v"(a2), "=&v"(a3) : "v"(ta0), "v"(ta1), "n"((q) * 4096), "n"((q) * 4096 + 2048) : "memory"); \
        f32x4 c4 = {0.f, 0.f, 0.f, 0.f}, c5 = {0.f, 0.f, 0.f, 0.f}; \
        c4 = __builtin_amdgcn_mfma_f32_16x16x32_fp8_fp8(pk64(a0.x, a0.y), pk64(bC0.x, bC0.y), c4, 0, 0, 0); \
        c5 = __builtin_amdgcn_mfma_f32_16x16x32_fp8_fp8(pk64(a2.x, a2.y), pk64(bC0.x, bC0.y), c5, 0, 0, 0); \
        c4 = __builtin_amdgcn_mfma_f32_16x16x32_fp8_fp8(pk64(a0.z, a0.w), pk64(bC0.z, bC0.w), c4, 0, 0, 0); \
        c5 = __builtin_amdgcn_mfma_f32_16x16x32_fp8_fp8(pk64(a2.z, a2.w), pk64(bC0.z, bC0.w), c5, 0, 0, 0); \
        c4 = __builtin_amdgcn_mfma_f32_16x16x32_fp8_fp8(pk64(a1.x, a1.y), pk64(bC1.x, bC1.y), c4, 0, 0, 0); \
        c5 = __builtin_amdgcn_mfma_f32_16x16x32_fp8_fp8(pk64(a3.x, a3.y), pk64(bC1.x, bC1.y), c5, 0, 0, 0); \
        c4 = __builtin_amdgcn_mfma_f32_16x16x32_fp8_fp8(pk64(a1.z, a1.w), pk64(bC1.z, bC1.w), c4, 0, 0, 0); \
        c5 = __builtin_amdgcn_mfma_f32_16x16x32_fp8_fp8(pk64(a3.z, a3.w), pk64(bC1.z, bC1.w), c5, 0, 0, 0); \
        acc[(q) * 2] = c4; acc[(q) * 2 + 1] = c5; }
        int R = gw;
#pragma unroll
        for (int i = 0; i < 16; ++i) eN[i] = 0;
        uint4 bC0 = make_uint4(0, 0, 0, 0), bC1 = bC0;
        if (R < nrows) {
            PS_IDX(eN, R);
            PU_DMA(eN, 0); PU_DMA(eN, 1); PU_DMA(eN, 2); PU_DMA(eN, 3);
            bC0 = *(const uint4*)(xq + (size_t)R * 2048); bC1 = *(const uint4*)(xq + (size_t)R * 2048 + 64);
            const int R1 = min(R + nw, nrows - 1);
            PS_IDX(eN, R1);
            asm volatile("s_waitcnt vmcnt(0)" : "+v"(bC0.x), "+v"(bC1.x), "+v"(eN[0]), "+v"(eN[4]), "+v"(eN[8]), "+v"(eN[12]) :: "memory");
        }
        for (; R < nrows; R += nw) {
            const int Rn = R + nw, R1 = min(Rn, nrows - 1), R2 = min(Rn + nw, nrows - 1);
            const bool more = Rn < nrows;
            u32x4 i0, i1, i2, i3, nb0, nb1;
            {
                const int* iptr = pl_idx + ((size_t)sub * NT + R2) * 16;
                const unsigned char* xptr = xq + (size_t)R1 * 2048;
                asm volatile("global_load_dwordx4 %0, %6, off\n\tglobal_load_dwordx4 %1, %6, off offset:16\n\tglobal_load_dwordx4 %2, %6, off offset:32\n\tglobal_load_dwordx4 %3, %6, off offset:48\n\t"
                             "global_load_dwordx4 %4, %7, off\n\tglobal_load_dwordx4 %5, %7, off offset:64"
                             : "=&v"(i0), "=&v"(i1), "=&v"(i2), "=&v"(i3), "=&v"(nb0), "=&v"(nb1) : "v"(iptr), "v"(xptr) : "memory");
            }
            f32x4 acc[8];
#define PU_STEP(q) { if (more) asm volatile("s_waitcnt vmcnt(19)" ::: "memory"); else asm volatile("s_waitcnt vmcnt(0)" ::: "memory"); \
            PU_MMA(q); if (more) { PU_DMA(eN, q); } }
            PU_STEP(0); PU_STEP(1); PU_STEP(2); PU_STEP(3);
            f32x4 s0[4], s1[2], s2;
#pragma unroll
            for (int i = 0; i < 4; ++i)
#pragma unroll
                for (int r = 0; r < 4; ++r) s0[i][r] = (fm & 2) ? acc[2 * i + 1][r] : acc[2 * i][r];
#pragma unroll
            for (int i = 0; i < 2; ++i)
#pragma unroll
                for (int r = 0; r < 4; ++r) s1[i][r] = (fm & 4) ? s0[2 * i + 1][r] : s0[2 * i][r];
#pragma unroll
            for (int r = 0; r < 4; ++r) { const float t = (fm & 8) ? s1[1][r] : s1[0][r]; s2[r] = t + dpp_quad<0xB1>(t); }
            if (!(fm & 1)) *(uint2*)(pd + (size_t)R * 128) = make_uint2(pk_bf16(s2[0], s2[1]), pk_bf16(s2[2], s2[3]));
            if (more) asm volatile("s_waitcnt vmcnt(17)" : "+v"(i0), "+v"(i1), "+v"(i2), "+v"(i3), "+v"(nb0), "+v"(nb1) :: "memory");
            else asm volatile("s_waitcnt vmcnt(0)" : "+v"(i0), "+v"(i1), "+v"(i2), "+v"(i3), "+v"(nb0), "+v"(nb1) :: "memory");
            eN[0] = i0.x; eN[1] = i0.y; eN[2] = i0.z; eN[3] = i0.w; eN[4] = i1.x; eN[5] = i1.y; eN[6] = i1.z; eN[7] = i1.w;
            eN[8] = i2.x; eN[9] = i2.y; eN[10] = i2.z; eN[11] = i2.w; eN[12] = i3.x; eN[13] = i3.y; eN[14] = i3.z; eN[15] = i3.w;
            bC0 = make_uint4(nb0.x, nb0.y, nb0.z, nb0.w); bC1 = make_uint4(nb1.x, nb1.y, nb1.z, nb1.w);
        }
        asm volatile("s_waitcnt vmcnt(0)" ::: "memory");
    }
}
DEV void phase_peer_c(const Params& p, int layer) {
    const int tid = tid_opaque(), lane = tid & 63;
    const int gw = blockIdx.x * 8 + (tid >> 6), nw = gridDim.x * 8;
    unsigned char* ws = p.ws;
    const float* usc = (const float*)(ws + WS_PSC) + layer * 16384;
    const float* vsc = (const float*)(ws + WS_PSC) + 32768 + layer * 16384;
    const int* pl_idx = (const int*)(ws + WS_S + 3 * U_BYTES);
    const float* pl_gate = (const float*)(ws + WS_S + 3 * U_BYTES + (size_t)NT * 128 * 4);
    float* pd = (float*)(ws + WS_S + 4 * U_BYTES);
    const bf16_t* pdh = (const bf16_t*)(ws + WS_S + 5 * U_BYTES);
    const int nrows = layer ? NL : NT;
    const int head0 = 2 * (lane & 3), kk = lane >> 2;
    for (int R = gw; R < nrows; R += nw) {
        float d0 = 0.f, d1 = 0.f;
#pragma unroll
        for (int xx = 0; xx < 8; ++xx) { const unsigned t = *(const unsigned*)(pdh + ((size_t)xx * NT + R) * 128 + 2 * lane); d0 += bf_lo(t); d1 += bf_hi(t); }
        const size_t po = ((size_t)head0 * NT + R) * 16 + kk;
        const int e0 = pl_idx[po], e1 = pl_idx[po + (size_t)NT * 16];
        const float g0 = pl_gate[po], g1 = pl_gate[po + (size_t)NT * 16];
        d0 *= usc[e0] * 0.25f; d1 *= usc[e1] * 0.25f;
        const float c0 = g0 * vsc[e0] * 0.5f * d0 * (1.0f + erff(d0 * 0.70710678118f));
        const float c1 = g1 * vsc[e1] * 0.5f * d1 * (1.0f + erff(d1 * 0.70710678118f));
        pd[(size_t)R * 128 + 16 * head0 + kk] = c0;
        pd[(size_t)R * 128 + 16 * head0 + 16 + kk] = c1;
    }
}
DEV void phase_peer_v(const Params& p, int layer) {
    const int tid = tid_opaque(), lane = tid & 63, sub = lane >> 3, ch = lane & 7;
    const int ng = gridDim.x >> 3, x = blockIdx.x & 7, wq = blockIdx.x >> 3;
    if (wq < ng) {
        const int gw = __builtin_amdgcn_readfirstlane(wq * 8 + (tid >> 6)), nw = ng * 8;
        unsigned char* ws = p.ws;
        const __amdgpu_buffer_rsrc_t rs = __builtin_amdgcn_make_buffer_rsrc((void*)(ws + WS_PV + ((size_t)layer * 8 + x) * (16384 * 128)), 0, 16384 * 128, 0x00020000);
        const int* pl_idx = (const int*)(ws + WS_S + 3 * U_BYTES);
        const float* cb = (const float*)(ws + WS_S + 4 * U_BYTES) + 16 * sub;
        float* ctxr = (float*)(ws + WS_CTXR);
        const float* mods = (const float*)(ws + WS_MOD) + (size_t)layer * 9 * 6144 + 5 * 1024;
        const unsigned ch16 = 16u * (unsigned)ch;
        const int col = 128 * x + 16 * ch + 2 * sub;
        const int nrows = layer ? NL : NT;
        uint4 bufA[8], bufB[8];
        int eC[16], eN[16];
        float cC[16], cN[16];
#define PS_CF(cc, Rr) { _Pragma("unroll") for (int i = 0; i < 4; ++i) { const float4 t = *(const float4*)(cb + (size_t)(Rr) * 128 + 4 * i); \
        cc[4 * i] = t.x; cc[4 * i + 1] = t.y; cc[4 * i + 2] = t.z; cc[4 * i + 3] = t.w; } }
#define PV_FMA(accv, av) asm("v_fma_f32 %0, %1, %2, %0" : "+v"(accv) : "v"(cf), "v"(av))
#define PV_AXPY(buf, h) { _Pragma("unroll") for (int e = 0; e < 8; ++e) { \
        const float cf = cC[(h) * 8 + e]; const unsigned vw[4] = {buf[e].x, buf[e].y, buf[e].z, buf[e].w}; \
        _Pragma("unroll") for (int i = 0; i < 4; ++i) { \
            const f32x2 a = __builtin_amdgcn_cvt_pk_f32_fp8((int)vw[i], false), b2 = __builtin_amdgcn_cvt_pk_f32_fp8((int)vw[i], true); \
            PV_FMA(a16[4 * i], a.x); PV_FMA(a16[4 * i + 1], a.y); PV_FMA(a16[4 * i + 2], b2.x); PV_FMA(a16[4 * i + 3], b2.y); } } }
        int R = gw;
#pragma unroll
        for (int i = 0; i < 16; ++i) { eC[i] = 0; eN[i] = 0; cC[i] = 0.f; cN[i] = 0.f; }
        if (R < nrows) { PS_IDX(eC, R); PS_CF(cC, R); PS_LOAD(bufA, eC, 0); }
        for (; R < nrows; R += nw) {
            const int Rn = R + nw;
            if (Rn < nrows) { PS_IDX(eN, Rn); PS_CF(cN, Rn); }
            PS_LOAD(bufB, eC, 1);
            float* xrow = (R < NL ? p.out + (size_t)R * 1024 : ctxr + (size_t)(R - NL) * 1024) + col;
            const float2 xa = *(const float2*)xrow, ga = *(const float2*)(mods + (size_t)mod_batch(R) * 6144 + col);
            float a16[16];
#pragma unroll
            for (int i = 0; i < 16; ++i) a16[i] = 0.f;
            PV_AXPY(bufA, 0);
            if (Rn < nrows) { PS_LOAD(bufA, eN, 0); }
            PV_AXPY(bufB, 1);
            float s8[8], t4[4];
#pragma unroll
            for (int j = 0; j < 8; ++j) { const u32x2 r = __builtin_amdgcn_permlane32_swap(__float_as_uint(a16[j]), __float_as_uint(a16[8 + j]), false, false); s8[j] = __uint_as_float(r.x) + __uint_as_float(r.y); }
#pragma unroll
            for (int j = 0; j < 4; ++j) { const u32x2 r = __builtin_amdgcn_permlane16_swap(__float_as_uint(s8[j]), __float_as_uint(s8[4 + j]), false, false); t4[j] = __uint_as_float(r.x) + __uint_as_float(r.y); }
            const float wa0 = t4[0] + dpp_ror<8>(t4[0]), wa1 = t4[1] + dpp_ror<8>(t4[1]), wb0 = t4[2] + dpp_ror<8>(t4[2]), wb1 = t4[3] + dpp_ror<8>(t4[3]);
            const float w0 = (lane & 8) ? wb0 : wa0, w1 = (lane & 8) ? wb1 : wa1;
            *(float2*)xrow = make_float2(xa.x + ga.x * w0, xa.y + ga.y * w1);
#pragma unroll
            for (int i = 0; i < 16; ++i) { eC[i] = eN[i]; cC[i] = cN[i]; }
        }
    }
}
DEV void phase_final_norm(const Params& p) {
    const int tid = tid_opaque(), lane = tid & 63;
    const int gw = blockIdx.x * 8 + (tid >> 6), nw = gridDim.x * 8;
    const float* gn = p.in[34];
    for (int R = gw; R < NL; R += nw) {
        float* xr = p.out + (size_t)R * 1024;
        float4 v[4]; float ss = 0.f;
#pragma unroll
        for (int i = 0; i < 4; ++i) { v[i] = *(const float4*)(xr + i * 256 + lane * 4); ss += v[i].x * v[i].x + v[i].y * v[i].y + v[i].z * v[i].z + v[i].w * v[i].w; }
        ss = wave_allreduce(ss);
        const float rs = rsqrtf(ss * (1.0f / 1024.0f) + 1e-6f);
#pragma unroll
        for (int i = 0; i < 4; ++i) {
            const float4 gg = *(const float4*)(gn + i * 256 + lane * 4);
            *(float4*)(xr + i * 256 + lane * 4) = make_float4(v[i].x * rs * gg.x, v[i].y * rs * gg.y, v[i].z * rs * gg.z, v[i].w * rs * gg.w);
        }
    }
}

DEV void phase_gla_proj(const Params& p, unsigned char* lds) {
    unsigned char* ws = p.ws;
    const bf16_t* h = (const bf16_t*)(ws + WS_S + 0 * U_BYTES);
    const bf16_t* wint = (const bf16_t*)(ws + WS_WIN);
    {
        pg8::Gemm g{h, wint, NT, 3072, 1024};
        pg8::StaticOrder so; so.init(NT, 3072, gridDim.x, blockIdx.x);
        pg8::EpiBf16Tiles ep{(bf16_t*)(ws + WS_S + 1 * U_BYTES), 2048, 8, (bf16_t*)(ws + WS_S + 3 * U_BYTES), 1024};
        pg8::gemm_phase(( PG8_LAS unsigned char*)lds, g, so, ep, nullptr);
    }
    __syncthreads();
    for (int u = blockIdx.x; u < NT / 128; u += gridDim.x) {
        ALoadPlain al{h, 1024};
        EpiLr ep{(float*)(ws + WS_LR)};
        gemm_unit<128>(lds, al, wint + (size_t)3072 * 1024, 1024, u * 128, ep);
    }
}

DEV void conv_emit(const float (&acc)[8], int c, bf16_t* dst) {
    const float qs = (c < 512) ? 0.08838834764831845f : 1.0f;
    unsigned ow[4];
#pragma unroll
    for (int j = 0; j < 4; ++j) { const float a0 = acc[2 * j], a1 = acc[2 * j + 1]; ow[j] = pk_bf16(a0 * sigmoidf_(a0) * qs, a1 * sigmoidf_(a1) * qs); }
    *(uint4*)dst = make_uint4(ow[0], ow[1], ow[2], ow[3]);
}
DEV void conv_tap(float (&acc)[8], const uint4& v, const float (&w)[8]) {
    acc[0] += bf_lo(v.x) * w[0]; acc[1] += bf_hi(v.x) * w[1]; acc[2] += bf_lo(v.y) * w[2]; acc[3] += bf_hi(v.y) * w[3];
    acc[4] += bf_lo(v.z) * w[4]; acc[5] += bf_hi(v.z) * w[5]; acc[6] += bf_lo(v.w) * w[6]; acc[7] += bf_hi(v.w) * w[7];
}
DEV void phase_gla_conv(const Params& p) {
    const int tid = tid_opaque();
    unsigned char* ws = p.ws;
    const bf16_t* z = (const bf16_t*)(ws + WS_S + 1 * U_BYTES);
    bf16_t* o = (bf16_t*)(ws + WS_S + 4 * U_BYTES);
    const float* cw = p.in[25];
    const int x = tid >> 3, cl = (tid & 7) * 8;
    for (int task = blockIdx.x; task < 8 * 32; task += gridDim.x) {
        const int cb = task & 31, b = task >> 5;
        const int c = cb * 64 + cl;
        float w[9][8];
#pragma unroll
        for (int t = 0; t < 9; ++t) { const float4 w0 = *(const float4*)(cw + t * 2048 + c), w1 = *(const float4*)(cw + t * 2048 + c + 4); w[t][0] = w0.x; w[t][1] = w0.y; w[t][2] = w0.z; w[t][3] = w0.w; w[t][4] = w1.x; w[t][5] = w1.y; w[t][6] = w1.z; w[t][7] = w1.w; }
        const uint4 zero4 = make_uint4(0, 0, 0, 0);
        auto load_row = [&](int y, uint4 (&r)[3]) {
            if (y < 0 || y >= 128) { r[0] = zero4; r[1] = zero4; r[2] = zero4; return; }
            const bf16_t* row = z + ((size_t)b * 8192 + (size_t)y * 64 + x) * 2048 + c;
            r[1] = *(const uint4*)row;
            r[0] = (x > 0) ? *(const uint4*)(row - 2048) : zero4;
            r[2] = (x < 63) ? *(const uint4*)(row + 2048) : zero4;
        };
        uint4 r0[3], r1[3], r2[3], r3[3], r4[3];
        const int y0 = 0;
        load_row(y0 - 1, r0); load_row(y0, r1); load_row(y0 + 1, r2); load_row(y0 + 2, r3);
#pragma unroll 1
        for (int yy = 0; yy < 128; ++yy) {
            load_row(y0 + yy + 3, r4);
            float acc[8];
#pragma unroll
            for (int j = 0; j < 8; ++j) acc[j] = 0.f;
#pragma unroll
            for (int dx = 0; dx < 3; ++dx) { conv_tap(acc, r0[dx], w[dx]); conv_tap(acc, r1[dx], w[3 + dx]); conv_tap(acc, r2[dx], w[6 + dx]); }
            conv_emit(acc, c, o + ((size_t)b * 8192 + (size_t)(y0 + yy) * 64 + x) * 2048 + c);
#pragma unroll
            for (int dx = 0; dx < 3; ++dx) { r0[dx] = r1[dx]; r1[dx] = r2[dx]; r2[dx] = r3[dx]; r3[dx] = r4[dx]; }
        }
    }
    for (int task = blockIdx.x; task < (NC / 64) * 8; task += gridDim.x) {
        const int rb = task >> 3, cbk = task & 7;
        const int R = NL + rb * 64 + (tid >> 3);
        const int t = (R - NL) & 255;
#pragma unroll 1
        for (int i = 0; i < 4; ++i) {
            const int c = cbk * 256 + (tid & 7) * 8 + i * 64;
            float acc[8];
#pragma unroll
            for (int j = 0; j < 8; ++j) acc[j] = 0.f;
#pragma unroll
            for (int dx = -1; dx <= 1; ++dx) {
                if (t + dx >= 0 && t + dx < 256) {
                    const uint4 v = *(const uint4*)(z + (size_t)(R + dx) * 2048 + c);
                    const float* wp = cw + (3 + (dx + 1)) * 2048 + c;
                    const float4 w0 = *(const float4*)wp, w1 = *(const float4*)(wp + 4);
                    const float wv[8] = {w0.x, w0.y, w0.z, w0.w, w1.x, w1.y, w1.z, w1.w};
                    conv_tap(acc, v, wv);
                }
            }
            conv_emit(acc, c, o + (size_t)R * 2048 + c);
        }
    }
}

constexpr int GT_QE = 0, GT_KET = 16384, GT_A = 32768, GT_CONST = 40960, GT_STRIDE = 43008;
constexpr int GT_N0 = (int)((2 * U_BYTES) / GT_STRIDE);
constexpr size_t WS_TOTAL = 1073741824ull;
static_assert((size_t)(NB * 4 * 2 * 132 - GT_N0) * GT_STRIDE <= WS_TOTAL - WS_END, "tile records do not fit");
DEV size_t gla_tile_off(int b, int hd, int d, int cc) {
    const int idx = (((b * 4 + hd) * 2 + d) * 132) + cc;
    return idx < GT_N0 ? WS_S + (size_t)idx * GT_STRIDE : WS_END + (size_t)(idx - GT_N0) * GT_STRIDE;
}
DEV int gla_row0(int b, int cc) { return cc < 4 ? NL + b * 256 + cc * 64 : b * 8192 + (cc - 4) * 64; }
DEV void phase_gla_prep(const Params& p, unsigned char* lds) {
    const int tid = tid_opaque(), lane = tid & 63, wv = tid >> 6;
    const int fr = lane & 15, fq = lane >> 4;
    unsigned char* ws = p.ws;
    constexpr int QE = 0, KE = 16384, KET = 32768, BC = 49152  , GS = 82944  , LRL = 86528  , BCS = 132;
    const bf16_t* qkv = (const bf16_t*)(ws + WS_S + 4 * U_BYTES);
    const float* lrb = (const float*)(ws + WS_LR);
    unsigned char* gt = ws;
    float* bc = (float*)(lds + BC);
    float* gs = (float*)(lds + GS);
    const int li = tid >> 3, lc = tid & 7;
    const int d = blockIdx.x & 1, hd = (blockIdx.x >> 1) & 3;
    bf16x8 gkf;
    {
        unsigned w4[4] = {0u, 0u, 0u, 0u};
        if (fq < 2) {
#pragma unroll
            for (int e2 = 0; e2 < 4; ++e2) {
                const float g0 = p.in[26][(size_t)(d * 16 + 8 * fq + 2 * e2) * 512 + hd * 128 + wv * 16 + fr];
                const float g1 = p.in[26][(size_t)(d * 16 + 8 * fq + 2 * e2 + 1) * 512 + hd * 128 + wv * 16 + fr];
                w4[e2] = pk_bf16(g0, g1);
            }
        }
        gkf = as_bf16x8(make_uint4(w4[0], w4[1], w4[2], w4[3]));
    }
    const float4 gb4 = *(const float4*)(p.in[27] + d * 512 + hd * 128 + wv * 16 + 4 * fq);
    const int qstep = (int)(gridDim.x >> 3);
    uint4 nq0, nq1, nk0, nk1; float2 nl;
    auto fetch = [&](int q) {
        const size_t R = (size_t)(gla_row0(q / 132, q % 132) + li);
        const bf16_t* row = qkv + R * 2048;
        nq0 = *(const uint4*)(row + hd * 128 + lc * 8); nq1 = *(const uint4*)(row + hd * 128 + 64 + lc * 8);
        nk0 = *(const uint4*)(row + 512 + hd * 128 + lc * 8); nk1 = *(const uint4*)(row + 512 + hd * 128 + 64 + lc * 8);
        nl = *(const float2*)(lrb + R * 32 + d * 16 + lc * 2);
    };
    int q = (int)(blockIdx.x >> 3);
    if (q < NB * 132) fetch(q);
    for (; q < NB * 132; q += qstep) {
        const int cc = q % 132, b = q / 132;
        unsigned char* rec = gt + gla_tile_off(b, hd, d, cc);
        const uint4 rq0 = nq0, rq1 = nq1, rk0 = nk0, rk1 = nk1; const float2 rl = nl;
        if (q + qstep < NB * 132) fetch(q + qstep);
        *(unsigned*)(lds + LRL + li * 32 + lc * 4) = pk_bf16(rl.x, rl.y);
        __syncthreads();
        {
            const float gbv[4] = {gb4.x, gb4.y, gb4.z, gb4.w};
#pragma unroll
            for (int itl = 0; itl < 4; ++itl) {
                uint4 lr4 = *(const uint4*)(lds + LRL + (itl * 16 + fr) * 32 + (fq & 1) * 16);
                if (fq >= 2) lr4 = make_uint4(0, 0, 0, 0);
                f32x4 a = {0.f, 0.f, 0.f, 0.f};
                a = __builtin_amdgcn_mfma_f32_16x16x32_bf16(gkf, as_bf16x8(lr4), a, 0, 0, 0);
                float s[4], tot[4];
#pragma unroll
                for (int j = 0; j < 4; ++j) {
                    const float xx = a[j] + gbv[j];
                    const float la = (fminf(xx, 0.f) - __logf(1.0f + __expf(-fabsf(xx)))) * (1.0f / 16.0f);
                    float pf = la;
                    pf += dpp_shr0<1>(pf); pf += dpp_shr0<2>(pf); pf += dpp_shr0<4>(pf); pf += dpp_shr0<8>(pf);
                    tot[j] = __shfl(pf, (lane & 48) | 15);
                    s[j] = d ? (tot[j] - pf + la) : pf;
                }
                *(float4*)(bc + (itl * 16 + fr) * BCS + wv * 16 + 4 * fq) = make_float4(s[0], s[1], s[2], s[3]);
                if (fr == 15) *(float4*)(gs + itl * 128 + wv * 16 + 4 * fq) = make_float4(tot[0], tot[1], tot[2], tot[3]);
            }
        }
        __syncthreads();
        if (tid < 128) {
            const float g0 = gs[tid], g1 = gs[128 + tid], g2 = gs[256 + tid], g3 = gs[384 + tid];
            const float refc = d ? (bc[31 * BCS + tid] + g2 + g3) : (bc[32 * BCS + tid] + g0 + g1), lastc = g0 + g1 + g2 + g3;
            const float dl = __expf(lastc), er = __expf(refc), el = __expf(lastc - refc);
            gs[512 + tid] = refc;
            float* cst = (float*)(rec + GT_CONST);
            cst[tid] = er; cst[128 + tid] = el; cst[256 + tid] = dl;
        }
        __syncthreads();
        {
            const int grp = li >> 4;
            const uint4 rqs[2] = {rq0, rq1}, rks[2] = {rk0, rk1};
#pragma unroll
            for (int hseg = 0; hseg < 2; ++hseg) {
                const int k0 = hseg * 64 + lc * 8;
                float bcv[8], refv[8];
#pragma unroll
                for (int j4 = 0; j4 < 2; ++j4) {
                    const float4 g0 = *(const float4*)(gs + k0 + j4 * 4), g1 = *(const float4*)(gs + 128 + k0 + j4 * 4);
                    const float4 g2 = *(const float4*)(gs + 256 + k0 + j4 * 4), g3 = *(const float4*)(gs + 384 + k0 + j4 * 4);
                    const float4 bi = *(const float4*)(bc + li * BCS + k0 + j4 * 4), rf = *(const float4*)(gs + 512 + k0 + j4 * 4);
                    const float g0a[4] = {g0.x, g0.y, g0.z, g0.w}, g1a[4] = {g1.x, g1.y, g1.z, g1.w}, g2a[4] = {g2.x, g2.y, g2.z, g2.w}, g3a[4] = {g3.x, g3.y, g3.z, g3.w};
                    const float bia[4] = {bi.x, bi.y, bi.z, bi.w}, rfa[4] = {rf.x, rf.y, rf.z, rf.w};
#pragma unroll
                    for (int j = 0; j < 4; ++j) {
                        const float pre = d ? ((grp < 1 ? g1a[j] : 0.f) + (grp < 2 ? g2a[j] : 0.f) + (grp < 3 ? g3a[j] : 0.f))
                                            : ((grp > 0 ? g0a[j] : 0.f) + (grp > 1 ? g1a[j] : 0.f) + (grp > 2 ? g2a[j] : 0.f));
                        bcv[j4 * 4 + j] = bia[j] + pre;
                        refv[j4 * 4 + j] = rfa[j];
                    }
                }
                const unsigned qw[4] = {rqs[hseg].x, rqs[hseg].y, rqs[hseg].z, rqs[hseg].w}, kw[4] = {rks[hseg].x, rks[hseg].y, rks[hseg].z, rks[hseg].w};
                unsigned oqe[4], oke[4];
#pragma unroll
                for (int j2 = 0; j2 < 4; ++j2) {
                    const float q0 = bf_lo(qw[j2]), q1 = bf_hi(qw[j2]), kk0 = bf_lo(kw[j2]), kk1 = bf_hi(kw[j2]);
                    const float e0 = __expf(bcv[2 * j2] - refv[2 * j2]), e1 = __expf(bcv[2 * j2 + 1] - refv[2 * j2 + 1]);
                    const float r0 = __builtin_amdgcn_rcpf(e0), r1 = __builtin_amdgcn_rcpf(e1);
                    oqe[j2] = pk_bf16(q0 * e0, q1 * e1);
                    oke[j2] = pk_bf16(kk0 * r0, kk1 * r1);
                    const int kc0 = k0 + 2 * j2;
                    *(bf16_t*)(lds + KET + tile_off2(kc0, li >> 3) + (li & 7) * 2) = (bf16_t)(oke[j2] & 0xffffu);
                    *(bf16_t*)(lds + KET + tile_off2(kc0 + 1, li >> 3) + (li & 7) * 2) = (bf16_t)(oke[j2] >> 16);
                }
                const int chq = hseg * 8 + lc;
                const int so = li * 256 + ((chq ^ (li & 15)) << 4);
                *(uint4*)(lds + QE + so) = make_uint4(oqe[0], oqe[1], oqe[2], oqe[3]);
                *(uint4*)(lds + KE + so) = make_uint4(oke[0], oke[1], oke[2], oke[3]);
                *(uint4*)(rec + GT_QE + so) = make_uint4(oqe[0], oqe[1], oqe[2], oqe[3]);
            }
        }
        __syncthreads();
        {
            const int it = wv & 3, pr2 = wv >> 2;
#pragma unroll
            for (int jj = 0; jj < 2; ++jj) {
                const int jt = pr2 * 2 + jj;
                f32x4 a = {0.f, 0.f, 0.f, 0.f};
                if (d ? (jt >= it) : (jt <= it)) {
#pragma unroll
                    for (int ks = 0; ks < 4; ++ks) {
                        const int ch = ks * 4 + fq;
                        const int rj = jt * 16 + fr, ri = it * 16 + fr;
                        const bf16x8 fa = *(const bf16x8*)(lds + KE + rj * 256 + ((ch ^ (rj & 15)) << 4));
                        const bf16x8 fb = *(const bf16x8*)(lds + QE + ri * 256 + ((ch ^ (ri & 15)) << 4));
                        a = __builtin_amdgcn_mfma_f32_16x16x32_bf16(fa, fb, a, 0, 0, 0);
                    }
                }
                const int i = it * 16 + fr, j = jt * 16 + 4 * fq;
                float av[4];
#pragma unroll
                for (int e = 0; e < 4; ++e) av[e] = (d ? (j + e >= i) : (j + e <= i)) ? a[e] : 0.f;
                *(uint2*)(rec + GT_A + i * 128 + (((j >> 3) ^ (i & 7)) << 4) + (j & 7) * 2) = make_uint2(pk_bf16(av[0], av[1]), pk_bf16(av[2], av[3]));
            }
#pragma unroll
            for (int i = 0; i < 2; ++i) *(uint4*)(rec + GT_KET + i * 8192 + tid * 16) = *(const uint4*)(lds + KET + i * 8192 + tid * 16);
        }
        __syncthreads();
    }
}

DEV void phase_gla_scan(const Params& p, unsigned char* lds) {
    const int tid = tid_opaque(), lane = tid & 63, wv = tid >> 6;
    const int fr = lane & 15, fq = lane >> 4;
    unsigned char* ws = p.ws;
    constexpr int QE = 0  , KET = 32768  , AL = 65536  , VT = 81920, ST = 90112  ;
    const bf16_t* qkv = (const bf16_t*)(ws + WS_S + 4 * U_BYTES);
    const unsigned char* gt = ws;
    for (int unit = blockIdx.x; unit < 256; unit += gridDim.x) {
        const int vs = unit & 3, d = (unit >> 2) & 1, hd = (unit >> 3) & 3, b = unit >> 5;
        bf16_t* odst = d ? (bf16_t*)(ws + WS_S + 2 * U_BYTES) : (bf16_t*)(ws + WS_S + 4 * U_BYTES);
        const int old_ = d ? 1024 : 2048;
        const int li = tid >> 3, lc = tid & 7;
        auto ccof = [&](int c) -> int { return d ? (c < 4 ? 3 - c : 135 - c) : c; };
        auto dma = [&](int cc, int buf) {
            const unsigned char* rec = gt + gla_tile_off(b, hd, d, cc);
#pragma unroll
            for (int i = 0; i < 2; ++i) {
                __builtin_amdgcn_global_load_lds((const unsigned*)(rec + GT_QE + i * 8192 + tid * 16), (unsigned*)(lds + QE + buf * 16384 + i * 8192 + tid * 16), 16, 0, 0);
                __builtin_amdgcn_global_load_lds((const unsigned*)(rec + GT_KET + i * 8192 + tid * 16), (unsigned*)(lds + KET + buf * 16384 + i * 8192 + tid * 16), 16, 0, 0);
            }
            __builtin_amdgcn_global_load_lds((const unsigned*)(rec + GT_A + tid * 16), (unsigned*)(lds + AL + buf * 8192 + tid * 16), 16, 0, 0);
        };
        uint4 nv; float4 n_dl, n_el, n_er;
        auto loads = [&](int c) {
            const int cc = ccof(c);
            nv = *(const uint4*)(qkv + (size_t)(gla_row0(b, cc) + li) * 2048 + 1024 + hd * 256 + vs * 64 + lc * 8);
            const float* cst = (const float*)(gt + gla_tile_off(b, hd, d, cc) + GT_CONST);
            n_el = *(const float4*)(cst + 128 + wv * 16 + 4 * fq); n_dl = *(const float4*)(cst + 256 + wv * 16 + 4 * fq);
            if (c + 1 < 132) n_er = *(const float4*)((const float*)(gt + gla_tile_off(b, hd, d, ccof(c + 1)) + GT_CONST) + wv * 16 + 4 * fq);
            else n_er = make_float4(0.f, 0.f, 0.f, 0.f);
        };
        f32x4 accS[4];
#pragma unroll
        for (int i = 0; i < 4; ++i) accS[i] = (f32x4){0.f, 0.f, 0.f, 0.f};
        for (int i = tid; i < 32768 / 16; i += NTHREADS) *(uint4*)(lds + ST + i * 16) = make_uint4(0, 0, 0, 0);
        dma(ccof(0), 0);
        loads(0);
        for (int c = 0; c < 132; ++c) {
            const int buf = c & 1, cc = ccof(c);
            const uint4 rv = nv; const float4 dl4 = n_dl, el4 = n_el, er4 = n_er;
            asm volatile("s_waitcnt vmcnt(0)" ::: "memory");
            {
                const unsigned vw[4] = {rv.x, rv.y, rv.z, rv.w};
#pragma unroll
                for (int j2 = 0; j2 < 4; ++j2) {
                    const int vc0 = lc * 8 + 2 * j2;
                    *(bf16_t*)(lds + VT + tile_off2(vc0, li >> 3) + (li & 7) * 2) = (bf16_t)(vw[j2] & 0xffffu);
                    *(bf16_t*)(lds + VT + tile_off2(vc0 + 1, li >> 3) + (li & 7) * 2) = (bf16_t)(vw[j2] >> 16);
                }
            }
            asm volatile("s_waitcnt lgkmcnt(0)" ::: "memory"); __builtin_amdgcn_s_barrier(); asm volatile("" ::: "memory");
            if (c + 1 < 132) { dma(ccof(c + 1), buf ^ 1); loads(c + 1); }
            const int it = wv & 3, pr2 = wv >> 2;
            const int r0 = gla_row0(b, cc);
#pragma unroll
            for (int vv = 0; vv < 2; ++vv) {
                const int vt = pr2 * 2 + vv;
                f32x4 a = {0.f, 0.f, 0.f, 0.f};
#pragma unroll
                for (int ks = 0; ks < 4; ++ks) {
                    const int ch = ks * 4 + fq;
                    const int rvv = vt * 16 + fr, ri = it * 16 + fr;
                    const bf16x8 fa = *(const bf16x8*)(lds + ST + buf * 16384 + rvv * 256 + ((ch ^ (rvv & 15)) << 4));
                    const bf16x8 fb = *(const bf16x8*)(lds + QE + buf * 16384 + ri * 256 + ((ch ^ (ri & 15)) << 4));
                    a = __builtin_amdgcn_mfma_f32_16x16x32_bf16(fa, fb, a, 0, 0, 0);
                }
#pragma unroll
                for (int ks = 0; ks < 2; ++ks) {
                    const int ch = ks * 4 + fq;
                    const int rvv = vt * 16 + fr, ri = it * 16 + fr;
                    const bf16x8 fa = *(const bf16x8*)(lds + VT + tile_off2(rvv, ch));
                    const bf16x8 fb = *(const bf16x8*)(lds + AL + buf * 8192 + ri * 128 + ((ch ^ (ri & 7)) << 4));
                    a = __builtin_amdgcn_mfma_f32_16x16x32_bf16(fa, fb, a, 0, 0, 0);
                }
                const int i = it * 16 + fr, vcol = vt * 16 + 4 * fq;
                *(uint2*)(odst + (size_t)(r0 + i) * old_ + hd * 256 + vs * 64 + vcol) = make_uint2(pk_bf16(a[0], a[1]), pk_bf16(a[2], a[3]));
            }
            {
                const int kt = wv;
                bf16x8 fa[2];
#pragma unroll
                for (int ks = 0; ks < 2; ++ks) fa[ks] = *(const bf16x8*)(lds + KET + buf * 16384 + tile_off2(kt * 16 + fr, ks * 4 + fq));
#pragma unroll
                for (int vt = 0; vt < 4; ++vt) {
                    f32x4 t = {0.f, 0.f, 0.f, 0.f};
#pragma unroll
                    for (int ks = 0; ks < 2; ++ks) t = __builtin_amdgcn_mfma_f32_16x16x32_bf16(fa[ks], *(const bf16x8*)(lds + VT + tile_off2(vt * 16 + fr, ks * 4 + fq)), t, 0, 0, 0);
                    f32x4 a = accS[vt];
                    a[0] = a[0] * dl4.x + t[0] * el4.x; a[1] = a[1] * dl4.y + t[1] * el4.y; a[2] = a[2] * dl4.z + t[2] * el4.z; a[3] = a[3] * dl4.w + t[3] * el4.w;
                    accS[vt] = a;
                    const int vcol = vt * 16 + fr, kcol = kt * 16 + 4 * fq;
                    *(uint2*)(lds + ST + (buf ^ 1) * 16384 + vcol * 256 + (((kcol >> 3) ^ (vcol & 15)) << 4) + (kcol & 7) * 2) =
                        make_uint2(pk_bf16(a[0] * er4.x, a[1] * er4.y), pk_bf16(a[2] * er4.z, a[3] * er4.w));
                }
            }
            asm volatile("s_waitcnt lgkmcnt(0)" ::: "memory"); __builtin_amdgcn_s_barrier(); asm volatile("" ::: "memory");
        }
        asm volatile("s_waitcnt vmcnt(0)" ::: "memory");
        __syncthreads();
    }
}

DEV void phase_gla_readout(const Params& p) {
    const int tid = tid_opaque(), lane = tid & 63;
    const int gw = blockIdx.x * 8 + (tid >> 6), nw = gridDim.x * 8;
    unsigned char* ws = p.ws;
    const bf16_t* o0 = (const bf16_t*)(ws + WS_S + 4 * U_BYTES);
    const bf16_t* o1 = (const bf16_t*)(ws + WS_S + 2 * U_BYTES);
    const bf16_t* gb = (const bf16_t*)(ws + WS_S + 3 * U_BYTES);
    bf16_t* ao = (bf16_t*)(ws + WS_S + 0 * U_BYTES);
    const float4 hn = *(const float4*)(p.in[28] + lane * 4);
    for (int item0 = gw; item0 < NL * 4; item0 += 4 * nw) {
        uint2 a[4], b2[4], g2[4];
#pragma unroll
        for (int q = 0; q < 4; ++q) {
            const int item = min(item0 + q * nw, NL * 4 - 1);
            const size_t off = (size_t)(item >> 2) * 1024 + (item & 3) * 256 + lane * 4;
            a[q] = *(const uint2*)(o0 + off + (size_t)(item >> 2) * 1024); b2[q] = *(const uint2*)(o1 + off); g2[q] = *(const uint2*)(gb + off);
        }
        float v[4][4], ss[4];
#pragma unroll
        for (int q = 0; q < 4; ++q) {
            v[q][0] = bf_lo(a[q].x) + bf_lo(b2[q].x); v[q][1] = bf_hi(a[q].x) + bf_hi(b2[q].x); v[q][2] = bf_lo(a[q].y) + bf_lo(b2[q].y); v[q][3] = bf_hi(a[q].y) + bf_hi(b2[q].y);
            ss[q] = v[q][0] * v[q][0] + v[q][1] * v[q][1] + v[q][2] * v[q][2] + v[q][3] * v[q][3];
        }
#pragma unroll
        for (int q = 0; q < 4; ++q) ss[q] = wave_allreduce(ss[q]);
#pragma unroll
        for (int q = 0; q < 4; ++q) {
            const int item = item0 + q * nw;
            if (item < NL * 4) {
                const size_t off = (size_t)(item >> 2) * 1024 + (item & 3) * 256 + lane * 4;
                const float rs = rsqrtf(ss[q] * (1.0f / 256.0f) + 1e-6f);
                const float g0 = bf_lo(g2[q].x), g1 = bf_hi(g2[q].x), g2f = bf_lo(g2[q].y), g3 = bf_hi(g2[q].y);
                const float r0 = v[q][0] * rs * hn.x * (g0 * sigmoidf_(g0)), r1 = v[q][1] * rs * hn.y * (g1 * sigmoidf_(g1));
                const float r2 = v[q][2] * rs * hn.z * (g2f * sigmoidf_(g2f)), r3 = v[q][3] * rs * hn.w * (g3 * sigmoidf_(g3));
                *(uint2*)(ao + off) = make_uint2(pk_bf16(r0, r1), pk_bf16(r2, r3));
            }
        }
    }
}


#define XB_TMO      128
#define XB_XCNT(j)  (256  + 64 * (j))
#define XB_XSUB(j)  (1280 + 64 * (j))
#define XB_XGEN(j)  (2304 + 64 * (j))
#define XB_TOP      3328
#define XB_TOPGEN   3392
#define XB_SPIN_CAP (1u << 22)
DEV unsigned xb_ld(unsigned* p) { return __hip_atomic_load(p, __ATOMIC_RELAXED, __HIP_MEMORY_SCOPE_AGENT); }
DEV unsigned xb_add(unsigned* p, unsigned v) { return __hip_atomic_fetch_add(p, v, __ATOMIC_RELAXED, __HIP_MEMORY_SCOPE_AGENT); }
DEV unsigned xb_xcc_id() { return (unsigned)__builtin_amdgcn_s_getreg((3 << 11) | 20) & 0xFu; }
#define XB_SPIN(cond, bar) do { unsigned _sp = 0; while (cond) { __builtin_amdgcn_s_sleep(1); \
    if ((++_sp & 255u) == 0u) { if (xb_ld(&(bar)[XB_TMO])) break; if (_sp > XB_SPIN_CAP) { atomicAdd(&(bar)[XB_TMO], 1u); break; } } } } while (0)
DEV void xcd_barrier_complete(unsigned* bar, unsigned x, unsigned& nloc, unsigned& nx) {
    const unsigned G = gridDim.x;
    unsigned sum, cnt, mine, sp = 0u;
    for (;;) {
        sum = 0u; cnt = 0u; mine = 0u;
#pragma unroll
        for (unsigned j = 0; j < 16; ++j) { const unsigned c = xb_ld(&bar[XB_XCNT(j)]); sum += c; cnt += (c > 0u) ? 1u : 0u; mine = (j == x) ? c : mine; }
        if (sum == G) break;
        __builtin_amdgcn_s_sleep(1);
        if ((++sp & 255u) == 0u) { if (xb_ld(&bar[XB_TMO])) break; if (sp > XB_SPIN_CAP) { atomicAdd(&bar[XB_TMO], 1u); break; } }
    }
    nloc = mine > 0u ? mine : 1u; nx = cnt > 0u ? cnt : 1u;
}
DEV void xcd_barrier(unsigned* bar, volatile LAS3 unsigned* st) {
    asm volatile("s_waitcnt vmcnt(0)" ::: "memory");
    __syncthreads();
    if (tid_opaque() == 0) {
        const unsigned x = xb_xcc_id();
        __builtin_amdgcn_s_waitcnt(0);
        unsigned nloc = st[0], nx = st[1];
        if (nloc == 0u) { xcd_barrier_complete(bar, x, nloc, nx); st[0] = nloc; st[1] = nx; }
        const unsigned old = xb_add(&bar[XB_XSUB(x)], 1u);
        const unsigned gen = old / nloc;
        if (old + 1u == (gen + 1u) * nloc) {
            __builtin_amdgcn_fence(__ATOMIC_RELEASE, "agent");
            asm volatile("s_waitcnt vmcnt(0)" ::: "memory");
            const unsigned og = xb_add(&bar[XB_TOP], 1u);
            const unsigned tg = og / nx;
            if (og + 1u == (tg + 1u) * nx) xb_add(&bar[XB_TOPGEN], 1u);
            else XB_SPIN(xb_ld(&bar[XB_TOPGEN]) == tg, bar);
            __builtin_amdgcn_fence(__ATOMIC_ACQUIRE, "agent");
            xb_add(&bar[XB_XGEN(x)], 1u);
            asm volatile("s_waitcnt vmcnt(0)" ::: "memory");
        } else {
            XB_SPIN(xb_ld(&bar[XB_XGEN(x)]) == gen, bar);
            __builtin_amdgcn_fence(__ATOMIC_ACQUIRE, "agent");
            asm volatile("s_waitcnt vmcnt(0)" ::: "memory");
        }
    }
    __syncthreads();
}
#define SYNC() do { asm volatile("s_waitcnt vmcnt(0)" ::: "memory"); grid.sync(); \
    if (tid_opaque() == 0) { __builtin_amdgcn_fence(__ATOMIC_ACQUIRE, "agent"); asm volatile("s_waitcnt vmcnt(0)" ::: "memory"); } \
    __syncthreads(); } while (0)
__global__ void __launch_bounds__(NTHREADS) mega_fwd(Params p) {
    unsigned char* const lds = g_lds;
    cg::grid_group grid = cg::this_grid();
#define XBAR ((unsigned*)(p.ws + WS_BAR))
#define XST ((volatile LAS3 unsigned*)(lds + LDS_BYTES - 16))
    if ((threadIdx.x & 63) == 0) g_lds[LDS_WTAB + hw_wave_slot()] = (unsigned char)(threadIdx.x >> 6);
    if (threadIdx.x == 0) { XST[0] = 0u; XST[1] = 0u; (void)xb_add(&XBAR[XB_XCNT(xb_xcc_id())], 1u); }
    __syncthreads();
#define S0 ((bf16_t*)(p.ws + WS_S + 0 * U_BYTES))
#define SLOT(i) ((bf16_t*)(p.ws + WS_S + (size_t)(i) * U_BYTES))
#define S1 ((bf16_t*)(p.ws + WS_S + 1 * U_BYTES))
#define CTXR ((const float*)(p.ws + WS_CTXR))
    phase0(p, lds); SYNC();
#undef SYNC
#define SYNC() xcd_barrier(XBAR, XST)
    phase_normmix(p, S0, SLOT(5), SLOT(1), SLOT(2)); SYNC();
    phase_rw_proj1(p, lds, 0, SLOT(5), SLOT(3)); SYNC();
    phase_rw_proj1(p, lds, 1, SLOT(1), SLOT(5)); SYNC();
    phase_rw_proj1(p, lds, 2, SLOT(2), SLOT(1)); phase_rw_lora(p, lds); SYNC();
    REPEAT(3, phase_rw_scan(p, lds));
    phase_rw_scan(p, lds); SYNC();
    REPEAT(4, phase_rw_readout(p));
    phase_rw_readout(p); SYNC();
    REPEAT(5, phase_wo(p, lds, 0));
    phase_wo(p, lds, 0); SYNC();
    REPEAT(6, phase_normmod(p, 0, 1, p.out, CTXR, NT, S1, (unsigned char*)SLOT(2)));
    phase_normmod(p, 0, 1, p.out, CTXR, NT, S1, (unsigned char*)SLOT(2)); SYNC();
    REPEAT(7, phase_peer_select(p, lds, 0));
    phase_peer_select(p, lds, 0); SYNC();
    phase_peer_u(p, lds, 0); SYNC();
    phase_peer_c(p, 0); SYNC();
    phase_peer_v(p, 0); SYNC();
    phase_normmod(p, 1, 0, p.out, CTXR, NT, S0, nullptr); SYNC();
    REPEAT(9, phase_gla_proj(p, lds));
    phase_gla_proj(p, lds); SYNC();
    REPEAT(10, phase_gla_conv(p));
    phase_gla_conv(p); SYNC();
    REPEAT(18, phase_gla_prep(p, lds));
    phase_gla_prep(p, lds); SYNC();
    REPEAT(11, phase_gla_scan(p, lds));
    phase_gla_scan(p, lds); SYNC();
    REPEAT(12, phase_gla_readout(p));
    phase_gla_readout(p); SYNC();
    phase_wo(p, lds, 1); SYNC();
    REPEAT(14, phase_normmod(p, 1, 1, p.out, CTXR, NL, S0, (unsigned char*)SLOT(2)));
    phase_normmod(p, 1, 1, p.out, CTXR, NL, S0, (unsigned char*)SLOT(2)); SYNC();
    REPEAT(15, phase_peer_select(p, lds, 1));
    phase_peer_select(p, lds, 1); SYNC();
    phase_peer_u(p, lds, 1); SYNC();
    phase_peer_c(p, 1); SYNC();
    phase_peer_v(p, 1); SYNC();
    phase_final_norm(p);
}

extern "C" void kernel_launch(void* const* d_in, const int* in_sizes, int n_in, void* d_out, int out_size, void* d_ws, size_t ws_size, hipStream_t stream) {
    static int grid_blocks = 0;
    if (grid_blocks == 0) {
        if (n_in != 35 || ws_size < WS_TOTAL) { fprintf(stderr, "kernel_launch: unexpected n_in %d or ws_size %zu (< %zu)\n", n_in, ws_size, (size_t)WS_END); grid_blocks = -1; return; }
        int dev = 0, cus = 0, per_cu = 0;
        if (hipGetDevice(&dev) != hipSuccess || hipDeviceGetAttribute(&cus, hipDeviceAttributeMultiprocessorCount, dev) != hipSuccess) { fprintf(stderr, "kernel_launch: device query failed\n"); grid_blocks = -1; return; }
        if (hipFuncSetAttribute((const void*)mega_fwd, hipFuncAttributeMaxDynamicSharedMemorySize, LDS_BYTES) != hipSuccess) { fprintf(stderr, "kernel_launch: hipFuncSetAttribute failed\n"); grid_blocks = -1; return; }
        if (hipOccupancyMaxActiveBlocksPerMultiprocessor(&per_cu, (const void*)mega_fwd, NTHREADS, LDS_BYTES) != hipSuccess || per_cu < 1) { fprintf(stderr, "kernel_launch: occupancy query says %d blocks per CU\n", per_cu); grid_blocks = -1; return; }
        grid_blocks = cus;
    }
    if (grid_blocks < 0) return;
    Params p{};
    for (int i = 0; i < 35; ++i) p.in[i] = (const float*)d_in[i];
    p.out = (float*)d_out;
    p.ws = (unsigned char*)d_ws;
    if (hipMemsetAsync((char*)d_ws + WS_BAR, 0, 16384, stream) != hipSuccess) { fprintf(stderr, "kernel_launch: hipMemsetAsync failed\n"); return; }
    void* args[] = {&p};
    hipError_t e = hipLaunchCooperativeKernel((const void*)mega_fwd, dim3(grid_blocks), dim3(NTHREADS), args, LDS_BYTES, stream);
    if (e != hipSuccess) fprintf(stderr, "kernel_launch: cooperative launch failed: %s (grid %d)\n", hipGetErrorString(e), grid_blocks);
}
```

```cpp
#include <hip/hip_runtime.h>
#include <hip/hip_cooperative_groups.h>
#include <cstdio>
#include <cstdint>
namespace cg = cooperative_groups;

#define DEV __device__ __forceinline__
#ifndef REP
#define REP 0
#endif
#define GREPS(n) ((REP == (n)) ? 2 : 1)
#define REPEAT(n, stmt) do { if (REP == (n)) { stmt; SYNC(); } } while (0)

typedef unsigned short bf16_t;
typedef short bf16x8 __attribute__((ext_vector_type(8)));
typedef float f32x4 __attribute__((ext_vector_type(4)));
typedef __bf16 bf16x2v __attribute__((ext_vector_type(2)));

constexpr int D = 1024;
constexpr int NB = 8, SEQ = 8192, CTXL = 256;
constexpr int NL = NB * SEQ, NC = NB * CTXL, NT = NL + NC;
constexpr int NTHREADS = 512;
constexpr int LDS_BYTES = 160 * 1024;

constexpr size_t U_BYTES = (size_t)NT * 1024 * 2;
constexpr size_t WS_BAR = 0;
constexpr size_t WS_MOD = 16384;
constexpr size_t WS_CTXR = WS_MOD + (size_t)2 * 9 * 6144 * 4;
constexpr size_t WS_LR = WS_CTXR + (size_t)NC * 1024 * 4;
constexpr size_t WS_BONUS = WS_LR + (size_t)NT * 32 * 4;
constexpr size_t WS_WPROJ = WS_BONUS + (size_t)2 * NT * 16 * 4;
constexpr size_t WS_W2T = WS_WPROJ + (size_t)3456 * 1024 * 2;
constexpr size_t WS_A2T = WS_W2T + (size_t)2 * 1024 * 64 * 2;
constexpr size_t WS_G2T = WS_A2T + (size_t)2 * 1024 * 64 * 2;
constexpr size_t WS_WO0 = WS_G2T + (size_t)1024 * 128 * 2;
constexpr size_t WS_WO1 = WS_WO0 + (size_t)1024 * 1024 * 2;
constexpr size_t WS_WQ = WS_WO1 + (size_t)1024 * 1024 * 2;
constexpr size_t WS_KEYS = WS_WQ + (size_t)2 * 2048 * 1024 * 2;
constexpr size_t WS_WIN = WS_KEYS + (size_t)2 * 8 * 2 * 128 * 128 * 2;
constexpr size_t WS_PU = WS_WIN + (size_t)3200 * 1024 * 2;
constexpr size_t WS_PV = WS_PU + (size_t)2 * 16384 * 1024;
constexpr size_t WS_PSC = WS_PV + (size_t)2 * 16384 * 1024;
constexpr size_t WS_S = WS_PSC + (size_t)2 * 2 * 16384 * 4;
constexpr size_t WS_END = WS_S + 6 * U_BYTES;
static_assert(WS_END <= 1073741824ull, "workspace too large");
static_assert((WS_CTXR % 256) == 0 && (WS_WPROJ % 256) == 0 && (WS_S % 256) == 0, "alignment");

struct Params {
    const float* in[35];
    float* out;
    unsigned char* ws;
    int pad0, pad1;
};

DEV float bf_lo(unsigned u) { return __uint_as_float(u << 16); }
DEV float bf_hi(unsigned u) { return __uint_as_float(u & 0xffff0000u); }
typedef float f32x2v __attribute__((ext_vector_type(2)));
typedef unsigned int u32x2v __attribute__((ext_vector_type(2)));
typedef short s16x4v __attribute__((ext_vector_type(4)));
DEV unsigned pk_bf16(float lo, float hi) { const f32x2v f = {lo, hi}; union { bf16x2v v; unsigned u; } x; x.v = __builtin_convertvector(f, bf16x2v); return x.u; }
template <int N> DEV float dpp_ror(float x) { return __int_as_float(__builtin_amdgcn_update_dpp(0, __float_as_int(x), 0x120 + N, 0xF, 0xF, false)); }
DEV float row16_allreduce(float x) { x += dpp_ror<8>(x); x += dpp_ror<4>(x); x += dpp_ror<2>(x); x += dpp_ror<1>(x); return x; }
DEV float wave_allreduce(float x) { x = row16_allreduce(x); x += __shfl_xor(x, 16); x += __shfl_xor(x, 32); return x; }
DEV float sigmoidf_(float x) { return 1.0f / (1.0f + __expf(-x)); }
DEV float softplusf_(float z) { return fmaxf(z, 0.f) + __logf(1.0f + __expf(-fabsf(z))); }
DEV unsigned mono_u32(float f) { unsigned u = __float_as_uint(f); return u ^ ((u >> 31) ? 0xFFFFFFFFu : 0x80000000u); }
DEV float unmono_u32(unsigned k) { unsigned u = (k & 0x80000000u) ? (k ^ 0x80000000u) : ~k; return __uint_as_float(u); }
DEV bf16x8 as_bf16x8(uint4 v) { union { uint4 u; bf16x8 b; } x; x.u = v; return x.b; }
#define LAS3 __attribute__((address_space(3)))
extern __shared__ __attribute__((aligned(16))) unsigned char g_lds[];
constexpr int LDS_WTAB = LDS_BYTES - 128;
DEV unsigned hw_wave_slot() { return (unsigned)__builtin_amdgcn_s_getreg((5 << 11) | 4) & 63u; }
DEV int tid_opaque() {
    const int wv = (int)*(const volatile unsigned char*)(g_lds + LDS_WTAB + hw_wave_slot());
    int t = (wv << 6) | (int)__builtin_amdgcn_mbcnt_hi(~0u, __builtin_amdgcn_mbcnt_lo(~0u, 0u));
    asm volatile("" : "+v"(t));
    return t;
}
DEV int mod_batch(int R) { return R < NL ? (R >> 13) : 8; }

template <int BN, class AL, class EP>
DEV void gemm_unit(unsigned char* lds, const AL& al, const bf16_t* Bt, int K, int m0, const EP& ep) {
    constexpr int NI = BN / 64;
    constexpr int A_BYTES = 128 * 128;
    constexpr int B_BYTES = BN * 128;
    const int tid = tid_opaque(), lane = tid & 63, wv = tid >> 6, wm = wv >> 2, wn = wv & 3;
    const int fr = lane & 15, fq = lane >> 4;
    unsigned char* sA = lds;
    unsigned char* sB = lds + 2 * A_BYTES;
    f32x4 acc[4][NI];
#pragma unroll
    for (int mi = 0; mi < 4; ++mi)
#pragma unroll
        for (int ni = 0; ni < NI; ++ni) acc[mi][ni] = (f32x4){0.f, 0.f, 0.f, 0.f};
    const int KT = K >> 6;
    const int drow = tid >> 3, dch = (tid & 7) ^ (drow & 7);
    const bf16_t* bsrc = Bt + (size_t)drow * K + dch * 8;
    uint4 ra[2];
    auto stage = [&](int kt, int buf) {
        const int k0 = kt * 64;
#pragma unroll
        for (int i = 0; i < BN / 64; ++i)
            __builtin_amdgcn_global_load_lds((const unsigned*)(bsrc + (size_t)(64 * i) * K + k0), (unsigned*)(sB + buf * B_BYTES + i * 8192 + tid * 16), 16, 0, 0);
        if constexpr (AL::DMA) {
#pragma unroll
            for (int i = 0; i < 2; ++i)
                __builtin_amdgcn_global_load_lds((const unsigned*)(al.A + (size_t)(m0 + drow + 64 * i) * al.lda + k0 + dch * 8), (unsigned*)(sA + buf * A_BYTES + i * 8192 + tid * 16), 16, 0, 0);
        } else {
#pragma unroll
            for (int i = 0; i < 2; ++i) { const int q = tid + 512 * i; ra[i] = al.load(m0 + (q >> 3), k0 + (q & 7) * 8); }
        }
    };
    auto commit = [&](int buf) {
        if constexpr (!AL::DMA) {
#pragma unroll
            for (int i = 0; i < 2; ++i) { const int q = tid + 512 * i, row = q >> 3, ch = q & 7; *(uint4*)(sA + buf * A_BYTES + row * 128 + ((ch ^ (row & 7)) << 4)) = ra[i]; }
        }
    };
    auto compute = [&](int buf) {
        const unsigned char* a_base = sA + buf * A_BYTES;
        const unsigned char* b_base = sB + buf * B_BYTES;
#pragma unroll
        for (int ks = 0; ks < 2; ++ks) {
            bf16x8 af[4], bfr[NI];
            const int ch = ks * 4 + fq;
#pragma unroll
            for (int mi = 0; mi < 4; ++mi) { const int row = wm * 64 + mi * 16 + fr; af[mi] = *(const bf16x8*)(a_base + row * 128 + ((ch ^ (row & 7)) << 4)); }
#pragma unroll
            for (int ni = 0; ni < NI; ++ni) { const int row = wn * (BN / 4) + ni * 16 + fr; bfr[ni] = *(const bf16x8*)(b_base + row * 128 + ((ch ^ (row & 7)) << 4)); }
#pragma unroll
            for (int mi = 0; mi < 4; ++mi)
#pragma unroll
                for (int ni = 0; ni < NI; ++ni) acc[mi][ni] = __builtin_amdgcn_mfma_f32_16x16x32_bf16(bfr[ni], af[mi], acc[mi][ni], 0, 0, 0);
        }
    };
    if constexpr (AL::DMA) {
        constexpr int STG = A_BYTES + B_BYTES;
        auto stage3 = [&](int kt, int b3) {
            const int k0 = kt * 64;
            unsigned char* base = lds + b3 * STG;
#pragma unroll
            for (int i = 0; i < BN / 64; ++i)
                __builtin_amdgcn_global_load_lds((const unsigned*)(bsrc + (size_t)(64 * i) * K + k0), (unsigned*)(base + A_BYTES + i * 8192 + tid * 16), 16, 0, 0);
#pragma unroll
            for (int i = 0; i < 2; ++i)
                __builtin_amdgcn_global_load_lds((const unsigned*)(al.A + (size_t)(m0 + drow + 64 * i) * al.lda + k0 + dch * 8), (unsigned*)(base + i * 8192 + tid * 16), 16, 0, 0);
        };
        auto compute3 = [&](int b3) {
            const unsigned char* a_base = lds + b3 * STG;
            const unsigned char* b_base = a_base + A_BYTES;
#pragma unroll
            for (int ks = 0; ks < 2; ++ks) {
                bf16x8 af[4], bfr[NI];
                const int ch = ks * 4 + fq;
#pragma unroll
                for (int mi = 0; mi < 4; ++mi) { const int row = wm * 64 + mi * 16 + fr; af[mi] = *(const bf16x8*)(a_base + row * 128 + ((ch ^ (row & 7)) << 4)); }
#pragma unroll
                for (int ni = 0; ni < NI; ++ni) { const int row = wn * (BN / 4) + ni * 16 + fr; bfr[ni] = *(const bf16x8*)(b_base + row * 128 + ((ch ^ (row & 7)) << 4)); }
#pragma unroll
                for (int mi = 0; mi < 4; ++mi)
#pragma unroll
                    for (int ni = 0; ni < NI; ++ni) acc[mi][ni] = __builtin_amdgcn_mfma_f32_16x16x32_bf16(bfr[ni], af[mi], acc[mi][ni], 0, 0, 0);
            }
        };
        stage3(0, 0);
        stage3(1, 1);
        int b3 = 0;
        for (int kt = 0; kt < KT; ++kt) {
            if (kt + 1 < KT) { if constexpr (BN == 256) asm volatile("s_waitcnt vmcnt(6)" ::: "memory"); else asm volatile("s_waitcnt vmcnt(4)" ::: "memory"); }
            else asm volatile("s_waitcnt vmcnt(0)" ::: "memory");
            asm volatile("s_waitcnt lgkmcnt(0)" ::: "memory");
            __builtin_amdgcn_s_barrier();
            asm volatile("" ::: "memory");
            const int bn = (b3 == 0) ? 2 : b3 - 1;
            if (kt + 2 < KT) stage3(kt + 2, bn);
            compute3(b3);
            b3 = (b3 == 2) ? 0 : b3 + 1;
        }
        asm volatile("s_waitcnt lgkmcnt(0)" ::: "memory");
        __builtin_amdgcn_s_barrier();
        asm volatile("" ::: "memory");
    } else {
        stage(0, 0);
        commit(0);
        asm volatile("s_waitcnt vmcnt(0)" ::: "memory");
        __syncthreads();
        for (int kt = 0; kt < KT; ++kt) {
            const int cur = kt & 1;
            const bool more = (kt + 1 < KT);
            if (more) stage(kt + 1, cur ^ 1);
            compute(cur);
            if (more) commit(cur ^ 1);
            asm volatile("s_waitcnt vmcnt(0)" ::: "memory");
            __syncthreads();
        }
    }
    ep(acc, m0, wm, wn, fr, fq);
}

struct ALoadPlain {
    static constexpr bool DMA = true;
    const bf16_t* A; int lda;
    DEV uint4 load(int R, int k) const { return *(const uint4*)(A + (size_t)R * lda + k); }
};
struct ALoadMix {
    static constexpr bool DMA = false;
    const bf16_t* h; const float* mix; const bf16_t* A; int lda;
    DEV uint4 load(int R, int k) const {
        const bf16_t* pc = h + (size_t)R * 1024 + k;
        const uint4 c = *(const uint4*)pc;
        const int t = (R < NL) ? (R & 8191) : ((R - NL) & 255);
        const int last = (R < NL) ? 8191 : 255;
        uint4 pv = *(const uint4*)(pc - (t != 0 ? 1024 : 0)), nv = *(const uint4*)(pc + (t != last ? 1024 : 0));
        if (t == 0) pv = make_uint4(0, 0, 0, 0);
        if (t == last) nv = make_uint4(0, 0, 0, 0);
        const float4 m0 = *(const float4*)(mix + k), m1 = *(const float4*)(mix + k + 4);
        const unsigned cc[4] = {c.x, c.y, c.z, c.w}, pp[4] = {pv.x, pv.y, pv.z, pv.w}, nn[4] = {nv.x, nv.y, nv.z, nv.w};
        const float mm[8] = {m0.x, m0.y, m0.z, m0.w, m1.x, m1.y, m1.z, m1.w};
        unsigned o[4];
#pragma unroll
        for (int i = 0; i < 4; ++i) {
            const float hc0 = bf_lo(cc[i]), hc1 = bf_hi(cc[i]);
            const float s0 = 0.5f * (bf_lo(pp[i]) + bf_lo(nn[i])), s1 = 0.5f * (bf_hi(pp[i]) + bf_hi(nn[i]));
            o[i] = pk_bf16(hc0 + (s0 - hc0) * mm[2 * i], hc1 + (s1 - hc1) * mm[2 * i + 1]);
        }
        return make_uint4(o[0], o[1], o[2], o[3]);
    }
};

struct TrJob { int in_idx, src_off, K, N, src_ld, dst_ld; unsigned long long dst_off; int tile0; };
constexpr int NTRJOBS = 19;
__device__ const TrJob g_trjobs[NTRJOBS] = {
    {9, 0 * 1048576, 1024, 1024, 1024, 1024, WS_WPROJ + 0ull * 1024 * 1024 * 2, 0},
    {9, 1 * 1048576, 1024, 1024, 1024, 1024, WS_WPROJ + 1ull * 1024 * 1024 * 2, 256},
    {9, 2 * 1048576, 1024, 1024, 1024, 1024, WS_WPROJ + 2ull * 1024 * 1024 * 2, 512},
    {11, 0, 1024, 64, 64, 1024, WS_WPROJ + 3072ull * 1024 * 2, 768},
    {11, 65536, 1024, 64, 64, 1024, WS_WPROJ + 3136ull * 1024 * 2, 784},
    {14, 0, 1024, 64, 64, 1024, WS_WPROJ + 3200ull * 1024 * 2, 800},
    {14, 65536, 1024, 64, 64, 1024, WS_WPROJ + 3264ull * 1024 * 2, 816},
    {16, 0, 1024, 128, 128, 1024, WS_WPROJ + 3328ull * 1024 * 2, 832},
    {12, 0, 64, 1024, 1024, 64, WS_W2T, 864},
    {12, 65536, 64, 1024, 1024, 64, WS_W2T + 1024ull * 64 * 2, 880},
    {15, 0, 64, 1024, 1024, 64, WS_A2T, 896},
    {15, 65536, 64, 1024, 1024, 64, WS_A2T + 1024ull * 64 * 2, 912},
    {17, 0, 128, 1024, 1024, 128, WS_G2T, 928},
    {23, 0, 1024, 1024, 1024, 1024, WS_WO0, 960},
    {29, 0, 1024, 1024, 1024, 1024, WS_WO1, 1216},
    {30, 0, 1024, 2048, 2048, 1024, WS_WQ, 1472},
    {30, 2097152, 1024, 2048, 2048, 1024, WS_WQ + 2048ull * 1024 * 2, 1984},
    {24, 0, 1024, 3104, 3104, 1024, WS_WIN, 2496},
    {0, 0, 0, 0, 0, 0, 0, 2496 + 16 * 49},
};
constexpr int NTRTILES = 2496 + 16 * 49;

DEV void phase0(const Params& p, unsigned char* lds) {
    const int tid = tid_opaque();
    unsigned char* ws = p.ws;
    {
        float* sc = (float*)lds;
        float* red = sc + 9 * 1024;
        float* mods = (float*)(ws + WS_MOD);
        bool have_sc = false;
        for (int task = blockIdx.x; task < 192; task += gridDim.x) {
            if (!have_sc) {
                for (int i = tid; i < 9 * 1024; i += NTHREADS) {
                    const int mb = i >> 10, k = i & 1023;
                    const float cv = mb < 8 ? p.in[1][mb * 1024 + k] : p.in[3][k];
                    sc[i] = cv / (1.0f + __expf(-cv));
                }
                have_sc = true;
            }
            __syncthreads();
            const int l = task / 96, nb = task % 96;
            const int nn = tid & 63, kg = tid >> 6;
            const float* w = p.in[4] + (size_t)l * 1024 * 6144 + nb * 64 + nn;
            float acc[9];
#pragma unroll
            for (int m = 0; m < 9; ++m) acc[m] = 0.f;
            for (int k = kg * 128; k < kg * 128 + 128; ++k) {
                const float wv = w[(size_t)k * 6144];
#pragma unroll
                for (int m = 0; m < 9; ++m) acc[m] += sc[m * 1024 + k] * wv;
            }
#pragma unroll
            for (int m = 0; m < 9; ++m) red[(kg * 9 + m) * 64 + nn] = acc[m];
            __syncthreads();
            for (int i = tid; i < 576; i += NTHREADS) {
                const int m = i >> 6, n2 = i & 63;
                float s = p.in[5][l * 6144 + nb * 64 + n2];
#pragma unroll
                for (int g = 0; g < 8; ++g) s += red[(g * 9 + m) * 64 + n2];
                mods[(size_t)(l * 9 + m) * 6144 + nb * 64 + n2] = s;
            }
            __syncthreads();
        }
        __syncthreads();
    }
    {
        float* tile = (float*)lds;
        for (int tt = blockIdx.x; tt < NTRTILES; tt += gridDim.x) {
            int j = 0;
#pragma unroll 1
            while (j + 1 < NTRJOBS && g_trjobs[j + 1].tile0 <= tt) ++j;
            const TrJob jb = g_trjobs[j];
            const int tl = tt - jb.tile0;
            const int ntn = (jb.N + 63) >> 6;
            const int k0 = (tl / ntn) * 64, n0 = (tl % ntn) * 64;
            const float* src = p.in[jb.in_idx] + jb.src_off;
            bf16_t* dst = (bf16_t*)(ws + jb.dst_off);
            {
                const int kr = tid >> 4, nc4 = (tid & 15) * 4;
#pragma unroll
                for (int i = 0; i < 2; ++i) {
                    const int kk = kr + 32 * i;
                    float4 v = make_float4(0.f, 0.f, 0.f, 0.f);
                    if (n0 + nc4 < jb.N) v = *(const float4*)(src + (size_t)(k0 + kk) * jb.src_ld + n0 + nc4);
                    tile[kk * 65 + nc4 + 0] = v.x; tile[kk * 65 + nc4 + 1] = v.y; tile[kk * 65 + nc4 + 2] = v.z; tile[kk * 65 + nc4 + 3] = v.w;
                }
            }
            __syncthreads();
            {
                const int nn = tid >> 3, kc = (tid & 7) * 8;
                if (n0 + nn < jb.N) {
                    unsigned o[4];
#pragma unroll
                    for (int i = 0; i < 4; ++i) o[i] = pk_bf16(tile[(kc + 2 * i) * 65 + nn], tile[(kc + 2 * i + 1) * 65 + nn]);
                    *(uint4*)(dst + (size_t)(n0 + nn) * jb.dst_ld + k0 + kc) = make_uint4(o[0], o[1], o[2], o[3]);
                }
            }
            __syncthreads();
        }
    }
    {
        const size_t gtid = (size_t)blockIdx.x * NTHREADS + tid, gstride = (size_t)gridDim.x * NTHREADS;
        {
            const float* src = p.in[31];
            bf16_t* dst = (bf16_t*)(ws + WS_KEYS);
            const size_t n8 = (size_t)2 * 8 * 2 * 128 * 128 / 8;
            for (size_t i = gtid; i < n8; i += gstride) {
                const float4 a = *(const float4*)(src + i * 8), b = *(const float4*)(src + i * 8 + 4);
                *(uint4*)(dst + i * 8) = make_uint4(pk_bf16(a.x, a.y), pk_bf16(a.z, a.w), pk_bf16(b.x, b.y), pk_bf16(b.z, b.w));
            }
        }
        bf16_t* wpad = (bf16_t*)(ws + WS_WIN) + (size_t)3104 * 1024;
        for (size_t i = gtid; i < (size_t)96 * 1024 / 8; i += gstride) *(uint4*)(wpad + i * 8) = make_uint4(0, 0, 0, 0);
        const int lane = tid & 63;
        const int gw = blockIdx.x * 8 + (tid >> 6), nw = gridDim.x * 8;
        float* scales = (float*)(ws + WS_PSC);
        for (int rowi = gw * 32; rowi < 2 * 32768; rowi += nw * 32)
        for (int row2 = rowi; row2 < rowi + 32; row2 += 4) {
            float4 v[4][4]; float am[4];
#pragma unroll
            for (int q = 0; q < 4; ++q) {
                const int row = row2 + q, tbl = row >> 15, r = row & 32767;
                const float* srow = p.in[32 + tbl] + (size_t)r * 1024;
                am[q] = 0.f;
#pragma unroll
                for (int i = 0; i < 4; ++i) { v[q][i] = *(const float4*)(srow + 16 * lane + 4 * i); am[q] = fmaxf(am[q], fmaxf(fmaxf(fabsf(v[q][i].x), fabsf(v[q][i].y)), fmaxf(fabsf(v[q][i].z), fabsf(v[q][i].w)))); }
            }
#pragma unroll
            for (int o = 1; o < 64; o <<= 1) { const float a0 = __shfl_xor(am[0], o), a1 = __shfl_xor(am[1], o), a2 = __shfl_xor(am[2], o), a3 = __shfl_xor(am[3], o); am[0] = fmaxf(am[0], a0); am[1] = fmaxf(am[1], a1); am[2] = fmaxf(am[2], a2); am[3] = fmaxf(am[3], a3); }
#pragma unroll
            for (int q = 0; q < 4; ++q) {
                const int row = row2 + q, tbl = row >> 15, r = row & 32767;
                const float scale = am[q] > 0.f ? am[q] * (1.0f / 448.0f) : 1.0f;
                const float inv = 1.0f / scale;
                unsigned w[4];
#pragma unroll
                for (int i = 0; i < 4; ++i) {
                    int t = 0;
                    t = __builtin_amdgcn_cvt_pk_fp8_f32(v[q][i].x * inv, v[q][i].y * inv, t, false);
                    t = __builtin_amdgcn_cvt_pk_fp8_f32(v[q][i].z * inv, v[q][i].w * inv, t, true);
                    w[i] = (unsigned)t;
                }
                *(uint4*)(ws + (tbl ? WS_PV : WS_PU) + ((size_t)(r >> 14) * 8 + (lane >> 3)) * (16384 * 128) + (size_t)(r & 16383) * 128 + 16 * (lane & 7)) = make_uint4(w[0], w[1], w[2], w[3]);
                if (lane == 0) scales[tbl * 32768 + r] = scale;
            }
        }
    }
}

DEV void normmod_store(const float4 (&v)[4], float ss, const float* g, const float* shift, const float* scale, bf16_t* dst, unsigned char* xq, int lane) {
    const float rs = rsqrtf(ss * (1.0f / 1024.0f) + 1e-6f);
#pragma unroll
    for (int i = 0; i < 4; ++i) {
        const int col = i * 256 + lane * 4;
        const float4 gg = *(const float4*)(g + col), sh = *(const float4*)(shift + col), sc = *(const float4*)(scale + col);
        const float y0 = v[i].x * rs * gg.x * (1.f + sc.x) + sh.x, y1 = v[i].y * rs * gg.y * (1.f + sc.y) + sh.y;
        const float y2 = v[i].z * rs * gg.z * (1.f + sc.z) + sh.z, y3 = v[i].w * rs * gg.w * (1.f + sc.w) + sh.w;
        *(uint2*)(dst + col) = make_uint2(pk_bf16(y0, y1), pk_bf16(y2, y3));
        if (xq) {
            const float z0 = __builtin_amdgcn_fmed3f(4.f * y0, -448.f, 448.f), z1 = __builtin_amdgcn_fmed3f(4.f * y1, -448.f, 448.f);
            const float z2 = __builtin_amdgcn_fmed3f(4.f * y2, -448.f, 448.f), z3 = __builtin_amdgcn_fmed3f(4.f * y3, -448.f, 448.f);
            int hi = __builtin_amdgcn_cvt_pk_fp8_f32(z0, z1, 0, false); hi = __builtin_amdgcn_cvt_pk_fp8_f32(z2, z3, hi, true);
            const f32x2v h01 = __builtin_amdgcn_cvt_pk_f32_fp8(hi, false), h23 = __builtin_amdgcn_cvt_pk_f32_fp8(hi, true);
            int lo = __builtin_amdgcn_cvt_pk_fp8_f32(z0 - h01.x, z1 - h01.y, 0, false); lo = __builtin_amdgcn_cvt_pk_fp8_f32(z2 - h23.x, z3 - h23.y, lo, true);
            *(int*)(xq + col) = hi; *(int*)(xq + 1024 + col) = lo;
        }
    }
}
DEV void phase_normmod(const Params& p, int layer, int which, const float* xl, const float* xc, int nrows, bf16_t* dst, unsigned char* xq) {
    const int tid = tid_opaque(), lane = tid & 63;
    const int gw = blockIdx.x * 8 + (tid >> 6), nw = gridDim.x * 8;
    const float* mods = (const float*)(p.ws + WS_MOD) + (size_t)layer * 9 * 6144;
    const float* g = p.in[which ? 7 : 6] + layer * 1024;
    for (int R = gw; R < nrows; R += nw) {
        const float* xr = R < NL ? xl + (size_t)R * 1024 : xc + (size_t)(R - NL) * 1024;
        float4 v[4]; float ss = 0.f;
#pragma unroll
        for (int i = 0; i < 4; ++i) { v[i] = *(const float4*)(xr + i * 256 + lane * 4); ss += v[i].x * v[i].x + v[i].y * v[i].y + v[i].z * v[i].z + v[i].w * v[i].w; }
        ss = wave_allreduce(ss);
        const float* mrow = mods + (size_t)mod_batch(R) * 6144 + (which ? 3 : 0) * 1024;
        normmod_store(v, ss, g, mrow, mrow + 1024, dst + (size_t)R * 1024, xq ? xq + (size_t)R * 2048 : nullptr, lane);
    }
}
DEV void phase_normmix(const Params& p, bf16_t* hdst, bf16_t* xr, bf16_t* xk, bf16_t* xv) {
    const int tid = tid_opaque(), lane = tid & 63;
    const int gw = __builtin_amdgcn_readfirstlane(blockIdx.x * 8 + (tid >> 6)), nw = gridDim.x * 8;
    const float* mods = (const float*)(p.ws + WS_MOD);
    const float* g = p.in[6];
    for (int run = gw; run < NT / 8; run += nw) {
        const int R0 = run * 8;
        const int t0 = R0 < NL ? (R0 & 8191) : ((R0 - NL) & 255), slen = R0 < NL ? 8192 : 256;
        const float* mrow = mods + (size_t)mod_batch(R0) * 6144;
        float4 gg[4], sh[4], sc[4], m0[4], m2[4], m3[4];
#pragma unroll
        for (int i = 0; i < 4; ++i) {
            const int col = i * 256 + lane * 4;
            gg[i] = *(const float4*)(g + col); sh[i] = *(const float4*)(mrow + col); sc[i] = *(const float4*)(mrow + 1024 + col);
            m0[i] = *(const float4*)(p.in[8] + col); m2[i] = *(const float4*)(p.in[8] + 2 * 1024 + col); m3[i] = *(const float4*)(p.in[8] + 3 * 1024 + col);
        }
        auto hrow = [&](int R, float4 (&h)[4]) {
            const float* xrw = R < NL ? p.in[0] + (size_t)R * 1024 : p.in[2] + (size_t)(R - NL) * 1024;
            float ss = 0.f;
#pragma unroll
            for (int i = 0; i < 4; ++i) { h[i] = *(const float4*)(xrw + i * 256 + lane * 4); ss += h[i].x * h[i].x + h[i].y * h[i].y + h[i].z * h[i].z + h[i].w * h[i].w; }
            ss = wave_allreduce(ss);
            const float rs = rsqrtf(ss * (1.0f / 1024.0f) + 1e-6f);
#pragma unroll
            for (int i = 0; i < 4; ++i) {
                h[i].x = h[i].x * rs * gg[i].x * (1.f + sc[i].x) + sh[i].x; h[i].y = h[i].y * rs * gg[i].y * (1.f + sc[i].y) + sh[i].y;
                h[i].z = h[i].z * rs * gg[i].z * (1.f + sc[i].z) + sh[i].z; h[i].w = h[i].w * rs * gg[i].w * (1.f + sc[i].w) + sh[i].w;
            }
        };
        float4 hp[4], hc[4], hn[4];
        if (t0 > 0) hrow(R0 - 1, hp); else { hp[0] = hp[1] = hp[2] = hp[3] = make_float4(0.f, 0.f, 0.f, 0.f); }
        hrow(R0, hc);
#pragma unroll 1
        for (int i8 = 0; i8 < 8; ++i8) {
            const int R = R0 + i8;
            if (t0 + i8 + 1 < slen) hrow(R + 1, hn); else { hn[0] = hn[1] = hn[2] = hn[3] = make_float4(0.f, 0.f, 0.f, 0.f); }
#pragma unroll
            for (int i = 0; i < 4; ++i) {
                const size_t o = (size_t)R * 1024 + i * 256 + lane * 4;
                const float4 c = hc[i];
                const float4 xx = make_float4(0.5f * (hp[i].x + hn[i].x) - c.x, 0.5f * (hp[i].y + hn[i].y) - c.y, 0.5f * (hp[i].z + hn[i].z) - c.z, 0.5f * (hp[i].w + hn[i].w) - c.w);
                *(uint2*)(hdst + o) = make_uint2(pk_bf16(c.x, c.y), pk_bf16(c.z, c.w));
                *(uint2*)(xr + o) = make_uint2(pk_bf16(c.x + xx.x * m0[i].x, c.y + xx.y * m0[i].y), pk_bf16(c.z + xx.z * m0[i].z, c.w + xx.w * m0[i].w));
                *(uint2*)(xk + o) = make_uint2(pk_bf16(c.x + xx.x * m2[i].x, c.y + xx.y * m2[i].y), pk_bf16(c.z + xx.z * m2[i].z, c.w + xx.w * m2[i].w));
                *(uint2*)(xv + o) = make_uint2(pk_bf16(c.x + xx.x * m3[i].x, c.y + xx.y * m3[i].y), pk_bf16(c.z + xx.z * m3[i].z, c.w + xx.w * m3[i].w));
            }
#pragma unroll
            for (int i = 0; i < 4; ++i) { hp[i] = hc[i]; hc[i] = hn[i]; }
        }
    }
}

template <int BN> struct EpiBf16 {
    bf16_t* dst; int ldd; int col0; int act;
    DEV void operator()(const f32x4 (&acc)[4][BN / 64], int m0, int wm, int wn, int fr, int fq) const {
#pragma unroll
        for (int mi = 0; mi < 4; ++mi) {
            const size_t R = (size_t)(m0 + wm * 64 + mi * 16 + fr);
#pragma unroll
            for (int ni = 0; ni < BN / 64; ++ni) {
                const int col = col0 + wn * (BN / 4) + ni * 16 + 4 * fq;
                float v[4] = {acc[mi][ni][0], acc[mi][ni][1], acc[mi][ni][2], acc[mi][ni][3]};
                if (act == 1) {
#pragma unroll
                    for (int j = 0; j < 4; ++j) v[j] = tanhf(v[j]);
                } else if (act == 2) {
#pragma unroll
                    for (int j = 0; j < 4; ++j) v[j] = sigmoidf_(v[j]);
                }
                *(uint2*)(dst + R * ldd + col) = make_uint2(pk_bf16(v[0], v[1]), pk_bf16(v[2], v[3]));
            }
        }
    }
};
struct EpiResid {
    const float* xold_lat; const float* xold_ctx; float* dst_lat; float* dst_ctx; const float* gate; int col0;
    DEV void operator()(const f32x4 (&acc)[4][4], int m0, int wm, int wn, int fr, int fq) const {
#pragma unroll
        for (int mi = 0; mi < 4; ++mi) {
            const int R = m0 + wm * 64 + mi * 16 + fr;
            const float* src = R < NL ? xold_lat + (size_t)R * 1024 : xold_ctx + (size_t)(R - NL) * 1024;
            float* dst = R < NL ? dst_lat + (size_t)R * 1024 : dst_ctx + (size_t)(R - NL) * 1024;
            const float* gr = gate + (size_t)mod_batch(R) * 6144;
#pragma unroll
            for (int ni = 0; ni < 4; ++ni) {
                const int col = col0 + wn * 64 + ni * 16 + 4 * fq;
                const float4 xo = *(const float4*)(src + col), g4 = *(const float4*)(gr + col);
                *(float4*)(dst + col) = make_float4(xo.x + g4.x * acc[mi][ni][0], xo.y + g4.y * acc[mi][ni][1], xo.z + g4.z * acc[mi][ni][2], xo.w + g4.w * acc[mi][ni][3]);
            }
        }
    }
};
struct EpiLr {
    float* dst;
    DEV void operator()(const f32x4 (&acc)[4][2], int m0, int wm, int wn, int fr, int fq) const {
        if (wn != 0) return;
#pragma unroll
        for (int mi = 0; mi < 4; ++mi) {
            const size_t R = (size_t)(m0 + wm * 64 + mi * 16 + fr);
#pragma unroll
            for (int ni = 0; ni < 2; ++ni) { const int col = ni * 16 + 4 * fq; *(float4*)(dst + R * 32 + col) = make_float4(acc[mi][ni][0], acc[mi][ni][1], acc[mi][ni][2], acc[mi][ni][3]); }
        }
    }
};

namespace pg8 {
#define PG8_LAS __attribute__((address_space(3)))
constexpr int BM = 256, BK = 64, HALF = 128, HTB = HALF * BK * 2  , STAGE_BYTES = 8 * HTB, NXCD = 8, WGM = 8;

__host__ __device__ __forceinline__ int lds_byte(int r, int c) { const int st = (r >> 4) * 2 + (c >> 5), rr = r & 15, cc = c & 31, ob = rr * 64 + cc * 2; return st * 1024 + (ob ^ (((ob >> 9) & 1) << 5)); }
__host__ __device__ __forceinline__ void stage_rc(int b, int& R, int& C) { const int st = b / 1024, sb = b % 1024, swz = sb ^ (((sb >> 9) & 1) << 5); R = (st >> 1) * 16 + swz / 64; C = (st & 1) * 32 + (swz % 64) / 2; }
__host__ __device__ __forceinline__ int perm32(int rho) { const int n = rho >> 4, i = rho & 15; return 8 * (i >> 2) + 4 * n + (i & 3); }
struct Unit { int pm, pn; };
struct Gemm { const bf16_t* A; const bf16_t* Bt; int M, N, K; };
struct StaticOrder {
    int nM, nN, nwg, G, c;
    __host__ __device__ void init(int M, int N, int G_, int c_) { nM = M / BM; nN = N / BM; nwg = nM * nN; G = G_; c = c_; }
    __host__ __device__ bool next(int i, Unit& u) const {
        const long L = (long)i * G + c; if (L >= nwg) return false;
        int wgid = (int)L; { const int q = nwg / NXCD, r = nwg % NXCD, xcd = wgid % NXCD, off = wgid / NXCD; wgid = (xcd < r ? xcd * (q + 1) : r * (q + 1) + (xcd - r) * q) + off; }
        const int nig = WGM * nN, gid = wgid / nig, fm = gid * WGM, gsz = (nM - fm) < WGM ? (nM - fm) : WGM;
        u.pm = fm + ((wgid % nig) % gsz); u.pn = (wgid % nig) / gsz; return true;
    }
    __device__ __forceinline__ void a_ready(const Unit&) const {}
    __device__ __forceinline__ void done(const Unit&) const {}
};
template <class Epi, class Sched, bool STAMP = false>
__device__ __forceinline__ void gemm_phase(PG8_LAS unsigned char* lds, const Gemm g, const Sched& S, const Epi& E, unsigned long long* stamps) {
    const int tid = tid_opaque(), wid = __builtin_amdgcn_readfirstlane(tid >> 6), lane = tid & 63, wr = wid >> 2, wc = wid & 3, fr = lane & 15, fq = lane >> 4;
    const int K = g.K, nt = K / BK;
    int ts_lo = 0, ts_hi = 0, nts = 0; const unsigned long long rt_entry = STAMP ? (unsigned long long)wall_clock64() : 0ull;
#define PG8_STAMP() do { if (STAMP && wid == 0 && nts < 64) { const unsigned long long _c = (unsigned long long)clock64(); \
        ts_lo = (lane == nts) ? (int)(unsigned)_c : ts_lo; ts_hi = (lane == nts) ? (int)(unsigned)(_c >> 32) : ts_hi; ++nts; } } while (0)
    PG8_STAMP();
    unsigned voffA[2], voffB[2];
#pragma unroll
    for (int i = 0; i < 2; ++i) { int R, C; stage_rc(tid * 16 + i * 8192, R, C); const int Rb = Epi::PERM ? ((R & ~31) + perm32(R & 31)) : R;
        voffA[i] = (unsigned)(R * K + C) * 2u; voffB[i] = (unsigned)(Rb * K + C) * 2u; }
    const size_t kstep = (size_t)(BK * 2);
    const size_t hstep = (size_t)HALF * K * 2;
    const size_t tstep = 2 * hstep;
    const unsigned ldsw = (unsigned)wid * 1024u;
    const int aoff = lds_byte(wr * 64 + fr, fq * 8), boff = lds_byte(wc * 32 + fr, fq * 8);
#define PG8_SA(b, h) (((b) * 2 + (h)) * HTB)
#define PG8_SB(b, h) ((4 + (b) * 2 + (h)) * HTB)
#define PG8_STAGE(bufoff, gbase, voff) do { _Pragma("unroll") for (int _i = 0; _i < 2; ++_i) \
        __builtin_amdgcn_global_load_lds((const unsigned*)((const char*)(gbase) + (voff)[_i]), (PG8_LAS unsigned*)(lds + (bufoff) + ldsw + _i * 8192), 16, 0, 0); } while (0)
#define PG8_LDA(dst, b, h) do { _Pragma("unroll") for (int m = 0; m < 4; ++m) _Pragma("unroll") for (int k = 0; k < 2; ++k) dst[m][k] = *(const PG8_LAS bf16x8*)(lds + PG8_SA(b, h) + aoff + m * 2048 + k * 1024); } while (0)
#define PG8_LDB(dst, b, h) do { _Pragma("unroll") for (int n = 0; n < 2; ++n) _Pragma("unroll") for (int k = 0; k < 2; ++k) dst[n][k] = *(const PG8_LAS bf16x8*)(lds + PG8_SB(b, h) + boff + n * 2048 + k * 1024); } while (0)
#define PG8_MMA(ai, bj, At, Bt) do { __builtin_amdgcn_s_setprio(1); _Pragma("unroll") for (int m = 0; m < 4; ++m) _Pragma("unroll") for (int n = 0; n < 2; ++n) _Pragma("unroll") for (int k = 0; k < 2; ++k) \
        acc[ai][bj][m][n] = __builtin_amdgcn_mfma_f32_16x16x32_bf16(Bt[n][k], At[m][k], acc[ai][bj][m][n], 0, 0, 0); __builtin_amdgcn_s_setprio(0); } while (0)
#define PG8_WAIT_V(n) asm volatile("s_waitcnt vmcnt(" #n ")" ::: "memory")
#define PG8_WAIT_L(n) asm volatile("s_waitcnt lgkmcnt(" #n ")" ::: "memory")
#define PG8_BAR __builtin_amdgcn_s_barrier()
#define PG8_SCHED __builtin_amdgcn_sched_barrier(0)
    Unit cur, nxt; int ui = 0;
    if (!S.next(0, cur)) return;
    f32x4 acc[2][2][4][2];
#pragma unroll
    for (int a = 0; a < 2; ++a)
#pragma unroll
        for (int b = 0; b < 2; ++b)
#pragma unroll
            for (int m = 0; m < 4; ++m)
#pragma unroll
                for (int n = 0; n < 2; ++n) acc[a][b][m][n] = (f32x4){0.f, 0.f, 0.f, 0.f};
    bf16x8 At[4][2], B0[2][2], B1[2][2];
    const char* cA = (const char*)g.A + (size_t)cur.pm * tstep; const char* cB = (const char*)g.Bt + (size_t)cur.pn * tstep;
    S.a_ready(cur);
    PG8_STAGE(PG8_SB(0, 0), cB, voffB); PG8_STAGE(PG8_SA(0, 0), cA, voffA); PG8_STAGE(PG8_SB(0, 1), cB + hstep, voffB); PG8_STAGE(PG8_SA(0, 1), cA + hstep, voffA);
    if (wr == 1) PG8_BAR;
    PG8_WAIT_V(4); PG8_BAR;
    PG8_STAGE(PG8_SB(1, 0), cB + kstep, voffB); PG8_STAGE(PG8_SA(1, 0), cA + kstep, voffA); PG8_STAGE(PG8_SB(1, 1), cB + hstep + kstep, voffB);
    PG8_WAIT_V(6); PG8_BAR;
    PG8_STAMP();
    for (;;) {
        const bool has_next = S.next(ui + 1, nxt);
        const char* nA = has_next ? (const char*)g.A + (size_t)nxt.pm * tstep : cA; const char* nB = has_next ? (const char*)g.Bt + (size_t)nxt.pn * tstep : cB;
        for (int t = 0; t < nt; t += 2) {
            const bool last = (t == nt - 2);
            const char* a1 = cA + (size_t)(t + 1) * kstep;
            const char* a2 = last ? nA : cA + (size_t)(t + 2) * kstep; const char* b2 = last ? nB : cB + (size_t)(t + 2) * kstep;
            const char* a3 = a2 + kstep; const char* b3 = b2 + kstep;
            if (last && has_next) S.a_ready(nxt);
            PG8_LDB(B0, 0, 0); PG8_SCHED; PG8_LDA(At, 0, 0); PG8_STAGE(PG8_SA(1, 1), a1 + hstep, voffA);
            PG8_WAIT_L(8); PG8_BAR; PG8_WAIT_L(0); PG8_MMA(0, 0, At, B0); PG8_BAR; PG8_SCHED;
            PG8_LDB(B1, 0, 1); PG8_STAGE(PG8_SB(0, 0), b2, voffB);
            PG8_BAR; PG8_WAIT_L(0); PG8_MMA(0, 1, At, B1); PG8_BAR;
            PG8_LDA(At, 0, 1); PG8_STAGE(PG8_SA(0, 0), a2, voffA);
            PG8_BAR; PG8_WAIT_L(0); PG8_MMA(1, 0, At, B0); PG8_BAR; PG8_SCHED;
            PG8_STAGE(PG8_SB(0, 1), b2 + hstep, voffB);
            PG8_WAIT_V(6); PG8_BAR; PG8_MMA(1, 1, At, B1); PG8_BAR;
            PG8_LDB(B0, 1, 0); PG8_SCHED; PG8_LDA(At, 1, 0); PG8_STAGE(PG8_SA(0, 1), a2 + hstep, voffA);
            PG8_WAIT_L(8); PG8_BAR; PG8_WAIT_L(0); PG8_MMA(0, 0, At, B0); PG8_BAR; PG8_SCHED;
            PG8_LDB(B1, 1, 1); PG8_STAGE(PG8_SB(1, 0), b3, voffB);
            PG8_BAR; PG8_WAIT_L(0); PG8_MMA(0, 1, At, B1); PG8_BAR;
            PG8_LDA(At, 1, 1); PG8_STAGE(PG8_SA(1, 0), a3, voffA);
            PG8_BAR; PG8_WAIT_L(0); PG8_MMA(1, 0, At, B0); PG8_BAR; PG8_SCHED;
            PG8_STAGE(PG8_SB(1, 1), b3 + hstep, voffB);
            PG8_WAIT_V(6); PG8_BAR; PG8_MMA(1, 1, At, B1); PG8_BAR;
        }
        PG8_STAMP();
        if constexpr (!Epi::AFTER_DRAIN) { E(acc, cur, wr, wc, fr, fq); S.done(cur); }
        PG8_STAMP();
        if (!has_next) break;
#pragma unroll
        for (int a = 0; a < 2; ++a)
#pragma unroll
            for (int b = 0; b < 2; ++b)
#pragma unroll
                for (int m = 0; m < 4; ++m)
#pragma unroll
                    for (int n = 0; n < 2; ++n) acc[a][b][m][n] = (f32x4){0.f, 0.f, 0.f, 0.f};
        cur = nxt; cA = nA; cB = nB; ++ui;
    }
    PG8_WAIT_V(0);
    if (wr == 0) PG8_BAR;
    PG8_BAR;
    if constexpr (Epi::AFTER_DRAIN) { E.fused(acc, cur, wr, wc, fr, fq, lds, wid, lane); S.done(cur); }
    PG8_STAMP();
    if (STAMP && wid == 0) { stamps[lane] = lane < nts ? (((unsigned long long)(unsigned)ts_hi << 32) | (unsigned)ts_lo) : 0ull;
        if (lane == 62) stamps[62] = rt_entry; if (lane == 63) stamps[63] = (unsigned long long)wall_clock64(); }
#undef PG8_STAMP
#undef PG8_SA
#undef PG8_SB
#undef PG8_STAGE
#undef PG8_LDA
#undef PG8_LDB
#undef PG8_MMA
#undef PG8_WAIT_V
#undef PG8_WAIT_L
#undef PG8_BAR
#undef PG8_SCHED
}
struct EpiBf16Tiles {
    static constexpr bool PERM = true, AFTER_DRAIN = false;
    bf16_t* d0; int ld0; int ntile0; bf16_t* d1; int ld1;
    __device__ __forceinline__ void operator()(const f32x4 (&acc)[2][2][4][2], const Unit& u, int wr, int wc, int fr, int fq) const {
        bf16_t* base = u.pn < ntile0 ? d0 : d1; const int ld = u.pn < ntile0 ? ld0 : ld1; const int colt = (u.pn < ntile0 ? u.pn : u.pn - ntile0) * BM;
        const int row0 = u.pm * BM + wr * 64 + fr, col0 = colt + wc * 32 + 8 * fq;
#pragma unroll
        for (int ai = 0; ai < 2; ++ai)
#pragma unroll
            for (int m = 0; m < 4; ++m) { bf16_t* rowp = base + (size_t)(row0 + ai * HALF + m * 16) * ld + col0;
#pragma unroll
                for (int bj = 0; bj < 2; ++bj) { const f32x4 v0 = acc[ai][bj][m][0], v1 = acc[ai][bj][m][1];
                    *(uint4*)(rowp + bj * HALF) = make_uint4(pk_bf16(v0[0], v0[1]), pk_bf16(v0[2], v0[3]), pk_bf16(v1[0], v1[1]), pk_bf16(v1[2], v1[3])); } }
    }
};
struct EpiResid256 {
    static constexpr bool PERM = false, AFTER_DRAIN = false;
    const float* xold_lat; const float* xold_ctx; float* dst_lat; float* dst_ctx; const float* gate;
    __device__ __forceinline__ void operator()(const f32x4 (&acc)[2][2][4][2], const Unit& u, int wr, int wc, int fr, int fq) const {
        const int row0 = u.pm * BM + wr * 64 + fr, col0 = u.pn * BM + wc * 32 + 4 * fq;
#pragma unroll
        for (int ai = 0; ai < 2; ++ai)
#pragma unroll
            for (int m = 0; m < 4; ++m) {
                const int R = row0 + ai * HALF + m * 16;
                const float* src = R < NL ? xold_lat + (size_t)R * 1024 : xold_ctx + (size_t)(R - NL) * 1024;
                float* dst = R < NL ? dst_lat + (size_t)R * 1024 : dst_ctx + (size_t)(R - NL) * 1024;
                const float* gr = gate + (size_t)mod_batch(R) * 6144;
#pragma unroll
                for (int bj = 0; bj < 2; ++bj)
#pragma unroll
                    for (int n = 0; n < 2; ++n) {
                        const int col = col0 + bj * HALF + n * 16;
                        const float4 xo = *(const float4*)(src + col), g4 = *(const float4*)(gr + col);
                        const f32x4 a = acc[ai][bj][m][n];
                        *(float4*)(dst + col) = make_float4(xo.x + g4.x * a[0], xo.y + g4.y * a[1], xo.z + g4.z * a[2], xo.w + g4.w * a[3]);
                    }
            }
    }
};
}

DEV void phase_rw_proj1(const Params& p, unsigned char* lds, int which, const bf16_t* A, bf16_t* dst) {
    pg8::Gemm g{A, (const bf16_t*)(p.ws + WS_WPROJ) + (size_t)which * 1024 * 1024, NT, 1024, 1024};
    pg8::StaticOrder so; so.init(NT, 1024, gridDim.x, blockIdx.x);
    pg8::EpiBf16Tiles ep{dst, 1024, 4, dst, 1024};
    pg8::gemm_phase((PG8_LAS unsigned char*)lds, g, so, ep, nullptr);
    __syncthreads();
}
DEV void phase_rw_lora(const Params& p, unsigned char* lds) {
    unsigned char* ws = p.ws;
    const bf16_t* h = (const bf16_t*)(ws + WS_S + 0 * U_BYTES);
    const bf16_t* wproj = (const bf16_t*)(ws + WS_WPROJ);
    const int nunits = (NT / 128) * 3;
    for (int u = blockIdx.x; u < nunits; u += gridDim.x) {
        const int mt = u / 3, lg = u % 3, m0 = mt * 128;
        const int mixid = lg == 0 ? 1 : (lg == 1 ? 4 : 5);
        ALoadMix al{h, p.in[8] + mixid * 1024, h, 1024};
        EpiBf16<128> ep{(bf16_t*)(ws + WS_S + 4 * U_BYTES), 384, lg * 128, lg == 0 ? 1 : (lg == 1 ? 0 : 2)};
        gemm_unit<128>(lds, al, wproj + (size_t)(3072 + lg * 128) * 1024, 1024, m0, ep);
    }
}

template <int N> DEV float dpp_shr0(float x) { return __int_as_float(__builtin_amdgcn_update_dpp(0, __float_as_int(x), 0x110 + N, 0xF, 0xF, true)); }
template <int CTRL> DEV float dpp_quad(float x) { return __int_as_float(__builtin_amdgcn_update_dpp(0, __float_as_int(x), CTRL, 0xF, 0xF, false)); }
DEV int tile_off(int row, int ch) { return row * 128 + ((ch ^ (row & 7)) << 4); }
DEV int tile_off2(int row, int ch) { return row * 128 + ((ch ^ ((row ^ (row >> 3)) & 7)) << 4); }
DEV void phase_rw_scan(const Params& p, unsigned char* lds) {
    const int tid = tid_opaque(), lane = tid & 63;
    const int wv = __builtin_amdgcn_readfirstlane(tid >> 6);
    const int fr = lane & 15, fq = lane >> 4;
    unsigned char* ws = p.ws;
    constexpr int SH = 0, SL = 8192, AT = 16384  , RT = 20480  , BT = 24576  , KT = 28672  , BKT = 32768  , UV = 49152  , NT = 65536  ;
    constexpr int MFA = 69632, MFK = 70656, X0 = 71680, VS = 75776  , PP = 83968, PM = 88064, PI = 92160, AA = 96256  ;
    constexpr int PL = 116736  , YB = 117760, LDS_END = 121856;
    const bf16_t* rbuf = (const bf16_t*)(ws + WS_S + 3 * U_BYTES);
    const bf16_t* kbuf = (const bf16_t*)(ws + WS_S + 5 * U_BYTES);
    const bf16_t* vbuf = (const bf16_t*)(ws + WS_S + 1 * U_BYTES);
    const bf16_t* lora = (const bf16_t*)(ws + WS_S + 4 * U_BYTES);
    for (int unit = blockIdx.x; unit < 256; unit += gridDim.x) {
        const int b = unit >> 5, hh = (unit >> 1) & 15, d = unit & 1;
        bf16_t* ydst = (bf16_t*)(ws + WS_S + (size_t)(d ? 2 : 0) * U_BYTES);
        float* bonus = (float*)(ws + WS_BONUS) + (size_t)((d * NB + b) * 16 + hh) * 8448;
        const int s_e = (tid >> 4) & 15, j0 = (tid & 15) * 4;
        const int ni = wv & 3;
        auto Rof = [&](int c, int s) -> int {
            if (c < 16) { const int q = c * 16 + s; return NL + b * 256 + (d ? 255 - q : q); }
            const int q = (c - 16) * 16 + s; return b * 8192 + (d ? 8191 - q : q);
        };
        constexpr int CST = LDS_END;
        uint2 pr = make_uint2(0, 0), pk = pr, pv = pr; uint4 paw[2], paa[2];
        if (wv >= 4) {
            const int ct = (tid - 256) * 16;
            *(float4*)(lds + CST + 0 * 4096 + ct) = *(const float4*)(p.in[18] + hh * 64 + j0);
            *(float4*)(lds + CST + 1 * 4096 + ct) = *(const float4*)(p.in[19] + hh * 64 + j0);
            *(float4*)(lds + CST + 2 * 4096 + ct) = *(const float4*)(p.in[20] + hh * 64 + j0);
            *(float4*)(lds + CST + 3 * 4096 + ct) = *(const float4*)(p.in[10] + d * 1024 + hh * 64 + ni * 16 + fq * 4);
            *(float4*)(lds + CST + 4 * 4096 + ct) = *(const float4*)(p.in[13] + d * 1024 + hh * 64 + ni * 16 + fq * 4);
#pragma unroll
            for (int ks = 0; ks < 2; ++ks) {
                *(uint4*)(lds + CST + (5 + ks) * 4096 + ct) = *(const uint4*)((const bf16_t*)(ws + WS_W2T) + (size_t)d * 1024 * 64 + (size_t)(hh * 64 + ni * 16 + fr) * 64 + ks * 32 + fq * 8);
                *(uint4*)(lds + CST + (7 + ks) * 4096 + ct) = *(const uint4*)((const bf16_t*)(ws + WS_A2T) + (size_t)d * 1024 * 64 + (size_t)(hh * 64 + ni * 16 + fr) * 64 + ks * 32 + fq * 8);
            }
        }
        auto load_lora = [&](int c) {
            const size_t R2 = (size_t)Rof(c, fr);
#pragma unroll
            for (int ks = 0; ks < 2; ++ks) { paw[ks] = *(const uint4*)(lora + R2 * 384 + d * 64 + ks * 32 + fq * 8); paa[ks] = *(const uint4*)(lora + R2 * 384 + 128 + d * 64 + ks * 32 + fq * 8); }
        };
        auto load_rkv = [&](int c) {
            const size_t off = (size_t)Rof(c, s_e) * 1024 + hh * 64 + j0;
            pr = *(const uint2*)(rbuf + off); pk = *(const uint2*)(kbuf + off); pv = *(const uint2*)(vbuf + off);
        };
        auto step_up = [&](int c) {
            const int ct = (tid - 256) * 16;
            const float4 bias_w = *(const float4*)(lds + CST + 3 * 4096 + ct), bias_a = *(const float4*)(lds + CST + 4 * 4096 + ct);
            bf16x8 bfw[2], bfa[2];
#pragma unroll
            for (int ks = 0; ks < 2; ++ks) { bfw[ks] = *(const bf16x8*)(lds + CST + (5 + ks) * 4096 + ct); bfa[ks] = *(const bf16x8*)(lds + CST + (7 + ks) * 4096 + ct); }
            f32x4 accw = {0.f, 0.f, 0.f, 0.f}, acca = {0.f, 0.f, 0.f, 0.f};
#pragma unroll
            for (int ks = 0; ks < 2; ++ks) { accw = __builtin_amdgcn_mfma_f32_16x16x32_bf16(bfw[ks], as_bf16x8(paw[ks]), accw, 0, 0, 0); acca = __builtin_amdgcn_mfma_f32_16x16x32_bf16(bfa[ks], as_bf16x8(paa[ks]), acca, 0, 0, 0); }
            const int n = ni * 16 + fq * 4;
            const float bw[4] = {bias_w.x, bias_w.y, bias_w.z, bias_w.w}, ba[4] = {bias_a.x, bias_a.y, bias_a.z, bias_a.w};
            float P[4], Pm[4], Pi[4], av[4];
#pragma unroll
            for (int j = 0; j < 4; ++j) {
                const float e = 0.6065306597f * __builtin_amdgcn_rcpf(1.0f + __expf(-(accw[j] + bw[j])));
                float s = e;
                s += dpp_shr0<1>(s); s += dpp_shr0<2>(s); s += dpp_shr0<4>(s); s += dpp_shr0<8>(s);
                P[j] = __expf(-s); Pi[j] = __builtin_amdgcn_rcpf(P[j]); Pm[j] = P[j] * __expf(e);
                av[j] = __builtin_amdgcn_rcpf(1.0f + __expf(-(acca[j] + ba[j])));
            }
            const int pb = (c & 1) * 16384;
            *(float4*)(lds + PP + pb + (fr * 64 + n) * 4) = make_float4(P[0], P[1], P[2], P[3]);
            *(float4*)(lds + PM + pb + (fr * 64 + n) * 4) = make_float4(Pm[0], Pm[1], Pm[2], Pm[3]);
            *(float4*)(lds + PI + pb + (fr * 64 + n) * 4) = make_float4(Pi[0], Pi[1], Pi[2], Pi[3]);
            *(float4*)(lds + AA + pb + (fr * 64 + n) * 4) = make_float4(av[0], av[1], av[2], av[3]);
            if (fr == 15) *(float4*)(lds + PL + (c & 3) * 256 + n * 4) = make_float4(P[0], P[1], P[2], P[3]);
        };
        auto step_vec = [&](int c) {
            const int eo = (s_e * 64 + j0) * 4, pb = (c & 1) * 16384, tb = (c & 1) * 8192, ct = (tid - 256) * 16;
            const float4 kk_c = *(const float4*)(lds + CST + 0 * 4096 + ct), ka_c = *(const float4*)(lds + CST + 1 * 4096 + ct), rk_c = *(const float4*)(lds + CST + 2 * 4096 + ct);
            const float4 a4 = *(const float4*)(lds + AA + pb + eo), P4 = *(const float4*)(lds + PP + pb + eo), Pm4 = *(const float4*)(lds + PM + pb + eo), Pi4 = *(const float4*)(lds + PI + pb + eo);
            const float kx[4] = {bf_lo(pk.x), bf_hi(pk.x), bf_lo(pk.y), bf_hi(pk.y)};
            const float rx[4] = {bf_lo(pr.x), bf_hi(pr.x), bf_lo(pr.y), bf_hi(pr.y)};
            const float av[4] = {a4.x, a4.y, a4.z, a4.w}, Pv[4] = {P4.x, P4.y, P4.z, P4.w}, Pmv[4] = {Pm4.x, Pm4.y, Pm4.z, Pm4.w}, Piv[4] = {Pi4.x, Pi4.y, Pi4.z, Pi4.w};
            const float kkc[4] = {kk_c.x, kk_c.y, kk_c.z, kk_c.w}, kac[4] = {ka_c.x, ka_c.y, ka_c.z, ka_c.w}, rkc[4] = {rk_c.x, rk_c.y, rk_c.z, rk_c.w};
            float t[4], n2 = 0.f;
#pragma unroll
            for (int j = 0; j < 4; ++j) { t[j] = kx[j] * kkc[j]; n2 += t[j] * t[j]; }
            n2 = row16_allreduce(n2);
            const float inv = __builtin_amdgcn_rsqf(fmaxf(n2, 1e-24f));
            float at[4], bt[4], kt[4], rt[4], bon = 0.f;
#pragma unroll
            for (int j = 0; j < 4; ++j) {
                const float kkv = t[j] * inv;
                const float kd = kx[j] * (1.0f + (av[j] - 1.0f) * kac[j]);
                const float bq = kkv * av[j];
                bon += rx[j] * kd * rkc[j];
                at[j] = -kkv * Pmv[j]; bt[j] = bq * Piv[j]; kt[j] = kd * Piv[j]; rt[j] = rx[j] * Pv[j];
            }
            bon = row16_allreduce(bon);
            if ((tid & 15) == 0) { const int Rb = Rof(c, s_e); bonus[Rb < NL ? 256 + (Rb & 8191) : ((Rb - NL) & 255)] = bon; }
            const int ro = tile_off(s_e, j0 >> 3) + (j0 & 7) * 2;
            *(uint2*)(lds + AT + (c & 1) * 2048 + ro) = make_uint2(pk_bf16(at[0], at[1]), pk_bf16(at[2], at[3]));
            *(uint2*)(lds + RT + (c & 1) * 2048 + ro) = make_uint2(pk_bf16(rt[0], rt[1]), pk_bf16(rt[2], rt[3]));
            const unsigned b01 = pk_bf16(bt[0], bt[1]), b23 = pk_bf16(bt[2], bt[3]), k01 = pk_bf16(kt[0], kt[1]), k23 = pk_bf16(kt[2], kt[3]);
            *(uint2*)(lds + BT + (c & 1) * 2048 + ro) = make_uint2(b01, b23);
            *(uint2*)(lds + KT + (c & 1) * 2048 + ro) = make_uint2(k01, k23);
            const unsigned bw2[4] = {b01 & 0xffffu, b01 >> 16, b23 & 0xffffu, b23 >> 16}, kw2[4] = {k01 & 0xffffu, k01 >> 16, k23 & 0xffffu, k23 >> 16};
            const unsigned vw[4] = {pv.x & 0xffffu, pv.x >> 16, pv.y & 0xffffu, pv.y >> 16};
            const int e0 = (s_e & 7) * 2, cq = s_e >> 3, a_ = tid & 15;
            const int B0 = j0 * 128 + e0 + (((cq ^ (4 * (a_ & 1)) ^ (a_ >> 1)) & 7) << 4);
#pragma unroll
            for (int j = 0; j < 4; ++j) {
                *(bf16_t*)(lds + BKT + tb + (B0 ^ ((0 ^ j) << 4)) + j * 128) = (bf16_t)bw2[j];
                *(bf16_t*)(lds + BKT + tb + (B0 ^ ((2 ^ j) << 4)) + j * 128) = (bf16_t)kw2[j];
                *(bf16_t*)(lds + BKT + tb + (B0 ^ ((4 ^ j) << 4)) + j * 128) = (bf16_t)bw2[j];
                *(bf16_t*)(lds + UV + tb + (B0 ^ ((2 ^ j) << 4)) + j * 128) = (bf16_t)vw[j];
            }
        };
        f32x4 accY = {0.f, 0.f, 0.f, 0.f};
        auto prod_S = [&](int c) {
            const int vt = wv & 3, tb = (c & 1) * 2048;
            f32x4 accX = {0.f, 0.f, 0.f, 0.f}, accR = {0.f, 0.f, 0.f, 0.f};
#pragma unroll
            for (int ks = 0; ks < 2; ++ks) {
                const int ch = ks * 4 + fq;
                const bf16x8 sh = *(const bf16x8*)(lds + SH + tile_off(vt * 16 + fr, ch)), sl = *(const bf16x8*)(lds + SL + tile_off(vt * 16 + fr, ch));
                const bf16x8 fa = *(const bf16x8*)(lds + AT + tb + tile_off(fr, ch)), frr = *(const bf16x8*)(lds + RT + tb + tile_off(fr, ch));
                accX = __builtin_amdgcn_mfma_f32_16x16x32_bf16(sh, fa, accX, 0, 0, 0);
                accR = __builtin_amdgcn_mfma_f32_16x16x32_bf16(sh, frr, accR, 0, 0, 0);
                accX = __builtin_amdgcn_mfma_f32_16x16x32_bf16(sl, fa, accX, 0, 0, 0);
                accR = __builtin_amdgcn_mfma_f32_16x16x32_bf16(sl, frr, accR, 0, 0, 0);
            }
            accY = accR;
            {
                const u32x2v av = *(const u32x2v*)(lds + UV + (c & 1) * 8192 + tile_off2(vt * 16 + fr, 2 + (fq >> 1)) + (fq & 1) * 8);
                const u32x2v mh = *(const u32x2v*)(lds + MFK + (fr * 4 + fq) * 8), ml = *(const u32x2v*)(lds + MFK + 512 + (fr * 4 + fq) * 8);
                accX = __builtin_amdgcn_mfma_f32_16x16x16bf16_1k(__builtin_bit_cast(s16x4v, av), __builtin_bit_cast(s16x4v, mh), accX, 0, 0, 0);
                accX = __builtin_amdgcn_mfma_f32_16x16x16bf16_1k(__builtin_bit_cast(s16x4v, av), __builtin_bit_cast(s16x4v, ml), accX, 0, 0, 0);
            }
#pragma unroll
            for (int j = 0; j < 4; ++j) *(float*)(lds + X0 + ((vt * 16 + 4 * fq + j) * 16 + fr) * 4) = accX[j];
        };
        auto prod_V = [&](int c) {
            const int tb = (c & 1) * 2048, w4 = wv & 3;
            f32x4 m = {0.f, 0.f, 0.f, 0.f};
#pragma unroll
            for (int ks = 0; ks < 2; ++ks) {
                const int ch = ks * 4 + fq;
                const bf16x8 fa = *(const bf16x8*)(lds + ((w4 & 1) ? KT : BT) + tb + tile_off(fr, ch));
                const bf16x8 fb = *(const bf16x8*)(lds + ((w4 & 2) ? RT : AT) + tb + tile_off(fr, ch));
                m = __builtin_amdgcn_mfma_f32_16x16x32_bf16(fa, fb, m, 0, 0, 0);
            }
            if (w4 == 0) {
                float* mf = (float*)(lds + MFA);
#pragma unroll
                for (int j = 0; j < 4; ++j) mf[(fr * 4 + j) * 4 + fq] = (4 * fq + j < fr) ? m[j] : 0.f;
            } else if (w4 == 1) {
                const float m0 = (4 * fq + 0 < fr) ? m[0] : 0.f, m1 = (4 * fq + 1 < fr) ? m[1] : 0.f, m2 = (4 * fq + 2 < fr) ? m[2] : 0.f, m3 = (4 * fq + 3 < fr) ? m[3] : 0.f;
                const unsigned h01 = pk_bf16(m0, m1), h23 = pk_bf16(m2, m3);
                *(uint2*)(lds + MFK + (fr * 4 + fq) * 8) = make_uint2(h01, h23);
                *(uint2*)(lds + MFK + 512 + (fr * 4 + fq) * 8) = make_uint2(pk_bf16(m0 - bf_lo(h01), m1 - bf_hi(h01)), pk_bf16(m2 - bf_lo(h23), m3 - bf_hi(h23)));
            } else {
                const float m0 = (4 * fq + 0 <= fr) ? m[0] : 0.f, m1 = (4 * fq + 1 <= fr) ? m[1] : 0.f, m2 = (4 * fq + 2 <= fr) ? m[2] : 0.f, m3 = (4 * fq + 3 <= fr) ? m[3] : 0.f;
                const uint2 o = make_uint2(pk_bf16(m0, m1), pk_bf16(m2, m3));
                const int colb = (w4 == 2 ? 0 : 16) + 4 * fq;
                *(uint2*)(lds + NT + tb + tile_off(fr, colb >> 3) + (colb & 7) * 2) = o;
                if (w4 == 2) *(uint2*)(lds + NT + tb + tile_off(fr, (32 + 4 * fq) >> 3) + ((32 + 4 * fq) & 7) * 2) = o;
            }
        };
        auto step_rec = [&](int c) {
            const int v = tid >> 2, pq = tid & 3;
            float cc[16];
#pragma unroll
            for (int i = 0; i < 4; ++i) { const float4 q = *(const float4*)(lds + X0 + (v * 16 + 4 * i) * 4); cc[4 * i] = q.x; cc[4 * i + 1] = q.y; cc[4 * i + 2] = q.z; cc[4 * i + 3] = q.w; }
            float4 ma[16];
#pragma unroll
            for (int t = 1; t < 16; ++t) ma[t] = *(const float4*)(lds + MFA + ((t * 4 + pq) * 4) * 4);
            ma[0] = make_float4(0.f, 0.f, 0.f, 0.f);
            float uown[4] = {0.f, 0.f, 0.f, 0.f}, uall[16];
#pragma unroll
            for (int t = 0; t < 16; ++t) {
                float s = uown[0] * ma[t].x; s = fmaf(uown[1], ma[t].y, s); s = fmaf(uown[2], ma[t].z, s); s = fmaf(uown[3], ma[t].w, s);
                s += dpp_quad<0xB1>(s); s += dpp_quad<0x4E>(s);
                const float u = cc[t] + s;
                uall[t] = u;
                if (pq == (t & 3)) uown[t >> 2] = u;
            }
            if (pq < 2) {
                unsigned o[8];
#pragma unroll
                for (int i = 0; i < 8; ++i) {
                    const unsigned hi = pk_bf16(uall[2 * i], uall[2 * i + 1]);
                    o[i] = pq ? pk_bf16(uall[2 * i] - bf_lo(hi), uall[2 * i + 1] - bf_hi(hi)) : hi;
                }
                const int cb = pq ? 4 : 0;
                *(uint4*)(lds + UV + (c & 1) * 8192 + tile_off2(v, cb)) = make_uint4(o[0], o[1], o[2], o[3]);
                *(uint4*)(lds + UV + (c & 1) * 8192 + tile_off2(v, cb + 1)) = make_uint4(o[4], o[5], o[6], o[7]);
            }
        };
        f32x4 accS[2];
        accS[0] = (f32x4){0.f, 0.f, 0.f, 0.f}; accS[1] = (f32x4){0.f, 0.f, 0.f, 0.f};
        auto step_upd = [&](int c) {
            const int vt = wv & 3;
            bf16x8 fuv[2];
#pragma unroll
            for (int ks = 0; ks < 2; ++ks) fuv[ks] = *(const bf16x8*)(lds + UV + (c & 1) * 8192 + tile_off2(vt * 16 + fr, ks * 4 + fq));
            if (wv < 4) {
#pragma unroll
                for (int ks = 0; ks < 2; ++ks) accY = __builtin_amdgcn_mfma_f32_16x16x32_bf16(fuv[ks], *(const bf16x8*)(lds + NT + (c & 1) * 2048 + tile_off(fr, ks * 4 + fq)), accY, 0, 0, 0);
                *(float4*)(lds + YB + (fr * 64 + vt * 16 + 4 * fq) * 4) = make_float4(accY[0], accY[1], accY[2], accY[3]);
            }
#pragma unroll
            for (int k2 = 0; k2 < 2; ++k2) {
                const int kt = 2 * (wv >> 2) + k2;
                f32x4 a = accS[k2];
#pragma unroll
                for (int ks = 0; ks < 2; ++ks) a = __builtin_amdgcn_mfma_f32_16x16x32_bf16(*(const bf16x8*)(lds + BKT + (c & 1) * 8192 + tile_off2(kt * 16 + fr, ks * 4 + fq)), fuv[ks], a, 0, 0, 0);
                const float4 pl = *(const float4*)(lds + PL + (c & 3) * 256 + (kt * 16 + 4 * fq) * 4);
                a[0] *= pl.x; a[1] *= pl.y; a[2] *= pl.z; a[3] *= pl.w;
                accS[k2] = a;
                const unsigned h01 = pk_bf16(a[0], a[1]), h23 = pk_bf16(a[2], a[3]);
                const unsigned l01 = pk_bf16(a[0] - bf_lo(h01), a[1] - bf_hi(h01)), l23 = pk_bf16(a[2] - bf_lo(h23), a[3] - bf_hi(h23));
                const int kc = kt * 16 + 4 * fq;
                const int so = tile_off(vt * 16 + fr, kc >> 3) + (kc & 7) * 2;
                *(uint2*)(lds + SH + so) = make_uint2(h01, h23);
                *(uint2*)(lds + SL + so) = make_uint2(l01, l23);
            }
        };
        for (int i = tid; i < LDS_END / 16; i += NTHREADS) *(uint4*)(lds + i * 16) = make_uint4(0, 0, 0, 0);
        if (wv >= 4) { load_lora(0); load_rkv(0); }
        __syncthreads();
        if (wv >= 4) { step_up(0); load_lora(1); }
        __syncthreads();
        if (wv >= 4) { step_vec(0); step_up(1); load_rkv(1); load_lora(2); }
        __syncthreads();
        if (wv >= 4) prod_V(0);
        __syncthreads();
        auto ystore = [&](int c) {
            const float4 y4 = *(const float4*)(lds + YB + (s_e * 64 + j0) * 4);
            *(uint2*)(ydst + (size_t)Rof(c, s_e) * 1024 + hh * 64 + j0) = make_uint2(pk_bf16(y4.x, y4.y), pk_bf16(y4.z, y4.w));
        };
        if (wv < 4) {
            unsigned pfd = 0;
            for (int c = 0; c < 528; ++c) {
                if (c > 0) ystore(c - 1);
                if (c + 4 < 528 && tid < 80) {
                    const bf16_t* pf;
                    if (tid < 48) { const int ten = tid >> 4; pf = (ten == 0 ? rbuf : (ten == 1 ? kbuf : vbuf)) + (size_t)Rof(c + 4, tid & 15) * 1024 + hh * 64; }
                    else { const int i = tid - 48; pf = lora + (size_t)Rof(c + 4, i >> 1) * 384 + (i & 1) * 128 + d * 64; }
                    asm volatile("global_load_dword %0, %1, off" : "=v"(pfd) : "v"(pf) : "memory");
                }
                __builtin_amdgcn_s_setprio(3);
                prod_S(c);
                step_rec(c);
                __builtin_amdgcn_s_setprio(0);
                __syncthreads();
                step_upd(c);
                __syncthreads();
                asm volatile("" :: "v"(pfd));
            }
        } else {
            for (int c = 0; c < 528; ++c) {
                if (c + 1 < 528) step_vec(c + 1);
                if (c + 2 < 528) { step_up(c + 2); load_rkv(c + 2); }
                if (c + 3 < 528) load_lora(c + 3);
                __syncthreads();
                step_upd(c);
                if (c + 1 < 528) prod_V(c + 1);
                __syncthreads();
            }
        }
        if (wv < 4) ystore(527);
        __syncthreads();
    }
}

DEV void phase_rw_readout(const Params& p) {
    const int tid = tid_opaque(), lane = tid & 63, wv = tid >> 6, wm = wv >> 2, wn = wv & 3;
    const int fr = lane & 15, fq = lane >> 4;
    unsigned char* ws = p.ws;
    const bf16_t* y0b = (const bf16_t*)(ws + WS_S + 0 * U_BYTES);
    const bf16_t* y1b = (const bf16_t*)(ws + WS_S + 2 * U_BYTES);
    const bf16_t* vb = (const bf16_t*)(ws + WS_S + 1 * U_BYTES);
    const bf16_t* lora = (const bf16_t*)(ws + WS_S + 4 * U_BYTES);
    const bf16_t* g2t = (const bf16_t*)(ws + WS_G2T);
    bf16_t* ao = (bf16_t*)(ws + WS_S + 5 * U_BYTES);
    const float* bon0 = (const float*)(ws + WS_BONUS);
    const float* bon1 = bon0 + (size_t)NB * 16 * 8448;
    const float* lnw = p.in[21];
    const float* lnb = p.in[22];
    const int nunits = (NT / 128) * 4;
    for (int u = blockIdx.x; u < nunits; u += gridDim.x) {
        const int mt = u >> 2, nt = u & 3, m0 = mt * 128;
        const int hh = nt * 4 + wn;
        f32x4 acc[4][4];
#pragma unroll
        for (int mi = 0; mi < 4; ++mi)
#pragma unroll
            for (int ni = 0; ni < 4; ++ni) acc[mi][ni] = (f32x4){0.f, 0.f, 0.f, 0.f};
#pragma unroll 2
        for (int ks = 0; ks < 4; ++ks) {
            bf16x8 af[4], bfr[4];
#pragma unroll
            for (int mi = 0; mi < 4; ++mi) af[mi] = *(const bf16x8*)(lora + (size_t)(m0 + wm * 64 + mi * 16 + fr) * 384 + 256 + ks * 32 + fq * 8);
#pragma unroll
            for (int ni = 0; ni < 4; ++ni) bfr[ni] = *(const bf16x8*)(g2t + (size_t)(hh * 64 + 16 * (fr >> 2) + 4 * ni + (fr & 3)) * 128 + ks * 32 + fq * 8);
#pragma unroll
            for (int mi = 0; mi < 4; ++mi)
#pragma unroll
                for (int ni = 0; ni < 4; ++ni) acc[mi][ni] = __builtin_amdgcn_mfma_f32_16x16x32_bf16(bfr[ni], af[mi], acc[mi][ni], 0, 0, 0);
        }
#pragma unroll
        for (int mi = 0; mi < 4; ++mi) {
            const size_t R = (size_t)(m0 + wm * 64 + mi * 16 + fr);
            float yv[4][4]; float sum = 0.f;
            const int colb = hh * 64 + 16 * fq;
            {
                const uint4 a0 = *(const uint4*)(y0b + R * 1024 + colb), a1 = *(const uint4*)(y0b + R * 1024 + colb + 8);
                const uint4 c0 = *(const uint4*)(y1b + R * 1024 + colb), c1 = *(const uint4*)(y1b + R * 1024 + colb + 8);
                const unsigned aw[8] = {a0.x, a0.y, a0.z, a0.w, a1.x, a1.y, a1.z, a1.w}, cw[8] = {c0.x, c0.y, c0.z, c0.w, c1.x, c1.y, c1.z, c1.w};
#pragma unroll
                for (int ni = 0; ni < 4; ++ni) {
                    yv[ni][0] = bf_lo(aw[2 * ni]) + bf_lo(cw[2 * ni]); yv[ni][1] = bf_hi(aw[2 * ni]) + bf_hi(cw[2 * ni]);
                    yv[ni][2] = bf_lo(aw[2 * ni + 1]) + bf_lo(cw[2 * ni + 1]); yv[ni][3] = bf_hi(aw[2 * ni + 1]) + bf_hi(cw[2 * ni + 1]);
                    sum += (yv[ni][0] + yv[ni][1]) + (yv[ni][2] + yv[ni][3]);
                }
            }
            sum += __shfl_xor(sum, 16); sum += __shfl_xor(sum, 32);
            const float mu = sum * (1.0f / 64.0f);
            float q = 0.f;
#pragma unroll
            for (int ni = 0; ni < 4; ++ni)
#pragma unroll
                for (int j = 0; j < 4; ++j) { const float dlt = yv[ni][j] - mu; q += dlt * dlt; }
            q += __shfl_xor(q, 16); q += __shfl_xor(q, 32);
            const float rstd = rsqrtf(q * (1.0f / 64.0f) + 64e-5f);
            const size_t bidx = (size_t)(((R < NL ? (R >> 13) : ((R - NL) >> 8)) * 16 + hh)) * 8448 + (R < NL ? 256 + (R & 8191) : ((R - NL) & 255));
            const float bs = bon0[bidx] + bon1[bidx];
            const uint4 v0 = *(const uint4*)(vb + R * 1024 + colb), v1 = *(const uint4*)(vb + R * 1024 + colb + 8);
            const unsigned vw[8] = {v0.x, v0.y, v0.z, v0.w, v1.x, v1.y, v1.z, v1.w};
            unsigned ow[8];
#pragma unroll
            for (int ni = 0; ni < 4; ++ni) {
                const int col = colb + 4 * ni;
                const float4 lw = *(const float4*)(lnw + col), lb = *(const float4*)(lnb + col);
                const float o0 = ((yv[ni][0] - mu) * rstd * lw.x + lb.x + bs * bf_lo(vw[2 * ni])) * acc[mi][ni][0];
                const float o1 = ((yv[ni][1] - mu) * rstd * lw.y + lb.y + bs * bf_hi(vw[2 * ni])) * acc[mi][ni][1];
                const float o2 = ((yv[ni][2] - mu) * rstd * lw.z + lb.z + bs * bf_lo(vw[2 * ni + 1])) * acc[mi][ni][2];
                const float o3 = ((yv[ni][3] - mu) * rstd * lw.w + lb.w + bs * bf_hi(vw[2 * ni + 1])) * acc[mi][ni][3];
                ow[2 * ni] = pk_bf16(o0, o1); ow[2 * ni + 1] = pk_bf16(o2, o3);
            }
            *(uint4*)(ao + R * 1024 + colb) = make_uint4(ow[0], ow[1], ow[2], ow[3]);
            *(uint4*)(ao + R * 1024 + colb + 8) = make_uint4(ow[4], ow[5], ow[6], ow[7]);
        }
    }
}

DEV void phase_wo(const Params& p, unsigned char* lds, int layer) {
    unsigned char* ws = p.ws;
    const bf16_t* ao = (const bf16_t*)(ws + WS_S + (size_t)(layer ? 0 : 5) * U_BYTES);
    const bf16_t* wot = (const bf16_t*)(ws + (layer ? WS_WO1 : WS_WO0));
    float* ctxr = (float*)(ws + WS_CTXR);
    const float* gate = (const float*)(ws + WS_MOD) + (size_t)layer * 9 * 6144 + 2 * 1024;
    const int M = layer ? NL : NT;
    pg8::Gemm g{ao, wot, M, 1024, 1024};
    pg8::StaticOrder so; so.init(M, 1024, gridDim.x, blockIdx.x);
    pg8::EpiResid256 ep{layer ? p.out : p.in[0], layer ? ctxr : p.in[2], p.out, ctxr, gate};
    pg8::gemm_phase((PG8_LAS unsigned char*)lds, g, so, ep, nullptr);
    __syncthreads();
}

struct EpiQTile {
    unsigned char* lds;
    DEV void operator()(const f32x4 (&acc)[4][4], int m0, int wm, int wn, int fr, int fq) const {
        const int pp = wn >> 1;
#pragma unroll
        for (int mi = 0; mi < 4; ++mi) {
            const int m = wm * 64 + mi * 16 + fr;
#pragma unroll
            for (int ni = 0; ni < 4; ++ni) {
                const int c = (wn & 1) * 64 + ni * 16 + 4 * fq;
                *(uint2*)(lds + pp * 32768 + m * 256 + (((c >> 3) ^ (m & 15)) << 4) + (c & 7) * 2) = make_uint2(pk_bf16(acc[mi][ni][0], acc[mi][ni][1]), pk_bf16(acc[mi][ni][2], acc[mi][ni][3]));
            }
        }
    }
};
DEV void phase_peer_select(const Params& p, unsigned char* lds, int layer) {
    const int tid = tid_opaque(), lane = tid & 63, wv = tid >> 6, wm = wv >> 2, wn = wv & 3;
    const int fr = lane & 15, fq = lane >> 4;
    unsigned char* ws = p.ws;
    const bf16_t* hp = (const bf16_t*)(ws + WS_S + (size_t)(layer ? 0 : 1) * U_BYTES);
    const bf16_t* wqt = (const bf16_t*)(ws + WS_WQ) + (size_t)layer * 2048 * 1024;
    const bf16_t* keys = (const bf16_t*)(ws + WS_KEYS) + (size_t)layer * 8 * 2 * 128 * 128;
    int* pl_idx = (int*)(ws + WS_S + 3 * U_BYTES);
    float* pl_gate = (float*)(ws + WS_S + 3 * U_BYTES + (size_t)NT * 128 * 4);
    unsigned* slist = (unsigned*)lds;
    unsigned* tlist = (unsigned*)(lds + 256 * 132 * 4);
    const int mtiles = layer ? NL / 128 : NT / 128;
    for (int u = blockIdx.x; u < mtiles * 8; u += gridDim.x) {
        const int mt = u >> 3, head = u & 7, m0 = mt * 128;
        ALoadPlain al{hp, 1024};
        EpiQTile ep{lds};
        gemm_unit<256>(lds, al, wqt + (size_t)head * 256 * 1024, 1024, m0, ep);
        __syncthreads();
        const int pp = wn >> 1, nk0 = (wn & 1) * 64;
        f32x4 sc[4][4];
#pragma unroll
        for (int mi = 0; mi < 4; ++mi)
#pragma unroll
            for (int ni = 0; ni < 4; ++ni) sc[mi][ni] = (f32x4){0.f, 0.f, 0.f, 0.f};
        const bf16_t* kb = keys + (size_t)(head * 2 + pp) * 16384;
#pragma unroll
        for (int ks = 0; ks < 4; ++ks) {
            bf16x8 af[4], bfr[4];
            const int ch = ks * 4 + fq;
#pragma unroll
            for (int mi = 0; mi < 4; ++mi) { const int m = wm * 64 + mi * 16 + fr; af[mi] = *(const bf16x8*)(lds + pp * 32768 + m * 256 + ((ch ^ (m & 15)) << 4)); }
#pragma unroll
            for (int ni = 0; ni < 4; ++ni) bfr[ni] = *(const bf16x8*)(kb + (size_t)(nk0 + ni * 16 + fr) * 128 + ks * 32 + fq * 8);
#pragma unroll
            for (int mi = 0; mi < 4; ++mi)
#pragma unroll
                for (int ni = 0; ni < 4; ++ni) sc[mi][ni] = __builtin_amdgcn_mfma_f32_16x16x32_bf16(bfr[ni], af[mi], sc[mi][ni], 0, 0, 0);
        }
        __syncthreads();
#pragma unroll
        for (int mi = 0; mi < 4; ++mi) {
            const int m = wm * 64 + mi * 16 + fr;
#pragma unroll
            for (int ni = 0; ni < 4; ++ni) {
                const int n = nk0 + ni * 16 + 4 * fq;
                uint4 o;
                o.x = (mono_u32(sc[mi][ni][0]) & ~127u) | (unsigned)(127 - (n + 0));
                o.y = (mono_u32(sc[mi][ni][1]) & ~127u) | (unsigned)(127 - (n + 1));
                o.z = (mono_u32(sc[mi][ni][2]) & ~127u) | (unsigned)(127 - (n + 2));
                o.w = (mono_u32(sc[mi][ni][3]) & ~127u) | (unsigned)(127 - (n + 3));
                *(uint4*)(slist + (size_t)(pp * 128 + m) * 132 + n) = o;
            }
        }
        __syncthreads();
        {
            const int L = tid >> 1, g2 = tid & 1;
            unsigned t[64];
            {
                const unsigned* srcp = slist + (size_t)L * 132 + g2 * 64;
#pragma unroll
                for (int i = 0; i < 16; ++i) { const uint4 v = *(const uint4*)(srcp + i * 4); t[4 * i] = v.x; t[4 * i + 1] = v.y; t[4 * i + 2] = v.z; t[4 * i + 3] = v.w; }
            }
#pragma unroll
            for (int o = 0; o < 64; o += 16) {
#pragma unroll
                for (int pp2 = 1; pp2 < 16; pp2 <<= 1)
#pragma unroll
                    for (int k = pp2; k >= 1; k >>= 1)
#pragma unroll
                        for (int j = k % pp2; j <= 15 - k; j += 2 * k)
#pragma unroll
                            for (int i = 0; i < k; ++i) {
                                if (i + j + k <= 15 && (i + j) / (2 * pp2) == (i + j + k) / (2 * pp2)) {
                                    const unsigned mx = max(t[o + i + j], t[o + i + j + k]), mn = min(t[o + i + j], t[o + i + j + k]);
                                    t[o + i + j] = mx; t[o + i + j + k] = mn;
                                }
                            }
            }
#pragma unroll
            for (int rnd = 0; rnd < 4; ++rnd) {
                const int oa = rnd == 1 ? 32 : 0, ob = rnd == 0 ? 16 : (rnd == 1 ? 48 : 32);
                unsigned c[16];
#pragma unroll
                for (int i = 0; i < 16; ++i) {
                    unsigned b;
                    if (rnd < 3) b = t[ob + 15 - i];
                    else b = (unsigned)__builtin_amdgcn_update_dpp(0, (int)t[15 - i], 0xB1, 0xF, 0xF, false);
                    c[i] = max(t[oa + i], b);
                }
#pragma unroll
                for (int j = 8; j > 0; j >>= 1)
#pragma unroll
                    for (int i = 0; i < 16; ++i) {
                        const int l = i ^ j;
                        if (l > i) { const unsigned mx = max(c[i], c[l]), mn = min(c[i], c[l]); c[i] = mx; c[l] = mn; }
                    }
#pragma unroll
                for (int i = 0; i < 16; ++i) t[oa + i] = c[i];
            }
            if (g2 == 0) {
#pragma unroll
                for (int i = 0; i < 4; ++i) *(uint4*)(tlist + L * 16 + i * 4) = make_uint4(t[4 * i], t[4 * i + 1], t[4 * i + 2], t[4 * i + 3]);
            }
        }
        __syncthreads();
        if (tid < 128) {
            float v0[16], v1[16];
#pragma unroll
            for (int i = 0; i < 16; ++i) { v0[i] = unmono_u32(tlist[tid * 16 + i] & ~127u); v1[i] = unmono_u32(tlist[(128 + tid) * 16 + i] & ~127u); }
            unsigned cd[16];
#pragma unroll
            for (int i = 0; i < 16; ++i) cd[i] = 0u;
#pragma unroll
            for (int i = 0; i < 16; ++i) {
#pragma unroll
                for (int j = 0; j < 16; ++j) {
                    if ((i + 1) * (j + 1) <= 16) {
                        unsigned x = (mono_u32(v0[i] + v1[j]) & ~255u) | (unsigned)(255 - (i * 16 + j));
#pragma unroll
                        for (int q = (i + 1) * (j + 1) - 1; q < 16; ++q) { const unsigned mx = max(cd[q], x); x = min(cd[q], x); cd[q] = mx; }
                    }
                }
            }
            float sv[16]; int ex[16];
#pragma unroll
            for (int q = 0; q < 16; ++q) {
                const int slot = 255 - (int)(cd[q] & 255u);
                const unsigned a = tlist[tid * 16 + (slot >> 4)], b2 = tlist[(128 + tid) * 16 + (slot & 15)];
                sv[q] = unmono_u32(a & ~127u) + unmono_u32(b2 & ~127u);
                ex[q] = (127 - (int)(a & 127u)) * 128 + (127 - (int)(b2 & 127u));
            }
            float mx = sv[0];
#pragma unroll
            for (int q = 1; q < 16; ++q) mx = fmaxf(mx, sv[q]);
            float den = 0.f;
#pragma unroll
            for (int q = 0; q < 16; ++q) { sv[q] = __expf(sv[q] - mx); den += sv[q]; }
            const float rden = 1.0f / den;
            const size_t base = ((size_t)head * NT + (m0 + tid)) * 16;
#pragma unroll
            for (int i = 0; i < 4; ++i) {
                *(int4*)(pl_idx + base + i * 4) = make_int4(ex[4 * i], ex[4 * i + 1], ex[4 * i + 2], ex[4 * i + 3]);
                *(float4*)(pl_gate + base + i * 4) = make_float4(sv[4 * i] * rden, sv[4 * i + 1] * rden, sv[4 * i + 2] * rden, sv[4 * i + 3] * rden);
            }
        }
        __syncthreads();
    }
}

typedef float f32x2 __attribute__((ext_vector_type(2)));
typedef unsigned int u32x4 __attribute__((ext_vector_type(4)));
typedef unsigned int u32x2 __attribute__((ext_vector_type(2)));
#define PS_LOAD(buf, ee, h) { _Pragma("unroll") for (int e = 0; e < 8; ++e) { \
        const u32x4 t4 = __builtin_amdgcn_raw_buffer_load_b128(rs, ((unsigned)ee[(h) * 8 + e] << 7) + ch16, 0, 0); buf[e] = make_uint4(t4.x, t4.y, t4.z, t4.w); } }
#define PS_IDX(ee, Rr) { _Pragma("unroll") for (int i = 0; i < 4; ++i) { const int4 t = *(const int4*)(pl_idx + ((size_t)sub * NT + (Rr)) * 16 + 4 * i); \
        ee[4 * i] = t.x; ee[4 * i + 1] = t.y; ee[4 * i + 2] = t.z; ee[4 * i + 3] = t.w; } }
DEV long pk64(unsigned lo, unsigned hi) { return (long)(((unsigned long long)hi << 32) | (unsigned long long)lo); }
DEV void phase_peer_u(const Params& p, unsigned char* lds, int layer) {
    const int tid = tid_opaque(), lane = tid & 63, wv = tid >> 6, sub = lane >> 3, ch = lane & 7, fm = lane & 15, fg = lane >> 4;
    const int ng = gridDim.x >> 3, x = blockIdx.x & 7, wq = blockIdx.x >> 3;
    if (wq < ng) {
        const int gw = __builtin_amdgcn_readfirstlane(wq * 8 + wv), nw = ng * 8;
        unsigned char* ws = p.ws;
        const unsigned char* tab = ws + WS_PU + ((size_t)layer * 8 + x) * (16384 * 128);
        const int* pl_idx = (const int*)(ws + WS_S + 3 * U_BYTES);
        const unsigned char* xq = ws + WS_S + 2 * U_BYTES + (size_t)(fm & 1) * 1024 + 128 * x + 16 * fg;
        bf16_t* pd = (bf16_t*)(ws + WS_S + 5 * U_BYTES) + (size_t)x * NT * 128 + 16 * (fm >> 1) + 4 * fg;
        unsigned char* tile = lds + wv * 16384;
        const unsigned cE16 = 16u * (unsigned)(ch ^ (sub >> 1)), cO16 = cE16 ^ 64u;
        const unsigned aoff0 = (unsigned)fm * 128u + (unsigned)((fg ^ (fm >> 1)) << 4), aoff1 = (unsigned)fm * 128u + (unsigned)(((4 + fg) ^ (fm >> 1)) << 4);
        const int nrows = layer ? NL : NT;
        int eN[16];
#define PU_DMA(ee, q) { _Pragma("unroll") for (int j = 0; j < 4; ++j) { const int jj = (q) * 4 + j; \
        __builtin_amdgcn_global_load_lds((const unsigned*)(tab + (((unsigned)ee[jj] << 7) + ((jj & 1) ? cO16 : cE16))), (unsigned*)(tile + jj * 1024 + lane * 16), 16, 0, 0); } }
        const unsigned ta0 = (unsigned)(size_t)((LAS3 unsigned char*)tile) + aoff0, ta1 = (unsigned)(size_t)((LAS3 unsigned char*)tile) + aoff1;
#define PU_MMA(q) { u32x4 a0, a1, a2, a3; \
        asm volatile("ds_read_b128 %0, %4 offset:%6\n\tds_read_b128 %1, %5 offset:%6\n\tds_read_b128 %2, %4 offset:%7\n\tds_read_b128 %3, %5 offset:%7\n\ts_waitcnt lgkmcnt(0)" \
            : "=&v"(a0), "=&v"(a1), "=&v"(a2), "=&v"(a3) : "v"(ta0), "v"(ta1), "n"((q) * 4096), "n"((q) * 4096 + 2048) : "memory"); \
        f32x4 c4 = {0.f, 0.f, 0.f, 0.f}, c5 = {0.f, 0.f, 0.f, 0.f}; \
        c4 = __builtin_amdgcn_mfma_f32_16x16x32_fp8_fp8(pk64(a0.x, a0.y), pk64(bC0.x, bC0.y), c4, 0, 0, 0); \
        c5 = __builtin_amdgcn_mfma_f32_16x16x32_fp8_fp8(pk64(a2.x, a2.y), pk64(bC0.x, bC0.y), c5, 0, 0, 0); \
        c4 = __builtin_amdgcn_mfma_f32_16x16x32_fp8_fp8(pk64(a0.z, a0.w), pk64(bC0.z, bC0.w), c4, 0, 0, 0); \
        c5 = __builtin_amdgcn_mfma_f32_16x16x32_fp8_fp8(pk64(a2.z, a2.w), pk64(bC0.z, bC0.w), c5, 0, 0, 0); \
        c4 = __builtin_amdgcn_mfma_f32_16x16x32_fp8_fp8(pk64(a1.x, a1.y), pk64(bC1.x, bC1.y), c4, 0, 0, 0); \
        c5 = __builtin_amdgcn_mfma_f32_16x16x32_fp8_fp8(pk64(a3.x, a3.y), pk64(bC1.x, bC1.y), c5, 0, 0, 0); \
        c4 = __builtin_amdgcn_mfma_f32_16x16x32_fp8_fp8(pk64(a1.z, a1.w), pk64(bC1.z, bC1.w), c4, 0, 0, 0); \
        c5 = __builtin_amdgcn_mfma_f32_16x16x32_fp8_fp8(pk64(a3.z, a3.w), pk64(bC1.z, bC1.w), c5, 0, 0, 0); \
        acc[(q) * 2] = c4; acc[(q) * 2 + 1] = c5; }
        int R = gw;
#pragma unroll
        for (int i = 0; i < 16; ++i) eN[i] = 0;
        uint4 bC0 = make_uint4(0, 0, 0, 0), bC1 = bC0;
        if (R < nrows) {
            PS_IDX(eN, R);
            PU_DMA(eN, 0); PU_DMA(eN, 1); PU_DMA(eN, 2); PU_DMA(eN, 3);
            bC0 = *(const uint4*)(xq + (size_t)R * 2048); bC1 = *(const uint4*)(xq + (size_t)R * 2048 + 64);
            const int R1 = min(R + nw, nrows - 1);
            PS_IDX(eN, R1);
            asm volatile("s_waitcnt vmcnt(0)" : "+v"(bC0.x), "+v"(bC1.x), "+v"(eN[0]), "+v"(eN[4]), "+v"(eN[8]), "+v"(eN[12]) :: "memory");
        }
        for (; R < nrows; R += nw) {
            const int Rn = R + nw, R1 = min(Rn, nrows - 1), R2 = min(Rn + nw, nrows - 1);
            const bool more = Rn < nrows;
            u32x4 i0, i1, i2, i3, nb0, nb1;
            {
                const int* iptr = pl_idx + ((size_t)sub * NT + R2) * 16;
                const unsigned char* xptr = xq + (size_t)R1 * 2048;
                asm volatile("global_load_dwordx4 %0, %6, off\n\tglobal_load_dwordx4 %1, %6, off offset:16\n\tglobal_load_dwordx4 %2, %6, off offset:32\n\tglobal_load_dwordx4 %3, %6, off offset:48\n\t"
                             "global_load_dwordx4 %4, %7, off\n\tglobal_load_dwordx4 %5, %7, off offset:64"
                             : "=&v"(i0), "=&v"(i1), "=&v"(i2), "=&v"(i3), "=&v"(nb0), "=&v"(nb1) : "v"(iptr), "v"(xptr) : "memory");
            }
            f32x4 acc[8];
#define PU_STEP(q) { if (more) asm volatile("s_waitcnt vmcnt(19)" ::: "memory"); else asm volatile("s_waitcnt vmcnt(0)" ::: "memory"); \
            PU_MMA(q); if (more) { PU_DMA(eN, q); } }
            PU_STEP(0); PU_STEP(1); PU_STEP(2); PU_STEP(3);
            f32x4 s0[4], s1[2], s2;
#pragma unroll
            for (int i = 0; i < 4; ++i)
#pragma unroll
                for (int r = 0; r < 4; ++r) s0[i][r] = (fm & 2) ? acc[2 * i + 1][r] : acc[2 * i][r];
#pragma unroll
            for (int i = 0; i < 2; ++i)
#pragma unroll
                for (int r = 0; r < 4; ++r) s1[i][r] = (fm & 4) ? s0[2 * i + 1][r] : s0[2 * i][r];
#pragma unroll
            for (int r = 0; r < 4; ++r) { const float t = (fm & 8) ? s1[1][r] : s1[0][r]; s2[r] = t + dpp_quad<0xB1>(t); }
            if (!(fm & 1)) *(uint2*)(pd + (size_t)R * 128) = make_uint2(pk_bf16(s2[0], s2[1]), pk_bf16(s2[2], s2[3]));
            if (more) asm volatile("s_waitcnt vmcnt(17)" : "+v"(i0), "+v"(i1), "+v"(i2), "+v"(i3), "+v"(nb0), "+v"(nb1) :: "memory");
            else asm volatile("s_waitcnt vmcnt(0)" : "+v"(i0), "+v"(i1), "+v"(i2), "+v"(i3), "+v"(nb0), "+v"(nb1) :: "memory");
            eN[0] = i0.x; eN[1] = i0.y; eN[2] = i0.z; eN[3] = i0.w; eN[4] = i1.x; eN[5] = i1.y; eN[6] = i1.z; eN[7] = i1.w;
            eN[8] = i2.x; eN[9] = i2.y; eN[10] = i2.z; eN[11] = i2.w; eN[12] = i3.x; eN[13] = i3.y; eN[14] = i3.z; eN[15] = i3.w;
            bC0 = make_uint4(nb0.x, nb0.y, nb0.z, nb0.w); bC1 = make_uint4(nb1.x, nb1.y, nb1.z, nb1.w);
        }
        asm volatile("s_waitcnt vmcnt(0)" ::: "memory");
    }
}
DEV void phase_peer_c(const Params& p, int layer) {
    const int tid = tid_opaque(), lane = tid & 63;
    const int gw = blockIdx.x * 8 + (tid >> 6), nw = gridDim.x * 8;
    unsigned char* ws = p.ws;
    const float* usc = (const float*)(ws + WS_PSC) + layer * 16384;
    const float* vsc = (const float*)(ws + WS_PSC) + 32768 + layer * 16384;
    const int* pl_idx = (const int*)(ws + WS_S + 3 * U_BYTES);
    const float* pl_gate = (const float*)(ws + WS_S + 3 * U_BYTES + (size_t)NT * 128 * 4);
    float* pd = (float*)(ws + WS_S + 4 * U_BYTES);
    const bf16_t* pdh = (const bf16_t*)(ws + WS_S + 5 * U_BYTES);
    const int nrows = layer ? NL : NT;
    const int head0 = 2 * (lane & 3), kk = lane >> 2;
    for (int R = gw; R < nrows; R += nw) {
        float d0 = 0.f, d1 = 0.f;
#pragma unroll
        for (int xx = 0; xx < 8; ++xx) { const unsigned t = *(const unsigned*)(pdh + ((size_t)xx * NT + R) * 128 + 2 * lane); d0 += bf_lo(t); d1 += bf_hi(t); }
        const size_t po = ((size_t)head0 * NT + R) * 16 + kk;
        const int e0 = pl_idx[po], e1 = pl_idx[po + (size_t)NT * 16];
        const float g0 = pl_gate[po], g1 = pl_gate[po + (size_t)NT * 16];
        d0 *= usc[e0] * 0.25f; d1 *= usc[e1] * 0.25f;
        const float c0 = g0 * vsc[e0] * 0.5f * d0 * (1.0f + erff(d0 * 0.70710678118f));
        const float c1 = g1 * vsc[e1] * 0.5f * d1 * (1.0f + erff(d1 * 0.70710678118f));
        pd[(size_t)R * 128 + 16 * head0 + kk] = c0;
        pd[(size_t)R * 128 + 16 * head0 + 16 + kk] = c1;
    }
}
DEV void phase_peer_v(const Params& p, int layer) {
    const int tid = tid_opaque(), lane = tid & 63, sub = lane >> 3, ch = lane & 7;
    const int ng = gridDim.x >> 3, x = blockIdx.x & 7, wq = blockIdx.x >> 3;
    if (wq < ng) {
        const int gw = __builtin_amdgcn_readfirstlane(wq * 8 + (tid >> 6)), nw = ng * 8;
        unsigned char* ws = p.ws;
        const __amdgpu_buffer_rsrc_t rs = __builtin_amdgcn_make_buffer_rsrc((void*)(ws + WS_PV + ((size_t)layer * 8 + x) * (16384 * 128)), 0, 16384 * 128, 0x00020000);
        const int* pl_idx = (const int*)(ws + WS_S + 3 * U_BYTES);
        const float* cb = (const float*)(ws + WS_S + 4 * U_BYTES) + 16 * sub;
        float* ctxr = (float*)(ws + WS_CTXR);
        const float* mods = (const float*)(ws + WS_MOD) + (size_t)layer * 9 * 6144 + 5 * 1024;
        const unsigned ch16 = 16u * (unsigned)ch;
        const int col = 128 * x + 16 * ch + 2 * sub;
        const int nrows = layer ? NL : NT;
        uint4 bufA[8], bufB[8];
        int eC[16], eN[16];
        float cC[16], cN[16];
#define PS_CF(cc, Rr) { _Pragma("unroll") for (int i = 0; i < 4; ++i) { const float4 t = *(const float4*)(cb + (size_t)(Rr) * 128 + 4 * i); \
        cc[4 * i] = t.x; cc[4 * i + 1] = t.y; cc[4 * i + 2] = t.z; cc[4 * i + 3] = t.w; } }
#define PV_FMA(accv, av) asm("v_fma_f32 %0, %1, %2, %0" : "+v"(accv) : "v"(cf), "v"(av))
#define PV_AXPY(buf, h) { _Pragma("unroll") for (int e = 0; e < 8; ++e) { \
        const float cf = cC[(h) * 8 + e]; const unsigned vw[4] = {buf[e].x, buf[e].y, buf[e].z, buf[e].w}; \
        _Pragma("unroll") for (int i = 0; i < 4; ++i) { \
            const f32x2 a = __builtin_amdgcn_cvt_pk_f32_fp8((int)vw[i], false), b2 = __builtin_amdgcn_cvt_pk_f32_fp8((int)vw[i], true); \
            PV_FMA(a16[4 * i], a.x); PV_FMA(a16[4 * i + 1], a.y); PV_FMA(a16[4 * i + 2], b2.x); PV_FMA(a16[4 * i + 3], b2.y); } } }
        int R = gw;
#pragma unroll
        for (int i = 0; i < 16; ++i) { eC[i] = 0; eN[i] = 0; cC[i] = 0.f; cN[i] = 0.f; }
        if (R < nrows) { PS_IDX(eC, R); PS_CF(cC, R); PS_LOAD(bufA, eC, 0); }
        for (; R < nrows; R += nw) {
            const int Rn = R + nw;
            if (Rn < nrows) { PS_IDX(eN, Rn); PS_CF(cN, Rn); }
            PS_LOAD(bufB, eC, 1);
            float* xrow = (R < NL ? p.out + (size_t)R * 1024 : ctxr + (size_t)(R - NL) * 1024) + col;
            const float2 xa = *(const float2*)xrow, ga = *(const float2*)(mods + (size_t)mod_batch(R) * 6144 + col);
            float a16[16];
#pragma unroll
            for (int i = 0; i < 16; ++i) a16[i] = 0.f;
            PV_AXPY(bufA, 0);
            if (Rn < nrows) { PS_LOAD(bufA, eN, 0); }
            PV_AXPY(bufB, 1);
            float s8[8], t4[4];
#pragma unroll
            for (int j = 0; j < 8; ++j) { const u32x2 r = __builtin_amdgcn_permlane32_swap(__float_as_uint(a16[j]), __float_as_uint(a16[8 + j]), false, false); s8[j] = __uint_as_float(r.x) + __uint_as_float(r.y); }
#pragma unroll
            for (int j = 0; j < 4; ++j) { const u32x2 r = __builtin_amdgcn_permlane16_swap(__float_as_uint(s8[j]), __float_as_uint(s8[4 + j]), false, false); t4[j] = __uint_as_float(r.x) + __uint_as_float(r.y); }
            const float wa0 = t4[0] + dpp_ror<8>(t4[0]), wa1 = t4[1] + dpp_ror<8>(t4[1]), wb0 = t4[2] + dpp_ror<8>(t4[2]), wb1 = t4[3] + dpp_ror<8>(t4[3]);
            const float w0 = (lane & 8) ? wb0 : wa0, w1 = (lane & 8) ? wb1 : wa1;
            *(float2*)xrow = make_float2(xa.x + ga.x * w0, xa.y + ga.y * w1);
#pragma unroll
            for (int i = 0; i < 16; ++i) { eC[i] = eN[i]; cC[i] = cN[i]; }
        }
    }
}
DEV void phase_final_norm(const Params& p) {
    const int tid = tid_opaque(), lane = tid & 63;
    const int gw = blockIdx.x * 8 + (tid >> 6), nw = gridDim.x * 8;
    const float* gn = p.in[34];
    for (int R = gw; R < NL; R += nw) {
        float* xr = p.out + (size_t)R * 1024;
        float4 v[4]; float ss = 0.f;
#pragma unroll
        for (int i = 0; i < 4; ++i) { v[i] = *(const float4*)(xr + i * 256 + lane * 4); ss += v[i].x * v[i].x + v[i].y * v[i].y + v[i].z * v[i].z + v[i].w * v[i].w; }
        ss = wave_allreduce(ss);
        const float rs = rsqrtf(ss * (1.0f / 1024.0f) + 1e-6f);
#pragma unroll
        for (int i = 0; i < 4; ++i) {
            const float4 gg = *(const float4*)(gn + i * 256 + lane * 4);
            *(float4*)(xr + i * 256 + lane * 4) = make_float4(v[i].x * rs * gg.x, v[i].y * rs * gg.y, v[i].z * rs * gg.z, v[i].w * rs * gg.w);
        }
    }
}

DEV void phase_gla_proj(const Params& p, unsigned char* lds) {
    unsigned char* ws = p.ws;
    const bf16_t* h = (const bf16_t*)(ws + WS_S + 0 * U_BYTES);
    const bf16_t* wint = (const bf16_t*)(ws + WS_WIN);
    {
        pg8::Gemm g{h, wint, NT, 3072, 1024};
        pg8::StaticOrder so; so.init(NT, 3072, gridDim.x, blockIdx.x);
        pg8::EpiBf16Tiles ep{(bf16_t*)(ws + WS_S + 1 * U_BYTES), 2048, 8, (bf16_t*)(ws + WS_S + 3 * U_BYTES), 1024};
        pg8::gemm_phase(( PG8_LAS unsigned char*)lds, g, so, ep, nullptr);
    }
    __syncthreads();
    for (int u = blockIdx.x; u < NT / 128; u += gridDim.x) {
        ALoadPlain al{h, 1024};
        EpiLr ep{(float*)(ws + WS_LR)};
        gemm_unit<128>(lds, al, wint + (size_t)3072 * 1024, 1024, u * 128, ep);
    }
}

DEV void conv_emit(const float (&acc)[8], int c, bf16_t* dst) {
    const float qs = (c < 512) ? 0.08838834764831845f : 1.0f;
    unsigned ow[4];
#pragma unroll
    for (int j = 0; j < 4; ++j) { const float a0 = acc[2 * j], a1 = acc[2 * j + 1]; ow[j] = pk_bf16(a0 * sigmoidf_(a0) * qs, a1 * sigmoidf_(a1) * qs); }
    *(uint4*)dst = make_uint4(ow[0], ow[1], ow[2], ow[3]);
}
DEV void conv_tap(float (&acc)[8], const uint4& v, const float (&w)[8]) {
    acc[0] += bf_lo(v.x) * w[0]; acc[1] += bf_hi(v.x) * w[1]; acc[2] += bf_lo(v.y) * w[2]; acc[3] += bf_hi(v.y) * w[3];
    acc[4] += bf_lo(v.z) * w[4]; acc[5] += bf_hi(v.z) * w[5]; acc[6] += bf_lo(v.w) * w[6]; acc[7] += bf_hi(v.w) * w[7];
}
DEV void phase_gla_conv(const Params& p) {
    const int tid = tid_opaque();
    unsigned char* ws = p.ws;
    const bf16_t* z = (const bf16_t*)(ws + WS_S + 1 * U_BYTES);
    bf16_t* o = (bf16_t*)(ws + WS_S + 4 * U_BYTES);
    const float* cw = p.in[25];
    const int x = tid >> 3, cl = (tid & 7) * 8;
    for (int task = blockIdx.x; task < 8 * 32; task += gridDim.x) {
        const int cb = task & 31, b = task >> 5;
        const int c = cb * 64 + cl;
        float w[9][8];
#pragma unroll
        for (int t = 0; t < 9; ++t) { const float4 w0 = *(const float4*)(cw + t * 2048 + c), w1 = *(const float4*)(cw + t * 2048 + c + 4); w[t][0] = w0.x; w[t][1] = w0.y; w[t][2] = w0.z; w[t][3] = w0.w; w[t][4] = w1.x; w[t][5] = w1.y; w[t][6] = w1.z; w[t][7] = w1.w; }
        const uint4 zero4 = make_uint4(0, 0, 0, 0);
        auto load_row = [&](int y, uint4 (&r)[3]) {
            if (y < 0 || y >= 128) { r[0] = zero4; r[1] = zero4; r[2] = zero4; return; }
            const bf16_t* row = z + ((size_t)b * 8192 + (size_t)y * 64 + x) * 2048 + c;
            r[1] = *(const uint4*)row;
            r[0] = (x > 0) ? *(const uint4*)(row - 2048) : zero4;
            r[2] = (x < 63) ? *(const uint4*)(row + 2048) : zero4;
        };
        uint4 r0[3], r1[3], r2[3], r3[3], r4[3];
        const int y0 = 0;
        load_row(y0 - 1, r0); load_row(y0, r1); load_row(y0 + 1, r2); load_row(y0 + 2, r3);
#pragma unroll 1
        for (int yy = 0; yy < 128; ++yy) {
            load_row(y0 + yy + 3, r4);
            float acc[8];
#pragma unroll
            for (int j = 0; j < 8; ++j) acc[j] = 0.f;
#pragma unroll
            for (int dx = 0; dx < 3; ++dx) { conv_tap(acc, r0[dx], w[dx]); conv_tap(acc, r1[dx], w[3 + dx]); conv_tap(acc, r2[dx], w[6 + dx]); }
            conv_emit(acc, c, o + ((size_t)b * 8192 + (size_t)(y0 + yy) * 64 + x) * 2048 + c);
#pragma unroll
            for (int dx = 0; dx < 3; ++dx) { r0[dx] = r1[dx]; r1[dx] = r2[dx]; r2[dx] = r3[dx]; r3[dx] = r4[dx]; }
        }
    }
    for (int task = blockIdx.x; task < (NC / 64) * 8; task += gridDim.x) {
        const int rb = task >> 3, cbk = task & 7;
        const int R = NL + rb * 64 + (tid >> 3);
        const int t = (R - NL) & 255;
#pragma unroll 1
        for (int i = 0; i < 4; ++i) {
            const int c = cbk * 256 + (tid & 7) * 8 + i * 64;
            float acc[8];
#pragma unroll
            for (int j = 0; j < 8; ++j) acc[j] = 0.f;
#pragma unroll
            for (int dx = -1; dx <= 1; ++dx) {
                if (t + dx >= 0 && t + dx < 256) {
                    const uint4 v = *(const uint4*)(z + (size_t)(R + dx) * 2048 + c);
                    const float* wp = cw + (3 + (dx + 1)) * 2048 + c;
                    const float4 w0 = *(const float4*)wp, w1 = *(const float4*)(wp + 4);
                    const float wv[8] = {w0.x, w0.y, w0.z, w0.w, w1.x, w1.y, w1.z, w1.w};
                    conv_tap(acc, v, wv);
                }
            }
            conv_emit(acc, c, o + (size_t)R * 2048 + c);
        }
    }
}

constexpr int GT_QE = 0, GT_KET = 16384, GT_A = 32768, GT_CONST = 40960, GT_STRIDE = 43008;
constexpr int GT_N0 = (int)((2 * U_BYTES) / GT_STRIDE);
constexpr size_t WS_TOTAL = 1073741824ull;
static_assert((size_t)(NB * 4 * 2 * 132 - GT_N0) * GT_STRIDE <= WS_TOTAL - WS_END, "tile records do not fit");
DEV size_t gla_tile_off(int b, int hd, int d, int cc) {
    const int idx = (((b * 4 + hd) * 2 + d) * 132) + cc;
    return idx < GT_N0 ? WS_S + (size_t)idx * GT_STRIDE : WS_END + (size_t)(idx - GT_N0) * GT_STRIDE;
}
DEV int gla_row0(int b, int cc) { return cc < 4 ? NL + b * 256 + cc * 64 : b * 8192 + (cc - 4) * 64; }
DEV void phase_gla_prep(const Params& p, unsigned char* lds) {
    const int tid = tid_opaque(), lane = tid & 63, wv = tid >> 6;
    const int fr = lane & 15, fq = lane >> 4;
    unsigned char* ws = p.ws;
    constexpr int QE = 0, KE = 16384, KET = 32768, BC = 49152  , GS = 82944  , LRL = 86528  , BCS = 132;
    const bf16_t* qkv = (const bf16_t*)(ws + WS_S + 4 * U_BYTES);
    const float* lrb = (const float*)(ws + WS_LR);
    unsigned char* gt = ws;
    float* bc = (float*)(lds + BC);
    float* gs = (float*)(lds + GS);
    const int li = tid >> 3, lc = tid & 7;
    const int d = blockIdx.x & 1, hd = (blockIdx.x >> 1) & 3;
    bf16x8 gkf;
    {
        unsigned w4[4] = {0u, 0u, 0u, 0u};
        if (fq < 2) {
#pragma unroll
            for (int e2 = 0; e2 < 4; ++e2) {
                const float g0 = p.in[26][(size_t)(d * 16 + 8 * fq + 2 * e2) * 512 + hd * 128 + wv * 16 + fr];
                const float g1 = p.in[26][(size_t)(d * 16 + 8 * fq + 2 * e2 + 1) * 512 + hd * 128 + wv * 16 + fr];
                w4[e2] = pk_bf16(g0, g1);
            }
        }
        gkf = as_bf16x8(make_uint4(w4[0], w4[1], w4[2], w4[3]));
    }
    const float4 gb4 = *(const float4*)(p.in[27] + d * 512 + hd * 128 + wv * 16 + 4 * fq);
    const int qstep = (int)(gridDim.x >> 3);
    uint4 nq0, nq1, nk0, nk1; float2 nl;
    auto fetch = [&](int q) {
        const size_t R = (size_t)(gla_row0(q / 132, q % 132) + li);
        const bf16_t* row = qkv + R * 2048;
        nq0 = *(const uint4*)(row + hd * 128 + lc * 8); nq1 = *(const uint4*)(row + hd * 128 + 64 + lc * 8);
        nk0 = *(const uint4*)(row + 512 + hd * 128 + lc * 8); nk1 = *(const uint4*)(row + 512 + hd * 128 + 64 + lc * 8);
        nl = *(const float2*)(lrb + R * 32 + d * 16 + lc * 2);
    };
    int q = (int)(blockIdx.x >> 3);
    if (q < NB * 132) fetch(q);
    for (; q < NB * 132; q += qstep) {
        const int cc = q % 132, b = q / 132;
        unsigned char* rec = gt + gla_tile_off(b, hd, d, cc);
        const uint4 rq0 = nq0, rq1 = nq1, rk0 = nk0, rk1 = nk1; const float2 rl = nl;
        if (q + qstep < NB * 132) fetch(q + qstep);
        *(unsigned*)(lds + LRL + li * 32 + lc * 4) = pk_bf16(rl.x, rl.y);
        __syncthreads();
        {
            const float gbv[4] = {gb4.x, gb4.y, gb4.z, gb4.w};
#pragma unroll
            for (int itl = 0; itl < 4; ++itl) {
                uint4 lr4 = *(const uint4*)(lds + LRL + (itl * 16 + fr) * 32 + (fq & 1) * 16);
                if (fq >= 2) lr4 = make_uint4(0, 0, 0, 0);
                f32x4 a = {0.f, 0.f, 0.f, 0.f};
                a = __builtin_amdgcn_mfma_f32_16x16x32_bf16(gkf, as_bf16x8(lr4), a, 0, 0, 0);
                float s[4], tot[4];
#pragma unroll
                for (int j = 0; j < 4; ++j) {
                    const float xx = a[j] + gbv[j];
                    const float la = (fminf(xx, 0.f) - __logf(1.0f + __expf(-fabsf(xx)))) * (1.0f / 16.0f);
                    float pf = la;
                    pf += dpp_shr0<1>(pf); pf += dpp_shr0<2>(pf); pf += dpp_shr0<4>(pf); pf += dpp_shr0<8>(pf);
                    tot[j] = __shfl(pf, (lane & 48) | 15);
                    s[j] = d ? (tot[j] - pf + la) : pf;
                }
                *(float4*)(bc + (itl * 16 + fr) * BCS + wv * 16 + 4 * fq) = make_float4(s[0], s[1], s[2], s[3]);
                if (fr == 15) *(float4*)(gs + itl * 128 + wv * 16 + 4 * fq) = make_float4(tot[0], tot[1], tot[2], tot[3]);
            }
        }
        __syncthreads();
        if (tid < 128) {
            const float g0 = gs[tid], g1 = gs[128 + tid], g2 = gs[256 + tid], g3 = gs[384 + tid];
            const float refc = d ? (bc[31 * BCS + tid] + g2 + g3) : (bc[32 * BCS + tid] + g0 + g1), lastc = g0 + g1 + g2 + g3;
            const float dl = __expf(lastc), er = __expf(refc), el = __expf(lastc - refc);
            gs[512 + tid] = refc;
            float* cst = (float*)(rec + GT_CONST);
            cst[tid] = er; cst[128 + tid] = el; cst[256 + tid] = dl;
        }
        __syncthreads();
        {
            const int grp = li >> 4;
            const uint4 rqs[2] = {rq0, rq1}, rks[2] = {rk0, rk1};
#pragma unroll
            for (int hseg = 0; hseg < 2; ++hseg) {
                const int k0 = hseg * 64 + lc * 8;
                float bcv[8], refv[8];
#pragma unroll
                for (int j4 = 0; j4 < 2; ++j4) {
                    const float4 g0 = *(const float4*)(gs + k0 + j4 * 4), g1 = *(const float4*)(gs + 128 + k0 + j4 * 4);
                    const float4 g2 = *(const float4*)(gs + 256 + k0 + j4 * 4), g3 = *(const float4*)(gs + 384 + k0 + j4 * 4);
                    const float4 bi = *(const float4*)(bc + li * BCS + k0 + j4 * 4), rf = *(const float4*)(gs + 512 + k0 + j4 * 4);
                    const float g0a[4] = {g0.x, g0.y, g0.z, g0.w}, g1a[4] = {g1.x, g1.y, g1.z, g1.w}, g2a[4] = {g2.x, g2.y, g2.z, g2.w}, g3a[4] = {g3.x, g3.y, g3.z, g3.w};
                    const float bia[4] = {bi.x, bi.y, bi.z, bi.w}, rfa[4] = {rf.x, rf.y, rf.z, rf.w};
#pragma unroll
                    for (int j = 0; j < 4; ++j) {
                        const float pre = d ? ((grp < 1 ? g1a[j] : 0.f) + (grp < 2 ? g2a[j] : 0.f) + (grp < 3 ? g3a[j] : 0.f))
                                            : ((grp > 0 ? g0a[j] : 0.f) + (grp > 1 ? g1a[j] : 0.f) + (grp > 2 ? g2a[j] : 0.f));
                        bcv[j4 * 4 + j] = bia[j] + pre;
                        refv[j4 * 4 + j] = rfa[j];
                    }
                }
                const unsigned qw[4] = {rqs[hseg].x, rqs[hseg].y, rqs[hseg].z, rqs[hseg].w}, kw[4] = {rks[hseg].x, rks[hseg].y, rks[hseg].z, rks[hseg].w};
                unsigned oqe[4], oke[4];
#pragma unroll
                for (int j2 = 0; j2 < 4; ++j2) {
                    const float q0 = bf_lo(qw[j2]), q1 = bf_hi(qw[j2]), kk0 = bf_lo(kw[j2]), kk1 = bf_hi(kw[j2]);
                    const float e0 = __expf(bcv[2 * j2] - refv[2 * j2]), e1 = __expf(bcv[2 * j2 + 1] - refv[2 * j2 + 1]);
                    const float r0 = __builtin_amdgcn_rcpf(e0), r1 = __builtin_amdgcn_rcpf(e1);
                    oqe[j2] = pk_bf16(q0 * e0, q1 * e1);
                    oke[j2] = pk_bf16(kk0 * r0, kk1 * r1);
                    const int kc0 = k0 + 2 * j2;
                    *(bf16_t*)(lds + KET + tile_off2(kc0, li >> 3) + (li & 7) * 2) = (bf16_t)(oke[j2] & 0xffffu);
                    *(bf16_t*)(lds + KET + tile_off2(kc0 + 1, li >> 3) + (li & 7) * 2) = (bf16_t)(oke[j2] >> 16);
                }
                const int chq = hseg * 8 + lc;
                const int so = li * 256 + ((chq ^ (li & 15)) << 4);
                *(uint4*)(lds + QE + so) = make_uint4(oqe[0], oqe[1], oqe[2], oqe[3]);
                *(uint4*)(lds + KE + so) = make_uint4(oke[0], oke[1], oke[2], oke[3]);
                *(uint4*)(rec + GT_QE + so) = make_uint4(oqe[0], oqe[1], oqe[2], oqe[3]);
            }
        }
        __syncthreads();
        {
            const int it = wv & 3, pr2 = wv >> 2;
#pragma unroll
            for (int jj = 0; jj < 2; ++jj) {
                const int jt = pr2 * 2 + jj;
                f32x4 a = {0.f, 0.f, 0.f, 0.f};
                if (d ? (jt >= it) : (jt <= it)) {
#pragma unroll
                    for (int ks = 0; ks < 4; ++ks) {
                        const int ch = ks * 4 + fq;
                        const int rj = jt * 16 + fr, ri = it * 16 + fr;
                        const bf16x8 fa = *(const bf16x8*)(lds + KE + rj * 256 + ((ch ^ (rj & 15)) << 4));
                        const bf16x8 fb = *(const bf16x8*)(lds + QE + ri * 256 + ((ch ^ (ri & 15)) << 4));
                        a = __builtin_amdgcn_mfma_f32_16x16x32_bf16(fa, fb, a, 0, 0, 0);
                    }
                }
                const int i = it * 16 + fr, j = jt * 16 + 4 * fq;
                float av[4];
#pragma unroll
                for (int e = 0; e < 4; ++e) av[e] = (d ? (j + e >= i) : (j + e <= i)) ? a[e] : 0.f;
                *(uint2*)(rec + GT_A + i * 128 + (((j >> 3) ^ (i & 7)) << 4) + (j & 7) * 2) = make_uint2(pk_bf16(av[0], av[1]), pk_bf16(av[2], av[3]));
            }
#pragma unroll
            for (int i = 0; i < 2; ++i) *(uint4*)(rec + GT_KET + i * 8192 + tid * 16) = *(const uint4*)(lds + KET + i * 8192 + tid * 16);
        }
        __syncthreads();
    }
}

DEV void phase_gla_scan(const Params& p, unsigned char* lds) {
    const int tid = tid_opaque(), lane = tid & 63, wv = tid >> 6;
    const int fr = lane & 15, fq = lane >> 4;
    unsigned char* ws = p.ws;
    constexpr int QE = 0  , KET = 32768  , AL = 65536  , VT = 81920, ST = 90112  ;
    const bf16_t* qkv = (const bf16_t*)(ws + WS_S + 4 * U_BYTES);
    const unsigned char* gt = ws;
    for (int unit = blockIdx.x; unit < 256; unit += gridDim.x) {
        const int vs = unit & 3, d = (unit >> 2) & 1, hd = (unit >> 3) & 3, b = unit >> 5;
        bf16_t* odst = d ? (bf16_t*)(ws + WS_S + 2 * U_BYTES) : (bf16_t*)(ws + WS_S + 4 * U_BYTES);
        const int old_ = d ? 1024 : 2048;
        const int li = tid >> 3, lc = tid & 7;
        auto ccof = [&](int c) -> int { return d ? (c < 4 ? 3 - c : 135 - c) : c; };
        auto dma = [&](int cc, int buf) {
            const unsigned char* rec = gt + gla_tile_off(b, hd, d, cc);
#pragma unroll
            for (int i = 0; i < 2; ++i) {
                __builtin_amdgcn_global_load_lds((const unsigned*)(rec + GT_QE + i * 8192 + tid * 16), (unsigned*)(lds + QE + buf * 16384 + i * 8192 + tid * 16), 16, 0, 0);
                __builtin_amdgcn_global_load_lds((const unsigned*)(rec + GT_KET + i * 8192 + tid * 16), (unsigned*)(lds + KET + buf * 16384 + i * 8192 + tid * 16), 16, 0, 0);
            }
            __builtin_amdgcn_global_load_lds((const unsigned*)(rec + GT_A + tid * 16), (unsigned*)(lds + AL + buf * 8192 + tid * 16), 16, 0, 0);
        };
        uint4 nv; float4 n_dl, n_el, n_er;
        auto loads = [&](int c) {
            const int cc = ccof(c);
            nv = *(const uint4*)(qkv + (size_t)(gla_row0(b, cc) + li) * 2048 + 1024 + hd * 256 + vs * 64 + lc * 8);
            const float* cst = (const float*)(gt + gla_tile_off(b, hd, d, cc) + GT_CONST);
            n_el = *(const float4*)(cst + 128 + wv * 16 + 4 * fq); n_dl = *(const float4*)(cst + 256 + wv * 16 + 4 * fq);
            if (c + 1 < 132) n_er = *(const float4*)((const float*)(gt + gla_tile_off(b, hd, d, ccof(c + 1)) + GT_CONST) + wv * 16 + 4 * fq);
            else n_er = make_float4(0.f, 0.f, 0.f, 0.f);
        };
        f32x4 accS[4];
#pragma unroll
        for (int i = 0; i < 4; ++i) accS[i] = (f32x4){0.f, 0.f, 0.f, 0.f};
        for (int i = tid; i < 32768 / 16; i += NTHREADS) *(uint4*)(lds + ST + i * 16) = make_uint4(0, 0, 0, 0);
        dma(ccof(0), 0);
        loads(0);
        for (int c = 0; c < 132; ++c) {
            const int buf = c & 1, cc = ccof(c);
            const uint4 rv = nv; const float4 dl4 = n_dl, el4 = n_el, er4 = n_er;
            asm volatile("s_waitcnt vmcnt(0)" ::: "memory");
            {
                const unsigned vw[4] = {rv.x, rv.y, rv.z, rv.w};
#pragma unroll
                for (int j2 = 0; j2 < 4; ++j2) {
                    const int vc0 = lc * 8 + 2 * j2;
                    *(bf16_t*)(lds + VT + tile_off2(vc0, li >> 3) + (li & 7) * 2) = (bf16_t)(vw[j2] & 0xffffu);
                    *(bf16_t*)(lds + VT + tile_off2(vc0 + 1, li >> 3) + (li & 7) * 2) = (bf16_t)(vw[j2] >> 16);
                }
            }
            asm volatile("s_waitcnt lgkmcnt(0)" ::: "memory"); __builtin_amdgcn_s_barrier(); asm volatile("" ::: "memory");
            if (c + 1 < 132) { dma(ccof(c + 1), buf ^ 1); loads(c + 1); }
            const int it = wv & 3, pr2 = wv >> 2;
            const int r0 = gla_row0(b, cc);
#pragma unroll
            for (int vv = 0; vv < 2; ++vv) {
                const int vt = pr2 * 2 + vv;
                f32x4 a = {0.f, 0.f, 0.f, 0.f};
#pragma unroll
                for (int ks = 0; ks < 4; ++ks) {
                    const int ch = ks * 4 + fq;
                    const int rvv = vt * 16 + fr, ri = it * 16 + fr;
                    const bf16x8 fa = *(const bf16x8*)(lds + ST + buf * 16384 + rvv * 256 + ((ch ^ (rvv & 15)) << 4));
                    const bf16x8 fb = *(const bf16x8*)(lds + QE + buf * 16384 + ri * 256 + ((ch ^ (ri & 15)) << 4));
                    a = __builtin_amdgcn_mfma_f32_16x16x32_bf16(fa, fb, a, 0, 0, 0);
                }
#pragma unroll
                for (int ks = 0; ks < 2; ++ks) {
                    const int ch = ks * 4 + fq;
                    const int rvv = vt * 16 + fr, ri = it * 16 + fr;
                    const bf16x8 fa = *(const bf16x8*)(lds + VT + tile_off2(rvv, ch));
                    const bf16x8 fb = *(const bf16x8*)(lds + AL + buf * 8192 + ri * 128 + ((ch ^ (ri & 7)) << 4));
                    a = __builtin_amdgcn_mfma_f32_16x16x32_bf16(fa, fb, a, 0, 0, 0);
                }
                const int i = it * 16 + fr, vcol = vt * 16 + 4 * fq;
                *(uint2*)(odst + (size_t)(r0 + i) * old_ + hd * 256 + vs * 64 + vcol) = make_uint2(pk_bf16(a[0], a[1]), pk_bf16(a[2], a[3]));
            }
            {
                const int kt = wv;
                bf16x8 fa[2];
#pragma unroll
                for (int ks = 0; ks < 2; ++ks) fa[ks] = *(const bf16x8*)(lds + KET + buf * 16384 + tile_off2(kt * 16 + fr, ks * 4 + fq));
#pragma unroll
                for (int vt = 0; vt < 4; ++vt) {
                    f32x4 t = {0.f, 0.f, 0.f, 0.f};
#pragma unroll
                    for (int ks = 0; ks < 2; ++ks) t = __builtin_amdgcn_mfma_f32_16x16x32_bf16(fa[ks], *(const bf16x8*)(lds + VT + tile_off2(vt * 16 + fr, ks * 4 + fq)), t, 0, 0, 0);
                    f32x4 a = accS[vt];
                    a[0] = a[0] * dl4.x + t[0] * el4.x; a[1] = a[1] * dl4.y + t[1] * el4.y; a[2] = a[2] * dl4.z + t[2] * el4.z; a[3] = a[3] * dl4.w + t[3] * el4.w;
                    accS[vt] = a;
                    const int vcol = vt * 16 + fr, kcol = kt * 16 + 4 * fq;
                    *(uint2*)(lds + ST + (buf ^ 1) * 16384 + vcol * 256 + (((kcol >> 3) ^ (vcol & 15)) << 4) + (kcol & 7) * 2) =
                        make_uint2(pk_bf16(a[0] * er4.x, a[1] * er4.y), pk_bf16(a[2] * er4.z, a[3] * er4.w));
                }
            }
            asm volatile("s_waitcnt lgkmcnt(0)" ::: "memory"); __builtin_amdgcn_s_barrier(); asm volatile("" ::: "memory");
        }
        asm volatile("s_waitcnt vmcnt(0)" ::: "memory");
        __syncthreads();
    }
}

DEV void phase_gla_readout(const Params& p) {
    const int tid = tid_opaque(), lane = tid & 63;
    const int gw = blockIdx.x * 8 + (tid >> 6), nw = gridDim.x * 8;
    unsigned char* ws = p.ws;
    const bf16_t* o0 = (const bf16_t*)(ws + WS_S + 4 * U_BYTES);
    const bf16_t* o1 = (const bf16_t*)(ws + WS_S + 2 * U_BYTES);
    const bf16_t* gb = (const bf16_t*)(ws + WS_S + 3 * U_BYTES);
    bf16_t* ao = (bf16_t*)(ws + WS_S + 0 * U_BYTES);
    const float4 hn = *(const float4*)(p.in[28] + lane * 4);
    for (int item0 = gw; item0 < NL * 4; item0 += 4 * nw) {
        uint2 a[4], b2[4], g2[4];
#pragma unroll
        for (int q = 0; q < 4; ++q) {
            const int item = min(item0 + q * nw, NL * 4 - 1);
            const size_t off = (size_t)(item >> 2) * 1024 + (item & 3) * 256 + lane * 4;
            a[q] = *(const uint2*)(o0 + off + (size_t)(item >> 2) * 1024); b2[q] = *(const uint2*)(o1 + off); g2[q] = *(const uint2*)(gb + off);
        }
        float v[4][4], ss[4];
#pragma unroll
        for (int q = 0; q < 4; ++q) {
            v[q][0] = bf_lo(a[q].x) + bf_lo(b2[q].x); v[q][1] = bf_hi(a[q].x) + bf_hi(b2[q].x); v[q][2] = bf_lo(a[q].y) + bf_lo(b2[q].y); v[q][3] = bf_hi(a[q].y) + bf_hi(b2[q].y);
            ss[q] = v[q][0] * v[q][0] + v[q][1] * v[q][1] + v[q][2] * v[q][2] + v[q][3] * v[q][3];
        }
#pragma unroll
        for (int q = 0; q < 4; ++q) ss[q] = wave_allreduce(ss[q]);
#pragma unroll
        for (int q = 0; q < 4; ++q) {
            const int item = item0 + q * nw;
            if (item < NL * 4) {
                const size_t off = (size_t)(item >> 2) * 1024 + (item & 3) * 256 + lane * 4;
                const float rs = rsqrtf(ss[q] * (1.0f / 256.0f) + 1e-6f);
                const float g0 = bf_lo(g2[q].x), g1 = bf_hi(g2[q].x), g2f = bf_lo(g2[q].y), g3 = bf_hi(g2[q].y);
                const float r0 = v[q][0] * rs * hn.x * (g0 * sigmoidf_(g0)), r1 = v[q][1] * rs * hn.y * (g1 * sigmoidf_(g1));
                const float r2 = v[q][2] * rs * hn.z * (g2f * sigmoidf_(g2f)), r3 = v[q][3] * rs * hn.w * (g3 * sigmoidf_(g3));
                *(uint2*)(ao + off) = make_uint2(pk_bf16(r0, r1), pk_bf16(r2, r3));
            }
        }
    }
}


#define XB_TMO      128
#define XB_XCNT(j)  (256  + 64 * (j))
#define XB_XSUB(j)  (1280 + 64 * (j))
#define XB_XGEN(j)  (2304 + 64 * (j))
#define XB_TOP      3328
#define XB_TOPGEN   3392
#define XB_SPIN_CAP (1u << 22)
DEV unsigned xb_ld(unsigned* p) { return __hip_atomic_load(p, __ATOMIC_RELAXED, __HIP_MEMORY_SCOPE_AGENT); }
DEV unsigned xb_add(unsigned* p, unsigned v) { return __hip_atomic_fetch_add(p, v, __ATOMIC_RELAXED, __HIP_MEMORY_SCOPE_AGENT); }
DEV unsigned xb_xcc_id() { return (unsigned)__builtin_amdgcn_s_getreg((3 << 11) | 20) & 0xFu; }
#define XB_SPIN(cond, bar) do { unsigned _sp = 0; while (cond) { __builtin_amdgcn_s_sleep(1); \
    if ((++_sp & 255u) == 0u) { if (xb_ld(&(bar)[XB_TMO])) break; if (_sp > XB_SPIN_CAP) { atomicAdd(&(bar)[XB_TMO], 1u); break; } } } } while (0)
DEV void xcd_barrier_complete(unsigned* bar, unsigned x, unsigned& nloc, unsigned& nx) {
    const unsigned G = gridDim.x;
    unsigned sum, cnt, mine, sp = 0u;
    for (;;) {
        sum = 0u; cnt = 0u; mine = 0u;
#pragma unroll
        for (unsigned j = 0; j < 16; ++j) { const unsigned c = xb_ld(&bar[XB_XCNT(j)]); sum += c; cnt += (c > 0u) ? 1u : 0u; mine = (j == x) ? c : mine; }
        if (sum == G) break;
        __builtin_amdgcn_s_sleep(1);
        if ((++sp & 255u) == 0u) { if (xb_ld(&bar[XB_TMO])) break; if (sp > XB_SPIN_CAP) { atomicAdd(&bar[XB_TMO], 1u); break; } }
    }
    nloc = mine > 0u ? mine : 1u; nx = cnt > 0u ? cnt : 1u;
}
DEV void xcd_barrier(unsigned* bar, volatile LAS3 unsigned* st) {
    asm volatile("s_waitcnt vmcnt(0)" ::: "memory");
    __syncthreads();
    if (tid_opaque() == 0) {
        const unsigned x = xb_xcc_id();
        __builtin_amdgcn_s_waitcnt(0);
        unsigned nloc = st[0], nx = st[1];
        if (nloc == 0u) { xcd_barrier_complete(bar, x, nloc, nx); st[0] = nloc; st[1] = nx; }
        const unsigned old = xb_add(&bar[XB_XSUB(x)], 1u);
        const unsigned gen = old / nloc;
        if (old + 1u == (gen + 1u) * nloc) {
            __builtin_amdgcn_fence(__ATOMIC_RELEASE, "agent");
            asm volatile("s_waitcnt vmcnt(0)" ::: "memory");
            const unsigned og = xb_add(&bar[XB_TOP], 1u);
            const unsigned tg = og / nx;
            if (og + 1u == (tg + 1u) * nx) xb_add(&bar[XB_TOPGEN], 1u);
            else XB_SPIN(xb_ld(&bar[XB_TOPGEN]) == tg, bar);
            __builtin_amdgcn_fence(__ATOMIC_ACQUIRE, "agent");
            xb_add(&bar[XB_XGEN(x)], 1u);
            asm volatile("s_waitcnt vmcnt(0)" ::: "memory");
        } else {
            XB_SPIN(xb_ld(&bar[XB_XGEN(x)]) == gen, bar);
            __builtin_amdgcn_fence(__ATOMIC_ACQUIRE, "agent");
            asm volatile("s_waitcnt vmcnt(0)" ::: "memory");
        }
    }
    __syncthreads();
}
#define SYNC() do { asm volatile("s_waitcnt vmcnt(0)" ::: "memory"); grid.sync(); \
    if (tid_opaque() == 0) { __builtin_amdgcn_fence(__ATOMIC_ACQUIRE, "agent"); asm volatile("s_waitcnt vmcnt(0)" ::: "memory"); } \
    __syncthreads(); } while (0)
__global__ void __launch_bounds__(NTHREADS) mega_fwd(Params p) {
    unsigned char* const lds = g_lds;
    cg::grid_group grid = cg::this_grid();
#define XBAR ((unsigned*)(p.ws + WS_BAR))
#define XST ((volatile LAS3 unsigned*)(lds + LDS_BYTES - 16))
    if ((threadIdx.x & 63) == 0) g_lds[LDS_WTAB + hw_wave_slot()] = (unsigned char)(threadIdx.x >> 6);
    if (threadIdx.x == 0) { XST[0] = 0u; XST[1] = 0u; (void)xb_add(&XBAR[XB_XCNT(xb_xcc_id())], 1u); }
    __syncthreads();
#define S0 ((bf16_t*)(p.ws + WS_S + 0 * U_BYTES))
#define SLOT(i) ((bf16_t*)(p.ws + WS_S + (size_t)(i) * U_BYTES))
#define S1 ((bf16_t*)(p.ws + WS_S + 1 * U_BYTES))
#define CTXR ((const float*)(p.ws + WS_CTXR))
    phase0(p, lds); SYNC();
#undef SYNC
#define SYNC() xcd_barrier(XBAR, XST)
    phase_normmix(p, S0, SLOT(5), SLOT(1), SLOT(2)); SYNC();
    phase_rw_proj1(p, lds, 0, SLOT(5), SLOT(3)); SYNC();
    phase_rw_proj1(p, lds, 1, SLOT(1), SLOT(5)); SYNC();
    phase_rw_proj1(p, lds, 2, SLOT(2), SLOT(1)); phase_rw_lora(p, lds); SYNC();
    REPEAT(3, phase_rw_scan(p, lds));
    phase_rw_scan(p, lds); SYNC();
    REPEAT(4, phase_rw_readout(p));
    phase_rw_readout(p); SYNC();
    REPEAT(5, phase_wo(p, lds, 0));
    phase_wo(p, lds, 0); SYNC();
    REPEAT(6, phase_normmod(p, 0, 1, p.out, CTXR, NT, S1, (unsigned char*)SLOT(2)));
    phase_normmod(p, 0, 1, p.out, CTXR, NT, S1, (unsigned char*)SLOT(2)); SYNC();
    REPEAT(7, phase_peer_select(p, lds, 0));
    phase_peer_select(p, lds, 0); SYNC();
    phase_peer_u(p, lds, 0); SYNC();
    phase_peer_c(p, 0); SYNC();
    phase_peer_v(p, 0); SYNC();
    phase_normmod(p, 1, 0, p.out, CTXR, NT, S0, nullptr); SYNC();
    REPEAT(9, phase_gla_proj(p, lds));
    phase_gla_proj(p, lds); SYNC();
    REPEAT(10, phase_gla_conv(p));
    phase_gla_conv(p); SYNC();
    REPEAT(18, phase_gla_prep(p, lds));
    phase_gla_prep(p, lds); SYNC();
    REPEAT(11, phase_gla_scan(p, lds));
    phase_gla_scan(p, lds); SYNC();
    REPEAT(12, phase_gla_readout(p));
    phase_gla_readout(p); SYNC();
    phase_wo(p, lds, 1); SYNC();
    REPEAT(14, phase_normmod(p, 1, 1, p.out, CTXR, NL, S0, (unsigned char*)SLOT(2)));
    phase_normmod(p, 1, 1, p.out, CTXR, NL, S0, (unsigned char*)SLOT(2)); SYNC();
    REPEAT(15, phase_peer_select(p, lds, 1));
    phase_peer_select(p, lds, 1); SYNC();
    phase_peer_u(p, lds, 1); SYNC();
    phase_peer_c(p, 1); SYNC();
    phase_peer_v(p, 1); SYNC();
    phase_final_norm(p);
}

extern "C" void kernel_launch(void* const* d_in, const int* in_sizes, int n_in, void* d_out, int out_size, void* d_ws, size_t ws_size, hipStream_t stream) {
    static int grid_blocks = 0;
    if (grid_blocks == 0) {
        if (n_in != 35 || ws_size < WS_TOTAL) { fprintf(stderr, "kernel_launch: unexpected n_in %d or ws_size %zu (< %zu)\n", n_in, ws_size, (size_t)WS_END); grid_blocks = -1; return; }
        int dev = 0, cus = 0, per_cu = 0;
        if (hipGetDevice(&dev) != hipSuccess || hipDeviceGetAttribute(&cus, hipDeviceAttributeMultiprocessorCount, dev) != hipSuccess) { fprintf(stderr, "kernel_launch: device query failed\n"); grid_blocks = -1; return; }
        if (hipFuncSetAttribute((const void*)mega_fwd, hipFuncAttributeMaxDynamicSharedMemorySize, LDS_BYTES) != hipSuccess) { fprintf(stderr, "kernel_launch: hipFuncSetAttribute failed\n"); grid_blocks = -1; return; }
        if (hipOccupancyMaxActiveBlocksPerMultiprocessor(&per_cu, (const void*)mega_fwd, NTHREADS, LDS_BYTES) != hipSuccess || per_cu < 1) { fprintf(stderr, "kernel_launch: occupancy query says %d blocks per CU\n", per_cu); grid_blocks = -1; return; }
        grid_blocks = cus;
    }
    if (grid_blocks < 0) return;
    Params p{};
    for (int i = 0; i < 35; ++i) p.in[i] = (const float*)d_in[i];
    p.out = (float*)d_out;
    p.ws = (unsigned char*)d_ws;
    if (hipMemsetAsync((char*)d_ws + WS_BAR, 0, 16384, stream) != hipSuccess) { fprintf(stderr, "kernel_launch: hipMemsetAsync failed\n"); return; }
    void* args[] = {&p};
    hipError_t e = hipLaunchCooperativeKernel((const void*)mega_fwd, dim3(grid_blocks), dim3(NTHREADS), args, LDS_BYTES, stream);
    if (e != hipSuccess) fprintf(stderr, "kernel_launch: cooperative launch failed: %s (grid %d)\n", hipGetErrorString(e), grid_blocks);
}
```

```cpp
#include <hip/hip_runtime.h>
#include <hip/hip_cooperative_groups.h>
#include <cstdio>
#include <cstdint>
namespace cg = cooperative_groups;

#define DEV __device__ __forceinline__
#ifndef REP
#define REP 0
#endif
#define GREPS(n) ((REP == (n)) ? 2 : 1)
#define REPEAT(n, stmt) do { if (REP == (n)) { stmt; SYNC(); } } while (0)

typedef unsigned short bf16_t;
typedef short bf16x8 __attribute__((ext_vector_type(8)));
typedef float f32x4 __attribute__((ext_vector_type(4)));
typedef __bf16 bf16x2v __attribute__((ext_vector_type(2)));

constexpr int D = 1024;
constexpr int NB = 8, SEQ = 8192, CTXL = 256;
constexpr int NL = NB * SEQ, NC = NB * CTXL, NT = NL + NC;
constexpr int NTHREADS = 512;
constexpr int LDS_BYTES = 160 * 1024;

constexpr size_t U_BYTES = (size_t)NT * 1024 * 2;
constexpr size_t WS_BAR = 0;
constexpr size_t WS_MOD = 16384;
constexpr size_t WS_CTXR = WS_MOD + (size_t)2 * 9 * 6144 * 4;
constexpr size_t WS_LR = WS_CTXR + (size_t)NC * 1024 * 4;
constexpr size_t WS_BONUS = WS_LR + (size_t)NT * 32 * 4;
constexpr size_t WS_WPROJ = WS_BONUS + (size_t)2 * NT * 16 * 4;
constexpr size_t WS_W2T = WS_WPROJ + (size_t)3456 * 1024 * 2;
constexpr size_t WS_A2T = WS_W2T + (size_t)2 * 1024 * 64 * 2;
constexpr size_t WS_G2T = WS_A2T + (size_t)2 * 1024 * 64 * 2;
constexpr size_t WS_WO0 = WS_G2T + (size_t)1024 * 128 * 2;
constexpr size_t WS_WO1 = WS_WO0 + (size_t)1024 * 1024 * 2;
constexpr size_t WS_WQ = WS_WO1 + (size_t)1024 * 1024 * 2;
constexpr size_t WS_KEYS = WS_WQ + (size_t)2 * 2048 * 1024 * 2;
constexpr size_t WS_WIN = WS_KEYS + (size_t)2 * 8 * 2 * 128 * 128 * 2;
constexpr size_t WS_PU = WS_WIN + (size_t)3200 * 1024 * 2;
constexpr size_t WS_PV = WS_PU + (size_t)2 * 16384 * 1024;
constexpr size_t WS_PSC = WS_PV + (size_t)2 * 16384 * 1024;
constexpr size_t WS_S = WS_PSC + (size_t)2 * 2 * 16384 * 4;
constexpr size_t WS_END = WS_S + 6 * U_BYTES;
static_assert(WS_END <= 1073741824ull, "workspace too large");
static_assert((WS_CTXR % 256) == 0 && (WS_WPROJ % 256) == 0 && (WS_S % 256) == 0, "alignment");

struct Params {
    const float* in[35];
    float* out;
    unsigned char* ws;
    int pad0, pad1;
};

DEV float bf_lo(unsigned u) { return __uint_as_float(u << 16); }
DEV float bf_hi(unsigned u) { return __uint_as_float(u & 0xffff0000u); }
typedef float f32x2v __attribute__((ext_vector_type(2)));
typedef unsigned int u32x2v __attribute__((ext_vector_type(2)));
typedef short s16x4v __attribute__((ext_vector_type(4)));
DEV unsigned pk_bf16(float lo, float hi) { const f32x2v f = {lo, hi}; union { bf16x2v v; unsigned u; } x; x.v = __builtin_convertvector(f, bf16x2v); return x.u; }
template <int N> DEV float dpp_ror(float x) { return __int_as_float(__builtin_amdgcn_update_dpp(0, __float_as_int(x), 0x120 + N, 0xF, 0xF, false)); }
DEV float row16_allreduce(float x) { x += dpp_ror<8>(x); x += dpp_ror<4>(x); x += dpp_ror<2>(x); x += dpp_ror<1>(x); return x; }
DEV float wave_allreduce(float x) { x = row16_allreduce(x); x += __shfl_xor(x, 16); x += __shfl_xor(x, 32); return x; }
DEV float sigmoidf_(float x) { return 1.0f / (1.0f + __expf(-x)); }
DEV float softplusf_(float z) { return fmaxf(z, 0.f) + __logf(1.0f + __expf(-fabsf(z))); }
DEV unsigned mono_u32(float f) { unsigned u = __float_as_uint(f); return u ^ ((u >> 31) ? 0xFFFFFFFFu : 0x80000000u); }
DEV float unmono_u32(unsigned k) { unsigned u = (k & 0x80000000u) ? (k ^ 0x80000000u) : ~k; return __uint_as_float(u); }
DEV bf16x8 as_bf16x8(uint4 v) { union { uint4 u; bf16x8 b; } x; x.u = v; return x.b; }
#define LAS3 __attribute__((address_space(3)))
extern __shared__ __attribute__((aligned(16))) unsigned char g_lds[];
constexpr int LDS_WTAB = LDS_BYTES - 128;
DEV unsigned hw_wave_slot() { return (unsigned)__builtin_amdgcn_s_getreg((5 << 11) | 4) & 63u; }
DEV int tid_opaque() {
    const int wv = (int)*(const volatile unsigned char*)(g_lds + LDS_WTAB + hw_wave_slot());
    int t = (wv << 6) | (int)__builtin_amdgcn_mbcnt_hi(~0u, __builtin_amdgcn_mbcnt_lo(~0u, 0u));
    asm volatile("" : "+v"(t));
    return t;
}
DEV int mod_batch(int R) { return R < NL ? (R >> 13) : 8; }

template <int BN, class AL, class EP>
DEV void gemm_unit(unsigned char* lds, const AL& al, const bf16_t* Bt, int K, int m0, const EP& ep) {
    constexpr int NI = BN / 64;
    constexpr int A_BYTES = 128 * 128;
    constexpr int B_BYTES = BN * 128;
    const int tid = tid_opaque(), lane = tid & 63, wv = tid >> 6, wm = wv >> 2, wn = wv & 3;
    const int fr = lane & 15, fq = lane >> 4;
    unsigned char* sA = lds;
    unsigned char* sB = lds + 2 * A_BYTES;
    f32x4 acc[4][NI];
#pragma unroll
    for (int mi = 0; mi < 4; ++mi)
#pragma unroll
        for (int ni = 0; ni < NI; ++ni) acc[mi][ni] = (f32x4){0.f, 0.f, 0.f, 0.f};
    const int KT = K >> 6;
    const int drow = tid >> 3, dch = (tid & 7) ^ (drow & 7);
    const bf16_t* bsrc = Bt + (size_t)drow * K + dch * 8;
    uint4 ra[2];
    auto stage = [&](int kt, int buf) {
        const int k0 = kt * 64;
#pragma unroll
        for (int i = 0; i < BN / 64; ++i)
            __builtin_amdgcn_global_load_lds((const unsigned*)(bsrc + (size_t)(64 * i) * K + k0), (unsigned*)(sB + buf * B_BYTES + i * 8192 + tid * 16), 16, 0, 0);
        if constexpr (AL::DMA) {
#pragma unroll
            for (int i = 0; i < 2; ++i)
                __builtin_amdgcn_global_load_lds((const unsigned*)(al.A + (size_t)(m0 + drow + 64 * i) * al.lda + k0 + dch * 8), (unsigned*)(sA + buf * A_BYTES + i * 8192 + tid * 16), 16, 0, 0);
        } else {
#pragma unroll
            for (int i = 0; i < 2; ++i) { const int q = tid + 512 * i; ra[i] = al.load(m0 + (q >> 3), k0 + (q & 7) * 8); }
        }
    };
    auto commit = [&](int buf) {
        if constexpr (!AL::DMA) {
#pragma unroll
            for (int i = 0; i < 2; ++i) { const int q = tid + 512 * i, row = q >> 3, ch = q & 7; *(uint4*)(sA + buf * A_BYTES + row * 128 + ((ch ^ (row & 7)) << 4)) = ra[i]; }
        }
    };
    auto compute = [&](int buf) {
        const unsigned char* a_base = sA + buf * A_BYTES;
        const unsigned char* b_base = sB + buf * B_BYTES;
#pragma unroll
        for (int ks = 0; ks < 2; ++ks) {
            bf16x8 af[4], bfr[NI];
            const int ch = ks * 4 + fq;
#pragma unroll
            for (int mi = 0; mi < 4; ++mi) { const int row = wm * 64 + mi * 16 + fr; af[mi] = *(const bf16x8*)(a_base + row * 128 + ((ch ^ (row & 7)) << 4)); }
#pragma unroll
            for (int ni = 0; ni < NI; ++ni) { const int row = wn * (BN / 4) + ni * 16 + fr; bfr[ni] = *(const bf16x8*)(b_base + row * 128 + ((ch ^ (row & 7)) << 4)); }
#pragma unroll
            for (int mi = 0; mi < 4; ++mi)
#pragma unroll
                for (int ni = 0; ni < NI; ++ni) acc[mi][ni] = __builtin_amdgcn_mfma_f32_16x16x32_bf16(bfr[ni], af[mi], acc[mi][ni], 0, 0, 0);
        }
    };
    if constexpr (AL::DMA) {
        constexpr int STG = A_BYTES + B_BYTES;
        auto stage3 = [&](int kt, int b3) {
            const int k0 = kt * 64;
            unsigned char* base = lds + b3 * STG;
#pragma unroll
            for (int i = 0; i < BN / 64; ++i)
                __builtin_amdgcn_global_load_lds((const unsigned*)(bsrc + (size_t)(64 * i) * K + k0), (unsigned*)(base + A_BYTES + i * 8192 + tid * 16), 16, 0, 0);
#pragma unroll
            for (int i = 0; i < 2; ++i)
                __builtin_amdgcn_global_load_lds((const unsigned*)(al.A + (size_t)(m0 + drow + 64 * i) * al.lda + k0 + dch * 8), (unsigned*)(base + i * 8192 + tid * 16), 16, 0, 0);
        };
        auto compute3 = [&](int b3) {
            const unsigned char* a_base = lds + b3 * STG;
            const unsigned char* b_base = a_base + A_BYTES;
#pragma unroll
            for (int ks = 0; ks < 2; ++ks) {
                bf16x8 af[4], bfr[NI];
                const int ch = ks * 4 + fq;
#pragma unroll
                for (int mi = 0; mi < 4; ++mi) { const int row = wm * 64 + mi * 16 + fr; af[mi] = *(const bf16x8*)(a_base + row * 128 + ((ch ^ (row & 7)) << 4)); }
#pragma unroll
                for (int ni = 0; ni < NI; ++ni) { const int row = wn * (BN / 4) + ni * 16 + fr; bfr[ni] = *(const bf16x8*)(b_base + row * 128 + ((ch ^ (row & 7)) << 4)); }
#pragma unroll
                for (int mi = 0; mi < 4; ++mi)
#pragma unroll
                    for (int ni = 0; ni < NI; ++ni) acc[mi][ni] = __builtin_amdgcn_mfma_f32_16x16x32_bf16(bfr[ni], af[mi], acc[mi][ni], 0, 0, 0);
            }
        };
        stage3(0, 0);
        stage3(1, 1);
        int b3 = 0;
        for (int kt = 0; kt < KT; ++kt) {
            if (kt + 1 < KT) { if constexpr (BN == 256) asm volatile("s_waitcnt vmcnt(6)" ::: "memory"); else asm volatile("s_waitcnt vmcnt(4)" ::: "memory"); }
            else asm volatile("s_waitcnt vmcnt(0)" ::: "memory");
            asm volatile("s_waitcnt lgkmcnt(0)" ::: "memory");
            __builtin_amdgcn_s_barrier();
            asm volatile("" ::: "memory");
            const int bn = (b3 == 0) ? 2 : b3 - 1;
            if (kt + 2 < KT) stage3(kt + 2, bn);
            compute3(b3);
            b3 = (b3 == 2) ? 0 : b3 + 1;
        }
        asm volatile("s_waitcnt lgkmcnt(0)" ::: "memory");
        __builtin_amdgcn_s_barrier();
        asm volatile("" ::: "memory");
    } else {
        stage(0, 0);
        commit(0);
        asm volatile("s_waitcnt vmcnt(0)" ::: "memory");
        __syncthreads();
        for (int kt = 0; kt < KT; ++kt) {
            const int cur = kt & 1;
            const bool more = (kt + 1 < KT);
            if (more) stage(kt + 1, cur ^ 1);
            compute(cur);
            if (more) commit(cur ^ 1);
            asm volatile("s_waitcnt vmcnt(0)" ::: "memory");
            __syncthreads();
        }
    }
    ep(acc, m0, wm, wn, fr, fq);
}

struct ALoadPlain {
    static constexpr bool DMA = true;
    const bf16_t* A; int lda;
    DEV uint4 load(int R, int k) const { return *(const uint4*)(A + (size_t)R * lda + k); }
};
struct ALoadMix {
    static constexpr bool DMA = false;
    const bf16_t* h; const float* mix; const bf16_t* A; int lda;
    DEV uint4 load(int R, int k) const {
        const bf16_t* pc = h + (size_t)R * 1024 + k;
        const uint4 c = *(const uint4*)pc;
        const int t = (R < NL) ? (R & 8191) : ((R - NL) & 255);
        const int last = (R < NL) ? 8191 : 255;
        uint4 pv = *(const uint4*)(pc - (t != 0 ? 1024 : 0)), nv = *(const uint4*)(pc + (t != last ? 1024 : 0));
        if (t == 0) pv = make_uint4(0, 0, 0, 0);
        if (t == last) nv = make_uint4(0, 0, 0, 0);
        const float4 m0 = *(const float4*)(mix + k), m1 = *(const float4*)(mix + k + 4);
        const unsigned cc[4] = {c.x, c.y, c.z, c.w}, pp[4] = {pv.x, pv.y, pv.z, pv.w}, nn[4] = {nv.x, nv.y, nv.z, nv.w};
        const float mm[8] = {m0.x, m0.y, m0.z, m0.w, m1.x, m1.y, m1.z, m1.w};
        unsigned o[4];
#pragma unroll
        for (int i = 0; i < 4; ++i) {
            const float hc0 = bf_lo(cc[i]), hc1 = bf_hi(cc[i]);
            const float s0 = 0.5f * (bf_lo(pp[i]) + bf_lo(nn[i])), s1 = 0.5f * (bf_hi(pp[i]) + bf_hi(nn[i]));
            o[i] = pk_bf16(hc0 + (s0 - hc0) * mm[2 * i], hc1 + (s1 - hc1) * mm[2 * i + 1]);
        }
        return make_uint4(o[0], o[1], o[2], o[3]);
    }
};

struct TrJob { int in_idx, src_off, K, N, src_ld, dst_ld; unsigned long long dst_off; int tile0; };
constexpr int NTRJOBS = 19;
__device__ const TrJob g_trjobs[NTRJOBS] = {
    {9, 0 * 1048576, 1024, 1024, 1024, 1024, WS_WPROJ + 0ull * 1024 * 1024 * 2, 0},
    {9, 1 * 1048576, 1024, 1024, 1024, 1024, WS_WPROJ + 1ull * 1024 * 1024 * 2, 256},
    {9, 2 * 1048576, 1024, 1024, 1024, 1024, WS_WPROJ + 2ull * 1024 * 1024 * 2, 512},
    {11, 0, 1024, 64, 64, 1024, WS_WPROJ + 3072ull * 1024 * 2, 768},
    {11, 65536, 1024, 64, 64, 1024, WS_WPROJ + 3136ull * 1024 * 2, 784},
    {14, 0, 1024, 64, 64, 1024, WS_WPROJ + 3200ull * 1024 * 2, 800},
    {14, 65536, 1024, 64, 64, 1024, WS_WPROJ + 3264ull * 1024 * 2, 816},
    {16, 0, 1024, 128, 128, 1024, WS_WPROJ + 3328ull * 1024 * 2, 832},
    {12, 0, 64, 1024, 1024, 64, WS_W2T, 864},
    {12, 65536, 64, 1024, 1024, 64, WS_W2T + 1024ull * 64 * 2, 880},
    {15, 0, 64, 1024, 1024, 64, WS_A2T, 896},
    {15, 65536, 64, 1024, 1024, 64, WS_A2T + 1024ull * 64 * 2, 912},
    {17, 0, 128, 1024, 1024, 128, WS_G2T, 928},
    {23, 0, 1024, 1024, 1024, 1024, WS_WO0, 960},
    {29, 0, 1024, 1024, 1024, 1024, WS_WO1, 1216},
    {30, 0, 1024, 2048, 2048, 1024, WS_WQ, 1472},
    {30, 2097152, 1024, 2048, 2048, 1024, WS_WQ + 2048ull * 1024 * 2, 1984},
    {24, 0, 1024, 3104, 3104, 1024, WS_WIN, 2496},
    {0, 0, 0, 0, 0, 0, 0, 2496 + 16 * 49},
};
constexpr int NTRTILES = 2496 + 16 * 49;

DEV void phase0(const Params& p, unsigned char* lds) {
    const int tid = tid_opaque();
    unsigned char* ws = p.ws;
    {
        float* sc = (float*)lds;
        float* red = sc + 9 * 1024;
        float* mods = (float*)(ws + WS_MOD);
        bool have_sc = false;
        for (int task = blockIdx.x; task < 192; task += gridDim.x) {
            if (!have_sc) {
                for (int i = tid; i < 9 * 1024; i += NTHREADS) {
                    const int mb = i >> 10, k = i & 1023;
                    const float cv = mb < 8 ? p.in[1][mb * 1024 + k] : p.in[3][k];
                    sc[i] = cv / (1.0f + __expf(-cv));
                }
                have_sc = true;
            }
            __syncthreads();
            const int l = task / 96, nb = task % 96;
            const int nn = tid & 63, kg = tid >> 6;
            const float* w = p.in[4] + (size_t)l * 1024 * 6144 + nb * 64 + nn;
            float acc[9];
#pragma unroll
            for (int m = 0; m < 9; ++m) acc[m] = 0.f;
            for (int k = kg * 128; k < kg * 128 + 128; ++k) {
                const float wv = w[(size_t)k * 6144];
#pragma unroll
                for (int m = 0; m < 9; ++m) acc[m] += sc[m * 1024 + k] * wv;
            }
#pragma unroll
            for (int m = 0; m < 9; ++m) red[(kg * 9 + m) * 64 + nn] = acc[m];
            __syncthreads();
            for (int i = tid; i < 576; i += NTHREADS) {
                const int m = i >> 6, n2 = i & 63;
                float s = p.in[5][l * 6144 + nb * 64 + n2];
#pragma unroll
                for (int g = 0; g < 8; ++g) s += red[(g * 9 + m) * 64 + n2];
                mods[(size_t)(l * 9 + m) * 6144 + nb * 64 + n2] = s;
            }
            __syncthreads();
        }
        __syncthreads();
    }
    {
        float* tile = (float*)lds;
        for (int tt = blockIdx.x; tt < NTRTILES; tt += gridDim.x) {
            int j = 0;
#pragma unroll 1
            while (j + 1 < NTRJOBS && g_trjobs[j + 1].tile0 <= tt) ++j;
            const TrJob jb = g_trjobs[j];
            const int tl = tt - jb.tile0;
            const int ntn = (jb.N + 63) >> 6;
            const int k0 = (tl / ntn) * 64, n0 = (tl % ntn) * 64;
            const float* src = p.in[jb.in_idx] + jb.src_off;
            bf16_t* dst = (bf16_t*)(ws + jb.dst_off);
            {
                const int kr = tid >> 4, nc4 = (tid & 15) * 4;
#pragma unroll
                for (int i = 0; i < 2; ++i) {
                    const int kk = kr + 32 * i;
                    float4 v = make_float4(0.f, 0.f, 0.f, 0.f);
                    if (n0 + nc4 < jb.N) v = *(const float4*)(src + (size_t)(k0 + kk) * jb.src_ld + n0 + nc4);
                    tile[kk * 65 + nc4 + 0] = v.x; tile[kk * 65 + nc4 + 1] = v.y; tile[kk * 65 + nc4 + 2] = v.z; tile[kk * 65 + nc4 + 3] = v.w;
                }
            }
            __syncthreads();
            {
                const int nn = tid >> 3, kc = (tid & 7) * 8;
                if (n0 + nn < jb.N) {
                    unsigned o[4];
#pragma unroll
                    for (int i = 0; i < 4; ++i) o[i] = pk_bf16(tile[(kc + 2 * i) * 65 + nn], tile[(kc + 2 * i + 1) * 65 + nn]);
                    *(uint4*)(dst + (size_t)(n0 + nn) * jb.dst_ld + k0 + kc) = make_uint4(o[0], o[1], o[2], o[3]);
                }
            }
            __syncthreads();
        }
    }
    {
        const size_t gtid = (size_t)blockIdx.x * NTHREADS + tid, gstride = (size_t)gridDim.x * NTHREADS;
        {
            const float* src = p.in[31];
            bf16_t* dst = (bf16_t*)(ws + WS_KEYS);
            const size_t n8 = (size_t)2 * 8 * 2 * 128 * 128 / 8;
            for (size_t i = gtid; i < n8; i += gstride) {
                const float4 a = *(const float4*)(src + i * 8), b = *(const float4*)(src + i * 8 + 4);
                *(uint4*)(dst + i * 8) = make_uint4(pk_bf16(a.x, a.y), pk_bf16(a.z, a.w), pk_bf16(b.x, b.y), pk_bf16(b.z, b.w));
            }
        }
        bf16_t* wpad = (bf16_t*)(ws + WS_WIN) + (size_t)3104 * 1024;
        for (size_t i = gtid; i < (size_t)96 * 1024 / 8; i += gstride) *(uint4*)(wpad + i * 8) = make_uint4(0, 0, 0, 0);
        const int lane = tid & 63;
        const int gw = blockIdx.x * 8 + (tid >> 6), nw = gridDim.x * 8;
        float* scales = (float*)(ws + WS_PSC);
        for (int rowi = gw * 32; rowi < 2 * 32768; rowi += nw * 32)
        for (int row2 = rowi; row2 < rowi + 32; row2 += 4) {
            float4 v[4][4]; float am[4];
#pragma unroll
            for (int q = 0; q < 4; ++q) {
                const int row = row2 + q, tbl = row >> 15, r = row & 32767;
                const float* srow = p.in[32 + tbl] + (size_t)r * 1024;
                am[q] = 0.f;
#pragma unroll
                for (int i = 0; i < 4; ++i) { v[q][i] = *(const float4*)(srow + 16 * lane + 4 * i); am[q] = fmaxf(am[q], fmaxf(fmaxf(fabsf(v[q][i].x), fabsf(v[q][i].y)), fmaxf(fabsf(v[q][i].z), fabsf(v[q][i].w)))); }
            }
#pragma unroll
            for (int o = 1; o < 64; o <<= 1) { const float a0 = __shfl_xor(am[0], o), a1 = __shfl_xor(am[1], o), a2 = __shfl_xor(am[2], o), a3 = __shfl_xor(am[3], o); am[0] = fmaxf(am[0], a0); am[1] = fmaxf(am[1], a1); am[2] = fmaxf(am[2], a2); am[3] = fmaxf(am[3], a3); }
#pragma unroll
            for (int q = 0; q < 4; ++q) {
                const int row = row2 + q, tbl = row >> 15, r = row & 32767;
                const float scale = am[q] > 0.f ? am[q] * (1.0f / 448.0f) : 1.0f;
                const float inv = 1.0f / scale;
                unsigned w[4];
#pragma unroll
                for (int i = 0; i < 4; ++i) {
                    int t = 0;
                    t = __builtin_amdgcn_cvt_pk_fp8_f32(v[q][i].x * inv, v[q][i].y * inv, t, false);
                    t = __builtin_amdgcn_cvt_pk_fp8_f32(v[q][i].z * inv, v[q][i].w * inv, t, true);
                    w[i] = (unsigned)t;
                }
                *(uint4*)(ws + (tbl ? WS_PV : WS_PU) + ((size_t)(r >> 14) * 8 + (lane >> 3)) * (16384 * 128) + (size_t)(r & 16383) * 128 + 16 * (lane & 7)) = make_uint4(w[0], w[1], w[2], w[3]);
                if (lane == 0) scales[tbl * 32768 + r] = scale;
            }
        }
    }
}

DEV void normmod_store(const float4 (&v)[4], float ss, const float* g, const float* shift, const float* scale, bf16_t* dst, unsigned char* xq, int lane) {
    const float rs = rsqrtf(ss * (1.0f / 1024.0f) + 1e-6f);
#pragma unroll
    for (int i = 0; i < 4; ++i) {
        const int col = i * 256 + lane * 4;
        const float4 gg = *(const float4*)(g + col), sh = *(const float4*)(shift + col), sc = *(const float4*)(scale + col);
        const float y0 = v[i].x * rs * gg.x * (1.f + sc.x) + sh.x, y1 = v[i].y * rs * gg.y * (1.f + sc.y) + sh.y;
        const float y2 = v[i].z * rs * gg.z * (1.f + sc.z) + sh.z, y3 = v[i].w * rs * gg.w * (1.f + sc.w) + sh.w;
        *(uint2*)(dst + col) = make_uint2(pk_bf16(y0, y1), pk_bf16(y2, y3));
        if (xq) {
            const float z0 = __builtin_amdgcn_fmed3f(4.f * y0, -448.f, 448.f), z1 = __builtin_amdgcn_fmed3f(4.f * y1, -448.f, 448.f);
            const float z2 = __builtin_amdgcn_fmed3f(4.f * y2, -448.f, 448.f), z3 = __builtin_amdgcn_fmed3f(4.f * y3, -448.f, 448.f);
            int hi = __builtin_amdgcn_cvt_pk_fp8_f32(z0, z1, 0, false); hi = __builtin_amdgcn_cvt_pk_fp8_f32(z2, z3, hi, true);
            const f32x2v h01 = __builtin_amdgcn_cvt_pk_f32_fp8(hi, false), h23 = __builtin_amdgcn_cvt_pk_f32_fp8(hi, true);
            int lo = __builtin_amdgcn_cvt_pk_fp8_f32(z0 - h01.x, z1 - h01.y, 0, false); lo = __builtin_amdgcn_cvt_pk_fp8_f32(z2 - h23.x, z3 - h23.y, lo, true);
            *(int*)(xq + col) = hi; *(int*)(xq + 1024 + col) = lo;
        }
    }
}
DEV void phase_normmod(const Params& p, int layer, int which, const float* xl, const float* xc, int nrows, bf16_t* dst, unsigned char* xq) {
    const int tid = tid_opaque(), lane = tid & 63;
    const int gw = blockIdx.x * 8 + (tid >> 6), nw = gridDim.x * 8;
    const float* mods = (const float*)(p.ws + WS_MOD) + (size_t)layer * 9 * 6144;
    const float* g = p.in[which ? 7 : 6] + layer * 1024;
    for (int R = gw; R < nrows; R += nw) {
        const float* xr = R < NL ? xl + (size_t)R * 1024 : xc + (size_t)(R - NL) * 1024;
        float4 v[4]; float ss = 0.f;
#pragma unroll
        for (int i = 0; i < 4; ++i) { v[i] = *(const float4*)(xr + i * 256 + lane * 4); ss += v[i].x * v[i].x + v[i].y * v[i].y + v[i].z * v[i].z + v[i].w * v[i].w; }
        ss = wave_allreduce(ss);
        const float* mrow = mods + (size_t)mod_batch(R) * 6144 + (which ? 3 : 0) * 1024;
        normmod_store(v, ss, g, mrow, mrow + 1024, dst + (size_t)R * 1024, xq ? xq + (size_t)R * 2048 : nullptr, lane);
    }
}
DEV void phase_normmix(const Params& p, bf16_t* hdst, bf16_t* xr, bf16_t* xk, bf16_t* xv) {
    const int tid = tid_opaque(), lane = tid & 63;
    const int gw = __builtin_amdgcn_readfirstlane(blockIdx.x * 8 + (tid >> 6)), nw = gridDim.x * 8;
    const float* mods = (const float*)(p.ws + WS_MOD);
    const float* g = p.in[6];
    for (int run = gw; run < NT / 8; run += nw) {
        const int R0 = run * 8;
        const int t0 = R0 < NL ? (R0 & 8191) : ((R0 - NL) & 255), slen = R0 < NL ? 8192 : 256;
        const float* mrow = mods + (size_t)mod_batch(R0) * 6144;
        float4 gg[4], sh[4], sc[4], m0[4], m2[4], m3[4];
#pragma unroll
        for (int i = 0; i < 4; ++i) {
            const int col = i * 256 + lane * 4;
            gg[i] = *(const float4*)(g + col); sh[i] = *(const float4*)(mrow + col); sc[i] = *(const float4*)(mrow + 1024 + col);
            m0[i] = *(const float4*)(p.in[8] + col); m2[i] = *(const float4*)(p.in[8] + 2 * 1024 + col); m3[i] = *(const float4*)(p.in[8] + 3 * 1024 + col);
        }
        auto hrow = [&](int R, float4 (&h)[4]) {
            const float* xrw = R < NL ? p.in[0] + (size_t)R * 1024 : p.in[2] + (size_t)(R - NL) * 1024;
            float ss = 0.f;
#pragma unroll
            for (int i = 0; i < 4; ++i) { h[i] = *(const float4*)(xrw + i * 256 + lane * 4); ss += h[i].x * h[i].x + h[i].y * h[i].y + h[i].z * h[i].z + h[i].w * h[i].w; }
            ss = wave_allreduce(ss);
            const float rs = rsqrtf(ss * (1.0f / 1024.0f) + 1e-6f);
#pragma unroll
            for (int i = 0; i < 4; ++i) {
                h[i].x = h[i].x * rs * gg[i].x * (1.f + sc[i].x) + sh[i].x; h[i].y = h[i].y * rs * gg[i].y * (1.f + sc[i].y) + sh[i].y;
                h[i].z = h[i].z * rs * gg[i].z * (1.f + sc[i].z) + sh[i].z; h[i].w = h[i].w * rs * gg[i].w * (1.f + sc[i].w) + sh[i].w;
            }
        };
        float4 hp[4], hc[4], hn[4];
        if (t0 > 0) hrow(R0 - 1, hp); else { hp[0] = hp[1] = hp[2] = hp[3] = make_float4(0.f, 0.f, 0.f, 0.f); }
        hrow(R0, hc);
#pragma unroll 1
        for (int i8 = 0; i8 < 8; ++i8) {
            const int R = R0 + i8;
            if (t0 + i8 + 1 < slen) hrow(R + 1, hn); else { hn[0] = hn[1] = hn[2] = hn[3] = make_float4(0.f, 0.f, 0.f, 0.f); }
#pragma unroll
            for (int i = 0; i < 4; ++i) {
                const size_t o = (size_t)R * 1024 + i * 256 + lane * 4;
                const float4 c = hc[i];
                const float4 xx = make_float4(0.5f * (hp[i].x + hn[i].x) - c.x, 0.5f * (hp[i].y + hn[i].y) - c.y, 0.5f * (hp[i].z + hn[i].z) - c.z, 0.5f * (hp[i].w + hn[i].w) - c.w);
                *(uint2*)(hdst + o) = make_uint2(pk_bf16(c.x, c.y), pk_bf16(c.z, c.w));
                *(uint2*)(xr + o) = make_uint2(pk_bf16(c.x + xx.x * m0[i].x, c.y + xx.y * m0[i].y), pk_bf16(c.z + xx.z * m0[i].z, c.w + xx.w * m0[i].w));
                *(uint2*)(xk + o) = make_uint2(pk_bf16(c.x + xx.x * m2[i].x, c.y + xx.y * m2[i].y), pk_bf16(c.z + xx.z * m2[i].z, c.w + xx.w * m2[i].w));
                *(uint2*)(xv + o) = make_uint2(pk_bf16(c.x + xx.x * m3[i].x, c.y + xx.y * m3[i].y), pk_bf16(c.z + xx.z * m3[i].z, c.w + xx.w * m3[i].w));
            }
#pragma unroll
            for (int i = 0; i < 4; ++i) { hp[i] = hc[i]; hc[i] = hn[i]; }
        }
    }
}

template <int BN> struct EpiBf16 {
    bf16_t* dst; int ldd; int col0; int act;
    DEV void operator()(const f32x4 (&acc)[4][BN / 64], int m0, int wm, int wn, int fr, int fq) const {
#pragma unroll
        for (int mi = 0; mi < 4; ++mi) {
            const size_t R = (size_t)(m0 + wm * 64 + mi * 16 + fr);
#pragma unroll
            for (int ni = 0; ni < BN / 64; ++ni) {
                const int col = col0 + wn * (BN / 4) + ni * 16 + 4 * fq;
                float v[4] = {acc[mi][ni][0], acc[mi][ni][1], acc[mi][ni][2], acc[mi][ni][3]};
                if (act == 1) {
#pragma unroll
                    for (int j = 0; j < 4; ++j) v[j] = tanhf(v[j]);
                } else if (act == 2) {
#pragma unroll
                    for (int j = 0; j < 4; ++j) v[j] = sigmoidf_(v[j]);
                }
                *(uint2*)(dst + R * ldd + col) = make_uint2(pk_bf16(v[0], v[1]), pk_bf16(v[2], v[3]));
            }
        }
    }
};
template <int NI> struct EpiResid {
    const float* xold_lat; const float* xold_ctx; float* dst_lat; float* dst_ctx; const float* gate; int col0;
    DEV void operator()(const f32x4 (&acc)[4][NI], int m0, int wm, int wn, int fr, int fq) const {
#pragma unroll
        for (int mi = 0; mi < 4; ++mi) {
            const int R = m0 + wm * 64 + mi * 16 + fr;
            const float* src = R < NL ? xold_lat + (size_t)R * 1024 : xold_ctx + (size_t)(R - NL) * 1024;
            float* dst = R < NL ? dst_lat + (size_t)R * 1024 : dst_ctx + (size_t)(R - NL) * 1024;
            const float* gr = gate + (size_t)mod_batch(R) * 6144;
#pragma unroll
            for (int ni = 0; ni < NI; ++ni) {
                const int col = col0 + wn * (NI * 16) + ni * 16 + 4 * fq;
                const float4 xo = *(const float4*)(src + col), g4 = *(const float4*)(gr + col);
                *(float4*)(dst + col) = make_float4(xo.x + g4.x * acc[mi][ni][0], xo.y + g4.y * acc[mi][ni][1], xo.z + g4.z * acc[mi][ni][2], xo.w + g4.w * acc[mi][ni][3]);
            }
        }
    }
};
struct EpiLr {
    float* dst;
    DEV void operator()(const f32x4 (&acc)[4][2], int m0, int wm, int wn, int fr, int fq) const {
        if (wn != 0) return;
#pragma unroll
        for (int mi = 0; mi < 4; ++mi) {
            const size_t R = (size_t)(m0 + wm * 64 + mi * 16 + fr);
#pragma unroll
            for (int ni = 0; ni < 2; ++ni) { const int col = ni * 16 + 4 * fq; *(float4*)(dst + R * 32 + col) = make_float4(acc[mi][ni][0], acc[mi][ni][1], acc[mi][ni][2], acc[mi][ni][3]); }
        }
    }
};

namespace pg8 {
#define PG8_LAS __attribute__((address_space(3)))
constexpr int BM = 256, BK = 64, HALF = 128, HTB = HALF * BK * 2  , STAGE_BYTES = 8 * HTB, NXCD = 8, WGM = 8;

__host__ __device__ __forceinline__ int lds_byte(int r, int c) { const int st = (r >> 4) * 2 + (c >> 5), rr = r & 15, cc = c & 31, ob = rr * 64 + cc * 2; return st * 1024 + (ob ^ (((ob >> 9) & 1) << 5)); }
__host__ __device__ __forceinline__ void stage_rc(int b, int& R, int& C) { const int st = b / 1024, sb = b % 1024, swz = sb ^ (((sb >> 9) & 1) << 5); R = (st >> 1) * 16 + swz / 64; C = (st & 1) * 32 + (swz % 64) / 2; }
__host__ __device__ __forceinline__ int perm32(int rho) { const int n = rho >> 4, i = rho & 15; return 8 * (i >> 2) + 4 * n + (i & 3); }
struct Unit { int pm, pn; };
struct Gemm { const bf16_t* A; const bf16_t* Bt; int M, N, K; };
struct StaticOrder {
    int nM, nN, nwg, G, c;
    __host__ __device__ void init(int M, int N, int G_, int c_) { nM = M / BM; nN = N / BM; nwg = nM * nN; G = G_; c = c_; }
    __host__ __device__ bool next(int i, Unit& u) const {
        const long L = (long)i * G + c; if (L >= nwg) return false;
        int wgid = (int)L; { const int q = nwg / NXCD, r = nwg % NXCD, xcd = wgid % NXCD, off = wgid / NXCD; wgid = (xcd < r ? xcd * (q + 1) : r * (q + 1) + (xcd - r) * q) + off; }
        const int nig = WGM * nN, gid = wgid / nig, fm = gid * WGM, gsz = (nM - fm) < WGM ? (nM - fm) : WGM;
        u.pm = fm + ((wgid % nig) % gsz); u.pn = (wgid % nig) / gsz; return true;
    }
    __device__ __forceinline__ void a_ready(const Unit&) const {}
    __device__ __forceinline__ void done(const Unit&) const {}
};
template <class Epi, class Sched, bool STAMP = false>
__device__ __forceinline__ void gemm_phase(PG8_LAS unsigned char* lds, const Gemm g, const Sched& S, const Epi& E, unsigned long long* stamps) {
    const int tid = tid_opaque(), wid = __builtin_amdgcn_readfirstlane(tid >> 6), lane = tid & 63, wr = wid >> 2, wc = wid & 3, fr = lane & 15, fq = lane >> 4;
    const int K = g.K, nt = K / BK;
    int ts_lo = 0, ts_hi = 0, nts = 0; const unsigned long long rt_entry = STAMP ? (unsigned long long)wall_clock64() : 0ull;
#define PG8_STAMP() do { if (STAMP && wid == 0 && nts < 64) { const unsigned long long _c = (unsigned long long)clock64(); \
        ts_lo = (lane == nts) ? (int)(unsigned)_c : ts_lo; ts_hi = (lane == nts) ? (int)(unsigned)(_c >> 32) : ts_hi; ++nts; } } while (0)
    PG8_STAMP();
    unsigned voffA[2], voffB[2];
#pragma unroll
    for (int i = 0; i < 2; ++i) { int R, C; stage_rc(tid * 16 + i * 8192, R, C); const int Rb = Epi::PERM ? ((R & ~31) + perm32(R & 31)) : R;
        voffA[i] = (unsigned)(R * K + C) * 2u; voffB[i] = (unsigned)(Rb * K + C) * 2u; }
    const size_t kstep = (size_t)(BK * 2);
    const size_t hstep = (size_t)HALF * K * 2;
    const size_t tstep = 2 * hstep;
    const unsigned ldsw = (unsigned)wid * 1024u;
    const int aoff = lds_byte(wr * 64 + fr, fq * 8), boff = lds_byte(wc * 32 + fr, fq * 8);
#define PG8_SA(b, h) (((b) * 2 + (h)) * HTB)
#define PG8_SB(b, h) ((4 + (b) * 2 + (h)) * HTB)
#define PG8_STAGE(bufoff, gbase, voff) do { _Pragma("unroll") for (int _i = 0; _i < 2; ++_i) \
        __builtin_amdgcn_global_load_lds((const unsigned*)((const char*)(gbase) + (voff)[_i]), (PG8_LAS unsigned*)(lds + (bufoff) + ldsw + _i * 8192), 16, 0, 0); } while (0)
#define PG8_LDA(dst, b, h) do { _Pragma("unroll") for (int m = 0; m < 4; ++m) _Pragma("unroll") for (int k = 0; k < 2; ++k) dst[m][k] = *(const PG8_LAS bf16x8*)(lds + PG8_SA(b, h) + aoff + m * 2048 + k * 1024); } while (0)
#define PG8_LDB(dst, b, h) do { _Pragma("unroll") for (int n = 0; n < 2; ++n) _Pragma("unroll") for (int k = 0; k < 2; ++k) dst[n][k] = *(const PG8_LAS bf16x8*)(lds + PG8_SB(b, h) + boff + n * 2048 + k * 1024); } while (0)
#define PG8_MMA(ai, bj, At, Bt) do { __builtin_amdgcn_s_setprio(1); _Pragma("unroll") for (int m = 0; m < 4; ++m) _Pragma("unroll") for (int n = 0; n < 2; ++n) _Pragma("unroll") for (int k = 0; k < 2; ++k) \
        acc[ai][bj][m][n] = __builtin_amdgcn_mfma_f32_16x16x32_bf16(Bt[n][k], At[m][k], acc[ai][bj][m][n], 0, 0, 0); __builtin_amdgcn_s_setprio(0); } while (0)
#define PG8_WAIT_V(n) asm volatile("s_waitcnt vmcnt(" #n ")" ::: "memory")
#define PG8_WAIT_L(n) asm volatile("s_waitcnt lgkmcnt(" #n ")" ::: "memory")
#define PG8_BAR __builtin_amdgcn_s_barrier()
#define PG8_SCHED __builtin_amdgcn_sched_barrier(0)
    Unit cur, nxt; int ui = 0;
    if (!S.next(0, cur)) return;
    f32x4 acc[2][2][4][2];
#pragma unroll
    for (int a = 0; a < 2; ++a)
#pragma unroll
        for (int b = 0; b < 2; ++b)
#pragma unroll
            for (int m = 0; m < 4; ++m)
#pragma unroll
                for (int n = 0; n < 2; ++n) acc[a][b][m][n] = (f32x4){0.f, 0.f, 0.f, 0.f};
    bf16x8 At[4][2], B0[2][2], B1[2][2];
    const char* cA = (const char*)g.A + (size_t)cur.pm * tstep; const char* cB = (const char*)g.Bt + (size_t)cur.pn * tstep;
    S.a_ready(cur);
    PG8_STAGE(PG8_SB(0, 0), cB, voffB); PG8_STAGE(PG8_SA(0, 0), cA, voffA); PG8_STAGE(PG8_SB(0, 1), cB + hstep, voffB); PG8_STAGE(PG8_SA(0, 1), cA + hstep, voffA);
    if (wr == 1) PG8_BAR;
    PG8_WAIT_V(4); PG8_BAR;
    PG8_STAGE(PG8_SB(1, 0), cB + kstep, voffB); PG8_STAGE(PG8_SA(1, 0), cA + kstep, voffA); PG8_STAGE(PG8_SB(1, 1), cB + hstep + kstep, voffB);
    PG8_WAIT_V(6); PG8_BAR;
    PG8_STAMP();
    for (;;) {
        const bool has_next = S.next(ui + 1, nxt);
        const char* nA = has_next ? (const char*)g.A + (size_t)nxt.pm * tstep : cA; const char* nB = has_next ? (const char*)g.Bt + (size_t)nxt.pn * tstep : cB;
        for (int t = 0; t < nt; t += 2) {
            const bool last = (t == nt - 2);
            const char* a1 = cA + (size_t)(t + 1) * kstep;
            const char* a2 = last ? nA : cA + (size_t)(t + 2) * kstep; const char* b2 = last ? nB : cB + (size_t)(t + 2) * kstep;
            const char* a3 = a2 + kstep; const char* b3 = b2 + kstep;
            if (last && has_next) S.a_ready(nxt);
            PG8_LDB(B0, 0, 0); PG8_SCHED; PG8_LDA(At, 0, 0); PG8_STAGE(PG8_SA(1, 1), a1 + hstep, voffA);
            PG8_WAIT_L(8); PG8_BAR; PG8_WAIT_L(0); PG8_MMA(0, 0, At, B0); PG8_BAR; PG8_SCHED;
            PG8_LDB(B1, 0, 1); PG8_STAGE(PG8_SB(0, 0), b2, voffB);
            PG8_BAR; PG8_WAIT_L(0); PG8_MMA(0, 1, At, B1); PG8_BAR;
            PG8_LDA(At, 0, 1); PG8_STAGE(PG8_SA(0, 0), a2, voffA);
            PG8_BAR; PG8_WAIT_L(0); PG8_MMA(1, 0, At, B0); PG8_BAR; PG8_SCHED;
            PG8_STAGE(PG8_SB(0, 1), b2 + hstep, voffB);
            PG8_WAIT_V(6); PG8_BAR; PG8_MMA(1, 1, At, B1); PG8_BAR;
            PG8_LDB(B0, 1, 0); PG8_SCHED; PG8_LDA(At, 1, 0); PG8_STAGE(PG8_SA(0, 1), a2 + hstep, voffA);
            PG8_WAIT_L(8); PG8_BAR; PG8_WAIT_L(0); PG8_MMA(0, 0, At, B0); PG8_BAR; PG8_SCHED;
            PG8_LDB(B1, 1, 1); PG8_STAGE(PG8_SB(1, 0), b3, voffB);
            PG8_BAR; PG8_WAIT_L(0); PG8_MMA(0, 1, At, B1); PG8_BAR;
            PG8_LDA(At, 1, 1); PG8_STAGE(PG8_SA(1, 0), a3, voffA);
            PG8_BAR; PG8_WAIT_L(0); PG8_MMA(1, 0, At, B0); PG8_BAR; PG8_SCHED;
            PG8_STAGE(PG8_SB(1, 1), b3 + hstep, voffB);
            PG8_WAIT_V(6); PG8_BAR; PG8_MMA(1, 1, At, B1); PG8_BAR;
        }
        PG8_STAMP();
        if constexpr (!Epi::AFTER_DRAIN) { E(acc, cur, wr, wc, fr, fq); S.done(cur); }
        PG8_STAMP();
        if (!has_next) break;
#pragma unroll
        for (int a = 0; a < 2; ++a)
#pragma unroll
            for (int b = 0; b < 2; ++b)
#pragma unroll
                for (int m = 0; m < 4; ++m)
#pragma unroll
                    for (int n = 0; n < 2; ++n) acc[a][b][m][n] = (f32x4){0.f, 0.f, 0.f, 0.f};
        cur = nxt; cA = nA; cB = nB; ++ui;
    }
    PG8_WAIT_V(0);
    if (wr == 0) PG8_BAR;
    PG8_BAR;
    if constexpr (Epi::AFTER_DRAIN) { E.fused(acc, cur, wr, wc, fr, fq, lds, wid, lane); S.done(cur); }
    PG8_STAMP();
    if (STAMP && wid == 0) { stamps[lane] = lane < nts ? (((unsigned long long)(unsigned)ts_hi << 32) | (unsigned)ts_lo) : 0ull;
        if (lane == 62) stamps[62] = rt_entry; if (lane == 63) stamps[63] = (unsigned long long)wall_clock64(); }
#undef PG8_STAMP
#undef PG8_SA
#undef PG8_SB
#undef PG8_STAGE
#undef PG8_LDA
#undef PG8_LDB
#undef PG8_MMA
#undef PG8_WAIT_V
#undef PG8_WAIT_L
#undef PG8_BAR
#undef PG8_SCHED
}
struct EpiBf16Tiles {
    static constexpr bool PERM = true, AFTER_DRAIN = false;
    bf16_t* d0; int ld0; int ntile0; bf16_t* d1; int ld1;
    __device__ __forceinline__ void operator()(const f32x4 (&acc)[2][2][4][2], const Unit& u, int wr, int wc, int fr, int fq) const {
        bf16_t* base = u.pn < ntile0 ? d0 : d1; const int ld = u.pn < ntile0 ? ld0 : ld1; const int colt = (u.pn < ntile0 ? u.pn : u.pn - ntile0) * BM;
        const int row0 = u.pm * BM + wr * 64 + fr, col0 = colt + wc * 32 + 8 * fq;
#pragma unroll
        for (int ai = 0; ai < 2; ++ai)
#pragma unroll
            for (int m = 0; m < 4; ++m) { bf16_t* rowp = base + (size_t)(row0 + ai * HALF + m * 16) * ld + col0;
#pragma unroll
                for (int bj = 0; bj < 2; ++bj) { const f32x4 v0 = acc[ai][bj][m][0], v1 = acc[ai][bj][m][1];
                    *(uint4*)(rowp + bj * HALF) = make_uint4(pk_bf16(v0[0], v0[1]), pk_bf16(v0[2], v0[3]), pk_bf16(v1[0], v1[1]), pk_bf16(v1[2], v1[3])); } }
    }
};
struct EpiResid256 {
    static constexpr bool PERM = false, AFTER_DRAIN = false;
    const float* xold_lat; const float* xold_ctx; float* dst_lat; float* dst_ctx; const float* gate;
    __device__ __forceinline__ void operator()(const f32x4 (&acc)[2][2][4][2], const Unit& u, int wr, int wc, int fr, int fq) const {
        const int row0 = u.pm * BM + wr * 64 + fr, col0 = u.pn * BM + wc * 32 + 4 * fq;
#pragma unroll
        for (int ai = 0; ai < 2; ++ai)
#pragma unroll
            for (int m = 0; m < 4; ++m) {
                const int R = row0 + ai * HALF + m * 16;
                const float* src = R < NL ? xold_lat + (size_t)R * 1024 : xold_ctx + (size_t)(R - NL) * 1024;
                float* dst = R < NL ? dst_lat + (size_t)R * 1024 : dst_ctx + (size_t)(R - NL) * 1024;
                const float* gr = gate + (size_t)mod_batch(R) * 6144;
#pragma unroll
                for (int bj = 0; bj < 2; ++bj)
#pragma unroll
                    for (int n = 0; n < 2; ++n) {
                        const int col = col0 + bj * HALF + n * 16;
                        const float4 xo = *(const float4*)(src + col), g4 = *(const float4*)(gr + col);
                        const f32x4 a = acc[ai][bj][m][n];
                        *(float4*)(dst + col) = make_float4(xo.x + g4.x * a[0], xo.y + g4.y * a[1], xo.z + g4.z * a[2], xo.w + g4.w * a[3]);
                    }
            }
    }
};
}

DEV void rw_proj_ctx_tile(const Params& p, unsigned char* lds, int which, const bf16_t* A, bf16_t* dst, int u) {
    const int mt = u >> 3, nt = u & 7;
    ALoadPlain al{A, 1024};
    EpiBf16<128> ep{dst, 1024, nt * 128, 0};
    gemm_unit<128>(lds, al, (const bf16_t*)(p.ws + WS_WPROJ) + (size_t)which * 1024 * 1024 + (size_t)nt * 128 * 1024, 1024, NL + mt * 128, ep);
}
DEV void phase_rw_proj1(const Params& p, unsigned char* lds, int which, const bf16_t* A, bf16_t* dst, int ctx_here) {
    pg8::Gemm g{A, (const bf16_t*)(p.ws + WS_WPROJ) + (size_t)which * 1024 * 1024, NL, 1024, 1024};
    pg8::StaticOrder so; so.init(NL, 1024, gridDim.x, blockIdx.x);
    pg8::EpiBf16Tiles ep{dst, 1024, 4, dst, 1024};
    pg8::gemm_phase((PG8_LAS unsigned char*)lds, g, so, ep, nullptr);
    __syncthreads();
    if (ctx_here)
        for (int u = blockIdx.x; u < (NC / 128) * 8; u += gridDim.x) rw_proj_ctx_tile(p, lds, which, A, dst, u);
}
DEV void phase_rw_lora(const Params& p, unsigned char* lds, const bf16_t* vin, bf16_t* vdst) {
    unsigned char* ws = p.ws;
    const bf16_t* h = (const bf16_t*)(ws + WS_S + 0 * U_BYTES);
    const bf16_t* wproj = (const bf16_t*)(ws + WS_WPROJ);
    const int nunits = (NT / 128) * 3;
    for (int u = blockIdx.x; u < nunits + (NC / 128) * 8; u += gridDim.x) {
        if (u >= nunits) { rw_proj_ctx_tile(p, lds, 2, vin, vdst, u - nunits); continue; }
        const int mt = u / 3, lg = u % 3, m0 = mt * 128;
        const int mixid = lg == 0 ? 1 : (lg == 1 ? 4 : 5);
        ALoadMix al{h, p.in[8] + mixid * 1024, h, 1024};
        EpiBf16<128> ep{(bf16_t*)(ws + WS_S + 4 * U_BYTES), 384, lg * 128, lg == 0 ? 1 : (lg == 1 ? 0 : 2)};
        gemm_unit<128>(lds, al, wproj + (size_t)(3072 + lg * 128) * 1024, 1024, m0, ep);
    }
}

template <int N> DEV float dpp_shr0(float x) { return __int_as_float(__builtin_amdgcn_update_dpp(0, __float_as_int(x), 0x110 + N, 0xF, 0xF, true)); }
template <int CTRL> DEV float dpp_quad(float x) { return __int_as_float(__builtin_amdgcn_update_dpp(0, __float_as_int(x), CTRL, 0xF, 0xF, false)); }
DEV int tile_off(int row, int ch) { return row * 128 + ((ch ^ (row & 7)) << 4); }
DEV int tile_off2(int row, int ch) { return row * 128 + ((ch ^ ((row ^ (row >> 3)) & 7)) << 4); }
DEV void phase_rw_scan(const Params& p, unsigned char* lds) {
    const int tid = tid_opaque(), lane = tid & 63;
    const int wv = __builtin_amdgcn_readfirstlane(tid >> 6);
    const int fr = lane & 15, fq = lane >> 4;
    unsigned char* ws = p.ws;
    constexpr int SH = 0, SL = 8192, AT = 16384  , RT = 20480  , BT = 24576  , KT = 28672  , BKT = 32768  , UV = 49152  , NT = 65536  ;
    constexpr int MFA = 69632, MFK = 70656, X0 = 71680, VS = 75776  , PP = 83968, PM = 88064, PI = 92160, AA = 96256  ;
    constexpr int PL = 116736  , YB = 117760, LDS_END = 121856;
    const bf16_t* rbuf = (const bf16_t*)(ws + WS_S + 3 * U_BYTES);
    const bf16_t* kbuf = (const bf16_t*)(ws + WS_S + 5 * U_BYTES);
    const bf16_t* vbuf = (const bf16_t*)(ws + WS_S + 1 * U_BYTES);
    const bf16_t* lora = (const bf16_t*)(ws + WS_S + 4 * U_BYTES);
    for (int unit = blockIdx.x; unit < 256; unit += gridDim.x) {
        const int b = unit >> 5, hh = (unit >> 1) & 15, d = unit & 1;
        bf16_t* ydst = (bf16_t*)(ws + WS_S + (size_t)(d ? 2 : 0) * U_BYTES);
        float* bonus = (float*)(ws + WS_BONUS) + (size_t)((d * NB + b) * 16 + hh) * 8448;
        const int s_e = (tid >> 4) & 15, j0 = (tid & 15) * 4;
        const int ni = wv & 3;
        auto Rof = [&](int c, int s) -> int {
            if (c < 16) { const int q = c * 16 + s; return NL + b * 256 + (d ? 255 - q : q); }
            const int q = (c - 16) * 16 + s; return b * 8192 + (d ? 8191 - q : q);
        };
        constexpr int CST = LDS_END;
        uint2 pr = make_uint2(0, 0), pk = pr, pv = pr; uint4 paw[2], paa[2];
        if (wv >= 4) {
            const int ct = (tid - 256) * 16;
            *(float4*)(lds + CST + 0 * 4096 + ct) = *(const float4*)(p.in[18] + hh * 64 + j0);
            *(float4*)(lds + CST + 1 * 4096 + ct) = *(const float4*)(p.in[19] + hh * 64 + j0);
            *(float4*)(lds + CST + 2 * 4096 + ct) = *(const float4*)(p.in[20] + hh * 64 + j0);
            *(float4*)(lds + CST + 3 * 4096 + ct) = *(const float4*)(p.in[10] + d * 1024 + hh * 64 + ni * 16 + fq * 4);
            *(float4*)(lds + CST + 4 * 4096 + ct) = *(const float4*)(p.in[13] + d * 1024 + hh * 64 + ni * 16 + fq * 4);
#pragma unroll
            for (int ks = 0; ks < 2; ++ks) {
                *(uint4*)(lds + CST + (5 + ks) * 4096 + ct) = *(const uint4*)((const bf16_t*)(ws + WS_W2T) + (size_t)d * 1024 * 64 + (size_t)(hh * 64 + ni * 16 + fr) * 64 + ks * 32 + fq * 8);
                *(uint4*)(lds + CST + (7 + ks) * 4096 + ct) = *(const uint4*)((const bf16_t*)(ws + WS_A2T) + (size_t)d * 1024 * 64 + (size_t)(hh * 64 + ni * 16 + fr) * 64 + ks * 32 + fq * 8);
            }
        }
        auto load_lora = [&](int c) {
            const size_t R2 = (size_t)Rof(c, fr);
#pragma unroll
            for (int ks = 0; ks < 2; ++ks) { paw[ks] = *(const uint4*)(lora + R2 * 384 + d * 64 + ks * 32 + fq * 8); paa[ks] = *(const uint4*)(lora + R2 * 384 + 128 + d * 64 + ks * 32 + fq * 8); }
        };
        auto load_rkv = [&](int c) {
            const size_t off = (size_t)Rof(c, s_e) * 1024 + hh * 64 + j0;
            pr = *(const uint2*)(rbuf + off); pk = *(const uint2*)(kbuf + off); pv = *(const uint2*)(vbuf + off);
        };
        auto step_up = [&](int c) {
            const int ct = (tid - 256) * 16;
            const float4 bias_w = *(const float4*)(lds + CST + 3 * 4096 + ct), bias_a = *(const float4*)(lds + CST + 4 * 4096 + ct);
            bf16x8 bfw[2], bfa[2];
#pragma unroll
            for (int ks = 0; ks < 2; ++ks) { bfw[ks] = *(const bf16x8*)(lds + CST + (5 + ks) * 4096 + ct); bfa[ks] = *(const bf16x8*)(lds + CST + (7 + ks) * 4096 + ct); }
            f32x4 accw = {0.f, 0.f, 0.f, 0.f}, acca = {0.f, 0.f, 0.f, 0.f};
#pragma unroll
            for (int ks = 0; ks < 2; ++ks) { accw = __builtin_amdgcn_mfma_f32_16x16x32_bf16(bfw[ks], as_bf16x8(paw[ks]), accw, 0, 0, 0); acca = __builtin_amdgcn_mfma_f32_16x16x32_bf16(bfa[ks], as_bf16x8(paa[ks]), acca, 0, 0, 0); }
            const int n = ni * 16 + fq * 4;
            const float bw[4] = {bias_w.x, bias_w.y, bias_w.z, bias_w.w}, ba[4] = {bias_a.x, bias_a.y, bias_a.z, bias_a.w};
            float P[4], Pm[4], Pi[4], av[4];
#pragma unroll
            for (int j = 0; j < 4; ++j) {
                const float e = 0.6065306597f * __builtin_amdgcn_rcpf(1.0f + __expf(-(accw[j] + bw[j])));
                float s = e;
                s += dpp_shr0<1>(s); s += dpp_shr0<2>(s); s += dpp_shr0<4>(s); s += dpp_shr0<8>(s);
                P[j] = __expf(-s); Pi[j] = __builtin_amdgcn_rcpf(P[j]); Pm[j] = P[j] * __expf(e);
                av[j] = __builtin_amdgcn_rcpf(1.0f + __expf(-(acca[j] + ba[j])));
            }
            const int pb = (c & 1) * 16384;
            *(float4*)(lds + PP + pb + (fr * 64 + n) * 4) = make_float4(P[0], P[1], P[2], P[3]);
            *(float4*)(lds + PM + pb + (fr * 64 + n) * 4) = make_float4(Pm[0], Pm[1], Pm[2], Pm[3]);
            *(float4*)(lds + PI + pb + (fr * 64 + n) * 4) = make_float4(Pi[0], Pi[1], Pi[2], Pi[3]);
            *(float4*)(lds + AA + pb + (fr * 64 + n) * 4) = make_float4(av[0], av[1], av[2], av[3]);
            if (fr == 15) *(float4*)(lds + PL + (c & 3) * 256 + n * 4) = make_float4(P[0], P[1], P[2], P[3]);
        };
        auto step_vec = [&](int c) {
            const int eo = (s_e * 64 + j0) * 4, pb = (c & 1) * 16384, tb = (c & 1) * 8192, ct = (tid - 256) * 16;
            const float4 kk_c = *(const float4*)(lds + CST + 0 * 4096 + ct), ka_c = *(const float4*)(lds + CST + 1 * 4096 + ct), rk_c = *(const float4*)(lds + CST + 2 * 4096 + ct);
            const float4 a4 = *(const float4*)(lds + AA + pb + eo), P4 = *(const float4*)(lds + PP + pb + eo), Pm4 = *(const float4*)(lds + PM + pb + eo), Pi4 = *(const float4*)(lds + PI + pb + eo);
            const float kx[4] = {bf_lo(pk.x), bf_hi(pk.x), bf_lo(pk.y), bf_hi(pk.y)};
            const float rx[4] = {bf_lo(pr.x), bf_hi(pr.x), bf_lo(pr.y), bf_hi(pr.y)};
            const float av[4] = {a4.x, a4.y, a4.z, a4.w}, Pv[4] = {P4.x, P4.y, P4.z, P4.w}, Pmv[4] = {Pm4.x, Pm4.y, Pm4.z, Pm4.w}, Piv[4] = {Pi4.x, Pi4.y, Pi4.z, Pi4.w};
            const float kkc[4] = {kk_c.x, kk_c.y, kk_c.z, kk_c.w}, kac[4] = {ka_c.x, ka_c.y, ka_c.z, ka_c.w}, rkc[4] = {rk_c.x, rk_c.y, rk_c.z, rk_c.w};
            float t[4], n2 = 0.f;
#pragma unroll
            for (int j = 0; j < 4; ++j) { t[j] = kx[j] * kkc[j]; n2 += t[j] * t[j]; }
            n2 = row16_allreduce(n2);
            const float inv = __builtin_amdgcn_rsqf(fmaxf(n2, 1e-24f));
            float at[4], bt[4], kt[4], rt[4], bon = 0.f;
#pragma unroll
            for (int j = 0; j < 4; ++j) {
                const float kkv = t[j] * inv;
                const float kd = kx[j] * (1.0f + (av[j] - 1.0f) * kac[j]);
                const float bq = kkv * av[j];
                bon += rx[j] * kd * rkc[j];
                at[j] = -kkv * Pmv[j]; bt[j] = bq * Piv[j]; kt[j] = kd * Piv[j]; rt[j] = rx[j] * Pv[j];
            }
            bon = row16_allreduce(bon);
            if ((tid & 15) == 0) { const int Rb = Rof(c, s_e); bonus[Rb < NL ? 256 + (Rb & 8191) : ((Rb - NL) & 255)] = bon; }
            const int ro = tile_off(s_e, j0 >> 3) + (j0 & 7) * 2;
            *(uint2*)(lds + AT + (c & 1) * 2048 + ro) = make_uint2(pk_bf16(at[0], at[1]), pk_bf16(at[2], at[3]));
            *(uint2*)(lds + RT + (c & 1) * 2048 + ro) = make_uint2(pk_bf16(rt[0], rt[1]), pk_bf16(rt[2], rt[3]));
            const unsigned b01 = pk_bf16(bt[0], bt[1]), b23 = pk_bf16(bt[2], bt[3]), k01 = pk_bf16(kt[0], kt[1]), k23 = pk_bf16(kt[2], kt[3]);
            *(uint2*)(lds + BT + (c & 1) * 2048 + ro) = make_uint2(b01, b23);
            *(uint2*)(lds + KT + (c & 1) * 2048 + ro) = make_uint2(k01, k23);
            const unsigned bw2[4] = {b01 & 0xffffu, b01 >> 16, b23 & 0xffffu, b23 >> 16}, kw2[4] = {k01 & 0xffffu, k01 >> 16, k23 & 0xffffu, k23 >> 16};
            const unsigned vw[4] = {pv.x & 0xffffu, pv.x >> 16, pv.y & 0xffffu, pv.y >> 16};
            const int e0 = (s_e & 7) * 2, cq = s_e >> 3, a_ = tid & 15;
            const int B0 = j0 * 128 + e0 + (((cq ^ (4 * (a_ & 1)) ^ (a_ >> 1)) & 7) << 4);
#pragma unroll
            for (int j = 0; j < 4; ++j) {
                *(bf16_t*)(lds + BKT + tb + (B0 ^ ((0 ^ j) << 4)) + j * 128) = (bf16_t)bw2[j];
                *(bf16_t*)(lds + BKT + tb + (B0 ^ ((2 ^ j) << 4)) + j * 128) = (bf16_t)kw2[j];
                *(bf16_t*)(lds + BKT + tb + (B0 ^ ((4 ^ j) << 4)) + j * 128) = (bf16_t)bw2[j];
                *(bf16_t*)(lds + UV + tb + (B0 ^ ((2 ^ j) << 4)) + j * 128) = (bf16_t)vw[j];
            }
        };
        f32x4 accY = {0.f, 0.f, 0.f, 0.f};
        auto prod_S = [&](int c) {
            const int vt = wv & 3, tb = (c & 1) * 2048;
            f32x4 accX = {0.f, 0.f, 0.f, 0.f}, accR = {0.f, 0.f, 0.f, 0.f};
#pragma unroll
            for (int ks = 0; ks < 2; ++ks) {
                const int ch = ks * 4 + fq;
                const bf16x8 sh = *(const bf16x8*)(lds + SH + tile_off(vt * 16 + fr, ch)), sl = *(const bf16x8*)(lds + SL + tile_off(vt * 16 + fr, ch));
                const bf16x8 fa = *(const bf16x8*)(lds + AT + tb + tile_off(fr, ch)), frr = *(const bf16x8*)(lds + RT + tb + tile_off(fr, ch));
                accX = __builtin_amdgcn_mfma_f32_16x16x32_bf16(sh, fa, accX, 0, 0, 0);
                accR = __builtin_amdgcn_mfma_f32_16x16x32_bf16(sh, frr, accR, 0, 0, 0);
                accX = __builtin_amdgcn_mfma_f32_16x16x32_bf16(sl, fa, accX, 0, 0, 0);
                accR = __builtin_amdgcn_mfma_f32_16x16x32_bf16(sl, frr, accR, 0, 0, 0);
            }
            accY = accR;
            {
                const u32x2v av = *(const u32x2v*)(lds + UV + (c & 1) * 8192 + tile_off2(vt * 16 + fr, 2 + (fq >> 1)) + (fq & 1) * 8);
                const u32x2v mh = *(const u32x2v*)(lds + MFK + (fr * 4 + fq) * 8), ml = *(const u32x2v*)(lds + MFK + 512 + (fr * 4 + fq) * 8);
                accX = __builtin_amdgcn_mfma_f32_16x16x16bf16_1k(__builtin_bit_cast(s16x4v, av), __builtin_bit_cast(s16x4v, mh), accX, 0, 0, 0);
                accX = __builtin_amdgcn_mfma_f32_16x16x16bf16_1k(__builtin_bit_cast(s16x4v, av), __builtin_bit_cast(s16x4v, ml), accX, 0, 0, 0);
            }
#pragma unroll
            for (int j = 0; j < 4; ++j) *(float*)(lds + X0 + ((vt * 16 + 4 * fq + j) * 16 + fr) * 4) = accX[j];
        };
        auto prod_V = [&](int c) {
            const int tb = (c & 1) * 2048, w4 = wv & 3;
            f32x4 m = {0.f, 0.f, 0.f, 0.f};
#pragma unroll
            for (int ks = 0; ks < 2; ++ks) {
                const int ch = ks * 4 + fq;
                const bf16x8 fa = *(const bf16x8*)(lds + ((w4 & 1) ? KT : BT) + tb + tile_off(fr, ch));
                const bf16x8 fb = *(const bf16x8*)(lds + ((w4 & 2) ? RT : AT) + tb + tile_off(fr, ch));
                m = __builtin_amdgcn_mfma_f32_16x16x32_bf16(fa, fb, m, 0, 0, 0);
            }
            if (w4 == 0) {
                float* mf = (float*)(lds + MFA);
#pragma unroll
                for (int j = 0; j < 4; ++j) mf[(fr * 4 + j) * 4 + fq] = (4 * fq + j < fr) ? m[j] : 0.f;
            } else if (w4 == 1) {
                const float m0 = (4 * fq + 0 < fr) ? m[0] : 0.f, m1 = (4 * fq + 1 < fr) ? m[1] : 0.f, m2 = (4 * fq + 2 < fr) ? m[2] : 0.f, m3 = (4 * fq + 3 < fr) ? m[3] : 0.f;
                const unsigned h01 = pk_bf16(m0, m1), h23 = pk_bf16(m2, m3);
                *(uint2*)(lds + MFK + (fr * 4 + fq) * 8) = make_uint2(h01, h23);
                *(uint2*)(lds + MFK + 512 + (fr * 4 + fq) * 8) = make_uint2(pk_bf16(m0 - bf_lo(h01), m1 - bf_hi(h01)), pk_bf16(m2 - bf_lo(h23), m3 - bf_hi(h23)));
            } else {
                const float m0 = (4 * fq + 0 <= fr) ? m[0] : 0.f, m1 = (4 * fq + 1 <= fr) ? m[1] : 0.f, m2 = (4 * fq + 2 <= fr) ? m[2] : 0.f, m3 = (4 * fq + 3 <= fr) ? m[3] : 0.f;
                const uint2 o = make_uint2(pk_bf16(m0, m1), pk_bf16(m2, m3));
                const int colb = (w4 == 2 ? 0 : 16) + 4 * fq;
                *(uint2*)(lds + NT + tb + tile_off(fr, colb >> 3) + (colb & 7) * 2) = o;
                if (w4 == 2) *(uint2*)(lds + NT + tb + tile_off(fr, (32 + 4 * fq) >> 3) + ((32 + 4 * fq) & 7) * 2) = o;
            }
        };
        auto step_rec = [&](int c) {
            const int v = tid >> 2, pq = tid & 3;
            float cc[16];
#pragma unroll
            for (int i = 0; i < 4; ++i) { const float4 q = *(const float4*)(lds + X0 + (v * 16 + 4 * i) * 4); cc[4 * i] = q.x; cc[4 * i + 1] = q.y; cc[4 * i + 2] = q.z; cc[4 * i + 3] = q.w; }
            float4 ma[16];
#pragma unroll
            for (int t = 1; t < 16; ++t) ma[t] = *(const float4*)(lds + MFA + ((t * 4 + pq) * 4) * 4);
            ma[0] = make_float4(0.f, 0.f, 0.f, 0.f);
            float uown[4] = {0.f, 0.f, 0.f, 0.f}, uall[16];
#pragma unroll
            for (int t = 0; t < 16; ++t) {
                float s = uown[0] * ma[t].x; s = fmaf(uown[1], ma[t].y, s); s = fmaf(uown[2], ma[t].z, s); s = fmaf(uown[3], ma[t].w, s);
                s += dpp_quad<0xB1>(s); s += dpp_quad<0x4E>(s);
                const float u = cc[t] + s;
                uall[t] = u;
                if (pq == (t & 3)) uown[t >> 2] = u;
            }
            if (pq < 2) {
                unsigned o[8];
#pragma unroll
                for (int i = 0; i < 8; ++i) {
                    const unsigned hi = pk_bf16(uall[2 * i], uall[2 * i + 1]);
                    o[i] = pq ? pk_bf16(uall[2 * i] - bf_lo(hi), uall[2 * i + 1] - bf_hi(hi)) : hi;
                }
                const int cb = pq ? 4 : 0;
                *(uint4*)(lds + UV + (c & 1) * 8192 + tile_off2(v, cb)) = make_uint4(o[0], o[1], o[2], o[3]);
                *(uint4*)(lds + UV + (c & 1) * 8192 + tile_off2(v, cb + 1)) = make_uint4(o[4], o[5], o[6], o[7]);
            }
        };
        f32x4 accS[2];
        accS[0] = (f32x4){0.f, 0.f, 0.f, 0.f}; accS[1] = (f32x4){0.f, 0.f, 0.f, 0.f};
        auto step_upd = [&](int c) {
            const int vt = wv & 3;
            bf16x8 fuv[2];
#pragma unroll
            for (int ks = 0; ks < 2; ++ks) fuv[ks] = *(const bf16x8*)(lds + UV + (c & 1) * 8192 + tile_off2(vt * 16 + fr, ks * 4 + fq));
            if (wv < 4) {
#pragma unroll
                for (int ks = 0; ks < 2; ++ks) accY = __builtin_amdgcn_mfma_f32_16x16x32_bf16(fuv[ks], *(const bf16x8*)(lds + NT + (c & 1) * 2048 + tile_off(fr, ks * 4 + fq)), accY, 0, 0, 0);
                *(float4*)(lds + YB + (fr * 64 + vt * 16 + 4 * fq) * 4) = make_float4(accY[0], accY[1], accY[2], accY[3]);
            }
#pragma unroll
            for (int k2 = 0; k2 < 2; ++k2) {
                const int kt = 2 * (wv >> 2) + k2;
                f32x4 a = accS[k2];
#pragma unroll
                for (int ks = 0; ks < 2; ++ks) a = __builtin_amdgcn_mfma_f32_16x16x32_bf16(*(const bf16x8*)(lds + BKT + (c & 1) * 8192 + tile_off2(kt * 16 + fr, ks * 4 + fq)), fuv[ks], a, 0, 0, 0);
                const float4 pl = *(const float4*)(lds + PL + (c & 3) * 256 + (kt * 16 + 4 * fq) * 4);
                a[0] *= pl.x; a[1] *= pl.y; a[2] *= pl.z; a[3] *= pl.w;
                accS[k2] = a;
                const unsigned h01 = pk_bf16(a[0], a[1]), h23 = pk_bf16(a[2], a[3]);
                const unsigned l01 = pk_bf16(a[0] - bf_lo(h01), a[1] - bf_hi(h01)), l23 = pk_bf16(a[2] - bf_lo(h23), a[3] - bf_hi(h23));
                const int kc = kt * 16 + 4 * fq;
                const int so = tile_off(vt * 16 + fr, kc >> 3) + (kc & 7) * 2;
                *(uint2*)(lds + SH + so) = make_uint2(h01, h23);
                *(uint2*)(lds + SL + so) = make_uint2(l01, l23);
            }
        };
        for (int i = tid; i < LDS_END / 16; i += NTHREADS) *(uint4*)(lds + i * 16) = make_uint4(0, 0, 0, 0);
        if (wv >= 4) { load_lora(0); load_rkv(0); }
        __syncthreads();
        if (wv >= 4) { step_up(0); load_lora(1); }
        __syncthreads();
        if (wv >= 4) { step_vec(0); step_up(1); load_rkv(1); load_lora(2); }
        __syncthreads();
        if (wv >= 4) prod_V(0);
        __syncthreads();
        auto ystore = [&](int c) {
            const float4 y4 = *(const float4*)(lds + YB + (s_e * 64 + j0) * 4);
            *(uint2*)(ydst + (size_t)Rof(c, s_e) * 1024 + hh * 64 + j0) = make_uint2(pk_bf16(y4.x, y4.y), pk_bf16(y4.z, y4.w));
        };
        if (wv < 4) {
            unsigned pfd = 0;
            for (int c = 0; c < 528; ++c) {
                if (c > 0) ystore(c - 1);
                if (c + 4 < 528 && tid < 80) {
                    const bf16_t* pf;
                    if (tid < 48) { const int ten = tid >> 4; pf = (ten == 0 ? rbuf : (ten == 1 ? kbuf : vbuf)) + (size_t)Rof(c + 4, tid & 15) * 1024 + hh * 64; }
                    else { const int i = tid - 48; pf = lora + (size_t)Rof(c + 4, i >> 1) * 384 + (i & 1) * 128 + d * 64; }
                    asm volatile("global_load_dword %0, %1, off" : "=v"(pfd) : "v"(pf) : "memory");
                }
                __builtin_amdgcn_s_setprio(3);
                prod_S(c);
                step_rec(c);
                __builtin_amdgcn_s_setprio(0);
                __syncthreads();
                step_upd(c);
                __syncthreads();
                asm volatile("" :: "v"(pfd));
            }
        } else {
            for (int c = 0; c < 528; ++c) {
                if (c + 1 < 528) step_vec(c + 1);
                if (c + 2 < 528) { step_up(c + 2); load_rkv(c + 2); }
                if (c + 3 < 528) load_lora(c + 3);
                __syncthreads();
                step_upd(c);
                if (c + 1 < 528) prod_V(c + 1);
                __syncthreads();
            }
        }
        if (wv < 4) ystore(527);
        __syncthreads();
    }
}

DEV void phase_rw_readout(const Params& p) {
    const int tid = tid_opaque(), lane = tid & 63, wv = tid >> 6, wm = wv >> 2, wn = wv & 3;
    const int fr = lane & 15, fq = lane >> 4;
    unsigned char* ws = p.ws;
    const bf16_t* y0b = (const bf16_t*)(ws + WS_S + 0 * U_BYTES);
    const bf16_t* y1b = (const bf16_t*)(ws + WS_S + 2 * U_BYTES);
    const bf16_t* vb = (const bf16_t*)(ws + WS_S + 1 * U_BYTES);
    const bf16_t* lora = (const bf16_t*)(ws + WS_S + 4 * U_BYTES);
    const bf16_t* g2t = (const bf16_t*)(ws + WS_G2T);
    bf16_t* ao = (bf16_t*)(ws + WS_S + 5 * U_BYTES);
    const float* bon0 = (const float*)(ws + WS_BONUS);
    const float* bon1 = bon0 + (size_t)NB * 16 * 8448;
    const float* lnw = p.in[21];
    const float* lnb = p.in[22];
    const int nunits = (NT / 128) * 4;
    for (int u = blockIdx.x; u < nunits; u += gridDim.x) {
        const int mt = u >> 2, nt = u & 3, m0 = mt * 128;
        const int hh = nt * 4 + wn;
        f32x4 acc[4][4];
#pragma unroll
        for (int mi = 0; mi < 4; ++mi)
#pragma unroll
            for (int ni = 0; ni < 4; ++ni) acc[mi][ni] = (f32x4){0.f, 0.f, 0.f, 0.f};
#pragma unroll 2
        for (int ks = 0; ks < 4; ++ks) {
            bf16x8 af[4], bfr[4];
#pragma unroll
            for (int mi = 0; mi < 4; ++mi) af[mi] = *(const bf16x8*)(lora + (size_t)(m0 + wm * 64 + mi * 16 + fr) * 384 + 256 + ks * 32 + fq * 8);
#pragma unroll
            for (int ni = 0; ni < 4; ++ni) bfr[ni] = *(const bf16x8*)(g2t + (size_t)(hh * 64 + 16 * (fr >> 2) + 4 * ni + (fr & 3)) * 128 + ks * 32 + fq * 8);
#pragma unroll
            for (int mi = 0; mi < 4; ++mi)
#pragma unroll
                for (int ni = 0; ni < 4; ++ni) acc[mi][ni] = __builtin_amdgcn_mfma_f32_16x16x32_bf16(bfr[ni], af[mi], acc[mi][ni], 0, 0, 0);
        }
#pragma unroll
        for (int mi = 0; mi < 4; ++mi) {
            const size_t R = (size_t)(m0 + wm * 64 + mi * 16 + fr);
            float yv[4][4]; float sum = 0.f;
            const int colb = hh * 64 + 16 * fq;
            {
                const uint4 a0 = *(const uint4*)(y0b + R * 1024 + colb), a1 = *(const uint4*)(y0b + R * 1024 + colb + 8);
                const uint4 c0 = *(const uint4*)(y1b + R * 1024 + colb), c1 = *(const uint4*)(y1b + R * 1024 + colb + 8);
                const unsigned aw[8] = {a0.x, a0.y, a0.z, a0.w, a1.x, a1.y, a1.z, a1.w}, cw[8] = {c0.x, c0.y, c0.z, c0.w, c1.x, c1.y, c1.z, c1.w};
#pragma unroll
                for (int ni = 0; ni < 4; ++ni) {
                    yv[ni][0] = bf_lo(aw[2 * ni]) + bf_lo(cw[2 * ni]); yv[ni][1] = bf_hi(aw[2 * ni]) + bf_hi(cw[2 * ni]);
                    yv[ni][2] = bf_lo(aw[2 * ni + 1]) + bf_lo(cw[2 * ni + 1]); yv[ni][3] = bf_hi(aw[2 * ni + 1]) + bf_hi(cw[2 * ni + 1]);
                    sum += (yv[ni][0] + yv[ni][1]) + (yv[ni][2] + yv[ni][3]);
                }
            }
            sum += __shfl_xor(sum, 16); sum += __shfl_xor(sum, 32);
            const float mu = sum * (1.0f / 64.0f);
            float q = 0.f;
#pragma unroll
            for (int ni = 0; ni < 4; ++ni)
#pragma unroll
                for (int j = 0; j < 4; ++j) { const float dlt = yv[ni][j] - mu; q += dlt * dlt; }
            q += __shfl_xor(q, 16); q += __shfl_xor(q, 32);
            const float rstd = rsqrtf(q * (1.0f / 64.0f) + 64e-5f);
            const size_t bidx = (size_t)(((R < NL ? (R >> 13) : ((R - NL) >> 8)) * 16 + hh)) * 8448 + (R < NL ? 256 + (R & 8191) : ((R - NL) & 255));
            const float bs = bon0[bidx] + bon1[bidx];
            const uint4 v0 = *(const uint4*)(vb + R * 1024 + colb), v1 = *(const uint4*)(vb + R * 1024 + colb + 8);
            const unsigned vw[8] = {v0.x, v0.y, v0.z, v0.w, v1.x, v1.y, v1.z, v1.w};
            unsigned ow[8];
#pragma unroll
            for (int ni = 0; ni < 4; ++ni) {
                const int col = colb + 4 * ni;
                const float4 lw = *(const float4*)(lnw + col), lb = *(const float4*)(lnb + col);
                const float o0 = ((yv[ni][0] - mu) * rstd * lw.x + lb.x + bs * bf_lo(vw[2 * ni])) * acc[mi][ni][0];
                const float o1 = ((yv[ni][1] - mu) * rstd * lw.y + lb.y + bs * bf_hi(vw[2 * ni])) * acc[mi][ni][1];
                const float o2 = ((yv[ni][2] - mu) * rstd * lw.z + lb.z + bs * bf_lo(vw[2 * ni + 1])) * acc[mi][ni][2];
                const float o3 = ((yv[ni][3] - mu) * rstd * lw.w + lb.w + bs * bf_hi(vw[2 * ni + 1])) * acc[mi][ni][3];
                ow[2 * ni] = pk_bf16(o0, o1); ow[2 * ni + 1] = pk_bf16(o2, o3);
            }
            *(uint4*)(ao + R * 1024 + colb) = make_uint4(ow[0], ow[1], ow[2], ow[3]);
            *(uint4*)(ao + R * 1024 + colb + 8) = make_uint4(ow[4], ow[5], ow[6], ow[7]);
        }
    }
}

DEV void phase_wo(const Params& p, unsigned char* lds, int layer) {
    unsigned char* ws = p.ws;
    const bf16_t* ao = (const bf16_t*)(ws + WS_S + (size_t)(layer ? 0 : 5) * U_BYTES);
    const bf16_t* wot = (const bf16_t*)(ws + (layer ? WS_WO1 : WS_WO0));
    float* ctxr = (float*)(ws + WS_CTXR);
    const float* gate = (const float*)(ws + WS_MOD) + (size_t)layer * 9 * 6144 + 2 * 1024;
    const int M = NL;
    pg8::Gemm g{ao, wot, M, 1024, 1024};
    pg8::StaticOrder so; so.init(M, 1024, gridDim.x, blockIdx.x);
    pg8::EpiResid256 ep{layer ? p.out : p.in[0], layer ? ctxr : p.in[2], p.out, ctxr, gate};
    pg8::gemm_phase((PG8_LAS unsigned char*)lds, g, so, ep, nullptr);
    __syncthreads();
    if (!layer)
        for (int u = blockIdx.x; u < (NC / 128) * 8; u += gridDim.x) {
            const int mt = u >> 3, nt = u & 7;
            ALoadPlain al{ao, 1024};
            EpiResid<2> ep2{p.in[0], p.in[2], p.out, ctxr, gate, nt * 128};
            gemm_unit<128>(lds, al, wot + (size_t)nt * 128 * 1024, 1024, NL + mt * 128, ep2);
        }
}

struct EpiQTile {
    unsigned char* lds;
    DEV void operator()(const f32x4 (&acc)[4][4], int m0, int wm, int wn, int fr, int fq) const {
        const int pp = wn >> 1;
#pragma unroll
        for (int mi = 0; mi < 4; ++mi) {
            const int m = wm * 64 + mi * 16 + fr;
#pragma unroll
            for (int ni = 0; ni < 4; ++ni) {
                const int c = (wn & 1) * 64 + ni * 16 + 4 * fq;
                *(uint2*)(lds + pp * 32768 + m * 256 + (((c >> 3) ^ (m & 15)) << 4) + (c & 7) * 2) = make_uint2(pk_bf16(acc[mi][ni][0], acc[mi][ni][1]), pk_bf16(acc[mi][ni][2], acc[mi][ni][3]));
            }
        }
    }
};
DEV void phase_peer_select(const Params& p, unsigned char* lds, int layer) {
    const int tid = tid_opaque(), lane = tid & 63, wv = tid >> 6, wm = wv >> 2, wn = wv & 3;
    const int fr = lane & 15, fq = lane >> 4;
    unsigned char* ws = p.ws;
    const bf16_t* hp = (const bf16_t*)(ws + WS_S + (size_t)(layer ? 0 : 1) * U_BYTES);
    const bf16_t* wqt = (const bf16_t*)(ws + WS_WQ) + (size_t)layer * 2048 * 1024;
    const bf16_t* keys = (const bf16_t*)(ws + WS_KEYS) + (size_t)layer * 8 * 2 * 128 * 128;
    int* pl_idx = (int*)(ws + WS_S + 3 * U_BYTES);
    float* pl_gate = (float*)(ws + WS_S + 3 * U_BYTES + (size_t)NT * 128 * 4);
    unsigned* slist = (unsigned*)lds;
    unsigned* tlist = (unsigned*)(lds + 256 * 132 * 4);
    const int mtiles = layer ? NL / 128 : NT / 128;
    for (int u = blockIdx.x; u < mtiles * 8; u += gridDim.x) {
        const int mt = u >> 3, head = u & 7, m0 = mt * 128;
        ALoadPlain al{hp, 1024};
        EpiQTile ep{lds};
        gemm_unit<256>(lds, al, wqt + (size_t)head * 256 * 1024, 1024, m0, ep);
        __syncthreads();
        const int pp = wn >> 1, nk0 = (wn & 1) * 64;
        f32x4 sc[4][4];
#pragma unroll
        for (int mi = 0; mi < 4; ++mi)
#pragma unroll
            for (int ni = 0; ni < 4; ++ni) sc[mi][ni] = (f32x4){0.f, 0.f, 0.f, 0.f};
        const bf16_t* kb = keys + (size_t)(head * 2 + pp) * 16384;
#pragma unroll
        for (int ks = 0; ks < 4; ++ks) {
            bf16x8 af[4], bfr[4];
            const int ch = ks * 4 + fq;
#pragma unroll
            for (int mi = 0; mi < 4; ++mi) { const int m = wm * 64 + mi * 16 + fr; af[mi] = *(const bf16x8*)(lds + pp * 32768 + m * 256 + ((ch ^ (m & 15)) << 4)); }
#pragma unroll
            for (int ni = 0; ni < 4; ++ni) bfr[ni] = *(const bf16x8*)(kb + (size_t)(nk0 + ni * 16 + fr) * 128 + ks * 32 + fq * 8);
#pragma unroll
            for (int mi = 0; mi < 4; ++mi)
#pragma unroll
                for (int ni = 0; ni < 4; ++ni) sc[mi][ni] = __builtin_amdgcn_mfma_f32_16x16x32_bf16(bfr[ni], af[mi], sc[mi][ni], 0, 0, 0);
        }
        __syncthreads();
#pragma unroll
        for (int mi = 0; mi < 4; ++mi) {
            const int m = wm * 64 + mi * 16 + fr;
#pragma unroll
            for (int ni = 0; ni < 4; ++ni) {
                const int n = nk0 + ni * 16 + 4 * fq;
                uint4 o;
                o.x = (mono_u32(sc[mi][ni][0]) & ~127u) | (unsigned)(127 - (n + 0));
                o.y = (mono_u32(sc[mi][ni][1]) & ~127u) | (unsigned)(127 - (n + 1));
                o.z = (mono_u32(sc[mi][ni][2]) & ~127u) | (unsigned)(127 - (n + 2));
                o.w = (mono_u32(sc[mi][ni][3]) & ~127u) | (unsigned)(127 - (n + 3));
                *(uint4*)(slist + (size_t)(pp * 128 + m) * 132 + n) = o;
            }
        }
        __syncthreads();
        {
            const int L = tid >> 1, g2 = tid & 1;
            unsigned t[64];
            {
                const unsigned* srcp = slist + (size_t)L * 132 + g2 * 64;
#pragma unroll
                for (int i = 0; i < 16; ++i) { const uint4 v = *(const uint4*)(srcp + i * 4); t[4 * i] = v.x; t[4 * i + 1] = v.y; t[4 * i + 2] = v.z; t[4 * i + 3] = v.w; }
            }
#pragma unroll
            for (int o = 0; o < 64; o += 16) {
#pragma unroll
                for (int pp2 = 1; pp2 < 16; pp2 <<= 1)
#pragma unroll
                    for (int k = pp2; k >= 1; k >>= 1)
#pragma unroll
                        for (int j = k % pp2; j <= 15 - k; j += 2 * k)
#pragma unroll
                            for (int i = 0; i < k; ++i) {
                                if (i + j + k <= 15 && (i + j) / (2 * pp2) == (i + j + k) / (2 * pp2)) {
                                    const unsigned mx = max(t[o + i + j], t[o + i + j + k]), mn = min(t[o + i + j], t[o + i + j + k]);
                                    t[o + i + j] = mx; t[o + i + j + k] = mn;
                                }
                            }
            }
#pragma unroll
            for (int rnd = 0; rnd < 4; ++rnd) {
                const int oa = rnd == 1 ? 32 : 0, ob = rnd == 0 ? 16 : (rnd == 1 ? 48 : 32);
                unsigned c[16];
#pragma unroll
                for (int i = 0; i < 16; ++i) {
                    unsigned b;
                    if (rnd < 3) b = t[ob + 15 - i];
                    else b = (unsigned)__builtin_amdgcn_update_dpp(0, (int)t[15 - i], 0xB1, 0xF, 0xF, false);
                    c[i] = max(t[oa + i], b);
                }
#pragma unroll
                for (int j = 8; j > 0; j >>= 1)
#pragma unroll
                    for (int i = 0; i < 16; ++i) {
                        const int l = i ^ j;
                        if (l > i) { const unsigned mx = max(c[i], c[l]), mn = min(c[i], c[l]); c[i] = mx; c[l] = mn; }
                    }
#pragma unroll
                for (int i = 0; i < 16; ++i) t[oa + i] = c[i];
            }
            if (g2 == 0) {
#pragma unroll
                for (int i = 0; i < 4; ++i) *(uint4*)(tlist + L * 16 + i * 4) = make_uint4(t[4 * i], t[4 * i + 1], t[4 * i + 2], t[4 * i + 3]);
            }
        }
        __syncthreads();
        if (tid < 128) {
            float v0[16], v1[16];
#pragma unroll
            for (int i = 0; i < 16; ++i) { v0[i] = unmono_u32(tlist[tid * 16 + i] & ~127u); v1[i] = unmono_u32(tlist[(128 + tid) * 16 + i] & ~127u); }
            unsigned cd[16];
#pragma unroll
            for (int i = 0; i < 16; ++i) cd[i] = 0u;
#pragma unroll
            for (int i = 0; i < 16; ++i) {
#pragma unroll
                for (int j = 0; j < 16; ++j) {
                    if ((i + 1) * (j + 1) <= 16) {
                        unsigned x = (mono_u32(v0[i] + v1[j]) & ~255u) | (unsigned)(255 - (i * 16 + j));
#pragma unroll
                        for (int q = (i + 1) * (j + 1) - 1; q < 16; ++q) { const unsigned mx = max(cd[q], x); x = min(cd[q], x); cd[q] = mx; }
                    }
                }
            }
            float sv[16]; int ex[16];
#pragma unroll
            for (int q = 0; q < 16; ++q) {
                const int slot = 255 - (int)(cd[q] & 255u);
                const unsigned a = tlist[tid * 16 + (slot >> 4)], b2 = tlist[(128 + tid) * 16 + (slot & 15)];
                sv[q] = unmono_u32(a & ~127u) + unmono_u32(b2 & ~127u);
                ex[q] = (127 - (int)(a & 127u)) * 128 + (127 - (int)(b2 & 127u));
            }
            float mx = sv[0];
#pragma unroll
            for (int q = 1; q < 16; ++q) mx = fmaxf(mx, sv[q]);
            float den = 0.f;
#pragma unroll
            for (int q = 0; q < 16; ++q) { sv[q] = __expf(sv[q] - mx); den += sv[q]; }
            const float rden = 1.0f / den;
            const size_t base = ((size_t)head * NT + (m0 + tid)) * 16;
#pragma unroll
            for (int i = 0; i < 4; ++i) {
                *(int4*)(pl_idx + base + i * 4) = make_int4(ex[4 * i], ex[4 * i + 1], ex[4 * i + 2], ex[4 * i + 3]);
                *(float4*)(pl_gate + base + i * 4) = make_float4(sv[4 * i] * rden, sv[4 * i + 1] * rden, sv[4 * i + 2] * rden, sv[4 * i + 3] * rden);
            }
        }
        __syncthreads();
    }
}

typedef float f32x2 __attribute__((ext_vector_type(2)));
typedef unsigned int u32x4 __attribute__((ext_vector_type(4)));
typedef unsigned int u32x2 __attribute__((ext_vector_type(2)));
#define PS_LOAD(buf, ee, h) { _Pragma("unroll") for (int e = 0; e < 8; ++e) { \
        const u32x4 t4 = __builtin_amdgcn_raw_buffer_load_b128(rs, ((unsigned)ee[(h) * 8 + e] << 7) + ch16, 0, 0); buf[e] = make_uint4(t4.x, t4.y, t4.z, t4.w); } }
#define PS_IDX(ee, Rr) { _Pragma("unroll") for (int i = 0; i < 4; ++i) { const int4 t = *(const int4*)(pl_idx + ((size_t)sub * NT + (Rr)) * 16 + 4 * i); \
        ee[4 * i] = t.x; ee[4 * i + 1] = t.y; ee[4 * i + 2] = t.z; ee[4 * i + 3] = t.w; } }
DEV long pk64(unsigned lo, unsigned hi) { return (long)(((unsigned long long)hi << 32) | (unsigned long long)lo); }
DEV void phase_peer_u(const Params& p, unsigned char* lds, int layer) {
    const int tid = tid_opaque(), lane = tid & 63, wv = tid >> 6, sub = lane >> 3, ch = lane & 7, fm = lane & 15, fg = lane >> 4;
    const int ng = gridDim.x >> 3, x = blockIdx.x & 7, wq = blockIdx.x >> 3;
    if (wq < ng) {
        const int gw = __builtin_amdgcn_readfirstlane(wq * 8 + wv), nw = ng * 8;
        unsigned char* ws = p.ws;
        const unsigned char* tab = ws + WS_PU + ((size_t)layer * 8 + x) * (16384 * 128);
        const int* pl_idx = (const int*)(ws + WS_S + 3 * U_BYTES);
        const unsigned char* xq = ws + WS_S + 2 * U_BYTES + (size_t)(fm & 1) * 1024 + 128 * x + 16 * fg;
        bf16_t* pd = (bf16_t*)(ws + WS_S + 5 * U_BYTES) + (size_t)x * NT * 128 + 16 * (fm >> 1) + 4 * fg;
        unsigned char* tile = lds + wv * 16384;
        const unsigned cE16 = 16u * (unsigned)(ch ^ (sub >> 1)), cO16 = cE16 ^ 64u;
        const unsigned aoff0 = (unsigned)fm * 128u + (unsigned)((fg ^ (fm >> 1)) << 4), aoff1 = (unsigned)fm * 128u + (unsigned)(((4 + fg) ^ (fm >> 1)) << 4);
        const int nrows = layer ? NL : NT;
        int eN[16];
#define PU_DMA(ee, q) { _Pragma("unroll") for (int j = 0; j < 4; ++j) { const int jj = (q) * 4 + j; \
        __builtin_amdgcn_global_load_lds((const unsigned*)(tab + (((unsigned)ee[jj] << 7) + ((jj & 1) ? cO16 : cE16))), (unsigned*)(tile + jj * 1024 + lane * 16), 16, 0, 0); } }
        const unsigned ta0 = (unsigned)(size_t)((LAS3 unsigned char*)tile) + aoff0, ta1 = (unsigned)(size_t)((LAS3 unsigned char*)tile) + aoff1;
#define PU_MMA(q) { u32x4 a0, a1, a2, a3; \
        asm volatile("ds_read_b128 %0, %4 offset:%6\n\tds_read_b128 %1, %5 offset:%6\n\tds_read_b128 %2, %4 offset:%7\n\tds_read_b128 %3, %5 offset:%7\n\ts_waitcnt lgkmcnt(0)" \
            : "=&v"(a0), "=&v"(a1), "=&v"(a2), "=&v"(a3) : "v"(ta0), "v"(ta1), "n"((q) * 4096), "n"((q) * 4096 + 2048) : "memory"); \
        f32x4 c4 = {0.f, 0.f, 0.f, 0.f}, c5 = {0.f, 0.f, 0.f, 0.f}; \
        c4 = __builtin_amdgcn_mfma_f32_16x16x32_fp8_fp8(pk64(a0.x, a0.y), pk64(bC0.x, bC0.y), c4, 0, 0, 0); \
        c5 = __builtin_amdgcn_mfma_f32_16x16x32_fp8_fp8(pk64(a2.x, a2.y), pk64(bC0.x, bC0.y), c5, 0, 0, 0); \
        c4 = __builtin_amdgcn_mfma_f32_16x16x32_fp8_fp8(pk64(a0.z, a0.w), pk64(bC0.z, bC0.w), c4, 0, 0, 0); \
        c5 = __builtin_amdgcn_mfma_f32_16x16x32_fp8_fp8(pk64(a2.z, a2.w), pk64(bC0.z, bC0.w), c5, 0, 0, 0); \
        c4 = __builtin_amdgcn_mfma_f32_16x16x32_fp8_fp8(pk64(a1.x, a1.y), pk64(bC1.x, bC1.y), c4, 0, 0, 0); \
        c5 = __builtin_amdgcn_mfma_f32_16x16x32_fp8_fp8(pk64(a3.x, a3.y), pk64(bC1.x, bC1.y), c5, 0, 0, 0); \
        c4 = __builtin_amdgcn_mfma_f32_16x16x32_fp8_fp8(pk64(a1.z, a1.w), pk64(bC1.z, bC1.w), c4, 0, 0, 0); \
        c5 = __builtin_amdgcn_mfma_f32_16x16x32_fp8_fp8(pk64(a3.z, a3.w), pk64(bC1.z, bC1.w), c5, 0, 0, 0); \
        acc[(q) * 2] = c4; acc[(q) * 2 + 1] = c5; }
        int R = gw;
#pragma unroll
        for (int i = 0; i < 16; ++i) eN[i] = 0;
        uint4 bC0 = make_uint4(0, 0, 0, 0), bC1 = bC0;
        if (R < nrows) {
            PS_IDX(eN, R);
            PU_DMA(eN, 0); PU_DMA(eN, 1); PU_DMA(eN, 2); PU_DMA(eN, 3);
            bC0 = *(const uint4*)(xq + (size_t)R * 2048); bC1 = *(const uint4*)(xq + (size_t)R * 2048 + 64);
            const int R1 = min(R + nw, nrows - 1);
            PS_IDX(eN, R1);
            asm volatile("s_waitcnt vmcnt(0)" : "+v"(bC0.x), "+v"(bC1.x), "+v"(eN[0]), "+v"(eN[4]), "+v"(eN[8]), "+v"(eN[12]) :: "memory");
        }
        for (; R < nrows; R += nw) {
            const int Rn = R + nw, R1 = min(Rn, nrows - 1), R2 = min(Rn + nw, nrows - 1);
            const bool more = Rn < nrows;
            u32x4 i0, i1, i2, i3, nb0, nb1;
            {
                const int* iptr = pl_idx + ((size_t)sub * NT + R2) * 16;
                const unsigned char* xptr = xq + (size_t)R1 * 2048;
                asm volatile("global_load_dwordx4 %0, %6, off\n\tglobal_load_dwordx4 %1, %6, off offset:16\n\tglobal_load_dwordx4 %2, %6, off offset:32\n\tglobal_load_dwordx4 %3, %6, off offset:48\n\t"
                             "global_load_dwordx4 %4, %7, off\n\tglobal_load_dwordx4 %5, %7, off offset:64"
                             : "=&v"(i0), "=&v"(i1), "=&v"(i2), "=&v"(i3), "=&v"(nb0), "=&v"(nb1) : "v"(iptr), "v"(xptr) : "memory");
            }
            f32x4 acc[8];
#define PU_STEP(q) { if (more) asm volatile("s_waitcnt vmcnt(19)" ::: "memory"); else asm volatile("s_waitcnt vmcnt(0)" ::: "memory"); \
            PU_MMA(q); if (more) { PU_DMA(eN, q); } }
            PU_STEP(0); PU_STEP(1); PU_STEP(2); PU_STEP(3);
            f32x4 s0[4], s1[2], s2;
#pragma unroll
            for (int i = 0; i < 4; ++i)
#pragma unroll
                for (int r = 0; r < 4; ++r) s0[i][r] = (fm & 2) ? acc[2 * i + 1][r] : acc[2 * i][r];
#pragma unroll
            for (int i = 0; i < 2; ++i)
#pragma unroll
                for (int r = 0; r < 4; ++r) s1[i][r] = (fm & 4) ? s0[2 * i + 1][r] : s0[2 * i][r];
#pragma unroll
            for (int r = 0; r < 4; ++r) { const float t = (fm & 8) ? s1[1][r] : s1[0][r]; s2[r] = t + dpp_quad<0xB1>(t); }
            if (!(fm & 1)) *(uint2*)(pd + (size_t)R * 128) = make_uint2(pk_bf16(s2[0], s2[1]), pk_bf16(s2[2], s2[3]));
            if (more) asm volatile("s_waitcnt vmcnt(17)" : "+v"(i0), "+v"(i1), "+v"(i2), "+v"(i3), "+v"(nb0), "+v"(nb1) :: "memory");
            else asm volatile("s_waitcnt vmcnt(0)" : "+v"(i0), "+v"(i1), "+v"(i2), "+v"(i3), "+v"(nb0), "+v"(nb1) :: "memory");
            eN[0] = i0.x; eN[1] = i0.y; eN[2] = i0.z; eN[3] = i0.w; eN[4] = i1.x; eN[5] = i1.y; eN[6] = i1.z; eN[7] = i1.w;
            eN[8] = i2.x; eN[9] = i2.y; eN[10] = i2.z; eN[11] = i2.w; eN[12] = i3.x; eN[13] = i3.y; eN[14] = i3.z; eN[15] = i3.w;
            bC0 = make_uint4(nb0.x, nb0.y, nb0.z, nb0.w); bC1 = make_uint4(nb1.x, nb1.y, nb1.z, nb1.w);
        }
        asm volatile("s_waitcnt vmcnt(0)" ::: "memory");
    }
}
DEV void phase_peer_c(const Params& p, int layer) {
    const int tid = tid_opaque(), lane = tid & 63;
    const int gw = blockIdx.x * 8 + (tid >> 6), nw = gridDim.x * 8;
    unsigned char* ws = p.ws;
    const float* usc = (const float*)(ws + WS_PSC) + layer * 16384;
    const float* vsc = (const float*)(ws + WS_PSC) + 32768 + layer * 16384;
    const int* pl_idx = (const int*)(ws + WS_S + 3 * U_BYTES);
    const float* pl_gate = (const float*)(ws + WS_S + 3 * U_BYTES + (size_t)NT * 128 * 4);
    float* pd = (float*)(ws + WS_S + 4 * U_BYTES);
    const bf16_t* pdh = (const bf16_t*)(ws + WS_S + 5 * U_BYTES);
    const int nrows = layer ? NL : NT;
    const int head0 = 2 * (lane & 3), kk = lane >> 2;
    for (int R = gw; R < nrows; R += nw) {
        float d0 = 0.f, d1 = 0.f;
#pragma unroll
        for (int xx = 0; xx < 8; ++xx) { const unsigned t = *(const unsigned*)(pdh + ((size_t)xx * NT + R) * 128 + 2 * lane); d0 += bf_lo(t); d1 += bf_hi(t); }
        const size_t po = ((size_t)head0 * NT + R) * 16 + kk;
        const int e0 = pl_idx[po], e1 = pl_idx[po + (size_t)NT * 16];
        const float g0 = pl_gate[po], g1 = pl_gate[po + (size_t)NT * 16];
        d0 *= usc[e0] * 0.25f; d1 *= usc[e1] * 0.25f;
        const float c0 = g0 * vsc[e0] * 0.5f * d0 * (1.0f + erff(d0 * 0.70710678118f));
        const float c1 = g1 * vsc[e1] * 0.5f * d1 * (1.0f + erff(d1 * 0.70710678118f));
        pd[(size_t)R * 128 + 16 * head0 + kk] = c0;
        pd[(size_t)R * 128 + 16 * head0 + 16 + kk] = c1;
    }
}
DEV void phase_peer_v(const Params& p, int layer) {
    const int tid = tid_opaque(), lane = tid & 63, sub = lane >> 3, ch = lane & 7;
    const int ng = gridDim.x >> 3, x = blockIdx.x & 7, wq = blockIdx.x >> 3;
    if (wq < ng) {
        const int gw = __builtin_amdgcn_readfirstlane(wq * 8 + (tid >> 6)), nw = ng * 8;
        unsigned char* ws = p.ws;
        const __amdgpu_buffer_rsrc_t rs = __builtin_amdgcn_make_buffer_rsrc((void*)(ws + WS_PV + ((size_t)layer * 8 + x) * (16384 * 128)), 0, 16384 * 128, 0x00020000);
        const int* pl_idx = (const int*)(ws + WS_S + 3 * U_BYTES);
        const float* cb = (const float*)(ws + WS_S + 4 * U_BYTES) + 16 * sub;
        float* ctxr = (float*)(ws + WS_CTXR);
        const float* mods = (const float*)(ws + WS_MOD) + (size_t)layer * 9 * 6144 + 5 * 1024;
        const unsigned ch16 = 16u * (unsigned)ch;
        const int col = 128 * x + 16 * ch + 2 * sub;
        const int nrows = layer ? NL : NT;
        uint4 bufA[8], bufB[8];
        int eC[16], eN[16];
        float cC[16], cN[16];
#define PS_CF(cc, Rr) { _Pragma("unroll") for (int i = 0; i < 4; ++i) { const float4 t = *(const float4*)(cb + (size_t)(Rr) * 128 + 4 * i); \
        cc[4 * i] = t.x; cc[4 * i + 1] = t.y; cc[4 * i + 2] = t.z; cc[4 * i + 3] = t.w; } }
#define PV_FMA(accv, av) asm("v_fma_f32 %0, %1, %2, %0" : "+v"(accv) : "v"(cf), "v"(av))
#define PV_AXPY(buf, h) { _Pragma("unroll") for (int e = 0; e < 8; ++e) { \
        const float cf = cC[(h) * 8 + e]; const unsigned vw[4] = {buf[e].x, buf[e].y, buf[e].z, buf[e].w}; \
        _Pragma("unroll") for (int i = 0; i < 4; ++i) { \
            const f32x2 a = __builtin_amdgcn_cvt_pk_f32_fp8((int)vw[i], false), b2 = __builtin_amdgcn_cvt_pk_f32_fp8((int)vw[i], true); \
            PV_FMA(a16[4 * i], a.x); PV_FMA(a16[4 * i + 1], a.y); PV_FMA(a16[4 * i + 2], b2.x); PV_FMA(a16[4 * i + 3], b2.y); } } }
        int R = gw;
#pragma unroll
        for (int i = 0; i < 16; ++i) { eC[i] = 0; eN[i] = 0; cC[i] = 0.f; cN[i] = 0.f; }
        if (R < nrows) { PS_IDX(eC, R); PS_CF(cC, R); PS_LOAD(bufA, eC, 0); }
        for (; R < nrows; R += nw) {
            const int Rn = R + nw;
            if (Rn < nrows) { PS_IDX(eN, Rn); PS_CF(cN, Rn); }
            PS_LOAD(bufB, eC, 1);
            float* xrow = (R < NL ? p.out + (size_t)R * 1024 : ctxr + (size_t)(R - NL) * 1024) + col;
            const float2 xa = *(const float2*)xrow, ga = *(const float2*)(mods + (size_t)mod_batch(R) * 6144 + col);
            float a16[16];
#pragma unroll
            for (int i = 0; i < 16; ++i) a16[i] = 0.f;
            PV_AXPY(bufA, 0);
            if (Rn < nrows) { PS_LOAD(bufA, eN, 0); }
            PV_AXPY(bufB, 1);
            float s8[8], t4[4];
#pragma unroll
            for (int j = 0; j < 8; ++j) { const u32x2 r = __builtin_amdgcn_permlane32_swap(__float_as_uint(a16[j]), __float_as_uint(a16[8 + j]), false, false); s8[j] = __uint_as_float(r.x) + __uint_as_float(r.y); }
#pragma unroll
            for (int j = 0; j < 4; ++j) { const u32x2 r = __builtin_amdgcn_permlane16_swap(__float_as_uint(s8[j]), __float_as_uint(s8[4 + j]), false, false); t4[j] = __uint_as_float(r.x) + __uint_as_float(r.y); }
            const float wa0 = t4[0] + dpp_ror<8>(t4[0]), wa1 = t4[1] + dpp_ror<8>(t4[1]), wb0 = t4[2] + dpp_ror<8>(t4[2]), wb1 = t4[3] + dpp_ror<8>(t4[3]);
            const float w0 = (lane & 8) ? wb0 : wa0, w1 = (lane & 8) ? wb1 : wa1;
            *(float2*)xrow = make_float2(xa.x + ga.x * w0, xa.y + ga.y * w1);
#pragma unroll
            for (int i = 0; i < 16; ++i) { eC[i] = eN[i]; cC[i] = cN[i]; }
        }
    }
}
DEV void phase_final_norm(const Params& p) {
    const int tid = tid_opaque(), lane = tid & 63;
    const int gw = blockIdx.x * 8 + (tid >> 6), nw = gridDim.x * 8;
    const float* gn = p.in[34];
    for (int R = gw; R < NL; R += nw) {
        float* xr = p.out + (size_t)R * 1024;
        float4 v[4]; float ss = 0.f;
#pragma unroll
        for (int i = 0; i < 4; ++i) { v[i] = *(const float4*)(xr + i * 256 + lane * 4); ss += v[i].x * v[i].x + v[i].y * v[i].y + v[i].z * v[i].z + v[i].w * v[i].w; }
        ss = wave_allreduce(ss);
        const float rs = rsqrtf(ss * (1.0f / 1024.0f) + 1e-6f);
#pragma unroll
        for (int i = 0; i < 4; ++i) {
            const float4 gg = *(const float4*)(gn + i * 256 + lane * 4);
            *(float4*)(xr + i * 256 + lane * 4) = make_float4(v[i].x * rs * gg.x, v[i].y * rs * gg.y, v[i].z * rs * gg.z, v[i].w * rs * gg.w);
        }
    }
}

DEV void phase_gla_proj(const Params& p, unsigned char* lds) {
    unsigned char* ws = p.ws;
    const bf16_t* h = (const bf16_t*)(ws + WS_S + 0 * U_BYTES);
    const bf16_t* wint = (const bf16_t*)(ws + WS_WIN);
    {
        pg8::Gemm g{h, wint, NT, 3072, 1024};
        pg8::StaticOrder so; so.init(NT, 3072, gridDim.x, blockIdx.x);
        pg8::EpiBf16Tiles ep{(bf16_t*)(ws + WS_S + 1 * U_BYTES), 2048, 8, (bf16_t*)(ws + WS_S + 3 * U_BYTES), 1024};
        pg8::gemm_phase(( PG8_LAS unsigned char*)lds, g, so, ep, nullptr);
    }
    __syncthreads();
    for (int u = blockIdx.x; u < NT / 128; u += gridDim.x) {
        ALoadPlain al{h, 1024};
        EpiLr ep{(float*)(ws + WS_LR)};
        gemm_unit<128>(lds, al, wint + (size_t)3072 * 1024, 1024, u * 128, ep);
    }
}

DEV void conv_emit(const float (&acc)[8], int c, bf16_t* dst) {
    const float qs = (c < 512) ? 0.08838834764831845f : 1.0f;
    unsigned ow[4];
#pragma unroll
    for (int j = 0; j < 4; ++j) { const float a0 = acc[2 * j], a1 = acc[2 * j + 1]; ow[j] = pk_bf16(a0 * sigmoidf_(a0) * qs, a1 * sigmoidf_(a1) * qs); }
    *(uint4*)dst = make_uint4(ow[0], ow[1], ow[2], ow[3]);
}
DEV void conv_tap(float (&acc)[8], const uint4& v, const float (&w)[8]) {
    acc[0] += bf_lo(v.x) * w[0]; acc[1] += bf_hi(v.x) * w[1]; acc[2] += bf_lo(v.y) * w[2]; acc[3] += bf_hi(v.y) * w[3];
    acc[4] += bf_lo(v.z) * w[4]; acc[5] += bf_hi(v.z) * w[5]; acc[6] += bf_lo(v.w) * w[6]; acc[7] += bf_hi(v.w) * w[7];
}
DEV void phase_gla_conv(const Params& p) {
    const int tid = tid_opaque();
    unsigned char* ws = p.ws;
    const bf16_t* z = (const bf16_t*)(ws + WS_S + 1 * U_BYTES);
    bf16_t* o = (bf16_t*)(ws + WS_S + 4 * U_BYTES);
    const float* cw = p.in[25];
    const int x = tid >> 3, cl = (tid & 7) * 8;
    for (int task = blockIdx.x; task < 8 * 32; task += gridDim.x) {
        const int cb = task & 31, b = task >> 5;
        const int c = cb * 64 + cl;
        float w[9][8];
#pragma unroll
        for (int t = 0; t < 9; ++t) { const float4 w0 = *(const float4*)(cw + t * 2048 + c), w1 = *(const float4*)(cw + t * 2048 + c + 4); w[t][0] = w0.x; w[t][1] = w0.y; w[t][2] = w0.z; w[t][3] = w0.w; w[t][4] = w1.x; w[t][5] = w1.y; w[t][6] = w1.z; w[t][7] = w1.w; }
        const uint4 zero4 = make_uint4(0, 0, 0, 0);
        auto load_row = [&](int y, uint4 (&r)[3]) {
            if (y < 0 || y >= 128) { r[0] = zero4; r[1] = zero4; r[2] = zero4; return; }
            const bf16_t* row = z + ((size_t)b * 8192 + (size_t)y * 64 + x) * 2048 + c;
            r[1] = *(const uint4*)row;
            r[0] = (x > 0) ? *(const uint4*)(row - 2048) : zero4;
            r[2] = (x < 63) ? *(const uint4*)(row + 2048) : zero4;
        };
        uint4 r0[3], r1[3], r2[3], r3[3], r4[3];
        const int y0 = 0;
        load_row(y0 - 1, r0); load_row(y0, r1); load_row(y0 + 1, r2); load_row(y0 + 2, r3);
#pragma unroll 1
        for (int yy = 0; yy < 128; ++yy) {
            load_row(y0 + yy + 3, r4);
            float acc[8];
#pragma unroll
            for (int j = 0; j < 8; ++j) acc[j] = 0.f;
#pragma unroll
            for (int dx = 0; dx < 3; ++dx) { conv_tap(acc, r0[dx], w[dx]); conv_tap(acc, r1[dx], w[3 + dx]); conv_tap(acc, r2[dx], w[6 + dx]); }
            conv_emit(acc, c, o + ((size_t)b * 8192 + (size_t)(y0 + yy) * 64 + x) * 2048 + c);
#pragma unroll
            for (int dx = 0; dx < 3; ++dx) { r0[dx] = r1[dx]; r1[dx] = r2[dx]; r2[dx] = r3[dx]; r3[dx] = r4[dx]; }
        }
    }
    for (int task = blockIdx.x; task < (NC / 64) * 8; task += gridDim.x) {
        const int rb = task >> 3, cbk = task & 7;
        const int R = NL + rb * 64 + (tid >> 3);
        const int t = (R - NL) & 255;
#pragma unroll 1
        for (int i = 0; i < 4; ++i) {
            const int c = cbk * 256 + (tid & 7) * 8 + i * 64;
            float acc[8];
#pragma unroll
            for (int j = 0; j < 8; ++j) acc[j] = 0.f;
#pragma unroll
            for (int dx = -1; dx <= 1; ++dx) {
                if (t + dx >= 0 && t + dx < 256) {
                    const uint4 v = *(const uint4*)(z + (size_t)(R + dx) * 2048 + c);
                    const float* wp = cw + (3 + (dx + 1)) * 2048 + c;
                    const float4 w0 = *(const float4*)wp, w1 = *(const float4*)(wp + 4);
                    const float wv[8] = {w0.x, w0.y, w0.z, w0.w, w1.x, w1.y, w1.z, w1.w};
                    conv_tap(acc, v, wv);
                }
            }
            conv_emit(acc, c, o + (size_t)R * 2048 + c);
        }
    }
}

constexpr int GT_QE = 0, GT_KET = 16384, GT_A = 32768, GT_CONST = 40960, GT_STRIDE = 43008;
constexpr int GT_N0 = (int)((2 * U_BYTES) / GT_STRIDE);
constexpr size_t WS_TOTAL = 1073741824ull;
static_assert((size_t)(NB * 4 * 2 * 132 - GT_N0) * GT_STRIDE <= WS_TOTAL - WS_END, "tile records do not fit");
DEV size_t gla_tile_off(int b, int hd, int d, int cc) {
    const int idx = (((b * 4 + hd) * 2 + d) * 132) + cc;
    return idx < GT_N0 ? WS_S + (size_t)idx * GT_STRIDE : WS_END + (size_t)(idx - GT_N0) * GT_STRIDE;
}
DEV int gla_row0(int b, int cc) { return cc < 4 ? NL + b * 256 + cc * 64 : b * 8192 + (cc - 4) * 64; }
DEV void phase_gla_prep(const Params& p, unsigned char* lds) {
    const int tid = tid_opaque(), lane = tid & 63, wv = tid >> 6;
    const int fr = lane & 15, fq = lane >> 4;
    unsigned char* ws = p.ws;
    constexpr int QE = 0, KE = 16384, KET = 32768, BC = 49152  , GS = 82944  , LRL = 86528  , BCS = 132;
    const bf16_t* qkv = (const bf16_t*)(ws + WS_S + 4 * U_BYTES);
    const float* lrb = (const float*)(ws + WS_LR);
    unsigned char* gt = ws;
    float* bc = (float*)(lds + BC);
    float* gs = (float*)(lds + GS);
    const int li = tid >> 3, lc = tid & 7;
    const int d = blockIdx.x & 1, hd = (blockIdx.x >> 1) & 3;
    bf16x8 gkf;
    {
        unsigned w4[4] = {0u, 0u, 0u, 0u};
        if (fq < 2) {
#pragma unroll
            for (int e2 = 0; e2 < 4; ++e2) {
                const float g0 = p.in[26][(size_t)(d * 16 + 8 * fq + 2 * e2) * 512 + hd * 128 + wv * 16 + fr];
                const float g1 = p.in[26][(size_t)(d * 16 + 8 * fq + 2 * e2 + 1) * 512 + hd * 128 + wv * 16 + fr];
                w4[e2] = pk_bf16(g0, g1);
            }
        }
        gkf = as_bf16x8(make_uint4(w4[0], w4[1], w4[2], w4[3]));
    }
    const float4 gb4 = *(const float4*)(p.in[27] + d * 512 + hd * 128 + wv * 16 + 4 * fq);
    const int qstep = (int)(gridDim.x >> 3);
    uint4 nq0, nq1, nk0, nk1; float2 nl;
    auto fetch = [&](int q) {
        const size_t R = (size_t)(gla_row0(q / 132, q % 132) + li);
        const bf16_t* row = qkv + R * 2048;
        nq0 = *(const uint4*)(row + hd * 128 + lc * 8); nq1 = *(const uint4*)(row + hd * 128 + 64 + lc * 8);
        nk0 = *(const uint4*)(row + 512 + hd * 128 + lc * 8); nk1 = *(const uint4*)(row + 512 + hd * 128 + 64 + lc * 8);
        nl = *(const float2*)(lrb + R * 32 + d * 16 + lc * 2);
    };
    int q = (int)(blockIdx.x >> 3);
    if (q < NB * 132) fetch(q);
    for (; q < NB * 132; q += qstep) {
        const int cc = q % 132, b = q / 132;
        unsigned char* rec = gt + gla_tile_off(b, hd, d, cc);
        const uint4 rq0 = nq0, rq1 = nq1, rk0 = nk0, rk1 = nk1; const float2 rl = nl;
        if (q + qstep < NB * 132) fetch(q + qstep);
        *(unsigned*)(lds + LRL + li * 32 + lc * 4) = pk_bf16(rl.x, rl.y);
        __syncthreads();
        {
            const float gbv[4] = {gb4.x, gb4.y, gb4.z, gb4.w};
#pragma unroll
            for (int itl = 0; itl < 4; ++itl) {
                uint4 lr4 = *(const uint4*)(lds + LRL + (itl * 16 + fr) * 32 + (fq & 1) * 16);
                if (fq >= 2) lr4 = make_uint4(0, 0, 0, 0);
                f32x4 a = {0.f, 0.f, 0.f, 0.f};
                a = __builtin_amdgcn_mfma_f32_16x16x32_bf16(gkf, as_bf16x8(lr4), a, 0, 0, 0);
                float s[4], tot[4];
#pragma unroll
                for (int j = 0; j < 4; ++j) {
                    const float xx = a[j] + gbv[j];
                    const float la = (fminf(xx, 0.f) - __logf(1.0f + __expf(-fabsf(xx)))) * (1.0f / 16.0f);
                    float pf = la;
                    pf += dpp_shr0<1>(pf); pf += dpp_shr0<2>(pf); pf += dpp_shr0<4>(pf); pf += dpp_shr0<8>(pf);
                    tot[j] = __shfl(pf, (lane & 48) | 15);
                    s[j] = d ? (tot[j] - pf + la) : pf;
                }
                *(float4*)(bc + (itl * 16 + fr) * BCS + wv * 16 + 4 * fq) = make_float4(s[0], s[1], s[2], s[3]);
                if (fr == 15) *(float4*)(gs + itl * 128 + wv * 16 + 4 * fq) = make_float4(tot[0], tot[1], tot[2], tot[3]);
            }
        }
        __syncthreads();
        if (tid < 128) {
            const float g0 = gs[tid], g1 = gs[128 + tid], g2 = gs[256 + tid], g3 = gs[384 + tid];
            const float refc = d ? (bc[31 * BCS + tid] + g2 + g3) : (bc[32 * BCS + tid] + g0 + g1), lastc = g0 + g1 + g2 + g3;
            const float dl = __expf(lastc), er = __expf(refc), el = __expf(lastc - refc);
            gs[512 + tid] = refc;
            float* cst = (float*)(rec + GT_CONST);
            cst[tid] = er; cst[128 + tid] = el; cst[256 + tid] = dl;
        }
        __syncthreads();
        {
            const int grp = li >> 4;
            const uint4 rqs[2] = {rq0, rq1}, rks[2] = {rk0, rk1};
#pragma unroll
            for (int hseg = 0; hseg < 2; ++hseg) {
                const int k0 = hseg * 64 + lc * 8;
                float bcv[8], refv[8];
#pragma unroll
                for (int j4 = 0; j4 < 2; ++j4) {
                    const float4 g0 = *(const float4*)(gs + k0 + j4 * 4), g1 = *(const float4*)(gs + 128 + k0 + j4 * 4);
                    const float4 g2 = *(const float4*)(gs + 256 + k0 + j4 * 4), g3 = *(const float4*)(gs + 384 + k0 + j4 * 4);
                    const float4 bi = *(const float4*)(bc + li * BCS + k0 + j4 * 4), rf = *(const float4*)(gs + 512 + k0 + j4 * 4);
                    const float g0a[4] = {g0.x, g0.y, g0.z, g0.w}, g1a[4] = {g1.x, g1.y, g1.z, g1.w}, g2a[4] = {g2.x, g2.y, g2.z, g2.w}, g3a[4] = {g3.x, g3.y, g3.z, g3.w};
                    const float bia[4] = {bi.x, bi.y, bi.z, bi.w}, rfa[4] = {rf.x, rf.y, rf.z, rf.w};
#pragma unroll
                    for (int j = 0; j < 4; ++j) {
                        const float pre = d ? ((grp < 1 ? g1a[j] : 0.f) + (grp < 2 ? g2a[j] : 0.f) + (grp < 3 ? g3a[j] : 0.f))
                                            : ((grp > 0 ? g0a[j] : 0.f) + (grp > 1 ? g1a[j] : 0.f) + (grp > 2 ? g2a[j] : 0.f));
                        bcv[j4 * 4 + j] = bia[j] + pre;
                        refv[j4 * 4 + j] = rfa[j];
                    }
                }
                const unsigned qw[4] = {rqs[hseg].x, rqs[hseg].y, rqs[hseg].z, rqs[hseg].w}, kw[4] = {rks[hseg].x, rks[hseg].y, rks[hseg].z, rks[hseg].w};
                unsigned oqe[4], oke[4];
#pragma unroll
                for (int j2 = 0; j2 < 4; ++j2) {
                    const float q0 = bf_lo(qw[j2]), q1 = bf_hi(qw[j2]), kk0 = bf_lo(kw[j2]), kk1 = bf_hi(kw[j2]);
                    const float e0 = __expf(bcv[2 * j2] - refv[2 * j2]), e1 = __expf(bcv[2 * j2 + 1] - refv[2 * j2 + 1]);
                    const float r0 = __builtin_amdgcn_rcpf(e0), r1 = __builtin_amdgcn_rcpf(e1);
                    oqe[j2] = pk_bf16(q0 * e0, q1 * e1);
                    oke[j2] = pk_bf16(kk0 * r0, kk1 * r1);
                    const int kc0 = k0 + 2 * j2;
                    *(bf16_t*)(lds + KET + tile_off2(kc0, li >> 3) + (li & 7) * 2) = (bf16_t)(oke[j2] & 0xffffu);
                    *(bf16_t*)(lds + KET + tile_off2(kc0 + 1, li >> 3) + (li & 7) * 2) = (bf16_t)(oke[j2] >> 16);
                }
                const int chq = hseg * 8 + lc;
                const int so = li * 256 + ((chq ^ (li & 15)) << 4);
                *(uint4*)(lds + QE + so) = make_uint4(oqe[0], oqe[1], oqe[2], oqe[3]);
                *(uint4*)(lds + KE + so) = make_uint4(oke[0], oke[1], oke[2], oke[3]);
                *(uint4*)(rec + GT_QE + so) = make_uint4(oqe[0], oqe[1], oqe[2], oqe[3]);
            }
        }
        __syncthreads();
        {
            const int it = wv & 3, pr2 = wv >> 2;
#pragma unroll
            for (int jj = 0; jj < 2; ++jj) {
                const int jt = pr2 * 2 + jj;
                f32x4 a = {0.f, 0.f, 0.f, 0.f};
                if (d ? (jt >= it) : (jt <= it)) {
#pragma unroll
                    for (int ks = 0; ks < 4; ++ks) {
                        const int ch = ks * 4 + fq;
                        const int rj = jt * 16 + fr, ri = it * 16 + fr;
                        const bf16x8 fa = *(const bf16x8*)(lds + KE + rj * 256 + ((ch ^ (rj & 15)) << 4));
                        const bf16x8 fb = *(const bf16x8*)(lds + QE + ri * 256 + ((ch ^ (ri & 15)) << 4));
                        a = __builtin_amdgcn_mfma_f32_16x16x32_bf16(fa, fb, a, 0, 0, 0);
                    }
                }
                const int i = it * 16 + fr, j = jt * 16 + 4 * fq;
                float av[4];
#pragma unroll
                for (int e = 0; e < 4; ++e) av[e] = (d ? (j + e >= i) : (j + e <= i)) ? a[e] : 0.f;
                *(uint2*)(rec + GT_A + i * 128 + (((j >> 3) ^ (i & 7)) << 4) + (j & 7) * 2) = make_uint2(pk_bf16(av[0], av[1]), pk_bf16(av[2], av[3]));
            }
#pragma unroll
            for (int i = 0; i < 2; ++i) *(uint4*)(rec + GT_KET + i * 8192 + tid * 16) = *(const uint4*)(lds + KET + i * 8192 + tid * 16);
        }
        __syncthreads();
    }
}

DEV void phase_gla_scan(const Params& p, unsigned char* lds) {
    const int tid = tid_opaque(), lane = tid & 63, wv = tid >> 6;
    const int fr = lane & 15, fq = lane >> 4;
    unsigned char* ws = p.ws;
    constexpr int QE = 0  , KET = 32768  , AL = 65536  , VT = 81920, ST = 90112  ;
    const bf16_t* qkv = (const bf16_t*)(ws + WS_S + 4 * U_BYTES);
    const unsigned char* gt = ws;
    for (int unit = blockIdx.x; unit < 256; unit += gridDim.x) {
        const int vs = unit & 3, d = (unit >> 2) & 1, hd = (unit >> 3) & 3, b = unit >> 5;
        bf16_t* odst = d ? (bf16_t*)(ws + WS_S + 2 * U_BYTES) : (bf16_t*)(ws + WS_S + 4 * U_BYTES);
        const int old_ = d ? 1024 : 2048;
        const int li = tid >> 3, lc = tid & 7;
        auto ccof = [&](int c) -> int { return d ? (c < 4 ? 3 - c : 135 - c) : c; };
        auto dma = [&](int cc, int buf) {
            const unsigned char* rec = gt + gla_tile_off(b, hd, d, cc);
#pragma unroll
            for (int i = 0; i < 2; ++i) {
                __builtin_amdgcn_global_load_lds((const unsigned*)(rec + GT_QE + i * 8192 + tid * 16), (unsigned*)(lds + QE + buf * 16384 + i * 8192 + tid * 16), 16, 0, 0);
                __builtin_amdgcn_global_load_lds((const unsigned*)(rec + GT_KET + i * 8192 + tid * 16), (unsigned*)(lds + KET + buf * 16384 + i * 8192 + tid * 16), 16, 0, 0);
            }
            __builtin_amdgcn_global_load_lds((const unsigned*)(rec + GT_A + tid * 16), (unsigned*)(lds + AL + buf * 8192 + tid * 16), 16, 0, 0);
        };
        uint4 nv; float4 n_dl, n_el, n_er;
        auto loads = [&](int c) {
            const int cc = ccof(c);
            nv = *(const uint4*)(qkv + (size_t)(gla_row0(b, cc) + li) * 2048 + 1024 + hd * 256 + vs * 64 + lc * 8);
            const float* cst = (const float*)(gt + gla_tile_off(b, hd, d, cc) + GT_CONST);
            n_el = *(const float4*)(cst + 128 + wv * 16 + 4 * fq); n_dl = *(const float4*)(cst + 256 + wv * 16 + 4 * fq);
            if (c + 1 < 132) n_er = *(const float4*)((const float*)(gt + gla_tile_off(b, hd, d, ccof(c + 1)) + GT_CONST) + wv * 16 + 4 * fq);
            else n_er = make_float4(0.f, 0.f, 0.f, 0.f);
        };
        f32x4 accS[4];
#pragma unroll
        for (int i = 0; i < 4; ++i) accS[i] = (f32x4){0.f, 0.f, 0.f, 0.f};
        for (int i = tid; i < 32768 / 16; i += NTHREADS) *(uint4*)(lds + ST + i * 16) = make_uint4(0, 0, 0, 0);
        dma(ccof(0), 0);
        loads(0);
        for (int c = 0; c < 132; ++c) {
            const int buf = c & 1, cc = ccof(c);
            const uint4 rv = nv; const float4 dl4 = n_dl, el4 = n_el, er4 = n_er;
            asm volatile("s_waitcnt vmcnt(0)" ::: "memory");
            {
                const unsigned vw[4] = {rv.x, rv.y, rv.z, rv.w};
#pragma unroll
                for (int j2 = 0; j2 < 4; ++j2) {
                    const int vc0 = lc * 8 + 2 * j2;
                    *(bf16_t*)(lds + VT + tile_off2(vc0, li >> 3) + (li & 7) * 2) = (bf16_t)(vw[j2] & 0xffffu);
                    *(bf16_t*)(lds + VT + tile_off2(vc0 + 1, li >> 3) + (li & 7) * 2) = (bf16_t)(vw[j2] >> 16);
                }
            }
            asm volatile("s_waitcnt lgkmcnt(0)" ::: "memory"); __builtin_amdgcn_s_barrier(); asm volatile("" ::: "memory");
            if (c + 1 < 132) { dma(ccof(c + 1), buf ^ 1); loads(c + 1); }
            const int it = wv & 3, pr2 = wv >> 2;
            const int r0 = gla_row0(b, cc);
#pragma unroll
            for (int vv = 0; vv < 2; ++vv) {
                const int vt = pr2 * 2 + vv;
                f32x4 a = {0.f, 0.f, 0.f, 0.f};
#pragma unroll
                for (int ks = 0; ks < 4; ++ks) {
                    const int ch = ks * 4 + fq;
                    const int rvv = vt * 16 + fr, ri = it * 16 + fr;
                    const bf16x8 fa = *(const bf16x8*)(lds + ST + buf * 16384 + rvv * 256 + ((ch ^ (rvv & 15)) << 4));
                    const bf16x8 fb = *(const bf16x8*)(lds + QE + buf * 16384 + ri * 256 + ((ch ^ (ri & 15)) << 4));
                    a = __builtin_amdgcn_mfma_f32_16x16x32_bf16(fa, fb, a, 0, 0, 0);
                }
#pragma unroll
                for (int ks = 0; ks < 2; ++ks) {
                    const int ch = ks * 4 + fq;
                    const int rvv = vt * 16 + fr, ri = it * 16 + fr;
                    const bf16x8 fa = *(const bf16x8*)(lds + VT + tile_off2(rvv, ch));
                    const bf16x8 fb = *(const bf16x8*)(lds + AL + buf * 8192 + ri * 128 + ((ch ^ (ri & 7)) << 4));
                    a = __builtin_amdgcn_mfma_f32_16x16x32_bf16(fa, fb, a, 0, 0, 0);
                }
                const int i = it * 16 + fr, vcol = vt * 16 + 4 * fq;
                *(uint2*)(odst + (size_t)(r0 + i) * old_ + hd * 256 + vs * 64 + vcol) = make_uint2(pk_bf16(a[0], a[1]), pk_bf16(a[2], a[3]));
            }
            {
                const int kt = wv;
                bf16x8 fa[2];
#pragma unroll
                for (int ks = 0; ks < 2; ++ks) fa[ks] = *(const bf16x8*)(lds + KET + buf * 16384 + tile_off2(kt * 16 + fr, ks * 4 + fq));
#pragma unroll
                for (int vt = 0; vt < 4; ++vt) {
                    f32x4 t = {0.f, 0.f, 0.f, 0.f};
#pragma unroll
                    for (int ks = 0; ks < 2; ++ks) t = __builtin_amdgcn_mfma_f32_16x16x32_bf16(fa[ks], *(const bf16x8*)(lds + VT + tile_off2(vt * 16 + fr, ks * 4 + fq)), t, 0, 0, 0);
                    f32x4 a = accS[vt];
                    a[0] = a[0] * dl4.x + t[0] * el4.x; a[1] = a[1] * dl4.y + t[1] * el4.y; a[2] = a[2] * dl4.z + t[2] * el4.z; a[3] = a[3] * dl4.w + t[3] * el4.w;
                    accS[vt] = a;
                    const int vcol = vt * 16 + fr, kcol = kt * 16 + 4 * fq;
                    *(uint2*)(lds + ST + (buf ^ 1) * 16384 + vcol * 256 + (((kcol >> 3) ^ (vcol & 15)) << 4) + (kcol & 7) * 2) =
                        make_uint2(pk_bf16(a[0] * er4.x, a[1] * er4.y), pk_bf16(a[2] * er4.z, a[3] * er4.w));
                }
            }
            asm volatile("s_waitcnt lgkmcnt(0)" ::: "memory"); __builtin_amdgcn_s_barrier(); asm volatile("" ::: "memory");
        }
        asm volatile("s_waitcnt vmcnt(0)" ::: "memory");
        __syncthreads();
    }
}

DEV void phase_gla_readout(const Params& p) {
    const int tid = tid_opaque(), lane = tid & 63;
    const int gw = blockIdx.x * 8 + (tid >> 6), nw = gridDim.x * 8;
    unsigned char* ws = p.ws;
    const bf16_t* o0 = (const bf16_t*)(ws + WS_S + 4 * U_BYTES);
    const bf16_t* o1 = (const bf16_t*)(ws + WS_S + 2 * U_BYTES);
    const bf16_t* gb = (const bf16_t*)(ws + WS_S + 3 * U_BYTES);
    bf16_t* ao = (bf16_t*)(ws + WS_S + 0 * U_BYTES);
    const float4 hn = *(const float4*)(p.in[28] + lane * 4);
    for (int item0 = gw; item0 < NL * 4; item0 += 4 * nw) {
        uint2 a[4], b2[4], g2[4];
#pragma unroll
        for (int q = 0; q < 4; ++q) {
            const int item = min(item0 + q * nw, NL * 4 - 1);
            const size_t off = (size_t)(item >> 2) * 1024 + (item & 3) * 256 + lane * 4;
            a[q] = *(const uint2*)(o0 + off + (size_t)(item >> 2) * 1024); b2[q] = *(const uint2*)(o1 + off); g2[q] = *(const uint2*)(gb + off);
        }
        float v[4][4], ss[4];
#pragma unroll
        for (int q = 0; q < 4; ++q) {
            v[q][0] = bf_lo(a[q].x) + bf_lo(b2[q].x); v[q][1] = bf_hi(a[q].x) + bf_hi(b2[q].x); v[q][2] = bf_lo(a[q].y) + bf_lo(b2[q].y); v[q][3] = bf_hi(a[q].y) + bf_hi(b2[q].y);
            ss[q] = v[q][0] * v[q][0] + v[q][1] * v[q][1] + v[q][2] * v[q][2] + v[q][3] * v[q][3];
        }
#pragma unroll
        for (int q = 0; q < 4; ++q) ss[q] = wave_allreduce(ss[q]);
#pragma unroll
        for (int q = 0; q < 4; ++q) {
            const int item = item0 + q * nw;
            if (item < NL * 4) {
                const size_t off = (size_t)(item >> 2) * 1024 + (item & 3) * 256 + lane * 4;
                const float rs = rsqrtf(ss[q] * (1.0f / 256.0f) + 1e-6f);
                const float g0 = bf_lo(g2[q].x), g1 = bf_hi(g2[q].x), g2f = bf_lo(g2[q].y), g3 = bf_hi(g2[q].y);
                const float r0 = v[q][0] * rs * hn.x * (g0 * sigmoidf_(g0)), r1 = v[q][1] * rs * hn.y * (g1 * sigmoidf_(g1));
                const float r2 = v[q][2] * rs * hn.z * (g2f * sigmoidf_(g2f)), r3 = v[q][3] * rs * hn.w * (g3 * sigmoidf_(g3));
                *(uint2*)(ao + off) = make_uint2(pk_bf16(r0, r1), pk_bf16(r2, r3));
            }
        }
    }
}


#define XB_TMO      128
#define XB_XCNT(j)  (256  + 64 * (j))
#define XB_XSUB(j)  (1280 + 64 * (j))
#define XB_XGEN(j)  (2304 + 64 * (j))
#define XB_TOP      3328
#define XB_TOPGEN   3392
#define XB_SPIN_CAP (1u << 22)
DEV unsigned xb_ld(unsigned* p) { return __hip_atomic_load(p, __ATOMIC_RELAXED, __HIP_MEMORY_SCOPE_AGENT); }
DEV unsigned xb_add(unsigned* p, unsigned v) { return __hip_atomic_fetch_add(p, v, __ATOMIC_RELAXED, __HIP_MEMORY_SCOPE_AGENT); }
DEV unsigned xb_xcc_id() { return (unsigned)__builtin_amdgcn_s_getreg((3 << 11) | 20) & 0xFu; }
#define XB_SPIN(cond, bar) do { unsigned _sp = 0; while (cond) { __builtin_amdgcn_s_sleep(1); \
    if ((++_sp & 255u) == 0u) { if (xb_ld(&(bar)[XB_TMO])) break; if (_sp > XB_SPIN_CAP) { atomicAdd(&(bar)[XB_TMO], 1u); break; } } } } while (0)
DEV void xcd_barrier_complete(unsigned* bar, unsigned x, unsigned& nloc, unsigned& nx) {
    const unsigned G = gridDim.x;
    unsigned sum, cnt, mine, sp = 0u;
    for (;;) {
        sum = 0u; cnt = 0u; mine = 0u;
#pragma unroll
        for (unsigned j = 0; j < 16; ++j) { const unsigned c = xb_ld(&bar[XB_XCNT(j)]); sum += c; cnt += (c > 0u) ? 1u : 0u; mine = (j == x) ? c : mine; }
        if (sum == G) break;
        __builtin_amdgcn_s_sleep(1);
        if ((++sp & 255u) == 0u) { if (xb_ld(&bar[XB_TMO])) break; if (sp > XB_SPIN_CAP) { atomicAdd(&bar[XB_TMO], 1u); break; } }
    }
    nloc = mine > 0u ? mine : 1u; nx = cnt > 0u ? cnt : 1u;
}
DEV void xcd_barrier(unsigned* bar, volatile LAS3 unsigned* st) {
    asm volatile("s_waitcnt vmcnt(0)" ::: "memory");
    __syncthreads();
    if (tid_opaque() == 0) {
        const unsigned x = xb_xcc_id();
        __builtin_amdgcn_s_waitcnt(0);
        unsigned nloc = st[0], nx = st[1];
        if (nloc == 0u) { xcd_barrier_complete(bar, x, nloc, nx); st[0] = nloc; st[1] = nx; }
        const unsigned old = xb_add(&bar[XB_XSUB(x)], 1u);
        const unsigned gen = old / nloc;
        if (old + 1u == (gen + 1u) * nloc) {
            __builtin_amdgcn_fence(__ATOMIC_RELEASE, "agent");
            asm volatile("s_waitcnt vmcnt(0)" ::: "memory");
            const unsigned og = xb_add(&bar[XB_TOP], 1u);
            const unsigned tg = og / nx;
            if (og + 1u == (tg + 1u) * nx) xb_add(&bar[XB_TOPGEN], 1u);
            else XB_SPIN(xb_ld(&bar[XB_TOPGEN]) == tg, bar);
            __builtin_amdgcn_fence(__ATOMIC_ACQUIRE, "agent");
            xb_add(&bar[XB_XGEN(x)], 1u);
            asm volatile("s_waitcnt vmcnt(0)" ::: "memory");
        } else {
            XB_SPIN(xb_ld(&bar[XB_XGEN(x)]) == gen, bar);
            __builtin_amdgcn_fence(__ATOMIC_ACQUIRE, "agent");
            asm volatile("s_waitcnt vmcnt(0)" ::: "memory");
        }
    }
    __syncthreads();
}
#define SYNC() do { asm volatile("s_waitcnt vmcnt(0)" ::: "memory"); grid.sync(); \
    if (tid_opaque() == 0) { __builtin_amdgcn_fence(__ATOMIC_ACQUIRE, "agent"); asm volatile("s_waitcnt vmcnt(0)" ::: "memory"); } \
    __syncthreads(); } while (0)
__global__ void __launch_bounds__(NTHREADS) mega_fwd(Params p) {
    unsigned char* const lds = g_lds;
    cg::grid_group grid = cg::this_grid();
#define XBAR ((unsigned*)(p.ws + WS_BAR))
#define XST ((volatile LAS3 unsigned*)(lds + LDS_BYTES - 16))
    if ((threadIdx.x & 63) == 0) g_lds[LDS_WTAB + hw_wave_slot()] = (unsigned char)(threadIdx.x >> 6);
    if (threadIdx.x == 0) { XST[0] = 0u; XST[1] = 0u; (void)xb_add(&XBAR[XB_XCNT(xb_xcc_id())], 1u); }
    __syncthreads();
#define S0 ((bf16_t*)(p.ws + WS_S + 0 * U_BYTES))
#define SLOT(i) ((bf16_t*)(p.ws + WS_S + (size_t)(i) * U_BYTES))
#define S1 ((bf16_t*)(p.ws + WS_S + 1 * U_BYTES))
#define CTXR ((const float*)(p.ws + WS_CTXR))
    phase0(p, lds); SYNC();
#undef SYNC
#define SYNC() xcd_barrier(XBAR, XST)
    phase_normmix(p, S0, SLOT(5), SLOT(1), SLOT(2)); SYNC();
    phase_rw_proj1(p, lds, 0, SLOT(5), SLOT(3), 1); SYNC();
    phase_rw_proj1(p, lds, 1, SLOT(1), SLOT(5), 1); SYNC();
    phase_rw_proj1(p, lds, 2, SLOT(2), SLOT(1), 0); phase_rw_lora(p, lds, SLOT(2), SLOT(1)); SYNC();
    REPEAT(3, phase_rw_scan(p, lds));
    phase_rw_scan(p, lds); SYNC();
    REPEAT(4, phase_rw_readout(p));
    phase_rw_readout(p); SYNC();
    REPEAT(5, phase_wo(p, lds, 0));
    phase_wo(p, lds, 0); SYNC();
    REPEAT(6, phase_normmod(p, 0, 1, p.out, CTXR, NT, S1, (unsigned char*)SLOT(2)));
    phase_normmod(p, 0, 1, p.out, CTXR, NT, S1, (unsigned char*)SLOT(2)); SYNC();
    REPEAT(7, phase_peer_select(p, lds, 0));
    phase_peer_select(p, lds, 0); SYNC();
    phase_peer_u(p, lds, 0); SYNC();
    phase_peer_c(p, 0); SYNC();
    phase_peer_v(p, 0); SYNC();
    phase_normmod(p, 1, 0, p.out, CTXR, NT, S0, nullptr); SYNC();
    REPEAT(9, phase_gla_proj(p, lds));
    phase_gla_proj(p, lds); SYNC();
    REPEAT(10, phase_gla_conv(p));
    phase_gla_conv(p); SYNC();
    REPEAT(18, phase_gla_prep(p, lds));
    phase_gla_prep(p, lds); SYNC();
    REPEAT(11, phase_gla_scan(p, lds));
    phase_gla_scan(p, lds); SYNC();
    REPEAT(12, phase_gla_readout(p));
    phase_gla_readout(p); SYNC();
    phase_wo(p, lds, 1); SYNC();
    REPEAT(14, phase_normmod(p, 1, 1, p.out, CTXR, NL, S0, (unsigned char*)SLOT(2)));
    phase_normmod(p, 1, 1, p.out, CTXR, NL, S0, (unsigned char*)SLOT(2)); SYNC();
    REPEAT(15, phase_peer_select(p, lds, 1));
    phase_peer_select(p, lds, 1); SYNC();
    phase_peer_u(p, lds, 1); SYNC();
    phase_peer_c(p, 1); SYNC();
    phase_peer_v(p, 1); SYNC();
    phase_final_norm(p);
}

extern "C" void kernel_launch(void* const* d_in, const int* in_sizes, int n_in, void* d_out, int out_size, void* d_ws, size_t ws_size, hipStream_t stream) {
    static int grid_blocks = 0;
    if (grid_blocks == 0) {
        if (n_in != 35 || ws_size < WS_TOTAL) { fprintf(stderr, "kernel_launch: unexpected n_in %d or ws_size %zu (< %zu)\n", n_in, ws_size, (size_t)WS_END); grid_blocks = -1; return; }
        int dev = 0, cus = 0, per_cu = 0;
        if (hipGetDevice(&dev) != hipSuccess || hipDeviceGetAttribute(&cus, hipDeviceAttributeMultiprocessorCount, dev) != hipSuccess) { fprintf(stderr, "kernel_launch: device query failed\n"); grid_blocks = -1; return; }
        if (hipFuncSetAttribute((const void*)mega_fwd, hipFuncAttributeMaxDynamicSharedMemorySize, LDS_BYTES) != hipSuccess) { fprintf(stderr, "kernel_launch: hipFuncSetAttribute failed\n"); grid_blocks = -1; return; }
        if (hipOccupancyMaxActiveBlocksPerMultiprocessor(&per_cu, (const void*)mega_fwd, NTHREADS, LDS_BYTES) != hipSuccess || per_cu < 1) { fprintf(stderr, "kernel_launch: occupancy query says %d blocks per CU\n", per_cu); grid_blocks = -1; return; }
        grid_blocks = cus;
    }
    if (grid_blocks < 0) return;
    Params p{};
    for (int i = 0; i < 35; ++i) p.in[i] = (const float*)d_in[i];
    p.out = (float*)d_out;
    p.ws = (unsigned char*)d_ws;
    if (hipMemsetAsync((char*)d_ws + WS_BAR, 0, 16384, stream) != hipSuccess) { fprintf(stderr, "kernel_launch: hipMemsetAsync failed\n"); return; }
    void* args[] = {&p};
    hipError_t e = hipLaunchCooperativeKernel((const void*)mega_fwd, dim3(grid_blocks), dim3(NTHREADS), args, LDS_BYTES, stream);
    if (e != hipSuccess) fprintf(stderr, "kernel_launch: cooperative launch failed: %s (grid %d)\n", hipGetErrorString(e), grid_blocks);
}
```

```cpp
#include <hip/hip_runtime.h>
#include <hip/hip_cooperative_groups.h>
#include <cstdio>
#include <cstdint>
namespace cg = cooperative_groups;

#define DEV __device__ __forceinline__
#ifndef REP
#define REP 0
#endif
#define GREPS(n) ((REP == (n)) ? 2 : 1)
#define REPEAT(n, stmt) do { if (REP == (n)) { stmt; SYNC(); } } while (0)

typedef unsigned short bf16_t;
typedef short bf16x8 __attribute__((ext_vector_type(8)));
typedef float f32x4 __attribute__((ext_vector_type(4)));
typedef __bf16 bf16x2v __attribute__((ext_vector_type(2)));

constexpr int D = 1024;
constexpr int NB = 8, SEQ = 8192, CTXL = 256;
constexpr int NL = NB * SEQ, NC = NB * CTXL, NT = NL + NC;
constexpr int NTHREADS = 512;
constexpr int LDS_BYTES = 160 * 1024;

constexpr size_t U_BYTES = (size_t)NT * 1024 * 2;
constexpr size_t WS_BAR = 0;
constexpr size_t WS_MOD = 16384;
constexpr size_t WS_CTXR = WS_MOD + (size_t)2 * 9 * 6144 * 4;
constexpr size_t WS_LR = WS_CTXR + (size_t)NC * 1024 * 4;
constexpr size_t WS_BONUS = WS_LR + (size_t)NT * 32 * 4;
constexpr size_t WS_WPROJ = WS_BONUS + (size_t)2 * NT * 16 * 4;
constexpr size_t WS_W2T = WS_WPROJ + (size_t)3456 * 1024 * 2;
constexpr size_t WS_A2T = WS_W2T + (size_t)2 * 1024 * 64 * 2;
constexpr size_t WS_G2T = WS_A2T + (size_t)2 * 1024 * 64 * 2;
constexpr size_t WS_WO0 = WS_G2T + (size_t)1024 * 128 * 2;
constexpr size_t WS_WO1 = WS_WO0 + (size_t)1024 * 1024 * 2;
constexpr size_t WS_WQ = WS_WO1 + (size_t)1024 * 1024 * 2;
constexpr size_t WS_KEYS = WS_WQ + (size_t)2 * 2048 * 1024 * 2;
constexpr size_t WS_WIN = WS_KEYS + (size_t)2 * 8 * 2 * 128 * 128 * 2;
constexpr size_t WS_PU = WS_WIN + (size_t)3200 * 1024 * 2;
constexpr size_t WS_PV = WS_PU + (size_t)2 * 16384 * 1024;
constexpr size_t WS_PSC = WS_PV + (size_t)2 * 16384 * 1024;
constexpr size_t WS_S = WS_PSC + (size_t)2 * 2 * 16384 * 4;
constexpr size_t WS_END = WS_S + 6 * U_BYTES;
static_assert(WS_END <= 1073741824ull, "workspace too large");
static_assert((WS_CTXR % 256) == 0 && (WS_WPROJ % 256) == 0 && (WS_S % 256) == 0, "alignment");

struct Params {
    const float* in[35];
    float* out;
    unsigned char* ws;
    int pad0, pad1;
};

DEV float bf_lo(unsigned u) { return __uint_as_float(u << 16); }
DEV float bf_hi(unsigned u) { return __uint_as_float(u & 0xffff0000u); }
typedef float f32x2v __attribute__((ext_vector_type(2)));
typedef unsigned int u32x2v __attribute__((ext_vector_type(2)));
typedef short s16x4v __attribute__((ext_vector_type(4)));
DEV unsigned pk_bf16(float lo, float hi) { const f32x2v f = {lo, hi}; union { bf16x2v v; unsigned u; } x; x.v = __builtin_convertvector(f, bf16x2v); return x.u; }
template <int N> DEV float dpp_ror(float x) { return __int_as_float(__builtin_amdgcn_update_dpp(0, __float_as_int(x), 0x120 + N, 0xF, 0xF, false)); }
DEV float row16_allreduce(float x) { x += dpp_ror<8>(x); x += dpp_ror<4>(x); x += dpp_ror<2>(x); x += dpp_ror<1>(x); return x; }
DEV float wave_allreduce(float x) { x = row16_allreduce(x); x += __shfl_xor(x, 16); x += __shfl_xor(x, 32); return x; }
DEV float sigmoidf_(float x) { return __builtin_amdgcn_rcpf(1.0f + __expf(-x)); }
DEV float softplusf_(float z) { return fmaxf(z, 0.f) + __logf(1.0f + __expf(-fabsf(z))); }
DEV unsigned mono_u32(float f) { unsigned u = __float_as_uint(f); return u ^ ((u >> 31) ? 0xFFFFFFFFu : 0x80000000u); }
DEV float unmono_u32(unsigned k) { unsigned u = (k & 0x80000000u) ? (k ^ 0x80000000u) : ~k; return __uint_as_float(u); }
DEV bf16x8 as_bf16x8(uint4 v) { union { uint4 u; bf16x8 b; } x; x.u = v; return x.b; }
#define LAS3 __attribute__((address_space(3)))
extern __shared__ __attribute__((aligned(16))) unsigned char g_lds[];
constexpr int LDS_WTAB = LDS_BYTES - 128;
DEV unsigned hw_wave_slot() { return (unsigned)__builtin_amdgcn_s_getreg((5 << 11) | 4) & 63u; }
DEV int tid_opaque() {
    const int wv = (int)*(const volatile unsigned char*)(g_lds + LDS_WTAB + hw_wave_slot());
    int t = (wv << 6) | (int)__builtin_amdgcn_mbcnt_hi(~0u, __builtin_amdgcn_mbcnt_lo(~0u, 0u));
    asm volatile("" : "+v"(t));
    return t;
}
DEV int mod_batch(int R) { return R < NL ? (R >> 13) : 8; }

template <int BN, class AL, class EP>
DEV void gemm_unit(unsigned char* lds, const AL& al, const bf16_t* Bt, int K, int m0, const EP& ep) {
    constexpr int NI = BN / 64;
    constexpr int A_BYTES = 128 * 128;
    constexpr int B_BYTES = BN * 128;
    const int tid = tid_opaque(), lane = tid & 63, wv = tid >> 6, wm = wv >> 2, wn = wv & 3;
    const int fr = lane & 15, fq = lane >> 4;
    unsigned char* sA = lds;
    unsigned char* sB = lds + 2 * A_BYTES;
    f32x4 acc[4][NI];
#pragma unroll
    for (int mi = 0; mi < 4; ++mi)
#pragma unroll
        for (int ni = 0; ni < NI; ++ni) acc[mi][ni] = (f32x4){0.f, 0.f, 0.f, 0.f};
    const int KT = K >> 6;
    const int drow = tid >> 3, dch = (tid & 7) ^ (drow & 7);
    const bf16_t* bsrc = Bt + (size_t)drow * K + dch * 8;
    uint4 ra[2];
    auto stage = [&](int kt, int buf) {
        const int k0 = kt * 64;
#pragma unroll
        for (int i = 0; i < BN / 64; ++i)
            __builtin_amdgcn_global_load_lds((const unsigned*)(bsrc + (size_t)(64 * i) * K + k0), (unsigned*)(sB + buf * B_BYTES + i * 8192 + tid * 16), 16, 0, 0);
        if constexpr (AL::DMA) {
#pragma unroll
            for (int i = 0; i < 2; ++i)
                __builtin_amdgcn_global_load_lds((const unsigned*)(al.A + (size_t)(m0 + drow + 64 * i) * al.lda + k0 + dch * 8), (unsigned*)(sA + buf * A_BYTES + i * 8192 + tid * 16), 16, 0, 0);
        } else {
#pragma unroll
            for (int i = 0; i < 2; ++i) { const int q = tid + 512 * i; ra[i] = al.load(m0 + (q >> 3), k0 + (q & 7) * 8); }
        }
    };
    auto commit = [&](int buf) {
        if constexpr (!AL::DMA) {
#pragma unroll
            for (int i = 0; i < 2; ++i) { const int q = tid + 512 * i, row = q >> 3, ch = q & 7; *(uint4*)(sA + buf * A_BYTES + row * 128 + ((ch ^ (row & 7)) << 4)) = ra[i]; }
        }
    };
    auto compute = [&](int buf) {
        const unsigned char* a_base = sA + buf * A_BYTES;
        const unsigned char* b_base = sB + buf * B_BYTES;
#pragma unroll
        for (int ks = 0; ks < 2; ++ks) {
            bf16x8 af[4], bfr[NI];
            const int ch = ks * 4 + fq;
#pragma unroll
            for (int mi = 0; mi < 4; ++mi) { const int row = wm * 64 + mi * 16 + fr; af[mi] = *(const bf16x8*)(a_base + row * 128 + ((ch ^ (row & 7)) << 4)); }
#pragma unroll
            for (int ni = 0; ni < NI; ++ni) { const int row = wn * (BN / 4) + ni * 16 + fr; bfr[ni] = *(const bf16x8*)(b_base + row * 128 + ((ch ^ (row & 7)) << 4)); }
#pragma unroll
            for (int mi = 0; mi < 4; ++mi)
#pragma unroll
                for (int ni = 0; ni < NI; ++ni) acc[mi][ni] = __builtin_amdgcn_mfma_f32_16x16x32_bf16(bfr[ni], af[mi], acc[mi][ni], 0, 0, 0);
        }
    };
    if constexpr (AL::DMA) {
        constexpr int STG = A_BYTES + B_BYTES;
        auto stage3 = [&](int kt, int b3) {
            const int k0 = kt * 64;
            unsigned char* base = lds + b3 * STG;
#pragma unroll
            for (int i = 0; i < BN / 64; ++i)
                __builtin_amdgcn_global_load_lds((const unsigned*)(bsrc + (size_t)(64 * i) * K + k0), (unsigned*)(base + A_BYTES + i * 8192 + tid * 16), 16, 0, 0);
#pragma unroll
            for (int i = 0; i < 2; ++i)
                __builtin_amdgcn_global_load_lds((const unsigned*)(al.A + (size_t)(m0 + drow + 64 * i) * al.lda + k0 + dch * 8), (unsigned*)(base + i * 8192 + tid * 16), 16, 0, 0);
        };
        auto compute3 = [&](int b3) {
            const unsigned char* a_base = lds + b3 * STG;
            const unsigned char* b_base = a_base + A_BYTES;
#pragma unroll
            for (int ks = 0; ks < 2; ++ks) {
                bf16x8 af[4], bfr[NI];
                const int ch = ks * 4 + fq;
#pragma unroll
                for (int mi = 0; mi < 4; ++mi) { const int row = wm * 64 + mi * 16 + fr; af[mi] = *(const bf16x8*)(a_base + row * 128 + ((ch ^ (row & 7)) << 4)); }
#pragma unroll
                for (int ni = 0; ni < NI; ++ni) { const int row = wn * (BN / 4) + ni * 16 + fr; bfr[ni] = *(const bf16x8*)(b_base + row * 128 + ((ch ^ (row & 7)) << 4)); }
#pragma unroll
                for (int mi = 0; mi < 4; ++mi)
#pragma unroll
                    for (int ni = 0; ni < NI; ++ni) acc[mi][ni] = __builtin_amdgcn_mfma_f32_16x16x32_bf16(bfr[ni], af[mi], acc[mi][ni], 0, 0, 0);
            }
        };
        stage3(0, 0);
        stage3(1, 1);
        int b3 = 0;
        for (int kt = 0; kt < KT; ++kt) {
            if (kt + 1 < KT) { if constexpr (BN == 256) asm volatile("s_waitcnt vmcnt(6)" ::: "memory"); else asm volatile("s_waitcnt vmcnt(4)" ::: "memory"); }
            else asm volatile("s_waitcnt vmcnt(0)" ::: "memory");
            asm volatile("s_waitcnt lgkmcnt(0)" ::: "memory");
            __builtin_amdgcn_s_barrier();
            asm volatile("" ::: "memory");
            const int bn = (b3 == 0) ? 2 : b3 - 1;
            if (kt + 2 < KT) stage3(kt + 2, bn);
            compute3(b3);
            b3 = (b3 == 2) ? 0 : b3 + 1;
        }
        asm volatile("s_waitcnt lgkmcnt(0)" ::: "memory");
        __builtin_amdgcn_s_barrier();
        asm volatile("" ::: "memory");
    } else {
        stage(0, 0);
        commit(0);
        asm volatile("s_waitcnt vmcnt(0)" ::: "memory");
        __syncthreads();
        for (int kt = 0; kt < KT; ++kt) {
            const int cur = kt & 1;
            const bool more = (kt + 1 < KT);
            if (more) stage(kt + 1, cur ^ 1);
            compute(cur);
            if (more) commit(cur ^ 1);
            asm volatile("s_waitcnt vmcnt(0)" ::: "memory");
            __syncthreads();
        }
    }
    ep(acc, m0, wm, wn, fr, fq);
}

struct ALoadPlain {
    static constexpr bool DMA = true;
    const bf16_t* A; int lda;
    DEV uint4 load(int R, int k) const { return *(const uint4*)(A + (size_t)R * lda + k); }
};
struct ALoadMix {
    static constexpr bool DMA = false;
    const bf16_t* h; const float* mix; const bf16_t* A; int lda;
    DEV uint4 load(int R, int k) const {
        const bf16_t* pc = h + (size_t)R * 1024 + k;
        const uint4 c = *(const uint4*)pc;
        const int t = (R < NL) ? (R & 8191) : ((R - NL) & 255);
        const int last = (R < NL) ? 8191 : 255;
        uint4 pv = *(const uint4*)(pc - (t != 0 ? 1024 : 0)), nv = *(const uint4*)(pc + (t != last ? 1024 : 0));
        if (t == 0) pv = make_uint4(0, 0, 0, 0);
        if (t == last) nv = make_uint4(0, 0, 0, 0);
        const float4 m0 = *(const float4*)(mix + k), m1 = *(const float4*)(mix + k + 4);
        const unsigned cc[4] = {c.x, c.y, c.z, c.w}, pp[4] = {pv.x, pv.y, pv.z, pv.w}, nn[4] = {nv.x, nv.y, nv.z, nv.w};
        const float mm[8] = {m0.x, m0.y, m0.z, m0.w, m1.x, m1.y, m1.z, m1.w};
        unsigned o[4];
#pragma unroll
        for (int i = 0; i < 4; ++i) {
            const float hc0 = bf_lo(cc[i]), hc1 = bf_hi(cc[i]);
            const float s0 = 0.5f * (bf_lo(pp[i]) + bf_lo(nn[i])), s1 = 0.5f * (bf_hi(pp[i]) + bf_hi(nn[i]));
            o[i] = pk_bf16(hc0 + (s0 - hc0) * mm[2 * i], hc1 + (s1 - hc1) * mm[2 * i + 1]);
        }
        return make_uint4(o[0], o[1], o[2], o[3]);
    }
};

struct TrJob { int in_idx, src_off, K, N, src_ld, dst_ld; unsigned long long dst_off; int tile0; };
constexpr int NTRJOBS = 19;
__device__ const TrJob g_trjobs[NTRJOBS] = {
    {9, 0 * 1048576, 1024, 1024, 1024, 1024, WS_WPROJ + 0ull * 1024 * 1024 * 2, 0},
    {9, 1 * 1048576, 1024, 1024, 1024, 1024, WS_WPROJ + 1ull * 1024 * 1024 * 2, 256},
    {9, 2 * 1048576, 1024, 1024, 1024, 1024, WS_WPROJ + 2ull * 1024 * 1024 * 2, 512},
    {11, 0, 1024, 64, 64, 1024, WS_WPROJ + 3072ull * 1024 * 2, 768},
    {11, 65536, 1024, 64, 64, 1024, WS_WPROJ + 3136ull * 1024 * 2, 784},
    {14, 0, 1024, 64, 64, 1024, WS_WPROJ + 3200ull * 1024 * 2, 800},
    {14, 65536, 1024, 64, 64, 1024, WS_WPROJ + 3264ull * 1024 * 2, 816},
    {16, 0, 1024, 128, 128, 1024, WS_WPROJ + 3328ull * 1024 * 2, 832},
    {12, 0, 64, 1024, 1024, 64, WS_W2T, 864},
    {12, 65536, 64, 1024, 1024, 64, WS_W2T + 1024ull * 64 * 2, 880},
    {15, 0, 64, 1024, 1024, 64, WS_A2T, 896},
    {15, 65536, 64, 1024, 1024, 64, WS_A2T + 1024ull * 64 * 2, 912},
    {17, 0, 128, 1024, 1024, 128, WS_G2T, 928},
    {23, 0, 1024, 1024, 1024, 1024, WS_WO0, 960},
    {29, 0, 1024, 1024, 1024, 1024, WS_WO1, 1216},
    {30, 0, 1024, 2048, 2048, 1024, WS_WQ, 1472},
    {30, 2097152, 1024, 2048, 2048, 1024, WS_WQ + 2048ull * 1024 * 2, 1984},
    {24, 0, 1024, 3104, 3104, 1024, WS_WIN, 2496},
    {0, 0, 0, 0, 0, 0, 0, 2496 + 16 * 49},
};
constexpr int NTRTILES = 2496 + 16 * 49;

DEV void phase0(const Params& p, unsigned char* lds) {
    const int tid = tid_opaque();
    unsigned char* ws = p.ws;
    {
        float* sc = (float*)lds;
        float* red = sc + 9 * 1024;
        float* mods = (float*)(ws + WS_MOD);
        bool have_sc = false;
        for (int task = blockIdx.x; task < 192; task += gridDim.x) {
            if (!have_sc) {
                for (int i = tid; i < 9 * 1024; i += NTHREADS) {
                    const int mb = i >> 10, k = i & 1023;
                    const float cv = mb < 8 ? p.in[1][mb * 1024 + k] : p.in[3][k];
                    sc[i] = cv / (1.0f + __expf(-cv));
                }
                have_sc = true;
            }
            __syncthreads();
            const int l = task / 96, nb = task % 96;
            const int nn = tid & 63, kg = tid >> 6;
            const float* w = p.in[4] + (size_t)l * 1024 * 6144 + nb * 64 + nn;
            float acc[9];
#pragma unroll
            for (int m = 0; m < 9; ++m) acc[m] = 0.f;
            for (int k = kg * 128; k < kg * 128 + 128; ++k) {
                const float wv = w[(size_t)k * 6144];
#pragma unroll
                for (int m = 0; m < 9; ++m) acc[m] += sc[m * 1024 + k] * wv;
            }
#pragma unroll
            for (int m = 0; m < 9; ++m) red[(kg * 9 + m) * 64 + nn] = acc[m];
            __syncthreads();
            for (int i = tid; i < 576; i += NTHREADS) {
                const int m = i >> 6, n2 = i & 63;
                float s = p.in[5][l * 6144 + nb * 64 + n2];
#pragma unroll
                for (int g = 0; g < 8; ++g) s += red[(g * 9 + m) * 64 + n2];
                mods[(size_t)(l * 9 + m) * 6144 + nb * 64 + n2] = s;
            }
            __syncthreads();
        }
        __syncthreads();
    }
    {
        float* tile = (float*)lds;
        for (int tt = blockIdx.x; tt < NTRTILES; tt += gridDim.x) {
            int j = 0;
#pragma unroll 1
            while (j + 1 < NTRJOBS && g_trjobs[j + 1].tile0 <= tt) ++j;
            const TrJob jb = g_trjobs[j];
            const int tl = tt - jb.tile0;
            const int ntn = (jb.N + 63) >> 6;
            const int k0 = (tl / ntn) * 64, n0 = (tl % ntn) * 64;
            const float* src = p.in[jb.in_idx] + jb.src_off;
            bf16_t* dst = (bf16_t*)(ws + jb.dst_off);
            {
                const int kr = tid >> 4, nc4 = (tid & 15) * 4;
#pragma unroll
                for (int i = 0; i < 2; ++i) {
                    const int kk = kr + 32 * i;
                    float4 v = make_float4(0.f, 0.f, 0.f, 0.f);
                    if (n0 + nc4 < jb.N) v = *(const float4*)(src + (size_t)(k0 + kk) * jb.src_ld + n0 + nc4);
                    tile[kk * 65 + nc4 + 0] = v.x; tile[kk * 65 + nc4 + 1] = v.y; tile[kk * 65 + nc4 + 2] = v.z; tile[kk * 65 + nc4 + 3] = v.w;
                }
            }
            __syncthreads();
            {
                const int nn = tid >> 3, kc = (tid & 7) * 8;
                if (n0 + nn < jb.N) {
                    unsigned o[4];
#pragma unroll
                    for (int i = 0; i < 4; ++i) o[i] = pk_bf16(tile[(kc + 2 * i) * 65 + nn], tile[(kc + 2 * i + 1) * 65 + nn]);
                    *(uint4*)(dst + (size_t)(n0 + nn) * jb.dst_ld + k0 + kc) = make_uint4(o[0], o[1], o[2], o[3]);
                }
            }
            __syncthreads();
        }
    }
    {
        const size_t gtid = (size_t)blockIdx.x * NTHREADS + tid, gstride = (size_t)gridDim.x * NTHREADS;
        {
            const float* src = p.in[31];
            bf16_t* dst = (bf16_t*)(ws + WS_KEYS);
            const size_t n8 = (size_t)2 * 8 * 2 * 128 * 128 / 8;
            for (size_t i = gtid; i < n8; i += gstride) {
                const float4 a = *(const float4*)(src + i * 8), b = *(const float4*)(src + i * 8 + 4);
                *(uint4*)(dst + i * 8) = make_uint4(pk_bf16(a.x, a.y), pk_bf16(a.z, a.w), pk_bf16(b.x, b.y), pk_bf16(b.z, b.w));
            }
        }
        bf16_t* wpad = (bf16_t*)(ws + WS_WIN) + (size_t)3104 * 1024;
        for (size_t i = gtid; i < (size_t)96 * 1024 / 8; i += gstride) *(uint4*)(wpad + i * 8) = make_uint4(0, 0, 0, 0);
        const int lane = tid & 63;
        const int gw = blockIdx.x * 8 + (tid >> 6), nw = gridDim.x * 8;
        float* scales = (float*)(ws + WS_PSC);
        for (int rowi = gw * 32; rowi < 2 * 32768; rowi += nw * 32)
        for (int row2 = rowi; row2 < rowi + 32; row2 += 4) {
            float4 v[4][4]; float am[4];
#pragma unroll
            for (int q = 0; q < 4; ++q) {
                const int row = row2 + q, tbl = row >> 15, r = row & 32767;
                const float* srow = p.in[32 + tbl] + (size_t)r * 1024;
                am[q] = 0.f;
#pragma unroll
                for (int i = 0; i < 4; ++i) { v[q][i] = *(const float4*)(srow + 16 * lane + 4 * i); am[q] = fmaxf(am[q], fmaxf(fmaxf(fabsf(v[q][i].x), fabsf(v[q][i].y)), fmaxf(fabsf(v[q][i].z), fabsf(v[q][i].w)))); }
            }
#pragma unroll
            for (int o = 1; o < 64; o <<= 1) { const float a0 = __shfl_xor(am[0], o), a1 = __shfl_xor(am[1], o), a2 = __shfl_xor(am[2], o), a3 = __shfl_xor(am[3], o); am[0] = fmaxf(am[0], a0); am[1] = fmaxf(am[1], a1); am[2] = fmaxf(am[2], a2); am[3] = fmaxf(am[3], a3); }
#pragma unroll
            for (int q = 0; q < 4; ++q) {
                const int row = row2 + q, tbl = row >> 15, r = row & 32767;
                const float scale = am[q] > 0.f ? am[q] * (1.0f / 448.0f) : 1.0f;
                const float inv = 1.0f / scale;
                unsigned w[4];
#pragma unroll
                for (int i = 0; i < 4; ++i) {
                    int t = 0;
                    t = __builtin_amdgcn_cvt_pk_fp8_f32(v[q][i].x * inv, v[q][i].y * inv, t, false);
                    t = __builtin_amdgcn_cvt_pk_fp8_f32(v[q][i].z * inv, v[q][i].w * inv, t, true);
                    w[i] = (unsigned)t;
                }
                *(uint4*)(ws + (tbl ? WS_PV : WS_PU) + ((size_t)(r >> 14) * 8 + (lane >> 3)) * (16384 * 128) + (size_t)(r & 16383) * 128 + 16 * (lane & 7)) = make_uint4(w[0], w[1], w[2], w[3]);
                if (lane == 0) scales[tbl * 32768 + r] = scale;
            }
        }
    }
}

DEV void normmod_store(const float4 (&v)[4], float ss, const float* g, const float* shift, const float* scale, bf16_t* dst, unsigned char* xq, int lane) {
    const float rs = rsqrtf(ss * (1.0f / 1024.0f) + 1e-6f);
#pragma unroll
    for (int i = 0; i < 4; ++i) {
        const int col = i * 256 + lane * 4;
        const float4 gg = *(const float4*)(g + col), sh = *(const float4*)(shift + col), sc = *(const float4*)(scale + col);
        const float y0 = v[i].x * rs * gg.x * (1.f + sc.x) + sh.x, y1 = v[i].y * rs * gg.y * (1.f + sc.y) + sh.y;
        const float y2 = v[i].z * rs * gg.z * (1.f + sc.z) + sh.z, y3 = v[i].w * rs * gg.w * (1.f + sc.w) + sh.w;
        *(uint2*)(dst + col) = make_uint2(pk_bf16(y0, y1), pk_bf16(y2, y3));
        if (xq) {
            const float z0 = __builtin_amdgcn_fmed3f(4.f * y0, -448.f, 448.f), z1 = __builtin_amdgcn_fmed3f(4.f * y1, -448.f, 448.f);
            const float z2 = __builtin_amdgcn_fmed3f(4.f * y2, -448.f, 448.f), z3 = __builtin_amdgcn_fmed3f(4.f * y3, -448.f, 448.f);
            int hi = __builtin_amdgcn_cvt_pk_fp8_f32(z0, z1, 0, false); hi = __builtin_amdgcn_cvt_pk_fp8_f32(z2, z3, hi, true);
            const f32x2v h01 = __builtin_amdgcn_cvt_pk_f32_fp8(hi, false), h23 = __builtin_amdgcn_cvt_pk_f32_fp8(hi, true);
            int lo = __builtin_amdgcn_cvt_pk_fp8_f32(z0 - h01.x, z1 - h01.y, 0, false); lo = __builtin_amdgcn_cvt_pk_fp8_f32(z2 - h23.x, z3 - h23.y, lo, true);
            *(int*)(xq + col) = hi; *(int*)(xq + 1024 + col) = lo;
        }
    }
}
DEV void phase_normmod(const Params& p, int layer, int which, const float* xl, const float* xc, int nrows, bf16_t* dst, unsigned char* xq) {
    const int tid = tid_opaque(), lane = tid & 63;
    const int gw = blockIdx.x * 8 + (tid >> 6), nw = gridDim.x * 8;
    const float* mods = (const float*)(p.ws + WS_MOD) + (size_t)layer * 9 * 6144;
    const float* g = p.in[which ? 7 : 6] + layer * 1024;
    for (int R = gw; R < nrows; R += nw) {
        const float* xr = R < NL ? xl + (size_t)R * 1024 : xc + (size_t)(R - NL) * 1024;
        float4 v[4]; float ss = 0.f;
#pragma unroll
        for (int i = 0; i < 4; ++i) { v[i] = *(const float4*)(xr + i * 256 + lane * 4); ss += v[i].x * v[i].x + v[i].y * v[i].y + v[i].z * v[i].z + v[i].w * v[i].w; }
        ss = wave_allreduce(ss);
        const float* mrow = mods + (size_t)mod_batch(R) * 6144 + (which ? 3 : 0) * 1024;
        normmod_store(v, ss, g, mrow, mrow + 1024, dst + (size_t)R * 1024, xq ? xq + (size_t)R * 2048 : nullptr, lane);
    }
}
DEV void phase_normmix(const Params& p, bf16_t* hdst, bf16_t* xr, bf16_t* xk, bf16_t* xv) {
    const int tid = tid_opaque(), lane = tid & 63;
    const int gw = __builtin_amdgcn_readfirstlane(blockIdx.x * 8 + (tid >> 6)), nw = gridDim.x * 8;
    const float* mods = (const float*)(p.ws + WS_MOD);
    const float* g = p.in[6];
    for (int run = gw; run < NT / 8; run += nw) {
        const int R0 = run * 8;
        const int t0 = R0 < NL ? (R0 & 8191) : ((R0 - NL) & 255), slen = R0 < NL ? 8192 : 256;
        const float* mrow = mods + (size_t)mod_batch(R0) * 6144;
        float4 gg[4], sh[4], sc[4], m0[4], m2[4], m3[4];
#pragma unroll
        for (int i = 0; i < 4; ++i) {
            const int col = i * 256 + lane * 4;
            gg[i] = *(const float4*)(g + col); sh[i] = *(const float4*)(mrow + col); sc[i] = *(const float4*)(mrow + 1024 + col);
            m0[i] = *(const float4*)(p.in[8] + col); m2[i] = *(const float4*)(p.in[8] + 2 * 1024 + col); m3[i] = *(const float4*)(p.in[8] + 3 * 1024 + col);
        }
        auto hrow = [&](int R, float4 (&h)[4]) {
            const float* xrw = R < NL ? p.in[0] + (size_t)R * 1024 : p.in[2] + (size_t)(R - NL) * 1024;
            float ss = 0.f;
#pragma unroll
            for (int i = 0; i < 4; ++i) { h[i] = *(const float4*)(xrw + i * 256 + lane * 4); ss += h[i].x * h[i].x + h[i].y * h[i].y + h[i].z * h[i].z + h[i].w * h[i].w; }
            ss = wave_allreduce(ss);
            const float rs = rsqrtf(ss * (1.0f / 1024.0f) + 1e-6f);
#pragma unroll
            for (int i = 0; i < 4; ++i) {
                h[i].x = h[i].x * rs * gg[i].x * (1.f + sc[i].x) + sh[i].x; h[i].y = h[i].y * rs * gg[i].y * (1.f + sc[i].y) + sh[i].y;
                h[i].z = h[i].z * rs * gg[i].z * (1.f + sc[i].z) + sh[i].z; h[i].w = h[i].w * rs * gg[i].w * (1.f + sc[i].w) + sh[i].w;
            }
        };
        float4 hp[4], hc[4], hn[4];
        if (t0 > 0) hrow(R0 - 1, hp); else { hp[0] = hp[1] = hp[2] = hp[3] = make_float4(0.f, 0.f, 0.f, 0.f); }
        hrow(R0, hc);
#pragma unroll 1
        for (int i8 = 0; i8 < 8; ++i8) {
            const int R = R0 + i8;
            if (t0 + i8 + 1 < slen) hrow(R + 1, hn); else { hn[0] = hn[1] = hn[2] = hn[3] = make_float4(0.f, 0.f, 0.f, 0.f); }
#pragma unroll
            for (int i = 0; i < 4; ++i) {
                const size_t o = (size_t)R * 1024 + i * 256 + lane * 4;
                const float4 c = hc[i];
                const float4 xx = make_float4(0.5f * (hp[i].x + hn[i].x) - c.x, 0.5f * (hp[i].y + hn[i].y) - c.y, 0.5f * (hp[i].z + hn[i].z) - c.z, 0.5f * (hp[i].w + hn[i].w) - c.w);
                *(uint2*)(hdst + o) = make_uint2(pk_bf16(c.x, c.y), pk_bf16(c.z, c.w));
                *(uint2*)(xr + o) = make_uint2(pk_bf16(c.x + xx.x * m0[i].x, c.y + xx.y * m0[i].y), pk_bf16(c.z + xx.z * m0[i].z, c.w + xx.w * m0[i].w));
                *(uint2*)(xk + o) = make_uint2(pk_bf16(c.x + xx.x * m2[i].x, c.y + xx.y * m2[i].y), pk_bf16(c.z + xx.z * m2[i].z, c.w + xx.w * m2[i].w));
                *(uint2*)(xv + o) = make_uint2(pk_bf16(c.x + xx.x * m3[i].x, c.y + xx.y * m3[i].y), pk_bf16(c.z + xx.z * m3[i].z, c.w + xx.w * m3[i].w));
            }
#pragma unroll
            for (int i = 0; i < 4; ++i) { hp[i] = hc[i]; hc[i] = hn[i]; }
        }
    }
}

template <int BN> struct EpiBf16 {
    bf16_t* dst; int ldd; int col0; int act;
    DEV void operator()(const f32x4 (&acc)[4][BN / 64], int m0, int wm, int wn, int fr, int fq) const {
#pragma unroll
        for (int mi = 0; mi < 4; ++mi) {
            const size_t R = (size_t)(m0 + wm * 64 + mi * 16 + fr);
#pragma unroll
            for (int ni = 0; ni < BN / 64; ++ni) {
                const int col = col0 + wn * (BN / 4) + ni * 16 + 4 * fq;
                float v[4] = {acc[mi][ni][0], acc[mi][ni][1], acc[mi][ni][2], acc[mi][ni][3]};
                if (act == 1) {
#pragma unroll
                    for (int j = 0; j < 4; ++j) v[j] = 1.0f - 2.0f * __builtin_amdgcn_rcpf(1.0f + __expf(2.0f * v[j]));
                } else if (act == 2) {
#pragma unroll
                    for (int j = 0; j < 4; ++j) v[j] = sigmoidf_(v[j]);
                }
                *(uint2*)(dst + R * ldd + col) = make_uint2(pk_bf16(v[0], v[1]), pk_bf16(v[2], v[3]));
            }
        }
    }
};
template <int NI> struct EpiResid {
    const float* xold_lat; const float* xold_ctx; float* dst_lat; float* dst_ctx; const float* gate; int col0;
    DEV void operator()(const f32x4 (&acc)[4][NI], int m0, int wm, int wn, int fr, int fq) const {
#pragma unroll
        for (int mi = 0; mi < 4; ++mi) {
            const int R = m0 + wm * 64 + mi * 16 + fr;
            const float* src = R < NL ? xold_lat + (size_t)R * 1024 : xold_ctx + (size_t)(R - NL) * 1024;
            float* dst = R < NL ? dst_lat + (size_t)R * 1024 : dst_ctx + (size_t)(R - NL) * 1024;
            const float* gr = gate + (size_t)mod_batch(R) * 6144;
#pragma unroll
            for (int ni = 0; ni < NI; ++ni) {
                const int col = col0 + wn * (NI * 16) + ni * 16 + 4 * fq;
                const float4 xo = *(const float4*)(src + col), g4 = *(const float4*)(gr + col);
                *(float4*)(dst + col) = make_float4(xo.x + g4.x * acc[mi][ni][0], xo.y + g4.y * acc[mi][ni][1], xo.z + g4.z * acc[mi][ni][2], xo.w + g4.w * acc[mi][ni][3]);
            }
        }
    }
};
struct EpiLr {
    float* dst;
    DEV void operator()(const f32x4 (&acc)[4][2], int m0, int wm, int wn, int fr, int fq) const {
        if (wn != 0) return;
#pragma unroll
        for (int mi = 0; mi < 4; ++mi) {
            const size_t R = (size_t)(m0 + wm * 64 + mi * 16 + fr);
#pragma unroll
            for (int ni = 0; ni < 2; ++ni) { const int col = ni * 16 + 4 * fq; *(float4*)(dst + R * 32 + col) = make_float4(acc[mi][ni][0], acc[mi][ni][1], acc[mi][ni][2], acc[mi][ni][3]); }
        }
    }
};

namespace pg8 {
#define PG8_LAS __attribute__((address_space(3)))
constexpr int BM = 256, BK = 64, HALF = 128, HTB = HALF * BK * 2  , STAGE_BYTES = 8 * HTB, NXCD = 8, WGM = 8;

__host__ __device__ __forceinline__ int lds_byte(int r, int c) { const int st = (r >> 4) * 2 + (c >> 5), rr = r & 15, cc = c & 31, ob = rr * 64 + cc * 2; return st * 1024 + (ob ^ (((ob >> 9) & 1) << 5)); }
__host__ __device__ __forceinline__ void stage_rc(int b, int& R, int& C) { const int st = b / 1024, sb = b % 1024, swz = sb ^ (((sb >> 9) & 1) << 5); R = (st >> 1) * 16 + swz / 64; C = (st & 1) * 32 + (swz % 64) / 2; }
__host__ __device__ __forceinline__ int perm32(int rho) { const int n = rho >> 4, i = rho & 15; return 8 * (i >> 2) + 4 * n + (i & 3); }
struct Unit { int pm, pn; };
struct Gemm { const bf16_t* A; const bf16_t* Bt; int M, N, K; };
struct StaticOrder {
    int nM, nN, nwg, G, c;
    __host__ __device__ void init(int M, int N, int G_, int c_) { nM = M / BM; nN = N / BM; nwg = nM * nN; G = G_; c = c_; }
    __host__ __device__ bool next(int i, Unit& u) const {
        const long L = (long)i * G + c; if (L >= nwg) return false;
        int wgid = (int)L; { const int q = nwg / NXCD, r = nwg % NXCD, xcd = wgid % NXCD, off = wgid / NXCD; wgid = (xcd < r ? xcd * (q + 1) : r * (q + 1) + (xcd - r) * q) + off; }
        const int nig = WGM * nN, gid = wgid / nig, fm = gid * WGM, gsz = (nM - fm) < WGM ? (nM - fm) : WGM;
        u.pm = fm + ((wgid % nig) % gsz); u.pn = (wgid % nig) / gsz; return true;
    }
    __device__ __forceinline__ void a_ready(const Unit&) const {}
    __device__ __forceinline__ void done(const Unit&) const {}
};
template <class Epi, class Sched, bool STAMP = false>
__device__ __forceinline__ void gemm_phase(PG8_LAS unsigned char* lds, const Gemm g, const Sched& S, const Epi& E, unsigned long long* stamps) {
    const int tid = tid_opaque(), wid = __builtin_amdgcn_readfirstlane(tid >> 6), lane = tid & 63, wr = wid >> 2, wc = wid & 3, fr = lane & 15, fq = lane >> 4;
    const int K = g.K, nt = K / BK;
    int ts_lo = 0, ts_hi = 0, nts = 0; const unsigned long long rt_entry = STAMP ? (unsigned long long)wall_clock64() : 0ull;
#define PG8_STAMP() do { if (STAMP && wid == 0 && nts < 64) { const unsigned long long _c = (unsigned long long)clock64(); \
        ts_lo = (lane == nts) ? (int)(unsigned)_c : ts_lo; ts_hi = (lane == nts) ? (int)(unsigned)(_c >> 32) : ts_hi; ++nts; } } while (0)
    PG8_STAMP();
    unsigned voffA[2], voffB[2];
#pragma unroll
    for (int i = 0; i < 2; ++i) { int R, C; stage_rc(tid * 16 + i * 8192, R, C); const int Rb = Epi::PERM ? ((R & ~31) + perm32(R & 31)) : R;
        voffA[i] = (unsigned)(R * K + C) * 2u; voffB[i] = (unsigned)(Rb * K + C) * 2u; }
    const size_t kstep = (size_t)(BK * 2);
    const size_t hstep = (size_t)HALF * K * 2;
    const size_t tstep = 2 * hstep;
    const unsigned ldsw = (unsigned)wid * 1024u;
    const int aoff = lds_byte(wr * 64 + fr, fq * 8), boff = lds_byte(wc * 32 + fr, fq * 8);
#define PG8_SA(b, h) (((b) * 2 + (h)) * HTB)
#define PG8_SB(b, h) ((4 + (b) * 2 + (h)) * HTB)
#define PG8_STAGE(bufoff, gbase, voff) do { _Pragma("unroll") for (int _i = 0; _i < 2; ++_i) \
        __builtin_amdgcn_global_load_lds((const unsigned*)((const char*)(gbase) + (voff)[_i]), (PG8_LAS unsigned*)(lds + (bufoff) + ldsw + _i * 8192), 16, 0, 0); } while (0)
#define PG8_LDA(dst, b, h) do { _Pragma("unroll") for (int m = 0; m < 4; ++m) _Pragma("unroll") for (int k = 0; k < 2; ++k) dst[m][k] = *(const PG8_LAS bf16x8*)(lds + PG8_SA(b, h) + aoff + m * 2048 + k * 1024); } while (0)
#define PG8_LDB(dst, b, h) do { _Pragma("unroll") for (int n = 0; n < 2; ++n) _Pragma("unroll") for (int k = 0; k < 2; ++k) dst[n][k] = *(const PG8_LAS bf16x8*)(lds + PG8_SB(b, h) + boff + n * 2048 + k * 1024); } while (0)
#define PG8_MMA(ai, bj, At, Bt) do { __builtin_amdgcn_s_setprio(1); _Pragma("unroll") for (int m = 0; m < 4; ++m) _Pragma("unroll") for (int n = 0; n < 2; ++n) _Pragma("unroll") for (int k = 0; k < 2; ++k) \
        acc[ai][bj][m][n] = __builtin_amdgcn_mfma_f32_16x16x32_bf16(Bt[n][k], At[m][k], acc[ai][bj][m][n], 0, 0, 0); __builtin_amdgcn_s_setprio(0); } while (0)
#define PG8_WAIT_V(n) asm volatile("s_waitcnt vmcnt(" #n ")" ::: "memory")
#define PG8_WAIT_L(n) asm volatile("s_waitcnt lgkmcnt(" #n ")" ::: "memory")
#define PG8_BAR __builtin_amdgcn_s_barrier()
#define PG8_SCHED __builtin_amdgcn_sched_barrier(0)
    Unit cur, nxt; int ui = 0;
    if (!S.next(0, cur)) return;
    f32x4 acc[2][2][4][2];
#pragma unroll
    for (int a = 0; a < 2; ++a)
#pragma unroll
        for (int b = 0; b < 2; ++b)
#pragma unroll
            for (int m = 0; m < 4; ++m)
#pragma unroll
                for (int n = 0; n < 2; ++n) acc[a][b][m][n] = (f32x4){0.f, 0.f, 0.f, 0.f};
    bf16x8 At[4][2], B0[2][2], B1[2][2];
    const char* cA = (const char*)g.A + (size_t)cur.pm * tstep; const char* cB = (const char*)g.Bt + (size_t)cur.pn * tstep;
    S.a_ready(cur);
    PG8_STAGE(PG8_SB(0, 0), cB, voffB); PG8_STAGE(PG8_SA(0, 0), cA, voffA); PG8_STAGE(PG8_SB(0, 1), cB + hstep, voffB); PG8_STAGE(PG8_SA(0, 1), cA + hstep, voffA);
    if (wr == 1) PG8_BAR;
    PG8_WAIT_V(4); PG8_BAR;
    PG8_STAGE(PG8_SB(1, 0), cB + kstep, voffB); PG8_STAGE(PG8_SA(1, 0), cA + kstep, voffA); PG8_STAGE(PG8_SB(1, 1), cB + hstep + kstep, voffB);
    PG8_WAIT_V(6); PG8_BAR;
    PG8_STAMP();
    for (;;) {
        const bool has_next = S.next(ui + 1, nxt);
        const char* nA = has_next ? (const char*)g.A + (size_t)nxt.pm * tstep : cA; const char* nB = has_next ? (const char*)g.Bt + (size_t)nxt.pn * tstep : cB;
        for (int t = 0; t < nt; t += 2) {
            const bool last = (t == nt - 2);
            const char* a1 = cA + (size_t)(t + 1) * kstep;
            const char* a2 = last ? nA : cA + (size_t)(t + 2) * kstep; const char* b2 = last ? nB : cB + (size_t)(t + 2) * kstep;
            const char* a3 = a2 + kstep; const char* b3 = b2 + kstep;
            if (last && has_next) S.a_ready(nxt);
            PG8_LDB(B0, 0, 0); PG8_SCHED; PG8_LDA(At, 0, 0); PG8_STAGE(PG8_SA(1, 1), a1 + hstep, voffA);
            PG8_WAIT_L(8); PG8_BAR; PG8_WAIT_L(0); PG8_MMA(0, 0, At, B0); PG8_BAR; PG8_SCHED;
            PG8_LDB(B1, 0, 1); PG8_STAGE(PG8_SB(0, 0), b2, voffB);
            PG8_BAR; PG8_WAIT_L(0); PG8_MMA(0, 1, At, B1); PG8_BAR;
            PG8_LDA(At, 0, 1); PG8_STAGE(PG8_SA(0, 0), a2, voffA);
            PG8_BAR; PG8_WAIT_L(0); PG8_MMA(1, 0, At, B0); PG8_BAR; PG8_SCHED;
            PG8_STAGE(PG8_SB(0, 1), b2 + hstep, voffB);
            PG8_WAIT_V(6); PG8_BAR; PG8_MMA(1, 1, At, B1); PG8_BAR;
            PG8_LDB(B0, 1, 0); PG8_SCHED; PG8_LDA(At, 1, 0); PG8_STAGE(PG8_SA(0, 1), a2 + hstep, voffA);
            PG8_WAIT_L(8); PG8_BAR; PG8_WAIT_L(0); PG8_MMA(0, 0, At, B0); PG8_BAR; PG8_SCHED;
            PG8_LDB(B1, 1, 1); PG8_STAGE(PG8_SB(1, 0), b3, voffB);
            PG8_BAR; PG8_WAIT_L(0); PG8_MMA(0, 1, At, B1); PG8_BAR;
            PG8_LDA(At, 1, 1); PG8_STAGE(PG8_SA(1, 0), a3, voffA);
            PG8_BAR; PG8_WAIT_L(0); PG8_MMA(1, 0, At, B0); PG8_BAR; PG8_SCHED;
            PG8_STAGE(PG8_SB(1, 1), b3 + hstep, voffB);
            PG8_WAIT_V(6); PG8_BAR; PG8_MMA(1, 1, At, B1); PG8_BAR;
        }
        PG8_STAMP();
        if constexpr (!Epi::AFTER_DRAIN) { E(acc, cur, wr, wc, fr, fq); S.done(cur); }
        PG8_STAMP();
        if (!has_next) break;
#pragma unroll
        for (int a = 0; a < 2; ++a)
#pragma unroll
            for (int b = 0; b < 2; ++b)
#pragma unroll
                for (int m = 0; m < 4; ++m)
#pragma unroll
                    for (int n = 0; n < 2; ++n) acc[a][b][m][n] = (f32x4){0.f, 0.f, 0.f, 0.f};
        cur = nxt; cA = nA; cB = nB; ++ui;
    }
    PG8_WAIT_V(0);
    if (wr == 0) PG8_BAR;
    PG8_BAR;
    if constexpr (Epi::AFTER_DRAIN) { E.fused(acc, cur, wr, wc, fr, fq, lds, wid, lane); S.done(cur); }
    PG8_STAMP();
    if (STAMP && wid == 0) { stamps[lane] = lane < nts ? (((unsigned long long)(unsigned)ts_hi << 32) | (unsigned)ts_lo) : 0ull;
        if (lane == 62) stamps[62] = rt_entry; if (lane == 63) stamps[63] = (unsigned long long)wall_clock64(); }
#undef PG8_STAMP
#undef PG8_SA
#undef PG8_SB
#undef PG8_STAGE
#undef PG8_LDA
#undef PG8_LDB
#undef PG8_MMA
#undef PG8_WAIT_V
#undef PG8_WAIT_L
#undef PG8_BAR
#undef PG8_SCHED
}
struct EpiBf16Tiles {
    static constexpr bool PERM = true, AFTER_DRAIN = false;
    bf16_t* d0; int ld0; int ntile0; bf16_t* d1; int ld1;
    __device__ __forceinline__ void operator()(const f32x4 (&acc)[2][2][4][2], const Unit& u, int wr, int wc, int fr, int fq) const {
        bf16_t* base = u.pn < ntile0 ? d0 : d1; const int ld = u.pn < ntile0 ? ld0 : ld1; const int colt = (u.pn < ntile0 ? u.pn : u.pn - ntile0) * BM;
        const int row0 = u.pm * BM + wr * 64 + fr, col0 = colt + wc * 32 + 8 * fq;
#pragma unroll
        for (int ai = 0; ai < 2; ++ai)
#pragma unroll
            for (int m = 0; m < 4; ++m) { bf16_t* rowp = base + (size_t)(row0 + ai * HALF + m * 16) * ld + col0;
#pragma unroll
                for (int bj = 0; bj < 2; ++bj) { const f32x4 v0 = acc[ai][bj][m][0], v1 = acc[ai][bj][m][1];
                    *(uint4*)(rowp + bj * HALF) = make_uint4(pk_bf16(v0[0], v0[1]), pk_bf16(v0[2], v0[3]), pk_bf16(v1[0], v1[1]), pk_bf16(v1[2], v1[3])); } }
    }
};
struct EpiResid256 {
    static constexpr bool PERM = false, AFTER_DRAIN = false;
    const float* xold_lat; const float* xold_ctx; float* dst_lat; float* dst_ctx; const float* gate;
    __device__ __forceinline__ void operator()(const f32x4 (&acc)[2][2][4][2], const Unit& u, int wr, int wc, int fr, int fq) const {
        const int row0 = u.pm * BM + wr * 64 + fr, col0 = u.pn * BM + wc * 32 + 4 * fq;
#pragma unroll
        for (int ai = 0; ai < 2; ++ai)
#pragma unroll
            for (int m = 0; m < 4; ++m) {
                const int R = row0 + ai * HALF + m * 16;
                const float* src = R < NL ? xold_lat + (size_t)R * 1024 : xold_ctx + (size_t)(R - NL) * 1024;
                float* dst = R < NL ? dst_lat + (size_t)R * 1024 : dst_ctx + (size_t)(R - NL) * 1024;
                const float* gr = gate + (size_t)mod_batch(R) * 6144;
#pragma unroll
                for (int bj = 0; bj < 2; ++bj)
#pragma unroll
                    for (int n = 0; n < 2; ++n) {
                        const int col = col0 + bj * HALF + n * 16;
                        const float4 xo = *(const float4*)(src + col), g4 = *(const float4*)(gr + col);
                        const f32x4 a = acc[ai][bj][m][n];
                        *(float4*)(dst + col) = make_float4(xo.x + g4.x * a[0], xo.y + g4.y * a[1], xo.z + g4.z * a[2], xo.w + g4.w * a[3]);
                    }
            }
    }
};
}

DEV void rw_proj_ctx_tile(const Params& p, unsigned char* lds, int which, const bf16_t* A, bf16_t* dst, int u) {
    const int mt = u >> 3, nt = u & 7;
    ALoadPlain al{A, 1024};
    EpiBf16<128> ep{dst, 1024, nt * 128, 0};
    gemm_unit<128>(lds, al, (const bf16_t*)(p.ws + WS_WPROJ) + (size_t)which * 1024 * 1024 + (size_t)nt * 128 * 1024, 1024, NL + mt * 128, ep);
}
DEV void phase_rw_proj1(const Params& p, unsigned char* lds, int which, const bf16_t* A, bf16_t* dst, int ctx_here) {
    pg8::Gemm g{A, (const bf16_t*)(p.ws + WS_WPROJ) + (size_t)which * 1024 * 1024, NL, 1024, 1024};
    pg8::StaticOrder so; so.init(NL, 1024, gridDim.x, blockIdx.x);
    pg8::EpiBf16Tiles ep{dst, 1024, 4, dst, 1024};
    pg8::gemm_phase((PG8_LAS unsigned char*)lds, g, so, ep, nullptr);
    __syncthreads();
    if (ctx_here)
        for (int u = blockIdx.x; u < (NC / 128) * 8; u += gridDim.x) rw_proj_ctx_tile(p, lds, which, A, dst, u);
}
DEV void phase_rw_lora(const Params& p, unsigned char* lds, const bf16_t* vin, bf16_t* vdst) {
    unsigned char* ws = p.ws;
    const bf16_t* h = (const bf16_t*)(ws + WS_S + 0 * U_BYTES);
    const bf16_t* wproj = (const bf16_t*)(ws + WS_WPROJ);
    const int nunits = (NT / 128) * 3;
    for (int u = blockIdx.x; u < nunits + (NC / 128) * 8; u += gridDim.x) {
        if (u >= nunits) { rw_proj_ctx_tile(p, lds, 2, vin, vdst, u - nunits); continue; }
        const int mt = u / 3, lg = u % 3, m0 = mt * 128;
        const int mixid = lg == 0 ? 1 : (lg == 1 ? 4 : 5);
        ALoadMix al{h, p.in[8] + mixid * 1024, h, 1024};
        EpiBf16<128> ep{(bf16_t*)(ws + WS_S + 4 * U_BYTES), 384, lg * 128, lg == 0 ? 1 : (lg == 1 ? 0 : 2)};
        gemm_unit<128>(lds, al, wproj + (size_t)(3072 + lg * 128) * 1024, 1024, m0, ep);
    }
}

template <int N> DEV float dpp_shr0(float x) { return __int_as_float(__builtin_amdgcn_update_dpp(0, __float_as_int(x), 0x110 + N, 0xF, 0xF, true)); }
template <int CTRL> DEV float dpp_quad(float x) { return __int_as_float(__builtin_amdgcn_update_dpp(0, __float_as_int(x), CTRL, 0xF, 0xF, false)); }
DEV int tile_off(int row, int ch) { return row * 128 + ((ch ^ (row & 7)) << 4); }
DEV int tile_off2(int row, int ch) { return row * 128 + ((ch ^ ((row ^ (row >> 3)) & 7)) << 4); }
DEV void phase_rw_scan(const Params& p, unsigned char* lds) {
    const int tid = tid_opaque(), lane = tid & 63;
    const int wv = __builtin_amdgcn_readfirstlane(tid >> 6);
    const int fr = lane & 15, fq = lane >> 4;
    unsigned char* ws = p.ws;
    constexpr int SH = 0, SL = 8192, AT = 16384  , RT = 20480  , BT = 24576  , KT = 28672  , BKT = 32768  , UV = 49152  , NT = 65536  ;
    constexpr int MFA = 69632, MFK = 70656, X0 = 71680, VS = 75776  , PP = 83968, PM = 88064, PI = 92160, AA = 96256  ;
    constexpr int PL = 116736  , YB = 117760, LDS_END = 121856;
    const bf16_t* rbuf = (const bf16_t*)(ws + WS_S + 3 * U_BYTES);
    const bf16_t* kbuf = (const bf16_t*)(ws + WS_S + 5 * U_BYTES);
    const bf16_t* vbuf = (const bf16_t*)(ws + WS_S + 1 * U_BYTES);
    const bf16_t* lora = (const bf16_t*)(ws + WS_S + 4 * U_BYTES);
    for (int unit = blockIdx.x; unit < 256; unit += gridDim.x) {
        const int b = unit >> 5, hh = (unit >> 1) & 15, d = unit & 1;
        bf16_t* ydst = (bf16_t*)(ws + WS_S + (size_t)(d ? 2 : 0) * U_BYTES);
        float* bonus = (float*)(ws + WS_BONUS) + (size_t)((d * NB + b) * 16 + hh) * 8448;
        const int s_e = (tid >> 4) & 15, j0 = (tid & 15) * 4;
        const int ni = wv & 3;
        auto Rof = [&](int c, int s) -> int {
            if (c < 16) { const int q = c * 16 + s; return NL + b * 256 + (d ? 255 - q : q); }
            const int q = (c - 16) * 16 + s; return b * 8192 + (d ? 8191 - q : q);
        };
        constexpr int CST = LDS_END;
        uint2 pr = make_uint2(0, 0), pk = pr, pv = pr; uint4 paw[2], paa[2];
        if (wv >= 4) {
            const int ct = (tid - 256) * 16;
            *(float4*)(lds + CST + 0 * 4096 + ct) = *(const float4*)(p.in[18] + hh * 64 + j0);
            *(float4*)(lds + CST + 1 * 4096 + ct) = *(const float4*)(p.in[19] + hh * 64 + j0);
            *(float4*)(lds + CST + 2 * 4096 + ct) = *(const float4*)(p.in[20] + hh * 64 + j0);
            *(float4*)(lds + CST + 3 * 4096 + ct) = *(const float4*)(p.in[10] + d * 1024 + hh * 64 + ni * 16 + fq * 4);
            *(float4*)(lds + CST + 4 * 4096 + ct) = *(const float4*)(p.in[13] + d * 1024 + hh * 64 + ni * 16 + fq * 4);
#pragma unroll
            for (int ks = 0; ks < 2; ++ks) {
                *(uint4*)(lds + CST + (5 + ks) * 4096 + ct) = *(const uint4*)((const bf16_t*)(ws + WS_W2T) + (size_t)d * 1024 * 64 + (size_t)(hh * 64 + ni * 16 + fr) * 64 + ks * 32 + fq * 8);
                *(uint4*)(lds + CST + (7 + ks) * 4096 + ct) = *(const uint4*)((const bf16_t*)(ws + WS_A2T) + (size_t)d * 1024 * 64 + (size_t)(hh * 64 + ni * 16 + fr) * 64 + ks * 32 + fq * 8);
            }
        }
        auto load_lora = [&](int c) {
            const size_t R2 = (size_t)Rof(c, fr);
#pragma unroll
            for (int ks = 0; ks < 2; ++ks) { paw[ks] = *(const uint4*)(lora + R2 * 384 + d * 64 + ks * 32 + fq * 8); paa[ks] = *(const uint4*)(lora + R2 * 384 + 128 + d * 64 + ks * 32 + fq * 8); }
        };
        auto load_rkv = [&](int c) {
            const size_t off = (size_t)Rof(c, s_e) * 1024 + hh * 64 + j0;
            pr = *(const uint2*)(rbuf + off); pk = *(const uint2*)(kbuf + off); pv = *(const uint2*)(vbuf + off);
        };
        auto step_up = [&](int c) {
            const int ct = (tid - 256) * 16;
            const float4 bias_w = *(const float4*)(lds + CST + 3 * 4096 + ct), bias_a = *(const float4*)(lds + CST + 4 * 4096 + ct);
            bf16x8 bfw[2], bfa[2];
#pragma unroll
            for (int ks = 0; ks < 2; ++ks) { bfw[ks] = *(const bf16x8*)(lds + CST + (5 + ks) * 4096 + ct); bfa[ks] = *(const bf16x8*)(lds + CST + (7 + ks) * 4096 + ct); }
            f32x4 accw = {0.f, 0.f, 0.f, 0.f}, acca = {0.f, 0.f, 0.f, 0.f};
#pragma unroll
            for (int ks = 0; ks < 2; ++ks) { accw = __builtin_amdgcn_mfma_f32_16x16x32_bf16(bfw[ks], as_bf16x8(paw[ks]), accw, 0, 0, 0); acca = __builtin_amdgcn_mfma_f32_16x16x32_bf16(bfa[ks], as_bf16x8(paa[ks]), acca, 0, 0, 0); }
            const int n = ni * 16 + fq * 4;
            const float bw[4] = {bias_w.x, bias_w.y, bias_w.z, bias_w.w}, ba[4] = {bias_a.x, bias_a.y, bias_a.z, bias_a.w};
            float P[4], Pm[4], Pi[4], av[4];
#pragma unroll
            for (int j = 0; j < 4; ++j) {
                const float e = 0.6065306597f * __builtin_amdgcn_rcpf(1.0f + __expf(-(accw[j] + bw[j])));
                float s = e;
                s += dpp_shr0<1>(s); s += dpp_shr0<2>(s); s += dpp_shr0<4>(s); s += dpp_shr0<8>(s);
                P[j] = __expf(-s); Pi[j] = __builtin_amdgcn_rcpf(P[j]); Pm[j] = P[j] * __expf(e);
                av[j] = __builtin_amdgcn_rcpf(1.0f + __expf(-(acca[j] + ba[j])));
            }
            const int pb = (c & 1) * 16384;
            *(float4*)(lds + PP + pb + (fr * 64 + n) * 4) = make_float4(P[0], P[1], P[2], P[3]);
            *(float4*)(lds + PM + pb + (fr * 64 + n) * 4) = make_float4(Pm[0], Pm[1], Pm[2], Pm[3]);
            *(float4*)(lds + PI + pb + (fr * 64 + n) * 4) = make_float4(Pi[0], Pi[1], Pi[2], Pi[3]);
            *(float4*)(lds + AA + pb + (fr * 64 + n) * 4) = make_float4(av[0], av[1], av[2], av[3]);
            if (fr == 15) *(float4*)(lds + PL + (c & 3) * 256 + n * 4) = make_float4(P[0], P[1], P[2], P[3]);
        };
        auto step_vec = [&](int c) {
            const int eo = (s_e * 64 + j0) * 4, pb = (c & 1) * 16384, tb = (c & 1) * 8192, ct = (tid - 256) * 16;
            const float4 kk_c = *(const float4*)(lds + CST + 0 * 4096 + ct), ka_c = *(const float4*)(lds + CST + 1 * 4096 + ct), rk_c = *(const float4*)(lds + CST + 2 * 4096 + ct);
            const float4 a4 = *(const float4*)(lds + AA + pb + eo), P4 = *(const float4*)(lds + PP + pb + eo), Pm4 = *(const float4*)(lds + PM + pb + eo), Pi4 = *(const float4*)(lds + PI + pb + eo);
            const float kx[4] = {bf_lo(pk.x), bf_hi(pk.x), bf_lo(pk.y), bf_hi(pk.y)};
            const float rx[4] = {bf_lo(pr.x), bf_hi(pr.x), bf_lo(pr.y), bf_hi(pr.y)};
            const float av[4] = {a4.x, a4.y, a4.z, a4.w}, Pv[4] = {P4.x, P4.y, P4.z, P4.w}, Pmv[4] = {Pm4.x, Pm4.y, Pm4.z, Pm4.w}, Piv[4] = {Pi4.x, Pi4.y, Pi4.z, Pi4.w};
            const float kkc[4] = {kk_c.x, kk_c.y, kk_c.z, kk_c.w}, kac[4] = {ka_c.x, ka_c.y, ka_c.z, ka_c.w}, rkc[4] = {rk_c.x, rk_c.y, rk_c.z, rk_c.w};
            float t[4], n2 = 0.f;
#pragma unroll
            for (int j = 0; j < 4; ++j) { t[j] = kx[j] * kkc[j]; n2 += t[j] * t[j]; }
            n2 = row16_allreduce(n2);
            const float inv = __builtin_amdgcn_rsqf(fmaxf(n2, 1e-24f));
            float at[4], bt[4], kt[4], rt[4], bon = 0.f;
#pragma unroll
            for (int j = 0; j < 4; ++j) {
                const float kkv = t[j] * inv;
                const float kd = kx[j] * (1.0f + (av[j] - 1.0f) * kac[j]);
                const float bq = kkv * av[j];
                bon += rx[j] * kd * rkc[j];
                at[j] = -kkv * Pmv[j]; bt[j] = bq * Piv[j]; kt[j] = kd * Piv[j]; rt[j] = rx[j] * Pv[j];
            }
            bon = row16_allreduce(bon);
            if ((tid & 15) == 0) { const int Rb = Rof(c, s_e); bonus[Rb < NL ? 256 + (Rb & 8191) : ((Rb - NL) & 255)] = bon; }
            const int ro = tile_off(s_e, j0 >> 3) + (j0 & 7) * 2;
            *(uint2*)(lds + AT + (c & 1) * 2048 + ro) = make_uint2(pk_bf16(at[0], at[1]), pk_bf16(at[2], at[3]));
            *(uint2*)(lds + RT + (c & 1) * 2048 + ro) = make_uint2(pk_bf16(rt[0], rt[1]), pk_bf16(rt[2], rt[3]));
            const unsigned b01 = pk_bf16(bt[0], bt[1]), b23 = pk_bf16(bt[2], bt[3]), k01 = pk_bf16(kt[0], kt[1]), k23 = pk_bf16(kt[2], kt[3]);
            *(uint2*)(lds + BT + (c & 1) * 2048 + ro) = make_uint2(b01, b23);
            *(uint2*)(lds + KT + (c & 1) * 2048 + ro) = make_uint2(k01, k23);
            const unsigned bw2[4] = {b01 & 0xffffu, b01 >> 16, b23 & 0xffffu, b23 >> 16}, kw2[4] = {k01 & 0xffffu, k01 >> 16, k23 & 0xffffu, k23 >> 16};
            const unsigned vw[4] = {pv.x & 0xffffu, pv.x >> 16, pv.y & 0xffffu, pv.y >> 16};
            const int e0 = (s_e & 7) * 2, cq = s_e >> 3, a_ = tid & 15;
            const int B0 = j0 * 128 + e0 + (((cq ^ (4 * (a_ & 1)) ^ (a_ >> 1)) & 7) << 4);
#pragma unroll
            for (int j = 0; j < 4; ++j) {
                *(bf16_t*)(lds + BKT + tb + (B0 ^ ((0 ^ j) << 4)) + j * 128) = (bf16_t)bw2[j];
                *(bf16_t*)(lds + BKT + tb + (B0 ^ ((2 ^ j) << 4)) + j * 128) = (bf16_t)kw2[j];
                *(bf16_t*)(lds + BKT + tb + (B0 ^ ((4 ^ j) << 4)) + j * 128) = (bf16_t)bw2[j];
                *(bf16_t*)(lds + UV + tb + (B0 ^ ((2 ^ j) << 4)) + j * 128) = (bf16_t)vw[j];
            }
        };
        f32x4 accY = {0.f, 0.f, 0.f, 0.f};
        auto prod_S = [&](int c) {
            const int vt = wv & 3, tb = (c & 1) * 2048;
            f32x4 accX = {0.f, 0.f, 0.f, 0.f}, accR = {0.f, 0.f, 0.f, 0.f};
#pragma unroll
            for (int ks = 0; ks < 2; ++ks) {
                const int ch = ks * 4 + fq;
                const bf16x8 sh = *(const bf16x8*)(lds + SH + tile_off(vt * 16 + fr, ch)), sl = *(const bf16x8*)(lds + SL + tile_off(vt * 16 + fr, ch));
                const bf16x8 fa = *(const bf16x8*)(lds + AT + tb + tile_off(fr, ch)), frr = *(const bf16x8*)(lds + RT + tb + tile_off(fr, ch));
                accX = __builtin_amdgcn_mfma_f32_16x16x32_bf16(sh, fa, accX, 0, 0, 0);
                accR = __builtin_amdgcn_mfma_f32_16x16x32_bf16(sh, frr, accR, 0, 0, 0);
                accX = __builtin_amdgcn_mfma_f32_16x16x32_bf16(sl, fa, accX, 0, 0, 0);
                accR = __builtin_amdgcn_mfma_f32_16x16x32_bf16(sl, frr, accR, 0, 0, 0);
            }
            accY = accR;
            {
                const u32x2v av = *(const u32x2v*)(lds + UV + (c & 1) * 8192 + tile_off2(vt * 16 + fr, 2 + (fq >> 1)) + (fq & 1) * 8);
                const u32x2v mh = *(const u32x2v*)(lds + MFK + (fr * 4 + fq) * 8), ml = *(const u32x2v*)(lds + MFK + 512 + (fr * 4 + fq) * 8);
                accX = __builtin_amdgcn_mfma_f32_16x16x16bf16_1k(__builtin_bit_cast(s16x4v, av), __builtin_bit_cast(s16x4v, mh), accX, 0, 0, 0);
                accX = __builtin_amdgcn_mfma_f32_16x16x16bf16_1k(__builtin_bit_cast(s16x4v, av), __builtin_bit_cast(s16x4v, ml), accX, 0, 0, 0);
            }
#pragma unroll
            for (int j = 0; j < 4; ++j) *(float*)(lds + X0 + ((vt * 16 + 4 * fq + j) * 16 + fr) * 4) = accX[j];
        };
        auto prod_V = [&](int c) {
            const int tb = (c & 1) * 2048, w4 = wv & 3;
            f32x4 m = {0.f, 0.f, 0.f, 0.f};
#pragma unroll
            for (int ks = 0; ks < 2; ++ks) {
                const int ch = ks * 4 + fq;
                const bf16x8 fa = *(const bf16x8*)(lds + ((w4 & 1) ? KT : BT) + tb + tile_off(fr, ch));
                const bf16x8 fb = *(const bf16x8*)(lds + ((w4 & 2) ? RT : AT) + tb + tile_off(fr, ch));
                m = __builtin_amdgcn_mfma_f32_16x16x32_bf16(fa, fb, m, 0, 0, 0);
            }
            if (w4 == 0) {
                float* mf = (float*)(lds + MFA);
#pragma unroll
                for (int j = 0; j < 4; ++j) mf[(fr * 4 + j) * 4 + fq] = (4 * fq + j < fr) ? m[j] : 0.f;
            } else if (w4 == 1) {
                const float m0 = (4 * fq + 0 < fr) ? m[0] : 0.f, m1 = (4 * fq + 1 < fr) ? m[1] : 0.f, m2 = (4 * fq + 2 < fr) ? m[2] : 0.f, m3 = (4 * fq + 3 < fr) ? m[3] : 0.f;
                const unsigned h01 = pk_bf16(m0, m1), h23 = pk_bf16(m2, m3);
                *(uint2*)(lds + MFK + (fr * 4 + fq) * 8) = make_uint2(h01, h23);
                *(uint2*)(lds + MFK + 512 + (fr * 4 + fq) * 8) = make_uint2(pk_bf16(m0 - bf_lo(h01), m1 - bf_hi(h01)), pk_bf16(m2 - bf_lo(h23), m3 - bf_hi(h23)));
            } else {
                const float m0 = (4 * fq + 0 <= fr) ? m[0] : 0.f, m1 = (4 * fq + 1 <= fr) ? m[1] : 0.f, m2 = (4 * fq + 2 <= fr) ? m[2] : 0.f, m3 = (4 * fq + 3 <= fr) ? m[3] : 0.f;
                const uint2 o = make_uint2(pk_bf16(m0, m1), pk_bf16(m2, m3));
                const int colb = (w4 == 2 ? 0 : 16) + 4 * fq;
                *(uint2*)(lds + NT + tb + tile_off(fr, colb >> 3) + (colb & 7) * 2) = o;
                if (w4 == 2) *(uint2*)(lds + NT + tb + tile_off(fr, (32 + 4 * fq) >> 3) + ((32 + 4 * fq) & 7) * 2) = o;
            }
        };
        auto step_rec = [&](int c) {
            const int v = tid >> 2, pq = tid & 3;
            float cc[16];
#pragma unroll
            for (int i = 0; i < 4; ++i) { const float4 q = *(const float4*)(lds + X0 + (v * 16 + 4 * i) * 4); cc[4 * i] = q.x; cc[4 * i + 1] = q.y; cc[4 * i + 2] = q.z; cc[4 * i + 3] = q.w; }
            float4 ma[16];
#pragma unroll
            for (int t = 1; t < 16; ++t) ma[t] = *(const float4*)(lds + MFA + ((t * 4 + pq) * 4) * 4);
            ma[0] = make_float4(0.f, 0.f, 0.f, 0.f);
            float uown[4] = {0.f, 0.f, 0.f, 0.f}, uall[16];
#pragma unroll
            for (int t = 0; t < 16; ++t) {
                float s = uown[0] * ma[t].x; s = fmaf(uown[1], ma[t].y, s); s = fmaf(uown[2], ma[t].z, s); s = fmaf(uown[3], ma[t].w, s);
                s += dpp_quad<0xB1>(s); s += dpp_quad<0x4E>(s);
                const float u = cc[t] + s;
                uall[t] = u;
                if (pq == (t & 3)) uown[t >> 2] = u;
            }
            if (pq < 2) {
                unsigned o[8];
#pragma unroll
                for (int i = 0; i < 8; ++i) {
                    const unsigned hi = pk_bf16(uall[2 * i], uall[2 * i + 1]);
                    o[i] = pq ? pk_bf16(uall[2 * i] - bf_lo(hi), uall[2 * i + 1] - bf_hi(hi)) : hi;
                }
                const int cb = pq ? 4 : 0;
                *(uint4*)(lds + UV + (c & 1) * 8192 + tile_off2(v, cb)) = make_uint4(o[0], o[1], o[2], o[3]);
                *(uint4*)(lds + UV + (c & 1) * 8192 + tile_off2(v, cb + 1)) = make_uint4(o[4], o[5], o[6], o[7]);
            }
        };
        f32x4 accS[2];
        accS[0] = (f32x4){0.f, 0.f, 0.f, 0.f}; accS[1] = (f32x4){0.f, 0.f, 0.f, 0.f};
        auto step_upd = [&](int c) {
            const int vt = wv & 3;
            bf16x8 fuv[2];
#pragma unroll
            for (int ks = 0; ks < 2; ++ks) fuv[ks] = *(const bf16x8*)(lds + UV + (c & 1) * 8192 + tile_off2(vt * 16 + fr, ks * 4 + fq));
            if (wv < 4) {
#pragma unroll
                for (int ks = 0; ks < 2; ++ks) accY = __builtin_amdgcn_mfma_f32_16x16x32_bf16(fuv[ks], *(const bf16x8*)(lds + NT + (c & 1) * 2048 + tile_off(fr, ks * 4 + fq)), accY, 0, 0, 0);
                *(float4*)(lds + YB + (fr * 64 + vt * 16 + 4 * fq) * 4) = make_float4(accY[0], accY[1], accY[2], accY[3]);
            }
#pragma unroll
            for (int k2 = 0; k2 < 2; ++k2) {
                const int kt = 2 * (wv >> 2) + k2;
                f32x4 a = accS[k2];
#pragma unroll
                for (int ks = 0; ks < 2; ++ks) a = __builtin_amdgcn_mfma_f32_16x16x32_bf16(*(const bf16x8*)(lds + BKT + (c & 1) * 8192 + tile_off2(kt * 16 + fr, ks * 4 + fq)), fuv[ks], a, 0, 0, 0);
                const float4 pl = *(const float4*)(lds + PL + (c & 3) * 256 + (kt * 16 + 4 * fq) * 4);
                a[0] *= pl.x; a[1] *= pl.y; a[2] *= pl.z; a[3] *= pl.w;
                accS[k2] = a;
                const unsigned h01 = pk_bf16(a[0], a[1]), h23 = pk_bf16(a[2], a[3]);
                const unsigned l01 = pk_bf16(a[0] - bf_lo(h01), a[1] - bf_hi(h01)), l23 = pk_bf16(a[2] - bf_lo(h23), a[3] - bf_hi(h23));
                const int kc = kt * 16 + 4 * fq;
                const int so = tile_off(vt * 16 + fr, kc >> 3) + (kc & 7) * 2;
                *(uint2*)(lds + SH + so) = make_uint2(h01, h23);
                *(uint2*)(lds + SL + so) = make_uint2(l01, l23);
            }
        };
        for (int i = tid; i < LDS_END / 16; i += NTHREADS) *(uint4*)(lds + i * 16) = make_uint4(0, 0, 0, 0);
        if (wv >= 4) { load_lora(0); load_rkv(0); }
        __syncthreads();
        if (wv >= 4) { step_up(0); load_lora(1); }
        __syncthreads();
        if (wv >= 4) { step_vec(0); step_up(1); load_rkv(1); load_lora(2); }
        __syncthreads();
        if (wv >= 4) prod_V(0);
        __syncthreads();
        auto ystore = [&](int c) {
            const float4 y4 = *(const float4*)(lds + YB + (s_e * 64 + j0) * 4);
            *(uint2*)(ydst + (size_t)Rof(c, s_e) * 1024 + hh * 64 + j0) = make_uint2(pk_bf16(y4.x, y4.y), pk_bf16(y4.z, y4.w));
        };
        if (wv < 4) {
            unsigned pfd = 0;
            for (int c = 0; c < 528; ++c) {
                if (c > 0) ystore(c - 1);
                if (c + 4 < 528 && tid < 80) {
                    const bf16_t* pf;
                    if (tid < 48) { const int ten = tid >> 4; pf = (ten == 0 ? rbuf : (ten == 1 ? kbuf : vbuf)) + (size_t)Rof(c + 4, tid & 15) * 1024 + hh * 64; }
                    else { const int i = tid - 48; pf = lora + (size_t)Rof(c + 4, i >> 1) * 384 + (i & 1) * 128 + d * 64; }
                    asm volatile("global_load_dword %0, %1, off" : "=v"(pfd) : "v"(pf) : "memory");
                }
                __builtin_amdgcn_s_setprio(3);
                prod_S(c);
                step_rec(c);
                __builtin_amdgcn_s_setprio(0);
                __syncthreads();
                step_upd(c);
                __syncthreads();
                asm volatile("" :: "v"(pfd));
            }
        } else {
            for (int c = 0; c < 528; ++c) {
                if (c + 1 < 528) step_vec(c + 1);
                if (c + 2 < 528) { step_up(c + 2); load_rkv(c + 2); }
                if (c + 3 < 528) load_lora(c + 3);
                __syncthreads();
                step_upd(c);
                if (c + 1 < 528) prod_V(c + 1);
                __syncthreads();
            }
        }
        if (wv < 4) ystore(527);
        __syncthreads();
    }
}

DEV void phase_rw_readout(const Params& p) {
    const int tid = tid_opaque(), lane = tid & 63, wv = tid >> 6, wm = wv >> 2, wn = wv & 3;
    const int fr = lane & 15, fq = lane >> 4;
    unsigned char* ws = p.ws;
    const bf16_t* y0b = (const bf16_t*)(ws + WS_S + 0 * U_BYTES);
    const bf16_t* y1b = (const bf16_t*)(ws + WS_S + 2 * U_BYTES);
    const bf16_t* vb = (const bf16_t*)(ws + WS_S + 1 * U_BYTES);
    const bf16_t* lora = (const bf16_t*)(ws + WS_S + 4 * U_BYTES);
    const bf16_t* g2t = (const bf16_t*)(ws + WS_G2T);
    bf16_t* ao = (bf16_t*)(ws + WS_S + 5 * U_BYTES);
    const float* bon0 = (const float*)(ws + WS_BONUS);
    const float* bon1 = bon0 + (size_t)NB * 16 * 8448;
    const float* lnw = p.in[21];
    const float* lnb = p.in[22];
    const int nunits = (NT / 128) * 4;
    for (int u = blockIdx.x; u < nunits; u += gridDim.x) {
        const int mt = u >> 2, nt = u & 3, m0 = mt * 128;
        const int hh = nt * 4 + wn;
        f32x4 acc[4][4];
#pragma unroll
        for (int mi = 0; mi < 4; ++mi)
#pragma unroll
            for (int ni = 0; ni < 4; ++ni) acc[mi][ni] = (f32x4){0.f, 0.f, 0.f, 0.f};
#pragma unroll 2
        for (int ks = 0; ks < 4; ++ks) {
            bf16x8 af[4], bfr[4];
#pragma unroll
            for (int mi = 0; mi < 4; ++mi) af[mi] = *(const bf16x8*)(lora + (size_t)(m0 + wm * 64 + mi * 16 + fr) * 384 + 256 + ks * 32 + fq * 8);
#pragma unroll
            for (int ni = 0; ni < 4; ++ni) bfr[ni] = *(const bf16x8*)(g2t + (size_t)(hh * 64 + 16 * (fr >> 2) + 4 * ni + (fr & 3)) * 128 + ks * 32 + fq * 8);
#pragma unroll
            for (int mi = 0; mi < 4; ++mi)
#pragma unroll
                for (int ni = 0; ni < 4; ++ni) acc[mi][ni] = __builtin_amdgcn_mfma_f32_16x16x32_bf16(bfr[ni], af[mi], acc[mi][ni], 0, 0, 0);
        }
#pragma unroll
        for (int mi = 0; mi < 4; ++mi) {
            const size_t R = (size_t)(m0 + wm * 64 + mi * 16 + fr);
            float yv[4][4]; float sum = 0.f;
            const int colb = hh * 64 + 16 * fq;
            {
                const uint4 a0 = *(const uint4*)(y0b + R * 1024 + colb), a1 = *(const uint4*)(y0b + R * 1024 + colb + 8);
                const uint4 c0 = *(const uint4*)(y1b + R * 1024 + colb), c1 = *(const uint4*)(y1b + R * 1024 + colb + 8);
                const unsigned aw[8] = {a0.x, a0.y, a0.z, a0.w, a1.x, a1.y, a1.z, a1.w}, cw[8] = {c0.x, c0.y, c0.z, c0.w, c1.x, c1.y, c1.z, c1.w};
#pragma unroll
                for (int ni = 0; ni < 4; ++ni) {
                    yv[ni][0] = bf_lo(aw[2 * ni]) + bf_lo(cw[2 * ni]); yv[ni][1] = bf_hi(aw[2 * ni]) + bf_hi(cw[2 * ni]);
                    yv[ni][2] = bf_lo(aw[2 * ni + 1]) + bf_lo(cw[2 * ni + 1]); yv[ni][3] = bf_hi(aw[2 * ni + 1]) + bf_hi(cw[2 * ni + 1]);
                    sum += (yv[ni][0] + yv[ni][1]) + (yv[ni][2] + yv[ni][3]);
                }
            }
            sum += __shfl_xor(sum, 16); sum += __shfl_xor(sum, 32);
            const float mu = sum * (1.0f / 64.0f);
            float q = 0.f;
#pragma unroll
            for (int ni = 0; ni < 4; ++ni)
#pragma unroll
                for (int j = 0; j < 4; ++j) { const float dlt = yv[ni][j] - mu; q += dlt * dlt; }
            q += __shfl_xor(q, 16); q += __shfl_xor(q, 32);
            const float rstd = rsqrtf(q * (1.0f / 64.0f) + 64e-5f);
            const size_t bidx = (size_t)(((R < NL ? (R >> 13) : ((R - NL) >> 8)) * 16 + hh)) * 8448 + (R < NL ? 256 + (R & 8191) : ((R - NL) & 255));
            const float bs = bon0[bidx] + bon1[bidx];
            const uint4 v0 = *(const uint4*)(vb + R * 1024 + colb), v1 = *(const uint4*)(vb + R * 1024 + colb + 8);
            const unsigned vw[8] = {v0.x, v0.y, v0.z, v0.w, v1.x, v1.y, v1.z, v1.w};
            unsigned ow[8];
#pragma unroll
            for (int ni = 0; ni < 4; ++ni) {
                const int col = colb + 4 * ni;
                const float4 lw = *(const float4*)(lnw + col), lb = *(const float4*)(lnb + col);
                const float o0 = ((yv[ni][0] - mu) * rstd * lw.x + lb.x + bs * bf_lo(vw[2 * ni])) * acc[mi][ni][0];
                const float o1 = ((yv[ni][1] - mu) * rstd * lw.y + lb.y + bs * bf_hi(vw[2 * ni])) * acc[mi][ni][1];
                const float o2 = ((yv[ni][2] - mu) * rstd * lw.z + lb.z + bs * bf_lo(vw[2 * ni + 1])) * acc[mi][ni][2];
                const float o3 = ((yv[ni][3] - mu) * rstd * lw.w + lb.w + bs * bf_hi(vw[2 * ni + 1])) * acc[mi][ni][3];
                ow[2 * ni] = pk_bf16(o0, o1); ow[2 * ni + 1] = pk_bf16(o2, o3);
            }
            *(uint4*)(ao + R * 1024 + colb) = make_uint4(ow[0], ow[1], ow[2], ow[3]);
            *(uint4*)(ao + R * 1024 + colb + 8) = make_uint4(ow[4], ow[5], ow[6], ow[7]);
        }
    }
}

DEV void phase_wo(const Params& p, unsigned char* lds, int layer) {
    unsigned char* ws = p.ws;
    const bf16_t* ao = (const bf16_t*)(ws + WS_S + (size_t)(layer ? 0 : 5) * U_BYTES);
    const bf16_t* wot = (const bf16_t*)(ws + (layer ? WS_WO1 : WS_WO0));
    float* ctxr = (float*)(ws + WS_CTXR);
    const float* gate = (const float*)(ws + WS_MOD) + (size_t)layer * 9 * 6144 + 2 * 1024;
    const int M = NL;
    pg8::Gemm g{ao, wot, M, 1024, 1024};
    pg8::StaticOrder so; so.init(M, 1024, gridDim.x, blockIdx.x);
    pg8::EpiResid256 ep{layer ? p.out : p.in[0], layer ? ctxr : p.in[2], p.out, ctxr, gate};
    pg8::gemm_phase((PG8_LAS unsigned char*)lds, g, so, ep, nullptr);
    __syncthreads();
    if (!layer)
        for (int u = blockIdx.x; u < (NC / 128) * 8; u += gridDim.x) {
            const int mt = u >> 3, nt = u & 7;
            ALoadPlain al{ao, 1024};
            EpiResid<2> ep2{p.in[0], p.in[2], p.out, ctxr, gate, nt * 128};
            gemm_unit<128>(lds, al, wot + (size_t)nt * 128 * 1024, 1024, NL + mt * 128, ep2);
        }
}

struct EpiQTile {
    unsigned char* lds;
    DEV void operator()(const f32x4 (&acc)[4][4], int m0, int wm, int wn, int fr, int fq) const {
        const int pp = wn >> 1;
#pragma unroll
        for (int mi = 0; mi < 4; ++mi) {
            const int m = wm * 64 + mi * 16 + fr;
#pragma unroll
            for (int ni = 0; ni < 4; ++ni) {
                const int c = (wn & 1) * 64 + ni * 16 + 4 * fq;
                *(uint2*)(lds + pp * 32768 + m * 256 + (((c >> 3) ^ (m & 15)) << 4) + (c & 7) * 2) = make_uint2(pk_bf16(acc[mi][ni][0], acc[mi][ni][1]), pk_bf16(acc[mi][ni][2], acc[mi][ni][3]));
            }
        }
    }
};
DEV void phase_peer_select(const Params& p, unsigned char* lds, int layer) {
    const int tid = tid_opaque(), lane = tid & 63, wv = tid >> 6, wm = wv >> 2, wn = wv & 3;
    const int fr = lane & 15, fq = lane >> 4;
    unsigned char* ws = p.ws;
    const bf16_t* hp = (const bf16_t*)(ws + WS_S + (size_t)(layer ? 0 : 1) * U_BYTES);
    const bf16_t* wqt = (const bf16_t*)(ws + WS_WQ) + (size_t)layer * 2048 * 1024;
    const bf16_t* keys = (const bf16_t*)(ws + WS_KEYS) + (size_t)layer * 8 * 2 * 128 * 128;
    int* pl_idx = (int*)(ws + WS_S + 3 * U_BYTES);
    float* pl_gate = (float*)(ws + WS_S + 3 * U_BYTES + (size_t)NT * 128 * 4);
    unsigned* slist = (unsigned*)lds;
    unsigned* tlist = (unsigned*)(lds + 256 * 132 * 4);
    const int mtiles = layer ? NL / 128 : NT / 128;
    for (int u = blockIdx.x; u < mtiles * 8; u += gridDim.x) {
        const int mt = u >> 3, head = u & 7, m0 = mt * 128;
        ALoadPlain al{hp, 1024};
        EpiQTile ep{lds};
        gemm_unit<256>(lds, al, wqt + (size_t)head * 256 * 1024, 1024, m0, ep);
        __syncthreads();
        const int pp = wn >> 1, nk0 = (wn & 1) * 64;
        f32x4 sc[4][4];
#pragma unroll
        for (int mi = 0; mi < 4; ++mi)
#pragma unroll
            for (int ni = 0; ni < 4; ++ni) sc[mi][ni] = (f32x4){0.f, 0.f, 0.f, 0.f};
        const bf16_t* kb = keys + (size_t)(head * 2 + pp) * 16384;
#pragma unroll
        for (int ks = 0; ks < 4; ++ks) {
            bf16x8 af[4], bfr[4];
            const int ch = ks * 4 + fq;
#pragma unroll
            for (int mi = 0; mi < 4; ++mi) { const int m = wm * 64 + mi * 16 + fr; af[mi] = *(const bf16x8*)(lds + pp * 32768 + m * 256 + ((ch ^ (m & 15)) << 4)); }
#pragma unroll
            for (int ni = 0; ni < 4; ++ni) bfr[ni] = *(const bf16x8*)(kb + (size_t)(nk0 + ni * 16 + fr) * 128 + ks * 32 + fq * 8);
#pragma unroll
            for (int mi = 0; mi < 4; ++mi)
#pragma unroll
                for (int ni = 0; ni < 4; ++ni) sc[mi][ni] = __builtin_amdgcn_mfma_f32_16x16x32_bf16(bfr[ni], af[mi], sc[mi][ni], 0, 0, 0);
        }
        __syncthreads();
#pragma unroll
        for (int mi = 0; mi < 4; ++mi) {
            const int m = wm * 64 + mi * 16 + fr;
#pragma unroll
            for (int ni = 0; ni < 4; ++ni) {
                const int n = nk0 + ni * 16 + 4 * fq;
                uint4 o;
                o.x = (mono_u32(sc[mi][ni][0]) & ~127u) | (unsigned)(127 - (n + 0));
                o.y = (mono_u32(sc[mi][ni][1]) & ~127u) | (unsigned)(127 - (n + 1));
                o.z = (mono_u32(sc[mi][ni][2]) & ~127u) | (unsigned)(127 - (n + 2));
                o.w = (mono_u32(sc[mi][ni][3]) & ~127u) | (unsigned)(127 - (n + 3));
                *(uint4*)(slist + (size_t)(pp * 128 + m) * 132 + n) = o;
            }
        }
        __syncthreads();
        {
            const int L = tid >> 1, g2 = tid & 1;
            unsigned t[64];
            {
                const unsigned* srcp = slist + (size_t)L * 132 + g2 * 64;
#pragma unroll
                for (int i = 0; i < 16; ++i) { const uint4 v = *(const uint4*)(srcp + i * 4); t[4 * i] = v.x; t[4 * i + 1] = v.y; t[4 * i + 2] = v.z; t[4 * i + 3] = v.w; }
            }
#pragma unroll
            for (int o = 0; o < 64; o += 16) {
#pragma unroll
                for (int pp2 = 1; pp2 < 16; pp2 <<= 1)
#pragma unroll
                    for (int k = pp2; k >= 1; k >>= 1)
#pragma unroll
                        for (int j = k % pp2; j <= 15 - k; j += 2 * k)
#pragma unroll
                            for (int i = 0; i < k; ++i) {
                                if (i + j + k <= 15 && (i + j) / (2 * pp2) == (i + j + k) / (2 * pp2)) {
                                    const unsigned mx = max(t[o + i + j], t[o + i + j + k]), mn = min(t[o + i + j], t[o + i + j + k]);
                                    t[o + i + j] = mx; t[o + i + j + k] = mn;
                                }
                            }
            }
#pragma unroll
            for (int rnd = 0; rnd < 4; ++rnd) {
                const int oa = rnd == 1 ? 32 : 0, ob = rnd == 0 ? 16 : (rnd == 1 ? 48 : 32);
                unsigned c[16];
#pragma unroll
                for (int i = 0; i < 16; ++i) {
                    unsigned b;
                    if (rnd < 3) b = t[ob + 15 - i];
                    else b = (unsigned)__builtin_amdgcn_update_dpp(0, (int)t[15 - i], 0xB1, 0xF, 0xF, false);
                    c[i] = max(t[oa + i], b);
                }
#pragma unroll
                for (int j = 8; j > 0; j >>= 1)
#pragma unroll
                    for (int i = 0; i < 16; ++i) {
                        const int l = i ^ j;
                        if (l > i) { const unsigned mx = max(c[i], c[l]), mn = min(c[i], c[l]); c[i] = mx; c[l] = mn; }
                    }
#pragma unroll
                for (int i = 0; i < 16; ++i) t[oa + i] = c[i];
            }
            if (g2 == 0) {
#pragma unroll
                for (int i = 0; i < 4; ++i) *(uint4*)(tlist + L * 16 + i * 4) = make_uint4(t[4 * i], t[4 * i + 1], t[4 * i + 2], t[4 * i + 3]);
            }
        }
        __syncthreads();
        if (tid < 128) {
            float v0[16], v1[16];
#pragma unroll
            for (int i = 0; i < 16; ++i) { v0[i] = unmono_u32(tlist[tid * 16 + i] & ~127u); v1[i] = unmono_u32(tlist[(128 + tid) * 16 + i] & ~127u); }
            unsigned cd[16];
#pragma unroll
            for (int i = 0; i < 16; ++i) cd[i] = 0u;
#pragma unroll
            for (int i = 0; i < 16; ++i) {
#pragma unroll
                for (int j = 0; j < 16; ++j) {
                    if ((i + 1) * (j + 1) <= 16) {
                        unsigned x = (mono_u32(v0[i] + v1[j]) & ~255u) | (unsigned)(255 - (i * 16 + j));
#pragma unroll
                        for (int q = (i + 1) * (j + 1) - 1; q < 16; ++q) { const unsigned mx = max(cd[q], x); x = min(cd[q], x); cd[q] = mx; }
                    }
                }
            }
            float sv[16]; int ex[16];
#pragma unroll
            for (int q = 0; q < 16; ++q) {
                const int slot = 255 - (int)(cd[q] & 255u);
                const unsigned a = tlist[tid * 16 + (slot >> 4)], b2 = tlist[(128 + tid) * 16 + (slot & 15)];
                sv[q] = unmono_u32(a & ~127u) + unmono_u32(b2 & ~127u);
                ex[q] = (127 - (int)(a & 127u)) * 128 + (127 - (int)(b2 & 127u));
            }
            float mx = sv[0];
#pragma unroll
            for (int q = 1; q < 16; ++q) mx = fmaxf(mx, sv[q]);
            float den = 0.f;
#pragma unroll
            for (int q = 0; q < 16; ++q) { sv[q] = __expf(sv[q] - mx); den += sv[q]; }
            const float rden = 1.0f / den;
            const size_t base = ((size_t)head * NT + (m0 + tid)) * 16;
#pragma unroll
            for (int i = 0; i < 4; ++i) {
                *(int4*)(pl_idx + base + i * 4) = make_int4(ex[4 * i], ex[4 * i + 1], ex[4 * i + 2], ex[4 * i + 3]);
                *(float4*)(pl_gate + base + i * 4) = make_float4(sv[4 * i] * rden, sv[4 * i + 1] * rden, sv[4 * i + 2] * rden, sv[4 * i + 3] * rden);
            }
        }
        __syncthreads();
    }
}

typedef float f32x2 __attribute__((ext_vector_type(2)));
typedef unsigned int u32x4 __attribute__((ext_vector_type(4)));
typedef unsigned int u32x2 __attribute__((ext_vector_type(2)));
#define PS_LOAD(buf, ee, h) { _Pragma("unroll") for (int e = 0; e < 8; ++e) { \
        const u32x4 t4 = __builtin_amdgcn_raw_buffer_load_b128(rs, ((unsigned)ee[(h) * 8 + e] << 7) + ch16, 0, 0); buf[e] = make_uint4(t4.x, t4.y, t4.z, t4.w); } }
#define PS_IDX(ee, Rr) { _Pragma("unroll") for (int i = 0; i < 4; ++i) { const int4 t = *(const int4*)(pl_idx + ((size_t)sub * NT + (Rr)) * 16 + 4 * i); \
        ee[4 * i] = t.x; ee[4 * i + 1] = t.y; ee[4 * i + 2] = t.z; ee[4 * i + 3] = t.w; } }
DEV long pk64(unsigned lo, unsigned hi) { return (long)(((unsigned long long)hi << 32) | (unsigned long long)lo); }
DEV void phase_peer_u(const Params& p, unsigned char* lds, int layer) {
    const int tid = tid_opaque(), lane = tid & 63, wv = tid >> 6, sub = lane >> 3, ch = lane & 7, fm = lane & 15, fg = lane >> 4;
    const int ng = gridDim.x >> 3, x = blockIdx.x & 7, wq = blockIdx.x >> 3;
    if (wq < ng) {
        const int gw = __builtin_amdgcn_readfirstlane(wq * 8 + wv), nw = ng * 8;
        unsigned char* ws = p.ws;
        const unsigned char* tab = ws + WS_PU + ((size_t)layer * 8 + x) * (16384 * 128);
        const int* pl_idx = (const int*)(ws + WS_S + 3 * U_BYTES);
        const unsigned char* xq = ws + WS_S + 2 * U_BYTES + (size_t)(fm & 1) * 1024 + 128 * x + 16 * fg;
        bf16_t* pd = (bf16_t*)(ws + WS_S + 5 * U_BYTES) + (size_t)x * NT * 128 + 16 * (fm >> 1) + 4 * fg;
        unsigned char* tile = lds + wv * 16384;
        const unsigned cE16 = 16u * (unsigned)(ch ^ (sub >> 1)), cO16 = cE16 ^ 64u;
        const unsigned aoff0 = (unsigned)fm * 128u + (unsigned)((fg ^ (fm >> 1)) << 4), aoff1 = (unsigned)fm * 128u + (unsigned)(((4 + fg) ^ (fm >> 1)) << 4);
        const int nrows = layer ? NL : NT;
        int eN[16];
#define PU_DMA(ee, q) { _Pragma("unroll") for (int j = 0; j < 4; ++j) { const int jj = (q) * 4 + j; \
        __builtin_amdgcn_global_load_lds((const unsigned*)(tab + (((unsigned)ee[jj] << 7) + ((jj & 1) ? cO16 : cE16))), (unsigned*)(tile + jj * 1024 + lane * 16), 16, 0, 0); } }
        const unsigned ta0 = (unsigned)(size_t)((LAS3 unsigned char*)tile) + aoff0, ta1 = (unsigned)(size_t)((LAS3 unsigned char*)tile) + aoff1;
#define PU_MMA(q) { u32x4 a0, a1, a2, a3; \
        asm volatile("ds_read_b128 %0, %4 offset:%6\n\tds_read_b128 %1, %5 offset:%6\n\tds_read_b128 %2, %4 offset:%7\n\tds_read_b128 %3, %5 offset:%7\n\ts_waitcnt lgkmcnt(0)" \
            : "=&v"(a0), "=&v"(a1), "=&v"(a2), "=&v"(a3) : "v"(ta0), "v"(ta1), "n"((q) * 4096), "n"((q) * 4096 + 2048) : "memory"); \
        f32x4 c4 = {0.f, 0.f, 0.f, 0.f}, c5 = {0.f, 0.f, 0.f, 0.f}; \
        c4 = __builtin_amdgcn_mfma_f32_16x16x32_fp8_fp8(pk64(a0.x, a0.y), pk64(bC0.x, bC0.y), c4, 0, 0, 0); \
        c5 = __builtin_amdgcn_mfma_f32_16x16x32_fp8_fp8(pk64(a2.x, a2.y), pk64(bC0.x, bC0.y), c5, 0, 0, 0); \
        c4 = __builtin_amdgcn_mfma_f32_16x16x32_fp8_fp8(pk64(a0.z, a0.w), pk64(bC0.z, bC0.w), c4, 0, 0, 0); \
        c5 = __builtin_amdgcn_mfma_f32_16x16x32_fp8_fp8(pk64(a2.z, a2.w), pk64(bC0.z, bC0.w), c5, 0, 0, 0); \
        c4 = __builtin_amdgcn_mfma_f32_16x16x32_fp8_fp8(pk64(a1.x, a1.y), pk64(bC1.x, bC1.y), c4, 0, 0, 0); \
        c5 = __builtin_amdgcn_mfma_f32_16x16x32_fp8_fp8(pk64(a3.x, a3.y), pk64(bC1.x, bC1.y), c5, 0, 0, 0); \
        c4 = __builtin_amdgcn_mfma_f32_16x16x32_fp8_fp8(pk64(a1.z, a1.w), pk64(bC1.z, bC1.w), c4, 0, 0, 0); \
        c5 = __builtin_amdgcn_mfma_f32_16x16x32_fp8_fp8(pk64(a3.z, a3.w), pk64(bC1.z, bC1.w), c5, 0, 0, 0); \
        acc[(q) * 2] = c4; acc[(q) * 2 + 1] = c5; }
        int R = gw;
#pragma unroll
        for (int i = 0; i < 16; ++i) eN[i] = 0;
        uint4 bC0 = make_uint4(0, 0, 0, 0), bC1 = bC0;
        if (R < nrows) {
            PS_IDX(eN, R);
            PU_DMA(eN, 0); PU_DMA(eN, 1); PU_DMA(eN, 2); PU_DMA(eN, 3);
            bC0 = *(const uint4*)(xq + (size_t)R * 2048); bC1 = *(const uint4*)(xq + (size_t)R * 2048 + 64);
            const int R1 = min(R + nw, nrows - 1);
            PS_IDX(eN, R1);
            asm volatile("s_waitcnt vmcnt(0)" : "+v"(bC0.x), "+v"(bC1.x), "+v"(eN[0]), "+v"(eN[4]), "+v"(eN[8]), "+v"(eN[12]) :: "memory");
        }
        for (; R < nrows; R += nw) {
            const int Rn = R + nw, R1 = min(Rn, nrows - 1), R2 = min(Rn + nw, nrows - 1);
            const bool more = Rn < nrows;
            u32x4 i0, i1, i2, i3, nb0, nb1;
            {
                const int* iptr = pl_idx + ((size_t)sub * NT + R2) * 16;
                const unsigned char* xptr = xq + (size_t)R1 * 2048;
                asm volatile("global_load_dwordx4 %0, %6, off\n\tglobal_load_dwordx4 %1, %6, off offset:16\n\tglobal_load_dwordx4 %2, %6, off offset:32\n\tglobal_load_dwordx4 %3, %6, off offset:48\n\t"
                             "global_load_dwordx4 %4, %7, off\n\tglobal_load_dwordx4 %5, %7, off offset:64"
                             : "=&v"(i0), "=&v"(i1), "=&v"(i2), "=&v"(i3), "=&v"(nb0), "=&v"(nb1) : "v"(iptr), "v"(xptr) : "memory");
            }
            f32x4 acc[8];
#define PU_STEP(q) { if (more) asm volatile("s_waitcnt vmcnt(19)" ::: "memory"); else asm volatile("s_waitcnt vmcnt(0)" ::: "memory"); \
            PU_MMA(q); if (more) { PU_DMA(eN, q); } }
            PU_STEP(0); PU_STEP(1); PU_STEP(2); PU_STEP(3);
            f32x4 s0[4], s1[2], s2;
#pragma unroll
            for (int i = 0; i < 4; ++i)
#pragma unroll
                for (int r = 0; r < 4; ++r) s0[i][r] = (fm & 2) ? acc[2 * i + 1][r] : acc[2 * i][r];
#pragma unroll
            for (int i = 0; i < 2; ++i)
#pragma unroll
                for (int r = 0; r < 4; ++r) s1[i][r] = (fm & 4) ? s0[2 * i + 1][r] : s0[2 * i][r];
#pragma unroll
            for (int r = 0; r < 4; ++r) { const float t = (fm & 8) ? s1[1][r] : s1[0][r]; s2[r] = t + dpp_quad<0xB1>(t); }
            if (!(fm & 1)) *(uint2*)(pd + (size_t)R * 128) = make_uint2(pk_bf16(s2[0], s2[1]), pk_bf16(s2[2], s2[3]));
            if (more) asm volatile("s_waitcnt vmcnt(17)" : "+v"(i0), "+v"(i1), "+v"(i2), "+v"(i3), "+v"(nb0), "+v"(nb1) :: "memory");
            else asm volatile("s_waitcnt vmcnt(0)" : "+v"(i0), "+v"(i1), "+v"(i2), "+v"(i3), "+v"(nb0), "+v"(nb1) :: "memory");
            eN[0] = i0.x; eN[1] = i0.y; eN[2] = i0.z; eN[3] = i0.w; eN[4] = i1.x; eN[5] = i1.y; eN[6] = i1.z; eN[7] = i1.w;
            eN[8] = i2.x; eN[9] = i2.y; eN[10] = i2.z; eN[11] = i2.w; eN[12] = i3.x; eN[13] = i3.y; eN[14] = i3.z; eN[15] = i3.w;
            bC0 = make_uint4(nb0.x, nb0.y, nb0.z, nb0.w); bC1 = make_uint4(nb1.x, nb1.y, nb1.z, nb1.w);
        }
        asm volatile("s_waitcnt vmcnt(0)" ::: "memory");
    }
}
DEV void phase_peer_c(const Params& p, int layer) {
    const int tid = tid_opaque(), lane = tid & 63;
    const int gw = blockIdx.x * 8 + (tid >> 6), nw = gridDim.x * 8;
    unsigned char* ws = p.ws;
    const float* usc = (const float*)(ws + WS_PSC) + layer * 16384;
    const float* vsc = (const float*)(ws + WS_PSC) + 32768 + layer * 16384;
    const int* pl_idx = (const int*)(ws + WS_S + 3 * U_BYTES);
    const float* pl_gate = (const float*)(ws + WS_S + 3 * U_BYTES + (size_t)NT * 128 * 4);
    float* pd = (float*)(ws + WS_S + 4 * U_BYTES);
    const bf16_t* pdh = (const bf16_t*)(ws + WS_S + 5 * U_BYTES);
    const int nrows = layer ? NL : NT;
    const int head0 = 2 * (lane & 3), kk = lane >> 2;
    for (int R = gw; R < nrows; R += nw) {
        float d0 = 0.f, d1 = 0.f;
#pragma unroll
        for (int xx = 0; xx < 8; ++xx) { const unsigned t = *(const unsigned*)(pdh + ((size_t)xx * NT + R) * 128 + 2 * lane); d0 += bf_lo(t); d1 += bf_hi(t); }
        const size_t po = ((size_t)head0 * NT + R) * 16 + kk;
        const int e0 = pl_idx[po], e1 = pl_idx[po + (size_t)NT * 16];
        const float g0 = pl_gate[po], g1 = pl_gate[po + (size_t)NT * 16];
        d0 *= usc[e0] * 0.25f; d1 *= usc[e1] * 0.25f;
        const float c0 = g0 * vsc[e0] * 0.5f * d0 * (1.0f + erff(d0 * 0.70710678118f));
        const float c1 = g1 * vsc[e1] * 0.5f * d1 * (1.0f + erff(d1 * 0.70710678118f));
        pd[(size_t)R * 128 + 16 * head0 + kk] = c0;
        pd[(size_t)R * 128 + 16 * head0 + 16 + kk] = c1;
    }
}
DEV void phase_peer_v(const Params& p, int layer) {
    const int tid = tid_opaque(), lane = tid & 63, sub = lane >> 3, ch = lane & 7;
    const int ng = gridDim.x >> 3, x = blockIdx.x & 7, wq = blockIdx.x >> 3;
    if (wq < ng) {
        const int gw = __builtin_amdgcn_readfirstlane(wq * 8 + (tid >> 6)), nw = ng * 8;
        unsigned char* ws = p.ws;
        const __amdgpu_buffer_rsrc_t rs = __builtin_amdgcn_make_buffer_rsrc((void*)(ws + WS_PV + ((size_t)layer * 8 + x) * (16384 * 128)), 0, 16384 * 128, 0x00020000);
        const int* pl_idx = (const int*)(ws + WS_S + 3 * U_BYTES);
        const float* cb = (const float*)(ws + WS_S + 4 * U_BYTES) + 16 * sub;
        float* ctxr = (float*)(ws + WS_CTXR);
        const float* mods = (const float*)(ws + WS_MOD) + (size_t)layer * 9 * 6144 + 5 * 1024;
        const unsigned ch16 = 16u * (unsigned)ch;
        const int col = 128 * x + 16 * ch + 2 * sub;
        const int nrows = layer ? NL : NT;
        uint4 bufA[8], bufB[8];
        int eC[16], eN[16];
        float cC[16], cN[16];
#define PS_CF(cc, Rr) { _Pragma("unroll") for (int i = 0; i < 4; ++i) { const float4 t = *(const float4*)(cb + (size_t)(Rr) * 128 + 4 * i); \
        cc[4 * i] = t.x; cc[4 * i + 1] = t.y; cc[4 * i + 2] = t.z; cc[4 * i + 3] = t.w; } }
#define PV_FMA(accv, av) asm("v_fma_f32 %0, %1, %2, %0" : "+v"(accv) : "v"(cf), "v"(av))
#define PV_AXPY(buf, h) { _Pragma("unroll") for (int e = 0; e < 8; ++e) { \
        const float cf = cC[(h) * 8 + e]; const unsigned vw[4] = {buf[e].x, buf[e].y, buf[e].z, buf[e].w}; \
        _Pragma("unroll") for (int i = 0; i < 4; ++i) { \
            const f32x2 a = __builtin_amdgcn_cvt_pk_f32_fp8((int)vw[i], false), b2 = __builtin_amdgcn_cvt_pk_f32_fp8((int)vw[i], true); \
            PV_FMA(a16[4 * i], a.x); PV_FMA(a16[4 * i + 1], a.y); PV_FMA(a16[4 * i + 2], b2.x); PV_FMA(a16[4 * i + 3], b2.y); } } }
        int R = gw;
#pragma unroll
        for (int i = 0; i < 16; ++i) { eC[i] = 0; eN[i] = 0; cC[i] = 0.f; cN[i] = 0.f; }
        if (R < nrows) { PS_IDX(eC, R); PS_CF(cC, R); PS_LOAD(bufA, eC, 0); }
        for (; R < nrows; R += nw) {
            const int Rn = R + nw;
            if (Rn < nrows) { PS_IDX(eN, Rn); PS_CF(cN, Rn); }
            PS_LOAD(bufB, eC, 1);
            float* xrow = (R < NL ? p.out + (size_t)R * 1024 : ctxr + (size_t)(R - NL) * 1024) + col;
            const float2 xa = *(const float2*)xrow, ga = *(const float2*)(mods + (size_t)mod_batch(R) * 6144 + col);
            float a16[16];
#pragma unroll
            for (int i = 0; i < 16; ++i) a16[i] = 0.f;
            PV_AXPY(bufA, 0);
            if (Rn < nrows) { PS_LOAD(bufA, eN, 0); }
            PV_AXPY(bufB, 1);
            float s8[8], t4[4];
#pragma unroll
            for (int j = 0; j < 8; ++j) { const u32x2 r = __builtin_amdgcn_permlane32_swap(__float_as_uint(a16[j]), __float_as_uint(a16[8 + j]), false, false); s8[j] = __uint_as_float(r.x) + __uint_as_float(r.y); }
#pragma unroll
            for (int j = 0; j < 4; ++j) { const u32x2 r = __builtin_amdgcn_permlane16_swap(__float_as_uint(s8[j]), __float_as_uint(s8[4 + j]), false, false); t4[j] = __uint_as_float(r.x) + __uint_as_float(r.y); }
            const float wa0 = t4[0] + dpp_ror<8>(t4[0]), wa1 = t4[1] + dpp_ror<8>(t4[1]), wb0 = t4[2] + dpp_ror<8>(t4[2]), wb1 = t4[3] + dpp_ror<8>(t4[3]);
            const float w0 = (lane & 8) ? wb0 : wa0, w1 = (lane & 8) ? wb1 : wa1;
            *(float2*)xrow = make_float2(xa.x + ga.x * w0, xa.y + ga.y * w1);
#pragma unroll
            for (int i = 0; i < 16; ++i) { eC[i] = eN[i]; cC[i] = cN[i]; }
        }
    }
}
DEV void phase_final_norm(const Params& p) {
    const int tid = tid_opaque(), lane = tid & 63;
    const int gw = blockIdx.x * 8 + (tid >> 6), nw = gridDim.x * 8;
    const float* gn = p.in[34];
    for (int R = gw; R < NL; R += nw) {
        float* xr = p.out + (size_t)R * 1024;
        float4 v[4]; float ss = 0.f;
#pragma unroll
        for (int i = 0; i < 4; ++i) { v[i] = *(const float4*)(xr + i * 256 + lane * 4); ss += v[i].x * v[i].x + v[i].y * v[i].y + v[i].z * v[i].z + v[i].w * v[i].w; }
        ss = wave_allreduce(ss);
        const float rs = rsqrtf(ss * (1.0f / 1024.0f) + 1e-6f);
#pragma unroll
        for (int i = 0; i < 4; ++i) {
            const float4 gg = *(const float4*)(gn + i * 256 + lane * 4);
            *(float4*)(xr + i * 256 + lane * 4) = make_float4(v[i].x * rs * gg.x, v[i].y * rs * gg.y, v[i].z * rs * gg.z, v[i].w * rs * gg.w);
        }
    }
}

DEV void phase_gla_proj(const Params& p, unsigned char* lds) {
    unsigned char* ws = p.ws;
    const bf16_t* h = (const bf16_t*)(ws + WS_S + 0 * U_BYTES);
    const bf16_t* wint = (const bf16_t*)(ws + WS_WIN);
    {
        pg8::Gemm g{h, wint, NT, 3072, 1024};
        pg8::StaticOrder so; so.init(NT, 3072, gridDim.x, blockIdx.x);
        pg8::EpiBf16Tiles ep{(bf16_t*)(ws + WS_S + 1 * U_BYTES), 2048, 8, (bf16_t*)(ws + WS_S + 3 * U_BYTES), 1024};
        pg8::gemm_phase(( PG8_LAS unsigned char*)lds, g, so, ep, nullptr);
    }
    __syncthreads();
    for (int u = blockIdx.x; u < NT / 128; u += gridDim.x) {
        ALoadPlain al{h, 1024};
        EpiLr ep{(float*)(ws + WS_LR)};
        gemm_unit<128>(lds, al, wint + (size_t)3072 * 1024, 1024, u * 128, ep);
    }
}

DEV void conv_emit(const float (&acc)[8], int c, bf16_t* dst) {
    const float qs = (c < 512) ? 0.08838834764831845f : 1.0f;
    unsigned ow[4];
#pragma unroll
    for (int j = 0; j < 4; ++j) { const float a0 = acc[2 * j], a1 = acc[2 * j + 1]; ow[j] = pk_bf16(a0 * sigmoidf_(a0) * qs, a1 * sigmoidf_(a1) * qs); }
    *(uint4*)dst = make_uint4(ow[0], ow[1], ow[2], ow[3]);
}
DEV void conv_tap(float (&acc)[8], const uint4& v, const float (&w)[8]) {
    acc[0] += bf_lo(v.x) * w[0]; acc[1] += bf_hi(v.x) * w[1]; acc[2] += bf_lo(v.y) * w[2]; acc[3] += bf_hi(v.y) * w[3];
    acc[4] += bf_lo(v.z) * w[4]; acc[5] += bf_hi(v.z) * w[5]; acc[6] += bf_lo(v.w) * w[6]; acc[7] += bf_hi(v.w) * w[7];
}
DEV void phase_gla_conv(const Params& p) {
    const int tid = tid_opaque();
    unsigned char* ws = p.ws;
    const bf16_t* z = (const bf16_t*)(ws + WS_S + 1 * U_BYTES);
    bf16_t* o = (bf16_t*)(ws + WS_S + 4 * U_BYTES);
    const float* cw = p.in[25];
    const int x = tid >> 3, cl = (tid & 7) * 8;
    for (int task = blockIdx.x; task < 8 * 32; task += gridDim.x) {
        const int cb = task & 31, b = task >> 5;
        const int c = cb * 64 + cl;
        float w[9][8];
#pragma unroll
        for (int t = 0; t < 9; ++t) { const float4 w0 = *(const float4*)(cw + t * 2048 + c), w1 = *(const float4*)(cw + t * 2048 + c + 4); w[t][0] = w0.x; w[t][1] = w0.y; w[t][2] = w0.z; w[t][3] = w0.w; w[t][4] = w1.x; w[t][5] = w1.y; w[t][6] = w1.z; w[t][7] = w1.w; }
        const uint4 zero4 = make_uint4(0, 0, 0, 0);
        auto load_row = [&](int y, uint4 (&r)[3]) {
            if (y < 0 || y >= 128) { r[0] = zero4; r[1] = zero4; r[2] = zero4; return; }
            const bf16_t* row = z + ((size_t)b * 8192 + (size_t)y * 64 + x) * 2048 + c;
            r[1] = *(const uint4*)row;
            r[0] = (x > 0) ? *(const uint4*)(row - 2048) : zero4;
            r[2] = (x < 63) ? *(const uint4*)(row + 2048) : zero4;
        };
        uint4 rr[8][3];
        load_row(-1, rr[7]);
#pragma unroll
        for (int s = 0; s < 6; ++s) load_row(s, rr[s]);
#pragma unroll 1
        for (int yb = 0; yb < 128; yb += 8) {
#pragma unroll
            for (int s = 0; s < 8; ++s) {
                const int y = yb + s;
                load_row(y + 6, rr[(s + 6) & 7]);
                float acc[8];
#pragma unroll
                for (int j = 0; j < 8; ++j) acc[j] = 0.f;
#pragma unroll
                for (int dx = 0; dx < 3; ++dx) { conv_tap(acc, rr[(s + 7) & 7][dx], w[dx]); conv_tap(acc, rr[s][dx], w[3 + dx]); conv_tap(acc, rr[(s + 1) & 7][dx], w[6 + dx]); }
                conv_emit(acc, c, o + ((size_t)b * 8192 + (size_t)y * 64 + x) * 2048 + c);
            }
        }
    }
    for (int task = blockIdx.x; task < (NC / 64) * 8; task += gridDim.x) {
        const int rb = task >> 3, cbk = task & 7;
        const int R = NL + rb * 64 + (tid >> 3);
        const int t = (R - NL) & 255;
#pragma unroll 1
        for (int i = 0; i < 4; ++i) {
            const int c = cbk * 256 + (tid & 7) * 8 + i * 64;
            float acc[8];
#pragma unroll
            for (int j = 0; j < 8; ++j) acc[j] = 0.f;
#pragma unroll
            for (int dx = -1; dx <= 1; ++dx) {
                if (t + dx >= 0 && t + dx < 256) {
                    const uint4 v = *(const uint4*)(z + (size_t)(R + dx) * 2048 + c);
                    const float* wp = cw + (3 + (dx + 1)) * 2048 + c;
                    const float4 w0 = *(const float4*)wp, w1 = *(const float4*)(wp + 4);
                    const float wv[8] = {w0.x, w0.y, w0.z, w0.w, w1.x, w1.y, w1.z, w1.w};
                    conv_tap(acc, v, wv);
                }
            }
            conv_emit(acc, c, o + (size_t)R * 2048 + c);
        }
    }
}

constexpr int GT_QE = 0, GT_KET = 16384, GT_A = 32768, GT_CONST = 40960, GT_STRIDE = 43008;
constexpr int GT_N0 = (int)((2 * U_BYTES) / GT_STRIDE);
constexpr size_t WS_TOTAL = 1073741824ull;
static_assert((size_t)(NB * 4 * 2 * 132 - GT_N0) * GT_STRIDE <= WS_TOTAL - WS_END, "tile records do not fit");
DEV size_t gla_tile_off(int b, int hd, int d, int cc) {
    const int idx = (((b * 4 + hd) * 2 + d) * 132) + cc;
    return idx < GT_N0 ? WS_S + (size_t)idx * GT_STRIDE : WS_END + (size_t)(idx - GT_N0) * GT_STRIDE;
}
DEV int gla_row0(int b, int cc) { return cc < 4 ? NL + b * 256 + cc * 64 : b * 8192 + (cc - 4) * 64; }
DEV void phase_gla_prep(const Params& p, unsigned char* lds) {
    const int tid = tid_opaque(), lane = tid & 63, wv = tid >> 6;
    const int fr = lane & 15, fq = lane >> 4;
    unsigned char* ws = p.ws;
    constexpr int QE = 0, KE = 16384, KET = 32768, BC = 49152  , GS = 82944  , LRL = 86528  , BCS = 132;
    const bf16_t* qkv = (const bf16_t*)(ws + WS_S + 4 * U_BYTES);
    const float* lrb = (const float*)(ws + WS_LR);
    unsigned char* gt = ws;
    float* bc = (float*)(lds + BC);
    float* gs = (float*)(lds + GS);
    const int li = tid >> 3, lc = tid & 7;
    const int d = blockIdx.x & 1, hd = (blockIdx.x >> 1) & 3;
    bf16x8 gkf;
    {
        unsigned w4[4] = {0u, 0u, 0u, 0u};
        if (fq < 2) {
#pragma unroll
            for (int e2 = 0; e2 < 4; ++e2) {
                const float g0 = p.in[26][(size_t)(d * 16 + 8 * fq + 2 * e2) * 512 + hd * 128 + wv * 16 + fr];
                const float g1 = p.in[26][(size_t)(d * 16 + 8 * fq + 2 * e2 + 1) * 512 + hd * 128 + wv * 16 + fr];
                w4[e2] = pk_bf16(g0, g1);
            }
        }
        gkf = as_bf16x8(make_uint4(w4[0], w4[1], w4[2], w4[3]));
    }
    const float4 gb4 = *(const float4*)(p.in[27] + d * 512 + hd * 128 + wv * 16 + 4 * fq);
    const int qstep = (int)(gridDim.x >> 3);
    uint4 nq0, nq1, nk0, nk1; float2 nl;
    auto fetch = [&](int q) {
        const size_t R = (size_t)(gla_row0(q / 132, q % 132) + li);
        const bf16_t* row = qkv + R * 2048;
        nq0 = *(const uint4*)(row + hd * 128 + lc * 8); nq1 = *(const uint4*)(row + hd * 128 + 64 + lc * 8);
        nk0 = *(const uint4*)(row + 512 + hd * 128 + lc * 8); nk1 = *(const uint4*)(row + 512 + hd * 128 + 64 + lc * 8);
        nl = *(const float2*)(lrb + R * 32 + d * 16 + lc * 2);
    };
    int q = (int)(blockIdx.x >> 3);
    if (q < NB * 132) fetch(q);
    for (; q < NB * 132; q += qstep) {
        const int cc = q % 132, b = q / 132;
        unsigned char* rec = gt + gla_tile_off(b, hd, d, cc);
        const uint4 rq0 = nq0, rq1 = nq1, rk0 = nk0, rk1 = nk1; const float2 rl = nl;
        if (q + qstep < NB * 132) fetch(q + qstep);
        *(unsigned*)(lds + LRL + li * 32 + lc * 4) = pk_bf16(rl.x, rl.y);
        __syncthreads();
        {
            const float gbv[4] = {gb4.x, gb4.y, gb4.z, gb4.w};
#pragma unroll
            for (int itl = 0; itl < 4; ++itl) {
                uint4 lr4 = *(const uint4*)(lds + LRL + (itl * 16 + fr) * 32 + (fq & 1) * 16);
                if (fq >= 2) lr4 = make_uint4(0, 0, 0, 0);
                f32x4 a = {0.f, 0.f, 0.f, 0.f};
                a = __builtin_amdgcn_mfma_f32_16x16x32_bf16(gkf, as_bf16x8(lr4), a, 0, 0, 0);
                float s[4], tot[4];
#pragma unroll
                for (int j = 0; j < 4; ++j) {
                    const float xx = a[j] + gbv[j];
                    const float la = (fminf(xx, 0.f) - __logf(1.0f + __expf(-fabsf(xx)))) * (1.0f / 16.0f);
                    float pf = la;
                    pf += dpp_shr0<1>(pf); pf += dpp_shr0<2>(pf); pf += dpp_shr0<4>(pf); pf += dpp_shr0<8>(pf);
                    tot[j] = __shfl(pf, (lane & 48) | 15);
                    s[j] = d ? (tot[j] - pf + la) : pf;
                }
                *(float4*)(bc + (itl * 16 + fr) * BCS + wv * 16 + 4 * fq) = make_float4(s[0], s[1], s[2], s[3]);
                if (fr == 15) *(float4*)(gs + itl * 128 + wv * 16 + 4 * fq) = make_float4(tot[0], tot[1], tot[2], tot[3]);
            }
        }
        __syncthreads();
        if (tid < 128) {
            const float g0 = gs[tid], g1 = gs[128 + tid], g2 = gs[256 + tid], g3 = gs[384 + tid];
            const float refc = d ? (bc[31 * BCS + tid] + g2 + g3) : (bc[32 * BCS + tid] + g0 + g1), lastc = g0 + g1 + g2 + g3;
            const float dl = __expf(lastc), er = __expf(refc), el = __expf(lastc - refc);
            gs[512 + tid] = refc;
            float* cst = (float*)(rec + GT_CONST);
            cst[tid] = er; cst[128 + tid] = el; cst[256 + tid] = dl;
        }
        __syncthreads();
        {
            const int grp = li >> 4;
            const uint4 rqs[2] = {rq0, rq1}, rks[2] = {rk0, rk1};
#pragma unroll
            for (int hseg = 0; hseg < 2; ++hseg) {
                const int k0 = hseg * 64 + lc * 8;
                float bcv[8], refv[8];
#pragma unroll
                for (int j4 = 0; j4 < 2; ++j4) {
                    const float4 g0 = *(const float4*)(gs + k0 + j4 * 4), g1 = *(const float4*)(gs + 128 + k0 + j4 * 4);
                    const float4 g2 = *(const float4*)(gs + 256 + k0 + j4 * 4), g3 = *(const float4*)(gs + 384 + k0 + j4 * 4);
                    const float4 bi = *(const float4*)(bc + li * BCS + k0 + j4 * 4), rf = *(const float4*)(gs + 512 + k0 + j4 * 4);
                    const float g0a[4] = {g0.x, g0.y, g0.z, g0.w}, g1a[4] = {g1.x, g1.y, g1.z, g1.w}, g2a[4] = {g2.x, g2.y, g2.z, g2.w}, g3a[4] = {g3.x, g3.y, g3.z, g3.w};
                    const float bia[4] = {bi.x, bi.y, bi.z, bi.w}, rfa[4] = {rf.x, rf.y, rf.z, rf.w};
#pragma unroll
                    for (int j = 0; j < 4; ++j) {
                        const float pre = d ? ((grp < 1 ? g1a[j] : 0.f) + (grp < 2 ? g2a[j] : 0.f) + (grp < 3 ? g3a[j] : 0.f))
                                            : ((grp > 0 ? g0a[j] : 0.f) + (grp > 1 ? g1a[j] : 0.f) + (grp > 2 ? g2a[j] : 0.f));
                        bcv[j4 * 4 + j] = bia[j] + pre;
                        refv[j4 * 4 + j] = rfa[j];
                    }
                }
                const unsigned qw[4] = {rqs[hseg].x, rqs[hseg].y, rqs[hseg].z, rqs[hseg].w}, kw[4] = {rks[hseg].x, rks[hseg].y, rks[hseg].z, rks[hseg].w};
                unsigned oqe[4], oke[4];
#pragma unroll
                for (int j2 = 0; j2 < 4; ++j2) {
                    const float q0 = bf_lo(qw[j2]), q1 = bf_hi(qw[j2]), kk0 = bf_lo(kw[j2]), kk1 = bf_hi(kw[j2]);
                    const float e0 = __expf(bcv[2 * j2] - refv[2 * j2]), e1 = __expf(bcv[2 * j2 + 1] - refv[2 * j2 + 1]);
                    const float r0 = __builtin_amdgcn_rcpf(e0), r1 = __builtin_amdgcn_rcpf(e1);
                    oqe[j2] = pk_bf16(q0 * e0, q1 * e1);
                    oke[j2] = pk_bf16(kk0 * r0, kk1 * r1);
                    const int kc0 = k0 + 2 * j2;
                    *(bf16_t*)(lds + KET + tile_off2(kc0, li >> 3) + (li & 7) * 2) = (bf16_t)(oke[j2] & 0xffffu);
                    *(bf16_t*)(lds + KET + tile_off2(kc0 + 1, li >> 3) + (li & 7) * 2) = (bf16_t)(oke[j2] >> 16);
                }
                const int chq = hseg * 8 + lc;
                const int so = li * 256 + ((chq ^ (li & 15)) << 4);
                *(uint4*)(lds + QE + so) = make_uint4(oqe[0], oqe[1], oqe[2], oqe[3]);
                *(uint4*)(lds + KE + so) = make_uint4(oke[0], oke[1], oke[2], oke[3]);
                *(uint4*)(rec + GT_QE + so) = make_uint4(oqe[0], oqe[1], oqe[2], oqe[3]);
            }
        }
        __syncthreads();
        {
            const int it = wv & 3, pr2 = wv >> 2;
#pragma unroll
            for (int jj = 0; jj < 2; ++jj) {
                const int jt = pr2 * 2 + jj;
                f32x4 a = {0.f, 0.f, 0.f, 0.f};
                if (d ? (jt >= it) : (jt <= it)) {
#pragma unroll
                    for (int ks = 0; ks < 4; ++ks) {
                        const int ch = ks * 4 + fq;
                        const int rj = jt * 16 + fr, ri = it * 16 + fr;
                        const bf16x8 fa = *(const bf16x8*)(lds + KE + rj * 256 + ((ch ^ (rj & 15)) << 4));
                        const bf16x8 fb = *(const bf16x8*)(lds + QE + ri * 256 + ((ch ^ (ri & 15)) << 4));
                        a = __builtin_amdgcn_mfma_f32_16x16x32_bf16(fa, fb, a, 0, 0, 0);
                    }
                }
                const int i = it * 16 + fr, j = jt * 16 + 4 * fq;
                float av[4];
#pragma unroll
                for (int e = 0; e < 4; ++e) av[e] = (d ? (j + e >= i) : (j + e <= i)) ? a[e] : 0.f;
                *(uint2*)(rec + GT_A + i * 128 + (((j >> 3) ^ (i & 7)) << 4) + (j & 7) * 2) = make_uint2(pk_bf16(av[0], av[1]), pk_bf16(av[2], av[3]));
            }
#pragma unroll
            for (int i = 0; i < 2; ++i) *(uint4*)(rec + GT_KET + i * 8192 + tid * 16) = *(const uint4*)(lds + KET + i * 8192 + tid * 16);
        }
        __syncthreads();
    }
}

DEV void phase_gla_scan(const Params& p, unsigned char* lds) {
    const int tid = tid_opaque(), lane = tid & 63, wv = tid >> 6;
    const int fr = lane & 15, fq = lane >> 4;
    unsigned char* ws = p.ws;
    constexpr int QE = 0  , KET = 32768  , AL = 65536  , VT = 81920, ST = 90112  ;
    const bf16_t* qkv = (const bf16_t*)(ws + WS_S + 4 * U_BYTES);
    const unsigned char* gt = ws;
    for (int unit = blockIdx.x; unit < 256; unit += gridDim.x) {
        const int vs = unit & 3, d = (unit >> 2) & 1, hd = (unit >> 3) & 3, b = unit >> 5;
        bf16_t* odst = d ? (bf16_t*)(ws + WS_S + 2 * U_BYTES) : (bf16_t*)(ws + WS_S + 4 * U_BYTES);
        const int old_ = d ? 1024 : 2048;
        const int li = tid >> 3, lc = tid & 7;
        auto ccof = [&](int c) -> int { return d ? (c < 4 ? 3 - c : 135 - c) : c; };
        auto dma = [&](int cc, int buf) {
            const unsigned char* rec = gt + gla_tile_off(b, hd, d, cc);
#pragma unroll
            for (int i = 0; i < 2; ++i) {
                __builtin_amdgcn_global_load_lds((const unsigned*)(rec + GT_QE + i * 8192 + tid * 16), (unsigned*)(lds + QE + buf * 16384 + i * 8192 + tid * 16), 16, 0, 0);
                __builtin_amdgcn_global_load_lds((const unsigned*)(rec + GT_KET + i * 8192 + tid * 16), (unsigned*)(lds + KET + buf * 16384 + i * 8192 + tid * 16), 16, 0, 0);
            }
            __builtin_amdgcn_global_load_lds((const unsigned*)(rec + GT_A + tid * 16), (unsigned*)(lds + AL + buf * 8192 + tid * 16), 16, 0, 0);
        };
        uint4 nv; float4 n_dl, n_el, n_er;
        auto loads = [&](int c) {
            const int cc = ccof(c);
            nv = *(const uint4*)(qkv + (size_t)(gla_row0(b, cc) + li) * 2048 + 1024 + hd * 256 + vs * 64 + lc * 8);
            const float* cst = (const float*)(gt + gla_tile_off(b, hd, d, cc) + GT_CONST);
            n_el = *(const float4*)(cst + 128 + wv * 16 + 4 * fq); n_dl = *(const float4*)(cst + 256 + wv * 16 + 4 * fq);
            if (c + 1 < 132) n_er = *(const float4*)((const float*)(gt + gla_tile_off(b, hd, d, ccof(c + 1)) + GT_CONST) + wv * 16 + 4 * fq);
            else n_er = make_float4(0.f, 0.f, 0.f, 0.f);
        };
        f32x4 accS[4];
#pragma unroll
        for (int i = 0; i < 4; ++i) accS[i] = (f32x4){0.f, 0.f, 0.f, 0.f};
        for (int i = tid; i < 32768 / 16; i += NTHREADS) *(uint4*)(lds + ST + i * 16) = make_uint4(0, 0, 0, 0);
        dma(ccof(0), 0);
        loads(0);
        for (int c = 0; c < 132; ++c) {
            const int buf = c & 1, cc = ccof(c);
            const uint4 rv = nv; const float4 dl4 = n_dl, el4 = n_el, er4 = n_er;
            asm volatile("s_waitcnt vmcnt(0)" ::: "memory");
            {
                const unsigned vw[4] = {rv.x, rv.y, rv.z, rv.w};
#pragma unroll
                for (int j2 = 0; j2 < 4; ++j2) {
                    const int vc0 = lc * 8 + 2 * j2;
                    *(bf16_t*)(lds + VT + tile_off2(vc0, li >> 3) + (li & 7) * 2) = (bf16_t)(vw[j2] & 0xffffu);
                    *(bf16_t*)(lds + VT + tile_off2(vc0 + 1, li >> 3) + (li & 7) * 2) = (bf16_t)(vw[j2] >> 16);
                }
            }
            asm volatile("s_waitcnt lgkmcnt(0)" ::: "memory"); __builtin_amdgcn_s_barrier(); asm volatile("" ::: "memory");
            if (c + 1 < 132) { dma(ccof(c + 1), buf ^ 1); loads(c + 1); }
            const int it = wv & 3, pr2 = wv >> 2;
            const int r0 = gla_row0(b, cc);
#pragma unroll
            for (int vv = 0; vv < 2; ++vv) {
                const int vt = pr2 * 2 + vv;
                f32x4 a = {0.f, 0.f, 0.f, 0.f};
#pragma unroll
                for (int ks = 0; ks < 4; ++ks) {
                    const int ch = ks * 4 + fq;
                    const int rvv = vt * 16 + fr, ri = it * 16 + fr;
                    const bf16x8 fa = *(const bf16x8*)(lds + ST + buf * 16384 + rvv * 256 + ((ch ^ (rvv & 15)) << 4));
                    const bf16x8 fb = *(const bf16x8*)(lds + QE + buf * 16384 + ri * 256 + ((ch ^ (ri & 15)) << 4));
                    a = __builtin_amdgcn_mfma_f32_16x16x32_bf16(fa, fb, a, 0, 0, 0);
                }
#pragma unroll
                for (int ks = 0; ks < 2; ++ks) {
                    const int ch = ks * 4 + fq;
                    const int rvv = vt * 16 + fr, ri = it * 16 + fr;
                    const bf16x8 fa = *(const bf16x8*)(lds + VT + tile_off2(rvv, ch));
                    const bf16x8 fb = *(const bf16x8*)(lds + AL + buf * 8192 + ri * 128 + ((ch ^ (ri & 7)) << 4));
                    a = __builtin_amdgcn_mfma_f32_16x16x32_bf16(fa, fb, a, 0, 0, 0);
                }
                const int i = it * 16 + fr, vcol = vt * 16 + 4 * fq;
                *(uint2*)(odst + (size_t)(r0 + i) * old_ + hd * 256 + vs * 64 + vcol) = make_uint2(pk_bf16(a[0], a[1]), pk_bf16(a[2], a[3]));
            }
            {
                const int kt = wv;
                bf16x8 fa[2];
#pragma unroll
                for (int ks = 0; ks < 2; ++ks) fa[ks] = *(const bf16x8*)(lds + KET + buf * 16384 + tile_off2(kt * 16 + fr, ks * 4 + fq));
#pragma unroll
                for (int vt = 0; vt < 4; ++vt) {
                    f32x4 t = {0.f, 0.f, 0.f, 0.f};
#pragma unroll
                    for (int ks = 0; ks < 2; ++ks) t = __builtin_amdgcn_mfma_f32_16x16x32_bf16(fa[ks], *(const bf16x8*)(lds + VT + tile_off2(vt * 16 + fr, ks * 4 + fq)), t, 0, 0, 0);
                    f32x4 a = accS[vt];
                    a[0] = a[0] * dl4.x + t[0] * el4.x; a[1] = a[1] * dl4.y + t[1] * el4.y; a[2] = a[2] * dl4.z + t[2] * el4.z; a[3] = a[3] * dl4.w + t[3] * el4.w;
                    accS[vt] = a;
                    const int vcol = vt * 16 + fr, kcol = kt * 16 + 4 * fq;
                    *(uint2*)(lds + ST + (buf ^ 1) * 16384 + vcol * 256 + (((kcol >> 3) ^ (vcol & 15)) << 4) + (kcol & 7) * 2) =
                        make_uint2(pk_bf16(a[0] * er4.x, a[1] * er4.y), pk_bf16(a[2] * er4.z, a[3] * er4.w));
                }
            }
            asm volatile("s_waitcnt lgkmcnt(0)" ::: "memory"); __builtin_amdgcn_s_barrier(); asm volatile("" ::: "memory");
        }
        asm volatile("s_waitcnt vmcnt(0)" ::: "memory");
        __syncthreads();
    }
}

DEV void phase_gla_readout(const Params& p) {
    const int tid = tid_opaque(), lane = tid & 63;
    const int gw = blockIdx.x * 8 + (tid >> 6), nw = gridDim.x * 8;
    unsigned char* ws = p.ws;
    const bf16_t* o0 = (const bf16_t*)(ws + WS_S + 4 * U_BYTES);
    const bf16_t* o1 = (const bf16_t*)(ws + WS_S + 2 * U_BYTES);
    const bf16_t* gb = (const bf16_t*)(ws + WS_S + 3 * U_BYTES);
    bf16_t* ao = (bf16_t*)(ws + WS_S + 0 * U_BYTES);
    const float4 hn = *(const float4*)(p.in[28] + lane * 4);
    for (int item0 = gw; item0 < NL * 4; item0 += 4 * nw) {
        uint2 a[4], b2[4], g2[4];
#pragma unroll
        for (int q = 0; q < 4; ++q) {
            const int item = min(item0 + q * nw, NL * 4 - 1);
            const size_t off = (size_t)(item >> 2) * 1024 + (item & 3) * 256 + lane * 4;
            a[q] = *(const uint2*)(o0 + off + (size_t)(item >> 2) * 1024); b2[q] = *(const uint2*)(o1 + off); g2[q] = *(const uint2*)(gb + off);
        }
        float v[4][4], ss[4];
#pragma unroll
        for (int q = 0; q < 4; ++q) {
            v[q][0] = bf_lo(a[q].x) + bf_lo(b2[q].x); v[q][1] = bf_hi(a[q].x) + bf_hi(b2[q].x); v[q][2] = bf_lo(a[q].y) + bf_lo(b2[q].y); v[q][3] = bf_hi(a[q].y) + bf_hi(b2[q].y);
            ss[q] = v[q][0] * v[q][0] + v[q][1] * v[q][1] + v[q][2] * v[q][2] + v[q][3] * v[q][3];
        }
#pragma unroll
        for (int q = 0; q < 4; ++q) ss[q] = wave_allreduce(ss[q]);
#pragma unroll
        for (int q = 0; q < 4; ++q) {
            const int item = item0 + q * nw;
            if (item < NL * 4) {
                const size_t off = (size_t)(item >> 2) * 1024 + (item & 3) * 256 + lane * 4;
                const float rs = rsqrtf(ss[q] * (1.0f / 256.0f) + 1e-6f);
                const float g0 = bf_lo(g2[q].x), g1 = bf_hi(g2[q].x), g2f = bf_lo(g2[q].y), g3 = bf_hi(g2[q].y);
                const float r0 = v[q][0] * rs * hn.x * (g0 * sigmoidf_(g0)), r1 = v[q][1] * rs * hn.y * (g1 * sigmoidf_(g1));
                const float r2 = v[q][2] * rs * hn.z * (g2f * sigmoidf_(g2f)), r3 = v[q][3] * rs * hn.w * (g3 * sigmoidf_(g3));
                *(uint2*)(ao + off) = make_uint2(pk_bf16(r0, r1), pk_bf16(r2, r3));
            }
        }
    }
}


#define XB_TMO      128
#define XB_XCNT(j)  (256  + 64 * (j))
#define XB_XSUB(j)  (1280 + 64 * (j))
#define XB_XGEN(j)  (2304 + 64 * (j))
#define XB_TOP      3328
#define XB_TOPGEN   3392
#define XB_SPIN_CAP (1u << 22)
DEV unsigned xb_ld(unsigned* p) { return __hip_atomic_load(p, __ATOMIC_RELAXED, __HIP_MEMORY_SCOPE_AGENT); }
DEV unsigned xb_add(unsigned* p, unsigned v) { return __hip_atomic_fetch_add(p, v, __ATOMIC_RELAXED, __HIP_MEMORY_SCOPE_AGENT); }
DEV unsigned xb_xcc_id() { return (unsigned)__builtin_amdgcn_s_getreg((3 << 11) | 20) & 0xFu; }
#define XB_SPIN(cond, bar) do { unsigned _sp = 0; while (cond) { __builtin_amdgcn_s_sleep(1); \
    if ((++_sp & 255u) == 0u) { if (xb_ld(&(bar)[XB_TMO])) break; if (_sp > XB_SPIN_CAP) { atomicAdd(&(bar)[XB_TMO], 1u); break; } } } } while (0)
DEV void xcd_barrier_complete(unsigned* bar, unsigned x, unsigned& nloc, unsigned& nx) {
    const unsigned G = gridDim.x;
    unsigned sum, cnt, mine, sp = 0u;
    for (;;) {
        sum = 0u; cnt = 0u; mine = 0u;
#pragma unroll
        for (unsigned j = 0; j < 16; ++j) { const unsigned c = xb_ld(&bar[XB_XCNT(j)]); sum += c; cnt += (c > 0u) ? 1u : 0u; mine = (j == x) ? c : mine; }
        if (sum == G) break;
        __builtin_amdgcn_s_sleep(1);
        if ((++sp & 255u) == 0u) { if (xb_ld(&bar[XB_TMO])) break; if (sp > XB_SPIN_CAP) { atomicAdd(&bar[XB_TMO], 1u); break; } }
    }
    nloc = mine > 0u ? mine : 1u; nx = cnt > 0u ? cnt : 1u;
}
DEV void xcd_barrier(unsigned* bar, volatile LAS3 unsigned* st) {
    asm volatile("s_waitcnt vmcnt(0)" ::: "memory");
    __syncthreads();
    if (tid_opaque() == 0) {
        const unsigned x = xb_xcc_id();
        __builtin_amdgcn_s_waitcnt(0);
        unsigned nloc = st[0], nx = st[1];
        if (nloc == 0u) { xcd_barrier_complete(bar, x, nloc, nx); st[0] = nloc; st[1] = nx; }
        const unsigned old = xb_add(&bar[XB_XSUB(x)], 1u);
        const unsigned gen = old / nloc;
        if (old + 1u == (gen + 1u) * nloc) {
            __builtin_amdgcn_fence(__ATOMIC_RELEASE, "agent");
            asm volatile("s_waitcnt vmcnt(0)" ::: "memory");
            const unsigned og = xb_add(&bar[XB_TOP], 1u);
            const unsigned tg = og / nx;
            if (og + 1u == (tg + 1u) * nx) xb_add(&bar[XB_TOPGEN], 1u);
            else XB_SPIN(xb_ld(&bar[XB_TOPGEN]) == tg, bar);
            __builtin_amdgcn_fence(__ATOMIC_ACQUIRE, "agent");
            xb_add(&bar[XB_XGEN(x)], 1u);
            asm volatile("s_waitcnt vmcnt(0)" ::: "memory");
        } else {
            XB_SPIN(xb_ld(&bar[XB_XGEN(x)]) == gen, bar);
            __builtin_amdgcn_fence(__ATOMIC_ACQUIRE, "agent");
            asm volatile("s_waitcnt vmcnt(0)" ::: "memory");
        }
    }
    __syncthreads();
}
#define SYNC() do { asm volatile("s_waitcnt vmcnt(0)" ::: "memory"); grid.sync(); \
    if (tid_opaque() == 0) { __builtin_amdgcn_fence(__ATOMIC_ACQUIRE, "agent"); asm volatile("s_waitcnt vmcnt(0)" ::: "memory"); } \
    __syncthreads(); } while (0)
__global__ void __launch_bounds__(NTHREADS) mega_fwd(Params p) {
    unsigned char* const lds = g_lds;
    cg::grid_group grid = cg::this_grid();
#define XBAR ((unsigned*)(p.ws + WS_BAR))
#define XST ((volatile LAS3 unsigned*)(lds + LDS_BYTES - 16))
    if ((threadIdx.x & 63) == 0) g_lds[LDS_WTAB + hw_wave_slot()] = (unsigned char)(threadIdx.x >> 6);
    if (threadIdx.x == 0) { XST[0] = 0u; XST[1] = 0u; (void)xb_add(&XBAR[XB_XCNT(xb_xcc_id())], 1u); }
    __syncthreads();
#define S0 ((bf16_t*)(p.ws + WS_S + 0 * U_BYTES))
#define SLOT(i) ((bf16_t*)(p.ws + WS_S + (size_t)(i) * U_BYTES))
#define S1 ((bf16_t*)(p.ws + WS_S + 1 * U_BYTES))
#define CTXR ((const float*)(p.ws + WS_CTXR))
    phase0(p, lds); SYNC();
#undef SYNC
#define SYNC() xcd_barrier(XBAR, XST)
    phase_normmix(p, S0, SLOT(5), SLOT(1), SLOT(2)); SYNC();
    phase_rw_proj1(p, lds, 0, SLOT(5), SLOT(3), 1); SYNC();
    phase_rw_proj1(p, lds, 1, SLOT(1), SLOT(5), 1); SYNC();
    phase_rw_proj1(p, lds, 2, SLOT(2), SLOT(1), 0); phase_rw_lora(p, lds, SLOT(2), SLOT(1)); SYNC();
    REPEAT(3, phase_rw_scan(p, lds));
    phase_rw_scan(p, lds); SYNC();
    REPEAT(4, phase_rw_readout(p));
    phase_rw_readout(p); SYNC();
    REPEAT(5, phase_wo(p, lds, 0));
    phase_wo(p, lds, 0); SYNC();
    REPEAT(6, phase_normmod(p, 0, 1, p.out, CTXR, NT, S1, (unsigned char*)SLOT(2)));
    phase_normmod(p, 0, 1, p.out, CTXR, NT, S1, (unsigned char*)SLOT(2)); SYNC();
    REPEAT(7, phase_peer_select(p, lds, 0));
    phase_peer_select(p, lds, 0); SYNC();
    phase_peer_u(p, lds, 0); SYNC();
    phase_peer_c(p, 0); SYNC();
    phase_peer_v(p, 0); SYNC();
    phase_normmod(p, 1, 0, p.out, CTXR, NT, S0, nullptr); SYNC();
    REPEAT(9, phase_gla_proj(p, lds));
    phase_gla_proj(p, lds); SYNC();
    REPEAT(10, phase_gla_conv(p));
    phase_gla_conv(p); SYNC();
    REPEAT(18, phase_gla_prep(p, lds));
    phase_gla_prep(p, lds); SYNC();
    REPEAT(11, phase_gla_scan(p, lds));
    phase_gla_scan(p, lds); SYNC();
    REPEAT(12, phase_gla_readout(p));
    phase_gla_readout(p); SYNC();
    phase_wo(p, lds, 1); SYNC();
    REPEAT(14, phase_normmod(p, 1, 1, p.out, CTXR, NL, S0, (unsigned char*)SLOT(2)));
    phase_normmod(p, 1, 1, p.out, CTXR, NL, S0, (unsigned char*)SLOT(2)); SYNC();
    REPEAT(15, phase_peer_select(p, lds, 1));
    phase_peer_select(p, lds, 1); SYNC();
    phase_peer_u(p, lds, 1); SYNC();
    phase_peer_c(p, 1); SYNC();
    phase_peer_v(p, 1); SYNC();
    phase_final_norm(p);
}

extern "C" void kernel_launch(void* const* d_in, const int* in_sizes, int n_in, void* d_out, int out_size, void* d_ws, size_t ws_size, hipStream_t stream) {
    static int grid_blocks = 0;
    if (grid_blocks == 0) {
        if (n_in != 35 || ws_size < WS_TOTAL) { fprintf(stderr, "kernel_launch: unexpected n_in %d or ws_size %zu (< %zu)\n", n_in, ws_size, (size_t)WS_END); grid_blocks = -1; return; }
        int dev = 0, cus = 0, per_cu = 0;
        if (hipGetDevice(&dev) != hipSuccess || hipDeviceGetAttribute(&cus, hipDeviceAttributeMultiprocessorCount, dev) != hipSuccess) { fprintf(stderr, "kernel_launch: device query failed\n"); grid_blocks = -1; return; }
        if (hipFuncSetAttribute((const void*)mega_fwd, hipFuncAttributeMaxDynamicSharedMemorySize, LDS_BYTES) != hipSuccess) { fprintf(stderr, "kernel_launch: hipFuncSetAttribute failed\n"); grid_blocks = -1; return; }
        if (hipOccupancyMaxActiveBlocksPerMultiprocessor(&per_cu, (const void*)mega_fwd, NTHREADS, LDS_BYTES) != hipSuccess || per_cu < 1) { fprintf(stderr, "kernel_launch: occupancy query says %d blocks per CU\n", per_cu); grid_blocks = -1; return; }
        grid_blocks = cus;
    }
    if (grid_blocks < 0) return;
    Params p{};
    for (int i = 0; i < 35; ++i) p.in[i] = (const float*)d_in[i];
    p.out = (float*)d_out;
    p.ws = (unsigned char*)d_ws;
    if (hipMemsetAsync((char*)d_ws + WS_BAR, 0, 16384, stream) != hipSuccess) { fprintf(stderr, "kernel_launch: hipMemsetAsync failed\n"); return; }
    void* args[] = {&p};
    hipError_t e = hipLaunchCooperativeKernel((const void*)mega_fwd, dim3(grid_blocks), dim3(NTHREADS), args, LDS_BYTES, stream);
    if (e != hipSuccess) fprintf(stderr, "kernel_launch: cooperative launch failed: %s (grid %d)\n", hipGetErrorString(e), grid_blocks);
}
```

```cpp
#include <hip/hip_runtime.h>
#include <hip/hip_cooperative_groups.h>
#include <cstdio>
#include <cstdint>
namespace cg = cooperative_groups;

#define DEV __device__ __forceinline__
#ifndef REP
#define REP 0
#endif
#define GREPS(n) ((REP == (n)) ? 2 : 1)
#define REPEAT(n, stmt) do { if (REP == (n)) { stmt; SYNC(); } } while (0)

typedef unsigned short bf16_t;
typedef short bf16x8 __attribute__((ext_vector_type(8)));
typedef float f32x4 __attribute__((ext_vector_type(4)));
typedef __bf16 bf16x2v __attribute__((ext_vector_type(2)));

constexpr int D = 1024;
constexpr int NB = 8, SEQ = 8192, CTXL = 256;
constexpr int NL = NB * SEQ, NC = NB * CTXL, NT = NL + NC;
constexpr int NTHREADS = 512;
constexpr int LDS_BYTES = 160 * 1024;

constexpr size_t U_BYTES = (size_t)NT * 1024 * 2;
constexpr size_t WS_BAR = 0;
constexpr size_t WS_MOD = 16384;
constexpr size_t WS_CTXR = WS_MOD + (size_t)2 * 9 * 6144 * 4;
constexpr size_t WS_LR = WS_CTXR + (size_t)NC * 1024 * 4;
constexpr size_t WS_BONUS = WS_LR + (size_t)NT * 32 * 4;
constexpr size_t WS_WPROJ = WS_BONUS + (size_t)2 * NT * 16 * 4;
constexpr size_t WS_W2T = WS_WPROJ + (size_t)3456 * 1024 * 2;
constexpr size_t WS_A2T = WS_W2T + (size_t)2 * 1024 * 64 * 2;
constexpr size_t WS_G2T = WS_A2T + (size_t)2 * 1024 * 64 * 2;
constexpr size_t WS_WO0 = WS_G2T + (size_t)1024 * 128 * 2;
constexpr size_t WS_WO1 = WS_WO0 + (size_t)1024 * 1024 * 2;
constexpr size_t WS_WQ = WS_WO1 + (size_t)1024 * 1024 * 2;
constexpr size_t WS_KEYS = WS_WQ + (size_t)2 * 2048 * 1024 * 2;
constexpr size_t WS_WIN = WS_KEYS + (size_t)2 * 8 * 2 * 128 * 128 * 2;
constexpr size_t WS_PU = WS_WIN + (size_t)3200 * 1024 * 2;
constexpr size_t WS_PV = WS_PU + (size_t)2 * 16384 * 1024;
constexpr size_t WS_PSC = WS_PV + (size_t)2 * 16384 * 1024;
constexpr size_t WS_S = WS_PSC + (size_t)2 * 2 * 16384 * 4;
constexpr size_t WS_END = WS_S + 6 * U_BYTES;
static_assert(WS_END <= 1073741824ull, "workspace too large");
static_assert((WS_CTXR % 256) == 0 && (WS_WPROJ % 256) == 0 && (WS_S % 256) == 0, "alignment");

struct Params {
    const float* in[35];
    float* out;
    unsigned char* ws;
    int pad0, pad1;
};

DEV float bf_lo(unsigned u) { return __uint_as_float(u << 16); }
DEV float bf_hi(unsigned u) { return __uint_as_float(u & 0xffff0000u); }
typedef float f32x2v __attribute__((ext_vector_type(2)));
typedef unsigned int u32x2v __attribute__((ext_vector_type(2)));
typedef short s16x4v __attribute__((ext_vector_type(4)));
DEV unsigned pk_bf16(float lo, float hi) { const f32x2v f = {lo, hi}; union { bf16x2v v; unsigned u; } x; x.v = __builtin_convertvector(f, bf16x2v); return x.u; }
template <int N> DEV float dpp_ror(float x) { return __int_as_float(__builtin_amdgcn_update_dpp(0, __float_as_int(x), 0x120 + N, 0xF, 0xF, false)); }
DEV float row16_allreduce(float x) { x += dpp_ror<8>(x); x += dpp_ror<4>(x); x += dpp_ror<2>(x); x += dpp_ror<1>(x); return x; }
DEV float wave_allreduce(float x) { x = row16_allreduce(x); x += __shfl_xor(x, 16); x += __shfl_xor(x, 32); return x; }
DEV float sigmoidf_(float x) { return __builtin_amdgcn_rcpf(1.0f + __expf(-x)); }
DEV float softplusf_(float z) { return fmaxf(z, 0.f) + __logf(1.0f + __expf(-fabsf(z))); }
DEV unsigned mono_u32(float f) { unsigned u = __float_as_uint(f); return u ^ ((u >> 31) ? 0xFFFFFFFFu : 0x80000000u); }
DEV float unmono_u32(unsigned k) { unsigned u = (k & 0x80000000u) ? (k ^ 0x80000000u) : ~k; return __uint_as_float(u); }
DEV bf16x8 as_bf16x8(uint4 v) { union { uint4 u; bf16x8 b; } x; x.u = v; return x.b; }
#define LAS3 __attribute__((address_space(3)))
extern __shared__ __attribute__((aligned(16))) unsigned char g_lds[];
constexpr int LDS_WTAB = LDS_BYTES - 128;
DEV unsigned hw_wave_slot() { return (unsigned)__builtin_amdgcn_s_getreg((5 << 11) | 4) & 63u; }
DEV int tid_opaque() {
    const int wv = (int)*(const volatile unsigned char*)(g_lds + LDS_WTAB + hw_wave_slot());
    int t = (wv << 6) | (int)__builtin_amdgcn_mbcnt_hi(~0u, __builtin_amdgcn_mbcnt_lo(~0u, 0u));
    asm volatile("" : "+v"(t));
    return t;
}
DEV int mod_batch(int R) { return R < NL ? (R >> 13) : 8; }

template <int BN, class AL, class EP>
DEV void gemm_unit(unsigned char* lds, const AL& al, const bf16_t* Bt, int K, int m0, const EP& ep) {
    constexpr int NI = BN / 64;
    constexpr int A_BYTES = 128 * 128;
    constexpr int B_BYTES = BN * 128;
    const int tid = tid_opaque(), lane = tid & 63, wv = tid >> 6, wm = wv >> 2, wn = wv & 3;
    const int fr = lane & 15, fq = lane >> 4;
    unsigned char* sA = lds;
    unsigned char* sB = lds + 2 * A_BYTES;
    f32x4 acc[4][NI];
#pragma unroll
    for (int mi = 0; mi < 4; ++mi)
#pragma unroll
        for (int ni = 0; ni < NI; ++ni) acc[mi][ni] = (f32x4){0.f, 0.f, 0.f, 0.f};
    const int KT = K >> 6;
    const int drow = tid >> 3, dch = (tid & 7) ^ (drow & 7);
    const bf16_t* bsrc = Bt + (size_t)drow * K + dch * 8;
    uint4 ra[2];
    auto stage = [&](int kt, int buf) {
        const int k0 = kt * 64;
#pragma unroll
        for (int i = 0; i < BN / 64; ++i)
            __builtin_amdgcn_global_load_lds((const unsigned*)(bsrc + (size_t)(64 * i) * K + k0), (unsigned*)(sB + buf * B_BYTES + i * 8192 + tid * 16), 16, 0, 0);
        if constexpr (AL::DMA) {
#pragma unroll
            for (int i = 0; i < 2; ++i)
                __builtin_amdgcn_global_load_lds((const unsigned*)(al.A + (size_t)(m0 + drow + 64 * i) * al.lda + k0 + dch * 8), (unsigned*)(sA + buf * A_BYTES + i * 8192 + tid * 16), 16, 0, 0);
        } else {
#pragma unroll
            for (int i = 0; i < 2; ++i) { const int q = tid + 512 * i; ra[i] = al.load(m0 + (q >> 3), k0 + (q & 7) * 8); }
        }
    };
    auto commit = [&](int buf) {
        if constexpr (!AL::DMA) {
#pragma unroll
            for (int i = 0; i < 2; ++i) { const int q = tid + 512 * i, row = q >> 3, ch = q & 7; *(uint4*)(sA + buf * A_BYTES + row * 128 + ((ch ^ (row & 7)) << 4)) = ra[i]; }
        }
    };
    auto compute = [&](int buf) {
        const unsigned char* a_base = sA + buf * A_BYTES;
        const unsigned char* b_base = sB + buf * B_BYTES;
#pragma unroll
        for (int ks = 0; ks < 2; ++ks) {
            bf16x8 af[4], bfr[NI];
            const int ch = ks * 4 + fq;
#pragma unroll
            for (int mi = 0; mi < 4; ++mi) { const int row = wm * 64 + mi * 16 + fr; af[mi] = *(const bf16x8*)(a_base + row * 128 + ((ch ^ (row & 7)) << 4)); }
#pragma unroll
            for (int ni = 0; ni < NI; ++ni) { const int row = wn * (BN / 4) + ni * 16 + fr; bfr[ni] = *(const bf16x8*)(b_base + row * 128 + ((ch ^ (row & 7)) << 4)); }
#pragma unroll
            for (int mi = 0; mi < 4; ++mi)
#pragma unroll
                for (int ni = 0; ni < NI; ++ni) acc[mi][ni] = __builtin_amdgcn_mfma_f32_16x16x32_bf16(bfr[ni], af[mi], acc[mi][ni], 0, 0, 0);
        }
    };
    if constexpr (AL::DMA) {
        constexpr int STG = A_BYTES + B_BYTES;
        auto stage3 = [&](int kt, int b3) {
            const int k0 = kt * 64;
            unsigned char* base = lds + b3 * STG;
#pragma unroll
            for (int i = 0; i < BN / 64; ++i)
                __builtin_amdgcn_global_load_lds((const unsigned*)(bsrc + (size_t)(64 * i) * K + k0), (unsigned*)(base + A_BYTES + i * 8192 + tid * 16), 16, 0, 0);
#pragma unroll
            for (int i = 0; i < 2; ++i)
                __builtin_amdgcn_global_load_lds((const unsigned*)(al.A + (size_t)(m0 + drow + 64 * i) * al.lda + k0 + dch * 8), (unsigned*)(base + i * 8192 + tid * 16), 16, 0, 0);
        };
        auto compute3 = [&](int b3) {
            const unsigned char* a_base = lds + b3 * STG;
            const unsigned char* b_base = a_base + A_BYTES;
#pragma unroll
            for (int ks = 0; ks < 2; ++ks) {
                bf16x8 af[4], bfr[NI];
                const int ch = ks * 4 + fq;
#pragma unroll
                for (int mi = 0; mi < 4; ++mi) { const int row = wm * 64 + mi * 16 + fr; af[mi] = *(const bf16x8*)(a_base + row * 128 + ((ch ^ (row & 7)) << 4)); }
#pragma unroll
                for (int ni = 0; ni < NI; ++ni) { const int row = wn * (BN / 4) + ni * 16 + fr; bfr[ni] = *(const bf16x8*)(b_base + row * 128 + ((ch ^ (row & 7)) << 4)); }
#pragma unroll
                for (int mi = 0; mi < 4; ++mi)
#pragma unroll
                    for (int ni = 0; ni < NI; ++ni) acc[mi][ni] = __builtin_amdgcn_mfma_f32_16x16x32_bf16(bfr[ni], af[mi], acc[mi][ni], 0, 0, 0);
            }
        };
        stage3(0, 0);
        stage3(1, 1);
        int b3 = 0;
        for (int kt = 0; kt < KT; ++kt) {
            if (kt + 1 < KT) { if constexpr (BN == 256) asm volatile("s_waitcnt vmcnt(6)" ::: "memory"); else asm volatile("s_waitcnt vmcnt(4)" ::: "memory"); }
            else asm volatile("s_waitcnt vmcnt(0)" ::: "memory");
            asm volatile("s_waitcnt lgkmcnt(0)" ::: "memory");
            __builtin_amdgcn_s_barrier();
            asm volatile("" ::: "memory");
            const int bn = (b3 == 0) ? 2 : b3 - 1;
            if (kt + 2 < KT) stage3(kt + 2, bn);
            compute3(b3);
            b3 = (b3 == 2) ? 0 : b3 + 1;
        }
        asm volatile("s_waitcnt lgkmcnt(0)" ::: "memory");
        __builtin_amdgcn_s_barrier();
        asm volatile("" ::: "memory");
    } else {
        stage(0, 0);
        commit(0);
        asm volatile("s_waitcnt vmcnt(0)" ::: "memory");
        __syncthreads();
        for (int kt = 0; kt < KT; ++kt) {
            const int cur = kt & 1;
            const bool more = (kt + 1 < KT);
            if (more) stage(kt + 1, cur ^ 1);
            compute(cur);
            if (more) commit(cur ^ 1);
            asm volatile("s_waitcnt vmcnt(0)" ::: "memory");
            __syncthreads();
        }
    }
    ep(acc, m0, wm, wn, fr, fq);
}

struct ALoadPlain {
    static constexpr bool DMA = true;
    const bf16_t* A; int lda;
    DEV uint4 load(int R, int k) const { return *(const uint4*)(A + (size_t)R * lda + k); }
};
struct ALoadMix {
    static constexpr bool DMA = false;
    const bf16_t* h; const float* mix; const bf16_t* A; int lda;
    DEV uint4 load(int R, int k) const {
        const bf16_t* pc = h + (size_t)R * 1024 + k;
        const uint4 c = *(const uint4*)pc;
        const int t = (R < NL) ? (R & 8191) : ((R - NL) & 255);
        const int last = (R < NL) ? 8191 : 255;
        uint4 pv = *(const uint4*)(pc - (t != 0 ? 1024 : 0)), nv = *(const uint4*)(pc + (t != last ? 1024 : 0));
        if (t == 0) pv = make_uint4(0, 0, 0, 0);
        if (t == last) nv = make_uint4(0, 0, 0, 0);
        const float4 m0 = *(const float4*)(mix + k), m1 = *(const float4*)(mix + k + 4);
        const unsigned cc[4] = {c.x, c.y, c.z, c.w}, pp[4] = {pv.x, pv.y, pv.z, pv.w}, nn[4] = {nv.x, nv.y, nv.z, nv.w};
        const float mm[8] = {m0.x, m0.y, m0.z, m0.w, m1.x, m1.y, m1.z, m1.w};
        unsigned o[4];
#pragma unroll
        for (int i = 0; i < 4; ++i) {
            const float hc0 = bf_lo(cc[i]), hc1 = bf_hi(cc[i]);
            const float s0 = 0.5f * (bf_lo(pp[i]) + bf_lo(nn[i])), s1 = 0.5f * (bf_hi(pp[i]) + bf_hi(nn[i]));
            o[i] = pk_bf16(hc0 + (s0 - hc0) * mm[2 * i], hc1 + (s1 - hc1) * mm[2 * i + 1]);
        }
        return make_uint4(o[0], o[1], o[2], o[3]);
    }
};

struct TrJob { int in_idx, src_off, K, N, src_ld, dst_ld; unsigned long long dst_off; int tile0; };
constexpr int NTRJOBS = 19;
__device__ const TrJob g_trjobs[NTRJOBS] = {
    {9, 0 * 1048576, 1024, 1024, 1024, 1024, WS_WPROJ + 0ull * 1024 * 1024 * 2, 0},
    {9, 1 * 1048576, 1024, 1024, 1024, 1024, WS_WPROJ + 1ull * 1024 * 1024 * 2, 256},
    {9, 2 * 1048576, 1024, 1024, 1024, 1024, WS_WPROJ + 2ull * 1024 * 1024 * 2, 512},
    {11, 0, 1024, 64, 64, 1024, WS_WPROJ + 3072ull * 1024 * 2, 768},
    {11, 65536, 1024, 64, 64, 1024, WS_WPROJ + 3136ull * 1024 * 2, 784},
    {14, 0, 1024, 64, 64, 1024, WS_WPROJ + 3200ull * 1024 * 2, 800},
    {14, 65536, 1024, 64, 64, 1024, WS_WPROJ + 3264ull * 1024 * 2, 816},
    {16, 0, 1024, 128, 128, 1024, WS_WPROJ + 3328ull * 1024 * 2, 832},
    {12, 0, 64, 1024, 1024, 64, WS_W2T, 864},
    {12, 65536, 64, 1024, 1024, 64, WS_W2T + 1024ull * 64 * 2, 880},
    {15, 0, 64, 1024, 1024, 64, WS_A2T, 896},
    {15, 65536, 64, 1024, 1024, 64, WS_A2T + 1024ull * 64 * 2, 912},
    {17, 0, 128, 1024, 1024, 128, WS_G2T, 928},
    {23, 0, 1024, 1024, 1024, 1024, WS_WO0, 960},
    {29, 0, 1024, 1024, 1024, 1024, WS_WO1, 1216},
    {30, 0, 1024, 2048, 2048, 1024, WS_WQ, 1472},
    {30, 2097152, 1024, 2048, 2048, 1024, WS_WQ + 2048ull * 1024 * 2, 1984},
    {24, 0, 1024, 3104, 3104, 1024, WS_WIN, 2496},
    {0, 0, 0, 0, 0, 0, 0, 2496 + 16 * 49},
};
constexpr int NTRTILES = 2496 + 16 * 49;

DEV void phase0(const Params& p, unsigned char* lds) {
    const int tid = tid_opaque();
    unsigned char* ws = p.ws;
    {
        float* sc = (float*)lds;
        float* red = sc + 9 * 1024;
        float* mods = (float*)(ws + WS_MOD);
        bool have_sc = false;
        for (int task = blockIdx.x; task < 192; task += gridDim.x) {
            if (!have_sc) {
                for (int i = tid; i < 9 * 1024; i += NTHREADS) {
                    const int mb = i >> 10, k = i & 1023;
                    const float cv = mb < 8 ? p.in[1][mb * 1024 + k] : p.in[3][k];
                    sc[i] = cv / (1.0f + __expf(-cv));
                }
                have_sc = true;
            }
            __syncthreads();
            const int l = task / 96, nb = task % 96;
            const int nn = tid & 63, kg = tid >> 6;
            const float* w = p.in[4] + (size_t)l * 1024 * 6144 + nb * 64 + nn;
            float acc[9];
#pragma unroll
            for (int m = 0; m < 9; ++m) acc[m] = 0.f;
            for (int k = kg * 128; k < kg * 128 + 128; ++k) {
                const float wv = w[(size_t)k * 6144];
#pragma unroll
                for (int m = 0; m < 9; ++m) acc[m] += sc[m * 1024 + k] * wv;
            }
#pragma unroll
            for (int m = 0; m < 9; ++m) red[(kg * 9 + m) * 64 + nn] = acc[m];
            __syncthreads();
            for (int i = tid; i < 576; i += NTHREADS) {
                const int m = i >> 6, n2 = i & 63;
                float s = p.in[5][l * 6144 + nb * 64 + n2];
#pragma unroll
                for (int g = 0; g < 8; ++g) s += red[(g * 9 + m) * 64 + n2];
                mods[(size_t)(l * 9 + m) * 6144 + nb * 64 + n2] = s;
            }
            __syncthreads();
        }
        __syncthreads();
    }
    {
        float* tile = (float*)lds;
        for (int tt = blockIdx.x; tt < NTRTILES; tt += gridDim.x) {
            int j = 0;
#pragma unroll 1
            while (j + 1 < NTRJOBS && g_trjobs[j + 1].tile0 <= tt) ++j;
            const TrJob jb = g_trjobs[j];
            const int tl = tt - jb.tile0;
            const int ntn = (jb.N + 63) >> 6;
            const int k0 = (tl / ntn) * 64, n0 = (tl % ntn) * 64;
            const float* src = p.in[jb.in_idx] + jb.src_off;
            bf16_t* dst = (bf16_t*)(ws + jb.dst_off);
            {
                const int kr = tid >> 4, nc4 = (tid & 15) * 4;
#pragma unroll
                for (int i = 0; i < 2; ++i) {
                    const int kk = kr + 32 * i;
                    float4 v = make_float4(0.f, 0.f, 0.f, 0.f);
                    if (n0 + nc4 < jb.N) v = *(const float4*)(src + (size_t)(k0 + kk) * jb.src_ld + n0 + nc4);
                    tile[kk * 65 + nc4 + 0] = v.x; tile[kk * 65 + nc4 + 1] = v.y; tile[kk * 65 + nc4 + 2] = v.z; tile[kk * 65 + nc4 + 3] = v.w;
                }
            }
            __syncthreads();
            {
                const int nn = tid >> 3, kc = (tid & 7) * 8;
                if (n0 + nn < jb.N) {
                    unsigned o[4];
#pragma unroll
                    for (int i = 0; i < 4; ++i) o[i] = pk_bf16(tile[(kc + 2 * i) * 65 + nn], tile[(kc + 2 * i + 1) * 65 + nn]);
                    *(uint4*)(dst + (size_t)(n0 + nn) * jb.dst_ld + k0 + kc) = make_uint4(o[0], o[1], o[2], o[3]);
                }
            }
            __syncthreads();
        }
    }
    {
        const size_t gtid = (size_t)blockIdx.x * NTHREADS + tid, gstride = (size_t)gridDim.x * NTHREADS;
        {
            const float* src = p.in[31];
            bf16_t* dst = (bf16_t*)(ws + WS_KEYS);
            const size_t n8 = (size_t)2 * 8 * 2 * 128 * 128 / 8;
            for (size_t i = gtid; i < n8; i += gstride) {
                const float4 a = *(const float4*)(src + i * 8), b = *(const float4*)(src + i * 8 + 4);
                *(uint4*)(dst + i * 8) = make_uint4(pk_bf16(a.x, a.y), pk_bf16(a.z, a.w), pk_bf16(b.x, b.y), pk_bf16(b.z, b.w));
            }
        }
        bf16_t* wpad = (bf16_t*)(ws + WS_WIN) + (size_t)3104 * 1024;
        for (size_t i = gtid; i < (size_t)96 * 1024 / 8; i += gstride) *(uint4*)(wpad + i * 8) = make_uint4(0, 0, 0, 0);
        const int lane = tid & 63;
        const int gw = blockIdx.x * 8 + (tid >> 6), nw = gridDim.x * 8;
        float* scales = (float*)(ws + WS_PSC);
        for (int rowi = gw * 32; rowi < 2 * 32768; rowi += nw * 32)
        for (int row2 = rowi; row2 < rowi + 32; row2 += 4) {
            float4 v[4][4]; float am[4];
#pragma unroll
            for (int q = 0; q < 4; ++q) {
                const int row = row2 + q, tbl = row >> 15, r = row & 32767;
                const float* srow = p.in[32 + tbl] + (size_t)r * 1024;
                am[q] = 0.f;
#pragma unroll
                for (int i = 0; i < 4; ++i) { v[q][i] = *(const float4*)(srow + 16 * lane + 4 * i); am[q] = fmaxf(am[q], fmaxf(fmaxf(fabsf(v[q][i].x), fabsf(v[q][i].y)), fmaxf(fabsf(v[q][i].z), fabsf(v[q][i].w)))); }
            }
#pragma unroll
            for (int o = 1; o < 64; o <<= 1) { const float a0 = __shfl_xor(am[0], o), a1 = __shfl_xor(am[1], o), a2 = __shfl_xor(am[2], o), a3 = __shfl_xor(am[3], o); am[0] = fmaxf(am[0], a0); am[1] = fmaxf(am[1], a1); am[2] = fmaxf(am[2], a2); am[3] = fmaxf(am[3], a3); }
#pragma unroll
            for (int q = 0; q < 4; ++q) {
                const int row = row2 + q, tbl = row >> 15, r = row & 32767;
                const float scale = am[q] > 0.f ? am[q] * (1.0f / 448.0f) : 1.0f;
                const float inv = 1.0f / scale;
                unsigned w[4];
#pragma unroll
                for (int i = 0; i < 4; ++i) {
                    int t = 0;
                    t = __builtin_amdgcn_cvt_pk_fp8_f32(v[q][i].x * inv, v[q][i].y * inv, t, false);
                    t = __builtin_amdgcn_cvt_pk_fp8_f32(v[q][i].z * inv, v[q][i].w * inv, t, true);
                    w[i] = (unsigned)t;
                }
                *(uint4*)(ws + (tbl ? WS_PV : WS_PU) + ((size_t)(r >> 14) * 8 + (lane >> 3)) * (16384 * 128) + (size_t)(r & 16383) * 128 + 16 * (lane & 7)) = make_uint4(w[0], w[1], w[2], w[3]);
                if (lane == 0) scales[tbl * 32768 + r] = scale;
            }
        }
    }
}

DEV void normmod_store(const float4 (&v)[4], float ss, const float* g, const float* shift, const float* scale, bf16_t* dst, unsigned char* xq, int lane) {
    const float rs = rsqrtf(ss * (1.0f / 1024.0f) + 1e-6f);
#pragma unroll
    for (int i = 0; i < 4; ++i) {
        const int col = i * 256 + lane * 4;
        const float4 gg = *(const float4*)(g + col), sh = *(const float4*)(shift + col), sc = *(const float4*)(scale + col);
        const float y0 = v[i].x * rs * gg.x * (1.f + sc.x) + sh.x, y1 = v[i].y * rs * gg.y * (1.f + sc.y) + sh.y;
        const float y2 = v[i].z * rs * gg.z * (1.f + sc.z) + sh.z, y3 = v[i].w * rs * gg.w * (1.f + sc.w) + sh.w;
        *(uint2*)(dst + col) = make_uint2(pk_bf16(y0, y1), pk_bf16(y2, y3));
        if (xq) {
            const float z0 = __builtin_amdgcn_fmed3f(4.f * y0, -448.f, 448.f), z1 = __builtin_amdgcn_fmed3f(4.f * y1, -448.f, 448.f);
            const float z2 = __builtin_amdgcn_fmed3f(4.f * y2, -448.f, 448.f), z3 = __builtin_amdgcn_fmed3f(4.f * y3, -448.f, 448.f);
            int hi = __builtin_amdgcn_cvt_pk_fp8_f32(z0, z1, 0, false); hi = __builtin_amdgcn_cvt_pk_fp8_f32(z2, z3, hi, true);
            const f32x2v h01 = __builtin_amdgcn_cvt_pk_f32_fp8(hi, false), h23 = __builtin_amdgcn_cvt_pk_f32_fp8(hi, true);
            int lo = __builtin_amdgcn_cvt_pk_fp8_f32(z0 - h01.x, z1 - h01.y, 0, false); lo = __builtin_amdgcn_cvt_pk_fp8_f32(z2 - h23.x, z3 - h23.y, lo, true);
            *(int*)(xq + col) = hi; *(int*)(xq + 1024 + col) = lo;
        }
    }
}
DEV void phase_normmod(const Params& p, int layer, int which, const bf16_t* xl, const bf16_t* xc, int nrows, bf16_t* dst, unsigned char* xq) {
    const int tid = tid_opaque(), lane = tid & 63;
    const int gw = blockIdx.x * 8 + (tid >> 6), nw = gridDim.x * 8;
    const float* mods = (const float*)(p.ws + WS_MOD) + (size_t)layer * 9 * 6144;
    const float* g = p.in[which ? 7 : 6] + layer * 1024;
    for (int R = gw; R < nrows; R += nw) {
        const bf16_t* xr = R < NL ? xl + (size_t)R * 1024 : xc + (size_t)(R - NL) * 1024;
        float4 v[4]; float ss = 0.f;
#pragma unroll
        for (int i = 0; i < 4; ++i) { const uint2 t = *(const uint2*)(xr + i * 256 + lane * 4); v[i] = make_float4(bf_lo(t.x), bf_hi(t.x), bf_lo(t.y), bf_hi(t.y)); ss += v[i].x * v[i].x + v[i].y * v[i].y + v[i].z * v[i].z + v[i].w * v[i].w; }
        ss = wave_allreduce(ss);
        const float* mrow = mods + (size_t)mod_batch(R) * 6144 + (which ? 3 : 0) * 1024;
        normmod_store(v, ss, g, mrow, mrow + 1024, dst + (size_t)R * 1024, xq ? xq + (size_t)R * 2048 : nullptr, lane);
    }
}
DEV void phase_normmix(const Params& p, bf16_t* hdst, bf16_t* xr, bf16_t* xk, bf16_t* xv) {
    const int tid = tid_opaque(), lane = tid & 63;
    const int gw = __builtin_amdgcn_readfirstlane(blockIdx.x * 8 + (tid >> 6)), nw = gridDim.x * 8;
    const float* mods = (const float*)(p.ws + WS_MOD);
    const float* g = p.in[6];
    for (int run = gw; run < NT / 8; run += nw) {
        const int R0 = run * 8;
        const int t0 = R0 < NL ? (R0 & 8191) : ((R0 - NL) & 255), slen = R0 < NL ? 8192 : 256;
        const float* mrow = mods + (size_t)mod_batch(R0) * 6144;
        float4 gg[4], sh[4], sc[4], m0[4], m2[4], m3[4];
#pragma unroll
        for (int i = 0; i < 4; ++i) {
            const int col = i * 256 + lane * 4;
            gg[i] = *(const float4*)(g + col); sh[i] = *(const float4*)(mrow + col); sc[i] = *(const float4*)(mrow + 1024 + col);
            m0[i] = *(const float4*)(p.in[8] + col); m2[i] = *(const float4*)(p.in[8] + 2 * 1024 + col); m3[i] = *(const float4*)(p.in[8] + 3 * 1024 + col);
        }
        auto hrow = [&](int R, float4 (&h)[4]) {
            const float* xrw = R < NL ? p.in[0] + (size_t)R * 1024 : p.in[2] + (size_t)(R - NL) * 1024;
            float ss = 0.f;
#pragma unroll
            for (int i = 0; i < 4; ++i) { h[i] = *(const float4*)(xrw + i * 256 + lane * 4); ss += h[i].x * h[i].x + h[i].y * h[i].y + h[i].z * h[i].z + h[i].w * h[i].w; }
            ss = wave_allreduce(ss);
            const float rs = rsqrtf(ss * (1.0f / 1024.0f) + 1e-6f);
#pragma unroll
            for (int i = 0; i < 4; ++i) {
                h[i].x = h[i].x * rs * gg[i].x * (1.f + sc[i].x) + sh[i].x; h[i].y = h[i].y * rs * gg[i].y * (1.f + sc[i].y) + sh[i].y;
                h[i].z = h[i].z * rs * gg[i].z * (1.f + sc[i].z) + sh[i].z; h[i].w = h[i].w * rs * gg[i].w * (1.f + sc[i].w) + sh[i].w;
            }
        };
        float4 hp[4], hc[4], hn[4];
        if (t0 > 0) hrow(R0 - 1, hp); else { hp[0] = hp[1] = hp[2] = hp[3] = make_float4(0.f, 0.f, 0.f, 0.f); }
        hrow(R0, hc);
#pragma unroll 1
        for (int i8 = 0; i8 < 8; ++i8) {
            const int R = R0 + i8;
            if (t0 + i8 + 1 < slen) hrow(R + 1, hn); else { hn[0] = hn[1] = hn[2] = hn[3] = make_float4(0.f, 0.f, 0.f, 0.f); }
#pragma unroll
            for (int i = 0; i < 4; ++i) {
                const size_t o = (size_t)R * 1024 + i * 256 + lane * 4;
                const float4 c = hc[i];
                const float4 xx = make_float4(0.5f * (hp[i].x + hn[i].x) - c.x, 0.5f * (hp[i].y + hn[i].y) - c.y, 0.5f * (hp[i].z + hn[i].z) - c.z, 0.5f * (hp[i].w + hn[i].w) - c.w);
                *(uint2*)(hdst + o) = make_uint2(pk_bf16(c.x, c.y), pk_bf16(c.z, c.w));
                *(uint2*)(xr + o) = make_uint2(pk_bf16(c.x + xx.x * m0[i].x, c.y + xx.y * m0[i].y), pk_bf16(c.z + xx.z * m0[i].z, c.w + xx.w * m0[i].w));
                *(uint2*)(xk + o) = make_uint2(pk_bf16(c.x + xx.x * m2[i].x, c.y + xx.y * m2[i].y), pk_bf16(c.z + xx.z * m2[i].z, c.w + xx.w * m2[i].w));
                *(uint2*)(xv + o) = make_uint2(pk_bf16(c.x + xx.x * m3[i].x, c.y + xx.y * m3[i].y), pk_bf16(c.z + xx.z * m3[i].z, c.w + xx.w * m3[i].w));
            }
#pragma unroll
            for (int i = 0; i < 4; ++i) { hp[i] = hc[i]; hc[i] = hn[i]; }
        }
    }
}

template <int BN> struct EpiBf16 {
    bf16_t* dst; int ldd; int col0; int act;
    DEV void operator()(const f32x4 (&acc)[4][BN / 64], int m0, int wm, int wn, int fr, int fq) const {
#pragma unroll
        for (int mi = 0; mi < 4; ++mi) {
            const size_t R = (size_t)(m0 + wm * 64 + mi * 16 + fr);
#pragma unroll
            for (int ni = 0; ni < BN / 64; ++ni) {
                const int col = col0 + wn * (BN / 4) + ni * 16 + 4 * fq;
                float v[4] = {acc[mi][ni][0], acc[mi][ni][1], acc[mi][ni][2], acc[mi][ni][3]};
                if (act == 1) {
#pragma unroll
                    for (int j = 0; j < 4; ++j) v[j] = 1.0f - 2.0f * __builtin_amdgcn_rcpf(1.0f + __expf(2.0f * v[j]));
                } else if (act == 2) {
#pragma unroll
                    for (int j = 0; j < 4; ++j) v[j] = sigmoidf_(v[j]);
                }
                *(uint2*)(dst + R * ldd + col) = make_uint2(pk_bf16(v[0], v[1]), pk_bf16(v[2], v[3]));
            }
        }
    }
};
template <int NI> struct EpiResid {
    const float* xold_lat; const float* xold_ctx; bf16_t* dst_lat; bf16_t* dst_ctx; const float* gate; int col0;
    DEV void operator()(const f32x4 (&acc)[4][NI], int m0, int wm, int wn, int fr, int fq) const {
#pragma unroll
        for (int mi = 0; mi < 4; ++mi) {
            const int R = m0 + wm * 64 + mi * 16 + fr;
            const float* src = R < NL ? xold_lat + (size_t)R * 1024 : xold_ctx + (size_t)(R - NL) * 1024;
            bf16_t* dst = R < NL ? dst_lat + (size_t)R * 1024 : dst_ctx + (size_t)(R - NL) * 1024;
            const float* gr = gate + (size_t)mod_batch(R) * 6144;
#pragma unroll
            for (int ni = 0; ni < NI; ++ni) {
                const int col = col0 + wn * (NI * 16) + ni * 16 + 4 * fq;
                const float4 xo = *(const float4*)(src + col), g4 = *(const float4*)(gr + col);
                *(uint2*)(dst + col) = make_uint2(pk_bf16(xo.x + g4.x * acc[mi][ni][0], xo.y + g4.y * acc[mi][ni][1]), pk_bf16(xo.z + g4.z * acc[mi][ni][2], xo.w + g4.w * acc[mi][ni][3]));
            }
        }
    }
};
struct EpiLr {
    float* dst;
    DEV void operator()(const f32x4 (&acc)[4][2], int m0, int wm, int wn, int fr, int fq) const {
        if (wn != 0) return;
#pragma unroll
        for (int mi = 0; mi < 4; ++mi) {
            const size_t R = (size_t)(m0 + wm * 64 + mi * 16 + fr);
#pragma unroll
            for (int ni = 0; ni < 2; ++ni) { const int col = ni * 16 + 4 * fq; *(float4*)(dst + R * 32 + col) = make_float4(acc[mi][ni][0], acc[mi][ni][1], acc[mi][ni][2], acc[mi][ni][3]); }
        }
    }
};

namespace pg8 {
#define PG8_LAS __attribute__((address_space(3)))
constexpr int BM = 256, BK = 64, HALF = 128, HTB = HALF * BK * 2  , STAGE_BYTES = 8 * HTB, NXCD = 8, WGM = 8;

__host__ __device__ __forceinline__ int lds_byte(int r, int c) { const int st = (r >> 4) * 2 + (c >> 5), rr = r & 15, cc = c & 31, ob = rr * 64 + cc * 2; return st * 1024 + (ob ^ (((ob >> 9) & 1) << 5)); }
__host__ __device__ __forceinline__ void stage_rc(int b, int& R, int& C) { const int st = b / 1024, sb = b % 1024, swz = sb ^ (((sb >> 9) & 1) << 5); R = (st >> 1) * 16 + swz / 64; C = (st & 1) * 32 + (swz % 64) / 2; }
__host__ __device__ __forceinline__ int perm32(int rho) { const int n = rho >> 4, i = rho & 15; return 8 * (i >> 2) + 4 * n + (i & 3); }
struct Unit { int pm, pn; };
struct Gemm { const bf16_t* A; const bf16_t* Bt; int M, N, K; };
struct StaticOrder {
    int nM, nN, nwg, G, c;
    __host__ __device__ void init(int M, int N, int G_, int c_) { nM = M / BM; nN = N / BM; nwg = nM * nN; G = G_; c = c_; }
    __host__ __device__ bool next(int i, Unit& u) const {
        const long L = (long)i * G + c; if (L >= nwg) return false;
        int wgid = (int)L; { const int q = nwg / NXCD, r = nwg % NXCD, xcd = wgid % NXCD, off = wgid / NXCD; wgid = (xcd < r ? xcd * (q + 1) : r * (q + 1) + (xcd - r) * q) + off; }
        const int nig = WGM * nN, gid = wgid / nig, fm = gid * WGM, gsz = (nM - fm) < WGM ? (nM - fm) : WGM;
        u.pm = fm + ((wgid % nig) % gsz); u.pn = (wgid % nig) / gsz; return true;
    }
    __device__ __forceinline__ void a_ready(const Unit&) const {}
    __device__ __forceinline__ void done(const Unit&) const {}
};
template <class Epi, class Sched, bool STAMP = false>
__device__ __forceinline__ void gemm_phase(PG8_LAS unsigned char* lds, const Gemm g, const Sched& S, const Epi& E, unsigned long long* stamps) {
    const int tid = tid_opaque(), wid = __builtin_amdgcn_readfirstlane(tid >> 6), lane = tid & 63, wr = wid >> 2, wc = wid & 3, fr = lane & 15, fq = lane >> 4;
    const int K = g.K, nt = K / BK;
    int ts_lo = 0, ts_hi = 0, nts = 0; const unsigned long long rt_entry = STAMP ? (unsigned long long)wall_clock64() : 0ull;
#define PG8_STAMP() do { if (STAMP && wid == 0 && nts < 64) { const unsigned long long _c = (unsigned long long)clock64(); \
        ts_lo = (lane == nts) ? (int)(unsigned)_c : ts_lo; ts_hi = (lane == nts) ? (int)(unsigned)(_c >> 32) : ts_hi; ++nts; } } while (0)
    PG8_STAMP();
    unsigned voffA[2], voffB[2];
#pragma unroll
    for (int i = 0; i < 2; ++i) { int R, C; stage_rc(tid * 16 + i * 8192, R, C); const int Rb = Epi::PERM ? ((R & ~31) + perm32(R & 31)) : R;
        voffA[i] = (unsigned)(R * K + C) * 2u; voffB[i] = (unsigned)(Rb * K + C) * 2u; }
    const size_t kstep = (size_t)(BK * 2);
    const size_t hstep = (size_t)HALF * K * 2;
    const size_t tstep = 2 * hstep;
    const unsigned ldsw = (unsigned)wid * 1024u;
    const int aoff = lds_byte(wr * 64 + fr, fq * 8), boff = lds_byte(wc * 32 + fr, fq * 8);
#define PG8_SA(b, h) (((b) * 2 + (h)) * HTB)
#define PG8_SB(b, h) ((4 + (b) * 2 + (h)) * HTB)
#define PG8_STAGE(bufoff, gbase, voff) do { _Pragma("unroll") for (int _i = 0; _i < 2; ++_i) \
        __builtin_amdgcn_global_load_lds((const unsigned*)((const char*)(gbase) + (voff)[_i]), (PG8_LAS unsigned*)(lds + (bufoff) + ldsw + _i * 8192), 16, 0, 0); } while (0)
#define PG8_LDA(dst, b, h) do { _Pragma("unroll") for (int m = 0; m < 4; ++m) _Pragma("unroll") for (int k = 0; k < 2; ++k) dst[m][k] = *(const PG8_LAS bf16x8*)(lds + PG8_SA(b, h) + aoff + m * 2048 + k * 1024); } while (0)
#define PG8_LDB(dst, b, h) do { _Pragma("unroll") for (int n = 0; n < 2; ++n) _Pragma("unroll") for (int k = 0; k < 2; ++k) dst[n][k] = *(const PG8_LAS bf16x8*)(lds + PG8_SB(b, h) + boff + n * 2048 + k * 1024); } while (0)
#define PG8_MMA(ai, bj, At, Bt) do { __builtin_amdgcn_s_setprio(1); _Pragma("unroll") for (int m = 0; m < 4; ++m) _Pragma("unroll") for (int n = 0; n < 2; ++n) _Pragma("unroll") for (int k = 0; k < 2; ++k) \
        acc[ai][bj][m][n] = __builtin_amdgcn_mfma_f32_16x16x32_bf16(Bt[n][k], At[m][k], acc[ai][bj][m][n], 0, 0, 0); __builtin_amdgcn_s_setprio(0); } while (0)
#define PG8_WAIT_V(n) asm volatile("s_waitcnt vmcnt(" #n ")" ::: "memory")
#define PG8_WAIT_L(n) asm volatile("s_waitcnt lgkmcnt(" #n ")" ::: "memory")
#define PG8_BAR __builtin_amdgcn_s_barrier()
#define PG8_SCHED __builtin_amdgcn_sched_barrier(0)
    Unit cur, nxt; int ui = 0;
    if (!S.next(0, cur)) return;
    f32x4 acc[2][2][4][2];
#pragma unroll
    for (int a = 0; a < 2; ++a)
#pragma unroll
        for (int b = 0; b < 2; ++b)
#pragma unroll
            for (int m = 0; m < 4; ++m)
#pragma unroll
                for (int n = 0; n < 2; ++n) acc[a][b][m][n] = (f32x4){0.f, 0.f, 0.f, 0.f};
    bf16x8 At[4][2], B0[2][2], B1[2][2];
    const char* cA = (const char*)g.A + (size_t)cur.pm * tstep; const char* cB = (const char*)g.Bt + (size_t)cur.pn * tstep;
    S.a_ready(cur);
    PG8_STAGE(PG8_SB(0, 0), cB, voffB); PG8_STAGE(PG8_SA(0, 0), cA, voffA); PG8_STAGE(PG8_SB(0, 1), cB + hstep, voffB); PG8_STAGE(PG8_SA(0, 1), cA + hstep, voffA);
    if (wr == 1) PG8_BAR;
    PG8_WAIT_V(4); PG8_BAR;
    PG8_STAGE(PG8_SB(1, 0), cB + kstep, voffB); PG8_STAGE(PG8_SA(1, 0), cA + kstep, voffA); PG8_STAGE(PG8_SB(1, 1), cB + hstep + kstep, voffB);
    PG8_WAIT_V(6); PG8_BAR;
    PG8_STAMP();
    for (;;) {
        const bool has_next = S.next(ui + 1, nxt);
        const char* nA = has_next ? (const char*)g.A + (size_t)nxt.pm * tstep : cA; const char* nB = has_next ? (const char*)g.Bt + (size_t)nxt.pn * tstep : cB;
        for (int t = 0; t < nt; t += 2) {
            const bool last = (t == nt - 2);
            const char* a1 = cA + (size_t)(t + 1) * kstep;
            const char* a2 = last ? nA : cA + (size_t)(t + 2) * kstep; const char* b2 = last ? nB : cB + (size_t)(t + 2) * kstep;
            const char* a3 = a2 + kstep; const char* b3 = b2 + kstep;
            if (last && has_next) S.a_ready(nxt);
            PG8_LDB(B0, 0, 0); PG8_SCHED; PG8_LDA(At, 0, 0); PG8_STAGE(PG8_SA(1, 1), a1 + hstep, voffA);
            PG8_WAIT_L(8); PG8_BAR; PG8_WAIT_L(0); PG8_MMA(0, 0, At, B0); PG8_BAR; PG8_SCHED;
            PG8_LDB(B1, 0, 1); PG8_STAGE(PG8_SB(0, 0), b2, voffB);
            PG8_BAR; PG8_WAIT_L(0); PG8_MMA(0, 1, At, B1); PG8_BAR;
            PG8_LDA(At, 0, 1); PG8_STAGE(PG8_SA(0, 0), a2, voffA);
            PG8_BAR; PG8_WAIT_L(0); PG8_MMA(1, 0, At, B0); PG8_BAR; PG8_SCHED;
            PG8_STAGE(PG8_SB(0, 1), b2 + hstep, voffB);
            PG8_WAIT_V(6); PG8_BAR; PG8_MMA(1, 1, At, B1); PG8_BAR;
            PG8_LDB(B0, 1, 0); PG8_SCHED; PG8_LDA(At, 1, 0); PG8_STAGE(PG8_SA(0, 1), a2 + hstep, voffA);
            PG8_WAIT_L(8); PG8_BAR; PG8_WAIT_L(0); PG8_MMA(0, 0, At, B0); PG8_BAR; PG8_SCHED;
            PG8_LDB(B1, 1, 1); PG8_STAGE(PG8_SB(1, 0), b3, voffB);
            PG8_BAR; PG8_WAIT_L(0); PG8_MMA(0, 1, At, B1); PG8_BAR;
            PG8_LDA(At, 1, 1); PG8_STAGE(PG8_SA(1, 0), a3, voffA);
            PG8_BAR; PG8_WAIT_L(0); PG8_MMA(1, 0, At, B0); PG8_BAR; PG8_SCHED;
            PG8_STAGE(PG8_SB(1, 1), b3 + hstep, voffB);
            PG8_WAIT_V(6); PG8_BAR; PG8_MMA(1, 1, At, B1); PG8_BAR;
        }
        PG8_STAMP();
        if constexpr (!Epi::AFTER_DRAIN) { E(acc, cur, wr, wc, fr, fq); S.done(cur); }
        PG8_STAMP();
        if (!has_next) break;
#pragma unroll
        for (int a = 0; a < 2; ++a)
#pragma unroll
            for (int b = 0; b < 2; ++b)
#pragma unroll
                for (int m = 0; m < 4; ++m)
#pragma unroll
                    for (int n = 0; n < 2; ++n) acc[a][b][m][n] = (f32x4){0.f, 0.f, 0.f, 0.f};
        cur = nxt; cA = nA; cB = nB; ++ui;
    }
    PG8_WAIT_V(0);
    if (wr == 0) PG8_BAR;
    PG8_BAR;
    if constexpr (Epi::AFTER_DRAIN) { E.fused(acc, cur, wr, wc, fr, fq, lds, wid, lane); S.done(cur); }
    PG8_STAMP();
    if (STAMP && wid == 0) { stamps[lane] = lane < nts ? (((unsigned long long)(unsigned)ts_hi << 32) | (unsigned)ts_lo) : 0ull;
        if (lane == 62) stamps[62] = rt_entry; if (lane == 63) stamps[63] = (unsigned long long)wall_clock64(); }
#undef PG8_STAMP
#undef PG8_SA
#undef PG8_SB
#undef PG8_STAGE
#undef PG8_LDA
#undef PG8_LDB
#undef PG8_MMA
#undef PG8_WAIT_V
#undef PG8_WAIT_L
#undef PG8_BAR
#undef PG8_SCHED
}
struct EpiBf16Tiles {
    static constexpr bool PERM = true, AFTER_DRAIN = false;
    bf16_t* d0; int ld0; int ntile0; bf16_t* d1; int ld1;
    __device__ __forceinline__ void operator()(const f32x4 (&acc)[2][2][4][2], const Unit& u, int wr, int wc, int fr, int fq) const {
        bf16_t* base = u.pn < ntile0 ? d0 : d1; const int ld = u.pn < ntile0 ? ld0 : ld1; const int colt = (u.pn < ntile0 ? u.pn : u.pn - ntile0) * BM;
        const int row0 = u.pm * BM + wr * 64 + fr, col0 = colt + wc * 32 + 8 * fq;
#pragma unroll
        for (int ai = 0; ai < 2; ++ai)
#pragma unroll
            for (int m = 0; m < 4; ++m) { bf16_t* rowp = base + (size_t)(row0 + ai * HALF + m * 16) * ld + col0;
#pragma unroll
                for (int bj = 0; bj < 2; ++bj) { const f32x4 v0 = acc[ai][bj][m][0], v1 = acc[ai][bj][m][1];
                    *(uint4*)(rowp + bj * HALF) = make_uint4(pk_bf16(v0[0], v0[1]), pk_bf16(v0[2], v0[3]), pk_bf16(v1[0], v1[1]), pk_bf16(v1[2], v1[3])); } }
    }
};
struct EpiResid256 {
    static constexpr bool PERM = false, AFTER_DRAIN = false;
    const float* xin_lat; const float* xin_ctx; bf16_t* xs_lat; bf16_t* xs_ctx; const float* gate; int src_stream;
    __device__ __forceinline__ void operator()(const f32x4 (&acc)[2][2][4][2], const Unit& u, int wr, int wc, int fr, int fq) const {
        const int row0 = u.pm * BM + wr * 64 + fr, col0 = u.pn * BM + wc * 32 + 4 * fq;
#pragma unroll
        for (int ai = 0; ai < 2; ++ai)
#pragma unroll
            for (int m = 0; m < 4; ++m) {
                const int R = row0 + ai * HALF + m * 16;
                const float* src = R < NL ? xin_lat + (size_t)R * 1024 : xin_ctx + (size_t)(R - NL) * 1024;
                bf16_t* dst = R < NL ? xs_lat + (size_t)R * 1024 : xs_ctx + (size_t)(R - NL) * 1024;
                const float* gr = gate + (size_t)mod_batch(R) * 6144;
#pragma unroll
                for (int bj = 0; bj < 2; ++bj)
#pragma unroll
                    for (int n = 0; n < 2; ++n) {
                        const int col = col0 + bj * HALF + n * 16;
                        float4 xo;
                        if (src_stream) { const uint2 t = *(const uint2*)(dst + col); xo = make_float4(bf_lo(t.x), bf_hi(t.x), bf_lo(t.y), bf_hi(t.y)); }
                        else xo = *(const float4*)(src + col);
                        const float4 g4 = *(const float4*)(gr + col);
                        const f32x4 a = acc[ai][bj][m][n];
                        *(uint2*)(dst + col) = make_uint2(pk_bf16(xo.x + g4.x * a[0], xo.y + g4.y * a[1]), pk_bf16(xo.z + g4.z * a[2], xo.w + g4.w * a[3]));
                    }
            }
    }
};
}

DEV void rw_proj_ctx_tile(const Params& p, unsigned char* lds, int which, const bf16_t* A, bf16_t* dst, int u) {
    const int mt = u >> 3, nt = u & 7;
    ALoadPlain al{A, 1024};
    EpiBf16<128> ep{dst, 1024, nt * 128, 0};
    gemm_unit<128>(lds, al, (const bf16_t*)(p.ws + WS_WPROJ) + (size_t)which * 1024 * 1024 + (size_t)nt * 128 * 1024, 1024, NL + mt * 128, ep);
}
DEV void phase_rw_proj1(const Params& p, unsigned char* lds, int which, const bf16_t* A, bf16_t* dst, int ctx_here) {
    pg8::Gemm g{A, (const bf16_t*)(p.ws + WS_WPROJ) + (size_t)which * 1024 * 1024, NL, 1024, 1024};
    pg8::StaticOrder so; so.init(NL, 1024, gridDim.x, blockIdx.x);
    pg8::EpiBf16Tiles ep{dst, 1024, 4, dst, 1024};
    pg8::gemm_phase((PG8_LAS unsigned char*)lds, g, so, ep, nullptr);
    __syncthreads();
    if (ctx_here)
        for (int u = blockIdx.x; u < (NC / 128) * 8; u += gridDim.x) rw_proj_ctx_tile(p, lds, which, A, dst, u);
}
DEV void phase_rw_lora(const Params& p, unsigned char* lds, const bf16_t* vin, bf16_t* vdst) {
    unsigned char* ws = p.ws;
    const bf16_t* h = (const bf16_t*)(ws + WS_S + 0 * U_BYTES);
    const bf16_t* wproj = (const bf16_t*)(ws + WS_WPROJ);
    const int nunits = (NT / 128) * 3;
    for (int u = blockIdx.x; u < nunits + (NC / 128) * 8; u += gridDim.x) {
        if (u >= nunits) { rw_proj_ctx_tile(p, lds, 2, vin, vdst, u - nunits); continue; }
        const int mt = u / 3, lg = u % 3, m0 = mt * 128;
        const int mixid = lg == 0 ? 1 : (lg == 1 ? 4 : 5);
        ALoadMix al{h, p.in[8] + mixid * 1024, h, 1024};
        EpiBf16<128> ep{(bf16_t*)(ws + WS_S + 4 * U_BYTES), 384, lg * 128, lg == 0 ? 1 : (lg == 1 ? 0 : 2)};
        gemm_unit<128>(lds, al, wproj + (size_t)(3072 + lg * 128) * 1024, 1024, m0, ep);
    }
}

template <int N> DEV float dpp_shr0(float x) { return __int_as_float(__builtin_amdgcn_update_dpp(0, __float_as_int(x), 0x110 + N, 0xF, 0xF, true)); }
template <int CTRL> DEV float dpp_quad(float x) { return __int_as_float(__builtin_amdgcn_update_dpp(0, __float_as_int(x), CTRL, 0xF, 0xF, false)); }
DEV int tile_off(int row, int ch) { return row * 128 + ((ch ^ (row & 7)) << 4); }
DEV int tile_off2(int row, int ch) { return row * 128 + ((ch ^ ((row ^ (row >> 3)) & 7)) << 4); }
DEV void phase_rw_scan(const Params& p, unsigned char* lds) {
    const int tid = tid_opaque(), lane = tid & 63;
    const int wv = __builtin_amdgcn_readfirstlane(tid >> 6);
    const int fr = lane & 15, fq = lane >> 4;
    unsigned char* ws = p.ws;
    constexpr int SH = 0, SL = 8192, AT = 16384  , RT = 20480  , BT = 24576  , KT = 28672  , BKT = 32768  , UV = 49152  , NT = 65536  ;
    constexpr int MFA = 69632, MFK = 70656, X0 = 71680, VS = 75776  , PP = 83968, PM = 88064, PI = 92160, AA = 96256  ;
    constexpr int PL = 116736  , YB = 117760, LDS_END = 121856;
    const bf16_t* rbuf = (const bf16_t*)(ws + WS_S + 3 * U_BYTES);
    const bf16_t* kbuf = (const bf16_t*)(ws + WS_S + 5 * U_BYTES);
    const bf16_t* vbuf = (const bf16_t*)(ws + WS_S + 1 * U_BYTES);
    const bf16_t* lora = (const bf16_t*)(ws + WS_S + 4 * U_BYTES);
    for (int unit = blockIdx.x; unit < 256; unit += gridDim.x) {
        const int b = unit >> 5, hh = (unit >> 1) & 15, d = unit & 1;
        bf16_t* ydst = (bf16_t*)(ws + WS_S + (size_t)(d ? 2 : 0) * U_BYTES);
        float* bonus = (float*)(ws + WS_BONUS) + (size_t)((d * NB + b) * 16 + hh) * 8448;
        const int s_e = (tid >> 4) & 15, j0 = (tid & 15) * 4;
        const int ni = wv & 3;
        auto Rof = [&](int c, int s) -> int {
            if (c < 16) { const int q = c * 16 + s; return NL + b * 256 + (d ? 255 - q : q); }
            const int q = (c - 16) * 16 + s; return b * 8192 + (d ? 8191 - q : q);
        };
        constexpr int CST = LDS_END;
        uint2 pr = make_uint2(0, 0), pk = pr, pv = pr; uint4 paw[2], paa[2];
        if (wv >= 4) {
            const int ct = (tid - 256) * 16;
            *(float4*)(lds + CST + 0 * 4096 + ct) = *(const float4*)(p.in[18] + hh * 64 + j0);
            *(float4*)(lds + CST + 1 * 4096 + ct) = *(const float4*)(p.in[19] + hh * 64 + j0);
            *(float4*)(lds + CST + 2 * 4096 + ct) = *(const float4*)(p.in[20] + hh * 64 + j0);
            *(float4*)(lds + CST + 3 * 4096 + ct) = *(const float4*)(p.in[10] + d * 1024 + hh * 64 + ni * 16 + fq * 4);
            *(float4*)(lds + CST + 4 * 4096 + ct) = *(const float4*)(p.in[13] + d * 1024 + hh * 64 + ni * 16 + fq * 4);
#pragma unroll
            for (int ks = 0; ks < 2; ++ks) {
                *(uint4*)(lds + CST + (5 + ks) * 4096 + ct) = *(const uint4*)((const bf16_t*)(ws + WS_W2T) + (size_t)d * 1024 * 64 + (size_t)(hh * 64 + ni * 16 + fr) * 64 + ks * 32 + fq * 8);
                *(uint4*)(lds + CST + (7 + ks) * 4096 + ct) = *(const uint4*)((const bf16_t*)(ws + WS_A2T) + (size_t)d * 1024 * 64 + (size_t)(hh * 64 + ni * 16 + fr) * 64 + ks * 32 + fq * 8);
            }
        }
        auto load_lora = [&](int c) {
            const size_t R2 = (size_t)Rof(c, fr);
#pragma unroll
            for (int ks = 0; ks < 2; ++ks) { paw[ks] = *(const uint4*)(lora + R2 * 384 + d * 64 + ks * 32 + fq * 8); paa[ks] = *(const uint4*)(lora + R2 * 384 + 128 + d * 64 + ks * 32 + fq * 8); }
        };
        auto load_rkv = [&](int c) {
            const size_t off = (size_t)Rof(c, s_e) * 1024 + hh * 64 + j0;
            pr = *(const uint2*)(rbuf + off); pk = *(const uint2*)(kbuf + off); pv = *(const uint2*)(vbuf + off);
        };
        auto step_up = [&](int c) {
            const int ct = (tid - 256) * 16;
            const float4 bias_w = *(const float4*)(lds + CST + 3 * 4096 + ct), bias_a = *(const float4*)(lds + CST + 4 * 4096 + ct);
            bf16x8 bfw[2], bfa[2];
#pragma unroll
            for (int ks = 0; ks < 2; ++ks) { bfw[ks] = *(const bf16x8*)(lds + CST + (5 + ks) * 4096 + ct); bfa[ks] = *(const bf16x8*)(lds + CST + (7 + ks) * 4096 + ct); }
            f32x4 accw = {0.f, 0.f, 0.f, 0.f}, acca = {0.f, 0.f, 0.f, 0.f};
#pragma unroll
            for (int ks = 0; ks < 2; ++ks) { accw = __builtin_amdgcn_mfma_f32_16x16x32_bf16(bfw[ks], as_bf16x8(paw[ks]), accw, 0, 0, 0); acca = __builtin_amdgcn_mfma_f32_16x16x32_bf16(bfa[ks], as_bf16x8(paa[ks]), acca, 0, 0, 0); }
            const int n = ni * 16 + fq * 4;
            const float bw[4] = {bias_w.x, bias_w.y, bias_w.z, bias_w.w}, ba[4] = {bias_a.x, bias_a.y, bias_a.z, bias_a.w};
            float P[4], Pm[4], Pi[4], av[4];
#pragma unroll
            for (int j = 0; j < 4; ++j) {
                const float e = 0.6065306597f * __builtin_amdgcn_rcpf(1.0f + __expf(-(accw[j] + bw[j])));
                float s = e;
                s += dpp_shr0<1>(s); s += dpp_shr0<2>(s); s += dpp_shr0<4>(s); s += dpp_shr0<8>(s);
                P[j] = __expf(-s); Pi[j] = __builtin_amdgcn_rcpf(P[j]); Pm[j] = P[j] * __expf(e);
                av[j] = __builtin_amdgcn_rcpf(1.0f + __expf(-(acca[j] + ba[j])));
            }
            const int pb = (c & 1) * 16384;
            *(float4*)(lds + PP + pb + (fr * 64 + n) * 4) = make_float4(P[0], P[1], P[2], P[3]);
            *(float4*)(lds + PM + pb + (fr * 64 + n) * 4) = make_float4(Pm[0], Pm[1], Pm[2], Pm[3]);
            *(float4*)(lds + PI + pb + (fr * 64 + n) * 4) = make_float4(Pi[0], Pi[1], Pi[2], Pi[3]);
            *(float4*)(lds + AA + pb + (fr * 64 + n) * 4) = make_float4(av[0], av[1], av[2], av[3]);
            if (fr == 15) *(float4*)(lds + PL + (c & 3) * 256 + n * 4) = make_float4(P[0], P[1], P[2], P[3]);
        };
        auto step_vec = [&](int c) {
            const int eo = (s_e * 64 + j0) * 4, pb = (c & 1) * 16384, tb = (c & 1) * 8192, ct = (tid - 256) * 16;
            const float4 kk_c = *(const float4*)(lds + CST + 0 * 4096 + ct), ka_c = *(const float4*)(lds + CST + 1 * 4096 + ct), rk_c = *(const float4*)(lds + CST + 2 * 4096 + ct);
            const float4 a4 = *(const float4*)(lds + AA + pb + eo), P4 = *(const float4*)(lds + PP + pb + eo), Pm4 = *(const float4*)(lds + PM + pb + eo), Pi4 = *(const float4*)(lds + PI + pb + eo);
            const float kx[4] = {bf_lo(pk.x), bf_hi(pk.x), bf_lo(pk.y), bf_hi(pk.y)};
            const float rx[4] = {bf_lo(pr.x), bf_hi(pr.x), bf_lo(pr.y), bf_hi(pr.y)};
            const float av[4] = {a4.x, a4.y, a4.z, a4.w}, Pv[4] = {P4.x, P4.y, P4.z, P4.w}, Pmv[4] = {Pm4.x, Pm4.y, Pm4.z, Pm4.w}, Piv[4] = {Pi4.x, Pi4.y, Pi4.z, Pi4.w};
            const float kkc[4] = {kk_c.x, kk_c.y, kk_c.z, kk_c.w}, kac[4] = {ka_c.x, ka_c.y, ka_c.z, ka_c.w}, rkc[4] = {rk_c.x, rk_c.y, rk_c.z, rk_c.w};
            float t[4], n2 = 0.f;
#pragma unroll
            for (int j = 0; j < 4; ++j) { t[j] = kx[j] * kkc[j]; n2 += t[j] * t[j]; }
            n2 = row16_allreduce(n2);
            const float inv = __builtin_amdgcn_rsqf(fmaxf(n2, 1e-24f));
            float at[4], bt[4], kt[4], rt[4], bon = 0.f;
#pragma unroll
            for (int j = 0; j < 4; ++j) {
                const float kkv = t[j] * inv;
                const float kd = kx[j] * (1.0f + (av[j] - 1.0f) * kac[j]);
                const float bq = kkv * av[j];
                bon += rx[j] * kd * rkc[j];
                at[j] = -kkv * Pmv[j]; bt[j] = bq * Piv[j]; kt[j] = kd * Piv[j]; rt[j] = rx[j] * Pv[j];
            }
            bon = row16_allreduce(bon);
            if ((tid & 15) == 0) { const int Rb = Rof(c, s_e); bonus[Rb < NL ? 256 + (Rb & 8191) : ((Rb - NL) & 255)] = bon; }
            const int ro = tile_off(s_e, j0 >> 3) + (j0 & 7) * 2;
            *(uint2*)(lds + AT + (c & 1) * 2048 + ro) = make_uint2(pk_bf16(at[0], at[1]), pk_bf16(at[2], at[3]));
            *(uint2*)(lds + RT + (c & 1) * 2048 + ro) = make_uint2(pk_bf16(rt[0], rt[1]), pk_bf16(rt[2], rt[3]));
            const unsigned b01 = pk_bf16(bt[0], bt[1]), b23 = pk_bf16(bt[2], bt[3]), k01 = pk_bf16(kt[0], kt[1]), k23 = pk_bf16(kt[2], kt[3]);
            *(uint2*)(lds + BT + (c & 1) * 2048 + ro) = make_uint2(b01, b23);
            *(uint2*)(lds + KT + (c & 1) * 2048 + ro) = make_uint2(k01, k23);
            const unsigned bw2[4] = {b01 & 0xffffu, b01 >> 16, b23 & 0xffffu, b23 >> 16}, kw2[4] = {k01 & 0xffffu, k01 >> 16, k23 & 0xffffu, k23 >> 16};
            const unsigned vw[4] = {pv.x & 0xffffu, pv.x >> 16, pv.y & 0xffffu, pv.y >> 16};
            const int e0 = (s_e & 7) * 2, cq = s_e >> 3, a_ = tid & 15;
            const int B0 = j0 * 128 + e0 + (((cq ^ (4 * (a_ & 1)) ^ (a_ >> 1)) & 7) << 4);
#pragma unroll
            for (int j = 0; j < 4; ++j) {
                *(bf16_t*)(lds + BKT + tb + (B0 ^ ((0 ^ j) << 4)) + j * 128) = (bf16_t)bw2[j];
                *(bf16_t*)(lds + BKT + tb + (B0 ^ ((2 ^ j) << 4)) + j * 128) = (bf16_t)kw2[j];
                *(bf16_t*)(lds + BKT + tb + (B0 ^ ((4 ^ j) << 4)) + j * 128) = (bf16_t)bw2[j];
                *(bf16_t*)(lds + UV + tb + (B0 ^ ((2 ^ j) << 4)) + j * 128) = (bf16_t)vw[j];
            }
        };
        f32x4 accY = {0.f, 0.f, 0.f, 0.f};
        auto prod_S = [&](int c) {
            const int vt = wv & 3, tb = (c & 1) * 2048;
            f32x4 accX = {0.f, 0.f, 0.f, 0.f}, accR = {0.f, 0.f, 0.f, 0.f};
#pragma unroll
            for (int ks = 0; ks < 2; ++ks) {
                const int ch = ks * 4 + fq;
                const bf16x8 sh = *(const bf16x8*)(lds + SH + tile_off(vt * 16 + fr, ch)), sl = *(const bf16x8*)(lds + SL + tile_off(vt * 16 + fr, ch));
                const bf16x8 fa = *(const bf16x8*)(lds + AT + tb + tile_off(fr, ch)), frr = *(const bf16x8*)(lds + RT + tb + tile_off(fr, ch));
                accX = __builtin_amdgcn_mfma_f32_16x16x32_bf16(sh, fa, accX, 0, 0, 0);
                accR = __builtin_amdgcn_mfma_f32_16x16x32_bf16(sh, frr, accR, 0, 0, 0);
                accX = __builtin_amdgcn_mfma_f32_16x16x32_bf16(sl, fa, accX, 0, 0, 0);
                accR = __builtin_amdgcn_mfma_f32_16x16x32_bf16(sl, frr, accR, 0, 0, 0);
            }
            accY = accR;
            {
                const u32x2v av = *(const u32x2v*)(lds + UV + (c & 1) * 8192 + tile_off2(vt * 16 + fr, 2 + (fq >> 1)) + (fq & 1) * 8);
                const u32x2v mh = *(const u32x2v*)(lds + MFK + (fr * 4 + fq) * 8), ml = *(const u32x2v*)(lds + MFK + 512 + (fr * 4 + fq) * 8);
                accX = __builtin_amdgcn_mfma_f32_16x16x16bf16_1k(__builtin_bit_cast(s16x4v, av), __builtin_bit_cast(s16x4v, mh), accX, 0, 0, 0);
                accX = __builtin_amdgcn_mfma_f32_16x16x16bf16_1k(__builtin_bit_cast(s16x4v, av), __builtin_bit_cast(s16x4v, ml), accX, 0, 0, 0);
            }
#pragma unroll
            for (int j = 0; j < 4; ++j) *(float*)(lds + X0 + ((vt * 16 + 4 * fq + j) * 16 + fr) * 4) = accX[j];
        };
        auto prod_V = [&](int c) {
            const int tb = (c & 1) * 2048, w4 = wv & 3;
            f32x4 m = {0.f, 0.f, 0.f, 0.f};
#pragma unroll
            for (int ks = 0; ks < 2; ++ks) {
                const int ch = ks * 4 + fq;
                const bf16x8 fa = *(const bf16x8*)(lds + ((w4 & 1) ? KT : BT) + tb + tile_off(fr, ch));
                const bf16x8 fb = *(const bf16x8*)(lds + ((w4 & 2) ? RT : AT) + tb + tile_off(fr, ch));
                m = __builtin_amdgcn_mfma_f32_16x16x32_bf16(fa, fb, m, 0, 0, 0);
            }
            if (w4 == 0) {
                float* mf = (float*)(lds + MFA);
#pragma unroll
                for (int j = 0; j < 4; ++j) mf[(fr * 4 + j) * 4 + fq] = (4 * fq + j < fr) ? m[j] : 0.f;
            } else if (w4 == 1) {
                const float m0 = (4 * fq + 0 < fr) ? m[0] : 0.f, m1 = (4 * fq + 1 < fr) ? m[1] : 0.f, m2 = (4 * fq + 2 < fr) ? m[2] : 0.f, m3 = (4 * fq + 3 < fr) ? m[3] : 0.f;
                const unsigned h01 = pk_bf16(m0, m1), h23 = pk_bf16(m2, m3);
                *(uint2*)(lds + MFK + (fr * 4 + fq) * 8) = make_uint2(h01, h23);
                *(uint2*)(lds + MFK + 512 + (fr * 4 + fq) * 8) = make_uint2(pk_bf16(m0 - bf_lo(h01), m1 - bf_hi(h01)), pk_bf16(m2 - bf_lo(h23), m3 - bf_hi(h23)));
            } else {
                const float m0 = (4 * fq + 0 <= fr) ? m[0] : 0.f, m1 = (4 * fq + 1 <= fr) ? m[1] : 0.f, m2 = (4 * fq + 2 <= fr) ? m[2] : 0.f, m3 = (4 * fq + 3 <= fr) ? m[3] : 0.f;
                const uint2 o = make_uint2(pk_bf16(m0, m1), pk_bf16(m2, m3));
                const int colb = (w4 == 2 ? 0 : 16) + 4 * fq;
                *(uint2*)(lds + NT + tb + tile_off(fr, colb >> 3) + (colb & 7) * 2) = o;
                if (w4 == 2) *(uint2*)(lds + NT + tb + tile_off(fr, (32 + 4 * fq) >> 3) + ((32 + 4 * fq) & 7) * 2) = o;
            }
        };
        auto step_rec = [&](int c) {
            const int v = tid >> 2, pq = tid & 3;
            float cc[16];
#pragma unroll
            for (int i = 0; i < 4; ++i) { const float4 q = *(const float4*)(lds + X0 + (v * 16 + 4 * i) * 4); cc[4 * i] = q.x; cc[4 * i + 1] = q.y; cc[4 * i + 2] = q.z; cc[4 * i + 3] = q.w; }
            float4 ma[16];
#pragma unroll
            for (int t = 1; t < 16; ++t) ma[t] = *(const float4*)(lds + MFA + ((t * 4 + pq) * 4) * 4);
            ma[0] = make_float4(0.f, 0.f, 0.f, 0.f);
            float uown[4] = {0.f, 0.f, 0.f, 0.f}, uall[16];
#pragma unroll
            for (int t = 0; t < 16; ++t) {
                float s = uown[0] * ma[t].x; s = fmaf(uown[1], ma[t].y, s); s = fmaf(uown[2], ma[t].z, s); s = fmaf(uown[3], ma[t].w, s);
                s += dpp_quad<0xB1>(s); s += dpp_quad<0x4E>(s);
                const float u = cc[t] + s;
                uall[t] = u;
                if (pq == (t & 3)) uown[t >> 2] = u;
            }
            if (pq < 2) {
                unsigned o[8];
#pragma unroll
                for (int i = 0; i < 8; ++i) {
                    const unsigned hi = pk_bf16(uall[2 * i], uall[2 * i + 1]);
                    o[i] = pq ? pk_bf16(uall[2 * i] - bf_lo(hi), uall[2 * i + 1] - bf_hi(hi)) : hi;
                }
                const int cb = pq ? 4 : 0;
                *(uint4*)(lds + UV + (c & 1) * 8192 + tile_off2(v, cb)) = make_uint4(o[0], o[1], o[2], o[3]);
                *(uint4*)(lds + UV + (c & 1) * 8192 + tile_off2(v, cb + 1)) = make_uint4(o[4], o[5], o[6], o[7]);
            }
        };
        f32x4 accS[2];
        accS[0] = (f32x4){0.f, 0.f, 0.f, 0.f}; accS[1] = (f32x4){0.f, 0.f, 0.f, 0.f};
        auto step_upd = [&](int c) {
            const int vt = wv & 3;
            bf16x8 fuv[2];
#pragma unroll
            for (int ks = 0; ks < 2; ++ks) fuv[ks] = *(const bf16x8*)(lds + UV + (c & 1) * 8192 + tile_off2(vt * 16 + fr, ks * 4 + fq));
            if (wv < 4) {
#pragma unroll
                for (int ks = 0; ks < 2; ++ks) accY = __builtin_amdgcn_mfma_f32_16x16x32_bf16(fuv[ks], *(const bf16x8*)(lds + NT + (c & 1) * 2048 + tile_off(fr, ks * 4 + fq)), accY, 0, 0, 0);
                *(float4*)(lds + YB + (fr * 64 + vt * 16 + 4 * fq) * 4) = make_float4(accY[0], accY[1], accY[2], accY[3]);
            }
#pragma unroll
            for (int k2 = 0; k2 < 2; ++k2) {
                const int kt = 2 * (wv >> 2) + k2;
                f32x4 a = accS[k2];
#pragma unroll
                for (int ks = 0; ks < 2; ++ks) a = __builtin_amdgcn_mfma_f32_16x16x32_bf16(*(const bf16x8*)(lds + BKT + (c & 1) * 8192 + tile_off2(kt * 16 + fr, ks * 4 + fq)), fuv[ks], a, 0, 0, 0);
                const float4 pl = *(const float4*)(lds + PL + (c & 3) * 256 + (kt * 16 + 4 * fq) * 4);
                a[0] *= pl.x; a[1] *= pl.y; a[2] *= pl.z; a[3] *= pl.w;
                accS[k2] = a;
                const unsigned h01 = pk_bf16(a[0], a[1]), h23 = pk_bf16(a[2], a[3]);
                const unsigned l01 = pk_bf16(a[0] - bf_lo(h01), a[1] - bf_hi(h01)), l23 = pk_bf16(a[2] - bf_lo(h23), a[3] - bf_hi(h23));
                const int kc = kt * 16 + 4 * fq;
                const int so = tile_off(vt * 16 + fr, kc >> 3) + (kc & 7) * 2;
                *(uint2*)(lds + SH + so) = make_uint2(h01, h23);
                *(uint2*)(lds + SL + so) = make_uint2(l01, l23);
            }
        };
        for (int i = tid; i < LDS_END / 16; i += NTHREADS) *(uint4*)(lds + i * 16) = make_uint4(0, 0, 0, 0);
        if (wv >= 4) { load_lora(0); load_rkv(0); }
        __syncthreads();
        if (wv >= 4) { step_up(0); load_lora(1); }
        __syncthreads();
        if (wv >= 4) { step_vec(0); step_up(1); load_rkv(1); load_lora(2); }
        __syncthreads();
        if (wv >= 4) prod_V(0);
        __syncthreads();
        auto ystore = [&](int c) {
            const float4 y4 = *(const float4*)(lds + YB + (s_e * 64 + j0) * 4);
            *(uint2*)(ydst + (size_t)Rof(c, s_e) * 1024 + hh * 64 + j0) = make_uint2(pk_bf16(y4.x, y4.y), pk_bf16(y4.z, y4.w));
        };
        if (wv < 4) {
            unsigned pfd = 0;
            for (int c = 0; c < 528; ++c) {
                if (c > 0) ystore(c - 1);
                if (c + 4 < 528 && tid < 80) {
                    const bf16_t* pf;
                    if (tid < 48) { const int ten = tid >> 4; pf = (ten == 0 ? rbuf : (ten == 1 ? kbuf : vbuf)) + (size_t)Rof(c + 4, tid & 15) * 1024 + hh * 64; }
                    else { const int i = tid - 48; pf = lora + (size_t)Rof(c + 4, i >> 1) * 384 + (i & 1) * 128 + d * 64; }
                    asm volatile("global_load_dword %0, %1, off" : "=v"(pfd) : "v"(pf) : "memory");
                }
                __builtin_amdgcn_s_setprio(3);
                prod_S(c);
                step_rec(c);
                __builtin_amdgcn_s_setprio(0);
                __syncthreads();
                step_upd(c);
                __syncthreads();
                asm volatile("" :: "v"(pfd));
            }
        } else {
            for (int c = 0; c < 528; ++c) {
                if (c + 1 < 528) step_vec(c + 1);
                if (c + 2 < 528) { step_up(c + 2); load_rkv(c + 2); }
                if (c + 3 < 528) load_lora(c + 3);
                __syncthreads();
                step_upd(c);
                if (c + 1 < 528) prod_V(c + 1);
                __syncthreads();
            }
        }
        if (wv < 4) ystore(527);
        __syncthreads();
    }
}

DEV void phase_rw_readout(const Params& p) {
    const int tid = tid_opaque(), lane = tid & 63, wv = tid >> 6, wm = wv >> 2, wn = wv & 3;
    const int fr = lane & 15, fq = lane >> 4;
    unsigned char* ws = p.ws;
    const bf16_t* y0b = (const bf16_t*)(ws + WS_S + 0 * U_BYTES);
    const bf16_t* y1b = (const bf16_t*)(ws + WS_S + 2 * U_BYTES);
    const bf16_t* vb = (const bf16_t*)(ws + WS_S + 1 * U_BYTES);
    const bf16_t* lora = (const bf16_t*)(ws + WS_S + 4 * U_BYTES);
    const bf16_t* g2t = (const bf16_t*)(ws + WS_G2T);
    bf16_t* ao = (bf16_t*)(ws + WS_S + 5 * U_BYTES);
    const float* bon0 = (const float*)(ws + WS_BONUS);
    const float* bon1 = bon0 + (size_t)NB * 16 * 8448;
    const float* lnw = p.in[21];
    const float* lnb = p.in[22];
    const int nunits = (NT / 128) * 4;
    for (int u = blockIdx.x; u < nunits; u += gridDim.x) {
        const int mt = u >> 2, nt = u & 3, m0 = mt * 128;
        const int hh = nt * 4 + wn;
        f32x4 acc[4][4];
#pragma unroll
        for (int mi = 0; mi < 4; ++mi)
#pragma unroll
            for (int ni = 0; ni < 4; ++ni) acc[mi][ni] = (f32x4){0.f, 0.f, 0.f, 0.f};
#pragma unroll 2
        for (int ks = 0; ks < 4; ++ks) {
            bf16x8 af[4], bfr[4];
#pragma unroll
            for (int mi = 0; mi < 4; ++mi) af[mi] = *(const bf16x8*)(lora + (size_t)(m0 + wm * 64 + mi * 16 + fr) * 384 + 256 + ks * 32 + fq * 8);
#pragma unroll
            for (int ni = 0; ni < 4; ++ni) bfr[ni] = *(const bf16x8*)(g2t + (size_t)(hh * 64 + 16 * (fr >> 2) + 4 * ni + (fr & 3)) * 128 + ks * 32 + fq * 8);
#pragma unroll
            for (int mi = 0; mi < 4; ++mi)
#pragma unroll
                for (int ni = 0; ni < 4; ++ni) acc[mi][ni] = __builtin_amdgcn_mfma_f32_16x16x32_bf16(bfr[ni], af[mi], acc[mi][ni], 0, 0, 0);
        }
#pragma unroll
        for (int mi = 0; mi < 4; ++mi) {
            const size_t R = (size_t)(m0 + wm * 64 + mi * 16 + fr);
            float yv[4][4]; float sum = 0.f;
            const int colb = hh * 64 + 16 * fq;
            {
                const uint4 a0 = *(const uint4*)(y0b + R * 1024 + colb), a1 = *(const uint4*)(y0b + R * 1024 + colb + 8);
                const uint4 c0 = *(const uint4*)(y1b + R * 1024 + colb), c1 = *(const uint4*)(y1b + R * 1024 + colb + 8);
                const unsigned aw[8] = {a0.x, a0.y, a0.z, a0.w, a1.x, a1.y, a1.z, a1.w}, cw[8] = {c0.x, c0.y, c0.z, c0.w, c1.x, c1.y, c1.z, c1.w};
#pragma unroll
                for (int ni = 0; ni < 4; ++ni) {
                    yv[ni][0] = bf_lo(aw[2 * ni]) + bf_lo(cw[2 * ni]); yv[ni][1] = bf_hi(aw[2 * ni]) + bf_hi(cw[2 * ni]);
                    yv[ni][2] = bf_lo(aw[2 * ni + 1]) + bf_lo(cw[2 * ni + 1]); yv[ni][3] = bf_hi(aw[2 * ni + 1]) + bf_hi(cw[2 * ni + 1]);
                    sum += (yv[ni][0] + yv[ni][1]) + (yv[ni][2] + yv[ni][3]);
                }
            }
            sum += __shfl_xor(sum, 16); sum += __shfl_xor(sum, 32);
            const float mu = sum * (1.0f / 64.0f);
            float q = 0.f;
#pragma unroll
            for (int ni = 0; ni < 4; ++ni)
#pragma unroll
                for (int j = 0; j < 4; ++j) { const float dlt = yv[ni][j] - mu; q += dlt * dlt; }
            q += __shfl_xor(q, 16); q += __shfl_xor(q, 32);
            const float rstd = rsqrtf(q * (1.0f / 64.0f) + 64e-5f);
            const size_t bidx = (size_t)(((R < NL ? (R >> 13) : ((R - NL) >> 8)) * 16 + hh)) * 8448 + (R < NL ? 256 + (R & 8191) : ((R - NL) & 255));
            const float bs = bon0[bidx] + bon1[bidx];
            const uint4 v0 = *(const uint4*)(vb + R * 1024 + colb), v1 = *(const uint4*)(vb + R * 1024 + colb + 8);
            const unsigned vw[8] = {v0.x, v0.y, v0.z, v0.w, v1.x, v1.y, v1.z, v1.w};
            unsigned ow[8];
#pragma unroll
            for (int ni = 0; ni < 4; ++ni) {
                const int col = colb + 4 * ni;
                const float4 lw = *(const float4*)(lnw + col), lb = *(const float4*)(lnb + col);
                const float o0 = ((yv[ni][0] - mu) * rstd * lw.x + lb.x + bs * bf_lo(vw[2 * ni])) * acc[mi][ni][0];
                const float o1 = ((yv[ni][1] - mu) * rstd * lw.y + lb.y + bs * bf_hi(vw[2 * ni])) * acc[mi][ni][1];
                const float o2 = ((yv[ni][2] - mu) * rstd * lw.z + lb.z + bs * bf_lo(vw[2 * ni + 1])) * acc[mi][ni][2];
                const float o3 = ((yv[ni][3] - mu) * rstd * lw.w + lb.w + bs * bf_hi(vw[2 * ni + 1])) * acc[mi][ni][3];
                ow[2 * ni] = pk_bf16(o0, o1); ow[2 * ni + 1] = pk_bf16(o2, o3);
            }
            *(uint4*)(ao + R * 1024 + colb) = make_uint4(ow[0], ow[1], ow[2], ow[3]);
            *(uint4*)(ao + R * 1024 + colb + 8) = make_uint4(ow[4], ow[5], ow[6], ow[7]);
        }
    }
}

DEV void phase_wo(const Params& p, unsigned char* lds, int layer) {
    unsigned char* ws = p.ws;
    const bf16_t* ao = (const bf16_t*)(ws + WS_S + (size_t)(layer ? 0 : 5) * U_BYTES);
    const bf16_t* wot = (const bf16_t*)(ws + (layer ? WS_WO1 : WS_WO0));
    bf16_t* xs_lat = (bf16_t*)p.out; bf16_t* xs_ctx = (bf16_t*)(ws + WS_CTXR);
    const float* gate = (const float*)(ws + WS_MOD) + (size_t)layer * 9 * 6144 + 2 * 1024;
    const int M = NL;
    pg8::Gemm g{ao, wot, M, 1024, 1024};
    pg8::StaticOrder so; so.init(M, 1024, gridDim.x, blockIdx.x);
    pg8::EpiResid256 ep{p.in[0], p.in[2], xs_lat, xs_ctx, gate, layer};
    pg8::gemm_phase((PG8_LAS unsigned char*)lds, g, so, ep, nullptr);
    __syncthreads();
    if (!layer)
        for (int u = blockIdx.x; u < (NC / 128) * 8; u += gridDim.x) {
            const int mt = u >> 3, nt = u & 7;
            ALoadPlain al{ao, 1024};
            EpiResid<2> ep2{p.in[0], p.in[2], xs_lat, xs_ctx, gate, nt * 128};
            gemm_unit<128>(lds, al, wot + (size_t)nt * 128 * 1024, 1024, NL + mt * 128, ep2);
        }
}

struct EpiQTile {
    unsigned char* lds;
    DEV void operator()(const f32x4 (&acc)[4][4], int m0, int wm, int wn, int fr, int fq) const {
        const int pp = wn >> 1;
#pragma unroll
        for (int mi = 0; mi < 4; ++mi) {
            const int m = wm * 64 + mi * 16 + fr;
#pragma unroll
            for (int ni = 0; ni < 4; ++ni) {
                const int c = (wn & 1) * 64 + ni * 16 + 4 * fq;
                *(uint2*)(lds + pp * 32768 + m * 256 + (((c >> 3) ^ (m & 15)) << 4) + (c & 7) * 2) = make_uint2(pk_bf16(acc[mi][ni][0], acc[mi][ni][1]), pk_bf16(acc[mi][ni][2], acc[mi][ni][3]));
            }
        }
    }
};
DEV void phase_peer_select(const Params& p, unsigned char* lds, int layer) {
    const int tid = tid_opaque(), lane = tid & 63, wv = tid >> 6, wm = wv >> 2, wn = wv & 3;
    const int fr = lane & 15, fq = lane >> 4;
    unsigned char* ws = p.ws;
    const bf16_t* hp = (const bf16_t*)(ws + WS_S + (size_t)(layer ? 0 : 1) * U_BYTES);
    const bf16_t* wqt = (const bf16_t*)(ws + WS_WQ) + (size_t)layer * 2048 * 1024;
    const bf16_t* keys = (const bf16_t*)(ws + WS_KEYS) + (size_t)layer * 8 * 2 * 128 * 128;
    int* pl_idx = (int*)(ws + WS_S + 3 * U_BYTES);
    float* pl_gate = (float*)(ws + WS_S + 3 * U_BYTES + (size_t)NT * 128 * 4);
    unsigned* slist = (unsigned*)lds;
    unsigned* tlist = (unsigned*)(lds + 256 * 132 * 4);
    const int mtiles = layer ? NL / 128 : NT / 128;
    for (int u = blockIdx.x; u < mtiles * 8; u += gridDim.x) {
        const int mt = u >> 3, head = u & 7, m0 = mt * 128;
        ALoadPlain al{hp, 1024};
        EpiQTile ep{lds};
        gemm_unit<256>(lds, al, wqt + (size_t)head * 256 * 1024, 1024, m0, ep);
        __syncthreads();
        const int pp = wn >> 1, nk0 = (wn & 1) * 64;
        f32x4 sc[4][4];
#pragma unroll
        for (int mi = 0; mi < 4; ++mi)
#pragma unroll
            for (int ni = 0; ni < 4; ++ni) sc[mi][ni] = (f32x4){0.f, 0.f, 0.f, 0.f};
        const bf16_t* kb = keys + (size_t)(head * 2 + pp) * 16384;
#pragma unroll
        for (int ks = 0; ks < 4; ++ks) {
            bf16x8 af[4], bfr[4];
            const int ch = ks * 4 + fq;
#pragma unroll
            for (int mi = 0; mi < 4; ++mi) { const int m = wm * 64 + mi * 16 + fr; af[mi] = *(const bf16x8*)(lds + pp * 32768 + m * 256 + ((ch ^ (m & 15)) << 4)); }
#pragma unroll
            for (int ni = 0; ni < 4; ++ni) bfr[ni] = *(const bf16x8*)(kb + (size_t)(nk0 + ni * 16 + fr) * 128 + ks * 32 + fq * 8);
#pragma unroll
            for (int mi = 0; mi < 4; ++mi)
#pragma unroll
                for (int ni = 0; ni < 4; ++ni) sc[mi][ni] = __builtin_amdgcn_mfma_f32_16x16x32_bf16(bfr[ni], af[mi], sc[mi][ni], 0, 0, 0);
        }
        __syncthreads();
#pragma unroll
        for (int mi = 0; mi < 4; ++mi) {
            const int m = wm * 64 + mi * 16 + fr;
#pragma unroll
            for (int ni = 0; ni < 4; ++ni) {
                const int n = nk0 + ni * 16 + 4 * fq;
                uint4 o;
                o.x = (mono_u32(sc[mi][ni][0]) & ~127u) | (unsigned)(127 - (n + 0));
                o.y = (mono_u32(sc[mi][ni][1]) & ~127u) | (unsigned)(127 - (n + 1));
                o.z = (mono_u32(sc[mi][ni][2]) & ~127u) | (unsigned)(127 - (n + 2));
                o.w = (mono_u32(sc[mi][ni][3]) & ~127u) | (unsigned)(127 - (n + 3));
                *(uint4*)(slist + (size_t)(pp * 128 + m) * 132 + n) = o;
            }
        }
        __syncthreads();
        {
            const int L = tid >> 1, g2 = tid & 1;
            unsigned t[64];
            {
                const unsigned* srcp = slist + (size_t)L * 132 + g2 * 64;
#pragma unroll
                for (int i = 0; i < 16; ++i) { const uint4 v = *(const uint4*)(srcp + i * 4); t[4 * i] = v.x; t[4 * i + 1] = v.y; t[4 * i + 2] = v.z; t[4 * i + 3] = v.w; }
            }
#pragma unroll
            for (int o = 0; o < 64; o += 16) {
#pragma unroll
                for (int pp2 = 1; pp2 < 16; pp2 <<= 1)
#pragma unroll
                    for (int k = pp2; k >= 1; k >>= 1)
#pragma unroll
                        for (int j = k % pp2; j <= 15 - k; j += 2 * k)
#pragma unroll
                            for (int i = 0; i < k; ++i) {
                                if (i + j + k <= 15 && (i + j) / (2 * pp2) == (i + j + k) / (2 * pp2)) {
                                    const unsigned mx = max(t[o + i + j], t[o + i + j + k]), mn = min(t[o + i + j], t[o + i + j + k]);
                                    t[o + i + j] = mx; t[o + i + j + k] = mn;
                                }
                            }
            }
#pragma unroll
            for (int rnd = 0; rnd < 4; ++rnd) {
                const int oa = rnd == 1 ? 32 : 0, ob = rnd == 0 ? 16 : (rnd == 1 ? 48 : 32);
                unsigned c[16];
#pragma unroll
                for (int i = 0; i < 16; ++i) {
                    unsigned b;
                    if (rnd < 3) b = t[ob + 15 - i];
                    else b = (unsigned)__builtin_amdgcn_update_dpp(0, (int)t[15 - i], 0xB1, 0xF, 0xF, false);
                    c[i] = max(t[oa + i], b);
                }
#pragma unroll
                for (int j = 8; j > 0; j >>= 1)
#pragma unroll
                    for (int i = 0; i < 16; ++i) {
                        const int l = i ^ j;
                        if (l > i) { const unsigned mx = max(c[i], c[l]), mn = min(c[i], c[l]); c[i] = mx; c[l] = mn; }
                    }
#pragma unroll
                for (int i = 0; i < 16; ++i) t[oa + i] = c[i];
            }
            if (g2 == 0) {
#pragma unroll
                for (int i = 0; i < 4; ++i) *(uint4*)(tlist + L * 16 + i * 4) = make_uint4(t[4 * i], t[4 * i + 1], t[4 * i + 2], t[4 * i + 3]);
            }
        }
        __syncthreads();
        if (tid < 128) {
            float v0[16], v1[16];
#pragma unroll
            for (int i = 0; i < 16; ++i) { v0[i] = unmono_u32(tlist[tid * 16 + i] & ~127u); v1[i] = unmono_u32(tlist[(128 + tid) * 16 + i] & ~127u); }
            unsigned cd[16];
#pragma unroll
            for (int i = 0; i < 16; ++i) cd[i] = 0u;
#pragma unroll
            for (int i = 0; i < 16; ++i) {
#pragma unroll
                for (int j = 0; j < 16; ++j) {
                    if ((i + 1) * (j + 1) <= 16) {
                        unsigned x = (mono_u32(v0[i] + v1[j]) & ~255u) | (unsigned)(255 - (i * 16 + j));
#pragma unroll
                        for (int q = (i + 1) * (j + 1) - 1; q < 16; ++q) { const unsigned mx = max(cd[q], x); x = min(cd[q], x); cd[q] = mx; }
                    }
                }
            }
            float sv[16]; int ex[16];
#pragma unroll
            for (int q = 0; q < 16; ++q) {
                const int slot = 255 - (int)(cd[q] & 255u);
                const unsigned a = tlist[tid * 16 + (slot >> 4)], b2 = tlist[(128 + tid) * 16 + (slot & 15)];
                sv[q] = unmono_u32(a & ~127u) + unmono_u32(b2 & ~127u);
                ex[q] = (127 - (int)(a & 127u)) * 128 + (127 - (int)(b2 & 127u));
            }
            float mx = sv[0];
#pragma unroll
            for (int q = 1; q < 16; ++q) mx = fmaxf(mx, sv[q]);
            float den = 0.f;
#pragma unroll
            for (int q = 0; q < 16; ++q) { sv[q] = __expf(sv[q] - mx); den += sv[q]; }
            const float rden = 1.0f / den;
            const size_t base = ((size_t)head * NT + (m0 + tid)) * 16;
#pragma unroll
            for (int i = 0; i < 4; ++i) {
                *(int4*)(pl_idx + base + i * 4) = make_int4(ex[4 * i], ex[4 * i + 1], ex[4 * i + 2], ex[4 * i + 3]);
                *(float4*)(pl_gate + base + i * 4) = make_float4(sv[4 * i] * rden, sv[4 * i + 1] * rden, sv[4 * i + 2] * rden, sv[4 * i + 3] * rden);
            }
        }
        __syncthreads();
    }
}

typedef float f32x2 __attribute__((ext_vector_type(2)));
typedef unsigned int u32x4 __attribute__((ext_vector_type(4)));
typedef unsigned int u32x2 __attribute__((ext_vector_type(2)));
#define PS_LOAD(buf, ee, h) { _Pragma("unroll") for (int e = 0; e < 8; ++e) { \
        const u32x4 t4 = __builtin_amdgcn_raw_buffer_load_b128(rs, ((unsigned)ee[(h) * 8 + e] << 7) + ch16, 0, 0); buf[e] = make_uint4(t4.x, t4.y, t4.z, t4.w); } }
#define PS_IDX(ee, Rr) { _Pragma("unroll") for (int i = 0; i < 4; ++i) { const int4 t = *(const int4*)(pl_idx + ((size_t)sub * NT + (Rr)) * 16 + 4 * i); \
        ee[4 * i] = t.x; ee[4 * i + 1] = t.y; ee[4 * i + 2] = t.z; ee[4 * i + 3] = t.w; } }
DEV long pk64(unsigned lo, unsigned hi) { return (long)(((unsigned long long)hi << 32) | (unsigned long long)lo); }
DEV void phase_peer_u(const Params& p, unsigned char* lds, int layer) {
    const int tid = tid_opaque(), lane = tid & 63, wv = tid >> 6, sub = lane >> 3, ch = lane & 7, fm = lane & 15, fg = lane >> 4;
    const int ng = gridDim.x >> 3, x = blockIdx.x & 7, wq = blockIdx.x >> 3;
    if (wq < ng) {
        const int gw = __builtin_amdgcn_readfirstlane(wq * 8 + wv), nw = ng * 8;
        unsigned char* ws = p.ws;
        const unsigned char* tab = ws + WS_PU + ((size_t)layer * 8 + x) * (16384 * 128);
        const int* pl_idx = (const int*)(ws + WS_S + 3 * U_BYTES);
        const unsigned char* xq = ws + WS_S + 2 * U_BYTES + (size_t)(fm & 1) * 1024 + 128 * x + 16 * fg;
        bf16_t* pd = (bf16_t*)(ws + WS_S + 5 * U_BYTES) + (size_t)x * NT * 128 + 16 * (fm >> 1) + 4 * fg;
        unsigned char* tile = lds + wv * 16384;
        const unsigned cE16 = 16u * (unsigned)(ch ^ (sub >> 1)), cO16 = cE16 ^ 64u;
        const unsigned aoff0 = (unsigned)fm * 128u + (unsigned)((fg ^ (fm >> 1)) << 4), aoff1 = (unsigned)fm * 128u + (unsigned)(((4 + fg) ^ (fm >> 1)) << 4);
        const int nrows = layer ? NL : NT;
        int eN[16];
#define PU_DMA(ee, q) { _Pragma("unroll") for (int j = 0; j < 4; ++j) { const int jj = (q) * 4 + j; \
        __builtin_amdgcn_global_load_lds((const unsigned*)(tab + (((unsigned)ee[jj] << 7) + ((jj & 1) ? cO16 : cE16))), (unsigned*)(tile + jj * 1024 + lane * 16), 16, 0, 0); } }
        const unsigned ta0 = (unsigned)(size_t)((LAS3 unsigned char*)tile) + aoff0, ta1 = (unsigned)(size_t)((LAS3 unsigned char*)tile) + aoff1;
#define PU_MMA(q) { u32x4 a0, a1, a2, a3; \
        asm volatile("ds_read_b128 %0, %4 offset:%6\n\tds_read_b128 %1, %5 offset:%6\n\tds_read_b128 %2, %4 offset:%7\n\tds_read_b128 %3, %5 offset:%7\n\ts_waitcnt lgkmcnt(0)" \
            : "=&v"(a0), "=&v"(a1), "=&v"(a2), "=&v"(a3) : "v"(ta0), "v"(ta1), "n"((q) * 4096), "n"((q) * 4096 + 2048) : "memory"); \
        f32x4 c4 = {0.f, 0.f, 0.f, 0.f}, c5 = {0.f, 0.f, 0.f, 0.f}; \
        c4 = __builtin_amdgcn_mfma_f32_16x16x32_fp8_fp8(pk64(a0.x, a0.y), pk64(bC0.x, bC0.y), c4, 0, 0, 0); \
        c5 = __builtin_amdgcn_mfma_f32_16x16x32_fp8_fp8(pk64(a2.x, a2.y), pk64(bC0.x, bC0.y), c5, 0, 0, 0); \
        c4 = __builtin_amdgcn_mfma_f32_16x16x32_fp8_fp8(pk64(a0.z, a0.w), pk64(bC0.z, bC0.w), c4, 0, 0, 0); \
        c5 = __builtin_amdgcn_mfma_f32_16x16x32_fp8_fp8(pk64(a2.z, a2.w), pk64(bC0.z, bC0.w), c5, 0, 0, 0); \
        c4 = __builtin_amdgcn_mfma_f32_16x16x32_fp8_fp8(pk64(a1.x, a1.y), pk64(bC1.x, bC1.y), c4, 0, 0, 0); \
        c5 = __builtin_amdgcn_mfma_f32_16x16x32_fp8_fp8(pk64(a3.x, a3.y), pk64(bC1.x, bC1.y), c5, 0, 0, 0); \
        c4 = __builtin_amdgcn_mfma_f32_16x16x32_fp8_fp8(pk64(a1.z, a1.w), pk64(bC1.z, bC1.w), c4, 0, 0, 0); \
        c5 = __builtin_amdgcn_mfma_f32_16x16x32_fp8_fp8(pk64(a3.z, a3.w), pk64(bC1.z, bC1.w), c5, 0, 0, 0); \
        acc[(q) * 2] = c4; acc[(q) * 2 + 1] = c5; }
        int R = gw;
#pragma unroll
        for (int i = 0; i < 16; ++i) eN[i] = 0;
        uint4 bC0 = make_uint4(0, 0, 0, 0), bC1 = bC0;
        if (R < nrows) {
            PS_IDX(eN, R);
            PU_DMA(eN, 0); PU_DMA(eN, 1); PU_DMA(eN, 2); PU_DMA(eN, 3);
            bC0 = *(const uint4*)(xq + (size_t)R * 2048); bC1 = *(const uint4*)(xq + (size_t)R * 2048 + 64);
            const int R1 = min(R + nw, nrows - 1);
            PS_IDX(eN, R1);
            asm volatile("s_waitcnt vmcnt(0)" : "+v"(bC0.x), "+v"(bC1.x), "+v"(eN[0]), "+v"(eN[4]), "+v"(eN[8]), "+v"(eN[12]) :: "memory");
        }
        for (; R < nrows; R += nw) {
            const int Rn = R + nw, R1 = min(Rn, nrows - 1), R2 = min(Rn + nw, nrows - 1);
            const bool more = Rn < nrows;
            u32x4 i0, i1, i2, i3, nb0, nb1;
            {
                const int* iptr = pl_idx + ((size_t)sub * NT + R2) * 16;
                const unsigned char* xptr = xq + (size_t)R1 * 2048;
                asm volatile("global_load_dwordx4 %0, %6, off\n\tglobal_load_dwordx4 %1, %6, off offset:16\n\tglobal_load_dwordx4 %2, %6, off offset:32\n\tglobal_load_dwordx4 %3, %6, off offset:48\n\t"
                             "global_load_dwordx4 %4, %7, off\n\tglobal_load_dwordx4 %5, %7, off offset:64"
                             : "=&v"(i0), "=&v"(i1), "=&v"(i2), "=&v"(i3), "=&v"(nb0), "=&v"(nb1) : "v"(iptr), "v"(xptr) : "memory");
            }
            f32x4 acc[8];
#define PU_STEP(q) { if (more) asm volatile("s_waitcnt vmcnt(19)" ::: "memory"); else asm volatile("s_waitcnt vmcnt(0)" ::: "memory"); \
            PU_MMA(q); if (more) { PU_DMA(eN, q); } }
            PU_STEP(0); PU_STEP(1); PU_STEP(2); PU_STEP(3);
            f32x4 s0[4], s1[2], s2;
#pragma unroll
            for (int i = 0; i < 4; ++i)
#pragma unroll
                for (int r = 0; r < 4; ++r) s0[i][r] = (fm & 2) ? acc[2 * i + 1][r] : acc[2 * i][r];
#pragma unroll
            for (int i = 0; i < 2; ++i)
#pragma unroll
                for (int r = 0; r < 4; ++r) s1[i][r] = (fm & 4) ? s0[2 * i + 1][r] : s0[2 * i][r];
#pragma unroll
            for (int r = 0; r < 4; ++r) { const float t = (fm & 8) ? s1[1][r] : s1[0][r]; s2[r] = t + dpp_quad<0xB1>(t); }
            if (!(fm & 1)) *(uint2*)(pd + (size_t)R * 128) = make_uint2(pk_bf16(s2[0], s2[1]), pk_bf16(s2[2], s2[3]));
            if (more) asm volatile("s_waitcnt vmcnt(17)" : "+v"(i0), "+v"(i1), "+v"(i2), "+v"(i3), "+v"(nb0), "+v"(nb1) :: "memory");
            else asm volatile("s_waitcnt vmcnt(0)" : "+v"(i0), "+v"(i1), "+v"(i2), "+v"(i3), "+v"(nb0), "+v"(nb1) :: "memory");
            eN[0] = i0.x; eN[1] = i0.y; eN[2] = i0.z; eN[3] = i0.w; eN[4] = i1.x; eN[5] = i1.y; eN[6] = i1.z; eN[7] = i1.w;
            eN[8] = i2.x; eN[9] = i2.y; eN[10] = i2.z; eN[11] = i2.w; eN[12] = i3.x; eN[13] = i3.y; eN[14] = i3.z; eN[15] = i3.w;
            bC0 = make_uint4(nb0.x, nb0.y, nb0.z, nb0.w); bC1 = make_uint4(nb1.x, nb1.y, nb1.z, nb1.w);
        }
        asm volatile("s_waitcnt vmcnt(0)" ::: "memory");
    }
}
DEV void phase_peer_c(const Params& p, int layer) {
    const int tid = tid_opaque(), lane = tid & 63;
    const int gw = blockIdx.x * 8 + (tid >> 6), nw = gridDim.x * 8;
    unsigned char* ws = p.ws;
    const float* usc = (const float*)(ws + WS_PSC) + layer * 16384;
    const float* vsc = (const float*)(ws + WS_PSC) + 32768 + layer * 16384;
    const int* pl_idx = (const int*)(ws + WS_S + 3 * U_BYTES);
    const float* pl_gate = (const float*)(ws + WS_S + 3 * U_BYTES + (size_t)NT * 128 * 4);
    float* pd = (float*)(ws + WS_S + 4 * U_BYTES);
    const bf16_t* pdh = (const bf16_t*)(ws + WS_S + 5 * U_BYTES);
    const int nrows = layer ? NL : NT;
    const int head0 = 2 * (lane & 3), kk = lane >> 2;
    for (int R = gw; R < nrows; R += nw) {
        float d0 = 0.f, d1 = 0.f;
#pragma unroll
        for (int xx = 0; xx < 8; ++xx) { const unsigned t = *(const unsigned*)(pdh + ((size_t)xx * NT + R) * 128 + 2 * lane); d0 += bf_lo(t); d1 += bf_hi(t); }
        const size_t po = ((size_t)head0 * NT + R) * 16 + kk;
        const int e0 = pl_idx[po], e1 = pl_idx[po + (size_t)NT * 16];
        const float g0 = pl_gate[po], g1 = pl_gate[po + (size_t)NT * 16];
        d0 *= usc[e0] * 0.25f; d1 *= usc[e1] * 0.25f;
        const float c0 = g0 * vsc[e0] * 0.5f * d0 * (1.0f + erff(d0 * 0.70710678118f));
        const float c1 = g1 * vsc[e1] * 0.5f * d1 * (1.0f + erff(d1 * 0.70710678118f));
        pd[(size_t)R * 128 + 16 * head0 + kk] = c0;
        pd[(size_t)R * 128 + 16 * head0 + 16 + kk] = c1;
    }
}
DEV void phase_peer_v(const Params& p, int layer) {
    const int tid = tid_opaque(), lane = tid & 63, sub = lane >> 3, ch = lane & 7;
    const int ng = gridDim.x >> 3, x = blockIdx.x & 7, wq = blockIdx.x >> 3;
    if (wq < ng) {
        const int gw = __builtin_amdgcn_readfirstlane(wq * 8 + (tid >> 6)), nw = ng * 8;
        unsigned char* ws = p.ws;
        const __amdgpu_buffer_rsrc_t rs = __builtin_amdgcn_make_buffer_rsrc((void*)(ws + WS_PV + ((size_t)layer * 8 + x) * (16384 * 128)), 0, 16384 * 128, 0x00020000);
        const int* pl_idx = (const int*)(ws + WS_S + 3 * U_BYTES);
        const float* cb = (const float*)(ws + WS_S + 4 * U_BYTES) + 16 * sub;
        bf16_t* xs_lat = (bf16_t*)p.out; bf16_t* xs_ctx = (bf16_t*)(ws + WS_CTXR);
        float* xf = (float*)(ws + WS_S + 1 * U_BYTES);
        const float* mods = (const float*)(ws + WS_MOD) + (size_t)layer * 9 * 6144 + 5 * 1024;
        const unsigned ch16 = 16u * (unsigned)ch;
        const int col = 128 * x + 16 * ch + 2 * sub;
        const int nrows = layer ? NL : NT;
        uint4 bufA[8], bufB[8];
        int eC[16], eN[16];
        float cC[16], cN[16];
#define PS_CF(cc, Rr) { _Pragma("unroll") for (int i = 0; i < 4; ++i) { const float4 t = *(const float4*)(cb + (size_t)(Rr) * 128 + 4 * i); \
        cc[4 * i] = t.x; cc[4 * i + 1] = t.y; cc[4 * i + 2] = t.z; cc[4 * i + 3] = t.w; } }
#define PV_FMA(accv, av) asm("v_fma_f32 %0, %1, %2, %0" : "+v"(accv) : "v"(cf), "v"(av))
#define PV_AXPY(buf, h) { _Pragma("unroll") for (int e = 0; e < 8; ++e) { \
        const float cf = cC[(h) * 8 + e]; const unsigned vw[4] = {buf[e].x, buf[e].y, buf[e].z, buf[e].w}; \
        _Pragma("unroll") for (int i = 0; i < 4; ++i) { \
            const f32x2 a = __builtin_amdgcn_cvt_pk_f32_fp8((int)vw[i], false), b2 = __builtin_amdgcn_cvt_pk_f32_fp8((int)vw[i], true); \
            PV_FMA(a16[4 * i], a.x); PV_FMA(a16[4 * i + 1], a.y); PV_FMA(a16[4 * i + 2], b2.x); PV_FMA(a16[4 * i + 3], b2.y); } } }
        int R = gw;
#pragma unroll
        for (int i = 0; i < 16; ++i) { eC[i] = 0; eN[i] = 0; cC[i] = 0.f; cN[i] = 0.f; }
        if (R < nrows) { PS_IDX(eC, R); PS_CF(cC, R); PS_LOAD(bufA, eC, 0); }
        for (; R < nrows; R += nw) {
            const int Rn = R + nw;
            if (Rn < nrows) { PS_IDX(eN, Rn); PS_CF(cN, Rn); }
            PS_LOAD(bufB, eC, 1);
            bf16_t* xrow = (R < NL ? xs_lat + (size_t)R * 1024 : xs_ctx + (size_t)(R - NL) * 1024) + col;
            const unsigned xaw = *(const unsigned*)xrow;
            const float2 xa = make_float2(bf_lo(xaw), bf_hi(xaw)), ga = *(const float2*)(mods + (size_t)mod_batch(R) * 6144 + col);
            float a16[16];
#pragma unroll
            for (int i = 0; i < 16; ++i) a16[i] = 0.f;
            PV_AXPY(bufA, 0);
            if (Rn < nrows) { PS_LOAD(bufA, eN, 0); }
            PV_AXPY(bufB, 1);
            float s8[8], t4[4];
#pragma unroll
            for (int j = 0; j < 8; ++j) { const u32x2 r = __builtin_amdgcn_permlane32_swap(__float_as_uint(a16[j]), __float_as_uint(a16[8 + j]), false, false); s8[j] = __uint_as_float(r.x) + __uint_as_float(r.y); }
#pragma unroll
            for (int j = 0; j < 4; ++j) { const u32x2 r = __builtin_amdgcn_permlane16_swap(__float_as_uint(s8[j]), __float_as_uint(s8[4 + j]), false, false); t4[j] = __uint_as_float(r.x) + __uint_as_float(r.y); }
            const float wa0 = t4[0] + dpp_ror<8>(t4[0]), wa1 = t4[1] + dpp_ror<8>(t4[1]), wb0 = t4[2] + dpp_ror<8>(t4[2]), wb1 = t4[3] + dpp_ror<8>(t4[3]);
            const float w0 = (lane & 8) ? wb0 : wa0, w1 = (lane & 8) ? wb1 : wa1;
            if (layer) *(float2*)(xf + (size_t)R * 1024 + col) = make_float2(xa.x + ga.x * w0, xa.y + ga.y * w1);
            else *(unsigned*)xrow = pk_bf16(xa.x + ga.x * w0, xa.y + ga.y * w1);
#pragma unroll
            for (int i = 0; i < 16; ++i) { eC[i] = eN[i]; cC[i] = cN[i]; }
        }
    }
}
DEV void phase_final_norm(const Params& p) {
    const int tid = tid_opaque(), lane = tid & 63;
    const int gw = blockIdx.x * 8 + (tid >> 6), nw = gridDim.x * 8;
    const float* gn = p.in[34];
    for (int R = gw; R < NL; R += nw) {
        const float* xsrc = (const float*)(p.ws + WS_S + 1 * U_BYTES) + (size_t)R * 1024;
        float* xr = p.out + (size_t)R * 1024;
        float4 v[4]; float ss = 0.f;
#pragma unroll
        for (int i = 0; i < 4; ++i) { v[i] = *(const float4*)(xsrc + i * 256 + lane * 4); ss += v[i].x * v[i].x + v[i].y * v[i].y + v[i].z * v[i].z + v[i].w * v[i].w; }
        ss = wave_allreduce(ss);
        const float rs = rsqrtf(ss * (1.0f / 1024.0f) + 1e-6f);
#pragma unroll
        for (int i = 0; i < 4; ++i) {
            const float4 gg = *(const float4*)(gn + i * 256 + lane * 4);
            *(float4*)(xr + i * 256 + lane * 4) = make_float4(v[i].x * rs * gg.x, v[i].y * rs * gg.y, v[i].z * rs * gg.z, v[i].w * rs * gg.w);
        }
    }
}

DEV void phase_gla_proj(const Params& p, unsigned char* lds) {
    unsigned char* ws = p.ws;
    const bf16_t* h = (const bf16_t*)(ws + WS_S + 0 * U_BYTES);
    const bf16_t* wint = (const bf16_t*)(ws + WS_WIN);
    {
        pg8::Gemm g{h, wint, NT, 3072, 1024};
        pg8::StaticOrder so; so.init(NT, 3072, gridDim.x, blockIdx.x);
        pg8::EpiBf16Tiles ep{(bf16_t*)(ws + WS_S + 1 * U_BYTES), 2048, 8, (bf16_t*)(ws + WS_S + 3 * U_BYTES), 1024};
        pg8::gemm_phase(( PG8_LAS unsigned char*)lds, g, so, ep, nullptr);
    }
    __syncthreads();
    for (int u = blockIdx.x; u < NT / 128; u += gridDim.x) {
        ALoadPlain al{h, 1024};
        EpiLr ep{(float*)(ws + WS_LR)};
        gemm_unit<128>(lds, al, wint + (size_t)3072 * 1024, 1024, u * 128, ep);
    }
}

DEV void conv_emit(const float (&acc)[8], int c, bf16_t* dst) {
    const float qs = (c < 512) ? 0.08838834764831845f : 1.0f;
    unsigned ow[4];
#pragma unroll
    for (int j = 0; j < 4; ++j) { const float a0 = acc[2 * j], a1 = acc[2 * j + 1]; ow[j] = pk_bf16(a0 * sigmoidf_(a0) * qs, a1 * sigmoidf_(a1) * qs); }
    *(uint4*)dst = make_uint4(ow[0], ow[1], ow[2], ow[3]);
}
DEV void conv_tap(float (&acc)[8], const uint4& v, const float (&w)[8]) {
    acc[0] += bf_lo(v.x) * w[0]; acc[1] += bf_hi(v.x) * w[1]; acc[2] += bf_lo(v.y) * w[2]; acc[3] += bf_hi(v.y) * w[3];
    acc[4] += bf_lo(v.z) * w[4]; acc[5] += bf_hi(v.z) * w[5]; acc[6] += bf_lo(v.w) * w[6]; acc[7] += bf_hi(v.w) * w[7];
}
DEV void phase_gla_conv(const Params& p) {
    const int tid = tid_opaque();
    unsigned char* ws = p.ws;
    const bf16_t* z = (const bf16_t*)(ws + WS_S + 1 * U_BYTES);
    bf16_t* o = (bf16_t*)(ws + WS_S + 4 * U_BYTES);
    const float* cw = p.in[25];
    const int x = tid >> 3, cl = (tid & 7) * 8;
    for (int task = blockIdx.x; task < 8 * 32; task += gridDim.x) {
        const int cb = task & 31, b = task >> 5;
        const int c = cb * 64 + cl;
        float w[9][8];
#pragma unroll
        for (int t = 0; t < 9; ++t) { const float4 w0 = *(const float4*)(cw + t * 2048 + c), w1 = *(const float4*)(cw + t * 2048 + c + 4); w[t][0] = w0.x; w[t][1] = w0.y; w[t][2] = w0.z; w[t][3] = w0.w; w[t][4] = w1.x; w[t][5] = w1.y; w[t][6] = w1.z; w[t][7] = w1.w; }
        const uint4 zero4 = make_uint4(0, 0, 0, 0);
        auto load_row = [&](int y, uint4 (&r)[3]) {
            if (y < 0 || y >= 128) { r[0] = zero4; r[1] = zero4; r[2] = zero4; return; }
            const bf16_t* row = z + ((size_t)b * 8192 + (size_t)y * 64 + x) * 2048 + c;
            r[1] = *(const uint4*)row;
            r[0] = (x > 0) ? *(const uint4*)(row - 2048) : zero4;
            r[2] = (x < 63) ? *(const uint4*)(row + 2048) : zero4;
        };
        uint4 rr[8][3];
        load_row(-1, rr[7]);
#pragma unroll
        for (int s = 0; s < 6; ++s) load_row(s, rr[s]);
#pragma unroll 1
        for (int yb = 0; yb < 128; yb += 8) {
#pragma unroll
            for (int s = 0; s < 8; ++s) {
                const int y = yb + s;
                load_row(y + 6, rr[(s + 6) & 7]);
                float acc[8];
#pragma unroll
                for (int j = 0; j < 8; ++j) acc[j] = 0.f;
#pragma unroll
                for (int dx = 0; dx < 3; ++dx) { conv_tap(acc, rr[(s + 7) & 7][dx], w[dx]); conv_tap(acc, rr[s][dx], w[3 + dx]); conv_tap(acc, rr[(s + 1) & 7][dx], w[6 + dx]); }
                conv_emit(acc, c, o + ((size_t)b * 8192 + (size_t)y * 64 + x) * 2048 + c);
            }
        }
    }
    for (int task = blockIdx.x; task < (NC / 64) * 8; task += gridDim.x) {
        const int rb = task >> 3, cbk = task & 7;
        const int R = NL + rb * 64 + (tid >> 3);
        const int t = (R - NL) & 255;
#pragma unroll 1
        for (int i = 0; i < 4; ++i) {
            const int c = cbk * 256 + (tid & 7) * 8 + i * 64;
            float acc[8];
#pragma unroll
            for (int j = 0; j < 8; ++j) acc[j] = 0.f;
#pragma unroll
            for (int dx = -1; dx <= 1; ++dx) {
                if (t + dx >= 0 && t + dx < 256) {
                    const uint4 v = *(const uint4*)(z + (size_t)(R + dx) * 2048 + c);
                    const float* wp = cw + (3 + (dx + 1)) * 2048 + c;
                    const float4 w0 = *(const float4*)wp, w1 = *(const float4*)(wp + 4);
                    const float wv[8] = {w0.x, w0.y, w0.z, w0.w, w1.x, w1.y, w1.z, w1.w};
                    conv_tap(acc, v, wv);
                }
            }
            conv_emit(acc, c, o + (size_t)R * 2048 + c);
        }
    }
}

constexpr int GT_QE = 0, GT_KET = 16384, GT_A = 32768, GT_CONST = 40960, GT_STRIDE = 43008;
constexpr int GT_N0 = (int)((2 * U_BYTES) / GT_STRIDE);
constexpr size_t WS_TOTAL = 1073741824ull;
static_assert((size_t)(NB * 4 * 2 * 132 - GT_N0) * GT_STRIDE <= WS_TOTAL - WS_END, "tile records do not fit");
DEV size_t gla_tile_off(int b, int hd, int d, int cc) {
    const int idx = (((b * 4 + hd) * 2 + d) * 132) + cc;
    return idx < GT_N0 ? WS_S + (size_t)idx * GT_STRIDE : WS_END + (size_t)(idx - GT_N0) * GT_STRIDE;
}
DEV int gla_row0(int b, int cc) { return cc < 4 ? NL + b * 256 + cc * 64 : b * 8192 + (cc - 4) * 64; }
DEV void phase_gla_prep(const Params& p, unsigned char* lds) {
    const int tid = tid_opaque(), lane = tid & 63, wv = tid >> 6;
    const int fr = lane & 15, fq = lane >> 4;
    unsigned char* ws = p.ws;
    constexpr int QE = 0, KE = 16384, KET = 32768, BC = 49152  , GS = 82944  , LRL = 86528  , BCS = 132;
    const bf16_t* qkv = (const bf16_t*)(ws + WS_S + 4 * U_BYTES);
    const float* lrb = (const float*)(ws + WS_LR);
    unsigned char* gt = ws;
    float* bc = (float*)(lds + BC);
    float* gs = (float*)(lds + GS);
    const int li = tid >> 3, lc = tid & 7;
    const int d = blockIdx.x & 1, hd = (blockIdx.x >> 1) & 3;
    bf16x8 gkf;
    {
        unsigned w4[4] = {0u, 0u, 0u, 0u};
        if (fq < 2) {
#pragma unroll
            for (int e2 = 0; e2 < 4; ++e2) {
                const float g0 = p.in[26][(size_t)(d * 16 + 8 * fq + 2 * e2) * 512 + hd * 128 + wv * 16 + fr];
                const float g1 = p.in[26][(size_t)(d * 16 + 8 * fq + 2 * e2 + 1) * 512 + hd * 128 + wv * 16 + fr];
                w4[e2] = pk_bf16(g0, g1);
            }
        }
        gkf = as_bf16x8(make_uint4(w4[0], w4[1], w4[2], w4[3]));
    }
    const float4 gb4 = *(const float4*)(p.in[27] + d * 512 + hd * 128 + wv * 16 + 4 * fq);
    const int qstep = (int)(gridDim.x >> 3);
    uint4 nq0, nq1, nk0, nk1; float2 nl;
    auto fetch = [&](int q) {
        const size_t R = (size_t)(gla_row0(q / 132, q % 132) + li);
        const bf16_t* row = qkv + R * 2048;
        nq0 = *(const uint4*)(row + hd * 128 + lc * 8); nq1 = *(const uint4*)(row + hd * 128 + 64 + lc * 8);
        nk0 = *(const uint4*)(row + 512 + hd * 128 + lc * 8); nk1 = *(const uint4*)(row + 512 + hd * 128 + 64 + lc * 8);
        nl = *(const float2*)(lrb + R * 32 + d * 16 + lc * 2);
    };
    int q = (int)(blockIdx.x >> 3);
    if (q < NB * 132) fetch(q);
    for (; q < NB * 132; q += qstep) {
        const int cc = q % 132, b = q / 132;
        unsigned char* rec = gt + gla_tile_off(b, hd, d, cc);
        const uint4 rq0 = nq0, rq1 = nq1, rk0 = nk0, rk1 = nk1; const float2 rl = nl;
        if (q + qstep < NB * 132) fetch(q + qstep);
        *(unsigned*)(lds + LRL + li * 32 + lc * 4) = pk_bf16(rl.x, rl.y);
        __syncthreads();
        {
            const float gbv[4] = {gb4.x, gb4.y, gb4.z, gb4.w};
#pragma unroll
            for (int itl = 0; itl < 4; ++itl) {
                uint4 lr4 = *(const uint4*)(lds + LRL + (itl * 16 + fr) * 32 + (fq & 1) * 16);
                if (fq >= 2) lr4 = make_uint4(0, 0, 0, 0);
                f32x4 a = {0.f, 0.f, 0.f, 0.f};
                a = __builtin_amdgcn_mfma_f32_16x16x32_bf16(gkf, as_bf16x8(lr4), a, 0, 0, 0);
                float s[4], tot[4];
#pragma unroll
                for (int j = 0; j < 4; ++j) {
                    const float xx = a[j] + gbv[j];
                    const float la = (fminf(xx, 0.f) - __logf(1.0f + __expf(-fabsf(xx)))) * (1.0f / 16.0f);
                    float pf = la;
                    pf += dpp_shr0<1>(pf); pf += dpp_shr0<2>(pf); pf += dpp_shr0<4>(pf); pf += dpp_shr0<8>(pf);
                    tot[j] = __shfl(pf, (lane & 48) | 15);
                    s[j] = d ? (tot[j] - pf + la) : pf;
                }
                *(float4*)(bc + (itl * 16 + fr) * BCS + wv * 16 + 4 * fq) = make_float4(s[0], s[1], s[2], s[3]);
                if (fr == 15) *(float4*)(gs + itl * 128 + wv * 16 + 4 * fq) = make_float4(tot[0], tot[1], tot[2], tot[3]);
            }
        }
        __syncthreads();
        if (tid < 128) {
            const float g0 = gs[tid], g1 = gs[128 + tid], g2 = gs[256 + tid], g3 = gs[384 + tid];
            const float refc = d ? (bc[31 * BCS + tid] + g2 + g3) : (bc[32 * BCS + tid] + g0 + g1), lastc = g0 + g1 + g2 + g3;
            const float dl = __expf(lastc), er = __expf(refc), el = __expf(lastc - refc);
            gs[512 + tid] = refc;
            float* cst = (float*)(rec + GT_CONST);
            cst[tid] = er; cst[128 + tid] = el; cst[256 + tid] = dl;
        }
        __syncthreads();
        {
            const int grp = li >> 4;
            const uint4 rqs[2] = {rq0, rq1}, rks[2] = {rk0, rk1};
#pragma unroll
            for (int hseg = 0; hseg < 2; ++hseg) {
                const int k0 = hseg * 64 + lc * 8;
                float bcv[8], refv[8];
#pragma unroll
                for (int j4 = 0; j4 < 2; ++j4) {
                    const float4 g0 = *(const float4*)(gs + k0 + j4 * 4), g1 = *(const float4*)(gs + 128 + k0 + j4 * 4);
                    const float4 g2 = *(const float4*)(gs + 256 + k0 + j4 * 4), g3 = *(const float4*)(gs + 384 + k0 + j4 * 4);
                    const float4 bi = *(const float4*)(bc + li * BCS + k0 + j4 * 4), rf = *(const float4*)(gs + 512 + k0 + j4 * 4);
                    const float g0a[4] = {g0.x, g0.y, g0.z, g0.w}, g1a[4] = {g1.x, g1.y, g1.z, g1.w}, g2a[4] = {g2.x, g2.y, g2.z, g2.w}, g3a[4] = {g3.x, g3.y, g3.z, g3.w};
                    const float bia[4] = {bi.x, bi.y, bi.z, bi.w}, rfa[4] = {rf.x, rf.y, rf.z, rf.w};
#pragma unroll
                    for (int j = 0; j < 4; ++j) {
                        const float pre = d ? ((grp < 1 ? g1a[j] : 0.f) + (grp < 2 ? g2a[j] : 0.f) + (grp < 3 ? g3a[j] : 0.f))
                                            : ((grp > 0 ? g0a[j] : 0.f) + (grp > 1 ? g1a[j] : 0.f) + (grp > 2 ? g2a[j] : 0.f));
                        bcv[j4 * 4 + j] = bia[j] + pre;
                        refv[j4 * 4 + j] = rfa[j];
                    }
                }
                const unsigned qw[4] = {rqs[hseg].x, rqs[hseg].y, rqs[hseg].z, rqs[hseg].w}, kw[4] = {rks[hseg].x, rks[hseg].y, rks[hseg].z, rks[hseg].w};
                unsigned oqe[4], oke[4];
#pragma unroll
                for (int j2 = 0; j2 < 4; ++j2) {
                    const float q0 = bf_lo(qw[j2]), q1 = bf_hi(qw[j2]), kk0 = bf_lo(kw[j2]), kk1 = bf_hi(kw[j2]);
                    const float e0 = __expf(bcv[2 * j2] - refv[2 * j2]), e1 = __expf(bcv[2 * j2 + 1] - refv[2 * j2 + 1]);
                    const float r0 = __builtin_amdgcn_rcpf(e0), r1 = __builtin_amdgcn_rcpf(e1);
                    oqe[j2] = pk_bf16(q0 * e0, q1 * e1);
                    oke[j2] = pk_bf16(kk0 * r0, kk1 * r1);
                    const int kc0 = k0 + 2 * j2;
                    *(bf16_t*)(lds + KET + tile_off2(kc0, li >> 3) + (li & 7) * 2) = (bf16_t)(oke[j2] & 0xffffu);
                    *(bf16_t*)(lds + KET + tile_off2(kc0 + 1, li >> 3) + (li & 7) * 2) = (bf16_t)(oke[j2] >> 16);
                }
                const int chq = hseg * 8 + lc;
                const int so = li * 256 + ((chq ^ (li & 15)) << 4);
                *(uint4*)(lds + QE + so) = make_uint4(oqe[0], oqe[1], oqe[2], oqe[3]);
                *(uint4*)(lds + KE + so) = make_uint4(oke[0], oke[1], oke[2], oke[3]);
                *(uint4*)(rec + GT_QE + so) = make_uint4(oqe[0], oqe[1], oqe[2], oqe[3]);
            }
        }
        __syncthreads();
        {
            const int it = wv & 3, pr2 = wv >> 2;
#pragma unroll
            for (int jj = 0; jj < 2; ++jj) {
                const int jt = pr2 * 2 + jj;
                f32x4 a = {0.f, 0.f, 0.f, 0.f};
                if (d ? (jt >= it) : (jt <= it)) {
#pragma unroll
                    for (int ks = 0; ks < 4; ++ks) {
                        const int ch = ks * 4 + fq;
                        const int rj = jt * 16 + fr, ri = it * 16 + fr;
                        const bf16x8 fa = *(const bf16x8*)(lds + KE + rj * 256 + ((ch ^ (rj & 15)) << 4));
                        const bf16x8 fb = *(const bf16x8*)(lds + QE + ri * 256 + ((ch ^ (ri & 15)) << 4));
                        a = __builtin_amdgcn_mfma_f32_16x16x32_bf16(fa, fb, a, 0, 0, 0);
                    }
                }
                const int i = it * 16 + fr, j = jt * 16 + 4 * fq;
                float av[4];
#pragma unroll
                for (int e = 0; e < 4; ++e) av[e] = (d ? (j + e >= i) : (j + e <= i)) ? a[e] : 0.f;
                *(uint2*)(rec + GT_A + i * 128 + (((j >> 3) ^ (i & 7)) << 4) + (j & 7) * 2) = make_uint2(pk_bf16(av[0], av[1]), pk_bf16(av[2], av[3]));
            }
#pragma unroll
            for (int i = 0; i < 2; ++i) *(uint4*)(rec + GT_KET + i * 8192 + tid * 16) = *(const uint4*)(lds + KET + i * 8192 + tid * 16);
        }
        __syncthreads();
    }
}

DEV void phase_gla_scan(const Params& p, unsigned char* lds) {
    const int tid = tid_opaque(), lane = tid & 63, wv = tid >> 6;
    const int fr = lane & 15, fq = lane >> 4;
    unsigned char* ws = p.ws;
    constexpr int QE = 0  , KET = 32768  , AL = 65536  , VT = 81920, ST = 90112  ;
    const bf16_t* qkv = (const bf16_t*)(ws + WS_S + 4 * U_BYTES);
    const unsigned char* gt = ws;
    for (int unit = blockIdx.x; unit < 256; unit += gridDim.x) {
        const int vs = unit & 3, d = (unit >> 2) & 1, hd = (unit >> 3) & 3, b = unit >> 5;
        bf16_t* odst = d ? (bf16_t*)(ws + WS_S + 2 * U_BYTES) : (bf16_t*)(ws + WS_S + 4 * U_BYTES);
        const int old_ = d ? 1024 : 2048;
        const int li = tid >> 3, lc = tid & 7;
        auto ccof = [&](int c) -> int { return d ? (c < 4 ? 3 - c : 135 - c) : c; };
        auto dma = [&](int cc, int buf) {
            const unsigned char* rec = gt + gla_tile_off(b, hd, d, cc);
#pragma unroll
            for (int i = 0; i < 2; ++i) {
                __builtin_amdgcn_global_load_lds((const unsigned*)(rec + GT_QE + i * 8192 + tid * 16), (unsigned*)(lds + QE + buf * 16384 + i * 8192 + tid * 16), 16, 0, 0);
                __builtin_amdgcn_global_load_lds((const unsigned*)(rec + GT_KET + i * 8192 + tid * 16), (unsigned*)(lds + KET + buf * 16384 + i * 8192 + tid * 16), 16, 0, 0);
            }
            __builtin_amdgcn_global_load_lds((const unsigned*)(rec + GT_A + tid * 16), (unsigned*)(lds + AL + buf * 8192 + tid * 16), 16, 0, 0);
        };
        uint4 nv; float4 n_dl, n_el, n_er;
        auto loads = [&](int c) {
            const int cc = ccof(c);
            nv = *(const uint4*)(qkv + (size_t)(gla_row0(b, cc) + li) * 2048 + 1024 + hd * 256 + vs * 64 + lc * 8);
            const float* cst = (const float*)(gt + gla_tile_off(b, hd, d, cc) + GT_CONST);
            n_el = *(const float4*)(cst + 128 + wv * 16 + 4 * fq); n_dl = *(const float4*)(cst + 256 + wv * 16 + 4 * fq);
            if (c + 1 < 132) n_er = *(const float4*)((const float*)(gt + gla_tile_off(b, hd, d, ccof(c + 1)) + GT_CONST) + wv * 16 + 4 * fq);
            else n_er = make_float4(0.f, 0.f, 0.f, 0.f);
        };
        f32x4 accS[4];
#pragma unroll
        for (int i = 0; i < 4; ++i) accS[i] = (f32x4){0.f, 0.f, 0.f, 0.f};
        for (int i = tid; i < 32768 / 16; i += NTHREADS) *(uint4*)(lds + ST + i * 16) = make_uint4(0, 0, 0, 0);
        dma(ccof(0), 0);
        loads(0);
        for (int c = 0; c < 132; ++c) {
            const int buf = c & 1, cc = ccof(c);
            const uint4 rv = nv; const float4 dl4 = n_dl, el4 = n_el, er4 = n_er;
            asm volatile("s_waitcnt vmcnt(0)" ::: "memory");
            {
                const unsigned vw[4] = {rv.x, rv.y, rv.z, rv.w};
#pragma unroll
                for (int j2 = 0; j2 < 4; ++j2) {
                    const int vc0 = lc * 8 + 2 * j2;
                    *(bf16_t*)(lds + VT + tile_off2(vc0, li >> 3) + (li & 7) * 2) = (bf16_t)(vw[j2] & 0xffffu);
                    *(bf16_t*)(lds + VT + tile_off2(vc0 + 1, li >> 3) + (li & 7) * 2) = (bf16_t)(vw[j2] >> 16);
                }
            }
            asm volatile("s_waitcnt lgkmcnt(0)" ::: "memory"); __builtin_amdgcn_s_barrier(); asm volatile("" ::: "memory");
            if (c + 1 < 132) { dma(ccof(c + 1), buf ^ 1); loads(c + 1); }
            const int it = wv & 3, pr2 = wv >> 2;
            const int r0 = gla_row0(b, cc);
#pragma unroll
            for (int vv = 0; vv < 2; ++vv) {
                const int vt = pr2 * 2 + vv;
                f32x4 a = {0.f, 0.f, 0.f, 0.f};
#pragma unroll
                for (int ks = 0; ks < 4; ++ks) {
                    const int ch = ks * 4 + fq;
                    const int rvv = vt * 16 + fr, ri = it * 16 + fr;
                    const bf16x8 fa = *(const bf16x8*)(lds + ST + buf * 16384 + rvv * 256 + ((ch ^ (rvv & 15)) << 4));
                    const bf16x8 fb = *(const bf16x8*)(lds + QE + buf * 16384 + ri * 256 + ((ch ^ (ri & 15)) << 4));
                    a = __builtin_amdgcn_mfma_f32_16x16x32_bf16(fa, fb, a, 0, 0, 0);
                }
#pragma unroll
                for (int ks = 0; ks < 2; ++ks) {
                    const int ch = ks * 4 + fq;
                    const int rvv = vt * 16 + fr, ri = it * 16 + fr;
                    const bf16x8 fa = *(const bf16x8*)(lds + VT + tile_off2(rvv, ch));
                    const bf16x8 fb = *(const bf16x8*)(lds + AL + buf * 8192 + ri * 128 + ((ch ^ (ri & 7)) << 4));
                    a = __builtin_amdgcn_mfma_f32_16x16x32_bf16(fa, fb, a, 0, 0, 0);
                }
                const int i = it * 16 + fr, vcol = vt * 16 + 4 * fq;
                *(uint2*)(odst + (size_t)(r0 + i) * old_ + hd * 256 + vs * 64 + vcol) = make_uint2(pk_bf16(a[0], a[1]), pk_bf16(a[2], a[3]));
            }
            {
                const int kt = wv;
                bf16x8 fa[2];
#pragma unroll
                for (int ks = 0; ks < 2; ++ks) fa[ks] = *(const bf16x8*)(lds + KET + buf * 16384 + tile_off2(kt * 16 + fr, ks * 4 + fq));
#pragma unroll
                for (int vt = 0; vt < 4; ++vt) {
                    f32x4 t = {0.f, 0.f, 0.f, 0.f};
#pragma unroll
                    for (int ks = 0; ks < 2; ++ks) t = __builtin_amdgcn_mfma_f32_16x16x32_bf16(fa[ks], *(const bf16x8*)(lds + VT + tile_off2(vt * 16 + fr, ks * 4 + fq)), t, 0, 0, 0);
                    f32x4 a = accS[vt];
                    a[0] = a[0] * dl4.x + t[0] * el4.x; a[1] = a[1] * dl4.y + t[1] * el4.y; a[2] = a[2] * dl4.z + t[2] * el4.z; a[3] = a[3] * dl4.w + t[3] * el4.w;
                    accS[vt] = a;
                    const int vcol = vt * 16 + fr, kcol = kt * 16 + 4 * fq;
                    *(uint2*)(lds + ST + (buf ^ 1) * 16384 + vcol * 256 + (((kcol >> 3) ^ (vcol & 15)) << 4) + (kcol & 7) * 2) =
                        make_uint2(pk_bf16(a[0] * er4.x, a[1] * er4.y), pk_bf16(a[2] * er4.z, a[3] * er4.w));
                }
            }
            asm volatile("s_waitcnt lgkmcnt(0)" ::: "memory"); __builtin_amdgcn_s_barrier(); asm volatile("" ::: "memory");
        }
        asm volatile("s_waitcnt vmcnt(0)" ::: "memory");
        __syncthreads();
    }
}

DEV void phase_gla_readout(const Params& p) {
    const int tid = tid_opaque(), lane = tid & 63;
    const int gw = blockIdx.x * 8 + (tid >> 6), nw = gridDim.x * 8;
    unsigned char* ws = p.ws;
    const bf16_t* o0 = (const bf16_t*)(ws + WS_S + 4 * U_BYTES);
    const bf16_t* o1 = (const bf16_t*)(ws + WS_S + 2 * U_BYTES);
    const bf16_t* gb = (const bf16_t*)(ws + WS_S + 3 * U_BYTES);
    bf16_t* ao = (bf16_t*)(ws + WS_S + 0 * U_BYTES);
    const float4 hn = *(const float4*)(p.in[28] + lane * 4);
    for (int item0 = gw; item0 < NL * 4; item0 += 4 * nw) {
        uint2 a[4], b2[4], g2[4];
#pragma unroll
        for (int q = 0; q < 4; ++q) {
            const int item = min(item0 + q * nw, NL * 4 - 1);
            const size_t off = (size_t)(item >> 2) * 1024 + (item & 3) * 256 + lane * 4;
            a[q] = *(const uint2*)(o0 + off + (size_t)(item >> 2) * 1024); b2[q] = *(const uint2*)(o1 + off); g2[q] = *(const uint2*)(gb + off);
        }
        float v[4][4], ss[4];
#pragma unroll
        for (int q = 0; q < 4; ++q) {
            v[q][0] = bf_lo(a[q].x) + bf_lo(b2[q].x); v[q][1] = bf_hi(a[q].x) + bf_hi(b2[q].x); v[q][2] = bf_lo(a[q].y) + bf_lo(b2[q].y); v[q][3] = bf_hi(a[q].y) + bf_hi(b2[q].y);
            ss[q] = v[q][0] * v[q][0] + v[q][1] * v[q][1] + v[q][2] * v[q][2] + v[q][3] * v[q][3];
        }
#pragma unroll
        for (int q = 0; q < 4; ++q) ss[q] = wave_allreduce(ss[q]);
#pragma unroll
        for (int q = 0; q < 4; ++q) {
            const int item = item0 + q * nw;
            if (item < NL * 4) {
                const size_t off = (size_t)(item >> 2) * 1024 + (item & 3) * 256 + lane * 4;
                const float rs = rsqrtf(ss[q] * (1.0f / 256.0f) + 1e-6f);
                const float g0 = bf_lo(g2[q].x), g1 = bf_hi(g2[q].x), g2f = bf_lo(g2[q].y), g3 = bf_hi(g2[q].y);
                const float r0 = v[q][0] * rs * hn.x * (g0 * sigmoidf_(g0)), r1 = v[q][1] * rs * hn.y * (g1 * sigmoidf_(g1));
                const float r2 = v[q][2] * rs * hn.z * (g2f * sigmoidf_(g2f)), r3 = v[q][3] * rs * hn.w * (g3 * sigmoidf_(g3));
                *(uint2*)(ao + off) = make_uint2(pk_bf16(r0, r1), pk_bf16(r2, r3));
            }
        }
    }
}


#define XB_TMO      128
#define XB_XCNT(j)  (256  + 64 * (j))
#define XB_XSUB(j)  (1280 + 64 * (j))
#define XB_XGEN(j)  (2304 + 64 * (j))
#define XB_TOP      3328
#define XB_TOPGEN   3392
#define XB_SPIN_CAP (1u << 22)
DEV unsigned xb_ld(unsigned* p) { return __hip_atomic_load(p, __ATOMIC_RELAXED, __HIP_MEMORY_SCOPE_AGENT); }
DEV unsigned xb_add(unsigned* p, unsigned v) { return __hip_atomic_fetch_add(p, v, __ATOMIC_RELAXED, __HIP_MEMORY_SCOPE_AGENT); }
DEV unsigned xb_xcc_id() { return (unsigned)__builtin_amdgcn_s_getreg((3 << 11) | 20) & 0xFu; }
#define XB_SPIN(cond, bar) do { unsigned _sp = 0; while (cond) { __builtin_amdgcn_s_sleep(1); \
    if ((++_sp & 255u) == 0u) { if (xb_ld(&(bar)[XB_TMO])) break; if (_sp > XB_SPIN_CAP) { atomicAdd(&(bar)[XB_TMO], 1u); break; } } } } while (0)
DEV void xcd_barrier_complete(unsigned* bar, unsigned x, unsigned& nloc, unsigned& nx) {
    const unsigned G = gridDim.x;
    unsigned sum, cnt, mine, sp = 0u;
    for (;;) {
        sum = 0u; cnt = 0u; mine = 0u;
#pragma unroll
        for (unsigned j = 0; j < 16; ++j) { const unsigned c = xb_ld(&bar[XB_XCNT(j)]); sum += c; cnt += (c > 0u) ? 1u : 0u; mine = (j == x) ? c : mine; }
        if (sum == G) break;
        __builtin_amdgcn_s_sleep(1);
        if ((++sp & 255u) == 0u) { if (xb_ld(&bar[XB_TMO])) break; if (sp > XB_SPIN_CAP) { atomicAdd(&bar[XB_TMO], 1u); break; } }
    }
    nloc = mine > 0u ? mine : 1u; nx = cnt > 0u ? cnt : 1u;
}
DEV void xcd_barrier(unsigned* bar, volatile LAS3 unsigned* st) {
    asm volatile("s_waitcnt vmcnt(0)" ::: "memory");
    __syncthreads();
    if (tid_opaque() == 0) {
        const unsigned x = xb_xcc_id();
        __builtin_amdgcn_s_waitcnt(0);
        unsigned nloc = st[0], nx = st[1];
        if (nloc == 0u) { xcd_barrier_complete(bar, x, nloc, nx); st[0] = nloc; st[1] = nx; }
        const unsigned old = xb_add(&bar[XB_XSUB(x)], 1u);
        const unsigned gen = old / nloc;
        if (old + 1u == (gen + 1u) * nloc) {
            __builtin_amdgcn_fence(__ATOMIC_RELEASE, "agent");
            asm volatile("s_waitcnt vmcnt(0)" ::: "memory");
            const unsigned og = xb_add(&bar[XB_TOP], 1u);
            const unsigned tg = og / nx;
            if (og + 1u == (tg + 1u) * nx) xb_add(&bar[XB_TOPGEN], 1u);
            else XB_SPIN(xb_ld(&bar[XB_TOPGEN]) == tg, bar);
            __builtin_amdgcn_fence(__ATOMIC_ACQUIRE, "agent");
            xb_add(&bar[XB_XGEN(x)], 1u);
            asm volatile("s_waitcnt vmcnt(0)" ::: "memory");
        } else {
            XB_SPIN(xb_ld(&bar[XB_XGEN(x)]) == gen, bar);
            __builtin_amdgcn_fence(__ATOMIC_ACQUIRE, "agent");
            asm volatile("s_waitcnt vmcnt(0)" ::: "memory");
        }
    }
    __syncthreads();
}
#define SYNC() do { asm volatile("s_waitcnt vmcnt(0)" ::: "memory"); grid.sync(); \
    if (tid_opaque() == 0) { __builtin_amdgcn_fence(__ATOMIC_ACQUIRE, "agent"); asm volatile("s_waitcnt vmcnt(0)" ::: "memory"); } \
    __syncthreads(); } while (0)
__global__ void __launch_bounds__(NTHREADS) mega_fwd(Params p) {
    unsigned char* const lds = g_lds;
    cg::grid_group grid = cg::this_grid();
#define XBAR ((unsigned*)(p.ws + WS_BAR))
#define XST ((volatile LAS3 unsigned*)(lds + LDS_BYTES - 16))
    if ((threadIdx.x & 63) == 0) g_lds[LDS_WTAB + hw_wave_slot()] = (unsigned char)(threadIdx.x >> 6);
    if (threadIdx.x == 0) { XST[0] = 0u; XST[1] = 0u; (void)xb_add(&XBAR[XB_XCNT(xb_xcc_id())], 1u); }
    __syncthreads();
#define S0 ((bf16_t*)(p.ws + WS_S + 0 * U_BYTES))
#define SLOT(i) ((bf16_t*)(p.ws + WS_S + (size_t)(i) * U_BYTES))
#define S1 ((bf16_t*)(p.ws + WS_S + 1 * U_BYTES))
#define CTXR ((const bf16_t*)(p.ws + WS_CTXR))
#define XSL ((const bf16_t*)p.out)
    phase0(p, lds); SYNC();
#undef SYNC
#define SYNC() xcd_barrier(XBAR, XST)
    phase_normmix(p, S0, SLOT(5), SLOT(1), SLOT(2)); SYNC();
    phase_rw_proj1(p, lds, 0, SLOT(5), SLOT(3), 1); SYNC();
    phase_rw_proj1(p, lds, 1, SLOT(1), SLOT(5), 1); SYNC();
    phase_rw_proj1(p, lds, 2, SLOT(2), SLOT(1), 0); phase_rw_lora(p, lds, SLOT(2), SLOT(1)); SYNC();
    REPEAT(3, phase_rw_scan(p, lds));
    phase_rw_scan(p, lds); SYNC();
    REPEAT(4, phase_rw_readout(p));
    phase_rw_readout(p); SYNC();
    REPEAT(5, phase_wo(p, lds, 0));
    phase_wo(p, lds, 0); SYNC();
    REPEAT(6, phase_normmod(p, 0, 1, XSL, CTXR, NT, S1, (unsigned char*)SLOT(2)));
    phase_normmod(p, 0, 1, XSL, CTXR, NT, S1, (unsigned char*)SLOT(2)); SYNC();
    REPEAT(7, phase_peer_select(p, lds, 0));
    phase_peer_select(p, lds, 0); SYNC();
    phase_peer_u(p, lds, 0); SYNC();
    phase_peer_c(p, 0); SYNC();
    phase_peer_v(p, 0); SYNC();
    phase_normmod(p, 1, 0, XSL, CTXR, NT, S0, nullptr); SYNC();
    REPEAT(9, phase_gla_proj(p, lds));
    phase_gla_proj(p, lds); SYNC();
    REPEAT(10, phase_gla_conv(p));
    phase_gla_conv(p); SYNC();
    REPEAT(18, phase_gla_prep(p, lds));
    phase_gla_prep(p, lds); SYNC();
    REPEAT(11, phase_gla_scan(p, lds));
    phase_gla_scan(p, lds); SYNC();
    REPEAT(12, phase_gla_readout(p));
    phase_gla_readout(p); SYNC();
    phase_wo(p, lds, 1); SYNC();
    REPEAT(14, phase_normmod(p, 1, 1, XSL, CTXR, NL, S0, (unsigned char*)SLOT(2)));
    phase_normmod(p, 1, 1, XSL, CTXR, NL, S0, (unsigned char*)SLOT(2)); SYNC();
    REPEAT(15, phase_peer_select(p, lds, 1));
    phase_peer_select(p, lds, 1); SYNC();
    phase_peer_u(p, lds, 1); SYNC();
    phase_peer_c(p, 1); SYNC();
    phase_peer_v(p, 1); SYNC();
    phase_final_norm(p);
}

extern "C" void kernel_launch(void* const* d_in, const int* in_sizes, int n_in, void* d_out, int out_size, void* d_ws, size_t ws_size, hipStream_t stream) {
    static int grid_blocks = 0;
    if (grid_blocks == 0) {
        if (n_in != 35 || ws_size < WS_TOTAL) { fprintf(stderr, "kernel_launch: unexpected n_in %d or ws_size %zu (< %zu)\n", n_in, ws_size, (size_t)WS_END); grid_blocks = -1; return; }
        int dev = 0, cus = 0, per_cu = 0;
        if (hipGetDevice(&dev) != hipSuccess || hipDeviceGetAttribute(&cus, hipDeviceAttributeMultiprocessorCount, dev) != hipSuccess) { fprintf(stderr, "kernel_launch: device query failed\n"); grid_blocks = -1; return; }
        if (hipFuncSetAttribute((const void*)mega_fwd, hipFuncAttributeMaxDynamicSharedMemorySize, LDS_BYTES) != hipSuccess) { fprintf(stderr, "kernel_launch: hipFuncSetAttribute failed\n"); grid_blocks = -1; return; }
        if (hipOccupancyMaxActiveBlocksPerMultiprocessor(&per_cu, (const void*)mega_fwd, NTHREADS, LDS_BYTES) != hipSuccess || per_cu < 1) { fprintf(stderr, "kernel_launch: occupancy query says %d blocks per CU\n", per_cu); grid_blocks = -1; return; }
        grid_blocks = cus;
    }
    if (grid_blocks < 0) return;
    Params p{};
    for (int i = 0; i < 35; ++i) p.in[i] = (const float*)d_in[i];
    p.out = (float*)d_out;
    p.ws = (unsigned char*)d_ws;
    if (hipMemsetAsync((char*)d_ws + WS_BAR, 0, 16384, stream) != hipSuccess) { fprintf(stderr, "kernel_launch: hipMemsetAsync failed\n"); return; }
    void* args[] = {&p};
    hipError_t e = hipLaunchCooperativeKernel((const void*)mega_fwd, dim3(grid_blocks), dim3(NTHREADS), args, LDS_BYTES, stream);
    if (e != hipSuccess) fprintf(stderr, "kernel_launch: cooperative launch failed: %s (grid %d)\n", hipGetErrorString(e), grid_blocks);
}
```
